# Optimizing an MI355X kernel written in HIP

```python
import math
import jax, jax.numpy as jnp
from jax import lax
import numpy as np

D_MODEL = 1024
BATCH = 8
SEQ = 4096
DEPTH = 2

N_MIXERS = 2
N_MLA_LAYERS = (DEPTH + N_MIXERS - 1) // N_MIXERS
N_HYENA_LAYERS = DEPTH // N_MIXERS

MLA_HEADS = 8
Q_LORA = 256
KV_LORA = 128
QK_NOPE = 128
QK_ROPE = 64
QK_HEAD = QK_NOPE + QK_ROPE
V_HEAD = 128
ROPE_HALF = QK_ROPE // 2
ROPE_THETA = 10000.0
Q_BLOCK = 128

HYENA_ORDER = 2
SHORT_CONV = 3
FILTER_EMB = 33
FILTER_BANDS = (FILTER_EMB - 1) // 2
FILTER_WIDTH = 64
FAST_DECAY = 0.3
SLOW_DECAY = 1.5
DECAY_TARGET = 1e-2

N_GROUPS = 4
EXPERTS_PER_GROUP = 4
N_EXPERTS = N_GROUPS * EXPERTS_PER_GROUP
TOP_K = 2
D_EXPERT = 256

EPS = 1e-6

kernel_name = "hybrid_mla_hyena_hmoe_encoder"


def rms_norm(x, g):
    xf = x.astype(jnp.float32)
    y = xf * lax.rsqrt(jnp.mean(xf * xf, axis=-1, keepdims=True) + EPS)
    return (y * g.astype(jnp.float32)).astype(x.dtype)


def modulate(h, shift, scale):
    return h * (1 + scale[:, None, :]) + shift[:, None, :]


def rope_tables(positions):
    inv_freq = 1.0 / (ROPE_THETA ** (jnp.arange(0, QK_ROPE, 2, dtype=jnp.float32) / QK_ROPE))
    ang = positions.astype(jnp.float32)[..., None] * inv_freq
    return jnp.cos(ang), jnp.sin(ang)


def apply_rope(x, cos, sin):
    xf = x.astype(jnp.float32)
    x1, x2 = xf[..., :ROPE_HALF], xf[..., ROPE_HALF:]
    return jnp.concatenate([x1 * cos - x2 * sin, x1 * sin + x2 * cos], axis=-1).astype(x.dtype)


def mla_mixer(h, cos, sin, w_down, q_a_g, kv_a_g, w_uq, w_ukv, q_norm_g, k_norm_g, w_o):
    B, S, _ = h.shape
    lat = h @ w_down
    c_q = lat[..., :Q_LORA]
    c_kv = lat[..., Q_LORA:Q_LORA + KV_LORA]
    k_pe = lat[..., Q_LORA + KV_LORA:]
    q = (rms_norm(c_q, q_a_g) @ w_uq).reshape(B, S, MLA_HEADS, QK_HEAD)
    kv = (rms_norm(c_kv, kv_a_g) @ w_ukv).reshape(B, S, MLA_HEADS, QK_NOPE + V_HEAD)
    cos_h, sin_h = cos[:, :, None, :], sin[:, :, None, :]
    q_nope = rms_norm(q[..., :QK_NOPE], q_norm_g[:QK_NOPE])
    q_pe = apply_rope(rms_norm(q[..., QK_NOPE:], q_norm_g[QK_NOPE:]), cos_h, sin_h)
    k_nope = rms_norm(kv[..., :QK_NOPE], k_norm_g[:QK_NOPE])
    k_pe = apply_rope(rms_norm(k_pe, k_norm_g[QK_NOPE:]), cos, sin)
    v = kv[..., QK_NOPE:]
    q = jnp.concatenate([q_nope, q_pe], axis=-1)
    k = jnp.concatenate([k_nope, jnp.broadcast_to(k_pe[:, :, None, :], (B, S, MLA_HEADS, QK_ROPE))], axis=-1)
    scale = QK_HEAD ** -0.5
    n_blk = S // Q_BLOCK
    q_blocks = q.reshape(B, n_blk, Q_BLOCK, MLA_HEADS, QK_HEAD).transpose(1, 0, 2, 3, 4)

    def attend(q_blk):
        s = jnp.einsum('bqhd,bkhd->bhqk', q_blk, k, preferred_element_type=jnp.float32) * scale
        p = jax.nn.softmax(s, axis=-1).astype(v.dtype)
        return jnp.einsum('bhqk,bkhd->bqhd', p, v)

    o = lax.map(attend, q_blocks)
    o = o.transpose(1, 0, 2, 3, 4).reshape(B, S, MLA_HEADS * V_HEAD)
    return o @ w_o


def hyena_filters(L, w1, b1, f1, w2, b2, f2, w3, b3, f3, w4):
    f32 = jnp.float32
    t = jnp.linspace(0.0, 1.0, L, dtype=f32)[:, None]
    w = 2.0 * math.pi * jnp.arange(L, dtype=f32)[:, None] / L
    fr = jnp.linspace(1e-4, FILTER_BANDS - 1, FILTER_BANDS, dtype=f32)[None, :]
    z = jnp.concatenate([t, jnp.cos(fr * w), -jnp.sin(fr * w)], axis=-1)
    hdn = jnp.sin(f1.astype(f32) * (z @ w1.astype(f32) + b1.astype(f32)))
    hdn = jnp.sin(f2.astype(f32) * (hdn @ w2.astype(f32) + b2.astype(f32)))
    hdn = jnp.sin(f3.astype(f32) * (hdn @ w3.astype(f32) + b3.astype(f32)))
    h = (hdn @ w4.astype(f32)).reshape(L, HYENA_ORDER, 2, D_MODEL)
    deltas = jnp.abs(jnp.linspace(math.log(FAST_DECAY) / DECAY_TARGET,
                                  math.log(SLOW_DECAY) / DECAY_TARGET, D_MODEL, dtype=f32))
    decay = jnp.exp(-t * deltas)
    h = h * decay[:, None, None, :]
    return h / (jnp.sum(jnp.abs(h), axis=0, keepdims=True) + EPS)


def bidir_long_conv(u, h_fwd, h_bwd, bias):
    B, L, D = u.shape
    k2 = jnp.concatenate([h_fwd, jnp.zeros((1, D), jnp.float32), h_bwd[:0:-1]], axis=0)
    k_f = jnp.fft.rfft(k2, axis=0)
    u_f = jnp.fft.rfft(u.astype(jnp.float32), n=2 * L, axis=1)
    y = jnp.fft.irfft(u_f * k_f[None], n=2 * L, axis=1)[:, :L]
    return (y + u.astype(jnp.float32) * bias.astype(jnp.float32)).astype(u.dtype)


def hyena_mixer(h, w_in, b_in, conv_w, conv_b, f_w1, f_b1, f_freq1, f_w2, f_b2, f_freq2,
                f_w3, f_b3, f_freq3, f_w4, filt_bias, w_out):
    B, L, _ = h.shape
    C = 3 * D_MODEL
    u = h @ w_in + b_in
    u = lax.conv_general_dilated(u, conv_w[:, None, :].astype(u.dtype), window_strides=(1,),
                                 padding=((SHORT_CONV // 2, SHORT_CONV // 2),),
                                 dimension_numbers=('NWC', 'WIO', 'NWC'),
                                 feature_group_count=C) + conv_b
    x1, x2, v = jnp.split(u, 3, axis=-1)
    filt = hyena_filters(L, f_w1, f_b1, f_freq1, f_w2, f_b2, f_freq2, f_w3, f_b3, f_freq3, f_w4)
    z = v
    for o, gate in enumerate((x1, x2)):
        z = gate * bidir_long_conv(z, filt[:, o, 0], filt[:, o, 1], filt_bias[o])
    return z @ w_out


def hier_moe(h, wg, bg, we, be, w_gate, w_up, w_down):
    B, S, D = h.shape
    t = h.reshape(B * S, D)
    T = t.shape[0]
    g_prob = jax.nn.softmax((t @ wg).astype(jnp.float32) + bg.astype(jnp.float32), axis=-1)
    g_w, g_idx = lax.top_k(g_prob, 1)
    e_logits = ((t @ we).astype(jnp.float32) + be.astype(jnp.float32)).reshape(T, N_GROUPS, EXPERTS_PER_GROUP)
    e_logits = jnp.take_along_axis(e_logits, g_idx[:, :, None], axis=1)[:, 0]
    e_w, e_idx = lax.top_k(jax.nn.softmax(e_logits, axis=-1), TOP_K)
    weights = g_w * (e_w / jnp.sum(e_w, axis=-1, keepdims=True))
    expert = g_idx * EXPERTS_PER_GROUP + e_idx
    combine = jnp.sum(jax.nn.one_hot(expert, N_EXPERTS, dtype=jnp.float32) * weights[..., None], axis=1)
    combine = combine.astype(t.dtype)
    out = jnp.zeros_like(t)
    for e in range(N_EXPERTS):
        a = jax.nn.silu(t @ w_gate[e]) * (t @ w_up[e])
        out = out + combine[:, e:e + 1] * (a @ w_down[e])
    return out.reshape(B, S, D)


def setup_inputs(seed: int = 0) -> dict:
    key = jax.random.key(seed)
    ks = iter(jax.random.split(key, 64))
    D = D_MODEL
    NA, NH = N_MLA_LAYERS, N_HYENA_LAYERS

    def nrm(shape, scale):
        return jax.random.normal(next(ks), shape, jnp.float32) * scale

    def gain(shape):
        return 1.0 + nrm(shape, 0.02)

    x = nrm((BATCH, SEQ, D), 1.0)
    c = nrm((BATCH, D), 1.0)
    offs = jax.random.randint(next(ks), (BATCH, 1), 0, 1024, dtype=jnp.int32)
    positions = offs + jnp.arange(SEQ, dtype=jnp.int32)[None, :]
    return {
        "x": x, "c": c, "positions": positions,
        "ada_w": nrm((DEPTH, D, 6 * D), 0.5 * D ** -0.5),
        "ada_b": nrm((DEPTH, 6 * D), 0.02),
        "norm_mix_g": gain((DEPTH, D)),
        "norm_ffn_g": gain((DEPTH, D)),
        "mla_w_down": nrm((NA, D, Q_LORA + KV_LORA + QK_ROPE), D ** -0.5),
        "mla_q_a_g": gain((NA, Q_LORA)),
        "mla_kv_a_g": gain((NA, KV_LORA)),
        "mla_w_uq": nrm((NA, Q_LORA, MLA_HEADS * QK_HEAD), Q_LORA ** -0.5),
        "mla_w_ukv": nrm((NA, KV_LORA, MLA_HEADS * (QK_NOPE + V_HEAD)), KV_LORA ** -0.5),
        "mla_q_norm_g": gain((NA, QK_HEAD)),
        "mla_k_norm_g": gain((NA, QK_HEAD)),
        "mla_w_o": nrm((NA, MLA_HEADS * V_HEAD, D), (MLA_HEADS * V_HEAD) ** -0.5),
        "hy_w_in": nrm((NH, D, 3 * D), D ** -0.5),
        "hy_b_in": nrm((NH, 3 * D), 0.02),
        "hy_conv_w": nrm((NH, SHORT_CONV, 3 * D), SHORT_CONV ** -0.5),
        "hy_conv_b": nrm((NH, 3 * D), 0.02),
        "hy_f_w1": nrm((NH, FILTER_EMB, FILTER_WIDTH), FILTER_EMB ** -0.5),
        "hy_f_b1": nrm((NH, FILTER_WIDTH), 0.1),
        "hy_f_freq1": gain((NH, FILTER_WIDTH)),
        "hy_f_w2": nrm((NH, FILTER_WIDTH, FILTER_WIDTH), FILTER_WIDTH ** -0.5),
        "hy_f_b2": nrm((NH, FILTER_WIDTH), 0.1),
        "hy_f_freq2": gain((NH, FILTER_WIDTH)),
        "hy_f_w3": nrm((NH, FILTER_WIDTH, FILTER_WIDTH), FILTER_WIDTH ** -0.5),
        "hy_f_b3": nrm((NH, FILTER_WIDTH), 0.1),
        "hy_f_freq3": gain((NH, FILTER_WIDTH)),
        "hy_f_w4": nrm((NH, FILTER_WIDTH, HYENA_ORDER * 2 * D), FILTER_WIDTH ** -0.5),
        "hy_filt_bias": nrm((NH, HYENA_ORDER, D), 1.0),
        "hy_w_out": nrm((NH, D, D), D ** -0.5),
        "moe_wg": nrm((DEPTH, D, N_GROUPS), D ** -0.5),
        "moe_bg": nrm((DEPTH, N_GROUPS), 0.01),
        "moe_we": nrm((DEPTH, D, N_EXPERTS), D ** -0.5),
        "moe_be": nrm((DEPTH, N_EXPERTS), 0.01),
        "moe_w_gate": nrm((DEPTH, N_EXPERTS, D, D_EXPERT), D ** -0.5),
        "moe_w_up": nrm((DEPTH, N_EXPERTS, D, D_EXPERT), D ** -0.5),
        "moe_w_down": nrm((DEPTH, N_EXPERTS, D_EXPERT, D), D_EXPERT ** -0.5),
    }


def reference(x, c, positions, ada_w, ada_b, norm_mix_g, norm_ffn_g,
              mla_w_down, mla_q_a_g, mla_kv_a_g, mla_w_uq, mla_w_ukv, mla_q_norm_g, mla_k_norm_g, mla_w_o,
              hy_w_in, hy_b_in, hy_conv_w, hy_conv_b,
              hy_f_w1, hy_f_b1, hy_f_freq1, hy_f_w2, hy_f_b2, hy_f_freq2,
              hy_f_w3, hy_f_b3, hy_f_freq3, hy_f_w4, hy_filt_bias, hy_w_out,
              moe_wg, moe_bg, moe_we, moe_be, moe_w_gate, moe_w_up, moe_w_down):
    cos, sin = rope_tables(positions)
    c_act = jax.nn.silu(c.astype(jnp.float32))
    for i in range(DEPTH):
        mod = (c_act @ ada_w[i].astype(jnp.float32) + ada_b[i].astype(jnp.float32)).astype(x.dtype)
        sh1, sc1, g1, sh2, sc2, g2 = jnp.split(mod, 6, axis=-1)
        h = modulate(rms_norm(x, norm_mix_g[i]), sh1, sc1)
        j = i // N_MIXERS
        if i % N_MIXERS == 0:
            y = mla_mixer(h, cos, sin, mla_w_down[j], mla_q_a_g[j], mla_kv_a_g[j], mla_w_uq[j],
                          mla_w_ukv[j], mla_q_norm_g[j], mla_k_norm_g[j], mla_w_o[j])
        else:
            y = hyena_mixer(h, hy_w_in[j], hy_b_in[j], hy_conv_w[j], hy_conv_b[j],
                            hy_f_w1[j], hy_f_b1[j], hy_f_freq1[j], hy_f_w2[j], hy_f_b2[j], hy_f_freq2[j],
                            hy_f_w3[j], hy_f_b3[j], hy_f_freq3[j], hy_f_w4[j], hy_filt_bias[j], hy_w_out[j])
        x = x + g1[:, None, :] * y
        h = modulate(rms_norm(x, norm_ffn_g[i]), sh2, sc2)
        x = x + g2[:, None, :] * hier_moe(h, moe_wg[i], moe_bg[i], moe_we[i], moe_be[i],
                                          moe_w_gate[i], moe_w_up[i], moe_w_down[i])
    return x
```

```cpp
#include <hip/hip_runtime.h>
#include <cstdio>
#include <cstdint>
namespace pg8 {
#define PG8_LAS __attribute__((address_space(3)))
typedef unsigned short bf16_t;
typedef short bf16x8 __attribute__((ext_vector_type(8)));
typedef float f32x4 __attribute__((ext_vector_type(4)));
typedef unsigned u32x4 __attribute__((ext_vector_type(4)));
constexpr int BM = 256, BK = 64, HALF = 128, HTB = HALF * BK * 2  , STAGE_BYTES = 8 * HTB, NXCD = 8, WGM = 8;

__host__ __device__ __forceinline__ int lds_byte(int r, int c) { const int st = (r >> 4) * 2 + (c >> 5), rr = r & 15, cc = c & 31, ob = rr * 64 + cc * 2; return st * 1024 + (ob ^ (((ob >> 9) & 1) << 5)); }
__host__ __device__ __forceinline__ void stage_rc(int b, int& R, int& C) { const int st = b / 1024, sb = b % 1024, swz = sb ^ (((sb >> 9) & 1) << 5); R = (st >> 1) * 16 + swz / 64; C = (st & 1) * 32 + (swz % 64) / 2; }
__host__ __device__ __forceinline__ int perm32(int rho) { const int n = rho >> 4, i = rho & 15; return 8 * (i >> 2) + 4 * n + (i & 3); }

struct Unit { int pm, pn; };
struct Gemm { const bf16_t* A; const bf16_t* Bt; int M, N, K; };

struct StaticOrder {
    int nM, nN, nwg, G, c;
    __host__ __device__ void init(int M, int N, int G_, int c_) { nM = M / BM; nN = N / BM; nwg = nM * nN; G = G_; c = c_; }
    __host__ __device__ bool next(int i, Unit& u) const {
        const long L = (long)i * G + c; if (L >= nwg) return false;
        int wgid = (int)L; { const int q = nwg / NXCD, r = nwg % NXCD, xcd = wgid % NXCD, off = wgid / NXCD; wgid = (xcd < r ? xcd * (q + 1) : r * (q + 1) + (xcd - r) * q) + off; }
        const int nig = WGM * nN, gid = wgid / nig, fm = gid * WGM, gsz = (nM - fm) < WGM ? (nM - fm) : WGM;
        u.pm = fm + ((wgid % nig) % gsz); u.pn = (wgid % nig) / gsz; return true;
    }
    __device__ __forceinline__ void a_ready(const Unit&) const {}
    __device__ __forceinline__ void done(const Unit&) const {}
};

__device__ __forceinline__ unsigned cvt_pk_bf16(float lo, float hi) { unsigned r; asm volatile("v_cvt_pk_bf16_f32 %0, %1, %2" : "=v"(r) : "v"(lo), "v"(hi)); return r; }
typedef float f32x2 __attribute__((ext_vector_type(2)));
typedef unsigned u32x2 __attribute__((ext_vector_type(2)));
struct EpiF32 {
    static constexpr bool PERM = false, AFTER_DRAIN = false;
    float* C; int ldc;
    __device__ __forceinline__ void operator()(const f32x4 (&acc)[2][2][4][2], const Unit& u, int wr, int wc, int fr, int fq) const {
        const int row0 = u.pm * BM + wr * 64 + fr, col0 = u.pn * BM + wc * 32 + 4 * fq;
#pragma unroll
        for (int ai = 0; ai < 2; ++ai)
#pragma unroll
            for (int m = 0; m < 4; ++m) { float* rowp = C + (size_t)(row0 + ai * HALF + m * 16) * ldc + col0;
#pragma unroll
                for (int bj = 0; bj < 2; ++bj)
#pragma unroll
                    for (int n = 0; n < 2; ++n) *(f32x4*)(rowp + bj * HALF + n * 16) = acc[ai][bj][m][n]; }
    }
};
struct EpiBf16R {
    static constexpr bool PERM = true, AFTER_DRAIN = false;
    bf16_t* O; int ldc; const float* rowbias;
    __device__ __forceinline__ void operator()(const f32x4 (&acc)[2][2][4][2], const Unit& u, int wr, int wc, int fr, int fq) const {
        const int row0 = u.pm * BM + wr * 64 + fr, col0 = u.pn * BM + wc * 32 + 8 * fq;
#pragma unroll
        for (int ai = 0; ai < 2; ++ai)
#pragma unroll
            for (int m = 0; m < 4; ++m) { const int row = row0 + ai * HALF + m * 16; bf16_t* rowp = O + (size_t)row * ldc + col0; const float rb = rowbias ? rowbias[row] : 0.f;
#pragma unroll
                for (int bj = 0; bj < 2; ++bj) { const f32x4 v0 = acc[ai][bj][m][0] + rb, v1 = acc[ai][bj][m][1] + rb;
                    u32x4 w; w.x = cvt_pk_bf16(v0[0], v0[1]); w.y = cvt_pk_bf16(v0[2], v0[3]); w.z = cvt_pk_bf16(v1[0], v1[1]); w.w = cvt_pk_bf16(v1[2], v1[3]);
                    *(u32x4*)(rowp + bj * HALF) = w; } }
    }
};
struct EpiResGate {
    static constexpr bool PERM = false, AFTER_DRAIN = false;
    const float* base; float* out; const float* gate; int ldc;
    __device__ __forceinline__ void operator()(const f32x4 (&acc)[2][2][4][2], const Unit& u, int wr, int wc, int fr, int fq) const {
        const int row0 = u.pm * BM + wr * 64 + fr, col0 = u.pn * BM + wc * 32 + 4 * fq;
        const float* gp = gate + (size_t)(u.pm >> 4) * 6144 + col0;
        f32x4 gv[2][2];
#pragma unroll
        for (int bj = 0; bj < 2; ++bj)
#pragma unroll
            for (int n = 0; n < 2; ++n) gv[bj][n] = *(const f32x4*)(gp + bj * HALF + n * 16);
#pragma unroll
        for (int ai = 0; ai < 2; ++ai)
#pragma unroll
            for (int m = 0; m < 4; ++m) { const size_t off = (size_t)(row0 + ai * HALF + m * 16) * ldc + col0;
#pragma unroll
                for (int bj = 0; bj < 2; ++bj)
#pragma unroll
                    for (int n = 0; n < 2; ++n) { const f32x4 bs = *(const f32x4*)(base + off + bj * HALF + n * 16); *(f32x4*)(out + off + bj * HALF + n * 16) = bs + gv[bj][n] * acc[ai][bj][m][n]; }
                asm volatile("" ::: "memory"); }
    }
};
__device__ __forceinline__ void pair_of(int pi, int& i, int& j) { i = pi < 3 ? 0 : (pi < 5 ? 1 : 2); j = pi < 3 ? pi + 1 : (pi < 5 ? pi - 1 : 3); }
struct MoeOrder {
    const PG8_LAS int* tinfo; int G, c, mode;
    __device__ __forceinline__ bool next(int i, Unit& u) const {
        const long L = (long)i * G + c; const int nt = tinfo[0]; if (L >= 4L * nt) return false;
        const int mt = (int)(L >> 2), q = (int)(L & 3), bk = tinfo[1 + mt];
        u.pm = mt;
        if (mode == 0) { int ii, jj; pair_of(bk % 6, ii, jj); const int e = (bk / 6) * 4 + ((q >> 1) ? jj : ii); u.pn = e * 2 + (q & 1); }
        else u.pn = bk * 4 + q;
        return true;
    }
    __device__ __forceinline__ void a_ready(const Unit&) const {}
    __device__ __forceinline__ void done(const Unit&) const {}
};
struct EpiSwiGLU {
    static constexpr bool PERM = true, AFTER_DRAIN = false;
    bf16_t* H; const int* tokw; const PG8_LAS int* tinfo;
    __device__ __forceinline__ void operator()(const f32x4 (&acc)[2][2][4][2], const Unit& u, int wr, int wc, int, int) const {
        int ln = threadIdx.x & 63; asm volatile("" : "+v"(ln)); const int fr = ln & 15, fq = ln >> 4;
        const int bk = tinfo[1 + u.pm]; int ii, jj; pair_of(bk % 6, ii, jj);
        const int e = u.pn >> 1, hh = u.pn & 1, slot = (e == (bk / 6) * 4 + jj) ? 1 : 0;
        const int row0 = u.pm * BM + wr * 64 + fr, col0 = slot * 256 + hh * 128 + wc * 32 + 8 * fq;
#pragma unroll
        for (int ai = 0; ai < 2; ++ai)
#pragma unroll
            for (int m = 0; m < 4; ++m) { const int row = row0 + ai * HALF + m * 16; const float w = __int_as_float(tokw[(size_t)row * 4 + 1 + slot]);
                float a[8];
#pragma unroll
                for (int n = 0; n < 2; ++n)
#pragma unroll
                    for (int j = 0; j < 4; ++j) { const float g = acc[ai][0][m][n][j], up = acc[ai][1][m][n][j];
                        const float sg = g * __builtin_amdgcn_rcpf(1.0f + __builtin_amdgcn_exp2f(-1.4426950408889634f * g)); a[n * 4 + j] = sg * up * w; }
                u32x4 o; o.x = cvt_pk_bf16(a[0], a[1]); o.y = cvt_pk_bf16(a[2], a[3]); o.z = cvt_pk_bf16(a[4], a[5]); o.w = cvt_pk_bf16(a[6], a[7]);
                *(u32x4*)(H + (size_t)row * 512 + col0) = o; asm volatile("" ::: "memory"); }
    }
};
struct EpiMoeOut {
    static constexpr bool PERM = false, AFTER_DRAIN = false;
    float* out; const float* gate; const int* tokw; const PG8_LAS int* tinfo;
    __device__ __forceinline__ void operator()(const f32x4 (&acc)[2][2][4][2], const Unit& u, int wr, int wc, int fr, int fq) const {
        const int bk = tinfo[1 + u.pm], r_end = tinfo[256 + bk] + tinfo[288 + bk];
        const int row0 = u.pm * BM + wr * 64 + fr, col0 = (u.pn & 3) * BM + wc * 32 + 4 * fq;
#pragma unroll
        for (int ai = 0; ai < 2; ++ai)
#pragma unroll
            for (int m = 0; m < 4; ++m) { const int row = row0 + ai * HALF + m * 16;
                if (row < r_end) { const int tok = tokw[(size_t)row * 4]; float* op = out + (size_t)tok * 1024 + col0; const float* gp = gate + (size_t)(tok >> 12) * 6144 + col0;
#pragma unroll
                    for (int bj = 0; bj < 2; ++bj)
#pragma unroll
                        for (int n = 0; n < 2; ++n) { const f32x4 bs = *(const f32x4*)(op + bj * HALF + n * 16), gv = *(const f32x4*)(gp + bj * HALF + n * 16); *(f32x4*)(op + bj * HALF + n * 16) = bs + gv * acc[ai][bj][m][n]; } }
                asm volatile("" ::: "memory"); }
    }
};
template <class Epi, class Sched, bool ALIGN_EPI = false, bool SP2 = false>
__device__ __forceinline__ void gemm_phase(PG8_LAS unsigned char* lds, const Gemm g, const Sched& S, const Epi& E) {
    const int tid = threadIdx.x, wid = __builtin_amdgcn_readfirstlane(tid >> 6), lane = tid & 63, wr = wid >> 2, wc = wid & 3, fr = lane & 15, fq = lane >> 4;
    int K = g.K; asm volatile("" : "+s"(K)); const int nt = K / BK;
    unsigned voffA[2], voffB[2];
#pragma unroll
    for (int i = 0; i < 2; ++i) { int R, C; stage_rc(tid * 16 + i * 8192, R, C); const int Rb = Epi::PERM ? ((R & ~31) + perm32(R & 31)) : R;
        voffA[i] = (unsigned)(R * K + C) * 2u; voffB[i] = (unsigned)(Rb * K + C) * 2u; }
    const size_t kstep = (size_t)(BK * 2);
    const size_t hstep = (size_t)HALF * K * 2;
    const size_t tstep = 2 * hstep;
    const unsigned ldsw = (unsigned)wid * 1024u;
    const int aoff = lds_byte(wr * 64 + fr, fq * 8), boff = lds_byte(wc * 32 + fr, fq * 8);
#define PG8_SA(b, h) (((b) * 2 + (h)) * HTB)
#define PG8_SB(b, h) ((4 + (b) * 2 + (h)) * HTB)
#define PG8_STAGE(bufoff, gbase, voff) do { _Pragma("unroll") for (int _i = 0; _i < 2; ++_i) \
        __builtin_amdgcn_global_load_lds((const unsigned*)((const char*)(gbase) + (voff)[_i]), (PG8_LAS unsigned*)(lds + (bufoff) + ldsw + _i * 8192), 16, 0, 0); } while (0)
#define PG8_LDA(dst, b, h) do { _Pragma("unroll") for (int m = 0; m < 4; ++m) _Pragma("unroll") for (int k = 0; k < 2; ++k) dst[m][k] = *(const PG8_LAS bf16x8*)(lds + PG8_SA(b, h) + aoff + m * 2048 + k * 1024); } while (0)
#define PG8_LDB(dst, b, h) do { _Pragma("unroll") for (int n = 0; n < 2; ++n) _Pragma("unroll") for (int k = 0; k < 2; ++k) dst[n][k] = *(const PG8_LAS bf16x8*)(lds + PG8_SB(b, h) + boff + n * 2048 + k * 1024); } while (0)
#define PG8_MMA(ai, bj, At, Bt) do { __builtin_amdgcn_s_setprio(1); _Pragma("unroll") for (int m = 0; m < 4; ++m) _Pragma("unroll") for (int n = 0; n < 2; ++n) _Pragma("unroll") for (int k = 0; k < 2; ++k) \
        acc[ai][bj][m][n] = __builtin_amdgcn_mfma_f32_16x16x32_bf16(Bt[n][k], At[m][k], acc[ai][bj][m][n], 0, 0, 0); __builtin_amdgcn_s_setprio(0); } while (0)
#define PG8_WAIT_V(n) asm volatile("s_waitcnt vmcnt(" #n ")" ::: "memory")
#define PG8_WAIT_L(n) asm volatile("s_waitcnt lgkmcnt(" #n ")" ::: "memory")
#define PG8_BAR __builtin_amdgcn_s_barrier()
#define PG8_SCHED __builtin_amdgcn_sched_barrier(0)
    Unit cur, nxt; int ui = 0;
    if (!S.next(0, cur)) return;
    f32x4 acc[2][2][4][2];
#pragma unroll
    for (int a = 0; a < 2; ++a)
#pragma unroll
        for (int b = 0; b < 2; ++b)
#pragma unroll
            for (int m = 0; m < 4; ++m)
#pragma unroll
                for (int n = 0; n < 2; ++n) acc[a][b][m][n] = (f32x4){0.f, 0.f, 0.f, 0.f};
    bf16x8 At[4][2], B0[2][2], B1[2][2];
    const char* cA = (const char*)g.A + (size_t)cur.pm * tstep; const char* cB = (const char*)g.Bt + (size_t)cur.pn * tstep;
    S.a_ready(cur);
    if constexpr (SP2) {
        PG8_STAGE(PG8_SB(0, 0), cB, voffB); PG8_STAGE(PG8_SB(0, 1), cB + hstep, voffB); PG8_STAGE(PG8_SA(0, 0), cA, voffA); PG8_STAGE(PG8_SA(0, 1), cA + hstep, voffA);
        if (wr == 1) PG8_BAR;
        PG8_WAIT_V(2); PG8_BAR;
        PG8_STAGE(PG8_SB(1, 0), cB + kstep, voffB); PG8_STAGE(PG8_SA(1, 0), cA + kstep, voffA); PG8_STAGE(PG8_SB(1, 1), cB + hstep + kstep, voffB);
        PG8_WAIT_V(6); PG8_BAR;
    } else {
        PG8_STAGE(PG8_SB(0, 0), cB, voffB); PG8_STAGE(PG8_SA(0, 0), cA, voffA); PG8_STAGE(PG8_SB(0, 1), cB + hstep, voffB); PG8_STAGE(PG8_SA(0, 1), cA + hstep, voffA);
        if (wr == 1) PG8_BAR;
        PG8_WAIT_V(4); PG8_BAR;
        PG8_STAGE(PG8_SB(1, 0), cB + kstep, voffB); PG8_STAGE(PG8_SA(1, 0), cA + kstep, voffA); PG8_STAGE(PG8_SB(1, 1), cB + hstep + kstep, voffB);
        PG8_WAIT_V(6); PG8_BAR;
    }
    for (;;) {
        const bool has_next = S.next(ui + 1, nxt);
        const char* nA = has_next ? (const char*)g.A + (size_t)nxt.pm * tstep : cA; const char* nB = has_next ? (const char*)g.Bt + (size_t)nxt.pn * tstep : cB;
        for (int t = 0; t < nt; t += 2) {
            const bool last = (t == nt - 2);
            const char* a1 = cA + (size_t)(t + 1) * kstep;
            const char* a2 = last ? nA : cA + (size_t)(t + 2) * kstep; const char* b2 = last ? nB : cB + (size_t)(t + 2) * kstep;
            const char* a3 = a2 + kstep; const char* b3 = b2 + kstep;
            if (last && has_next) S.a_ready(nxt);
            if constexpr (SP2) {
            PG8_LDB(B0, 0, 0); PG8_LDB(B1, 0, 1); PG8_SCHED; PG8_LDA(At, 0, 0); PG8_STAGE(PG8_SA(1, 1), a1 + hstep, voffA);
            PG8_WAIT_V(8); PG8_WAIT_L(0); PG8_BAR; PG8_MMA(0, 0, At, B0); PG8_MMA(0, 1, At, B1); PG8_BAR; PG8_SCHED;
            PG8_LDA(At, 0, 1); PG8_STAGE(PG8_SB(0, 0), b2, voffB); PG8_STAGE(PG8_SB(0, 1), b2 + hstep, voffB); PG8_STAGE(PG8_SA(0, 0), a2, voffA);
            PG8_WAIT_V(8); PG8_WAIT_L(0); PG8_BAR; PG8_MMA(1, 0, At, B0); PG8_MMA(1, 1, At, B1); PG8_BAR; PG8_SCHED;
            PG8_LDB(B0, 1, 0); PG8_LDB(B1, 1, 1); PG8_SCHED; PG8_LDA(At, 1, 0); PG8_STAGE(PG8_SA(0, 1), a2 + hstep, voffA);
            PG8_WAIT_V(8); PG8_WAIT_L(0); PG8_BAR; PG8_MMA(0, 0, At, B0); PG8_MMA(0, 1, At, B1); PG8_BAR; PG8_SCHED;
            PG8_LDA(At, 1, 1); PG8_STAGE(PG8_SB(1, 0), b3, voffB); PG8_STAGE(PG8_SB(1, 1), b3 + hstep, voffB); PG8_STAGE(PG8_SA(1, 0), a3, voffA);
            PG8_WAIT_V(8); PG8_WAIT_L(0); PG8_BAR; PG8_MMA(1, 0, At, B0); PG8_MMA(1, 1, At, B1); PG8_BAR; PG8_SCHED;
            } else {
            PG8_LDB(B0, 0, 0); PG8_SCHED; PG8_LDA(At, 0, 0); PG8_STAGE(PG8_SA(1, 1), a1 + hstep, voffA);
            PG8_WAIT_L(8); PG8_BAR; PG8_WAIT_L(0); PG8_MMA(0, 0, At, B0); PG8_BAR; PG8_SCHED;
            PG8_LDB(B1, 0, 1); PG8_STAGE(PG8_SB(0, 0), b2, voffB);
            PG8_BAR; PG8_WAIT_L(0); PG8_MMA(0, 1, At, B1); PG8_BAR;
            PG8_LDA(At, 0, 1); PG8_STAGE(PG8_SA(0, 0), a2, voffA);
            PG8_BAR; PG8_WAIT_L(0); PG8_MMA(1, 0, At, B0); PG8_BAR; PG8_SCHED;
            PG8_STAGE(PG8_SB(0, 1), b2 + hstep, voffB);
            PG8_WAIT_V(6); PG8_BAR; PG8_MMA(1, 1, At, B1); PG8_BAR;
            PG8_LDB(B0, 1, 0); PG8_SCHED; PG8_LDA(At, 1, 0); PG8_STAGE(PG8_SA(0, 1), a2 + hstep, voffA);
            PG8_WAIT_L(8); PG8_BAR; PG8_WAIT_L(0); PG8_MMA(0, 0, At, B0); PG8_BAR; PG8_SCHED;
            PG8_LDB(B1, 1, 1); PG8_STAGE(PG8_SB(1, 0), b3, voffB);
            PG8_BAR; PG8_WAIT_L(0); PG8_MMA(0, 1, At, B1); PG8_BAR;
            PG8_LDA(At, 1, 1); PG8_STAGE(PG8_SA(1, 0), a3, voffA);
            PG8_BAR; PG8_WAIT_L(0); PG8_MMA(1, 0, At, B0); PG8_BAR; PG8_SCHED;
            PG8_STAGE(PG8_SB(1, 1), b3 + hstep, voffB);
            PG8_WAIT_V(6); PG8_BAR; PG8_MMA(1, 1, At, B1); PG8_BAR;
            }
        }
        if constexpr (ALIGN_EPI) { if (wr == 0) PG8_BAR; }
        if constexpr (!Epi::AFTER_DRAIN) { E(acc, cur, wr, wc, fr, fq); S.done(cur); }
        if (!has_next) break;
#pragma unroll
        for (int a = 0; a < 2; ++a)
#pragma unroll
            for (int b = 0; b < 2; ++b)
#pragma unroll
                for (int m = 0; m < 4; ++m)
#pragma unroll
                    for (int n = 0; n < 2; ++n) acc[a][b][m][n] = (f32x4){0.f, 0.f, 0.f, 0.f};
        cur = nxt; cA = nA; cB = nB; ++ui;
        if constexpr (ALIGN_EPI) { if (wr == 1) PG8_BAR; }
    }
    PG8_WAIT_V(0);
    if constexpr (!ALIGN_EPI) { if (wr == 0) PG8_BAR; }
    PG8_BAR;
    if constexpr (Epi::AFTER_DRAIN) { E.fused(acc, cur, wr, wc, fr, fq, lds, wid, lane); S.done(cur); }
#undef PG8_SA
#undef PG8_SB
#undef PG8_STAGE
#undef PG8_LDA
#undef PG8_LDB
#undef PG8_MMA
#undef PG8_WAIT_V
#undef PG8_WAIT_L
#undef PG8_BAR
#undef PG8_SCHED
}
}
namespace att {
typedef unsigned short bf16;
using bf16x8 = __attribute__((ext_vector_type(8))) short;
using s16x4  = __attribute__((ext_vector_type(4))) short;
using f32x16 = __attribute__((ext_vector_type(16))) float;
using u32x4  = __attribute__((ext_vector_type(4))) unsigned;
using f32x4_t = __attribute__((ext_vector_type(4))) float;
constexpr int NW = 8, QBLK = 32, KVBLK = 64, SEQ = 4096;
constexpr int LDQ = 1536, LDKV = 2048, LDO = 1024;
constexpr int SHM_V = 16384, SHM_KN = 64 * 272, SHM_KP = 64 * 144;
constexpr int OFF_V = 0, OFF_KN = 2 * SHM_V, OFF_KP = OFF_KN + 2 * SHM_KN, OFF_WS = OFF_KP + 2 * SHM_KP, OFF_QP = OFF_WS + NW * 64 * 4, LDS_BYTES = OFF_QP + NW * 32 * 144;
#define AKSWZ(row, colB) ((row) * 272 + (colB))
#define APSWZ(row, ch) ((row) * 144 + ((ch) << 4))
#define ASBAR() __builtin_amdgcn_sched_barrier(0)
__device__ __forceinline__ int crow(int r, int hi) { return (r & 3) + 8 * (r >> 2) + 4 * hi; }
__device__ __forceinline__ unsigned cvtpk(float lo, float hi) { unsigned r; asm volatile("v_cvt_pk_bf16_f32 %0, %1, %2" : "=v"(r) : "v"(lo), "v"(hi)); return r; }
__device__ __forceinline__ float bf2f(unsigned short b) { return __uint_as_float(((unsigned)b) << 16); }
__device__ __forceinline__ void smA(f32x16& p0) { for (int r = 0; r < 16; ++r) p0[r] = __builtin_amdgcn_exp2f(p0[r]); }
__device__ __forceinline__ void smB(f32x16& p0, f32x16& p1, float& l_reg, bf16x8& pa0, bf16x8& pa1, bf16x8& pa2, bf16x8& pa3) {
  for (int r = 0; r < 16; ++r) p1[r] = __builtin_amdgcn_exp2f(p1[r]);
  float ps = 0; for (int r = 0; r < 16; ++r) ps += p0[r]; for (int r = 0; r < 16; ++r) ps += p1[r];
  l_reg += ps;
#define PK4(P, BASE, OUT) do { unsigned a0 = cvtpk(P[BASE + 0], P[BASE + 1]), a1 = cvtpk(P[BASE + 2], P[BASE + 3]);   \
    unsigned b0 = cvtpk(P[BASE + 4], P[BASE + 5]), b1 = cvtpk(P[BASE + 6], P[BASE + 7]);                              \
    auto r0 = __builtin_amdgcn_permlane32_swap(a0, b0, false, false); auto r1 = __builtin_amdgcn_permlane32_swap(a1, b1, false, false); \
    u32x4 w = {r0[0], r1[0], r0[1], r1[1]}; OUT = *reinterpret_cast<bf16x8*>(&w); } while (0)
  PK4(p0, 0, pa0); PK4(p0, 8, pa1); PK4(p1, 0, pa2); PK4(p1, 8, pa3);
#undef PK4
}
__device__ __forceinline__ void qkt(f32x16& p0, f32x16& p1, const char* Kn, const char* Kp, const bf16x8* qr, const char* Qp, float negm, int r32, int hi) {
  { const int nb = __builtin_amdgcn_readfirstlane(__float_as_int(negm));
#pragma unroll
    for (int r = 0; r < 16; ++r) { float a, bq; asm volatile("v_mov_b32 %0, %1" : "=v"(a) : "s"(nb)); asm volatile("v_mov_b32 %0, %1" : "=v"(bq) : "s"(nb)); p0[r] = a; p1[r] = bq; } }
#define KRD(d, half) ((d) < 8 ? *reinterpret_cast<const bf16x8*>(Kn + AKSWZ((half) * 32 + r32, ((d) * 16 + hi * 8) * 2)) : *reinterpret_cast<const bf16x8*>(Kp + APSWZ((half) * 32 + r32, ((d) - 8) * 2 + hi)))
#define QRD(d) ((d) < 8 ? qr[(d) < 8 ? (d) : 0] : *reinterpret_cast<const bf16x8*>(Qp + APSWZ(r32, ((d) - 8) * 2 + hi)))
  bf16x8 a0 = KRD(0, 0), a1 = KRD(0, 1), c0 = KRD(1, 0), c1 = KRD(1, 1), qa = QRD(0), qc = QRD(1);
  ASBAR();
#pragma unroll
  for (int d = 0; d < 12; d += 2) {
    p0 = __builtin_amdgcn_mfma_f32_32x32x16_bf16(a0, qa, p0, 0, 0, 0);
    p1 = __builtin_amdgcn_mfma_f32_32x32x16_bf16(a1, qa, p1, 0, 0, 0);
    if (d + 2 < 12) { a0 = KRD(d + 2, 0); a1 = KRD(d + 2, 1); qa = QRD(d + 2); }
    ASBAR();
    p0 = __builtin_amdgcn_mfma_f32_32x32x16_bf16(c0, qc, p0, 0, 0, 0);
    p1 = __builtin_amdgcn_mfma_f32_32x32x16_bf16(c1, qc, p1, 0, 0, 0);
    if (d + 3 < 12) { c0 = KRD(d + 3, 0); c1 = KRD(d + 3, 1); qc = QRD(d + 3); }
    ASBAR();
  }
#undef KRD
#undef QRD
}
__device__ __forceinline__ int v_st(int k, int c) { const int kk = (k & ~0xC) | ((k & 4) << 1) | ((k & 8) >> 1); return ((kk >> 3) * 4 + (c >> 5)) * 512 + ((kk & 7) * 32 + (c & 31)) * 2; }
__device__ __forceinline__ int v_rd_base(int lane) { return ((lane & 3) << 3) | (((lane >> 2) & 3) << 6) | (((lane >> 4) & 1) << 5) | (((lane >> 5) & 1) << 8); }
constexpr int v_rd_off(int d0, int ks, int half) { return d0 * 512 + ks * 4096 + half * 2048; }
template <int OFF> __device__ __forceinline__ s16x4 tr_read(int vb) {
  s16x4 r; asm volatile("ds_read_b64_tr_b16 %0, %1 offset:%2" : "=&v"(r) : "v"(vb), "i"(OFF) : "memory"); return r;
}
template <int D0> __device__ __forceinline__ void pv_one(f32x16& od, int vb, bf16x8 pa0, bf16x8 pa1, bf16x8 pa2, bf16x8 pa3) {
  const s16x4 l0 = tr_read<v_rd_off(D0, 0, 0)>(vb), h0 = tr_read<v_rd_off(D0, 0, 1)>(vb), l1 = tr_read<v_rd_off(D0, 1, 0)>(vb), h1 = tr_read<v_rd_off(D0, 1, 1)>(vb);
  const s16x4 l2 = tr_read<v_rd_off(D0, 2, 0)>(vb), h2 = tr_read<v_rd_off(D0, 2, 1)>(vb), l3 = tr_read<v_rd_off(D0, 3, 0)>(vb), h3 = tr_read<v_rd_off(D0, 3, 1)>(vb);
  asm volatile("s_waitcnt lgkmcnt(0)" ::: "memory"); ASBAR();
#define PK(L, H) (bf16x8){L[0], L[1], L[2], L[3], H[0], H[1], H[2], H[3]}
  od = __builtin_amdgcn_mfma_f32_32x32x16_bf16(pa0, PK(l0, h0), od, 0, 0, 0);
  od = __builtin_amdgcn_mfma_f32_32x32x16_bf16(pa1, PK(l1, h1), od, 0, 0, 0);
  od = __builtin_amdgcn_mfma_f32_32x32x16_bf16(pa2, PK(l2, h2), od, 0, 0, 0);
  od = __builtin_amdgcn_mfma_f32_32x32x16_bf16(pa3, PK(l3, h3), od, 0, 0, 0);
#undef PK
}
__device__ __forceinline__ void pv_d0(f32x16* o, int vb, bf16x8 pa0, bf16x8 pa1, bf16x8 pa2, bf16x8 pa3) {
  pv_one<0>(o[0], vb, pa0, pa1, pa2, pa3); pv_one<1>(o[1], vb, pa0, pa1, pa2, pa3); pv_one<2>(o[2], vb, pa0, pa1, pa2, pa3); pv_one<3>(o[3], vb, pa0, pa1, pa2, pa3);
}
__device__ __forceinline__ void attn_unit(int b, int h, int s0, const bf16* __restrict__ Qraw, const bf16* __restrict__ KV, const bf16* __restrict__ KPE, bf16* __restrict__ O,
                                          const float* __restrict__ rope, const float* __restrict__ qg, float smaxC, char* lds) {
  int tid = threadIdx.x; asm volatile("" : "+v"(tid));
  const int wid = __builtin_amdgcn_readfirstlane(tid >> 6), lane = tid & 63, r32 = lane & 31, hi = lane >> 5;
  int opq = 0; asm volatile("" : "+s"(opq));
  char* V_lds = lds + OFF_V; char* KN_lds = lds + OFF_KN; char* KP_lds = lds + OFF_KP;
  float* ws = (float*)(lds + OFF_WS) + wid * 64; float* li_l = ws;
  constexpr float C = 0.072168783648703220f * 1.4426950408889634f;
  bf16x8 qr[8]; char* Qp = lds + OFF_QP + wid * (32 * 144);
  {
    typedef __attribute__((address_space(1))) const float gfloat; typedef __attribute__((address_space(1))) const bf16x8 gbf16x8; typedef __attribute__((address_space(1))) const f32x4_t gf32x4;
    const long trow = (long)b * SEQ + s0 + wid * QBLK + r32;
    gbf16x8* Qw = (gbf16x8*)(Qraw + trow * LDQ + h * 192 + hi * 8);
    gf32x4* rp4 = (gf32x4*)(rope + trow * 64 + hi * 16);
    gf32x4* qg4 = (gf32x4*)(qg + opq + hi * 8);
    bf16x8 raw[12]; float ssn = 0.f, ssp = 0.f;
#pragma unroll
    for (int d0 = 0; d0 < 12; ++d0) { raw[d0] = Qw[2 * d0];
#pragma unroll
      for (int j = 0; j < 8; ++j) { const float f = bf2f((unsigned short)raw[d0][j]); if (d0 < 8) ssn += f * f; else ssp += f * f; } }
    ssn += __shfl_xor(ssn, 32); ssp += __shfl_xor(ssp, 32);
    const float rn = rsqrtf(ssn * (1.f / 128.f) + 1e-6f) * C, rp = rsqrtf(ssp * (1.f / 64.f) + 1e-6f) * C;
#pragma unroll
    for (int d0 = 0; d0 < 8; ++d0) { const f32x4_t ga = qg4[4 * d0], gb = qg4[4 * d0 + 1]; float g[8];
#pragma unroll
      for (int j = 0; j < 8; ++j) g[j] = bf2f((unsigned short)raw[d0][j]) * rn * (j < 4 ? ga[j & 3] : gb[j & 3]);
      u32x4 w = {cvtpk(g[0], g[1]), cvtpk(g[2], g[3]), cvtpk(g[4], g[5]), cvtpk(g[6], g[7])}; qr[d0] = *reinterpret_cast<bf16x8*>(&w); }
#pragma unroll
    for (int dd = 0; dd < 2; ++dd) {
      float lo[8], hh[8];
      const f32x4_t g1a = qg4[4 * (8 + dd)], g1b = qg4[4 * (8 + dd) + 1], g2a = qg4[4 * (10 + dd)], g2b = qg4[4 * (10 + dd) + 1];
#pragma unroll
      for (int j = 0; j < 8; ++j) { const f32x4_t cs4 = rp4[8 * dd + (j >> 1)];
        const float cs = cs4[(j & 1) * 2], sn = cs4[(j & 1) * 2 + 1];
        const float x1 = bf2f((unsigned short)raw[8 + dd][j]) * rp * (j < 4 ? g1a[j & 3] : g1b[j & 3]), x2 = bf2f((unsigned short)raw[10 + dd][j]) * rp * (j < 4 ? g2a[j & 3] : g2b[j & 3]);
        lo[j] = x1 * cs - x2 * sn; hh[j] = x1 * sn + x2 * cs; }
      u32x4 w1 = {cvtpk(lo[0], lo[1]), cvtpk(lo[2], lo[3]), cvtpk(lo[4], lo[5]), cvtpk(lo[6], lo[7])}; *reinterpret_cast<u32x4*>(Qp + APSWZ(r32, dd * 2 + hi)) = w1;
      u32x4 w2 = {cvtpk(hh[0], hh[1]), cvtpk(hh[2], hh[3]), cvtpk(hh[4], hh[5]), cvtpk(hh[6], hh[7])}; *reinterpret_cast<u32x4*>(Qp + APSWZ(r32, (2 + dd) * 2 + hi)) = w2; }
  }
  const float negm = -smaxC;
  float l_reg = 0.f; f32x16 o[4] = {};
  const char* Kh = (const char*)(KV + (long)b * SEQ * LDKV + h * 256); const char* Ph = (const char*)(KPE + (long)b * SEQ * 64);
  const int sr = tid >> 4, sc = (tid & 15) * 8, vst0 = v_st(sr, sc), vst1 = v_st(32 + sr, sc);
  const int kst0 = AKSWZ(sr, sc * 2), kst1 = AKSWZ(32 + sr, sc * 2);
  const int pr = tid >> 3, pc = tid & 7, pst = APSWZ(pr, pc);
  const unsigned gk0 = (unsigned)(sr * LDKV + sc) * 2u, gk1 = gk0 + 32u * LDKV * 2u, gp0 = (unsigned)(pr * 64 + pc * 8) * 2u;
  const int vb0 = (int)(uintptr_t)V_lds + v_rd_base(lane);
  bf16x8 s_v0, s_v1, s_k0, s_k1, s_p;
#define SLOAD(k0) do { const char* kb_ = Kh + (size_t)(k0) * (LDKV * 2); const char* pb_ = Ph + (size_t)(k0) * 128; \
    s_k0 = *reinterpret_cast<const bf16x8*>(kb_ + gk0); s_v0 = *reinterpret_cast<const bf16x8*>(kb_ + gk0 + 256); \
    s_k1 = *reinterpret_cast<const bf16x8*>(kb_ + gk1); s_v1 = *reinterpret_cast<const bf16x8*>(kb_ + gk1 + 256); \
    s_p = *reinterpret_cast<const bf16x8*>(pb_ + gp0); } while (0)
#define SWRITE(bb) do { *(bf16x8*)(V_lds + (bb) * SHM_V + vst0) = s_v0; *(bf16x8*)(V_lds + (bb) * SHM_V + vst1) = s_v1; \
    *(bf16x8*)(KN_lds + (bb) * SHM_KN + kst0) = s_k0; *(bf16x8*)(KN_lds + (bb) * SHM_KN + kst1) = s_k1; *(bf16x8*)(KP_lds + (bb) * SHM_KP + pst) = s_p; } while (0)
#define TILE(bb) do { f32x16 p0, p1; bf16x8 pa0, pa1, pa2, pa3; \
    qkt(p0, p1, KN_lds + (bb) * SHM_KN, KP_lds + (bb) * SHM_KP, qr, Qp, negm, r32, hi); \
    smA(p0); smB(p0, p1, l_reg, pa0, pa1, pa2, pa3); ASBAR(); \
    pv_d0(o, vb0 + (bb) * SHM_V, pa0, pa1, pa2, pa3); } while (0)
  constexpr int NT = SEQ / KVBLK;
  SLOAD(0); SWRITE(0); __syncthreads(); SLOAD(KVBLK);
  for (int j = 0; j < NT; j += 2) {
    TILE(0);
    SWRITE(1);
    __syncthreads();
    if (j + 2 < NT) SLOAD((j + 2) * KVBLK);
    TILE(1);
    if (j + 2 < NT) SWRITE(0);
    __syncthreads();
    if (j + 3 < NT) SLOAD((j + 3) * KVBLK);
  }
  int lane_e = lane; asm volatile("" : "+v"(lane_e));
  const int r32e = lane_e & 31, hie = lane_e >> 5;
  l_reg += __shfl_xor(l_reg, 32);
  if (hie == 0) li_l[r32e] = l_reg; asm volatile("s_waitcnt lgkmcnt(0)" ::: "memory");
  float rli[16];
#pragma unroll
  for (int r = 0; r < 16; ++r) rli[r] = __builtin_amdgcn_rcpf(li_l[crow(r, hie)]);
  char* Ow = (char*)(O + ((long)b * SEQ + s0 + wid * QBLK) * LDO + h * 128);
#pragma unroll
  for (int r = 0; r < 16; ++r) { const unsigned ooff = (unsigned)(crow(r, hie) * LDO + r32e) * 2u;
#pragma unroll
    for (int d0 = 0; d0 < 4; ++d0) { const unsigned pk = cvtpk(o[d0][r] * rli[r], 0.f); *(bf16*)(Ow + ooff + d0 * 64) = (bf16)(pk & 0xffffu); } }
  __syncthreads();
#undef SLOAD
#undef SWRITE
#undef TILE
}
}
#ifndef HD
#define HD __device__ __forceinline__
#endif
struct c32 { float x, y; };
HD c32 cmk(float x, float y) { c32 r; r.x = x; r.y = y; return r; }
HD c32 cadd(c32 a, c32 b) { return cmk(a.x + b.x, a.y + b.y); }
HD c32 csub(c32 a, c32 b) { return cmk(a.x - b.x, a.y - b.y); }
HD c32 cmul(c32 a, c32 b) { return cmk(a.x * b.x - a.y * b.y, a.x * b.y + a.y * b.x); }
HD c32 cmulc(c32 a, c32 b) { return cmk(a.x * b.x + a.y * b.y, a.y * b.x - a.x * b.y); }
constexpr int BR4(int i) { return ((i & 1) << 3) | ((i & 2) << 1) | ((i & 4) >> 1) | ((i & 8) >> 3); }
template <int SGN, int J> HD c32 tw16(c32 a) {
    if constexpr (J == 0) return a;
    else if constexpr (J == 4) return SGN < 0 ? cmk(a.y, -a.x) : cmk(-a.y, a.x);
    else {
        constexpr float CS[8] = {1.f, 0.92387953251128674f, 0.70710678118654752f, 0.38268343236508977f, 0.f, -0.38268343236508977f, -0.70710678118654752f, -0.92387953251128674f};
        constexpr float SN[8] = {0.f, 0.38268343236508977f, 0.70710678118654752f, 0.92387953251128674f, 1.f, 0.92387953251128674f, 0.70710678118654752f, 0.38268343236508977f};
        constexpr float c = CS[J], s = SN[J];
        if constexpr (SGN < 0) return cmk(a.x * c + a.y * s, a.y * c - a.x * s);
        else return cmk(a.x * c - a.y * s, a.y * c + a.x * s);
    }
}
#define FFT_BF(i, j, J) { const c32 u_ = v[i], w_ = v[j]; v[i] = cadd(u_, w_); v[j] = tw16<SGN, J>(csub(u_, w_)); }
template <int SGN> HD void dft16_dif(c32 (&v)[16]) {
    FFT_BF(0, 8, 0) FFT_BF(1, 9, 1) FFT_BF(2, 10, 2) FFT_BF(3, 11, 3) FFT_BF(4, 12, 4) FFT_BF(5, 13, 5) FFT_BF(6, 14, 6) FFT_BF(7, 15, 7)
    FFT_BF(0, 4, 0) FFT_BF(1, 5, 2) FFT_BF(2, 6, 4) FFT_BF(3, 7, 6) FFT_BF(8, 12, 0) FFT_BF(9, 13, 2) FFT_BF(10, 14, 4) FFT_BF(11, 15, 6)
    FFT_BF(0, 2, 0) FFT_BF(1, 3, 4) FFT_BF(4, 6, 0) FFT_BF(5, 7, 4) FFT_BF(8, 10, 0) FFT_BF(9, 11, 4) FFT_BF(12, 14, 0) FFT_BF(13, 15, 4)
    FFT_BF(0, 1, 0) FFT_BF(2, 3, 0) FFT_BF(4, 5, 0) FFT_BF(6, 7, 0) FFT_BF(8, 9, 0) FFT_BF(10, 11, 0) FFT_BF(12, 13, 0) FFT_BF(14, 15, 0)
}
#undef FFT_BF
#define FFT_BT(i, j, J) { const c32 u_ = v[i], w_ = tw16<SGN, J>(v[j]); v[i] = cadd(u_, w_); v[j] = csub(u_, w_); }
template <int SGN> HD void dft16_dit(c32 (&v)[16]) {
    FFT_BT(0, 1, 0) FFT_BT(2, 3, 0) FFT_BT(4, 5, 0) FFT_BT(6, 7, 0) FFT_BT(8, 9, 0) FFT_BT(10, 11, 0) FFT_BT(12, 13, 0) FFT_BT(14, 15, 0)
    FFT_BT(0, 2, 0) FFT_BT(1, 3, 4) FFT_BT(4, 6, 0) FFT_BT(5, 7, 4) FFT_BT(8, 10, 0) FFT_BT(9, 11, 4) FFT_BT(12, 14, 0) FFT_BT(13, 15, 4)
    FFT_BT(0, 4, 0) FFT_BT(1, 5, 2) FFT_BT(2, 6, 4) FFT_BT(3, 7, 6) FFT_BT(8, 12, 0) FFT_BT(9, 13, 2) FFT_BT(10, 14, 4) FFT_BT(11, 15, 6)
    FFT_BT(0, 8, 0) FFT_BT(1, 9, 1) FFT_BT(2, 10, 2) FFT_BT(3, 11, 3) FFT_BT(4, 12, 4) FFT_BT(5, 13, 5) FFT_BT(6, 14, 6) FFT_BT(7, 15, 7)
}
#undef FFT_BT
constexpr int FFT_PS = 272;
constexpr int FFT_EX_ELEMS = 16 * FFT_PS;
template <class EX> HD void fft_fwd_a(c32 (&v)[16], const c32* T1, EX ex, int tid) {
    dft16_dif<-1>(v);
#pragma unroll
    for (int p = 0; p < 16; ++p) { ex[p * FFT_PS + tid] = cmul(v[BR4(p)], T1[256 * p]); if ((p & 3) == 3) __builtin_amdgcn_sched_barrier(0); }
}
template <class EX> HD void fft_fwd_b(c32 (&v)[16], const c32* T2, EX exr, EX ex, int tid) {
    const int p2 = tid >> 4, c = tid & 15;
#pragma unroll
    for (int b = 0; b < 16; ++b) v[b] = exr[p2 * FFT_PS + 16 * b + c];
    dft16_dif<-1>(v);
#pragma unroll
    for (int q = 0; q < 16; ++q) ex[p2 * FFT_PS + q * 16 + ((c + q) & 15)] = cmul(v[BR4(q)], T2[q]);
}
template <class EX> HD void fft_fwd_c(c32 (&v)[16], EX ex, int tid) {
    const int p2 = tid >> 4, q = tid & 15;
#pragma unroll
    for (int c = 0; c < 16; ++c) v[c] = ex[p2 * FFT_PS + q * 16 + ((c + q) & 15)];
    dft16_dif<-1>(v);
}
template <class EX> HD void fft_inv_a(c32 (&v)[16], EX ex, int tid) {
    const int p = tid >> 4, q = tid & 15;
    dft16_dit<+1>(v);
#pragma unroll
    for (int c = 0; c < 16; ++c) ex[p * FFT_PS + q * 16 + ((c + q) & 15)] = v[c];
}
template <class EX> HD void fft_inv_b(c32 (&v)[16], const c32* T2, EX exr, EX ex, int tid) {
    const int p = tid >> 4, c = tid & 15;
#pragma unroll
    for (int q = 0; q < 16; ++q) v[BR4(q)] = cmulc(exr[p * FFT_PS + q * 16 + ((c + q) & 15)], T2[q]);
    dft16_dit<+1>(v);
#pragma unroll
    for (int b = 0; b < 16; ++b) ex[p * FFT_PS + 16 * b + c] = v[b];
}
template <class EX> HD void fft_inv_c(c32 (&v)[16], const c32* T1, EX ex, int tid) {
#pragma unroll
    for (int p = 0; p < 16; ++p) { v[BR4(p)] = cmulc(ex[p * FFT_PS + tid], T1[256 * p]); if ((p & 3) == 3) __builtin_amdgcn_sched_barrier(0); }
    dft16_dit<+1>(v);
}
constexpr int NWAVES = 8, NTHR = 512;
constexpr int BATCH = 8, SEQ = 4096, DM = 1024, T = BATCH * SEQ;
constexpr float EPS = 1e-6f;
constexpr size_t MiB = 1u << 20;
constexpr size_t WS_CTL = 0, CTL_ZERO_BYTES = 1 * MiB;
constexpr size_t WS_MOD = 1 * MiB;
constexpr size_t WS_HDNS = 1 * MiB + 512 * 1024;
constexpr size_t WS_W4S = 3 * MiB + 512 * 1024;
constexpr size_t WS_ROUTE = 6 * MiB;
constexpr size_t WS_TOKW = 7 * MiB;
constexpr size_t WS_WD = 8 * MiB;
constexpr size_t WS_WUQ = 9 * MiB;
constexpr size_t WS_WUKV = 10 * MiB;
constexpr size_t WS_WO = 11 * MiB;
constexpr size_t WS_WIN = 13 * MiB;
constexpr size_t WS_WOUT = 19 * MiB;
constexpr size_t WS_WGU = 21 * MiB;
constexpr size_t WS_WDN = 53 * MiB;
constexpr size_t R1 = 104 * MiB;
constexpr size_t R2 = 232 * MiB;
constexpr size_t R3 = 424 * MiB;
constexpr size_t WS_KV = R1, WS_XN2 = R1, WS_KF = R1;
constexpr size_t WS_XN = R2, WS_O = R2;
constexpr size_t WS_LAT = R2 + 64 * MiB;
constexpr size_t WS_HACT = R2 + 64 * MiB;
constexpr size_t WS_CQN = R2 + 128 * MiB;
constexpr size_t WS_CKVN = R2 + 144 * MiB;
constexpr size_t WS_KPE = R2 + 160 * MiB;
constexpr size_t WS_ROPE = R2 + 164 * MiB;
constexpr size_t WS_QRAW = 408 * MiB;
constexpr size_t WS_XN2S = 424 * MiB;
constexpr size_t WS_XN1 = 424 * MiB;
constexpr size_t WS_ZT = 424 * MiB;
constexpr size_t WS_HT = R2;
constexpr size_t WS_UT = R2;
constexpr size_t WS_Z = R2;
constexpr size_t WS_END = 512 * MiB;
constexpr int MS_ROWS = T + 24 * 256;
constexpr int CW_BAR = 4096;
constexpr int CW_CNT = 8192;
constexpr int RING_OFF = 0, RING_BYTES = 131072;
constexpr int LDSCTL_OFF = RING_BYTES;
constexpr int MISC_OFF = LDSCTL_OFF;
constexpr int TINFO_OFF = LDSCTL_OFF + 256;
constexpr int RED_OFF = LDSCTL_OFF + 256 + 1280;
constexpr int LDS_BYTES = 147456;
static_assert(RED_OFF + 256 <= LDS_BYTES, "LDS map");

#define GAS __attribute__((address_space(1)))
#define LAS __attribute__((address_space(3)))
typedef unsigned short bf16;
typedef unsigned v4u __attribute__((ext_vector_type(4)));
typedef unsigned v2u __attribute__((ext_vector_type(2)));
typedef int v4i __attribute__((ext_vector_type(4)));
typedef float f32x4 __attribute__((ext_vector_type(4)));
typedef GAS unsigned gu32;
#define RLX_AGENT __ATOMIC_RELAXED, __HIP_MEMORY_SCOPE_AGENT
#define LDS_WAIT() asm volatile("s_waitcnt lgkmcnt(0)" ::: "memory")
__device__ __forceinline__ unsigned pk2(float lo, float hi) { return pg8::cvt_pk_bf16(lo, hi); }
__device__ __forceinline__ float bf2f(unsigned short b) { return __uint_as_float(((unsigned)b) << 16); }
__device__ __forceinline__ float wave_sum(float v) {
#pragma unroll
    for (int o = 1; o < 64; o <<= 1) v += __shfl_xor(v, o);
    return v;
}

#define XB_TMO      128
#define XB_XCNT(j)  (256  + 64 * (j))
#define XB_XSUB(j)  (1280 + 64 * (j))
#define XB_XGEN(j)  (2304 + 64 * (j))
#define XB_TOP      3328
#define XB_TOPGEN   3392
#define XCD_BAR_WORDS 3456
#define XB_SPIN_CAP (1u << 18)

__device__ __forceinline__ unsigned xb_ld(unsigned* p)              { return __hip_atomic_load(p, __ATOMIC_RELAXED, __HIP_MEMORY_SCOPE_AGENT); }
__device__ __forceinline__ unsigned xb_add(unsigned* p, unsigned v) { return __hip_atomic_fetch_add(p, v, __ATOMIC_RELAXED, __HIP_MEMORY_SCOPE_AGENT); }
__device__ __forceinline__ unsigned xb_xcc_id() { return (unsigned)__builtin_amdgcn_s_getreg((3 << 11) | 20) & 0xFu; }
#define XB_SPIN(cond, bar) do { unsigned _sp = 0; while (cond) { __builtin_amdgcn_s_sleep(1); \
    if ((++_sp & 255u) == 0u) { if (xb_ld(&(bar)[XB_TMO])) break; if (_sp > XB_SPIN_CAP) { atomicAdd(&(bar)[XB_TMO], 1u); break; } } } } while (0)

struct XcdBarrier {
    unsigned* bar; unsigned x;
    volatile LAS unsigned* st;
};

__device__ __forceinline__ XcdBarrier xcd_barrier_post(unsigned* bar, volatile LAS unsigned* st) {
    XcdBarrier b; b.bar = bar; b.x = xb_xcc_id(); b.st = st;
    if (threadIdx.x == 0) (void)xb_add(&bar[XB_XCNT(b.x)], 1u);
    return b;
}
__device__ __forceinline__ void xcd_barrier_complete(unsigned* bar, unsigned x, unsigned& nloc, unsigned& nx) {
    const unsigned G = gridDim.x * gridDim.y * gridDim.z;
    unsigned sum, cnt, mine, sp = 0u;
    for (;;) {
        sum = 0u; cnt = 0u; mine = 0u;
#pragma unroll
        for (unsigned j = 0; j < 16; ++j) { const unsigned c = xb_ld(&bar[XB_XCNT(j)]); sum += c; cnt += (c > 0u) ? 1u : 0u; mine = (j == x) ? c : mine; }
        if (sum == G) break;
        __builtin_amdgcn_s_sleep(1);
        if ((++sp & 255u) == 0u) { if (xb_ld(&bar[XB_TMO])) break; if (sp > XB_SPIN_CAP) { atomicAdd(&bar[XB_TMO], 1u); break; } }
    }
    nloc = mine > 0u ? mine : 1u; nx = cnt > 0u ? cnt : 1u;
}

__device__ __forceinline__ void xcd_barrier(const XcdBarrier& b) {
    asm volatile("s_waitcnt vmcnt(0)" ::: "memory");
    __syncthreads();
    if (threadIdx.x == 0) {
        unsigned* bar = b.bar;
        __builtin_amdgcn_s_waitcnt(0);
        unsigned nloc = b.st[0], nx = b.st[1];
        if (nloc == 0u) { xcd_barrier_complete(bar, b.x, nloc, nx); b.st[0] = nloc; b.st[1] = nx; }
        const unsigned old = xb_add(&bar[XB_XSUB(b.x)], 1u);
        const unsigned gen = old / nloc;
        if (old + 1u == (gen + 1u) * nloc) {
            __builtin_amdgcn_fence(__ATOMIC_RELEASE, "agent");
            asm volatile("s_waitcnt vmcnt(0)" ::: "memory");
            const unsigned og = xb_add(&bar[XB_TOP], 1u);
            const unsigned tg = og / nx;
            if (og + 1u == (tg + 1u) * nx) xb_add(&bar[XB_TOPGEN], 1u);
            else XB_SPIN(xb_ld(&bar[XB_TOPGEN]) == tg, bar);
            __builtin_amdgcn_fence(__ATOMIC_ACQUIRE, "agent");
            xb_add(&bar[XB_XGEN(b.x)], 1u);
            asm volatile("s_waitcnt vmcnt(0)" ::: "memory");
        } else {
            XB_SPIN(xb_ld(&bar[XB_XGEN(b.x)]) == gen, bar);
            __builtin_amdgcn_fence(__ATOMIC_ACQUIRE, "agent");
            asm volatile("s_waitcnt vmcnt(0)" ::: "memory");
        }
    }
    __syncthreads();
}


struct Ctx { unsigned char* lds; int tid, lane, wave, vcu, G, gw, NGW; };

__device__ __forceinline__ void transpose_item(const float* W, int ldw, int k0, int n0, bf16* WT, int ldt, int drow0, int dcol0, float* scr, int lane) {
#pragma unroll 8
    for (int i = 0; i < 32; ++i) { const int kk = 2 * i + (lane >> 5); scr[kk * 33 + (lane & 31)] = W[(size_t)(k0 + kk) * ldw + n0 + (lane & 31)]; }
    LDS_WAIT();
    const int c = lane & 7;
#pragma unroll
    for (int j = 0; j < 4; ++j) { const int n = (lane >> 3) + 8 * j; const float* s = scr + (8 * c) * 33 + n;
        v4u o; o.x = pk2(s[0 * 33], s[1 * 33]); o.y = pk2(s[2 * 33], s[3 * 33]); o.z = pk2(s[4 * 33], s[5 * 33]); o.w = pk2(s[6 * 33], s[7 * 33]);
        *(v4u*)(WT + (size_t)(drow0 + n) * ldt + dcol0 + k0 + 8 * c) = o; }
    LDS_WAIT();
}
typedef __attribute__((address_space(4))) const char kchar;
struct In { int opq;
    __device__ __forceinline__ const float* operator[](int k) const { kchar* ka = (kchar*)__builtin_amdgcn_kernarg_segment_ptr(); return *(const float* const __attribute__((address_space(4)))*)(ka + 8 * k + opq); } };
__device__ __forceinline__ unsigned char* karg_ws(int opq) { kchar* ka = (kchar*)__builtin_amdgcn_kernarg_segment_ptr(); return *(unsigned char* const __attribute__((address_space(4)))*)(ka + 38 * 8 + 8 + opq); }
__device__ __forceinline__ float* karg_out(int opq) { kchar* ka = (kchar*)__builtin_amdgcn_kernarg_segment_ptr(); return *(float* const __attribute__((address_space(4)))*)(ka + 38 * 8 + opq); }

__device__ __forceinline__ void p0_prologue(const Ctx& F, const In& in, unsigned char* ws) {
    float* scr = (float*)(F.lds + RING_OFF + F.wave * 16384);
    bf16* Wd = (bf16*)(ws + WS_WD); bf16* Wuq = (bf16*)(ws + WS_WUQ); bf16* Wukv = (bf16*)(ws + WS_WUKV); bf16* Wo = (bf16*)(ws + WS_WO);
    bf16* Win = (bf16*)(ws + WS_WIN); bf16* Wout = (bf16*)(ws + WS_WOUT); bf16* Wgu = (bf16*)(ws + WS_WGU); bf16* Wdn = (bf16*)(ws + WS_WDN);
    constexpr int I_D = 16 * 14, I_UQ = 4 * 48, I_UKV = 2 * 64, I_O = 16 * 32, I_IN = 16 * 96, I_OUT = 16 * 32, I_GU = 2 * 16 * 2 * (16 * 8), I_DN = 2 * 24 * 2 * (4 * 32);
    constexpr int NITEMS = I_D + I_UQ + I_UKV + I_O + I_IN + I_OUT + I_GU + I_DN;
    for (int it = F.gw; it < NITEMS; it += F.NGW) {
        int r = it; const float* W; int ldw, k0, n0, ldt, drow0, dcol0 = 0; bf16* WT;
        if (r < I_D) { W = in[7]; ldw = 448; k0 = (r / 14) * 64; n0 = (r % 14) * 32; WT = Wd; ldt = 1024; drow0 = n0; }
        else if ((r -= I_D) < I_UQ) { W = in[10]; ldw = 1536; k0 = (r / 48) * 64; n0 = (r % 48) * 32; WT = Wuq; ldt = 256; drow0 = n0; }
        else if ((r -= I_UQ) < I_UKV) { W = in[11]; ldw = 2048; k0 = (r / 64) * 64; n0 = (r % 64) * 32; WT = Wukv; ldt = 256; drow0 = n0; }
        else if ((r -= I_UKV) < I_O) { W = in[14]; ldw = 1024; k0 = (r / 32) * 64; n0 = (r % 32) * 32; WT = Wo; ldt = 1024; drow0 = n0; }
        else if ((r -= I_O) < I_IN) { W = in[15]; ldw = 3072; k0 = (r / 96) * 64; n0 = (r % 96) * 32; WT = Win; ldt = 1024; drow0 = n0; }
        else if ((r -= I_IN) < I_OUT) { W = in[30]; ldw = 1024; k0 = (r / 32) * 64; n0 = (r % 32) * 32; WT = Wout; ldt = 1024; drow0 = n0; }
        else if ((r -= I_OUT) < I_GU) {
            const int sub = r % 128, mat = r / 128, which = mat & 1, le = mat >> 1;
            W = (which ? in[36] : in[35]) + (size_t)le * 1024 * 256; ldw = 256; k0 = (sub / 8) * 64; n0 = (sub % 8) * 32;
            WT = Wgu + (size_t)le * 512 * 1024; ldt = 1024; drow0 = (n0 >> 7) * 256 + which * 128 + (n0 & 127); }
        else { r -= I_GU;
            const int sub = r % 128, mat = r / 128, slot = mat & 1, lb = mat >> 1, layer = lb / 24, bk = lb % 24;
            int ii, jj; pg8::pair_of(bk % 6, ii, jj); const int e = (bk / 6) * 4 + (slot ? jj : ii);
            W = in[37] + (size_t)(layer * 16 + e) * 256 * 1024; ldw = 1024; k0 = (sub / 32) * 64; n0 = (sub % 32) * 32;
            WT = Wdn + (size_t)lb * 1024 * 512; ldt = 512; drow0 = n0; dcol0 = slot * 256; }
        transpose_item(W, ldw, k0, n0, WT, ldt, drow0, dcol0, scr, F.lane);
    }
    { const int gt = F.vcu * NTHR + F.tid, NGT = F.G * NTHR; const v4u z = {0u, 0u, 0u, 0u};
      for (int i = gt; i < 64 * 1024 / 8; i += NGT) *(v4u*)(Wd + (size_t)448 * 1024 + (size_t)i * 8) = z;
      for (int i = gt; i < 2048 * 16; i += NGT) *(v4u*)(Wukv + (size_t)(i >> 4) * 256 + 128 + (i & 15) * 8) = z; }
    { const int gt = F.vcu * NTHR + F.tid, NGT = F.G * NTHR; float* RT = (float*)(ws + WS_ROPE); const int* posi = (const int*)in[2];
      for (int i = gt; i < T * 32; i += NGT) { const int t = i >> 5, e = i & 31; const float inv = 1.0f / powf(10000.f, (float)(2 * e) * (1.f / 64.f));
        float sn, cs; sincosf((float)posi[t] * inv, &sn, &cs); RT[(size_t)i * 2] = cs; RT[(size_t)i * 2 + 1] = sn; } }
    { const int gt = F.vcu * NTHR + F.tid, NGT = F.G * NTHR; bf16* W4S = (bf16*)(ws + WS_W4S); const float* w4 = in[28];
      for (int i = gt; i < 4096 * 64; i += NGT) { const int k = i >> 12, col = i & 4095; const float w = w4[(size_t)k * 4096 + col];
        const unsigned hi = pk2(w, 0.f) & 0xffffu; const float lo = w - bf2f((unsigned short)hi); const unsigned lob = pk2(lo, 0.f) & 0xffffu;
        bf16* d = W4S + (size_t)col * 256 + k; d[0] = (bf16)hi; d[64] = (bf16)hi; d[128] = (bf16)lob; d[192] = 0; } }
    { bf16* HDp = (bf16*)(ws + WS_HDNS); float* sv = scr;
      const int j = F.lane;
      for (int t = F.gw; t < 4096; t += F.NGW) {
        float zf = 0.f;
        { const float w = 6.2831855f * (float)t * (1.f / 4096.f);
          if (j == 0) zf = (float)t / 4095.f;
          else if (j <= 16) { const float fr = 1e-4f + (float)(j - 1) * ((15.f - 1e-4f) / 15.f); zf = cosf(fr * w); }
          else if (j <= 32) { const float fr = 1e-4f + (float)(j - 17) * ((15.f - 1e-4f) / 15.f); zf = -sinf(fr * w); } }
        sv[j] = zf; LDS_WAIT();
        float a = in[20][j];
#pragma unroll 3
        for (int k = 0; k < 33; ++k) a += sv[k] * in[19][k * 64 + j];
        float h = sinf(in[21][j] * a); LDS_WAIT(); sv[j] = h; LDS_WAIT();
        a = in[23][j];
#pragma unroll 4
        for (int k = 0; k < 64; ++k) a += sv[k] * in[22][k * 64 + j];
        h = sinf(in[24][j] * a); LDS_WAIT(); sv[j] = h; LDS_WAIT();
        a = in[26][j];
#pragma unroll 4
        for (int k = 0; k < 64; ++k) a += sv[k] * in[25][k * 64 + j];
        h = sinf(in[27][j] * a); LDS_WAIT();
        const unsigned hi = pk2(h, 0.f) & 0xffffu; const float lo = h - bf2f((unsigned short)hi); const unsigned lob = pk2(lo, 0.f) & 0xffffu;
        bf16* d = HDp + (size_t)t * 256 + j; d[0] = (bf16)hi; d[64] = (bf16)lob; d[128] = (bf16)hi; d[192] = 0;
      } }
    __syncthreads();
    { float* cact = (float*)(F.lds + RING_OFF); float* red = cact + 8 * 1024;
      float* MOD = (float*)(ws + WS_MOD);
      for (int i = F.tid; i < 8 * 1024; i += NTHR) { const float x = in[1][i]; cact[i] = x / (1.f + __expf(-x)); }
      __syncthreads();
      for (int it = F.vcu; it < 2 * 96; it += F.G) {
        const int layer = it / 96, cb = it % 96, col = F.tid & 63, kg = F.tid >> 6;
        const float* W = in[3] + (size_t)layer * 1024 * 6144 + cb * 64 + col;
        float acc[8] = {0.f, 0.f, 0.f, 0.f, 0.f, 0.f, 0.f, 0.f};
#pragma unroll 4
        for (int k = kg * 128; k < kg * 128 + 128; ++k) { const float w = W[(size_t)k * 6144];
#pragma unroll
          for (int b = 0; b < 8; ++b) acc[b] += cact[b * 1024 + k] * w; }
#pragma unroll
        for (int b = 0; b < 8; ++b) red[(kg * 8 + b) * 64 + col] = acc[b];
        __syncthreads();
        { const int b = F.tid >> 6; float s = in[4][layer * 6144 + cb * 64 + col];
#pragma unroll
          for (int g = 0; g < 8; ++g) s += red[(g * 8 + b) * 64 + col];
          MOD[((size_t)layer * 8 + b) * 6144 + cb * 64 + col] = s; }
        __syncthreads();
      } }
}

__device__ __forceinline__ void norm_mod_phase(const Ctx& F, const float* X, const float* g, const float* sc, const float* sh, bf16* OUT) {
    for (int ch = F.gw; ch < T / 16; ch += F.NGW) {
        const int r0 = ch * 16, b = r0 >> 12;
        f32x4 A[4], S[4];
#pragma unroll
        for (int j = 0; j < 4; ++j) { const int col = 4 * F.lane + 256 * j; const f32x4 gv = *(const f32x4*)(g + col), sv = *(const f32x4*)(sc + (size_t)b * 6144 + col); A[j] = gv * (1.f + sv); S[j] = *(const f32x4*)(sh + (size_t)b * 6144 + col); }
        for (int rr = 0; rr < 16; ++rr) { const float* xr = X + (size_t)(r0 + rr) * DM + 4 * F.lane;
            f32x4 v[4]; float ss = 0.f;
#pragma unroll
            for (int j = 0; j < 4; ++j) { v[j] = *(const f32x4*)(xr + 256 * j); ss += (v[j].x * v[j].x + v[j].y * v[j].y) + (v[j].z * v[j].z + v[j].w * v[j].w); }
            const float rstd = rsqrtf(wave_sum(ss) * (1.f / DM) + EPS);
            bf16* orow = OUT + (size_t)(r0 + rr) * DM + 4 * F.lane;
#pragma unroll
            for (int j = 0; j < 4; ++j) { const f32x4 o = v[j] * rstd * A[j] + S[j]; v2u w; w.x = pk2(o.x, o.y); w.y = pk2(o.z, o.w); *(v2u*)(orow + 256 * j) = w; } }
    }
}

__device__ __forceinline__ void lat_post_phase(const Ctx& F, const float* LAT, const float* qag, const float* kvag, const float* kng, const float* rope, bf16* CQN, bf16* CKVN, bf16* KPE) {
    const int l = F.lane;
    const f32x4 gq = *(const f32x4*)(qag + 4 * l);
    const f32x4 g2 = l < 32 ? *(const f32x4*)(kvag + 4 * l) : (l < 48 ? *(const f32x4*)(kng + 128 + 4 * (l - 32)) : (f32x4){0.f, 0.f, 0.f, 0.f});
    for (int row = F.gw; row < T; row += F.NGW) {
        const float* lr = LAT + (size_t)row * 512;
        const f32x4 a = *(const f32x4*)(lr + 4 * l);
        const f32x4 c = l < 48 ? *(const f32x4*)(lr + 256 + 4 * l) : (f32x4){0.f, 0.f, 0.f, 0.f};
        const float sq = (a.x * a.x + a.y * a.y) + (a.z * a.z + a.w * a.w), sc = (c.x * c.x + c.y * c.y) + (c.z * c.z + c.w * c.w);
        const float s_q = wave_sum(sq), s_kv = wave_sum(l < 32 ? sc : 0.f), s_pe = wave_sum((l >= 32 && l < 48) ? sc : 0.f);
        const float rq = rsqrtf(s_q * (1.f / 256.f) + EPS), rkv = rsqrtf(s_kv * (1.f / 128.f) + EPS), rpe = rsqrtf(s_pe * (1.f / 64.f) + EPS);
        { const f32x4 o = a * rq * gq; v2u w; w.x = pk2(o.x, o.y); w.y = pk2(o.z, o.w); *(v2u*)(CQN + (size_t)row * 256 + 4 * l) = w; }
        if (l < 32) { const f32x4 o = c * rkv * g2; v2u w; w.x = pk2(o.x, o.y); w.y = pk2(o.z, o.w); *(v2u*)(CKVN + (size_t)row * 256 + 4 * l) = w; }
        else { v2u w; w.x = 0u; w.y = 0u; *(v2u*)(CKVN + (size_t)row * 256 + 128 + 4 * (l - 32)) = w; }
        const f32x4 n = c * rpe * g2;
        f32x4 other; other.x = __shfl_xor(n.x, 8); other.y = __shfl_xor(n.y, 8); other.z = __shfl_xor(n.z, 8); other.w = __shfl_xor(n.w, 8);
        if (l >= 32 && l < 48) { const bool first = l < 40; const int e0 = 4 * ((l - 32) & 7);
            float o[4];
#pragma unroll
            for (int i = 0; i < 4; ++i) { const int e = e0 + i; const float cs = rope[(size_t)row * 64 + e * 2], sn = rope[(size_t)row * 64 + e * 2 + 1];
                const float mine = n[i], oth = other[i]; o[i] = first ? (mine * cs - oth * sn) : (oth * sn + mine * cs); }
            v2u w; w.x = pk2(o[0], o[1]); w.y = pk2(o[2], o[3]); *(v2u*)(KPE + (size_t)row * 64 + 4 * (l - 32)) = w; }
    }
}

__device__ __forceinline__ void knorm_phase(const Ctx& F, bf16* KV, const float* kng) {
    const int l = F.lane, h = l >> 3, e0 = (l & 7) * 16;
    float g[16];
#pragma unroll
    for (int i = 0; i < 16; ++i) g[i] = kng[e0 + i];
    for (int row = F.gw; row < T; row += F.NGW) {
        bf16* p = KV + (size_t)row * 2048 + h * 256 + e0;
        const v4u r0 = *(const v4u*)p, r1 = *(const v4u*)(p + 8);
        float f[16]; const unsigned w[8] = {r0.x, r0.y, r0.z, r0.w, r1.x, r1.y, r1.z, r1.w};
        float ss = 0.f;
#pragma unroll
        for (int i = 0; i < 8; ++i) { f[2 * i] = __uint_as_float(w[i] << 16); f[2 * i + 1] = __uint_as_float(w[i] & 0xffff0000u); ss += f[2 * i] * f[2 * i] + f[2 * i + 1] * f[2 * i + 1]; }
        ss += __shfl_xor(ss, 1); ss += __shfl_xor(ss, 2); ss += __shfl_xor(ss, 4);
        const float r = rsqrtf(ss * (1.f / 128.f) + EPS);
        v4u o0, o1;
        o0.x = pk2(f[0] * r * g[0], f[1] * r * g[1]); o0.y = pk2(f[2] * r * g[2], f[3] * r * g[3]); o0.z = pk2(f[4] * r * g[4], f[5] * r * g[5]); o0.w = pk2(f[6] * r * g[6], f[7] * r * g[7]);
        o1.x = pk2(f[8] * r * g[8], f[9] * r * g[9]); o1.y = pk2(f[10] * r * g[10], f[11] * r * g[11]); o1.z = pk2(f[12] * r * g[12], f[13] * r * g[13]); o1.w = pk2(f[14] * r * g[14], f[15] * r * g[15]);
        *(v4u*)p = o0; *(v4u*)(p + 8) = o1;
    }
}

__device__ __forceinline__ void route_phase(const Ctx& F, const float* X, const float* g, const float* sc, const float* sh, const float* wg, const float* bg, const float* we, const float* be,
                                            bf16* XN2, int* ROUTE, gu32* cnt) {
    float* W20 = (float*)(F.lds + RING_OFF);
    for (int i = F.tid; i < 20 * 1024; i += NTHR) { const int o = i >> 10, col = i & 1023; W20[i] = o < 4 ? wg[col * 4 + o] : we[col * 16 + (o - 4)]; }
    __syncthreads();
    float bgv[4], bev[16];
#pragma unroll
    for (int i = 0; i < 4; ++i) bgv[i] = bg[i];
#pragma unroll
    for (int i = 0; i < 16; ++i) bev[i] = be[i];
    for (int ch = F.gw; ch < T / 16; ch += F.NGW) {
        const int r0 = ch * 16, b = r0 >> 12;
        f32x4 A[4], S[4];
#pragma unroll
        for (int j = 0; j < 4; ++j) { const int col = 4 * F.lane + 256 * j; const f32x4 gv = *(const f32x4*)(g + col), sv = *(const f32x4*)(sc + (size_t)b * 6144 + col); A[j] = gv * (1.f + sv); S[j] = *(const f32x4*)(sh + (size_t)b * 6144 + col); }
        for (int rr = 0; rr < 16; ++rr) { const int row = r0 + rr; const float* xr = X + (size_t)row * DM + 4 * F.lane;
            f32x4 v[4]; float ss = 0.f;
#pragma unroll
            for (int j = 0; j < 4; ++j) { v[j] = *(const f32x4*)(xr + 256 * j); ss += (v[j].x * v[j].x + v[j].y * v[j].y) + (v[j].z * v[j].z + v[j].w * v[j].w); }
            const float rstd = rsqrtf(wave_sum(ss) * (1.f / DM) + EPS);
            bf16* orow = XN2 + (size_t)row * DM + 4 * F.lane;
#pragma unroll
            for (int j = 0; j < 4; ++j) { v[j] = v[j] * rstd * A[j] + S[j]; v2u w; w.x = pk2(v[j].x, v[j].y); w.y = pk2(v[j].z, v[j].w); *(v2u*)(orow + 256 * j) = w; }
            float lg[20];
#pragma unroll
            for (int o = 0; o < 20; ++o) { float a = 0.f;
#pragma unroll
                for (int j = 0; j < 4; ++j) { const f32x4 w = *(const f32x4*)(W20 + o * 1024 + 4 * F.lane + 256 * j); a += (v[j].x * w.x + v[j].y * w.y) + (v[j].z * w.z + v[j].w * w.w); }
                lg[o] = wave_sum(a); }
            const float g0 = lg[0] + bgv[0], g1 = lg[1] + bgv[1], g2 = lg[2] + bgv[2], g3 = lg[3] + bgv[3];
            int gi = 0; float gm = g0; if (g1 > gm) { gm = g1; gi = 1; } if (g2 > gm) { gm = g2; gi = 2; } if (g3 > gm) { gm = g3; gi = 3; }
            const float gw_ = 1.f / (__expf(g0 - gm) + __expf(g1 - gm) + __expf(g2 - gm) + __expf(g3 - gm));
            float e[4];
#pragma unroll
            for (int k = 0; k < 4; ++k) e[k] = (gi == 0 ? lg[4 + k] + bev[k] : gi == 1 ? lg[8 + k] + bev[4 + k] : gi == 2 ? lg[12 + k] + bev[8 + k] : lg[16 + k] + bev[12 + k]);
            int i1 = 0; float m1 = e[0];
#pragma unroll
            for (int k = 1; k < 4; ++k) if (e[k] > m1) { m1 = e[k]; i1 = k; }
            int i2 = -1; float m2 = -3.0e38f;
#pragma unroll
            for (int k = 0; k < 4; ++k) if (k != i1 && e[k] > m2) { m2 = e[k]; i2 = k; }
            const float t2 = __expf(m2 - m1), w1 = gw_ / (1.f + t2), w2 = gw_ * t2 / (1.f + t2);
            const int ilo = i1 < i2 ? i1 : i2, ihi = i1 < i2 ? i2 : i1; const float wlo = i1 < i2 ? w1 : w2, whi = i1 < i2 ? w2 : w1;
            const int pi = ilo == 0 ? ihi - 1 : (ilo == 1 ? ihi + 1 : 5), bk = gi * 6 + pi;
            if (F.lane == 0) { const unsigned pos = __hip_atomic_fetch_add(cnt + bk * 64, 1u, RLX_AGENT);
                v4i r; r.x = bk; r.y = (int)pos; r.z = __float_as_int(wlo); r.w = __float_as_int(whi); *(v4i*)(ROUTE + (size_t)row * 4) = r; }
        }
    }
}
__device__ __forceinline__ void moe_table(const Ctx& F, const gu32* cnt) {
    int* tinfo = (int*)(F.lds + TINFO_OFF);
    __syncthreads();
    if (F.tid == 0) { int nt = 0;
        for (int b = 0; b < 24; ++b) { const int c = (int)__hip_atomic_load(cnt + b * 64, RLX_AGENT); const int tiles = (c + 255) >> 8;
            tinfo[256 + b] = nt * 256; tinfo[288 + b] = c; for (int i = 0; i < tiles; ++i) tinfo[1 + nt + i] = b; nt += tiles; }
        tinfo[0] = nt; }
    __syncthreads();
}
__device__ __forceinline__ void permute_phase(const Ctx& F, const bf16* XN2, const int* ROUTE, bf16* XN2S, int* TOKW) {
    const int* tinfo = (const int*)(F.lds + TINFO_OFF);
    for (int row = F.gw; row < T; row += F.NGW) {
        const v4i r = *(const v4i*)(ROUTE + (size_t)row * 4);
        const int srow = tinfo[256 + r.x] + r.y;
        const v4u a = *(const v4u*)(XN2 + (size_t)row * DM + 8 * F.lane), bq = *(const v4u*)(XN2 + (size_t)row * DM + 512 + 8 * F.lane);
        *(v4u*)(XN2S + (size_t)srow * DM + 8 * F.lane) = a; *(v4u*)(XN2S + (size_t)srow * DM + 512 + 8 * F.lane) = bq;
        if (F.lane == 0) { v4i w; w.x = row; w.y = r.z; w.z = r.w; w.w = 0; *(v4i*)(TOKW + (size_t)srow * 4) = w; }
    }
}

constexpr float W32C[16] = {1.f, 0.98078528040323043f, 0.92387953251128674f, 0.83146961230254524f, 0.70710678118654752f, 0.55557023301960218f, 0.38268343236508977f, 0.19509032201612825f,
                            0.f, -0.19509032201612825f, -0.38268343236508977f, -0.55557023301960218f, -0.70710678118654752f, -0.83146961230254524f, -0.92387953251128674f, -0.98078528040323043f};
constexpr float W32S[16] = {0.f, 0.19509032201612825f, 0.38268343236508977f, 0.55557023301960218f, 0.70710678118654752f, 0.83146961230254524f, 0.92387953251128674f, 0.98078528040323043f,
                            1.f, 0.98078528040323043f, 0.92387953251128674f, 0.83146961230254524f, 0.70710678118654752f, 0.55557023301960218f, 0.38268343236508977f, 0.19509032201612825f};
struct FftTw { const c32* T1; c32 tob; const c32* T2; };
template <int A> __device__ __forceinline__ c32 mul_to(c32 x, c32 tob) { const c32 y = cmul(x, tob); return cmk(y.x * W32C[A] + y.y * W32S[A], y.y * W32C[A] - y.x * W32S[A]); }
template <int A> __device__ __forceinline__ c32 mul_toc(c32 x, c32 tob) { const c32 y = cmulc(x, tob); return cmk(y.x * W32C[A] - y.y * W32S[A], y.y * W32C[A] + y.x * W32S[A]); }
#define TO_ALL(OP) OP(0) OP(1) OP(2) OP(3) OP(4) OP(5) OP(6) OP(7) OP(8) OP(9) OP(10) OP(11) OP(12) OP(13) OP(14) OP(15)
__device__ __forceinline__ void fft_twiddles(FftTw& W, int gt, c32* t1tab, c32* t2tab, int tid) {
    if (tid < 256) { float s, c; sincosf(-6.283185307179586f * (float)(((tid >> 4) * (tid & 15)) & 255) * (1.f / 256.f), &s, &c); t2tab[(tid >> 4) * 17 + (tid & 15)] = cmk(c, s); }
    for (int i = tid; i < 4096; i += NTHR) { const int p = i >> 8, t = i & 255; float s, c; sincosf(-6.283185307179586f * (float)((t * p) & 4095) * (1.f / 4096.f), &s, &c); t1tab[i] = cmk(c, s); }
    { float s, c; sincosf(-6.283185307179586f * (float)gt * (1.f / 8192.f), &s, &c); W.tob = cmk(c, s); }
    W.T1 = t1tab + gt; W.T2 = t2tab + (gt & 15) * 17;
    __syncthreads();
}
__device__ __forceinline__ void fft_forward_ab(c32 (&v)[16], const FftTw& W, c32* ex, int gt) {
    __syncthreads();
    fft_fwd_a(v, W.T1, ex, gt);
    __syncthreads();
    fft_fwd_b(v, W.T2, ex, ex, gt);
    __builtin_amdgcn_wave_barrier(); asm volatile("" ::: "memory");
}
__device__ __forceinline__ void fft_forward(c32 (&v)[16], const FftTw& W, c32* ex, int gt) { fft_forward_ab(v, W, ex, gt); fft_fwd_c(v, ex, gt); }
__device__ __forceinline__ void fft_inverse(c32 (&v)[16], const FftTw& W, c32* ex, int gt) {
    __builtin_amdgcn_wave_barrier(); asm volatile("" ::: "memory");
    fft_inv_a(v, ex, gt);
    __builtin_amdgcn_wave_barrier(); asm volatile("" ::: "memory");
    fft_inv_b(v, W.T2, ex, ex, gt);
    __syncthreads();
    fft_inv_c(v, W.T1, ex, gt);
}
__device__ __forceinline__ void filter_phase(const Ctx& F, const float* HT, const float* fbias, c32* KF) {
    const int g = F.tid >> 8, gt = F.tid & 255;
    c32* ex = (c32*)(F.lds + RING_OFF + g * 36864);
    float* rev = (float*)ex;
    float* red = (float*)(F.lds + RED_OFF);
    FftTw W; fft_twiddles(W, gt, (c32*)(F.lds + RING_OFF + 73728), (c32*)(F.lds + RING_OFF + 110592), F.tid);
    for (int d = F.vcu; d < DM; d += F.G) {
        int gtv = gt; asm volatile("" : "+v"(gtv));
        const float delta = fabsf(-120.39728043259361f + (float)d * ((40.546510810816436f + 120.39728043259361f) / 1023.f));
        const float* hfp = HT + (size_t)(g * 2048 + d) * 4096; const float* hbp = HT + (size_t)(g * 2048 + 1024 + d) * 4096;
        float hf[16], hb[16]; float sf = 0.f, sb = 0.f;
#pragma unroll
        for (int a = 0; a < 16; ++a) { const int t = 256 * a + gtv; const float dec = __expf(-((float)t * (1.f / 4095.f)) * delta); hf[a] = hfp[t] * dec; hb[a] = hbp[t] * dec; sf += fabsf(hf[a]); sb += fabsf(hb[a]); }
        sf = wave_sum(sf); sb = wave_sum(sb);
        __syncthreads();
        if (F.lane == 0) { red[F.wave * 2] = sf; red[F.wave * 2 + 1] = sb; }
        __syncthreads();
        sf = red[g * 8] + red[g * 8 + 2] + red[g * 8 + 4] + red[g * 8 + 6]; sb = red[g * 8 + 1] + red[g * 8 + 3] + red[g * 8 + 5] + red[g * 8 + 7];
        const float nf = 1.f / (sf + EPS) * (1.f / 8192.f), nb = 1.f / (sb + EPS) * (1.f / 8192.f);
#pragma unroll
        for (int a = 0; a < 16; ++a) rev[256 * a + gt] = hb[a] * nb;
        __syncthreads();
        c32 v[16];
#pragma unroll
        for (int a = 0; a < 16; ++a) { const int n = 256 * a + gt; hb[a] = n == 0 ? 0.f : rev[4096 - n]; hf[a] *= nf; v[a] = cmk(hf[a] + hb[a], 0.f); }
        fft_forward(v, W, ex, gt);
        c32* kf = KF + ((size_t)(d * 2 + g) * 2) * 4096; const float fb = fbias[g * 1024 + d] * (1.f / 4096.f);
#pragma unroll
        for (int i = 0; i < 16; ++i) kf[i * 256 + gtv] = cmk(v[i].x + fb, v[i].y);
#define OPX(A) v[A] = mul_to<A>(cmk(hf[A] - hb[A], 0.f), W.tob);
        TO_ALL(OPX)
#undef OPX
        fft_forward(v, W, ex, gt);
#pragma unroll
        for (int i = 0; i < 16; ++i) kf[4096 + i * 256 + gtv] = v[i];
    }
}
__device__ __forceinline__ void long_conv(c32 (&z)[16], const c32* kf, const FftTw& W, c32* ex, int gt) {
    typedef float f32x2v __attribute__((ext_vector_type(2))); typedef __attribute__((address_space(1))) const f32x2v gc32;
    c32 v[16], k[16]; int gk = gt; asm volatile("" : "+v"(gk));
#define OPX(A) v[A] = mul_to<A>(z[A], W.tob);
    TO_ALL(OPX)
#undef OPX
    fft_forward_ab(v, W, ex, gt);
    asm volatile("" ::: "memory");
#pragma unroll
    for (int i = 0; i < 16; ++i) { const f32x2v t_ = ((gc32*)kf)[4096 + i * 256 + gk]; k[i] = cmk(t_.x, t_.y); }
    fft_fwd_c(v, ex, gt);
#pragma unroll
    for (int i = 0; i < 16; ++i) v[i] = cmul(v[i], k[i]);
    fft_inverse(v, W, ex, gt);
#define OPX(A) v[A] = mul_toc<A>(v[A], W.tob);
    TO_ALL(OPX)
#undef OPX
    fft_forward_ab(z, W, ex, gt);
    asm volatile("" ::: "memory");
#pragma unroll
    for (int i = 0; i < 16; ++i) { const f32x2v t_ = ((gc32*)kf)[i * 256 + gk]; k[i] = cmk(t_.x, t_.y); }
    fft_fwd_c(z, ex, gt);
#pragma unroll
    for (int i = 0; i < 16; ++i) z[i] = cmul(z[i], k[i]);
    fft_inverse(z, W, ex, gt);
#pragma unroll
    for (int a = 0; a < 16; ++a) z[a] = cadd(z[a], v[a]);
}
__device__ __forceinline__ void load_conv3(c32 (&o)[16], const bf16* urow, int b0, float w0, float w1, float w2, float cb, bf16* stg, int gt) {
    typedef __attribute__((address_space(1))) const v4u gv4u;
    constexpr int SS = 4112;
    asm volatile("" : "+v"(gt));
    __syncthreads();
#pragma unroll
    for (int q = 0; q < 2; ++q) {
#pragma unroll
        for (int i = 0; i < 2; ++i) { const int ch = gt + 256 * i; *(v4u*)(stg + q * SS + 8 + ch * 8) = *(gv4u*)(urow + (size_t)(b0 + q) * SEQ + ch * 8); }
        if (gt == 0) { stg[q * SS + 7] = 0; stg[q * SS + 4104] = 0; } }
    __syncthreads();
#pragma unroll
    for (int a = 0; a < 16; ++a) { const int t = 256 * a + gt; float r[2];
#pragma unroll
        for (int q = 0; q < 2; ++q) { const bf16* sp = stg + q * SS + 7 + t; r[q] = w0 * bf2f(sp[0]) + w1 * bf2f(sp[1]) + w2 * bf2f(sp[2]) + cb; }
        o[a] = cmk(r[0], r[1]); if ((a & 3) == 3) __builtin_amdgcn_sched_barrier(0); }
}
__device__ __forceinline__ void conv_phase(const Ctx& F, const bf16* UT, const c32* KF, const float* convw, const float* convb, bf16* ZT) {
    const int g = F.tid >> 8, gt = F.tid & 255;
    c32* ex = (c32*)(F.lds + RING_OFF + g * 36864);
    bf16* stg = (bf16*)ex;
    FftTw W; fft_twiddles(W, gt, (c32*)(F.lds + RING_OFF + 73728), (c32*)(F.lds + RING_OFF + 110592), F.tid);
    for (int d = F.vcu; d < DM; d += F.G) {
        const c32* kf0 = KF + ((size_t)(d * 2 + 0) * 2) * 4096; const c32* kf1 = KF + ((size_t)(d * 2 + 1) * 2) * 4096;
        for (int pp = 0; pp < 2; ++pp) { const int b0 = (2 * g + pp) * 2;
            int gtv = gt; asm volatile("" : "+v"(gtv));
            c32 z[16], gate[16];
            { const int c = 2048 + d; load_conv3(z, UT + (size_t)c * T, b0, convw[c], convw[3072 + c], convw[6144 + c], convb[c], stg, gtv); }
            long_conv(z, kf0, W, ex, gtv);
            { const int c = d; load_conv3(gate, UT + (size_t)c * T, b0, convw[c], convw[3072 + c], convw[6144 + c], convb[c], stg, gtv); }
#pragma unroll
            for (int a = 0; a < 16; ++a) z[a] = cmk(z[a].x * gate[a].x, z[a].y * gate[a].y);
            long_conv(z, kf1, W, ex, gtv);
            { const int c = 1024 + d; load_conv3(gate, UT + (size_t)c * T, b0, convw[c], convw[3072 + c], convw[6144 + c], convb[c], stg, gtv); }
            bf16* zr = ZT + (size_t)d * T + (size_t)b0 * SEQ;
#pragma unroll
            for (int a = 0; a < 16; ++a) { const int t = 256 * a + gtv; const unsigned pk = pk2(z[a].x * gate[a].x, z[a].y * gate[a].y); zr[t] = (bf16)(pk & 0xffffu); zr[SEQ + t] = (bf16)(pk >> 16); }
        }
    }
}
__device__ __forceinline__ void transpose_phase(const Ctx& F, const bf16* ZT, bf16* Z) {
    bf16* tile = (bf16*)(F.lds + RING_OFF + F.wave * 8704);
    const int l = F.lane;
    for (int it = F.gw; it < 16 * 512; it += F.NGW) { const int d0 = (it & 15) * 64, t0 = (it >> 4) * 64;
#pragma unroll
        for (int i = 0; i < 8; ++i) { const int dr = i * 8 + (l >> 3), c = l & 7; const v4u x = *(const v4u*)(ZT + (size_t)(d0 + dr) * T + t0 + c * 8);
            v2u* p = (v2u*)(tile + dr * 68 + c * 8); v2u a; a.x = x.x; a.y = x.y; p[0] = a; a.x = x.z; a.y = x.w; p[1] = a; }
        LDS_WAIT();
#pragma unroll
        for (int i = 0; i < 8; ++i) { const int tr = i * 8 + (l >> 3), c = l & 7; unsigned short e[8];
#pragma unroll
            for (int k = 0; k < 8; ++k) e[k] = tile[(c * 8 + k) * 68 + tr];
            v4u o; o.x = e[0] | ((unsigned)e[1] << 16); o.y = e[2] | ((unsigned)e[3] << 16); o.z = e[4] | ((unsigned)e[5] << 16); o.w = e[6] | ((unsigned)e[7] << 16);
            *(v4u*)(Z + (size_t)(t0 + tr) * DM + d0 + c * 8) = o; }
        LDS_WAIT();
    }
}

constexpr int NPH = 22;
#define MOE_PHASES(L) do { \
        const int mb = 8 + 10 * L; \
        if (IN(mb)) { PH_ARGS; const float* mod = WSP(float, WS_MOD) + (size_t)L * 8 * 6144; gu32* cnt = (gu32*)(ws + WS_CTL) + CW_CNT + L * 24 * 64; \
            route_phase(F, out, in[6] + L * 1024, mod + 4 * 1024, mod + 3 * 1024, in[31] + L * 4096, in[32] + L * 4, in[33] + L * 16384, in[34] + L * 16, WSP(bf16, WS_XN2), WSP(int, WS_ROUTE), cnt); } SEAM(mb); \
        if (IN(mb + 1)) { PH_ARGS; gu32* cnt = (gu32*)(ws + WS_CTL) + CW_CNT + L * 24 * 64; moe_table(F, cnt); permute_phase(F, WSP(bf16, WS_XN2), WSP(int, WS_ROUTE), WSP(bf16, WS_XN2S), WSP(int, WS_TOKW)); } SEAM(mb + 1); \
        if (IN(mb + 2)) { PH_ARGS; gu32* cnt = (gu32*)(ws + WS_CTL) + CW_CNT + L * 24 * 64; moe_table(F, cnt); \
            pg8::Gemm gm{WSP(bf16, WS_XN2S), WSP(bf16, WS_WGU) + (size_t)L * 16 * 512 * 1024, MS_ROWS, 8192, 1024}; pg8::MoeOrder S{tinfo, F.G, F.vcu, 0}; pg8::EpiSwiGLU E{WSP(bf16, WS_HACT), WSP(int, WS_TOKW), tinfo}; \
            pg8::gemm_phase<pg8::EpiSwiGLU, pg8::MoeOrder, true, true>(ring, gm, S, E); } SEAM(mb + 2); \
        if (IN(mb + 3)) { PH_ARGS; gu32* cnt = (gu32*)(ws + WS_CTL) + CW_CNT + L * 24 * 64; moe_table(F, cnt); const float* mod = WSP(float, WS_MOD) + (size_t)L * 8 * 6144; \
            pg8::Gemm gm{WSP(bf16, WS_HACT), WSP(bf16, WS_WDN) + (size_t)L * 24 * 1024 * 512, MS_ROWS, 24 * 1024, 512}; pg8::MoeOrder S{tinfo, F.G, F.vcu, 1}; pg8::EpiMoeOut E{out, mod + 5 * 1024, WSP(int, WS_TOKW), tinfo}; \
            pg8::gemm_phase<pg8::EpiMoeOut, pg8::MoeOrder, true, true>(ring, gm, S, E); } \
    } while (0)
struct Args { const float* in[38]; float* out; unsigned char* ws; int ph_lo, ph_hi; };
static_assert(sizeof(Args) == 38 * 8 + 8 + 8 + 8, "Args layout (read back through the kernarg segment pointer)");
__global__ void __launch_bounds__(NTHR, 2) fwd_kernel(Args args) {
    extern __shared__ __attribute__((aligned(16))) unsigned char lds[];
#define MK_CTX(F, tx) Ctx F; F.lds = lds; F.tid = (tx); F.lane = F.tid & 63; F.wave = __builtin_amdgcn_readfirstlane(F.tid >> 6); \
    F.G = gridDim.x; { const int bx = blockIdx.x; F.vcu = (F.G % 8 == 0) ? (bx % 8) * (F.G / 8) + bx / 8 : bx; } F.gw = F.vcu * NWAVES + F.wave; F.NGW = F.G * NWAVES
    for (int u = threadIdx.x; u < (LDS_BYTES - LDSCTL_OFF) / 4; u += NTHR) ((LAS unsigned*)((LAS unsigned char*)lds + LDSCTL_OFF))[u] = 0u;
    __syncthreads();
    const int lo = args.ph_lo, hi = args.ph_hi;
    const bool use_bar = (hi - lo) > 1;
    XcdBarrier bar; bar.bar = (unsigned*)(args.ws + WS_CTL) + CW_BAR; bar.x = 0; bar.st = nullptr;
    if (use_bar) bar = xcd_barrier_post((unsigned*)(args.ws + WS_CTL) + CW_BAR, (volatile LAS unsigned*)((LAS unsigned char*)lds + MISC_OFF) + 8);
#ifndef PHMASK
#define PHMASK 0xFFFFFFFFu
#endif
#define IN(k) (((PHMASK >> ((k) >= 18 ? (k) - 10 : (k))) & 1u) && lo <= (k) && (k) < hi)
#define SEAM(k) do { if (IN(k) && IN((k) + 1)) xcd_barrier(bar); } while (0)
#define PH_STR2(x) #x
#define PH_STR(x) PH_STR2(x)
#define PH_ARGS int opq_ = 0; asm volatile("; PHMARK line " PH_STR(__LINE__) : "+s"(opq_)); const In in{opq_}; unsigned char* const ws = karg_ws(opq_); float* const out = karg_out(opq_); (void)in; (void)ws; (void)out; int tx_ = threadIdx.x; asm volatile("" : "+v"(tx_)); MK_CTX(F, tx_)
#define WSP(type, off) ((type*)(ws + (off)))
    PG8_LAS unsigned char* ring = (PG8_LAS unsigned char*)lds + RING_OFF;
    const PG8_LAS int* tinfo = (const PG8_LAS int*)((PG8_LAS unsigned char*)lds + TINFO_OFF);

    if (IN(0)) { PH_ARGS; p0_prologue(F, in, ws); } SEAM(0);

            if (IN(1)) { PH_ARGS; const float* mod = WSP(float, WS_MOD); norm_mod_phase(F, in[0], in[5], mod + 1024, mod, WSP(bf16, WS_XN)); } SEAM(1);
            if (IN(2)) { PH_ARGS; pg8::Gemm gm{WSP(bf16, WS_XN), WSP(bf16, WS_WD), T, 512, 1024}; pg8::StaticOrder S; S.init(T, 512, F.G, (int)blockIdx.x); pg8::EpiF32 E{WSP(float, WS_LAT), 512};
                pg8::gemm_phase<pg8::EpiF32, pg8::StaticOrder, true, true>(ring, gm, S, E); } SEAM(2);
            if (IN(3)) { PH_ARGS; lat_post_phase(F, WSP(float, WS_LAT), in[8], in[9], in[13], WSP(float, WS_ROPE), WSP(bf16, WS_CQN), WSP(bf16, WS_CKVN), WSP(bf16, WS_KPE)); } SEAM(3);
            if (IN(4)) { PH_ARGS;
                { pg8::Gemm gm{WSP(bf16, WS_CQN), WSP(bf16, WS_WUQ), T, 1536, 256}; pg8::StaticOrder S; S.init(T, 1536, F.G, (int)blockIdx.x); pg8::EpiBf16R E{WSP(bf16, WS_QRAW), 1536, nullptr};
                  pg8::gemm_phase<pg8::EpiBf16R, pg8::StaticOrder, true, true>(ring, gm, S, E); }
                { pg8::Gemm gm{WSP(bf16, WS_CKVN), WSP(bf16, WS_WUKV), T, 2048, 256}; pg8::StaticOrder S; S.init(T, 2048, F.G, (int)blockIdx.x); pg8::EpiBf16R E{WSP(bf16, WS_KV), 2048, nullptr};
                  pg8::gemm_phase<pg8::EpiBf16R, pg8::StaticOrder, true, true>(ring, gm, S, E); }
            } SEAM(4);
            if (IN(5)) { PH_ARGS; knorm_phase(F, WSP(bf16, WS_KV), in[13]); } SEAM(5);
            if (IN(6)) { PH_ARGS;
                const float* qg = in[12]; const float* kg = in[13];
                float gqn = 0.f, gkn = 0.f, gqp = 0.f, gkp = 0.f;
                for (int i = 0; i < 128; ++i) { gqn = fmaxf(gqn, fabsf(qg[i])); gkn = fmaxf(gkn, fabsf(kg[i])); }
                for (int i = 128; i < 192; ++i) { gqp = fmaxf(gqp, fabsf(qg[i])); gkp = fmaxf(gkp, fabsf(kg[i])); }
                const float smaxC = (128.f * gqn * gkn + 64.f * gqp * gkp) * (0.072168783648703220f * 1.4426950408889634f);
                for (int u = F.vcu; u < 1024; u += F.G) { const int b = u >> 7, h = (u >> 4) & 7, qb = u & 15;
                    att::attn_unit(b, h, qb * 256, WSP(bf16, WS_QRAW), WSP(bf16, WS_KV), WSP(bf16, WS_KPE), WSP(bf16, WS_O), WSP(float, WS_ROPE), qg, smaxC, (char*)lds + RING_OFF); }
            } SEAM(6);
            if (IN(7)) { PH_ARGS; pg8::Gemm gm{WSP(bf16, WS_O), WSP(bf16, WS_WO), T, 1024, 1024}; pg8::StaticOrder S; S.init(T, 1024, F.G, (int)blockIdx.x); pg8::EpiResGate E{in[0], out, WSP(float, WS_MOD) + 2048, 1024};
                pg8::gemm_phase<pg8::EpiResGate, pg8::StaticOrder, true, true>(ring, gm, S, E); } SEAM(7);
    MOE_PHASES(0); SEAM(11);
            if (IN(12)) { PH_ARGS; const float* mod = WSP(float, WS_MOD) + 8 * 6144; norm_mod_phase(F, out, in[5] + 1024, mod + 1024, mod, WSP(bf16, WS_XN1));
                __syncthreads();
                pg8::Gemm gm{WSP(bf16, WS_W4S), WSP(bf16, WS_HDNS), 4096, 4096, 256}; pg8::StaticOrder S; S.init(4096, 4096, F.G, (int)blockIdx.x); pg8::EpiF32 E{WSP(float, WS_HT), 4096};
                pg8::gemm_phase<pg8::EpiF32, pg8::StaticOrder, true, true>(ring, gm, S, E); } SEAM(12);
            if (IN(13)) { PH_ARGS; filter_phase(F, WSP(float, WS_HT), in[29], WSP(c32, WS_KF)); } SEAM(13);
            if (IN(14)) { PH_ARGS; pg8::Gemm gm{WSP(bf16, WS_WIN), WSP(bf16, WS_XN1), 3072, T, 1024}; pg8::StaticOrder S; S.init(3072, T, F.G, (int)blockIdx.x); pg8::EpiBf16R E{WSP(bf16, WS_UT), T, in[16]};
                pg8::gemm_phase<pg8::EpiBf16R, pg8::StaticOrder, true, true>(ring, gm, S, E); } SEAM(14);
            if (IN(15)) { PH_ARGS; conv_phase(F, WSP(bf16, WS_UT), WSP(c32, WS_KF), in[17], in[18], WSP(bf16, WS_ZT)); } SEAM(15);
            if (IN(16)) { PH_ARGS; transpose_phase(F, WSP(bf16, WS_ZT), WSP(bf16, WS_Z)); } SEAM(16);
            if (IN(17)) { PH_ARGS; pg8::Gemm gm{WSP(bf16, WS_Z), WSP(bf16, WS_WOUT), T, 1024, 1024}; pg8::StaticOrder S; S.init(T, 1024, F.G, (int)blockIdx.x); pg8::EpiResGate E{out, out, WSP(float, WS_MOD) + 8 * 6144 + 2048, 1024};
                pg8::gemm_phase<pg8::EpiResGate, pg8::StaticOrder, true, true>(ring, gm, S, E); } SEAM(17);
    MOE_PHASES(1);
#undef IN
#undef SEAM
}

#ifndef ONE_LAUNCH
#define ONE_LAUNCH 0
#endif
extern "C" void kernel_launch(void* const* d_in, const int* in_sizes, int n_in, void* d_out, int out_size, void* d_ws, size_t ws_size, hipStream_t stream) {
    static int grid = 0;
    if (grid == 0) {
        if (n_in != 38 || in_sizes[0] != T * DM || out_size != T * DM || ws_size < WS_END) { fprintf(stderr, "kernel_launch: shape mismatch n_in %d in0 %d out %d ws %zu\n", n_in, n_in > 0 ? in_sizes[0] : -1, out_size, ws_size); grid = -1; return; }
        int dev = 0, cus = 0, per_cu = 0;
        if (hipGetDevice(&dev) != hipSuccess || hipDeviceGetAttribute(&cus, hipDeviceAttributeMultiprocessorCount, dev) != hipSuccess) { grid = -1; return; }
        if (hipFuncSetAttribute((const void*)fwd_kernel, hipFuncAttributeMaxDynamicSharedMemorySize, LDS_BYTES) != hipSuccess) { fprintf(stderr, "kernel_launch: hipFuncSetAttribute failed\n"); grid = -1; return; }
        if (hipOccupancyMaxActiveBlocksPerMultiprocessor(&per_cu, (const void*)fwd_kernel, NTHR, LDS_BYTES) != hipSuccess || per_cu < 1) { fprintf(stderr, "kernel_launch: occupancy query says %d\n", per_cu); }
        (void)hipGetLastError();
        grid = cus;
    }
    if (grid < 0) return;
    if (hipMemsetAsync((char*)d_ws + WS_CTL, 0, CTL_ZERO_BYTES, stream) != hipSuccess) return;
    Args a{};
    for (int i = 0; i < 38; ++i) a.in[i] = (const float*)d_in[i];
    a.out = (float*)d_out; a.ws = (unsigned char*)d_ws;
#if ONE_LAUNCH
    a.ph_lo = 0; a.ph_hi = NPH;
    hipLaunchKernelGGL(fwd_kernel, dim3(grid), dim3(NTHR), LDS_BYTES, stream, a);
#else
    for (int p = 0; p < NPH; ++p) { a.ph_lo = p; a.ph_hi = p + 1; hipLaunchKernelGGL(fwd_kernel, dim3(grid), dim3(NTHR), LDS_BYTES, stream, a); }
#endif
    const hipError_t le = hipPeekAtLastError();
    if (le != hipSuccess) fprintf(stderr, "kernel_launch: launch failed: %s\n", hipGetErrorName(le));
}
```

```cpp
#include <hip/hip_runtime.h>
#include <cstdio>
#include <cstdint>
namespace pg8 {
#define PG8_LAS __attribute__((address_space(3)))
typedef unsigned short bf16_t;
typedef short bf16x8 __attribute__((ext_vector_type(8)));
typedef float f32x4 __attribute__((ext_vector_type(4)));
typedef unsigned u32x4 __attribute__((ext_vector_type(4)));
constexpr int BM = 256, BK = 64, HALF = 128, HTB = HALF * BK * 2  , STAGE_BYTES = 8 * HTB, NXCD = 8, WGM = 8;

__host__ __device__ __forceinline__ int lds_byte(int r, int c) { const int st = (r >> 4) * 2 + (c >> 5), rr = r & 15, cc = c & 31, ob = rr * 64 + cc * 2; return st * 1024 + (ob ^ (((ob >> 9) & 1) << 5)); }
__host__ __device__ __forceinline__ void stage_rc(int b, int& R, int& C) { const int st = b / 1024, sb = b % 1024, swz = sb ^ (((sb >> 9) & 1) << 5); R = (st >> 1) * 16 + swz / 64; C = (st & 1) * 32 + (swz % 64) / 2; }
__host__ __device__ __forceinline__ int perm32(int rho) { const int n = rho >> 4, i = rho & 15; return 8 * (i >> 2) + 4 * n + (i & 3); }

struct Unit { int pm, pn; };
struct Gemm { const bf16_t* A; const bf16_t* Bt; int M, N, K; };

struct StaticOrder {
    int nM, nN, nwg, G, c;
    __host__ __device__ void init(int M, int N, int G_, int c_) { nM = M / BM; nN = N / BM; nwg = nM * nN; G = G_; c = c_; }
    __host__ __device__ bool next(int i, Unit& u) const {
        const long L = (long)i * G + c; if (L >= nwg) return false;
        int wgid = (int)L; { const int q = nwg / NXCD, r = nwg % NXCD, xcd = wgid % NXCD, off = wgid / NXCD; wgid = (xcd < r ? xcd * (q + 1) : r * (q + 1) + (xcd - r) * q) + off; }
        const int nig = WGM * nN, gid = wgid / nig, fm = gid * WGM, gsz = (nM - fm) < WGM ? (nM - fm) : WGM;
        u.pm = fm + ((wgid % nig) % gsz); u.pn = (wgid % nig) / gsz; return true;
    }
    __device__ __forceinline__ void a_ready(const Unit&) const {}
    __device__ __forceinline__ void done(const Unit&) const {}
};

__device__ __forceinline__ unsigned cvt_pk_bf16(float lo, float hi) { unsigned r; asm volatile("v_cvt_pk_bf16_f32 %0, %1, %2" : "=v"(r) : "v"(lo), "v"(hi)); return r; }
typedef float f32x2 __attribute__((ext_vector_type(2)));
typedef unsigned u32x2 __attribute__((ext_vector_type(2)));
struct EpiF32 {
    static constexpr bool PERM = false, AFTER_DRAIN = false;
    float* C; int ldc;
    __device__ __forceinline__ void operator()(const f32x4 (&acc)[2][2][4][2], const Unit& u, int wr, int wc, int fr, int fq) const {
        const int row0 = u.pm * BM + wr * 64 + fr, col0 = u.pn * BM + wc * 32 + 4 * fq;
#pragma unroll
        for (int ai = 0; ai < 2; ++ai)
#pragma unroll
            for (int m = 0; m < 4; ++m) { float* rowp = C + (size_t)(row0 + ai * HALF + m * 16) * ldc + col0;
#pragma unroll
                for (int bj = 0; bj < 2; ++bj)
#pragma unroll
                    for (int n = 0; n < 2; ++n) *(f32x4*)(rowp + bj * HALF + n * 16) = acc[ai][bj][m][n]; }
    }
};
struct EpiBf16R {
    static constexpr bool PERM = true, AFTER_DRAIN = false;
    bf16_t* O; int ldc; const float* rowbias;
    __device__ __forceinline__ void operator()(const f32x4 (&acc)[2][2][4][2], const Unit& u, int wr, int wc, int fr, int fq) const {
        const int row0 = u.pm * BM + wr * 64 + fr, col0 = u.pn * BM + wc * 32 + 8 * fq;
#pragma unroll
        for (int ai = 0; ai < 2; ++ai)
#pragma unroll
            for (int m = 0; m < 4; ++m) { const int row = row0 + ai * HALF + m * 16; bf16_t* rowp = O + (size_t)row * ldc + col0; const float rb = rowbias ? rowbias[row] : 0.f;
#pragma unroll
                for (int bj = 0; bj < 2; ++bj) { const f32x4 v0 = acc[ai][bj][m][0] + rb, v1 = acc[ai][bj][m][1] + rb;
                    u32x4 w; w.x = cvt_pk_bf16(v0[0], v0[1]); w.y = cvt_pk_bf16(v0[2], v0[3]); w.z = cvt_pk_bf16(v1[0], v1[1]); w.w = cvt_pk_bf16(v1[2], v1[3]);
                    *(u32x4*)(rowp + bj * HALF) = w; } }
    }
};
__device__ __forceinline__ f32x4 ld4(const float* p) { return *(const f32x4*)p; }
__device__ __forceinline__ f32x4 ld4(const bf16_t* p) { const u32x2 w = *(const u32x2*)p; f32x4 r; r[0] = __uint_as_float(w.x << 16); r[1] = __uint_as_float(w.x & 0xffff0000u); r[2] = __uint_as_float(w.y << 16); r[3] = __uint_as_float(w.y & 0xffff0000u); return r; }
__device__ __forceinline__ void st4(float* p, f32x4 v) { *(f32x4*)p = v; }
__device__ __forceinline__ void st4(bf16_t* p, f32x4 v) { u32x2 w; w.x = cvt_pk_bf16(v[0], v[1]); w.y = cvt_pk_bf16(v[2], v[3]); *(u32x2*)p = w; }
template <class TB, class TO> struct EpiResGate {
    static constexpr bool PERM = false, AFTER_DRAIN = false;
    const TB* base; TO* out; const float* gate; int ldc;
    __device__ __forceinline__ void operator()(const f32x4 (&acc)[2][2][4][2], const Unit& u, int wr, int wc, int fr, int fq) const {
        const int row0 = u.pm * BM + wr * 64 + fr, col0 = u.pn * BM + wc * 32 + 4 * fq;
        const float* gp = gate + (size_t)(u.pm >> 4) * 6144 + col0;
        f32x4 gv[2][2];
#pragma unroll
        for (int bj = 0; bj < 2; ++bj)
#pragma unroll
            for (int n = 0; n < 2; ++n) gv[bj][n] = *(const f32x4*)(gp + bj * HALF + n * 16);
#pragma unroll
        for (int ai = 0; ai < 2; ++ai)
#pragma unroll
            for (int m = 0; m < 4; ++m) { const size_t off = (size_t)(row0 + ai * HALF + m * 16) * ldc + col0;
#pragma unroll
                for (int bj = 0; bj < 2; ++bj)
#pragma unroll
                    for (int n = 0; n < 2; ++n) { const f32x4 bs = ld4(base + off + bj * HALF + n * 16); st4(out + off + bj * HALF + n * 16, bs + gv[bj][n] * acc[ai][bj][m][n]); }
                asm volatile("" ::: "memory"); }
    }
};
struct EpiLat {
    static constexpr bool PERM = false, AFTER_DRAIN = false;
    bf16_t* CQN; bf16_t* CKVN; unsigned char* KPE  ; const float* qag; const float* kvag; const float* kng; const float* rope; PG8_LAS float* P;
    __device__ __forceinline__ void operator()(const f32x4 (&acc)[2][2][4][2], const Unit& u, int wr, int wc, int, int) const {
        int ln = (int)__builtin_amdgcn_mbcnt_hi(~0u, __builtin_amdgcn_mbcnt_lo(~0u, 0u)); asm volatile("" : "+v"(ln)); const int fr = ln & 15, fq = ln >> 4;
        const int row0 = u.pm * BM + wr * 64 + fr;
#pragma unroll
        for (int ai = 0; ai < 2; ++ai)
#pragma unroll
            for (int m = 0; m < 4; ++m) { float s0 = 0.f, s1 = 0.f;
#pragma unroll
                for (int n = 0; n < 2; ++n) { const f32x4 a = acc[ai][0][m][n], b = acc[ai][1][m][n];
                    s0 += (a[0] * a[0] + a[1] * a[1]) + (a[2] * a[2] + a[3] * a[3]); s1 += (b[0] * b[0] + b[1] * b[1]) + (b[2] * b[2] + b[3] * b[3]); }
                s0 += __shfl_xor(s0, 16); s0 += __shfl_xor(s0, 32); s1 += __shfl_xor(s1, 16); s1 += __shfl_xor(s1, 32);
                if (fq == 0) { const int rl = ai * HALF + wr * 64 + m * 16 + fr; P[rl * 8 + wc] = s0; P[rl * 8 + 4 + wc] = s1; } }
        asm volatile("s_waitcnt lgkmcnt(0)" ::: "memory"); __builtin_amdgcn_s_barrier(); asm volatile("" ::: "memory");
        const int cl = wc * 32 + 4 * fq;
        if (u.pn == 0) {
            f32x4 g[2][2];
#pragma unroll
            for (int bj = 0; bj < 2; ++bj)
#pragma unroll
                for (int n = 0; n < 2; ++n) g[bj][n] = *(const f32x4*)(qag + bj * HALF + cl + 16 * n);
#pragma unroll
            for (int ai = 0; ai < 2; ++ai)
#pragma unroll
                for (int m = 0; m < 4; ++m) { const int rl = ai * HALF + wr * 64 + m * 16 + fr; const f32x4 pa = *(const PG8_LAS f32x4*)(P + rl * 8), pb = *(const PG8_LAS f32x4*)(P + rl * 8 + 4);
                    const float r = __builtin_amdgcn_rsqf((((pa[0] + pa[1]) + (pa[2] + pa[3])) + ((pb[0] + pb[1]) + (pb[2] + pb[3]))) * (1.f / 256.f) + 1e-6f);
                    bf16_t* rowp = CQN + (size_t)(row0 + ai * HALF + m * 16) * 256 + cl;
#pragma unroll
                    for (int bj = 0; bj < 2; ++bj)
#pragma unroll
                        for (int n = 0; n < 2; ++n) { const f32x4 v = acc[ai][bj][m][n] * r * g[bj][n]; u32x2 w; w.x = cvt_pk_bf16(v[0], v[1]); w.y = cvt_pk_bf16(v[2], v[3]); *(u32x2*)(rowp + bj * HALF + 16 * n) = w; } }
        } else {
            f32x4 gk[2], gp[2]; const int e0 = 16 * (wc & 1) + 4 * fq;
#pragma unroll
            for (int n = 0; n < 2; ++n) { gk[n] = *(const f32x4*)(kvag + cl + 16 * n); gp[n] = *(const f32x4*)(kng + 128 + e0 + 32 * n); }
#pragma unroll
            for (int ai = 0; ai < 2; ++ai)
#pragma unroll
                for (int m = 0; m < 4; ++m) { const int rl = ai * HALF + wr * 64 + m * 16 + fr; const f32x4 pa = *(const PG8_LAS f32x4*)(P + rl * 8), pb = *(const PG8_LAS f32x4*)(P + rl * 8 + 4);
                    const float rkv = __builtin_amdgcn_rsqf(((pa[0] + pa[1]) + (pa[2] + pa[3])) * (1.f / 128.f) + 1e-6f), rpe = __builtin_amdgcn_rsqf((pb[0] + pb[1]) * (1.f / 64.f) + 1e-6f);
                    const size_t row = (size_t)(row0 + ai * HALF + m * 16);
#pragma unroll
                    for (int n = 0; n < 2; ++n) { const f32x4 v = acc[ai][0][m][n] * rkv * gk[n]; u32x2 w; w.x = cvt_pk_bf16(v[0], v[1]); w.y = cvt_pk_bf16(v[2], v[3]); *(u32x2*)(CKVN + row * 128 + cl + 16 * n) = w; }
                    if (wc < 2) { const f32x4 x1 = acc[ai][1][m][0] * rpe * gp[0], x2 = acc[ai][1][m][1] * rpe * gp[1];
                        const f32x4 c0 = *(const f32x4*)(rope + row * 64 + e0 * 2), c1 = *(const f32x4*)(rope + row * 64 + e0 * 2 + 4);
                        const float cs[4] = {c0[0], c0[2], c1[0], c1[2]}, sn[4] = {c0[1], c0[3], c1[1], c1[3]};
                        float o1[4], o2[4];
#pragma unroll
                        for (int j = 0; j < 4; ++j) { o1[j] = x1[j] * cs[j] - x2[j] * sn[j]; o2[j] = x1[j] * sn[j] + x2[j] * cs[j]; }
                        int w1 = 0, w2 = 0; w1 = __builtin_amdgcn_cvt_pk_fp8_f32(o1[0], o1[1], w1, false); w1 = __builtin_amdgcn_cvt_pk_fp8_f32(o1[2], o1[3], w1, true); w2 = __builtin_amdgcn_cvt_pk_fp8_f32(o2[0], o2[1], w2, false); w2 = __builtin_amdgcn_cvt_pk_fp8_f32(o2[2], o2[3], w2, true);
                        *(int*)(KPE + row * 64 + e0) = w1; *(int*)(KPE + row * 64 + 32 + e0) = w2; }
                    asm volatile("" ::: "memory"); }
        }
        asm volatile("s_waitcnt lgkmcnt(0)" ::: "memory"); __builtin_amdgcn_s_barrier(); asm volatile("" ::: "memory");
    }
};
struct EpiK8 {
    static constexpr bool PERM = true, AFTER_DRAIN = false;
    unsigned char* K8; const float* kng; PG8_LAS float* P;
    __device__ __forceinline__ void operator()(const f32x4 (&acc)[2][2][4][2], const Unit& u, int wr, int wc, int, int) const {
        int ln = (int)__builtin_amdgcn_mbcnt_hi(~0u, __builtin_amdgcn_mbcnt_lo(~0u, 0u)); asm volatile("" : "+v"(ln)); const int fr = ln & 15, fq = ln >> 4;
#pragma unroll
        for (int ai = 0; ai < 2; ++ai)
#pragma unroll
            for (int m = 0; m < 4; ++m) {
#pragma unroll
                for (int bj = 0; bj < 2; ++bj) { const f32x4 a = acc[ai][bj][m][0], b = acc[ai][bj][m][1];
                    float s = (a[0] * a[0] + a[1] * a[1]) + (a[2] * a[2] + a[3] * a[3]) + (b[0] * b[0] + b[1] * b[1]) + (b[2] * b[2] + b[3] * b[3]);
                    s += __shfl_xor(s, 16); s += __shfl_xor(s, 32);
                    if (fq == 0) P[(ai * HALF + wr * 64 + m * 16 + fr) * 8 + bj * 4 + wc] = s; } }
        asm volatile("s_waitcnt lgkmcnt(0)" ::: "memory"); __builtin_amdgcn_s_barrier(); asm volatile("" ::: "memory");
        const f32x4 g0 = *(const f32x4*)(kng + wc * 32 + 8 * fq), g1 = *(const f32x4*)(kng + wc * 32 + 8 * fq + 4);
        const int row0 = u.pm * BM + wr * 64 + fr;
#pragma unroll
        for (int ai = 0; ai < 2; ++ai)
#pragma unroll
            for (int m = 0; m < 4; ++m) { const int rl = ai * HALF + wr * 64 + m * 16 + fr;
#pragma unroll
                for (int bj = 0; bj < 2; ++bj) { const f32x4 p4 = *(const PG8_LAS f32x4*)(P + rl * 8 + bj * 4);
                    const float r = __builtin_amdgcn_rsqf(((p4[0] + p4[1]) + (p4[2] + p4[3])) * (1.f / 128.f) + 1e-6f);
                    const f32x4 v0 = acc[ai][bj][m][0] * r * g0, v1 = acc[ai][bj][m][1] * r * g1;
                    int w0 = 0, w1 = 0; w0 = __builtin_amdgcn_cvt_pk_fp8_f32(v0[0], v0[1], w0, false); w0 = __builtin_amdgcn_cvt_pk_fp8_f32(v0[2], v0[3], w0, true); w1 = __builtin_amdgcn_cvt_pk_fp8_f32(v1[0], v1[1], w1, false); w1 = __builtin_amdgcn_cvt_pk_fp8_f32(v1[2], v1[3], w1, true);
                    u32x2 w; w.x = (unsigned)w0; w.y = (unsigned)w1; *(u32x2*)(K8 + ((size_t)(row0 + ai * HALF + m * 16) * 8 + 2 * u.pn + bj) * 128 + wc * 32 + 8 * fq) = w; } }
        asm volatile("s_waitcnt lgkmcnt(0)" ::: "memory"); __builtin_amdgcn_s_barrier(); asm volatile("" ::: "memory");
    }
};
struct EpiF8T {
    static constexpr bool PERM = true, AFTER_DRAIN = false;
    unsigned char* O; int ldc;
    __device__ __forceinline__ void operator()(const f32x4 (&acc)[2][2][4][2], const Unit& u, int wr, int wc, int fr, int fq) const {
        const int row0 = u.pm * BM + wr * 64 + fr, col0 = u.pn * BM + wc * 32 + 8 * fq;
#pragma unroll
        for (int ai = 0; ai < 2; ++ai)
#pragma unroll
            for (int m = 0; m < 4; ++m) { unsigned char* rowp = O + (size_t)(row0 + ai * HALF + m * 16) * ldc + col0;
#pragma unroll
                for (int bj = 0; bj < 2; ++bj) { const f32x4 v0 = acc[ai][bj][m][0], v1 = acc[ai][bj][m][1];
                    int w0 = 0, w1 = 0; w0 = __builtin_amdgcn_cvt_pk_fp8_f32(v0[0], v0[1], w0, false); w0 = __builtin_amdgcn_cvt_pk_fp8_f32(v0[2], v0[3], w0, true); w1 = __builtin_amdgcn_cvt_pk_fp8_f32(v1[0], v1[1], w1, false); w1 = __builtin_amdgcn_cvt_pk_fp8_f32(v1[2], v1[3], w1, true);
                    u32x2 w; w.x = (unsigned)w0; w.y = (unsigned)w1; *(u32x2*)(rowp + bj * HALF) = w; } }
    }
};
__device__ __forceinline__ void pair_of(int pi, int& i, int& j) { i = pi < 3 ? 0 : (pi < 5 ? 1 : 2); j = pi < 3 ? pi + 1 : (pi < 5 ? pi - 1 : 3); }
struct MoeOrder {
    const PG8_LAS int* tinfo; int G, c, mode; const int* list;
    __device__ __forceinline__ int tok(const Unit& u, int r) const { const int bk = tinfo[1 + u.pm], pos = u.pm * BM - tinfo[256 + bk] + r; return list[bk * 32768 + (pos < tinfo[288 + bk] ? pos : 0)]; }
    __device__ __forceinline__ bool next(int i, Unit& u) const {
        const long L = (long)i * G + c; const int nt = tinfo[0]; if (L >= 4L * nt) return false;
        const int mt = (int)(L >> 2), q = (int)(L & 3), bk = tinfo[1 + mt];
        u.pm = mt;
        if (mode == 0) { int ii, jj; pair_of(bk % 6, ii, jj); const int e = (bk / 6) * 4 + ((q >> 1) ? jj : ii); u.pn = e * 2 + (q & 1); }
        else u.pn = bk * 4 + q;
        return true;
    }
    __device__ __forceinline__ void a_ready(const Unit&) const {}
    __device__ __forceinline__ void done(const Unit&) const {}
};
struct EpiSwiGLU {
    static constexpr bool PERM = true, AFTER_DRAIN = false;
    bf16_t* H; const float* wl; const PG8_LAS int* tinfo;
    __device__ __forceinline__ void operator()(const f32x4 (&acc)[2][2][4][2], const Unit& u, int wr, int wc, int, int) const {
        int ln = (int)__builtin_amdgcn_mbcnt_hi(~0u, __builtin_amdgcn_mbcnt_lo(~0u, 0u)); asm volatile("" : "+v"(ln)); const int fr = ln & 15, fq = ln >> 4;
        const int bk = tinfo[1 + u.pm]; int ii, jj; pair_of(bk % 6, ii, jj);
        const int e = u.pn >> 1, hh = u.pn & 1, slot = (e == (bk / 6) * 4 + jj) ? 1 : 0;
        const int row0 = u.pm * BM + wr * 64 + fr, col0 = slot * 256 + hh * 128 + wc * 32 + 8 * fq;
#pragma unroll
        for (int ai = 0; ai < 2; ++ai)
#pragma unroll
            for (int m = 0; m < 4; ++m) { const int row = row0 + ai * HALF + m * 16, pos = row - tinfo[256 + bk]; const float w = pos < tinfo[288 + bk] ? wl[((size_t)bk * 32768 + pos) * 2 + slot] : 0.f;
                float a[8];
#pragma unroll
                for (int n = 0; n < 2; ++n)
#pragma unroll
                    for (int j = 0; j < 4; ++j) { const float g = acc[ai][0][m][n][j], up = acc[ai][1][m][n][j];
                        const float sg = g * __builtin_amdgcn_rcpf(1.0f + __builtin_amdgcn_exp2f(-1.4426950408889634f * g)); a[n * 4 + j] = sg * up * w; }
                u32x4 o; o.x = cvt_pk_bf16(a[0], a[1]); o.y = cvt_pk_bf16(a[2], a[3]); o.z = cvt_pk_bf16(a[4], a[5]); o.w = cvt_pk_bf16(a[6], a[7]);
                *(u32x4*)(H + (size_t)row * 512 + col0) = o; asm volatile("" ::: "memory"); }
    }
};
template <class TO> struct EpiMoeOut {
    static constexpr bool PERM = false, AFTER_DRAIN = false;
    const bf16_t* xr; TO* out; const float* gate; const int* list; const PG8_LAS int* tinfo;
    __device__ __forceinline__ void operator()(const f32x4 (&acc)[2][2][4][2], const Unit& u, int wr, int wc, int fr, int fq) const {
        const int bk = tinfo[1 + u.pm], r_end = tinfo[256 + bk] + tinfo[288 + bk];
        const int row0 = u.pm * BM + wr * 64 + fr, col0 = (u.pn & 3) * BM + wc * 32 + 4 * fq;
#pragma unroll
        for (int ai = 0; ai < 2; ++ai)
#pragma unroll
            for (int m = 0; m < 4; ++m) { const int row = row0 + ai * HALF + m * 16;
                if (row < r_end) { const int tok = list[bk * 32768 + row - tinfo[256 + bk]]; TO* op = out + (size_t)tok * 1024 + col0; const bf16_t* xp = xr + (size_t)tok * 1024 + col0; const float* gp = gate + (size_t)(tok >> 12) * 6144 + col0;
#pragma unroll
                    for (int bj = 0; bj < 2; ++bj)
#pragma unroll
                        for (int n = 0; n < 2; ++n) { const f32x4 bs = ld4(xp + bj * HALF + n * 16), gv = *(const f32x4*)(gp + bj * HALF + n * 16); st4(op + bj * HALF + n * 16, bs + gv * acc[ai][bj][m][n]); } }
                asm volatile("" ::: "memory"); }
    }
};
template <class Epi, class Sched, bool ALIGN_EPI = false, bool SP2 = false>
__device__ __forceinline__ void gemm_phase(PG8_LAS unsigned char* lds, const Gemm g, const Sched& S, const Epi& E, const int tid) {
    const int wid = __builtin_amdgcn_readfirstlane(tid >> 6), lane = tid & 63, wr = wid >> 2, wc = wid & 3, fr = lane & 15, fq = lane >> 4;
    int K = g.K; asm volatile("" : "+s"(K)); const int nt = K / BK;
    unsigned voffA[2], voffB[2];
#pragma unroll
    for (int i = 0; i < 2; ++i) { int R, C; stage_rc(tid * 16 + i * 8192, R, C); const int Rb = Epi::PERM ? ((R & ~31) + perm32(R & 31)) : R;
        voffA[i] = (unsigned)(R * K + C) * 2u; voffB[i] = (unsigned)(Rb * K + C) * 2u; }
    const size_t kstep = (size_t)(BK * 2);
    const size_t hstep = (size_t)HALF * K * 2;
    const size_t tstep = 2 * hstep;
    const unsigned ldsw = (unsigned)wid * 1024u;
    const int aoff = lds_byte(wr * 64 + fr, fq * 8), boff = lds_byte(wc * 32 + fr, fq * 8);
#define PG8_SA(b, h) (((b) * 2 + (h)) * HTB)
#define PG8_SB(b, h) ((4 + (b) * 2 + (h)) * HTB)
#define PG8_STAGE(bufoff, gbase, voff) do { _Pragma("unroll") for (int _i = 0; _i < 2; ++_i) \
        __builtin_amdgcn_global_load_lds((const unsigned*)((const char*)(gbase) + (voff)[_i]), (PG8_LAS unsigned*)(lds + (bufoff) + ldsw + _i * 8192), 16, 0, 0); } while (0)
#define PG8_LDA(dst, b, h) do { _Pragma("unroll") for (int m = 0; m < 4; ++m) _Pragma("unroll") for (int k = 0; k < 2; ++k) dst[m][k] = *(const PG8_LAS bf16x8*)(lds + PG8_SA(b, h) + aoff + m * 2048 + k * 1024); } while (0)
#define PG8_LDB(dst, b, h) do { _Pragma("unroll") for (int n = 0; n < 2; ++n) _Pragma("unroll") for (int k = 0; k < 2; ++k) dst[n][k] = *(const PG8_LAS bf16x8*)(lds + PG8_SB(b, h) + boff + n * 2048 + k * 1024); } while (0)
#define PG8_MMA(ai, bj, At, Bt) do { __builtin_amdgcn_s_setprio(1); _Pragma("unroll") for (int m = 0; m < 4; ++m) _Pragma("unroll") for (int n = 0; n < 2; ++n) _Pragma("unroll") for (int k = 0; k < 2; ++k) \
        acc[ai][bj][m][n] = __builtin_amdgcn_mfma_f32_16x16x32_bf16(Bt[n][k], At[m][k], acc[ai][bj][m][n], 0, 0, 0); __builtin_amdgcn_s_setprio(0); } while (0)
#define PG8_WAIT_V(n) asm volatile("s_waitcnt vmcnt(" #n ")" ::: "memory")
#define PG8_WAIT_L(n) asm volatile("s_waitcnt lgkmcnt(" #n ")" ::: "memory")
#define PG8_BAR __builtin_amdgcn_s_barrier()
#define PG8_SCHED __builtin_amdgcn_sched_barrier(0)
    Unit cur, nxt; int ui = 0;
    if (!S.next(0, cur)) return;
    f32x4 acc[2][2][4][2];
#pragma unroll
    for (int a = 0; a < 2; ++a)
#pragma unroll
        for (int b = 0; b < 2; ++b)
#pragma unroll
            for (int m = 0; m < 4; ++m)
#pragma unroll
                for (int n = 0; n < 2; ++n) acc[a][b][m][n] = (f32x4){0.f, 0.f, 0.f, 0.f};
    bf16x8 At[4][2], B0[2][2], B1[2][2];
    const char* cA = (const char*)g.A + (size_t)cur.pm * tstep; const char* cB = (const char*)g.Bt + (size_t)cur.pn * tstep;
    S.a_ready(cur);
    if constexpr (SP2) {
        PG8_STAGE(PG8_SB(0, 0), cB, voffB); PG8_STAGE(PG8_SB(0, 1), cB + hstep, voffB); PG8_STAGE(PG8_SA(0, 0), cA, voffA); PG8_STAGE(PG8_SA(0, 1), cA + hstep, voffA);
        if (wr == 1) PG8_BAR;
        PG8_WAIT_V(2); PG8_BAR;
        PG8_STAGE(PG8_SB(1, 0), cB + kstep, voffB); PG8_STAGE(PG8_SA(1, 0), cA + kstep, voffA); PG8_STAGE(PG8_SB(1, 1), cB + hstep + kstep, voffB);
        PG8_WAIT_V(6); PG8_BAR;
    } else {
        PG8_STAGE(PG8_SB(0, 0), cB, voffB); PG8_STAGE(PG8_SA(0, 0), cA, voffA); PG8_STAGE(PG8_SB(0, 1), cB + hstep, voffB); PG8_STAGE(PG8_SA(0, 1), cA + hstep, voffA);
        if (wr == 1) PG8_BAR;
        PG8_WAIT_V(4); PG8_BAR;
        PG8_STAGE(PG8_SB(1, 0), cB + kstep, voffB); PG8_STAGE(PG8_SA(1, 0), cA + kstep, voffA); PG8_STAGE(PG8_SB(1, 1), cB + hstep + kstep, voffB);
        PG8_WAIT_V(6); PG8_BAR;
    }
    for (;;) {
        const bool has_next = S.next(ui + 1, nxt);
        const char* nA = has_next ? (const char*)g.A + (size_t)nxt.pm * tstep : cA; const char* nB = has_next ? (const char*)g.Bt + (size_t)nxt.pn * tstep : cB;
        for (int t = 0; t < nt; t += 2) {
            const bool last = (t == nt - 2);
            const char* a1 = cA + (size_t)(t + 1) * kstep;
            const char* a2 = last ? nA : cA + (size_t)(t + 2) * kstep; const char* b2 = last ? nB : cB + (size_t)(t + 2) * kstep;
            const char* a3 = a2 + kstep; const char* b3 = b2 + kstep;
            if (last && has_next) S.a_ready(nxt);
            if constexpr (SP2) {
            PG8_LDB(B0, 0, 0); PG8_LDB(B1, 0, 1); PG8_SCHED; PG8_LDA(At, 0, 0); PG8_STAGE(PG8_SA(1, 1), a1 + hstep, voffA);
            PG8_WAIT_V(8); PG8_WAIT_L(0); PG8_BAR; PG8_MMA(0, 0, At, B0); PG8_MMA(0, 1, At, B1); PG8_BAR; PG8_SCHED;
            PG8_LDA(At, 0, 1); PG8_STAGE(PG8_SB(0, 0), b2, voffB); PG8_STAGE(PG8_SB(0, 1), b2 + hstep, voffB); PG8_STAGE(PG8_SA(0, 0), a2, voffA);
            PG8_WAIT_V(8); PG8_WAIT_L(0); PG8_BAR; PG8_MMA(1, 0, At, B0); PG8_MMA(1, 1, At, B1); PG8_BAR; PG8_SCHED;
            PG8_LDB(B0, 1, 0); PG8_LDB(B1, 1, 1); PG8_SCHED; PG8_LDA(At, 1, 0); PG8_STAGE(PG8_SA(0, 1), a2 + hstep, voffA);
            PG8_WAIT_V(8); PG8_WAIT_L(0); PG8_BAR; PG8_MMA(0, 0, At, B0); PG8_MMA(0, 1, At, B1); PG8_BAR; PG8_SCHED;
            PG8_LDA(At, 1, 1); PG8_STAGE(PG8_SB(1, 0), b3, voffB); PG8_STAGE(PG8_SB(1, 1), b3 + hstep, voffB); PG8_STAGE(PG8_SA(1, 0), a3, voffA);
            PG8_WAIT_V(8); PG8_WAIT_L(0); PG8_BAR; PG8_MMA(1, 0, At, B0); PG8_MMA(1, 1, At, B1); PG8_BAR; PG8_SCHED;
            } else {
            PG8_LDB(B0, 0, 0); PG8_SCHED; PG8_LDA(At, 0, 0); PG8_STAGE(PG8_SA(1, 1), a1 + hstep, voffA);
            PG8_WAIT_L(8); PG8_BAR; PG8_WAIT_L(0); PG8_MMA(0, 0, At, B0); PG8_BAR; PG8_SCHED;
            PG8_LDB(B1, 0, 1); PG8_STAGE(PG8_SB(0, 0), b2, voffB);
            PG8_BAR; PG8_WAIT_L(0); PG8_MMA(0, 1, At, B1); PG8_BAR;
            PG8_LDA(At, 0, 1); PG8_STAGE(PG8_SA(0, 0), a2, voffA);
            PG8_BAR; PG8_WAIT_L(0); PG8_MMA(1, 0, At, B0); PG8_BAR; PG8_SCHED;
            PG8_STAGE(PG8_SB(0, 1), b2 + hstep, voffB);
            PG8_WAIT_V(6); PG8_BAR; PG8_MMA(1, 1, At, B1); PG8_BAR;
            PG8_LDB(B0, 1, 0); PG8_SCHED; PG8_LDA(At, 1, 0); PG8_STAGE(PG8_SA(0, 1), a2 + hstep, voffA);
            PG8_WAIT_L(8); PG8_BAR; PG8_WAIT_L(0); PG8_MMA(0, 0, At, B0); PG8_BAR; PG8_SCHED;
            PG8_LDB(B1, 1, 1); PG8_STAGE(PG8_SB(1, 0), b3, voffB);
            PG8_BAR; PG8_WAIT_L(0); PG8_MMA(0, 1, At, B1); PG8_BAR;
            PG8_LDA(At, 1, 1); PG8_STAGE(PG8_SA(1, 0), a3, voffA);
            PG8_BAR; PG8_WAIT_L(0); PG8_MMA(1, 0, At, B0); PG8_BAR; PG8_SCHED;
            PG8_STAGE(PG8_SB(1, 1), b3 + hstep, voffB);
            PG8_WAIT_V(6); PG8_BAR; PG8_MMA(1, 1, At, B1); PG8_BAR;
            }
        }
        if constexpr (ALIGN_EPI) { if (wr == 0) PG8_BAR; }
        if constexpr (!Epi::AFTER_DRAIN) { E(acc, cur, wr, wc, fr, fq); S.done(cur); }
        if (!has_next) break;
#pragma unroll
        for (int a = 0; a < 2; ++a)
#pragma unroll
            for (int b = 0; b < 2; ++b)
#pragma unroll
                for (int m = 0; m < 4; ++m)
#pragma unroll
                    for (int n = 0; n < 2; ++n) acc[a][b][m][n] = (f32x4){0.f, 0.f, 0.f, 0.f};
        cur = nxt; cA = nA; cB = nB; ++ui;
        if constexpr (ALIGN_EPI) { if (wr == 1) PG8_BAR; }
    }
    PG8_WAIT_V(0);
    if constexpr (!ALIGN_EPI) { if (wr == 0) PG8_BAR; }
    PG8_BAR;
    if constexpr (Epi::AFTER_DRAIN) { E.fused(acc, cur, wr, wc, fr, fq, lds, wid, lane); S.done(cur); }
#undef PG8_SA
#undef PG8_SB
#undef PG8_STAGE
#undef PG8_LDA
#undef PG8_LDB
#undef PG8_MMA
#undef PG8_WAIT_V
#undef PG8_WAIT_L
#undef PG8_BAR
#undef PG8_SCHED
}
template <class Epi, class Sched, bool ALIGN_EPI = true, bool SP2 = true>
__device__ __forceinline__ void gemm_phase_gather(PG8_LAS unsigned char* lds, const Gemm g, const Sched& S, const Epi& E, const int tid) {
    static_assert(SP2, "gather form: SP2 loop only");
    const int wid = __builtin_amdgcn_readfirstlane(tid >> 6), lane = tid & 63, wr = wid >> 2, wc = wid & 3, fr = lane & 15, fq = lane >> 4;
    int K = g.K; asm volatile("" : "+s"(K)); const int nt = K / BK;
    unsigned voffA[2], voffB[2];
#pragma unroll
    for (int i = 0; i < 2; ++i) { int R, C; stage_rc(tid * 16 + i * 8192, R, C); const int Rb = Epi::PERM ? ((R & ~31) + perm32(R & 31)) : R;
        voffA[i] = (unsigned)(R * K + C) * 2u; voffB[i] = (unsigned)(Rb * K + C) * 2u; }
    int gR, gC; stage_rc(tid * 16, gR, gC);
    unsigned vG[2][2], vN[2][2];
    const size_t kstep = (size_t)(BK * 2);
    const size_t hstep = (size_t)HALF * K * 2;
    const size_t tstep = 2 * hstep;
    const unsigned ldsw = (unsigned)wid * 1024u;
    const int aoff = lds_byte(wr * 64 + fr, fq * 8), boff = lds_byte(wc * 32 + fr, fq * 8);
#define PG8_SA(b, h) (((b) * 2 + (h)) * HTB)
#define PG8_SB(b, h) ((4 + (b) * 2 + (h)) * HTB)
#define PG8_STAGE(bufoff, gbase, voff) do { _Pragma("unroll") for (int _i = 0; _i < 2; ++_i) \
        __builtin_amdgcn_global_load_lds((const unsigned*)((const char*)(gbase) + (voff)[_i]), (PG8_LAS unsigned*)(lds + (bufoff) + ldsw + _i * 8192), 16, 0, 0); } while (0)
#define PG8_LDA(dst, b, h) do { _Pragma("unroll") for (int m = 0; m < 4; ++m) _Pragma("unroll") for (int k = 0; k < 2; ++k) dst[m][k] = *(const PG8_LAS bf16x8*)(lds + PG8_SA(b, h) + aoff + m * 2048 + k * 1024); } while (0)
#define PG8_LDB(dst, b, h) do { _Pragma("unroll") for (int n = 0; n < 2; ++n) _Pragma("unroll") for (int k = 0; k < 2; ++k) dst[n][k] = *(const PG8_LAS bf16x8*)(lds + PG8_SB(b, h) + boff + n * 2048 + k * 1024); } while (0)
#define PG8_MMA(ai, bj, At, Bt) do { __builtin_amdgcn_s_setprio(1); _Pragma("unroll") for (int m = 0; m < 4; ++m) _Pragma("unroll") for (int n = 0; n < 2; ++n) _Pragma("unroll") for (int k = 0; k < 2; ++k) \
        acc[ai][bj][m][n] = __builtin_amdgcn_mfma_f32_16x16x32_bf16(Bt[n][k], At[m][k], acc[ai][bj][m][n], 0, 0, 0); __builtin_amdgcn_s_setprio(0); } while (0)
#define PG8_WAIT_V(n) asm volatile("s_waitcnt vmcnt(" #n ")" ::: "memory")
#define PG8_WAIT_L(n) asm volatile("s_waitcnt lgkmcnt(" #n ")" ::: "memory")
#define PG8_BAR __builtin_amdgcn_s_barrier()
#define PG8_SCHED __builtin_amdgcn_sched_barrier(0)
    Unit cur, nxt; int ui = 0;
    if (!S.next(0, cur)) return;
    f32x4 acc[2][2][4][2];
#pragma unroll
    for (int a = 0; a < 2; ++a)
#pragma unroll
        for (int b = 0; b < 2; ++b)
#pragma unroll
            for (int m = 0; m < 4; ++m)
#pragma unroll
                for (int n = 0; n < 2; ++n) acc[a][b][m][n] = (f32x4){0.f, 0.f, 0.f, 0.f};
    bf16x8 At[4][2], B0[2][2], B1[2][2];
    const char* cA = (const char*)g.A; const char* cB = (const char*)g.Bt + (size_t)cur.pn * tstep;
    S.a_ready(cur);
#pragma unroll
    for (int h = 0; h < 2; ++h)
#pragma unroll
        for (int i = 0; i < 2; ++i) vG[h][i] = (unsigned)S.tok(cur, h * HALF + gR + 64 * i) * (unsigned)(K * 2) + (unsigned)(gC * 2);
    if constexpr (SP2) {
        PG8_STAGE(PG8_SB(0, 0), cB, voffB); PG8_STAGE(PG8_SB(0, 1), cB + hstep, voffB); PG8_STAGE(PG8_SA(0, 0), cA, vG[0]); PG8_STAGE(PG8_SA(0, 1), cA, vG[1]);
        if (wr == 1) PG8_BAR;
        PG8_WAIT_V(2); PG8_BAR;
        PG8_STAGE(PG8_SB(1, 0), cB + kstep, voffB); PG8_STAGE(PG8_SA(1, 0), cA + kstep, vG[0]); PG8_STAGE(PG8_SB(1, 1), cB + hstep + kstep, voffB);
        PG8_WAIT_V(6); PG8_BAR;
    } else {
        PG8_STAGE(PG8_SB(0, 0), cB, voffB); PG8_STAGE(PG8_SA(0, 0), cA, voffA); PG8_STAGE(PG8_SB(0, 1), cB + hstep, voffB); PG8_STAGE(PG8_SA(0, 1), cA + hstep, voffA);
        if (wr == 1) PG8_BAR;
        PG8_WAIT_V(4); PG8_BAR;
        PG8_STAGE(PG8_SB(1, 0), cB + kstep, voffB); PG8_STAGE(PG8_SA(1, 0), cA + kstep, voffA); PG8_STAGE(PG8_SB(1, 1), cB + hstep + kstep, voffB);
        PG8_WAIT_V(6); PG8_BAR;
    }
    for (;;) {
        const bool has_next = S.next(ui + 1, nxt);
        const char* nA = cA; const char* nB = has_next ? (const char*)g.Bt + (size_t)nxt.pn * tstep : cB;
        for (int t = 0; t < nt; t += 2) {
            const bool last = (t == nt - 2);
            const char* a1 = cA + (size_t)(t + 1) * kstep;
            const char* a2 = last ? nA : cA + (size_t)(t + 2) * kstep; const char* b2 = last ? nB : cB + (size_t)(t + 2) * kstep;
            const char* a3 = a2 + kstep; const char* b3 = b2 + kstep;
            if (last && has_next) { S.a_ready(nxt);
#pragma unroll
                for (int h = 0; h < 2; ++h)
#pragma unroll
                    for (int i = 0; i < 2; ++i) vN[h][i] = (unsigned)S.tok(nxt, h * HALF + gR + 64 * i) * (unsigned)(K * 2) + (unsigned)(gC * 2); }
            if constexpr (SP2) {
            PG8_LDB(B0, 0, 0); PG8_LDB(B1, 0, 1); PG8_SCHED; PG8_LDA(At, 0, 0); PG8_STAGE(PG8_SA(1, 1), a1, vG[1]);
            if (last && has_next) { vG[0][0] = vN[0][0]; vG[0][1] = vN[0][1]; vG[1][0] = vN[1][0]; vG[1][1] = vN[1][1]; }
            PG8_WAIT_V(8); PG8_WAIT_L(0); PG8_BAR; PG8_MMA(0, 0, At, B0); PG8_MMA(0, 1, At, B1); PG8_BAR; PG8_SCHED;
            PG8_LDA(At, 0, 1); PG8_STAGE(PG8_SB(0, 0), b2, voffB); PG8_STAGE(PG8_SB(0, 1), b2 + hstep, voffB); PG8_STAGE(PG8_SA(0, 0), a2, vG[0]);
            PG8_WAIT_V(8); PG8_WAIT_L(0); PG8_BAR; PG8_MMA(1, 0, At, B0); PG8_MMA(1, 1, At, B1); PG8_BAR; PG8_SCHED;
            PG8_LDB(B0, 1, 0); PG8_LDB(B1, 1, 1); PG8_SCHED; PG8_LDA(At, 1, 0); PG8_STAGE(PG8_SA(0, 1), a2, vG[1]);
            PG8_WAIT_V(8); PG8_WAIT_L(0); PG8_BAR; PG8_MMA(0, 0, At, B0); PG8_MMA(0, 1, At, B1); PG8_BAR; PG8_SCHED;
            PG8_LDA(At, 1, 1); PG8_STAGE(PG8_SB(1, 0), b3, voffB); PG8_STAGE(PG8_SB(1, 1), b3 + hstep, voffB); PG8_STAGE(PG8_SA(1, 0), a3, vG[0]);
            PG8_WAIT_V(8); PG8_WAIT_L(0); PG8_BAR; PG8_MMA(1, 0, At, B0); PG8_MMA(1, 1, At, B1); PG8_BAR; PG8_SCHED;
            } else {
            PG8_LDB(B0, 0, 0); PG8_SCHED; PG8_LDA(At, 0, 0); PG8_STAGE(PG8_SA(1, 1), a1 + hstep, voffA);
            PG8_WAIT_L(8); PG8_BAR; PG8_WAIT_L(0); PG8_MMA(0, 0, At, B0); PG8_BAR; PG8_SCHED;
            PG8_LDB(B1, 0, 1); PG8_STAGE(PG8_SB(0, 0), b2, voffB);
            PG8_BAR; PG8_WAIT_L(0); PG8_MMA(0, 1, At, B1); PG8_BAR;
            PG8_LDA(At, 0, 1); PG8_STAGE(PG8_SA(0, 0), a2, voffA);
            PG8_BAR; PG8_WAIT_L(0); PG8_MMA(1, 0, At, B0); PG8_BAR; PG8_SCHED;
            PG8_STAGE(PG8_SB(0, 1), b2 + hstep, voffB);
            PG8_WAIT_V(6); PG8_BAR; PG8_MMA(1, 1, At, B1); PG8_BAR;
            PG8_LDB(B0, 1, 0); PG8_SCHED; PG8_LDA(At, 1, 0); PG8_STAGE(PG8_SA(0, 1), a2 + hstep, voffA);
            PG8_WAIT_L(8); PG8_BAR; PG8_WAIT_L(0); PG8_MMA(0, 0, At, B0); PG8_BAR; PG8_SCHED;
            PG8_LDB(B1, 1, 1); PG8_STAGE(PG8_SB(1, 0), b3, voffB);
            PG8_BAR; PG8_WAIT_L(0); PG8_MMA(0, 1, At, B1); PG8_BAR;
            PG8_LDA(At, 1, 1); PG8_STAGE(PG8_SA(1, 0), a3, voffA);
            PG8_BAR; PG8_WAIT_L(0); PG8_MMA(1, 0, At, B0); PG8_BAR; PG8_SCHED;
            PG8_STAGE(PG8_SB(1, 1), b3 + hstep, voffB);
            PG8_WAIT_V(6); PG8_BAR; PG8_MMA(1, 1, At, B1); PG8_BAR;
            }
        }
        if constexpr (ALIGN_EPI) { if (wr == 0) PG8_BAR; }
        if constexpr (!Epi::AFTER_DRAIN) { E(acc, cur, wr, wc, fr, fq); S.done(cur); }
        if (!has_next) break;
#pragma unroll
        for (int a = 0; a < 2; ++a)
#pragma unroll
            for (int b = 0; b < 2; ++b)
#pragma unroll
                for (int m = 0; m < 4; ++m)
#pragma unroll
                    for (int n = 0; n < 2; ++n) acc[a][b][m][n] = (f32x4){0.f, 0.f, 0.f, 0.f};
        cur = nxt; cA = nA; cB = nB; ++ui;
        if constexpr (ALIGN_EPI) { if (wr == 1) PG8_BAR; }
    }
    PG8_WAIT_V(0);
    if constexpr (!ALIGN_EPI) { if (wr == 0) PG8_BAR; }
    PG8_BAR;
    if constexpr (Epi::AFTER_DRAIN) { E.fused(acc, cur, wr, wc, fr, fq, lds, wid, lane); S.done(cur); }
#undef PG8_SA
#undef PG8_SB
#undef PG8_STAGE
#undef PG8_LDA
#undef PG8_LDB
#undef PG8_MMA
#undef PG8_WAIT_V
#undef PG8_WAIT_L
#undef PG8_BAR
#undef PG8_SCHED
}
}
namespace att {
typedef unsigned short bf16;
using bf16x8 = __attribute__((ext_vector_type(8))) short;
using s16x4  = __attribute__((ext_vector_type(4))) short;
using f32x16 = __attribute__((ext_vector_type(16))) float;
using u32x4  = __attribute__((ext_vector_type(4))) unsigned;
using f32x4_t = __attribute__((ext_vector_type(4))) float;
constexpr int NW = 8, QBLK = 32, KVBLK = 64, SEQ = 4096;
constexpr int LDQ = 1536, LDKV = 2048, LDO = 1024;
constexpr int SHM_VT = 160 * 80, SHM_K8 = 64 * 208;
constexpr int OFF_V = 0, OFF_K8 = 3 * SHM_VT, OFF_WS = OFF_K8 + 2 * SHM_K8, LDS_BYTES = OFF_WS + NW * 64 * 4 + 64;
typedef int v8i32 __attribute__((ext_vector_type(8)));
typedef int v4i32 __attribute__((ext_vector_type(4)));
typedef int v2i32 __attribute__((ext_vector_type(2)));
constexpr int T_TOK = 8 * SEQ;
#define ASBAR() __builtin_amdgcn_sched_barrier(0)
__device__ __forceinline__ int crow(int r, int hi) { return (r & 3) + 8 * (r >> 2) + 4 * hi; }
__device__ __forceinline__ unsigned cvtpk(float lo, float hi) { unsigned r; asm volatile("v_cvt_pk_bf16_f32 %0, %1, %2" : "=v"(r) : "v"(lo), "v"(hi)); return r; }
__device__ __forceinline__ float bf2f(unsigned short b) { return __uint_as_float(((unsigned)b) << 16); }
template <bool SHIFT> __device__ __forceinline__ void smA(f32x16& p0, float negm) { for (int r = 0; r < 16; ++r) p0[r] = __builtin_amdgcn_exp2f(SHIFT ? p0[r] + negm : p0[r]); }
template <bool SHIFT> __device__ __forceinline__ void smB(f32x16& p0, f32x16& p1, float& l_reg, v8i32& p8, float negm) {
  for (int r = 0; r < 16; ++r) p1[r] = __builtin_amdgcn_exp2f(SHIFT ? p1[r] + negm : p1[r]);
  (void)l_reg;
#pragma unroll
  for (int w = 0; w < 4; ++w) { int a = 0, bq = 0;
    a = __builtin_amdgcn_cvt_pk_bf8_f32(p0[4 * w], p0[4 * w + 1], a, false); a = __builtin_amdgcn_cvt_pk_bf8_f32(p0[4 * w + 2], p0[4 * w + 3], a, true);
    bq = __builtin_amdgcn_cvt_pk_bf8_f32(p1[4 * w], p1[4 * w + 1], bq, false); bq = __builtin_amdgcn_cvt_pk_bf8_f32(p1[4 * w + 2], p1[4 * w + 3], bq, true);
    p8[w] = a; p8[4 + w] = bq; }
}
template <bool SHIFT> __device__ __forceinline__ void qkt(f32x16& p0, f32x16& p1, const char* K8, const v8i32* q8, float negm, int r32, int hi) {
  p0 = f32x16{}; p1 = f32x16{};
#define K8RD(m, half, part) (*reinterpret_cast<const v4i32*>(K8 + ((half) * 32 + r32) * 208 + (m) * 64 + hi * 32 + (part) * 16))
#define K8FR(m, half) ({ const v4i32 lo_ = K8RD(m, half, 0), hi_ = K8RD(m, half, 1); (v8i32){lo_[0], lo_[1], lo_[2], lo_[3], hi_[0], hi_[1], hi_[2], hi_[3]}; })
  v8i32 a0 = K8FR(0, 0), a1 = K8FR(0, 1), b0 = K8FR(1, 0), b1 = K8FR(1, 1);
  ASBAR();
  p0 = __builtin_amdgcn_mfma_scale_f32_32x32x64_f8f6f4(a0, q8[0], p0, 0, 0, 0, 0x7f7f7f7f, 0, 0x7f7f7f7f);
  p1 = __builtin_amdgcn_mfma_scale_f32_32x32x64_f8f6f4(a1, q8[0], p1, 0, 0, 0, 0x7f7f7f7f, 0, 0x7f7f7f7f);
  a0 = K8FR(2, 0); a1 = K8FR(2, 1);
  ASBAR();
  p0 = __builtin_amdgcn_mfma_scale_f32_32x32x64_f8f6f4(b0, q8[1], p0, 0, 0, 0, 0x7f7f7f7f, 0, 0x7f7f7f7f);
  p1 = __builtin_amdgcn_mfma_scale_f32_32x32x64_f8f6f4(b1, q8[1], p1, 0, 0, 0, 0x7f7f7f7f, 0, 0x7f7f7f7f);
  ASBAR();
  p0 = __builtin_amdgcn_mfma_scale_f32_32x32x64_f8f6f4(a0, q8[2], p0, 0, 0, 0, 0x7f7f7f7f, 0, 0x7f7f7f7f);
  p1 = __builtin_amdgcn_mfma_scale_f32_32x32x64_f8f6f4(a1, q8[2], p1, 0, 0, 0, 0x7f7f7f7f, 0, 0x7f7f7f7f);
  ASBAR();
#undef K8RD
#undef K8FR
}
__device__ __forceinline__ void pv_d0(f32x16* o  , const char* VT, v8i32 p8, int r32, int hi) {
#define VTFR(d0) ({ const v4i32 lo_ = *reinterpret_cast<const v4i32*>(VT + ((d0) * 32 + r32) * 80 + hi * 32), hi_ = *reinterpret_cast<const v4i32*>(VT + ((d0) * 32 + r32) * 80 + hi * 32 + 16); (v8i32){lo_[0], lo_[1], lo_[2], lo_[3], hi_[0], hi_[1], hi_[2], hi_[3]}; })
#define PVMMA(d0, fr) o[d0] = __builtin_amdgcn_mfma_scale_f32_32x32x64_f8f6f4(p8, fr, o[d0], 1  , 0  , 0, 0x7f7f7f7f, 0, 0x7f7f7f7f)
  v8i32 fa = VTFR(0), fb = VTFR(1);
  ASBAR();
  PVMMA(0, fa); fa = VTFR(2); ASBAR();
  PVMMA(1, fb); fb = VTFR(3); ASBAR();
  PVMMA(2, fa); fa = VTFR(4); ASBAR();
  PVMMA(3, fb); PVMMA(4, fa); ASBAR();
#undef VTFR
#undef PVMMA
}
template <bool SHIFT> __device__ __forceinline__ bool attn_unit(int b, int h, int s0, const bf16* Qraw, const unsigned char* __restrict__ VT8g, const unsigned char* __restrict__ K8g, const unsigned char* __restrict__ KP8g, bf16* __restrict__ O,
                                          const float* rope, const float* qg, float smaxC, char* lds, int wave_idx) {
  int tid; asm volatile("v_mbcnt_lo_u32_b32 %0, -1, 0\n\tv_mbcnt_hi_u32_b32 %0, -1, %0" : "=v"(tid)); tid += wave_idx * 64;
  const int wid = __builtin_amdgcn_readfirstlane(tid >> 6), lane = tid & 63, r32 = lane & 31, hi = lane >> 5;
  asm volatile("" : "+s"(qg));
  char* V_lds = lds + OFF_V; char* K8_lds = lds + OFF_K8;
  float* ws = (float*)(lds + OFF_WS) + wid * 64; float* li_l = ws;
  constexpr float C = 0.072168783648703220f * 1.4426950408889634f;
  v8i32 q8[3];
  {
    typedef __attribute__((address_space(1))) const bf16x8 gbf16x8; typedef __attribute__((address_space(1))) const f32x4_t gf32x4;
    const long trow = (long)b * SEQ + s0 + wid * QBLK + r32;
    unsigned qo = (unsigned)((trow * LDQ + h * 192) * 2); const unsigned ro = (unsigned)(trow * 256), go = (unsigned)(hi * 128);
#define Qn_(i) (*(gbf16x8*)((const char*)Qraw + qo + hi * 64 + (i) * 16))
#define Qr_(i) (*(gbf16x8*)((const char*)Qraw + qo + 256 + (i) * 16))
#define rp4_(i) (*(gf32x4*)((const char*)rope + ro + (i) * 16))
#define qgn_(i) (*(gf32x4*)((const char*)qg + go + (i) * 16))
#define qgr_(i) (*(gf32x4*)((const char*)qg + 512 + (i) * 16))
    float ssn = 0.f, ssp = 0.f;
#pragma unroll
    for (int c = 0; c < 8; ++c) { const bf16x8 a = Qn_((c >> 2) * 8 + (c & 3)), r = Qr_(c);
#pragma unroll
      for (int j = 0; j < 8; ++j) { const float f = bf2f((unsigned short)a[j]), g = bf2f((unsigned short)r[j]); ssn += f * f; ssp += g * g; } }
    ssn += __shfl_xor(ssn, 32);
    const float rn = rsqrtf(ssn * (1.f / 128.f) + 1e-6f) * C, rp = rsqrtf(ssp * (1.f / 64.f) + 1e-6f) * C;
    { float rn_ = rn, rp_ = rp; asm volatile("" : "+v"(qo), "+v"(rn_), "+v"(rp_) :: "memory"); }
#pragma unroll
    for (int m = 0; m < 2; ++m)
#pragma unroll
      for (int c = 0; c < 4; ++c) { const bf16x8 raw = Qn_(8 * m + c); const f32x4_t ga = qgn_(16 * m + 2 * c), gb = qgn_(16 * m + 2 * c + 1); float g[8];
#pragma unroll
        for (int j = 0; j < 8; ++j) g[j] = bf2f((unsigned short)raw[j]) * rn * (j < 4 ? ga[j & 3] : gb[j & 3]);
        int w0 = 0, w1 = 0; w0 = __builtin_amdgcn_cvt_pk_fp8_f32(g[0], g[1], w0, false); w0 = __builtin_amdgcn_cvt_pk_fp8_f32(g[2], g[3], w0, true);
        w1 = __builtin_amdgcn_cvt_pk_fp8_f32(g[4], g[5], w1, false); w1 = __builtin_amdgcn_cvt_pk_fp8_f32(g[6], g[7], w1, true);
        asm volatile("" : "+v"(w0), "+v"(w1) :: "memory");        q8[m][2 * c] = w0; q8[m][2 * c + 1] = w1; }
#pragma unroll
    for (int c = 0; c < 4; ++c) {
      const bf16x8 r1 = Qr_(c), r2 = Qr_(4 + c);
      const f32x4_t g1a = qgr_(2 * c), g1b = qgr_(2 * c + 1), g2a = qgr_(8 + 2 * c), g2b = qgr_(8 + 2 * c + 1); float ov[8];
#pragma unroll
      for (int j = 0; j < 8; ++j) { const f32x4_t cs4 = rp4_(4 * c + (j >> 1));
        const float cs = cs4[(j & 1) * 2], sn = cs4[(j & 1) * 2 + 1];
        const float x1 = bf2f((unsigned short)r1[j]) * rp * (j < 4 ? g1a[j & 3] : g1b[j & 3]), x2 = bf2f((unsigned short)r2[j]) * rp * (j < 4 ? g2a[j & 3] : g2b[j & 3]);
        ov[j] = hi == 0 ? (x1 * cs - x2 * sn) : (x1 * sn + x2 * cs); }
      int w0 = 0, w1 = 0; w0 = __builtin_amdgcn_cvt_pk_fp8_f32(ov[0], ov[1], w0, false); w0 = __builtin_amdgcn_cvt_pk_fp8_f32(ov[2], ov[3], w0, true);
      w1 = __builtin_amdgcn_cvt_pk_fp8_f32(ov[4], ov[5], w1, false); w1 = __builtin_amdgcn_cvt_pk_fp8_f32(ov[6], ov[7], w1, true);
      asm volatile("" : "+v"(w0), "+v"(w1) :: "memory"); q8[2][2 * c] = w0; q8[2][2 * c + 1] = w1; }
  #undef Qn_
#undef Qr_
#undef rp4_
#undef qgn_
#undef qgr_
  }
  const float negm = 15.0f - smaxC;
  float l_reg = 0.f; f32x16 o[5] = {};
  const char* Vg = (const char*)(VT8g + (size_t)h * 128 * T_TOK + (size_t)b * SEQ); const char* Kg = (const char*)(K8g + ((long)b * SEQ * 8 + h) * 128); const char* Pg = (const char*)(KP8g + (long)b * SEQ * 64);
  const int vc = tid >> 2, vq = tid & 3, vst = vc * 80 + 16 * (vq >> 1) + 8 * (vq & 1); const unsigned gvt = (unsigned)vc * (unsigned)T_TOK + 16u * (unsigned)vq;
  const int kr = tid >> 3, kc = tid & 7, kst = kr * 208 + kc * 16; const unsigned gk8 = (unsigned)(kr * 1024 + kc * 16);
  const int pr = (tid & 255) >> 2, pc = tid & 3, pst = pr * 208 + 128 + pc * 16; const unsigned gp8 = (unsigned)(pr * 64 + pc * 16);
  v4i32 s_v, s_k, s_p;
#define SLOAD(k0) do { s_v = *reinterpret_cast<const v4i32*>(Vg + (size_t)(k0) + gvt); \
    s_k = *reinterpret_cast<const v4i32*>(Kg + (size_t)(k0) * 1024 + gk8); if (tid < 256) s_p = *reinterpret_cast<const v4i32*>(Pg + (size_t)(k0) * 64 + gp8); } while (0)
#define SWRITE(kbuf, vbuf_) do { { v2i32 a_ = {s_v[0], s_v[2]}, b_ = {s_v[1], s_v[3]}; *(v2i32*)(V_lds + (vbuf_) * SHM_VT + vst) = a_; *(v2i32*)(V_lds + (vbuf_) * SHM_VT + vst + 32) = b_; } \
    *(v4i32*)(K8_lds + (kbuf) * SHM_K8 + kst) = s_k; if (tid < 256) *(v4i32*)(K8_lds + (kbuf) * SHM_K8 + pst) = s_p; } while (0)
  constexpr int NT = SEQ / KVBLK;
  v8i32 p8;
  if (tid < 480) { const int bsel = tid / 160, w16 = tid % 160; const int onev = (w16 < 5 && w16 != 4) ? 0x38383838 : 0; v4i32 cv = {onev, onev, onev, onev};
    *(v4i32*)(V_lds + bsel * SHM_VT + 128 * 80 + w16 * 16) = cv; }
  SLOAD(0); SWRITE(0, 0); __syncthreads(); SLOAD(KVBLK);
  if (wid < 4) {
    for (int j = 0, kb = 0, vbuf = 0, vnx = 1; j < NT; ++j) {
      f32x16 p0, p1;
      qkt<SHIFT>(p0, p1, K8_lds + kb * SHM_K8, q8, negm, r32, hi);
      smA<SHIFT>(p0, negm); smB<SHIFT>(p0, p1, l_reg, p8, negm); ASBAR();
      pv_d0(o, V_lds + vbuf * SHM_VT, p8, r32, hi);
      if (j + 1 < NT) SWRITE(kb ^ 1, vnx);
      __syncthreads();
      if (j + 2 < NT) SLOAD((j + 2) * KVBLK);
      kb ^= 1; vbuf = vnx; vnx = vnx == 2 ? 0 : vnx + 1;
    }
  } else {
    int vprev = 0;
    __builtin_amdgcn_s_setprio(1);
    for (int j = 0, kb = 0, vbuf = 0, vnx = 1; j < NT; ++j) {
      f32x16 p0, p1;
      if (j > 0) pv_d0(o, V_lds + vprev * SHM_VT, p8, r32, hi);
      qkt<SHIFT>(p0, p1, K8_lds + kb * SHM_K8, q8, negm, r32, hi);
      smA<SHIFT>(p0, negm); smB<SHIFT>(p0, p1, l_reg, p8, negm); ASBAR();
      if (j + 1 < NT) SWRITE(kb ^ 1, vnx);
      __syncthreads();
      if (j + 2 < NT) SLOAD((j + 2) * KVBLK);
      kb ^= 1; vprev = vbuf; vbuf = vnx; vnx = vnx == 2 ? 0 : vnx + 1;
    }
    pv_d0(o, V_lds + vprev * SHM_VT, p8, r32, hi);
    __builtin_amdgcn_s_setprio(0);
  }
  int lane_e = lane; asm volatile("" : "+v"(lane_e));
  const int r32e = lane_e & 31, hie = lane_e >> 5;
  int* satf = (int*)(lds + OFF_WS + NW * 64 * 4);
  float lmax = 0.f;
  if (r32e == 0) {
#pragma unroll
    for (int r = 0; r < 16; ++r) { li_l[crow(r, hie)] = o[4][r]; lmax = fmaxf(lmax, o[4][r]); } }
  if (!SHIFT) { const bool sat = __any(lmax >= 57344.f); if (lane_e == 0) satf[wid] = sat ? 1 : 0; }
  asm volatile("s_waitcnt lgkmcnt(0)" ::: "memory");
  float rli[16];
#pragma unroll
  for (int r = 0; r < 16; ++r) rli[r] = __builtin_amdgcn_rcpf(li_l[crow(r, hie)]);
  char* Ow = (char*)(O + ((long)b * SEQ + s0 + wid * QBLK) * LDO + h * 128);
#pragma unroll
  for (int r = 0; r < 16; ++r) { const unsigned ooff = (unsigned)(crow(r, hie) * LDO + r32e) * 2u;
#pragma unroll
    for (int d0 = 0; d0 < 4; ++d0) { const unsigned pk = cvtpk(o[d0][r] * rli[r], 0.f); *(bf16*)(Ow + ooff + d0 * 64) = (bf16)(pk & 0xffffu); } }
  __syncthreads();
  bool redo = false;
  if (!SHIFT) { redo = (satf[0] | satf[1] | satf[2] | satf[3] | satf[4] | satf[5] | satf[6] | satf[7]) != 0; __syncthreads(); }
  return redo;
#undef SLOAD
#undef SWRITE
}
}
#ifndef HD
#define HD __device__ __forceinline__
#endif
struct c32 { float x, y; };
HD c32 cmk(float x, float y) { c32 r; r.x = x; r.y = y; return r; }
HD c32 cadd(c32 a, c32 b) { return cmk(a.x + b.x, a.y + b.y); }
HD c32 csub(c32 a, c32 b) { return cmk(a.x - b.x, a.y - b.y); }
HD c32 cmul(c32 a, c32 b) { return cmk(a.x * b.x - a.y * b.y, a.x * b.y + a.y * b.x); }
HD c32 cmulc(c32 a, c32 b) { return cmk(a.x * b.x + a.y * b.y, a.y * b.x - a.x * b.y); }
constexpr int BR4(int i) { return ((i & 1) << 3) | ((i & 2) << 1) | ((i & 4) >> 1) | ((i & 8) >> 3); }
template <int SGN, int J> HD c32 tw16(c32 a) {
    if constexpr (J == 0) return a;
    else if constexpr (J == 4) return SGN < 0 ? cmk(a.y, -a.x) : cmk(-a.y, a.x);
    else {
        constexpr float CS[8] = {1.f, 0.92387953251128674f, 0.70710678118654752f, 0.38268343236508977f, 0.f, -0.38268343236508977f, -0.70710678118654752f, -0.92387953251128674f};
        constexpr float SN[8] = {0.f, 0.38268343236508977f, 0.70710678118654752f, 0.92387953251128674f, 1.f, 0.92387953251128674f, 0.70710678118654752f, 0.38268343236508977f};
        constexpr float c = CS[J], s = SN[J];
        if constexpr (SGN < 0) return cmk(a.x * c + a.y * s, a.y * c - a.x * s);
        else return cmk(a.x * c - a.y * s, a.y * c + a.x * s);
    }
}
#define FFT_BF(i, j, J) { const c32 u_ = v[i], w_ = v[j]; v[i] = cadd(u_, w_); v[j] = tw16<SGN, J>(csub(u_, w_)); }
template <int SGN> HD void dft16_dif(c32 (&v)[16]) {
    FFT_BF(0, 8, 0) FFT_BF(1, 9, 1) FFT_BF(2, 10, 2) FFT_BF(3, 11, 3) FFT_BF(4, 12, 4) FFT_BF(5, 13, 5) FFT_BF(6, 14, 6) FFT_BF(7, 15, 7)
    FFT_BF(0, 4, 0) FFT_BF(1, 5, 2) FFT_BF(2, 6, 4) FFT_BF(3, 7, 6) FFT_BF(8, 12, 0) FFT_BF(9, 13, 2) FFT_BF(10, 14, 4) FFT_BF(11, 15, 6)
    FFT_BF(0, 2, 0) FFT_BF(1, 3, 4) FFT_BF(4, 6, 0) FFT_BF(5, 7, 4) FFT_BF(8, 10, 0) FFT_BF(9, 11, 4) FFT_BF(12, 14, 0) FFT_BF(13, 15, 4)
    FFT_BF(0, 1, 0) FFT_BF(2, 3, 0) FFT_BF(4, 5, 0) FFT_BF(6, 7, 0) FFT_BF(8, 9, 0) FFT_BF(10, 11, 0) FFT_BF(12, 13, 0) FFT_BF(14, 15, 0)
}
#undef FFT_BF
#define FFT_BT(i, j, J) { const c32 u_ = v[i], w_ = tw16<SGN, J>(v[j]); v[i] = cadd(u_, w_); v[j] = csub(u_, w_); }
template <int SGN> HD void dft16_dit(c32 (&v)[16]) {
    FFT_BT(0, 1, 0) FFT_BT(2, 3, 0) FFT_BT(4, 5, 0) FFT_BT(6, 7, 0) FFT_BT(8, 9, 0) FFT_BT(10, 11, 0) FFT_BT(12, 13, 0) FFT_BT(14, 15, 0)
    FFT_BT(0, 2, 0) FFT_BT(1, 3, 4) FFT_BT(4, 6, 0) FFT_BT(5, 7, 4) FFT_BT(8, 10, 0) FFT_BT(9, 11, 4) FFT_BT(12, 14, 0) FFT_BT(13, 15, 4)
    FFT_BT(0, 4, 0) FFT_BT(1, 5, 2) FFT_BT(2, 6, 4) FFT_BT(3, 7, 6) FFT_BT(8, 12, 0) FFT_BT(9, 13, 2) FFT_BT(10, 14, 4) FFT_BT(11, 15, 6)
    FFT_BT(0, 8, 0) FFT_BT(1, 9, 1) FFT_BT(2, 10, 2) FFT_BT(3, 11, 3) FFT_BT(4, 12, 4) FFT_BT(5, 13, 5) FFT_BT(6, 14, 6) FFT_BT(7, 15, 7)
}
#undef FFT_BT
constexpr int FFT_PS = 272;
constexpr int FFT_EX_ELEMS = 16 * FFT_PS;
template <class EX> HD void fft_fwd_a(c32 (&v)[16], const c32* T1, EX ex, int tid) {
    dft16_dif<-1>(v);
#pragma unroll
    for (int p = 0; p < 16; ++p) { ex[p * FFT_PS + tid] = cmul(v[BR4(p)], T1[256 * p]); if ((p & 3) == 3) __builtin_amdgcn_sched_barrier(0); }
}
template <class EX> HD void fft_fwd_b(c32 (&v)[16], const c32* T2, EX exr, EX ex, int tid) {
    const int p2 = tid >> 4, c = tid & 15;
#pragma unroll
    for (int b = 0; b < 16; ++b) v[b] = exr[p2 * FFT_PS + 16 * b + c];
    dft16_dif<-1>(v);
#pragma unroll
    for (int q = 0; q < 16; ++q) ex[p2 * FFT_PS + q * 16 + ((c + q) & 15)] = cmul(v[BR4(q)], T2[q]);
}
template <class EX> HD void fft_fwd_c(c32 (&v)[16], EX ex, int tid) {
    const int p2 = tid >> 4, q = tid & 15;
#pragma unroll
    for (int c = 0; c < 16; ++c) v[c] = ex[p2 * FFT_PS + q * 16 + ((c + q) & 15)];
    dft16_dif<-1>(v);
}
template <class EX> HD void fft_inv_a(c32 (&v)[16], EX ex, int tid) {
    const int p = tid >> 4, q = tid & 15;
    dft16_dit<+1>(v);
#pragma unroll
    for (int c = 0; c < 16; ++c) ex[p * FFT_PS + q * 16 + ((c + q) & 15)] = v[c];
}
template <class EX> HD void fft_inv_b(c32 (&v)[16], const c32* T2, EX exr, EX ex, int tid) {
    const int p = tid >> 4, c = tid & 15;
#pragma unroll
    for (int q = 0; q < 16; ++q) v[BR4(q)] = cmulc(exr[p * FFT_PS + q * 16 + ((c + q) & 15)], T2[q]);
    dft16_dit<+1>(v);
#pragma unroll
    for (int b = 0; b < 16; ++b) ex[p * FFT_PS + 16 * b + c] = v[b];
}
template <class EX> HD void fft_inv_c(c32 (&v)[16], const c32* T1, EX ex, int tid) {
#pragma unroll
    for (int p = 0; p < 16; ++p) { v[BR4(p)] = cmulc(ex[p * FFT_PS + tid], T1[256 * p]); if ((p & 3) == 3) __builtin_amdgcn_sched_barrier(0); }
    dft16_dit<+1>(v);
}
constexpr int NWAVES = 8, NTHR = 512;
constexpr int BATCH = 8, SEQ = 4096, DM = 1024, T = BATCH * SEQ;
constexpr float EPS = 1e-6f;
constexpr size_t MiB = 1u << 20;
constexpr size_t WS_CTL = 0, CTL_ZERO_BYTES = 64 * 1024;
constexpr size_t WS_MOD = 1 * MiB;
constexpr size_t WS_HDNS = 1 * MiB + 512 * 1024;
constexpr size_t WS_W4S = 3 * MiB + 512 * 1024;
constexpr size_t WS_LIST = 101 * MiB;
constexpr size_t WS_WL = 396 * MiB;
constexpr size_t WS_WD = 8 * MiB;
constexpr size_t WS_WUQ = 9 * MiB;
constexpr size_t WS_WUKV = 10 * MiB;
constexpr size_t WS_WO = 11 * MiB;
constexpr size_t WS_WIN = 13 * MiB;
constexpr size_t WS_WOUT = 19 * MiB;
constexpr size_t WS_WGU = 21 * MiB;
constexpr size_t WS_WDN = 53 * MiB;
constexpr size_t R1 = 104 * MiB;
constexpr size_t R2 = 232 * MiB;
constexpr size_t R3 = 424 * MiB;
constexpr size_t WS_VT8 = R1, WS_XN2 = R1, WS_KF = R1;
constexpr size_t WS_XN = R2, WS_O = R2;
constexpr size_t WS_LAT = R2 + 64 * MiB;
constexpr size_t WS_HACT = R2 + 64 * MiB;
constexpr size_t WS_CQN = R2 + 128 * MiB;
constexpr size_t WS_CKVN = R2 + 144 * MiB;
constexpr size_t WS_KPE = R2 + 160 * MiB;
constexpr size_t WS_K8 = R2 + 64 * MiB;
constexpr size_t WS_ROPE = R2 + 164 * MiB;
constexpr size_t WS_QRAW = 408 * MiB;
constexpr size_t WS_XN2S = 424 * MiB;
constexpr size_t WS_XR = 424 * MiB;
constexpr size_t WS_HT = R2;
constexpr size_t WS_UT = R2;
constexpr size_t WS_Z = R2;
constexpr size_t WS_END = 512 * MiB;
constexpr int MS_ROWS = T + 24 * 256;
constexpr int CW_BAR = 4096;
constexpr int CW_CNT = 8192;
constexpr int RING_OFF = 0, RING_BYTES = 147456;
constexpr int LDSCTL_OFF = RING_BYTES;
constexpr int MISC_OFF = LDSCTL_OFF;
constexpr int TINFO_OFF = LDSCTL_OFF + 256;
constexpr int RED_OFF = LDSCTL_OFF + 256 + 1280;
constexpr int EPIX_OFF = LDSCTL_OFF + 2048;
constexpr int LDS_BYTES = 163840;
static_assert(RED_OFF + 256 <= LDS_BYTES, "LDS map");

#define GAS __attribute__((address_space(1)))
#define LAS __attribute__((address_space(3)))
typedef unsigned short bf16;
typedef unsigned v4u __attribute__((ext_vector_type(4)));
typedef unsigned v2u __attribute__((ext_vector_type(2)));
typedef int v4i __attribute__((ext_vector_type(4)));
typedef float f32x4 __attribute__((ext_vector_type(4)));
typedef GAS unsigned gu32;
#define RLX_AGENT __ATOMIC_RELAXED, __HIP_MEMORY_SCOPE_AGENT
#define LDS_WAIT() asm volatile("s_waitcnt lgkmcnt(0)" ::: "memory")
__device__ __forceinline__ unsigned pk2(float lo, float hi) { return pg8::cvt_pk_bf16(lo, hi); }
__device__ __forceinline__ float bf2f(unsigned short b) { return __uint_as_float(((unsigned)b) << 16); }
__device__ __forceinline__ float wave_sum(float v) {
#pragma unroll
    for (int o = 1; o < 64; o <<= 1) v += __shfl_xor(v, o);
    return v;
}

#define XB_TMO      128
#define XB_XCNT(j)  (256  + 64 * (j))
#define XB_XSUB(j)  (1280 + 64 * (j))
#define XB_XGEN(j)  (2304 + 64 * (j))
#define XB_TOP      3328
#define XB_TOPGEN   3392
#define XCD_BAR_WORDS 3456
#define XB_SPIN_CAP (1u << 18)

__device__ __forceinline__ unsigned xb_ld(unsigned* p)              { return __hip_atomic_load(p, __ATOMIC_RELAXED, __HIP_MEMORY_SCOPE_AGENT); }
__device__ __forceinline__ unsigned xb_add(unsigned* p, unsigned v) { return __hip_atomic_fetch_add(p, v, __ATOMIC_RELAXED, __HIP_MEMORY_SCOPE_AGENT); }
__device__ __forceinline__ unsigned xb_xcc_id() { return (unsigned)__builtin_amdgcn_s_getreg((3 << 11) | 20) & 0xFu; }
#define XB_SPIN(cond, bar) do { unsigned _sp = 0; while (cond) { __builtin_amdgcn_s_sleep(1); \
    if ((++_sp & 255u) == 0u) { if (xb_ld(&(bar)[XB_TMO])) break; if (_sp > XB_SPIN_CAP) { atomicAdd(&(bar)[XB_TMO], 1u); break; } } } } while (0)

struct XcdBarrier {
    unsigned* bar; unsigned x;
    volatile LAS unsigned* st;
    int w0;
};

__device__ __forceinline__ XcdBarrier xcd_barrier_post(unsigned* bar, volatile LAS unsigned* st) {
    XcdBarrier b; b.bar = bar; b.x = xb_xcc_id(); b.st = st; b.w0 = 0;
    if (threadIdx.x == 0) (void)xb_add(&bar[XB_XCNT(b.x)], 1u);
    return b;
}
__device__ __forceinline__ void xcd_barrier_complete(unsigned* bar, unsigned x, unsigned& nloc, unsigned& nx) {
    const unsigned G = gridDim.x * gridDim.y * gridDim.z;
    unsigned sum, cnt, mine, sp = 0u;
    for (;;) {
        sum = 0u; cnt = 0u; mine = 0u;
#pragma unroll
        for (unsigned j = 0; j < 16; ++j) { const unsigned c = xb_ld(&bar[XB_XCNT(j)]); sum += c; cnt += (c > 0u) ? 1u : 0u; mine = (j == x) ? c : mine; }
        if (sum == G) break;
        __builtin_amdgcn_s_sleep(1);
        if ((++sp & 255u) == 0u) { if (xb_ld(&bar[XB_TMO])) break; if (sp > XB_SPIN_CAP) { atomicAdd(&bar[XB_TMO], 1u); break; } }
    }
    nloc = mine > 0u ? mine : 1u; nx = cnt > 0u ? cnt : 1u;
}

__device__ __forceinline__ void xcd_barrier(const XcdBarrier& b) {
    asm volatile("s_waitcnt vmcnt(0)" ::: "memory");
    __syncthreads();
    if (b.w0 && __builtin_amdgcn_mbcnt_hi(~0u, __builtin_amdgcn_mbcnt_lo(~0u, 0u)) == 0u) {
        unsigned* bar = b.bar;
        __builtin_amdgcn_s_waitcnt(0);
        unsigned nloc = b.st[0], nx = b.st[1];
        if (nloc == 0u) { xcd_barrier_complete(bar, b.x, nloc, nx); b.st[0] = nloc; b.st[1] = nx; }
        const unsigned old = xb_add(&bar[XB_XSUB(b.x)], 1u);
        const unsigned gen = old / nloc;
        if (old + 1u == (gen + 1u) * nloc) {
            __builtin_amdgcn_fence(__ATOMIC_RELEASE, "agent");
            asm volatile("s_waitcnt vmcnt(0)" ::: "memory");
            const unsigned og = xb_add(&bar[XB_TOP], 1u);
            const unsigned tg = og / nx;
            if (og + 1u == (tg + 1u) * nx) xb_add(&bar[XB_TOPGEN], 1u);
            else XB_SPIN(xb_ld(&bar[XB_TOPGEN]) == tg, bar);
            __builtin_amdgcn_fence(__ATOMIC_ACQUIRE, "agent");
            xb_add(&bar[XB_XGEN(b.x)], 1u);
            asm volatile("s_waitcnt vmcnt(0)" ::: "memory");
        } else {
            XB_SPIN(xb_ld(&bar[XB_XGEN(b.x)]) == gen, bar);
            __builtin_amdgcn_fence(__ATOMIC_ACQUIRE, "agent");
            asm volatile("s_waitcnt vmcnt(0)" ::: "memory");
        }
    }
    __syncthreads();
}


struct Ctx { unsigned char* lds; int tid, lane, wave, vcu, G, gw, NGW; };

__device__ __forceinline__ void transpose_item(const float* W, int ldw, int k0, int n0, bf16* WT, int ldt, int drow0, int dcol0, float* scr, int lane, bool kpe_perm) {
    float tv[32];
#pragma unroll
    for (int i = 0; i < 32; ++i) { const int kk = 2 * i + (lane >> 5); tv[i] = W[(size_t)(k0 + kk) * ldw + n0 + (lane & 31)]; }
#pragma unroll
    for (int i = 0; i < 32; ++i) { const int kk = 2 * i + (lane >> 5); scr[kk * 33 + (lane & 31)] = tv[i]; }
    LDS_WAIT();
    const int c = lane & 7;
#pragma unroll
    for (int j = 0; j < 4; ++j) { const int n = (lane >> 3) + 8 * j; const float* s = scr + (8 * c) * 33 + n;
        v4u o; o.x = pk2(s[0 * 33], s[1 * 33]); o.y = pk2(s[2 * 33], s[3 * 33]); o.z = pk2(s[4 * 33], s[5 * 33]); o.w = pk2(s[6 * 33], s[7 * 33]);
        int dr = drow0 + n; if (kpe_perm && dr >= 384 && dr < 448) { const int e = dr - 384; dr = 384 + 32 * ((e >> 4) & 1) + 16 * (e >> 5) + (e & 15); }
        *(v4u*)(WT + (size_t)dr * ldt + dcol0 + k0 + 8 * c) = o; }
    LDS_WAIT();
}
typedef __attribute__((address_space(4))) const char kchar;
struct In { int opq;
    __device__ __forceinline__ const float* operator[](int k) const { kchar* ka = (kchar*)__builtin_amdgcn_kernarg_segment_ptr(); return *(const float* const __attribute__((address_space(4)))*)(ka + 8 * k + opq); } };
__device__ __forceinline__ unsigned char* karg_ws(int opq) { kchar* ka = (kchar*)__builtin_amdgcn_kernarg_segment_ptr(); return *(unsigned char* const __attribute__((address_space(4)))*)(ka + 38 * 8 + 8 + opq); }
__device__ __forceinline__ float* karg_out(int opq) { kchar* ka = (kchar*)__builtin_amdgcn_kernarg_segment_ptr(); return *(float* const __attribute__((address_space(4)))*)(ka + 38 * 8 + opq); }

__device__ __forceinline__ void p0_prologue(const Ctx& F, const In& in, unsigned char* ws) {
    float* scr = (float*)(F.lds + RING_OFF + F.wave * 16384);
    bf16* Wd = (bf16*)(ws + WS_WD); bf16* Wuq = (bf16*)(ws + WS_WUQ); bf16* Wukv = (bf16*)(ws + WS_WUKV); bf16* Wo = (bf16*)(ws + WS_WO);
    bf16* Win = (bf16*)(ws + WS_WIN); bf16* Wout = (bf16*)(ws + WS_WOUT); bf16* Wgu = (bf16*)(ws + WS_WGU); bf16* Wdn = (bf16*)(ws + WS_WDN);
    constexpr int I_D = 16 * 14, I_UQ = 4 * 48, I_UKV = 2 * 64, I_O = 16 * 32, I_IN = 16 * 96, I_OUT = 16 * 32, I_GU = 2 * 16 * 2 * (16 * 8), I_DN = 2 * 24 * 2 * (4 * 32);
    constexpr int NITEMS = I_D + I_UQ + I_UKV + I_O + I_IN + I_OUT + I_GU + I_DN;
    for (int it = F.gw; it < NITEMS; it += F.NGW) {
        int r = it; const float* W; int ldw, k0, n0, ldt, drow0, dcol0 = 0; bf16* WT;
        if (r < I_D) { W = in[7]; ldw = 448; k0 = (r / 14) * 64; n0 = (r % 14) * 32; WT = Wd; ldt = 1024; drow0 = n0; }
        else if ((r -= I_D) < I_UQ) { W = in[10]; ldw = 1536; k0 = (r / 48) * 64; n0 = (r % 48) * 32; WT = Wuq; ldt = 256; drow0 = n0; }
        else if ((r -= I_UQ) < I_UKV) { W = in[11]; ldw = 2048; k0 = (r / 64) * 64; n0 = (r % 64) * 32; ldt = 128;
            WT = Wukv + ((n0 & 128) ? 1024 * 128 : 0); drow0 = (n0 >> 8) * 128 + (n0 & 127); }
        else if ((r -= I_UKV) < I_O) { W = in[14]; ldw = 1024; k0 = (r / 32) * 64; n0 = (r % 32) * 32; WT = Wo; ldt = 1024; drow0 = n0; }
        else if ((r -= I_O) < I_IN) { W = in[15]; ldw = 3072; k0 = (r / 96) * 64; n0 = (r % 96) * 32; WT = Win; ldt = 1024; drow0 = n0; }
        else if ((r -= I_IN) < I_OUT) { W = in[30]; ldw = 1024; k0 = (r / 32) * 64; n0 = (r % 32) * 32; WT = Wout; ldt = 1024; drow0 = n0; }
        else if ((r -= I_OUT) < I_GU) {
            const int sub = r % 128, mat = r / 128, which = mat & 1, le = mat >> 1;
            W = (which ? in[36] : in[35]) + (size_t)le * 1024 * 256; ldw = 256; k0 = (sub / 8) * 64; n0 = (sub % 8) * 32;
            WT = Wgu + (size_t)le * 512 * 1024; ldt = 1024; drow0 = (n0 >> 7) * 256 + which * 128 + (n0 & 127); }
        else { r -= I_GU;
            const int sub = r % 128, mat = r / 128, slot = mat & 1, lb = mat >> 1, layer = lb / 24, bk = lb % 24;
            int ii, jj; pg8::pair_of(bk % 6, ii, jj); const int e = (bk / 6) * 4 + (slot ? jj : ii);
            W = in[37] + (size_t)(layer * 16 + e) * 256 * 1024; ldw = 1024; k0 = (sub / 32) * 64; n0 = (sub % 32) * 32;
            WT = Wdn + (size_t)lb * 1024 * 512; ldt = 512; drow0 = n0; dcol0 = slot * 256; }
        transpose_item(W, ldw, k0, n0, WT, ldt, drow0, dcol0, scr, F.lane, it < I_D);
    }
    { const int gt = F.vcu * NTHR + F.tid, NGT = F.G * NTHR; const v4u z = {0u, 0u, 0u, 0u};
      for (int i = gt; i < 64 * 1024 / 8; i += NGT) *(v4u*)(Wd + (size_t)448 * 1024 + (size_t)i * 8) = z;
    }
    { const int gt = F.vcu * NTHR + F.tid, NGT = F.G * NTHR; float* RT = (float*)(ws + WS_ROPE); const int* posi = (const int*)in[2];
      for (int i = gt; i < T * 32; i += NGT) { const int t = i >> 5, e = i & 31; const float inv = 1.0f / powf(10000.f, (float)(2 * e) * (1.f / 64.f));
        float sn, cs; sincosf((float)posi[t] * inv, &sn, &cs); RT[(size_t)i * 2] = cs; RT[(size_t)i * 2 + 1] = sn; } }
    { const int gt = F.vcu * NTHR + F.tid, NGT = F.G * NTHR; bf16* W4S = (bf16*)(ws + WS_W4S); const float* w4 = in[28];
      for (int i = gt; i < 4096 * 64; i += NGT) { const int k = i >> 12, col = i & 4095; const float w = w4[(size_t)k * 4096 + col];
        const unsigned hi = pk2(w, 0.f) & 0xffffu; const float lo = w - bf2f((unsigned short)hi); const unsigned lob = pk2(lo, 0.f) & 0xffffu;
        bf16* d = W4S + (size_t)col * 256 + k; d[0] = (bf16)hi; d[64] = (bf16)hi; d[128] = (bf16)lob; d[192] = 0; } }
    { bf16* HDp = (bf16*)(ws + WS_HDNS); float* sv = scr;
      const int j = F.lane;
      for (int t = F.gw; t < 4096; t += F.NGW) {
        float zf = 0.f;
        { const float w = 6.2831855f * (float)t * (1.f / 4096.f);
          if (j == 0) zf = (float)t / 4095.f;
          else if (j <= 16) { const float fr = 1e-4f + (float)(j - 1) * ((15.f - 1e-4f) / 15.f); zf = cosf(fr * w); }
          else if (j <= 32) { const float fr = 1e-4f + (float)(j - 17) * ((15.f - 1e-4f) / 15.f); zf = -sinf(fr * w); } }
        sv[j] = zf; LDS_WAIT();
        float a = in[20][j];
#pragma unroll 3
        for (int k = 0; k < 33; ++k) a += sv[k] * in[19][k * 64 + j];
        float h = sinf(in[21][j] * a); LDS_WAIT(); sv[j] = h; LDS_WAIT();
        a = in[23][j];
#pragma unroll 4
        for (int k = 0; k < 64; ++k) a += sv[k] * in[22][k * 64 + j];
        h = sinf(in[24][j] * a); LDS_WAIT(); sv[j] = h; LDS_WAIT();
        a = in[26][j];
#pragma unroll 4
        for (int k = 0; k < 64; ++k) a += sv[k] * in[25][k * 64 + j];
        h = sinf(in[27][j] * a); LDS_WAIT();
        const unsigned hi = pk2(h, 0.f) & 0xffffu; const float lo = h - bf2f((unsigned short)hi); const unsigned lob = pk2(lo, 0.f) & 0xffffu;
        bf16* d = HDp + (size_t)t * 256 + j; d[0] = (bf16)hi; d[64] = (bf16)lob; d[128] = (bf16)hi; d[192] = 0;
      } }
    __syncthreads();
    { float* cact = (float*)(F.lds + RING_OFF); float* red = cact + 8 * 1024;
      float* MOD = (float*)(ws + WS_MOD);
      for (int i = F.tid; i < 8 * 1024; i += NTHR) { const float x = in[1][i]; cact[i] = x / (1.f + __expf(-x)); }
      __syncthreads();
      for (int it = F.vcu; it < 2 * 96; it += F.G) {
        const int layer = it / 96, cb = it % 96, col = F.tid & 63, kg = F.tid >> 6;
        const float* W = in[3] + (size_t)layer * 1024 * 6144 + cb * 64 + col;
        float acc[8] = {0.f, 0.f, 0.f, 0.f, 0.f, 0.f, 0.f, 0.f};
#pragma unroll 16
        for (int k = kg * 128; k < kg * 128 + 128; ++k) { const float w = W[(size_t)k * 6144];
#pragma unroll
          for (int b = 0; b < 8; ++b) acc[b] += cact[b * 1024 + k] * w; }
#pragma unroll
        for (int b = 0; b < 8; ++b) red[(kg * 8 + b) * 64 + col] = acc[b];
        __syncthreads();
        { const int b = F.tid >> 6; float s = in[4][layer * 6144 + cb * 64 + col];
#pragma unroll
          for (int g = 0; g < 8; ++g) s += red[(g * 8 + b) * 64 + col];
          MOD[((size_t)layer * 8 + b) * 6144 + cb * 64 + col] = s; }
        __syncthreads();
      } }
}

template <class TX> __device__ __forceinline__ f32x4 ldrow4(const TX* p);
template <> __device__ __forceinline__ f32x4 ldrow4<float>(const float* p) { return *(const __attribute__((address_space(1))) f32x4*)p; }
template <> __device__ __forceinline__ f32x4 ldrow4<bf16>(const bf16* p) { const v2u w = *(const __attribute__((address_space(1))) v2u*)p; f32x4 r; r[0] = __uint_as_float(w.x << 16); r[1] = __uint_as_float(w.x & 0xffff0000u); r[2] = __uint_as_float(w.y << 16); r[3] = __uint_as_float(w.y & 0xffff0000u); return r; }
template <class TX> __device__ __forceinline__ void norm_mod_phase(const Ctx& F, const TX* X, const float* g, const float* sc, const float* sh, bf16* OUT) {
    for (int ch = F.gw; ch < T / 16; ch += F.NGW) {
        const int r0 = ch * 16, b = r0 >> 12;
        f32x4 A[4], S[4];
#pragma unroll
        for (int j = 0; j < 4; ++j) { const int col = 4 * F.lane + 256 * j; const f32x4 gv = *(const f32x4*)(g + col), sv = *(const f32x4*)(sc + (size_t)b * 6144 + col); A[j] = gv * (1.f + sv); S[j] = *(const f32x4*)(sh + (size_t)b * 6144 + col); }
        const TX* xr = X + (size_t)r0 * DM + 4 * F.lane;
        f32x4 nx[4];
#pragma unroll
        for (int j = 0; j < 4; ++j) nx[j] = ldrow4<TX>(xr + 256 * j);
        for (int rr = 0; rr < 16; ++rr) {
            f32x4 v[4]; float ss = 0.f;
#pragma unroll
            for (int j = 0; j < 4; ++j) { v[j] = nx[j]; ss += (v[j].x * v[j].x + v[j].y * v[j].y) + (v[j].z * v[j].z + v[j].w * v[j].w); }
            if (rr < 15) {
#pragma unroll
                for (int j = 0; j < 4; ++j) nx[j] = ldrow4<TX>(xr + (size_t)(rr + 1) * DM + 256 * j); }
            const float rstd = rsqrtf(wave_sum(ss) * (1.f / DM) + EPS);
            bf16* orow = OUT + (size_t)(r0 + rr) * DM + 4 * F.lane;
#pragma unroll
            for (int j = 0; j < 4; ++j) { const f32x4 o = v[j] * rstd * A[j] + S[j]; v2u w; w.x = pk2(o.x, o.y); w.y = pk2(o.z, o.w); *(v2u*)(orow + 256 * j) = w; } }
    }
}

__device__ __forceinline__ void lat_post_phase(const Ctx& F, const float* LAT, const float* qag, const float* kvag, const float* kng, const float* rope, bf16* CQN, bf16* CKVN, bf16* KPE) {
    const int l = F.lane;
    const f32x4 gq = *(const f32x4*)(qag + 4 * l);
    const f32x4 g2 = l < 32 ? *(const f32x4*)(kvag + 4 * l) : (l < 48 ? *(const f32x4*)(kng + 128 + 4 * (l - 32)) : (f32x4){0.f, 0.f, 0.f, 0.f});
    f32x4 na = *(const f32x4*)(LAT + (size_t)F.gw * 512 + 4 * l), nc = l < 48 ? *(const f32x4*)(LAT + (size_t)F.gw * 512 + 256 + 4 * l) : (f32x4){0.f, 0.f, 0.f, 0.f};
    for (int row = F.gw; row < T; row += F.NGW) {
        const f32x4 a = na, c = nc;
        if (row + F.NGW < T) { const float* nr = LAT + (size_t)(row + F.NGW) * 512; na = *(const f32x4*)(nr + 4 * l); if (l < 48) nc = *(const f32x4*)(nr + 256 + 4 * l); }
        const float sq = (a.x * a.x + a.y * a.y) + (a.z * a.z + a.w * a.w), sc = (c.x * c.x + c.y * c.y) + (c.z * c.z + c.w * c.w);
        const float s_q = wave_sum(sq), s_kv = wave_sum(l < 32 ? sc : 0.f), s_pe = wave_sum((l >= 32 && l < 48) ? sc : 0.f);
        const float rq = rsqrtf(s_q * (1.f / 256.f) + EPS), rkv = rsqrtf(s_kv * (1.f / 128.f) + EPS), rpe = rsqrtf(s_pe * (1.f / 64.f) + EPS);
        { const f32x4 o = a * rq * gq; v2u w; w.x = pk2(o.x, o.y); w.y = pk2(o.z, o.w); *(v2u*)(CQN + (size_t)row * 256 + 4 * l) = w; }
        if (l < 32) { const f32x4 o = c * rkv * g2; v2u w; w.x = pk2(o.x, o.y); w.y = pk2(o.z, o.w); *(v2u*)(CKVN + (size_t)row * 256 + 4 * l) = w; }
        else { v2u w; w.x = 0u; w.y = 0u; *(v2u*)(CKVN + (size_t)row * 256 + 128 + 4 * (l - 32)) = w; }
        const f32x4 n = c * rpe * g2;
        f32x4 other; other.x = __shfl_xor(n.x, 8); other.y = __shfl_xor(n.y, 8); other.z = __shfl_xor(n.z, 8); other.w = __shfl_xor(n.w, 8);
        if (l >= 32 && l < 48) { const bool first = l < 40; const int e0 = 4 * ((l - 32) & 7);
            float o[4];
#pragma unroll
            for (int i = 0; i < 4; ++i) { const int e = e0 + i; const float cs = rope[(size_t)row * 64 + e * 2], sn = rope[(size_t)row * 64 + e * 2 + 1];
                const float mine = n[i], oth = other[i]; o[i] = first ? (mine * cs - oth * sn) : (oth * sn + mine * cs); }
            v2u w; w.x = pk2(o[0], o[1]); w.y = pk2(o[2], o[3]); *(v2u*)(KPE + (size_t)row * 64 + 4 * (l - 32)) = w; }
    }
}

__device__ __forceinline__ void knorm_phase(const Ctx& F, bf16* KV, const float* kng) {
    const int l = F.lane, h = l >> 3, e0 = (l & 7) * 16;
    float g[16];
#pragma unroll
    for (int i = 0; i < 16; ++i) g[i] = kng[e0 + i];
    for (int row = F.gw; row < T; row += F.NGW) {
        bf16* p = KV + (size_t)row * 2048 + h * 256 + e0;
        const v4u r0 = *(const v4u*)p, r1 = *(const v4u*)(p + 8);
        float f[16]; const unsigned w[8] = {r0.x, r0.y, r0.z, r0.w, r1.x, r1.y, r1.z, r1.w};
        float ss = 0.f;
#pragma unroll
        for (int i = 0; i < 8; ++i) { f[2 * i] = __uint_as_float(w[i] << 16); f[2 * i + 1] = __uint_as_float(w[i] & 0xffff0000u); ss += f[2 * i] * f[2 * i] + f[2 * i + 1] * f[2 * i + 1]; }
        ss += __shfl_xor(ss, 1); ss += __shfl_xor(ss, 2); ss += __shfl_xor(ss, 4);
        const float r = rsqrtf(ss * (1.f / 128.f) + EPS);
        v4u o0, o1;
        o0.x = pk2(f[0] * r * g[0], f[1] * r * g[1]); o0.y = pk2(f[2] * r * g[2], f[3] * r * g[3]); o0.z = pk2(f[4] * r * g[4], f[5] * r * g[5]); o0.w = pk2(f[6] * r * g[6], f[7] * r * g[7]);
        o1.x = pk2(f[8] * r * g[8], f[9] * r * g[9]); o1.y = pk2(f[10] * r * g[10], f[11] * r * g[11]); o1.z = pk2(f[12] * r * g[12], f[13] * r * g[13]); o1.w = pk2(f[14] * r * g[14], f[15] * r * g[15]);
        *(v4u*)p = o0; *(v4u*)(p + 8) = o1;
    }
}

__device__ __forceinline__ void route_phase(const Ctx& F, const bf16* X, const float* g, const float* sc, const float* sh, const float* wg, const float* bg, const float* we, const float* be,
                                            bf16* XN2, int* LIST, float* WL, gu32* cnt) {
    float* W20 = (float*)(F.lds + RING_OFF);
    for (int i = F.tid; i < 20 * 1024; i += NTHR) { const int o = i >> 10, col = i & 1023; W20[i] = o < 4 ? wg[col * 4 + o] : we[col * 16 + (o - 4)]; }
    __syncthreads();
    float bgv[4];
#pragma unroll
    for (int i = 0; i < 4; ++i) bgv[i] = bg[i];
    for (int ch = F.gw; ch < T / 16; ch += F.NGW) {
        const int r0 = ch * 16, b = r0 >> 12;
        f32x4 A[4], S[4];
#pragma unroll
        for (int j = 0; j < 4; ++j) { const int col = 4 * F.lane + 256 * j; const f32x4 gv = *(const f32x4*)(g + col), sv = *(const f32x4*)(sc + (size_t)b * 6144 + col); A[j] = gv * (1.f + sv); S[j] = *(const f32x4*)(sh + (size_t)b * 6144 + col); }
        const bf16* xr = X + (size_t)r0 * DM + 4 * F.lane;
        f32x4 nx[4];
#pragma unroll
        for (int j = 0; j < 4; ++j) nx[j] = ldrow4<bf16>(xr + 256 * j);
        for (int rr = 0; rr < 16; ++rr) { const int row = r0 + rr;
            f32x4 v[4]; float ss = 0.f;
#pragma unroll
            for (int j = 0; j < 4; ++j) { v[j] = nx[j]; ss += (v[j].x * v[j].x + v[j].y * v[j].y) + (v[j].z * v[j].z + v[j].w * v[j].w); }
            if (rr < 15) {
#pragma unroll
                for (int j = 0; j < 4; ++j) nx[j] = ldrow4<bf16>(xr + (size_t)(rr + 1) * DM + 256 * j); }
            const float rstd = rsqrtf(wave_sum(ss) * (1.f / DM) + EPS);
            bf16* orow = XN2 + (size_t)row * DM + 4 * F.lane;
#pragma unroll
            for (int j = 0; j < 4; ++j) { v[j] = v[j] * rstd * A[j] + S[j]; v2u w; w.x = pk2(v[j].x, v[j].y); w.y = pk2(v[j].z, v[j].w); *(v2u*)(orow + 256 * j) = w; }
            float gl[4];
#pragma unroll
            for (int o = 0; o < 4; ++o) { float a = 0.f;
#pragma unroll
                for (int j = 0; j < 4; ++j) { const f32x4 w = *(const f32x4*)(W20 + o * 1024 + 4 * F.lane + 256 * j); a += (v[j].x * w.x + v[j].y * w.y) + (v[j].z * w.z + v[j].w * w.w); }
                gl[o] = wave_sum(a) + bgv[o]; }
            int gi = 0; float gm = gl[0]; if (gl[1] > gm) { gm = gl[1]; gi = 1; } if (gl[2] > gm) { gm = gl[2]; gi = 2; } if (gl[3] > gm) { gm = gl[3]; gi = 3; }
            gi = __builtin_amdgcn_readfirstlane(gi);
            const float gw_ = 1.f / (__expf(gl[0] - gm) + __expf(gl[1] - gm) + __expf(gl[2] - gm) + __expf(gl[3] - gm));
            const float* We = W20 + (4 + 4 * gi) * 1024 + 4 * F.lane;
            float e[4];
#pragma unroll
            for (int k = 0; k < 4; ++k) { float a = 0.f;
#pragma unroll
                for (int j = 0; j < 4; ++j) { const f32x4 w = *(const f32x4*)(We + k * 1024 + 256 * j); a += (v[j].x * w.x + v[j].y * w.y) + (v[j].z * w.z + v[j].w * w.w); }
                e[k] = wave_sum(a) + be[4 * gi + k]; }
            int i1 = 0; float m1 = e[0];
#pragma unroll
            for (int k = 1; k < 4; ++k) if (e[k] > m1) { m1 = e[k]; i1 = k; }
            int i2 = -1; float m2 = -3.0e38f;
#pragma unroll
            for (int k = 0; k < 4; ++k) if (k != i1 && e[k] > m2) { m2 = e[k]; i2 = k; }
            const float t2 = __expf(m2 - m1), w1 = gw_ / (1.f + t2), w2 = gw_ * t2 / (1.f + t2);
            const int ilo = i1 < i2 ? i1 : i2, ihi = i1 < i2 ? i2 : i1; const float wlo = i1 < i2 ? w1 : w2, whi = i1 < i2 ? w2 : w1;
            const int pi = ilo == 0 ? ihi - 1 : (ilo == 1 ? ihi + 1 : 5), bk = gi * 6 + pi;
            if (F.lane == 0) { const unsigned pos = __hip_atomic_fetch_add(cnt + bk * 64, 1u, RLX_AGENT);
                LIST[bk * 32768 + pos] = row; float2 ww; ww.x = wlo; ww.y = whi; *(float2*)(WL + ((size_t)bk * 32768 + pos) * 2) = ww; }
        }
    }
}
__device__ __forceinline__ void moe_table(const Ctx& F, const gu32* cnt) {
    int* tinfo = (int*)(F.lds + TINFO_OFF);
    __syncthreads();
    if (F.tid == 0) { int nt = 0;
        for (int b = 0; b < 24; ++b) { const int c = (int)__hip_atomic_load(cnt + b * 64, RLX_AGENT); const int tiles = (c + 255) >> 8;
            tinfo[256 + b] = nt * 256; tinfo[288 + b] = c; for (int i = 0; i < tiles; ++i) tinfo[1 + nt + i] = b; nt += tiles; }
        tinfo[0] = nt; }
    __syncthreads();
}
__device__ __forceinline__ void permute_phase(const Ctx& F, const bf16* XN2, const int* ROUTE, bf16* XN2S, int* TOKW) {
    const int* tinfo = (const int*)(F.lds + TINFO_OFF);
    for (int ch = F.gw; ch < T / 4; ch += F.NGW) {
        v4i r[4]; v4u a[4], bq[4];
#pragma unroll
        for (int i = 0; i < 4; ++i) { const int row = ch * 4 + i; r[i] = *(const v4i*)(ROUTE + (size_t)row * 4);
            a[i] = *(const v4u*)(XN2 + (size_t)row * DM + 8 * F.lane); bq[i] = *(const v4u*)(XN2 + (size_t)row * DM + 512 + 8 * F.lane); }
#pragma unroll
        for (int i = 0; i < 4; ++i) { const int row = ch * 4 + i, srow = tinfo[256 + r[i].x] + r[i].y;
            *(v4u*)(XN2S + (size_t)srow * DM + 8 * F.lane) = a[i]; *(v4u*)(XN2S + (size_t)srow * DM + 512 + 8 * F.lane) = bq[i];
            if (F.lane == 0) { v4i w; w.x = row; w.y = r[i].z; w.z = r[i].w; w.w = 0; *(v4i*)(TOKW + (size_t)srow * 4) = w; } }
    }
}

constexpr float W32C[16] = {1.f, 0.98078528040323043f, 0.92387953251128674f, 0.83146961230254524f, 0.70710678118654752f, 0.55557023301960218f, 0.38268343236508977f, 0.19509032201612825f,
                            0.f, -0.19509032201612825f, -0.38268343236508977f, -0.55557023301960218f, -0.70710678118654752f, -0.83146961230254524f, -0.92387953251128674f, -0.98078528040323043f};
constexpr float W32S[16] = {0.f, 0.19509032201612825f, 0.38268343236508977f, 0.55557023301960218f, 0.70710678118654752f, 0.83146961230254524f, 0.92387953251128674f, 0.98078528040323043f,
                            1.f, 0.98078528040323043f, 0.92387953251128674f, 0.83146961230254524f, 0.70710678118654752f, 0.55557023301960218f, 0.38268343236508977f, 0.19509032201612825f};
struct FftTw { const c32* T1; c32 tob; const c32* T2; };
template <int A> __device__ __forceinline__ c32 mul_to(c32 x, c32 tob) { const c32 y = cmul(x, tob); return cmk(y.x * W32C[A] + y.y * W32S[A], y.y * W32C[A] - y.x * W32S[A]); }
template <int A> __device__ __forceinline__ c32 mul_toc(c32 x, c32 tob) { const c32 y = cmulc(x, tob); return cmk(y.x * W32C[A] - y.y * W32S[A], y.y * W32C[A] + y.x * W32S[A]); }
#define TO_ALL(OP) OP(0) OP(1) OP(2) OP(3) OP(4) OP(5) OP(6) OP(7) OP(8) OP(9) OP(10) OP(11) OP(12) OP(13) OP(14) OP(15)
__device__ __forceinline__ void fft_twiddles(FftTw& W, int gt, c32* t1tab, c32* t2tab, int tid) {
    if (tid < 256) { float s, c; sincosf(-6.283185307179586f * (float)(((tid >> 4) * (tid & 15)) & 255) * (1.f / 256.f), &s, &c); t2tab[(tid >> 4) * 17 + (tid & 15)] = cmk(c, s); }
    for (int i = tid; i < 4096; i += NTHR) { const int p = i >> 8, t = i & 255; float s, c; sincosf(-6.283185307179586f * (float)((t * p) & 4095) * (1.f / 4096.f), &s, &c); t1tab[i] = cmk(c, s); }
    { float s, c; sincosf(-6.283185307179586f * (float)gt * (1.f / 8192.f), &s, &c); W.tob = cmk(c, s); }
    W.T1 = t1tab + gt; W.T2 = t2tab + (gt & 15) * 17;
    __syncthreads();
}
__device__ __forceinline__ void fft_forward_a(c32 (&v)[16], const FftTw& W, c32* ex, int gt) {
    __syncthreads();
    fft_fwd_a(v, W.T1, ex, gt);
    __syncthreads();
}
__device__ __forceinline__ void fft_forward_bc(c32 (&v)[16], const FftTw& W, c32* ex, int gt) {
    fft_fwd_b(v, W.T2, ex, ex, gt);
    __builtin_amdgcn_wave_barrier(); asm volatile("" ::: "memory");
    fft_fwd_c(v, ex, gt);
}
__device__ __forceinline__ void fft_forward(c32 (&v)[16], const FftTw& W, c32* ex, int gt) { fft_forward_a(v, W, ex, gt); fft_forward_bc(v, W, ex, gt); }
__device__ __forceinline__ void fft_inverse(c32 (&v)[16], const FftTw& W, c32* ex, int gt) {
    __builtin_amdgcn_wave_barrier(); asm volatile("" ::: "memory");
    fft_inv_a(v, ex, gt);
    __builtin_amdgcn_wave_barrier(); asm volatile("" ::: "memory");
    fft_inv_b(v, W.T2, ex, ex, gt);
    __syncthreads();
    fft_inv_c(v, W.T1, ex, gt);
}
__device__ __forceinline__ void filter_phase(const Ctx& F, const float* HT, const float* fbias, c32* KF) {
    const int g = __builtin_amdgcn_readfirstlane(F.tid >> 8), gt = F.tid & 255;
    c32* ex = (c32*)(F.lds + RING_OFF + g * 36864);
    float* rev = (float*)ex;
    float* red = (float*)(F.lds + RED_OFF);
    FftTw W; fft_twiddles(W, gt, (c32*)(F.lds + RING_OFF + 73728), (c32*)(F.lds + RING_OFF + 110592), F.tid);
    for (int d = F.vcu; d < DM; d += F.G) {
        int gtv = gt; asm volatile("" : "+v"(gtv));
        const float delta = fabsf(-120.39728043259361f + (float)d * ((40.546510810816436f + 120.39728043259361f) / 1023.f));
        const float* hfp = HT + (size_t)(g * 2048 + d) * 4096; const float* hbp = HT + (size_t)(g * 2048 + 1024 + d) * 4096;
        float hf[16], hb[16]; float sf = 0.f, sb = 0.f;
#pragma unroll
        for (int a = 0; a < 16; ++a) { const int t = 256 * a + gtv; const float dec = __expf(-((float)t * (1.f / 4095.f)) * delta); hf[a] = hfp[t] * dec; hb[a] = hbp[t] * dec; sf += fabsf(hf[a]); sb += fabsf(hb[a]); }
        sf = wave_sum(sf); sb = wave_sum(sb);
        __syncthreads();
        if (F.lane == 0) { red[F.wave * 2] = sf; red[F.wave * 2 + 1] = sb; }
        __syncthreads();
        sf = red[g * 8] + red[g * 8 + 2] + red[g * 8 + 4] + red[g * 8 + 6]; sb = red[g * 8 + 1] + red[g * 8 + 3] + red[g * 8 + 5] + red[g * 8 + 7];
        const float nf = 1.f / (sf + EPS) * (1.f / 8192.f), nb = 1.f / (sb + EPS) * (1.f / 8192.f);
#pragma unroll
        for (int a = 0; a < 16; ++a) rev[256 * a + gt] = hb[a] * nb;
        __syncthreads();
        c32 v[16];
#pragma unroll
        for (int a = 0; a < 16; ++a) { const int n = 256 * a + gt; hb[a] = n == 0 ? 0.f : rev[4096 - n]; hf[a] *= nf; v[a] = cmk(hf[a] + hb[a], 0.f); }
        fft_forward(v, W, ex, gt);
        c32* kf = KF + ((size_t)(d * 2 + g) * 2) * 4096; const float fb = fbias[g * 1024 + d] * (1.f / 4096.f);
#pragma unroll
        for (int i = 0; i < 16; ++i) kf[i * 256 + gtv] = cmk(v[i].x + fb, v[i].y);
#define OPX(A) v[A] = mul_to<A>(cmk(hf[A] - hb[A], 0.f), W.tob);
        TO_ALL(OPX)
#undef OPX
        fft_forward(v, W, ex, gt);
#pragma unroll
        for (int i = 0; i < 16; ++i) kf[4096 + i * 256 + gtv] = v[i];
    }
}
__device__ __forceinline__ void long_conv(c32 (&z)[16], const c32* kf, const FftTw& W, c32* ex, int gt) {
    typedef float f32x2v __attribute__((ext_vector_type(2))); typedef __attribute__((address_space(1))) const f32x2v gc32;
    c32 v[16], k[16]; int gk = gt; asm volatile("" : "+v"(gk));
#define OPX(A) v[A] = mul_to<A>(z[A], W.tob);
    TO_ALL(OPX)
#undef OPX
    fft_forward_a(v, W, ex, gt);
    asm volatile("" ::: "memory");
#pragma unroll
    for (int i = 0; i < 16; ++i) { const f32x2v t_ = ((gc32*)kf)[4096 + i * 256 + gk]; k[i] = cmk(t_.x, t_.y); }
    fft_forward_bc(v, W, ex, gt);
#pragma unroll
    for (int i = 0; i < 16; ++i) v[i] = cmul(v[i], k[i]);
    fft_inverse(v, W, ex, gt);
#define OPX(A) v[A] = mul_toc<A>(v[A], W.tob);
    TO_ALL(OPX)
#undef OPX
    fft_forward_a(z, W, ex, gt);
    asm volatile("" ::: "memory");
#pragma unroll
    for (int i = 0; i < 16; ++i) { const f32x2v t_ = ((gc32*)kf)[i * 256 + gk]; k[i] = cmk(t_.x, t_.y); }
    fft_forward_bc(z, W, ex, gt);
#pragma unroll
    for (int i = 0; i < 16; ++i) z[i] = cmul(z[i], k[i]);
    fft_inverse(z, W, ex, gt);
#pragma unroll
    for (int a = 0; a < 16; ++a) z[a] = cadd(z[a], v[a]);
}
struct RawSeq { v4u r[2][2]; };
__device__ __forceinline__ void raw_issue(RawSeq& q, const bf16* urow, int b0, int gt) {
    typedef __attribute__((address_space(1))) const v4u gv4u;
    asm volatile("" : "+v"(gt));
#pragma unroll
    for (int s_ = 0; s_ < 2; ++s_)
#pragma unroll
        for (int i = 0; i < 2; ++i) q.r[s_][i] = *(gv4u*)(urow + (size_t)(b0 + s_) * SEQ + (gt + 256 * i) * 8);
}
__device__ __forceinline__ void stage_conv3(c32 (&o)[16], const RawSeq& q, float w0, float w1, float w2, float cb, bf16* stg, int gt) {
    constexpr int SS = 4112;
    __syncthreads();
#pragma unroll
    for (int s_ = 0; s_ < 2; ++s_) {
#pragma unroll
        for (int i = 0; i < 2; ++i) *(v4u*)(stg + s_ * SS + 8 + (gt + 256 * i) * 8) = q.r[s_][i];
        if (gt == 0) { stg[s_ * SS + 7] = 0; stg[s_ * SS + 4104] = 0; } }
    __syncthreads();
#pragma unroll
    for (int a = 0; a < 16; ++a) { const int t = 256 * a + gt; float r[2];
#pragma unroll
        for (int s_ = 0; s_ < 2; ++s_) { const bf16* sp = stg + s_ * SS + 7 + t; r[s_] = w0 * bf2f(sp[0]) + w1 * bf2f(sp[1]) + w2 * bf2f(sp[2]) + cb; }
        o[a] = cmk(r[0], r[1]); if ((a & 3) == 3) __builtin_amdgcn_sched_barrier(0); }
}
__device__ __forceinline__ void conv_phase(const Ctx& F, const bf16* UT, const c32* KF, const float* convw, const float* convb, bf16* ZT) {
    const int g = __builtin_amdgcn_readfirstlane(F.tid >> 8), gt = F.tid & 255;
    c32* ex = (c32*)(F.lds + RING_OFF + g * 36864);
    bf16* stg = (bf16*)ex;
    FftTw W; fft_twiddles(W, gt, (c32*)(F.lds + RING_OFF + 73728), (c32*)(F.lds + RING_OFF + 110592), F.tid);
    RawSeq raw;
    if (F.vcu < DM) raw_issue(raw, UT + (size_t)(2048 + F.vcu) * T, (2 * g) * 2, gt);
    for (int d = F.vcu; d < DM; d += F.G) {
        const c32* kf0 = KF + ((size_t)(d * 2 + 0) * 2) * 4096; const c32* kf1 = KF + ((size_t)(d * 2 + 1) * 2) * 4096;
        for (int pp = 0; pp < 2; ++pp) { const int b0 = (2 * g + pp) * 2;
            int gtv = gt; asm volatile("" : "+v"(gtv));
            c32 z[16], gate[16];
            { const int c = 2048 + d; stage_conv3(z, raw, convw[c], convw[3072 + c], convw[6144 + c], convb[c], stg, gtv); }
            raw_issue(raw, UT + (size_t)d * T, b0, gtv);
            long_conv(z, kf0, W, ex, gtv);
            { const int c = d; stage_conv3(gate, raw, convw[c], convw[3072 + c], convw[6144 + c], convb[c], stg, gtv); }
            raw_issue(raw, UT + (size_t)(1024 + d) * T, b0, gtv);
#pragma unroll
            for (int a = 0; a < 16; ++a) z[a] = cmk(z[a].x * gate[a].x, z[a].y * gate[a].y);
            long_conv(z, kf1, W, ex, gtv);
            { const int c = 1024 + d; stage_conv3(gate, raw, convw[c], convw[3072 + c], convw[6144 + c], convb[c], stg, gtv); }
            { const int dn = pp == 0 ? d : d + F.G; if (dn < DM) raw_issue(raw, UT + (size_t)(2048 + dn) * T, pp == 0 ? b0 + 2 : (2 * g) * 2, gtv); }
            bf16* zr = ZT + (size_t)d * T + (size_t)b0 * SEQ;
#pragma unroll
            for (int a = 0; a < 16; ++a) { const int t = 256 * a + gtv; const unsigned pk = pk2(z[a].x * gate[a].x, z[a].y * gate[a].y); zr[t] = (bf16)(pk & 0xffffu); zr[SEQ + t] = (bf16)(pk >> 16); }
        }
    }
}
__device__ __forceinline__ void transpose_phase(const Ctx& F, const bf16* ZT, bf16* Z) {
    bf16* tile = (bf16*)(F.lds + RING_OFF + F.wave * 8704);
    const int l = F.lane;
    v4u x[8];
    if (F.gw < 16 * 512) { const int d0 = (F.gw & 15) * 64, t0 = (F.gw >> 4) * 64;
#pragma unroll
        for (int i = 0; i < 8; ++i) x[i] = *(const v4u*)(ZT + (size_t)(d0 + i * 8 + (l >> 3)) * T + t0 + (l & 7) * 8); }
    for (int it = F.gw; it < 16 * 512; it += F.NGW) { const int d0 = (it & 15) * 64, t0 = (it >> 4) * 64;
#pragma unroll
        for (int i = 0; i < 8; ++i) { const int dr = i * 8 + (l >> 3), c = l & 7;
            v2u* p = (v2u*)(tile + dr * 68 + c * 8); v2u a; a.x = x[i].x; a.y = x[i].y; p[0] = a; a.x = x[i].z; a.y = x[i].w; p[1] = a; }
        const int itn = it + F.NGW;
        if (itn < 16 * 512) { const int dn = (itn & 15) * 64, tn = (itn >> 4) * 64;
#pragma unroll
            for (int i = 0; i < 8; ++i) x[i] = *(const v4u*)(ZT + (size_t)(dn + i * 8 + (l >> 3)) * T + tn + (l & 7) * 8); }
        LDS_WAIT();
#pragma unroll
        for (int i = 0; i < 8; ++i) { const int tr = i * 8 + (l >> 3), c = l & 7; unsigned short e[8];
#pragma unroll
            for (int k = 0; k < 8; ++k) e[k] = tile[(c * 8 + k) * 68 + tr];
            v4u o; o.x = e[0] | ((unsigned)e[1] << 16); o.y = e[2] | ((unsigned)e[3] << 16); o.z = e[4] | ((unsigned)e[5] << 16); o.w = e[6] | ((unsigned)e[7] << 16);
            *(v4u*)(Z + (size_t)(t0 + tr) * DM + d0 + c * 8) = o; }
        LDS_WAIT();
    }
}

constexpr int NPH = 22;
#define MOE_PHASES(L) do { \
        const int mb = 8 + 10 * L; \
        if (IN(mb)) { PH_ARGS; const float* mod = WSP(float, WS_MOD) + (size_t)L * 8 * 6144; gu32* cnt = (gu32*)(ws + WS_CTL) + CW_CNT + L * 24 * 64; \
            route_phase(F, WSP(bf16, WS_XR), in[6] + L * 1024, mod + 4 * 1024, mod + 3 * 1024, in[31] + L * 4096, in[32] + L * 4, in[33] + L * 16384, in[34] + L * 16, WSP(bf16, WS_XN2), WSP(int, WS_LIST), WSP(float, WS_WL), cnt); \
            if (L == 0) { __syncthreads();        \
                pg8::Gemm gmh{WSP(bf16, WS_W4S), WSP(bf16, WS_HDNS), 4096, 4096, 256}; pg8::StaticOrder Sh; Sh.init(4096, 4096, F.G, (int)blockIdx.x); pg8::EpiF32 Eh{WSP(float, WS_HT), 4096}; \
                REP(11) pg8::gemm_phase<pg8::EpiF32, pg8::StaticOrder, true, true>(ring, gmh, Sh, Eh, F.tid); } } \
        if (IN(mb) && IN(mb + 2)) xcd_barrier(bar); \
        if (IN(mb + 2)) { PH_ARGS; gu32* cnt = (gu32*)(ws + WS_CTL) + CW_CNT + L * 24 * 64; moe_table(F, cnt); \
            pg8::Gemm gm{WSP(bf16, WS_XN2), WSP(bf16, WS_WGU) + (size_t)L * 16 * 512 * 1024, MS_ROWS, 8192, 1024}; pg8::MoeOrder S{tinfo, F.G, F.vcu, 0, WSP(int, WS_LIST)}; pg8::EpiSwiGLU E{WSP(bf16, WS_HACT), WSP(float, WS_WL), tinfo}; \
            REP(10) pg8::gemm_phase_gather<pg8::EpiSwiGLU, pg8::MoeOrder, true, true>(ring, gm, S, E, F.tid); } SEAM(mb + 2); \
        if (IN(mb + 3)) { PH_ARGS; gu32* cnt = (gu32*)(ws + WS_CTL) + CW_CNT + L * 24 * 64; moe_table(F, cnt); const float* mod = WSP(float, WS_MOD) + (size_t)L * 8 * 6144; \
            pg8::Gemm gm{WSP(bf16, WS_HACT), WSP(bf16, WS_WDN) + (size_t)L * 24 * 1024 * 512, MS_ROWS, 24 * 1024, 512}; pg8::MoeOrder S{tinfo, F.G, F.vcu, 1, WSP(int, WS_LIST)}; if (L == 0) { pg8::EpiMoeOut<bf16> E{WSP(bf16, WS_XR), WSP(bf16, WS_XR), mod + 5 * 1024, WSP(int, WS_LIST), tinfo}; pg8::gemm_phase<pg8::EpiMoeOut<bf16>, pg8::MoeOrder, true, true>(ring, gm, S, E, F.tid); } \
            else { pg8::EpiMoeOut<float> E{WSP(bf16, WS_XR), out, mod + 5 * 1024, WSP(int, WS_LIST), tinfo}; pg8::gemm_phase<pg8::EpiMoeOut<float>, pg8::MoeOrder, true, true>(ring, gm, S, E, F.tid); } \
            if (L == 0) { __syncthreads(); REP(13) filter_phase(F, WSP(float, WS_HT), in[29], WSP(c32, WS_KF)); }       \
            } \
    } while (0)
struct Args { const float* in[38]; float* out; unsigned char* ws; int ph_lo, ph_hi; };
static_assert(sizeof(Args) == 38 * 8 + 8 + 8 + 8, "Args layout (read back through the kernarg segment pointer)");
__global__ void __launch_bounds__(NTHR, 2) fwd_kernel(Args args) {
    extern __shared__ __attribute__((aligned(16))) unsigned char lds[];
#define MK_CTX(F, tx) Ctx F; F.lds = lds; F.tid = (tx); F.lane = F.tid & 63; F.wave = __builtin_amdgcn_readfirstlane(F.tid >> 6); \
    F.G = gridDim.x; { const int bx = blockIdx.x; F.vcu = (F.G % 8 == 0) ? (bx % 8) * (F.G / 8) + bx / 8 : bx; } F.gw = F.vcu * NWAVES + F.wave; F.NGW = F.G * NWAVES
    for (int u = threadIdx.x; u < (LDS_BYTES - LDSCTL_OFF) / 4; u += NTHR) ((LAS unsigned*)((LAS unsigned char*)lds + LDSCTL_OFF))[u] = 0u;
    __syncthreads();
    const int wave_s_ = __builtin_amdgcn_readfirstlane(threadIdx.x >> 6);
    const int lo = args.ph_lo, hi = args.ph_hi;
    const bool use_bar = (hi - lo) > 1;
    XcdBarrier bar; bar.bar = (unsigned*)(args.ws + WS_CTL) + CW_BAR; bar.x = 0; bar.st = nullptr; bar.w0 = 0;
    if (use_bar) bar = xcd_barrier_post((unsigned*)(args.ws + WS_CTL) + CW_BAR, (volatile LAS unsigned*)((LAS unsigned char*)lds + MISC_OFF) + 8);
    bar.w0 = (wave_s_ == 0) ? 1 : 0;
#ifndef PHMASK
#define PHMASK 0xFFFFFFFFu
#endif
#define IN(k) (((PHMASK >> ((k) >= 18 ? (k) - 10 : (k))) & 1u) && lo <= (k) && (k) < hi)
#ifndef REPMASK
#define REPMASK 0u
#endif
#define NREP(k) (((REPMASK >> (k)) & 1u) ? 2 : 1)
#define REP(k) for (int rep_ = 0; rep_ < NREP(k); ++rep_)
#define SEAM(k) do { if (IN(k) && IN((k) + 1)) xcd_barrier(bar); } while (0)
#define PH_STR2(x) #x
#define PH_STR(x) PH_STR2(x)
#define PH_ARGS int opq_ = 0; asm volatile("; PHMARK line " PH_STR(__LINE__) : "+s"(opq_)); const In in{opq_}; unsigned char* const ws = karg_ws(opq_); float* const out = karg_out(opq_); (void)in; (void)ws; (void)out; int tx_ = wave_s_ * 64 + (int)__builtin_amdgcn_mbcnt_hi(~0u, __builtin_amdgcn_mbcnt_lo(~0u, 0u)); asm volatile("" : "+v"(tx_)); MK_CTX(F, tx_)
#define WSP(type, off) ((type*)(ws + (off)))
    PG8_LAS unsigned char* ring = (PG8_LAS unsigned char*)lds + RING_OFF;
    const PG8_LAS int* tinfo = (const PG8_LAS int*)((PG8_LAS unsigned char*)lds + TINFO_OFF);

    if (IN(0)) { PH_ARGS; REP(0) p0_prologue(F, in, ws); } SEAM(0);

            if (IN(1)) { PH_ARGS; const float* mod = WSP(float, WS_MOD); REP(1) norm_mod_phase(F, in[0], in[5], mod + 1024, mod, WSP(bf16, WS_XN)); } SEAM(1);
            if (IN(2)) { PH_ARGS; pg8::Gemm gm{WSP(bf16, WS_XN), WSP(bf16, WS_WD), T, 512, 1024}; pg8::StaticOrder S; S.init(T, 512, F.G, (int)blockIdx.x);
                pg8::EpiLat E{WSP(bf16, WS_CQN), WSP(bf16, WS_CKVN), WSP(unsigned char, WS_KPE), in[8], in[9], in[13], WSP(float, WS_ROPE), (PG8_LAS float*)((PG8_LAS unsigned char*)lds + EPIX_OFF)};
                REP(2) pg8::gemm_phase<pg8::EpiLat, pg8::StaticOrder, true, true>(ring, gm, S, E, F.tid); }
            if (IN(2) && IN(4)) xcd_barrier(bar);
            if (IN(4)) { PH_ARGS; REP(4) {
                { pg8::Gemm gm{WSP(bf16, WS_CQN), WSP(bf16, WS_WUQ), T, 1536, 256}; pg8::StaticOrder S; S.init(T, 1536, F.G, (int)blockIdx.x); pg8::EpiBf16R E{WSP(bf16, WS_QRAW), 1536, nullptr};
                  pg8::gemm_phase<pg8::EpiBf16R, pg8::StaticOrder, true, true>(ring, gm, S, E, F.tid); }
                { pg8::Gemm gm{WSP(bf16, WS_CKVN), WSP(bf16, WS_WUKV), T, 1024, 128};   pg8::StaticOrder S; S.init(T, 1024, F.G, (int)blockIdx.x);
                  pg8::EpiK8 E{WSP(unsigned char, WS_K8), in[13], (PG8_LAS float*)((PG8_LAS unsigned char*)lds + EPIX_OFF)};
                  pg8::gemm_phase<pg8::EpiK8, pg8::StaticOrder, true, true>(ring, gm, S, E, F.tid); }
                { pg8::Gemm gm{WSP(bf16, WS_WUKV) + 1024 * 128, WSP(bf16, WS_CKVN), 1024, T, 128}; pg8::StaticOrder S; S.init(1024, T, F.G, (int)blockIdx.x);
                  pg8::EpiF8T E{WSP(unsigned char, WS_VT8), T};
                  pg8::gemm_phase<pg8::EpiF8T, pg8::StaticOrder, true, true>(ring, gm, S, E, F.tid); } }
            } if (IN(4) && IN(6)) xcd_barrier(bar);
            if (IN(6)) { PH_ARGS;
                const float* qg = in[12]; const float* kg = in[13];
#define ATT_SMAX(var) float var; { float gqn = 0.f, gkn = 0.f, gqp = 0.f, gkp = 0.f; \
                    for (int i = 0; i < 128; ++i) { gqn = fmaxf(gqn, fabsf(qg[i])); gkn = fmaxf(gkn, fabsf(kg[i])); } \
                    for (int i = 128; i < 192; ++i) { gqp = fmaxf(gqp, fabsf(qg[i])); gkp = fmaxf(gkp, fabsf(kg[i])); } \
                    var = (128.f * gqn * gkn + 64.f * gqp * gkp) * (0.072168783648703220f * 1.4426950408889634f); }
                unsigned redo_mask = 0u;
                { ATT_SMAX(smaxC)
                  if (smaxC < 60.f) { int i = 0;
                    for (int u = F.vcu; u < 1024; u += F.G, ++i) { const int b = u >> 7, h = (u >> 4) & 7, qb = u & 15;
                        if (att::attn_unit<false>(b, h, qb * 256, WSP(bf16, WS_QRAW), WSP(unsigned char, WS_VT8), WSP(unsigned char, WS_K8), WSP(unsigned char, WS_KPE), WSP(bf16, WS_O), WSP(float, WS_ROPE), qg, 0.f, (char*)lds + RING_OFF, wave_s_)) redo_mask |= 1u << (i & 31); } }
                  else redo_mask = 0xffffffffu; }
                redo_mask = (unsigned)__builtin_amdgcn_readfirstlane((int)redo_mask);
                if (redo_mask) { int i = 0; ATT_SMAX(smaxC2)
                    for (int u = F.vcu; u < 1024; u += F.G, ++i) { const int b = u >> 7, h = (u >> 4) & 7, qb = u & 15;
                        if ((redo_mask >> (i & 31)) & 1u) (void)att::attn_unit<true>(b, h, qb * 256, WSP(bf16, WS_QRAW), WSP(unsigned char, WS_VT8), WSP(unsigned char, WS_K8), WSP(unsigned char, WS_KPE), WSP(bf16, WS_O), WSP(float, WS_ROPE), qg, smaxC2, (char*)lds + RING_OFF, wave_s_); } }
#undef ATT_SMAX
            } SEAM(6);
            if (IN(7)) { PH_ARGS; pg8::Gemm gm{WSP(bf16, WS_O), WSP(bf16, WS_WO), T, 1024, 1024}; pg8::StaticOrder S; S.init(T, 1024, F.G, (int)blockIdx.x); pg8::EpiResGate<float, bf16> E{in[0], WSP(bf16, WS_XR), WSP(float, WS_MOD) + 2048, 1024};
                REP(7) pg8::gemm_phase<pg8::EpiResGate<float, bf16>, pg8::StaticOrder, true, true>(ring, gm, S, E, F.tid); } SEAM(7);
    MOE_PHASES(0); SEAM(11);
            if (IN(12)) { PH_ARGS; const float* mod = WSP(float, WS_MOD) + 8 * 6144; REP(12) norm_mod_phase(F, WSP(bf16, WS_XR), in[5] + 1024, mod + 1024, mod, (bf16*)out); }
            if (IN(12) && IN(14)) xcd_barrier(bar);
            if (IN(14)) { PH_ARGS; pg8::Gemm gm{WSP(bf16, WS_WIN), (const bf16*)out, 3072, T, 1024}; pg8::StaticOrder S; S.init(3072, T, F.G, (int)blockIdx.x); pg8::EpiBf16R E{WSP(bf16, WS_UT), T, in[16]};
                REP(14) pg8::gemm_phase<pg8::EpiBf16R, pg8::StaticOrder, true, true>(ring, gm, S, E, F.tid); } SEAM(14);
            if (IN(15)) { PH_ARGS; for (int rep = 0; rep < NREP(15); ++rep) conv_phase(F, WSP(bf16, WS_UT), WSP(c32, WS_KF), in[17], in[18], (bf16*)out); } SEAM(15);
            if (IN(16)) { PH_ARGS; REP(16) transpose_phase(F, (const bf16*)out, WSP(bf16, WS_Z)); } SEAM(16);
            if (IN(17)) { PH_ARGS; pg8::Gemm gm{WSP(bf16, WS_Z), WSP(bf16, WS_WOUT), T, 1024, 1024}; pg8::StaticOrder S; S.init(T, 1024, F.G, (int)blockIdx.x); pg8::EpiResGate<bf16, bf16> E{WSP(bf16, WS_XR), WSP(bf16, WS_XR), WSP(float, WS_MOD) + 8 * 6144 + 2048, 1024};
                pg8::gemm_phase<pg8::EpiResGate<bf16, bf16>, pg8::StaticOrder, true, true>(ring, gm, S, E, F.tid); } SEAM(17);
    MOE_PHASES(1);
#undef IN
#undef SEAM
}

#ifndef ONE_LAUNCH
#define ONE_LAUNCH 1
#endif
extern "C" void kernel_launch(void* const* d_in, const int* in_sizes, int n_in, void* d_out, int out_size, void* d_ws, size_t ws_size, hipStream_t stream) {
    static int grid = 0;
    if (grid == 0) {
        if (n_in != 38 || in_sizes[0] != T * DM || out_size != T * DM || ws_size < WS_END) { fprintf(stderr, "kernel_launch: shape mismatch n_in %d in0 %d out %d ws %zu\n", n_in, n_in > 0 ? in_sizes[0] : -1, out_size, ws_size); grid = -1; return; }
        int dev = 0, cus = 0, per_cu = 0;
        if (hipGetDevice(&dev) != hipSuccess || hipDeviceGetAttribute(&cus, hipDeviceAttributeMultiprocessorCount, dev) != hipSuccess) { grid = -1; return; }
        if (hipFuncSetAttribute((const void*)fwd_kernel, hipFuncAttributeMaxDynamicSharedMemorySize, LDS_BYTES) != hipSuccess) { fprintf(stderr, "kernel_launch: hipFuncSetAttribute failed\n"); grid = -1; return; }
        if (hipOccupancyMaxActiveBlocksPerMultiprocessor(&per_cu, (const void*)fwd_kernel, NTHR, LDS_BYTES) != hipSuccess || per_cu < 1) { fprintf(stderr, "kernel_launch: occupancy query says %d\n", per_cu); }
        (void)hipGetLastError();
        grid = cus;
    }
    if (grid < 0) return;
    if (hipMemsetAsync((char*)d_ws + WS_CTL, 0, CTL_ZERO_BYTES, stream) != hipSuccess) return;
    Args a{};
    for (int i = 0; i < 38; ++i) a.in[i] = (const float*)d_in[i];
    a.out = (float*)d_out; a.ws = (unsigned char*)d_ws;
#if ONE_LAUNCH
    a.ph_lo = 0; a.ph_hi = NPH;
    hipLaunchKernelGGL(fwd_kernel, dim3(grid), dim3(NTHR), LDS_BYTES, stream, a);
#else
    for (int p = 0; p < NPH; ++p) { a.ph_lo = p; a.ph_hi = p + 1; hipLaunchKernelGGL(fwd_kernel, dim3(grid), dim3(NTHR), LDS_BYTES, stream, a); }
#endif
    const hipError_t le = hipPeekAtLastError();
    if (le != hipSuccess) fprintf(stderr, "kernel_launch: launch failed: %s\n", hipGetErrorName(le));
}
```

```cpp
#include <hip/hip_runtime.h>
#include <cstdio>
#include <cstdint>
namespace pg8 {
#define PG8_LAS __attribute__((address_space(3)))
typedef unsigned short bf16_t;
typedef short bf16x8 __attribute__((ext_vector_type(8)));
typedef float f32x4 __attribute__((ext_vector_type(4)));
typedef unsigned u32x4 __attribute__((ext_vector_type(4)));
typedef int v4i_t __attribute__((ext_vector_type(4)));
typedef int v8i_t __attribute__((ext_vector_type(8)));
constexpr int BM = 256, BK = 64, HALF = 128, HTB = HALF * BK * 2  , STAGE_BYTES = 8 * HTB, NXCD = 8, WGM = 8;

__host__ __device__ __forceinline__ int lds_byte(int r, int c) { const int st = (r >> 4) * 2 + (c >> 5), rr = r & 15, cc = c & 31, ob = rr * 64 + cc * 2; return st * 1024 + (ob ^ (((ob >> 9) & 1) << 5)); }
__host__ __device__ __forceinline__ void stage_rc(int b, int& R, int& C) { const int st = b / 1024, sb = b % 1024, swz = sb ^ (((sb >> 9) & 1) << 5); R = (st >> 1) * 16 + swz / 64; C = (st & 1) * 32 + (swz % 64) / 2; }
__host__ __device__ __forceinline__ int perm32(int rho) { const int n = rho >> 4, i = rho & 15; return 8 * (i >> 2) + 4 * n + (i & 3); }

struct Unit { int pm, pn; };
struct Gemm { const bf16_t* A; const bf16_t* Bt; int M, N, K; };

struct StaticOrder {
    int nM, nN, nwg, G, c;
    __host__ __device__ void init(int M, int N, int G_, int c_) { nM = M / BM; nN = N / BM; nwg = nM * nN; G = G_; c = c_; }
    __host__ __device__ bool next(int i, Unit& u) const {
        const long L = (long)i * G + c; if (L >= nwg) return false;
        int wgid = (int)L; { const int q = nwg / NXCD, r = nwg % NXCD, xcd = wgid % NXCD, off = wgid / NXCD; wgid = (xcd < r ? xcd * (q + 1) : r * (q + 1) + (xcd - r) * q) + off; }
        const int nig = WGM * nN, gid = wgid / nig, fm = gid * WGM, gsz = (nM - fm) < WGM ? (nM - fm) : WGM;
        u.pm = fm + ((wgid % nig) % gsz); u.pn = (wgid % nig) / gsz; return true;
    }
    __device__ __forceinline__ void a_ready(const Unit&) const {}
    __device__ __forceinline__ void done(const Unit&) const {}
};

__device__ __forceinline__ unsigned cvt_pk_bf16(float lo, float hi) { unsigned r; asm volatile("v_cvt_pk_bf16_f32 %0, %1, %2" : "=v"(r) : "v"(lo), "v"(hi)); return r; }
typedef float f32x2 __attribute__((ext_vector_type(2)));
typedef unsigned u32x2 __attribute__((ext_vector_type(2)));
struct EpiF32 {
    static constexpr bool PERM = false, AFTER_DRAIN = false;
    float* C; int ldc;
    __device__ __forceinline__ void operator()(const f32x4 (&acc)[2][2][4][2], const Unit& u, int wr, int wc, int fr, int fq) const {
        const int row0 = u.pm * BM + wr * 64 + fr, col0 = u.pn * BM + wc * 32 + 4 * fq;
#pragma unroll
        for (int ai = 0; ai < 2; ++ai)
#pragma unroll
            for (int m = 0; m < 4; ++m) { float* rowp = C + (size_t)(row0 + ai * HALF + m * 16) * ldc + col0;
#pragma unroll
                for (int bj = 0; bj < 2; ++bj)
#pragma unroll
                    for (int n = 0; n < 2; ++n) *(f32x4*)(rowp + bj * HALF + n * 16) = acc[ai][bj][m][n]; }
    }
};
struct EpiBf16R {
    static constexpr bool PERM = true, AFTER_DRAIN = false;
    bf16_t* O; int ldc; const float* rowbias;
    __device__ __forceinline__ void operator()(const f32x4 (&acc)[2][2][4][2], const Unit& u, int wr, int wc, int fr, int fq) const {
        const int row0 = u.pm * BM + wr * 64 + fr, col0 = u.pn * BM + wc * 32 + 8 * fq;
#pragma unroll
        for (int ai = 0; ai < 2; ++ai)
#pragma unroll
            for (int m = 0; m < 4; ++m) { const int row = row0 + ai * HALF + m * 16; bf16_t* rowp = O + (size_t)row * ldc + col0; const float rb = rowbias ? rowbias[row] : 0.f;
#pragma unroll
                for (int bj = 0; bj < 2; ++bj) { const f32x4 v0 = acc[ai][bj][m][0] + rb, v1 = acc[ai][bj][m][1] + rb;
                    u32x4 w; w.x = cvt_pk_bf16(v0[0], v0[1]); w.y = cvt_pk_bf16(v0[2], v0[3]); w.z = cvt_pk_bf16(v1[0], v1[1]); w.w = cvt_pk_bf16(v1[2], v1[3]);
                    *(u32x4*)(rowp + bj * HALF) = w; } }
    }
};
__device__ __forceinline__ f32x4 ld4(const float* p) { return *(const f32x4*)p; }
__device__ __forceinline__ f32x4 ld4(const bf16_t* p) { const u32x2 w = *(const u32x2*)p; f32x4 r; r[0] = __uint_as_float(w.x << 16); r[1] = __uint_as_float(w.x & 0xffff0000u); r[2] = __uint_as_float(w.y << 16); r[3] = __uint_as_float(w.y & 0xffff0000u); return r; }
__device__ __forceinline__ void st4(float* p, f32x4 v) { *(f32x4*)p = v; }
__device__ __forceinline__ void st4(bf16_t* p, f32x4 v) { u32x2 w; w.x = cvt_pk_bf16(v[0], v[1]); w.y = cvt_pk_bf16(v[2], v[3]); *(u32x2*)p = w; }
template <class TB, class TO> struct EpiResGate {
    static constexpr bool PERM = false, AFTER_DRAIN = false;
    const TB* base; TO* out; const float* gate; int ldc;
    __device__ __forceinline__ void operator()(const f32x4 (&acc)[2][2][4][2], const Unit& u, int wr, int wc, int fr, int fq) const {
        const int row0 = u.pm * BM + wr * 64 + fr, col0 = u.pn * BM + wc * 32 + 4 * fq;
        const float* gp = gate + (size_t)(u.pm >> 4) * 6144 + col0;
        f32x4 gv[2][2];
#pragma unroll
        for (int bj = 0; bj < 2; ++bj)
#pragma unroll
            for (int n = 0; n < 2; ++n) gv[bj][n] = *(const f32x4*)(gp + bj * HALF + n * 16);
#pragma unroll
        for (int ai = 0; ai < 2; ++ai)
#pragma unroll
            for (int m = 0; m < 4; ++m) { const size_t off = (size_t)(row0 + ai * HALF + m * 16) * ldc + col0;
#pragma unroll
                for (int bj = 0; bj < 2; ++bj)
#pragma unroll
                    for (int n = 0; n < 2; ++n) { const f32x4 bs = ld4(base + off + bj * HALF + n * 16); st4(out + off + bj * HALF + n * 16, bs + gv[bj][n] * acc[ai][bj][m][n]); }
                asm volatile("" ::: "memory"); }
    }
};
struct EpiLat {
    static constexpr bool PERM = false, AFTER_DRAIN = false;
    bf16_t* CQN; bf16_t* CKVN; unsigned char* KPE  ; const float* qag; const float* kvag; const float* kng; const float* rope; PG8_LAS float* P;
    __device__ __forceinline__ void operator()(const f32x4 (&acc)[2][2][4][2], const Unit& u, int wr, int wc, int, int) const {
        int ln = (int)__builtin_amdgcn_mbcnt_hi(~0u, __builtin_amdgcn_mbcnt_lo(~0u, 0u)); asm volatile("" : "+v"(ln)); const int fr = ln & 15, fq = ln >> 4;
        const int row0 = u.pm * BM + wr * 64 + fr;
#pragma unroll
        for (int ai = 0; ai < 2; ++ai)
#pragma unroll
            for (int m = 0; m < 4; ++m) { float s0 = 0.f, s1 = 0.f;
#pragma unroll
                for (int n = 0; n < 2; ++n) { const f32x4 a = acc[ai][0][m][n], b = acc[ai][1][m][n];
                    s0 += (a[0] * a[0] + a[1] * a[1]) + (a[2] * a[2] + a[3] * a[3]); s1 += (b[0] * b[0] + b[1] * b[1]) + (b[2] * b[2] + b[3] * b[3]); }
                s0 += __shfl_xor(s0, 16); s0 += __shfl_xor(s0, 32); s1 += __shfl_xor(s1, 16); s1 += __shfl_xor(s1, 32);
                if (fq == 0) { const int rl = ai * HALF + wr * 64 + m * 16 + fr; P[rl * 8 + wc] = s0; P[rl * 8 + 4 + wc] = s1; } }
        asm volatile("s_waitcnt lgkmcnt(0)" ::: "memory"); __builtin_amdgcn_s_barrier(); asm volatile("" ::: "memory");
        const int cl = wc * 32 + 4 * fq;
        if (u.pn == 0) {
            f32x4 g[2][2];
#pragma unroll
            for (int bj = 0; bj < 2; ++bj)
#pragma unroll
                for (int n = 0; n < 2; ++n) g[bj][n] = *(const f32x4*)(qag + bj * HALF + cl + 16 * n);
#pragma unroll
            for (int ai = 0; ai < 2; ++ai)
#pragma unroll
                for (int m = 0; m < 4; ++m) { const int rl = ai * HALF + wr * 64 + m * 16 + fr; const f32x4 pa = *(const PG8_LAS f32x4*)(P + rl * 8), pb = *(const PG8_LAS f32x4*)(P + rl * 8 + 4);
                    const float r = __builtin_amdgcn_rsqf((((pa[0] + pa[1]) + (pa[2] + pa[3])) + ((pb[0] + pb[1]) + (pb[2] + pb[3]))) * (1.f / 256.f) + 1e-6f);
                    bf16_t* rowp = CQN + (size_t)(row0 + ai * HALF + m * 16) * 256 + cl;
#pragma unroll
                    for (int bj = 0; bj < 2; ++bj)
#pragma unroll
                        for (int n = 0; n < 2; ++n) { const f32x4 v = acc[ai][bj][m][n] * r * g[bj][n]; u32x2 w; w.x = cvt_pk_bf16(v[0], v[1]); w.y = cvt_pk_bf16(v[2], v[3]); *(u32x2*)(rowp + bj * HALF + 16 * n) = w; } }
        } else {
            f32x4 gk[2], gp[2]; const int e0 = 16 * (wc & 1) + 4 * fq;
#pragma unroll
            for (int n = 0; n < 2; ++n) { gk[n] = *(const f32x4*)(kvag + cl + 16 * n); gp[n] = *(const f32x4*)(kng + 128 + e0 + 32 * n); }
#pragma unroll
            for (int ai = 0; ai < 2; ++ai)
#pragma unroll
                for (int m = 0; m < 4; ++m) { const int rl = ai * HALF + wr * 64 + m * 16 + fr; const f32x4 pa = *(const PG8_LAS f32x4*)(P + rl * 8), pb = *(const PG8_LAS f32x4*)(P + rl * 8 + 4);
                    const float rkv = __builtin_amdgcn_rsqf(((pa[0] + pa[1]) + (pa[2] + pa[3])) * (1.f / 128.f) + 1e-6f), rpe = __builtin_amdgcn_rsqf((pb[0] + pb[1]) * (1.f / 64.f) + 1e-6f);
                    const size_t row = (size_t)(row0 + ai * HALF + m * 16);
#pragma unroll
                    for (int n = 0; n < 2; ++n) { const f32x4 v = acc[ai][0][m][n] * rkv * gk[n]; u32x2 w; w.x = cvt_pk_bf16(v[0], v[1]); w.y = cvt_pk_bf16(v[2], v[3]); *(u32x2*)(CKVN + row * 128 + cl + 16 * n) = w; }
                    if (wc < 2) { const f32x4 x1 = acc[ai][1][m][0] * rpe * gp[0], x2 = acc[ai][1][m][1] * rpe * gp[1];
                        const f32x4 c0 = *(const f32x4*)(rope + row * 64 + e0 * 2), c1 = *(const f32x4*)(rope + row * 64 + e0 * 2 + 4);
                        const float cs[4] = {c0[0], c0[2], c1[0], c1[2]}, sn[4] = {c0[1], c0[3], c1[1], c1[3]};
                        float o1[4], o2[4];
#pragma unroll
                        for (int j = 0; j < 4; ++j) { o1[j] = x1[j] * cs[j] - x2[j] * sn[j]; o2[j] = x1[j] * sn[j] + x2[j] * cs[j]; }
                        int w1 = 0, w2 = 0; w1 = __builtin_amdgcn_cvt_pk_fp8_f32(o1[0], o1[1], w1, false); w1 = __builtin_amdgcn_cvt_pk_fp8_f32(o1[2], o1[3], w1, true); w2 = __builtin_amdgcn_cvt_pk_fp8_f32(o2[0], o2[1], w2, false); w2 = __builtin_amdgcn_cvt_pk_fp8_f32(o2[2], o2[3], w2, true);
                        *(int*)(KPE + row * 64 + e0) = w1; *(int*)(KPE + row * 64 + 32 + e0) = w2; }
                    asm volatile("" ::: "memory"); }
        }
        asm volatile("s_waitcnt lgkmcnt(0)" ::: "memory"); __builtin_amdgcn_s_barrier(); asm volatile("" ::: "memory");
    }
};
struct EpiK8 {
    static constexpr bool PERM = true, AFTER_DRAIN = false;
    unsigned char* K8; const float* kng; PG8_LAS float* P;
    __device__ __forceinline__ void operator()(const f32x4 (&acc)[2][2][4][2], const Unit& u, int wr, int wc, int, int) const {
        int ln = (int)__builtin_amdgcn_mbcnt_hi(~0u, __builtin_amdgcn_mbcnt_lo(~0u, 0u)); asm volatile("" : "+v"(ln)); const int fr = ln & 15, fq = ln >> 4;
#pragma unroll
        for (int ai = 0; ai < 2; ++ai)
#pragma unroll
            for (int m = 0; m < 4; ++m) {
#pragma unroll
                for (int bj = 0; bj < 2; ++bj) { const f32x4 a = acc[ai][bj][m][0], b = acc[ai][bj][m][1];
                    float s = (a[0] * a[0] + a[1] * a[1]) + (a[2] * a[2] + a[3] * a[3]) + (b[0] * b[0] + b[1] * b[1]) + (b[2] * b[2] + b[3] * b[3]);
                    s += __shfl_xor(s, 16); s += __shfl_xor(s, 32);
                    if (fq == 0) P[(ai * HALF + wr * 64 + m * 16 + fr) * 8 + bj * 4 + wc] = s; } }
        asm volatile("s_waitcnt lgkmcnt(0)" ::: "memory"); __builtin_amdgcn_s_barrier(); asm volatile("" ::: "memory");
        const f32x4 g0 = *(const f32x4*)(kng + wc * 32 + 8 * fq), g1 = *(const f32x4*)(kng + wc * 32 + 8 * fq + 4);
        const int row0 = u.pm * BM + wr * 64 + fr;
#pragma unroll
        for (int ai = 0; ai < 2; ++ai)
#pragma unroll
            for (int m = 0; m < 4; ++m) { const int rl = ai * HALF + wr * 64 + m * 16 + fr;
#pragma unroll
                for (int bj = 0; bj < 2; ++bj) { const f32x4 p4 = *(const PG8_LAS f32x4*)(P + rl * 8 + bj * 4);
                    const float r = __builtin_amdgcn_rsqf(((p4[0] + p4[1]) + (p4[2] + p4[3])) * (1.f / 128.f) + 1e-6f);
                    const f32x4 v0 = acc[ai][bj][m][0] * r * g0, v1 = acc[ai][bj][m][1] * r * g1;
                    int w0 = 0, w1 = 0; w0 = __builtin_amdgcn_cvt_pk_fp8_f32(v0[0], v0[1], w0, false); w0 = __builtin_amdgcn_cvt_pk_fp8_f32(v0[2], v0[3], w0, true); w1 = __builtin_amdgcn_cvt_pk_fp8_f32(v1[0], v1[1], w1, false); w1 = __builtin_amdgcn_cvt_pk_fp8_f32(v1[2], v1[3], w1, true);
                    u32x2 w; w.x = (unsigned)w0; w.y = (unsigned)w1; *(u32x2*)(K8 + ((size_t)(row0 + ai * HALF + m * 16) * 8 + 2 * u.pn + bj) * 128 + wc * 32 + 8 * fq) = w; } }
        asm volatile("s_waitcnt lgkmcnt(0)" ::: "memory"); __builtin_amdgcn_s_barrier(); asm volatile("" ::: "memory");
    }
};
struct EpiF8T {
    static constexpr bool PERM = true, AFTER_DRAIN = false;
    unsigned char* O; int ldc;
    __device__ __forceinline__ void operator()(const f32x4 (&acc)[2][2][4][2], const Unit& u, int wr, int wc, int fr, int fq) const {
        const int row0 = u.pm * BM + wr * 64 + fr, col0 = u.pn * BM + wc * 32 + 8 * fq;
#pragma unroll
        for (int ai = 0; ai < 2; ++ai)
#pragma unroll
            for (int m = 0; m < 4; ++m) { unsigned char* rowp = O + (size_t)(row0 + ai * HALF + m * 16) * ldc + col0;
#pragma unroll
                for (int bj = 0; bj < 2; ++bj) { const f32x4 v0 = acc[ai][bj][m][0], v1 = acc[ai][bj][m][1];
                    int w0 = 0, w1 = 0; w0 = __builtin_amdgcn_cvt_pk_fp8_f32(v0[0], v0[1], w0, false); w0 = __builtin_amdgcn_cvt_pk_fp8_f32(v0[2], v0[3], w0, true); w1 = __builtin_amdgcn_cvt_pk_fp8_f32(v1[0], v1[1], w1, false); w1 = __builtin_amdgcn_cvt_pk_fp8_f32(v1[2], v1[3], w1, true);
                    u32x2 w; w.x = (unsigned)w0; w.y = (unsigned)w1; *(u32x2*)(rowp + bj * HALF) = w; } }
    }
};
__device__ __forceinline__ void pair_of(int pi, int& i, int& j) { i = pi < 3 ? 0 : (pi < 5 ? 1 : 2); j = pi < 3 ? pi + 1 : (pi < 5 ? pi - 1 : 3); }
struct MoeOrder {
    const PG8_LAS int* tinfo; int G, c, mode; const int* list;
    __device__ __forceinline__ int tok(const Unit& u, int r) const { const int bk = tinfo[1 + u.pm], pos = u.pm * BM - tinfo[256 + bk] + r; return list[bk * 32768 + (pos < tinfo[288 + bk] ? pos : 0)]; }
    __device__ __forceinline__ bool next(int i, Unit& u) const {
        const long L = (long)i * G + c; const int nt = tinfo[0]; if (L >= 4L * nt) return false;
        const int mt = (int)(L >> 2), q = (int)(L & 3), bk = tinfo[1 + mt];
        u.pm = mt;
        if (mode == 0) { int ii, jj; pair_of(bk % 6, ii, jj); const int e = (bk / 6) * 4 + ((q >> 1) ? jj : ii); u.pn = e * 2 + (q & 1); }
        else u.pn = bk * 4 + q;
        return true;
    }
    __device__ __forceinline__ void a_ready(const Unit&) const {}
    __device__ __forceinline__ void done(const Unit&) const {}
};
struct EpiSwiGLU {
    static constexpr bool PERM = true, AFTER_DRAIN = false;
    bf16_t* H; const float* wl; const PG8_LAS int* tinfo;
    __device__ __forceinline__ void operator()(const f32x4 (&acc)[2][2][4][2], const Unit& u, int wr, int wc, int, int) const {
        int ln = (int)__builtin_amdgcn_mbcnt_hi(~0u, __builtin_amdgcn_mbcnt_lo(~0u, 0u)); asm volatile("" : "+v"(ln)); const int fr = ln & 15, fq = ln >> 4;
        const int bk = tinfo[1 + u.pm]; int ii, jj; pair_of(bk % 6, ii, jj);
        const int e = u.pn >> 1, hh = u.pn & 1, slot = (e == (bk / 6) * 4 + jj) ? 1 : 0;
        const int row0 = u.pm * BM + wr * 64 + fr, col0 = slot * 256 + hh * 128 + wc * 32 + 8 * fq;
#pragma unroll
        for (int ai = 0; ai < 2; ++ai)
#pragma unroll
            for (int m = 0; m < 4; ++m) { const int row = row0 + ai * HALF + m * 16, pos = row - tinfo[256 + bk]; const float w = pos < tinfo[288 + bk] ? wl[((size_t)bk * 32768 + pos) * 2 + slot] : 0.f;
                float a[8];
#pragma unroll
                for (int n = 0; n < 2; ++n)
#pragma unroll
                    for (int j = 0; j < 4; ++j) { const float g = acc[ai][0][m][n][j], up = acc[ai][1][m][n][j];
                        const float sg = g * __builtin_amdgcn_rcpf(1.0f + __builtin_amdgcn_exp2f(-1.4426950408889634f * g)); a[n * 4 + j] = sg * up * w; }
                u32x4 o; o.x = cvt_pk_bf16(a[0], a[1]); o.y = cvt_pk_bf16(a[2], a[3]); o.z = cvt_pk_bf16(a[4], a[5]); o.w = cvt_pk_bf16(a[6], a[7]);
                *(u32x4*)(H + (size_t)row * 512 + col0) = o; asm volatile("" ::: "memory"); }
    }
};
template <class TO> struct EpiMoeOut {
    static constexpr bool PERM = false, AFTER_DRAIN = false;
    const bf16_t* xr; TO* out; const float* gate; const int* list; const PG8_LAS int* tinfo;
    __device__ __forceinline__ void operator()(const f32x4 (&acc)[2][2][4][2], const Unit& u, int wr, int wc, int fr, int fq) const {
        const int bk = tinfo[1 + u.pm], r_end = tinfo[256 + bk] + tinfo[288 + bk];
        const int row0 = u.pm * BM + wr * 64 + fr, col0 = (u.pn & 3) * BM + wc * 32 + 4 * fq;
#pragma unroll
        for (int ai = 0; ai < 2; ++ai)
#pragma unroll
            for (int m = 0; m < 4; ++m) { const int row = row0 + ai * HALF + m * 16;
                if (row < r_end) { const int tok = list[bk * 32768 + row - tinfo[256 + bk]]; TO* op = out + (size_t)tok * 1024 + col0; const bf16_t* xp = xr + (size_t)tok * 1024 + col0; const float* gp = gate + (size_t)(tok >> 12) * 6144 + col0;
#pragma unroll
                    for (int bj = 0; bj < 2; ++bj)
#pragma unroll
                        for (int n = 0; n < 2; ++n) { const f32x4 bs = ld4(xp + bj * HALF + n * 16), gv = *(const f32x4*)(gp + bj * HALF + n * 16); st4(op + bj * HALF + n * 16, bs + gv * acc[ai][bj][m][n]); } }
                asm volatile("" ::: "memory"); }
    }
};
template <class Epi, class Sched, bool ALIGN_EPI = false, bool SP2 = false, int F8 = -1>
__device__ __forceinline__ void gemm_phase(PG8_LAS unsigned char* lds, const Gemm g, const Sched& S, const Epi& E, const int tid) {
    const int wid = __builtin_amdgcn_readfirstlane(tid >> 6), lane = tid & 63, wr = wid >> 2, wc = wid & 3, fr = lane & 15, fq = lane >> 4;
    int K = g.K; asm volatile("" : "+s"(K)); const int nt = K / BK;
    unsigned voffA[2], voffB[2];
#pragma unroll
    for (int i = 0; i < 2; ++i) { int R, C; stage_rc(tid * 16 + i * 8192, R, C); const int Rb = Epi::PERM ? ((R & ~31) + perm32(R & 31)) : R;
        voffA[i] = (unsigned)(R * K + C) * 2u; voffB[i] = (unsigned)(Rb * K + C) * 2u; }
    const size_t kstep = (size_t)(BK * 2);
    const size_t hstep = (size_t)HALF * K * 2;
    const size_t tstep = 2 * hstep;
    const unsigned ldsw = (unsigned)wid * 1024u;
    const int aoff = lds_byte(wr * 64 + fr, fq * 8), boff = lds_byte(wc * 32 + fr, fq * 8);
#define PG8_SA(b, h) (((b) * 2 + (h)) * HTB)
#define PG8_SB(b, h) ((4 + (b) * 2 + (h)) * HTB)
#define PG8_STAGE(bufoff, gbase, voff) do { _Pragma("unroll") for (int _i = 0; _i < 2; ++_i) \
        __builtin_amdgcn_global_load_lds((const unsigned*)((const char*)(gbase) + (voff)[_i]), (PG8_LAS unsigned*)(lds + (bufoff) + ldsw + _i * 8192), 16, 0, 0); } while (0)
#define PG8_LDA(dst, b, h) do { _Pragma("unroll") for (int m = 0; m < 4; ++m) _Pragma("unroll") for (int k = 0; k < 2; ++k) dst[m][k] = *(const PG8_LAS bf16x8*)(lds + PG8_SA(b, h) + aoff + m * 2048 + k * 1024); } while (0)
#define PG8_LDB(dst, b, h) do { _Pragma("unroll") for (int n = 0; n < 2; ++n) _Pragma("unroll") for (int k = 0; k < 2; ++k) dst[n][k] = *(const PG8_LAS bf16x8*)(lds + PG8_SB(b, h) + boff + n * 2048 + k * 1024); } while (0)
#define PG8_CAT(x0, x1) ({ const v4i_t lo_ = __builtin_bit_cast(v4i_t, x0), hi_ = __builtin_bit_cast(v4i_t, x1); (v8i_t){lo_[0], lo_[1], lo_[2], lo_[3], hi_[0], hi_[1], hi_[2], hi_[3]}; })
#define PG8_MMA(ai, bj, At, Bt) do { __builtin_amdgcn_s_setprio(1); _Pragma("unroll") for (int m = 0; m < 4; ++m) _Pragma("unroll") for (int n = 0; n < 2; ++n) { \
        if constexpr (F8 >= 0) acc[ai][bj][m][n] = __builtin_amdgcn_mfma_scale_f32_16x16x128_f8f6f4(PG8_CAT(Bt[n][0], Bt[n][1]), PG8_CAT(At[m][0], At[m][1]), acc[ai][bj][m][n], 0, 0, 0, 0x7f7f7f7f, 0, (127 - F8) * 0x01010101); \
        else { _Pragma("unroll") for (int k = 0; k < 2; ++k) acc[ai][bj][m][n] = __builtin_amdgcn_mfma_f32_16x16x32_bf16(Bt[n][k], At[m][k], acc[ai][bj][m][n], 0, 0, 0); } } \
        __builtin_amdgcn_s_setprio(0); } while (0)
#define PG8_WAIT_V(n) asm volatile("s_waitcnt vmcnt(" #n ")" ::: "memory")
#define PG8_WAIT_L(n) asm volatile("s_waitcnt lgkmcnt(" #n ")" ::: "memory")
#define PG8_BAR __builtin_amdgcn_s_barrier()
#define PG8_SCHED __builtin_amdgcn_sched_barrier(0)
    Unit cur, nxt; int ui = 0;
    if (!S.next(0, cur)) return;
    f32x4 acc[2][2][4][2];
#pragma unroll
    for (int a = 0; a < 2; ++a)
#pragma unroll
        for (int b = 0; b < 2; ++b)
#pragma unroll
            for (int m = 0; m < 4; ++m)
#pragma unroll
                for (int n = 0; n < 2; ++n) acc[a][b][m][n] = (f32x4){0.f, 0.f, 0.f, 0.f};
    bf16x8 At[4][2], B0[2][2], B1[2][2];
    const char* cA = (const char*)g.A + (size_t)cur.pm * tstep; const char* cB = (const char*)g.Bt + (size_t)cur.pn * tstep;
    S.a_ready(cur);
    if constexpr (SP2) {
        PG8_STAGE(PG8_SB(0, 0), cB, voffB); PG8_STAGE(PG8_SB(0, 1), cB + hstep, voffB); PG8_STAGE(PG8_SA(0, 0), cA, voffA); PG8_STAGE(PG8_SA(0, 1), cA + hstep, voffA);
        if (wr == 1) PG8_BAR;
        PG8_WAIT_V(2); PG8_BAR;
        PG8_STAGE(PG8_SB(1, 0), cB + kstep, voffB); PG8_STAGE(PG8_SA(1, 0), cA + kstep, voffA); PG8_STAGE(PG8_SB(1, 1), cB + hstep + kstep, voffB);
        PG8_WAIT_V(6); PG8_BAR;
    } else {
        PG8_STAGE(PG8_SB(0, 0), cB, voffB); PG8_STAGE(PG8_SA(0, 0), cA, voffA); PG8_STAGE(PG8_SB(0, 1), cB + hstep, voffB); PG8_STAGE(PG8_SA(0, 1), cA + hstep, voffA);
        if (wr == 1) PG8_BAR;
        PG8_WAIT_V(4); PG8_BAR;
        PG8_STAGE(PG8_SB(1, 0), cB + kstep, voffB); PG8_STAGE(PG8_SA(1, 0), cA + kstep, voffA); PG8_STAGE(PG8_SB(1, 1), cB + hstep + kstep, voffB);
        PG8_WAIT_V(6); PG8_BAR;
    }
    for (;;) {
        const bool has_next = S.next(ui + 1, nxt);
        const char* nA = has_next ? (const char*)g.A + (size_t)nxt.pm * tstep : cA; const char* nB = has_next ? (const char*)g.Bt + (size_t)nxt.pn * tstep : cB;
        for (int t = 0; t < nt; t += 2) {
            const bool last = (t == nt - 2);
            const char* a1 = cA + (size_t)(t + 1) * kstep;
            const char* a2 = last ? nA : cA + (size_t)(t + 2) * kstep; const char* b2 = last ? nB : cB + (size_t)(t + 2) * kstep;
            const char* a3 = a2 + kstep; const char* b3 = b2 + kstep;
            if (last && has_next) S.a_ready(nxt);
            if constexpr (SP2) {
            PG8_LDB(B0, 0, 0); PG8_LDB(B1, 0, 1); PG8_SCHED; PG8_LDA(At, 0, 0); PG8_STAGE(PG8_SA(1, 1), a1 + hstep, voffA);
            PG8_WAIT_V(8); PG8_WAIT_L(0); PG8_BAR; PG8_MMA(0, 0, At, B0); PG8_MMA(0, 1, At, B1); PG8_BAR; PG8_SCHED;
            PG8_LDA(At, 0, 1); PG8_STAGE(PG8_SB(0, 0), b2, voffB); PG8_STAGE(PG8_SB(0, 1), b2 + hstep, voffB); PG8_STAGE(PG8_SA(0, 0), a2, voffA);
            PG8_WAIT_V(8); PG8_WAIT_L(0); PG8_BAR; PG8_MMA(1, 0, At, B0); PG8_MMA(1, 1, At, B1); PG8_BAR; PG8_SCHED;
            PG8_LDB(B0, 1, 0); PG8_LDB(B1, 1, 1); PG8_SCHED; PG8_LDA(At, 1, 0); PG8_STAGE(PG8_SA(0, 1), a2 + hstep, voffA);
            PG8_WAIT_V(8); PG8_WAIT_L(0); PG8_BAR; PG8_MMA(0, 0, At, B0); PG8_MMA(0, 1, At, B1); PG8_BAR; PG8_SCHED;
            PG8_LDA(At, 1, 1); PG8_STAGE(PG8_SB(1, 0), b3, voffB); PG8_STAGE(PG8_SB(1, 1), b3 + hstep, voffB); PG8_STAGE(PG8_SA(1, 0), a3, voffA);
            PG8_WAIT_V(8); PG8_WAIT_L(0); PG8_BAR; PG8_MMA(1, 0, At, B0); PG8_MMA(1, 1, At, B1); PG8_BAR; PG8_SCHED;
            } else {
            PG8_LDB(B0, 0, 0); PG8_SCHED; PG8_LDA(At, 0, 0); PG8_STAGE(PG8_SA(1, 1), a1 + hstep, voffA);
            PG8_WAIT_L(8); PG8_BAR; PG8_WAIT_L(0); PG8_MMA(0, 0, At, B0); PG8_BAR; PG8_SCHED;
            PG8_LDB(B1, 0, 1); PG8_STAGE(PG8_SB(0, 0), b2, voffB);
            PG8_BAR; PG8_WAIT_L(0); PG8_MMA(0, 1, At, B1); PG8_BAR;
            PG8_LDA(At, 0, 1); PG8_STAGE(PG8_SA(0, 0), a2, voffA);
            PG8_BAR; PG8_WAIT_L(0); PG8_MMA(1, 0, At, B0); PG8_BAR; PG8_SCHED;
            PG8_STAGE(PG8_SB(0, 1), b2 + hstep, voffB);
            PG8_WAIT_V(6); PG8_BAR; PG8_MMA(1, 1, At, B1); PG8_BAR;
            PG8_LDB(B0, 1, 0); PG8_SCHED; PG8_LDA(At, 1, 0); PG8_STAGE(PG8_SA(0, 1), a2 + hstep, voffA);
            PG8_WAIT_L(8); PG8_BAR; PG8_WAIT_L(0); PG8_MMA(0, 0, At, B0); PG8_BAR; PG8_SCHED;
            PG8_LDB(B1, 1, 1); PG8_STAGE(PG8_SB(1, 0), b3, voffB);
            PG8_BAR; PG8_WAIT_L(0); PG8_MMA(0, 1, At, B1); PG8_BAR;
            PG8_LDA(At, 1, 1); PG8_STAGE(PG8_SA(1, 0), a3, voffA);
            PG8_BAR; PG8_WAIT_L(0); PG8_MMA(1, 0, At, B0); PG8_BAR; PG8_SCHED;
            PG8_STAGE(PG8_SB(1, 1), b3 + hstep, voffB);
            PG8_WAIT_V(6); PG8_BAR; PG8_MMA(1, 1, At, B1); PG8_BAR;
            }
        }
        if constexpr (ALIGN_EPI) { if (wr == 0) PG8_BAR; }
        if constexpr (!Epi::AFTER_DRAIN) { E(acc, cur, wr, wc, fr, fq); S.done(cur); }
        if (!has_next) break;
#pragma unroll
        for (int a = 0; a < 2; ++a)
#pragma unroll
            for (int b = 0; b < 2; ++b)
#pragma unroll
                for (int m = 0; m < 4; ++m)
#pragma unroll
                    for (int n = 0; n < 2; ++n) acc[a][b][m][n] = (f32x4){0.f, 0.f, 0.f, 0.f};
        cur = nxt; cA = nA; cB = nB; ++ui;
        if constexpr (ALIGN_EPI) { if (wr == 1) PG8_BAR; }
    }
    PG8_WAIT_V(0);
    if constexpr (!ALIGN_EPI) { if (wr == 0) PG8_BAR; }
    PG8_BAR;
    if constexpr (Epi::AFTER_DRAIN) { E.fused(acc, cur, wr, wc, fr, fq, lds, wid, lane); S.done(cur); }
#undef PG8_SA
#undef PG8_SB
#undef PG8_STAGE
#undef PG8_LDA
#undef PG8_LDB
#undef PG8_MMA
#undef PG8_WAIT_V
#undef PG8_WAIT_L
#undef PG8_BAR
#undef PG8_SCHED
}
template <class Epi, class Sched, bool ALIGN_EPI = true, bool SP2 = true, int F8 = -1>
__device__ __forceinline__ void gemm_phase_gather(PG8_LAS unsigned char* lds, const Gemm g, const Sched& S, const Epi& E, const int tid) {
    static_assert(SP2, "gather form: SP2 loop only");
    const int wid = __builtin_amdgcn_readfirstlane(tid >> 6), lane = tid & 63, wr = wid >> 2, wc = wid & 3, fr = lane & 15, fq = lane >> 4;
    int K = g.K; asm volatile("" : "+s"(K)); const int nt = K / BK;
    unsigned voffA[2], voffB[2];
#pragma unroll
    for (int i = 0; i < 2; ++i) { int R, C; stage_rc(tid * 16 + i * 8192, R, C); const int Rb = Epi::PERM ? ((R & ~31) + perm32(R & 31)) : R;
        voffA[i] = (unsigned)(R * K + C) * 2u; voffB[i] = (unsigned)(Rb * K + C) * 2u; }
    int gR, gC; stage_rc(tid * 16, gR, gC);
    unsigned vG[2][2], vN[2][2];
    const size_t kstep = (size_t)(BK * 2);
    const size_t hstep = (size_t)HALF * K * 2;
    const size_t tstep = 2 * hstep;
    const unsigned ldsw = (unsigned)wid * 1024u;
    const int aoff = lds_byte(wr * 64 + fr, fq * 8), boff = lds_byte(wc * 32 + fr, fq * 8);
#define PG8_SA(b, h) (((b) * 2 + (h)) * HTB)
#define PG8_SB(b, h) ((4 + (b) * 2 + (h)) * HTB)
#define PG8_STAGE(bufoff, gbase, voff) do { _Pragma("unroll") for (int _i = 0; _i < 2; ++_i) \
        __builtin_amdgcn_global_load_lds((const unsigned*)((const char*)(gbase) + (voff)[_i]), (PG8_LAS unsigned*)(lds + (bufoff) + ldsw + _i * 8192), 16, 0, 0); } while (0)
#define PG8_LDA(dst, b, h) do { _Pragma("unroll") for (int m = 0; m < 4; ++m) _Pragma("unroll") for (int k = 0; k < 2; ++k) dst[m][k] = *(const PG8_LAS bf16x8*)(lds + PG8_SA(b, h) + aoff + m * 2048 + k * 1024); } while (0)
#define PG8_LDB(dst, b, h) do { _Pragma("unroll") for (int n = 0; n < 2; ++n) _Pragma("unroll") for (int k = 0; k < 2; ++k) dst[n][k] = *(const PG8_LAS bf16x8*)(lds + PG8_SB(b, h) + boff + n * 2048 + k * 1024); } while (0)
#define PG8_CAT(x0, x1) ({ const v4i_t lo_ = __builtin_bit_cast(v4i_t, x0), hi_ = __builtin_bit_cast(v4i_t, x1); (v8i_t){lo_[0], lo_[1], lo_[2], lo_[3], hi_[0], hi_[1], hi_[2], hi_[3]}; })
#define PG8_MMA(ai, bj, At, Bt) do { __builtin_amdgcn_s_setprio(1); _Pragma("unroll") for (int m = 0; m < 4; ++m) _Pragma("unroll") for (int n = 0; n < 2; ++n) { \
        if constexpr (F8 >= 0) acc[ai][bj][m][n] = __builtin_amdgcn_mfma_scale_f32_16x16x128_f8f6f4(PG8_CAT(Bt[n][0], Bt[n][1]), PG8_CAT(At[m][0], At[m][1]), acc[ai][bj][m][n], 0, 0, 0, 0x7f7f7f7f, 0, (127 - F8) * 0x01010101); \
        else { _Pragma("unroll") for (int k = 0; k < 2; ++k) acc[ai][bj][m][n] = __builtin_amdgcn_mfma_f32_16x16x32_bf16(Bt[n][k], At[m][k], acc[ai][bj][m][n], 0, 0, 0); } } \
        __builtin_amdgcn_s_setprio(0); } while (0)
#define PG8_WAIT_V(n) asm volatile("s_waitcnt vmcnt(" #n ")" ::: "memory")
#define PG8_WAIT_L(n) asm volatile("s_waitcnt lgkmcnt(" #n ")" ::: "memory")
#define PG8_BAR __builtin_amdgcn_s_barrier()
#define PG8_SCHED __builtin_amdgcn_sched_barrier(0)
    Unit cur, nxt; int ui = 0;
    if (!S.next(0, cur)) return;
    f32x4 acc[2][2][4][2];
#pragma unroll
    for (int a = 0; a < 2; ++a)
#pragma unroll
        for (int b = 0; b < 2; ++b)
#pragma unroll
            for (int m = 0; m < 4; ++m)
#pragma unroll
                for (int n = 0; n < 2; ++n) acc[a][b][m][n] = (f32x4){0.f, 0.f, 0.f, 0.f};
    bf16x8 At[4][2], B0[2][2], B1[2][2];
    const char* cA = (const char*)g.A; const char* cB = (const char*)g.Bt + (size_t)cur.pn * tstep;
    S.a_ready(cur);
#pragma unroll
    for (int h = 0; h < 2; ++h)
#pragma unroll
        for (int i = 0; i < 2; ++i) vG[h][i] = (unsigned)S.tok(cur, h * HALF + gR + 64 * i) * (unsigned)(K * 2) + (unsigned)(gC * 2);
    if constexpr (SP2) {
        PG8_STAGE(PG8_SB(0, 0), cB, voffB); PG8_STAGE(PG8_SB(0, 1), cB + hstep, voffB); PG8_STAGE(PG8_SA(0, 0), cA, vG[0]); PG8_STAGE(PG8_SA(0, 1), cA, vG[1]);
        if (wr == 1) PG8_BAR;
        PG8_WAIT_V(2); PG8_BAR;
        PG8_STAGE(PG8_SB(1, 0), cB + kstep, voffB); PG8_STAGE(PG8_SA(1, 0), cA + kstep, vG[0]); PG8_STAGE(PG8_SB(1, 1), cB + hstep + kstep, voffB);
        PG8_WAIT_V(6); PG8_BAR;
    } else {
        PG8_STAGE(PG8_SB(0, 0), cB, voffB); PG8_STAGE(PG8_SA(0, 0), cA, voffA); PG8_STAGE(PG8_SB(0, 1), cB + hstep, voffB); PG8_STAGE(PG8_SA(0, 1), cA + hstep, voffA);
        if (wr == 1) PG8_BAR;
        PG8_WAIT_V(4); PG8_BAR;
        PG8_STAGE(PG8_SB(1, 0), cB + kstep, voffB); PG8_STAGE(PG8_SA(1, 0), cA + kstep, voffA); PG8_STAGE(PG8_SB(1, 1), cB + hstep + kstep, voffB);
        PG8_WAIT_V(6); PG8_BAR;
    }
    for (;;) {
        const bool has_next = S.next(ui + 1, nxt);
        const char* nA = cA; const char* nB = has_next ? (const char*)g.Bt + (size_t)nxt.pn * tstep : cB;
        for (int t = 0; t < nt; t += 2) {
            const bool last = (t == nt - 2);
            const char* a1 = cA + (size_t)(t + 1) * kstep;
            const char* a2 = last ? nA : cA + (size_t)(t + 2) * kstep; const char* b2 = last ? nB : cB + (size_t)(t + 2) * kstep;
            const char* a3 = a2 + kstep; const char* b3 = b2 + kstep;
            if (last && has_next) { S.a_ready(nxt);
#pragma unroll
                for (int h = 0; h < 2; ++h)
#pragma unroll
                    for (int i = 0; i < 2; ++i) vN[h][i] = (unsigned)S.tok(nxt, h * HALF + gR + 64 * i) * (unsigned)(K * 2) + (unsigned)(gC * 2); }
            if constexpr (SP2) {
            PG8_LDB(B0, 0, 0); PG8_LDB(B1, 0, 1); PG8_SCHED; PG8_LDA(At, 0, 0); PG8_STAGE(PG8_SA(1, 1), a1, vG[1]);
            if (last && has_next) { vG[0][0] = vN[0][0]; vG[0][1] = vN[0][1]; vG[1][0] = vN[1][0]; vG[1][1] = vN[1][1]; }
            PG8_WAIT_V(8); PG8_WAIT_L(0); PG8_BAR; PG8_MMA(0, 0, At, B0); PG8_MMA(0, 1, At, B1); PG8_BAR; PG8_SCHED;
            PG8_LDA(At, 0, 1); PG8_STAGE(PG8_SB(0, 0), b2, voffB); PG8_STAGE(PG8_SB(0, 1), b2 + hstep, voffB); PG8_STAGE(PG8_SA(0, 0), a2, vG[0]);
            PG8_WAIT_V(8); PG8_WAIT_L(0); PG8_BAR; PG8_MMA(1, 0, At, B0); PG8_MMA(1, 1, At, B1); PG8_BAR; PG8_SCHED;
            PG8_LDB(B0, 1, 0); PG8_LDB(B1, 1, 1); PG8_SCHED; PG8_LDA(At, 1, 0); PG8_STAGE(PG8_SA(0, 1), a2, vG[1]);
            PG8_WAIT_V(8); PG8_WAIT_L(0); PG8_BAR; PG8_MMA(0, 0, At, B0); PG8_MMA(0, 1, At, B1); PG8_BAR; PG8_SCHED;
            PG8_LDA(At, 1, 1); PG8_STAGE(PG8_SB(1, 0), b3, voffB); PG8_STAGE(PG8_SB(1, 1), b3 + hstep, voffB); PG8_STAGE(PG8_SA(1, 0), a3, vG[0]);
            PG8_WAIT_V(8); PG8_WAIT_L(0); PG8_BAR; PG8_MMA(1, 0, At, B0); PG8_MMA(1, 1, At, B1); PG8_BAR; PG8_SCHED;
            } else {
            PG8_LDB(B0, 0, 0); PG8_SCHED; PG8_LDA(At, 0, 0); PG8_STAGE(PG8_SA(1, 1), a1 + hstep, voffA);
            PG8_WAIT_L(8); PG8_BAR; PG8_WAIT_L(0); PG8_MMA(0, 0, At, B0); PG8_BAR; PG8_SCHED;
            PG8_LDB(B1, 0, 1); PG8_STAGE(PG8_SB(0, 0), b2, voffB);
            PG8_BAR; PG8_WAIT_L(0); PG8_MMA(0, 1, At, B1); PG8_BAR;
            PG8_LDA(At, 0, 1); PG8_STAGE(PG8_SA(0, 0), a2, voffA);
            PG8_BAR; PG8_WAIT_L(0); PG8_MMA(1, 0, At, B0); PG8_BAR; PG8_SCHED;
            PG8_STAGE(PG8_SB(0, 1), b2 + hstep, voffB);
            PG8_WAIT_V(6); PG8_BAR; PG8_MMA(1, 1, At, B1); PG8_BAR;
            PG8_LDB(B0, 1, 0); PG8_SCHED; PG8_LDA(At, 1, 0); PG8_STAGE(PG8_SA(0, 1), a2 + hstep, voffA);
            PG8_WAIT_L(8); PG8_BAR; PG8_WAIT_L(0); PG8_MMA(0, 0, At, B0); PG8_BAR; PG8_SCHED;
            PG8_LDB(B1, 1, 1); PG8_STAGE(PG8_SB(1, 0), b3, voffB);
            PG8_BAR; PG8_WAIT_L(0); PG8_MMA(0, 1, At, B1); PG8_BAR;
            PG8_LDA(At, 1, 1); PG8_STAGE(PG8_SA(1, 0), a3, voffA);
            PG8_BAR; PG8_WAIT_L(0); PG8_MMA(1, 0, At, B0); PG8_BAR; PG8_SCHED;
            PG8_STAGE(PG8_SB(1, 1), b3 + hstep, voffB);
            PG8_WAIT_V(6); PG8_BAR; PG8_MMA(1, 1, At, B1); PG8_BAR;
            }
        }
        if constexpr (ALIGN_EPI) { if (wr == 0) PG8_BAR; }
        if constexpr (!Epi::AFTER_DRAIN) { E(acc, cur, wr, wc, fr, fq); S.done(cur); }
        if (!has_next) break;
#pragma unroll
        for (int a = 0; a < 2; ++a)
#pragma unroll
            for (int b = 0; b < 2; ++b)
#pragma unroll
                for (int m = 0; m < 4; ++m)
#pragma unroll
                    for (int n = 0; n < 2; ++n) acc[a][b][m][n] = (f32x4){0.f, 0.f, 0.f, 0.f};
        cur = nxt; cA = nA; cB = nB; ++ui;
        if constexpr (ALIGN_EPI) { if (wr == 1) PG8_BAR; }
    }
    PG8_WAIT_V(0);
    if constexpr (!ALIGN_EPI) { if (wr == 0) PG8_BAR; }
    PG8_BAR;
    if constexpr (Epi::AFTER_DRAIN) { E.fused(acc, cur, wr, wc, fr, fq, lds, wid, lane); S.done(cur); }
#undef PG8_SA
#undef PG8_SB
#undef PG8_STAGE
#undef PG8_LDA
#undef PG8_LDB
#undef PG8_MMA
#undef PG8_WAIT_V
#undef PG8_WAIT_L
#undef PG8_BAR
#undef PG8_SCHED
}
}
namespace att {
typedef unsigned short bf16;
using bf16x8 = __attribute__((ext_vector_type(8))) short;
using s16x4  = __attribute__((ext_vector_type(4))) short;
using f32x16 = __attribute__((ext_vector_type(16))) float;
using u32x4  = __attribute__((ext_vector_type(4))) unsigned;
using f32x4_t = __attribute__((ext_vector_type(4))) float;
constexpr int NW = 8, QBLK = 32, KVBLK = 64, SEQ = 4096;
constexpr int LDQ = 1536, LDKV = 2048, LDO = 1024;
constexpr int SHM_VT = 128 * 80, SHM_K8 = 64 * 208;
constexpr int OFF_V = 0, OFF_K8 = 3 * SHM_VT, OFF_WS = OFF_K8 + 2 * SHM_K8, LDS_BYTES = OFF_WS + NW * 64 * 4 + 64;
typedef int v8i32 __attribute__((ext_vector_type(8)));
typedef int v4i32 __attribute__((ext_vector_type(4)));
typedef int v2i32 __attribute__((ext_vector_type(2)));
constexpr int T_TOK = 8 * SEQ;
#define ASBAR() __builtin_amdgcn_sched_barrier(0)
__device__ __forceinline__ int crow(int r, int hi) { return (r & 3) + 8 * (r >> 2) + 4 * hi; }
__device__ __forceinline__ unsigned cvtpk(float lo, float hi) { unsigned r; asm volatile("v_cvt_pk_bf16_f32 %0, %1, %2" : "=v"(r) : "v"(lo), "v"(hi)); return r; }
__device__ __forceinline__ float bf2f(unsigned short b) { return __uint_as_float(((unsigned)b) << 16); }
template <bool SHIFT> __device__ __forceinline__ void smA(f32x16& p0, float negm) { for (int r = 0; r < 16; ++r) p0[r] = __builtin_amdgcn_exp2f(SHIFT ? p0[r] + negm : p0[r]); }
template <bool SHIFT> __device__ __forceinline__ void smB(f32x16& p0, f32x16& p1, float& l_reg, v8i32& p8, float negm) {
  for (int r = 0; r < 16; ++r) p1[r] = __builtin_amdgcn_exp2f(SHIFT ? p1[r] + negm : p1[r]);
  float ps = 0; for (int r = 0; r < 16; ++r) ps += p0[r]; for (int r = 0; r < 16; ++r) ps += p1[r];
  l_reg += ps;
#pragma unroll
  for (int w = 0; w < 4; ++w) { int a = 0, bq = 0;
    a = __builtin_amdgcn_cvt_pk_bf8_f32(p0[4 * w], p0[4 * w + 1], a, false); a = __builtin_amdgcn_cvt_pk_bf8_f32(p0[4 * w + 2], p0[4 * w + 3], a, true);
    bq = __builtin_amdgcn_cvt_pk_bf8_f32(p1[4 * w], p1[4 * w + 1], bq, false); bq = __builtin_amdgcn_cvt_pk_bf8_f32(p1[4 * w + 2], p1[4 * w + 3], bq, true);
    p8[w] = a; p8[4 + w] = bq; }
}
template <bool SHIFT> __device__ __forceinline__ void qkt(f32x16& p0, f32x16& p1, const char* K8, const v8i32* q8, float negm, int r32, int hi) {
  p0 = f32x16{}; p1 = f32x16{};
#define K8RD(m, half, part) (*reinterpret_cast<const v4i32*>(K8 + ((half) * 32 + r32) * 208 + (m) * 64 + hi * 32 + (part) * 16))
#define K8FR(m, half) ({ const v4i32 lo_ = K8RD(m, half, 0), hi_ = K8RD(m, half, 1); (v8i32){lo_[0], lo_[1], lo_[2], lo_[3], hi_[0], hi_[1], hi_[2], hi_[3]}; })
  v8i32 a0 = K8FR(0, 0), a1 = K8FR(0, 1), b0 = K8FR(1, 0), b1 = K8FR(1, 1);
  ASBAR();
  p0 = __builtin_amdgcn_mfma_scale_f32_32x32x64_f8f6f4(a0, q8[0], p0, 0, 0, 0, 0x7f7f7f7f, 0, 0x7f7f7f7f);
  p1 = __builtin_amdgcn_mfma_scale_f32_32x32x64_f8f6f4(a1, q8[0], p1, 0, 0, 0, 0x7f7f7f7f, 0, 0x7f7f7f7f);
  a0 = K8FR(2, 0); a1 = K8FR(2, 1);
  ASBAR();
  p0 = __builtin_amdgcn_mfma_scale_f32_32x32x64_f8f6f4(b0, q8[1], p0, 0, 0, 0, 0x7f7f7f7f, 0, 0x7f7f7f7f);
  p1 = __builtin_amdgcn_mfma_scale_f32_32x32x64_f8f6f4(b1, q8[1], p1, 0, 0, 0, 0x7f7f7f7f, 0, 0x7f7f7f7f);
  ASBAR();
  p0 = __builtin_amdgcn_mfma_scale_f32_32x32x64_f8f6f4(a0, q8[2], p0, 0, 0, 0, 0x7f7f7f7f, 0, 0x7f7f7f7f);
  p1 = __builtin_amdgcn_mfma_scale_f32_32x32x64_f8f6f4(a1, q8[2], p1, 0, 0, 0, 0x7f7f7f7f, 0, 0x7f7f7f7f);
  ASBAR();
#undef K8RD
#undef K8FR
}
__device__ __forceinline__ void pv_d0(f32x16* o, const char* VT, v8i32 p8, int r32, int hi) {
#define VTFR(d0) ({ const v4i32 lo_ = *reinterpret_cast<const v4i32*>(VT + ((d0) * 32 + r32) * 80 + hi * 32), hi_ = *reinterpret_cast<const v4i32*>(VT + ((d0) * 32 + r32) * 80 + hi * 32 + 16); (v8i32){lo_[0], lo_[1], lo_[2], lo_[3], hi_[0], hi_[1], hi_[2], hi_[3]}; })
#define PVMMA(d0, fr) o[d0] = __builtin_amdgcn_mfma_scale_f32_32x32x64_f8f6f4(p8, fr, o[d0], 1  , 0  , 0, 0x7f7f7f7f, 0, 0x7f7f7f7f)
  v8i32 fa = VTFR(0), fb = VTFR(1);
  ASBAR();
  PVMMA(0, fa); fa = VTFR(2); ASBAR();
  PVMMA(1, fb); fb = VTFR(3); ASBAR();
  PVMMA(2, fa); PVMMA(3, fb); ASBAR();
#undef VTFR
#undef PVMMA
}
template <bool SHIFT> __device__ __forceinline__ bool attn_unit(int b, int h, int s0, const bf16* Qraw, const unsigned char* __restrict__ VT8g, const unsigned char* __restrict__ K8g, const unsigned char* __restrict__ KP8g, bf16* __restrict__ O,
                                          const float* rope, const float* qg, float smaxC, char* lds, int tid) {
  asm volatile("" : "+v"(tid));
  const int wid = __builtin_amdgcn_readfirstlane(tid >> 6), lane = tid & 63, r32 = lane & 31, hi = lane >> 5;
  asm volatile("" : "+s"(qg));
  char* V_lds = lds + OFF_V; char* K8_lds = lds + OFF_K8;
  float* ws = (float*)(lds + OFF_WS) + wid * 64; float* li_l = ws;
  constexpr float C = 0.072168783648703220f * 1.4426950408889634f;
  v8i32 q8[3];
  {
    typedef __attribute__((address_space(1))) const bf16x8 gbf16x8; typedef __attribute__((address_space(1))) const f32x4_t gf32x4;
    const long trow = (long)b * SEQ + s0 + wid * QBLK + r32;
    unsigned qo = (unsigned)((trow * LDQ + h * 192) * 2); const unsigned ro = (unsigned)(trow * 256), go = (unsigned)(hi * 128);
#define Qn_(i) (*(gbf16x8*)((const char*)Qraw + qo + hi * 64 + (i) * 16))
#define Qr_(i) (*(gbf16x8*)((const char*)Qraw + qo + 256 + (i) * 16))
#define rp4_(i) (*(gf32x4*)((const char*)rope + ro + (i) * 16))
#define qgn_(i) (*(gf32x4*)((const char*)qg + go + (i) * 16))
#define qgr_(i) (*(gf32x4*)((const char*)qg + 512 + (i) * 16))
    float ssn = 0.f, ssp = 0.f;
#pragma unroll
    for (int c = 0; c < 8; ++c) { const bf16x8 a = Qn_((c >> 2) * 8 + (c & 3)), r = Qr_(c);
#pragma unroll
      for (int j = 0; j < 8; ++j) { const float f = bf2f((unsigned short)a[j]), g = bf2f((unsigned short)r[j]); ssn += f * f; ssp += g * g; } }
    ssn += __shfl_xor(ssn, 32);
    const float rn = rsqrtf(ssn * (1.f / 128.f) + 1e-6f) * C, rp = rsqrtf(ssp * (1.f / 64.f) + 1e-6f) * C;
    { float rn_ = rn, rp_ = rp; asm volatile("" : "+v"(qo), "+v"(rn_), "+v"(rp_) :: "memory"); }
#pragma unroll
    for (int m = 0; m < 2; ++m)
#pragma unroll
      for (int c = 0; c < 4; ++c) { const bf16x8 raw = Qn_(8 * m + c); const f32x4_t ga = qgn_(16 * m + 2 * c), gb = qgn_(16 * m + 2 * c + 1); float g[8];
#pragma unroll
        for (int j = 0; j < 8; ++j) g[j] = bf2f((unsigned short)raw[j]) * rn * (j < 4 ? ga[j & 3] : gb[j & 3]);
        int w0 = 0, w1 = 0; w0 = __builtin_amdgcn_cvt_pk_fp8_f32(g[0], g[1], w0, false); w0 = __builtin_amdgcn_cvt_pk_fp8_f32(g[2], g[3], w0, true);
        w1 = __builtin_amdgcn_cvt_pk_fp8_f32(g[4], g[5], w1, false); w1 = __builtin_amdgcn_cvt_pk_fp8_f32(g[6], g[7], w1, true);
        asm volatile("" : "+v"(w0), "+v"(w1) :: "memory");        q8[m][2 * c] = w0; q8[m][2 * c + 1] = w1; }
#pragma unroll
    for (int c = 0; c < 4; ++c) {
      const bf16x8 r1 = Qr_(c), r2 = Qr_(4 + c);
      const f32x4_t g1a = qgr_(2 * c), g1b = qgr_(2 * c + 1), g2a = qgr_(8 + 2 * c), g2b = qgr_(8 + 2 * c + 1); float ov[8];
#pragma unroll
      for (int j = 0; j < 8; ++j) { const f32x4_t cs4 = rp4_(4 * c + (j >> 1));
        const float cs = cs4[(j & 1) * 2], sn = cs4[(j & 1) * 2 + 1];
        const float x1 = bf2f((unsigned short)r1[j]) * rp * (j < 4 ? g1a[j & 3] : g1b[j & 3]), x2 = bf2f((unsigned short)r2[j]) * rp * (j < 4 ? g2a[j & 3] : g2b[j & 3]);
        ov[j] = hi == 0 ? (x1 * cs - x2 * sn) : (x1 * sn + x2 * cs); }
      int w0 = 0, w1 = 0; w0 = __builtin_amdgcn_cvt_pk_fp8_f32(ov[0], ov[1], w0, false); w0 = __builtin_amdgcn_cvt_pk_fp8_f32(ov[2], ov[3], w0, true);
      w1 = __builtin_amdgcn_cvt_pk_fp8_f32(ov[4], ov[5], w1, false); w1 = __builtin_amdgcn_cvt_pk_fp8_f32(ov[6], ov[7], w1, true);
      asm volatile("" : "+v"(w0), "+v"(w1) :: "memory"); q8[2][2 * c] = w0; q8[2][2 * c + 1] = w1; }
  #undef Qn_
#undef Qr_
#undef rp4_
#undef qgn_
#undef qgr_
  }
  const float negm = 15.0f - smaxC;
  float l_reg = 0.f; f32x16 o[4] = {};
  const char* Vg = (const char*)(VT8g + (size_t)h * 128 * T_TOK + (size_t)b * SEQ); const char* Kg = (const char*)(K8g + ((long)b * SEQ * 8 + h) * 128); const char* Pg = (const char*)(KP8g + (long)b * SEQ * 64);
  const int vc = tid >> 2, vq = tid & 3, vst = vc * 80 + 16 * (vq >> 1) + 8 * (vq & 1); const unsigned gvt = (unsigned)vc * (unsigned)T_TOK + 16u * (unsigned)vq;
  const int kr = tid >> 3, kc = tid & 7, kst = kr * 208 + kc * 16; const unsigned gk8 = (unsigned)(kr * 1024 + kc * 16);
  const int pr = (tid & 255) >> 2, pc = tid & 3, pst = pr * 208 + 128 + pc * 16; const unsigned gp8 = (unsigned)(pr * 64 + pc * 16);
  v4i32 s_v, s_k, s_p;
#define SLOAD(k0) do { s_v = *reinterpret_cast<const v4i32*>(Vg + (size_t)(k0) + gvt); \
    s_k = *reinterpret_cast<const v4i32*>(Kg + (size_t)(k0) * 1024 + gk8); if (tid < 256) s_p = *reinterpret_cast<const v4i32*>(Pg + (size_t)(k0) * 64 + gp8); } while (0)
#define SWRITE(kbuf, vbuf_) do { { v2i32 a_ = {s_v[0], s_v[2]}, b_ = {s_v[1], s_v[3]}; *(v2i32*)(V_lds + (vbuf_) * SHM_VT + vst) = a_; *(v2i32*)(V_lds + (vbuf_) * SHM_VT + vst + 32) = b_; } \
    *(v4i32*)(K8_lds + (kbuf) * SHM_K8 + kst) = s_k; if (tid < 256) *(v4i32*)(K8_lds + (kbuf) * SHM_K8 + pst) = s_p; } while (0)
  constexpr int NT = SEQ / KVBLK;
  v8i32 p8;
  SLOAD(0); SWRITE(0, 0); __syncthreads(); SLOAD(KVBLK);
  if (wid < 4) {
    for (int j = 0, kb = 0, vbuf = 0, vnx = 1; j < NT; ++j) {
      f32x16 p0, p1;
      qkt<SHIFT>(p0, p1, K8_lds + kb * SHM_K8, q8, negm, r32, hi);
      smA<SHIFT>(p0, negm); smB<SHIFT>(p0, p1, l_reg, p8, negm); ASBAR();
      pv_d0(o, V_lds + vbuf * SHM_VT, p8, r32, hi);
      if (j + 1 < NT) SWRITE(kb ^ 1, vnx);
      __syncthreads();
      if (j + 2 < NT) SLOAD((j + 2) * KVBLK);
      kb ^= 1; vbuf = vnx; vnx = vnx == 2 ? 0 : vnx + 1;
    }
  } else {
    int vprev = 0;
    __builtin_amdgcn_s_setprio(1);
    for (int j = 0, kb = 0, vbuf = 0, vnx = 1; j < NT; ++j) {
      f32x16 p0, p1;
      if (j > 0) pv_d0(o, V_lds + vprev * SHM_VT, p8, r32, hi);
      qkt<SHIFT>(p0, p1, K8_lds + kb * SHM_K8, q8, negm, r32, hi);
      smA<SHIFT>(p0, negm); smB<SHIFT>(p0, p1, l_reg, p8, negm); ASBAR();
      if (j + 1 < NT) SWRITE(kb ^ 1, vnx);
      __syncthreads();
      if (j + 2 < NT) SLOAD((j + 2) * KVBLK);
      kb ^= 1; vprev = vbuf; vbuf = vnx; vnx = vnx == 2 ? 0 : vnx + 1;
    }
    pv_d0(o, V_lds + vprev * SHM_VT, p8, r32, hi);
    __builtin_amdgcn_s_setprio(0);
  }
  int lane_e = lane; asm volatile("" : "+v"(lane_e));
  const int r32e = lane_e & 31, hie = lane_e >> 5;
  l_reg += __shfl_xor(l_reg, 32);
  int* satf = (int*)(lds + OFF_WS + NW * 64 * 4);
  if (!SHIFT) { const bool sat = __any(l_reg >= 57344.f); if (lane_e == 0) satf[wid] = sat ? 1 : 0; }
  if (hie == 0) li_l[r32e] = l_reg; asm volatile("s_waitcnt lgkmcnt(0)" ::: "memory");
  float rli[16];
#pragma unroll
  for (int r = 0; r < 16; ++r) rli[r] = __builtin_amdgcn_rcpf(li_l[crow(r, hie)]);
  char* Ow = (char*)(O + ((long)b * SEQ + s0 + wid * QBLK) * LDO + h * 128);
#pragma unroll
  for (int r = 0; r < 16; ++r) { const unsigned ooff = (unsigned)(crow(r, hie) * LDO + r32e) * 2u;
#pragma unroll
    for (int d0 = 0; d0 < 4; ++d0) { const unsigned pk = cvtpk(o[d0][r] * rli[r], 0.f); *(bf16*)(Ow + ooff + d0 * 64) = (bf16)(pk & 0xffffu); } }
  __syncthreads();
  bool redo = false;
  if (!SHIFT) { redo = (satf[0] | satf[1] | satf[2] | satf[3] | satf[4] | satf[5] | satf[6] | satf[7]) != 0; __syncthreads(); }
  return redo;
#undef SLOAD
#undef SWRITE
}
}
#ifndef HD
#define HD __device__ __forceinline__
#endif
struct c32 { float x, y; };
HD c32 cmk(float x, float y) { c32 r; r.x = x; r.y = y; return r; }
HD c32 cadd(c32 a, c32 b) { return cmk(a.x + b.x, a.y + b.y); }
HD c32 csub(c32 a, c32 b) { return cmk(a.x - b.x, a.y - b.y); }
HD c32 cmul(c32 a, c32 b) { return cmk(a.x * b.x - a.y * b.y, a.x * b.y + a.y * b.x); }
HD c32 cmulc(c32 a, c32 b) { return cmk(a.x * b.x + a.y * b.y, a.y * b.x - a.x * b.y); }
constexpr int BR4(int i) { return ((i & 1) << 3) | ((i & 2) << 1) | ((i & 4) >> 1) | ((i & 8) >> 3); }
template <int SGN, int J> HD c32 tw16(c32 a) {
    if constexpr (J == 0) return a;
    else if constexpr (J == 4) return SGN < 0 ? cmk(a.y, -a.x) : cmk(-a.y, a.x);
    else {
        constexpr float CS[8] = {1.f, 0.92387953251128674f, 0.70710678118654752f, 0.38268343236508977f, 0.f, -0.38268343236508977f, -0.70710678118654752f, -0.92387953251128674f};
        constexpr float SN[8] = {0.f, 0.38268343236508977f, 0.70710678118654752f, 0.92387953251128674f, 1.f, 0.92387953251128674f, 0.70710678118654752f, 0.38268343236508977f};
        constexpr float c = CS[J], s = SN[J];
        if constexpr (SGN < 0) return cmk(a.x * c + a.y * s, a.y * c - a.x * s);
        else return cmk(a.x * c - a.y * s, a.y * c + a.x * s);
    }
}
#define FFT_BF(i, j, J) { const c32 u_ = v[i], w_ = v[j]; v[i] = cadd(u_, w_); v[j] = tw16<SGN, J>(csub(u_, w_)); }
template <int SGN> HD void dft16_dif(c32 (&v)[16]) {
    FFT_BF(0, 8, 0) FFT_BF(1, 9, 1) FFT_BF(2, 10, 2) FFT_BF(3, 11, 3) FFT_BF(4, 12, 4) FFT_BF(5, 13, 5) FFT_BF(6, 14, 6) FFT_BF(7, 15, 7)
    FFT_BF(0, 4, 0) FFT_BF(1, 5, 2) FFT_BF(2, 6, 4) FFT_BF(3, 7, 6) FFT_BF(8, 12, 0) FFT_BF(9, 13, 2) FFT_BF(10, 14, 4) FFT_BF(11, 15, 6)
    FFT_BF(0, 2, 0) FFT_BF(1, 3, 4) FFT_BF(4, 6, 0) FFT_BF(5, 7, 4) FFT_BF(8, 10, 0) FFT_BF(9, 11, 4) FFT_BF(12, 14, 0) FFT_BF(13, 15, 4)
    FFT_BF(0, 1, 0) FFT_BF(2, 3, 0) FFT_BF(4, 5, 0) FFT_BF(6, 7, 0) FFT_BF(8, 9, 0) FFT_BF(10, 11, 0) FFT_BF(12, 13, 0) FFT_BF(14, 15, 0)
}
#undef FFT_BF
#define FFT_BT(i, j, J) { const c32 u_ = v[i], w_ = tw16<SGN, J>(v[j]); v[i] = cadd(u_, w_); v[j] = csub(u_, w_); }
template <int SGN> HD void dft16_dit(c32 (&v)[16]) {
    FFT_BT(0, 1, 0) FFT_BT(2, 3, 0) FFT_BT(4, 5, 0) FFT_BT(6, 7, 0) FFT_BT(8, 9, 0) FFT_BT(10, 11, 0) FFT_BT(12, 13, 0) FFT_BT(14, 15, 0)
    FFT_BT(0, 2, 0) FFT_BT(1, 3, 4) FFT_BT(4, 6, 0) FFT_BT(5, 7, 4) FFT_BT(8, 10, 0) FFT_BT(9, 11, 4) FFT_BT(12, 14, 0) FFT_BT(13, 15, 4)
    FFT_BT(0, 4, 0) FFT_BT(1, 5, 2) FFT_BT(2, 6, 4) FFT_BT(3, 7, 6) FFT_BT(8, 12, 0) FFT_BT(9, 13, 2) FFT_BT(10, 14, 4) FFT_BT(11, 15, 6)
    FFT_BT(0, 8, 0) FFT_BT(1, 9, 1) FFT_BT(2, 10, 2) FFT_BT(3, 11, 3) FFT_BT(4, 12, 4) FFT_BT(5, 13, 5) FFT_BT(6, 14, 6) FFT_BT(7, 15, 7)
}
#undef FFT_BT
constexpr int FFT_PS = 272;
constexpr int FFT_EX_ELEMS = 16 * FFT_PS;
template <class EX> HD void fft_fwd_a(c32 (&v)[16], const c32* T1, EX ex, int tid) {
    dft16_dif<-1>(v);
#pragma unroll
    for (int p = 0; p < 16; ++p) { ex[p * FFT_PS + tid] = cmul(v[BR4(p)], T1[256 * p]); if ((p & 3) == 3) __builtin_amdgcn_sched_barrier(0); }
}
template <class EX> HD void fft_fwd_b(c32 (&v)[16], const c32* T2, EX exr, EX ex, int tid) {
    const int p2 = tid >> 4, c = tid & 15;
#pragma unroll
    for (int b = 0; b < 16; ++b) v[b] = exr[p2 * FFT_PS + 16 * b + c];
    dft16_dif<-1>(v);
#pragma unroll
    for (int q = 0; q < 16; ++q) ex[p2 * FFT_PS + q * 16 + ((c + q) & 15)] = cmul(v[BR4(q)], T2[q]);
}
template <class EX> HD void fft_fwd_c(c32 (&v)[16], EX ex, int tid) {
    const int p2 = tid >> 4, q = tid & 15;
#pragma unroll
    for (int c = 0; c < 16; ++c) v[c] = ex[p2 * FFT_PS + q * 16 + ((c + q) & 15)];
    dft16_dif<-1>(v);
}
template <class EX> HD void fft_inv_a(c32 (&v)[16], EX ex, int tid) {
    const int p = tid >> 4, q = tid & 15;
    dft16_dit<+1>(v);
#pragma unroll
    for (int c = 0; c < 16; ++c) ex[p * FFT_PS + q * 16 + ((c + q) & 15)] = v[c];
}
template <class EX> HD void fft_inv_b(c32 (&v)[16], const c32* T2, EX exr, EX ex, int tid) {
    const int p = tid >> 4, c = tid & 15;
#pragma unroll
    for (int q = 0; q < 16; ++q) v[BR4(q)] = cmulc(exr[p * FFT_PS + q * 16 + ((c + q) & 15)], T2[q]);
    dft16_dit<+1>(v);
#pragma unroll
    for (int b = 0; b < 16; ++b) ex[p * FFT_PS + 16 * b + c] = v[b];
}
template <class EX> HD void fft_inv_c(c32 (&v)[16], const c32* T1, EX ex, int tid) {
#pragma unroll
    for (int p = 0; p < 16; ++p) { v[BR4(p)] = cmulc(ex[p * FFT_PS + tid], T1[256 * p]); if ((p & 3) == 3) __builtin_amdgcn_sched_barrier(0); }
    dft16_dit<+1>(v);
}
constexpr int NWAVES = 8, NTHR = 512;
constexpr int BATCH = 8, SEQ = 4096, DM = 1024, T = BATCH * SEQ;
constexpr float EPS = 1e-6f;
constexpr size_t MiB = 1u << 20;
constexpr size_t WS_CTL = 0, CTL_ZERO_BYTES = 64 * 1024;
constexpr size_t WS_MOD = 1 * MiB;
constexpr size_t WS_HDNS = 1 * MiB + 512 * 1024;
constexpr size_t WS_W4S = 3 * MiB + 512 * 1024;
constexpr size_t WS_LIST = 101 * MiB;
constexpr size_t WS_WL = 396 * MiB;
constexpr size_t WS_WD = 8 * MiB;
constexpr size_t WS_WUQ = 9 * MiB;
constexpr size_t WS_WUKV = 10 * MiB;
constexpr size_t WS_WO = 11 * MiB;
constexpr size_t WS_WIN = 13 * MiB;
constexpr size_t WS_WOUT = 19 * MiB;
constexpr size_t WS_WGU = 21 * MiB;
constexpr size_t WS_WDN = 53 * MiB;
constexpr size_t R1 = 104 * MiB;
constexpr size_t R2 = 232 * MiB;
constexpr size_t R3 = 424 * MiB;
constexpr size_t WS_VT8 = R1, WS_XN2 = R1, WS_KF = R1;
constexpr size_t WS_XN = R2, WS_O = R2;
constexpr size_t WS_LAT = R2 + 64 * MiB;
constexpr size_t WS_HACT = R2 + 64 * MiB;
constexpr size_t WS_CQN = R2 + 128 * MiB;
constexpr size_t WS_CKVN = R2 + 144 * MiB;
constexpr size_t WS_KPE = R2 + 160 * MiB;
constexpr size_t WS_K8 = R2 + 64 * MiB;
constexpr size_t WS_ROPE = R2 + 164 * MiB;
constexpr size_t WS_QRAW = 408 * MiB;
constexpr size_t WS_XN2S = 424 * MiB;
constexpr size_t WS_XR = 424 * MiB;
constexpr size_t WS_HT = R2;
constexpr size_t WS_UT = R2;
constexpr size_t WS_Z = R2;
constexpr size_t WS_END = 512 * MiB;
constexpr int MS_ROWS = T + 24 * 256;
constexpr int CW_BAR = 4096;
constexpr int CW_CNT = 8192;
constexpr int RING_OFF = 0, RING_BYTES = 147456;
constexpr int LDSCTL_OFF = RING_BYTES;
constexpr int MISC_OFF = LDSCTL_OFF;
constexpr int TINFO_OFF = LDSCTL_OFF + 256;
constexpr int RED_OFF = LDSCTL_OFF + 256 + 1280;
constexpr int EPIX_OFF = LDSCTL_OFF + 2048;
constexpr int LDS_BYTES = 163840;
static_assert(RED_OFF + 256 <= LDS_BYTES, "LDS map");

#define GAS __attribute__((address_space(1)))
#define LAS __attribute__((address_space(3)))
typedef unsigned short bf16;
typedef unsigned v4u __attribute__((ext_vector_type(4)));
typedef unsigned v2u __attribute__((ext_vector_type(2)));
typedef int v4i __attribute__((ext_vector_type(4)));
typedef float f32x4 __attribute__((ext_vector_type(4)));
typedef GAS unsigned gu32;
#define RLX_AGENT __ATOMIC_RELAXED, __HIP_MEMORY_SCOPE_AGENT
#define LDS_WAIT() asm volatile("s_waitcnt lgkmcnt(0)" ::: "memory")
__device__ __forceinline__ unsigned pk2(float lo, float hi) { return pg8::cvt_pk_bf16(lo, hi); }
__device__ __forceinline__ float bf2f(unsigned short b) { return __uint_as_float(((unsigned)b) << 16); }
__device__ __forceinline__ float wave_sum(float v) {
#pragma unroll
    for (int o = 1; o < 64; o <<= 1) v += __shfl_xor(v, o);
    return v;
}

#define XB_TMO      128
#define XB_XCNT(j)  (256  + 64 * (j))
#define XB_XSUB(j)  (1280 + 64 * (j))
#define XB_XGEN(j)  (2304 + 64 * (j))
#define XB_TOP      3328
#define XB_TOPGEN   3392
#define XCD_BAR_WORDS 3456
#define XB_SPIN_CAP (1u << 18)

__device__ __forceinline__ unsigned xb_ld(unsigned* p)              { return __hip_atomic_load(p, __ATOMIC_RELAXED, __HIP_MEMORY_SCOPE_AGENT); }
__device__ __forceinline__ unsigned xb_add(unsigned* p, unsigned v) { return __hip_atomic_fetch_add(p, v, __ATOMIC_RELAXED, __HIP_MEMORY_SCOPE_AGENT); }
__device__ __forceinline__ unsigned xb_xcc_id() { return (unsigned)__builtin_amdgcn_s_getreg((3 << 11) | 20) & 0xFu; }
#define XB_SPIN(cond, bar) do { unsigned _sp = 0; while (cond) { __builtin_amdgcn_s_sleep(1); \
    if ((++_sp & 255u) == 0u) { if (xb_ld(&(bar)[XB_TMO])) break; if (_sp > XB_SPIN_CAP) { atomicAdd(&(bar)[XB_TMO], 1u); break; } } } } while (0)

struct XcdBarrier {
    unsigned* bar; unsigned x;
    volatile LAS unsigned* st;
    int w0;
};

__device__ __forceinline__ XcdBarrier xcd_barrier_post(unsigned* bar, volatile LAS unsigned* st) {
    XcdBarrier b; b.bar = bar; b.x = xb_xcc_id(); b.st = st; b.w0 = 0;
    if (threadIdx.x == 0) (void)xb_add(&bar[XB_XCNT(b.x)], 1u);
    return b;
}
__device__ __forceinline__ void xcd_barrier_complete(unsigned* bar, unsigned x, unsigned& nloc, unsigned& nx) {
    const unsigned G = gridDim.x * gridDim.y * gridDim.z;
    unsigned sum, cnt, mine, sp = 0u;
    for (;;) {
        sum = 0u; cnt = 0u; mine = 0u;
#pragma unroll
        for (unsigned j = 0; j < 16; ++j) { const unsigned c = xb_ld(&bar[XB_XCNT(j)]); sum += c; cnt += (c > 0u) ? 1u : 0u; mine = (j == x) ? c : mine; }
        if (sum == G) break;
        __builtin_amdgcn_s_sleep(1);
        if ((++sp & 255u) == 0u) { if (xb_ld(&bar[XB_TMO])) break; if (sp > XB_SPIN_CAP) { atomicAdd(&bar[XB_TMO], 1u); break; } }
    }
    nloc = mine > 0u ? mine : 1u; nx = cnt > 0u ? cnt : 1u;
}

__device__ __forceinline__ void xcd_barrier(const XcdBarrier& b) {
    asm volatile("s_waitcnt vmcnt(0)" ::: "memory");
    __syncthreads();
    if (b.w0 && __builtin_amdgcn_mbcnt_hi(~0u, __builtin_amdgcn_mbcnt_lo(~0u, 0u)) == 0u) {
        unsigned* bar = b.bar;
        __builtin_amdgcn_s_waitcnt(0);
        unsigned nloc = b.st[0], nx = b.st[1];
        if (nloc == 0u) { xcd_barrier_complete(bar, b.x, nloc, nx); b.st[0] = nloc; b.st[1] = nx; }
        const unsigned old = xb_add(&bar[XB_XSUB(b.x)], 1u);
        const unsigned gen = old / nloc;
        if (old + 1u == (gen + 1u) * nloc) {
            __builtin_amdgcn_fence(__ATOMIC_RELEASE, "agent");
            asm volatile("s_waitcnt vmcnt(0)" ::: "memory");
            const unsigned og = xb_add(&bar[XB_TOP], 1u);
            const unsigned tg = og / nx;
            if (og + 1u == (tg + 1u) * nx) xb_add(&bar[XB_TOPGEN], 1u);
            else XB_SPIN(xb_ld(&bar[XB_TOPGEN]) == tg, bar);
            __builtin_amdgcn_fence(__ATOMIC_ACQUIRE, "agent");
            xb_add(&bar[XB_XGEN(b.x)], 1u);
            asm volatile("s_waitcnt vmcnt(0)" ::: "memory");
        } else {
            XB_SPIN(xb_ld(&bar[XB_XGEN(b.x)]) == gen, bar);
            __builtin_amdgcn_fence(__ATOMIC_ACQUIRE, "agent");
            asm volatile("s_waitcnt vmcnt(0)" ::: "memory");
        }
    }
    __syncthreads();
}


struct Ctx { unsigned char* lds; int tid, lane, wave, vcu, G, gw, NGW; };

__device__ __forceinline__ void transpose_item(const float* W, int ldw, int k0, int n0, bf16* WT, int ldt, int drow0, int dcol0, float* scr, int lane, bool kpe_perm) {
    float tv[32];
#pragma unroll
    for (int i = 0; i < 32; ++i) { const int kk = 2 * i + (lane >> 5); tv[i] = W[(size_t)(k0 + kk) * ldw + n0 + (lane & 31)]; }
#pragma unroll
    for (int i = 0; i < 32; ++i) { const int kk = 2 * i + (lane >> 5); scr[kk * 33 + (lane & 31)] = tv[i]; }
    LDS_WAIT();
    const int c = lane & 7;
#pragma unroll
    for (int j = 0; j < 4; ++j) { const int n = (lane >> 3) + 8 * j; const float* s = scr + (8 * c) * 33 + n;
        v4u o; o.x = pk2(s[0 * 33], s[1 * 33]); o.y = pk2(s[2 * 33], s[3 * 33]); o.z = pk2(s[4 * 33], s[5 * 33]); o.w = pk2(s[6 * 33], s[7 * 33]);
        int dr = drow0 + n; if (kpe_perm && dr >= 384 && dr < 448) { const int e = dr - 384; dr = 384 + 32 * ((e >> 4) & 1) + 16 * (e >> 5) + (e & 15); }
        *(v4u*)(WT + (size_t)dr * ldt + dcol0 + k0 + 8 * c) = o; }
    LDS_WAIT();
}
__device__ __forceinline__ void transpose_item8(const float* W, int ldw, int k0, int n0, unsigned char* WT8, int ldt8, int drow0, int dcol0, float* scr, int lane, float scale) {
    float tv[32];
#pragma unroll
    for (int i = 0; i < 32; ++i) { const int kk = 2 * i + (lane >> 5); tv[i] = W[(size_t)(k0 + kk) * ldw + n0 + (lane & 31)]; }
#pragma unroll
    for (int i = 0; i < 32; ++i) { const int kk = 2 * i + (lane >> 5); scr[kk * 33 + (lane & 31)] = tv[i]; }
    LDS_WAIT();
    const int n = lane >> 1, hf = lane & 1; const float* sp = scr + (32 * hf) * 33 + n;
    v4u o0, o1; unsigned w[8];
#pragma unroll
    for (int q = 0; q < 8; ++q) { int p = 0; p = __builtin_amdgcn_cvt_pk_fp8_f32(sp[(4 * q) * 33] * scale, sp[(4 * q + 1) * 33] * scale, p, false); p = __builtin_amdgcn_cvt_pk_fp8_f32(sp[(4 * q + 2) * 33] * scale, sp[(4 * q + 3) * 33] * scale, p, true); w[q] = (unsigned)p; }
    o0.x = w[0]; o0.y = w[1]; o0.z = w[2]; o0.w = w[3]; o1.x = w[4]; o1.y = w[5]; o1.z = w[6]; o1.w = w[7];
    unsigned char* d = WT8 + (size_t)(drow0 + n) * ldt8 + dcol0 + k0 + 32 * hf;
    *(v4u*)d = o0; *(v4u*)(d + 16) = o1;
    LDS_WAIT();
}
typedef __attribute__((address_space(4))) const char kchar;
struct In { int opq;
    __device__ __forceinline__ const float* operator[](int k) const { kchar* ka = (kchar*)__builtin_amdgcn_kernarg_segment_ptr(); return *(const float* const __attribute__((address_space(4)))*)(ka + 8 * k + opq); } };
__device__ __forceinline__ unsigned char* karg_ws(int opq) { kchar* ka = (kchar*)__builtin_amdgcn_kernarg_segment_ptr(); return *(unsigned char* const __attribute__((address_space(4)))*)(ka + 38 * 8 + 8 + opq); }
__device__ __forceinline__ float* karg_out(int opq) { kchar* ka = (kchar*)__builtin_amdgcn_kernarg_segment_ptr(); return *(float* const __attribute__((address_space(4)))*)(ka + 38 * 8 + opq); }

__device__ __forceinline__ void p0_prologue(const Ctx& F, const In& in, unsigned char* ws) {
    float* scr = (float*)(F.lds + RING_OFF + F.wave * 16384);
    bf16* Wd = (bf16*)(ws + WS_WD); bf16* Wuq = (bf16*)(ws + WS_WUQ); bf16* Wukv = (bf16*)(ws + WS_WUKV); bf16* Wo = (bf16*)(ws + WS_WO);
    bf16* Win = (bf16*)(ws + WS_WIN); bf16* Wout = (bf16*)(ws + WS_WOUT); bf16* Wgu = (bf16*)(ws + WS_WGU); bf16* Wdn = (bf16*)(ws + WS_WDN);
    constexpr int I_D = 16 * 14, I_UQ = 4 * 48, I_UKV = 2 * 64, I_O = 16 * 32, I_IN = 16 * 96, I_OUT = 16 * 32, I_GU = 2 * 16 * 2 * (16 * 8), I_DN = 2 * 24 * 2 * (4 * 32);
    constexpr int NITEMS = I_D + I_UQ + I_UKV + I_O + I_IN + I_OUT + I_GU + I_DN;
    for (int it = F.gw; it < NITEMS; it += F.NGW) {
        int r = it; const float* W; int ldw, k0, n0, ldt, drow0, dcol0 = 0; bf16* WT; float f8s = 0.f;
        if (r < I_D) { W = in[7]; ldw = 448; k0 = (r / 14) * 64; n0 = (r % 14) * 32; WT = Wd; ldt = 1024; drow0 = n0; }
        else if ((r -= I_D) < I_UQ) { W = in[10]; ldw = 1536; k0 = (r / 48) * 64; n0 = (r % 48) * 32; WT = Wuq; ldt = 256; drow0 = n0; }
        else if ((r -= I_UQ) < I_UKV) { W = in[11]; ldw = 2048; k0 = (r / 64) * 64; n0 = (r % 64) * 32; ldt = 128;
            WT = Wukv + ((n0 & 128) ? 1024 * 128 : 0); drow0 = (n0 >> 8) * 128 + (n0 & 127); }
        else if ((r -= I_UKV) < I_O) { W = in[14]; ldw = 1024; k0 = (r / 32) * 64; n0 = (r % 32) * 32; WT = Wo; ldt = 1024; drow0 = n0; }
        else if ((r -= I_O) < I_IN) { W = in[15]; ldw = 3072; k0 = (r / 96) * 64; n0 = (r % 96) * 32; WT = Win; ldt = 1024; drow0 = n0; }
        else if ((r -= I_IN) < I_OUT) { W = in[30]; ldw = 1024; k0 = (r / 32) * 64; n0 = (r % 32) * 32; WT = Wout; ldt = 1024; drow0 = n0; }
        else if ((r -= I_OUT) < I_GU) {
            const int sub = r % 128, mat = r / 128, which = mat & 1, le = mat >> 1;
            W = (which ? in[36] : in[35]) + (size_t)le * 1024 * 256; ldw = 256; k0 = (sub / 8) * 64; n0 = (sub % 8) * 32;
            WT = (bf16*)((unsigned char*)Wgu + (size_t)le * 512 * 1024); ldt = 1024; drow0 = (n0 >> 7) * 256 + which * 128 + (n0 & 127); f8s = 32.f; }
        else { r -= I_GU;
            const int sub = r % 128, mat = r / 128, slot = mat & 1, lb = mat >> 1, layer = lb / 24, bk = lb % 24;
            int ii, jj; pg8::pair_of(bk % 6, ii, jj); const int e = (bk / 6) * 4 + (slot ? jj : ii);
            W = in[37] + (size_t)(layer * 16 + e) * 256 * 1024; ldw = 1024; k0 = (sub / 32) * 64; n0 = (sub % 32) * 32;
            WT = Wdn + (size_t)lb * 1024 * 512; ldt = 512; drow0 = n0; dcol0 = slot * 256; }
        if (f8s != 0.f) transpose_item8(W, ldw, k0, n0, (unsigned char*)WT, ldt, drow0, dcol0, scr, F.lane, f8s);
        else transpose_item(W, ldw, k0, n0, WT, ldt, drow0, dcol0, scr, F.lane, it < I_D);
    }
    { const int gt = F.vcu * NTHR + F.tid, NGT = F.G * NTHR; const v4u z = {0u, 0u, 0u, 0u};
      for (int i = gt; i < 64 * 1024 / 8; i += NGT) *(v4u*)(Wd + (size_t)448 * 1024 + (size_t)i * 8) = z;
    }
    { const int gt = F.vcu * NTHR + F.tid, NGT = F.G * NTHR; float* RT = (float*)(ws + WS_ROPE); const int* posi = (const int*)in[2];
      for (int i = gt; i < T * 32; i += NGT) { const int t = i >> 5, e = i & 31; const float inv = 1.0f / powf(10000.f, (float)(2 * e) * (1.f / 64.f));
        float sn, cs; sincosf((float)posi[t] * inv, &sn, &cs); RT[(size_t)i * 2] = cs; RT[(size_t)i * 2 + 1] = sn; } }
    { const int gt = F.vcu * NTHR + F.tid, NGT = F.G * NTHR; bf16* W4S = (bf16*)(ws + WS_W4S); const float* w4 = in[28];
      for (int i = gt; i < 4096 * 64; i += NGT) { const int k = i >> 12, col = i & 4095; const float w = w4[(size_t)k * 4096 + col];
        const unsigned hi = pk2(w, 0.f) & 0xffffu; const float lo = w - bf2f((unsigned short)hi); const unsigned lob = pk2(lo, 0.f) & 0xffffu;
        bf16* d = W4S + (size_t)col * 256 + k; d[0] = (bf16)hi; d[64] = (bf16)hi; d[128] = (bf16)lob; d[192] = 0; } }
    { bf16* HDp = (bf16*)(ws + WS_HDNS); float* sv = scr;
      const int j = F.lane;
      for (int t = F.gw; t < 4096; t += F.NGW) {
        float zf = 0.f;
        { const float w = 6.2831855f * (float)t * (1.f / 4096.f);
          if (j == 0) zf = (float)t / 4095.f;
          else if (j <= 16) { const float fr = 1e-4f + (float)(j - 1) * ((15.f - 1e-4f) / 15.f); zf = cosf(fr * w); }
          else if (j <= 32) { const float fr = 1e-4f + (float)(j - 17) * ((15.f - 1e-4f) / 15.f); zf = -sinf(fr * w); } }
        sv[j] = zf; LDS_WAIT();
        float a = in[20][j];
#pragma unroll 3
        for (int k = 0; k < 33; ++k) a += sv[k] * in[19][k * 64 + j];
        float h = sinf(in[21][j] * a); LDS_WAIT(); sv[j] = h; LDS_WAIT();
        a = in[23][j];
#pragma unroll 4
        for (int k = 0; k < 64; ++k) a += sv[k] * in[22][k * 64 + j];
        h = sinf(in[24][j] * a); LDS_WAIT(); sv[j] = h; LDS_WAIT();
        a = in[26][j];
#pragma unroll 4
        for (int k = 0; k < 64; ++k) a += sv[k] * in[25][k * 64 + j];
        h = sinf(in[27][j] * a); LDS_WAIT();
        const unsigned hi = pk2(h, 0.f) & 0xffffu; const float lo = h - bf2f((unsigned short)hi); const unsigned lob = pk2(lo, 0.f) & 0xffffu;
        bf16* d = HDp + (size_t)t * 256 + j; d[0] = (bf16)hi; d[64] = (bf16)lob; d[128] = (bf16)hi; d[192] = 0;
      } }
    __syncthreads();
    { float* cact = (float*)(F.lds + RING_OFF); float* red = cact + 8 * 1024;
      float* MOD = (float*)(ws + WS_MOD);
      for (int i = F.tid; i < 8 * 1024; i += NTHR) { const float x = in[1][i]; cact[i] = x / (1.f + __expf(-x)); }
      __syncthreads();
      for (int it = F.vcu; it < 2 * 96; it += F.G) {
        const int layer = it / 96, cb = it % 96, col = F.tid & 63, kg = F.tid >> 6;
        const float* W = in[3] + (size_t)layer * 1024 * 6144 + cb * 64 + col;
        float acc[8] = {0.f, 0.f, 0.f, 0.f, 0.f, 0.f, 0.f, 0.f};
#pragma unroll 16
        for (int k = kg * 128; k < kg * 128 + 128; ++k) { const float w = W[(size_t)k * 6144];
#pragma unroll
          for (int b = 0; b < 8; ++b) acc[b] += cact[b * 1024 + k] * w; }
#pragma unroll
        for (int b = 0; b < 8; ++b) red[(kg * 8 + b) * 64 + col] = acc[b];
        __syncthreads();
        { const int b = F.tid >> 6; float s = in[4][layer * 6144 + cb * 64 + col];
#pragma unroll
          for (int g = 0; g < 8; ++g) s += red[(g * 8 + b) * 64 + col];
          MOD[((size_t)layer * 8 + b) * 6144 + cb * 64 + col] = s; }
        __syncthreads();
      } }
}

template <class TX> __device__ __forceinline__ f32x4 ldrow4(const TX* p);
template <> __device__ __forceinline__ f32x4 ldrow4<float>(const float* p) { return *(const __attribute__((address_space(1))) f32x4*)p; }
template <> __device__ __forceinline__ f32x4 ldrow4<bf16>(const bf16* p) { const v2u w = *(const __attribute__((address_space(1))) v2u*)p; f32x4 r; r[0] = __uint_as_float(w.x << 16); r[1] = __uint_as_float(w.x & 0xffff0000u); r[2] = __uint_as_float(w.y << 16); r[3] = __uint_as_float(w.y & 0xffff0000u); return r; }
template <class TX> __device__ __forceinline__ void norm_mod_phase(const Ctx& F, const TX* X, const float* g, const float* sc, const float* sh, bf16* OUT) {
    for (int ch = F.gw; ch < T / 16; ch += F.NGW) {
        const int r0 = ch * 16, b = r0 >> 12;
        f32x4 A[4], S[4];
#pragma unroll
        for (int j = 0; j < 4; ++j) { const int col = 4 * F.lane + 256 * j; const f32x4 gv = *(const f32x4*)(g + col), sv = *(const f32x4*)(sc + (size_t)b * 6144 + col); A[j] = gv * (1.f + sv); S[j] = *(const f32x4*)(sh + (size_t)b * 6144 + col); }
        const TX* xr = X + (size_t)r0 * DM + 4 * F.lane;
        f32x4 nx[4];
#pragma unroll
        for (int j = 0; j < 4; ++j) nx[j] = ldrow4<TX>(xr + 256 * j);
        for (int rr = 0; rr < 16; ++rr) {
            f32x4 v[4]; float ss = 0.f;
#pragma unroll
            for (int j = 0; j < 4; ++j) { v[j] = nx[j]; ss += (v[j].x * v[j].x + v[j].y * v[j].y) + (v[j].z * v[j].z + v[j].w * v[j].w); }
            if (rr < 15) {
#pragma unroll
                for (int j = 0; j < 4; ++j) nx[j] = ldrow4<TX>(xr + (size_t)(rr + 1) * DM + 256 * j); }
            const float rstd = rsqrtf(wave_sum(ss) * (1.f / DM) + EPS);
            bf16* orow = OUT + (size_t)(r0 + rr) * DM + 4 * F.lane;
#pragma unroll
            for (int j = 0; j < 4; ++j) { const f32x4 o = v[j] * rstd * A[j] + S[j]; v2u w; w.x = pk2(o.x, o.y); w.y = pk2(o.z, o.w); *(v2u*)(orow + 256 * j) = w; } }
    }
}

__device__ __forceinline__ void lat_post_phase(const Ctx& F, const float* LAT, const float* qag, const float* kvag, const float* kng, const float* rope, bf16* CQN, bf16* CKVN, bf16* KPE) {
    const int l = F.lane;
    const f32x4 gq = *(const f32x4*)(qag + 4 * l);
    const f32x4 g2 = l < 32 ? *(const f32x4*)(kvag + 4 * l) : (l < 48 ? *(const f32x4*)(kng + 128 + 4 * (l - 32)) : (f32x4){0.f, 0.f, 0.f, 0.f});
    f32x4 na = *(const f32x4*)(LAT + (size_t)F.gw * 512 + 4 * l), nc = l < 48 ? *(const f32x4*)(LAT + (size_t)F.gw * 512 + 256 + 4 * l) : (f32x4){0.f, 0.f, 0.f, 0.f};
    for (int row = F.gw; row < T; row += F.NGW) {
        const f32x4 a = na, c = nc;
        if (row + F.NGW < T) { const float* nr = LAT + (size_t)(row + F.NGW) * 512; na = *(const f32x4*)(nr + 4 * l); if (l < 48) nc = *(const f32x4*)(nr + 256 + 4 * l); }
        const float sq = (a.x * a.x + a.y * a.y) + (a.z * a.z + a.w * a.w), sc = (c.x * c.x + c.y * c.y) + (c.z * c.z + c.w * c.w);
        const float s_q = wave_sum(sq), s_kv = wave_sum(l < 32 ? sc : 0.f), s_pe = wave_sum((l >= 32 && l < 48) ? sc : 0.f);
        const float rq = rsqrtf(s_q * (1.f / 256.f) + EPS), rkv = rsqrtf(s_kv * (1.f / 128.f) + EPS), rpe = rsqrtf(s_pe * (1.f / 64.f) + EPS);
        { const f32x4 o = a * rq * gq; v2u w; w.x = pk2(o.x, o.y); w.y = pk2(o.z, o.w); *(v2u*)(CQN + (size_t)row * 256 + 4 * l) = w; }
        if (l < 32) { const f32x4 o = c * rkv * g2; v2u w; w.x = pk2(o.x, o.y); w.y = pk2(o.z, o.w); *(v2u*)(CKVN + (size_t)row * 256 + 4 * l) = w; }
        else { v2u w; w.x = 0u; w.y = 0u; *(v2u*)(CKVN + (size_t)row * 256 + 128 + 4 * (l - 32)) = w; }
        const f32x4 n = c * rpe * g2;
        f32x4 other; other.x = __shfl_xor(n.x, 8); other.y = __shfl_xor(n.y, 8); other.z = __shfl_xor(n.z, 8); other.w = __shfl_xor(n.w, 8);
        if (l >= 32 && l < 48) { const bool first = l < 40; const int e0 = 4 * ((l - 32) & 7);
            float o[4];
#pragma unroll
            for (int i = 0; i < 4; ++i) { const int e = e0 + i; const float cs = rope[(size_t)row * 64 + e * 2], sn = rope[(size_t)row * 64 + e * 2 + 1];
                const float mine = n[i], oth = other[i]; o[i] = first ? (mine * cs - oth * sn) : (oth * sn + mine * cs); }
            v2u w; w.x = pk2(o[0], o[1]); w.y = pk2(o[2], o[3]); *(v2u*)(KPE + (size_t)row * 64 + 4 * (l - 32)) = w; }
    }
}

__device__ __forceinline__ void knorm_phase(const Ctx& F, bf16* KV, const float* kng) {
    const int l = F.lane, h = l >> 3, e0 = (l & 7) * 16;
    float g[16];
#pragma unroll
    for (int i = 0; i < 16; ++i) g[i] = kng[e0 + i];
    for (int row = F.gw; row < T; row += F.NGW) {
        bf16* p = KV + (size_t)row * 2048 + h * 256 + e0;
        const v4u r0 = *(const v4u*)p, r1 = *(const v4u*)(p + 8);
        float f[16]; const unsigned w[8] = {r0.x, r0.y, r0.z, r0.w, r1.x, r1.y, r1.z, r1.w};
        float ss = 0.f;
#pragma unroll
        for (int i = 0; i < 8; ++i) { f[2 * i] = __uint_as_float(w[i] << 16); f[2 * i + 1] = __uint_as_float(w[i] & 0xffff0000u); ss += f[2 * i] * f[2 * i] + f[2 * i + 1] * f[2 * i + 1]; }
        ss += __shfl_xor(ss, 1); ss += __shfl_xor(ss, 2); ss += __shfl_xor(ss, 4);
        const float r = rsqrtf(ss * (1.f / 128.f) + EPS);
        v4u o0, o1;
        o0.x = pk2(f[0] * r * g[0], f[1] * r * g[1]); o0.y = pk2(f[2] * r * g[2], f[3] * r * g[3]); o0.z = pk2(f[4] * r * g[4], f[5] * r * g[5]); o0.w = pk2(f[6] * r * g[6], f[7] * r * g[7]);
        o1.x = pk2(f[8] * r * g[8], f[9] * r * g[9]); o1.y = pk2(f[10] * r * g[10], f[11] * r * g[11]); o1.z = pk2(f[12] * r * g[12], f[13] * r * g[13]); o1.w = pk2(f[14] * r * g[14], f[15] * r * g[15]);
        *(v4u*)p = o0; *(v4u*)(p + 8) = o1;
    }
}

__device__ __forceinline__ void route_phase(const Ctx& F, const bf16* X, const float* g, const float* sc, const float* sh, const float* wg, const float* bg, const float* we, const float* be,
                                            bf16* XN2, int* LIST, float* WL, gu32* cnt) {
    float* W20 = (float*)(F.lds + RING_OFF);
    for (int i = F.tid; i < 20 * 1024; i += NTHR) { const int o = i >> 10, col = i & 1023; W20[i] = o < 4 ? wg[col * 4 + o] : we[col * 16 + (o - 4)]; }
    __syncthreads();
    float bgv[4];
#pragma unroll
    for (int i = 0; i < 4; ++i) bgv[i] = bg[i];
    for (int ch = F.gw; ch < T / 16; ch += F.NGW) {
        const int r0 = ch * 16, b = r0 >> 12;
        f32x4 A[4], S[4];
#pragma unroll
        for (int j = 0; j < 4; ++j) { const int col = 4 * F.lane + 256 * j; const f32x4 gv = *(const f32x4*)(g + col), sv = *(const f32x4*)(sc + (size_t)b * 6144 + col); A[j] = gv * (1.f + sv); S[j] = *(const f32x4*)(sh + (size_t)b * 6144 + col); }
        const bf16* xr = X + (size_t)r0 * DM + 4 * F.lane;
        f32x4 nx[4];
#pragma unroll
        for (int j = 0; j < 4; ++j) nx[j] = ldrow4<bf16>(xr + 256 * j);
        for (int rr = 0; rr < 16; ++rr) { const int row = r0 + rr;
            f32x4 v[4]; float ss = 0.f;
#pragma unroll
            for (int j = 0; j < 4; ++j) { v[j] = nx[j]; ss += (v[j].x * v[j].x + v[j].y * v[j].y) + (v[j].z * v[j].z + v[j].w * v[j].w); }
            if (rr < 15) {
#pragma unroll
                for (int j = 0; j < 4; ++j) nx[j] = ldrow4<bf16>(xr + (size_t)(rr + 1) * DM + 256 * j); }
            const float rstd = rsqrtf(wave_sum(ss) * (1.f / DM) + EPS);
            unsigned char* orow = (unsigned char*)XN2 + (size_t)row * DM + 4 * F.lane;
#pragma unroll
            for (int j = 0; j < 4; ++j) { v[j] = v[j] * rstd * A[j] + S[j]; int p = 0; p = __builtin_amdgcn_cvt_pk_fp8_f32(v[j].x, v[j].y, p, false); p = __builtin_amdgcn_cvt_pk_fp8_f32(v[j].z, v[j].w, p, true); *(int*)(orow + 256 * j) = p; }
            float gl[4];
#pragma unroll
            for (int o = 0; o < 4; ++o) { float a = 0.f;
#pragma unroll
                for (int j = 0; j < 4; ++j) { const f32x4 w = *(const f32x4*)(W20 + o * 1024 + 4 * F.lane + 256 * j); a += (v[j].x * w.x + v[j].y * w.y) + (v[j].z * w.z + v[j].w * w.w); }
                gl[o] = wave_sum(a) + bgv[o]; }
            int gi = 0; float gm = gl[0]; if (gl[1] > gm) { gm = gl[1]; gi = 1; } if (gl[2] > gm) { gm = gl[2]; gi = 2; } if (gl[3] > gm) { gm = gl[3]; gi = 3; }
            gi = __builtin_amdgcn_readfirstlane(gi);
            const float gw_ = 1.f / (__expf(gl[0] - gm) + __expf(gl[1] - gm) + __expf(gl[2] - gm) + __expf(gl[3] - gm));
            const float* We = W20 + (4 + 4 * gi) * 1024 + 4 * F.lane;
            float e[4];
#pragma unroll
            for (int k = 0; k < 4; ++k) { float a = 0.f;
#pragma unroll
                for (int j = 0; j < 4; ++j) { const f32x4 w = *(const f32x4*)(We + k * 1024 + 256 * j); a += (v[j].x * w.x + v[j].y * w.y) + (v[j].z * w.z + v[j].w * w.w); }
                e[k] = wave_sum(a) + be[4 * gi + k]; }
            int i1 = 0; float m1 = e[0];
#pragma unroll
            for (int k = 1; k < 4; ++k) if (e[k] > m1) { m1 = e[k]; i1 = k; }
            int i2 = -1; float m2 = -3.0e38f;
#pragma unroll
            for (int k = 0; k < 4; ++k) if (k != i1 && e[k] > m2) { m2 = e[k]; i2 = k; }
            const float t2 = __expf(m2 - m1), w1 = gw_ / (1.f + t2), w2 = gw_ * t2 / (1.f + t2);
            const int ilo = i1 < i2 ? i1 : i2, ihi = i1 < i2 ? i2 : i1; const float wlo = i1 < i2 ? w1 : w2, whi = i1 < i2 ? w2 : w1;
            const int pi = ilo == 0 ? ihi - 1 : (ilo == 1 ? ihi + 1 : 5), bk = gi * 6 + pi;
            if (F.lane == 0) { const unsigned pos = __hip_atomic_fetch_add(cnt + bk * 64, 1u, RLX_AGENT);
                LIST[bk * 32768 + pos] = row; float2 ww; ww.x = wlo; ww.y = whi; *(float2*)(WL + ((size_t)bk * 32768 + pos) * 2) = ww; }
        }
    }
}
__device__ __forceinline__ void moe_table(const Ctx& F, const gu32* cnt) {
    int* tinfo = (int*)(F.lds + TINFO_OFF);
    __syncthreads();
    if (F.tid == 0) { int nt = 0;
        for (int b = 0; b < 24; ++b) { const int c = (int)__hip_atomic_load(cnt + b * 64, RLX_AGENT); const int tiles = (c + 255) >> 8;
            tinfo[256 + b] = nt * 256; tinfo[288 + b] = c; for (int i = 0; i < tiles; ++i) tinfo[1 + nt + i] = b; nt += tiles; }
        tinfo[0] = nt; }
    __syncthreads();
}
__device__ __forceinline__ void permute_phase(const Ctx& F, const bf16* XN2, const int* ROUTE, bf16* XN2S, int* TOKW) {
    const int* tinfo = (const int*)(F.lds + TINFO_OFF);
    for (int ch = F.gw; ch < T / 4; ch += F.NGW) {
        v4i r[4]; v4u a[4], bq[4];
#pragma unroll
        for (int i = 0; i < 4; ++i) { const int row = ch * 4 + i; r[i] = *(const v4i*)(ROUTE + (size_t)row * 4);
            a[i] = *(const v4u*)(XN2 + (size_t)row * DM + 8 * F.lane); bq[i] = *(const v4u*)(XN2 + (size_t)row * DM + 512 + 8 * F.lane); }
#pragma unroll
        for (int i = 0; i < 4; ++i) { const int row = ch * 4 + i, srow = tinfo[256 + r[i].x] + r[i].y;
            *(v4u*)(XN2S + (size_t)srow * DM + 8 * F.lane) = a[i]; *(v4u*)(XN2S + (size_t)srow * DM + 512 + 8 * F.lane) = bq[i];
            if (F.lane == 0) { v4i w; w.x = row; w.y = r[i].z; w.z = r[i].w; w.w = 0; *(v4i*)(TOKW + (size_t)srow * 4) = w; } }
    }
}

constexpr float W32C[16] = {1.f, 0.98078528040323043f, 0.92387953251128674f, 0.83146961230254524f, 0.70710678118654752f, 0.55557023301960218f, 0.38268343236508977f, 0.19509032201612825f,
                            0.f, -0.19509032201612825f, -0.38268343236508977f, -0.55557023301960218f, -0.70710678118654752f, -0.83146961230254524f, -0.92387953251128674f, -0.98078528040323043f};
constexpr float W32S[16] = {0.f, 0.19509032201612825f, 0.38268343236508977f, 0.55557023301960218f, 0.70710678118654752f, 0.83146961230254524f, 0.92387953251128674f, 0.98078528040323043f,
                            1.f, 0.98078528040323043f, 0.92387953251128674f, 0.83146961230254524f, 0.70710678118654752f, 0.55557023301960218f, 0.38268343236508977f, 0.19509032201612825f};
struct FftTw { const c32* T1; c32 tob; const c32* T2; };
template <int A> __device__ __forceinline__ c32 mul_to(c32 x, c32 tob) { const c32 y = cmul(x, tob); return cmk(y.x * W32C[A] + y.y * W32S[A], y.y * W32C[A] - y.x * W32S[A]); }
template <int A> __device__ __forceinline__ c32 mul_toc(c32 x, c32 tob) { const c32 y = cmulc(x, tob); return cmk(y.x * W32C[A] - y.y * W32S[A], y.y * W32C[A] + y.x * W32S[A]); }
#define TO_ALL(OP) OP(0) OP(1) OP(2) OP(3) OP(4) OP(5) OP(6) OP(7) OP(8) OP(9) OP(10) OP(11) OP(12) OP(13) OP(14) OP(15)
__device__ __forceinline__ void fft_twiddles(FftTw& W, int gt, c32* t1tab, c32* t2tab, int tid) {
    if (tid < 256) { float s, c; sincosf(-6.283185307179586f * (float)(((tid >> 4) * (tid & 15)) & 255) * (1.f / 256.f), &s, &c); t2tab[(tid >> 4) * 17 + (tid & 15)] = cmk(c, s); }
    for (int i = tid; i < 4096; i += NTHR) { const int p = i >> 8, t = i & 255; float s, c; sincosf(-6.283185307179586f * (float)((t * p) & 4095) * (1.f / 4096.f), &s, &c); t1tab[i] = cmk(c, s); }
    { float s, c; sincosf(-6.283185307179586f * (float)gt * (1.f / 8192.f), &s, &c); W.tob = cmk(c, s); }
    W.T1 = t1tab + gt; W.T2 = t2tab + (gt & 15) * 17;
    __syncthreads();
}
__device__ __forceinline__ void fft_forward_a(c32 (&v)[16], const FftTw& W, c32* ex, int gt) {
    __syncthreads();
    fft_fwd_a(v, W.T1, ex, gt);
    __syncthreads();
}
__device__ __forceinline__ void fft_forward_bc(c32 (&v)[16], const FftTw& W, c32* ex, int gt) {
    fft_fwd_b(v, W.T2, ex, ex, gt);
    __builtin_amdgcn_wave_barrier(); asm volatile("" ::: "memory");
    fft_fwd_c(v, ex, gt);
}
__device__ __forceinline__ void fft_forward(c32 (&v)[16], const FftTw& W, c32* ex, int gt) { fft_forward_a(v, W, ex, gt); fft_forward_bc(v, W, ex, gt); }
__device__ __forceinline__ void fft_inverse(c32 (&v)[16], const FftTw& W, c32* ex, int gt) {
    __builtin_amdgcn_wave_barrier(); asm volatile("" ::: "memory");
    fft_inv_a(v, ex, gt);
    __builtin_amdgcn_wave_barrier(); asm volatile("" ::: "memory");
    fft_inv_b(v, W.T2, ex, ex, gt);
    __syncthreads();
    fft_inv_c(v, W.T1, ex, gt);
}
__device__ __forceinline__ void filter_phase(const Ctx& F, const float* HT, const float* fbias, c32* KF) {
    const int g = __builtin_amdgcn_readfirstlane(F.tid >> 8), gt = F.tid & 255;
    c32* ex = (c32*)(F.lds + RING_OFF + g * 36864);
    float* rev = (float*)ex;
    float* red = (float*)(F.lds + RED_OFF);
    FftTw W; fft_twiddles(W, gt, (c32*)(F.lds + RING_OFF + 73728), (c32*)(F.lds + RING_OFF + 110592), F.tid);
    for (int d = F.vcu; d < DM; d += F.G) {
        int gtv = gt; asm volatile("" : "+v"(gtv));
        const float delta = fabsf(-120.39728043259361f + (float)d * ((40.546510810816436f + 120.39728043259361f) / 1023.f));
        const float* hfp = HT + (size_t)(g * 2048 + d) * 4096; const float* hbp = HT + (size_t)(g * 2048 + 1024 + d) * 4096;
        float hf[16], hb[16]; float sf = 0.f, sb = 0.f;
#pragma unroll
        for (int a = 0; a < 16; ++a) { const int t = 256 * a + gtv; const float dec = __expf(-((float)t * (1.f / 4095.f)) * delta); hf[a] = hfp[t] * dec; hb[a] = hbp[t] * dec; sf += fabsf(hf[a]); sb += fabsf(hb[a]); }
        sf = wave_sum(sf); sb = wave_sum(sb);
        __syncthreads();
        if (F.lane == 0) { red[F.wave * 2] = sf; red[F.wave * 2 + 1] = sb; }
        __syncthreads();
        sf = red[g * 8] + red[g * 8 + 2] + red[g * 8 + 4] + red[g * 8 + 6]; sb = red[g * 8 + 1] + red[g * 8 + 3] + red[g * 8 + 5] + red[g * 8 + 7];
        const float nf = 1.f / (sf + EPS) * (1.f / 8192.f), nb = 1.f / (sb + EPS) * (1.f / 8192.f);
#pragma unroll
        for (int a = 0; a < 16; ++a) rev[256 * a + gt] = hb[a] * nb;
        __syncthreads();
        c32 v[16];
#pragma unroll
        for (int a = 0; a < 16; ++a) { const int n = 256 * a + gt; hb[a] = n == 0 ? 0.f : rev[4096 - n]; hf[a] *= nf; v[a] = cmk(hf[a] + hb[a], 0.f); }
        fft_forward(v, W, ex, gt);
        c32* kf = KF + ((size_t)(d * 2 + g) * 2) * 4096; const float fb = fbias[g * 1024 + d] * (1.f / 4096.f);
#pragma unroll
        for (int i = 0; i < 16; ++i) kf[i * 256 + gtv] = cmk(v[i].x + fb, v[i].y);
#define OPX(A) v[A] = mul_to<A>(cmk(hf[A] - hb[A], 0.f), W.tob);
        TO_ALL(OPX)
#undef OPX
        fft_forward(v, W, ex, gt);
#pragma unroll
        for (int i = 0; i < 16; ++i) kf[4096 + i * 256 + gtv] = v[i];
    }
}
__device__ __forceinline__ void long_conv(c32 (&z)[16], const c32* kf, const FftTw& W, c32* ex, int gt) {
    typedef float f32x2v __attribute__((ext_vector_type(2))); typedef __attribute__((address_space(1))) const f32x2v gc32;
    c32 v[16], k[16]; int gk = gt; asm volatile("" : "+v"(gk));
#define OPX(A) v[A] = mul_to<A>(z[A], W.tob);
    TO_ALL(OPX)
#undef OPX
    fft_forward_a(v, W, ex, gt);
    asm volatile("" ::: "memory");
#pragma unroll
    for (int i = 0; i < 16; ++i) { const f32x2v t_ = ((gc32*)kf)[4096 + i * 256 + gk]; k[i] = cmk(t_.x, t_.y); }
    fft_forward_bc(v, W, ex, gt);
#pragma unroll
    for (int i = 0; i < 16; ++i) v[i] = cmul(v[i], k[i]);
    fft_inverse(v, W, ex, gt);
#define OPX(A) v[A] = mul_toc<A>(v[A], W.tob);
    TO_ALL(OPX)
#undef OPX
    fft_forward_a(z, W, ex, gt);
    asm volatile("" ::: "memory");
#pragma unroll
    for (int i = 0; i < 16; ++i) { const f32x2v t_ = ((gc32*)kf)[i * 256 + gk]; k[i] = cmk(t_.x, t_.y); }
    fft_forward_bc(z, W, ex, gt);
#pragma unroll
    for (int i = 0; i < 16; ++i) z[i] = cmul(z[i], k[i]);
    fft_inverse(z, W, ex, gt);
#pragma unroll
    for (int a = 0; a < 16; ++a) z[a] = cadd(z[a], v[a]);
}
struct RawSeq { v4u r[2][2]; };
__device__ __forceinline__ void raw_issue(RawSeq& q, const bf16* urow, int b0, int gt) {
    typedef __attribute__((address_space(1))) const v4u gv4u;
    asm volatile("" : "+v"(gt));
#pragma unroll
    for (int s_ = 0; s_ < 2; ++s_)
#pragma unroll
        for (int i = 0; i < 2; ++i) q.r[s_][i] = *(gv4u*)(urow + (size_t)(b0 + s_) * SEQ + (gt + 256 * i) * 8);
}
__device__ __forceinline__ void stage_conv3(c32 (&o)[16], const RawSeq& q, float w0, float w1, float w2, float cb, bf16* stg, int gt) {
    constexpr int SS = 4112;
    __syncthreads();
#pragma unroll
    for (int s_ = 0; s_ < 2; ++s_) {
#pragma unroll
        for (int i = 0; i < 2; ++i) *(v4u*)(stg + s_ * SS + 8 + (gt + 256 * i) * 8) = q.r[s_][i];
        if (gt == 0) { stg[s_ * SS + 7] = 0; stg[s_ * SS + 4104] = 0; } }
    __syncthreads();
#pragma unroll
    for (int a = 0; a < 16; ++a) { const int t = 256 * a + gt; float r[2];
#pragma unroll
        for (int s_ = 0; s_ < 2; ++s_) { const bf16* sp = stg + s_ * SS + 7 + t; r[s_] = w0 * bf2f(sp[0]) + w1 * bf2f(sp[1]) + w2 * bf2f(sp[2]) + cb; }
        o[a] = cmk(r[0], r[1]); if ((a & 3) == 3) __builtin_amdgcn_sched_barrier(0); }
}
__device__ __forceinline__ void conv_phase(const Ctx& F, const bf16* UT, const c32* KF, const float* convw, const float* convb, bf16* ZT) {
    const int g = __builtin_amdgcn_readfirstlane(F.tid >> 8), gt = F.tid & 255;
    c32* ex = (c32*)(F.lds + RING_OFF + g * 36864);
    bf16* stg = (bf16*)ex;
    FftTw W; fft_twiddles(W, gt, (c32*)(F.lds + RING_OFF + 73728), (c32*)(F.lds + RING_OFF + 110592), F.tid);
    RawSeq raw;
    if (F.vcu < DM) raw_issue(raw, UT + (size_t)(2048 + F.vcu) * T, (2 * g) * 2, gt);
    for (int d = F.vcu; d < DM; d += F.G) {
        const c32* kf0 = KF + ((size_t)(d * 2 + 0) * 2) * 4096; const c32* kf1 = KF + ((size_t)(d * 2 + 1) * 2) * 4096;
        for (int pp = 0; pp < 2; ++pp) { const int b0 = (2 * g + pp) * 2;
            int gtv = gt; asm volatile("" : "+v"(gtv));
            c32 z[16], gate[16];
            { const int c = 2048 + d; stage_conv3(z, raw, convw[c], convw[3072 + c], convw[6144 + c], convb[c], stg, gtv); }
            raw_issue(raw, UT + (size_t)d * T, b0, gtv);
            long_conv(z, kf0, W, ex, gtv);
            { const int c = d; stage_conv3(gate, raw, convw[c], convw[3072 + c], convw[6144 + c], convb[c], stg, gtv); }
            raw_issue(raw, UT + (size_t)(1024 + d) * T, b0, gtv);
#pragma unroll
            for (int a = 0; a < 16; ++a) z[a] = cmk(z[a].x * gate[a].x, z[a].y * gate[a].y);
            long_conv(z, kf1, W, ex, gtv);
            { const int c = 1024 + d; stage_conv3(gate, raw, convw[c], convw[3072 + c], convw[6144 + c], convb[c], stg, gtv); }
            { const int dn = pp == 0 ? d : d + F.G; if (dn < DM) raw_issue(raw, UT + (size_t)(2048 + dn) * T, pp == 0 ? b0 + 2 : (2 * g) * 2, gtv); }
            bf16* zr = ZT + (size_t)d * T + (size_t)b0 * SEQ;
#pragma unroll
            for (int a = 0; a < 16; ++a) { const int t = 256 * a + gtv; const unsigned pk = pk2(z[a].x * gate[a].x, z[a].y * gate[a].y); zr[t] = (bf16)(pk & 0xffffu); zr[SEQ + t] = (bf16)(pk >> 16); }
        }
    }
}
__device__ __forceinline__ void transpose_phase(const Ctx& F, const bf16* ZT, bf16* Z) {
    bf16* tile = (bf16*)(F.lds + RING_OFF + F.wave * 8704);
    const int l = F.lane;
    v4u x[8];
    if (F.gw < 16 * 512) { const int d0 = (F.gw & 15) * 64, t0 = (F.gw >> 4) * 64;
#pragma unroll
        for (int i = 0; i < 8; ++i) x[i] = *(const v4u*)(ZT + (size_t)(d0 + i * 8 + (l >> 3)) * T + t0 + (l & 7) * 8); }
    for (int it = F.gw; it < 16 * 512; it += F.NGW) { const int d0 = (it & 15) * 64, t0 = (it >> 4) * 64;
#pragma unroll
        for (int i = 0; i < 8; ++i) { const int dr = i * 8 + (l >> 3), c = l & 7;
            v2u* p = (v2u*)(tile + dr * 68 + c * 8); v2u a; a.x = x[i].x; a.y = x[i].y; p[0] = a; a.x = x[i].z; a.y = x[i].w; p[1] = a; }
        const int itn = it + F.NGW;
        if (itn < 16 * 512) { const int dn = (itn & 15) * 64, tn = (itn >> 4) * 64;
#pragma unroll
            for (int i = 0; i < 8; ++i) x[i] = *(const v4u*)(ZT + (size_t)(dn + i * 8 + (l >> 3)) * T + tn + (l & 7) * 8); }
        LDS_WAIT();
#pragma unroll
        for (int i = 0; i < 8; ++i) { const int tr = i * 8 + (l >> 3), c = l & 7; unsigned short e[8];
#pragma unroll
            for (int k = 0; k < 8; ++k) e[k] = tile[(c * 8 + k) * 68 + tr];
            v4u o; o.x = e[0] | ((unsigned)e[1] << 16); o.y = e[2] | ((unsigned)e[3] << 16); o.z = e[4] | ((unsigned)e[5] << 16); o.w = e[6] | ((unsigned)e[7] << 16);
            *(v4u*)(Z + (size_t)(t0 + tr) * DM + d0 + c * 8) = o; }
        LDS_WAIT();
    }
}

constexpr int NPH = 22;
#define MOE_PHASES(L) do { \
        const int mb = 8 + 10 * L; \
        if (IN(mb)) { PH_ARGS; const float* mod = WSP(float, WS_MOD) + (size_t)L * 8 * 6144; gu32* cnt = (gu32*)(ws + WS_CTL) + CW_CNT + L * 24 * 64; \
            route_phase(F, WSP(bf16, WS_XR), in[6] + L * 1024, mod + 4 * 1024, mod + 3 * 1024, in[31] + L * 4096, in[32] + L * 4, in[33] + L * 16384, in[34] + L * 16, WSP(bf16, WS_XN2), WSP(int, WS_LIST), WSP(float, WS_WL), cnt); \
            if (L == 0) { __syncthreads();        \
                pg8::Gemm gmh{WSP(bf16, WS_W4S), WSP(bf16, WS_HDNS), 4096, 4096, 256}; pg8::StaticOrder Sh; Sh.init(4096, 4096, F.G, (int)blockIdx.x); pg8::EpiF32 Eh{WSP(float, WS_HT), 4096}; \
                REP(11) pg8::gemm_phase<pg8::EpiF32, pg8::StaticOrder, true, true>(ring, gmh, Sh, Eh, F.tid); } } \
        if (IN(mb) && IN(mb + 2)) xcd_barrier(bar); \
        if (IN(mb + 2)) { PH_ARGS; gu32* cnt = (gu32*)(ws + WS_CTL) + CW_CNT + L * 24 * 64; moe_table(F, cnt); \
              \
            pg8::Gemm gm{WSP(bf16, WS_XN2), (const bf16*)(ws + WS_WGU + (size_t)L * 16 * 512 * 1024), MS_ROWS, 8192, 512}; pg8::MoeOrder S{tinfo, F.G, F.vcu, 0, WSP(int, WS_LIST)}; pg8::EpiSwiGLU E{WSP(bf16, WS_HACT), WSP(float, WS_WL), tinfo}; \
            REP(10) pg8::gemm_phase_gather<pg8::EpiSwiGLU, pg8::MoeOrder, true, true, 5>(ring, gm, S, E, F.tid); } SEAM(mb + 2); \
        if (IN(mb + 3)) { PH_ARGS; gu32* cnt = (gu32*)(ws + WS_CTL) + CW_CNT + L * 24 * 64; moe_table(F, cnt); const float* mod = WSP(float, WS_MOD) + (size_t)L * 8 * 6144; \
            pg8::Gemm gm{WSP(bf16, WS_HACT), WSP(bf16, WS_WDN) + (size_t)L * 24 * 1024 * 512, MS_ROWS, 24 * 1024, 512}; pg8::MoeOrder S{tinfo, F.G, F.vcu, 1, WSP(int, WS_LIST)}; if (L == 0) { pg8::EpiMoeOut<bf16> E{WSP(bf16, WS_XR), WSP(bf16, WS_XR), mod + 5 * 1024, WSP(int, WS_LIST), tinfo}; pg8::gemm_phase<pg8::EpiMoeOut<bf16>, pg8::MoeOrder, true, true>(ring, gm, S, E, F.tid); } \
            else { pg8::EpiMoeOut<float> E{WSP(bf16, WS_XR), out, mod + 5 * 1024, WSP(int, WS_LIST), tinfo}; pg8::gemm_phase<pg8::EpiMoeOut<float>, pg8::MoeOrder, true, true>(ring, gm, S, E, F.tid); } \
            if (L == 0) { __syncthreads(); REP(13) filter_phase(F, WSP(float, WS_HT), in[29], WSP(c32, WS_KF)); }       \
            } \
    } while (0)
struct Args { const float* in[38]; float* out; unsigned char* ws; int ph_lo, ph_hi; };
static_assert(sizeof(Args) == 38 * 8 + 8 + 8 + 8, "Args layout (read back through the kernarg segment pointer)");
__global__ void __launch_bounds__(NTHR, 2) fwd_kernel(Args args) {
    extern __shared__ __attribute__((aligned(16))) unsigned char lds[];
#define MK_CTX(F, tx) Ctx F; F.lds = lds; F.tid = (tx); F.lane = F.tid & 63; F.wave = __builtin_amdgcn_readfirstlane(F.tid >> 6); \
    F.G = gridDim.x; { const int bx = blockIdx.x; F.vcu = (F.G % 8 == 0) ? (bx % 8) * (F.G / 8) + bx / 8 : bx; } F.gw = F.vcu * NWAVES + F.wave; F.NGW = F.G * NWAVES
    for (int u = threadIdx.x; u < (LDS_BYTES - LDSCTL_OFF) / 4; u += NTHR) ((LAS unsigned*)((LAS unsigned char*)lds + LDSCTL_OFF))[u] = 0u;
    __syncthreads();
    const int wave_s_ = __builtin_amdgcn_readfirstlane(threadIdx.x >> 6);
    const int lo = args.ph_lo, hi = args.ph_hi;
    const bool use_bar = (hi - lo) > 1;
    XcdBarrier bar; bar.bar = (unsigned*)(args.ws + WS_CTL) + CW_BAR; bar.x = 0; bar.st = nullptr; bar.w0 = 0;
    if (use_bar) bar = xcd_barrier_post((unsigned*)(args.ws + WS_CTL) + CW_BAR, (volatile LAS unsigned*)((LAS unsigned char*)lds + MISC_OFF) + 8);
    bar.w0 = (wave_s_ == 0) ? 1 : 0;
#ifndef PHMASK
#define PHMASK 0xFFFFFFFFu
#endif
#define IN(k) (((PHMASK >> ((k) >= 18 ? (k) - 10 : (k))) & 1u) && lo <= (k) && (k) < hi)
#ifndef REPMASK
#define REPMASK 0u
#endif
#define NREP(k) (((REPMASK >> (k)) & 1u) ? 2 : 1)
#define REP(k) for (int rep_ = 0; rep_ < NREP(k); ++rep_)
#define SEAM(k) do { if (IN(k) && IN((k) + 1)) xcd_barrier(bar); } while (0)
#define PH_STR2(x) #x
#define PH_STR(x) PH_STR2(x)
#define PH_ARGS int opq_ = 0; asm volatile("; PHMARK line " PH_STR(__LINE__) : "+s"(opq_)); const In in{opq_}; unsigned char* const ws = karg_ws(opq_); float* const out = karg_out(opq_); (void)in; (void)ws; (void)out; int tx_ = wave_s_ * 64 + (int)__builtin_amdgcn_mbcnt_hi(~0u, __builtin_amdgcn_mbcnt_lo(~0u, 0u)); asm volatile("" : "+v"(tx_)); MK_CTX(F, tx_)
#define WSP(type, off) ((type*)(ws + (off)))
    PG8_LAS unsigned char* ring = (PG8_LAS unsigned char*)lds + RING_OFF;
    const PG8_LAS int* tinfo = (const PG8_LAS int*)((PG8_LAS unsigned char*)lds + TINFO_OFF);

    if (IN(0)) { PH_ARGS; REP(0) p0_prologue(F, in, ws); } SEAM(0);

            if (IN(1)) { PH_ARGS; const float* mod = WSP(float, WS_MOD); REP(1) norm_mod_phase(F, in[0], in[5], mod + 1024, mod, WSP(bf16, WS_XN)); } SEAM(1);
            if (IN(2)) { PH_ARGS; pg8::Gemm gm{WSP(bf16, WS_XN), WSP(bf16, WS_WD), T, 512, 1024}; pg8::StaticOrder S; S.init(T, 512, F.G, (int)blockIdx.x);
                pg8::EpiLat E{WSP(bf16, WS_CQN), WSP(bf16, WS_CKVN), WSP(unsigned char, WS_KPE), in[8], in[9], in[13], WSP(float, WS_ROPE), (PG8_LAS float*)((PG8_LAS unsigned char*)lds + EPIX_OFF)};
                REP(2) pg8::gemm_phase<pg8::EpiLat, pg8::StaticOrder, true, true>(ring, gm, S, E, F.tid); }
            if (IN(2) && IN(4)) xcd_barrier(bar);
            if (IN(4)) { PH_ARGS; REP(4) {
                { pg8::Gemm gm{WSP(bf16, WS_CQN), WSP(bf16, WS_WUQ), T, 1536, 256}; pg8::StaticOrder S; S.init(T, 1536, F.G, (int)blockIdx.x); pg8::EpiBf16R E{WSP(bf16, WS_QRAW), 1536, nullptr};
                  pg8::gemm_phase<pg8::EpiBf16R, pg8::StaticOrder, true, true>(ring, gm, S, E, F.tid); }
                { pg8::Gemm gm{WSP(bf16, WS_CKVN), WSP(bf16, WS_WUKV), T, 1024, 128};   pg8::StaticOrder S; S.init(T, 1024, F.G, (int)blockIdx.x);
                  pg8::EpiK8 E{WSP(unsigned char, WS_K8), in[13], (PG8_LAS float*)((PG8_LAS unsigned char*)lds + EPIX_OFF)};
                  pg8::gemm_phase<pg8::EpiK8, pg8::StaticOrder, true, true>(ring, gm, S, E, F.tid); }
                { pg8::Gemm gm{WSP(bf16, WS_WUKV) + 1024 * 128, WSP(bf16, WS_CKVN), 1024, T, 128}; pg8::StaticOrder S; S.init(1024, T, F.G, (int)blockIdx.x);
                  pg8::EpiF8T E{WSP(unsigned char, WS_VT8), T};
                  pg8::gemm_phase<pg8::EpiF8T, pg8::StaticOrder, true, true>(ring, gm, S, E, F.tid); } }
            } if (IN(4) && IN(6)) xcd_barrier(bar);
            if (IN(6)) { PH_ARGS;
                const float* qg = in[12]; const float* kg = in[13];
                float gqn = 0.f, gkn = 0.f, gqp = 0.f, gkp = 0.f;
                for (int i = 0; i < 128; ++i) { gqn = fmaxf(gqn, fabsf(qg[i])); gkn = fmaxf(gkn, fabsf(kg[i])); }
                for (int i = 128; i < 192; ++i) { gqp = fmaxf(gqp, fabsf(qg[i])); gkp = fmaxf(gkp, fabsf(kg[i])); }
                const float smaxC = (128.f * gqn * gkn + 64.f * gqp * gkp) * (0.072168783648703220f * 1.4426950408889634f);
                unsigned redo_mask = 0u;
                if (smaxC < 60.f) for (int rep_ = 0; rep_ < NREP(6); ++rep_) { int i = 0;
                    for (int u = F.vcu; u < 1024; u += F.G, ++i) { const int b = u >> 7, h = (u >> 4) & 7, qb = u & 15;
                        if (att::attn_unit<false>(b, h, qb * 256, WSP(bf16, WS_QRAW), WSP(unsigned char, WS_VT8), WSP(unsigned char, WS_K8), WSP(unsigned char, WS_KPE), WSP(bf16, WS_O), WSP(float, WS_ROPE), qg, smaxC, (char*)lds + RING_OFF, F.tid)) redo_mask |= 1u << (i & 31); } }
                else redo_mask = 0xffffffffu;
                redo_mask = (unsigned)__builtin_amdgcn_readfirstlane((int)redo_mask);
                if (redo_mask) { int i = 0;
                    for (int u = F.vcu; u < 1024; u += F.G, ++i) { const int b = u >> 7, h = (u >> 4) & 7, qb = u & 15;
                        if ((redo_mask >> (i & 31)) & 1u) (void)att::attn_unit<true>(b, h, qb * 256, WSP(bf16, WS_QRAW), WSP(unsigned char, WS_VT8), WSP(unsigned char, WS_K8), WSP(unsigned char, WS_KPE), WSP(bf16, WS_O), WSP(float, WS_ROPE), qg, smaxC, (char*)lds + RING_OFF, F.tid); } }
            } SEAM(6);
            if (IN(7)) { PH_ARGS; pg8::Gemm gm{WSP(bf16, WS_O), WSP(bf16, WS_WO), T, 1024, 1024}; pg8::StaticOrder S; S.init(T, 1024, F.G, (int)blockIdx.x); pg8::EpiResGate<float, bf16> E{in[0], WSP(bf16, WS_XR), WSP(float, WS_MOD) + 2048, 1024};
                REP(7) pg8::gemm_phase<pg8::EpiResGate<float, bf16>, pg8::StaticOrder, true, true>(ring, gm, S, E, F.tid); } SEAM(7);
    MOE_PHASES(0); SEAM(11);
            if (IN(12)) { PH_ARGS; const float* mod = WSP(float, WS_MOD) + 8 * 6144; REP(12) norm_mod_phase(F, WSP(bf16, WS_XR), in[5] + 1024, mod + 1024, mod, (bf16*)out); }
            if (IN(12) && IN(14)) xcd_barrier(bar);
            if (IN(14)) { PH_ARGS; pg8::Gemm gm{WSP(bf16, WS_WIN), (const bf16*)out, 3072, T, 1024}; pg8::StaticOrder S; S.init(3072, T, F.G, (int)blockIdx.x); pg8::EpiBf16R E{WSP(bf16, WS_UT), T, in[16]};
                REP(14) pg8::gemm_phase<pg8::EpiBf16R, pg8::StaticOrder, true, true>(ring, gm, S, E, F.tid); } SEAM(14);
            if (IN(15)) { PH_ARGS; for (int rep = 0; rep < NREP(15); ++rep) conv_phase(F, WSP(bf16, WS_UT), WSP(c32, WS_KF), in[17], in[18], (bf16*)out); } SEAM(15);
            if (IN(16)) { PH_ARGS; REP(16) transpose_phase(F, (const bf16*)out, WSP(bf16, WS_Z)); } SEAM(16);
            if (IN(17)) { PH_ARGS; pg8::Gemm gm{WSP(bf16, WS_Z), WSP(bf16, WS_WOUT), T, 1024, 1024}; pg8::StaticOrder S; S.init(T, 1024, F.G, (int)blockIdx.x); pg8::EpiResGate<bf16, bf16> E{WSP(bf16, WS_XR), WSP(bf16, WS_XR), WSP(float, WS_MOD) + 8 * 6144 + 2048, 1024};
                pg8::gemm_phase<pg8::EpiResGate<bf16, bf16>, pg8::StaticOrder, true, true>(ring, gm, S, E, F.tid); } SEAM(17);
    MOE_PHASES(1);
#undef IN
#undef SEAM
}

#ifndef ONE_LAUNCH
#define ONE_LAUNCH 1
#endif
extern "C" void kernel_launch(void* const* d_in, const int* in_sizes, int n_in, void* d_out, int out_size, void* d_ws, size_t ws_size, hipStream_t stream) {
    static int grid = 0;
    if (grid == 0) {
        if (n_in != 38 || in_sizes[0] != T * DM || out_size != T * DM || ws_size < WS_END) { fprintf(stderr, "kernel_launch: shape mismatch n_in %d in0 %d out %d ws %zu\n", n_in, n_in > 0 ? in_sizes[0] : -1, out_size, ws_size); grid = -1; return; }
        int dev = 0, cus = 0, per_cu = 0;
        if (hipGetDevice(&dev) != hipSuccess || hipDeviceGetAttribute(&cus, hipDeviceAttributeMultiprocessorCount, dev) != hipSuccess) { grid = -1; return; }
        if (hipFuncSetAttribute((const void*)fwd_kernel, hipFuncAttributeMaxDynamicSharedMemorySize, LDS_BYTES) != hipSuccess) { fprintf(stderr, "kernel_launch: hipFuncSetAttribute failed\n"); grid = -1; return; }
        if (hipOccupancyMaxActiveBlocksPerMultiprocessor(&per_cu, (const void*)fwd_kernel, NTHR, LDS_BYTES) != hipSuccess || per_cu < 1) { fprintf(stderr, "kernel_launch: occupancy query says %d\n", per_cu); }
        (void)hipGetLastError();
        grid = cus;
    }
    if (grid < 0) return;
    if (hipMemsetAsync((char*)d_ws + WS_CTL, 0, CTL_ZERO_BYTES, stream) != hipSuccess) return;
    Args a{};
    for (int i = 0; i < 38; ++i) a.in[i] = (const float*)d_in[i];
    a.out = (float*)d_out; a.ws = (unsigned char*)d_ws;
#if ONE_LAUNCH
    a.ph_lo = 0; a.ph_hi = NPH;
    hipLaunchKernelGGL(fwd_kernel, dim3(grid), dim3(NTHR), LDS_BYTES, stream, a);
#else
    for (int p = 0; p < NPH; ++p) { a.ph_lo = p; a.ph_hi = p + 1; hipLaunchKernelGGL(fwd_kernel, dim3(grid), dim3(NTHR), LDS_BYTES, stream, a); }
#endif
    const hipError_t le = hipPeekAtLastError();
    if (le != hipSuccess) fprintf(stderr, "kernel_launch: launch failed: %s\n", hipGetErrorName(le));
}
```

```cpp
#include <hip/hip_runtime.h>
#include <cstdio>
#include <cstdint>
namespace pg8 {
#define PG8_LAS __attribute__((address_space(3)))
typedef unsigned short bf16_t;
typedef short bf16x8 __attribute__((ext_vector_type(8)));
typedef float f32x4 __attribute__((ext_vector_type(4)));
typedef unsigned u32x4 __attribute__((ext_vector_type(4)));
typedef int v4i_t __attribute__((ext_vector_type(4)));
typedef int v8i_t __attribute__((ext_vector_type(8)));
constexpr int BM = 256, BK = 64, HALF = 128, HTB = HALF * BK * 2  , STAGE_BYTES = 8 * HTB, NXCD = 8, WGM = 8;

__host__ __device__ __forceinline__ int lds_byte(int r, int c) { const int st = (r >> 4) * 2 + (c >> 5), rr = r & 15, cc = c & 31, ob = rr * 64 + cc * 2; return st * 1024 + (ob ^ (((ob >> 9) & 1) << 5)); }
__host__ __device__ __forceinline__ void stage_rc(int b, int& R, int& C) { const int st = b / 1024, sb = b % 1024, swz = sb ^ (((sb >> 9) & 1) << 5); R = (st >> 1) * 16 + swz / 64; C = (st & 1) * 32 + (swz % 64) / 2; }
__host__ __device__ __forceinline__ int perm32(int rho) { const int n = rho >> 4, i = rho & 15; return 8 * (i >> 2) + 4 * n + (i & 3); }

struct Unit { int pm, pn; };
struct Gemm { const bf16_t* A; const bf16_t* Bt; int M, N, K; };

struct StaticOrder {
    int nM, nN, nwg, G, c;
    __host__ __device__ void init(int M, int N, int G_, int c_) { nM = M / BM; nN = N / BM; nwg = nM * nN; G = G_; c = c_; }
    __host__ __device__ bool next(int i, Unit& u) const {
        const long L = (long)i * G + c; if (L >= nwg) return false;
        int wgid = (int)L; { const int q = nwg / NXCD, r = nwg % NXCD, xcd = wgid % NXCD, off = wgid / NXCD; wgid = (xcd < r ? xcd * (q + 1) : r * (q + 1) + (xcd - r) * q) + off; }
        const int nig = WGM * nN, gid = wgid / nig, fm = gid * WGM, gsz = (nM - fm) < WGM ? (nM - fm) : WGM;
        u.pm = fm + ((wgid % nig) % gsz); u.pn = (wgid % nig) / gsz; return true;
    }
    __device__ __forceinline__ void a_ready(const Unit&) const {}
    __device__ __forceinline__ void done(const Unit&) const {}
};

__device__ __forceinline__ unsigned cvt_pk_bf16(float lo, float hi) { unsigned r; asm volatile("v_cvt_pk_bf16_f32 %0, %1, %2" : "=v"(r) : "v"(lo), "v"(hi)); return r; }
typedef float f32x2 __attribute__((ext_vector_type(2)));
typedef unsigned u32x2 __attribute__((ext_vector_type(2)));
struct EpiF32 {
    static constexpr bool PERM = false, AFTER_DRAIN = false;
    float* C; int ldc;
    __device__ __forceinline__ void operator()(const f32x4 (&acc)[2][2][4][2], const Unit& u, int wr, int wc, int fr, int fq) const {
        const int row0 = u.pm * BM + wr * 64 + fr, col0 = u.pn * BM + wc * 32 + 4 * fq;
#pragma unroll
        for (int ai = 0; ai < 2; ++ai)
#pragma unroll
            for (int m = 0; m < 4; ++m) { float* rowp = C + (size_t)(row0 + ai * HALF + m * 16) * ldc + col0;
#pragma unroll
                for (int bj = 0; bj < 2; ++bj)
#pragma unroll
                    for (int n = 0; n < 2; ++n) *(f32x4*)(rowp + bj * HALF + n * 16) = acc[ai][bj][m][n]; }
    }
};
struct EpiBf16R {
    static constexpr bool PERM = true, AFTER_DRAIN = false;
    bf16_t* O; int ldc; const float* rowbias;
    __device__ __forceinline__ void operator()(const f32x4 (&acc)[2][2][4][2], const Unit& u, int wr, int wc, int fr, int fq) const {
        const int row0 = u.pm * BM + wr * 64 + fr, col0 = u.pn * BM + wc * 32 + 8 * fq;
#pragma unroll
        for (int ai = 0; ai < 2; ++ai)
#pragma unroll
            for (int m = 0; m < 4; ++m) { const int row = row0 + ai * HALF + m * 16; bf16_t* rowp = O + (size_t)row * ldc + col0; const float rb = rowbias ? rowbias[row] : 0.f;
#pragma unroll
                for (int bj = 0; bj < 2; ++bj) { const f32x4 v0 = acc[ai][bj][m][0] + rb, v1 = acc[ai][bj][m][1] + rb;
                    u32x4 w; w.x = cvt_pk_bf16(v0[0], v0[1]); w.y = cvt_pk_bf16(v0[2], v0[3]); w.z = cvt_pk_bf16(v1[0], v1[1]); w.w = cvt_pk_bf16(v1[2], v1[3]);
                    *(u32x4*)(rowp + bj * HALF) = w; } }
    }
};
__device__ __forceinline__ f32x4 ld4(const float* p) { return *(const f32x4*)p; }
__device__ __forceinline__ f32x4 ld4(const bf16_t* p) { const u32x2 w = *(const u32x2*)p; f32x4 r; r[0] = __uint_as_float(w.x << 16); r[1] = __uint_as_float(w.x & 0xffff0000u); r[2] = __uint_as_float(w.y << 16); r[3] = __uint_as_float(w.y & 0xffff0000u); return r; }
__device__ __forceinline__ void st4(float* p, f32x4 v) { *(f32x4*)p = v; }
__device__ __forceinline__ void st4(bf16_t* p, f32x4 v) { u32x2 w; w.x = cvt_pk_bf16(v[0], v[1]); w.y = cvt_pk_bf16(v[2], v[3]); *(u32x2*)p = w; }
template <class TB, class TO> struct EpiResGate {
    static constexpr bool PERM = false, AFTER_DRAIN = false;
    const TB* base; TO* out; const float* gate; int ldc;
    __device__ __forceinline__ void operator()(const f32x4 (&acc)[2][2][4][2], const Unit& u, int wr, int wc, int fr, int fq) const {
        const int row0 = u.pm * BM + wr * 64 + fr, col0 = u.pn * BM + wc * 32 + 4 * fq;
        const float* gp = gate + (size_t)(u.pm >> 4) * 6144 + col0;
        f32x4 gv[2][2];
#pragma unroll
        for (int bj = 0; bj < 2; ++bj)
#pragma unroll
            for (int n = 0; n < 2; ++n) gv[bj][n] = *(const f32x4*)(gp + bj * HALF + n * 16);
#pragma unroll
        for (int ai = 0; ai < 2; ++ai)
#pragma unroll
            for (int m = 0; m < 4; ++m) { const size_t off = (size_t)(row0 + ai * HALF + m * 16) * ldc + col0;
#pragma unroll
                for (int bj = 0; bj < 2; ++bj)
#pragma unroll
                    for (int n = 0; n < 2; ++n) { const f32x4 bs = ld4(base + off + bj * HALF + n * 16); st4(out + off + bj * HALF + n * 16, bs + gv[bj][n] * acc[ai][bj][m][n]); }
                asm volatile("" ::: "memory"); }
    }
};
struct EpiLat {
    static constexpr bool PERM = false, AFTER_DRAIN = false;
    unsigned char* CQN  ; bf16_t* CKVN; unsigned char* KPE  ; const float* qag; const float* kvag; const float* kng; const float* rope; PG8_LAS float* P;
    __device__ __forceinline__ void operator()(const f32x4 (&acc)[2][2][4][2], const Unit& u, int wr, int wc, int, int) const {
        int ln = (int)__builtin_amdgcn_mbcnt_hi(~0u, __builtin_amdgcn_mbcnt_lo(~0u, 0u)); asm volatile("" : "+v"(ln)); const int fr = ln & 15, fq = ln >> 4;
        const int row0 = u.pm * BM + wr * 64 + fr;
#pragma unroll
        for (int ai = 0; ai < 2; ++ai)
#pragma unroll
            for (int m = 0; m < 4; ++m) { float s0 = 0.f, s1 = 0.f;
#pragma unroll
                for (int n = 0; n < 2; ++n) { const f32x4 a = acc[ai][0][m][n], b = acc[ai][1][m][n];
                    s0 += (a[0] * a[0] + a[1] * a[1]) + (a[2] * a[2] + a[3] * a[3]); s1 += (b[0] * b[0] + b[1] * b[1]) + (b[2] * b[2] + b[3] * b[3]); }
                s0 += __shfl_xor(s0, 16); s0 += __shfl_xor(s0, 32); s1 += __shfl_xor(s1, 16); s1 += __shfl_xor(s1, 32);
                if (fq == 0) { const int rl = ai * HALF + wr * 64 + m * 16 + fr; P[rl * 8 + wc] = s0; P[rl * 8 + 4 + wc] = s1; } }
        asm volatile("s_waitcnt lgkmcnt(0)" ::: "memory"); __builtin_amdgcn_s_barrier(); asm volatile("" ::: "memory");
        const int cl = wc * 32 + 4 * fq;
        if (u.pn == 0) {
            f32x4 g[2][2];
#pragma unroll
            for (int bj = 0; bj < 2; ++bj)
#pragma unroll
                for (int n = 0; n < 2; ++n) g[bj][n] = *(const f32x4*)(qag + bj * HALF + cl + 16 * n);
#pragma unroll
            for (int ai = 0; ai < 2; ++ai)
#pragma unroll
                for (int m = 0; m < 4; ++m) { const int rl = ai * HALF + wr * 64 + m * 16 + fr; const f32x4 pa = *(const PG8_LAS f32x4*)(P + rl * 8), pb = *(const PG8_LAS f32x4*)(P + rl * 8 + 4);
                    const float r = __builtin_amdgcn_rsqf((((pa[0] + pa[1]) + (pa[2] + pa[3])) + ((pb[0] + pb[1]) + (pb[2] + pb[3]))) * (1.f / 256.f) + 1e-6f);
                    unsigned char* rowp = CQN + (size_t)(row0 + ai * HALF + m * 16) * 256 + cl;
#pragma unroll
                    for (int bj = 0; bj < 2; ++bj)
#pragma unroll
                        for (int n = 0; n < 2; ++n) { const f32x4 v = acc[ai][bj][m][n] * r * g[bj][n]; int p = 0; p = __builtin_amdgcn_cvt_pk_fp8_f32(v[0], v[1], p, false); p = __builtin_amdgcn_cvt_pk_fp8_f32(v[2], v[3], p, true); *(int*)(rowp + bj * HALF + 16 * n) = p; } }
        } else {
            f32x4 gk[2], gp[2]; const int e0 = 16 * (wc & 1) + 4 * fq;
#pragma unroll
            for (int n = 0; n < 2; ++n) { gk[n] = *(const f32x4*)(kvag + cl + 16 * n); gp[n] = *(const f32x4*)(kng + 128 + e0 + 32 * n); }
#pragma unroll
            for (int ai = 0; ai < 2; ++ai)
#pragma unroll
                for (int m = 0; m < 4; ++m) { const int rl = ai * HALF + wr * 64 + m * 16 + fr; const f32x4 pa = *(const PG8_LAS f32x4*)(P + rl * 8), pb = *(const PG8_LAS f32x4*)(P + rl * 8 + 4);
                    const float rkv = __builtin_amdgcn_rsqf(((pa[0] + pa[1]) + (pa[2] + pa[3])) * (1.f / 128.f) + 1e-6f), rpe = __builtin_amdgcn_rsqf((pb[0] + pb[1]) * (1.f / 64.f) + 1e-6f);
                    const size_t row = (size_t)(row0 + ai * HALF + m * 16);
#pragma unroll
                    for (int n = 0; n < 2; ++n) { const f32x4 v = acc[ai][0][m][n] * rkv * gk[n]; u32x2 w; w.x = cvt_pk_bf16(v[0], v[1]); w.y = cvt_pk_bf16(v[2], v[3]); *(u32x2*)(CKVN + row * 128 + cl + 16 * n) = w; }
                    if (wc < 2) { const f32x4 x1 = acc[ai][1][m][0] * rpe * gp[0], x2 = acc[ai][1][m][1] * rpe * gp[1];
                        const f32x4 c0 = *(const f32x4*)(rope + row * 64 + e0 * 2), c1 = *(const f32x4*)(rope + row * 64 + e0 * 2 + 4);
                        const float cs[4] = {c0[0], c0[2], c1[0], c1[2]}, sn[4] = {c0[1], c0[3], c1[1], c1[3]};
                        float o1[4], o2[4];
#pragma unroll
                        for (int j = 0; j < 4; ++j) { o1[j] = x1[j] * cs[j] - x2[j] * sn[j]; o2[j] = x1[j] * sn[j] + x2[j] * cs[j]; }
                        int w1 = 0, w2 = 0; w1 = __builtin_amdgcn_cvt_pk_fp8_f32(o1[0], o1[1], w1, false); w1 = __builtin_amdgcn_cvt_pk_fp8_f32(o1[2], o1[3], w1, true); w2 = __builtin_amdgcn_cvt_pk_fp8_f32(o2[0], o2[1], w2, false); w2 = __builtin_amdgcn_cvt_pk_fp8_f32(o2[2], o2[3], w2, true);
                        *(int*)(KPE + row * 64 + e0) = w1; *(int*)(KPE + row * 64 + 32 + e0) = w2; }
                    asm volatile("" ::: "memory"); }
        }
        asm volatile("s_waitcnt lgkmcnt(0)" ::: "memory"); __builtin_amdgcn_s_barrier(); asm volatile("" ::: "memory");
    }
};
struct EpiK8 {
    static constexpr bool PERM = true, AFTER_DRAIN = false;
    unsigned char* K8; const float* kng; PG8_LAS float* P;
    __device__ __forceinline__ void operator()(const f32x4 (&acc)[2][2][4][2], const Unit& u, int wr, int wc, int, int) const {
        int ln = (int)__builtin_amdgcn_mbcnt_hi(~0u, __builtin_amdgcn_mbcnt_lo(~0u, 0u)); asm volatile("" : "+v"(ln)); const int fr = ln & 15, fq = ln >> 4;
#pragma unroll
        for (int ai = 0; ai < 2; ++ai)
#pragma unroll
            for (int m = 0; m < 4; ++m) {
#pragma unroll
                for (int bj = 0; bj < 2; ++bj) { const f32x4 a = acc[ai][bj][m][0], b = acc[ai][bj][m][1];
                    float s = (a[0] * a[0] + a[1] * a[1]) + (a[2] * a[2] + a[3] * a[3]) + (b[0] * b[0] + b[1] * b[1]) + (b[2] * b[2] + b[3] * b[3]);
                    s += __shfl_xor(s, 16); s += __shfl_xor(s, 32);
                    if (fq == 0) P[(ai * HALF + wr * 64 + m * 16 + fr) * 8 + bj * 4 + wc] = s; } }
        asm volatile("s_waitcnt lgkmcnt(0)" ::: "memory"); __builtin_amdgcn_s_barrier(); asm volatile("" ::: "memory");
        const f32x4 g0 = *(const f32x4*)(kng + wc * 32 + 8 * fq), g1 = *(const f32x4*)(kng + wc * 32 + 8 * fq + 4);
        const int row0 = u.pm * BM + wr * 64 + fr;
#pragma unroll
        for (int ai = 0; ai < 2; ++ai)
#pragma unroll
            for (int m = 0; m < 4; ++m) { const int rl = ai * HALF + wr * 64 + m * 16 + fr;
#pragma unroll
                for (int bj = 0; bj < 2; ++bj) { const f32x4 p4 = *(const PG8_LAS f32x4*)(P + rl * 8 + bj * 4);
                    const float r = __builtin_amdgcn_rsqf(((p4[0] + p4[1]) + (p4[2] + p4[3])) * (1.f / 128.f) + 1e-6f);
                    const f32x4 v0 = acc[ai][bj][m][0] * r * g0, v1 = acc[ai][bj][m][1] * r * g1;
                    int w0 = 0, w1 = 0; w0 = __builtin_amdgcn_cvt_pk_fp8_f32(v0[0], v0[1], w0, false); w0 = __builtin_amdgcn_cvt_pk_fp8_f32(v0[2], v0[3], w0, true); w1 = __builtin_amdgcn_cvt_pk_fp8_f32(v1[0], v1[1], w1, false); w1 = __builtin_amdgcn_cvt_pk_fp8_f32(v1[2], v1[3], w1, true);
                    u32x2 w; w.x = (unsigned)w0; w.y = (unsigned)w1; *(u32x2*)(K8 + ((size_t)(row0 + ai * HALF + m * 16) * 8 + 2 * u.pn + bj) * 128 + wc * 32 + 8 * fq) = w; } }
        asm volatile("s_waitcnt lgkmcnt(0)" ::: "memory"); __builtin_amdgcn_s_barrier(); asm volatile("" ::: "memory");
    }
};
struct EpiF8T {
    static constexpr bool PERM = true, AFTER_DRAIN = false;
    unsigned char* O; int ldc;
    __device__ __forceinline__ void operator()(const f32x4 (&acc)[2][2][4][2], const Unit& u, int wr, int wc, int fr, int fq) const {
        const int row0 = u.pm * BM + wr * 64 + fr, col0 = u.pn * BM + wc * 32 + 8 * fq;
#pragma unroll
        for (int ai = 0; ai < 2; ++ai)
#pragma unroll
            for (int m = 0; m < 4; ++m) { unsigned char* rowp = O + (size_t)(row0 + ai * HALF + m * 16) * ldc + col0;
#pragma unroll
                for (int bj = 0; bj < 2; ++bj) { const f32x4 v0 = acc[ai][bj][m][0], v1 = acc[ai][bj][m][1];
                    int w0 = 0, w1 = 0; w0 = __builtin_amdgcn_cvt_pk_fp8_f32(v0[0], v0[1], w0, false); w0 = __builtin_amdgcn_cvt_pk_fp8_f32(v0[2], v0[3], w0, true); w1 = __builtin_amdgcn_cvt_pk_fp8_f32(v1[0], v1[1], w1, false); w1 = __builtin_amdgcn_cvt_pk_fp8_f32(v1[2], v1[3], w1, true);
                    u32x2 w; w.x = (unsigned)w0; w.y = (unsigned)w1; *(u32x2*)(rowp + bj * HALF) = w; } }
    }
};
__device__ __forceinline__ void pair_of(int pi, int& i, int& j) { i = pi < 3 ? 0 : (pi < 5 ? 1 : 2); j = pi < 3 ? pi + 1 : (pi < 5 ? pi - 1 : 3); }
struct MoeOrder {
    const PG8_LAS int* tinfo; int G, c, mode; const int* list;
    __device__ __forceinline__ int tok(const Unit& u, int r) const { const int bk = tinfo[1 + u.pm], pos = u.pm * BM - tinfo[256 + bk] + r; return list[bk * 32768 + (pos < tinfo[288 + bk] ? pos : 0)]; }
    __device__ __forceinline__ bool next(int i, Unit& u) const {
        const long L = (long)i * G + c; const int nt = tinfo[0]; if (L >= 4L * nt) return false;
        const int mt = (int)(L >> 2), q = (int)(L & 3), bk = tinfo[1 + mt];
        u.pm = mt;
        if (mode == 0) { int ii, jj; pair_of(bk % 6, ii, jj); const int e = (bk / 6) * 4 + ((q >> 1) ? jj : ii); u.pn = e * 2 + (q & 1); }
        else u.pn = bk * 4 + q;
        return true;
    }
    __device__ __forceinline__ void a_ready(const Unit&) const {}
    __device__ __forceinline__ void done(const Unit&) const {}
};
struct EpiSwiGLU {
    static constexpr bool PERM = true, AFTER_DRAIN = false;
    bf16_t* H; const float* wl; const PG8_LAS int* tinfo;
    __device__ __forceinline__ void operator()(const f32x4 (&acc)[2][2][4][2], const Unit& u, int wr, int wc, int, int) const {
        int ln = (int)__builtin_amdgcn_mbcnt_hi(~0u, __builtin_amdgcn_mbcnt_lo(~0u, 0u)); asm volatile("" : "+v"(ln)); const int fr = ln & 15, fq = ln >> 4;
        const int bk = tinfo[1 + u.pm]; int ii, jj; pair_of(bk % 6, ii, jj);
        const int e = u.pn >> 1, hh = u.pn & 1, slot = (e == (bk / 6) * 4 + jj) ? 1 : 0;
        const int row0 = u.pm * BM + wr * 64 + fr, col0 = slot * 256 + hh * 128 + wc * 32 + 8 * fq;
#pragma unroll
        for (int ai = 0; ai < 2; ++ai)
#pragma unroll
            for (int m = 0; m < 4; ++m) { const int row = row0 + ai * HALF + m * 16, pos = row - tinfo[256 + bk]; const float w = pos < tinfo[288 + bk] ? wl[((size_t)bk * 32768 + pos) * 2 + slot] : 0.f;
                float a[8];
#pragma unroll
                for (int n = 0; n < 2; ++n)
#pragma unroll
                    for (int j = 0; j < 4; ++j) { const float g = acc[ai][0][m][n][j], up = acc[ai][1][m][n][j];
                        const float sg = g * __builtin_amdgcn_rcpf(1.0f + __builtin_amdgcn_exp2f(-1.4426950408889634f * g)); a[n * 4 + j] = sg * up * w; }
                u32x4 o; o.x = cvt_pk_bf16(a[0], a[1]); o.y = cvt_pk_bf16(a[2], a[3]); o.z = cvt_pk_bf16(a[4], a[5]); o.w = cvt_pk_bf16(a[6], a[7]);
                *(u32x4*)(H + (size_t)row * 512 + col0) = o; asm volatile("" ::: "memory"); }
    }
};
template <class TO> struct EpiMoeOut {
    static constexpr bool PERM = false, AFTER_DRAIN = false;
    const bf16_t* xr; TO* out; const float* gate; const int* list; const PG8_LAS int* tinfo;
    __device__ __forceinline__ void operator()(const f32x4 (&acc)[2][2][4][2], const Unit& u, int wr, int wc, int fr, int fq) const {
        const int bk = tinfo[1 + u.pm], r_end = tinfo[256 + bk] + tinfo[288 + bk];
        const int row0 = u.pm * BM + wr * 64 + fr, col0 = (u.pn & 3) * BM + wc * 32 + 4 * fq;
#pragma unroll
        for (int ai = 0; ai < 2; ++ai)
#pragma unroll
            for (int m = 0; m < 4; ++m) { const int row = row0 + ai * HALF + m * 16;
                if (row < r_end) { const int tok = list[bk * 32768 + row - tinfo[256 + bk]]; TO* op = out + (size_t)tok * 1024 + col0; const bf16_t* xp = xr + (size_t)tok * 1024 + col0; const float* gp = gate + (size_t)(tok >> 12) * 6144 + col0;
#pragma unroll
                    for (int bj = 0; bj < 2; ++bj)
#pragma unroll
                        for (int n = 0; n < 2; ++n) { const f32x4 bs = ld4(xp + bj * HALF + n * 16), gv = *(const f32x4*)(gp + bj * HALF + n * 16); st4(op + bj * HALF + n * 16, bs + gv * acc[ai][bj][m][n]); } }
                asm volatile("" ::: "memory"); }
    }
};
template <class Epi, class Sched, bool ALIGN_EPI = false, bool SP2 = false, int F8 = -1>
__device__ __forceinline__ void gemm_phase(PG8_LAS unsigned char* lds, const Gemm g, const Sched& S, const Epi& E, const int tid_in) {
    int tid = tid_in; asm volatile("" : "+v"(tid));
    const int wid = __builtin_amdgcn_readfirstlane(tid >> 6), lane = tid & 63, wr = wid >> 2, wc = wid & 3, fr = lane & 15, fq = lane >> 4;
    int K = g.K; asm volatile("" : "+s"(K)); const int nt = K / BK;
    unsigned voffA[2], voffB[2];
#pragma unroll
    for (int i = 0; i < 2; ++i) { int R, C; stage_rc(tid * 16 + i * 8192, R, C); const int Rb = Epi::PERM ? ((R & ~31) + perm32(R & 31)) : R;
        voffA[i] = (unsigned)(R * K + C) * 2u; voffB[i] = (unsigned)(Rb * K + C) * 2u; }
    const size_t kstep = (size_t)(BK * 2);
    const size_t hstep = (size_t)HALF * K * 2;
    const size_t tstep = 2 * hstep;
    const unsigned ldsw = (unsigned)wid * 1024u;
    const int aoff = lds_byte(wr * 64 + fr, fq * 8), boff = lds_byte(wc * 32 + fr, fq * 8);
#define PG8_SA(b, h) (((b) * 2 + (h)) * HTB)
#define PG8_SB(b, h) ((4 + (b) * 2 + (h)) * HTB)
#define PG8_STAGE(bufoff, gbase, voff) do { _Pragma("unroll") for (int _i = 0; _i < 2; ++_i) { unsigned vo_ = (voff)[_i]; asm volatile("" : "+v"(vo_));   \
        __builtin_amdgcn_global_load_lds((const unsigned*)((const char*)(gbase) + vo_), (PG8_LAS unsigned*)(lds + (bufoff) + ldsw + _i * 8192), 16, 0, 0); } } while (0)
#define PG8_LDA(dst, b, h) do { _Pragma("unroll") for (int m = 0; m < 4; ++m) { const bf16x8 x0_ = *(const PG8_LAS bf16x8*)(lds + PG8_SA(b, h) + aoff + m * 2048), x1_ = *(const PG8_LAS bf16x8*)(lds + PG8_SA(b, h) + aoff + m * 2048 + 1024); \
        if constexpr (F8 >= 0) dst##8[m] = PG8_CAT(x0_, x1_); else { dst[m][0] = x0_; dst[m][1] = x1_; } } } while (0)
#define PG8_LDB(dst, b, h) do { _Pragma("unroll") for (int n = 0; n < 2; ++n) { const bf16x8 x0_ = *(const PG8_LAS bf16x8*)(lds + PG8_SB(b, h) + boff + n * 2048), x1_ = *(const PG8_LAS bf16x8*)(lds + PG8_SB(b, h) + boff + n * 2048 + 1024); \
        if constexpr (F8 >= 0) dst##8[n] = PG8_CAT(x0_, x1_); else { dst[n][0] = x0_; dst[n][1] = x1_; } } } while (0)
#define PG8_CAT(x0, x1) ({ const v4i_t lo_ = __builtin_bit_cast(v4i_t, x0), hi_ = __builtin_bit_cast(v4i_t, x1); (v8i_t){lo_[0], lo_[1], lo_[2], lo_[3], hi_[0], hi_[1], hi_[2], hi_[3]}; })
#define PG8_MMA(ai, bj, At, Bt) do { __builtin_amdgcn_s_setprio(1); _Pragma("unroll") for (int m = 0; m < 4; ++m) _Pragma("unroll") for (int n = 0; n < 2; ++n) { \
        if constexpr (F8 >= 0) acc[ai][bj][m][n] = __builtin_amdgcn_mfma_scale_f32_16x16x128_f8f6f4(Bt##8[n], At##8[m], acc[ai][bj][m][n], 0, 0, 0, 0x7f7f7f7f, 0, (127 - F8) * 0x01010101); \
        else { _Pragma("unroll") for (int k = 0; k < 2; ++k) acc[ai][bj][m][n] = __builtin_amdgcn_mfma_f32_16x16x32_bf16(Bt[n][k], At[m][k], acc[ai][bj][m][n], 0, 0, 0); } } \
        __builtin_amdgcn_s_setprio(0); } while (0)
#define PG8_WAIT_V(n) asm volatile("s_waitcnt vmcnt(" #n ")" ::: "memory")
#define PG8_WAIT_L(n) asm volatile("s_waitcnt lgkmcnt(" #n ")" ::: "memory")
#define PG8_BAR __builtin_amdgcn_s_barrier()
#define PG8_SCHED __builtin_amdgcn_sched_barrier(0)
    Unit cur, nxt; int ui = 0;
    if (!S.next(0, cur)) return;
    f32x4 acc[2][2][4][2];
#pragma unroll
    for (int a = 0; a < 2; ++a)
#pragma unroll
        for (int b = 0; b < 2; ++b)
#pragma unroll
            for (int m = 0; m < 4; ++m)
#pragma unroll
                for (int n = 0; n < 2; ++n) acc[a][b][m][n] = (f32x4){0.f, 0.f, 0.f, 0.f};
    bf16x8 At[4][2], B0[2][2], B1[2][2]; v8i_t At8[4], B08[2], B18[2];
    const char* cA = (const char*)g.A + (size_t)cur.pm * tstep; const char* cB = (const char*)g.Bt + (size_t)cur.pn * tstep;
    S.a_ready(cur);
    if constexpr (SP2) {
        PG8_STAGE(PG8_SB(0, 0), cB, voffB); PG8_STAGE(PG8_SB(0, 1), cB + hstep, voffB); PG8_STAGE(PG8_SA(0, 0), cA, voffA); PG8_STAGE(PG8_SA(0, 1), cA + hstep, voffA);
        if (wr == 1) PG8_BAR;
        PG8_WAIT_V(2); PG8_BAR;
        PG8_STAGE(PG8_SB(1, 0), cB + kstep, voffB); PG8_STAGE(PG8_SA(1, 0), cA + kstep, voffA); PG8_STAGE(PG8_SB(1, 1), cB + hstep + kstep, voffB);
        PG8_WAIT_V(6); PG8_BAR;
    } else {
        PG8_STAGE(PG8_SB(0, 0), cB, voffB); PG8_STAGE(PG8_SA(0, 0), cA, voffA); PG8_STAGE(PG8_SB(0, 1), cB + hstep, voffB); PG8_STAGE(PG8_SA(0, 1), cA + hstep, voffA);
        if (wr == 1) PG8_BAR;
        PG8_WAIT_V(4); PG8_BAR;
        PG8_STAGE(PG8_SB(1, 0), cB + kstep, voffB); PG8_STAGE(PG8_SA(1, 0), cA + kstep, voffA); PG8_STAGE(PG8_SB(1, 1), cB + hstep + kstep, voffB);
        PG8_WAIT_V(6); PG8_BAR;
    }
    for (;;) {
        const bool has_next = S.next(ui + 1, nxt);
        const char* nA = has_next ? (const char*)g.A + (size_t)nxt.pm * tstep : cA; const char* nB = has_next ? (const char*)g.Bt + (size_t)nxt.pn * tstep : cB;
        for (int t = 0; t < nt; t += 2) {
            const bool last = (t == nt - 2);
            const char* a1 = cA + (size_t)(t + 1) * kstep;
            const char* a2 = last ? nA : cA + (size_t)(t + 2) * kstep; const char* b2 = last ? nB : cB + (size_t)(t + 2) * kstep;
            const char* a3 = a2 + kstep; const char* b3 = b2 + kstep;
            if (last && has_next) S.a_ready(nxt);
            if constexpr (SP2) {
            PG8_LDB(B0, 0, 0); PG8_LDB(B1, 0, 1); PG8_SCHED; PG8_LDA(At, 0, 0); PG8_STAGE(PG8_SA(1, 1), a1 + hstep, voffA);
            PG8_WAIT_V(8); PG8_WAIT_L(0); PG8_BAR; PG8_MMA(0, 0, At, B0); PG8_MMA(0, 1, At, B1); PG8_BAR; PG8_SCHED;
            PG8_LDA(At, 0, 1); PG8_STAGE(PG8_SB(0, 0), b2, voffB); PG8_STAGE(PG8_SB(0, 1), b2 + hstep, voffB); PG8_STAGE(PG8_SA(0, 0), a2, voffA);
            PG8_WAIT_V(8); PG8_WAIT_L(0); PG8_BAR; PG8_MMA(1, 0, At, B0); PG8_MMA(1, 1, At, B1); PG8_BAR; PG8_SCHED;
            PG8_LDB(B0, 1, 0); PG8_LDB(B1, 1, 1); PG8_SCHED; PG8_LDA(At, 1, 0); PG8_STAGE(PG8_SA(0, 1), a2 + hstep, voffA);
            PG8_WAIT_V(8); PG8_WAIT_L(0); PG8_BAR; PG8_MMA(0, 0, At, B0); PG8_MMA(0, 1, At, B1); PG8_BAR; PG8_SCHED;
            PG8_LDA(At, 1, 1); PG8_STAGE(PG8_SB(1, 0), b3, voffB); PG8_STAGE(PG8_SB(1, 1), b3 + hstep, voffB); PG8_STAGE(PG8_SA(1, 0), a3, voffA);
            PG8_WAIT_V(8); PG8_WAIT_L(0); PG8_BAR; PG8_MMA(1, 0, At, B0); PG8_MMA(1, 1, At, B1); PG8_BAR; PG8_SCHED;
            } else {
            PG8_LDB(B0, 0, 0); PG8_SCHED; PG8_LDA(At, 0, 0); PG8_STAGE(PG8_SA(1, 1), a1 + hstep, voffA);
            PG8_WAIT_L(8); PG8_BAR; PG8_WAIT_L(0); PG8_MMA(0, 0, At, B0); PG8_BAR; PG8_SCHED;
            PG8_LDB(B1, 0, 1); PG8_STAGE(PG8_SB(0, 0), b2, voffB);
            PG8_BAR; PG8_WAIT_L(0); PG8_MMA(0, 1, At, B1); PG8_BAR;
            PG8_LDA(At, 0, 1); PG8_STAGE(PG8_SA(0, 0), a2, voffA);
            PG8_BAR; PG8_WAIT_L(0); PG8_MMA(1, 0, At, B0); PG8_BAR; PG8_SCHED;
            PG8_STAGE(PG8_SB(0, 1), b2 + hstep, voffB);
            PG8_WAIT_V(6); PG8_BAR; PG8_MMA(1, 1, At, B1); PG8_BAR;
            PG8_LDB(B0, 1, 0); PG8_SCHED; PG8_LDA(At, 1, 0); PG8_STAGE(PG8_SA(0, 1), a2 + hstep, voffA);
            PG8_WAIT_L(8); PG8_BAR; PG8_WAIT_L(0); PG8_MMA(0, 0, At, B0); PG8_BAR; PG8_SCHED;
            PG8_LDB(B1, 1, 1); PG8_STAGE(PG8_SB(1, 0), b3, voffB);
            PG8_BAR; PG8_WAIT_L(0); PG8_MMA(0, 1, At, B1); PG8_BAR;
            PG8_LDA(At, 1, 1); PG8_STAGE(PG8_SA(1, 0), a3, voffA);
            PG8_BAR; PG8_WAIT_L(0); PG8_MMA(1, 0, At, B0); PG8_BAR; PG8_SCHED;
            PG8_STAGE(PG8_SB(1, 1), b3 + hstep, voffB);
            PG8_WAIT_V(6); PG8_BAR; PG8_MMA(1, 1, At, B1); PG8_BAR;
            }
        }
        if constexpr (ALIGN_EPI) { if (wr == 0) PG8_BAR; }
        if constexpr (!Epi::AFTER_DRAIN) { E(acc, cur, wr, wc, fr, fq); S.done(cur); }
        if (!has_next) break;
#pragma unroll
        for (int a = 0; a < 2; ++a)
#pragma unroll
            for (int b = 0; b < 2; ++b)
#pragma unroll
                for (int m = 0; m < 4; ++m)
#pragma unroll
                    for (int n = 0; n < 2; ++n) acc[a][b][m][n] = (f32x4){0.f, 0.f, 0.f, 0.f};
        cur = nxt; cA = nA; cB = nB; ++ui;
        if constexpr (ALIGN_EPI) { if (wr == 1) PG8_BAR; }
    }
    PG8_WAIT_V(0);
    if constexpr (!ALIGN_EPI) { if (wr == 0) PG8_BAR; }
    PG8_BAR;
    if constexpr (Epi::AFTER_DRAIN) { E.fused(acc, cur, wr, wc, fr, fq, lds, wid, lane); S.done(cur); }
#undef PG8_SA
#undef PG8_SB
#undef PG8_STAGE
#undef PG8_LDA
#undef PG8_LDB
#undef PG8_MMA
#undef PG8_WAIT_V
#undef PG8_WAIT_L
#undef PG8_BAR
#undef PG8_SCHED
}
template <class Epi, class Sched, bool ALIGN_EPI = true, bool SP2 = true, int F8 = -1>
__device__ __forceinline__ void gemm_phase_gather(PG8_LAS unsigned char* lds, const Gemm g, const Sched& S, const Epi& E, const int tid_in) {
    int tid = tid_in; asm volatile("" : "+v"(tid));
    static_assert(SP2, "gather form: SP2 loop only");
    const int wid = __builtin_amdgcn_readfirstlane(tid >> 6), lane = tid & 63, wr = wid >> 2, wc = wid & 3, fr = lane & 15, fq = lane >> 4;
    int K = g.K; asm volatile("" : "+s"(K)); const int nt = K / BK;
    unsigned voffA[2], voffB[2];
#pragma unroll
    for (int i = 0; i < 2; ++i) { int R, C; stage_rc(tid * 16 + i * 8192, R, C); const int Rb = Epi::PERM ? ((R & ~31) + perm32(R & 31)) : R;
        voffA[i] = (unsigned)(R * K + C) * 2u; voffB[i] = (unsigned)(Rb * K + C) * 2u; }
    int gR, gC; stage_rc(tid * 16, gR, gC);
    unsigned vG[2][2], vN[2][2];
    const size_t kstep = (size_t)(BK * 2);
    const size_t hstep = (size_t)HALF * K * 2;
    const size_t tstep = 2 * hstep;
    const unsigned ldsw = (unsigned)wid * 1024u;
    const int aoff = lds_byte(wr * 64 + fr, fq * 8), boff = lds_byte(wc * 32 + fr, fq * 8);
#define PG8_SA(b, h) (((b) * 2 + (h)) * HTB)
#define PG8_SB(b, h) ((4 + (b) * 2 + (h)) * HTB)
#define PG8_STAGE(bufoff, gbase, voff) do { _Pragma("unroll") for (int _i = 0; _i < 2; ++_i) { unsigned vo_ = (voff)[_i]; asm volatile("" : "+v"(vo_));   \
        __builtin_amdgcn_global_load_lds((const unsigned*)((const char*)(gbase) + vo_), (PG8_LAS unsigned*)(lds + (bufoff) + ldsw + _i * 8192), 16, 0, 0); } } while (0)
#define PG8_LDA(dst, b, h) do { _Pragma("unroll") for (int m = 0; m < 4; ++m) { const bf16x8 x0_ = *(const PG8_LAS bf16x8*)(lds + PG8_SA(b, h) + aoff + m * 2048), x1_ = *(const PG8_LAS bf16x8*)(lds + PG8_SA(b, h) + aoff + m * 2048 + 1024); \
        if constexpr (F8 >= 0) dst##8[m] = PG8_CAT(x0_, x1_); else { dst[m][0] = x0_; dst[m][1] = x1_; } } } while (0)
#define PG8_LDB(dst, b, h) do { _Pragma("unroll") for (int n = 0; n < 2; ++n) { const bf16x8 x0_ = *(const PG8_LAS bf16x8*)(lds + PG8_SB(b, h) + boff + n * 2048), x1_ = *(const PG8_LAS bf16x8*)(lds + PG8_SB(b, h) + boff + n * 2048 + 1024); \
        if constexpr (F8 >= 0) dst##8[n] = PG8_CAT(x0_, x1_); else { dst[n][0] = x0_; dst[n][1] = x1_; } } } while (0)
#define PG8_CAT(x0, x1) ({ const v4i_t lo_ = __builtin_bit_cast(v4i_t, x0), hi_ = __builtin_bit_cast(v4i_t, x1); (v8i_t){lo_[0], lo_[1], lo_[2], lo_[3], hi_[0], hi_[1], hi_[2], hi_[3]}; })
#define PG8_MMA(ai, bj, At, Bt) do { __builtin_amdgcn_s_setprio(1); _Pragma("unroll") for (int m = 0; m < 4; ++m) _Pragma("unroll") for (int n = 0; n < 2; ++n) { \
        if constexpr (F8 >= 0) acc[ai][bj][m][n] = __builtin_amdgcn_mfma_scale_f32_16x16x128_f8f6f4(Bt##8[n], At##8[m], acc[ai][bj][m][n], 0, 0, 0, 0x7f7f7f7f, 0, (127 - F8) * 0x01010101); \
        else { _Pragma("unroll") for (int k = 0; k < 2; ++k) acc[ai][bj][m][n] = __builtin_amdgcn_mfma_f32_16x16x32_bf16(Bt[n][k], At[m][k], acc[ai][bj][m][n], 0, 0, 0); } } \
        __builtin_amdgcn_s_setprio(0); } while (0)
#define PG8_WAIT_V(n) asm volatile("s_waitcnt vmcnt(" #n ")" ::: "memory")
#define PG8_WAIT_L(n) asm volatile("s_waitcnt lgkmcnt(" #n ")" ::: "memory")
#define PG8_BAR __builtin_amdgcn_s_barrier()
#define PG8_SCHED __builtin_amdgcn_sched_barrier(0)
    Unit cur, nxt; int ui = 0;
    if (!S.next(0, cur)) return;
    f32x4 acc[2][2][4][2];
#pragma unroll
    for (int a = 0; a < 2; ++a)
#pragma unroll
        for (int b = 0; b < 2; ++b)
#pragma unroll
            for (int m = 0; m < 4; ++m)
#pragma unroll
                for (int n = 0; n < 2; ++n) acc[a][b][m][n] = (f32x4){0.f, 0.f, 0.f, 0.f};
    bf16x8 At[4][2], B0[2][2], B1[2][2]; v8i_t At8[4], B08[2], B18[2];
    const char* cA = (const char*)g.A; const char* cB = (const char*)g.Bt + (size_t)cur.pn * tstep;
    S.a_ready(cur);
#pragma unroll
    for (int h = 0; h < 2; ++h)
#pragma unroll
        for (int i = 0; i < 2; ++i) vG[h][i] = (unsigned)S.tok(cur, h * HALF + gR + 64 * i) * (unsigned)(K * 2) + (unsigned)(gC * 2);
    if constexpr (SP2) {
        PG8_STAGE(PG8_SB(0, 0), cB, voffB); PG8_STAGE(PG8_SB(0, 1), cB + hstep, voffB); PG8_STAGE(PG8_SA(0, 0), cA, vG[0]); PG8_STAGE(PG8_SA(0, 1), cA, vG[1]);
        if (wr == 1) PG8_BAR;
        PG8_WAIT_V(2); PG8_BAR;
        PG8_STAGE(PG8_SB(1, 0), cB + kstep, voffB); PG8_STAGE(PG8_SA(1, 0), cA + kstep, vG[0]); PG8_STAGE(PG8_SB(1, 1), cB + hstep + kstep, voffB);
        PG8_WAIT_V(6); PG8_BAR;
    } else {
        PG8_STAGE(PG8_SB(0, 0), cB, voffB); PG8_STAGE(PG8_SA(0, 0), cA, voffA); PG8_STAGE(PG8_SB(0, 1), cB + hstep, voffB); PG8_STAGE(PG8_SA(0, 1), cA + hstep, voffA);
        if (wr == 1) PG8_BAR;
        PG8_WAIT_V(4); PG8_BAR;
        PG8_STAGE(PG8_SB(1, 0), cB + kstep, voffB); PG8_STAGE(PG8_SA(1, 0), cA + kstep, voffA); PG8_STAGE(PG8_SB(1, 1), cB + hstep + kstep, voffB);
        PG8_WAIT_V(6); PG8_BAR;
    }
    for (;;) {
        const bool has_next = S.next(ui + 1, nxt);
        const char* nA = cA; const char* nB = has_next ? (const char*)g.Bt + (size_t)nxt.pn * tstep : cB;
        for (int t = 0; t < nt; t += 2) {
            const bool last = (t == nt - 2);
            const char* a1 = cA + (size_t)(t + 1) * kstep;
            const char* a2 = last ? nA : cA + (size_t)(t + 2) * kstep; const char* b2 = last ? nB : cB + (size_t)(t + 2) * kstep;
            const char* a3 = a2 + kstep; const char* b3 = b2 + kstep;
            if (last && has_next) { S.a_ready(nxt);
#pragma unroll
                for (int h = 0; h < 2; ++h)
#pragma unroll
                    for (int i = 0; i < 2; ++i) vN[h][i] = (unsigned)S.tok(nxt, h * HALF + gR + 64 * i) * (unsigned)(K * 2) + (unsigned)(gC * 2); }
            if constexpr (SP2) {
            PG8_LDB(B0, 0, 0); PG8_LDB(B1, 0, 1); PG8_SCHED; PG8_LDA(At, 0, 0); PG8_STAGE(PG8_SA(1, 1), a1, vG[1]);
            if (last && has_next) { vG[0][0] = vN[0][0]; vG[0][1] = vN[0][1]; vG[1][0] = vN[1][0]; vG[1][1] = vN[1][1]; }
            PG8_WAIT_V(8); PG8_WAIT_L(0); PG8_BAR; PG8_MMA(0, 0, At, B0); PG8_MMA(0, 1, At, B1); PG8_BAR; PG8_SCHED;
            PG8_LDA(At, 0, 1); PG8_STAGE(PG8_SB(0, 0), b2, voffB); PG8_STAGE(PG8_SB(0, 1), b2 + hstep, voffB); PG8_STAGE(PG8_SA(0, 0), a2, vG[0]);
            PG8_WAIT_V(8); PG8_WAIT_L(0); PG8_BAR; PG8_MMA(1, 0, At, B0); PG8_MMA(1, 1, At, B1); PG8_BAR; PG8_SCHED;
            PG8_LDB(B0, 1, 0); PG8_LDB(B1, 1, 1); PG8_SCHED; PG8_LDA(At, 1, 0); PG8_STAGE(PG8_SA(0, 1), a2, vG[1]);
            PG8_WAIT_V(8); PG8_WAIT_L(0); PG8_BAR; PG8_MMA(0, 0, At, B0); PG8_MMA(0, 1, At, B1); PG8_BAR; PG8_SCHED;
            PG8_LDA(At, 1, 1); PG8_STAGE(PG8_SB(1, 0), b3, voffB); PG8_STAGE(PG8_SB(1, 1), b3 + hstep, voffB); PG8_STAGE(PG8_SA(1, 0), a3, vG[0]);
            PG8_WAIT_V(8); PG8_WAIT_L(0); PG8_BAR; PG8_MMA(1, 0, At, B0); PG8_MMA(1, 1, At, B1); PG8_BAR; PG8_SCHED;
            } else {
            PG8_LDB(B0, 0, 0); PG8_SCHED; PG8_LDA(At, 0, 0); PG8_STAGE(PG8_SA(1, 1), a1 + hstep, voffA);
            PG8_WAIT_L(8); PG8_BAR; PG8_WAIT_L(0); PG8_MMA(0, 0, At, B0); PG8_BAR; PG8_SCHED;
            PG8_LDB(B1, 0, 1); PG8_STAGE(PG8_SB(0, 0), b2, voffB);
            PG8_BAR; PG8_WAIT_L(0); PG8_MMA(0, 1, At, B1); PG8_BAR;
            PG8_LDA(At, 0, 1); PG8_STAGE(PG8_SA(0, 0), a2, voffA);
            PG8_BAR; PG8_WAIT_L(0); PG8_MMA(1, 0, At, B0); PG8_BAR; PG8_SCHED;
            PG8_STAGE(PG8_SB(0, 1), b2 + hstep, voffB);
            PG8_WAIT_V(6); PG8_BAR; PG8_MMA(1, 1, At, B1); PG8_BAR;
            PG8_LDB(B0, 1, 0); PG8_SCHED; PG8_LDA(At, 1, 0); PG8_STAGE(PG8_SA(0, 1), a2 + hstep, voffA);
            PG8_WAIT_L(8); PG8_BAR; PG8_WAIT_L(0); PG8_MMA(0, 0, At, B0); PG8_BAR; PG8_SCHED;
            PG8_LDB(B1, 1, 1); PG8_STAGE(PG8_SB(1, 0), b3, voffB);
            PG8_BAR; PG8_WAIT_L(0); PG8_MMA(0, 1, At, B1); PG8_BAR;
            PG8_LDA(At, 1, 1); PG8_STAGE(PG8_SA(1, 0), a3, voffA);
            PG8_BAR; PG8_WAIT_L(0); PG8_MMA(1, 0, At, B0); PG8_BAR; PG8_SCHED;
            PG8_STAGE(PG8_SB(1, 1), b3 + hstep, voffB);
            PG8_WAIT_V(6); PG8_BAR; PG8_MMA(1, 1, At, B1); PG8_BAR;
            }
        }
        if constexpr (ALIGN_EPI) { if (wr == 0) PG8_BAR; }
        if constexpr (!Epi::AFTER_DRAIN) { E(acc, cur, wr, wc, fr, fq); S.done(cur); }
        if (!has_next) break;
#pragma unroll
        for (int a = 0; a < 2; ++a)
#pragma unroll
            for (int b = 0; b < 2; ++b)
#pragma unroll
                for (int m = 0; m < 4; ++m)
#pragma unroll
                    for (int n = 0; n < 2; ++n) acc[a][b][m][n] = (f32x4){0.f, 0.f, 0.f, 0.f};
        cur = nxt; cA = nA; cB = nB; ++ui;
        if constexpr (ALIGN_EPI) { if (wr == 1) PG8_BAR; }
    }
    PG8_WAIT_V(0);
    if constexpr (!ALIGN_EPI) { if (wr == 0) PG8_BAR; }
    PG8_BAR;
    if constexpr (Epi::AFTER_DRAIN) { E.fused(acc, cur, wr, wc, fr, fq, lds, wid, lane); S.done(cur); }
#undef PG8_SA
#undef PG8_SB
#undef PG8_STAGE
#undef PG8_LDA
#undef PG8_LDB
#undef PG8_MMA
#undef PG8_WAIT_V
#undef PG8_WAIT_L
#undef PG8_BAR
#undef PG8_SCHED
}
}
namespace att {
typedef unsigned short bf16;
using bf16x8 = __attribute__((ext_vector_type(8))) short;
using s16x4  = __attribute__((ext_vector_type(4))) short;
using f32x16 = __attribute__((ext_vector_type(16))) float;
using u32x4  = __attribute__((ext_vector_type(4))) unsigned;
using f32x4_t = __attribute__((ext_vector_type(4))) float;
constexpr int NW = 8, QBLK = 32, KVBLK = 64, SEQ = 4096;
constexpr int LDQ = 1536, LDKV = 2048, LDO = 1024;
constexpr int SHM_VT = 128 * 80, SHM_K8 = 64 * 208;
constexpr int OFF_V = 0, OFF_K8 = 3 * SHM_VT, OFF_WS = OFF_K8 + 2 * SHM_K8, LDS_BYTES = OFF_WS + NW * 64 * 4 + 64;
typedef int v8i32 __attribute__((ext_vector_type(8)));
typedef int v4i32 __attribute__((ext_vector_type(4)));
typedef int v2i32 __attribute__((ext_vector_type(2)));
constexpr int T_TOK = 8 * SEQ;
#define ASBAR() __builtin_amdgcn_sched_barrier(0)
__device__ __forceinline__ int crow(int r, int hi) { return (r & 3) + 8 * (r >> 2) + 4 * hi; }
__device__ __forceinline__ unsigned cvtpk(float lo, float hi) { unsigned r; asm volatile("v_cvt_pk_bf16_f32 %0, %1, %2" : "=v"(r) : "v"(lo), "v"(hi)); return r; }
__device__ __forceinline__ float bf2f(unsigned short b) { return __uint_as_float(((unsigned)b) << 16); }
template <bool SHIFT> __device__ __forceinline__ void smA(f32x16& p0, float negm) { for (int r = 0; r < 16; ++r) p0[r] = __builtin_amdgcn_exp2f(SHIFT ? p0[r] + negm : p0[r]); }
template <bool SHIFT> __device__ __forceinline__ void smB(f32x16& p0, f32x16& p1, float& l_reg, v8i32& p8, float negm) {
  for (int r = 0; r < 16; ++r) p1[r] = __builtin_amdgcn_exp2f(SHIFT ? p1[r] + negm : p1[r]);
  float ps = 0; for (int r = 0; r < 16; ++r) ps += p0[r]; for (int r = 0; r < 16; ++r) ps += p1[r];
  l_reg += ps;
#pragma unroll
  for (int w = 0; w < 4; ++w) { int a = 0, bq = 0;
    a = __builtin_amdgcn_cvt_pk_bf8_f32(p0[4 * w], p0[4 * w + 1], a, false); a = __builtin_amdgcn_cvt_pk_bf8_f32(p0[4 * w + 2], p0[4 * w + 3], a, true);
    bq = __builtin_amdgcn_cvt_pk_bf8_f32(p1[4 * w], p1[4 * w + 1], bq, false); bq = __builtin_amdgcn_cvt_pk_bf8_f32(p1[4 * w + 2], p1[4 * w + 3], bq, true);
    p8[w] = a; p8[4 + w] = bq; }
}
template <bool SHIFT> __device__ __forceinline__ void qkt(f32x16& p0, f32x16& p1, const char* K8, const v8i32* q8, float negm, int r32, int hi) {
  p0 = f32x16{}; p1 = f32x16{};
#define K8RD(m, half, part) (*reinterpret_cast<const v4i32*>(K8 + ((half) * 32 + r32) * 208 + (m) * 64 + hi * 32 + (part) * 16))
#define K8FR(m, half) ({ const v4i32 lo_ = K8RD(m, half, 0), hi_ = K8RD(m, half, 1); (v8i32){lo_[0], lo_[1], lo_[2], lo_[3], hi_[0], hi_[1], hi_[2], hi_[3]}; })
  v8i32 a0 = K8FR(0, 0), a1 = K8FR(0, 1), b0 = K8FR(1, 0), b1 = K8FR(1, 1);
  ASBAR();
  p0 = __builtin_amdgcn_mfma_scale_f32_32x32x64_f8f6f4(a0, q8[0], p0, 0, 0, 0, 0x7f7f7f7f, 0, 0x7f7f7f7f);
  p1 = __builtin_amdgcn_mfma_scale_f32_32x32x64_f8f6f4(a1, q8[0], p1, 0, 0, 0, 0x7f7f7f7f, 0, 0x7f7f7f7f);
  a0 = K8FR(2, 0); a1 = K8FR(2, 1);
  ASBAR();
  p0 = __builtin_amdgcn_mfma_scale_f32_32x32x64_f8f6f4(b0, q8[1], p0, 0, 0, 0, 0x7f7f7f7f, 0, 0x7f7f7f7f);
  p1 = __builtin_amdgcn_mfma_scale_f32_32x32x64_f8f6f4(b1, q8[1], p1, 0, 0, 0, 0x7f7f7f7f, 0, 0x7f7f7f7f);
  ASBAR();
  p0 = __builtin_amdgcn_mfma_scale_f32_32x32x64_f8f6f4(a0, q8[2], p0, 0, 0, 0, 0x7f7f7f7f, 0, 0x7f7f7f7f);
  p1 = __builtin_amdgcn_mfma_scale_f32_32x32x64_f8f6f4(a1, q8[2], p1, 0, 0, 0, 0x7f7f7f7f, 0, 0x7f7f7f7f);
  ASBAR();
#undef K8RD
#undef K8FR
}
__device__ __forceinline__ void pv_d0(f32x16* o, const char* VT, v8i32 p8, int r32, int hi) {
#define VTFR(d0) ({ const v4i32 lo_ = *reinterpret_cast<const v4i32*>(VT + ((d0) * 32 + r32) * 80 + hi * 32), hi_ = *reinterpret_cast<const v4i32*>(VT + ((d0) * 32 + r32) * 80 + hi * 32 + 16); (v8i32){lo_[0], lo_[1], lo_[2], lo_[3], hi_[0], hi_[1], hi_[2], hi_[3]}; })
#define PVMMA(d0, fr) o[d0] = __builtin_amdgcn_mfma_scale_f32_32x32x64_f8f6f4(p8, fr, o[d0], 1  , 0  , 0, 0x7f7f7f7f, 0, 0x7f7f7f7f)
  v8i32 fa = VTFR(0), fb = VTFR(1);
  ASBAR();
  PVMMA(0, fa); fa = VTFR(2); ASBAR();
  PVMMA(1, fb); fb = VTFR(3); ASBAR();
  PVMMA(2, fa); PVMMA(3, fb); ASBAR();
#undef VTFR
#undef PVMMA
}
template <bool SHIFT> __device__ __forceinline__ bool attn_unit(int b, int h, int s0, const bf16* Qraw, const unsigned char* __restrict__ VT8g, const unsigned char* __restrict__ K8g, const unsigned char* __restrict__ KP8g, bf16* __restrict__ O,
                                          const float* rope, const float* qg, float smaxC, char* lds, int tid) {
  asm volatile("" : "+v"(tid));
  const int wid = __builtin_amdgcn_readfirstlane(tid >> 6), lane = tid & 63, r32 = lane & 31, hi = lane >> 5;
  asm volatile("" : "+s"(qg));
  char* V_lds = lds + OFF_V; char* K8_lds = lds + OFF_K8;
  float* ws = (float*)(lds + OFF_WS) + wid * 64; float* li_l = ws;
  constexpr float C = 0.072168783648703220f * 1.4426950408889634f;
  v8i32 q8[3];
  {
    typedef __attribute__((address_space(1))) const bf16x8 gbf16x8; typedef __attribute__((address_space(1))) const f32x4_t gf32x4;
    const long trow = (long)b * SEQ + s0 + wid * QBLK + r32;
    unsigned qo = (unsigned)((trow * LDQ + h * 192) * 2); const unsigned ro = (unsigned)(trow * 256), go = (unsigned)(hi * 128);
#define Qn_(i) (*(gbf16x8*)((const char*)Qraw + qo + hi * 64 + (i) * 16))
#define Qr_(i) (*(gbf16x8*)((const char*)Qraw + qo + 256 + (i) * 16))
#define rp4_(i) (*(gf32x4*)((const char*)rope + ro + (i) * 16))
#define qgn_(i) (*(gf32x4*)((const char*)qg + go + (i) * 16))
#define qgr_(i) (*(gf32x4*)((const char*)qg + 512 + (i) * 16))
    float ssn = 0.f, ssp = 0.f;
#pragma unroll
    for (int c = 0; c < 8; ++c) { const bf16x8 a = Qn_((c >> 2) * 8 + (c & 3)), r = Qr_(c);
#pragma unroll
      for (int j = 0; j < 8; ++j) { const float f = bf2f((unsigned short)a[j]), g = bf2f((unsigned short)r[j]); ssn += f * f; ssp += g * g; } }
    ssn += __shfl_xor(ssn, 32);
    const float rn = rsqrtf(ssn * (1.f / 128.f) + 1e-6f) * C, rp = rsqrtf(ssp * (1.f / 64.f) + 1e-6f) * C;
    { float rn_ = rn, rp_ = rp; asm volatile("" : "+v"(qo), "+v"(rn_), "+v"(rp_) :: "memory"); }
#pragma unroll
    for (int m = 0; m < 2; ++m)
#pragma unroll
      for (int c = 0; c < 4; ++c) { const bf16x8 raw = Qn_(8 * m + c); const f32x4_t ga = qgn_(16 * m + 2 * c), gb = qgn_(16 * m + 2 * c + 1); float g[8];
#pragma unroll
        for (int j = 0; j < 8; ++j) g[j] = bf2f((unsigned short)raw[j]) * rn * (j < 4 ? ga[j & 3] : gb[j & 3]);
        int w0 = 0, w1 = 0; w0 = __builtin_amdgcn_cvt_pk_fp8_f32(g[0], g[1], w0, false); w0 = __builtin_amdgcn_cvt_pk_fp8_f32(g[2], g[3], w0, true);
        w1 = __builtin_amdgcn_cvt_pk_fp8_f32(g[4], g[5], w1, false); w1 = __builtin_amdgcn_cvt_pk_fp8_f32(g[6], g[7], w1, true);
        asm volatile("" : "+v"(w0), "+v"(w1) :: "memory");        q8[m][2 * c] = w0; q8[m][2 * c + 1] = w1; }
#pragma unroll
    for (int c = 0; c < 4; ++c) {
      const bf16x8 r1 = Qr_(c), r2 = Qr_(4 + c);
      const f32x4_t g1a = qgr_(2 * c), g1b = qgr_(2 * c + 1), g2a = qgr_(8 + 2 * c), g2b = qgr_(8 + 2 * c + 1); float ov[8];
#pragma unroll
      for (int j = 0; j < 8; ++j) { const f32x4_t cs4 = rp4_(4 * c + (j >> 1));
        const float cs = cs4[(j & 1) * 2], sn = cs4[(j & 1) * 2 + 1];
        const float x1 = bf2f((unsigned short)r1[j]) * rp * (j < 4 ? g1a[j & 3] : g1b[j & 3]), x2 = bf2f((unsigned short)r2[j]) * rp * (j < 4 ? g2a[j & 3] : g2b[j & 3]);
        ov[j] = hi == 0 ? (x1 * cs - x2 * sn) : (x1 * sn + x2 * cs); }
      int w0 = 0, w1 = 0; w0 = __builtin_amdgcn_cvt_pk_fp8_f32(ov[0], ov[1], w0, false); w0 = __builtin_amdgcn_cvt_pk_fp8_f32(ov[2], ov[3], w0, true);
      w1 = __builtin_amdgcn_cvt_pk_fp8_f32(ov[4], ov[5], w1, false); w1 = __builtin_amdgcn_cvt_pk_fp8_f32(ov[6], ov[7], w1, true);
      asm volatile("" : "+v"(w0), "+v"(w1) :: "memory"); q8[2][2 * c] = w0; q8[2][2 * c + 1] = w1; }
  #undef Qn_
#undef Qr_
#undef rp4_
#undef qgn_
#undef qgr_
  }
  const float negm = 15.0f - smaxC;
  float l_reg = 0.f; f32x16 o[4] = {};
  const char* Vg = (const char*)(VT8g + (size_t)h * 128 * T_TOK + (size_t)b * SEQ); const char* Kg = (const char*)(K8g + ((long)b * SEQ * 8 + h) * 128); const char* Pg = (const char*)(KP8g + (long)b * SEQ * 64);
  const int vc = tid >> 2, vq = tid & 3, vst = vc * 80 + 16 * (vq >> 1) + 8 * (vq & 1); const unsigned gvt = (unsigned)vc * (unsigned)T_TOK + 16u * (unsigned)vq;
  const int kr = tid >> 3, kc = tid & 7, kst = kr * 208 + kc * 16; const unsigned gk8 = (unsigned)(kr * 1024 + kc * 16);
  const int pr = (tid & 255) >> 2, pc = tid & 3, pst = pr * 208 + 128 + pc * 16; const unsigned gp8 = (unsigned)(pr * 64 + pc * 16);
  v4i32 s_v, s_k, s_p;
#define SLOAD(k0) do { s_v = *reinterpret_cast<const v4i32*>(Vg + (size_t)(k0) + gvt); \
    s_k = *reinterpret_cast<const v4i32*>(Kg + (size_t)(k0) * 1024 + gk8); if (tid < 256) s_p = *reinterpret_cast<const v4i32*>(Pg + (size_t)(k0) * 64 + gp8); } while (0)
#define SWRITE(kbuf, vbuf_) do { { v2i32 a_ = {s_v[0], s_v[2]}, b_ = {s_v[1], s_v[3]}; *(v2i32*)(V_lds + (vbuf_) * SHM_VT + vst) = a_; *(v2i32*)(V_lds + (vbuf_) * SHM_VT + vst + 32) = b_; } \
    *(v4i32*)(K8_lds + (kbuf) * SHM_K8 + kst) = s_k; if (tid < 256) *(v4i32*)(K8_lds + (kbuf) * SHM_K8 + pst) = s_p; } while (0)
  constexpr int NT = SEQ / KVBLK;
  v8i32 p8;
  SLOAD(0); SWRITE(0, 0); __syncthreads(); SLOAD(KVBLK);
  if (wid < 4) {
    for (int j = 0, kb = 0, vbuf = 0, vnx = 1; j < NT; ++j) {
      f32x16 p0, p1;
      qkt<SHIFT>(p0, p1, K8_lds + kb * SHM_K8, q8, negm, r32, hi);
      smA<SHIFT>(p0, negm); smB<SHIFT>(p0, p1, l_reg, p8, negm); ASBAR();
      pv_d0(o, V_lds + vbuf * SHM_VT, p8, r32, hi);
      if (j + 1 < NT) SWRITE(kb ^ 1, vnx);
      __syncthreads();
      if (j + 2 < NT) SLOAD((j + 2) * KVBLK);
      kb ^= 1; vbuf = vnx; vnx = vnx == 2 ? 0 : vnx + 1;
    }
  } else {
    int vprev = 0;
    __builtin_amdgcn_s_setprio(1);
    for (int j = 0, kb = 0, vbuf = 0, vnx = 1; j < NT; ++j) {
      f32x16 p0, p1;
      if (j > 0) pv_d0(o, V_lds + vprev * SHM_VT, p8, r32, hi);
      qkt<SHIFT>(p0, p1, K8_lds + kb * SHM_K8, q8, negm, r32, hi);
      smA<SHIFT>(p0, negm); smB<SHIFT>(p0, p1, l_reg, p8, negm); ASBAR();
      if (j + 1 < NT) SWRITE(kb ^ 1, vnx);
      __syncthreads();
      if (j + 2 < NT) SLOAD((j + 2) * KVBLK);
      kb ^= 1; vprev = vbuf; vbuf = vnx; vnx = vnx == 2 ? 0 : vnx + 1;
    }
    pv_d0(o, V_lds + vprev * SHM_VT, p8, r32, hi);
    __builtin_amdgcn_s_setprio(0);
  }
  int lane_e = lane; asm volatile("" : "+v"(lane_e));
  const int r32e = lane_e & 31, hie = lane_e >> 5;
  l_reg += __shfl_xor(l_reg, 32);
  int* satf = (int*)(lds + OFF_WS + NW * 64 * 4);
  if (!SHIFT) { const bool sat = __any(l_reg >= 57344.f); if (lane_e == 0) satf[wid] = sat ? 1 : 0; }
  if (hie == 0) li_l[r32e] = l_reg; asm volatile("s_waitcnt lgkmcnt(0)" ::: "memory");
  float rli[16];
#pragma unroll
  for (int r = 0; r < 16; ++r) rli[r] = __builtin_amdgcn_rcpf(li_l[crow(r, hie)]);
  char* Ow = (char*)O + ((long)b * SEQ + s0 + wid * QBLK) * LDO + h * 128;
#pragma unroll
  for (int r = 0; r < 16; ++r) { const unsigned ooff = (unsigned)(crow(r, hie) * LDO + r32e);
#pragma unroll
    for (int d0 = 0; d0 < 4; ++d0) { const int pk = __builtin_amdgcn_cvt_pk_fp8_f32(o[d0][r] * rli[r] * 32.f, 0.f, 0, false); *(unsigned char*)(Ow + ooff + d0 * 32) = (unsigned char)(pk & 0xff); } }
  __syncthreads();
  bool redo = false;
  if (!SHIFT) { redo = (satf[0] | satf[1] | satf[2] | satf[3] | satf[4] | satf[5] | satf[6] | satf[7]) != 0; __syncthreads(); }
  return redo;
#undef SLOAD
#undef SWRITE
}
}
#ifndef HD
#define HD __device__ __forceinline__
#endif
struct c32 { float x, y; };
HD c32 cmk(float x, float y) { c32 r; r.x = x; r.y = y; return r; }
HD c32 cadd(c32 a, c32 b) { return cmk(a.x + b.x, a.y + b.y); }
HD c32 csub(c32 a, c32 b) { return cmk(a.x - b.x, a.y - b.y); }
HD c32 cmul(c32 a, c32 b) { return cmk(a.x * b.x - a.y * b.y, a.x * b.y + a.y * b.x); }
HD c32 cmulc(c32 a, c32 b) { return cmk(a.x * b.x + a.y * b.y, a.y * b.x - a.x * b.y); }
constexpr int BR4(int i) { return ((i & 1) << 3) | ((i & 2) << 1) | ((i & 4) >> 1) | ((i & 8) >> 3); }
template <int SGN, int J> HD c32 tw16(c32 a) {
    if constexpr (J == 0) return a;
    else if constexpr (J == 4) return SGN < 0 ? cmk(a.y, -a.x) : cmk(-a.y, a.x);
    else {
        constexpr float CS[8] = {1.f, 0.92387953251128674f, 0.70710678118654752f, 0.38268343236508977f, 0.f, -0.38268343236508977f, -0.70710678118654752f, -0.92387953251128674f};
        constexpr float SN[8] = {0.f, 0.38268343236508977f, 0.70710678118654752f, 0.92387953251128674f, 1.f, 0.92387953251128674f, 0.70710678118654752f, 0.38268343236508977f};
        constexpr float c = CS[J], s = SN[J];
        if constexpr (SGN < 0) return cmk(a.x * c + a.y * s, a.y * c - a.x * s);
        else return cmk(a.x * c - a.y * s, a.y * c + a.x * s);
    }
}
#define FFT_BF(i, j, J) { const c32 u_ = v[i], w_ = v[j]; v[i] = cadd(u_, w_); v[j] = tw16<SGN, J>(csub(u_, w_)); }
template <int SGN> HD void dft16_dif(c32 (&v)[16]) {
    FFT_BF(0, 8, 0) FFT_BF(1, 9, 1) FFT_BF(2, 10, 2) FFT_BF(3, 11, 3) FFT_BF(4, 12, 4) FFT_BF(5, 13, 5) FFT_BF(6, 14, 6) FFT_BF(7, 15, 7)
    FFT_BF(0, 4, 0) FFT_BF(1, 5, 2) FFT_BF(2, 6, 4) FFT_BF(3, 7, 6) FFT_BF(8, 12, 0) FFT_BF(9, 13, 2) FFT_BF(10, 14, 4) FFT_BF(11, 15, 6)
    FFT_BF(0, 2, 0) FFT_BF(1, 3, 4) FFT_BF(4, 6, 0) FFT_BF(5, 7, 4) FFT_BF(8, 10, 0) FFT_BF(9, 11, 4) FFT_BF(12, 14, 0) FFT_BF(13, 15, 4)
    FFT_BF(0, 1, 0) FFT_BF(2, 3, 0) FFT_BF(4, 5, 0) FFT_BF(6, 7, 0) FFT_BF(8, 9, 0) FFT_BF(10, 11, 0) FFT_BF(12, 13, 0) FFT_BF(14, 15, 0)
}
#undef FFT_BF
#define FFT_BT(i, j, J) { const c32 u_ = v[i], w_ = tw16<SGN, J>(v[j]); v[i] = cadd(u_, w_); v[j] = csub(u_, w_); }
template <int SGN> HD void dft16_dit(c32 (&v)[16]) {
    FFT_BT(0, 1, 0) FFT_BT(2, 3, 0) FFT_BT(4, 5, 0) FFT_BT(6, 7, 0) FFT_BT(8, 9, 0) FFT_BT(10, 11, 0) FFT_BT(12, 13, 0) FFT_BT(14, 15, 0)
    FFT_BT(0, 2, 0) FFT_BT(1, 3, 4) FFT_BT(4, 6, 0) FFT_BT(5, 7, 4) FFT_BT(8, 10, 0) FFT_BT(9, 11, 4) FFT_BT(12, 14, 0) FFT_BT(13, 15, 4)
    FFT_BT(0, 4, 0) FFT_BT(1, 5, 2) FFT_BT(2, 6, 4) FFT_BT(3, 7, 6) FFT_BT(8, 12, 0) FFT_BT(9, 13, 2) FFT_BT(10, 14, 4) FFT_BT(11, 15, 6)
    FFT_BT(0, 8, 0) FFT_BT(1, 9, 1) FFT_BT(2, 10, 2) FFT_BT(3, 11, 3) FFT_BT(4, 12, 4) FFT_BT(5, 13, 5) FFT_BT(6, 14, 6) FFT_BT(7, 15, 7)
}
#undef FFT_BT
constexpr int FFT_PS = 272;
constexpr int FFT_EX_ELEMS = 16 * FFT_PS;
template <class EX> HD void fft_fwd_a(c32 (&v)[16], const c32* T1, EX ex, int tid) {
    dft16_dif<-1>(v);
#pragma unroll
    for (int p = 0; p < 16; ++p) { ex[p * FFT_PS + tid] = cmul(v[BR4(p)], T1[256 * p]); if ((p & 3) == 3) __builtin_amdgcn_sched_barrier(0); }
}
template <class EX> HD void fft_fwd_b(c32 (&v)[16], const c32* T2, EX exr, EX ex, int tid) {
    const int p2 = tid >> 4, c = tid & 15;
#pragma unroll
    for (int b = 0; b < 16; ++b) v[b] = exr[p2 * FFT_PS + 16 * b + c];
    dft16_dif<-1>(v);
#pragma unroll
    for (int q = 0; q < 16; ++q) ex[p2 * FFT_PS + q * 16 + ((c + q) & 15)] = cmul(v[BR4(q)], T2[q]);
}
template <class EX> HD void fft_fwd_c(c32 (&v)[16], EX ex, int tid) {
    const int p2 = tid >> 4, q = tid & 15;
#pragma unroll
    for (int c = 0; c < 16; ++c) v[c] = ex[p2 * FFT_PS + q * 16 + ((c + q) & 15)];
    dft16_dif<-1>(v);
}
template <class EX> HD void fft_inv_a(c32 (&v)[16], EX ex, int tid) {
    const int p = tid >> 4, q = tid & 15;
    dft16_dit<+1>(v);
#pragma unroll
    for (int c = 0; c < 16; ++c) ex[p * FFT_PS + q * 16 + ((c + q) & 15)] = v[c];
}
template <class EX> HD void fft_inv_b(c32 (&v)[16], const c32* T2, EX exr, EX ex, int tid) {
    const int p = tid >> 4, c = tid & 15;
#pragma unroll
    for (int q = 0; q < 16; ++q) v[BR4(q)] = cmulc(exr[p * FFT_PS + q * 16 + ((c + q) & 15)], T2[q]);
    dft16_dit<+1>(v);
#pragma unroll
    for (int b = 0; b < 16; ++b) ex[p * FFT_PS + 16 * b + c] = v[b];
}
template <class EX> HD void fft_inv_c(c32 (&v)[16], const c32* T1, EX ex, int tid) {
#pragma unroll
    for (int p = 0; p < 16; ++p) { v[BR4(p)] = cmulc(ex[p * FFT_PS + tid], T1[256 * p]); if ((p & 3) == 3) __builtin_amdgcn_sched_barrier(0); }
    dft16_dit<+1>(v);
}
constexpr int NWAVES = 8, NTHR = 512;
constexpr int BATCH = 8, SEQ = 4096, DM = 1024, T = BATCH * SEQ;
constexpr float EPS = 1e-6f;
constexpr size_t MiB = 1u << 20;
constexpr size_t WS_CTL = 0, CTL_ZERO_BYTES = 64 * 1024;
constexpr size_t WS_MOD = 1 * MiB;
constexpr size_t WS_HDNS = 1 * MiB + 512 * 1024;
constexpr size_t WS_W4S = 3 * MiB + 512 * 1024;
constexpr size_t WS_LIST = 101 * MiB;
constexpr size_t WS_WL = 396 * MiB;
constexpr size_t WS_WD = 8 * MiB;
constexpr size_t WS_WUQ = 9 * MiB;
constexpr size_t WS_WUKV = 10 * MiB;
constexpr size_t WS_WO = 11 * MiB;
constexpr size_t WS_WIN = 13 * MiB;
constexpr size_t WS_WOUT = 19 * MiB;
constexpr size_t WS_WGU = 21 * MiB;
constexpr size_t WS_WDN = 53 * MiB;
constexpr size_t R1 = 104 * MiB;
constexpr size_t R2 = 232 * MiB;
constexpr size_t R3 = 424 * MiB;
constexpr size_t WS_VT8 = R1, WS_XN2 = R1, WS_KF = R1;
constexpr size_t WS_XN = R2, WS_O = R2;
constexpr size_t WS_LAT = R2 + 64 * MiB;
constexpr size_t WS_HACT = R2 + 64 * MiB;
constexpr size_t WS_CQN = R2 + 128 * MiB;
constexpr size_t WS_CKVN = R2 + 144 * MiB;
constexpr size_t WS_KPE = R2 + 160 * MiB;
constexpr size_t WS_K8 = R2 + 64 * MiB;
constexpr size_t WS_ROPE = R2 + 164 * MiB;
constexpr size_t WS_QRAW = 408 * MiB;
constexpr size_t WS_XN2S = 424 * MiB;
constexpr size_t WS_XR = 424 * MiB;
constexpr size_t WS_HT = R2;
constexpr size_t WS_UT = R2;
constexpr size_t WS_Z = R2;
constexpr size_t WS_END = 512 * MiB;
constexpr int MS_ROWS = T + 24 * 256;
constexpr int CW_BAR = 4096;
constexpr int CW_CNT = 8192;
constexpr int RING_OFF = 0, RING_BYTES = 147456;
constexpr int LDSCTL_OFF = RING_BYTES;
constexpr int MISC_OFF = LDSCTL_OFF;
constexpr int TINFO_OFF = LDSCTL_OFF + 256;
constexpr int RED_OFF = LDSCTL_OFF + 256 + 1280;
constexpr int EPIX_OFF = LDSCTL_OFF + 2048;
constexpr int LDS_BYTES = 163840;
static_assert(RED_OFF + 256 <= LDS_BYTES, "LDS map");

#define GAS __attribute__((address_space(1)))
#define LAS __attribute__((address_space(3)))
typedef unsigned short bf16;
typedef unsigned v4u __attribute__((ext_vector_type(4)));
typedef unsigned v2u __attribute__((ext_vector_type(2)));
typedef int v4i __attribute__((ext_vector_type(4)));
typedef float f32x4 __attribute__((ext_vector_type(4)));
typedef GAS unsigned gu32;
#define RLX_AGENT __ATOMIC_RELAXED, __HIP_MEMORY_SCOPE_AGENT
#define LDS_WAIT() asm volatile("s_waitcnt lgkmcnt(0)" ::: "memory")
__device__ __forceinline__ unsigned pk2(float lo, float hi) { return pg8::cvt_pk_bf16(lo, hi); }
__device__ __forceinline__ float bf2f(unsigned short b) { return __uint_as_float(((unsigned)b) << 16); }
__device__ __forceinline__ float wave_sum(float v) {
#pragma unroll
    for (int o = 1; o < 64; o <<= 1) v += __shfl_xor(v, o);
    return v;
}

#define XB_TMO      128
#define XB_XCNT(j)  (256  + 64 * (j))
#define XB_XSUB(j)  (1280 + 64 * (j))
#define XB_XGEN(j)  (2304 + 64 * (j))
#define XB_TOP      3328
#define XB_TOPGEN   3392
#define XCD_BAR_WORDS 3456
#define XB_SPIN_CAP (1u << 18)

__device__ __forceinline__ unsigned xb_ld(unsigned* p)              { return __hip_atomic_load(p, __ATOMIC_RELAXED, __HIP_MEMORY_SCOPE_AGENT); }
__device__ __forceinline__ unsigned xb_add(unsigned* p, unsigned v) { return __hip_atomic_fetch_add(p, v, __ATOMIC_RELAXED, __HIP_MEMORY_SCOPE_AGENT); }
__device__ __forceinline__ unsigned xb_xcc_id() { return (unsigned)__builtin_amdgcn_s_getreg((3 << 11) | 20) & 0xFu; }
#define XB_SPIN(cond, bar) do { unsigned _sp = 0; while (cond) { __builtin_amdgcn_s_sleep(1); \
    if ((++_sp & 255u) == 0u) { if (xb_ld(&(bar)[XB_TMO])) break; if (_sp > XB_SPIN_CAP) { atomicAdd(&(bar)[XB_TMO], 1u); break; } } } } while (0)

struct XcdBarrier {
    unsigned* bar; unsigned x;
    volatile LAS unsigned* st;
    int w0;
};

__device__ __forceinline__ XcdBarrier xcd_barrier_post(unsigned* bar, volatile LAS unsigned* st) {
    XcdBarrier b; b.bar = bar; b.x = xb_xcc_id(); b.st = st; b.w0 = 0;
    if (threadIdx.x == 0) (void)xb_add(&bar[XB_XCNT(b.x)], 1u);
    return b;
}
__device__ __forceinline__ void xcd_barrier_complete(unsigned* bar, unsigned x, unsigned& nloc, unsigned& nx) {
    const unsigned G = gridDim.x * gridDim.y * gridDim.z;
    unsigned sum, cnt, mine, sp = 0u;
    for (;;) {
        sum = 0u; cnt = 0u; mine = 0u;
#pragma unroll
        for (unsigned j = 0; j < 16; ++j) { const unsigned c = xb_ld(&bar[XB_XCNT(j)]); sum += c; cnt += (c > 0u) ? 1u : 0u; mine = (j == x) ? c : mine; }
        if (sum == G) break;
        __builtin_amdgcn_s_sleep(1);
        if ((++sp & 255u) == 0u) { if (xb_ld(&bar[XB_TMO])) break; if (sp > XB_SPIN_CAP) { atomicAdd(&bar[XB_TMO], 1u); break; } }
    }
    nloc = mine > 0u ? mine : 1u; nx = cnt > 0u ? cnt : 1u;
}

__device__ __forceinline__ void xcd_barrier(const XcdBarrier& b) {
    asm volatile("s_waitcnt vmcnt(0)" ::: "memory");
    __syncthreads();
    if (b.w0 && __builtin_amdgcn_mbcnt_hi(~0u, __builtin_amdgcn_mbcnt_lo(~0u, 0u)) == 0u) {
        unsigned* bar = b.bar;
        __builtin_amdgcn_s_waitcnt(0);
        unsigned nloc = b.st[0], nx = b.st[1];
        if (nloc == 0u) { xcd_barrier_complete(bar, b.x, nloc, nx); b.st[0] = nloc; b.st[1] = nx; }
        const unsigned old = xb_add(&bar[XB_XSUB(b.x)], 1u);
        const unsigned gen = old / nloc;
        if (old + 1u == (gen + 1u) * nloc) {
            __builtin_amdgcn_fence(__ATOMIC_RELEASE, "agent");
            asm volatile("s_waitcnt vmcnt(0)" ::: "memory");
            const unsigned og = xb_add(&bar[XB_TOP], 1u);
            const unsigned tg = og / nx;
            if (og + 1u == (tg + 1u) * nx) xb_add(&bar[XB_TOPGEN], 1u);
            else XB_SPIN(xb_ld(&bar[XB_TOPGEN]) == tg, bar);
            __builtin_amdgcn_fence(__ATOMIC_ACQUIRE, "agent");
            xb_add(&bar[XB_XGEN(b.x)], 1u);
            asm volatile("s_waitcnt vmcnt(0)" ::: "memory");
        } else {
            XB_SPIN(xb_ld(&bar[XB_XGEN(b.x)]) == gen, bar);
            __builtin_amdgcn_fence(__ATOMIC_ACQUIRE, "agent");
            asm volatile("s_waitcnt vmcnt(0)" ::: "memory");
        }
    }
    __syncthreads();
}


struct Ctx { unsigned char* lds; int tid, lane, wave, vcu, G, gw, NGW; };

__device__ __forceinline__ void transpose_item(const float* W, int ldw, int k0, int n0, bf16* WT, int ldt, int drow0, int dcol0, float* scr, int lane, bool kpe_perm) {
    float tv[32];
#pragma unroll
    for (int i = 0; i < 32; ++i) { const int kk = 2 * i + (lane >> 5); tv[i] = W[(size_t)(k0 + kk) * ldw + n0 + (lane & 31)]; }
#pragma unroll
    for (int i = 0; i < 32; ++i) { const int kk = 2 * i + (lane >> 5); scr[kk * 33 + (lane & 31)] = tv[i]; }
    LDS_WAIT();
    const int c = lane & 7;
#pragma unroll
    for (int j = 0; j < 4; ++j) { const int n = (lane >> 3) + 8 * j; const float* s = scr + (8 * c) * 33 + n;
        v4u o; o.x = pk2(s[0 * 33], s[1 * 33]); o.y = pk2(s[2 * 33], s[3 * 33]); o.z = pk2(s[4 * 33], s[5 * 33]); o.w = pk2(s[6 * 33], s[7 * 33]);
        int dr = drow0 + n; if (kpe_perm && dr >= 384 && dr < 448) { const int e = dr - 384; dr = 384 + 32 * ((e >> 4) & 1) + 16 * (e >> 5) + (e & 15); }
        *(v4u*)(WT + (size_t)dr * ldt + dcol0 + k0 + 8 * c) = o; }
    LDS_WAIT();
}
__device__ __forceinline__ void transpose_item8(const float* W, int ldw, int k0, int n0, unsigned char* WT8, int ldt8, int drow0, int dcol0, float* scr, int lane, float scale, bool kpe_perm) {
    float tv[32];
#pragma unroll
    for (int i = 0; i < 32; ++i) { const int kk = 2 * i + (lane >> 5); tv[i] = W[(size_t)(k0 + kk) * ldw + n0 + (lane & 31)]; }
#pragma unroll
    for (int i = 0; i < 32; ++i) { const int kk = 2 * i + (lane >> 5); scr[kk * 33 + (lane & 31)] = tv[i]; }
    LDS_WAIT();
    const int n = lane >> 1, hf = lane & 1; const float* sp = scr + (32 * hf) * 33 + n;
    v4u o0, o1; unsigned w[8];
#pragma unroll
    for (int q = 0; q < 8; ++q) { int p = 0; p = __builtin_amdgcn_cvt_pk_fp8_f32(sp[(4 * q) * 33] * scale, sp[(4 * q + 1) * 33] * scale, p, false); p = __builtin_amdgcn_cvt_pk_fp8_f32(sp[(4 * q + 2) * 33] * scale, sp[(4 * q + 3) * 33] * scale, p, true); w[q] = (unsigned)p; }
    o0.x = w[0]; o0.y = w[1]; o0.z = w[2]; o0.w = w[3]; o1.x = w[4]; o1.y = w[5]; o1.z = w[6]; o1.w = w[7];
    int dr = drow0 + n; if (kpe_perm && dr >= 384 && dr < 448) { const int e = dr - 384; dr = 384 + 32 * ((e >> 4) & 1) + 16 * (e >> 5) + (e & 15); }
    unsigned char* d = WT8 + (size_t)dr * ldt8 + dcol0 + k0 + 32 * hf;
    *(v4u*)d = o0; *(v4u*)(d + 16) = o1;
    LDS_WAIT();
}
typedef __attribute__((address_space(4))) const char kchar;
struct In { int opq;
    __device__ __forceinline__ const float* operator[](int k) const { kchar* ka = (kchar*)__builtin_amdgcn_kernarg_segment_ptr(); return *(const float* const __attribute__((address_space(4)))*)(ka + 8 * k + opq); } };
__device__ __forceinline__ unsigned char* karg_ws(int opq) { kchar* ka = (kchar*)__builtin_amdgcn_kernarg_segment_ptr(); return *(unsigned char* const __attribute__((address_space(4)))*)(ka + 38 * 8 + 8 + opq); }
__device__ __forceinline__ float* karg_out(int opq) { kchar* ka = (kchar*)__builtin_amdgcn_kernarg_segment_ptr(); return *(float* const __attribute__((address_space(4)))*)(ka + 38 * 8 + opq); }

__device__ __forceinline__ void p0_prologue(const Ctx& F, const In& in, unsigned char* ws) {
    float* scr = (float*)(F.lds + RING_OFF + F.wave * 16384);
    bf16* Wd = (bf16*)(ws + WS_WD); bf16* Wuq = (bf16*)(ws + WS_WUQ); bf16* Wukv = (bf16*)(ws + WS_WUKV); bf16* Wo = (bf16*)(ws + WS_WO);
    bf16* Win = (bf16*)(ws + WS_WIN); bf16* Wout = (bf16*)(ws + WS_WOUT); bf16* Wgu = (bf16*)(ws + WS_WGU); bf16* Wdn = (bf16*)(ws + WS_WDN);
    constexpr int I_D = 16 * 14, I_UQ = 4 * 48, I_UKV = 2 * 64, I_O = 16 * 32, I_IN = 16 * 96, I_OUT = 16 * 32, I_GU = 2 * 16 * 2 * (16 * 8), I_DN = 2 * 24 * 2 * (4 * 32);
    constexpr int NITEMS = I_D + I_UQ + I_UKV + I_O + I_IN + I_OUT + I_GU + I_DN;
    for (int it = F.gw; it < NITEMS; it += F.NGW) {
        int r = it; const float* W; int ldw, k0, n0, ldt, drow0, dcol0 = 0; bf16* WT; float f8s = 0.f;
        if (r < I_D) { W = in[7]; ldw = 448; k0 = (r / 14) * 64; n0 = (r % 14) * 32; WT = Wd; ldt = 1024; drow0 = n0; f8s = 32.f; }
        else if ((r -= I_D) < I_UQ) { W = in[10]; ldw = 1536; k0 = (r / 48) * 64; n0 = (r % 48) * 32; WT = Wuq; ldt = 256; drow0 = n0; f8s = 16.f; }
        else if ((r -= I_UQ) < I_UKV) { W = in[11]; ldw = 2048; k0 = (r / 64) * 64; n0 = (r % 64) * 32; ldt = 128;
            WT = Wukv + ((n0 & 128) ? 1024 * 128 : 0); drow0 = (n0 >> 8) * 128 + (n0 & 127); }
        else if ((r -= I_UKV) < I_O) { W = in[14]; ldw = 1024; k0 = (r / 32) * 64; n0 = (r % 32) * 32; WT = Wo; ldt = 1024; drow0 = n0; f8s = 32.f; }
        else if ((r -= I_O) < I_IN) { W = in[15]; ldw = 3072; k0 = (r / 96) * 64; n0 = (r % 96) * 32; WT = Win; ldt = 1024; drow0 = n0; }
        else if ((r -= I_IN) < I_OUT) { W = in[30]; ldw = 1024; k0 = (r / 32) * 64; n0 = (r % 32) * 32; WT = Wout; ldt = 1024; drow0 = n0; }
        else if ((r -= I_OUT) < I_GU) {
            const int sub = r % 128, mat = r / 128, which = mat & 1, le = mat >> 1;
            W = (which ? in[36] : in[35]) + (size_t)le * 1024 * 256; ldw = 256; k0 = (sub / 8) * 64; n0 = (sub % 8) * 32;
            WT = (bf16*)((unsigned char*)Wgu + (size_t)le * 512 * 1024); ldt = 1024; drow0 = (n0 >> 7) * 256 + which * 128 + (n0 & 127); f8s = 32.f; }
        else { r -= I_GU;
            const int sub = r % 128, mat = r / 128, slot = mat & 1, lb = mat >> 1, layer = lb / 24, bk = lb % 24;
            int ii, jj; pg8::pair_of(bk % 6, ii, jj); const int e = (bk / 6) * 4 + (slot ? jj : ii);
            W = in[37] + (size_t)(layer * 16 + e) * 256 * 1024; ldw = 1024; k0 = (sub / 32) * 64; n0 = (sub % 32) * 32;
            WT = Wdn + (size_t)lb * 1024 * 512; ldt = 512; drow0 = n0; dcol0 = slot * 256; }
        if (f8s != 0.f) transpose_item8(W, ldw, k0, n0, (unsigned char*)WT, ldt, drow0, dcol0, scr, F.lane, f8s, it < I_D);
        else transpose_item(W, ldw, k0, n0, WT, ldt, drow0, dcol0, scr, F.lane, it < I_D);
    }
    { const int gt = F.vcu * NTHR + F.tid, NGT = F.G * NTHR; const v4u z = {0u, 0u, 0u, 0u};
      for (int i = gt; i < 64 * 1024 / 16; i += NGT) *(v4u*)((unsigned char*)Wd + (size_t)448 * 1024 + (size_t)i * 16) = z;
    }
    { const int gt = F.vcu * NTHR + F.tid, NGT = F.G * NTHR; float* RT = (float*)(ws + WS_ROPE); const int* posi = (const int*)in[2];
      for (int i = gt; i < T * 32; i += NGT) { const int t = i >> 5, e = i & 31; const float inv = 1.0f / powf(10000.f, (float)(2 * e) * (1.f / 64.f));
        float sn, cs; sincosf((float)posi[t] * inv, &sn, &cs); RT[(size_t)i * 2] = cs; RT[(size_t)i * 2 + 1] = sn; } }
    { const int gt = F.vcu * NTHR + F.tid, NGT = F.G * NTHR; bf16* W4S = (bf16*)(ws + WS_W4S); const float* w4 = in[28];
      for (int i = gt; i < 4096 * 64; i += NGT) { const int k = i >> 12, col = i & 4095; const float w = w4[(size_t)k * 4096 + col];
        const unsigned hi = pk2(w, 0.f) & 0xffffu; const float lo = w - bf2f((unsigned short)hi); const unsigned lob = pk2(lo, 0.f) & 0xffffu;
        bf16* d = W4S + (size_t)col * 256 + k; d[0] = (bf16)hi; d[64] = (bf16)hi; d[128] = (bf16)lob; d[192] = 0; } }
    { bf16* HDp = (bf16*)(ws + WS_HDNS); float* sv = scr;
      const int j = F.lane;
      for (int t = F.gw; t < 4096; t += F.NGW) {
        float zf = 0.f;
        { const float w = 6.2831855f * (float)t * (1.f / 4096.f);
          if (j == 0) zf = (float)t / 4095.f;
          else if (j <= 16) { const float fr = 1e-4f + (float)(j - 1) * ((15.f - 1e-4f) / 15.f); zf = cosf(fr * w); }
          else if (j <= 32) { const float fr = 1e-4f + (float)(j - 17) * ((15.f - 1e-4f) / 15.f); zf = -sinf(fr * w); } }
        sv[j] = zf; LDS_WAIT();
        float a = in[20][j];
#pragma unroll 3
        for (int k = 0; k < 33; ++k) a += sv[k] * in[19][k * 64 + j];
        float h = sinf(in[21][j] * a); LDS_WAIT(); sv[j] = h; LDS_WAIT();
        a = in[23][j];
#pragma unroll 4
        for (int k = 0; k < 64; ++k) a += sv[k] * in[22][k * 64 + j];
        h = sinf(in[24][j] * a); LDS_WAIT(); sv[j] = h; LDS_WAIT();
        a = in[26][j];
#pragma unroll 4
        for (int k = 0; k < 64; ++k) a += sv[k] * in[25][k * 64 + j];
        h = sinf(in[27][j] * a); LDS_WAIT();
        const unsigned hi = pk2(h, 0.f) & 0xffffu; const float lo = h - bf2f((unsigned short)hi); const unsigned lob = pk2(lo, 0.f) & 0xffffu;
        bf16* d = HDp + (size_t)t * 256 + j; d[0] = (bf16)hi; d[64] = (bf16)lob; d[128] = (bf16)hi; d[192] = 0;
      } }
    __syncthreads();
    { float* cact = (float*)(F.lds + RING_OFF); float* red = cact + 8 * 1024;
      float* MOD = (float*)(ws + WS_MOD);
      for (int i = F.tid; i < 8 * 1024; i += NTHR) { const float x = in[1][i]; cact[i] = x / (1.f + __expf(-x)); }
      __syncthreads();
      for (int it = F.vcu; it < 2 * 96; it += F.G) {
        const int layer = it / 96, cb = it % 96, col = F.tid & 63, kg = F.tid >> 6;
        const float* W = in[3] + (size_t)layer * 1024 * 6144 + cb * 64 + col;
        float acc[8] = {0.f, 0.f, 0.f, 0.f, 0.f, 0.f, 0.f, 0.f};
#pragma unroll 16
        for (int k = kg * 128; k < kg * 128 + 128; ++k) { const float w = W[(size_t)k * 6144];
#pragma unroll
          for (int b = 0; b < 8; ++b) acc[b] += cact[b * 1024 + k] * w; }
#pragma unroll
        for (int b = 0; b < 8; ++b) red[(kg * 8 + b) * 64 + col] = acc[b];
        __syncthreads();
        { const int b = F.tid >> 6; float s = in[4][layer * 6144 + cb * 64 + col];
#pragma unroll
          for (int g = 0; g < 8; ++g) s += red[(g * 8 + b) * 64 + col];
          MOD[((size_t)layer * 8 + b) * 6144 + cb * 64 + col] = s; }
        __syncthreads();
      } }
}

template <class TX> __device__ __forceinline__ f32x4 ldrow4(const TX* p);
template <> __device__ __forceinline__ f32x4 ldrow4<float>(const float* p) { return *(const __attribute__((address_space(1))) f32x4*)p; }
template <> __device__ __forceinline__ f32x4 ldrow4<bf16>(const bf16* p) { const v2u w = *(const __attribute__((address_space(1))) v2u*)p; f32x4 r; r[0] = __uint_as_float(w.x << 16); r[1] = __uint_as_float(w.x & 0xffff0000u); r[2] = __uint_as_float(w.y << 16); r[3] = __uint_as_float(w.y & 0xffff0000u); return r; }
template <class TX, bool OUT8 = false> __device__ __forceinline__ void norm_mod_phase(const Ctx& F, const TX* X, const float* g, const float* sc, const float* sh, bf16* OUT) {
    for (int ch = F.gw; ch < T / 16; ch += F.NGW) {
        const int r0 = ch * 16, b = r0 >> 12;
        f32x4 A[4], S[4];
#pragma unroll
        for (int j = 0; j < 4; ++j) { const int col = 4 * F.lane + 256 * j; const f32x4 gv = *(const f32x4*)(g + col), sv = *(const f32x4*)(sc + (size_t)b * 6144 + col); A[j] = gv * (1.f + sv); S[j] = *(const f32x4*)(sh + (size_t)b * 6144 + col); }
        const TX* xr = X + (size_t)r0 * DM + 4 * F.lane;
        f32x4 nx[4];
#pragma unroll
        for (int j = 0; j < 4; ++j) nx[j] = ldrow4<TX>(xr + 256 * j);
        for (int rr = 0; rr < 16; ++rr) {
            f32x4 v[4]; float ss = 0.f;
#pragma unroll
            for (int j = 0; j < 4; ++j) { v[j] = nx[j]; ss += (v[j].x * v[j].x + v[j].y * v[j].y) + (v[j].z * v[j].z + v[j].w * v[j].w); }
            if (rr < 15) {
#pragma unroll
                for (int j = 0; j < 4; ++j) nx[j] = ldrow4<TX>(xr + (size_t)(rr + 1) * DM + 256 * j); }
            const float rstd = rsqrtf(wave_sum(ss) * (1.f / DM) + EPS);
            if constexpr (OUT8) { unsigned char* orow = (unsigned char*)OUT + (size_t)(r0 + rr) * DM + 4 * F.lane;
#pragma unroll
                for (int j = 0; j < 4; ++j) { const f32x4 o = v[j] * rstd * A[j] + S[j]; int p = 0; p = __builtin_amdgcn_cvt_pk_fp8_f32(o.x, o.y, p, false); p = __builtin_amdgcn_cvt_pk_fp8_f32(o.z, o.w, p, true); *(int*)(orow + 256 * j) = p; } }
            else { bf16* orow = OUT + (size_t)(r0 + rr) * DM + 4 * F.lane;
#pragma unroll
                for (int j = 0; j < 4; ++j) { const f32x4 o = v[j] * rstd * A[j] + S[j]; v2u w; w.x = pk2(o.x, o.y); w.y = pk2(o.z, o.w); *(v2u*)(orow + 256 * j) = w; } } }
    }
}

__device__ __forceinline__ void lat_post_phase(const Ctx& F, const float* LAT, const float* qag, const float* kvag, const float* kng, const float* rope, bf16* CQN, bf16* CKVN, bf16* KPE) {
    const int l = F.lane;
    const f32x4 gq = *(const f32x4*)(qag + 4 * l);
    const f32x4 g2 = l < 32 ? *(const f32x4*)(kvag + 4 * l) : (l < 48 ? *(const f32x4*)(kng + 128 + 4 * (l - 32)) : (f32x4){0.f, 0.f, 0.f, 0.f});
    f32x4 na = *(const f32x4*)(LAT + (size_t)F.gw * 512 + 4 * l), nc = l < 48 ? *(const f32x4*)(LAT + (size_t)F.gw * 512 + 256 + 4 * l) : (f32x4){0.f, 0.f, 0.f, 0.f};
    for (int row = F.gw; row < T; row += F.NGW) {
        const f32x4 a = na, c = nc;
        if (row + F.NGW < T) { const float* nr = LAT + (size_t)(row + F.NGW) * 512; na = *(const f32x4*)(nr + 4 * l); if (l < 48) nc = *(const f32x4*)(nr + 256 + 4 * l); }
        const float sq = (a.x * a.x + a.y * a.y) + (a.z * a.z + a.w * a.w), sc = (c.x * c.x + c.y * c.y) + (c.z * c.z + c.w * c.w);
        const float s_q = wave_sum(sq), s_kv = wave_sum(l < 32 ? sc : 0.f), s_pe = wave_sum((l >= 32 && l < 48) ? sc : 0.f);
        const float rq = rsqrtf(s_q * (1.f / 256.f) + EPS), rkv = rsqrtf(s_kv * (1.f / 128.f) + EPS), rpe = rsqrtf(s_pe * (1.f / 64.f) + EPS);
        { const f32x4 o = a * rq * gq; v2u w; w.x = pk2(o.x, o.y); w.y = pk2(o.z, o.w); *(v2u*)(CQN + (size_t)row * 256 + 4 * l) = w; }
        if (l < 32) { const f32x4 o = c * rkv * g2; v2u w; w.x = pk2(o.x, o.y); w.y = pk2(o.z, o.w); *(v2u*)(CKVN + (size_t)row * 256 + 4 * l) = w; }
        else { v2u w; w.x = 0u; w.y = 0u; *(v2u*)(CKVN + (size_t)row * 256 + 128 + 4 * (l - 32)) = w; }
        const f32x4 n = c * rpe * g2;
        f32x4 other; other.x = __shfl_xor(n.x, 8); other.y = __shfl_xor(n.y, 8); other.z = __shfl_xor(n.z, 8); other.w = __shfl_xor(n.w, 8);
        if (l >= 32 && l < 48) { const bool first = l < 40; const int e0 = 4 * ((l - 32) & 7);
            float o[4];
#pragma unroll
            for (int i = 0; i < 4; ++i) { const int e = e0 + i; const float cs = rope[(size_t)row * 64 + e * 2], sn = rope[(size_t)row * 64 + e * 2 + 1];
                const float mine = n[i], oth = other[i]; o[i] = first ? (mine * cs - oth * sn) : (oth * sn + mine * cs); }
            v2u w; w.x = pk2(o[0], o[1]); w.y = pk2(o[2], o[3]); *(v2u*)(KPE + (size_t)row * 64 + 4 * (l - 32)) = w; }
    }
}

__device__ __forceinline__ void knorm_phase(const Ctx& F, bf16* KV, const float* kng) {
    const int l = F.lane, h = l >> 3, e0 = (l & 7) * 16;
    float g[16];
#pragma unroll
    for (int i = 0; i < 16; ++i) g[i] = kng[e0 + i];
    for (int row = F.gw; row < T; row += F.NGW) {
        bf16* p = KV + (size_t)row * 2048 + h * 256 + e0;
        const v4u r0 = *(const v4u*)p, r1 = *(const v4u*)(p + 8);
        float f[16]; const unsigned w[8] = {r0.x, r0.y, r0.z, r0.w, r1.x, r1.y, r1.z, r1.w};
        float ss = 0.f;
#pragma unroll
        for (int i = 0; i < 8; ++i) { f[2 * i] = __uint_as_float(w[i] << 16); f[2 * i + 1] = __uint_as_float(w[i] & 0xffff0000u); ss += f[2 * i] * f[2 * i] + f[2 * i + 1] * f[2 * i + 1]; }
        ss += __shfl_xor(ss, 1); ss += __shfl_xor(ss, 2); ss += __shfl_xor(ss, 4);
        const float r = rsqrtf(ss * (1.f / 128.f) + EPS);
        v4u o0, o1;
        o0.x = pk2(f[0] * r * g[0], f[1] * r * g[1]); o0.y = pk2(f[2] * r * g[2], f[3] * r * g[3]); o0.z = pk2(f[4] * r * g[4], f[5] * r * g[5]); o0.w = pk2(f[6] * r * g[6], f[7] * r * g[7]);
        o1.x = pk2(f[8] * r * g[8], f[9] * r * g[9]); o1.y = pk2(f[10] * r * g[10], f[11] * r * g[11]); o1.z = pk2(f[12] * r * g[12], f[13] * r * g[13]); o1.w = pk2(f[14] * r * g[14], f[15] * r * g[15]);
        *(v4u*)p = o0; *(v4u*)(p + 8) = o1;
    }
}

__device__ __forceinline__ void route_phase(const Ctx& F, const bf16* X, const float* g, const float* sc, const float* sh, const float* wg, const float* bg, const float* we, const float* be,
                                            bf16* XN2, int* LIST, float* WL, gu32* cnt) {
    float* W20 = (float*)(F.lds + RING_OFF);
    for (int i = F.tid; i < 20 * 1024; i += NTHR) { const int o = i >> 10, col = i & 1023; W20[i] = o < 4 ? wg[col * 4 + o] : we[col * 16 + (o - 4)]; }
    __syncthreads();
    float bgv[4];
#pragma unroll
    for (int i = 0; i < 4; ++i) bgv[i] = bg[i];
    for (int ch = F.gw; ch < T / 16; ch += F.NGW) {
        const int r0 = ch * 16, b = r0 >> 12;
        f32x4 A[4], S[4];
#pragma unroll
        for (int j = 0; j < 4; ++j) { const int col = 4 * F.lane + 256 * j; const f32x4 gv = *(const f32x4*)(g + col), sv = *(const f32x4*)(sc + (size_t)b * 6144 + col); A[j] = gv * (1.f + sv); S[j] = *(const f32x4*)(sh + (size_t)b * 6144 + col); }
        const bf16* xr = X + (size_t)r0 * DM + 4 * F.lane;
        f32x4 nx[4];
#pragma unroll
        for (int j = 0; j < 4; ++j) nx[j] = ldrow4<bf16>(xr + 256 * j);
        for (int rr = 0; rr < 16; ++rr) { const int row = r0 + rr;
            f32x4 v[4]; float ss = 0.f;
#pragma unroll
            for (int j = 0; j < 4; ++j) { v[j] = nx[j]; ss += (v[j].x * v[j].x + v[j].y * v[j].y) + (v[j].z * v[j].z + v[j].w * v[j].w); }
            if (rr < 15) {
#pragma unroll
                for (int j = 0; j < 4; ++j) nx[j] = ldrow4<bf16>(xr + (size_t)(rr + 1) * DM + 256 * j); }
            const float rstd = rsqrtf(wave_sum(ss) * (1.f / DM) + EPS);
            unsigned char* orow = (unsigned char*)XN2 + (size_t)row * DM + 4 * F.lane;
#pragma unroll
            for (int j = 0; j < 4; ++j) { v[j] = v[j] * rstd * A[j] + S[j]; int p = 0; p = __builtin_amdgcn_cvt_pk_fp8_f32(v[j].x, v[j].y, p, false); p = __builtin_amdgcn_cvt_pk_fp8_f32(v[j].z, v[j].w, p, true); *(int*)(orow + 256 * j) = p; }
            float gl[4];
#pragma unroll
            for (int o = 0; o < 4; ++o) { float a = 0.f;
#pragma unroll
                for (int j = 0; j < 4; ++j) { const f32x4 w = *(const f32x4*)(W20 + o * 1024 + 4 * F.lane + 256 * j); a += (v[j].x * w.x + v[j].y * w.y) + (v[j].z * w.z + v[j].w * w.w); }
                gl[o] = wave_sum(a) + bgv[o]; }
            int gi = 0; float gm = gl[0]; if (gl[1] > gm) { gm = gl[1]; gi = 1; } if (gl[2] > gm) { gm = gl[2]; gi = 2; } if (gl[3] > gm) { gm = gl[3]; gi = 3; }
            gi = __builtin_amdgcn_readfirstlane(gi);
            const float gw_ = 1.f / (__expf(gl[0] - gm) + __expf(gl[1] - gm) + __expf(gl[2] - gm) + __expf(gl[3] - gm));
            const float* We = W20 + (4 + 4 * gi) * 1024 + 4 * F.lane;
            float e[4];
#pragma unroll
            for (int k = 0; k < 4; ++k) { float a = 0.f;
#pragma unroll
                for (int j = 0; j < 4; ++j) { const f32x4 w = *(const f32x4*)(We + k * 1024 + 256 * j); a += (v[j].x * w.x + v[j].y * w.y) + (v[j].z * w.z + v[j].w * w.w); }
                e[k] = wave_sum(a) + be[4 * gi + k]; }
            int i1 = 0; float m1 = e[0];
#pragma unroll
            for (int k = 1; k < 4; ++k) if (e[k] > m1) { m1 = e[k]; i1 = k; }
            int i2 = -1; float m2 = -3.0e38f;
#pragma unroll
            for (int k = 0; k < 4; ++k) if (k != i1 && e[k] > m2) { m2 = e[k]; i2 = k; }
            const float t2 = __expf(m2 - m1), w1 = gw_ / (1.f + t2), w2 = gw_ * t2 / (1.f + t2);
            const int ilo = i1 < i2 ? i1 : i2, ihi = i1 < i2 ? i2 : i1; const float wlo = i1 < i2 ? w1 : w2, whi = i1 < i2 ? w2 : w1;
            const int pi = ilo == 0 ? ihi - 1 : (ilo == 1 ? ihi + 1 : 5), bk = gi * 6 + pi;
            if (F.lane == 0) { const unsigned pos = __hip_atomic_fetch_add(cnt + bk * 64, 1u, RLX_AGENT);
                LIST[bk * 32768 + pos] = row; float2 ww; ww.x = wlo; ww.y = whi; *(float2*)(WL + ((size_t)bk * 32768 + pos) * 2) = ww; }
        }
    }
}
__device__ __forceinline__ void moe_table(const Ctx& F, const gu32* cnt) {
    int* tinfo = (int*)(F.lds + TINFO_OFF);
    __syncthreads();
    if (F.tid == 0) { int nt = 0;
        for (int b = 0; b < 24; ++b) { const int c = (int)__hip_atomic_load(cnt + b * 64, RLX_AGENT); const int tiles = (c + 255) >> 8;
            tinfo[256 + b] = nt * 256; tinfo[288 + b] = c; for (int i = 0; i < tiles; ++i) tinfo[1 + nt + i] = b; nt += tiles; }
        tinfo[0] = nt; }
    __syncthreads();
}
__device__ __forceinline__ void permute_phase(const Ctx& F, const bf16* XN2, const int* ROUTE, bf16* XN2S, int* TOKW) {
    const int* tinfo = (const int*)(F.lds + TINFO_OFF);
    for (int ch = F.gw; ch < T / 4; ch += F.NGW) {
        v4i r[4]; v4u a[4], bq[4];
#pragma unroll
        for (int i = 0; i < 4; ++i) { const int row = ch * 4 + i; r[i] = *(const v4i*)(ROUTE + (size_t)row * 4);
            a[i] = *(const v4u*)(XN2 + (size_t)row * DM + 8 * F.lane); bq[i] = *(const v4u*)(XN2 + (size_t)row * DM + 512 + 8 * F.lane); }
#pragma unroll
        for (int i = 0; i < 4; ++i) { const int row = ch * 4 + i, srow = tinfo[256 + r[i].x] + r[i].y;
            *(v4u*)(XN2S + (size_t)srow * DM + 8 * F.lane) = a[i]; *(v4u*)(XN2S + (size_t)srow * DM + 512 + 8 * F.lane) = bq[i];
            if (F.lane == 0) { v4i w; w.x = row; w.y = r[i].z; w.z = r[i].w; w.w = 0; *(v4i*)(TOKW + (size_t)srow * 4) = w; } }
    }
}

constexpr float W32C[16] = {1.f, 0.98078528040323043f, 0.92387953251128674f, 0.83146961230254524f, 0.70710678118654752f, 0.55557023301960218f, 0.38268343236508977f, 0.19509032201612825f,
                            0.f, -0.19509032201612825f, -0.38268343236508977f, -0.55557023301960218f, -0.70710678118654752f, -0.83146961230254524f, -0.92387953251128674f, -0.98078528040323043f};
constexpr float W32S[16] = {0.f, 0.19509032201612825f, 0.38268343236508977f, 0.55557023301960218f, 0.70710678118654752f, 0.83146961230254524f, 0.92387953251128674f, 0.98078528040323043f,
                            1.f, 0.98078528040323043f, 0.92387953251128674f, 0.83146961230254524f, 0.70710678118654752f, 0.55557023301960218f, 0.38268343236508977f, 0.19509032201612825f};
struct FftTw { const c32* T1; c32 tob; const c32* T2; };
template <int A> __device__ __forceinline__ c32 mul_to(c32 x, c32 tob) { const c32 y = cmul(x, tob); return cmk(y.x * W32C[A] + y.y * W32S[A], y.y * W32C[A] - y.x * W32S[A]); }
template <int A> __device__ __forceinline__ c32 mul_toc(c32 x, c32 tob) { const c32 y = cmulc(x, tob); return cmk(y.x * W32C[A] - y.y * W32S[A], y.y * W32C[A] + y.x * W32S[A]); }
#define TO_ALL(OP) OP(0) OP(1) OP(2) OP(3) OP(4) OP(5) OP(6) OP(7) OP(8) OP(9) OP(10) OP(11) OP(12) OP(13) OP(14) OP(15)
__device__ __forceinline__ void fft_twiddles(FftTw& W, int gt, c32* t1tab, c32* t2tab, int tid) {
    if (tid < 256) { float s, c; sincosf(-6.283185307179586f * (float)(((tid >> 4) * (tid & 15)) & 255) * (1.f / 256.f), &s, &c); t2tab[(tid >> 4) * 17 + (tid & 15)] = cmk(c, s); }
    for (int i = tid; i < 4096; i += NTHR) { const int p = i >> 8, t = i & 255; float s, c; sincosf(-6.283185307179586f * (float)((t * p) & 4095) * (1.f / 4096.f), &s, &c); t1tab[i] = cmk(c, s); }
    { float s, c; sincosf(-6.283185307179586f * (float)gt * (1.f / 8192.f), &s, &c); W.tob = cmk(c, s); }
    W.T1 = t1tab + gt; W.T2 = t2tab + (gt & 15) * 17;
    __syncthreads();
}
__device__ __forceinline__ void fft_forward_a(c32 (&v)[16], const FftTw& W, c32* ex, int gt) {
    __syncthreads();
    fft_fwd_a(v, W.T1, ex, gt);
    __syncthreads();
}
__device__ __forceinline__ void fft_forward_bc(c32 (&v)[16], const FftTw& W, c32* ex, int gt) {
    fft_fwd_b(v, W.T2, ex, ex, gt);
    __builtin_amdgcn_wave_barrier(); asm volatile("" ::: "memory");
    fft_fwd_c(v, ex, gt);
}
__device__ __forceinline__ void fft_forward(c32 (&v)[16], const FftTw& W, c32* ex, int gt) { fft_forward_a(v, W, ex, gt); fft_forward_bc(v, W, ex, gt); }
__device__ __forceinline__ void fft_inverse(c32 (&v)[16], const FftTw& W, c32* ex, int gt) {
    __builtin_amdgcn_wave_barrier(); asm volatile("" ::: "memory");
    fft_inv_a(v, ex, gt);
    __builtin_amdgcn_wave_barrier(); asm volatile("" ::: "memory");
    fft_inv_b(v, W.T2, ex, ex, gt);
    __syncthreads();
    fft_inv_c(v, W.T1, ex, gt);
}
__device__ __forceinline__ void filter_phase(const Ctx& F, const float* HT, const float* fbias, c32* KF) {
    const int g = __builtin_amdgcn_readfirstlane(F.tid >> 8), gt = F.tid & 255;
    c32* ex = (c32*)(F.lds + RING_OFF + g * 36864);
    float* rev = (float*)ex;
    float* red = (float*)(F.lds + RED_OFF);
    FftTw W; fft_twiddles(W, gt, (c32*)(F.lds + RING_OFF + 73728), (c32*)(F.lds + RING_OFF + 110592), F.tid);
    for (int d = F.vcu; d < DM; d += F.G) {
        int gtv = gt; asm volatile("" : "+v"(gtv));
        const float delta = fabsf(-120.39728043259361f + (float)d * ((40.546510810816436f + 120.39728043259361f) / 1023.f));
        const float* hfp = HT + (size_t)(g * 2048 + d) * 4096; const float* hbp = HT + (size_t)(g * 2048 + 1024 + d) * 4096;
        float hf[16], hb[16]; float sf = 0.f, sb = 0.f;
#pragma unroll
        for (int a = 0; a < 16; ++a) { const int t = 256 * a + gtv; const float dec = __expf(-((float)t * (1.f / 4095.f)) * delta); hf[a] = hfp[t] * dec; hb[a] = hbp[t] * dec; sf += fabsf(hf[a]); sb += fabsf(hb[a]); }
        sf = wave_sum(sf); sb = wave_sum(sb);
        __syncthreads();
        if (F.lane == 0) { red[F.wave * 2] = sf; red[F.wave * 2 + 1] = sb; }
        __syncthreads();
        sf = red[g * 8] + red[g * 8 + 2] + red[g * 8 + 4] + red[g * 8 + 6]; sb = red[g * 8 + 1] + red[g * 8 + 3] + red[g * 8 + 5] + red[g * 8 + 7];
        const float nf = 1.f / (sf + EPS) * (1.f / 8192.f), nb = 1.f / (sb + EPS) * (1.f / 8192.f);
#pragma unroll
        for (int a = 0; a < 16; ++a) rev[256 * a + gt] = hb[a] * nb;
        __syncthreads();
        c32 v[16];
#pragma unroll
        for (int a = 0; a < 16; ++a) { const int n = 256 * a + gt; hb[a] = n == 0 ? 0.f : rev[4096 - n]; hf[a] *= nf; v[a] = cmk(hf[a] + hb[a], 0.f); }
        fft_forward(v, W, ex, gt);
        c32* kf = KF + ((size_t)(d * 2 + g) * 2) * 4096; const float fb = fbias[g * 1024 + d] * (1.f / 4096.f);
#pragma unroll
        for (int i = 0; i < 16; ++i) kf[i * 256 + gtv] = cmk(v[i].x + fb, v[i].y);
#define OPX(A) v[A] = mul_to<A>(cmk(hf[A] - hb[A], 0.f), W.tob);
        TO_ALL(OPX)
#undef OPX
        fft_forward(v, W, ex, gt);
#pragma unroll
        for (int i = 0; i < 16; ++i) kf[4096 + i * 256 + gtv] = v[i];
    }
}
__device__ __forceinline__ void long_conv(c32 (&z)[16], const c32* kf, const FftTw& W, c32* ex, int gt) {
    typedef float f32x2v __attribute__((ext_vector_type(2))); typedef __attribute__((address_space(1))) const f32x2v gc32;
    c32 v[16], k[16]; int gk = gt; asm volatile("" : "+v"(gk));
#define OPX(A) v[A] = mul_to<A>(z[A], W.tob);
    TO_ALL(OPX)
#undef OPX
    fft_forward_a(v, W, ex, gt);
    asm volatile("" ::: "memory");
#pragma unroll
    for (int i = 0; i < 16; ++i) { const f32x2v t_ = ((gc32*)kf)[4096 + i * 256 + gk]; k[i] = cmk(t_.x, t_.y); }
    fft_forward_bc(v, W, ex, gt);
#pragma unroll
    for (int i = 0; i < 16; ++i) v[i] = cmul(v[i], k[i]);
    fft_inverse(v, W, ex, gt);
#define OPX(A) v[A] = mul_toc<A>(v[A], W.tob);
    TO_ALL(OPX)
#undef OPX
    fft_forward_a(z, W, ex, gt);
    asm volatile("" ::: "memory");
#pragma unroll
    for (int i = 0; i < 16; ++i) { const f32x2v t_ = ((gc32*)kf)[i * 256 + gk]; k[i] = cmk(t_.x, t_.y); }
    fft_forward_bc(z, W, ex, gt);
#pragma unroll
    for (int i = 0; i < 16; ++i) z[i] = cmul(z[i], k[i]);
    fft_inverse(z, W, ex, gt);
#pragma unroll
    for (int a = 0; a < 16; ++a) z[a] = cadd(z[a], v[a]);
}
struct RawSeq { v4u r[2][2]; };
__device__ __forceinline__ void raw_issue(RawSeq& q, const bf16* urow, int b0, int gt) {
    typedef __attribute__((address_space(1))) const v4u gv4u;
    asm volatile("" : "+v"(gt));
#pragma unroll
    for (int s_ = 0; s_ < 2; ++s_)
#pragma unroll
        for (int i = 0; i < 2; ++i) q.r[s_][i] = *(gv4u*)(urow + (size_t)(b0 + s_) * SEQ + (gt + 256 * i) * 8);
}
__device__ __forceinline__ void stage_conv3(c32 (&o)[16], const RawSeq& q, float w0, float w1, float w2, float cb, bf16* stg, int gt) {
    constexpr int SS = 4112;
    __syncthreads();
#pragma unroll
    for (int s_ = 0; s_ < 2; ++s_) {
#pragma unroll
        for (int i = 0; i < 2; ++i) *(v4u*)(stg + s_ * SS + 8 + (gt + 256 * i) * 8) = q.r[s_][i];
        if (gt == 0) { stg[s_ * SS + 7] = 0; stg[s_ * SS + 4104] = 0; } }
    __syncthreads();
#pragma unroll
    for (int a = 0; a < 16; ++a) { const int t = 256 * a + gt; float r[2];
#pragma unroll
        for (int s_ = 0; s_ < 2; ++s_) { const bf16* sp = stg + s_ * SS + 7 + t; r[s_] = w0 * bf2f(sp[0]) + w1 * bf2f(sp[1]) + w2 * bf2f(sp[2]) + cb; }
        o[a] = cmk(r[0], r[1]); if ((a & 3) == 3) __builtin_amdgcn_sched_barrier(0); }
}
__device__ __forceinline__ void conv_phase(const Ctx& F, const bf16* UT, const c32* KF, const float* convw, const float* convb, bf16* ZT) {
    const int g = __builtin_amdgcn_readfirstlane(F.tid >> 8), gt = F.tid & 255;
    c32* ex = (c32*)(F.lds + RING_OFF + g * 36864);
    bf16* stg = (bf16*)ex;
    FftTw W; fft_twiddles(W, gt, (c32*)(F.lds + RING_OFF + 73728), (c32*)(F.lds + RING_OFF + 110592), F.tid);
    RawSeq raw;
    if (F.vcu < DM) raw_issue(raw, UT + (size_t)(2048 + F.vcu) * T, (2 * g) * 2, gt);
    for (int d = F.vcu; d < DM; d += F.G) {
        const c32* kf0 = KF + ((size_t)(d * 2 + 0) * 2) * 4096; const c32* kf1 = KF + ((size_t)(d * 2 + 1) * 2) * 4096;
        for (int pp = 0; pp < 2; ++pp) { const int b0 = (2 * g + pp) * 2;
            int gtv = gt; asm volatile("" : "+v"(gtv));
            c32 z[16], gate[16];
            { const int c = 2048 + d; stage_conv3(z, raw, convw[c], convw[3072 + c], convw[6144 + c], convb[c], stg, gtv); }
            raw_issue(raw, UT + (size_t)d * T, b0, gtv);
            long_conv(z, kf0, W, ex, gtv);
            { const int c = d; stage_conv3(gate, raw, convw[c], convw[3072 + c], convw[6144 + c], convb[c], stg, gtv); }
            raw_issue(raw, UT + (size_t)(1024 + d) * T, b0, gtv);
#pragma unroll
            for (int a = 0; a < 16; ++a) z[a] = cmk(z[a].x * gate[a].x, z[a].y * gate[a].y);
            long_conv(z, kf1, W, ex, gtv);
            { const int c = 1024 + d; stage_conv3(gate, raw, convw[c], convw[3072 + c], convw[6144 + c], convb[c], stg, gtv); }
            { const int dn = pp == 0 ? d : d + F.G; if (dn < DM) raw_issue(raw, UT + (size_t)(2048 + dn) * T, pp == 0 ? b0 + 2 : (2 * g) * 2, gtv); }
            bf16* zr = ZT + (size_t)d * T + (size_t)b0 * SEQ;
#pragma unroll
            for (int a = 0; a < 16; ++a) { const int t = 256 * a + gtv; const unsigned pk = pk2(z[a].x * gate[a].x, z[a].y * gate[a].y); zr[t] = (bf16)(pk & 0xffffu); zr[SEQ + t] = (bf16)(pk >> 16); }
        }
    }
}
__device__ __forceinline__ void transpose_phase(const Ctx& F, const bf16* ZT, bf16* Z) {
    bf16* tile = (bf16*)(F.lds + RING_OFF + F.wave * 8704);
    const int l = F.lane;
    v4u x[8];
    if (F.gw < 16 * 512) { const int d0 = (F.gw & 15) * 64, t0 = (F.gw >> 4) * 64;
#pragma unroll
        for (int i = 0; i < 8; ++i) x[i] = *(const v4u*)(ZT + (size_t)(d0 + i * 8 + (l >> 3)) * T + t0 + (l & 7) * 8); }
    for (int it = F.gw; it < 16 * 512; it += F.NGW) { const int d0 = (it & 15) * 64, t0 = (it >> 4) * 64;
#pragma unroll
        for (int i = 0; i < 8; ++i) { const int dr = i * 8 + (l >> 3), c = l & 7;
            v2u* p = (v2u*)(tile + dr * 68 + c * 8); v2u a; a.x = x[i].x; a.y = x[i].y; p[0] = a; a.x = x[i].z; a.y = x[i].w; p[1] = a; }
        const int itn = it + F.NGW;
        if (itn < 16 * 512) { const int dn = (itn & 15) * 64, tn = (itn >> 4) * 64;
#pragma unroll
            for (int i = 0; i < 8; ++i) x[i] = *(const v4u*)(ZT + (size_t)(dn + i * 8 + (l >> 3)) * T + tn + (l & 7) * 8); }
        LDS_WAIT();
#pragma unroll
        for (int i = 0; i < 8; ++i) { const int tr = i * 8 + (l >> 3), c = l & 7; unsigned short e[8];
#pragma unroll
            for (int k = 0; k < 8; ++k) e[k] = tile[(c * 8 + k) * 68 + tr];
            v4u o; o.x = e[0] | ((unsigned)e[1] << 16); o.y = e[2] | ((unsigned)e[3] << 16); o.z = e[4] | ((unsigned)e[5] << 16); o.w = e[6] | ((unsigned)e[7] << 16);
            *(v4u*)(Z + (size_t)(t0 + tr) * DM + d0 + c * 8) = o; }
        LDS_WAIT();
    }
}

constexpr int NPH = 22;
#define MOE_PHASES(L) do { \
        const int mb = 8 + 10 * L; \
        if (IN(mb)) { PH_ARGS; const float* mod = WSP(float, WS_MOD) + (size_t)L * 8 * 6144; gu32* cnt = (gu32*)(ws + WS_CTL) + CW_CNT + L * 24 * 64; \
            route_phase(F, WSP(bf16, WS_XR), in[6] + L * 1024, mod + 4 * 1024, mod + 3 * 1024, in[31] + L * 4096, in[32] + L * 4, in[33] + L * 16384, in[34] + L * 16, WSP(bf16, WS_XN2), WSP(int, WS_LIST), WSP(float, WS_WL), cnt); \
            if (L == 0) { __syncthreads();        \
                pg8::Gemm gmh{WSP(bf16, WS_W4S), WSP(bf16, WS_HDNS), 4096, 4096, 256}; pg8::StaticOrder Sh; Sh.init(4096, 4096, F.G, (int)blockIdx.x); pg8::EpiF32 Eh{WSP(float, WS_HT), 4096}; \
                REP(11) pg8::gemm_phase<pg8::EpiF32, pg8::StaticOrder, true, true>(ring, gmh, Sh, Eh, F.tid); } } \
        if (IN(mb) && IN(mb + 2)) xcd_barrier(bar); \
        if (IN(mb + 2)) { PH_ARGS; gu32* cnt = (gu32*)(ws + WS_CTL) + CW_CNT + L * 24 * 64; moe_table(F, cnt); \
              \
            pg8::Gemm gm{WSP(bf16, WS_XN2), (const bf16*)(ws + WS_WGU + (size_t)L * 16 * 512 * 1024), MS_ROWS, 8192, 512}; pg8::MoeOrder S{tinfo, F.G, F.vcu, 0, WSP(int, WS_LIST)}; pg8::EpiSwiGLU E{WSP(bf16, WS_HACT), WSP(float, WS_WL), tinfo}; \
            REP(10) pg8::gemm_phase_gather<pg8::EpiSwiGLU, pg8::MoeOrder, true, true, 5>(ring, gm, S, E, F.tid); } SEAM(mb + 2); \
        if (IN(mb + 3)) { PH_ARGS; gu32* cnt = (gu32*)(ws + WS_CTL) + CW_CNT + L * 24 * 64; moe_table(F, cnt); const float* mod = WSP(float, WS_MOD) + (size_t)L * 8 * 6144; \
            pg8::Gemm gm{WSP(bf16, WS_HACT), WSP(bf16, WS_WDN) + (size_t)L * 24 * 1024 * 512, MS_ROWS, 24 * 1024, 512}; pg8::MoeOrder S{tinfo, F.G, F.vcu, 1, WSP(int, WS_LIST)}; if (L == 0) { pg8::EpiMoeOut<bf16> E{WSP(bf16, WS_XR), WSP(bf16, WS_XR), mod + 5 * 1024, WSP(int, WS_LIST), tinfo}; pg8::gemm_phase<pg8::EpiMoeOut<bf16>, pg8::MoeOrder, true, true>(ring, gm, S, E, F.tid); } \
            else { pg8::EpiMoeOut<float> E{WSP(bf16, WS_XR), out, mod + 5 * 1024, WSP(int, WS_LIST), tinfo}; pg8::gemm_phase<pg8::EpiMoeOut<float>, pg8::MoeOrder, true, true>(ring, gm, S, E, F.tid); } \
            if (L == 0) { __syncthreads(); REP(13) filter_phase(F, WSP(float, WS_HT), in[29], WSP(c32, WS_KF)); }       \
            } \
    } while (0)
struct Args { const float* in[38]; float* out; unsigned char* ws; int ph_lo, ph_hi; };
static_assert(sizeof(Args) == 38 * 8 + 8 + 8 + 8, "Args layout (read back through the kernarg segment pointer)");
__global__ void __launch_bounds__(NTHR, 2) fwd_kernel(Args args) {
    extern __shared__ __attribute__((aligned(16))) unsigned char lds[];
#define MK_CTX(F, tx) Ctx F; F.lds = lds; F.tid = (tx); F.lane = F.tid & 63; F.wave = __builtin_amdgcn_readfirstlane(F.tid >> 6); \
    F.G = gridDim.x; { const int bx = blockIdx.x; F.vcu = (F.G % 8 == 0) ? (bx % 8) * (F.G / 8) + bx / 8 : bx; } F.gw = F.vcu * NWAVES + F.wave; F.NGW = F.G * NWAVES
    for (int u = threadIdx.x; u < (LDS_BYTES - LDSCTL_OFF) / 4; u += NTHR) ((LAS unsigned*)((LAS unsigned char*)lds + LDSCTL_OFF))[u] = 0u;
    __syncthreads();
    const int wave_s_ = __builtin_amdgcn_readfirstlane(threadIdx.x >> 6);
    const int lo = args.ph_lo, hi = args.ph_hi;
    const bool use_bar = (hi - lo) > 1;
    XcdBarrier bar; bar.bar = (unsigned*)(args.ws + WS_CTL) + CW_BAR; bar.x = 0; bar.st = nullptr; bar.w0 = 0;
    if (use_bar) bar = xcd_barrier_post((unsigned*)(args.ws + WS_CTL) + CW_BAR, (volatile LAS unsigned*)((LAS unsigned char*)lds + MISC_OFF) + 8);
    bar.w0 = (wave_s_ == 0) ? 1 : 0;
#ifndef PHMASK
#define PHMASK 0xFFFFFFFFu
#endif
#define IN(k) (((PHMASK >> ((k) >= 18 ? (k) - 10 : (k))) & 1u) && lo <= (k) && (k) < hi)
#ifndef REPMASK
#define REPMASK 0u
#endif
#define NREP(k) (((REPMASK >> (k)) & 1u) ? 2 : 1)
#define REP(k) for (int rep_ = 0; rep_ < NREP(k); ++rep_)
#define SEAM(k) do { if (IN(k) && IN((k) + 1)) xcd_barrier(bar); } while (0)
#define PH_STR2(x) #x
#define PH_STR(x) PH_STR2(x)
#define PH_ARGS int opq_ = 0; asm volatile("; PHMARK line " PH_STR(__LINE__) : "+s"(opq_)); const In in{opq_}; unsigned char* const ws = karg_ws(opq_); float* const out = karg_out(opq_); (void)in; (void)ws; (void)out; int tx_; asm volatile("v_mbcnt_lo_u32_b32 %0, -1, 0\n\tv_mbcnt_hi_u32_b32 %0, -1, %0" : "=v"(tx_)); tx_ += wave_s_ * 64; MK_CTX(F, tx_)
#define WSP(type, off) ((type*)(ws + (off)))
    PG8_LAS unsigned char* ring = (PG8_LAS unsigned char*)lds + RING_OFF;
    const PG8_LAS int* tinfo = (const PG8_LAS int*)((PG8_LAS unsigned char*)lds + TINFO_OFF);

    if (IN(0)) { PH_ARGS; REP(0) p0_prologue(F, in, ws); } SEAM(0);

            if (IN(1)) { PH_ARGS; const float* mod = WSP(float, WS_MOD); REP(1) norm_mod_phase<float, true>(F, in[0], in[5], mod + 1024, mod, WSP(bf16, WS_XN)); } SEAM(1);
            if (IN(2)) { PH_ARGS; pg8::Gemm gm{WSP(bf16, WS_XN), WSP(bf16, WS_WD), T, 512, 512};   pg8::StaticOrder S; S.init(T, 512, F.G, (int)blockIdx.x);
                pg8::EpiLat E{WSP(unsigned char, WS_CQN), WSP(bf16, WS_CKVN), WSP(unsigned char, WS_KPE), in[8], in[9], in[13], WSP(float, WS_ROPE), (PG8_LAS float*)((PG8_LAS unsigned char*)lds + EPIX_OFF)};
                REP(2) pg8::gemm_phase<pg8::EpiLat, pg8::StaticOrder, true, true, 5>(ring, gm, S, E, F.tid); }
            if (IN(2) && IN(4)) xcd_barrier(bar);
            if (IN(4)) { REP(4) {
                { PH_ARGS; pg8::Gemm gm{WSP(bf16, WS_CQN), WSP(bf16, WS_WUQ), T, 1536, 128};   pg8::StaticOrder S; S.init(T, 1536, F.G, (int)blockIdx.x); pg8::EpiBf16R E{WSP(bf16, WS_QRAW), 1536, nullptr};
                  pg8::gemm_phase<pg8::EpiBf16R, pg8::StaticOrder, true, true, 4>(ring, gm, S, E, F.tid); }
                { PH_ARGS; pg8::Gemm gm{WSP(bf16, WS_CKVN), WSP(bf16, WS_WUKV), T, 1024, 128};   pg8::StaticOrder S; S.init(T, 1024, F.G, (int)blockIdx.x);
                  pg8::EpiK8 E{WSP(unsigned char, WS_K8), in[13], (PG8_LAS float*)((PG8_LAS unsigned char*)lds + EPIX_OFF)};
                  pg8::gemm_phase<pg8::EpiK8, pg8::StaticOrder, true, true>(ring, gm, S, E, F.tid); }
                { PH_ARGS; pg8::Gemm gm{WSP(bf16, WS_WUKV) + 1024 * 128, WSP(bf16, WS_CKVN), 1024, T, 128}; pg8::StaticOrder S; S.init(1024, T, F.G, (int)blockIdx.x);
                  pg8::EpiF8T E{WSP(unsigned char, WS_VT8), T};
                  pg8::gemm_phase<pg8::EpiF8T, pg8::StaticOrder, true, true>(ring, gm, S, E, F.tid); } }
            } if (IN(4) && IN(6)) xcd_barrier(bar);
            if (IN(6)) { PH_ARGS;
                const float* qg = in[12]; const float* kg = in[13];
                float gqn = 0.f, gkn = 0.f, gqp = 0.f, gkp = 0.f;
                for (int i = 0; i < 128; ++i) { gqn = fmaxf(gqn, fabsf(qg[i])); gkn = fmaxf(gkn, fabsf(kg[i])); }
                for (int i = 128; i < 192; ++i) { gqp = fmaxf(gqp, fabsf(qg[i])); gkp = fmaxf(gkp, fabsf(kg[i])); }
                const float smaxC = (128.f * gqn * gkn + 64.f * gqp * gkp) * (0.072168783648703220f * 1.4426950408889634f);
                unsigned redo_mask = 0u;
                if (smaxC < 60.f) for (int rep_ = 0; rep_ < NREP(6); ++rep_) { int i = 0;
                    for (int u = F.vcu; u < 1024; u += F.G, ++i) { const int b = u >> 7, h = (u >> 4) & 7, qb = u & 15;
                        if (att::attn_unit<false>(b, h, qb * 256, WSP(bf16, WS_QRAW), WSP(unsigned char, WS_VT8), WSP(unsigned char, WS_K8), WSP(unsigned char, WS_KPE), WSP(bf16, WS_O), WSP(float, WS_ROPE), qg, smaxC, (char*)lds + RING_OFF, F.tid)) redo_mask |= 1u << (i & 31); } }
                else redo_mask = 0xffffffffu;
                redo_mask = (unsigned)__builtin_amdgcn_readfirstlane((int)redo_mask);
                if (redo_mask) { int i = 0;
                    for (int u = F.vcu; u < 1024; u += F.G, ++i) { const int b = u >> 7, h = (u >> 4) & 7, qb = u & 15;
                        if ((redo_mask >> (i & 31)) & 1u) (void)att::attn_unit<true>(b, h, qb * 256, WSP(bf16, WS_QRAW), WSP(unsigned char, WS_VT8), WSP(unsigned char, WS_K8), WSP(unsigned char, WS_KPE), WSP(bf16, WS_O), WSP(float, WS_ROPE), qg, smaxC, (char*)lds + RING_OFF, F.tid); } }
            } SEAM(6);
            if (IN(7)) { PH_ARGS; pg8::Gemm gm{WSP(bf16, WS_O), WSP(bf16, WS_WO), T, 1024, 512};   pg8::StaticOrder S; S.init(T, 1024, F.G, (int)blockIdx.x); pg8::EpiResGate<float, bf16> E{in[0], WSP(bf16, WS_XR), WSP(float, WS_MOD) + 2048, 1024};
                REP(7) pg8::gemm_phase<pg8::EpiResGate<float, bf16>, pg8::StaticOrder, true, true, 10>(ring, gm, S, E, F.tid); } SEAM(7);
    MOE_PHASES(0); SEAM(11);
            if (IN(12)) { PH_ARGS; const float* mod = WSP(float, WS_MOD) + 8 * 6144; REP(12) norm_mod_phase(F, WSP(bf16, WS_XR), in[5] + 1024, mod + 1024, mod, (bf16*)out); }
            if (IN(12) && IN(14)) xcd_barrier(bar);
            if (IN(14)) { PH_ARGS; pg8::Gemm gm{WSP(bf16, WS_WIN), (const bf16*)out, 3072, T, 1024}; pg8::StaticOrder S; S.init(3072, T, F.G, (int)blockIdx.x); pg8::EpiBf16R E{WSP(bf16, WS_UT), T, in[16]};
                REP(14) pg8::gemm_phase<pg8::EpiBf16R, pg8::StaticOrder, true, true>(ring, gm, S, E, F.tid); } SEAM(14);
            if (IN(15)) { PH_ARGS; for (int rep = 0; rep < NREP(15); ++rep) conv_phase(F, WSP(bf16, WS_UT), WSP(c32, WS_KF), in[17], in[18], (bf16*)out); } SEAM(15);
            if (IN(16)) { PH_ARGS; REP(16) transpose_phase(F, (const bf16*)out, WSP(bf16, WS_Z)); } SEAM(16);
            if (IN(17)) { PH_ARGS; pg8::Gemm gm{WSP(bf16, WS_Z), WSP(bf16, WS_WOUT), T, 1024, 1024}; pg8::StaticOrder S; S.init(T, 1024, F.G, (int)blockIdx.x); pg8::EpiResGate<bf16, bf16> E{WSP(bf16, WS_XR), WSP(bf16, WS_XR), WSP(float, WS_MOD) + 8 * 6144 + 2048, 1024};
                pg8::gemm_phase<pg8::EpiResGate<bf16, bf16>, pg8::StaticOrder, true, true>(ring, gm, S, E, F.tid); } SEAM(17);
    MOE_PHASES(1);
#undef IN
#undef SEAM
}

#ifndef ONE_LAUNCH
#define ONE_LAUNCH 1
#endif
extern "C" void kernel_launch(void* const* d_in, const int* in_sizes, int n_in, void* d_out, int out_size, void* d_ws, size_t ws_size, hipStream_t stream) {
    static int grid = 0;
    if (grid == 0) {
        if (n_in != 38 || in_sizes[0] != T * DM || out_size != T * DM || ws_size < WS_END) { fprintf(stderr, "kernel_launch: shape mismatch n_in %d in0 %d out %d ws %zu\n", n_in, n_in > 0 ? in_sizes[0] : -1, out_size, ws_size); grid = -1; return; }
        int dev = 0, cus = 0, per_cu = 0;
        if (hipGetDevice(&dev) != hipSuccess || hipDeviceGetAttribute(&cus, hipDeviceAttributeMultiprocessorCount, dev) != hipSuccess) { grid = -1; return; }
        if (hipFuncSetAttribute((const void*)fwd_kernel, hipFuncAttributeMaxDynamicSharedMemorySize, LDS_BYTES) != hipSuccess) { fprintf(stderr, "kernel_launch: hipFuncSetAttribute failed\n"); grid = -1; return; }
        if (hipOccupancyMaxActiveBlocksPerMultiprocessor(&per_cu, (const void*)fwd_kernel, NTHR, LDS_BYTES) != hipSuccess || per_cu < 1) { fprintf(stderr, "kernel_launch: occupancy query says %d\n", per_cu); }
        (void)hipGetLastError();
        grid = cus;
    }
    if (grid < 0) return;
    if (hipMemsetAsync((char*)d_ws + WS_CTL, 0, CTL_ZERO_BYTES, stream) != hipSuccess) return;
    Args a{};
    for (int i = 0; i < 38; ++i) a.in[i] = (const float*)d_in[i];
    a.out = (float*)d_out; a.ws = (unsigned char*)d_ws;
#if ONE_LAUNCH
    a.ph_lo = 0; a.ph_hi = NPH;
    hipLaunchKernelGGL(fwd_kernel, dim3(grid), dim3(NTHR), LDS_BYTES, stream, a);
#else
    for (int p = 0; p < NPH; ++p) { a.ph_lo = p; a.ph_hi = p + 1; hipLaunchKernelGGL(fwd_kernel, dim3(grid), dim3(NTHR), LDS_BYTES, stream, a); }
#endif
    const hipError_t le = hipPeekAtLastError();
    if (le != hipSuccess) fprintf(stderr, "kernel_launch: launch failed: %s\n", hipGetErrorName(le));
}
```

```cpp
#include <hip/hip_runtime.h>
#include <cstdio>
#include <cstdint>
namespace pg8 {
#define PG8_LAS __attribute__((address_space(3)))
typedef unsigned short bf16_t;
typedef short bf16x8 __attribute__((ext_vector_type(8)));
typedef float f32x4 __attribute__((ext_vector_type(4)));
typedef unsigned u32x4 __attribute__((ext_vector_type(4)));
typedef int v4i_t __attribute__((ext_vector_type(4)));
typedef int v8i_t __attribute__((ext_vector_type(8)));
constexpr int BM = 256, BK = 64, HALF = 128, HTB = HALF * BK * 2  , STAGE_BYTES = 8 * HTB, NXCD = 8, WGM = 8;

__host__ __device__ __forceinline__ int lds_byte(int r, int c) { const int st = (r >> 4) * 2 + (c >> 5), rr = r & 15, cc = c & 31, ob = rr * 64 + cc * 2; return st * 1024 + (ob ^ (((ob >> 9) & 1) << 5)); }
__host__ __device__ __forceinline__ void stage_rc(int b, int& R, int& C) { const int st = b / 1024, sb = b % 1024, swz = sb ^ (((sb >> 9) & 1) << 5); R = (st >> 1) * 16 + swz / 64; C = (st & 1) * 32 + (swz % 64) / 2; }
__host__ __device__ __forceinline__ int perm32(int rho) { const int n = rho >> 4, i = rho & 15; return 8 * (i >> 2) + 4 * n + (i & 3); }

struct Unit { int pm, pn; };
struct Gemm { const bf16_t* A; const bf16_t* Bt; int M, N, K; };

struct StaticOrder {
    int nM, nN, nwg, G, c;
    __host__ __device__ void init(int M, int N, int G_, int c_) { nM = M / BM; nN = N / BM; nwg = nM * nN; G = G_; c = c_; }
    __host__ __device__ bool next(int i, Unit& u) const {
        const long L = (long)i * G + c; if (L >= nwg) return false;
        int wgid = (int)L; { const int q = nwg / NXCD, r = nwg % NXCD, xcd = wgid % NXCD, off = wgid / NXCD; wgid = (xcd < r ? xcd * (q + 1) : r * (q + 1) + (xcd - r) * q) + off; }
        const int nig = WGM * nN, gid = wgid / nig, fm = gid * WGM, gsz = (nM - fm) < WGM ? (nM - fm) : WGM;
        u.pm = fm + ((wgid % nig) % gsz); u.pn = (wgid % nig) / gsz; return true;
    }
    __device__ __forceinline__ void a_ready(const Unit&) const {}
    __device__ __forceinline__ void done(const Unit&) const {}
};

__device__ __forceinline__ unsigned cvt_pk_bf16(float lo, float hi) { unsigned r; asm volatile("v_cvt_pk_bf16_f32 %0, %1, %2" : "=v"(r) : "v"(lo), "v"(hi)); return r; }
typedef float f32x2 __attribute__((ext_vector_type(2)));
typedef unsigned u32x2 __attribute__((ext_vector_type(2)));
struct EpiF32 {
    static constexpr bool PERM = false, AFTER_DRAIN = false;
    float* C; int ldc;
    __device__ __forceinline__ void operator()(const f32x4 (&acc)[2][2][4][2], const Unit& u, int wr, int wc, int fr, int fq) const {
        const int row0 = u.pm * BM + wr * 64 + fr, col0 = u.pn * BM + wc * 32 + 4 * fq;
#pragma unroll
        for (int ai = 0; ai < 2; ++ai)
#pragma unroll
            for (int m = 0; m < 4; ++m) { float* rowp = C + (size_t)(row0 + ai * HALF + m * 16) * ldc + col0;
#pragma unroll
                for (int bj = 0; bj < 2; ++bj)
#pragma unroll
                    for (int n = 0; n < 2; ++n) *(f32x4*)(rowp + bj * HALF + n * 16) = acc[ai][bj][m][n]; }
    }
};
struct EpiBf16R {
    static constexpr bool PERM = true, AFTER_DRAIN = false;
    bf16_t* O; int ldc; const float* rowbias;
    __device__ __forceinline__ void operator()(const f32x4 (&acc)[2][2][4][2], const Unit& u, int wr, int wc, int fr, int fq) const {
        const int row0 = u.pm * BM + wr * 64 + fr, col0 = u.pn * BM + wc * 32 + 8 * fq;
#pragma unroll
        for (int ai = 0; ai < 2; ++ai)
#pragma unroll
            for (int m = 0; m < 4; ++m) { const int row = row0 + ai * HALF + m * 16; bf16_t* rowp = O + (size_t)row * ldc + col0; const float rb = rowbias ? rowbias[row] : 0.f;
#pragma unroll
                for (int bj = 0; bj < 2; ++bj) { const f32x4 v0 = acc[ai][bj][m][0] + rb, v1 = acc[ai][bj][m][1] + rb;
                    u32x4 w; w.x = cvt_pk_bf16(v0[0], v0[1]); w.y = cvt_pk_bf16(v0[2], v0[3]); w.z = cvt_pk_bf16(v1[0], v1[1]); w.w = cvt_pk_bf16(v1[2], v1[3]);
                    *(u32x4*)(rowp + bj * HALF) = w; } }
    }
};
__device__ __forceinline__ f32x4 ld4(const float* p) { return *(const f32x4*)p; }
__device__ __forceinline__ f32x4 ld4(const bf16_t* p) { const u32x2 w = *(const u32x2*)p; f32x4 r; r[0] = __uint_as_float(w.x << 16); r[1] = __uint_as_float(w.x & 0xffff0000u); r[2] = __uint_as_float(w.y << 16); r[3] = __uint_as_float(w.y & 0xffff0000u); return r; }
__device__ __forceinline__ void st4(float* p, f32x4 v) { *(f32x4*)p = v; }
__device__ __forceinline__ void st4(bf16_t* p, f32x4 v) { u32x2 w; w.x = cvt_pk_bf16(v[0], v[1]); w.y = cvt_pk_bf16(v[2], v[3]); *(u32x2*)p = w; }
template <class TB, class TO> struct EpiResGate {
    static constexpr bool PERM = false, AFTER_DRAIN = false;
    const TB* base; TO* out; const float* gate; int ldc;
    __device__ __forceinline__ void operator()(const f32x4 (&acc)[2][2][4][2], const Unit& u, int wr, int wc, int fr, int fq) const {
        const int row0 = u.pm * BM + wr * 64 + fr, col0 = u.pn * BM + wc * 32 + 4 * fq;
        const float* gp = gate + (size_t)(u.pm >> 4) * 6144 + col0;
        f32x4 gv[2][2];
#pragma unroll
        for (int bj = 0; bj < 2; ++bj)
#pragma unroll
            for (int n = 0; n < 2; ++n) gv[bj][n] = *(const f32x4*)(gp + bj * HALF + n * 16);
#pragma unroll
        for (int ai = 0; ai < 2; ++ai)
#pragma unroll
            for (int m = 0; m < 4; ++m) { const size_t off = (size_t)(row0 + ai * HALF + m * 16) * ldc + col0;
#pragma unroll
                for (int bj = 0; bj < 2; ++bj)
#pragma unroll
                    for (int n = 0; n < 2; ++n) { const f32x4 bs = ld4(base + off + bj * HALF + n * 16); st4(out + off + bj * HALF + n * 16, bs + gv[bj][n] * acc[ai][bj][m][n]); }
                asm volatile("" ::: "memory"); }
    }
};
struct EpiLat {
    static constexpr bool PERM = false, AFTER_DRAIN = false;
    unsigned char* CQN  ; bf16_t* CKVN; unsigned char* KPE  ; const float* qag; const float* kvag; const float* kng; const float* rope; PG8_LAS float* P;
    __device__ __forceinline__ void operator()(const f32x4 (&acc)[2][2][4][2], const Unit& u, int wr, int wc, int, int) const {
        int ln = (int)__builtin_amdgcn_mbcnt_hi(~0u, __builtin_amdgcn_mbcnt_lo(~0u, 0u)); asm volatile("" : "+v"(ln)); const int fr = ln & 15, fq = ln >> 4;
        const int row0 = u.pm * BM + wr * 64 + fr;
#pragma unroll
        for (int ai = 0; ai < 2; ++ai)
#pragma unroll
            for (int m = 0; m < 4; ++m) { float s0 = 0.f, s1 = 0.f;
#pragma unroll
                for (int n = 0; n < 2; ++n) { const f32x4 a = acc[ai][0][m][n], b = acc[ai][1][m][n];
                    s0 += (a[0] * a[0] + a[1] * a[1]) + (a[2] * a[2] + a[3] * a[3]); s1 += (b[0] * b[0] + b[1] * b[1]) + (b[2] * b[2] + b[3] * b[3]); }
                s0 += __shfl_xor(s0, 16); s0 += __shfl_xor(s0, 32); s1 += __shfl_xor(s1, 16); s1 += __shfl_xor(s1, 32);
                if (fq == 0) { const int rl = ai * HALF + wr * 64 + m * 16 + fr; P[rl * 8 + wc] = s0; P[rl * 8 + 4 + wc] = s1; } }
        asm volatile("s_waitcnt lgkmcnt(0)" ::: "memory"); __builtin_amdgcn_s_barrier(); asm volatile("" ::: "memory");
        const int cl = wc * 32 + 4 * fq;
        if (u.pn == 0) {
            f32x4 g[2][2];
#pragma unroll
            for (int bj = 0; bj < 2; ++bj)
#pragma unroll
                for (int n = 0; n < 2; ++n) g[bj][n] = *(const f32x4*)(qag + bj * HALF + cl + 16 * n);
#pragma unroll
            for (int ai = 0; ai < 2; ++ai)
#pragma unroll
                for (int m = 0; m < 4; ++m) { const int rl = ai * HALF + wr * 64 + m * 16 + fr; const f32x4 pa = *(const PG8_LAS f32x4*)(P + rl * 8), pb = *(const PG8_LAS f32x4*)(P + rl * 8 + 4);
                    const float r = __builtin_amdgcn_rsqf((((pa[0] + pa[1]) + (pa[2] + pa[3])) + ((pb[0] + pb[1]) + (pb[2] + pb[3]))) * (1.f / 256.f) + 1e-6f);
                    unsigned char* rowp = CQN + (size_t)(row0 + ai * HALF + m * 16) * 256 + cl;
#pragma unroll
                    for (int bj = 0; bj < 2; ++bj)
#pragma unroll
                        for (int n = 0; n < 2; ++n) { const f32x4 v = acc[ai][bj][m][n] * r * g[bj][n]; int p = 0; p = __builtin_amdgcn_cvt_pk_fp8_f32(v[0], v[1], p, false); p = __builtin_amdgcn_cvt_pk_fp8_f32(v[2], v[3], p, true); *(int*)(rowp + bj * HALF + 16 * n) = p; } }
        } else {
            f32x4 gk[2], gp[2]; const int e0 = 16 * (wc & 1) + 4 * fq;
#pragma unroll
            for (int n = 0; n < 2; ++n) { gk[n] = *(const f32x4*)(kvag + cl + 16 * n); gp[n] = *(const f32x4*)(kng + 128 + e0 + 32 * n); }
#pragma unroll
            for (int ai = 0; ai < 2; ++ai)
#pragma unroll
                for (int m = 0; m < 4; ++m) { const int rl = ai * HALF + wr * 64 + m * 16 + fr; const f32x4 pa = *(const PG8_LAS f32x4*)(P + rl * 8), pb = *(const PG8_LAS f32x4*)(P + rl * 8 + 4);
                    const float rkv = __builtin_amdgcn_rsqf(((pa[0] + pa[1]) + (pa[2] + pa[3])) * (1.f / 128.f) + 1e-6f), rpe = __builtin_amdgcn_rsqf((pb[0] + pb[1]) * (1.f / 64.f) + 1e-6f);
                    const size_t row = (size_t)(row0 + ai * HALF + m * 16);
#pragma unroll
                    for (int n = 0; n < 2; ++n) { const f32x4 v = acc[ai][0][m][n] * rkv * gk[n]; u32x2 w; w.x = cvt_pk_bf16(v[0], v[1]); w.y = cvt_pk_bf16(v[2], v[3]); *(u32x2*)(CKVN + row * 128 + cl + 16 * n) = w; }
                    if (wc < 2) { const f32x4 x1 = acc[ai][1][m][0] * rpe * gp[0], x2 = acc[ai][1][m][1] * rpe * gp[1];
                        const f32x4 c0 = *(const f32x4*)(rope + row * 64 + e0 * 2), c1 = *(const f32x4*)(rope + row * 64 + e0 * 2 + 4);
                        const float cs[4] = {c0[0], c0[2], c1[0], c1[2]}, sn[4] = {c0[1], c0[3], c1[1], c1[3]};
                        float o1[4], o2[4];
#pragma unroll
                        for (int j = 0; j < 4; ++j) { o1[j] = x1[j] * cs[j] - x2[j] * sn[j]; o2[j] = x1[j] * sn[j] + x2[j] * cs[j]; }
                        int w1 = 0, w2 = 0; w1 = __builtin_amdgcn_cvt_pk_fp8_f32(o1[0], o1[1], w1, false); w1 = __builtin_amdgcn_cvt_pk_fp8_f32(o1[2], o1[3], w1, true); w2 = __builtin_amdgcn_cvt_pk_fp8_f32(o2[0], o2[1], w2, false); w2 = __builtin_amdgcn_cvt_pk_fp8_f32(o2[2], o2[3], w2, true);
                        *(int*)(KPE + row * 64 + e0) = w1; *(int*)(KPE + row * 64 + 32 + e0) = w2; }
                    asm volatile("" ::: "memory"); }
        }
        asm volatile("s_waitcnt lgkmcnt(0)" ::: "memory"); __builtin_amdgcn_s_barrier(); asm volatile("" ::: "memory");
    }
};
struct EpiK8 {
    static constexpr bool PERM = true, AFTER_DRAIN = false;
    unsigned char* K8; const float* kng; PG8_LAS float* P;
    __device__ __forceinline__ void operator()(const f32x4 (&acc)[2][2][4][2], const Unit& u, int wr, int wc, int, int) const {
        int ln = (int)__builtin_amdgcn_mbcnt_hi(~0u, __builtin_amdgcn_mbcnt_lo(~0u, 0u)); asm volatile("" : "+v"(ln)); const int fr = ln & 15, fq = ln >> 4;
#pragma unroll
        for (int ai = 0; ai < 2; ++ai)
#pragma unroll
            for (int m = 0; m < 4; ++m) {
#pragma unroll
                for (int bj = 0; bj < 2; ++bj) { const f32x4 a = acc[ai][bj][m][0], b = acc[ai][bj][m][1];
                    float s = (a[0] * a[0] + a[1] * a[1]) + (a[2] * a[2] + a[3] * a[3]) + (b[0] * b[0] + b[1] * b[1]) + (b[2] * b[2] + b[3] * b[3]);
                    s += __shfl_xor(s, 16); s += __shfl_xor(s, 32);
                    if (fq == 0) P[(ai * HALF + wr * 64 + m * 16 + fr) * 8 + bj * 4 + wc] = s; } }
        asm volatile("s_waitcnt lgkmcnt(0)" ::: "memory"); __builtin_amdgcn_s_barrier(); asm volatile("" ::: "memory");
        const f32x4 g0 = *(const f32x4*)(kng + wc * 32 + 8 * fq), g1 = *(const f32x4*)(kng + wc * 32 + 8 * fq + 4);
        const int row0 = u.pm * BM + wr * 64 + fr;
#pragma unroll
        for (int ai = 0; ai < 2; ++ai)
#pragma unroll
            for (int m = 0; m < 4; ++m) { const int rl = ai * HALF + wr * 64 + m * 16 + fr;
#pragma unroll
                for (int bj = 0; bj < 2; ++bj) { const f32x4 p4 = *(const PG8_LAS f32x4*)(P + rl * 8 + bj * 4);
                    const float r = __builtin_amdgcn_rsqf(((p4[0] + p4[1]) + (p4[2] + p4[3])) * (1.f / 128.f) + 1e-6f);
                    const f32x4 v0 = acc[ai][bj][m][0] * r * g0, v1 = acc[ai][bj][m][1] * r * g1;
                    int w0 = 0, w1 = 0; w0 = __builtin_amdgcn_cvt_pk_fp8_f32(v0[0], v0[1], w0, false); w0 = __builtin_amdgcn_cvt_pk_fp8_f32(v0[2], v0[3], w0, true); w1 = __builtin_amdgcn_cvt_pk_fp8_f32(v1[0], v1[1], w1, false); w1 = __builtin_amdgcn_cvt_pk_fp8_f32(v1[2], v1[3], w1, true);
                    u32x2 w; w.x = (unsigned)w0; w.y = (unsigned)w1; *(u32x2*)(K8 + ((size_t)(row0 + ai * HALF + m * 16) * 8 + 2 * u.pn + bj) * 128 + wc * 32 + 8 * fq) = w; } }
        asm volatile("s_waitcnt lgkmcnt(0)" ::: "memory"); __builtin_amdgcn_s_barrier(); asm volatile("" ::: "memory");
    }
};
struct EpiF8T {
    static constexpr bool PERM = true, AFTER_DRAIN = false;
    unsigned char* O; int ldc;
    __device__ __forceinline__ void operator()(const f32x4 (&acc)[2][2][4][2], const Unit& u, int wr, int wc, int fr, int fq) const {
        const int row0 = u.pm * BM + wr * 64 + fr, col0 = u.pn * BM + wc * 32 + 8 * fq;
#pragma unroll
        for (int ai = 0; ai < 2; ++ai)
#pragma unroll
            for (int m = 0; m < 4; ++m) { unsigned char* rowp = O + (size_t)(row0 + ai * HALF + m * 16) * ldc + col0;
#pragma unroll
                for (int bj = 0; bj < 2; ++bj) { const f32x4 v0 = acc[ai][bj][m][0], v1 = acc[ai][bj][m][1];
                    int w0 = 0, w1 = 0; w0 = __builtin_amdgcn_cvt_pk_fp8_f32(v0[0], v0[1], w0, false); w0 = __builtin_amdgcn_cvt_pk_fp8_f32(v0[2], v0[3], w0, true); w1 = __builtin_amdgcn_cvt_pk_fp8_f32(v1[0], v1[1], w1, false); w1 = __builtin_amdgcn_cvt_pk_fp8_f32(v1[2], v1[3], w1, true);
                    u32x2 w; w.x = (unsigned)w0; w.y = (unsigned)w1; *(u32x2*)(rowp + bj * HALF) = w; } }
    }
};
__device__ __forceinline__ void pair_of(int pi, int& i, int& j) { i = pi < 3 ? 0 : (pi < 5 ? 1 : 2); j = pi < 3 ? pi + 1 : (pi < 5 ? pi - 1 : 3); }
struct MoeOrder {
    const PG8_LAS int* tinfo; int G, c, mode; const int* list;
    __device__ __forceinline__ int tok(const Unit& u, int r) const { const int bk = tinfo[1 + u.pm], pos = u.pm * BM - tinfo[256 + bk] + r; return list[bk * 32768 + (pos < tinfo[288 + bk] ? pos : 0)]; }
    __device__ __forceinline__ bool next(int i, Unit& u) const {
        const long L = (long)i * G + c; const int nt = tinfo[0]; if (L >= 4L * nt) return false;
        const int mt = (int)(L >> 2), q = (int)(L & 3), bk = tinfo[1 + mt];
        u.pm = mt;
        if (mode == 0) { int ii, jj; pair_of(bk % 6, ii, jj); const int e = (bk / 6) * 4 + ((q >> 1) ? jj : ii); u.pn = e * 2 + (q & 1); }
        else u.pn = bk * 4 + q;
        return true;
    }
    __device__ __forceinline__ void a_ready(const Unit&) const {}
    __device__ __forceinline__ void done(const Unit&) const {}
};
struct EpiSwiGLU {
    static constexpr bool PERM = true, AFTER_DRAIN = false;
    bf16_t* H; const float* wl; const PG8_LAS int* tinfo;
    __device__ __forceinline__ void operator()(const f32x4 (&acc)[2][2][4][2], const Unit& u, int wr, int wc, int, int) const {
        int ln = (int)__builtin_amdgcn_mbcnt_hi(~0u, __builtin_amdgcn_mbcnt_lo(~0u, 0u)); asm volatile("" : "+v"(ln)); const int fr = ln & 15, fq = ln >> 4;
        const int bk = tinfo[1 + u.pm]; int ii, jj; pair_of(bk % 6, ii, jj);
        const int e = u.pn >> 1, hh = u.pn & 1, slot = (e == (bk / 6) * 4 + jj) ? 1 : 0;
        const int row0 = u.pm * BM + wr * 64 + fr, col0 = slot * 256 + hh * 128 + wc * 32 + 8 * fq;
#pragma unroll
        for (int ai = 0; ai < 2; ++ai)
#pragma unroll
            for (int m = 0; m < 4; ++m) { const int row = row0 + ai * HALF + m * 16, pos = row - tinfo[256 + bk]; const float w = pos < tinfo[288 + bk] ? wl[((size_t)bk * 32768 + pos) * 2 + slot] : 0.f;
                float a[8];
#pragma unroll
                for (int n = 0; n < 2; ++n)
#pragma unroll
                    for (int j = 0; j < 4; ++j) { const float g = acc[ai][0][m][n][j], up = acc[ai][1][m][n][j];
                        const float sg = g * __builtin_amdgcn_rcpf(1.0f + __builtin_amdgcn_exp2f(-1.4426950408889634f * g)); a[n * 4 + j] = sg * up * w; }
                u32x4 o; o.x = cvt_pk_bf16(a[0], a[1]); o.y = cvt_pk_bf16(a[2], a[3]); o.z = cvt_pk_bf16(a[4], a[5]); o.w = cvt_pk_bf16(a[6], a[7]);
                *(u32x4*)(H + (size_t)row * 512 + col0) = o; asm volatile("" ::: "memory"); }
    }
};
template <class TO> struct EpiMoeOut {
    static constexpr bool PERM = false, AFTER_DRAIN = false;
    const bf16_t* xr; TO* out; const float* gate; const int* list; const PG8_LAS int* tinfo;
    __device__ __forceinline__ void operator()(const f32x4 (&acc)[2][2][4][2], const Unit& u, int wr, int wc, int fr, int fq) const {
        const int bk = tinfo[1 + u.pm], r_end = tinfo[256 + bk] + tinfo[288 + bk];
        const int row0 = u.pm * BM + wr * 64 + fr, col0 = (u.pn & 3) * BM + wc * 32 + 4 * fq;
#pragma unroll
        for (int ai = 0; ai < 2; ++ai)
#pragma unroll
            for (int m = 0; m < 4; ++m) { const int row = row0 + ai * HALF + m * 16;
                if (row < r_end) { const int tok = list[bk * 32768 + row - tinfo[256 + bk]]; TO* op = out + (size_t)tok * 1024 + col0; const bf16_t* xp = xr + (size_t)tok * 1024 + col0; const float* gp = gate + (size_t)(tok >> 12) * 6144 + col0;
#pragma unroll
                    for (int bj = 0; bj < 2; ++bj)
#pragma unroll
                        for (int n = 0; n < 2; ++n) { const f32x4 bs = ld4(xp + bj * HALF + n * 16), gv = *(const f32x4*)(gp + bj * HALF + n * 16); st4(op + bj * HALF + n * 16, bs + gv * acc[ai][bj][m][n]); } }
                asm volatile("" ::: "memory"); }
    }
};
template <class Epi, class Sched, bool ALIGN_EPI = false, bool SP2 = false, int F8 = -1>
__device__ __forceinline__ void gemm_phase(PG8_LAS unsigned char* lds, const Gemm g, const Sched& S, const Epi& E, const int tid_in) {
    int tid = tid_in; asm volatile("" : "+v"(tid));
    const int wid = __builtin_amdgcn_readfirstlane(tid >> 6), lane = tid & 63, wr = wid >> 2, wc = wid & 3, fr = lane & 15, fq = lane >> 4;
    int K = g.K; asm volatile("" : "+s"(K)); const int nt = K / BK;
    unsigned voffA[2], voffB[2];
#pragma unroll
    for (int i = 0; i < 2; ++i) { int R, C; stage_rc(tid * 16 + i * 8192, R, C); const int Rb = Epi::PERM ? ((R & ~31) + perm32(R & 31)) : R;
        voffA[i] = (unsigned)(R * K + C) * 2u; voffB[i] = (unsigned)(Rb * K + C) * 2u; }
    const size_t kstep = (size_t)(BK * 2);
    const size_t hstep = (size_t)HALF * K * 2;
    const size_t tstep = 2 * hstep;
    const unsigned ldsw = (unsigned)wid * 1024u;
    const int aoff = lds_byte(wr * 64 + fr, fq * 8), boff = lds_byte(wc * 32 + fr, fq * 8);
#define PG8_SA(b, h) (((b) * 2 + (h)) * HTB)
#define PG8_SB(b, h) ((4 + (b) * 2 + (h)) * HTB)
#define PG8_STAGE(bufoff, gbase, voff) do { _Pragma("unroll") for (int _i = 0; _i < 2; ++_i) { unsigned vo_ = (voff)[_i]; asm volatile("" : "+v"(vo_));   \
        __builtin_amdgcn_global_load_lds((const unsigned*)((const char*)(gbase) + vo_), (PG8_LAS unsigned*)(lds + (bufoff) + ldsw + _i * 8192), 16, 0, 0); } } while (0)
#define PG8_LDA(dst, b, h) do { _Pragma("unroll") for (int m = 0; m < 4; ++m) { const bf16x8 x0_ = *(const PG8_LAS bf16x8*)(lds + PG8_SA(b, h) + aoff + m * 2048), x1_ = *(const PG8_LAS bf16x8*)(lds + PG8_SA(b, h) + aoff + m * 2048 + 1024); \
        if constexpr (F8 >= 0) dst##8[m] = PG8_CAT(x0_, x1_); else { dst[m][0] = x0_; dst[m][1] = x1_; } } } while (0)
#define PG8_LDB(dst, b, h) do { _Pragma("unroll") for (int n = 0; n < 2; ++n) { const bf16x8 x0_ = *(const PG8_LAS bf16x8*)(lds + PG8_SB(b, h) + boff + n * 2048), x1_ = *(const PG8_LAS bf16x8*)(lds + PG8_SB(b, h) + boff + n * 2048 + 1024); \
        if constexpr (F8 >= 0) dst##8[n] = PG8_CAT(x0_, x1_); else { dst[n][0] = x0_; dst[n][1] = x1_; } } } while (0)
#define PG8_CAT(x0, x1) ({ const v4i_t lo_ = __builtin_bit_cast(v4i_t, x0), hi_ = __builtin_bit_cast(v4i_t, x1); (v8i_t){lo_[0], lo_[1], lo_[2], lo_[3], hi_[0], hi_[1], hi_[2], hi_[3]}; })
#define PG8_MMA(ai, bj, At, Bt) do { __builtin_amdgcn_s_setprio(1); _Pragma("unroll") for (int m = 0; m < 4; ++m) _Pragma("unroll") for (int n = 0; n < 2; ++n) { \
        if constexpr (F8 >= 0) acc[ai][bj][m][n] = __builtin_amdgcn_mfma_scale_f32_16x16x128_f8f6f4(Bt##8[n], At##8[m], acc[ai][bj][m][n], 0, 0, 0, 0x7f7f7f7f, 0, (127 - F8) * 0x01010101); \
        else { _Pragma("unroll") for (int k = 0; k < 2; ++k) acc[ai][bj][m][n] = __builtin_amdgcn_mfma_f32_16x16x32_bf16(Bt[n][k], At[m][k], acc[ai][bj][m][n], 0, 0, 0); } } \
        __builtin_amdgcn_s_setprio(0); } while (0)
#define PG8_WAIT_V(n) asm volatile("s_waitcnt vmcnt(" #n ")" ::: "memory")
#define PG8_WAIT_L(n) asm volatile("s_waitcnt lgkmcnt(" #n ")" ::: "memory")
#define PG8_BAR __builtin_amdgcn_s_barrier()
#define PG8_SCHED __builtin_amdgcn_sched_barrier(0)
    Unit cur, nxt; int ui = 0;
    if (!S.next(0, cur)) return;
    f32x4 acc[2][2][4][2];
#pragma unroll
    for (int a = 0; a < 2; ++a)
#pragma unroll
        for (int b = 0; b < 2; ++b)
#pragma unroll
            for (int m = 0; m < 4; ++m)
#pragma unroll
                for (int n = 0; n < 2; ++n) acc[a][b][m][n] = (f32x4){0.f, 0.f, 0.f, 0.f};
    bf16x8 At[4][2], B0[2][2], B1[2][2]; v8i_t At8[4], B08[2], B18[2];
    const char* cA = (const char*)g.A + (size_t)cur.pm * tstep; const char* cB = (const char*)g.Bt + (size_t)cur.pn * tstep;
    S.a_ready(cur);
    if constexpr (SP2) {
        PG8_STAGE(PG8_SB(0, 0), cB, voffB); PG8_STAGE(PG8_SB(0, 1), cB + hstep, voffB); PG8_STAGE(PG8_SA(0, 0), cA, voffA); PG8_STAGE(PG8_SA(0, 1), cA + hstep, voffA);
        if (wr == 1) PG8_BAR;
        PG8_WAIT_V(2); PG8_BAR;
        PG8_STAGE(PG8_SB(1, 0), cB + kstep, voffB); PG8_STAGE(PG8_SA(1, 0), cA + kstep, voffA); PG8_STAGE(PG8_SB(1, 1), cB + hstep + kstep, voffB);
        PG8_WAIT_V(6); PG8_BAR;
    } else {
        PG8_STAGE(PG8_SB(0, 0), cB, voffB); PG8_STAGE(PG8_SA(0, 0), cA, voffA); PG8_STAGE(PG8_SB(0, 1), cB + hstep, voffB); PG8_STAGE(PG8_SA(0, 1), cA + hstep, voffA);
        if (wr == 1) PG8_BAR;
        PG8_WAIT_V(4); PG8_BAR;
        PG8_STAGE(PG8_SB(1, 0), cB + kstep, voffB); PG8_STAGE(PG8_SA(1, 0), cA + kstep, voffA); PG8_STAGE(PG8_SB(1, 1), cB + hstep + kstep, voffB);
        PG8_WAIT_V(6); PG8_BAR;
    }
    for (;;) {
        const bool has_next = S.next(ui + 1, nxt);
        const char* nA = has_next ? (const char*)g.A + (size_t)nxt.pm * tstep : cA; const char* nB = has_next ? (const char*)g.Bt + (size_t)nxt.pn * tstep : cB;
        for (int t = 0; t < nt; t += 2) {
            const bool last = (t == nt - 2);
            const char* a1 = cA + (size_t)(t + 1) * kstep;
            const char* a2 = last ? nA : cA + (size_t)(t + 2) * kstep; const char* b2 = last ? nB : cB + (size_t)(t + 2) * kstep;
            const char* a3 = a2 + kstep; const char* b3 = b2 + kstep;
            if (last && has_next) S.a_ready(nxt);
            if constexpr (SP2) {
            PG8_LDB(B0, 0, 0); PG8_LDB(B1, 0, 1); PG8_SCHED; PG8_LDA(At, 0, 0); PG8_STAGE(PG8_SA(1, 1), a1 + hstep, voffA);
            PG8_WAIT_V(8); PG8_WAIT_L(0); PG8_BAR; PG8_MMA(0, 0, At, B0); PG8_MMA(0, 1, At, B1); PG8_BAR; PG8_SCHED;
            PG8_LDA(At, 0, 1); PG8_STAGE(PG8_SB(0, 0), b2, voffB); PG8_STAGE(PG8_SB(0, 1), b2 + hstep, voffB); PG8_STAGE(PG8_SA(0, 0), a2, voffA);
            PG8_WAIT_V(8); PG8_WAIT_L(0); PG8_BAR; PG8_MMA(1, 0, At, B0); PG8_MMA(1, 1, At, B1); PG8_BAR; PG8_SCHED;
            PG8_LDB(B0, 1, 0); PG8_LDB(B1, 1, 1); PG8_SCHED; PG8_LDA(At, 1, 0); PG8_STAGE(PG8_SA(0, 1), a2 + hstep, voffA);
            PG8_WAIT_V(8); PG8_WAIT_L(0); PG8_BAR; PG8_MMA(0, 0, At, B0); PG8_MMA(0, 1, At, B1); PG8_BAR; PG8_SCHED;
            PG8_LDA(At, 1, 1); PG8_STAGE(PG8_SB(1, 0), b3, voffB); PG8_STAGE(PG8_SB(1, 1), b3 + hstep, voffB); PG8_STAGE(PG8_SA(1, 0), a3, voffA);
            PG8_WAIT_V(8); PG8_WAIT_L(0); PG8_BAR; PG8_MMA(1, 0, At, B0); PG8_MMA(1, 1, At, B1); PG8_BAR; PG8_SCHED;
            } else {
            PG8_LDB(B0, 0, 0); PG8_SCHED; PG8_LDA(At, 0, 0); PG8_STAGE(PG8_SA(1, 1), a1 + hstep, voffA);
            PG8_WAIT_L(8); PG8_BAR; PG8_WAIT_L(0); PG8_MMA(0, 0, At, B0); PG8_BAR; PG8_SCHED;
            PG8_LDB(B1, 0, 1); PG8_STAGE(PG8_SB(0, 0), b2, voffB);
            PG8_BAR; PG8_WAIT_L(0); PG8_MMA(0, 1, At, B1); PG8_BAR;
            PG8_LDA(At, 0, 1); PG8_STAGE(PG8_SA(0, 0), a2, voffA);
            PG8_BAR; PG8_WAIT_L(0); PG8_MMA(1, 0, At, B0); PG8_BAR; PG8_SCHED;
            PG8_STAGE(PG8_SB(0, 1), b2 + hstep, voffB);
            PG8_WAIT_V(6); PG8_BAR; PG8_MMA(1, 1, At, B1); PG8_BAR;
            PG8_LDB(B0, 1, 0); PG8_SCHED; PG8_LDA(At, 1, 0); PG8_STAGE(PG8_SA(0, 1), a2 + hstep, voffA);
            PG8_WAIT_L(8); PG8_BAR; PG8_WAIT_L(0); PG8_MMA(0, 0, At, B0); PG8_BAR; PG8_SCHED;
            PG8_LDB(B1, 1, 1); PG8_STAGE(PG8_SB(1, 0), b3, voffB);
            PG8_BAR; PG8_WAIT_L(0); PG8_MMA(0, 1, At, B1); PG8_BAR;
            PG8_LDA(At, 1, 1); PG8_STAGE(PG8_SA(1, 0), a3, voffA);
            PG8_BAR; PG8_WAIT_L(0); PG8_MMA(1, 0, At, B0); PG8_BAR; PG8_SCHED;
            PG8_STAGE(PG8_SB(1, 1), b3 + hstep, voffB);
            PG8_WAIT_V(6); PG8_BAR; PG8_MMA(1, 1, At, B1); PG8_BAR;
            }
        }
        if constexpr (ALIGN_EPI) { if (wr == 0) PG8_BAR; }
        if constexpr (!Epi::AFTER_DRAIN) { E(acc, cur, wr, wc, fr, fq); S.done(cur); }
        if (!has_next) break;
#pragma unroll
        for (int a = 0; a < 2; ++a)
#pragma unroll
            for (int b = 0; b < 2; ++b)
#pragma unroll
                for (int m = 0; m < 4; ++m)
#pragma unroll
                    for (int n = 0; n < 2; ++n) acc[a][b][m][n] = (f32x4){0.f, 0.f, 0.f, 0.f};
        cur = nxt; cA = nA; cB = nB; ++ui;
        if constexpr (ALIGN_EPI) { if (wr == 1) PG8_BAR; }
    }
    PG8_WAIT_V(0);
    if constexpr (!ALIGN_EPI) { if (wr == 0) PG8_BAR; }
    PG8_BAR;
    if constexpr (Epi::AFTER_DRAIN) { E.fused(acc, cur, wr, wc, fr, fq, lds, wid, lane); S.done(cur); }
#undef PG8_SA
#undef PG8_SB
#undef PG8_STAGE
#undef PG8_LDA
#undef PG8_LDB
#undef PG8_MMA
#undef PG8_WAIT_V
#undef PG8_WAIT_L
#undef PG8_BAR
#undef PG8_SCHED
}
template <class Epi, class Sched, bool ALIGN_EPI = true, bool SP2 = true, int F8 = -1>
__device__ __forceinline__ void gemm_phase_gather(PG8_LAS unsigned char* lds, const Gemm g, const Sched& S, const Epi& E, const int tid_in) {
    int tid = tid_in; asm volatile("" : "+v"(tid));
    static_assert(SP2, "gather form: SP2 loop only");
    const int wid = __builtin_amdgcn_readfirstlane(tid >> 6), lane = tid & 63, wr = wid >> 2, wc = wid & 3, fr = lane & 15, fq = lane >> 4;
    int K = g.K; asm volatile("" : "+s"(K)); const int nt = K / BK;
    unsigned voffA[2], voffB[2];
#pragma unroll
    for (int i = 0; i < 2; ++i) { int R, C; stage_rc(tid * 16 + i * 8192, R, C); const int Rb = Epi::PERM ? ((R & ~31) + perm32(R & 31)) : R;
        voffA[i] = (unsigned)(R * K + C) * 2u; voffB[i] = (unsigned)(Rb * K + C) * 2u; }
    int gR, gC; stage_rc(tid * 16, gR, gC);
    unsigned vG[2][2], vN[2][2];
    const size_t kstep = (size_t)(BK * 2);
    const size_t hstep = (size_t)HALF * K * 2;
    const size_t tstep = 2 * hstep;
    const unsigned ldsw = (unsigned)wid * 1024u;
    const int aoff = lds_byte(wr * 64 + fr, fq * 8), boff = lds_byte(wc * 32 + fr, fq * 8);
#define PG8_SA(b, h) (((b) * 2 + (h)) * HTB)
#define PG8_SB(b, h) ((4 + (b) * 2 + (h)) * HTB)
#define PG8_STAGE(bufoff, gbase, voff) do { _Pragma("unroll") for (int _i = 0; _i < 2; ++_i) { unsigned vo_ = (voff)[_i]; asm volatile("" : "+v"(vo_));   \
        __builtin_amdgcn_global_load_lds((const unsigned*)((const char*)(gbase) + vo_), (PG8_LAS unsigned*)(lds + (bufoff) + ldsw + _i * 8192), 16, 0, 0); } } while (0)
#define PG8_LDA(dst, b, h) do { _Pragma("unroll") for (int m = 0; m < 4; ++m) { const bf16x8 x0_ = *(const PG8_LAS bf16x8*)(lds + PG8_SA(b, h) + aoff + m * 2048), x1_ = *(const PG8_LAS bf16x8*)(lds + PG8_SA(b, h) + aoff + m * 2048 + 1024); \
        if constexpr (F8 >= 0) dst##8[m] = PG8_CAT(x0_, x1_); else { dst[m][0] = x0_; dst[m][1] = x1_; } } } while (0)
#define PG8_LDB(dst, b, h) do { _Pragma("unroll") for (int n = 0; n < 2; ++n) { const bf16x8 x0_ = *(const PG8_LAS bf16x8*)(lds + PG8_SB(b, h) + boff + n * 2048), x1_ = *(const PG8_LAS bf16x8*)(lds + PG8_SB(b, h) + boff + n * 2048 + 1024); \
        if constexpr (F8 >= 0) dst##8[n] = PG8_CAT(x0_, x1_); else { dst[n][0] = x0_; dst[n][1] = x1_; } } } while (0)
#define PG8_CAT(x0, x1) ({ const v4i_t lo_ = __builtin_bit_cast(v4i_t, x0), hi_ = __builtin_bit_cast(v4i_t, x1); (v8i_t){lo_[0], lo_[1], lo_[2], lo_[3], hi_[0], hi_[1], hi_[2], hi_[3]}; })
#define PG8_MMA(ai, bj, At, Bt) do { __builtin_amdgcn_s_setprio(1); _Pragma("unroll") for (int m = 0; m < 4; ++m) _Pragma("unroll") for (int n = 0; n < 2; ++n) { \
        if constexpr (F8 >= 0) acc[ai][bj][m][n] = __builtin_amdgcn_mfma_scale_f32_16x16x128_f8f6f4(Bt##8[n], At##8[m], acc[ai][bj][m][n], 0, 0, 0, 0x7f7f7f7f, 0, (127 - F8) * 0x01010101); \
        else { _Pragma("unroll") for (int k = 0; k < 2; ++k) acc[ai][bj][m][n] = __builtin_amdgcn_mfma_f32_16x16x32_bf16(Bt[n][k], At[m][k], acc[ai][bj][m][n], 0, 0, 0); } } \
        __builtin_amdgcn_s_setprio(0); } while (0)
#define PG8_WAIT_V(n) asm volatile("s_waitcnt vmcnt(" #n ")" ::: "memory")
#define PG8_WAIT_L(n) asm volatile("s_waitcnt lgkmcnt(" #n ")" ::: "memory")
#define PG8_BAR __builtin_amdgcn_s_barrier()
#define PG8_SCHED __builtin_amdgcn_sched_barrier(0)
    Unit cur, nxt; int ui = 0;
    if (!S.next(0, cur)) return;
    f32x4 acc[2][2][4][2];
#pragma unroll
    for (int a = 0; a < 2; ++a)
#pragma unroll
        for (int b = 0; b < 2; ++b)
#pragma unroll
            for (int m = 0; m < 4; ++m)
#pragma unroll
                for (int n = 0; n < 2; ++n) acc[a][b][m][n] = (f32x4){0.f, 0.f, 0.f, 0.f};
    bf16x8 At[4][2], B0[2][2], B1[2][2]; v8i_t At8[4], B08[2], B18[2];
    const char* cA = (const char*)g.A; const char* cB = (const char*)g.Bt + (size_t)cur.pn * tstep;
    S.a_ready(cur);
#pragma unroll
    for (int h = 0; h < 2; ++h)
#pragma unroll
        for (int i = 0; i < 2; ++i) vG[h][i] = (unsigned)S.tok(cur, h * HALF + gR + 64 * i) * (unsigned)(K * 2) + (unsigned)(gC * 2);
    if constexpr (SP2) {
        PG8_STAGE(PG8_SB(0, 0), cB, voffB); PG8_STAGE(PG8_SB(0, 1), cB + hstep, voffB); PG8_STAGE(PG8_SA(0, 0), cA, vG[0]); PG8_STAGE(PG8_SA(0, 1), cA, vG[1]);
        if (wr == 1) PG8_BAR;
        PG8_WAIT_V(2); PG8_BAR;
        PG8_STAGE(PG8_SB(1, 0), cB + kstep, voffB); PG8_STAGE(PG8_SA(1, 0), cA + kstep, vG[0]); PG8_STAGE(PG8_SB(1, 1), cB + hstep + kstep, voffB);
        PG8_WAIT_V(6); PG8_BAR;
    } else {
        PG8_STAGE(PG8_SB(0, 0), cB, voffB); PG8_STAGE(PG8_SA(0, 0), cA, voffA); PG8_STAGE(PG8_SB(0, 1), cB + hstep, voffB); PG8_STAGE(PG8_SA(0, 1), cA + hstep, voffA);
        if (wr == 1) PG8_BAR;
        PG8_WAIT_V(4); PG8_BAR;
        PG8_STAGE(PG8_SB(1, 0), cB + kstep, voffB); PG8_STAGE(PG8_SA(1, 0), cA + kstep, voffA); PG8_STAGE(PG8_SB(1, 1), cB + hstep + kstep, voffB);
        PG8_WAIT_V(6); PG8_BAR;
    }
    for (;;) {
        const bool has_next = S.next(ui + 1, nxt);
        const char* nA = cA; const char* nB = has_next ? (const char*)g.Bt + (size_t)nxt.pn * tstep : cB;
        for (int t = 0; t < nt; t += 2) {
            const bool last = (t == nt - 2);
            const char* a1 = cA + (size_t)(t + 1) * kstep;
            const char* a2 = last ? nA : cA + (size_t)(t + 2) * kstep; const char* b2 = last ? nB : cB + (size_t)(t + 2) * kstep;
            const char* a3 = a2 + kstep; const char* b3 = b2 + kstep;
            if (last && has_next) { S.a_ready(nxt);
#pragma unroll
                for (int h = 0; h < 2; ++h)
#pragma unroll
                    for (int i = 0; i < 2; ++i) vN[h][i] = (unsigned)S.tok(nxt, h * HALF + gR + 64 * i) * (unsigned)(K * 2) + (unsigned)(gC * 2); }
            if constexpr (SP2) {
            PG8_LDB(B0, 0, 0); PG8_LDB(B1, 0, 1); PG8_SCHED; PG8_LDA(At, 0, 0); PG8_STAGE(PG8_SA(1, 1), a1, vG[1]);
            if (last && has_next) { vG[0][0] = vN[0][0]; vG[0][1] = vN[0][1]; vG[1][0] = vN[1][0]; vG[1][1] = vN[1][1]; }
            PG8_WAIT_V(8); PG8_WAIT_L(0); PG8_BAR; PG8_MMA(0, 0, At, B0); PG8_MMA(0, 1, At, B1); PG8_BAR; PG8_SCHED;
            PG8_LDA(At, 0, 1); PG8_STAGE(PG8_SB(0, 0), b2, voffB); PG8_STAGE(PG8_SB(0, 1), b2 + hstep, voffB); PG8_STAGE(PG8_SA(0, 0), a2, vG[0]);
            PG8_WAIT_V(8); PG8_WAIT_L(0); PG8_BAR; PG8_MMA(1, 0, At, B0); PG8_MMA(1, 1, At, B1); PG8_BAR; PG8_SCHED;
            PG8_LDB(B0, 1, 0); PG8_LDB(B1, 1, 1); PG8_SCHED; PG8_LDA(At, 1, 0); PG8_STAGE(PG8_SA(0, 1), a2, vG[1]);
            PG8_WAIT_V(8); PG8_WAIT_L(0); PG8_BAR; PG8_MMA(0, 0, At, B0); PG8_MMA(0, 1, At, B1); PG8_BAR; PG8_SCHED;
            PG8_LDA(At, 1, 1); PG8_STAGE(PG8_SB(1, 0), b3, voffB); PG8_STAGE(PG8_SB(1, 1), b3 + hstep, voffB); PG8_STAGE(PG8_SA(1, 0), a3, vG[0]);
            PG8_WAIT_V(8); PG8_WAIT_L(0); PG8_BAR; PG8_MMA(1, 0, At, B0); PG8_MMA(1, 1, At, B1); PG8_BAR; PG8_SCHED;
            } else {
            PG8_LDB(B0, 0, 0); PG8_SCHED; PG8_LDA(At, 0, 0); PG8_STAGE(PG8_SA(1, 1), a1 + hstep, voffA);
            PG8_WAIT_L(8); PG8_BAR; PG8_WAIT_L(0); PG8_MMA(0, 0, At, B0); PG8_BAR; PG8_SCHED;
            PG8_LDB(B1, 0, 1); PG8_STAGE(PG8_SB(0, 0), b2, voffB);
            PG8_BAR; PG8_WAIT_L(0); PG8_MMA(0, 1, At, B1); PG8_BAR;
            PG8_LDA(At, 0, 1); PG8_STAGE(PG8_SA(0, 0), a2, voffA);
            PG8_BAR; PG8_WAIT_L(0); PG8_MMA(1, 0, At, B0); PG8_BAR; PG8_SCHED;
            PG8_STAGE(PG8_SB(0, 1), b2 + hstep, voffB);
            PG8_WAIT_V(6); PG8_BAR; PG8_MMA(1, 1, At, B1); PG8_BAR;
            PG8_LDB(B0, 1, 0); PG8_SCHED; PG8_LDA(At, 1, 0); PG8_STAGE(PG8_SA(0, 1), a2 + hstep, voffA);
            PG8_WAIT_L(8); PG8_BAR; PG8_WAIT_L(0); PG8_MMA(0, 0, At, B0); PG8_BAR; PG8_SCHED;
            PG8_LDB(B1, 1, 1); PG8_STAGE(PG8_SB(1, 0), b3, voffB);
            PG8_BAR; PG8_WAIT_L(0); PG8_MMA(0, 1, At, B1); PG8_BAR;
            PG8_LDA(At, 1, 1); PG8_STAGE(PG8_SA(1, 0), a3, voffA);
            PG8_BAR; PG8_WAIT_L(0); PG8_MMA(1, 0, At, B0); PG8_BAR; PG8_SCHED;
            PG8_STAGE(PG8_SB(1, 1), b3 + hstep, voffB);
            PG8_WAIT_V(6); PG8_BAR; PG8_MMA(1, 1, At, B1); PG8_BAR;
            }
        }
        if constexpr (ALIGN_EPI) { if (wr == 0) PG8_BAR; }
        if constexpr (!Epi::AFTER_DRAIN) { E(acc, cur, wr, wc, fr, fq); S.done(cur); }
        if (!has_next) break;
#pragma unroll
        for (int a = 0; a < 2; ++a)
#pragma unroll
            for (int b = 0; b < 2; ++b)
#pragma unroll
                for (int m = 0; m < 4; ++m)
#pragma unroll
                    for (int n = 0; n < 2; ++n) acc[a][b][m][n] = (f32x4){0.f, 0.f, 0.f, 0.f};
        cur = nxt; cA = nA; cB = nB; ++ui;
        if constexpr (ALIGN_EPI) { if (wr == 1) PG8_BAR; }
    }
    PG8_WAIT_V(0);
    if constexpr (!ALIGN_EPI) { if (wr == 0) PG8_BAR; }
    PG8_BAR;
    if constexpr (Epi::AFTER_DRAIN) { E.fused(acc, cur, wr, wc, fr, fq, lds, wid, lane); S.done(cur); }
#undef PG8_SA
#undef PG8_SB
#undef PG8_STAGE
#undef PG8_LDA
#undef PG8_LDB
#undef PG8_MMA
#undef PG8_WAIT_V
#undef PG8_WAIT_L
#undef PG8_BAR
#undef PG8_SCHED
}
}
namespace att {
typedef unsigned short bf16;
using bf16x8 = __attribute__((ext_vector_type(8))) short;
using s16x4  = __attribute__((ext_vector_type(4))) short;
using f32x16 = __attribute__((ext_vector_type(16))) float;
using u32x4  = __attribute__((ext_vector_type(4))) unsigned;
using f32x4_t = __attribute__((ext_vector_type(4))) float;
constexpr int NW = 8, QBLK = 32, KVBLK = 64, SEQ = 4096;
constexpr int LDQ = 1536, LDKV = 2048, LDO = 1024;
constexpr int SHM_VT = 128 * 80, SHM_K8 = 64 * 208;
constexpr int OFF_V = 0, OFF_K8 = 3 * SHM_VT, OFF_WS = OFF_K8 + 2 * SHM_K8, LDS_BYTES = OFF_WS + NW * 64 * 4 + 64;
typedef int v8i32 __attribute__((ext_vector_type(8)));
typedef int v4i32 __attribute__((ext_vector_type(4)));
typedef int v2i32 __attribute__((ext_vector_type(2)));
constexpr int T_TOK = 8 * SEQ;
#define ASBAR() __builtin_amdgcn_sched_barrier(0)
__device__ __forceinline__ int crow(int r, int hi) { return (r & 3) + 8 * (r >> 2) + 4 * hi; }
__device__ __forceinline__ unsigned cvtpk(float lo, float hi) { unsigned r; asm volatile("v_cvt_pk_bf16_f32 %0, %1, %2" : "=v"(r) : "v"(lo), "v"(hi)); return r; }
__device__ __forceinline__ float bf2f(unsigned short b) { return __uint_as_float(((unsigned)b) << 16); }
template <bool SHIFT> __device__ __forceinline__ void smA(f32x16& p0, float negm) { for (int r = 0; r < 16; ++r) p0[r] = __builtin_amdgcn_exp2f(SHIFT ? p0[r] + negm : p0[r]); }
template <bool SHIFT> __device__ __forceinline__ void smB(f32x16& p0, f32x16& p1, float& l_reg, v8i32& p8, float negm) {
  for (int r = 0; r < 16; ++r) p1[r] = __builtin_amdgcn_exp2f(SHIFT ? p1[r] + negm : p1[r]);
  float ps = 0; for (int r = 0; r < 16; ++r) ps += p0[r]; for (int r = 0; r < 16; ++r) ps += p1[r];
  l_reg += ps;
#pragma unroll
  for (int w = 0; w < 4; ++w) { int a = 0, bq = 0;
    a = __builtin_amdgcn_cvt_pk_bf8_f32(p0[4 * w], p0[4 * w + 1], a, false); a = __builtin_amdgcn_cvt_pk_bf8_f32(p0[4 * w + 2], p0[4 * w + 3], a, true);
    bq = __builtin_amdgcn_cvt_pk_bf8_f32(p1[4 * w], p1[4 * w + 1], bq, false); bq = __builtin_amdgcn_cvt_pk_bf8_f32(p1[4 * w + 2], p1[4 * w + 3], bq, true);
    p8[w] = a; p8[4 + w] = bq; }
}
template <bool SHIFT> __device__ __forceinline__ void qkt(f32x16& p0, f32x16& p1, const char* K8, const v8i32* q8, float negm, int r32, int hi) {
  p0 = f32x16{}; p1 = f32x16{};
#define K8RD(m, half, part) (*reinterpret_cast<const v4i32*>(K8 + ((half) * 32 + r32) * 208 + (m) * 64 + hi * 32 + (part) * 16))
#define K8FR(m, half) ({ const v4i32 lo_ = K8RD(m, half, 0), hi_ = K8RD(m, half, 1); (v8i32){lo_[0], lo_[1], lo_[2], lo_[3], hi_[0], hi_[1], hi_[2], hi_[3]}; })
  v8i32 a0 = K8FR(0, 0), a1 = K8FR(0, 1), b0 = K8FR(1, 0), b1 = K8FR(1, 1);
  ASBAR();
  p0 = __builtin_amdgcn_mfma_scale_f32_32x32x64_f8f6f4(a0, q8[0], p0, 0, 0, 0, 0x7f7f7f7f, 0, 0x7f7f7f7f);
  p1 = __builtin_amdgcn_mfma_scale_f32_32x32x64_f8f6f4(a1, q8[0], p1, 0, 0, 0, 0x7f7f7f7f, 0, 0x7f7f7f7f);
  a0 = K8FR(2, 0); a1 = K8FR(2, 1);
  ASBAR();
  p0 = __builtin_amdgcn_mfma_scale_f32_32x32x64_f8f6f4(b0, q8[1], p0, 0, 0, 0, 0x7f7f7f7f, 0, 0x7f7f7f7f);
  p1 = __builtin_amdgcn_mfma_scale_f32_32x32x64_f8f6f4(b1, q8[1], p1, 0, 0, 0, 0x7f7f7f7f, 0, 0x7f7f7f7f);
  ASBAR();
  p0 = __builtin_amdgcn_mfma_scale_f32_32x32x64_f8f6f4(a0, q8[2], p0, 0, 0, 0, 0x7f7f7f7f, 0, 0x7f7f7f7f);
  p1 = __builtin_amdgcn_mfma_scale_f32_32x32x64_f8f6f4(a1, q8[2], p1, 0, 0, 0, 0x7f7f7f7f, 0, 0x7f7f7f7f);
  ASBAR();
#undef K8RD
#undef K8FR
}
__device__ __forceinline__ void pv_d0(f32x16* o, const char* VT, v8i32 p8, int r32, int hi) {
#define VTFR(d0) ({ const v4i32 lo_ = *reinterpret_cast<const v4i32*>(VT + ((d0) * 32 + r32) * 80 + hi * 32), hi_ = *reinterpret_cast<const v4i32*>(VT + ((d0) * 32 + r32) * 80 + hi * 32 + 16); (v8i32){lo_[0], lo_[1], lo_[2], lo_[3], hi_[0], hi_[1], hi_[2], hi_[3]}; })
#define PVMMA(d0, fr) o[d0] = __builtin_amdgcn_mfma_scale_f32_32x32x64_f8f6f4(p8, fr, o[d0], 1  , 0  , 0, 0x7f7f7f7f, 0, 0x7f7f7f7f)
  v8i32 fa = VTFR(0), fb = VTFR(1);
  ASBAR();
  PVMMA(0, fa); fa = VTFR(2); ASBAR();
  PVMMA(1, fb); fb = VTFR(3); ASBAR();
  PVMMA(2, fa); PVMMA(3, fb); ASBAR();
#undef VTFR
#undef PVMMA
}
template <bool SHIFT> __device__ __forceinline__ bool attn_unit(int b, int h, int s0, const bf16* Qraw, const unsigned char* __restrict__ VT8g, const unsigned char* __restrict__ K8g, const unsigned char* __restrict__ KP8g, bf16* __restrict__ O,
                                          const float* rope, const float* qg, float smaxC, char* lds, int tid) {
  asm volatile("" : "+v"(tid));
  const int wid = __builtin_amdgcn_readfirstlane(tid >> 6), lane = tid & 63, r32 = lane & 31, hi = lane >> 5;
  asm volatile("" : "+s"(qg));
  char* V_lds = lds + OFF_V; char* K8_lds = lds + OFF_K8;
  float* ws = (float*)(lds + OFF_WS) + wid * 64; float* li_l = ws;
  constexpr float C = 0.072168783648703220f * 1.4426950408889634f;
  v8i32 q8[3];
  {
    typedef __attribute__((address_space(1))) const bf16x8 gbf16x8; typedef __attribute__((address_space(1))) const f32x4_t gf32x4;
    const long trow = (long)b * SEQ + s0 + wid * QBLK + r32;
    unsigned qo = (unsigned)((trow * LDQ + h * 192) * 2); const unsigned ro = (unsigned)(trow * 256), go = (unsigned)(hi * 128);
#define Qn_(i) (*(gbf16x8*)((const char*)Qraw + qo + hi * 64 + (i) * 16))
#define Qr_(i) (*(gbf16x8*)((const char*)Qraw + qo + 256 + (i) * 16))
#define rp4_(i) (*(gf32x4*)((const char*)rope + ro + (i) * 16))
#define qgn_(i) (*(gf32x4*)((const char*)qg + go + (i) * 16))
#define qgr_(i) (*(gf32x4*)((const char*)qg + 512 + (i) * 16))
    float ssn = 0.f, ssp = 0.f;
#pragma unroll
    for (int c = 0; c < 8; ++c) { const bf16x8 a = Qn_((c >> 2) * 8 + (c & 3)), r = Qr_(c);
#pragma unroll
      for (int j = 0; j < 8; ++j) { const float f = bf2f((unsigned short)a[j]), g = bf2f((unsigned short)r[j]); ssn += f * f; ssp += g * g; } }
    ssn += __shfl_xor(ssn, 32);
    const float rn = rsqrtf(ssn * (1.f / 128.f) + 1e-6f) * C, rp = rsqrtf(ssp * (1.f / 64.f) + 1e-6f) * C;
    { float rn_ = rn, rp_ = rp; asm volatile("" : "+v"(qo), "+v"(rn_), "+v"(rp_) :: "memory"); }
#pragma unroll
    for (int m = 0; m < 2; ++m)
#pragma unroll
      for (int c = 0; c < 4; ++c) { const bf16x8 raw = Qn_(8 * m + c); const f32x4_t ga = qgn_(16 * m + 2 * c), gb = qgn_(16 * m + 2 * c + 1); float g[8];
#pragma unroll
        for (int j = 0; j < 8; ++j) g[j] = bf2f((unsigned short)raw[j]) * rn * (j < 4 ? ga[j & 3] : gb[j & 3]);
        int w0 = 0, w1 = 0; w0 = __builtin_amdgcn_cvt_pk_fp8_f32(g[0], g[1], w0, false); w0 = __builtin_amdgcn_cvt_pk_fp8_f32(g[2], g[3], w0, true);
        w1 = __builtin_amdgcn_cvt_pk_fp8_f32(g[4], g[5], w1, false); w1 = __builtin_amdgcn_cvt_pk_fp8_f32(g[6], g[7], w1, true);
        asm volatile("" : "+v"(w0), "+v"(w1) :: "memory");        q8[m][2 * c] = w0; q8[m][2 * c + 1] = w1; }
#pragma unroll
    for (int c = 0; c < 4; ++c) {
      const bf16x8 r1 = Qr_(c), r2 = Qr_(4 + c);
      const f32x4_t g1a = qgr_(2 * c), g1b = qgr_(2 * c + 1), g2a = qgr_(8 + 2 * c), g2b = qgr_(8 + 2 * c + 1); float ov[8];
#pragma unroll
      for (int j = 0; j < 8; ++j) { const f32x4_t cs4 = rp4_(4 * c + (j >> 1));
        const float cs = cs4[(j & 1) * 2], sn = cs4[(j & 1) * 2 + 1];
        const float x1 = bf2f((unsigned short)r1[j]) * rp * (j < 4 ? g1a[j & 3] : g1b[j & 3]), x2 = bf2f((unsigned short)r2[j]) * rp * (j < 4 ? g2a[j & 3] : g2b[j & 3]);
        ov[j] = hi == 0 ? (x1 * cs - x2 * sn) : (x1 * sn + x2 * cs); }
      int w0 = 0, w1 = 0; w0 = __builtin_amdgcn_cvt_pk_fp8_f32(ov[0], ov[1], w0, false); w0 = __builtin_amdgcn_cvt_pk_fp8_f32(ov[2], ov[3], w0, true);
      w1 = __builtin_amdgcn_cvt_pk_fp8_f32(ov[4], ov[5], w1, false); w1 = __builtin_amdgcn_cvt_pk_fp8_f32(ov[6], ov[7], w1, true);
      asm volatile("" : "+v"(w0), "+v"(w1) :: "memory"); q8[2][2 * c] = w0; q8[2][2 * c + 1] = w1; }
  #undef Qn_
#undef Qr_
#undef rp4_
#undef qgn_
#undef qgr_
  }
  const float negm = 15.0f - smaxC;
  float l_reg = 0.f; f32x16 o[4] = {};
  const char* Vg = (const char*)(VT8g + (size_t)h * 128 * T_TOK + (size_t)b * SEQ); const char* Kg = (const char*)(K8g + ((long)b * SEQ * 8 + h) * 128); const char* Pg = (const char*)(KP8g + (long)b * SEQ * 64);
  const int vc = tid >> 2, vq = tid & 3, vst = vc * 80 + 16 * (vq >> 1) + 8 * (vq & 1); const unsigned gvt = (unsigned)vc * (unsigned)T_TOK + 16u * (unsigned)vq;
  const int kr = tid >> 3, kc = tid & 7, kst = kr * 208 + kc * 16; const unsigned gk8 = (unsigned)(kr * 1024 + kc * 16);
  const int pr = (tid & 255) >> 2, pc = tid & 3, pst = pr * 208 + 128 + pc * 16; const unsigned gp8 = (unsigned)(pr * 64 + pc * 16);
  v4i32 s_v, s_k, s_p;
#define SLOAD(k0) do { s_v = *reinterpret_cast<const v4i32*>(Vg + (size_t)(k0) + gvt); \
    s_k = *reinterpret_cast<const v4i32*>(Kg + (size_t)(k0) * 1024 + gk8); if (tid < 256) s_p = *reinterpret_cast<const v4i32*>(Pg + (size_t)(k0) * 64 + gp8); } while (0)
#define SWRITE(kbuf, vbuf_) do { { v2i32 a_ = {s_v[0], s_v[2]}, b_ = {s_v[1], s_v[3]}; *(v2i32*)(V_lds + (vbuf_) * SHM_VT + vst) = a_; *(v2i32*)(V_lds + (vbuf_) * SHM_VT + vst + 32) = b_; } \
    *(v4i32*)(K8_lds + (kbuf) * SHM_K8 + kst) = s_k; if (tid < 256) *(v4i32*)(K8_lds + (kbuf) * SHM_K8 + pst) = s_p; } while (0)
  constexpr int NT = SEQ / KVBLK;
  v8i32 p8;
  SLOAD(0); SWRITE(0, 0); __syncthreads(); SLOAD(KVBLK);
  if (wid < 4) {
    for (int j = 0, kb = 0, vbuf = 0, vnx = 1; j < NT; ++j) {
      f32x16 p0, p1;
      qkt<SHIFT>(p0, p1, K8_lds + kb * SHM_K8, q8, negm, r32, hi);
      smA<SHIFT>(p0, negm); smB<SHIFT>(p0, p1, l_reg, p8, negm); ASBAR();
      pv_d0(o, V_lds + vbuf * SHM_VT, p8, r32, hi);
      if (j + 1 < NT) SWRITE(kb ^ 1, vnx);
      __syncthreads();
      if (j + 2 < NT) SLOAD((j + 2) * KVBLK);
      kb ^= 1; vbuf = vnx; vnx = vnx == 2 ? 0 : vnx + 1;
    }
  } else {
    int vprev = 0;
    __builtin_amdgcn_s_setprio(1);
    for (int j = 0, kb = 0, vbuf = 0, vnx = 1; j < NT; ++j) {
      f32x16 p0, p1;
      if (j > 0) pv_d0(o, V_lds + vprev * SHM_VT, p8, r32, hi);
      qkt<SHIFT>(p0, p1, K8_lds + kb * SHM_K8, q8, negm, r32, hi);
      smA<SHIFT>(p0, negm); smB<SHIFT>(p0, p1, l_reg, p8, negm); ASBAR();
      if (j + 1 < NT) SWRITE(kb ^ 1, vnx);
      __syncthreads();
      if (j + 2 < NT) SLOAD((j + 2) * KVBLK);
      kb ^= 1; vprev = vbuf; vbuf = vnx; vnx = vnx == 2 ? 0 : vnx + 1;
    }
    pv_d0(o, V_lds + vprev * SHM_VT, p8, r32, hi);
    __builtin_amdgcn_s_setprio(0);
  }
  int lane_e = lane; asm volatile("" : "+v"(lane_e));
  const int r32e = lane_e & 31, hie = lane_e >> 5;
  l_reg += __shfl_xor(l_reg, 32);
  int* satf = (int*)(lds + OFF_WS + NW * 64 * 4);
  if (!SHIFT) { const bool sat = __any(l_reg >= 57344.f); if (lane_e == 0) satf[wid] = sat ? 1 : 0; }
  if (hie == 0) li_l[r32e] = l_reg; asm volatile("s_waitcnt lgkmcnt(0)" ::: "memory");
  float rli[16];
#pragma unroll
  for (int r = 0; r < 16; ++r) rli[r] = __builtin_amdgcn_rcpf(li_l[crow(r, hie)]);
  char* Ow = (char*)O + ((long)b * SEQ + s0 + wid * QBLK) * LDO + h * 128;
#pragma unroll
  for (int r = 0; r < 16; ++r) { const unsigned ooff = (unsigned)(crow(r, hie) * LDO + r32e);
#pragma unroll
    for (int d0 = 0; d0 < 4; ++d0) { const int pk = __builtin_amdgcn_cvt_pk_fp8_f32(o[d0][r] * rli[r] * 32.f, 0.f, 0, false); *(unsigned char*)(Ow + ooff + d0 * 32) = (unsigned char)(pk & 0xff); } }
  __syncthreads();
  bool redo = false;
  if (!SHIFT) { redo = (satf[0] | satf[1] | satf[2] | satf[3] | satf[4] | satf[5] | satf[6] | satf[7]) != 0; __syncthreads(); }
  return redo;
#undef SLOAD
#undef SWRITE
}
}
#ifndef HD
#define HD __device__ __forceinline__
#endif
struct c32 { float x, y; };
HD c32 cmk(float x, float y) { c32 r; r.x = x; r.y = y; return r; }
HD c32 cadd(c32 a, c32 b) { return cmk(a.x + b.x, a.y + b.y); }
HD c32 csub(c32 a, c32 b) { return cmk(a.x - b.x, a.y - b.y); }
HD c32 cmul(c32 a, c32 b) { return cmk(a.x * b.x - a.y * b.y, a.x * b.y + a.y * b.x); }
HD c32 cmulc(c32 a, c32 b) { return cmk(a.x * b.x + a.y * b.y, a.y * b.x - a.x * b.y); }
constexpr int BR4(int i) { return ((i & 1) << 3) | ((i & 2) << 1) | ((i & 4) >> 1) | ((i & 8) >> 3); }
template <int SGN, int J> HD c32 tw16(c32 a) {
    if constexpr (J == 0) return a;
    else if constexpr (J == 4) return SGN < 0 ? cmk(a.y, -a.x) : cmk(-a.y, a.x);
    else {
        constexpr float CS[8] = {1.f, 0.92387953251128674f, 0.70710678118654752f, 0.38268343236508977f, 0.f, -0.38268343236508977f, -0.70710678118654752f, -0.92387953251128674f};
        constexpr float SN[8] = {0.f, 0.38268343236508977f, 0.70710678118654752f, 0.92387953251128674f, 1.f, 0.92387953251128674f, 0.70710678118654752f, 0.38268343236508977f};
        constexpr float c = CS[J], s = SN[J];
        if constexpr (SGN < 0) return cmk(a.x * c + a.y * s, a.y * c - a.x * s);
        else return cmk(a.x * c - a.y * s, a.y * c + a.x * s);
    }
}
#define FFT_BF(i, j, J) { const c32 u_ = v[i], w_ = v[j]; v[i] = cadd(u_, w_); v[j] = tw16<SGN, J>(csub(u_, w_)); }
template <int SGN> HD void dft16_dif(c32 (&v)[16]) {
    FFT_BF(0, 8, 0) FFT_BF(1, 9, 1) FFT_BF(2, 10, 2) FFT_BF(3, 11, 3) FFT_BF(4, 12, 4) FFT_BF(5, 13, 5) FFT_BF(6, 14, 6) FFT_BF(7, 15, 7)
    FFT_BF(0, 4, 0) FFT_BF(1, 5, 2) FFT_BF(2, 6, 4) FFT_BF(3, 7, 6) FFT_BF(8, 12, 0) FFT_BF(9, 13, 2) FFT_BF(10, 14, 4) FFT_BF(11, 15, 6)
    FFT_BF(0, 2, 0) FFT_BF(1, 3, 4) FFT_BF(4, 6, 0) FFT_BF(5, 7, 4) FFT_BF(8, 10, 0) FFT_BF(9, 11, 4) FFT_BF(12, 14, 0) FFT_BF(13, 15, 4)
    FFT_BF(0, 1, 0) FFT_BF(2, 3, 0) FFT_BF(4, 5, 0) FFT_BF(6, 7, 0) FFT_BF(8, 9, 0) FFT_BF(10, 11, 0) FFT_BF(12, 13, 0) FFT_BF(14, 15, 0)
}
#undef FFT_BF
#define FFT_BT(i, j, J) { const c32 u_ = v[i], w_ = tw16<SGN, J>(v[j]); v[i] = cadd(u_, w_); v[j] = csub(u_, w_); }
template <int SGN> HD void dft16_dit(c32 (&v)[16]) {
    FFT_BT(0, 1, 0) FFT_BT(2, 3, 0) FFT_BT(4, 5, 0) FFT_BT(6, 7, 0) FFT_BT(8, 9, 0) FFT_BT(10, 11, 0) FFT_BT(12, 13, 0) FFT_BT(14, 15, 0)
    FFT_BT(0, 2, 0) FFT_BT(1, 3, 4) FFT_BT(4, 6, 0) FFT_BT(5, 7, 4) FFT_BT(8, 10, 0) FFT_BT(9, 11, 4) FFT_BT(12, 14, 0) FFT_BT(13, 15, 4)
    FFT_BT(0, 4, 0) FFT_BT(1, 5, 2) FFT_BT(2, 6, 4) FFT_BT(3, 7, 6) FFT_BT(8, 12, 0) FFT_BT(9, 13, 2) FFT_BT(10, 14, 4) FFT_BT(11, 15, 6)
    FFT_BT(0, 8, 0) FFT_BT(1, 9, 1) FFT_BT(2, 10, 2) FFT_BT(3, 11, 3) FFT_BT(4, 12, 4) FFT_BT(5, 13, 5) FFT_BT(6, 14, 6) FFT_BT(7, 15, 7)
}
#undef FFT_BT
constexpr int FFT_PS = 272;
constexpr int FFT_EX_ELEMS = 16 * FFT_PS;
template <class EX> HD void fft_fwd_a(c32 (&v)[16], const c32* T1, EX ex, int tid) {
    dft16_dif<-1>(v);
#pragma unroll
    for (int p = 0; p < 16; ++p) { ex[p * FFT_PS + tid] = cmul(v[BR4(p)], T1[256 * p]); if ((p & 3) == 3) __builtin_amdgcn_sched_barrier(0); }
}
template <class EX> HD void fft_fwd_b(c32 (&v)[16], const c32* T2, EX exr, EX ex, int tid) {
    const int p2 = tid >> 4, c = tid & 15;
#pragma unroll
    for (int b = 0; b < 16; ++b) v[b] = exr[p2 * FFT_PS + 16 * b + c];
    dft16_dif<-1>(v);
#pragma unroll
    for (int q = 0; q < 16; ++q) ex[p2 * FFT_PS + q * 16 + ((c + q) & 15)] = cmul(v[BR4(q)], T2[q]);
}
template <class EX> HD void fft_fwd_c(c32 (&v)[16], EX ex, int tid) {
    const int p2 = tid >> 4, q = tid & 15;
#pragma unroll
    for (int c = 0; c < 16; ++c) v[c] = ex[p2 * FFT_PS + q * 16 + ((c + q) & 15)];
    dft16_dif<-1>(v);
}
template <class EX> HD void fft_inv_a(c32 (&v)[16], EX ex, int tid) {
    const int p = tid >> 4, q = tid & 15;
    dft16_dit<+1>(v);
#pragma unroll
    for (int c = 0; c < 16; ++c) ex[p * FFT_PS + q * 16 + ((c + q) & 15)] = v[c];
}
template <class EX> HD void fft_inv_b(c32 (&v)[16], const c32* T2, EX exr, EX ex, int tid) {
    const int p = tid >> 4, c = tid & 15;
#pragma unroll
    for (int q = 0; q < 16; ++q) v[BR4(q)] = cmulc(exr[p * FFT_PS + q * 16 + ((c + q) & 15)], T2[q]);
    dft16_dit<+1>(v);
#pragma unroll
    for (int b = 0; b < 16; ++b) ex[p * FFT_PS + 16 * b + c] = v[b];
}
template <class EX> HD void fft_inv_c(c32 (&v)[16], const c32* T1, EX ex, int tid) {
#pragma unroll
    for (int p = 0; p < 16; ++p) { v[BR4(p)] = cmulc(ex[p * FFT_PS + tid], T1[256 * p]); if ((p & 3) == 3) __builtin_amdgcn_sched_barrier(0); }
    dft16_dit<+1>(v);
}
constexpr int NWAVES = 8, NTHR = 512;
constexpr int BATCH = 8, SEQ = 4096, DM = 1024, T = BATCH * SEQ;
constexpr float EPS = 1e-6f;
constexpr size_t MiB = 1u << 20;
constexpr size_t WS_CTL = 0, CTL_ZERO_BYTES = 64 * 1024;
constexpr size_t WS_MOD = 1 * MiB;
constexpr size_t WS_HDNS = 1 * MiB + 512 * 1024;
constexpr size_t WS_W4S = 3 * MiB + 512 * 1024;
constexpr size_t WS_LIST = 101 * MiB;
constexpr size_t WS_WL = 396 * MiB;
constexpr size_t WS_WD = 8 * MiB;
constexpr size_t WS_WUQ = 9 * MiB;
constexpr size_t WS_WUKV = 10 * MiB;
constexpr size_t WS_WO = 11 * MiB;
constexpr size_t WS_WIN = 13 * MiB;
constexpr size_t WS_WOUT = 19 * MiB;
constexpr size_t WS_WGU = 21 * MiB;
constexpr size_t WS_WDN = 53 * MiB;
constexpr size_t R1 = 104 * MiB;
constexpr size_t R2 = 232 * MiB;
constexpr size_t R3 = 424 * MiB;
constexpr size_t WS_VT8 = R1, WS_XN2 = R1, WS_KF = R1;
constexpr size_t WS_XN = R2, WS_O = R2;
constexpr size_t WS_LAT = R2 + 64 * MiB;
constexpr size_t WS_HACT = R2 + 64 * MiB;
constexpr size_t WS_CQN = R2 + 128 * MiB;
constexpr size_t WS_CKVN = R2 + 144 * MiB;
constexpr size_t WS_KPE = R2 + 160 * MiB;
constexpr size_t WS_K8 = R2 + 64 * MiB;
constexpr size_t WS_ROPE = R2 + 164 * MiB;
constexpr size_t WS_QRAW = 408 * MiB;
constexpr size_t WS_XN2S = 424 * MiB;
constexpr size_t WS_XR = 424 * MiB;
constexpr size_t WS_HT = R2;
constexpr size_t WS_UT = R2;
constexpr size_t WS_Z = R2;
constexpr size_t WS_END = 512 * MiB;
constexpr int MS_ROWS = T + 24 * 256;
constexpr int CW_BAR = 4096;
constexpr int CW_CNT = 8192;
constexpr int RING_OFF = 0, RING_BYTES = 147456;
constexpr int LDSCTL_OFF = RING_BYTES;
constexpr int MISC_OFF = LDSCTL_OFF;
constexpr int TINFO_OFF = LDSCTL_OFF + 256;
constexpr int RED_OFF = LDSCTL_OFF + 256 + 1280;
constexpr int EPIX_OFF = LDSCTL_OFF + 2048;
constexpr int LDS_BYTES = 163840;
static_assert(RED_OFF + 256 <= LDS_BYTES, "LDS map");

#define GAS __attribute__((address_space(1)))
#define LAS __attribute__((address_space(3)))
typedef unsigned short bf16;
typedef unsigned v4u __attribute__((ext_vector_type(4)));
typedef unsigned v2u __attribute__((ext_vector_type(2)));
typedef int v4i __attribute__((ext_vector_type(4)));
typedef float f32x4 __attribute__((ext_vector_type(4)));
typedef GAS unsigned gu32;
#define RLX_AGENT __ATOMIC_RELAXED, __HIP_MEMORY_SCOPE_AGENT
#define LDS_WAIT() asm volatile("s_waitcnt lgkmcnt(0)" ::: "memory")
__device__ __forceinline__ unsigned pk2(float lo, float hi) { return pg8::cvt_pk_bf16(lo, hi); }
__device__ __forceinline__ float bf2f(unsigned short b) { return __uint_as_float(((unsigned)b) << 16); }
__device__ __forceinline__ float wave_sum(float v) {
#pragma unroll
    for (int o = 1; o < 64; o <<= 1) v += __shfl_xor(v, o);
    return v;
}

#define XB_TMO      128
#define XB_XCNT(j)  (256  + 64 * (j))
#define XB_XSUB(j)  (1280 + 64 * (j))
#define XB_XGEN(j)  (2304 + 64 * (j))
#define XB_TOP      3328
#define XB_TOPGEN   3392
#define XCD_BAR_WORDS 3456
#define XB_SPIN_CAP (1u << 18)

__device__ __forceinline__ unsigned xb_ld(unsigned* p)              { return __hip_atomic_load(p, __ATOMIC_RELAXED, __HIP_MEMORY_SCOPE_AGENT); }
__device__ __forceinline__ unsigned xb_add(unsigned* p, unsigned v) { return __hip_atomic_fetch_add(p, v, __ATOMIC_RELAXED, __HIP_MEMORY_SCOPE_AGENT); }
__device__ __forceinline__ unsigned xb_xcc_id() { return (unsigned)__builtin_amdgcn_s_getreg((3 << 11) | 20) & 0xFu; }
#define XB_SPIN(cond, bar) do { unsigned _sp = 0; while (cond) { __builtin_amdgcn_s_sleep(1); \
    if ((++_sp & 255u) == 0u) { if (xb_ld(&(bar)[XB_TMO])) break; if (_sp > XB_SPIN_CAP) { atomicAdd(&(bar)[XB_TMO], 1u); break; } } } } while (0)

struct XcdBarrier {
    unsigned* bar; unsigned x;
    volatile LAS unsigned* st;
    int w0;
};

__device__ __forceinline__ XcdBarrier xcd_barrier_post(unsigned* bar, volatile LAS unsigned* st) {
    XcdBarrier b; b.bar = bar; b.x = xb_xcc_id(); b.st = st; b.w0 = 0;
    if (threadIdx.x == 0) (void)xb_add(&bar[XB_XCNT(b.x)], 1u);
    return b;
}
__device__ __forceinline__ void xcd_barrier_complete(unsigned* bar, unsigned x, unsigned& nloc, unsigned& nx) {
    const unsigned G = gridDim.x * gridDim.y * gridDim.z;
    unsigned sum, cnt, mine, sp = 0u;
    for (;;) {
        sum = 0u; cnt = 0u; mine = 0u;
#pragma unroll
        for (unsigned j = 0; j < 16; ++j) { const unsigned c = xb_ld(&bar[XB_XCNT(j)]); sum += c; cnt += (c > 0u) ? 1u : 0u; mine = (j == x) ? c : mine; }
        if (sum == G) break;
        __builtin_amdgcn_s_sleep(1);
        if ((++sp & 255u) == 0u) { if (xb_ld(&bar[XB_TMO])) break; if (sp > XB_SPIN_CAP) { atomicAdd(&bar[XB_TMO], 1u); break; } }
    }
    nloc = mine > 0u ? mine : 1u; nx = cnt > 0u ? cnt : 1u;
}

__device__ __forceinline__ void xcd_barrier(const XcdBarrier& b) {
    asm volatile("s_waitcnt vmcnt(0)" ::: "memory");
    __syncthreads();
    if (b.w0 && __builtin_amdgcn_mbcnt_hi(~0u, __builtin_amdgcn_mbcnt_lo(~0u, 0u)) == 0u) {
        unsigned* bar = b.bar;
        __builtin_amdgcn_s_waitcnt(0);
        unsigned nloc = b.st[0], nx = b.st[1];
        if (nloc == 0u) { xcd_barrier_complete(bar, b.x, nloc, nx); b.st[0] = nloc; b.st[1] = nx; }
        const unsigned old = xb_add(&bar[XB_XSUB(b.x)], 1u);
        const unsigned gen = old / nloc;
        if (old + 1u == (gen + 1u) * nloc) {
            __builtin_amdgcn_fence(__ATOMIC_RELEASE, "agent");
            asm volatile("s_waitcnt vmcnt(0)" ::: "memory");
            const unsigned og = xb_add(&bar[XB_TOP], 1u);
            const unsigned tg = og / nx;
            if (og + 1u == (tg + 1u) * nx) xb_add(&bar[XB_TOPGEN], 1u);
            else XB_SPIN(xb_ld(&bar[XB_TOPGEN]) == tg, bar);
            __builtin_amdgcn_fence(__ATOMIC_ACQUIRE, "agent");
            xb_add(&bar[XB_XGEN(b.x)], 1u);
            asm volatile("s_waitcnt vmcnt(0)" ::: "memory");
        } else {
            XB_SPIN(xb_ld(&bar[XB_XGEN(b.x)]) == gen, bar);
            __builtin_amdgcn_fence(__ATOMIC_ACQUIRE, "agent");
            asm volatile("s_waitcnt vmcnt(0)" ::: "memory");
        }
    }
    __syncthreads();
}


struct Ctx { unsigned char* lds; int tid, lane, wave, vcu, G, gw, NGW; };

__device__ __forceinline__ void transpose_item(const float* W, int ldw, int k0, int n0, bf16* WT, int ldt, int drow0, int dcol0, float* scr, int lane, bool kpe_perm) {
    float tv[32];
#pragma unroll
    for (int i = 0; i < 32; ++i) { const int kk = 2 * i + (lane >> 5); tv[i] = W[(size_t)(k0 + kk) * ldw + n0 + (lane & 31)]; }
#pragma unroll
    for (int i = 0; i < 32; ++i) { const int kk = 2 * i + (lane >> 5); scr[kk * 33 + (lane & 31)] = tv[i]; }
    LDS_WAIT();
    const int c = lane & 7;
#pragma unroll
    for (int j = 0; j < 4; ++j) { const int n = (lane >> 3) + 8 * j; const float* s = scr + (8 * c) * 33 + n;
        v4u o; o.x = pk2(s[0 * 33], s[1 * 33]); o.y = pk2(s[2 * 33], s[3 * 33]); o.z = pk2(s[4 * 33], s[5 * 33]); o.w = pk2(s[6 * 33], s[7 * 33]);
        int dr = drow0 + n; if (kpe_perm && dr >= 384 && dr < 448) { const int e = dr - 384; dr = 384 + 32 * ((e >> 4) & 1) + 16 * (e >> 5) + (e & 15); }
        *(v4u*)(WT + (size_t)dr * ldt + dcol0 + k0 + 8 * c) = o; }
    LDS_WAIT();
}
__device__ __forceinline__ void transpose_item8(const float* W, int ldw, int k0, int n0, unsigned char* WT8, int ldt8, int drow0, int dcol0, float* scr, int lane, float scale, bool kpe_perm) {
    float tv[32];
#pragma unroll
    for (int i = 0; i < 32; ++i) { const int kk = 2 * i + (lane >> 5); tv[i] = W[(size_t)(k0 + kk) * ldw + n0 + (lane & 31)]; }
#pragma unroll
    for (int i = 0; i < 32; ++i) { const int kk = 2 * i + (lane >> 5); scr[kk * 33 + (lane & 31)] = tv[i]; }
    LDS_WAIT();
    const int n = lane >> 1, hf = lane & 1; const float* sp = scr + (32 * hf) * 33 + n;
    v4u o0, o1; unsigned w[8];
#pragma unroll
    for (int q = 0; q < 8; ++q) { int p = 0; p = __builtin_amdgcn_cvt_pk_fp8_f32(sp[(4 * q) * 33] * scale, sp[(4 * q + 1) * 33] * scale, p, false); p = __builtin_amdgcn_cvt_pk_fp8_f32(sp[(4 * q + 2) * 33] * scale, sp[(4 * q + 3) * 33] * scale, p, true); w[q] = (unsigned)p; }
    o0.x = w[0]; o0.y = w[1]; o0.z = w[2]; o0.w = w[3]; o1.x = w[4]; o1.y = w[5]; o1.z = w[6]; o1.w = w[7];
    int dr = drow0 + n; if (kpe_perm && dr >= 384 && dr < 448) { const int e = dr - 384; dr = 384 + 32 * ((e >> 4) & 1) + 16 * (e >> 5) + (e & 15); }
    unsigned char* d = WT8 + (size_t)dr * ldt8 + dcol0 + k0 + 32 * hf;
    *(v4u*)d = o0; *(v4u*)(d + 16) = o1;
    LDS_WAIT();
}
typedef __attribute__((address_space(4))) const char kchar;
struct In { int opq;
    __device__ __forceinline__ const float* operator[](int k) const { kchar* ka = (kchar*)__builtin_amdgcn_kernarg_segment_ptr(); return *(const float* const __attribute__((address_space(4)))*)(ka + 8 * k + opq); } };
__device__ __forceinline__ unsigned char* karg_ws(int opq) { kchar* ka = (kchar*)__builtin_amdgcn_kernarg_segment_ptr(); return *(unsigned char* const __attribute__((address_space(4)))*)(ka + 38 * 8 + 8 + opq); }
__device__ __forceinline__ float* karg_out(int opq) { kchar* ka = (kchar*)__builtin_amdgcn_kernarg_segment_ptr(); return *(float* const __attribute__((address_space(4)))*)(ka + 38 * 8 + opq); }

__device__ __forceinline__ void p0_prologue(const Ctx& F, const In& in, unsigned char* ws) {
    float* scr = (float*)(F.lds + RING_OFF + F.wave * 16384);
    bf16* Wd = (bf16*)(ws + WS_WD); bf16* Wuq = (bf16*)(ws + WS_WUQ); bf16* Wukv = (bf16*)(ws + WS_WUKV); bf16* Wo = (bf16*)(ws + WS_WO);
    bf16* Win = (bf16*)(ws + WS_WIN); bf16* Wout = (bf16*)(ws + WS_WOUT); bf16* Wgu = (bf16*)(ws + WS_WGU); bf16* Wdn = (bf16*)(ws + WS_WDN);
    constexpr int I_D = 16 * 14, I_UQ = 4 * 48, I_UKV = 2 * 64, I_O = 16 * 32, I_IN = 16 * 96, I_OUT = 16 * 32, I_GU = 2 * 16 * 2 * (16 * 8), I_DN = 2 * 24 * 2 * (4 * 32);
    constexpr int NITEMS = I_D + I_UQ + I_UKV + I_O + I_IN + I_OUT + I_GU + I_DN;
    for (int it = F.gw; it < NITEMS; it += F.NGW) {
        int r = it; const float* W; int ldw, k0, n0, ldt, drow0, dcol0 = 0; bf16* WT; float f8s = 0.f;
        if (r < I_D) { W = in[7]; ldw = 448; k0 = (r / 14) * 64; n0 = (r % 14) * 32; WT = Wd; ldt = 1024; drow0 = n0; f8s = 32.f; }
        else if ((r -= I_D) < I_UQ) { W = in[10]; ldw = 1536; k0 = (r / 48) * 64; n0 = (r % 48) * 32; WT = Wuq; ldt = 256; drow0 = n0; f8s = 16.f; }
        else if ((r -= I_UQ) < I_UKV) { W = in[11]; ldw = 2048; k0 = (r / 64) * 64; n0 = (r % 64) * 32; ldt = 128;
            WT = Wukv + ((n0 & 128) ? 1024 * 128 : 0); drow0 = (n0 >> 8) * 128 + (n0 & 127); }
        else if ((r -= I_UKV) < I_O) { W = in[14]; ldw = 1024; k0 = (r / 32) * 64; n0 = (r % 32) * 32; WT = Wo; ldt = 1024; drow0 = n0; f8s = 32.f; }
        else if ((r -= I_O) < I_IN) { W = in[15]; ldw = 3072; k0 = (r / 96) * 64; n0 = (r % 96) * 32; WT = Win; ldt = 1024; drow0 = n0; }
        else if ((r -= I_IN) < I_OUT) { W = in[30]; ldw = 1024; k0 = (r / 32) * 64; n0 = (r % 32) * 32; WT = Wout; ldt = 1024; drow0 = n0; }
        else if ((r -= I_OUT) < I_GU) {
            const int sub = r % 128, mat = r / 128, which = mat & 1, le = mat >> 1;
            W = (which ? in[36] : in[35]) + (size_t)le * 1024 * 256; ldw = 256; k0 = (sub / 8) * 64; n0 = (sub % 8) * 32;
            WT = (bf16*)((unsigned char*)Wgu + (size_t)le * 512 * 1024); ldt = 1024; drow0 = (n0 >> 7) * 256 + which * 128 + (n0 & 127); f8s = 32.f; }
        else { r -= I_GU;
            const int sub = r % 128, mat = r / 128, slot = mat & 1, lb = mat >> 1, layer = lb / 24, bk = lb % 24;
            int ii, jj; pg8::pair_of(bk % 6, ii, jj); const int e = (bk / 6) * 4 + (slot ? jj : ii);
            W = in[37] + (size_t)(layer * 16 + e) * 256 * 1024; ldw = 1024; k0 = (sub / 32) * 64; n0 = (sub % 32) * 32;
            WT = Wdn + (size_t)lb * 1024 * 512; ldt = 512; drow0 = n0; dcol0 = slot * 256; }
        if (f8s != 0.f) transpose_item8(W, ldw, k0, n0, (unsigned char*)WT, ldt, drow0, dcol0, scr, F.lane, f8s, it < I_D);
        else transpose_item(W, ldw, k0, n0, WT, ldt, drow0, dcol0, scr, F.lane, it < I_D);
    }
    { const int gt = F.vcu * NTHR + F.tid, NGT = F.G * NTHR; const v4u z = {0u, 0u, 0u, 0u};
      for (int i = gt; i < 64 * 1024 / 16; i += NGT) *(v4u*)((unsigned char*)Wd + (size_t)448 * 1024 + (size_t)i * 16) = z;
    }
    { const int gt = F.vcu * NTHR + F.tid, NGT = F.G * NTHR; float* RT = (float*)(ws + WS_ROPE); const int* posi = (const int*)in[2];
      const float inv = __builtin_amdgcn_exp2f(-0.41524101186092029f * (float)(gt & 31));
      for (int i = gt; i < T * 32; i += NGT) { const int t = i >> 5;
        float sn, cs; sincosf((float)posi[t] * inv, &sn, &cs); *(v2u*)(RT + (size_t)i * 2) = (v2u){__float_as_uint(cs), __float_as_uint(sn)}; } }
    { const int gt = F.vcu * NTHR + F.tid, NGT = F.G * NTHR; bf16* W4S = (bf16*)(ws + WS_W4S); const float* w4 = in[28];
      for (int i = gt; i < 4096 * 8; i += NGT) { const int col = i & 4095, oct = i >> 12; float w[8];
#pragma unroll
        for (int q = 0; q < 8; ++q) w[q] = w4[(size_t)(8 * oct + q) * 4096 + col];
        unsigned hw[4], lw[4];
#pragma unroll
        for (int q = 0; q < 4; ++q) { const unsigned h2 = pk2(w[2 * q], w[2 * q + 1]); hw[q] = h2;
          lw[q] = pk2(w[2 * q] - __uint_as_float(h2 << 16), w[2 * q + 1] - __uint_as_float(h2 & 0xffff0000u)); }
        bf16* d = W4S + (size_t)col * 256 + 8 * oct; const v4u hv = {hw[0], hw[1], hw[2], hw[3]}, lv = {lw[0], lw[1], lw[2], lw[3]}, zv = {0u, 0u, 0u, 0u};
        *(v4u*)d = hv; *(v4u*)(d + 64) = hv; *(v4u*)(d + 128) = lv; *(v4u*)(d + 192) = zv; } }
    __syncthreads();
    { bf16* HDp = (bf16*)(ws + WS_HDNS); float* wl = (float*)(F.lds + RING_OFF); float* sv = wl + 161 * 64 + F.wave * 64;
      for (int i = F.tid; i < 161 * 64; i += NTHR) wl[i] = i < 33 * 64 ? in[19][i] : (i < 97 * 64 ? in[22][i - 33 * 64] : in[25][i - 97 * 64]);
      __syncthreads();
      const int j = F.lane; const float b1 = in[20][j], f1 = in[21][j], b2 = in[23][j], f2 = in[24][j], b3 = in[26][j], f3 = in[27][j];
      for (int t = F.gw; t < 4096; t += F.NGW) {
        float zf = 0.f;
        { const float w = 6.2831855f * (float)t * (1.f / 4096.f);
          if (j == 0) zf = (float)t / 4095.f;
          else if (j <= 16) { const float fr = 1e-4f + (float)(j - 1) * ((15.f - 1e-4f) / 15.f); zf = cosf(fr * w); }
          else if (j <= 32) { const float fr = 1e-4f + (float)(j - 17) * ((15.f - 1e-4f) / 15.f); zf = -sinf(fr * w); } }
        sv[j] = zf; LDS_WAIT();
        float a = b1;
#pragma unroll
        for (int k = 0; k < 33; ++k) a += sv[k] * wl[k * 64 + j];
        float h = sinf(f1 * a); LDS_WAIT(); sv[j] = h; LDS_WAIT();
        a = b2;
#pragma unroll 16
        for (int k = 0; k < 64; ++k) a += sv[k] * wl[(33 + k) * 64 + j];
        h = sinf(f2 * a); LDS_WAIT(); sv[j] = h; LDS_WAIT();
        a = b3;
#pragma unroll 16
        for (int k = 0; k < 64; ++k) a += sv[k] * wl[(97 + k) * 64 + j];
        h = sinf(f3 * a); LDS_WAIT();
        const unsigned hi = pk2(h, 0.f) & 0xffffu; const float lo = h - bf2f((unsigned short)hi); const unsigned lob = pk2(lo, 0.f) & 0xffffu;
        bf16* d = HDp + (size_t)t * 256 + j; d[0] = (bf16)hi; d[64] = (bf16)lob; d[128] = (bf16)hi; d[192] = 0;
      } }
    __syncthreads();
    { float* cact = (float*)(F.lds + RING_OFF); float* red = cact + 8 * 1024;
      float* MOD = (float*)(ws + WS_MOD);
      for (int i = F.tid; i < 8 * 1024; i += NTHR) { const float x = in[1][i]; cact[(i & 1023) * 8 + (i >> 10)] = x / (1.f + __expf(-x)); }
      __syncthreads();
      for (int it = F.vcu; it < 2 * 128; it += F.G) {
        const int layer = it >> 7, cb = it & 127, r5 = F.lane / 12, cq = F.lane - 12 * r5;
        const float* W = in[3] + (size_t)layer * 1024 * 6144 + cb * 48 + 4 * cq + (size_t)(F.wave * 128 + r5) * 6144;
        f32x4 acc[8];
#pragma unroll
        for (int b = 0; b < 8; ++b) acc[b] = (f32x4){0.f, 0.f, 0.f, 0.f};
#pragma unroll
        for (int hf = 0; hf < 2; ++hf) { f32x4 wv[13];
#pragma unroll
          for (int q = 0; q < 13; ++q) { const int kk = 5 * (13 * hf + q) + r5; wv[q] = (F.lane < 60 && kk < 128) ? *(const f32x4*)(W + (size_t)(5 * (13 * hf + q)) * 6144) : (f32x4){0.f, 0.f, 0.f, 0.f}; }
#pragma unroll
          for (int q = 0; q < 13; ++q) { int kk = 5 * (13 * hf + q) + r5; kk = kk < 128 ? kk : 127; const float* cp = cact + (F.wave * 128 + kk) * 8; const f32x4 c0 = *(const f32x4*)cp, c1 = *(const f32x4*)(cp + 4);
#pragma unroll
            for (int b = 0; b < 8; ++b) acc[b] += (b < 4 ? c0[b & 3] : c1[b & 3]) * wv[q]; } }
        if (F.lane < 60) {
#pragma unroll
          for (int b = 0; b < 8; ++b) *(f32x4*)(red + ((F.wave * 5 + r5) * 8 + b) * 48 + 4 * cq) = acc[b]; }
        __syncthreads();
        if (F.tid < 384) { const int b = F.tid / 48, col = F.tid - 48 * b; float s = in[4][layer * 6144 + cb * 48 + col];
#pragma unroll 8
          for (int p = 0; p < 40; ++p) s += red[(p * 8 + b) * 48 + col];
          MOD[((size_t)layer * 8 + b) * 6144 + cb * 48 + col] = s; }
        __syncthreads();
      } }
}

template <class TX> __device__ __forceinline__ f32x4 ldrow4(const TX* p);
template <> __device__ __forceinline__ f32x4 ldrow4<float>(const float* p) { return *(const __attribute__((address_space(1))) f32x4*)p; }
template <> __device__ __forceinline__ f32x4 ldrow4<bf16>(const bf16* p) { const v2u w = *(const __attribute__((address_space(1))) v2u*)p; f32x4 r; r[0] = __uint_as_float(w.x << 16); r[1] = __uint_as_float(w.x & 0xffff0000u); r[2] = __uint_as_float(w.y << 16); r[3] = __uint_as_float(w.y & 0xffff0000u); return r; }
template <class TX, bool OUT8 = false> __device__ __forceinline__ void norm_mod_phase(const Ctx& F, const TX* X, const float* g, const float* sc, const float* sh, bf16* OUT) {
    for (int ch = F.gw; ch < T / 16; ch += F.NGW) {
        const int r0 = ch * 16, b = r0 >> 12;
        f32x4 A[4], S[4];
#pragma unroll
        for (int j = 0; j < 4; ++j) { const int col = 4 * F.lane + 256 * j; const f32x4 gv = *(const f32x4*)(g + col), sv = *(const f32x4*)(sc + (size_t)b * 6144 + col); A[j] = gv * (1.f + sv); S[j] = *(const f32x4*)(sh + (size_t)b * 6144 + col); }
        const TX* xr = X + (size_t)r0 * DM + 4 * F.lane;
        f32x4 nx[4];
#pragma unroll
        for (int j = 0; j < 4; ++j) nx[j] = ldrow4<TX>(xr + 256 * j);
        for (int rr = 0; rr < 16; ++rr) {
            f32x4 v[4]; float ss = 0.f;
#pragma unroll
            for (int j = 0; j < 4; ++j) { v[j] = nx[j]; ss += (v[j].x * v[j].x + v[j].y * v[j].y) + (v[j].z * v[j].z + v[j].w * v[j].w); }
            if (rr < 15) {
#pragma unroll
                for (int j = 0; j < 4; ++j) nx[j] = ldrow4<TX>(xr + (size_t)(rr + 1) * DM + 256 * j); }
            const float rstd = rsqrtf(wave_sum(ss) * (1.f / DM) + EPS);
            if constexpr (OUT8) { unsigned char* orow = (unsigned char*)OUT + (size_t)(r0 + rr) * DM + 4 * F.lane;
#pragma unroll
                for (int j = 0; j < 4; ++j) { const f32x4 o = v[j] * rstd * A[j] + S[j]; int p = 0; p = __builtin_amdgcn_cvt_pk_fp8_f32(o.x, o.y, p, false); p = __builtin_amdgcn_cvt_pk_fp8_f32(o.z, o.w, p, true); *(int*)(orow + 256 * j) = p; } }
            else { bf16* orow = OUT + (size_t)(r0 + rr) * DM + 4 * F.lane;
#pragma unroll
                for (int j = 0; j < 4; ++j) { const f32x4 o = v[j] * rstd * A[j] + S[j]; v2u w; w.x = pk2(o.x, o.y); w.y = pk2(o.z, o.w); *(v2u*)(orow + 256 * j) = w; } } }
    }
}

__device__ __forceinline__ void lat_post_phase(const Ctx& F, const float* LAT, const float* qag, const float* kvag, const float* kng, const float* rope, bf16* CQN, bf16* CKVN, bf16* KPE) {
    const int l = F.lane;
    const f32x4 gq = *(const f32x4*)(qag + 4 * l);
    const f32x4 g2 = l < 32 ? *(const f32x4*)(kvag + 4 * l) : (l < 48 ? *(const f32x4*)(kng + 128 + 4 * (l - 32)) : (f32x4){0.f, 0.f, 0.f, 0.f});
    f32x4 na = *(const f32x4*)(LAT + (size_t)F.gw * 512 + 4 * l), nc = l < 48 ? *(const f32x4*)(LAT + (size_t)F.gw * 512 + 256 + 4 * l) : (f32x4){0.f, 0.f, 0.f, 0.f};
    for (int row = F.gw; row < T; row += F.NGW) {
        const f32x4 a = na, c = nc;
        if (row + F.NGW < T) { const float* nr = LAT + (size_t)(row + F.NGW) * 512; na = *(const f32x4*)(nr + 4 * l); if (l < 48) nc = *(const f32x4*)(nr + 256 + 4 * l); }
        const float sq = (a.x * a.x + a.y * a.y) + (a.z * a.z + a.w * a.w), sc = (c.x * c.x + c.y * c.y) + (c.z * c.z + c.w * c.w);
        const float s_q = wave_sum(sq), s_kv = wave_sum(l < 32 ? sc : 0.f), s_pe = wave_sum((l >= 32 && l < 48) ? sc : 0.f);
        const float rq = rsqrtf(s_q * (1.f / 256.f) + EPS), rkv = rsqrtf(s_kv * (1.f / 128.f) + EPS), rpe = rsqrtf(s_pe * (1.f / 64.f) + EPS);
        { const f32x4 o = a * rq * gq; v2u w; w.x = pk2(o.x, o.y); w.y = pk2(o.z, o.w); *(v2u*)(CQN + (size_t)row * 256 + 4 * l) = w; }
        if (l < 32) { const f32x4 o = c * rkv * g2; v2u w; w.x = pk2(o.x, o.y); w.y = pk2(o.z, o.w); *(v2u*)(CKVN + (size_t)row * 256 + 4 * l) = w; }
        else { v2u w; w.x = 0u; w.y = 0u; *(v2u*)(CKVN + (size_t)row * 256 + 128 + 4 * (l - 32)) = w; }
        const f32x4 n = c * rpe * g2;
        f32x4 other; other.x = __shfl_xor(n.x, 8); other.y = __shfl_xor(n.y, 8); other.z = __shfl_xor(n.z, 8); other.w = __shfl_xor(n.w, 8);
        if (l >= 32 && l < 48) { const bool first = l < 40; const int e0 = 4 * ((l - 32) & 7);
            float o[4];
#pragma unroll
            for (int i = 0; i < 4; ++i) { const int e = e0 + i; const float cs = rope[(size_t)row * 64 + e * 2], sn = rope[(size_t)row * 64 + e * 2 + 1];
                const float mine = n[i], oth = other[i]; o[i] = first ? (mine * cs - oth * sn) : (oth * sn + mine * cs); }
            v2u w; w.x = pk2(o[0], o[1]); w.y = pk2(o[2], o[3]); *(v2u*)(KPE + (size_t)row * 64 + 4 * (l - 32)) = w; }
    }
}

__device__ __forceinline__ void knorm_phase(const Ctx& F, bf16* KV, const float* kng) {
    const int l = F.lane, h = l >> 3, e0 = (l & 7) * 16;
    float g[16];
#pragma unroll
    for (int i = 0; i < 16; ++i) g[i] = kng[e0 + i];
    for (int row = F.gw; row < T; row += F.NGW) {
        bf16* p = KV + (size_t)row * 2048 + h * 256 + e0;
        const v4u r0 = *(const v4u*)p, r1 = *(const v4u*)(p + 8);
        float f[16]; const unsigned w[8] = {r0.x, r0.y, r0.z, r0.w, r1.x, r1.y, r1.z, r1.w};
        float ss = 0.f;
#pragma unroll
        for (int i = 0; i < 8; ++i) { f[2 * i] = __uint_as_float(w[i] << 16); f[2 * i + 1] = __uint_as_float(w[i] & 0xffff0000u); ss += f[2 * i] * f[2 * i] + f[2 * i + 1] * f[2 * i + 1]; }
        ss += __shfl_xor(ss, 1); ss += __shfl_xor(ss, 2); ss += __shfl_xor(ss, 4);
        const float r = rsqrtf(ss * (1.f / 128.f) + EPS);
        v4u o0, o1;
        o0.x = pk2(f[0] * r * g[0], f[1] * r * g[1]); o0.y = pk2(f[2] * r * g[2], f[3] * r * g[3]); o0.z = pk2(f[4] * r * g[4], f[5] * r * g[5]); o0.w = pk2(f[6] * r * g[6], f[7] * r * g[7]);
        o1.x = pk2(f[8] * r * g[8], f[9] * r * g[9]); o1.y = pk2(f[10] * r * g[10], f[11] * r * g[11]); o1.z = pk2(f[12] * r * g[12], f[13] * r * g[13]); o1.w = pk2(f[14] * r * g[14], f[15] * r * g[15]);
        *(v4u*)p = o0; *(v4u*)(p + 8) = o1;
    }
}

__device__ __forceinline__ void route_phase(const Ctx& F, const bf16* X, const float* g, const float* sc, const float* sh, const float* wg, const float* bg, const float* we, const float* be,
                                            bf16* XN2, int* LIST, float* WL, gu32* cnt) {
    float* W20 = (float*)(F.lds + RING_OFF);
    for (int i = F.tid; i < 20 * 1024; i += NTHR) { const int o = i >> 10, col = i & 1023; W20[i] = o < 4 ? wg[col * 4 + o] : we[col * 16 + (o - 4)]; }
    __syncthreads();
    float bgv[4];
#pragma unroll
    for (int i = 0; i < 4; ++i) bgv[i] = bg[i];
    for (int ch = F.gw; ch < T / 16; ch += F.NGW) {
        const int r0 = ch * 16, b = r0 >> 12;
        f32x4 A[4], S[4];
#pragma unroll
        for (int j = 0; j < 4; ++j) { const int col = 4 * F.lane + 256 * j; const f32x4 gv = *(const f32x4*)(g + col), sv = *(const f32x4*)(sc + (size_t)b * 6144 + col); A[j] = gv * (1.f + sv); S[j] = *(const f32x4*)(sh + (size_t)b * 6144 + col); }
        const bf16* xr = X + (size_t)r0 * DM + 4 * F.lane;
        f32x4 nx[4];
#pragma unroll
        for (int j = 0; j < 4; ++j) nx[j] = ldrow4<bf16>(xr + 256 * j);
        for (int rr = 0; rr < 16; ++rr) { const int row = r0 + rr;
            f32x4 v[4]; float ss = 0.f;
#pragma unroll
            for (int j = 0; j < 4; ++j) { v[j] = nx[j]; ss += (v[j].x * v[j].x + v[j].y * v[j].y) + (v[j].z * v[j].z + v[j].w * v[j].w); }
            if (rr < 15) {
#pragma unroll
                for (int j = 0; j < 4; ++j) nx[j] = ldrow4<bf16>(xr + (size_t)(rr + 1) * DM + 256 * j); }
            const float rstd = rsqrtf(wave_sum(ss) * (1.f / DM) + EPS);
            unsigned char* orow = (unsigned char*)XN2 + (size_t)row * DM + 4 * F.lane;
#pragma unroll
            for (int j = 0; j < 4; ++j) { v[j] = v[j] * rstd * A[j] + S[j]; int p = 0; p = __builtin_amdgcn_cvt_pk_fp8_f32(v[j].x, v[j].y, p, false); p = __builtin_amdgcn_cvt_pk_fp8_f32(v[j].z, v[j].w, p, true); *(int*)(orow + 256 * j) = p; }
            float gl[4];
#pragma unroll
            for (int o = 0; o < 4; ++o) { float a = 0.f;
#pragma unroll
                for (int j = 0; j < 4; ++j) { const f32x4 w = *(const f32x4*)(W20 + o * 1024 + 4 * F.lane + 256 * j); a += (v[j].x * w.x + v[j].y * w.y) + (v[j].z * w.z + v[j].w * w.w); }
                gl[o] = wave_sum(a) + bgv[o]; }
            int gi = 0; float gm = gl[0]; if (gl[1] > gm) { gm = gl[1]; gi = 1; } if (gl[2] > gm) { gm = gl[2]; gi = 2; } if (gl[3] > gm) { gm = gl[3]; gi = 3; }
            gi = __builtin_amdgcn_readfirstlane(gi);
            const float gw_ = 1.f / (__expf(gl[0] - gm) + __expf(gl[1] - gm) + __expf(gl[2] - gm) + __expf(gl[3] - gm));
            const float* We = W20 + (4 + 4 * gi) * 1024 + 4 * F.lane;
            float e[4];
#pragma unroll
            for (int k = 0; k < 4; ++k) { float a = 0.f;
#pragma unroll
                for (int j = 0; j < 4; ++j) { const f32x4 w = *(const f32x4*)(We + k * 1024 + 256 * j); a += (v[j].x * w.x + v[j].y * w.y) + (v[j].z * w.z + v[j].w * w.w); }
                e[k] = wave_sum(a) + be[4 * gi + k]; }
            int i1 = 0; float m1 = e[0];
#pragma unroll
            for (int k = 1; k < 4; ++k) if (e[k] > m1) { m1 = e[k]; i1 = k; }
            int i2 = -1; float m2 = -3.0e38f;
#pragma unroll
            for (int k = 0; k < 4; ++k) if (k != i1 && e[k] > m2) { m2 = e[k]; i2 = k; }
            const float t2 = __expf(m2 - m1), w1 = gw_ / (1.f + t2), w2 = gw_ * t2 / (1.f + t2);
            const int ilo = i1 < i2 ? i1 : i2, ihi = i1 < i2 ? i2 : i1; const float wlo = i1 < i2 ? w1 : w2, whi = i1 < i2 ? w2 : w1;
            const int pi = ilo == 0 ? ihi - 1 : (ilo == 1 ? ihi + 1 : 5), bk = gi * 6 + pi;
            if (F.lane == 0) { const unsigned pos = __hip_atomic_fetch_add(cnt + bk * 64, 1u, RLX_AGENT);
                LIST[bk * 32768 + pos] = row; float2 ww; ww.x = wlo; ww.y = whi; *(float2*)(WL + ((size_t)bk * 32768 + pos) * 2) = ww; }
        }
    }
}
__device__ __forceinline__ void moe_table(const Ctx& F, const gu32* cnt) {
    int* tinfo = (int*)(F.lds + TINFO_OFF);
    __syncthreads();
    if (F.tid == 0) { int nt = 0;
        for (int b = 0; b < 24; ++b) { const int c = (int)__hip_atomic_load(cnt + b * 64, RLX_AGENT); const int tiles = (c + 255) >> 8;
            tinfo[256 + b] = nt * 256; tinfo[288 + b] = c; for (int i = 0; i < tiles; ++i) tinfo[1 + nt + i] = b; nt += tiles; }
        tinfo[0] = nt; }
    __syncthreads();
}
__device__ __forceinline__ void permute_phase(const Ctx& F, const bf16* XN2, const int* ROUTE, bf16* XN2S, int* TOKW) {
    const int* tinfo = (const int*)(F.lds + TINFO_OFF);
    for (int ch = F.gw; ch < T / 4; ch += F.NGW) {
        v4i r[4]; v4u a[4], bq[4];
#pragma unroll
        for (int i = 0; i < 4; ++i) { const int row = ch * 4 + i; r[i] = *(const v4i*)(ROUTE + (size_t)row * 4);
            a[i] = *(const v4u*)(XN2 + (size_t)row * DM + 8 * F.lane); bq[i] = *(const v4u*)(XN2 + (size_t)row * DM + 512 + 8 * F.lane); }
#pragma unroll
        for (int i = 0; i < 4; ++i) { const int row = ch * 4 + i, srow = tinfo[256 + r[i].x] + r[i].y;
            *(v4u*)(XN2S + (size_t)srow * DM + 8 * F.lane) = a[i]; *(v4u*)(XN2S + (size_t)srow * DM + 512 + 8 * F.lane) = bq[i];
            if (F.lane == 0) { v4i w; w.x = row; w.y = r[i].z; w.z = r[i].w; w.w = 0; *(v4i*)(TOKW + (size_t)srow * 4) = w; } }
    }
}

constexpr float W32C[16] = {1.f, 0.98078528040323043f, 0.92387953251128674f, 0.83146961230254524f, 0.70710678118654752f, 0.55557023301960218f, 0.38268343236508977f, 0.19509032201612825f,
                            0.f, -0.19509032201612825f, -0.38268343236508977f, -0.55557023301960218f, -0.70710678118654752f, -0.83146961230254524f, -0.92387953251128674f, -0.98078528040323043f};
constexpr float W32S[16] = {0.f, 0.19509032201612825f, 0.38268343236508977f, 0.55557023301960218f, 0.70710678118654752f, 0.83146961230254524f, 0.92387953251128674f, 0.98078528040323043f,
                            1.f, 0.98078528040323043f, 0.92387953251128674f, 0.83146961230254524f, 0.70710678118654752f, 0.55557023301960218f, 0.38268343236508977f, 0.19509032201612825f};
struct FftTw { const c32* T1; c32 tob; const c32* T2; };
template <int A> __device__ __forceinline__ c32 mul_to(c32 x, c32 tob) { const c32 y = cmul(x, tob); return cmk(y.x * W32C[A] + y.y * W32S[A], y.y * W32C[A] - y.x * W32S[A]); }
template <int A> __device__ __forceinline__ c32 mul_toc(c32 x, c32 tob) { const c32 y = cmulc(x, tob); return cmk(y.x * W32C[A] - y.y * W32S[A], y.y * W32C[A] + y.x * W32S[A]); }
#define TO_ALL(OP) OP(0) OP(1) OP(2) OP(3) OP(4) OP(5) OP(6) OP(7) OP(8) OP(9) OP(10) OP(11) OP(12) OP(13) OP(14) OP(15)
__device__ __forceinline__ void fft_twiddles(FftTw& W, int gt, c32* t1tab, c32* t2tab, int tid) {
    if (tid < 256) { float s, c; sincosf(-6.283185307179586f * (float)(((tid >> 4) * (tid & 15)) & 255) * (1.f / 256.f), &s, &c); t2tab[(tid >> 4) * 17 + (tid & 15)] = cmk(c, s); }
    for (int i = tid; i < 4096; i += NTHR) { const int p = i >> 8, t = i & 255; float s, c; sincosf(-6.283185307179586f * (float)((t * p) & 4095) * (1.f / 4096.f), &s, &c); t1tab[i] = cmk(c, s); }
    { float s, c; sincosf(-6.283185307179586f * (float)gt * (1.f / 8192.f), &s, &c); W.tob = cmk(c, s); }
    W.T1 = t1tab + gt; W.T2 = t2tab + (gt & 15) * 17;
    __syncthreads();
}
__device__ __forceinline__ void fft_forward_a(c32 (&v)[16], const FftTw& W, c32* ex, int gt) {
    __syncthreads();
    fft_fwd_a(v, W.T1, ex, gt);
    __syncthreads();
}
__device__ __forceinline__ void fft_forward_bc(c32 (&v)[16], const FftTw& W, c32* ex, int gt) {
    fft_fwd_b(v, W.T2, ex, ex, gt);
    __builtin_amdgcn_wave_barrier(); asm volatile("" ::: "memory");
    fft_fwd_c(v, ex, gt);
}
__device__ __forceinline__ void fft_forward(c32 (&v)[16], const FftTw& W, c32* ex, int gt) { fft_forward_a(v, W, ex, gt); fft_forward_bc(v, W, ex, gt); }
__device__ __forceinline__ void fft_inverse(c32 (&v)[16], const FftTw& W, c32* ex, int gt) {
    __builtin_amdgcn_wave_barrier(); asm volatile("" ::: "memory");
    fft_inv_a(v, ex, gt);
    __builtin_amdgcn_wave_barrier(); asm volatile("" ::: "memory");
    fft_inv_b(v, W.T2, ex, ex, gt);
    __syncthreads();
    fft_inv_c(v, W.T1, ex, gt);
}
__device__ __forceinline__ void filter_phase(const Ctx& F, const float* HT, const float* fbias, c32* KF) {
    const int g = __builtin_amdgcn_readfirstlane(F.tid >> 8), gt = F.tid & 255;
    c32* ex = (c32*)(F.lds + RING_OFF + g * 36864);
    float* rev = (float*)ex;
    float* red = (float*)(F.lds + RED_OFF);
    FftTw W; fft_twiddles(W, gt, (c32*)(F.lds + RING_OFF + 73728), (c32*)(F.lds + RING_OFF + 110592), F.tid);
    for (int d = F.vcu; d < DM; d += F.G) {
        int gtv = gt; asm volatile("" : "+v"(gtv));
        const float delta = fabsf(-120.39728043259361f + (float)d * ((40.546510810816436f + 120.39728043259361f) / 1023.f));
        const float* hfp = HT + (size_t)(g * 2048 + d) * 4096; const float* hbp = HT + (size_t)(g * 2048 + 1024 + d) * 4096;
        float hf[16], hb[16]; float sf = 0.f, sb = 0.f;
#pragma unroll
        for (int a = 0; a < 16; ++a) { const int t = 256 * a + gtv; const float dec = __expf(-((float)t * (1.f / 4095.f)) * delta); hf[a] = hfp[t] * dec; hb[a] = hbp[t] * dec; sf += fabsf(hf[a]); sb += fabsf(hb[a]); }
        sf = wave_sum(sf); sb = wave_sum(sb);
        __syncthreads();
        if (F.lane == 0) { red[F.wave * 2] = sf; red[F.wave * 2 + 1] = sb; }
        __syncthreads();
        sf = red[g * 8] + red[g * 8 + 2] + red[g * 8 + 4] + red[g * 8 + 6]; sb = red[g * 8 + 1] + red[g * 8 + 3] + red[g * 8 + 5] + red[g * 8 + 7];
        const float nf = 1.f / (sf + EPS) * (1.f / 8192.f), nb = 1.f / (sb + EPS) * (1.f / 8192.f);
#pragma unroll
        for (int a = 0; a < 16; ++a) rev[256 * a + gt] = hb[a] * nb;
        __syncthreads();
        c32 v[16];
#pragma unroll
        for (int a = 0; a < 16; ++a) { const int n = 256 * a + gt; hb[a] = n == 0 ? 0.f : rev[4096 - n]; hf[a] *= nf; v[a] = cmk(hf[a] + hb[a], 0.f); }
        fft_forward(v, W, ex, gt);
        c32* kf = KF + ((size_t)(d * 2 + g) * 2) * 4096; const float fb = fbias[g * 1024 + d] * (1.f / 4096.f);
#pragma unroll
        for (int i = 0; i < 16; ++i) kf[i * 256 + gtv] = cmk(v[i].x + fb, v[i].y);
#define OPX(A) v[A] = mul_to<A>(cmk(hf[A] - hb[A], 0.f), W.tob);
        TO_ALL(OPX)
#undef OPX
        fft_forward(v, W, ex, gt);
#pragma unroll
        for (int i = 0; i < 16; ++i) kf[4096 + i * 256 + gtv] = v[i];
    }
}
__device__ __forceinline__ void long_conv(c32 (&z)[16], const c32* kf, const FftTw& W, c32* ex, int gt) {
    typedef float f32x2v __attribute__((ext_vector_type(2))); typedef __attribute__((address_space(1))) const f32x2v gc32;
    c32 v[16], k[16]; int gk = gt; asm volatile("" : "+v"(gk));
#define OPX(A) v[A] = mul_to<A>(z[A], W.tob);
    TO_ALL(OPX)
#undef OPX
    fft_forward_a(v, W, ex, gt);
    asm volatile("" ::: "memory");
#pragma unroll
    for (int i = 0; i < 16; ++i) { const f32x2v t_ = ((gc32*)kf)[4096 + i * 256 + gk]; k[i] = cmk(t_.x, t_.y); }
    fft_forward_bc(v, W, ex, gt);
#pragma unroll
    for (int i = 0; i < 16; ++i) v[i] = cmul(v[i], k[i]);
    fft_inverse(v, W, ex, gt);
#define OPX(A) v[A] = mul_toc<A>(v[A], W.tob);
    TO_ALL(OPX)
#undef OPX
    fft_forward_a(z, W, ex, gt);
    asm volatile("" ::: "memory");
#pragma unroll
    for (int i = 0; i < 16; ++i) { const f32x2v t_ = ((gc32*)kf)[i * 256 + gk]; k[i] = cmk(t_.x, t_.y); }
    fft_forward_bc(z, W, ex, gt);
#pragma unroll
    for (int i = 0; i < 16; ++i) z[i] = cmul(z[i], k[i]);
    fft_inverse(z, W, ex, gt);
#pragma unroll
    for (int a = 0; a < 16; ++a) z[a] = cadd(z[a], v[a]);
}
struct RawSeq { v4u r[2][2]; };
__device__ __forceinline__ void raw_issue(RawSeq& q, const bf16* urow, int b0, int gt) {
    typedef __attribute__((address_space(1))) const v4u gv4u;
    asm volatile("" : "+v"(gt));
#pragma unroll
    for (int s_ = 0; s_ < 2; ++s_)
#pragma unroll
        for (int i = 0; i < 2; ++i) q.r[s_][i] = *(gv4u*)(urow + (size_t)(b0 + s_) * SEQ + (gt + 256 * i) * 8);
}
__device__ __forceinline__ void stage_conv3(c32 (&o)[16], const RawSeq& q, float w0, float w1, float w2, float cb, bf16* stg, int gt) {
    constexpr int SS = 4112;
    __syncthreads();
#pragma unroll
    for (int s_ = 0; s_ < 2; ++s_) {
#pragma unroll
        for (int i = 0; i < 2; ++i) *(v4u*)(stg + s_ * SS + 8 + (gt + 256 * i) * 8) = q.r[s_][i];
        if (gt == 0) { stg[s_ * SS + 7] = 0; stg[s_ * SS + 4104] = 0; } }
    __syncthreads();
#pragma unroll
    for (int a = 0; a < 16; ++a) { const int t = 256 * a + gt; float r[2];
#pragma unroll
        for (int s_ = 0; s_ < 2; ++s_) { const bf16* sp = stg + s_ * SS + 7 + t; r[s_] = w0 * bf2f(sp[0]) + w1 * bf2f(sp[1]) + w2 * bf2f(sp[2]) + cb; }
        o[a] = cmk(r[0], r[1]); if ((a & 3) == 3) __builtin_amdgcn_sched_barrier(0); }
}
__device__ __forceinline__ void conv_phase(const Ctx& F, const bf16* UT, const c32* KF, const float* convw, const float* convb, bf16* ZT) {
    const int g = __builtin_amdgcn_readfirstlane(F.tid >> 8), gt = F.tid & 255;
    c32* ex = (c32*)(F.lds + RING_OFF + g * 36864);
    bf16* stg = (bf16*)ex;
    FftTw W; fft_twiddles(W, gt, (c32*)(F.lds + RING_OFF + 73728), (c32*)(F.lds + RING_OFF + 110592), F.tid);
    RawSeq raw;
    if (F.vcu < DM) raw_issue(raw, UT + (size_t)(2048 + F.vcu) * T, (2 * g) * 2, gt);
    for (int d = F.vcu; d < DM; d += F.G) {
        const c32* kf0 = KF + ((size_t)(d * 2 + 0) * 2) * 4096; const c32* kf1 = KF + ((size_t)(d * 2 + 1) * 2) * 4096;
        for (int pp = 0; pp < 2; ++pp) { const int b0 = (2 * g + pp) * 2;
            int gtv = gt; asm volatile("" : "+v"(gtv));
            c32 z[16], gate[16];
            { const int c = 2048 + d; stage_conv3(z, raw, convw[c], convw[3072 + c], convw[6144 + c], convb[c], stg, gtv); }
            raw_issue(raw, UT + (size_t)d * T, b0, gtv);
            long_conv(z, kf0, W, ex, gtv);
            { const int c = d; stage_conv3(gate, raw, convw[c], convw[3072 + c], convw[6144 + c], convb[c], stg, gtv); }
            raw_issue(raw, UT + (size_t)(1024 + d) * T, b0, gtv);
#pragma unroll
            for (int a = 0; a < 16; ++a) z[a] = cmk(z[a].x * gate[a].x, z[a].y * gate[a].y);
            long_conv(z, kf1, W, ex, gtv);
            { const int c = 1024 + d; stage_conv3(gate, raw, convw[c], convw[3072 + c], convw[6144 + c], convb[c], stg, gtv); }
            { const int dn = pp == 0 ? d : d + F.G; if (dn < DM) raw_issue(raw, UT + (size_t)(2048 + dn) * T, pp == 0 ? b0 + 2 : (2 * g) * 2, gtv); }
            bf16* zr = ZT + (size_t)d * T + (size_t)b0 * SEQ;
#pragma unroll
            for (int a = 0; a < 16; ++a) { const int t = 256 * a + gtv; const unsigned pk = pk2(z[a].x * gate[a].x, z[a].y * gate[a].y); zr[t] = (bf16)(pk & 0xffffu); zr[SEQ + t] = (bf16)(pk >> 16); }
        }
    }
}
__device__ __forceinline__ void transpose_phase(const Ctx& F, const bf16* ZT, bf16* Z) {
    bf16* tile = (bf16*)(F.lds + RING_OFF + F.wave * 8704);
    const int l = F.lane;
    v4u x[8];
    if (F.gw < 16 * 512) { const int d0 = (F.gw & 15) * 64, t0 = (F.gw >> 4) * 64;
#pragma unroll
        for (int i = 0; i < 8; ++i) x[i] = *(const v4u*)(ZT + (size_t)(d0 + i * 8 + (l >> 3)) * T + t0 + (l & 7) * 8); }
    for (int it = F.gw; it < 16 * 512; it += F.NGW) { const int d0 = (it & 15) * 64, t0 = (it >> 4) * 64;
#pragma unroll
        for (int i = 0; i < 8; ++i) { const int dr = i * 8 + (l >> 3), c = l & 7;
            v2u* p = (v2u*)(tile + dr * 68 + c * 8); v2u a; a.x = x[i].x; a.y = x[i].y; p[0] = a; a.x = x[i].z; a.y = x[i].w; p[1] = a; }
        const int itn = it + F.NGW;
        if (itn < 16 * 512) { const int dn = (itn & 15) * 64, tn = (itn >> 4) * 64;
#pragma unroll
            for (int i = 0; i < 8; ++i) x[i] = *(const v4u*)(ZT + (size_t)(dn + i * 8 + (l >> 3)) * T + tn + (l & 7) * 8); }
        LDS_WAIT();
#pragma unroll
        for (int i = 0; i < 8; ++i) { const int tr = i * 8 + (l >> 3), c = l & 7; unsigned short e[8];
#pragma unroll
            for (int k = 0; k < 8; ++k) e[k] = tile[(c * 8 + k) * 68 + tr];
            v4u o; o.x = e[0] | ((unsigned)e[1] << 16); o.y = e[2] | ((unsigned)e[3] << 16); o.z = e[4] | ((unsigned)e[5] << 16); o.w = e[6] | ((unsigned)e[7] << 16);
            *(v4u*)(Z + (size_t)(t0 + tr) * DM + d0 + c * 8) = o; }
        LDS_WAIT();
    }
}

constexpr int NPH = 22;
#define MOE_PHASES(L) do { \
        const int mb = 8 + 10 * L; \
        if (IN(mb)) { PH_ARGS; const float* mod = WSP(float, WS_MOD) + (size_t)L * 8 * 6144; gu32* cnt = (gu32*)(ws + WS_CTL) + CW_CNT + L * 24 * 64; \
            route_phase(F, WSP(bf16, WS_XR), in[6] + L * 1024, mod + 4 * 1024, mod + 3 * 1024, in[31] + L * 4096, in[32] + L * 4, in[33] + L * 16384, in[34] + L * 16, WSP(bf16, WS_XN2), WSP(int, WS_LIST), WSP(float, WS_WL), cnt); \
            if (L == 0) { __syncthreads();        \
                pg8::Gemm gmh{WSP(bf16, WS_W4S), WSP(bf16, WS_HDNS), 4096, 4096, 256}; pg8::StaticOrder Sh; Sh.init(4096, 4096, F.G, (int)blockIdx.x); pg8::EpiF32 Eh{WSP(float, WS_HT), 4096}; \
                REP(11) pg8::gemm_phase<pg8::EpiF32, pg8::StaticOrder, true, true>(ring, gmh, Sh, Eh, F.tid); } } \
        if (IN(mb) && IN(mb + 2)) xcd_barrier(bar); \
        if (IN(mb + 2)) { PH_ARGS; gu32* cnt = (gu32*)(ws + WS_CTL) + CW_CNT + L * 24 * 64; moe_table(F, cnt); \
              \
            pg8::Gemm gm{WSP(bf16, WS_XN2), (const bf16*)(ws + WS_WGU + (size_t)L * 16 * 512 * 1024), MS_ROWS, 8192, 512}; pg8::MoeOrder S{tinfo, F.G, F.vcu, 0, WSP(int, WS_LIST)}; pg8::EpiSwiGLU E{WSP(bf16, WS_HACT), WSP(float, WS_WL), tinfo}; \
            REP(10) pg8::gemm_phase_gather<pg8::EpiSwiGLU, pg8::MoeOrder, true, true, 5>(ring, gm, S, E, F.tid); } SEAM(mb + 2); \
        if (IN(mb + 3)) { PH_ARGS; gu32* cnt = (gu32*)(ws + WS_CTL) + CW_CNT + L * 24 * 64; moe_table(F, cnt); const float* mod = WSP(float, WS_MOD) + (size_t)L * 8 * 6144; \
            pg8::Gemm gm{WSP(bf16, WS_HACT), WSP(bf16, WS_WDN) + (size_t)L * 24 * 1024 * 512, MS_ROWS, 24 * 1024, 512}; pg8::MoeOrder S{tinfo, F.G, F.vcu, 1, WSP(int, WS_LIST)}; if (L == 0) { pg8::EpiMoeOut<bf16> E{WSP(bf16, WS_XR), WSP(bf16, WS_XR), mod + 5 * 1024, WSP(int, WS_LIST), tinfo}; pg8::gemm_phase<pg8::EpiMoeOut<bf16>, pg8::MoeOrder, true, true>(ring, gm, S, E, F.tid); } \
            else { pg8::EpiMoeOut<float> E{WSP(bf16, WS_XR), out, mod + 5 * 1024, WSP(int, WS_LIST), tinfo}; pg8::gemm_phase<pg8::EpiMoeOut<float>, pg8::MoeOrder, true, true>(ring, gm, S, E, F.tid); } \
            if (L == 0) { __syncthreads(); REP(13) filter_phase(F, WSP(float, WS_HT), in[29], WSP(c32, WS_KF)); }       \
            } \
    } while (0)
struct Args { const float* in[38]; float* out; unsigned char* ws; int ph_lo, ph_hi; };
static_assert(sizeof(Args) == 38 * 8 + 8 + 8 + 8, "Args layout (read back through the kernarg segment pointer)");
__global__ void __launch_bounds__(NTHR, 2) fwd_kernel(Args args) {
    extern __shared__ __attribute__((aligned(16))) unsigned char lds[];
#define MK_CTX(F, tx) Ctx F; F.lds = lds; F.tid = (tx); F.lane = F.tid & 63; F.wave = __builtin_amdgcn_readfirstlane(F.tid >> 6); \
    F.G = gridDim.x; { const int bx = blockIdx.x; F.vcu = (F.G % 8 == 0) ? (bx % 8) * (F.G / 8) + bx / 8 : bx; } F.gw = F.vcu * NWAVES + F.wave; F.NGW = F.G * NWAVES
    for (int u = threadIdx.x; u < (LDS_BYTES - LDSCTL_OFF) / 4; u += NTHR) ((LAS unsigned*)((LAS unsigned char*)lds + LDSCTL_OFF))[u] = 0u;
    __syncthreads();
    const int wave_s_ = __builtin_amdgcn_readfirstlane(threadIdx.x >> 6);
    const int lo = args.ph_lo, hi = args.ph_hi;
    const bool use_bar = (hi - lo) > 1;
    XcdBarrier bar; bar.bar = (unsigned*)(args.ws + WS_CTL) + CW_BAR; bar.x = 0; bar.st = nullptr; bar.w0 = 0;
    if (use_bar) bar = xcd_barrier_post((unsigned*)(args.ws + WS_CTL) + CW_BAR, (volatile LAS unsigned*)((LAS unsigned char*)lds + MISC_OFF) + 8);
    bar.w0 = (wave_s_ == 0) ? 1 : 0;
#ifndef PHMASK
#define PHMASK 0xFFFFFFFFu
#endif
#define IN(k) (((PHMASK >> ((k) >= 18 ? (k) - 10 : (k))) & 1u) && lo <= (k) && (k) < hi)
#ifndef REPMASK
#define REPMASK 0u
#endif
#define NREP(k) (((REPMASK >> (k)) & 1u) ? 2 : 1)
#define REP(k) for (int rep_ = 0; rep_ < NREP(k); ++rep_)
#define SEAM(k) do { if (IN(k) && IN((k) + 1)) xcd_barrier(bar); } while (0)
#define PH_STR2(x) #x
#define PH_STR(x) PH_STR2(x)
#define PH_ARGS int opq_ = 0; asm volatile("; PHMARK line " PH_STR(__LINE__) : "+s"(opq_)); const In in{opq_}; unsigned char* const ws = karg_ws(opq_); float* const out = karg_out(opq_); (void)in; (void)ws; (void)out; int tx_; asm volatile("v_mbcnt_lo_u32_b32 %0, -1, 0\n\tv_mbcnt_hi_u32_b32 %0, -1, %0" : "=v"(tx_)); tx_ += wave_s_ * 64; MK_CTX(F, tx_)
#define WSP(type, off) ((type*)(ws + (off)))
    PG8_LAS unsigned char* ring = (PG8_LAS unsigned char*)lds + RING_OFF;
    const PG8_LAS int* tinfo = (const PG8_LAS int*)((PG8_LAS unsigned char*)lds + TINFO_OFF);

    if (IN(0)) { PH_ARGS; REP(0) p0_prologue(F, in, ws); } SEAM(0);

            if (IN(1)) { PH_ARGS; const float* mod = WSP(float, WS_MOD); REP(1) norm_mod_phase<float, true>(F, in[0], in[5], mod + 1024, mod, WSP(bf16, WS_XN)); } SEAM(1);
            if (IN(2)) { PH_ARGS; pg8::Gemm gm{WSP(bf16, WS_XN), WSP(bf16, WS_WD), T, 512, 512};   pg8::StaticOrder S; S.init(T, 512, F.G, (int)blockIdx.x);
                pg8::EpiLat E{WSP(unsigned char, WS_CQN), WSP(bf16, WS_CKVN), WSP(unsigned char, WS_KPE), in[8], in[9], in[13], WSP(float, WS_ROPE), (PG8_LAS float*)((PG8_LAS unsigned char*)lds + EPIX_OFF)};
                REP(2) pg8::gemm_phase<pg8::EpiLat, pg8::StaticOrder, true, true, 5>(ring, gm, S, E, F.tid); }
            if (IN(2) && IN(4)) xcd_barrier(bar);
            if (IN(4)) { REP(4) {
                { PH_ARGS; pg8::Gemm gm{WSP(bf16, WS_CQN), WSP(bf16, WS_WUQ), T, 1536, 128};   pg8::StaticOrder S; S.init(T, 1536, F.G, (int)blockIdx.x); pg8::EpiBf16R E{WSP(bf16, WS_QRAW), 1536, nullptr};
                  pg8::gemm_phase<pg8::EpiBf16R, pg8::StaticOrder, true, true, 4>(ring, gm, S, E, F.tid); }
                { PH_ARGS; pg8::Gemm gm{WSP(bf16, WS_CKVN), WSP(bf16, WS_WUKV), T, 1024, 128};   pg8::StaticOrder S; S.init(T, 1024, F.G, (int)blockIdx.x);
                  pg8::EpiK8 E{WSP(unsigned char, WS_K8), in[13], (PG8_LAS float*)((PG8_LAS unsigned char*)lds + EPIX_OFF)};
                  pg8::gemm_phase<pg8::EpiK8, pg8::StaticOrder, true, true>(ring, gm, S, E, F.tid); }
                { PH_ARGS; pg8::Gemm gm{WSP(bf16, WS_WUKV) + 1024 * 128, WSP(bf16, WS_CKVN), 1024, T, 128}; pg8::StaticOrder S; S.init(1024, T, F.G, (int)blockIdx.x);
                  pg8::EpiF8T E{WSP(unsigned char, WS_VT8), T};
                  pg8::gemm_phase<pg8::EpiF8T, pg8::StaticOrder, true, true>(ring, gm, S, E, F.tid); } }
            } if (IN(4) && IN(6)) xcd_barrier(bar);
            if (IN(6)) { PH_ARGS;
                const float* qg = in[12]; const float* kg = in[13];
                float gqn = 0.f, gkn = 0.f, gqp = 0.f, gkp = 0.f;
                for (int i = 0; i < 128; ++i) { gqn = fmaxf(gqn, fabsf(qg[i])); gkn = fmaxf(gkn, fabsf(kg[i])); }
                for (int i = 128; i < 192; ++i) { gqp = fmaxf(gqp, fabsf(qg[i])); gkp = fmaxf(gkp, fabsf(kg[i])); }
                const float smaxC = (128.f * gqn * gkn + 64.f * gqp * gkp) * (0.072168783648703220f * 1.4426950408889634f);
                unsigned redo_mask = 0u;
                if (smaxC < 60.f) for (int rep_ = 0; rep_ < NREP(6); ++rep_) { int i = 0;
                    for (int u = F.vcu; u < 1024; u += F.G, ++i) { const int b = u >> 7, h = (u >> 4) & 7, qb = u & 15;
                        if (att::attn_unit<false>(b, h, qb * 256, WSP(bf16, WS_QRAW), WSP(unsigned char, WS_VT8), WSP(unsigned char, WS_K8), WSP(unsigned char, WS_KPE), WSP(bf16, WS_O), WSP(float, WS_ROPE), qg, smaxC, (char*)lds + RING_OFF, F.tid)) redo_mask |= 1u << (i & 31); } }
                else redo_mask = 0xffffffffu;
                redo_mask = (unsigned)__builtin_amdgcn_readfirstlane((int)redo_mask);
                if (redo_mask) { int i = 0;
                    for (int u = F.vcu; u < 1024; u += F.G, ++i) { const int b = u >> 7, h = (u >> 4) & 7, qb = u & 15;
                        if ((redo_mask >> (i & 31)) & 1u) (void)att::attn_unit<true>(b, h, qb * 256, WSP(bf16, WS_QRAW), WSP(unsigned char, WS_VT8), WSP(unsigned char, WS_K8), WSP(unsigned char, WS_KPE), WSP(bf16, WS_O), WSP(float, WS_ROPE), qg, smaxC, (char*)lds + RING_OFF, F.tid); } }
            } SEAM(6);
            if (IN(7)) { PH_ARGS; pg8::Gemm gm{WSP(bf16, WS_O), WSP(bf16, WS_WO), T, 1024, 512};   pg8::StaticOrder S; S.init(T, 1024, F.G, (int)blockIdx.x); pg8::EpiResGate<float, bf16> E{in[0], WSP(bf16, WS_XR), WSP(float, WS_MOD) + 2048, 1024};
                REP(7) pg8::gemm_phase<pg8::EpiResGate<float, bf16>, pg8::StaticOrder, true, true, 10>(ring, gm, S, E, F.tid); } SEAM(7);
    MOE_PHASES(0); SEAM(11);
            if (IN(12)) { PH_ARGS; const float* mod = WSP(float, WS_MOD) + 8 * 6144; REP(12) norm_mod_phase(F, WSP(bf16, WS_XR), in[5] + 1024, mod + 1024, mod, (bf16*)out); }
            if (IN(12) && IN(14)) xcd_barrier(bar);
            if (IN(14)) { PH_ARGS; pg8::Gemm gm{WSP(bf16, WS_WIN), (const bf16*)out, 3072, T, 1024}; pg8::StaticOrder S; S.init(3072, T, F.G, (int)blockIdx.x); pg8::EpiBf16R E{WSP(bf16, WS_UT), T, in[16]};
                REP(14) pg8::gemm_phase<pg8::EpiBf16R, pg8::StaticOrder, true, true>(ring, gm, S, E, F.tid); } SEAM(14);
            if (IN(15)) { PH_ARGS; for (int rep = 0; rep < NREP(15); ++rep) conv_phase(F, WSP(bf16, WS_UT), WSP(c32, WS_KF), in[17], in[18], (bf16*)out); } SEAM(15);
            if (IN(16)) { PH_ARGS; REP(16) transpose_phase(F, (const bf16*)out, WSP(bf16, WS_Z)); } SEAM(16);
            if (IN(17)) { PH_ARGS; pg8::Gemm gm{WSP(bf16, WS_Z), WSP(bf16, WS_WOUT), T, 1024, 1024}; pg8::StaticOrder S; S.init(T, 1024, F.G, (int)blockIdx.x); pg8::EpiResGate<bf16, bf16> E{WSP(bf16, WS_XR), WSP(bf16, WS_XR), WSP(float, WS_MOD) + 8 * 6144 + 2048, 1024};
                pg8::gemm_phase<pg8::EpiResGate<bf16, bf16>, pg8::StaticOrder, true, true>(ring, gm, S, E, F.tid); } SEAM(17);
    MOE_PHASES(1);
#undef IN
#undef SEAM
}

#ifndef ONE_LAUNCH
#define ONE_LAUNCH 1
#endif
extern "C" void kernel_launch(void* const* d_in, const int* in_sizes, int n_in, void* d_out, int out_size, void* d_ws, size_t ws_size, hipStream_t stream) {
    static int grid = 0;
    if (grid == 0) {
        if (n_in != 38 || in_sizes[0] != T * DM || out_size != T * DM || ws_size < WS_END) { fprintf(stderr, "kernel_launch: shape mismatch n_in %d in0 %d out %d ws %zu\n", n_in, n_in > 0 ? in_sizes[0] : -1, out_size, ws_size); grid = -1; return; }
        int dev = 0, cus = 0, per_cu = 0;
        if (hipGetDevice(&dev) != hipSuccess || hipDeviceGetAttribute(&cus, hipDeviceAttributeMultiprocessorCount, dev) != hipSuccess) { grid = -1; return; }
        if (hipFuncSetAttribute((const void*)fwd_kernel, hipFuncAttributeMaxDynamicSharedMemorySize, LDS_BYTES) != hipSuccess) { fprintf(stderr, "kernel_launch: hipFuncSetAttribute failed\n"); grid = -1; return; }
        if (hipOccupancyMaxActiveBlocksPerMultiprocessor(&per_cu, (const void*)fwd_kernel, NTHR, LDS_BYTES) != hipSuccess || per_cu < 1) { fprintf(stderr, "kernel_launch: occupancy query says %d\n", per_cu); }
        (void)hipGetLastError();
        grid = cus;
    }
    if (grid < 0) return;
    if (hipMemsetAsync((char*)d_ws + WS_CTL, 0, CTL_ZERO_BYTES, stream) != hipSuccess) return;
    Args a{};
    for (int i = 0; i < 38; ++i) a.in[i] = (const float*)d_in[i];
    a.out = (float*)d_out; a.ws = (unsigned char*)d_ws;
#if ONE_LAUNCH
    a.ph_lo = 0; a.ph_hi = NPH;
    hipLaunchKernelGGL(fwd_kernel, dim3(grid), dim3(NTHR), LDS_BYTES, stream, a);
#else
    for (int p = 0; p < NPH; ++p) { a.ph_lo = p; a.ph_hi = p + 1; hipLaunchKernelGGL(fwd_kernel, dim3(grid), dim3(NTHR), LDS_BYTES, stream, a); }
#endif
    const hipError_t le = hipPeekAtLastError();
    if (le != hipSuccess) fprintf(stderr, "kernel_launch: launch failed: %s\n", hipGetErrorName(le));
}
```

```cpp
#include <hip/hip_runtime.h>
#include <cstdio>
#include <cstdint>
namespace pg8 {
#define PG8_LAS __attribute__((address_space(3)))
typedef unsigned short bf16_t;
typedef short bf16x8 __attribute__((ext_vector_type(8)));
typedef float f32x4 __attribute__((ext_vector_type(4)));
typedef unsigned u32x4 __attribute__((ext_vector_type(4)));
typedef int v4i_t __attribute__((ext_vector_type(4)));
typedef int v8i_t __attribute__((ext_vector_type(8)));
constexpr int BM = 256, BK = 64, HALF = 128, HTB = HALF * BK * 2  , STAGE_BYTES = 8 * HTB, NXCD = 8, WGM = 8;

__host__ __device__ __forceinline__ int lds_byte(int r, int c) { const int st = (r >> 4) * 2 + (c >> 5), rr = r & 15, cc = c & 31, ob = rr * 64 + cc * 2; return st * 1024 + (ob ^ (((ob >> 9) & 1) << 5)); }
__host__ __device__ __forceinline__ void stage_rc(int b, int& R, int& C) { const int st = b / 1024, sb = b % 1024, swz = sb ^ (((sb >> 9) & 1) << 5); R = (st >> 1) * 16 + swz / 64; C = (st & 1) * 32 + (swz % 64) / 2; }
__host__ __device__ __forceinline__ int perm32(int rho) { const int n = rho >> 4, i = rho & 15; return 8 * (i >> 2) + 4 * n + (i & 3); }

struct Unit { int pm, pn; };
struct Gemm { const bf16_t* A; const bf16_t* Bt; int M, N, K; };

struct StaticOrder {
    int nM, nN, nwg, G, c;
    __host__ __device__ void init(int M, int N, int G_, int c_) { nM = M / BM; nN = N / BM; nwg = nM * nN; G = G_; c = c_; }
    __host__ __device__ bool next(int i, Unit& u) const {
        const long L = (long)i * G + c; if (L >= nwg) return false;
        int wgid = (int)L; { const int q = nwg / NXCD, r = nwg % NXCD, xcd = wgid % NXCD, off = wgid / NXCD; wgid = (xcd < r ? xcd * (q + 1) : r * (q + 1) + (xcd - r) * q) + off; }
        const int nig = WGM * nN, gid = wgid / nig, fm = gid * WGM, gsz = (nM - fm) < WGM ? (nM - fm) : WGM;
        u.pm = fm + ((wgid % nig) % gsz); u.pn = (wgid % nig) / gsz; return true;
    }
    __device__ __forceinline__ void a_ready(const Unit&) const {}
    __device__ __forceinline__ void done(const Unit&) const {}
};

__device__ __forceinline__ unsigned cvt_pk_bf16(float lo, float hi) { unsigned r; asm volatile("v_cvt_pk_bf16_f32 %0, %1, %2" : "=v"(r) : "v"(lo), "v"(hi)); return r; }
typedef float f32x2 __attribute__((ext_vector_type(2)));
typedef unsigned u32x2 __attribute__((ext_vector_type(2)));
struct EpiF32 {
    static constexpr bool PERM = false, AFTER_DRAIN = false;
    float* C; int ldc;
    __device__ __forceinline__ void operator()(const f32x4 (&acc)[2][2][4][2], const Unit& u, int wr, int wc, int fr, int fq) const {
        const int row0 = u.pm * BM + wr * 64 + fr, col0 = u.pn * BM + wc * 32 + 4 * fq;
#pragma unroll
        for (int ai = 0; ai < 2; ++ai)
#pragma unroll
            for (int m = 0; m < 4; ++m) { float* rowp = C + (size_t)(row0 + ai * HALF + m * 16) * ldc + col0;
#pragma unroll
                for (int bj = 0; bj < 2; ++bj)
#pragma unroll
                    for (int n = 0; n < 2; ++n) *(f32x4*)(rowp + bj * HALF + n * 16) = acc[ai][bj][m][n]; }
    }
};
struct EpiBf16R {
    static constexpr bool PERM = true, AFTER_DRAIN = false;
    bf16_t* O; int ldc; const float* rowbias;
    __device__ __forceinline__ void operator()(const f32x4 (&acc)[2][2][4][2], const Unit& u, int wr, int wc, int fr, int fq) const {
        const int row0 = u.pm * BM + wr * 64 + fr, col0 = u.pn * BM + wc * 32 + 8 * fq;
#pragma unroll
        for (int ai = 0; ai < 2; ++ai)
#pragma unroll
            for (int m = 0; m < 4; ++m) { const int row = row0 + ai * HALF + m * 16; bf16_t* rowp = O + (size_t)row * ldc + col0; const float rb = rowbias ? rowbias[row] : 0.f;
#pragma unroll
                for (int bj = 0; bj < 2; ++bj) { const f32x4 v0 = acc[ai][bj][m][0] + rb, v1 = acc[ai][bj][m][1] + rb;
                    u32x4 w; w.x = cvt_pk_bf16(v0[0], v0[1]); w.y = cvt_pk_bf16(v0[2], v0[3]); w.z = cvt_pk_bf16(v1[0], v1[1]); w.w = cvt_pk_bf16(v1[2], v1[3]);
                    *(u32x4*)(rowp + bj * HALF) = w; } }
    }
};
__device__ __forceinline__ f32x4 ld4(const float* p) { return *(const f32x4*)p; }
__device__ __forceinline__ f32x4 ld4(const bf16_t* p) { const u32x2 w = *(const u32x2*)p; f32x4 r; r[0] = __uint_as_float(w.x << 16); r[1] = __uint_as_float(w.x & 0xffff0000u); r[2] = __uint_as_float(w.y << 16); r[3] = __uint_as_float(w.y & 0xffff0000u); return r; }
__device__ __forceinline__ void st4(float* p, f32x4 v) { *(f32x4*)p = v; }
__device__ __forceinline__ void st4(bf16_t* p, f32x4 v) { u32x2 w; w.x = cvt_pk_bf16(v[0], v[1]); w.y = cvt_pk_bf16(v[2], v[3]); *(u32x2*)p = w; }
__device__ __forceinline__ f32x4 ldraw(const float* p) { return *(const f32x4*)p; }
__device__ __forceinline__ u32x2 ldraw(const bf16_t* p) { return *(const u32x2*)p; }
__device__ __forceinline__ f32x4 cvraw(f32x4 v) { return v; }
__device__ __forceinline__ f32x4 cvraw(u32x2 w) { f32x4 r; r[0] = __uint_as_float(w.x << 16); r[1] = __uint_as_float(w.x & 0xffff0000u); r[2] = __uint_as_float(w.y << 16); r[3] = __uint_as_float(w.y & 0xffff0000u); return r; }
template <class TB, class TO> struct EpiResGate {
    static constexpr bool PERM = false, AFTER_DRAIN = false;
    const TB* base; TO* out; const float* gate; int ldc;
    __device__ __forceinline__ void operator()(const f32x4 (&acc)[2][2][4][2], const Unit& u, int wr, int wc, int fr, int fq) const {
        const int row0 = u.pm * BM + wr * 64 + fr, col0 = u.pn * BM + wc * 32 + 4 * fq;
        const float* gp = gate + (size_t)(u.pm >> 4) * 6144 + col0;
        f32x4 gv[2][2];
#pragma unroll
        for (int bj = 0; bj < 2; ++bj)
#pragma unroll
            for (int n = 0; n < 2; ++n) gv[bj][n] = *(const f32x4*)(gp + bj * HALF + n * 16);
        constexpr int GB = sizeof(TB) == 2 ? 8 : 4;
        typedef decltype(ldraw(base)) raw_t;
#pragma unroll
        for (int g0 = 0; g0 < 8; g0 += GB) {
            raw_t bs[GB][2][2];
#pragma unroll
            for (int g = 0; g < GB; ++g) { const unsigned off = (unsigned)((row0 + ((g0 + g) >> 2) * HALF + ((g0 + g) & 3) * 16) * ldc + col0);
#pragma unroll
                for (int bj = 0; bj < 2; ++bj)
#pragma unroll
                    for (int n = 0; n < 2; ++n) bs[g][bj][n] = ldraw(base + off + bj * HALF + n * 16); }
#pragma unroll
            for (int g = 0; g < GB; ++g) { const int ai = (g0 + g) >> 2, m = (g0 + g) & 3; const unsigned off = (unsigned)((row0 + ai * HALF + m * 16) * ldc + col0);
#pragma unroll
                for (int bj = 0; bj < 2; ++bj)
#pragma unroll
                    for (int n = 0; n < 2; ++n) st4(out + off + bj * HALF + n * 16, cvraw(bs[g][bj][n]) + gv[bj][n] * acc[ai][bj][m][n]); }
            asm volatile("" ::: "memory"); }
    }
};
struct EpiLat {
    static constexpr bool PERM = false, AFTER_DRAIN = false;
    unsigned char* CQN  ; bf16_t* CKVN; unsigned char* KPE  ; const float* qag; const float* kvag; const float* kng; const float* rope; PG8_LAS float* P;
    __device__ __forceinline__ void operator()(const f32x4 (&acc)[2][2][4][2], const Unit& u, int wr, int wc, int, int) const {
        int ln = (int)__builtin_amdgcn_mbcnt_hi(~0u, __builtin_amdgcn_mbcnt_lo(~0u, 0u)); asm volatile("" : "+v"(ln)); const int fr = ln & 15, fq = ln >> 4;
        const int row0 = u.pm * BM + wr * 64 + fr;
#pragma unroll
        for (int ai = 0; ai < 2; ++ai)
#pragma unroll
            for (int m = 0; m < 4; ++m) { float s0 = 0.f, s1 = 0.f;
#pragma unroll
                for (int n = 0; n < 2; ++n) { const f32x4 a = acc[ai][0][m][n], b = acc[ai][1][m][n];
                    s0 += (a[0] * a[0] + a[1] * a[1]) + (a[2] * a[2] + a[3] * a[3]); s1 += (b[0] * b[0] + b[1] * b[1]) + (b[2] * b[2] + b[3] * b[3]); }
                s0 += __shfl_xor(s0, 16); s0 += __shfl_xor(s0, 32); s1 += __shfl_xor(s1, 16); s1 += __shfl_xor(s1, 32);
                if (fq == 0) { const int rl = ai * HALF + wr * 64 + m * 16 + fr; P[rl * 8 + wc] = s0; P[rl * 8 + 4 + wc] = s1; } }
        asm volatile("s_waitcnt lgkmcnt(0)" ::: "memory"); __builtin_amdgcn_s_barrier(); asm volatile("" ::: "memory");
        const int cl = wc * 32 + 4 * fq;
        if (u.pn == 0) {
            f32x4 g[2][2];
#pragma unroll
            for (int bj = 0; bj < 2; ++bj)
#pragma unroll
                for (int n = 0; n < 2; ++n) g[bj][n] = *(const f32x4*)(qag + bj * HALF + cl + 16 * n);
#pragma unroll
            for (int ai = 0; ai < 2; ++ai)
#pragma unroll
                for (int m = 0; m < 4; ++m) { const int rl = ai * HALF + wr * 64 + m * 16 + fr; const f32x4 pa = *(const PG8_LAS f32x4*)(P + rl * 8), pb = *(const PG8_LAS f32x4*)(P + rl * 8 + 4);
                    const float r = __builtin_amdgcn_rsqf((((pa[0] + pa[1]) + (pa[2] + pa[3])) + ((pb[0] + pb[1]) + (pb[2] + pb[3]))) * (1.f / 256.f) + 1e-6f);
                    unsigned char* rowp = CQN + (size_t)(row0 + ai * HALF + m * 16) * 256 + cl;
#pragma unroll
                    for (int bj = 0; bj < 2; ++bj)
#pragma unroll
                        for (int n = 0; n < 2; ++n) { const f32x4 v = acc[ai][bj][m][n] * r * g[bj][n]; int p = 0; p = __builtin_amdgcn_cvt_pk_fp8_f32(v[0], v[1], p, false); p = __builtin_amdgcn_cvt_pk_fp8_f32(v[2], v[3], p, true); *(int*)(rowp + bj * HALF + 16 * n) = p; } }
        } else {
            f32x4 gk[2], gp[2]; const int e0 = 16 * (wc & 1) + 4 * fq;
#pragma unroll
            for (int n = 0; n < 2; ++n) { gk[n] = *(const f32x4*)(kvag + cl + 16 * n); gp[n] = *(const f32x4*)(kng + 128 + e0 + 32 * n); }
#pragma unroll
            for (int ai = 0; ai < 2; ++ai)
#pragma unroll
                for (int m = 0; m < 4; ++m) { const int rl = ai * HALF + wr * 64 + m * 16 + fr; const f32x4 pa = *(const PG8_LAS f32x4*)(P + rl * 8), pb = *(const PG8_LAS f32x4*)(P + rl * 8 + 4);
                    const float rkv = __builtin_amdgcn_rsqf(((pa[0] + pa[1]) + (pa[2] + pa[3])) * (1.f / 128.f) + 1e-6f), rpe = __builtin_amdgcn_rsqf((pb[0] + pb[1]) * (1.f / 64.f) + 1e-6f);
                    const size_t row = (size_t)(row0 + ai * HALF + m * 16);
#pragma unroll
                    for (int n = 0; n < 2; ++n) { const f32x4 v = acc[ai][0][m][n] * rkv * gk[n]; u32x2 w; w.x = cvt_pk_bf16(v[0], v[1]); w.y = cvt_pk_bf16(v[2], v[3]); *(u32x2*)(CKVN + row * 128 + cl + 16 * n) = w; }
                    if (wc < 2) { const f32x4 x1 = acc[ai][1][m][0] * rpe * gp[0], x2 = acc[ai][1][m][1] * rpe * gp[1];
                        const f32x4 c0 = *(const f32x4*)(rope + row * 64 + e0 * 2), c1 = *(const f32x4*)(rope + row * 64 + e0 * 2 + 4);
                        const float cs[4] = {c0[0], c0[2], c1[0], c1[2]}, sn[4] = {c0[1], c0[3], c1[1], c1[3]};
                        float o1[4], o2[4];
#pragma unroll
                        for (int j = 0; j < 4; ++j) { o1[j] = x1[j] * cs[j] - x2[j] * sn[j]; o2[j] = x1[j] * sn[j] + x2[j] * cs[j]; }
                        int w1 = 0, w2 = 0; w1 = __builtin_amdgcn_cvt_pk_fp8_f32(o1[0], o1[1], w1, false); w1 = __builtin_amdgcn_cvt_pk_fp8_f32(o1[2], o1[3], w1, true); w2 = __builtin_amdgcn_cvt_pk_fp8_f32(o2[0], o2[1], w2, false); w2 = __builtin_amdgcn_cvt_pk_fp8_f32(o2[2], o2[3], w2, true);
                        *(int*)(KPE + row * 64 + e0) = w1; *(int*)(KPE + row * 64 + 32 + e0) = w2; }
                    asm volatile("" ::: "memory"); }
        }
        asm volatile("s_waitcnt lgkmcnt(0)" ::: "memory"); __builtin_amdgcn_s_barrier(); asm volatile("" ::: "memory");
    }
};
struct EpiK8 {
    static constexpr bool PERM = true, AFTER_DRAIN = false;
    unsigned char* K8; const float* kng; PG8_LAS float* P;
    __device__ __forceinline__ void operator()(const f32x4 (&acc)[2][2][4][2], const Unit& u, int wr, int wc, int, int) const {
        int ln = (int)__builtin_amdgcn_mbcnt_hi(~0u, __builtin_amdgcn_mbcnt_lo(~0u, 0u)); asm volatile("" : "+v"(ln)); const int fr = ln & 15, fq = ln >> 4;
#pragma unroll
        for (int ai = 0; ai < 2; ++ai)
#pragma unroll
            for (int m = 0; m < 4; ++m) {
#pragma unroll
                for (int bj = 0; bj < 2; ++bj) { const f32x4 a = acc[ai][bj][m][0], b = acc[ai][bj][m][1];
                    float s = (a[0] * a[0] + a[1] * a[1]) + (a[2] * a[2] + a[3] * a[3]) + (b[0] * b[0] + b[1] * b[1]) + (b[2] * b[2] + b[3] * b[3]);
                    s += __shfl_xor(s, 16); s += __shfl_xor(s, 32);
                    if (fq == 0) P[(ai * HALF + wr * 64 + m * 16 + fr) * 8 + bj * 4 + wc] = s; } }
        asm volatile("s_waitcnt lgkmcnt(0)" ::: "memory"); __builtin_amdgcn_s_barrier(); asm volatile("" ::: "memory");
        const f32x4 g0 = *(const f32x4*)(kng + wc * 32 + 8 * fq), g1 = *(const f32x4*)(kng + wc * 32 + 8 * fq + 4);
        const int row0 = u.pm * BM + wr * 64 + fr;
#pragma unroll
        for (int ai = 0; ai < 2; ++ai)
#pragma unroll
            for (int m = 0; m < 4; ++m) { const int rl = ai * HALF + wr * 64 + m * 16 + fr;
#pragma unroll
                for (int bj = 0; bj < 2; ++bj) { const f32x4 p4 = *(const PG8_LAS f32x4*)(P + rl * 8 + bj * 4);
                    const float r = __builtin_amdgcn_rsqf(((p4[0] + p4[1]) + (p4[2] + p4[3])) * (1.f / 128.f) + 1e-6f);
                    const f32x4 v0 = acc[ai][bj][m][0] * r * g0, v1 = acc[ai][bj][m][1] * r * g1;
                    int w0 = 0, w1 = 0; w0 = __builtin_amdgcn_cvt_pk_fp8_f32(v0[0], v0[1], w0, false); w0 = __builtin_amdgcn_cvt_pk_fp8_f32(v0[2], v0[3], w0, true); w1 = __builtin_amdgcn_cvt_pk_fp8_f32(v1[0], v1[1], w1, false); w1 = __builtin_amdgcn_cvt_pk_fp8_f32(v1[2], v1[3], w1, true);
                    u32x2 w; w.x = (unsigned)w0; w.y = (unsigned)w1; *(u32x2*)(K8 + ((size_t)(row0 + ai * HALF + m * 16) * 8 + 2 * u.pn + bj) * 128 + wc * 32 + 8 * fq) = w; } }
        asm volatile("s_waitcnt lgkmcnt(0)" ::: "memory"); __builtin_amdgcn_s_barrier(); asm volatile("" ::: "memory");
    }
};
struct EpiF8T {
    static constexpr bool PERM = true, AFTER_DRAIN = false;
    unsigned char* O; int ldc;
    __device__ __forceinline__ void operator()(const f32x4 (&acc)[2][2][4][2], const Unit& u, int wr, int wc, int fr, int fq) const {
        const int row0 = u.pm * BM + wr * 64 + fr, col0 = u.pn * BM + wc * 32 + 8 * fq;
#pragma unroll
        for (int ai = 0; ai < 2; ++ai)
#pragma unroll
            for (int m = 0; m < 4; ++m) { unsigned char* rowp = O + (size_t)(row0 + ai * HALF + m * 16) * ldc + col0;
#pragma unroll
                for (int bj = 0; bj < 2; ++bj) { const f32x4 v0 = acc[ai][bj][m][0], v1 = acc[ai][bj][m][1];
                    int w0 = 0, w1 = 0; w0 = __builtin_amdgcn_cvt_pk_fp8_f32(v0[0], v0[1], w0, false); w0 = __builtin_amdgcn_cvt_pk_fp8_f32(v0[2], v0[3], w0, true); w1 = __builtin_amdgcn_cvt_pk_fp8_f32(v1[0], v1[1], w1, false); w1 = __builtin_amdgcn_cvt_pk_fp8_f32(v1[2], v1[3], w1, true);
                    u32x2 w; w.x = (unsigned)w0; w.y = (unsigned)w1; *(u32x2*)(rowp + bj * HALF) = w; } }
    }
};
__device__ __forceinline__ void pair_of(int pi, int& i, int& j) { i = pi < 3 ? 0 : (pi < 5 ? 1 : 2); j = pi < 3 ? pi + 1 : (pi < 5 ? pi - 1 : 3); }
struct MoeOrder {
    const PG8_LAS int* tinfo; int G, c, mode; const int* list;
    __device__ __forceinline__ int tok(const Unit& u, int r) const { const int bk = tinfo[1 + u.pm], pos = u.pm * BM - tinfo[256 + bk] + r; return list[bk * 32768 + (pos < tinfo[288 + bk] ? pos : 0)]; }
    __device__ __forceinline__ bool next(int i, Unit& u) const {
        const long L = (long)i * G + c; const int nt = tinfo[0]; if (L >= 4L * nt) return false;
        const int mt = (int)(L >> 2), q = (int)(L & 3), bk = tinfo[1 + mt];
        u.pm = mt;
        if (mode == 0) { int ii, jj; pair_of(bk % 6, ii, jj); const int e = (bk / 6) * 4 + ((q >> 1) ? jj : ii); u.pn = e * 2 + (q & 1); }
        else u.pn = bk * 4 + q;
        return true;
    }
    __device__ __forceinline__ void a_ready(const Unit&) const {}
    __device__ __forceinline__ void done(const Unit&) const {}
};
struct EpiSwiGLU {
    static constexpr bool PERM = true, AFTER_DRAIN = false;
    bf16_t* H; const float* wl; const PG8_LAS int* tinfo;
    __device__ __forceinline__ void operator()(const f32x4 (&acc)[2][2][4][2], const Unit& u, int wr, int wc, int, int) const {
        int ln = (int)__builtin_amdgcn_mbcnt_hi(~0u, __builtin_amdgcn_mbcnt_lo(~0u, 0u)); asm volatile("" : "+v"(ln)); const int fr = ln & 15, fq = ln >> 4;
        const int bk = tinfo[1 + u.pm]; int ii, jj; pair_of(bk % 6, ii, jj);
        const int e = u.pn >> 1, hh = u.pn & 1, slot = (e == (bk / 6) * 4 + jj) ? 1 : 0;
        const int row0 = u.pm * BM + wr * 64 + fr, col0 = slot * 256 + hh * 128 + wc * 32 + 8 * fq;
        float w8[8];
#pragma unroll
        for (int g = 0; g < 8; ++g) { const int pos = row0 + (g >> 2) * HALF + (g & 3) * 16 - tinfo[256 + bk]; w8[g] = pos < tinfo[288 + bk] ? wl[((size_t)bk * 32768 + pos) * 2 + slot] : 0.f; }
#pragma unroll
        for (int ai = 0; ai < 2; ++ai)
#pragma unroll
            for (int m = 0; m < 4; ++m) { const int row = row0 + ai * HALF + m * 16; const float w = w8[ai * 4 + m];
                float a[8];
#pragma unroll
                for (int n = 0; n < 2; ++n)
#pragma unroll
                    for (int j = 0; j < 4; ++j) { const float g = acc[ai][0][m][n][j], up = acc[ai][1][m][n][j];
                        const float sg = g * __builtin_amdgcn_rcpf(1.0f + __builtin_amdgcn_exp2f(-1.4426950408889634f * g)); a[n * 4 + j] = sg * up * w; }
                u32x4 o; o.x = cvt_pk_bf16(a[0], a[1]); o.y = cvt_pk_bf16(a[2], a[3]); o.z = cvt_pk_bf16(a[4], a[5]); o.w = cvt_pk_bf16(a[6], a[7]);
                *(u32x4*)(H + (size_t)row * 512 + col0) = o; }
    }
};
template <class TO> struct EpiMoeOut {
    static constexpr bool PERM = false, AFTER_DRAIN = false;
    const bf16_t* xr; TO* out; const float* gate; const int* list; const PG8_LAS int* tinfo; PG8_LAS float* gl;
    __device__ __forceinline__ void operator()(const f32x4 (&acc)[2][2][4][2], const Unit& u, int wr, int wc, int fr, int fq) const {
        const int bk = tinfo[1 + u.pm], r_beg = tinfo[256 + bk], r_end = r_beg + tinfo[288 + bk];
        const int row0 = u.pm * BM + wr * 64 + fr, colu = (u.pn & 3) * BM, cl = wc * 32 + 4 * fq;
        int tk[8];
#pragma unroll
        for (int g = 0; g < 8; ++g) { const int row = row0 + (g >> 2) * HALF + (g & 3) * 16; tk[g] = row < r_end ? list[bk * 32768 + row - r_beg] : -1; }
        { const int t = (wr * 4 + wc) * 64 + fq * 16 + fr; const f32x4 gs = *(const f32x4*)(gate + (size_t)(t >> 6) * 6144 + colu + (t & 63) * 4);
          *(PG8_LAS f32x4*)(gl + (t >> 6) * 256 + (t & 63) * 4) = gs; }
        u32x2 bs[8][2][2];
#pragma unroll
        for (int g = 0; g < 8; ++g) { const unsigned xo = (unsigned)((tk[g] < 0 ? 0 : tk[g]) * 1024 + colu + cl);
#pragma unroll
            for (int bj = 0; bj < 2; ++bj)
#pragma unroll
                for (int n = 0; n < 2; ++n) bs[g][bj][n] = ldraw(xr + xo + bj * HALF + n * 16); }
        asm volatile("s_waitcnt lgkmcnt(0)" ::: "memory"); __builtin_amdgcn_s_barrier();
#pragma unroll
        for (int g = 0; g < 8; ++g) { const int ai = g >> 2, m = g & 3;
            if (tk[g] >= 0) { TO* op = out + (size_t)tk[g] * 1024 + colu + cl; const PG8_LAS float* gp = gl + (tk[g] >> 12) * 256 + cl;
#pragma unroll
                for (int bj = 0; bj < 2; ++bj)
#pragma unroll
                    for (int n = 0; n < 2; ++n) { const f32x4 gv = *(const PG8_LAS f32x4*)(gp + bj * HALF + n * 16); st4(op + bj * HALF + n * 16, cvraw(bs[g][bj][n]) + gv * acc[ai][bj][m][n]); } } }
    }
};
template <class Epi, class Sched, bool ALIGN_EPI = false, bool SP2 = false, int F8 = -1>
__device__ __forceinline__ void gemm_phase(PG8_LAS unsigned char* lds, const Gemm g, const Sched& S, const Epi& E, const int tid_in) {
    int tid = tid_in; asm volatile("" : "+v"(tid));
    const int wid = __builtin_amdgcn_readfirstlane(tid >> 6), lane = tid & 63, wr = wid >> 2, wc = wid & 3, fr = lane & 15, fq = lane >> 4;
    int K = g.K; asm volatile("" : "+s"(K)); const int nt = K / BK;
    unsigned voffA[2], voffB[2];
#pragma unroll
    for (int i = 0; i < 2; ++i) { int R, C; stage_rc(tid * 16 + i * 8192, R, C); const int Rb = Epi::PERM ? ((R & ~31) + perm32(R & 31)) : R;
        voffA[i] = (unsigned)(R * K + C) * 2u; voffB[i] = (unsigned)(Rb * K + C) * 2u; }
    const size_t kstep = (size_t)(BK * 2);
    const size_t hstep = (size_t)HALF * K * 2;
    const size_t tstep = 2 * hstep;
    const unsigned ldsw = (unsigned)wid * 1024u;
    const int aoff = lds_byte(wr * 64 + fr, fq * 8), boff = lds_byte(wc * 32 + fr, fq * 8);
#define PG8_SA(b, h) (((b) * 2 + (h)) * HTB)
#define PG8_SB(b, h) ((4 + (b) * 2 + (h)) * HTB)
#define PG8_STAGE(bufoff, gbase, voff) do { _Pragma("unroll") for (int _i = 0; _i < 2; ++_i) { unsigned vo_ = (voff)[_i]; asm volatile("" : "+v"(vo_));   \
        __builtin_amdgcn_global_load_lds((const unsigned*)((const char*)(gbase) + vo_), (PG8_LAS unsigned*)(lds + (bufoff) + ldsw + _i * 8192), 16, 0, 0); } } while (0)
#define PG8_LDA(dst, b, h) do { _Pragma("unroll") for (int m = 0; m < 4; ++m) { const bf16x8 x0_ = *(const PG8_LAS bf16x8*)(lds + PG8_SA(b, h) + aoff + m * 2048), x1_ = *(const PG8_LAS bf16x8*)(lds + PG8_SA(b, h) + aoff + m * 2048 + 1024); \
        if constexpr (F8 >= 0) dst##8[m] = PG8_CAT(x0_, x1_); else { dst[m][0] = x0_; dst[m][1] = x1_; } } } while (0)
#define PG8_LDB(dst, b, h) do { _Pragma("unroll") for (int n = 0; n < 2; ++n) { const bf16x8 x0_ = *(const PG8_LAS bf16x8*)(lds + PG8_SB(b, h) + boff + n * 2048), x1_ = *(const PG8_LAS bf16x8*)(lds + PG8_SB(b, h) + boff + n * 2048 + 1024); \
        if constexpr (F8 >= 0) dst##8[n] = PG8_CAT(x0_, x1_); else { dst[n][0] = x0_; dst[n][1] = x1_; } } } while (0)
#define PG8_CAT(x0, x1) ({ const v4i_t lo_ = __builtin_bit_cast(v4i_t, x0), hi_ = __builtin_bit_cast(v4i_t, x1); (v8i_t){lo_[0], lo_[1], lo_[2], lo_[3], hi_[0], hi_[1], hi_[2], hi_[3]}; })
#define PG8_MMA(ai, bj, At, Bt) do { __builtin_amdgcn_s_setprio(1); _Pragma("unroll") for (int m = 0; m < 4; ++m) _Pragma("unroll") for (int n = 0; n < 2; ++n) { \
        if constexpr (F8 >= 0) acc[ai][bj][m][n] = __builtin_amdgcn_mfma_scale_f32_16x16x128_f8f6f4(Bt##8[n], At##8[m], acc[ai][bj][m][n], 0, 0, 0, 0x7f7f7f7f, 0, (127 - F8) * 0x01010101); \
        else { _Pragma("unroll") for (int k = 0; k < 2; ++k) acc[ai][bj][m][n] = __builtin_amdgcn_mfma_f32_16x16x32_bf16(Bt[n][k], At[m][k], acc[ai][bj][m][n], 0, 0, 0); } } \
        __builtin_amdgcn_s_setprio(0); } while (0)
#define PG8_WAIT_V(n) asm volatile("s_waitcnt vmcnt(" #n ")" ::: "memory")
#define PG8_WAIT_L(n) asm volatile("s_waitcnt lgkmcnt(" #n ")" ::: "memory")
#define PG8_BAR __builtin_amdgcn_s_barrier()
#define PG8_SCHED __builtin_amdgcn_sched_barrier(0)
    Unit cur, nxt; int ui = 0;
    if (!S.next(0, cur)) return;
    f32x4 acc[2][2][4][2];
#pragma unroll
    for (int a = 0; a < 2; ++a)
#pragma unroll
        for (int b = 0; b < 2; ++b)
#pragma unroll
            for (int m = 0; m < 4; ++m)
#pragma unroll
                for (int n = 0; n < 2; ++n) acc[a][b][m][n] = (f32x4){0.f, 0.f, 0.f, 0.f};
    bf16x8 At[4][2], B0[2][2], B1[2][2]; v8i_t At8[4], B08[2], B18[2];
    const char* cA = (const char*)g.A + (size_t)cur.pm * tstep; const char* cB = (const char*)g.Bt + (size_t)cur.pn * tstep;
    S.a_ready(cur);
    if constexpr (SP2) {
        PG8_STAGE(PG8_SB(0, 0), cB, voffB); PG8_STAGE(PG8_SB(0, 1), cB + hstep, voffB); PG8_STAGE(PG8_SA(0, 0), cA, voffA); PG8_STAGE(PG8_SA(0, 1), cA + hstep, voffA);
        if (wr == 1) PG8_BAR;
        PG8_WAIT_V(2); PG8_BAR;
        PG8_STAGE(PG8_SB(1, 0), cB + kstep, voffB); PG8_STAGE(PG8_SA(1, 0), cA + kstep, voffA); PG8_STAGE(PG8_SB(1, 1), cB + hstep + kstep, voffB);
        PG8_WAIT_V(6); PG8_BAR;
    } else {
        PG8_STAGE(PG8_SB(0, 0), cB, voffB); PG8_STAGE(PG8_SA(0, 0), cA, voffA); PG8_STAGE(PG8_SB(0, 1), cB + hstep, voffB); PG8_STAGE(PG8_SA(0, 1), cA + hstep, voffA);
        if (wr == 1) PG8_BAR;
        PG8_WAIT_V(4); PG8_BAR;
        PG8_STAGE(PG8_SB(1, 0), cB + kstep, voffB); PG8_STAGE(PG8_SA(1, 0), cA + kstep, voffA); PG8_STAGE(PG8_SB(1, 1), cB + hstep + kstep, voffB);
        PG8_WAIT_V(6); PG8_BAR;
    }
    for (;;) {
        const bool has_next = S.next(ui + 1, nxt);
        const char* nA = has_next ? (const char*)g.A + (size_t)nxt.pm * tstep : cA; const char* nB = has_next ? (const char*)g.Bt + (size_t)nxt.pn * tstep : cB;
        for (int t = 0; t < nt; t += 2) {
            const bool last = (t == nt - 2);
            const char* a1 = cA + (size_t)(t + 1) * kstep;
            const char* a2 = last ? nA : cA + (size_t)(t + 2) * kstep; const char* b2 = last ? nB : cB + (size_t)(t + 2) * kstep;
            const char* a3 = a2 + kstep; const char* b3 = b2 + kstep;
            if (last && has_next) S.a_ready(nxt);
            if constexpr (SP2) {
            PG8_LDB(B0, 0, 0); PG8_LDB(B1, 0, 1); PG8_SCHED; PG8_LDA(At, 0, 0); PG8_STAGE(PG8_SA(1, 1), a1 + hstep, voffA);
            PG8_WAIT_V(8); PG8_WAIT_L(0); PG8_BAR; PG8_MMA(0, 0, At, B0); PG8_MMA(0, 1, At, B1); PG8_BAR; PG8_SCHED;
            PG8_LDA(At, 0, 1); PG8_STAGE(PG8_SB(0, 0), b2, voffB); PG8_STAGE(PG8_SB(0, 1), b2 + hstep, voffB); PG8_STAGE(PG8_SA(0, 0), a2, voffA);
            PG8_WAIT_V(8); PG8_WAIT_L(0); PG8_BAR; PG8_MMA(1, 0, At, B0); PG8_MMA(1, 1, At, B1); PG8_BAR; PG8_SCHED;
            PG8_LDB(B0, 1, 0); PG8_LDB(B1, 1, 1); PG8_SCHED; PG8_LDA(At, 1, 0); PG8_STAGE(PG8_SA(0, 1), a2 + hstep, voffA);
            PG8_WAIT_V(8); PG8_WAIT_L(0); PG8_BAR; PG8_MMA(0, 0, At, B0); PG8_MMA(0, 1, At, B1); PG8_BAR; PG8_SCHED;
            PG8_LDA(At, 1, 1); PG8_STAGE(PG8_SB(1, 0), b3, voffB); PG8_STAGE(PG8_SB(1, 1), b3 + hstep, voffB); PG8_STAGE(PG8_SA(1, 0), a3, voffA);
            PG8_WAIT_V(8); PG8_WAIT_L(0); PG8_BAR; PG8_MMA(1, 0, At, B0); PG8_MMA(1, 1, At, B1); PG8_BAR; PG8_SCHED;
            } else {
            PG8_LDB(B0, 0, 0); PG8_SCHED; PG8_LDA(At, 0, 0); PG8_STAGE(PG8_SA(1, 1), a1 + hstep, voffA);
            PG8_WAIT_L(8); PG8_BAR; PG8_WAIT_L(0); PG8_MMA(0, 0, At, B0); PG8_BAR; PG8_SCHED;
            PG8_LDB(B1, 0, 1); PG8_STAGE(PG8_SB(0, 0), b2, voffB);
            PG8_BAR; PG8_WAIT_L(0); PG8_MMA(0, 1, At, B1); PG8_BAR;
            PG8_LDA(At, 0, 1); PG8_STAGE(PG8_SA(0, 0), a2, voffA);
            PG8_BAR; PG8_WAIT_L(0); PG8_MMA(1, 0, At, B0); PG8_BAR; PG8_SCHED;
            PG8_STAGE(PG8_SB(0, 1), b2 + hstep, voffB);
            PG8_WAIT_V(6); PG8_BAR; PG8_MMA(1, 1, At, B1); PG8_BAR;
            PG8_LDB(B0, 1, 0); PG8_SCHED; PG8_LDA(At, 1, 0); PG8_STAGE(PG8_SA(0, 1), a2 + hstep, voffA);
            PG8_WAIT_L(8); PG8_BAR; PG8_WAIT_L(0); PG8_MMA(0, 0, At, B0); PG8_BAR; PG8_SCHED;
            PG8_LDB(B1, 1, 1); PG8_STAGE(PG8_SB(1, 0), b3, voffB);
            PG8_BAR; PG8_WAIT_L(0); PG8_MMA(0, 1, At, B1); PG8_BAR;
            PG8_LDA(At, 1, 1); PG8_STAGE(PG8_SA(1, 0), a3, voffA);
            PG8_BAR; PG8_WAIT_L(0); PG8_MMA(1, 0, At, B0); PG8_BAR; PG8_SCHED;
            PG8_STAGE(PG8_SB(1, 1), b3 + hstep, voffB);
            PG8_WAIT_V(6); PG8_BAR; PG8_MMA(1, 1, At, B1); PG8_BAR;
            }
        }
        if constexpr (ALIGN_EPI) { if (wr == 0) PG8_BAR; }
        if constexpr (!Epi::AFTER_DRAIN) { E(acc, cur, wr, wc, fr, fq); S.done(cur); }
        if (!has_next) break;
#pragma unroll
        for (int a = 0; a < 2; ++a)
#pragma unroll
            for (int b = 0; b < 2; ++b)
#pragma unroll
                for (int m = 0; m < 4; ++m)
#pragma unroll
                    for (int n = 0; n < 2; ++n) acc[a][b][m][n] = (f32x4){0.f, 0.f, 0.f, 0.f};
        cur = nxt; cA = nA; cB = nB; ++ui;
        if constexpr (ALIGN_EPI) { if (wr == 1) PG8_BAR; }
    }
    PG8_WAIT_V(0);
    if constexpr (!ALIGN_EPI) { if (wr == 0) PG8_BAR; }
    PG8_BAR;
    if constexpr (Epi::AFTER_DRAIN) { E.fused(acc, cur, wr, wc, fr, fq, lds, wid, lane); S.done(cur); }
#undef PG8_SA
#undef PG8_SB
#undef PG8_STAGE
#undef PG8_LDA
#undef PG8_LDB
#undef PG8_MMA
#undef PG8_WAIT_V
#undef PG8_WAIT_L
#undef PG8_BAR
#undef PG8_SCHED
}
template <class Epi, class Sched, bool ALIGN_EPI = true, bool SP2 = true, int F8 = -1>
__device__ __forceinline__ void gemm_phase_gather(PG8_LAS unsigned char* lds, const Gemm g, const Sched& S, const Epi& E, const int tid_in) {
    int tid = tid_in; asm volatile("" : "+v"(tid));
    static_assert(SP2, "gather form: SP2 loop only");
    const int wid = __builtin_amdgcn_readfirstlane(tid >> 6), lane = tid & 63, wr = wid >> 2, wc = wid & 3, fr = lane & 15, fq = lane >> 4;
    int K = g.K; asm volatile("" : "+s"(K)); const int nt = K / BK;
    unsigned voffA[2], voffB[2];
#pragma unroll
    for (int i = 0; i < 2; ++i) { int R, C; stage_rc(tid * 16 + i * 8192, R, C); const int Rb = Epi::PERM ? ((R & ~31) + perm32(R & 31)) : R;
        voffA[i] = (unsigned)(R * K + C) * 2u; voffB[i] = (unsigned)(Rb * K + C) * 2u; }
    int gR, gC; stage_rc(tid * 16, gR, gC);
    unsigned vG[2][2], vN[2][2];
    const size_t kstep = (size_t)(BK * 2);
    const size_t hstep = (size_t)HALF * K * 2;
    const size_t tstep = 2 * hstep;
    const unsigned ldsw = (unsigned)wid * 1024u;
    const int aoff = lds_byte(wr * 64 + fr, fq * 8), boff = lds_byte(wc * 32 + fr, fq * 8);
#define PG8_SA(b, h) (((b) * 2 + (h)) * HTB)
#define PG8_SB(b, h) ((4 + (b) * 2 + (h)) * HTB)
#define PG8_STAGE(bufoff, gbase, voff) do { _Pragma("unroll") for (int _i = 0; _i < 2; ++_i) { unsigned vo_ = (voff)[_i]; asm volatile("" : "+v"(vo_));   \
        __builtin_amdgcn_global_load_lds((const unsigned*)((const char*)(gbase) + vo_), (PG8_LAS unsigned*)(lds + (bufoff) + ldsw + _i * 8192), 16, 0, 0); } } while (0)
#define PG8_LDA(dst, b, h) do { _Pragma("unroll") for (int m = 0; m < 4; ++m) { const bf16x8 x0_ = *(const PG8_LAS bf16x8*)(lds + PG8_SA(b, h) + aoff + m * 2048), x1_ = *(const PG8_LAS bf16x8*)(lds + PG8_SA(b, h) + aoff + m * 2048 + 1024); \
        if constexpr (F8 >= 0) dst##8[m] = PG8_CAT(x0_, x1_); else { dst[m][0] = x0_; dst[m][1] = x1_; } } } while (0)
#define PG8_LDB(dst, b, h) do { _Pragma("unroll") for (int n = 0; n < 2; ++n) { const bf16x8 x0_ = *(const PG8_LAS bf16x8*)(lds + PG8_SB(b, h) + boff + n * 2048), x1_ = *(const PG8_LAS bf16x8*)(lds + PG8_SB(b, h) + boff + n * 2048 + 1024); \
        if constexpr (F8 >= 0) dst##8[n] = PG8_CAT(x0_, x1_); else { dst[n][0] = x0_; dst[n][1] = x1_; } } } while (0)
#define PG8_CAT(x0, x1) ({ const v4i_t lo_ = __builtin_bit_cast(v4i_t, x0), hi_ = __builtin_bit_cast(v4i_t, x1); (v8i_t){lo_[0], lo_[1], lo_[2], lo_[3], hi_[0], hi_[1], hi_[2], hi_[3]}; })
#define PG8_MMA(ai, bj, At, Bt) do { __builtin_amdgcn_s_setprio(1); _Pragma("unroll") for (int m = 0; m < 4; ++m) _Pragma("unroll") for (int n = 0; n < 2; ++n) { \
        if constexpr (F8 >= 0) acc[ai][bj][m][n] = __builtin_amdgcn_mfma_scale_f32_16x16x128_f8f6f4(Bt##8[n], At##8[m], acc[ai][bj][m][n], 0, 0, 0, 0x7f7f7f7f, 0, (127 - F8) * 0x01010101); \
        else { _Pragma("unroll") for (int k = 0; k < 2; ++k) acc[ai][bj][m][n] = __builtin_amdgcn_mfma_f32_16x16x32_bf16(Bt[n][k], At[m][k], acc[ai][bj][m][n], 0, 0, 0); } } \
        __builtin_amdgcn_s_setprio(0); } while (0)
#define PG8_WAIT_V(n) asm volatile("s_waitcnt vmcnt(" #n ")" ::: "memory")
#define PG8_WAIT_L(n) asm volatile("s_waitcnt lgkmcnt(" #n ")" ::: "memory")
#define PG8_BAR __builtin_amdgcn_s_barrier()
#define PG8_SCHED __builtin_amdgcn_sched_barrier(0)
    Unit cur, nxt; int ui = 0;
    if (!S.next(0, cur)) return;
    f32x4 acc[2][2][4][2];
#pragma unroll
    for (int a = 0; a < 2; ++a)
#pragma unroll
        for (int b = 0; b < 2; ++b)
#pragma unroll
            for (int m = 0; m < 4; ++m)
#pragma unroll
                for (int n = 0; n < 2; ++n) acc[a][b][m][n] = (f32x4){0.f, 0.f, 0.f, 0.f};
    bf16x8 At[4][2], B0[2][2], B1[2][2]; v8i_t At8[4], B08[2], B18[2];
    const char* cA = (const char*)g.A; const char* cB = (const char*)g.Bt + (size_t)cur.pn * tstep;
    S.a_ready(cur);
#pragma unroll
    for (int h = 0; h < 2; ++h)
#pragma unroll
        for (int i = 0; i < 2; ++i) vG[h][i] = (unsigned)S.tok(cur, h * HALF + gR + 64 * i) * (unsigned)(K * 2) + (unsigned)(gC * 2);
    if constexpr (SP2) {
        PG8_STAGE(PG8_SB(0, 0), cB, voffB); PG8_STAGE(PG8_SB(0, 1), cB + hstep, voffB); PG8_STAGE(PG8_SA(0, 0), cA, vG[0]); PG8_STAGE(PG8_SA(0, 1), cA, vG[1]);
        if (wr == 1) PG8_BAR;
        PG8_WAIT_V(2); PG8_BAR;
        PG8_STAGE(PG8_SB(1, 0), cB + kstep, voffB); PG8_STAGE(PG8_SA(1, 0), cA + kstep, vG[0]); PG8_STAGE(PG8_SB(1, 1), cB + hstep + kstep, voffB);
        PG8_WAIT_V(6); PG8_BAR;
    } else {
        PG8_STAGE(PG8_SB(0, 0), cB, voffB); PG8_STAGE(PG8_SA(0, 0), cA, voffA); PG8_STAGE(PG8_SB(0, 1), cB + hstep, voffB); PG8_STAGE(PG8_SA(0, 1), cA + hstep, voffA);
        if (wr == 1) PG8_BAR;
        PG8_WAIT_V(4); PG8_BAR;
        PG8_STAGE(PG8_SB(1, 0), cB + kstep, voffB); PG8_STAGE(PG8_SA(1, 0), cA + kstep, voffA); PG8_STAGE(PG8_SB(1, 1), cB + hstep + kstep, voffB);
        PG8_WAIT_V(6); PG8_BAR;
    }
    for (;;) {
        const bool has_next = S.next(ui + 1, nxt);
        const char* nA = cA; const char* nB = has_next ? (const char*)g.Bt + (size_t)nxt.pn * tstep : cB;
        for (int t = 0; t < nt; t += 2) {
            const bool last = (t == nt - 2);
            const char* a1 = cA + (size_t)(t + 1) * kstep;
            const char* a2 = last ? nA : cA + (size_t)(t + 2) * kstep; const char* b2 = last ? nB : cB + (size_t)(t + 2) * kstep;
            const char* a3 = a2 + kstep; const char* b3 = b2 + kstep;
            if (last && has_next) { S.a_ready(nxt);
#pragma unroll
                for (int h = 0; h < 2; ++h)
#pragma unroll
                    for (int i = 0; i < 2; ++i) vN[h][i] = (unsigned)S.tok(nxt, h * HALF + gR + 64 * i) * (unsigned)(K * 2) + (unsigned)(gC * 2); }
            if constexpr (SP2) {
            PG8_LDB(B0, 0, 0); PG8_LDB(B1, 0, 1); PG8_SCHED; PG8_LDA(At, 0, 0); PG8_STAGE(PG8_SA(1, 1), a1, vG[1]);
            if (last && has_next) { vG[0][0] = vN[0][0]; vG[0][1] = vN[0][1]; vG[1][0] = vN[1][0]; vG[1][1] = vN[1][1]; }
            PG8_WAIT_V(8); PG8_WAIT_L(0); PG8_BAR; PG8_MMA(0, 0, At, B0); PG8_MMA(0, 1, At, B1); PG8_BAR; PG8_SCHED;
            PG8_LDA(At, 0, 1); PG8_STAGE(PG8_SB(0, 0), b2, voffB); PG8_STAGE(PG8_SB(0, 1), b2 + hstep, voffB); PG8_STAGE(PG8_SA(0, 0), a2, vG[0]);
            PG8_WAIT_V(8); PG8_WAIT_L(0); PG8_BAR; PG8_MMA(1, 0, At, B0); PG8_MMA(1, 1, At, B1); PG8_BAR; PG8_SCHED;
            PG8_LDB(B0, 1, 0); PG8_LDB(B1, 1, 1); PG8_SCHED; PG8_LDA(At, 1, 0); PG8_STAGE(PG8_SA(0, 1), a2, vG[1]);
            PG8_WAIT_V(8); PG8_WAIT_L(0); PG8_BAR; PG8_MMA(0, 0, At, B0); PG8_MMA(0, 1, At, B1); PG8_BAR; PG8_SCHED;
            PG8_LDA(At, 1, 1); PG8_STAGE(PG8_SB(1, 0), b3, voffB); PG8_STAGE(PG8_SB(1, 1), b3 + hstep, voffB); PG8_STAGE(PG8_SA(1, 0), a3, vG[0]);
            PG8_WAIT_V(8); PG8_WAIT_L(0); PG8_BAR; PG8_MMA(1, 0, At, B0); PG8_MMA(1, 1, At, B1); PG8_BAR; PG8_SCHED;
            } else {
            PG8_LDB(B0, 0, 0); PG8_SCHED; PG8_LDA(At, 0, 0); PG8_STAGE(PG8_SA(1, 1), a1 + hstep, voffA);
            PG8_WAIT_L(8); PG8_BAR; PG8_WAIT_L(0); PG8_MMA(0, 0, At, B0); PG8_BAR; PG8_SCHED;
            PG8_LDB(B1, 0, 1); PG8_STAGE(PG8_SB(0, 0), b2, voffB);
            PG8_BAR; PG8_WAIT_L(0); PG8_MMA(0, 1, At, B1); PG8_BAR;
            PG8_LDA(At, 0, 1); PG8_STAGE(PG8_SA(0, 0), a2, voffA);
            PG8_BAR; PG8_WAIT_L(0); PG8_MMA(1, 0, At, B0); PG8_BAR; PG8_SCHED;
            PG8_STAGE(PG8_SB(0, 1), b2 + hstep, voffB);
            PG8_WAIT_V(6); PG8_BAR; PG8_MMA(1, 1, At, B1); PG8_BAR;
            PG8_LDB(B0, 1, 0); PG8_SCHED; PG8_LDA(At, 1, 0); PG8_STAGE(PG8_SA(0, 1), a2 + hstep, voffA);
            PG8_WAIT_L(8); PG8_BAR; PG8_WAIT_L(0); PG8_MMA(0, 0, At, B0); PG8_BAR; PG8_SCHED;
            PG8_LDB(B1, 1, 1); PG8_STAGE(PG8_SB(1, 0), b3, voffB);
            PG8_BAR; PG8_WAIT_L(0); PG8_MMA(0, 1, At, B1); PG8_BAR;
            PG8_LDA(At, 1, 1); PG8_STAGE(PG8_SA(1, 0), a3, voffA);
            PG8_BAR; PG8_WAIT_L(0); PG8_MMA(1, 0, At, B0); PG8_BAR; PG8_SCHED;
            PG8_STAGE(PG8_SB(1, 1), b3 + hstep, voffB);
            PG8_WAIT_V(6); PG8_BAR; PG8_MMA(1, 1, At, B1); PG8_BAR;
            }
        }
        if constexpr (ALIGN_EPI) { if (wr == 0) PG8_BAR; }
        if constexpr (!Epi::AFTER_DRAIN) { E(acc, cur, wr, wc, fr, fq); S.done(cur); }
        if (!has_next) break;
#pragma unroll
        for (int a = 0; a < 2; ++a)
#pragma unroll
            for (int b = 0; b < 2; ++b)
#pragma unroll
                for (int m = 0; m < 4; ++m)
#pragma unroll
                    for (int n = 0; n < 2; ++n) acc[a][b][m][n] = (f32x4){0.f, 0.f, 0.f, 0.f};
        cur = nxt; cA = nA; cB = nB; ++ui;
        if constexpr (ALIGN_EPI) { if (wr == 1) PG8_BAR; }
    }
    PG8_WAIT_V(0);
    if constexpr (!ALIGN_EPI) { if (wr == 0) PG8_BAR; }
    PG8_BAR;
    if constexpr (Epi::AFTER_DRAIN) { E.fused(acc, cur, wr, wc, fr, fq, lds, wid, lane); S.done(cur); }
#undef PG8_SA
#undef PG8_SB
#undef PG8_STAGE
#undef PG8_LDA
#undef PG8_LDB
#undef PG8_MMA
#undef PG8_WAIT_V
#undef PG8_WAIT_L
#undef PG8_BAR
#undef PG8_SCHED
}
}
namespace att {
typedef unsigned short bf16;
using bf16x8 = __attribute__((ext_vector_type(8))) short;
using s16x4  = __attribute__((ext_vector_type(4))) short;
using f32x16 = __attribute__((ext_vector_type(16))) float;
using u32x4  = __attribute__((ext_vector_type(4))) unsigned;
using f32x4_t = __attribute__((ext_vector_type(4))) float;
constexpr int NW = 8, QBLK = 32, KVBLK = 64, SEQ = 4096;
constexpr int LDQ = 1536, LDKV = 2048, LDO = 1024;
constexpr int SHM_VT = 128 * 80, SHM_K8 = 64 * 208;
constexpr int OFF_V = 0, OFF_K8 = 3 * SHM_VT, OFF_WS = OFF_K8 + 2 * SHM_K8, LDS_BYTES = OFF_WS + NW * 64 * 4 + 64;
typedef int v8i32 __attribute__((ext_vector_type(8)));
typedef int v4i32 __attribute__((ext_vector_type(4)));
typedef int v2i32 __attribute__((ext_vector_type(2)));
constexpr int T_TOK = 8 * SEQ;
#define ASBAR() __builtin_amdgcn_sched_barrier(0)
__device__ __forceinline__ int crow(int r, int hi) { return (r & 3) + 8 * (r >> 2) + 4 * hi; }
__device__ __forceinline__ unsigned cvtpk(float lo, float hi) { unsigned r; asm volatile("v_cvt_pk_bf16_f32 %0, %1, %2" : "=v"(r) : "v"(lo), "v"(hi)); return r; }
__device__ __forceinline__ float bf2f(unsigned short b) { return __uint_as_float(((unsigned)b) << 16); }
template <bool SHIFT> __device__ __forceinline__ void smA(f32x16& p0, float negm) { for (int r = 0; r < 16; ++r) p0[r] = __builtin_amdgcn_exp2f(SHIFT ? p0[r] + negm : p0[r]); }
template <bool SHIFT> __device__ __forceinline__ void smB(f32x16& p0, f32x16& p1, float& l_reg, v8i32& p8, float negm) {
  for (int r = 0; r < 16; ++r) p1[r] = __builtin_amdgcn_exp2f(SHIFT ? p1[r] + negm : p1[r]);
  float ps = 0; for (int r = 0; r < 16; ++r) ps += p0[r]; for (int r = 0; r < 16; ++r) ps += p1[r];
  l_reg += ps;
#pragma unroll
  for (int w = 0; w < 4; ++w) { int a = 0, bq = 0;
    a = __builtin_amdgcn_cvt_pk_bf8_f32(p0[4 * w], p0[4 * w + 1], a, false); a = __builtin_amdgcn_cvt_pk_bf8_f32(p0[4 * w + 2], p0[4 * w + 3], a, true);
    bq = __builtin_amdgcn_cvt_pk_bf8_f32(p1[4 * w], p1[4 * w + 1], bq, false); bq = __builtin_amdgcn_cvt_pk_bf8_f32(p1[4 * w + 2], p1[4 * w + 3], bq, true);
    p8[w] = a; p8[4 + w] = bq; }
}
template <bool SHIFT> __device__ __forceinline__ void qkt(f32x16& p0, f32x16& p1, const char* K8, const v8i32* q8, float negm, int r32, int hi) {
  p0 = f32x16{}; p1 = f32x16{};
#define K8RD(m, half, part) (*reinterpret_cast<const v4i32*>(K8 + ((half) * 32 + r32) * 208 + (m) * 64 + hi * 32 + (part) * 16))
#define K8FR(m, half) ({ const v4i32 lo_ = K8RD(m, half, 0), hi_ = K8RD(m, half, 1); (v8i32){lo_[0], lo_[1], lo_[2], lo_[3], hi_[0], hi_[1], hi_[2], hi_[3]}; })
  v8i32 a0 = K8FR(0, 0), a1 = K8FR(0, 1), b0 = K8FR(1, 0), b1 = K8FR(1, 1);
  ASBAR();
  p0 = __builtin_amdgcn_mfma_scale_f32_32x32x64_f8f6f4(a0, q8[0], p0, 0, 0, 0, 0x7f7f7f7f, 0, 0x7f7f7f7f);
  p1 = __builtin_amdgcn_mfma_scale_f32_32x32x64_f8f6f4(a1, q8[0], p1, 0, 0, 0, 0x7f7f7f7f, 0, 0x7f7f7f7f);
  a0 = K8FR(2, 0); a1 = K8FR(2, 1);
  ASBAR();
  p0 = __builtin_amdgcn_mfma_scale_f32_32x32x64_f8f6f4(b0, q8[1], p0, 0, 0, 0, 0x7f7f7f7f, 0, 0x7f7f7f7f);
  p1 = __builtin_amdgcn_mfma_scale_f32_32x32x64_f8f6f4(b1, q8[1], p1, 0, 0, 0, 0x7f7f7f7f, 0, 0x7f7f7f7f);
  ASBAR();
  p0 = __builtin_amdgcn_mfma_scale_f32_32x32x64_f8f6f4(a0, q8[2], p0, 0, 0, 0, 0x7f7f7f7f, 0, 0x7f7f7f7f);
  p1 = __builtin_amdgcn_mfma_scale_f32_32x32x64_f8f6f4(a1, q8[2], p1, 0, 0, 0, 0x7f7f7f7f, 0, 0x7f7f7f7f);
  ASBAR();
#undef K8RD
#undef K8FR
}
__device__ __forceinline__ void pv_d0(f32x16* o, const char* VT, v8i32 p8, int r32, int hi) {
#define VTFR(d0) ({ const v4i32 lo_ = *reinterpret_cast<const v4i32*>(VT + ((d0) * 32 + r32) * 80 + hi * 32), hi_ = *reinterpret_cast<const v4i32*>(VT + ((d0) * 32 + r32) * 80 + hi * 32 + 16); (v8i32){lo_[0], lo_[1], lo_[2], lo_[3], hi_[0], hi_[1], hi_[2], hi_[3]}; })
#define PVMMA(d0, fr) o[d0] = __builtin_amdgcn_mfma_scale_f32_32x32x64_f8f6f4(p8, fr, o[d0], 1  , 0  , 0, 0x7f7f7f7f, 0, 0x7f7f7f7f)
  v8i32 fa = VTFR(0), fb = VTFR(1);
  ASBAR();
  PVMMA(0, fa); fa = VTFR(2); ASBAR();
  PVMMA(1, fb); fb = VTFR(3); ASBAR();
  PVMMA(2, fa); PVMMA(3, fb); ASBAR();
#undef VTFR
#undef PVMMA
}
template <bool SHIFT> __device__ __forceinline__ bool attn_unit(int b, int h, int s0, const bf16* Qraw, const unsigned char* __restrict__ VT8g, const unsigned char* __restrict__ K8g, const unsigned char* __restrict__ KP8g, bf16* __restrict__ O,
                                          const float* rope, const float* qg, float smaxC, char* lds, int tid) {
  asm volatile("" : "+v"(tid));
  const int wid = __builtin_amdgcn_readfirstlane(tid >> 6), lane = tid & 63, r32 = lane & 31, hi = lane >> 5;
  asm volatile("" : "+s"(qg));
  char* V_lds = lds + OFF_V; char* K8_lds = lds + OFF_K8;
  float* ws = (float*)(lds + OFF_WS) + wid * 64; float* li_l = ws;
  constexpr float C = 0.072168783648703220f * 1.4426950408889634f;
  v8i32 q8[3];
  {
    typedef __attribute__((address_space(1))) const bf16x8 gbf16x8; typedef __attribute__((address_space(1))) const f32x4_t gf32x4;
    const long trow = (long)b * SEQ + s0 + wid * QBLK + r32;
    unsigned qo = (unsigned)((trow * LDQ + h * 192) * 2); const unsigned ro = (unsigned)(trow * 256), go = (unsigned)(hi * 128);
#define Qn_(i) (*(gbf16x8*)((const char*)Qraw + qo + hi * 64 + (i) * 16))
#define Qr_(i) (*(gbf16x8*)((const char*)Qraw + qo + 256 + (i) * 16))
#define rp4_(i) (*(gf32x4*)((const char*)rope + ro + (i) * 16))
#define qgn_(i) (*(gf32x4*)((const char*)qg + go + (i) * 16))
#define qgr_(i) (*(gf32x4*)((const char*)qg + 512 + (i) * 16))
    float ssn = 0.f, ssp = 0.f;
#pragma unroll
    for (int c = 0; c < 8; ++c) { const bf16x8 a = Qn_((c >> 2) * 8 + (c & 3)), r = Qr_(c);
#pragma unroll
      for (int j = 0; j < 8; ++j) { const float f = bf2f((unsigned short)a[j]), g = bf2f((unsigned short)r[j]); ssn += f * f; ssp += g * g; } }
    ssn += __shfl_xor(ssn, 32);
    const float rn = rsqrtf(ssn * (1.f / 128.f) + 1e-6f) * C, rp = rsqrtf(ssp * (1.f / 64.f) + 1e-6f) * C;
    { float rn_ = rn, rp_ = rp; asm volatile("" : "+v"(qo), "+v"(rn_), "+v"(rp_) :: "memory"); }
#pragma unroll
    for (int m = 0; m < 2; ++m)
#pragma unroll
      for (int c = 0; c < 4; ++c) { const bf16x8 raw = Qn_(8 * m + c); const f32x4_t ga = qgn_(16 * m + 2 * c), gb = qgn_(16 * m + 2 * c + 1); float g[8];
#pragma unroll
        for (int j = 0; j < 8; ++j) g[j] = bf2f((unsigned short)raw[j]) * rn * (j < 4 ? ga[j & 3] : gb[j & 3]);
        int w0 = 0, w1 = 0; w0 = __builtin_amdgcn_cvt_pk_fp8_f32(g[0], g[1], w0, false); w0 = __builtin_amdgcn_cvt_pk_fp8_f32(g[2], g[3], w0, true);
        w1 = __builtin_amdgcn_cvt_pk_fp8_f32(g[4], g[5], w1, false); w1 = __builtin_amdgcn_cvt_pk_fp8_f32(g[6], g[7], w1, true);
        asm volatile("" : "+v"(w0), "+v"(w1) :: "memory");        q8[m][2 * c] = w0; q8[m][2 * c + 1] = w1; }
#pragma unroll
    for (int c = 0; c < 4; ++c) {
      const bf16x8 r1 = Qr_(c), r2 = Qr_(4 + c);
      const f32x4_t g1a = qgr_(2 * c), g1b = qgr_(2 * c + 1), g2a = qgr_(8 + 2 * c), g2b = qgr_(8 + 2 * c + 1); float ov[8];
#pragma unroll
      for (int j = 0; j < 8; ++j) { const f32x4_t cs4 = rp4_(4 * c + (j >> 1));
        const float cs = cs4[(j & 1) * 2], sn = cs4[(j & 1) * 2 + 1];
        const float x1 = bf2f((unsigned short)r1[j]) * rp * (j < 4 ? g1a[j & 3] : g1b[j & 3]), x2 = bf2f((unsigned short)r2[j]) * rp * (j < 4 ? g2a[j & 3] : g2b[j & 3]);
        ov[j] = hi == 0 ? (x1 * cs - x2 * sn) : (x1 * sn + x2 * cs); }
      int w0 = 0, w1 = 0; w0 = __builtin_amdgcn_cvt_pk_fp8_f32(ov[0], ov[1], w0, false); w0 = __builtin_amdgcn_cvt_pk_fp8_f32(ov[2], ov[3], w0, true);
      w1 = __builtin_amdgcn_cvt_pk_fp8_f32(ov[4], ov[5], w1, false); w1 = __builtin_amdgcn_cvt_pk_fp8_f32(ov[6], ov[7], w1, true);
      asm volatile("" : "+v"(w0), "+v"(w1) :: "memory"); q8[2][2 * c] = w0; q8[2][2 * c + 1] = w1; }
  #undef Qn_
#undef Qr_
#undef rp4_
#undef qgn_
#undef qgr_
  }
  const float negm = 15.0f - smaxC;
  float l_reg = 0.f; f32x16 o[4] = {};
  const char* Vg = (const char*)(VT8g + (size_t)h * 128 * T_TOK + (size_t)b * SEQ); const char* Kg = (const char*)(K8g + ((long)b * SEQ * 8 + h) * 128); const char* Pg = (const char*)(KP8g + (long)b * SEQ * 64);
  const int vc = tid >> 2, vq = tid & 3, vst = vc * 80 + 16 * (vq >> 1) + 8 * (vq & 1); const unsigned gvt = (unsigned)vc * (unsigned)T_TOK + 16u * (unsigned)vq;
  const int kr = tid >> 3, kc = tid & 7, kst = kr * 208 + kc * 16; const unsigned gk8 = (unsigned)(kr * 1024 + kc * 16);
  const int pr = (tid & 255) >> 2, pc = tid & 3, pst = pr * 208 + 128 + pc * 16; const unsigned gp8 = (unsigned)(pr * 64 + pc * 16);
  v4i32 s_v, s_k, s_p;
#define SLOAD(k0) do { s_v = *reinterpret_cast<const v4i32*>(Vg + (size_t)(k0) + gvt); \
    s_k = *reinterpret_cast<const v4i32*>(Kg + (size_t)(k0) * 1024 + gk8); if (tid < 256) s_p = *reinterpret_cast<const v4i32*>(Pg + (size_t)(k0) * 64 + gp8); } while (0)
#define SWRITE(kbuf, vbuf_) do { { v2i32 a_ = {s_v[0], s_v[2]}, b_ = {s_v[1], s_v[3]}; *(v2i32*)(V_lds + (vbuf_) * SHM_VT + vst) = a_; *(v2i32*)(V_lds + (vbuf_) * SHM_VT + vst + 32) = b_; } \
    *(v4i32*)(K8_lds + (kbuf) * SHM_K8 + kst) = s_k; if (tid < 256) *(v4i32*)(K8_lds + (kbuf) * SHM_K8 + pst) = s_p; } while (0)
  constexpr int NT = SEQ / KVBLK;
  v8i32 p8;
  SLOAD(0); SWRITE(0, 0); __syncthreads(); SLOAD(KVBLK);
  if (wid < 4) {
    for (int j = 0, kb = 0, vbuf = 0, vnx = 1; j < NT; ++j) {
      f32x16 p0, p1;
      qkt<SHIFT>(p0, p1, K8_lds + kb * SHM_K8, q8, negm, r32, hi);
      smA<SHIFT>(p0, negm); smB<SHIFT>(p0, p1, l_reg, p8, negm); ASBAR();
      pv_d0(o, V_lds + vbuf * SHM_VT, p8, r32, hi);
      if (j + 1 < NT) SWRITE(kb ^ 1, vnx);
      __syncthreads();
      if (j + 2 < NT) SLOAD((j + 2) * KVBLK);
      kb ^= 1; vbuf = vnx; vnx = vnx == 2 ? 0 : vnx + 1;
    }
  } else {
    int vprev = 0;
    __builtin_amdgcn_s_setprio(1);
    for (int j = 0, kb = 0, vbuf = 0, vnx = 1; j < NT; ++j) {
      f32x16 p0, p1;
      if (j > 0) pv_d0(o, V_lds + vprev * SHM_VT, p8, r32, hi);
      qkt<SHIFT>(p0, p1, K8_lds + kb * SHM_K8, q8, negm, r32, hi);
      smA<SHIFT>(p0, negm); smB<SHIFT>(p0, p1, l_reg, p8, negm); ASBAR();
      if (j + 1 < NT) SWRITE(kb ^ 1, vnx);
      __syncthreads();
      if (j + 2 < NT) SLOAD((j + 2) * KVBLK);
      kb ^= 1; vprev = vbuf; vbuf = vnx; vnx = vnx == 2 ? 0 : vnx + 1;
    }
    pv_d0(o, V_lds + vprev * SHM_VT, p8, r32, hi);
    __builtin_amdgcn_s_setprio(0);
  }
  int lane_e = lane; asm volatile("" : "+v"(lane_e));
  const int r32e = lane_e & 31, hie = lane_e >> 5;
  l_reg += __shfl_xor(l_reg, 32);
  int* satf = (int*)(lds + OFF_WS + NW * 64 * 4);
  if (!SHIFT) { const bool sat = __any(l_reg >= 57344.f); if (lane_e == 0) satf[wid] = sat ? 1 : 0; }
  if (hie == 0) li_l[r32e] = l_reg; asm volatile("s_waitcnt lgkmcnt(0)" ::: "memory");
  float rli[16];
#pragma unroll
  for (int r = 0; r < 16; ++r) rli[r] = __builtin_amdgcn_rcpf(li_l[crow(r, hie)]);
  char* Ow = (char*)O + ((long)b * SEQ + s0 + wid * QBLK) * LDO + h * 128;
#pragma unroll
  for (int r = 0; r < 16; ++r) { const unsigned ooff = (unsigned)(crow(r, hie) * LDO + r32e);
#pragma unroll
    for (int d0 = 0; d0 < 4; ++d0) { const int pk = __builtin_amdgcn_cvt_pk_fp8_f32(o[d0][r] * rli[r] * 32.f, 0.f, 0, false); *(unsigned char*)(Ow + ooff + d0 * 32) = (unsigned char)(pk & 0xff); } }
  __syncthreads();
  bool redo = false;
  if (!SHIFT) { redo = (satf[0] | satf[1] | satf[2] | satf[3] | satf[4] | satf[5] | satf[6] | satf[7]) != 0; __syncthreads(); }
  return redo;
#undef SLOAD
#undef SWRITE
}
}
#ifndef HD
#define HD __device__ __forceinline__
#endif
struct c32 { float x, y; };
HD c32 cmk(float x, float y) { c32 r; r.x = x; r.y = y; return r; }
HD c32 cadd(c32 a, c32 b) { return cmk(a.x + b.x, a.y + b.y); }
HD c32 csub(c32 a, c32 b) { return cmk(a.x - b.x, a.y - b.y); }
HD c32 cmul(c32 a, c32 b) { return cmk(a.x * b.x - a.y * b.y, a.x * b.y + a.y * b.x); }
HD c32 cmulc(c32 a, c32 b) { return cmk(a.x * b.x + a.y * b.y, a.y * b.x - a.x * b.y); }
constexpr int BR4(int i) { return ((i & 1) << 3) | ((i & 2) << 1) | ((i & 4) >> 1) | ((i & 8) >> 3); }
template <int SGN, int J> HD c32 tw16(c32 a) {
    if constexpr (J == 0) return a;
    else if constexpr (J == 4) return SGN < 0 ? cmk(a.y, -a.x) : cmk(-a.y, a.x);
    else {
        constexpr float CS[8] = {1.f, 0.92387953251128674f, 0.70710678118654752f, 0.38268343236508977f, 0.f, -0.38268343236508977f, -0.70710678118654752f, -0.92387953251128674f};
        constexpr float SN[8] = {0.f, 0.38268343236508977f, 0.70710678118654752f, 0.92387953251128674f, 1.f, 0.92387953251128674f, 0.70710678118654752f, 0.38268343236508977f};
        constexpr float c = CS[J], s = SN[J];
        if constexpr (SGN < 0) return cmk(a.x * c + a.y * s, a.y * c - a.x * s);
        else return cmk(a.x * c - a.y * s, a.y * c + a.x * s);
    }
}
#define FFT_BF(i, j, J) { const c32 u_ = v[i], w_ = v[j]; v[i] = cadd(u_, w_); v[j] = tw16<SGN, J>(csub(u_, w_)); }
template <int SGN> HD void dft16_dif(c32 (&v)[16]) {
    FFT_BF(0, 8, 0) FFT_BF(1, 9, 1) FFT_BF(2, 10, 2) FFT_BF(3, 11, 3) FFT_BF(4, 12, 4) FFT_BF(5, 13, 5) FFT_BF(6, 14, 6) FFT_BF(7, 15, 7)
    FFT_BF(0, 4, 0) FFT_BF(1, 5, 2) FFT_BF(2, 6, 4) FFT_BF(3, 7, 6) FFT_BF(8, 12, 0) FFT_BF(9, 13, 2) FFT_BF(10, 14, 4) FFT_BF(11, 15, 6)
    FFT_BF(0, 2, 0) FFT_BF(1, 3, 4) FFT_BF(4, 6, 0) FFT_BF(5, 7, 4) FFT_BF(8, 10, 0) FFT_BF(9, 11, 4) FFT_BF(12, 14, 0) FFT_BF(13, 15, 4)
    FFT_BF(0, 1, 0) FFT_BF(2, 3, 0) FFT_BF(4, 5, 0) FFT_BF(6, 7, 0) FFT_BF(8, 9, 0) FFT_BF(10, 11, 0) FFT_BF(12, 13, 0) FFT_BF(14, 15, 0)
}
#undef FFT_BF
#define FFT_BT(i, j, J) { const c32 u_ = v[i], w_ = tw16<SGN, J>(v[j]); v[i] = cadd(u_, w_); v[j] = csub(u_, w_); }
template <int SGN> HD void dft16_dit(c32 (&v)[16]) {
    FFT_BT(0, 1, 0) FFT_BT(2, 3, 0) FFT_BT(4, 5, 0) FFT_BT(6, 7, 0) FFT_BT(8, 9, 0) FFT_BT(10, 11, 0) FFT_BT(12, 13, 0) FFT_BT(14, 15, 0)
    FFT_BT(0, 2, 0) FFT_BT(1, 3, 4) FFT_BT(4, 6, 0) FFT_BT(5, 7, 4) FFT_BT(8, 10, 0) FFT_BT(9, 11, 4) FFT_BT(12, 14, 0) FFT_BT(13, 15, 4)
    FFT_BT(0, 4, 0) FFT_BT(1, 5, 2) FFT_BT(2, 6, 4) FFT_BT(3, 7, 6) FFT_BT(8, 12, 0) FFT_BT(9, 13, 2) FFT_BT(10, 14, 4) FFT_BT(11, 15, 6)
    FFT_BT(0, 8, 0) FFT_BT(1, 9, 1) FFT_BT(2, 10, 2) FFT_BT(3, 11, 3) FFT_BT(4, 12, 4) FFT_BT(5, 13, 5) FFT_BT(6, 14, 6) FFT_BT(7, 15, 7)
}
#undef FFT_BT
constexpr int FFT_PS = 272;
constexpr int FFT_EX_ELEMS = 16 * FFT_PS;
template <class EX> HD void fft_fwd_a(c32 (&v)[16], const c32* T1, EX ex, int tid) {
    dft16_dif<-1>(v);
#pragma unroll
    for (int p = 0; p < 16; ++p) { ex[p * FFT_PS + tid] = cmul(v[BR4(p)], T1[256 * p]); if ((p & 3) == 3) __builtin_amdgcn_sched_barrier(0); }
}
template <class EX> HD void fft_fwd_b(c32 (&v)[16], const c32* T2, EX exr, EX ex, int tid) {
    const int p2 = tid >> 4, c = tid & 15;
#pragma unroll
    for (int b = 0; b < 16; ++b) v[b] = exr[p2 * FFT_PS + 16 * b + c];
    dft16_dif<-1>(v);
#pragma unroll
    for (int q = 0; q < 16; ++q) ex[p2 * FFT_PS + q * 16 + ((c + q) & 15)] = cmul(v[BR4(q)], T2[q]);
}
template <class EX> HD void fft_fwd_c(c32 (&v)[16], EX ex, int tid) {
    const int p2 = tid >> 4, q = tid & 15;
#pragma unroll
    for (int c = 0; c < 16; ++c) v[c] = ex[p2 * FFT_PS + q * 16 + ((c + q) & 15)];
    dft16_dif<-1>(v);
}
template <class EX> HD void fft_inv_a(c32 (&v)[16], EX ex, int tid) {
    const int p = tid >> 4, q = tid & 15;
    dft16_dit<+1>(v);
#pragma unroll
    for (int c = 0; c < 16; ++c) ex[p * FFT_PS + q * 16 + ((c + q) & 15)] = v[c];
}
template <class EX> HD void fft_inv_b(c32 (&v)[16], const c32* T2, EX exr, EX ex, int tid) {
    const int p = tid >> 4, c = tid & 15;
#pragma unroll
    for (int q = 0; q < 16; ++q) v[BR4(q)] = cmulc(exr[p * FFT_PS + q * 16 + ((c + q) & 15)], T2[q]);
    dft16_dit<+1>(v);
#pragma unroll
    for (int b = 0; b < 16; ++b) ex[p * FFT_PS + 16 * b + c] = v[b];
}
template <class EX> HD void fft_inv_c(c32 (&v)[16], const c32* T1, EX ex, int tid) {
#pragma unroll
    for (int p = 0; p < 16; ++p) { v[BR4(p)] = cmulc(ex[p * FFT_PS + tid], T1[256 * p]); if ((p & 3) == 3) __builtin_amdgcn_sched_barrier(0); }
    dft16_dit<+1>(v);
}
constexpr int NWAVES = 8, NTHR = 512;
constexpr int BATCH = 8, SEQ = 4096, DM = 1024, T = BATCH * SEQ;
constexpr float EPS = 1e-6f;
constexpr size_t MiB = 1u << 20;
constexpr size_t WS_CTL = 0, CTL_ZERO_BYTES = 64 * 1024;
constexpr size_t WS_MOD = 1 * MiB;
constexpr size_t WS_HDNS = 1 * MiB + 512 * 1024;
constexpr size_t WS_W4S = 3 * MiB + 512 * 1024;
constexpr size_t WS_LIST = 101 * MiB;
constexpr size_t WS_WL = 396 * MiB;
constexpr size_t WS_WD = 8 * MiB;
constexpr size_t WS_WUQ = 9 * MiB;
constexpr size_t WS_WUKV = 10 * MiB;
constexpr size_t WS_WO = 11 * MiB;
constexpr size_t WS_WIN = 13 * MiB;
constexpr size_t WS_WOUT = 19 * MiB;
constexpr size_t WS_WGU = 21 * MiB;
constexpr size_t WS_WDN = 53 * MiB;
constexpr size_t R1 = 104 * MiB;
constexpr size_t R2 = 232 * MiB;
constexpr size_t R3 = 424 * MiB;
constexpr size_t WS_VT8 = R1, WS_XN2 = R1, WS_KF = R1;
constexpr size_t WS_XN = R2, WS_O = R2;
constexpr size_t WS_LAT = R2 + 64 * MiB;
constexpr size_t WS_HACT = R2 + 64 * MiB;
constexpr size_t WS_CQN = R2 + 128 * MiB;
constexpr size_t WS_CKVN = R2 + 144 * MiB;
constexpr size_t WS_KPE = R2 + 160 * MiB;
constexpr size_t WS_K8 = R2 + 64 * MiB;
constexpr size_t WS_ROPE = R2 + 164 * MiB;
constexpr size_t WS_QRAW = 408 * MiB;
constexpr size_t WS_XN2S = 424 * MiB;
constexpr size_t WS_XR = 424 * MiB;
constexpr size_t WS_HT = R2;
constexpr size_t WS_UT = R2;
constexpr size_t WS_Z = R2;
constexpr size_t WS_END = 512 * MiB;
constexpr int MS_ROWS = T + 24 * 256;
constexpr int CW_BAR = 4096;
constexpr int CW_CNT = 8192;
constexpr int RING_OFF = 0, RING_BYTES = 147456;
constexpr int LDSCTL_OFF = RING_BYTES;
constexpr int MISC_OFF = LDSCTL_OFF;
constexpr int TINFO_OFF = LDSCTL_OFF + 256;
constexpr int RED_OFF = LDSCTL_OFF + 256 + 1280;
constexpr int EPIX_OFF = LDSCTL_OFF + 2048;
constexpr int LDS_BYTES = 163840;
static_assert(RED_OFF + 256 <= LDS_BYTES, "LDS map");

#define GAS __attribute__((address_space(1)))
#define LAS __attribute__((address_space(3)))
typedef unsigned short bf16;
typedef unsigned v4u __attribute__((ext_vector_type(4)));
typedef unsigned v2u __attribute__((ext_vector_type(2)));
typedef int v4i __attribute__((ext_vector_type(4)));
typedef float f32x4 __attribute__((ext_vector_type(4)));
typedef GAS unsigned gu32;
#define RLX_AGENT __ATOMIC_RELAXED, __HIP_MEMORY_SCOPE_AGENT
#define LDS_WAIT() asm volatile("s_waitcnt lgkmcnt(0)" ::: "memory")
__device__ __forceinline__ unsigned pk2(float lo, float hi) { return pg8::cvt_pk_bf16(lo, hi); }
__device__ __forceinline__ float bf2f(unsigned short b) { return __uint_as_float(((unsigned)b) << 16); }
__device__ __forceinline__ float wave_sum(float v) {
#pragma unroll
    for (int o = 1; o < 64; o <<= 1) v += __shfl_xor(v, o);
    return v;
}

#define XB_TMO      128
#define XB_XCNT(j)  (256  + 64 * (j))
#define XB_XSUB(j)  (1280 + 64 * (j))
#define XB_XGEN(j)  (2304 + 64 * (j))
#define XB_TOP      3328
#define XB_TOPGEN   3392
#define XCD_BAR_WORDS 3456
#define XB_SPIN_CAP (1u << 18)

__device__ __forceinline__ unsigned xb_ld(unsigned* p)              { return __hip_atomic_load(p, __ATOMIC_RELAXED, __HIP_MEMORY_SCOPE_AGENT); }
__device__ __forceinline__ unsigned xb_add(unsigned* p, unsigned v) { return __hip_atomic_fetch_add(p, v, __ATOMIC_RELAXED, __HIP_MEMORY_SCOPE_AGENT); }
__device__ __forceinline__ unsigned xb_xcc_id() { return (unsigned)__builtin_amdgcn_s_getreg((3 << 11) | 20) & 0xFu; }
#define XB_SPIN(cond, bar) do { unsigned _sp = 0; while (cond) { __builtin_amdgcn_s_sleep(1); \
    if ((++_sp & 255u) == 0u) { if (xb_ld(&(bar)[XB_TMO])) break; if (_sp > XB_SPIN_CAP) { atomicAdd(&(bar)[XB_TMO], 1u); break; } } } } while (0)

struct XcdBarrier {
    unsigned* bar; unsigned x;
    volatile LAS unsigned* st;
    int w0;
};

__device__ __forceinline__ XcdBarrier xcd_barrier_post(unsigned* bar, volatile LAS unsigned* st) {
    XcdBarrier b; b.bar = bar; b.x = xb_xcc_id(); b.st = st; b.w0 = 0;
    if (threadIdx.x == 0) (void)xb_add(&bar[XB_XCNT(b.x)], 1u);
    return b;
}
__device__ __forceinline__ void xcd_barrier_complete(unsigned* bar, unsigned x, unsigned& nloc, unsigned& nx) {
    const unsigned G = gridDim.x * gridDim.y * gridDim.z;
    unsigned sum, cnt, mine, sp = 0u;
    for (;;) {
        sum = 0u; cnt = 0u; mine = 0u;
#pragma unroll
        for (unsigned j = 0; j < 16; ++j) { const unsigned c = xb_ld(&bar[XB_XCNT(j)]); sum += c; cnt += (c > 0u) ? 1u : 0u; mine = (j == x) ? c : mine; }
        if (sum == G) break;
        __builtin_amdgcn_s_sleep(1);
        if ((++sp & 255u) == 0u) { if (xb_ld(&bar[XB_TMO])) break; if (sp > XB_SPIN_CAP) { atomicAdd(&bar[XB_TMO], 1u); break; } }
    }
    nloc = mine > 0u ? mine : 1u; nx = cnt > 0u ? cnt : 1u;
}

__device__ __forceinline__ void xcd_barrier(const XcdBarrier& b) {
    asm volatile("s_waitcnt vmcnt(0)" ::: "memory");
    __syncthreads();
    if (b.w0 && __builtin_amdgcn_mbcnt_hi(~0u, __builtin_amdgcn_mbcnt_lo(~0u, 0u)) == 0u) {
        unsigned* bar = b.bar;
        __builtin_amdgcn_s_waitcnt(0);
        unsigned nloc = b.st[0], nx = b.st[1];
        if (nloc == 0u) { xcd_barrier_complete(bar, b.x, nloc, nx); b.st[0] = nloc; b.st[1] = nx; }
        const unsigned old = xb_add(&bar[XB_XSUB(b.x)], 1u);
        const unsigned gen = old / nloc;
        if (old + 1u == (gen + 1u) * nloc) {
            __builtin_amdgcn_fence(__ATOMIC_RELEASE, "agent");
            asm volatile("s_waitcnt vmcnt(0)" ::: "memory");
            const unsigned og = xb_add(&bar[XB_TOP], 1u);
            const unsigned tg = og / nx;
            if (og + 1u == (tg + 1u) * nx) xb_add(&bar[XB_TOPGEN], 1u);
            else XB_SPIN(xb_ld(&bar[XB_TOPGEN]) == tg, bar);
            __builtin_amdgcn_fence(__ATOMIC_ACQUIRE, "agent");
            xb_add(&bar[XB_XGEN(b.x)], 1u);
            asm volatile("s_waitcnt vmcnt(0)" ::: "memory");
        } else {
            XB_SPIN(xb_ld(&bar[XB_XGEN(b.x)]) == gen, bar);
            __builtin_amdgcn_fence(__ATOMIC_ACQUIRE, "agent");
            asm volatile("s_waitcnt vmcnt(0)" ::: "memory");
        }
    }
    __syncthreads();
}


struct Ctx { unsigned char* lds; int tid, lane, wave, vcu, G, gw, NGW; };

__device__ __forceinline__ void transpose_item(const float* W, int ldw, int k0, int n0, bf16* WT, int ldt, int drow0, int dcol0, float* scr, int lane, bool kpe_perm) {
    float tv[32];
#pragma unroll
    for (int i = 0; i < 32; ++i) { const int kk = 2 * i + (lane >> 5); tv[i] = W[(size_t)(k0 + kk) * ldw + n0 + (lane & 31)]; }
#pragma unroll
    for (int i = 0; i < 32; ++i) { const int kk = 2 * i + (lane >> 5); scr[kk * 33 + (lane & 31)] = tv[i]; }
    LDS_WAIT();
    const int c = lane & 7;
#pragma unroll
    for (int j = 0; j < 4; ++j) { const int n = (lane >> 3) + 8 * j; const float* s = scr + (8 * c) * 33 + n;
        v4u o; o.x = pk2(s[0 * 33], s[1 * 33]); o.y = pk2(s[2 * 33], s[3 * 33]); o.z = pk2(s[4 * 33], s[5 * 33]); o.w = pk2(s[6 * 33], s[7 * 33]);
        int dr = drow0 + n; if (kpe_perm && dr >= 384 && dr < 448) { const int e = dr - 384; dr = 384 + 32 * ((e >> 4) & 1) + 16 * (e >> 5) + (e & 15); }
        *(v4u*)(WT + (size_t)dr * ldt + dcol0 + k0 + 8 * c) = o; }
    LDS_WAIT();
}
__device__ __forceinline__ void transpose_item8(const float* W, int ldw, int k0, int n0, unsigned char* WT8, int ldt8, int drow0, int dcol0, float* scr, int lane, float scale, bool kpe_perm) {
    float tv[32];
#pragma unroll
    for (int i = 0; i < 32; ++i) { const int kk = 2 * i + (lane >> 5); tv[i] = W[(size_t)(k0 + kk) * ldw + n0 + (lane & 31)]; }
#pragma unroll
    for (int i = 0; i < 32; ++i) { const int kk = 2 * i + (lane >> 5); scr[kk * 33 + (lane & 31)] = tv[i]; }
    LDS_WAIT();
    const int n = lane >> 1, hf = lane & 1; const float* sp = scr + (32 * hf) * 33 + n;
    v4u o0, o1; unsigned w[8];
#pragma unroll
    for (int q = 0; q < 8; ++q) { int p = 0; p = __builtin_amdgcn_cvt_pk_fp8_f32(sp[(4 * q) * 33] * scale, sp[(4 * q + 1) * 33] * scale, p, false); p = __builtin_amdgcn_cvt_pk_fp8_f32(sp[(4 * q + 2) * 33] * scale, sp[(4 * q + 3) * 33] * scale, p, true); w[q] = (unsigned)p; }
    o0.x = w[0]; o0.y = w[1]; o0.z = w[2]; o0.w = w[3]; o1.x = w[4]; o1.y = w[5]; o1.z = w[6]; o1.w = w[7];
    int dr = drow0 + n; if (kpe_perm && dr >= 384 && dr < 448) { const int e = dr - 384; dr = 384 + 32 * ((e >> 4) & 1) + 16 * (e >> 5) + (e & 15); }
    unsigned char* d = WT8 + (size_t)dr * ldt8 + dcol0 + k0 + 32 * hf;
    *(v4u*)d = o0; *(v4u*)(d + 16) = o1;
    LDS_WAIT();
}
typedef __attribute__((address_space(4))) const char kchar;
struct In { int opq;
    __device__ __forceinline__ const float* operator[](int k) const { kchar* ka = (kchar*)__builtin_amdgcn_kernarg_segment_ptr(); return *(const float* const __attribute__((address_space(4)))*)(ka + 8 * k + opq); } };
__device__ __forceinline__ unsigned char* karg_ws(int opq) { kchar* ka = (kchar*)__builtin_amdgcn_kernarg_segment_ptr(); return *(unsigned char* const __attribute__((address_space(4)))*)(ka + 38 * 8 + 8 + opq); }
__device__ __forceinline__ float* karg_out(int opq) { kchar* ka = (kchar*)__builtin_amdgcn_kernarg_segment_ptr(); return *(float* const __attribute__((address_space(4)))*)(ka + 38 * 8 + opq); }

__device__ __forceinline__ void p0_prologue(const Ctx& F, const In& in, unsigned char* ws) {
    float* scr = (float*)(F.lds + RING_OFF + F.wave * 16384);
    bf16* Wd = (bf16*)(ws + WS_WD); bf16* Wuq = (bf16*)(ws + WS_WUQ); bf16* Wukv = (bf16*)(ws + WS_WUKV); bf16* Wo = (bf16*)(ws + WS_WO);
    bf16* Win = (bf16*)(ws + WS_WIN); bf16* Wout = (bf16*)(ws + WS_WOUT); bf16* Wgu = (bf16*)(ws + WS_WGU); bf16* Wdn = (bf16*)(ws + WS_WDN);
    constexpr int I_D = 16 * 14, I_UQ = 4 * 48, I_UKV = 2 * 64, I_O = 16 * 32, I_IN = 16 * 96, I_OUT = 16 * 32, I_GU = 2 * 16 * 2 * (16 * 8), I_DN = 2 * 24 * 2 * (4 * 32);
    constexpr int NITEMS = I_D + I_UQ + I_UKV + I_O + I_IN + I_OUT + I_GU + I_DN;
    for (int it = F.gw; it < NITEMS; it += F.NGW) {
        int r = it; const float* W; int ldw, k0, n0, ldt, drow0, dcol0 = 0; bf16* WT; float f8s = 0.f;
        if (r < I_D) { W = in[7]; ldw = 448; k0 = (r / 14) * 64; n0 = (r % 14) * 32; WT = Wd; ldt = 1024; drow0 = n0; f8s = 32.f; }
        else if ((r -= I_D) < I_UQ) { W = in[10]; ldw = 1536; k0 = (r / 48) * 64; n0 = (r % 48) * 32; WT = Wuq; ldt = 256; drow0 = n0; f8s = 16.f; }
        else if ((r -= I_UQ) < I_UKV) { W = in[11]; ldw = 2048; k0 = (r / 64) * 64; n0 = (r % 64) * 32; ldt = 128;
            WT = Wukv + ((n0 & 128) ? 1024 * 128 : 0); drow0 = (n0 >> 8) * 128 + (n0 & 127); }
        else if ((r -= I_UKV) < I_O) { W = in[14]; ldw = 1024; k0 = (r / 32) * 64; n0 = (r % 32) * 32; WT = Wo; ldt = 1024; drow0 = n0; f8s = 32.f; }
        else if ((r -= I_O) < I_IN) { W = in[15]; ldw = 3072; k0 = (r / 96) * 64; n0 = (r % 96) * 32; WT = Win; ldt = 1024; drow0 = n0; }
        else if ((r -= I_IN) < I_OUT) { W = in[30]; ldw = 1024; k0 = (r / 32) * 64; n0 = (r % 32) * 32; WT = Wout; ldt = 1024; drow0 = n0; }
        else if ((r -= I_OUT) < I_GU) {
            const int sub = r % 128, mat = r / 128, which = mat & 1, le = mat >> 1;
            W = (which ? in[36] : in[35]) + (size_t)le * 1024 * 256; ldw = 256; k0 = (sub / 8) * 64; n0 = (sub % 8) * 32;
            WT = (bf16*)((unsigned char*)Wgu + (size_t)le * 512 * 1024); ldt = 1024; drow0 = (n0 >> 7) * 256 + which * 128 + (n0 & 127); f8s = 32.f; }
        else { r -= I_GU;
            const int sub = r % 128, mat = r / 128, slot = mat & 1, lb = mat >> 1, layer = lb / 24, bk = lb % 24;
            int ii, jj; pg8::pair_of(bk % 6, ii, jj); const int e = (bk / 6) * 4 + (slot ? jj : ii);
            W = in[37] + (size_t)(layer * 16 + e) * 256 * 1024; ldw = 1024; k0 = (sub / 32) * 64; n0 = (sub % 32) * 32;
            WT = Wdn + (size_t)lb * 1024 * 512; ldt = 512; drow0 = n0; dcol0 = slot * 256; }
        if (f8s != 0.f) transpose_item8(W, ldw, k0, n0, (unsigned char*)WT, ldt, drow0, dcol0, scr, F.lane, f8s, it < I_D);
        else transpose_item(W, ldw, k0, n0, WT, ldt, drow0, dcol0, scr, F.lane, it < I_D);
    }
    { const int gt = F.vcu * NTHR + F.tid, NGT = F.G * NTHR; const v4u z = {0u, 0u, 0u, 0u};
      for (int i = gt; i < 64 * 1024 / 16; i += NGT) *(v4u*)((unsigned char*)Wd + (size_t)448 * 1024 + (size_t)i * 16) = z;
    }
    { const int gt = F.vcu * NTHR + F.tid, NGT = F.G * NTHR; float* RT = (float*)(ws + WS_ROPE); const int* posi = (const int*)in[2];
      const float inv = __builtin_amdgcn_exp2f(-0.41524101186092029f * (float)(gt & 31));
      for (int i = gt; i < T * 32; i += NGT) { const int t = i >> 5;
        float sn, cs; sincosf((float)posi[t] * inv, &sn, &cs); *(v2u*)(RT + (size_t)i * 2) = (v2u){__float_as_uint(cs), __float_as_uint(sn)}; } }
    { const int gt = F.vcu * NTHR + F.tid, NGT = F.G * NTHR; bf16* W4S = (bf16*)(ws + WS_W4S); const float* w4 = in[28];
      for (int i = gt; i < 4096 * 8; i += NGT) { const int col = i & 4095, oct = i >> 12; float w[8];
#pragma unroll
        for (int q = 0; q < 8; ++q) w[q] = w4[(size_t)(8 * oct + q) * 4096 + col];
        unsigned hw[4], lw[4];
#pragma unroll
        for (int q = 0; q < 4; ++q) { const unsigned h2 = pk2(w[2 * q], w[2 * q + 1]); hw[q] = h2;
          lw[q] = pk2(w[2 * q] - __uint_as_float(h2 << 16), w[2 * q + 1] - __uint_as_float(h2 & 0xffff0000u)); }
        bf16* d = W4S + (size_t)col * 256 + 8 * oct; const v4u hv = {hw[0], hw[1], hw[2], hw[3]}, lv = {lw[0], lw[1], lw[2], lw[3]}, zv = {0u, 0u, 0u, 0u};
        *(v4u*)d = hv; *(v4u*)(d + 64) = hv; *(v4u*)(d + 128) = lv; *(v4u*)(d + 192) = zv; } }
    __syncthreads();
    { bf16* HDp = (bf16*)(ws + WS_HDNS); float* wl = (float*)(F.lds + RING_OFF); float* sv = wl + 161 * 64 + F.wave * 64;
      for (int i = F.tid; i < 161 * 64; i += NTHR) wl[i] = i < 33 * 64 ? in[19][i] : (i < 97 * 64 ? in[22][i - 33 * 64] : in[25][i - 97 * 64]);
      __syncthreads();
      const int j = F.lane; const float b1 = in[20][j], f1 = in[21][j], b2 = in[23][j], f2 = in[24][j], b3 = in[26][j], f3 = in[27][j];
      for (int t = F.gw; t < 4096; t += F.NGW) {
        float zf = 0.f;
        { const float w = 6.2831855f * (float)t * (1.f / 4096.f);
          if (j == 0) zf = (float)t / 4095.f;
          else if (j <= 16) { const float fr = 1e-4f + (float)(j - 1) * ((15.f - 1e-4f) / 15.f); zf = cosf(fr * w); }
          else if (j <= 32) { const float fr = 1e-4f + (float)(j - 17) * ((15.f - 1e-4f) / 15.f); zf = -sinf(fr * w); } }
        sv[j] = zf; LDS_WAIT();
        float a = b1;
#pragma unroll
        for (int k = 0; k < 33; ++k) a += sv[k] * wl[k * 64 + j];
        float h = sinf(f1 * a); LDS_WAIT(); sv[j] = h; LDS_WAIT();
        a = b2;
#pragma unroll 16
        for (int k = 0; k < 64; ++k) a += sv[k] * wl[(33 + k) * 64 + j];
        h = sinf(f2 * a); LDS_WAIT(); sv[j] = h; LDS_WAIT();
        a = b3;
#pragma unroll 16
        for (int k = 0; k < 64; ++k) a += sv[k] * wl[(97 + k) * 64 + j];
        h = sinf(f3 * a); LDS_WAIT();
        const unsigned hi = pk2(h, 0.f) & 0xffffu; const float lo = h - bf2f((unsigned short)hi); const unsigned lob = pk2(lo, 0.f) & 0xffffu;
        bf16* d = HDp + (size_t)t * 256 + j; d[0] = (bf16)hi; d[64] = (bf16)lob; d[128] = (bf16)hi; d[192] = 0;
      } }
    __syncthreads();
    { float* cact = (float*)(F.lds + RING_OFF); float* red = cact + 8 * 1024;
      float* MOD = (float*)(ws + WS_MOD);
      for (int i = F.tid; i < 8 * 1024; i += NTHR) { const float x = in[1][i]; cact[(i & 1023) * 8 + (i >> 10)] = x / (1.f + __expf(-x)); }
      __syncthreads();
      for (int it = F.vcu; it < 2 * 128; it += F.G) {
        const int layer = it >> 7, cb = it & 127, r5 = F.lane / 12, cq = F.lane - 12 * r5;
        const float* W = in[3] + (size_t)layer * 1024 * 6144 + cb * 48 + 4 * cq + (size_t)(F.wave * 128 + r5) * 6144;
        f32x4 acc[8];
#pragma unroll
        for (int b = 0; b < 8; ++b) acc[b] = (f32x4){0.f, 0.f, 0.f, 0.f};
#pragma unroll
        for (int hf = 0; hf < 2; ++hf) { f32x4 wv[13];
#pragma unroll
          for (int q = 0; q < 13; ++q) { const int kk = 5 * (13 * hf + q) + r5; wv[q] = (F.lane < 60 && kk < 128) ? *(const f32x4*)(W + (size_t)(5 * (13 * hf + q)) * 6144) : (f32x4){0.f, 0.f, 0.f, 0.f}; }
#pragma unroll
          for (int q = 0; q < 13; ++q) { int kk = 5 * (13 * hf + q) + r5; kk = kk < 128 ? kk : 127; const float* cp = cact + (F.wave * 128 + kk) * 8; const f32x4 c0 = *(const f32x4*)cp, c1 = *(const f32x4*)(cp + 4);
#pragma unroll
            for (int b = 0; b < 8; ++b) acc[b] += (b < 4 ? c0[b & 3] : c1[b & 3]) * wv[q]; } }
        if (F.lane < 60) {
#pragma unroll
          for (int b = 0; b < 8; ++b) *(f32x4*)(red + ((F.wave * 5 + r5) * 8 + b) * 48 + 4 * cq) = acc[b]; }
        __syncthreads();
        if (F.tid < 384) { const int b = F.tid / 48, col = F.tid - 48 * b; float s = in[4][layer * 6144 + cb * 48 + col];
#pragma unroll 8
          for (int p = 0; p < 40; ++p) s += red[(p * 8 + b) * 48 + col];
          MOD[((size_t)layer * 8 + b) * 6144 + cb * 48 + col] = s; }
        __syncthreads();
      } }
}

template <class TX> __device__ __forceinline__ f32x4 ldrow4(const TX* p);
template <> __device__ __forceinline__ f32x4 ldrow4<float>(const float* p) { return *(const __attribute__((address_space(1))) f32x4*)p; }
template <> __device__ __forceinline__ f32x4 ldrow4<bf16>(const bf16* p) { const v2u w = *(const __attribute__((address_space(1))) v2u*)p; f32x4 r; r[0] = __uint_as_float(w.x << 16); r[1] = __uint_as_float(w.x & 0xffff0000u); r[2] = __uint_as_float(w.y << 16); r[3] = __uint_as_float(w.y & 0xffff0000u); return r; }
template <class TX, bool OUT8 = false> __device__ __forceinline__ void norm_mod_phase(const Ctx& F, const TX* X, const float* g, const float* sc, const float* sh, bf16* OUT) {
    for (int ch = F.gw; ch < T / 16; ch += F.NGW) {
        const int r0 = ch * 16, b = r0 >> 12;
        f32x4 A[4], S[4];
#pragma unroll
        for (int j = 0; j < 4; ++j) { const int col = 4 * F.lane + 256 * j; const f32x4 gv = *(const f32x4*)(g + col), sv = *(const f32x4*)(sc + (size_t)b * 6144 + col); A[j] = gv * (1.f + sv); S[j] = *(const f32x4*)(sh + (size_t)b * 6144 + col); }
        const TX* xr = X + (size_t)r0 * DM + 4 * F.lane;
        f32x4 nx[4];
#pragma unroll
        for (int j = 0; j < 4; ++j) nx[j] = ldrow4<TX>(xr + 256 * j);
        for (int rr = 0; rr < 16; ++rr) {
            f32x4 v[4]; float ss = 0.f;
#pragma unroll
            for (int j = 0; j < 4; ++j) { v[j] = nx[j]; ss += (v[j].x * v[j].x + v[j].y * v[j].y) + (v[j].z * v[j].z + v[j].w * v[j].w); }
            if (rr < 15) {
#pragma unroll
                for (int j = 0; j < 4; ++j) nx[j] = ldrow4<TX>(xr + (size_t)(rr + 1) * DM + 256 * j); }
            const float rstd = rsqrtf(wave_sum(ss) * (1.f / DM) + EPS);
            if constexpr (OUT8) { unsigned char* orow = (unsigned char*)OUT + (size_t)(r0 + rr) * DM + 4 * F.lane;
#pragma unroll
                for (int j = 0; j < 4; ++j) { const f32x4 o = v[j] * rstd * A[j] + S[j]; int p = 0; p = __builtin_amdgcn_cvt_pk_fp8_f32(o.x, o.y, p, false); p = __builtin_amdgcn_cvt_pk_fp8_f32(o.z, o.w, p, true); *(int*)(orow + 256 * j) = p; } }
            else { bf16* orow = OUT + (size_t)(r0 + rr) * DM + 4 * F.lane;
#pragma unroll
                for (int j = 0; j < 4; ++j) { const f32x4 o = v[j] * rstd * A[j] + S[j]; v2u w; w.x = pk2(o.x, o.y); w.y = pk2(o.z, o.w); *(v2u*)(orow + 256 * j) = w; } } }
    }
}

__device__ __forceinline__ void lat_post_phase(const Ctx& F, const float* LAT, const float* qag, const float* kvag, const float* kng, const float* rope, bf16* CQN, bf16* CKVN, bf16* KPE) {
    const int l = F.lane;
    const f32x4 gq = *(const f32x4*)(qag + 4 * l);
    const f32x4 g2 = l < 32 ? *(const f32x4*)(kvag + 4 * l) : (l < 48 ? *(const f32x4*)(kng + 128 + 4 * (l - 32)) : (f32x4){0.f, 0.f, 0.f, 0.f});
    f32x4 na = *(const f32x4*)(LAT + (size_t)F.gw * 512 + 4 * l), nc = l < 48 ? *(const f32x4*)(LAT + (size_t)F.gw * 512 + 256 + 4 * l) : (f32x4){0.f, 0.f, 0.f, 0.f};
    for (int row = F.gw; row < T; row += F.NGW) {
        const f32x4 a = na, c = nc;
        if (row + F.NGW < T) { const float* nr = LAT + (size_t)(row + F.NGW) * 512; na = *(const f32x4*)(nr + 4 * l); if (l < 48) nc = *(const f32x4*)(nr + 256 + 4 * l); }
        const float sq = (a.x * a.x + a.y * a.y) + (a.z * a.z + a.w * a.w), sc = (c.x * c.x + c.y * c.y) + (c.z * c.z + c.w * c.w);
        const float s_q = wave_sum(sq), s_kv = wave_sum(l < 32 ? sc : 0.f), s_pe = wave_sum((l >= 32 && l < 48) ? sc : 0.f);
        const float rq = rsqrtf(s_q * (1.f / 256.f) + EPS), rkv = rsqrtf(s_kv * (1.f / 128.f) + EPS), rpe = rsqrtf(s_pe * (1.f / 64.f) + EPS);
        { const f32x4 o = a * rq * gq; v2u w; w.x = pk2(o.x, o.y); w.y = pk2(o.z, o.w); *(v2u*)(CQN + (size_t)row * 256 + 4 * l) = w; }
        if (l < 32) { const f32x4 o = c * rkv * g2; v2u w; w.x = pk2(o.x, o.y); w.y = pk2(o.z, o.w); *(v2u*)(CKVN + (size_t)row * 256 + 4 * l) = w; }
        else { v2u w; w.x = 0u; w.y = 0u; *(v2u*)(CKVN + (size_t)row * 256 + 128 + 4 * (l - 32)) = w; }
        const f32x4 n = c * rpe * g2;
        f32x4 other; other.x = __shfl_xor(n.x, 8); other.y = __shfl_xor(n.y, 8); other.z = __shfl_xor(n.z, 8); other.w = __shfl_xor(n.w, 8);
        if (l >= 32 && l < 48) { const bool first = l < 40; const int e0 = 4 * ((l - 32) & 7);
            float o[4];
#pragma unroll
            for (int i = 0; i < 4; ++i) { const int e = e0 + i; const float cs = rope[(size_t)row * 64 + e * 2], sn = rope[(size_t)row * 64 + e * 2 + 1];
                const float mine = n[i], oth = other[i]; o[i] = first ? (mine * cs - oth * sn) : (oth * sn + mine * cs); }
            v2u w; w.x = pk2(o[0], o[1]); w.y = pk2(o[2], o[3]); *(v2u*)(KPE + (size_t)row * 64 + 4 * (l - 32)) = w; }
    }
}

__device__ __forceinline__ void knorm_phase(const Ctx& F, bf16* KV, const float* kng) {
    const int l = F.lane, h = l >> 3, e0 = (l & 7) * 16;
    float g[16];
#pragma unroll
    for (int i = 0; i < 16; ++i) g[i] = kng[e0 + i];
    for (int row = F.gw; row < T; row += F.NGW) {
        bf16* p = KV + (size_t)row * 2048 + h * 256 + e0;
        const v4u r0 = *(const v4u*)p, r1 = *(const v4u*)(p + 8);
        float f[16]; const unsigned w[8] = {r0.x, r0.y, r0.z, r0.w, r1.x, r1.y, r1.z, r1.w};
        float ss = 0.f;
#pragma unroll
        for (int i = 0; i < 8; ++i) { f[2 * i] = __uint_as_float(w[i] << 16); f[2 * i + 1] = __uint_as_float(w[i] & 0xffff0000u); ss += f[2 * i] * f[2 * i] + f[2 * i + 1] * f[2 * i + 1]; }
        ss += __shfl_xor(ss, 1); ss += __shfl_xor(ss, 2); ss += __shfl_xor(ss, 4);
        const float r = rsqrtf(ss * (1.f / 128.f) + EPS);
        v4u o0, o1;
        o0.x = pk2(f[0] * r * g[0], f[1] * r * g[1]); o0.y = pk2(f[2] * r * g[2], f[3] * r * g[3]); o0.z = pk2(f[4] * r * g[4], f[5] * r * g[5]); o0.w = pk2(f[6] * r * g[6], f[7] * r * g[7]);
        o1.x = pk2(f[8] * r * g[8], f[9] * r * g[9]); o1.y = pk2(f[10] * r * g[10], f[11] * r * g[11]); o1.z = pk2(f[12] * r * g[12], f[13] * r * g[13]); o1.w = pk2(f[14] * r * g[14], f[15] * r * g[15]);
        *(v4u*)p = o0; *(v4u*)(p + 8) = o1;
    }
}

__device__ __forceinline__ void route_phase(const Ctx& F, const bf16* X, const float* g, const float* sc, const float* sh, const float* wg, const float* bg, const float* we, const float* be,
                                            bf16* XN2, int* LIST, float* WL, gu32* cnt) {
    float* W20 = (float*)(F.lds + RING_OFF);
    for (int i = F.tid; i < 20 * 1024; i += NTHR) { const int o = i >> 10, col = i & 1023; W20[i] = o < 4 ? wg[col * 4 + o] : we[col * 16 + (o - 4)]; }
    __syncthreads();
    float bgv[4];
#pragma unroll
    for (int i = 0; i < 4; ++i) bgv[i] = bg[i];
    for (int ch = F.gw; ch < T / 16; ch += F.NGW) {
        const int r0 = ch * 16, b = r0 >> 12;
        f32x4 A[4], S[4];
#pragma unroll
        for (int j = 0; j < 4; ++j) { const int col = 4 * F.lane + 256 * j; const f32x4 gv = *(const f32x4*)(g + col), sv = *(const f32x4*)(sc + (size_t)b * 6144 + col); A[j] = gv * (1.f + sv); S[j] = *(const f32x4*)(sh + (size_t)b * 6144 + col); }
        const bf16* xr = X + (size_t)r0 * DM + 4 * F.lane;
        f32x4 nx[4];
#pragma unroll
        for (int j = 0; j < 4; ++j) nx[j] = ldrow4<bf16>(xr + 256 * j);
        for (int rr = 0; rr < 16; ++rr) { const int row = r0 + rr;
            f32x4 v[4]; float ss = 0.f;
#pragma unroll
            for (int j = 0; j < 4; ++j) { v[j] = nx[j]; ss += (v[j].x * v[j].x + v[j].y * v[j].y) + (v[j].z * v[j].z + v[j].w * v[j].w); }
            if (rr < 15) {
#pragma unroll
                for (int j = 0; j < 4; ++j) nx[j] = ldrow4<bf16>(xr + (size_t)(rr + 1) * DM + 256 * j); }
            const float rstd = rsqrtf(wave_sum(ss) * (1.f / DM) + EPS);
            unsigned char* orow = (unsigned char*)XN2 + (size_t)row * DM + 4 * F.lane;
#pragma unroll
            for (int j = 0; j < 4; ++j) { v[j] = v[j] * rstd * A[j] + S[j]; int p = 0; p = __builtin_amdgcn_cvt_pk_fp8_f32(v[j].x, v[j].y, p, false); p = __builtin_amdgcn_cvt_pk_fp8_f32(v[j].z, v[j].w, p, true); *(int*)(orow + 256 * j) = p; }
            float gl[4];
#pragma unroll
            for (int o = 0; o < 4; ++o) { float a = 0.f;
#pragma unroll
                for (int j = 0; j < 4; ++j) { const f32x4 w = *(const f32x4*)(W20 + o * 1024 + 4 * F.lane + 256 * j); a += (v[j].x * w.x + v[j].y * w.y) + (v[j].z * w.z + v[j].w * w.w); }
                gl[o] = wave_sum(a) + bgv[o]; }
            int gi = 0; float gm = gl[0]; if (gl[1] > gm) { gm = gl[1]; gi = 1; } if (gl[2] > gm) { gm = gl[2]; gi = 2; } if (gl[3] > gm) { gm = gl[3]; gi = 3; }
            gi = __builtin_amdgcn_readfirstlane(gi);
            const float gw_ = 1.f / (__expf(gl[0] - gm) + __expf(gl[1] - gm) + __expf(gl[2] - gm) + __expf(gl[3] - gm));
            const float* We = W20 + (4 + 4 * gi) * 1024 + 4 * F.lane;
            float e[4];
#pragma unroll
            for (int k = 0; k < 4; ++k) { float a = 0.f;
#pragma unroll
                for (int j = 0; j < 4; ++j) { const f32x4 w = *(const f32x4*)(We + k * 1024 + 256 * j); a += (v[j].x * w.x + v[j].y * w.y) + (v[j].z * w.z + v[j].w * w.w); }
                e[k] = wave_sum(a) + be[4 * gi + k]; }
            int i1 = 0; float m1 = e[0];
#pragma unroll
            for (int k = 1; k < 4; ++k) if (e[k] > m1) { m1 = e[k]; i1 = k; }
            int i2 = -1; float m2 = -3.0e38f;
#pragma unroll
            for (int k = 0; k < 4; ++k) if (k != i1 && e[k] > m2) { m2 = e[k]; i2 = k; }
            const float t2 = __expf(m2 - m1), w1 = gw_ / (1.f + t2), w2 = gw_ * t2 / (1.f + t2);
            const int ilo = i1 < i2 ? i1 : i2, ihi = i1 < i2 ? i2 : i1; const float wlo = i1 < i2 ? w1 : w2, whi = i1 < i2 ? w2 : w1;
            const int pi = ilo == 0 ? ihi - 1 : (ilo == 1 ? ihi + 1 : 5), bk = gi * 6 + pi;
            if (F.lane == 0) { const unsigned pos = __hip_atomic_fetch_add(cnt + bk * 64, 1u, RLX_AGENT);
                LIST[bk * 32768 + pos] = row; float2 ww; ww.x = wlo; ww.y = whi; *(float2*)(WL + ((size_t)bk * 32768 + pos) * 2) = ww; }
        }
    }
}
__device__ __forceinline__ void moe_table(const Ctx& F, const gu32* cnt) {
    int* tinfo = (int*)(F.lds + TINFO_OFF);
    __syncthreads();
    if (F.tid == 0) { int nt = 0;
        for (int b = 0; b < 24; ++b) { const int c = (int)__hip_atomic_load(cnt + b * 64, RLX_AGENT); const int tiles = (c + 255) >> 8;
            tinfo[256 + b] = nt * 256; tinfo[288 + b] = c; for (int i = 0; i < tiles; ++i) tinfo[1 + nt + i] = b; nt += tiles; }
        tinfo[0] = nt; }
    __syncthreads();
}
__device__ __forceinline__ void permute_phase(const Ctx& F, const bf16* XN2, const int* ROUTE, bf16* XN2S, int* TOKW) {
    const int* tinfo = (const int*)(F.lds + TINFO_OFF);
    for (int ch = F.gw; ch < T / 4; ch += F.NGW) {
        v4i r[4]; v4u a[4], bq[4];
#pragma unroll
        for (int i = 0; i < 4; ++i) { const int row = ch * 4 + i; r[i] = *(const v4i*)(ROUTE + (size_t)row * 4);
            a[i] = *(const v4u*)(XN2 + (size_t)row * DM + 8 * F.lane); bq[i] = *(const v4u*)(XN2 + (size_t)row * DM + 512 + 8 * F.lane); }
#pragma unroll
        for (int i = 0; i < 4; ++i) { const int row = ch * 4 + i, srow = tinfo[256 + r[i].x] + r[i].y;
            *(v4u*)(XN2S + (size_t)srow * DM + 8 * F.lane) = a[i]; *(v4u*)(XN2S + (size_t)srow * DM + 512 + 8 * F.lane) = bq[i];
            if (F.lane == 0) { v4i w; w.x = row; w.y = r[i].z; w.z = r[i].w; w.w = 0; *(v4i*)(TOKW + (size_t)srow * 4) = w; } }
    }
}

constexpr float W32C[16] = {1.f, 0.98078528040323043f, 0.92387953251128674f, 0.83146961230254524f, 0.70710678118654752f, 0.55557023301960218f, 0.38268343236508977f, 0.19509032201612825f,
                            0.f, -0.19509032201612825f, -0.38268343236508977f, -0.55557023301960218f, -0.70710678118654752f, -0.83146961230254524f, -0.92387953251128674f, -0.98078528040323043f};
constexpr float W32S[16] = {0.f, 0.19509032201612825f, 0.38268343236508977f, 0.55557023301960218f, 0.70710678118654752f, 0.83146961230254524f, 0.92387953251128674f, 0.98078528040323043f,
                            1.f, 0.98078528040323043f, 0.92387953251128674f, 0.83146961230254524f, 0.70710678118654752f, 0.55557023301960218f, 0.38268343236508977f, 0.19509032201612825f};
struct FftTw { const c32* T1; c32 tob; const c32* T2; };
template <int A> __device__ __forceinline__ c32 mul_to(c32 x, c32 tob) { const c32 y = cmul(x, tob); return cmk(y.x * W32C[A] + y.y * W32S[A], y.y * W32C[A] - y.x * W32S[A]); }
template <int A> __device__ __forceinline__ c32 mul_toc(c32 x, c32 tob) { const c32 y = cmulc(x, tob); return cmk(y.x * W32C[A] - y.y * W32S[A], y.y * W32C[A] + y.x * W32S[A]); }
#define TO_ALL(OP) OP(0) OP(1) OP(2) OP(3) OP(4) OP(5) OP(6) OP(7) OP(8) OP(9) OP(10) OP(11) OP(12) OP(13) OP(14) OP(15)
__device__ __forceinline__ void fft_twiddles(FftTw& W, int gt, c32* t1tab, c32* t2tab, int tid) {
    if (tid < 256) { float s, c; sincosf(-6.283185307179586f * (float)(((tid >> 4) * (tid & 15)) & 255) * (1.f / 256.f), &s, &c); t2tab[(tid >> 4) * 17 + (tid & 15)] = cmk(c, s); }
    for (int i = tid; i < 4096; i += NTHR) { const int p = i >> 8, t = i & 255; float s, c; sincosf(-6.283185307179586f * (float)((t * p) & 4095) * (1.f / 4096.f), &s, &c); t1tab[i] = cmk(c, s); }
    { float s, c; sincosf(-6.283185307179586f * (float)gt * (1.f / 8192.f), &s, &c); W.tob = cmk(c, s); }
    W.T1 = t1tab + gt; W.T2 = t2tab + (gt & 15) * 17;
    __syncthreads();
}
__device__ __forceinline__ void fft_forward_a(c32 (&v)[16], const FftTw& W, c32* ex, int gt) {
    __syncthreads();
    fft_fwd_a(v, W.T1, ex, gt);
    __syncthreads();
}
__device__ __forceinline__ void fft_forward_bc(c32 (&v)[16], const FftTw& W, c32* ex, int gt) {
    fft_fwd_b(v, W.T2, ex, ex, gt);
    __builtin_amdgcn_wave_barrier(); asm volatile("" ::: "memory");
    fft_fwd_c(v, ex, gt);
}
__device__ __forceinline__ void fft_forward(c32 (&v)[16], const FftTw& W, c32* ex, int gt) { fft_forward_a(v, W, ex, gt); fft_forward_bc(v, W, ex, gt); }
__device__ __forceinline__ void fft_inverse(c32 (&v)[16], const FftTw& W, c32* ex, int gt) {
    __builtin_amdgcn_wave_barrier(); asm volatile("" ::: "memory");
    fft_inv_a(v, ex, gt);
    __builtin_amdgcn_wave_barrier(); asm volatile("" ::: "memory");
    fft_inv_b(v, W.T2, ex, ex, gt);
    __syncthreads();
    fft_inv_c(v, W.T1, ex, gt);
}
__device__ __forceinline__ void filter_phase(const Ctx& F, const float* HT, const float* fbias, c32* KF) {
    const int g = __builtin_amdgcn_readfirstlane(F.tid >> 8), gt = F.tid & 255;
    c32* ex = (c32*)(F.lds + RING_OFF + g * 36864);
    float* rev = (float*)ex;
    float* red = (float*)(F.lds + RED_OFF);
    FftTw W; fft_twiddles(W, gt, (c32*)(F.lds + RING_OFF + 73728), (c32*)(F.lds + RING_OFF + 110592), F.tid);
    for (int d = F.vcu; d < DM; d += F.G) {
        int gtv = gt; asm volatile("" : "+v"(gtv));
        const float delta = fabsf(-120.39728043259361f + (float)d * ((40.546510810816436f + 120.39728043259361f) / 1023.f));
        const float* hfp = HT + (size_t)(g * 2048 + d) * 4096; const float* hbp = HT + (size_t)(g * 2048 + 1024 + d) * 4096;
        float hf[16], hb[16]; float sf = 0.f, sb = 0.f;
#pragma unroll
        for (int a = 0; a < 16; ++a) { const int t = 256 * a + gtv; const float dec = __expf(-((float)t * (1.f / 4095.f)) * delta); hf[a] = hfp[t] * dec; hb[a] = hbp[t] * dec; sf += fabsf(hf[a]); sb += fabsf(hb[a]); }
        sf = wave_sum(sf); sb = wave_sum(sb);
        __syncthreads();
        if (F.lane == 0) { red[F.wave * 2] = sf; red[F.wave * 2 + 1] = sb; }
        __syncthreads();
        sf = red[g * 8] + red[g * 8 + 2] + red[g * 8 + 4] + red[g * 8 + 6]; sb = red[g * 8 + 1] + red[g * 8 + 3] + red[g * 8 + 5] + red[g * 8 + 7];
        const float nf = 1.f / (sf + EPS) * (1.f / 8192.f), nb = 1.f / (sb + EPS) * (1.f / 8192.f);
#pragma unroll
        for (int a = 0; a < 16; ++a) rev[256 * a + gt] = hb[a] * nb;
        __syncthreads();
        c32 v[16];
#pragma unroll
        for (int a = 0; a < 16; ++a) { const int n = 256 * a + gt; hb[a] = n == 0 ? 0.f : rev[4096 - n]; hf[a] *= nf; v[a] = cmk(hf[a] + hb[a], 0.f); }
        fft_forward(v, W, ex, gt);
        c32* kf = KF + ((size_t)(d * 2 + g) * 2) * 4096; const float fb = fbias[g * 1024 + d] * (1.f / 4096.f);
#pragma unroll
        for (int i = 0; i < 16; ++i) kf[i * 256 + gtv] = cmk(v[i].x + fb, v[i].y);
#define OPX(A) v[A] = mul_to<A>(cmk(hf[A] - hb[A], 0.f), W.tob);
        TO_ALL(OPX)
#undef OPX
        fft_forward(v, W, ex, gt);
#pragma unroll
        for (int i = 0; i < 16; ++i) kf[4096 + i * 256 + gtv] = v[i];
    }
}
__device__ __forceinline__ void long_conv(c32 (&z)[16], const c32* kf, const FftTw& W, c32* ex, int gt) {
    typedef float f32x2v __attribute__((ext_vector_type(2))); typedef __attribute__((address_space(1))) const f32x2v gc32;
    c32 v[16], k[16]; int gk = gt; asm volatile("" : "+v"(gk));
#define OPX(A) v[A] = mul_to<A>(z[A], W.tob);
    TO_ALL(OPX)
#undef OPX
    fft_forward_a(v, W, ex, gt);
    asm volatile("" ::: "memory");
#pragma unroll
    for (int i = 0; i < 16; ++i) { const f32x2v t_ = ((gc32*)kf)[4096 + i * 256 + gk]; k[i] = cmk(t_.x, t_.y); }
    fft_forward_bc(v, W, ex, gt);
#pragma unroll
    for (int i = 0; i < 16; ++i) v[i] = cmul(v[i], k[i]);
    fft_inverse(v, W, ex, gt);
#define OPX(A) v[A] = mul_toc<A>(v[A], W.tob);
    TO_ALL(OPX)
#undef OPX
    fft_forward_a(z, W, ex, gt);
    asm volatile("" ::: "memory");
#pragma unroll
    for (int i = 0; i < 16; ++i) { const f32x2v t_ = ((gc32*)kf)[i * 256 + gk]; k[i] = cmk(t_.x, t_.y); }
    fft_forward_bc(z, W, ex, gt);
#pragma unroll
    for (int i = 0; i < 16; ++i) z[i] = cmul(z[i], k[i]);
    fft_inverse(z, W, ex, gt);
#pragma unroll
    for (int a = 0; a < 16; ++a) z[a] = cadd(z[a], v[a]);
}
struct RawSeq { v4u r[2][2]; };
__device__ __forceinline__ void raw_issue(RawSeq& q, const bf16* urow, int b0, int gt) {
    typedef __attribute__((address_space(1))) const v4u gv4u;
    asm volatile("" : "+v"(gt));
#pragma unroll
    for (int s_ = 0; s_ < 2; ++s_)
#pragma unroll
        for (int i = 0; i < 2; ++i) q.r[s_][i] = *(gv4u*)(urow + (size_t)(b0 + s_) * SEQ + (gt + 256 * i) * 8);
}
__device__ __forceinline__ void stage_conv3(c32 (&o)[16], const RawSeq& q, float w0, float w1, float w2, float cb, bf16* stg, int gt) {
    constexpr int SS = 4112;
    __syncthreads();
#pragma unroll
    for (int s_ = 0; s_ < 2; ++s_) {
#pragma unroll
        for (int i = 0; i < 2; ++i) *(v4u*)(stg + s_ * SS + 8 + (gt + 256 * i) * 8) = q.r[s_][i];
        if (gt == 0) { stg[s_ * SS + 7] = 0; stg[s_ * SS + 4104] = 0; } }
    __syncthreads();
#pragma unroll
    for (int a = 0; a < 16; ++a) { const int t = 256 * a + gt; float r[2];
#pragma unroll
        for (int s_ = 0; s_ < 2; ++s_) { const bf16* sp = stg + s_ * SS + 7 + t; r[s_] = w0 * bf2f(sp[0]) + w1 * bf2f(sp[1]) + w2 * bf2f(sp[2]) + cb; }
        o[a] = cmk(r[0], r[1]); if ((a & 3) == 3) __builtin_amdgcn_sched_barrier(0); }
}
__device__ __forceinline__ void conv_phase(const Ctx& F, const bf16* UT, const c32* KF, const float* convw, const float* convb, bf16* ZT) {
    const int g = __builtin_amdgcn_readfirstlane(F.tid >> 8), gt = F.tid & 255;
    c32* ex = (c32*)(F.lds + RING_OFF + g * 36864);
    bf16* stg = (bf16*)ex;
    FftTw W; fft_twiddles(W, gt, (c32*)(F.lds + RING_OFF + 73728), (c32*)(F.lds + RING_OFF + 110592), F.tid);
    RawSeq raw;
    if (F.vcu < DM) raw_issue(raw, UT + (size_t)(2048 + F.vcu) * T, (2 * g) * 2, gt);
    for (int d = F.vcu; d < DM; d += F.G) {
        const c32* kf0 = KF + ((size_t)(d * 2 + 0) * 2) * 4096; const c32* kf1 = KF + ((size_t)(d * 2 + 1) * 2) * 4096;
        for (int pp = 0; pp < 2; ++pp) { const int b0 = (2 * g + pp) * 2;
            int gtv = gt; asm volatile("" : "+v"(gtv));
            c32 z[16], gate[16];
            { const int c = 2048 + d; stage_conv3(z, raw, convw[c], convw[3072 + c], convw[6144 + c], convb[c], stg, gtv); }
            raw_issue(raw, UT + (size_t)d * T, b0, gtv);
            long_conv(z, kf0, W, ex, gtv);
            { const int c = d; stage_conv3(gate, raw, convw[c], convw[3072 + c], convw[6144 + c], convb[c], stg, gtv); }
            raw_issue(raw, UT + (size_t)(1024 + d) * T, b0, gtv);
#pragma unroll
            for (int a = 0; a < 16; ++a) z[a] = cmk(z[a].x * gate[a].x, z[a].y * gate[a].y);
            long_conv(z, kf1, W, ex, gtv);
            { const int c = 1024 + d; stage_conv3(gate, raw, convw[c], convw[3072 + c], convw[6144 + c], convb[c], stg, gtv); }
            { const int dn = pp == 0 ? d : d + F.G; if (dn < DM) raw_issue(raw, UT + (size_t)(2048 + dn) * T, pp == 0 ? b0 + 2 : (2 * g) * 2, gtv); }
            bf16* zr = ZT + (size_t)d * T + (size_t)b0 * SEQ;
#pragma unroll
            for (int a = 0; a < 16; ++a) { const int t = 256 * a + gtv; const unsigned pk = pk2(z[a].x * gate[a].x, z[a].y * gate[a].y); zr[t] = (bf16)(pk & 0xffffu); zr[SEQ + t] = (bf16)(pk >> 16); }
        }
    }
}
__device__ __forceinline__ void transpose_phase(const Ctx& F, const bf16* ZT, bf16* Z) {
    bf16* tile = (bf16*)(F.lds + RING_OFF + F.wave * 8704);
    const int l = F.lane;
    v4u x[8];
    if (F.gw < 16 * 512) { const int d0 = (F.gw & 15) * 64, t0 = (F.gw >> 4) * 64;
#pragma unroll
        for (int i = 0; i < 8; ++i) x[i] = *(const v4u*)(ZT + (size_t)(d0 + i * 8 + (l >> 3)) * T + t0 + (l & 7) * 8); }
    for (int it = F.gw; it < 16 * 512; it += F.NGW) { const int d0 = (it & 15) * 64, t0 = (it >> 4) * 64;
#pragma unroll
        for (int i = 0; i < 8; ++i) { const int dr = i * 8 + (l >> 3), c = l & 7;
            v2u* p = (v2u*)(tile + dr * 68 + c * 8); v2u a; a.x = x[i].x; a.y = x[i].y; p[0] = a; a.x = x[i].z; a.y = x[i].w; p[1] = a; }
        const int itn = it + F.NGW;
        if (itn < 16 * 512) { const int dn = (itn & 15) * 64, tn = (itn >> 4) * 64;
#pragma unroll
            for (int i = 0; i < 8; ++i) x[i] = *(const v4u*)(ZT + (size_t)(dn + i * 8 + (l >> 3)) * T + tn + (l & 7) * 8); }
        LDS_WAIT();
#pragma unroll
        for (int i = 0; i < 8; ++i) { const int tr = i * 8 + (l >> 3), c = l & 7; unsigned short e[8];
#pragma unroll
            for (int k = 0; k < 8; ++k) e[k] = tile[(c * 8 + k) * 68 + tr];
            v4u o; o.x = e[0] | ((unsigned)e[1] << 16); o.y = e[2] | ((unsigned)e[3] << 16); o.z = e[4] | ((unsigned)e[5] << 16); o.w = e[6] | ((unsigned)e[7] << 16);
            *(v4u*)(Z + (size_t)(t0 + tr) * DM + d0 + c * 8) = o; }
        LDS_WAIT();
    }
}

constexpr int NPH = 22;
constexpr int seam_id(int k) { return k == 0 ? 0 : k == 1 ? 1 : k == 2 ? 2 : k == 4 ? 3 : k == 6 ? 4 : k == 7 ? 5 : k == 8 ? 6 : k == 10 ? 7 : k == 11 ? 8 : k == 12 ? 9 : k == 14 ? 10 : k == 15 ? 11 : k == 16 ? 12 : k == 17 ? 13 : k == 18 ? 14 : k == 20 ? 15 : -100; }
#ifdef PROBE_SEAM
__device__ __forceinline__ unsigned long long probe_now() { unsigned long long t; asm volatile("s_memrealtime %0\n\ts_waitcnt lgkmcnt(0)" : "=s"(t) :: "memory"); return t; }
#define SEAMHOOK(id) do { if ((id) == PROBE_SEAM) { const unsigned long long t1_ = probe_now(); while (probe_now() < t1_ + (t1_ - tlast_)) __builtin_amdgcn_s_sleep(4); } \
                          if ((id) + 1 == PROBE_SEAM) tlast_ = probe_now(); } while (0)
#define SEAMBAR(k) do { xcd_barrier(bar); SEAMHOOK(seam_id(k)); } while (0)
#else
#define SEAMHOOK(id) do { } while (0)
#define SEAMBAR(k) xcd_barrier(bar)
#endif
#define MOE_PHASES(L) do { \
        const int mb = 8 + 10 * L; \
        if (IN(mb)) { PH_ARGS; const float* mod = WSP(float, WS_MOD) + (size_t)L * 8 * 6144; gu32* cnt = (gu32*)(ws + WS_CTL) + CW_CNT + L * 24 * 64; \
            route_phase(F, WSP(bf16, WS_XR), in[6] + L * 1024, mod + 4 * 1024, mod + 3 * 1024, in[31] + L * 4096, in[32] + L * 4, in[33] + L * 16384, in[34] + L * 16, WSP(bf16, WS_XN2), WSP(int, WS_LIST), WSP(float, WS_WL), cnt); \
            if (L == 0) { __syncthreads();        \
                pg8::Gemm gmh{WSP(bf16, WS_W4S), WSP(bf16, WS_HDNS), 4096, 4096, 256}; pg8::StaticOrder Sh; Sh.init(4096, 4096, F.G, (int)blockIdx.x); pg8::EpiF32 Eh{WSP(float, WS_HT), 4096}; \
                REP(11) pg8::gemm_phase<pg8::EpiF32, pg8::StaticOrder, true, true>(ring, gmh, Sh, Eh, F.tid); } } \
        if (IN(mb) && IN(mb + 2)) SEAMBAR(mb); \
        if (IN(mb + 2)) { PH_ARGS; gu32* cnt = (gu32*)(ws + WS_CTL) + CW_CNT + L * 24 * 64; moe_table(F, cnt); \
              \
            pg8::Gemm gm{WSP(bf16, WS_XN2), (const bf16*)(ws + WS_WGU + (size_t)L * 16 * 512 * 1024), MS_ROWS, 8192, 512}; pg8::MoeOrder S{tinfo, F.G, F.vcu, 0, WSP(int, WS_LIST)}; pg8::EpiSwiGLU E{WSP(bf16, WS_HACT), WSP(float, WS_WL), tinfo}; \
            REP(10) pg8::gemm_phase_gather<pg8::EpiSwiGLU, pg8::MoeOrder, true, true, 5>(ring, gm, S, E, F.tid); } SEAM(mb + 2); \
        if (IN(mb + 3)) { PH_ARGS; gu32* cnt = (gu32*)(ws + WS_CTL) + CW_CNT + L * 24 * 64; moe_table(F, cnt); const float* mod = WSP(float, WS_MOD) + (size_t)L * 8 * 6144; \
            pg8::Gemm gm{WSP(bf16, WS_HACT), WSP(bf16, WS_WDN) + (size_t)L * 24 * 1024 * 512, MS_ROWS, 24 * 1024, 512}; pg8::MoeOrder S{tinfo, F.G, F.vcu, 1, WSP(int, WS_LIST)}; if (L == 0) { pg8::EpiMoeOut<bf16> E{WSP(bf16, WS_XR), WSP(bf16, WS_XR), mod + 5 * 1024, WSP(int, WS_LIST), tinfo, (PG8_LAS float*)((PG8_LAS unsigned char*)lds + EPIX_OFF)}; pg8::gemm_phase<pg8::EpiMoeOut<bf16>, pg8::MoeOrder, true, true>(ring, gm, S, E, F.tid); } \
            else { pg8::EpiMoeOut<float> E{WSP(bf16, WS_XR), out, mod + 5 * 1024, WSP(int, WS_LIST), tinfo, (PG8_LAS float*)((PG8_LAS unsigned char*)lds + EPIX_OFF)}; pg8::gemm_phase<pg8::EpiMoeOut<float>, pg8::MoeOrder, true, true>(ring, gm, S, E, F.tid); } \
            if (L == 0) { __syncthreads(); REP(13) filter_phase(F, WSP(float, WS_HT), in[29], WSP(c32, WS_KF)); }       \
            } \
    } while (0)
struct Args { const float* in[38]; float* out; unsigned char* ws; int ph_lo, ph_hi; };
static_assert(sizeof(Args) == 38 * 8 + 8 + 8 + 8, "Args layout (read back through the kernarg segment pointer)");
__global__ void __launch_bounds__(NTHR, 2) fwd_kernel(Args args) {
    extern __shared__ __attribute__((aligned(16))) unsigned char lds[];
#define MK_CTX(F, tx) Ctx F; F.lds = lds; F.tid = (tx); F.lane = F.tid & 63; F.wave = __builtin_amdgcn_readfirstlane(F.tid >> 6); \
    F.G = gridDim.x; { const int bx = blockIdx.x; F.vcu = (F.G % 8 == 0) ? (bx % 8) * (F.G / 8) + bx / 8 : bx; } F.gw = F.vcu * NWAVES + F.wave; F.NGW = F.G * NWAVES
    for (int u = threadIdx.x; u < (LDS_BYTES - LDSCTL_OFF) / 4; u += NTHR) ((LAS unsigned*)((LAS unsigned char*)lds + LDSCTL_OFF))[u] = 0u;
    __syncthreads();
    const int wave_s_ = __builtin_amdgcn_readfirstlane(threadIdx.x >> 6);
    const int lo = args.ph_lo, hi = args.ph_hi;
    const bool use_bar = (hi - lo) > 1;
    XcdBarrier bar; bar.bar = (unsigned*)(args.ws + WS_CTL) + CW_BAR; bar.x = 0; bar.st = nullptr; bar.w0 = 0;
    if (use_bar) bar = xcd_barrier_post((unsigned*)(args.ws + WS_CTL) + CW_BAR, (volatile LAS unsigned*)((LAS unsigned char*)lds + MISC_OFF) + 8);
    bar.w0 = (wave_s_ == 0) ? 1 : 0;
#ifndef PHMASK
#define PHMASK 0xFFFFFFFFu
#endif
#define IN(k) (((PHMASK >> ((k) >= 18 ? (k) - 10 : (k))) & 1u) && lo <= (k) && (k) < hi)
#ifndef REPMASK
#define REPMASK 0u
#endif
#define NREP(k) (((REPMASK >> (k)) & 1u) ? 2 : 1)
#define REP(k) for (int rep_ = 0; rep_ < NREP(k); ++rep_)
#define SEAM(k) do { if (IN(k) && IN((k) + 1)) SEAMBAR(k); } while (0)
#define PH_STR2(x) #x
#define PH_STR(x) PH_STR2(x)
#define PH_ARGS int opq_ = 0; asm volatile("; PHMARK line " PH_STR(__LINE__) : "+s"(opq_)); const In in{opq_}; unsigned char* const ws = karg_ws(opq_); float* const out = karg_out(opq_); (void)in; (void)ws; (void)out; int tx_; asm volatile("v_mbcnt_lo_u32_b32 %0, -1, 0\n\tv_mbcnt_hi_u32_b32 %0, -1, %0" : "=v"(tx_)); tx_ += wave_s_ * 64; MK_CTX(F, tx_)
#define WSP(type, off) ((type*)(ws + (off)))
    PG8_LAS unsigned char* ring = (PG8_LAS unsigned char*)lds + RING_OFF;
    const PG8_LAS int* tinfo = (const PG8_LAS int*)((PG8_LAS unsigned char*)lds + TINFO_OFF);

#ifdef PROBE_SEAM
    unsigned long long tlast_ = probe_now();
#endif
    if (IN(0)) { PH_ARGS; REP(0) p0_prologue(F, in, ws); } SEAM(0);

            if (IN(1)) { PH_ARGS; const float* mod = WSP(float, WS_MOD); REP(1) norm_mod_phase<float, true>(F, in[0], in[5], mod + 1024, mod, WSP(bf16, WS_XN)); } SEAM(1);
            if (IN(2)) { PH_ARGS; pg8::Gemm gm{WSP(bf16, WS_XN), WSP(bf16, WS_WD), T, 512, 512};   pg8::StaticOrder S; S.init(T, 512, F.G, (int)blockIdx.x);
                pg8::EpiLat E{WSP(unsigned char, WS_CQN), WSP(bf16, WS_CKVN), WSP(unsigned char, WS_KPE), in[8], in[9], in[13], WSP(float, WS_ROPE), (PG8_LAS float*)((PG8_LAS unsigned char*)lds + EPIX_OFF)};
                REP(2) pg8::gemm_phase<pg8::EpiLat, pg8::StaticOrder, true, true, 5>(ring, gm, S, E, F.tid); }
            if (IN(2) && IN(4)) SEAMBAR(2);
            if (IN(4)) { REP(4) {
                { PH_ARGS; pg8::Gemm gm{WSP(bf16, WS_CQN), WSP(bf16, WS_WUQ), T, 1536, 128};   pg8::StaticOrder S; S.init(T, 1536, F.G, (int)blockIdx.x); pg8::EpiBf16R E{WSP(bf16, WS_QRAW), 1536, nullptr};
                  pg8::gemm_phase<pg8::EpiBf16R, pg8::StaticOrder, true, true, 4>(ring, gm, S, E, F.tid); }
                { PH_ARGS; pg8::Gemm gm{WSP(bf16, WS_CKVN), WSP(bf16, WS_WUKV), T, 1024, 128};   pg8::StaticOrder S; S.init(T, 1024, F.G, (int)blockIdx.x);
                  pg8::EpiK8 E{WSP(unsigned char, WS_K8), in[13], (PG8_LAS float*)((PG8_LAS unsigned char*)lds + EPIX_OFF)};
                  pg8::gemm_phase<pg8::EpiK8, pg8::StaticOrder, true, true>(ring, gm, S, E, F.tid); }
                { PH_ARGS; pg8::Gemm gm{WSP(bf16, WS_WUKV) + 1024 * 128, WSP(bf16, WS_CKVN), 1024, T, 128}; pg8::StaticOrder S; S.init(1024, T, F.G, (int)blockIdx.x);
                  pg8::EpiF8T E{WSP(unsigned char, WS_VT8), T};
                  pg8::gemm_phase<pg8::EpiF8T, pg8::StaticOrder, true, true>(ring, gm, S, E, F.tid); } }
            } if (IN(4) && IN(6)) SEAMBAR(4);
            if (IN(6)) { PH_ARGS;
                const float* qg = in[12]; const float* kg = in[13];
                float gqn = 0.f, gkn = 0.f, gqp = 0.f, gkp = 0.f;
                for (int i = 0; i < 128; ++i) { gqn = fmaxf(gqn, fabsf(qg[i])); gkn = fmaxf(gkn, fabsf(kg[i])); }
                for (int i = 128; i < 192; ++i) { gqp = fmaxf(gqp, fabsf(qg[i])); gkp = fmaxf(gkp, fabsf(kg[i])); }
                const float smaxC = (128.f * gqn * gkn + 64.f * gqp * gkp) * (0.072168783648703220f * 1.4426950408889634f);
                unsigned redo_mask = 0u;
                if (smaxC < 60.f) for (int rep_ = 0; rep_ < NREP(6); ++rep_) { int i = 0;
                    for (int u = F.vcu; u < 1024; u += F.G, ++i) { const int b = u >> 7, h = (u >> 4) & 7, qb = u & 15;
                        if (att::attn_unit<false>(b, h, qb * 256, WSP(bf16, WS_QRAW), WSP(unsigned char, WS_VT8), WSP(unsigned char, WS_K8), WSP(unsigned char, WS_KPE), WSP(bf16, WS_O), WSP(float, WS_ROPE), qg, smaxC, (char*)lds + RING_OFF, F.tid)) redo_mask |= 1u << (i & 31); } }
                else redo_mask = 0xffffffffu;
                redo_mask = (unsigned)__builtin_amdgcn_readfirstlane((int)redo_mask);
                if (redo_mask) { int i = 0;
                    for (int u = F.vcu; u < 1024; u += F.G, ++i) { const int b = u >> 7, h = (u >> 4) & 7, qb = u & 15;
                        if ((redo_mask >> (i & 31)) & 1u) (void)att::attn_unit<true>(b, h, qb * 256, WSP(bf16, WS_QRAW), WSP(unsigned char, WS_VT8), WSP(unsigned char, WS_K8), WSP(unsigned char, WS_KPE), WSP(bf16, WS_O), WSP(float, WS_ROPE), qg, smaxC, (char*)lds + RING_OFF, F.tid); } }
            } SEAM(6);
            if (IN(7)) { PH_ARGS; pg8::Gemm gm{WSP(bf16, WS_O), WSP(bf16, WS_WO), T, 1024, 512};   pg8::StaticOrder S; S.init(T, 1024, F.G, (int)blockIdx.x); pg8::EpiResGate<float, bf16> E{in[0], WSP(bf16, WS_XR), WSP(float, WS_MOD) + 2048, 1024};
                REP(7) pg8::gemm_phase<pg8::EpiResGate<float, bf16>, pg8::StaticOrder, true, true, 10>(ring, gm, S, E, F.tid); } SEAM(7);
    MOE_PHASES(0); SEAM(11);
            if (IN(12)) { PH_ARGS; const float* mod = WSP(float, WS_MOD) + 8 * 6144; REP(12) norm_mod_phase(F, WSP(bf16, WS_XR), in[5] + 1024, mod + 1024, mod, (bf16*)out); }
            if (IN(12) && IN(14)) SEAMBAR(12);
            if (IN(14)) { PH_ARGS; pg8::Gemm gm{WSP(bf16, WS_WIN), (const bf16*)out, 3072, T, 1024}; pg8::StaticOrder S; S.init(3072, T, F.G, (int)blockIdx.x); pg8::EpiBf16R E{WSP(bf16, WS_UT), T, in[16]};
                REP(14) pg8::gemm_phase<pg8::EpiBf16R, pg8::StaticOrder, true, true>(ring, gm, S, E, F.tid); } SEAM(14);
            if (IN(15)) { PH_ARGS; for (int rep = 0; rep < NREP(15); ++rep) conv_phase(F, WSP(bf16, WS_UT), WSP(c32, WS_KF), in[17], in[18], (bf16*)out); } SEAM(15);
            if (IN(16)) { PH_ARGS; REP(16) transpose_phase(F, (const bf16*)out, WSP(bf16, WS_Z)); } SEAM(16);
            if (IN(17)) { PH_ARGS; pg8::Gemm gm{WSP(bf16, WS_Z), WSP(bf16, WS_WOUT), T, 1024, 1024}; pg8::StaticOrder S; S.init(T, 1024, F.G, (int)blockIdx.x); pg8::EpiResGate<bf16, bf16> E{WSP(bf16, WS_XR), WSP(bf16, WS_XR), WSP(float, WS_MOD) + 8 * 6144 + 2048, 1024};
                pg8::gemm_phase<pg8::EpiResGate<bf16, bf16>, pg8::StaticOrder, true, true>(ring, gm, S, E, F.tid); } SEAM(17);
    MOE_PHASES(1);
#ifdef PROBE_SEAM
    SEAMHOOK(16);
#endif
#undef IN
#undef SEAM
}

#ifndef ONE_LAUNCH
#define ONE_LAUNCH 1
#endif
extern "C" void kernel_launch(void* const* d_in, const int* in_sizes, int n_in, void* d_out, int out_size, void* d_ws, size_t ws_size, hipStream_t stream) {
    static int grid = 0;
    if (grid == 0) {
        if (n_in != 38 || in_sizes[0] != T * DM || out_size != T * DM || ws_size < WS_END) { fprintf(stderr, "kernel_launch: shape mismatch n_in %d in0 %d out %d ws %zu\n", n_in, n_in > 0 ? in_sizes[0] : -1, out_size, ws_size); grid = -1; return; }
        int dev = 0, cus = 0, per_cu = 0;
        if (hipGetDevice(&dev) != hipSuccess || hipDeviceGetAttribute(&cus, hipDeviceAttributeMultiprocessorCount, dev) != hipSuccess) { grid = -1; return; }
        if (hipFuncSetAttribute((const void*)fwd_kernel, hipFuncAttributeMaxDynamicSharedMemorySize, LDS_BYTES) != hipSuccess) { fprintf(stderr, "kernel_launch: hipFuncSetAttribute failed\n"); grid = -1; return; }
        if (hipOccupancyMaxActiveBlocksPerMultiprocessor(&per_cu, (const void*)fwd_kernel, NTHR, LDS_BYTES) != hipSuccess || per_cu < 1) { fprintf(stderr, "kernel_launch: occupancy query says %d\n", per_cu); }
        (void)hipGetLastError();
        grid = cus;
    }
    if (grid < 0) return;
    if (hipMemsetAsync((char*)d_ws + WS_CTL, 0, CTL_ZERO_BYTES, stream) != hipSuccess) return;
    Args a{};
    for (int i = 0; i < 38; ++i) a.in[i] = (const float*)d_in[i];
    a.out = (float*)d_out; a.ws = (unsigned char*)d_ws;
#if ONE_LAUNCH
    a.ph_lo = 0; a.ph_hi = NPH;
    hipLaunchKernelGGL(fwd_kernel, dim3(grid), dim3(NTHR), LDS_BYTES, stream, a);
#else
    for (int p = 0; p < NPH; ++p) { a.ph_lo = p; a.ph_hi = p + 1; hipLaunchKernelGGL(fwd_kernel, dim3(grid), dim3(NTHR), LDS_BYTES, stream, a); }
#endif
    const hipError_t le = hipPeekAtLastError();
    if (le != hipSuccess) fprintf(stderr, "kernel_launch: launch failed: %s\n", hipGetErrorName(le));
}
```

```cpp
#include <hip/hip_runtime.h>
#include <cstdio>
#include <cstdint>
namespace pg8 {
#define PG8_LAS __attribute__((address_space(3)))
typedef unsigned short bf16_t;
typedef short bf16x8 __attribute__((ext_vector_type(8)));
typedef float f32x4 __attribute__((ext_vector_type(4)));
typedef unsigned u32x4 __attribute__((ext_vector_type(4)));
typedef int v4i_t __attribute__((ext_vector_type(4)));
typedef int v8i_t __attribute__((ext_vector_type(8)));
constexpr int BM = 256, BK = 64, HALF = 128, HTB = HALF * BK * 2  , STAGE_BYTES = 8 * HTB, NXCD = 8, WGM = 8;

__host__ __device__ __forceinline__ int lds_byte(int r, int c) { const int st = (r >> 4) * 2 + (c >> 5), rr = r & 15, cc = c & 31, ob = rr * 64 + cc * 2; return st * 1024 + (ob ^ (((ob >> 9) & 1) << 5)); }
__host__ __device__ __forceinline__ void stage_rc(int b, int& R, int& C) { const int st = b / 1024, sb = b % 1024, swz = sb ^ (((sb >> 9) & 1) << 5); R = (st >> 1) * 16 + swz / 64; C = (st & 1) * 32 + (swz % 64) / 2; }
__host__ __device__ __forceinline__ int perm32(int rho) { const int n = rho >> 4, i = rho & 15; return 8 * (i >> 2) + 4 * n + (i & 3); }

struct Unit { int pm, pn; };
struct Gemm { const bf16_t* A; const bf16_t* Bt; int M, N, K; };

struct StaticOrder {
    int nM, nN, nwg, G, c;
    __host__ __device__ void init(int M, int N, int G_, int c_) { nM = M / BM; nN = N / BM; nwg = nM * nN; G = G_; c = c_; }
    __host__ __device__ bool next(int i, Unit& u) const {
        const long L = (long)i * G + c; if (L >= nwg) return false;
        int wgid = (int)L; { const int q = nwg / NXCD, r = nwg % NXCD, xcd = wgid % NXCD, off = wgid / NXCD; wgid = (xcd < r ? xcd * (q + 1) : r * (q + 1) + (xcd - r) * q) + off; }
        const int nig = WGM * nN, gid = wgid / nig, fm = gid * WGM, gsz = (nM - fm) < WGM ? (nM - fm) : WGM;
        u.pm = fm + ((wgid % nig) % gsz); u.pn = (wgid % nig) / gsz; return true;
    }
    __device__ __forceinline__ void a_ready(const Unit&) const {}
    __device__ __forceinline__ void done(const Unit&) const {}
};

__device__ __forceinline__ unsigned cvt_pk_bf16(float lo, float hi) { unsigned r; asm volatile("v_cvt_pk_bf16_f32 %0, %1, %2" : "=v"(r) : "v"(lo), "v"(hi)); return r; }
typedef float f32x2 __attribute__((ext_vector_type(2)));
typedef unsigned u32x2 __attribute__((ext_vector_type(2)));
struct EpiF32 {
    static constexpr bool PERM = false, AFTER_DRAIN = false;
    float* C; int ldc;
    __device__ __forceinline__ void operator()(const f32x4 (&acc)[2][2][4][2], const Unit& u, int wr, int wc, int fr, int fq) const {
        const int row0 = u.pm * BM + wr * 64 + fr, col0 = u.pn * BM + wc * 32 + 4 * fq;
#pragma unroll
        for (int ai = 0; ai < 2; ++ai)
#pragma unroll
            for (int m = 0; m < 4; ++m) { float* rowp = C + (size_t)(row0 + ai * HALF + m * 16) * ldc + col0;
#pragma unroll
                for (int bj = 0; bj < 2; ++bj)
#pragma unroll
                    for (int n = 0; n < 2; ++n) *(f32x4*)(rowp + bj * HALF + n * 16) = acc[ai][bj][m][n]; }
    }
};
struct EpiBf16R {
    static constexpr bool PERM = true, AFTER_DRAIN = false;
    bf16_t* O; int ldc; const float* rowbias;
    __device__ __forceinline__ void operator()(const f32x4 (&acc)[2][2][4][2], const Unit& u, int wr, int wc, int fr, int fq) const {
        const int row0 = u.pm * BM + wr * 64 + fr, col0 = u.pn * BM + wc * 32 + 8 * fq;
#pragma unroll
        for (int ai = 0; ai < 2; ++ai)
#pragma unroll
            for (int m = 0; m < 4; ++m) { const int row = row0 + ai * HALF + m * 16; bf16_t* rowp = O + (size_t)row * ldc + col0; const float rb = rowbias ? rowbias[row] : 0.f;
#pragma unroll
                for (int bj = 0; bj < 2; ++bj) { const f32x4 v0 = acc[ai][bj][m][0] + rb, v1 = acc[ai][bj][m][1] + rb;
                    u32x4 w; w.x = cvt_pk_bf16(v0[0], v0[1]); w.y = cvt_pk_bf16(v0[2], v0[3]); w.z = cvt_pk_bf16(v1[0], v1[1]); w.w = cvt_pk_bf16(v1[2], v1[3]);
                    *(u32x4*)(rowp + bj * HALF) = w; } }
    }
};
__device__ __forceinline__ f32x4 ld4(const float* p) { return *(const f32x4*)p; }
__device__ __forceinline__ f32x4 ld4(const bf16_t* p) { const u32x2 w = *(const u32x2*)p; f32x4 r; r[0] = __uint_as_float(w.x << 16); r[1] = __uint_as_float(w.x & 0xffff0000u); r[2] = __uint_as_float(w.y << 16); r[3] = __uint_as_float(w.y & 0xffff0000u); return r; }
__device__ __forceinline__ void st4(float* p, f32x4 v) { *(f32x4*)p = v; }
__device__ __forceinline__ void st4(bf16_t* p, f32x4 v) { u32x2 w; w.x = cvt_pk_bf16(v[0], v[1]); w.y = cvt_pk_bf16(v[2], v[3]); *(u32x2*)p = w; }
__device__ __forceinline__ f32x4 ldraw(const float* p) { return *(const f32x4*)p; }
__device__ __forceinline__ u32x2 ldraw(const bf16_t* p) { return *(const u32x2*)p; }
__device__ __forceinline__ f32x4 cvraw(f32x4 v) { return v; }
__device__ __forceinline__ f32x4 cvraw(u32x2 w) { f32x4 r; r[0] = __uint_as_float(w.x << 16); r[1] = __uint_as_float(w.x & 0xffff0000u); r[2] = __uint_as_float(w.y << 16); r[3] = __uint_as_float(w.y & 0xffff0000u); return r; }
template <class TB, class TO> struct EpiResGate {
    static constexpr bool PERM = false, AFTER_DRAIN = false;
    const TB* base; TO* out; const float* gate; int ldc;
    __device__ __forceinline__ void operator()(const f32x4 (&acc)[2][2][4][2], const Unit& u, int wr, int wc, int fr, int fq) const {
        const int row0 = u.pm * BM + wr * 64 + fr, col0 = u.pn * BM + wc * 32 + 4 * fq;
        const float* gp = gate + (size_t)(u.pm >> 4) * 6144 + col0;
        f32x4 gv[2][2];
#pragma unroll
        for (int bj = 0; bj < 2; ++bj)
#pragma unroll
            for (int n = 0; n < 2; ++n) gv[bj][n] = *(const f32x4*)(gp + bj * HALF + n * 16);
        constexpr int GB = sizeof(TB) == 2 ? 8 : 4;
        typedef decltype(ldraw(base)) raw_t;
#pragma unroll
        for (int g0 = 0; g0 < 8; g0 += GB) {
            raw_t bs[GB][2][2];
#pragma unroll
            for (int g = 0; g < GB; ++g) { const unsigned off = (unsigned)((row0 + ((g0 + g) >> 2) * HALF + ((g0 + g) & 3) * 16) * ldc + col0);
#pragma unroll
                for (int bj = 0; bj < 2; ++bj)
#pragma unroll
                    for (int n = 0; n < 2; ++n) bs[g][bj][n] = ldraw(base + off + bj * HALF + n * 16); }
#pragma unroll
            for (int g = 0; g < GB; ++g) { const int ai = (g0 + g) >> 2, m = (g0 + g) & 3; const unsigned off = (unsigned)((row0 + ai * HALF + m * 16) * ldc + col0);
#pragma unroll
                for (int bj = 0; bj < 2; ++bj)
#pragma unroll
                    for (int n = 0; n < 2; ++n) st4(out + off + bj * HALF + n * 16, cvraw(bs[g][bj][n]) + gv[bj][n] * acc[ai][bj][m][n]); }
            asm volatile("" ::: "memory"); }
    }
};
struct EpiLat {
    static constexpr bool PERM = false, AFTER_DRAIN = false;
    unsigned char* CQN  ; bf16_t* CKVN; unsigned char* KPE  ; const float* qag; const float* kvag; const float* kng; const float* rope; PG8_LAS float* P;
    __device__ __forceinline__ void operator()(const f32x4 (&acc)[2][2][4][2], const Unit& u, int wr, int wc, int, int) const {
        int ln = (int)__builtin_amdgcn_mbcnt_hi(~0u, __builtin_amdgcn_mbcnt_lo(~0u, 0u)); asm volatile("" : "+v"(ln)); const int fr = ln & 15, fq = ln >> 4;
        const int row0 = u.pm * BM + wr * 64 + fr;
#pragma unroll
        for (int ai = 0; ai < 2; ++ai)
#pragma unroll
            for (int m = 0; m < 4; ++m) { float s0 = 0.f, s1 = 0.f;
#pragma unroll
                for (int n = 0; n < 2; ++n) { const f32x4 a = acc[ai][0][m][n], b = acc[ai][1][m][n];
                    s0 += (a[0] * a[0] + a[1] * a[1]) + (a[2] * a[2] + a[3] * a[3]); s1 += (b[0] * b[0] + b[1] * b[1]) + (b[2] * b[2] + b[3] * b[3]); }
                s0 += __shfl_xor(s0, 16); s0 += __shfl_xor(s0, 32); s1 += __shfl_xor(s1, 16); s1 += __shfl_xor(s1, 32);
                if (fq == 0) { const int rl = ai * HALF + wr * 64 + m * 16 + fr; P[rl * 8 + wc] = s0; P[rl * 8 + 4 + wc] = s1; } }
        asm volatile("s_waitcnt lgkmcnt(0)" ::: "memory"); __builtin_amdgcn_s_barrier(); asm volatile("" ::: "memory");
        const int cl = wc * 32 + 4 * fq;
        if (u.pn == 0) {
            f32x4 g[2][2];
#pragma unroll
            for (int bj = 0; bj < 2; ++bj)
#pragma unroll
                for (int n = 0; n < 2; ++n) g[bj][n] = *(const f32x4*)(qag + bj * HALF + cl + 16 * n);
#pragma unroll
            for (int ai = 0; ai < 2; ++ai)
#pragma unroll
                for (int m = 0; m < 4; ++m) { const int rl = ai * HALF + wr * 64 + m * 16 + fr; const f32x4 pa = *(const PG8_LAS f32x4*)(P + rl * 8), pb = *(const PG8_LAS f32x4*)(P + rl * 8 + 4);
                    const float r = __builtin_amdgcn_rsqf((((pa[0] + pa[1]) + (pa[2] + pa[3])) + ((pb[0] + pb[1]) + (pb[2] + pb[3]))) * (1.f / 256.f) + 1e-6f);
                    unsigned char* rowp = CQN + (size_t)(row0 + ai * HALF + m * 16) * 256 + cl;
#pragma unroll
                    for (int bj = 0; bj < 2; ++bj)
#pragma unroll
                        for (int n = 0; n < 2; ++n) { const f32x4 v = acc[ai][bj][m][n] * r * g[bj][n]; int p = 0; p = __builtin_amdgcn_cvt_pk_fp8_f32(v[0], v[1], p, false); p = __builtin_amdgcn_cvt_pk_fp8_f32(v[2], v[3], p, true); *(int*)(rowp + bj * HALF + 16 * n) = p; } }
        } else {
            f32x4 gk[2], gp[2]; const int e0 = 16 * (wc & 1) + 4 * fq;
#pragma unroll
            for (int n = 0; n < 2; ++n) { gk[n] = *(const f32x4*)(kvag + cl + 16 * n); gp[n] = *(const f32x4*)(kng + 128 + e0 + 32 * n); }
#pragma unroll
            for (int ai = 0; ai < 2; ++ai)
#pragma unroll
                for (int m = 0; m < 4; ++m) { const int rl = ai * HALF + wr * 64 + m * 16 + fr; const f32x4 pa = *(const PG8_LAS f32x4*)(P + rl * 8), pb = *(const PG8_LAS f32x4*)(P + rl * 8 + 4);
                    const float rkv = __builtin_amdgcn_rsqf(((pa[0] + pa[1]) + (pa[2] + pa[3])) * (1.f / 128.f) + 1e-6f), rpe = __builtin_amdgcn_rsqf((pb[0] + pb[1]) * (1.f / 64.f) + 1e-6f);
                    const size_t row = (size_t)(row0 + ai * HALF + m * 16);
#pragma unroll
                    for (int n = 0; n < 2; ++n) { const f32x4 v = acc[ai][0][m][n] * rkv * gk[n]; u32x2 w; w.x = cvt_pk_bf16(v[0], v[1]); w.y = cvt_pk_bf16(v[2], v[3]); *(u32x2*)(CKVN + row * 128 + cl + 16 * n) = w; }
                    if (wc < 2) { const f32x4 x1 = acc[ai][1][m][0] * rpe * gp[0], x2 = acc[ai][1][m][1] * rpe * gp[1];
                        const f32x4 c0 = *(const f32x4*)(rope + row * 64 + e0 * 2), c1 = *(const f32x4*)(rope + row * 64 + e0 * 2 + 4);
                        const float cs[4] = {c0[0], c0[2], c1[0], c1[2]}, sn[4] = {c0[1], c0[3], c1[1], c1[3]};
                        float o1[4], o2[4];
#pragma unroll
                        for (int j = 0; j < 4; ++j) { o1[j] = x1[j] * cs[j] - x2[j] * sn[j]; o2[j] = x1[j] * sn[j] + x2[j] * cs[j]; }
                        int w1 = 0, w2 = 0; w1 = __builtin_amdgcn_cvt_pk_fp8_f32(o1[0], o1[1], w1, false); w1 = __builtin_amdgcn_cvt_pk_fp8_f32(o1[2], o1[3], w1, true); w2 = __builtin_amdgcn_cvt_pk_fp8_f32(o2[0], o2[1], w2, false); w2 = __builtin_amdgcn_cvt_pk_fp8_f32(o2[2], o2[3], w2, true);
                        *(int*)(KPE + row * 64 + e0) = w1; *(int*)(KPE + row * 64 + 32 + e0) = w2; }
                    asm volatile("" ::: "memory"); }
        }
        asm volatile("s_waitcnt lgkmcnt(0)" ::: "memory"); __builtin_amdgcn_s_barrier(); asm volatile("" ::: "memory");
    }
};
struct EpiK8 {
    static constexpr bool PERM = true, AFTER_DRAIN = false;
    unsigned char* K8; const float* kng; PG8_LAS float* P;
    __device__ __forceinline__ void operator()(const f32x4 (&acc)[2][2][4][2], const Unit& u, int wr, int wc, int, int) const {
        int ln = (int)__builtin_amdgcn_mbcnt_hi(~0u, __builtin_amdgcn_mbcnt_lo(~0u, 0u)); asm volatile("" : "+v"(ln)); const int fr = ln & 15, fq = ln >> 4;
#pragma unroll
        for (int ai = 0; ai < 2; ++ai)
#pragma unroll
            for (int m = 0; m < 4; ++m) {
#pragma unroll
                for (int bj = 0; bj < 2; ++bj) { const f32x4 a = acc[ai][bj][m][0], b = acc[ai][bj][m][1];
                    float s = (a[0] * a[0] + a[1] * a[1]) + (a[2] * a[2] + a[3] * a[3]) + (b[0] * b[0] + b[1] * b[1]) + (b[2] * b[2] + b[3] * b[3]);
                    s += __shfl_xor(s, 16); s += __shfl_xor(s, 32);
                    if (fq == 0) P[(ai * HALF + wr * 64 + m * 16 + fr) * 8 + bj * 4 + wc] = s; } }
        asm volatile("s_waitcnt lgkmcnt(0)" ::: "memory"); __builtin_amdgcn_s_barrier(); asm volatile("" ::: "memory");
        const f32x4 g0 = *(const f32x4*)(kng + wc * 32 + 8 * fq), g1 = *(const f32x4*)(kng + wc * 32 + 8 * fq + 4);
        const int row0 = u.pm * BM + wr * 64 + fr;
#pragma unroll
        for (int ai = 0; ai < 2; ++ai)
#pragma unroll
            for (int m = 0; m < 4; ++m) { const int rl = ai * HALF + wr * 64 + m * 16 + fr;
#pragma unroll
                for (int bj = 0; bj < 2; ++bj) { const f32x4 p4 = *(const PG8_LAS f32x4*)(P + rl * 8 + bj * 4);
                    const float r = __builtin_amdgcn_rsqf(((p4[0] + p4[1]) + (p4[2] + p4[3])) * (1.f / 128.f) + 1e-6f);
                    const f32x4 v0 = acc[ai][bj][m][0] * r * g0, v1 = acc[ai][bj][m][1] * r * g1;
                    int w0 = 0, w1 = 0; w0 = __builtin_amdgcn_cvt_pk_fp8_f32(v0[0], v0[1], w0, false); w0 = __builtin_amdgcn_cvt_pk_fp8_f32(v0[2], v0[3], w0, true); w1 = __builtin_amdgcn_cvt_pk_fp8_f32(v1[0], v1[1], w1, false); w1 = __builtin_amdgcn_cvt_pk_fp8_f32(v1[2], v1[3], w1, true);
                    u32x2 w; w.x = (unsigned)w0; w.y = (unsigned)w1; *(u32x2*)(K8 + ((size_t)(row0 + ai * HALF + m * 16) * 8 + 2 * u.pn + bj) * 128 + wc * 32 + 8 * fq) = w; } }
        asm volatile("s_waitcnt lgkmcnt(0)" ::: "memory"); __builtin_amdgcn_s_barrier(); asm volatile("" ::: "memory");
    }
};
struct EpiF8T {
    static constexpr bool PERM = true, AFTER_DRAIN = false;
    unsigned char* O; int ldc;
    __device__ __forceinline__ void operator()(const f32x4 (&acc)[2][2][4][2], const Unit& u, int wr, int wc, int fr, int fq) const {
        const int row0 = u.pm * BM + wr * 64 + fr, col0 = u.pn * BM + wc * 32 + 8 * fq;
#pragma unroll
        for (int ai = 0; ai < 2; ++ai)
#pragma unroll
            for (int m = 0; m < 4; ++m) { unsigned char* rowp = O + (size_t)(row0 + ai * HALF + m * 16) * ldc + col0;
#pragma unroll
                for (int bj = 0; bj < 2; ++bj) { const f32x4 v0 = acc[ai][bj][m][0], v1 = acc[ai][bj][m][1];
                    int w0 = 0, w1 = 0; w0 = __builtin_amdgcn_cvt_pk_fp8_f32(v0[0], v0[1], w0, false); w0 = __builtin_amdgcn_cvt_pk_fp8_f32(v0[2], v0[3], w0, true); w1 = __builtin_amdgcn_cvt_pk_fp8_f32(v1[0], v1[1], w1, false); w1 = __builtin_amdgcn_cvt_pk_fp8_f32(v1[2], v1[3], w1, true);
                    u32x2 w; w.x = (unsigned)w0; w.y = (unsigned)w1; *(u32x2*)(rowp + bj * HALF) = w; } }
    }
};
__device__ __forceinline__ void pair_of(int pi, int& i, int& j) { i = pi < 3 ? 0 : (pi < 5 ? 1 : 2); j = pi < 3 ? pi + 1 : (pi < 5 ? pi - 1 : 3); }
struct MoeOrder {
    const PG8_LAS int* tinfo; int G, c, mode; const int* list;
    __device__ __forceinline__ int tok(const Unit& u, int r) const { const int bk = tinfo[1 + u.pm], pos = u.pm * BM - tinfo[256 + bk] + r; return list[bk * 32768 + (pos < tinfo[288 + bk] ? pos : 0)]; }
    __device__ __forceinline__ bool next(int i, Unit& u) const {
        const long L = (long)i * G + c; const int nt = tinfo[0]; if (L >= 4L * nt) return false;
        const int mt = (int)(L >> 2), q = (int)(L & 3), bk = tinfo[1 + mt];
        u.pm = mt;
        if (mode == 0) { int ii, jj; pair_of(bk % 6, ii, jj); const int e = (bk / 6) * 4 + ((q >> 1) ? jj : ii); u.pn = e * 2 + (q & 1); }
        else u.pn = bk * 4 + q;
        return true;
    }
    __device__ __forceinline__ void a_ready(const Unit&) const {}
    __device__ __forceinline__ void done(const Unit&) const {}
};
struct EpiSwiGLU {
    static constexpr bool PERM = true, AFTER_DRAIN = false;
    bf16_t* H; const float* wl; const PG8_LAS int* tinfo;
    __device__ __forceinline__ void operator()(const f32x4 (&acc)[2][2][4][2], const Unit& u, int wr, int wc, int, int) const {
        int ln = (int)__builtin_amdgcn_mbcnt_hi(~0u, __builtin_amdgcn_mbcnt_lo(~0u, 0u)); asm volatile("" : "+v"(ln)); const int fr = ln & 15, fq = ln >> 4;
        const int bk = tinfo[1 + u.pm]; int ii, jj; pair_of(bk % 6, ii, jj);
        const int e = u.pn >> 1, hh = u.pn & 1, slot = (e == (bk / 6) * 4 + jj) ? 1 : 0;
        const int row0 = u.pm * BM + wr * 64 + fr, col0 = slot * 256 + hh * 128 + wc * 32 + 8 * fq;
        float w8[8];
#pragma unroll
        for (int g = 0; g < 8; ++g) { const int pos = row0 + (g >> 2) * HALF + (g & 3) * 16 - tinfo[256 + bk]; w8[g] = pos < tinfo[288 + bk] ? wl[((size_t)bk * 32768 + pos) * 2 + slot] : 0.f; }
#pragma unroll
        for (int ai = 0; ai < 2; ++ai)
#pragma unroll
            for (int m = 0; m < 4; ++m) { const int row = row0 + ai * HALF + m * 16; const float w = w8[ai * 4 + m];
                float a[8];
#pragma unroll
                for (int n = 0; n < 2; ++n)
#pragma unroll
                    for (int j = 0; j < 4; ++j) { const float g = acc[ai][0][m][n][j], up = acc[ai][1][m][n][j];
                        const float sg = g * __builtin_amdgcn_rcpf(1.0f + __builtin_amdgcn_exp2f(-1.4426950408889634f * g)); a[n * 4 + j] = sg * up * w; }
                u32x4 o; o.x = cvt_pk_bf16(a[0], a[1]); o.y = cvt_pk_bf16(a[2], a[3]); o.z = cvt_pk_bf16(a[4], a[5]); o.w = cvt_pk_bf16(a[6], a[7]);
                *(u32x4*)(H + (size_t)row * 512 + col0) = o; }
    }
};
template <class TO> struct EpiMoeOut {
    static constexpr bool PERM = false, AFTER_DRAIN = false;
    const bf16_t* xr; TO* out; const float* gate; const int* list; const PG8_LAS int* tinfo; PG8_LAS float* gl;
    __device__ __forceinline__ void operator()(const f32x4 (&acc)[2][2][4][2], const Unit& u, int wr, int wc, int fr, int fq) const {
        const int bk = tinfo[1 + u.pm], r_beg = tinfo[256 + bk], r_end = r_beg + tinfo[288 + bk];
        const int row0 = u.pm * BM + wr * 64 + fr, colu = (u.pn & 3) * BM, cl = wc * 32 + 4 * fq;
        int tk[8];
#pragma unroll
        for (int g = 0; g < 8; ++g) { const int row = row0 + (g >> 2) * HALF + (g & 3) * 16; tk[g] = row < r_end ? list[bk * 32768 + row - r_beg] : -1; }
        { const int t = (wr * 4 + wc) * 64 + fq * 16 + fr; const f32x4 gs = *(const f32x4*)(gate + (size_t)(t >> 6) * 6144 + colu + (t & 63) * 4);
          *(PG8_LAS f32x4*)(gl + (t >> 6) * 256 + (t & 63) * 4) = gs; }
        u32x2 bs[8][2][2];
#pragma unroll
        for (int g = 0; g < 8; ++g) { const unsigned xo = (unsigned)((tk[g] < 0 ? 0 : tk[g]) * 1024 + colu + cl);
#pragma unroll
            for (int bj = 0; bj < 2; ++bj)
#pragma unroll
                for (int n = 0; n < 2; ++n) bs[g][bj][n] = ldraw(xr + xo + bj * HALF + n * 16); }
        asm volatile("s_waitcnt lgkmcnt(0)" ::: "memory"); __builtin_amdgcn_s_barrier();
#pragma unroll
        for (int g = 0; g < 8; ++g) { const int ai = g >> 2, m = g & 3;
            if (tk[g] >= 0) { TO* op = out + (size_t)tk[g] * 1024 + colu + cl; const PG8_LAS float* gp = gl + (tk[g] >> 12) * 256 + cl;
#pragma unroll
                for (int bj = 0; bj < 2; ++bj)
#pragma unroll
                    for (int n = 0; n < 2; ++n) { const f32x4 gv = *(const PG8_LAS f32x4*)(gp + bj * HALF + n * 16); st4(op + bj * HALF + n * 16, cvraw(bs[g][bj][n]) + gv * acc[ai][bj][m][n]); } } }
    }
};
template <class Epi, class Sched, bool ALIGN_EPI = false, bool SP2 = false, int F8 = -1>
__device__ __forceinline__ void gemm_phase(PG8_LAS unsigned char* lds, const Gemm g, const Sched& S, const Epi& E, const int tid_in) {
    int tid = tid_in; asm volatile("" : "+v"(tid));
    const int wid = __builtin_amdgcn_readfirstlane(tid >> 6), lane = tid & 63, wr = wid >> 2, wc = wid & 3, fr = lane & 15, fq = lane >> 4;
    int K = g.K; asm volatile("" : "+s"(K)); const int nt = K / BK;
    unsigned voffA[2], voffB[2];
#pragma unroll
    for (int i = 0; i < 2; ++i) { int R, C; stage_rc(tid * 16 + i * 8192, R, C); const int Rb = Epi::PERM ? ((R & ~31) + perm32(R & 31)) : R;
        voffA[i] = (unsigned)(R * K + C) * 2u; voffB[i] = (unsigned)(Rb * K + C) * 2u; }
    const size_t kstep = (size_t)(BK * 2);
    const size_t hstep = (size_t)HALF * K * 2;
    const size_t tstep = 2 * hstep;
    const unsigned ldsw = (unsigned)wid * 1024u;
    const int aoff = lds_byte(wr * 64 + fr, fq * 8), boff = lds_byte(wc * 32 + fr, fq * 8);
#define PG8_SA(b, h) (((b) * 2 + (h)) * HTB)
#define PG8_SB(b, h) ((4 + (b) * 2 + (h)) * HTB)
#define PG8_STAGE(bufoff, gbase, voff) do { _Pragma("unroll") for (int _i = 0; _i < 2; ++_i) { unsigned vo_ = (voff)[_i]; asm volatile("" : "+v"(vo_));   \
        __builtin_amdgcn_global_load_lds((const unsigned*)((const char*)(gbase) + vo_), (PG8_LAS unsigned*)(lds + (bufoff) + ldsw + _i * 8192), 16, 0, 0); } } while (0)
#define PG8_LDA(dst, b, h) do { _Pragma("unroll") for (int m = 0; m < 4; ++m) { const bf16x8 x0_ = *(const PG8_LAS bf16x8*)(lds + PG8_SA(b, h) + aoff + m * 2048), x1_ = *(const PG8_LAS bf16x8*)(lds + PG8_SA(b, h) + aoff + m * 2048 + 1024); \
        if constexpr (F8 >= 0) dst##8[m] = PG8_CAT(x0_, x1_); else { dst[m][0] = x0_; dst[m][1] = x1_; } } } while (0)
#define PG8_LDB(dst, b, h) do { _Pragma("unroll") for (int n = 0; n < 2; ++n) { const bf16x8 x0_ = *(const PG8_LAS bf16x8*)(lds + PG8_SB(b, h) + boff + n * 2048), x1_ = *(const PG8_LAS bf16x8*)(lds + PG8_SB(b, h) + boff + n * 2048 + 1024); \
        if constexpr (F8 >= 0) dst##8[n] = PG8_CAT(x0_, x1_); else { dst[n][0] = x0_; dst[n][1] = x1_; } } } while (0)
#define PG8_CAT(x0, x1) ({ const v4i_t lo_ = __builtin_bit_cast(v4i_t, x0), hi_ = __builtin_bit_cast(v4i_t, x1); (v8i_t){lo_[0], lo_[1], lo_[2], lo_[3], hi_[0], hi_[1], hi_[2], hi_[3]}; })
#define PG8_MMA(ai, bj, At, Bt) do { __builtin_amdgcn_s_setprio(1); _Pragma("unroll") for (int m = 0; m < 4; ++m) _Pragma("unroll") for (int n = 0; n < 2; ++n) { \
        if constexpr (F8 >= 0) acc[ai][bj][m][n] = __builtin_amdgcn_mfma_scale_f32_16x16x128_f8f6f4(Bt##8[n], At##8[m], acc[ai][bj][m][n], 0, 0, 0, 0x7f7f7f7f, 0, (127 - F8) * 0x01010101); \
        else { _Pragma("unroll") for (int k = 0; k < 2; ++k) acc[ai][bj][m][n] = __builtin_amdgcn_mfma_f32_16x16x32_bf16(Bt[n][k], At[m][k], acc[ai][bj][m][n], 0, 0, 0); } } \
        __builtin_amdgcn_s_setprio(0); } while (0)
#define PG8_WAIT_V(n) asm volatile("s_waitcnt vmcnt(" #n ")" ::: "memory")
#define PG8_WAIT_L(n) asm volatile("s_waitcnt lgkmcnt(" #n ")" ::: "memory")
#define PG8_BAR __builtin_amdgcn_s_barrier()
#define PG8_SCHED __builtin_amdgcn_sched_barrier(0)
    Unit cur, nxt; int ui = 0;
    if (!S.next(0, cur)) return;
    f32x4 acc[2][2][4][2];
#pragma unroll
    for (int a = 0; a < 2; ++a)
#pragma unroll
        for (int b = 0; b < 2; ++b)
#pragma unroll
            for (int m = 0; m < 4; ++m)
#pragma unroll
                for (int n = 0; n < 2; ++n) acc[a][b][m][n] = (f32x4){0.f, 0.f, 0.f, 0.f};
    bf16x8 At[4][2], B0[2][2], B1[2][2]; v8i_t At8[4], B08[2], B18[2];
    const char* cA = (const char*)g.A + (size_t)cur.pm * tstep; const char* cB = (const char*)g.Bt + (size_t)cur.pn * tstep;
    S.a_ready(cur);
    if constexpr (SP2) {
        PG8_STAGE(PG8_SB(0, 0), cB, voffB); PG8_STAGE(PG8_SB(0, 1), cB + hstep, voffB); PG8_STAGE(PG8_SA(0, 0), cA, voffA); PG8_STAGE(PG8_SA(0, 1), cA + hstep, voffA);
        if (wr == 1) PG8_BAR;
        PG8_WAIT_V(2); PG8_BAR;
        PG8_STAGE(PG8_SB(1, 0), cB + kstep, voffB); PG8_STAGE(PG8_SA(1, 0), cA + kstep, voffA); PG8_STAGE(PG8_SB(1, 1), cB + hstep + kstep, voffB);
        PG8_WAIT_V(6); PG8_BAR;
    } else {
        PG8_STAGE(PG8_SB(0, 0), cB, voffB); PG8_STAGE(PG8_SA(0, 0), cA, voffA); PG8_STAGE(PG8_SB(0, 1), cB + hstep, voffB); PG8_STAGE(PG8_SA(0, 1), cA + hstep, voffA);
        if (wr == 1) PG8_BAR;
        PG8_WAIT_V(4); PG8_BAR;
        PG8_STAGE(PG8_SB(1, 0), cB + kstep, voffB); PG8_STAGE(PG8_SA(1, 0), cA + kstep, voffA); PG8_STAGE(PG8_SB(1, 1), cB + hstep + kstep, voffB);
        PG8_WAIT_V(6); PG8_BAR;
    }
    for (;;) {
        const bool has_next = S.next(ui + 1, nxt);
        const char* nA = has_next ? (const char*)g.A + (size_t)nxt.pm * tstep : cA; const char* nB = has_next ? (const char*)g.Bt + (size_t)nxt.pn * tstep : cB;
        for (int t = 0; t < nt; t += 2) {
            const bool last = (t == nt - 2);
            const char* a1 = cA + (size_t)(t + 1) * kstep;
            const char* a2 = last ? nA : cA + (size_t)(t + 2) * kstep; const char* b2 = last ? nB : cB + (size_t)(t + 2) * kstep;
            const char* a3 = a2 + kstep; const char* b3 = b2 + kstep;
            if (last && has_next) S.a_ready(nxt);
            if constexpr (SP2) {
            PG8_LDB(B0, 0, 0); PG8_LDB(B1, 0, 1); PG8_SCHED; PG8_LDA(At, 0, 0); PG8_STAGE(PG8_SA(1, 1), a1 + hstep, voffA);
            PG8_WAIT_V(8); PG8_WAIT_L(0); PG8_BAR; PG8_MMA(0, 0, At, B0); PG8_MMA(0, 1, At, B1); PG8_BAR; PG8_SCHED;
            PG8_LDA(At, 0, 1); PG8_STAGE(PG8_SB(0, 0), b2, voffB); PG8_STAGE(PG8_SB(0, 1), b2 + hstep, voffB); PG8_STAGE(PG8_SA(0, 0), a2, voffA);
            PG8_WAIT_V(8); PG8_WAIT_L(0); PG8_BAR; PG8_MMA(1, 0, At, B0); PG8_MMA(1, 1, At, B1); PG8_BAR; PG8_SCHED;
            PG8_LDB(B0, 1, 0); PG8_LDB(B1, 1, 1); PG8_SCHED; PG8_LDA(At, 1, 0); PG8_STAGE(PG8_SA(0, 1), a2 + hstep, voffA);
            PG8_WAIT_V(8); PG8_WAIT_L(0); PG8_BAR; PG8_MMA(0, 0, At, B0); PG8_MMA(0, 1, At, B1); PG8_BAR; PG8_SCHED;
            PG8_LDA(At, 1, 1); PG8_STAGE(PG8_SB(1, 0), b3, voffB); PG8_STAGE(PG8_SB(1, 1), b3 + hstep, voffB); PG8_STAGE(PG8_SA(1, 0), a3, voffA);
            PG8_WAIT_V(8); PG8_WAIT_L(0); PG8_BAR; PG8_MMA(1, 0, At, B0); PG8_MMA(1, 1, At, B1); PG8_BAR; PG8_SCHED;
            } else {
            PG8_LDB(B0, 0, 0); PG8_SCHED; PG8_LDA(At, 0, 0); PG8_STAGE(PG8_SA(1, 1), a1 + hstep, voffA);
            PG8_WAIT_L(8); PG8_BAR; PG8_WAIT_L(0); PG8_MMA(0, 0, At, B0); PG8_BAR; PG8_SCHED;
            PG8_LDB(B1, 0, 1); PG8_STAGE(PG8_SB(0, 0), b2, voffB);
            PG8_BAR; PG8_WAIT_L(0); PG8_MMA(0, 1, At, B1); PG8_BAR;
            PG8_LDA(At, 0, 1); PG8_STAGE(PG8_SA(0, 0), a2, voffA);
            PG8_BAR; PG8_WAIT_L(0); PG8_MMA(1, 0, At, B0); PG8_BAR; PG8_SCHED;
            PG8_STAGE(PG8_SB(0, 1), b2 + hstep, voffB);
            PG8_WAIT_V(6); PG8_BAR; PG8_MMA(1, 1, At, B1); PG8_BAR;
            PG8_LDB(B0, 1, 0); PG8_SCHED; PG8_LDA(At, 1, 0); PG8_STAGE(PG8_SA(0, 1), a2 + hstep, voffA);
            PG8_WAIT_L(8); PG8_BAR; PG8_WAIT_L(0); PG8_MMA(0, 0, At, B0); PG8_BAR; PG8_SCHED;
            PG8_LDB(B1, 1, 1); PG8_STAGE(PG8_SB(1, 0), b3, voffB);
            PG8_BAR; PG8_WAIT_L(0); PG8_MMA(0, 1, At, B1); PG8_BAR;
            PG8_LDA(At, 1, 1); PG8_STAGE(PG8_SA(1, 0), a3, voffA);
            PG8_BAR; PG8_WAIT_L(0); PG8_MMA(1, 0, At, B0); PG8_BAR; PG8_SCHED;
            PG8_STAGE(PG8_SB(1, 1), b3 + hstep, voffB);
            PG8_WAIT_V(6); PG8_BAR; PG8_MMA(1, 1, At, B1); PG8_BAR;
            }
        }
        if constexpr (ALIGN_EPI) { if (wr == 0) PG8_BAR; }
        if constexpr (!Epi::AFTER_DRAIN) { E(acc, cur, wr, wc, fr, fq); S.done(cur); }
        if (!has_next) break;
#pragma unroll
        for (int a = 0; a < 2; ++a)
#pragma unroll
            for (int b = 0; b < 2; ++b)
#pragma unroll
                for (int m = 0; m < 4; ++m)
#pragma unroll
                    for (int n = 0; n < 2; ++n) acc[a][b][m][n] = (f32x4){0.f, 0.f, 0.f, 0.f};
        cur = nxt; cA = nA; cB = nB; ++ui;
        if constexpr (ALIGN_EPI) { if (wr == 1) PG8_BAR; }
    }
    PG8_WAIT_V(0);
    if constexpr (!ALIGN_EPI) { if (wr == 0) PG8_BAR; }
    PG8_BAR;
    if constexpr (Epi::AFTER_DRAIN) { E.fused(acc, cur, wr, wc, fr, fq, lds, wid, lane); S.done(cur); }
#undef PG8_SA
#undef PG8_SB
#undef PG8_STAGE
#undef PG8_LDA
#undef PG8_LDB
#undef PG8_MMA
#undef PG8_WAIT_V
#undef PG8_WAIT_L
#undef PG8_BAR
#undef PG8_SCHED
}
template <class Epi, class Sched, bool ALIGN_EPI = true, bool SP2 = true, int F8 = -1>
__device__ __forceinline__ void gemm_phase_gather(PG8_LAS unsigned char* lds, const Gemm g, const Sched& S, const Epi& E, const int tid_in) {
    int tid = tid_in; asm volatile("" : "+v"(tid));
    static_assert(SP2, "gather form: SP2 loop only");
    const int wid = __builtin_amdgcn_readfirstlane(tid >> 6), lane = tid & 63, wr = wid >> 2, wc = wid & 3, fr = lane & 15, fq = lane >> 4;
    int K = g.K; asm volatile("" : "+s"(K)); const int nt = K / BK;
    unsigned voffA[2], voffB[2];
#pragma unroll
    for (int i = 0; i < 2; ++i) { int R, C; stage_rc(tid * 16 + i * 8192, R, C); const int Rb = Epi::PERM ? ((R & ~31) + perm32(R & 31)) : R;
        voffA[i] = (unsigned)(R * K + C) * 2u; voffB[i] = (unsigned)(Rb * K + C) * 2u; }
    int gR, gC; stage_rc(tid * 16, gR, gC);
    unsigned vG[2][2], vN[2][2];
    const size_t kstep = (size_t)(BK * 2);
    const size_t hstep = (size_t)HALF * K * 2;
    const size_t tstep = 2 * hstep;
    const unsigned ldsw = (unsigned)wid * 1024u;
    const int aoff = lds_byte(wr * 64 + fr, fq * 8), boff = lds_byte(wc * 32 + fr, fq * 8);
#define PG8_SA(b, h) (((b) * 2 + (h)) * HTB)
#define PG8_SB(b, h) ((4 + (b) * 2 + (h)) * HTB)
#define PG8_STAGE(bufoff, gbase, voff) do { _Pragma("unroll") for (int _i = 0; _i < 2; ++_i) { unsigned vo_ = (voff)[_i]; asm volatile("" : "+v"(vo_));   \
        __builtin_amdgcn_global_load_lds((const unsigned*)((const char*)(gbase) + vo_), (PG8_LAS unsigned*)(lds + (bufoff) + ldsw + _i * 8192), 16, 0, 0); } } while (0)
#define PG8_LDA(dst, b, h) do { _Pragma("unroll") for (int m = 0; m < 4; ++m) { const bf16x8 x0_ = *(const PG8_LAS bf16x8*)(lds + PG8_SA(b, h) + aoff + m * 2048), x1_ = *(const PG8_LAS bf16x8*)(lds + PG8_SA(b, h) + aoff + m * 2048 + 1024); \
        if constexpr (F8 >= 0) dst##8[m] = PG8_CAT(x0_, x1_); else { dst[m][0] = x0_; dst[m][1] = x1_; } } } while (0)
#define PG8_LDB(dst, b, h) do { _Pragma("unroll") for (int n = 0; n < 2; ++n) { const bf16x8 x0_ = *(const PG8_LAS bf16x8*)(lds + PG8_SB(b, h) + boff + n * 2048), x1_ = *(const PG8_LAS bf16x8*)(lds + PG8_SB(b, h) + boff + n * 2048 + 1024); \
        if constexpr (F8 >= 0) dst##8[n] = PG8_CAT(x0_, x1_); else { dst[n][0] = x0_; dst[n][1] = x1_; } } } while (0)
#define PG8_CAT(x0, x1) ({ const v4i_t lo_ = __builtin_bit_cast(v4i_t, x0), hi_ = __builtin_bit_cast(v4i_t, x1); (v8i_t){lo_[0], lo_[1], lo_[2], lo_[3], hi_[0], hi_[1], hi_[2], hi_[3]}; })
#define PG8_MMA(ai, bj, At, Bt) do { __builtin_amdgcn_s_setprio(1); _Pragma("unroll") for (int m = 0; m < 4; ++m) _Pragma("unroll") for (int n = 0; n < 2; ++n) { \
        if constexpr (F8 >= 0) acc[ai][bj][m][n] = __builtin_amdgcn_mfma_scale_f32_16x16x128_f8f6f4(Bt##8[n], At##8[m], acc[ai][bj][m][n], 0, 0, 0, 0x7f7f7f7f, 0, (127 - F8) * 0x01010101); \
        else { _Pragma("unroll") for (int k = 0; k < 2; ++k) acc[ai][bj][m][n] = __builtin_amdgcn_mfma_f32_16x16x32_bf16(Bt[n][k], At[m][k], acc[ai][bj][m][n], 0, 0, 0); } } \
        __builtin_amdgcn_s_setprio(0); } while (0)
#define PG8_WAIT_V(n) asm volatile("s_waitcnt vmcnt(" #n ")" ::: "memory")
#define PG8_WAIT_L(n) asm volatile("s_waitcnt lgkmcnt(" #n ")" ::: "memory")
#define PG8_BAR __builtin_amdgcn_s_barrier()
#define PG8_SCHED __builtin_amdgcn_sched_barrier(0)
    Unit cur, nxt; int ui = 0;
    if (!S.next(0, cur)) return;
    f32x4 acc[2][2][4][2];
#pragma unroll
    for (int a = 0; a < 2; ++a)
#pragma unroll
        for (int b = 0; b < 2; ++b)
#pragma unroll
            for (int m = 0; m < 4; ++m)
#pragma unroll
                for (int n = 0; n < 2; ++n) acc[a][b][m][n] = (f32x4){0.f, 0.f, 0.f, 0.f};
    bf16x8 At[4][2], B0[2][2], B1[2][2]; v8i_t At8[4], B08[2], B18[2];
    const char* cA = (const char*)g.A; const char* cB = (const char*)g.Bt + (size_t)cur.pn * tstep;
    S.a_ready(cur);
#pragma unroll
    for (int h = 0; h < 2; ++h)
#pragma unroll
        for (int i = 0; i < 2; ++i) vG[h][i] = (unsigned)S.tok(cur, h * HALF + gR + 64 * i) * (unsigned)(K * 2) + (unsigned)(gC * 2);
    if constexpr (SP2) {
        PG8_STAGE(PG8_SB(0, 0), cB, voffB); PG8_STAGE(PG8_SB(0, 1), cB + hstep, voffB); PG8_STAGE(PG8_SA(0, 0), cA, vG[0]); PG8_STAGE(PG8_SA(0, 1), cA, vG[1]);
        if (wr == 1) PG8_BAR;
        PG8_WAIT_V(2); PG8_BAR;
        PG8_STAGE(PG8_SB(1, 0), cB + kstep, voffB); PG8_STAGE(PG8_SA(1, 0), cA + kstep, vG[0]); PG8_STAGE(PG8_SB(1, 1), cB + hstep + kstep, voffB);
        PG8_WAIT_V(6); PG8_BAR;
    } else {
        PG8_STAGE(PG8_SB(0, 0), cB, voffB); PG8_STAGE(PG8_SA(0, 0), cA, voffA); PG8_STAGE(PG8_SB(0, 1), cB + hstep, voffB); PG8_STAGE(PG8_SA(0, 1), cA + hstep, voffA);
        if (wr == 1) PG8_BAR;
        PG8_WAIT_V(4); PG8_BAR;
        PG8_STAGE(PG8_SB(1, 0), cB + kstep, voffB); PG8_STAGE(PG8_SA(1, 0), cA + kstep, voffA); PG8_STAGE(PG8_SB(1, 1), cB + hstep + kstep, voffB);
        PG8_WAIT_V(6); PG8_BAR;
    }
    for (;;) {
        const bool has_next = S.next(ui + 1, nxt);
        const char* nA = cA; const char* nB = has_next ? (const char*)g.Bt + (size_t)nxt.pn * tstep : cB;
        for (int t = 0; t < nt; t += 2) {
            const bool last = (t == nt - 2);
            const char* a1 = cA + (size_t)(t + 1) * kstep;
            const char* a2 = last ? nA : cA + (size_t)(t + 2) * kstep; const char* b2 = last ? nB : cB + (size_t)(t + 2) * kstep;
            const char* a3 = a2 + kstep; const char* b3 = b2 + kstep;
            if (last && has_next) { S.a_ready(nxt);
#pragma unroll
                for (int h = 0; h < 2; ++h)
#pragma unroll
                    for (int i = 0; i < 2; ++i) vN[h][i] = (unsigned)S.tok(nxt, h * HALF + gR + 64 * i) * (unsigned)(K * 2) + (unsigned)(gC * 2); }
            if constexpr (SP2) {
            PG8_LDB(B0, 0, 0); PG8_LDB(B1, 0, 1); PG8_SCHED; PG8_LDA(At, 0, 0); PG8_STAGE(PG8_SA(1, 1), a1, vG[1]);
            if (last && has_next) { vG[0][0] = vN[0][0]; vG[0][1] = vN[0][1]; vG[1][0] = vN[1][0]; vG[1][1] = vN[1][1]; }
            PG8_WAIT_V(8); PG8_WAIT_L(0); PG8_BAR; PG8_MMA(0, 0, At, B0); PG8_MMA(0, 1, At, B1); PG8_BAR; PG8_SCHED;
            PG8_LDA(At, 0, 1); PG8_STAGE(PG8_SB(0, 0), b2, voffB); PG8_STAGE(PG8_SB(0, 1), b2 + hstep, voffB); PG8_STAGE(PG8_SA(0, 0), a2, vG[0]);
            PG8_WAIT_V(8); PG8_WAIT_L(0); PG8_BAR; PG8_MMA(1, 0, At, B0); PG8_MMA(1, 1, At, B1); PG8_BAR; PG8_SCHED;
            PG8_LDB(B0, 1, 0); PG8_LDB(B1, 1, 1); PG8_SCHED; PG8_LDA(At, 1, 0); PG8_STAGE(PG8_SA(0, 1), a2, vG[1]);
            PG8_WAIT_V(8); PG8_WAIT_L(0); PG8_BAR; PG8_MMA(0, 0, At, B0); PG8_MMA(0, 1, At, B1); PG8_BAR; PG8_SCHED;
            PG8_LDA(At, 1, 1); PG8_STAGE(PG8_SB(1, 0), b3, voffB); PG8_STAGE(PG8_SB(1, 1), b3 + hstep, voffB); PG8_STAGE(PG8_SA(1, 0), a3, vG[0]);
            PG8_WAIT_V(8); PG8_WAIT_L(0); PG8_BAR; PG8_MMA(1, 0, At, B0); PG8_MMA(1, 1, At, B1); PG8_BAR; PG8_SCHED;
            } else {
            PG8_LDB(B0, 0, 0); PG8_SCHED; PG8_LDA(At, 0, 0); PG8_STAGE(PG8_SA(1, 1), a1 + hstep, voffA);
            PG8_WAIT_L(8); PG8_BAR; PG8_WAIT_L(0); PG8_MMA(0, 0, At, B0); PG8_BAR; PG8_SCHED;
            PG8_LDB(B1, 0, 1); PG8_STAGE(PG8_SB(0, 0), b2, voffB);
            PG8_BAR; PG8_WAIT_L(0); PG8_MMA(0, 1, At, B1); PG8_BAR;
            PG8_LDA(At, 0, 1); PG8_STAGE(PG8_SA(0, 0), a2, voffA);
            PG8_BAR; PG8_WAIT_L(0); PG8_MMA(1, 0, At, B0); PG8_BAR; PG8_SCHED;
            PG8_STAGE(PG8_SB(0, 1), b2 + hstep, voffB);
            PG8_WAIT_V(6); PG8_BAR; PG8_MMA(1, 1, At, B1); PG8_BAR;
            PG8_LDB(B0, 1, 0); PG8_SCHED; PG8_LDA(At, 1, 0); PG8_STAGE(PG8_SA(0, 1), a2 + hstep, voffA);
            PG8_WAIT_L(8); PG8_BAR; PG8_WAIT_L(0); PG8_MMA(0, 0, At, B0); PG8_BAR; PG8_SCHED;
            PG8_LDB(B1, 1, 1); PG8_STAGE(PG8_SB(1, 0), b3, voffB);
            PG8_BAR; PG8_WAIT_L(0); PG8_MMA(0, 1, At, B1); PG8_BAR;
            PG8_LDA(At, 1, 1); PG8_STAGE(PG8_SA(1, 0), a3, voffA);
            PG8_BAR; PG8_WAIT_L(0); PG8_MMA(1, 0, At, B0); PG8_BAR; PG8_SCHED;
            PG8_STAGE(PG8_SB(1, 1), b3 + hstep, voffB);
            PG8_WAIT_V(6); PG8_BAR; PG8_MMA(1, 1, At, B1); PG8_BAR;
            }
        }
        if constexpr (ALIGN_EPI) { if (wr == 0) PG8_BAR; }
        if constexpr (!Epi::AFTER_DRAIN) { E(acc, cur, wr, wc, fr, fq); S.done(cur); }
        if (!has_next) break;
#pragma unroll
        for (int a = 0; a < 2; ++a)
#pragma unroll
            for (int b = 0; b < 2; ++b)
#pragma unroll
                for (int m = 0; m < 4; ++m)
#pragma unroll
                    for (int n = 0; n < 2; ++n) acc[a][b][m][n] = (f32x4){0.f, 0.f, 0.f, 0.f};
        cur = nxt; cA = nA; cB = nB; ++ui;
        if constexpr (ALIGN_EPI) { if (wr == 1) PG8_BAR; }
    }
    PG8_WAIT_V(0);
    if constexpr (!ALIGN_EPI) { if (wr == 0) PG8_BAR; }
    PG8_BAR;
    if constexpr (Epi::AFTER_DRAIN) { E.fused(acc, cur, wr, wc, fr, fq, lds, wid, lane); S.done(cur); }
#undef PG8_SA
#undef PG8_SB
#undef PG8_STAGE
#undef PG8_LDA
#undef PG8_LDB
#undef PG8_MMA
#undef PG8_WAIT_V
#undef PG8_WAIT_L
#undef PG8_BAR
#undef PG8_SCHED
}
}
namespace att {
typedef unsigned short bf16;
using bf16x8 = __attribute__((ext_vector_type(8))) short;
using s16x4  = __attribute__((ext_vector_type(4))) short;
using f32x16 = __attribute__((ext_vector_type(16))) float;
using u32x4  = __attribute__((ext_vector_type(4))) unsigned;
using f32x4_t = __attribute__((ext_vector_type(4))) float;
constexpr int NW = 8, QBLK = 32, KVBLK = 64, SEQ = 4096;
constexpr int LDQ = 1536, LDKV = 2048, LDO = 1024;
constexpr int SHM_VT = 128 * 80, SHM_K8 = 64 * 208;
constexpr int OFF_V = 0, OFF_K8 = 3 * SHM_VT, OFF_WS = OFF_K8 + 2 * SHM_K8, LDS_BYTES = OFF_WS + NW * 64 * 4 + 64;
typedef int v8i32 __attribute__((ext_vector_type(8)));
typedef int v4i32 __attribute__((ext_vector_type(4)));
typedef int v2i32 __attribute__((ext_vector_type(2)));
constexpr int T_TOK = 8 * SEQ;
#define ASBAR() __builtin_amdgcn_sched_barrier(0)
__device__ __forceinline__ int crow(int r, int hi) { return (r & 3) + 8 * (r >> 2) + 4 * hi; }
__device__ __forceinline__ unsigned cvtpk(float lo, float hi) { unsigned r; asm volatile("v_cvt_pk_bf16_f32 %0, %1, %2" : "=v"(r) : "v"(lo), "v"(hi)); return r; }
__device__ __forceinline__ float bf2f(unsigned short b) { return __uint_as_float(((unsigned)b) << 16); }
template <bool SHIFT> __device__ __forceinline__ void smA(f32x16& p0, float negm) { for (int r = 0; r < 16; ++r) p0[r] = __builtin_amdgcn_exp2f(SHIFT ? p0[r] + negm : p0[r]); }
template <bool SHIFT> __device__ __forceinline__ void smB(f32x16& p0, f32x16& p1, float& l_reg, v8i32& p8, float negm) {
  for (int r = 0; r < 16; ++r) p1[r] = __builtin_amdgcn_exp2f(SHIFT ? p1[r] + negm : p1[r]);
  float ps = 0; for (int r = 0; r < 16; ++r) ps += p0[r]; for (int r = 0; r < 16; ++r) ps += p1[r];
  l_reg += ps;
#pragma unroll
  for (int w = 0; w < 4; ++w) { int a = 0, bq = 0;
    a = __builtin_amdgcn_cvt_pk_bf8_f32(p0[4 * w], p0[4 * w + 1], a, false); a = __builtin_amdgcn_cvt_pk_bf8_f32(p0[4 * w + 2], p0[4 * w + 3], a, true);
    bq = __builtin_amdgcn_cvt_pk_bf8_f32(p1[4 * w], p1[4 * w + 1], bq, false); bq = __builtin_amdgcn_cvt_pk_bf8_f32(p1[4 * w + 2], p1[4 * w + 3], bq, true);
    p8[w] = a; p8[4 + w] = bq; }
}
template <bool SHIFT> __device__ __forceinline__ void qkt(f32x16& p0, f32x16& p1, const char* K8, const v8i32* q8, float negm, int r32, int hi) {
  p0 = f32x16{}; p1 = f32x16{};
#define K8RD(m, half, part) (*reinterpret_cast<const v4i32*>(K8 + ((half) * 32 + r32) * 208 + (m) * 64 + hi * 32 + (part) * 16))
#define K8FR(m, half) ({ const v4i32 lo_ = K8RD(m, half, 0), hi_ = K8RD(m, half, 1); (v8i32){lo_[0], lo_[1], lo_[2], lo_[3], hi_[0], hi_[1], hi_[2], hi_[3]}; })
  v8i32 a0 = K8FR(0, 0), a1 = K8FR(0, 1), b0 = K8FR(1, 0), b1 = K8FR(1, 1);
  ASBAR();
  p0 = __builtin_amdgcn_mfma_scale_f32_32x32x64_f8f6f4(a0, q8[0], p0, 0, 0, 0, 0x7f7f7f7f, 0, 0x7f7f7f7f);
  p1 = __builtin_amdgcn_mfma_scale_f32_32x32x64_f8f6f4(a1, q8[0], p1, 0, 0, 0, 0x7f7f7f7f, 0, 0x7f7f7f7f);
  a0 = K8FR(2, 0); a1 = K8FR(2, 1);
  ASBAR();
  p0 = __builtin_amdgcn_mfma_scale_f32_32x32x64_f8f6f4(b0, q8[1], p0, 0, 0, 0, 0x7f7f7f7f, 0, 0x7f7f7f7f);
  p1 = __builtin_amdgcn_mfma_scale_f32_32x32x64_f8f6f4(b1, q8[1], p1, 0, 0, 0, 0x7f7f7f7f, 0, 0x7f7f7f7f);
  ASBAR();
  p0 = __builtin_amdgcn_mfma_scale_f32_32x32x64_f8f6f4(a0, q8[2], p0, 0, 0, 0, 0x7f7f7f7f, 0, 0x7f7f7f7f);
  p1 = __builtin_amdgcn_mfma_scale_f32_32x32x64_f8f6f4(a1, q8[2], p1, 0, 0, 0, 0x7f7f7f7f, 0, 0x7f7f7f7f);
  ASBAR();
#undef K8RD
#undef K8FR
}
__device__ __forceinline__ void pv_d0(f32x16* o, const char* VT, v8i32 p8, int r32, int hi) {
#define VTFR(d0) ({ const v4i32 lo_ = *reinterpret_cast<const v4i32*>(VT + ((d0) * 32 + r32) * 80 + hi * 32), hi_ = *reinterpret_cast<const v4i32*>(VT + ((d0) * 32 + r32) * 80 + hi * 32 + 16); (v8i32){lo_[0], lo_[1], lo_[2], lo_[3], hi_[0], hi_[1], hi_[2], hi_[3]}; })
#define PVMMA(d0, fr) o[d0] = __builtin_amdgcn_mfma_scale_f32_32x32x64_f8f6f4(p8, fr, o[d0], 1  , 0  , 0, 0x7f7f7f7f, 0, 0x7f7f7f7f)
  v8i32 fa = VTFR(0), fb = VTFR(1);
  ASBAR();
  PVMMA(0, fa); fa = VTFR(2); ASBAR();
  PVMMA(1, fb); fb = VTFR(3); ASBAR();
  PVMMA(2, fa); PVMMA(3, fb); ASBAR();
#undef VTFR
#undef PVMMA
}
template <bool SHIFT> __device__ __forceinline__ bool attn_unit(int b, int h, int s0, const bf16* Qraw, const unsigned char* __restrict__ VT8g, const unsigned char* __restrict__ K8g, const unsigned char* __restrict__ KP8g, bf16* __restrict__ O,
                                          const float* rope, const float* qg, float smaxC, char* lds, int tid) {
  asm volatile("" : "+v"(tid));
  const int wid = __builtin_amdgcn_readfirstlane(tid >> 6), lane = tid & 63, r32 = lane & 31, hi = lane >> 5;
  asm volatile("" : "+s"(qg));
  char* V_lds = lds + OFF_V; char* K8_lds = lds + OFF_K8;
  float* ws = (float*)(lds + OFF_WS) + wid * 64; float* li_l = ws;
  constexpr float C = 0.072168783648703220f * 1.4426950408889634f;
  v8i32 q8[3];
  {
    typedef __attribute__((address_space(1))) const bf16x8 gbf16x8; typedef __attribute__((address_space(1))) const f32x4_t gf32x4;
    const long trow = (long)b * SEQ + s0 + wid * QBLK + r32;
    unsigned qo = (unsigned)((trow * LDQ + h * 192) * 2); const unsigned ro = (unsigned)(trow * 256), go = (unsigned)(hi * 128);
#define Qn_(i) (*(gbf16x8*)((const char*)Qraw + qo + hi * 64 + (i) * 16))
#define Qr_(i) (*(gbf16x8*)((const char*)Qraw + qo + 256 + (i) * 16))
#define rp4_(i) (*(gf32x4*)((const char*)rope + ro + (i) * 16))
#define qgn_(i) (*(gf32x4*)((const char*)qg + go + (i) * 16))
#define qgr_(i) (*(gf32x4*)((const char*)qg + 512 + (i) * 16))
    float ssn = 0.f, ssp = 0.f;
#pragma unroll
    for (int c = 0; c < 8; ++c) { const bf16x8 a = Qn_((c >> 2) * 8 + (c & 3)), r = Qr_(c);
#pragma unroll
      for (int j = 0; j < 8; ++j) { const float f = bf2f((unsigned short)a[j]), g = bf2f((unsigned short)r[j]); ssn += f * f; ssp += g * g; } }
    ssn += __shfl_xor(ssn, 32);
    const float rn = rsqrtf(ssn * (1.f / 128.f) + 1e-6f) * C, rp = rsqrtf(ssp * (1.f / 64.f) + 1e-6f) * C;
    { float rn_ = rn, rp_ = rp; asm volatile("" : "+v"(qo), "+v"(rn_), "+v"(rp_) :: "memory"); }
#pragma unroll
    for (int m = 0; m < 2; ++m)
#pragma unroll
      for (int c = 0; c < 4; ++c) { const bf16x8 raw = Qn_(8 * m + c); const f32x4_t ga = qgn_(16 * m + 2 * c), gb = qgn_(16 * m + 2 * c + 1); float g[8];
#pragma unroll
        for (int j = 0; j < 8; ++j) g[j] = bf2f((unsigned short)raw[j]) * rn * (j < 4 ? ga[j & 3] : gb[j & 3]);
        int w0 = 0, w1 = 0; w0 = __builtin_amdgcn_cvt_pk_fp8_f32(g[0], g[1], w0, false); w0 = __builtin_amdgcn_cvt_pk_fp8_f32(g[2], g[3], w0, true);
        w1 = __builtin_amdgcn_cvt_pk_fp8_f32(g[4], g[5], w1, false); w1 = __builtin_amdgcn_cvt_pk_fp8_f32(g[6], g[7], w1, true);
        asm volatile("" : "+v"(w0), "+v"(w1) :: "memory");        q8[m][2 * c] = w0; q8[m][2 * c + 1] = w1; }
#pragma unroll
    for (int c = 0; c < 4; ++c) {
      const bf16x8 r1 = Qr_(c), r2 = Qr_(4 + c);
      const f32x4_t g1a = qgr_(2 * c), g1b = qgr_(2 * c + 1), g2a = qgr_(8 + 2 * c), g2b = qgr_(8 + 2 * c + 1); float ov[8];
#pragma unroll
      for (int j = 0; j < 8; ++j) { const f32x4_t cs4 = rp4_(4 * c + (j >> 1));
        const float cs = cs4[(j & 1) * 2], sn = cs4[(j & 1) * 2 + 1];
        const float x1 = bf2f((unsigned short)r1[j]) * rp * (j < 4 ? g1a[j & 3] : g1b[j & 3]), x2 = bf2f((unsigned short)r2[j]) * rp * (j < 4 ? g2a[j & 3] : g2b[j & 3]);
        ov[j] = hi == 0 ? (x1 * cs - x2 * sn) : (x1 * sn + x2 * cs); }
      int w0 = 0, w1 = 0; w0 = __builtin_amdgcn_cvt_pk_fp8_f32(ov[0], ov[1], w0, false); w0 = __builtin_amdgcn_cvt_pk_fp8_f32(ov[2], ov[3], w0, true);
      w1 = __builtin_amdgcn_cvt_pk_fp8_f32(ov[4], ov[5], w1, false); w1 = __builtin_amdgcn_cvt_pk_fp8_f32(ov[6], ov[7], w1, true);
      asm volatile("" : "+v"(w0), "+v"(w1) :: "memory"); q8[2][2 * c] = w0; q8[2][2 * c + 1] = w1; }
  #undef Qn_
#undef Qr_
#undef rp4_
#undef qgn_
#undef qgr_
  }
  const float negm = 15.0f - smaxC;
  float l_reg = 0.f; f32x16 o[4] = {};
  const char* Vg = (const char*)(VT8g + (size_t)h * 128 * T_TOK + (size_t)b * SEQ); const char* Kg = (const char*)(K8g + ((long)b * SEQ * 8 + h) * 128); const char* Pg = (const char*)(KP8g + (long)b * SEQ * 64);
  const int vc = tid >> 2, vq = tid & 3, vst = vc * 80 + 16 * (vq >> 1) + 8 * (vq & 1); const unsigned gvt = (unsigned)vc * (unsigned)T_TOK + 16u * (unsigned)vq;
  const int kr = tid >> 3, kc = tid & 7, kst = kr * 208 + kc * 16; const unsigned gk8 = (unsigned)(kr * 1024 + kc * 16);
  const int pr = (tid & 255) >> 2, pc = tid & 3, pst = pr * 208 + 128 + pc * 16; const unsigned gp8 = (unsigned)(pr * 64 + pc * 16);
  v4i32 s_v, s_k, s_p;
#define SLOAD(k0) do { s_v = *reinterpret_cast<const v4i32*>(Vg + (size_t)(k0) + gvt); \
    s_k = *reinterpret_cast<const v4i32*>(Kg + (size_t)(k0) * 1024 + gk8); if (tid < 256) s_p = *reinterpret_cast<const v4i32*>(Pg + (size_t)(k0) * 64 + gp8); } while (0)
#define SWRITE(kbuf, vbuf_) do { { v2i32 a_ = {s_v[0], s_v[2]}, b_ = {s_v[1], s_v[3]}; *(v2i32*)(V_lds + (vbuf_) * SHM_VT + vst) = a_; *(v2i32*)(V_lds + (vbuf_) * SHM_VT + vst + 32) = b_; } \
    *(v4i32*)(K8_lds + (kbuf) * SHM_K8 + kst) = s_k; if (tid < 256) *(v4i32*)(K8_lds + (kbuf) * SHM_K8 + pst) = s_p; } while (0)
  constexpr int NT = SEQ / KVBLK;
  v8i32 p8;
  SLOAD(0); SWRITE(0, 0); __syncthreads(); SLOAD(KVBLK);
  if (wid < 4) {
    for (int j = 0, kb = 0, vbuf = 0, vnx = 1; j < NT; ++j) {
      f32x16 p0, p1;
      qkt<SHIFT>(p0, p1, K8_lds + kb * SHM_K8, q8, negm, r32, hi);
      smA<SHIFT>(p0, negm); smB<SHIFT>(p0, p1, l_reg, p8, negm); ASBAR();
      pv_d0(o, V_lds + vbuf * SHM_VT, p8, r32, hi);
      if (j + 1 < NT) SWRITE(kb ^ 1, vnx);
      __syncthreads();
      if (j + 2 < NT) SLOAD((j + 2) * KVBLK);
      kb ^= 1; vbuf = vnx; vnx = vnx == 2 ? 0 : vnx + 1;
    }
  } else {
    int vprev = 0;
    __builtin_amdgcn_s_setprio(1);
    for (int j = 0, kb = 0, vbuf = 0, vnx = 1; j < NT; ++j) {
      f32x16 p0, p1;
      if (j > 0) pv_d0(o, V_lds + vprev * SHM_VT, p8, r32, hi);
      qkt<SHIFT>(p0, p1, K8_lds + kb * SHM_K8, q8, negm, r32, hi);
      smA<SHIFT>(p0, negm); smB<SHIFT>(p0, p1, l_reg, p8, negm); ASBAR();
      if (j + 1 < NT) SWRITE(kb ^ 1, vnx);
      __syncthreads();
      if (j + 2 < NT) SLOAD((j + 2) * KVBLK);
      kb ^= 1; vprev = vbuf; vbuf = vnx; vnx = vnx == 2 ? 0 : vnx + 1;
    }
    pv_d0(o, V_lds + vprev * SHM_VT, p8, r32, hi);
    __builtin_amdgcn_s_setprio(0);
  }
  int lane_e = lane; asm volatile("" : "+v"(lane_e));
  const int r32e = lane_e & 31, hie = lane_e >> 5;
  l_reg += __shfl_xor(l_reg, 32);
  int* satf = (int*)(lds + OFF_WS + NW * 64 * 4);
  if (!SHIFT) { const bool sat = __any(l_reg >= 57344.f); if (lane_e == 0) satf[wid] = sat ? 1 : 0; }
  if (hie == 0) li_l[r32e] = l_reg; asm volatile("s_waitcnt lgkmcnt(0)" ::: "memory");
  float rli[16];
#pragma unroll
  for (int r = 0; r < 16; ++r) rli[r] = __builtin_amdgcn_rcpf(li_l[crow(r, hie)]);
  char* Ow = (char*)O + ((long)b * SEQ + s0 + wid * QBLK) * LDO + h * 128;
#pragma unroll
  for (int r = 0; r < 16; ++r) { const unsigned ooff = (unsigned)(crow(r, hie) * LDO + r32e);
#pragma unroll
    for (int d0 = 0; d0 < 4; ++d0) { const int pk = __builtin_amdgcn_cvt_pk_fp8_f32(o[d0][r] * rli[r] * 32.f, 0.f, 0, false); *(unsigned char*)(Ow + ooff + d0 * 32) = (unsigned char)(pk & 0xff); } }
  __syncthreads();
  bool redo = false;
  if (!SHIFT) { redo = (satf[0] | satf[1] | satf[2] | satf[3] | satf[4] | satf[5] | satf[6] | satf[7]) != 0; __syncthreads(); }
  return redo;
#undef SLOAD
#undef SWRITE
}
}
#ifndef HD
#define HD __device__ __forceinline__
#endif
struct c32 { float x, y; };
HD c32 cmk(float x, float y) { c32 r; r.x = x; r.y = y; return r; }
HD c32 cadd(c32 a, c32 b) { return cmk(a.x + b.x, a.y + b.y); }
HD c32 csub(c32 a, c32 b) { return cmk(a.x - b.x, a.y - b.y); }
HD c32 cmul(c32 a, c32 b) { return cmk(a.x * b.x - a.y * b.y, a.x * b.y + a.y * b.x); }
HD c32 cmulc(c32 a, c32 b) { return cmk(a.x * b.x + a.y * b.y, a.y * b.x - a.x * b.y); }
constexpr int BR4(int i) { return ((i & 1) << 3) | ((i & 2) << 1) | ((i & 4) >> 1) | ((i & 8) >> 3); }
template <int SGN, int J> HD c32 tw16(c32 a) {
    if constexpr (J == 0) return a;
    else if constexpr (J == 4) return SGN < 0 ? cmk(a.y, -a.x) : cmk(-a.y, a.x);
    else {
        constexpr float CS[8] = {1.f, 0.92387953251128674f, 0.70710678118654752f, 0.38268343236508977f, 0.f, -0.38268343236508977f, -0.70710678118654752f, -0.92387953251128674f};
        constexpr float SN[8] = {0.f, 0.38268343236508977f, 0.70710678118654752f, 0.92387953251128674f, 1.f, 0.92387953251128674f, 0.70710678118654752f, 0.38268343236508977f};
        constexpr float c = CS[J], s = SN[J];
        if constexpr (SGN < 0) return cmk(a.x * c + a.y * s, a.y * c - a.x * s);
        else return cmk(a.x * c - a.y * s, a.y * c + a.x * s);
    }
}
#define FFT_BF(i, j, J) { const c32 u_ = v[i], w_ = v[j]; v[i] = cadd(u_, w_); v[j] = tw16<SGN, J>(csub(u_, w_)); }
template <int SGN> HD void dft16_dif(c32 (&v)[16]) {
    FFT_BF(0, 8, 0) FFT_BF(1, 9, 1) FFT_BF(2, 10, 2) FFT_BF(3, 11, 3) FFT_BF(4, 12, 4) FFT_BF(5, 13, 5) FFT_BF(6, 14, 6) FFT_BF(7, 15, 7)
    FFT_BF(0, 4, 0) FFT_BF(1, 5, 2) FFT_BF(2, 6, 4) FFT_BF(3, 7, 6) FFT_BF(8, 12, 0) FFT_BF(9, 13, 2) FFT_BF(10, 14, 4) FFT_BF(11, 15, 6)
    FFT_BF(0, 2, 0) FFT_BF(1, 3, 4) FFT_BF(4, 6, 0) FFT_BF(5, 7, 4) FFT_BF(8, 10, 0) FFT_BF(9, 11, 4) FFT_BF(12, 14, 0) FFT_BF(13, 15, 4)
    FFT_BF(0, 1, 0) FFT_BF(2, 3, 0) FFT_BF(4, 5, 0) FFT_BF(6, 7, 0) FFT_BF(8, 9, 0) FFT_BF(10, 11, 0) FFT_BF(12, 13, 0) FFT_BF(14, 15, 0)
}
#undef FFT_BF
#define FFT_BT(i, j, J) { const c32 u_ = v[i], w_ = tw16<SGN, J>(v[j]); v[i] = cadd(u_, w_); v[j] = csub(u_, w_); }
template <int SGN> HD void dft16_dit(c32 (&v)[16]) {
    FFT_BT(0, 1, 0) FFT_BT(2, 3, 0) FFT_BT(4, 5, 0) FFT_BT(6, 7, 0) FFT_BT(8, 9, 0) FFT_BT(10, 11, 0) FFT_BT(12, 13, 0) FFT_BT(14, 15, 0)
    FFT_BT(0, 2, 0) FFT_BT(1, 3, 4) FFT_BT(4, 6, 0) FFT_BT(5, 7, 4) FFT_BT(8, 10, 0) FFT_BT(9, 11, 4) FFT_BT(12, 14, 0) FFT_BT(13, 15, 4)
    FFT_BT(0, 4, 0) FFT_BT(1, 5, 2) FFT_BT(2, 6, 4) FFT_BT(3, 7, 6) FFT_BT(8, 12, 0) FFT_BT(9, 13, 2) FFT_BT(10, 14, 4) FFT_BT(11, 15, 6)
    FFT_BT(0, 8, 0) FFT_BT(1, 9, 1) FFT_BT(2, 10, 2) FFT_BT(3, 11, 3) FFT_BT(4, 12, 4) FFT_BT(5, 13, 5) FFT_BT(6, 14, 6) FFT_BT(7, 15, 7)
}
#undef FFT_BT
constexpr int FFT_PS = 272;
constexpr int FFT_EX_ELEMS = 16 * FFT_PS;
template <class EX> HD void fft_fwd_a(c32 (&v)[16], const c32* T1, EX ex, int tid) {
    dft16_dif<-1>(v);
#pragma unroll
    for (int p = 0; p < 16; ++p) { ex[p * FFT_PS + tid] = cmul(v[BR4(p)], T1[256 * p]); if ((p & 3) == 3) __builtin_amdgcn_sched_barrier(0); }
}
template <class EX> HD void fft_fwd_b(c32 (&v)[16], const c32* T2, EX exr, EX ex, int tid) {
    const int p2 = tid >> 4, c = tid & 15;
#pragma unroll
    for (int b = 0; b < 16; ++b) v[b] = exr[p2 * FFT_PS + 16 * b + c];
    dft16_dif<-1>(v);
#pragma unroll
    for (int q = 0; q < 16; ++q) ex[p2 * FFT_PS + q * 16 + ((c + q) & 15)] = cmul(v[BR4(q)], T2[q]);
}
template <class EX> HD void fft_fwd_c(c32 (&v)[16], EX ex, int tid) {
    const int p2 = tid >> 4, q = tid & 15;
#pragma unroll
    for (int c = 0; c < 16; ++c) v[c] = ex[p2 * FFT_PS + q * 16 + ((c + q) & 15)];
    dft16_dif<-1>(v);
}
template <class EX> HD void fft_inv_a(c32 (&v)[16], EX ex, int tid) {
    const int p = tid >> 4, q = tid & 15;
    dft16_dit<+1>(v);
#pragma unroll
    for (int c = 0; c < 16; ++c) ex[p * FFT_PS + q * 16 + ((c + q) & 15)] = v[c];
}
template <class EX> HD void fft_inv_b(c32 (&v)[16], const c32* T2, EX exr, EX ex, int tid) {
    const int p = tid >> 4, c = tid & 15;
#pragma unroll
    for (int q = 0; q < 16; ++q) v[BR4(q)] = cmulc(exr[p * FFT_PS + q * 16 + ((c + q) & 15)], T2[q]);
    dft16_dit<+1>(v);
#pragma unroll
    for (int b = 0; b < 16; ++b) ex[p * FFT_PS + 16 * b + c] = v[b];
}
template <class EX> HD void fft_inv_c(c32 (&v)[16], const c32* T1, EX ex, int tid) {
#pragma unroll
    for (int p = 0; p < 16; ++p) { v[BR4(p)] = cmulc(ex[p * FFT_PS + tid], T1[256 * p]); if ((p & 3) == 3) __builtin_amdgcn_sched_barrier(0); }
    dft16_dit<+1>(v);
}
constexpr int NWAVES = 8, NTHR = 512;
constexpr int BATCH = 8, SEQ = 4096, DM = 1024, T = BATCH * SEQ;
constexpr float EPS = 1e-6f;
constexpr size_t MiB = 1u << 20;
constexpr size_t WS_CTL = 0, CTL_ZERO_BYTES = 64 * 1024;
constexpr size_t WS_MOD = 1 * MiB;
constexpr size_t WS_HDNS = 1 * MiB + 512 * 1024;
constexpr size_t WS_W4S = 3 * MiB + 512 * 1024;
constexpr size_t WS_LIST = 101 * MiB;
constexpr size_t WS_WL = 396 * MiB;
constexpr size_t WS_WD = 8 * MiB;
constexpr size_t WS_WUQ = 9 * MiB;
constexpr size_t WS_WUKV = 10 * MiB;
constexpr size_t WS_WO = 11 * MiB;
constexpr size_t WS_WIN = 13 * MiB;
constexpr size_t WS_WOUT = 19 * MiB;
constexpr size_t WS_WGU = 21 * MiB;
constexpr size_t WS_WDN = 53 * MiB;
constexpr size_t R1 = 104 * MiB;
constexpr size_t R2 = 232 * MiB;
constexpr size_t R3 = 424 * MiB;
constexpr size_t WS_VT8 = R1, WS_XN2 = R1, WS_KF = R1;
constexpr size_t WS_XN = R2, WS_O = R2;
constexpr size_t WS_LAT = R2 + 64 * MiB;
constexpr size_t WS_HACT = R2 + 64 * MiB;
constexpr size_t WS_CQN = R2 + 128 * MiB;
constexpr size_t WS_CKVN = R2 + 144 * MiB;
constexpr size_t WS_KPE = R2 + 160 * MiB;
constexpr size_t WS_K8 = R2 + 64 * MiB;
constexpr size_t WS_ROPE = R2 + 164 * MiB;
constexpr size_t WS_QRAW = 408 * MiB;
constexpr size_t WS_XN2S = 424 * MiB;
constexpr size_t WS_XR = 424 * MiB;
constexpr size_t WS_HT = R2;
constexpr size_t WS_UT = R2;
constexpr size_t WS_Z = R2;
constexpr size_t WS_END = 512 * MiB;
constexpr int MS_ROWS = T + 24 * 256;
constexpr int CW_BAR = 4096;
constexpr int CW_CNT = 8192;
constexpr int RING_OFF = 0, RING_BYTES = 147456;
constexpr int LDSCTL_OFF = RING_BYTES;
constexpr int MISC_OFF = LDSCTL_OFF;
constexpr int TINFO_OFF = LDSCTL_OFF + 256;
constexpr int RED_OFF = LDSCTL_OFF + 256 + 1280;
constexpr int EPIX_OFF = LDSCTL_OFF + 2048;
constexpr int LDS_BYTES = 163840;
static_assert(RED_OFF + 256 <= LDS_BYTES, "LDS map");

#define GAS __attribute__((address_space(1)))
#define LAS __attribute__((address_space(3)))
typedef unsigned short bf16;
typedef unsigned v4u __attribute__((ext_vector_type(4)));
typedef unsigned v2u __attribute__((ext_vector_type(2)));
typedef int v4i __attribute__((ext_vector_type(4)));
typedef float f32x4 __attribute__((ext_vector_type(4)));
typedef GAS unsigned gu32;
#define RLX_AGENT __ATOMIC_RELAXED, __HIP_MEMORY_SCOPE_AGENT
#define LDS_WAIT() asm volatile("s_waitcnt lgkmcnt(0)" ::: "memory")
__device__ __forceinline__ unsigned pk2(float lo, float hi) { return pg8::cvt_pk_bf16(lo, hi); }
__device__ __forceinline__ float bf2f(unsigned short b) { return __uint_as_float(((unsigned)b) << 16); }
__device__ __forceinline__ float wave_sum(float v) {
#pragma unroll
    for (int o = 1; o < 64; o <<= 1) v += __shfl_xor(v, o);
    return v;
}

#define XB_TMO      128
#define XB_XCNT(j)  (256  + 64 * (j))
#define XB_XSUB(j)  (1280 + 64 * (j))
#define XB_XGEN(j)  (2304 + 64 * (j))
#define XB_TOP      3328
#define XB_TOPGEN   3392
#define XCD_BAR_WORDS 3456
#define XB_SPIN_CAP (1u << 18)

__device__ __forceinline__ unsigned xb_ld(unsigned* p)              { return __hip_atomic_load(p, __ATOMIC_RELAXED, __HIP_MEMORY_SCOPE_AGENT); }
__device__ __forceinline__ unsigned xb_add(unsigned* p, unsigned v) { return __hip_atomic_fetch_add(p, v, __ATOMIC_RELAXED, __HIP_MEMORY_SCOPE_AGENT); }
__device__ __forceinline__ unsigned xb_xcc_id() { return (unsigned)__builtin_amdgcn_s_getreg((3 << 11) | 20) & 0xFu; }
#define XB_SPIN(cond, bar) do { unsigned _sp = 0; while (cond) { __builtin_amdgcn_s_sleep(1); \
    if ((++_sp & 255u) == 0u) { if (xb_ld(&(bar)[XB_TMO])) break; if (_sp > XB_SPIN_CAP) { atomicAdd(&(bar)[XB_TMO], 1u); break; } } } } while (0)

struct XcdBarrier {
    unsigned* bar; unsigned x;
    volatile LAS unsigned* st;
    int w0;
};

__device__ __forceinline__ XcdBarrier xcd_barrier_post(unsigned* bar, volatile LAS unsigned* st) {
    XcdBarrier b; b.bar = bar; b.x = xb_xcc_id(); b.st = st; b.w0 = 0;
    if (threadIdx.x == 0) (void)xb_add(&bar[XB_XCNT(b.x)], 1u);
    return b;
}
__device__ __forceinline__ void xcd_barrier_complete(unsigned* bar, unsigned x, unsigned& nloc, unsigned& nx) {
    const unsigned G = gridDim.x * gridDim.y * gridDim.z;
    unsigned sum, cnt, mine, sp = 0u;
    for (;;) {
        sum = 0u; cnt = 0u; mine = 0u;
#pragma unroll
        for (unsigned j = 0; j < 16; ++j) { const unsigned c = xb_ld(&bar[XB_XCNT(j)]); sum += c; cnt += (c > 0u) ? 1u : 0u; mine = (j == x) ? c : mine; }
        if (sum == G) break;
        __builtin_amdgcn_s_sleep(1);
        if ((++sp & 255u) == 0u) { if (xb_ld(&bar[XB_TMO])) break; if (sp > XB_SPIN_CAP) { atomicAdd(&bar[XB_TMO], 1u); break; } }
    }
    nloc = mine > 0u ? mine : 1u; nx = cnt > 0u ? cnt : 1u;
}

__device__ __forceinline__ void xcd_barrier(const XcdBarrier& b) {
    asm volatile("s_waitcnt vmcnt(0)" ::: "memory");
    __syncthreads();
    if (b.w0 && __builtin_amdgcn_mbcnt_hi(~0u, __builtin_amdgcn_mbcnt_lo(~0u, 0u)) == 0u) {
        unsigned* bar = b.bar;
        __builtin_amdgcn_s_waitcnt(0);
        unsigned nloc = b.st[0], nx = b.st[1];
        if (nloc == 0u) { xcd_barrier_complete(bar, b.x, nloc, nx); b.st[0] = nloc; b.st[1] = nx; }
        const unsigned old = xb_add(&bar[XB_XSUB(b.x)], 1u);
        const unsigned gen = old / nloc;
        if (old + 1u == (gen + 1u) * nloc) {
            __builtin_amdgcn_fence(__ATOMIC_RELEASE, "agent");
            asm volatile("s_waitcnt vmcnt(0)" ::: "memory");
            const unsigned og = xb_add(&bar[XB_TOP], 1u);
            const unsigned tg = og / nx;
            if (og + 1u == (tg + 1u) * nx) xb_add(&bar[XB_TOPGEN], 1u);
            else XB_SPIN(xb_ld(&bar[XB_TOPGEN]) == tg, bar);
            __builtin_amdgcn_fence(__ATOMIC_ACQUIRE, "agent");
            xb_add(&bar[XB_XGEN(b.x)], 1u);
            asm volatile("s_waitcnt vmcnt(0)" ::: "memory");
        } else {
            XB_SPIN(xb_ld(&bar[XB_XGEN(b.x)]) == gen, bar);
            __builtin_amdgcn_fence(__ATOMIC_ACQUIRE, "agent");
            asm volatile("s_waitcnt vmcnt(0)" ::: "memory");
        }
    }
    __syncthreads();
}


struct Ctx { unsigned char* lds; int tid, lane, wave, vcu, G, gw, NGW; };

__device__ __forceinline__ void transpose_item(const float* W, int ldw, int k0, int n0, bf16* WT, int ldt, int drow0, int dcol0, float* scr, int lane, bool kpe_perm) {
    float tv[32];
#pragma unroll
    for (int i = 0; i < 32; ++i) { const int kk = 2 * i + (lane >> 5); tv[i] = W[(size_t)(k0 + kk) * ldw + n0 + (lane & 31)]; }
#pragma unroll
    for (int i = 0; i < 32; ++i) { const int kk = 2 * i + (lane >> 5); scr[kk * 33 + (lane & 31)] = tv[i]; }
    LDS_WAIT();
    const int c = lane & 7;
#pragma unroll
    for (int j = 0; j < 4; ++j) { const int n = (lane >> 3) + 8 * j; const float* s = scr + (8 * c) * 33 + n;
        v4u o; o.x = pk2(s[0 * 33], s[1 * 33]); o.y = pk2(s[2 * 33], s[3 * 33]); o.z = pk2(s[4 * 33], s[5 * 33]); o.w = pk2(s[6 * 33], s[7 * 33]);
        int dr = drow0 + n; if (kpe_perm && dr >= 384 && dr < 448) { const int e = dr - 384; dr = 384 + 32 * ((e >> 4) & 1) + 16 * (e >> 5) + (e & 15); }
        *(v4u*)(WT + (size_t)dr * ldt + dcol0 + k0 + 8 * c) = o; }
    LDS_WAIT();
}
__device__ __forceinline__ void transpose_item8(const float* W, int ldw, int k0, int n0, unsigned char* WT8, int ldt8, int drow0, int dcol0, float* scr, int lane, float scale, bool kpe_perm) {
    float tv[32];
#pragma unroll
    for (int i = 0; i < 32; ++i) { const int kk = 2 * i + (lane >> 5); tv[i] = W[(size_t)(k0 + kk) * ldw + n0 + (lane & 31)]; }
#pragma unroll
    for (int i = 0; i < 32; ++i) { const int kk = 2 * i + (lane >> 5); scr[kk * 33 + (lane & 31)] = tv[i]; }
    LDS_WAIT();
    const int n = lane >> 1, hf = lane & 1; const float* sp = scr + (32 * hf) * 33 + n;
    v4u o0, o1; unsigned w[8];
#pragma unroll
    for (int q = 0; q < 8; ++q) { int p = 0; p = __builtin_amdgcn_cvt_pk_fp8_f32(sp[(4 * q) * 33] * scale, sp[(4 * q + 1) * 33] * scale, p, false); p = __builtin_amdgcn_cvt_pk_fp8_f32(sp[(4 * q + 2) * 33] * scale, sp[(4 * q + 3) * 33] * scale, p, true); w[q] = (unsigned)p; }
    o0.x = w[0]; o0.y = w[1]; o0.z = w[2]; o0.w = w[3]; o1.x = w[4]; o1.y = w[5]; o1.z = w[6]; o1.w = w[7];
    int dr = drow0 + n; if (kpe_perm && dr >= 384 && dr < 448) { const int e = dr - 384; dr = 384 + 32 * ((e >> 4) & 1) + 16 * (e >> 5) + (e & 15); }
    unsigned char* d = WT8 + (size_t)dr * ldt8 + dcol0 + k0 + 32 * hf;
    *(v4u*)d = o0; *(v4u*)(d + 16) = o1;
    LDS_WAIT();
}
typedef __attribute__((address_space(4))) const char kchar;
struct In { int opq;
    __device__ __forceinline__ const float* operator[](int k) const { kchar* ka = (kchar*)__builtin_amdgcn_kernarg_segment_ptr(); return *(const float* const __attribute__((address_space(4)))*)(ka + 8 * k + opq); } };
__device__ __forceinline__ unsigned char* karg_ws(int opq) { kchar* ka = (kchar*)__builtin_amdgcn_kernarg_segment_ptr(); return *(unsigned char* const __attribute__((address_space(4)))*)(ka + 38 * 8 + 8 + opq); }
__device__ __forceinline__ float* karg_out(int opq) { kchar* ka = (kchar*)__builtin_amdgcn_kernarg_segment_ptr(); return *(float* const __attribute__((address_space(4)))*)(ka + 38 * 8 + opq); }

__device__ __forceinline__ void p0_prologue(const Ctx& F, const In& in, unsigned char* ws) {
    float* scr = (float*)(F.lds + RING_OFF + F.wave * 16384);
    bf16* Wd = (bf16*)(ws + WS_WD); bf16* Wuq = (bf16*)(ws + WS_WUQ); bf16* Wukv = (bf16*)(ws + WS_WUKV); bf16* Wo = (bf16*)(ws + WS_WO);
    bf16* Win = (bf16*)(ws + WS_WIN); bf16* Wout = (bf16*)(ws + WS_WOUT); bf16* Wgu = (bf16*)(ws + WS_WGU); bf16* Wdn = (bf16*)(ws + WS_WDN);
    constexpr int I_D = 16 * 14, I_UQ = 4 * 48, I_UKV = 2 * 64, I_O = 16 * 32, I_IN = 16 * 96, I_OUT = 16 * 32, I_GU = 2 * 16 * 2 * (16 * 8), I_DN = 2 * 24 * 2 * (4 * 32);
    constexpr int NITEMS = I_D + I_UQ + I_UKV + I_O + I_IN + I_OUT + I_GU + I_DN;
    for (int it = F.gw; it < NITEMS; it += F.NGW) {
        int r = it; const float* W; int ldw, k0, n0, ldt, drow0, dcol0 = 0; bf16* WT; float f8s = 0.f;
        if (r < I_D) { W = in[7]; ldw = 448; k0 = (r / 14) * 64; n0 = (r % 14) * 32; WT = Wd; ldt = 1024; drow0 = n0; f8s = 32.f; }
        else if ((r -= I_D) < I_UQ) { W = in[10]; ldw = 1536; k0 = (r / 48) * 64; n0 = (r % 48) * 32; WT = Wuq; ldt = 256; drow0 = n0; f8s = 16.f; }
        else if ((r -= I_UQ) < I_UKV) { W = in[11]; ldw = 2048; k0 = (r / 64) * 64; n0 = (r % 64) * 32; ldt = 128;
            WT = Wukv + ((n0 & 128) ? 1024 * 128 : 0); drow0 = (n0 >> 8) * 128 + (n0 & 127); }
        else if ((r -= I_UKV) < I_O) { W = in[14]; ldw = 1024; k0 = (r / 32) * 64; n0 = (r % 32) * 32; WT = Wo; ldt = 1024; drow0 = n0; f8s = 32.f; }
        else if ((r -= I_O) < I_IN) { W = in[15]; ldw = 3072; k0 = (r / 96) * 64; n0 = (r % 96) * 32; WT = Win; ldt = 1024; drow0 = n0; }
        else if ((r -= I_IN) < I_OUT) { W = in[30]; ldw = 1024; k0 = (r / 32) * 64; n0 = (r % 32) * 32; WT = Wout; ldt = 1024; drow0 = n0; }
        else if ((r -= I_OUT) < I_GU) {
            const int sub = r % 128, mat = r / 128, which = mat & 1, le = mat >> 1;
            W = (which ? in[36] : in[35]) + (size_t)le * 1024 * 256; ldw = 256; k0 = (sub / 8) * 64; n0 = (sub % 8) * 32;
            WT = (bf16*)((unsigned char*)Wgu + (size_t)le * 512 * 1024); ldt = 1024; drow0 = (n0 >> 7) * 256 + which * 128 + (n0 & 127); f8s = 32.f; }
        else { r -= I_GU;
            const int sub = r % 128, mat = r / 128, slot = mat & 1, lb = mat >> 1, layer = lb / 24, bk = lb % 24;
            int ii, jj; pg8::pair_of(bk % 6, ii, jj); const int e = (bk / 6) * 4 + (slot ? jj : ii);
            W = in[37] + (size_t)(layer * 16 + e) * 256 * 1024; ldw = 1024; k0 = (sub / 32) * 64; n0 = (sub % 32) * 32;
            WT = Wdn + (size_t)lb * 1024 * 512; ldt = 512; drow0 = n0; dcol0 = slot * 256; }
        if (f8s != 0.f) transpose_item8(W, ldw, k0, n0, (unsigned char*)WT, ldt, drow0, dcol0, scr, F.lane, f8s, it < I_D);
        else transpose_item(W, ldw, k0, n0, WT, ldt, drow0, dcol0, scr, F.lane, it < I_D);
    }
    { const int gt = F.vcu * NTHR + F.tid, NGT = F.G * NTHR; const v4u z = {0u, 0u, 0u, 0u};
      for (int i = gt; i < 64 * 1024 / 16; i += NGT) *(v4u*)((unsigned char*)Wd + (size_t)448 * 1024 + (size_t)i * 16) = z;
    }
    { const int gt = F.vcu * NTHR + F.tid, NGT = F.G * NTHR; float* RT = (float*)(ws + WS_ROPE); const int* posi = (const int*)in[2];
      const float inv = __builtin_amdgcn_exp2f(-0.41524101186092029f * (float)(gt & 31));
      for (int i = gt; i < T * 32; i += NGT) { const int t = i >> 5;
        float sn, cs; sincosf((float)posi[t] * inv, &sn, &cs); *(v2u*)(RT + (size_t)i * 2) = (v2u){__float_as_uint(cs), __float_as_uint(sn)}; } }
    { const int gt = F.vcu * NTHR + F.tid, NGT = F.G * NTHR; bf16* W4S = (bf16*)(ws + WS_W4S); const float* w4 = in[28];
      for (int i = gt; i < 4096 * 8; i += NGT) { const int col = i & 4095, oct = i >> 12; float w[8];
#pragma unroll
        for (int q = 0; q < 8; ++q) w[q] = w4[(size_t)(8 * oct + q) * 4096 + col];
        unsigned hw[4], lw[4];
#pragma unroll
        for (int q = 0; q < 4; ++q) { const unsigned h2 = pk2(w[2 * q], w[2 * q + 1]); hw[q] = h2;
          lw[q] = pk2(w[2 * q] - __uint_as_float(h2 << 16), w[2 * q + 1] - __uint_as_float(h2 & 0xffff0000u)); }
        bf16* d = W4S + (size_t)col * 256 + 8 * oct; const v4u hv = {hw[0], hw[1], hw[2], hw[3]}, lv = {lw[0], lw[1], lw[2], lw[3]}, zv = {0u, 0u, 0u, 0u};
        *(v4u*)d = hv; *(v4u*)(d + 64) = hv; *(v4u*)(d + 128) = lv; *(v4u*)(d + 192) = zv; } }
    __syncthreads();
    { bf16* HDp = (bf16*)(ws + WS_HDNS); float* wl = (float*)(F.lds + RING_OFF); float* sv = wl + 161 * 64 + F.wave * 64;
      for (int i = F.tid; i < 161 * 64; i += NTHR) wl[i] = i < 33 * 64 ? in[19][i] : (i < 97 * 64 ? in[22][i - 33 * 64] : in[25][i - 97 * 64]);
      __syncthreads();
      const int j = F.lane; const float b1 = in[20][j], f1 = in[21][j], b2 = in[23][j], f2 = in[24][j], b3 = in[26][j], f3 = in[27][j];
      for (int t = F.gw; t < 4096; t += F.NGW) {
        float zf = 0.f;
        { const float w = 6.2831855f * (float)t * (1.f / 4096.f);
          if (j == 0) zf = (float)t / 4095.f;
          else if (j <= 16) { const float fr = 1e-4f + (float)(j - 1) * ((15.f - 1e-4f) / 15.f); zf = cosf(fr * w); }
          else if (j <= 32) { const float fr = 1e-4f + (float)(j - 17) * ((15.f - 1e-4f) / 15.f); zf = -sinf(fr * w); } }
        sv[j] = zf; LDS_WAIT();
        float a = b1;
#pragma unroll
        for (int k = 0; k < 33; ++k) a += sv[k] * wl[k * 64 + j];
        float h = sinf(f1 * a); LDS_WAIT(); sv[j] = h; LDS_WAIT();
        a = b2;
#pragma unroll 16
        for (int k = 0; k < 64; ++k) a += sv[k] * wl[(33 + k) * 64 + j];
        h = sinf(f2 * a); LDS_WAIT(); sv[j] = h; LDS_WAIT();
        a = b3;
#pragma unroll 16
        for (int k = 0; k < 64; ++k) a += sv[k] * wl[(97 + k) * 64 + j];
        h = sinf(f3 * a); LDS_WAIT();
        const unsigned hi = pk2(h, 0.f) & 0xffffu; const float lo = h - bf2f((unsigned short)hi); const unsigned lob = pk2(lo, 0.f) & 0xffffu;
        bf16* d = HDp + (size_t)t * 256 + j; d[0] = (bf16)hi; d[64] = (bf16)lob; d[128] = (bf16)hi; d[192] = 0;
      } }
    __syncthreads();
    { float* cact = (float*)(F.lds + RING_OFF); float* red = cact + 8 * 1024;
      float* MOD = (float*)(ws + WS_MOD);
      for (int i = F.tid; i < 8 * 1024; i += NTHR) { const float x = in[1][i]; cact[(i & 1023) * 8 + (i >> 10)] = x / (1.f + __expf(-x)); }
      __syncthreads();
      for (int it = F.vcu; it < 2 * 96; it += F.G) {
        const int layer = it / 96, cb = it - 96 * layer, r4 = F.lane >> 4, cq = F.lane & 15;
        const float* W = in[3] + (size_t)layer * 1024 * 6144 + cb * 64 + 4 * cq + (size_t)(F.wave * 128 + r4) * 6144;
        f32x4 acc[8];
#pragma unroll
        for (int b = 0; b < 8; ++b) acc[b] = (f32x4){0.f, 0.f, 0.f, 0.f};
#pragma unroll
        for (int hf = 0; hf < 2; ++hf) { f32x4 wv[16];
#pragma unroll
          for (int q = 0; q < 16; ++q) wv[q] = *(const f32x4*)(W + (size_t)(4 * (16 * hf + q)) * 6144);
#pragma unroll
          for (int q = 0; q < 16; ++q) { const int kk = 4 * (16 * hf + q) + r4; const float* cp = cact + (F.wave * 128 + kk) * 8; const f32x4 c0 = *(const f32x4*)cp, c1 = *(const f32x4*)(cp + 4);
#pragma unroll
            for (int b = 0; b < 8; ++b) acc[b] += (b < 4 ? c0[b & 3] : c1[b & 3]) * wv[q]; } }
#pragma unroll
        for (int b = 0; b < 8; ++b) *(f32x4*)(red + ((F.wave * 4 + r4) * 8 + b) * 64 + 4 * cq) = acc[b];
        __syncthreads();
        { const int b = F.tid >> 6, col = F.tid & 63; float s = in[4][layer * 6144 + cb * 64 + col];
#pragma unroll 8
          for (int p = 0; p < 32; ++p) s += red[(p * 8 + b) * 64 + col];
          MOD[((size_t)layer * 8 + b) * 6144 + cb * 64 + col] = s; }
        __syncthreads();
      } }
}

template <class TX> __device__ __forceinline__ f32x4 ldrow4(const TX* p);
template <> __device__ __forceinline__ f32x4 ldrow4<float>(const float* p) { return *(const __attribute__((address_space(1))) f32x4*)p; }
template <> __device__ __forceinline__ f32x4 ldrow4<bf16>(const bf16* p) { const v2u w = *(const __attribute__((address_space(1))) v2u*)p; f32x4 r; r[0] = __uint_as_float(w.x << 16); r[1] = __uint_as_float(w.x & 0xffff0000u); r[2] = __uint_as_float(w.y << 16); r[3] = __uint_as_float(w.y & 0xffff0000u); return r; }
template <class TX, bool OUT8 = false> __device__ __forceinline__ void norm_mod_phase(const Ctx& F, const TX* X, const float* g, const float* sc, const float* sh, bf16* OUT) {
    for (int ch = F.gw; ch < T / 16; ch += F.NGW) {
        const int r0 = ch * 16, b = r0 >> 12;
        f32x4 A[4], S[4];
#pragma unroll
        for (int j = 0; j < 4; ++j) { const int col = 4 * F.lane + 256 * j; const f32x4 gv = *(const f32x4*)(g + col), sv = *(const f32x4*)(sc + (size_t)b * 6144 + col); A[j] = gv * (1.f + sv); S[j] = *(const f32x4*)(sh + (size_t)b * 6144 + col); }
        const TX* xr = X + (size_t)r0 * DM + 4 * F.lane;
        f32x4 nx[4];
#pragma unroll
        for (int j = 0; j < 4; ++j) nx[j] = ldrow4<TX>(xr + 256 * j);
        for (int rr = 0; rr < 16; ++rr) {
            f32x4 v[4]; float ss = 0.f;
#pragma unroll
            for (int j = 0; j < 4; ++j) { v[j] = nx[j]; ss += (v[j].x * v[j].x + v[j].y * v[j].y) + (v[j].z * v[j].z + v[j].w * v[j].w); }
            if (rr < 15) {
#pragma unroll
                for (int j = 0; j < 4; ++j) nx[j] = ldrow4<TX>(xr + (size_t)(rr + 1) * DM + 256 * j); }
            const float rstd = rsqrtf(wave_sum(ss) * (1.f / DM) + EPS);
            if constexpr (OUT8) { unsigned char* orow = (unsigned char*)OUT + (size_t)(r0 + rr) * DM + 4 * F.lane;
#pragma unroll
                for (int j = 0; j < 4; ++j) { const f32x4 o = v[j] * rstd * A[j] + S[j]; int p = 0; p = __builtin_amdgcn_cvt_pk_fp8_f32(o.x, o.y, p, false); p = __builtin_amdgcn_cvt_pk_fp8_f32(o.z, o.w, p, true); *(int*)(orow + 256 * j) = p; } }
            else { bf16* orow = OUT + (size_t)(r0 + rr) * DM + 4 * F.lane;
#pragma unroll
                for (int j = 0; j < 4; ++j) { const f32x4 o = v[j] * rstd * A[j] + S[j]; v2u w; w.x = pk2(o.x, o.y); w.y = pk2(o.z, o.w); *(v2u*)(orow + 256 * j) = w; } } }
    }
}

__device__ __forceinline__ void lat_post_phase(const Ctx& F, const float* LAT, const float* qag, const float* kvag, const float* kng, const float* rope, bf16* CQN, bf16* CKVN, bf16* KPE) {
    const int l = F.lane;
    const f32x4 gq = *(const f32x4*)(qag + 4 * l);
    const f32x4 g2 = l < 32 ? *(const f32x4*)(kvag + 4 * l) : (l < 48 ? *(const f32x4*)(kng + 128 + 4 * (l - 32)) : (f32x4){0.f, 0.f, 0.f, 0.f});
    f32x4 na = *(const f32x4*)(LAT + (size_t)F.gw * 512 + 4 * l), nc = l < 48 ? *(const f32x4*)(LAT + (size_t)F.gw * 512 + 256 + 4 * l) : (f32x4){0.f, 0.f, 0.f, 0.f};
    for (int row = F.gw; row < T; row += F.NGW) {
        const f32x4 a = na, c = nc;
        if (row + F.NGW < T) { const float* nr = LAT + (size_t)(row + F.NGW) * 512; na = *(const f32x4*)(nr + 4 * l); if (l < 48) nc = *(const f32x4*)(nr + 256 + 4 * l); }
        const float sq = (a.x * a.x + a.y * a.y) + (a.z * a.z + a.w * a.w), sc = (c.x * c.x + c.y * c.y) + (c.z * c.z + c.w * c.w);
        const float s_q = wave_sum(sq), s_kv = wave_sum(l < 32 ? sc : 0.f), s_pe = wave_sum((l >= 32 && l < 48) ? sc : 0.f);
        const float rq = rsqrtf(s_q * (1.f / 256.f) + EPS), rkv = rsqrtf(s_kv * (1.f / 128.f) + EPS), rpe = rsqrtf(s_pe * (1.f / 64.f) + EPS);
        { const f32x4 o = a * rq * gq; v2u w; w.x = pk2(o.x, o.y); w.y = pk2(o.z, o.w); *(v2u*)(CQN + (size_t)row * 256 + 4 * l) = w; }
        if (l < 32) { const f32x4 o = c * rkv * g2; v2u w; w.x = pk2(o.x, o.y); w.y = pk2(o.z, o.w); *(v2u*)(CKVN + (size_t)row * 256 + 4 * l) = w; }
        else { v2u w; w.x = 0u; w.y = 0u; *(v2u*)(CKVN + (size_t)row * 256 + 128 + 4 * (l - 32)) = w; }
        const f32x4 n = c * rpe * g2;
        f32x4 other; other.x = __shfl_xor(n.x, 8); other.y = __shfl_xor(n.y, 8); other.z = __shfl_xor(n.z, 8); other.w = __shfl_xor(n.w, 8);
        if (l >= 32 && l < 48) { const bool first = l < 40; const int e0 = 4 * ((l - 32) & 7);
            float o[4];
#pragma unroll
            for (int i = 0; i < 4; ++i) { const int e = e0 + i; const float cs = rope[(size_t)row * 64 + e * 2], sn = rope[(size_t)row * 64 + e * 2 + 1];
                const float mine = n[i], oth = other[i]; o[i] = first ? (mine * cs - oth * sn) : (oth * sn + mine * cs); }
            v2u w; w.x = pk2(o[0], o[1]); w.y = pk2(o[2], o[3]); *(v2u*)(KPE + (size_t)row * 64 + 4 * (l - 32)) = w; }
    }
}

__device__ __forceinline__ void knorm_phase(const Ctx& F, bf16* KV, const float* kng) {
    const int l = F.lane, h = l >> 3, e0 = (l & 7) * 16;
    float g[16];
#pragma unroll
    for (int i = 0; i < 16; ++i) g[i] = kng[e0 + i];
    for (int row = F.gw; row < T; row += F.NGW) {
        bf16* p = KV + (size_t)row * 2048 + h * 256 + e0;
        const v4u r0 = *(const v4u*)p, r1 = *(const v4u*)(p + 8);
        float f[16]; const unsigned w[8] = {r0.x, r0.y, r0.z, r0.w, r1.x, r1.y, r1.z, r1.w};
        float ss = 0.f;
#pragma unroll
        for (int i = 0; i < 8; ++i) { f[2 * i] = __uint_as_float(w[i] << 16); f[2 * i + 1] = __uint_as_float(w[i] & 0xffff0000u); ss += f[2 * i] * f[2 * i] + f[2 * i + 1] * f[2 * i + 1]; }
        ss += __shfl_xor(ss, 1); ss += __shfl_xor(ss, 2); ss += __shfl_xor(ss, 4);
        const float r = rsqrtf(ss * (1.f / 128.f) + EPS);
        v4u o0, o1;
        o0.x = pk2(f[0] * r * g[0], f[1] * r * g[1]); o0.y = pk2(f[2] * r * g[2], f[3] * r * g[3]); o0.z = pk2(f[4] * r * g[4], f[5] * r * g[5]); o0.w = pk2(f[6] * r * g[6], f[7] * r * g[7]);
        o1.x = pk2(f[8] * r * g[8], f[9] * r * g[9]); o1.y = pk2(f[10] * r * g[10], f[11] * r * g[11]); o1.z = pk2(f[12] * r * g[12], f[13] * r * g[13]); o1.w = pk2(f[14] * r * g[14], f[15] * r * g[15]);
        *(v4u*)p = o0; *(v4u*)(p + 8) = o1;
    }
}

__device__ __forceinline__ void route_phase(const Ctx& F, const bf16* X, const float* g, const float* sc, const float* sh, const float* wg, const float* bg, const float* we, const float* be,
                                            bf16* XN2, int* LIST, float* WL, gu32* cnt) {
    float* W20 = (float*)(F.lds + RING_OFF);
    for (int i = F.tid; i < 20 * 1024; i += NTHR) { const int o = i >> 10, col = i & 1023; W20[i] = o < 4 ? wg[col * 4 + o] : we[col * 16 + (o - 4)]; }
    __syncthreads();
    float bgv[4];
#pragma unroll
    for (int i = 0; i < 4; ++i) bgv[i] = bg[i];
    for (int ch = F.gw; ch < T / 16; ch += F.NGW) {
        const int r0 = ch * 16, b = r0 >> 12;
        f32x4 A[4], S[4];
#pragma unroll
        for (int j = 0; j < 4; ++j) { const int col = 4 * F.lane + 256 * j; const f32x4 gv = *(const f32x4*)(g + col), sv = *(const f32x4*)(sc + (size_t)b * 6144 + col); A[j] = gv * (1.f + sv); S[j] = *(const f32x4*)(sh + (size_t)b * 6144 + col); }
        const bf16* xr = X + (size_t)r0 * DM + 4 * F.lane;
        f32x4 nx[4];
#pragma unroll
        for (int j = 0; j < 4; ++j) nx[j] = ldrow4<bf16>(xr + 256 * j);
        for (int rr = 0; rr < 16; ++rr) { const int row = r0 + rr;
            f32x4 v[4]; float ss = 0.f;
#pragma unroll
            for (int j = 0; j < 4; ++j) { v[j] = nx[j]; ss += (v[j].x * v[j].x + v[j].y * v[j].y) + (v[j].z * v[j].z + v[j].w * v[j].w); }
            if (rr < 15) {
#pragma unroll
                for (int j = 0; j < 4; ++j) nx[j] = ldrow4<bf16>(xr + (size_t)(rr + 1) * DM + 256 * j); }
            const float rstd = rsqrtf(wave_sum(ss) * (1.f / DM) + EPS);
            unsigned char* orow = (unsigned char*)XN2 + (size_t)row * DM + 4 * F.lane;
#pragma unroll
            for (int j = 0; j < 4; ++j) { v[j] = v[j] * rstd * A[j] + S[j]; int p = 0; p = __builtin_amdgcn_cvt_pk_fp8_f32(v[j].x, v[j].y, p, false); p = __builtin_amdgcn_cvt_pk_fp8_f32(v[j].z, v[j].w, p, true); *(int*)(orow + 256 * j) = p; }
            float gl[4];
#pragma unroll
            for (int o = 0; o < 4; ++o) { float a = 0.f;
#pragma unroll
                for (int j = 0; j < 4; ++j) { const f32x4 w = *(const f32x4*)(W20 + o * 1024 + 4 * F.lane + 256 * j); a += (v[j].x * w.x + v[j].y * w.y) + (v[j].z * w.z + v[j].w * w.w); }
                gl[o] = wave_sum(a) + bgv[o]; }
            int gi = 0; float gm = gl[0]; if (gl[1] > gm) { gm = gl[1]; gi = 1; } if (gl[2] > gm) { gm = gl[2]; gi = 2; } if (gl[3] > gm) { gm = gl[3]; gi = 3; }
            gi = __builtin_amdgcn_readfirstlane(gi);
            const float gw_ = 1.f / (__expf(gl[0] - gm) + __expf(gl[1] - gm) + __expf(gl[2] - gm) + __expf(gl[3] - gm));
            const float* We = W20 + (4 + 4 * gi) * 1024 + 4 * F.lane;
            float e[4];
#pragma unroll
            for (int k = 0; k < 4; ++k) { float a = 0.f;
#pragma unroll
                for (int j = 0; j < 4; ++j) { const f32x4 w = *(const f32x4*)(We + k * 1024 + 256 * j); a += (v[j].x * w.x + v[j].y * w.y) + (v[j].z * w.z + v[j].w * w.w); }
                e[k] = wave_sum(a) + be[4 * gi + k]; }
            int i1 = 0; float m1 = e[0];
#pragma unroll
            for (int k = 1; k < 4; ++k) if (e[k] > m1) { m1 = e[k]; i1 = k; }
            int i2 = -1; float m2 = -3.0e38f;
#pragma unroll
            for (int k = 0; k < 4; ++k) if (k != i1 && e[k] > m2) { m2 = e[k]; i2 = k; }
            const float t2 = __expf(m2 - m1), w1 = gw_ / (1.f + t2), w2 = gw_ * t2 / (1.f + t2);
            const int ilo = i1 < i2 ? i1 : i2, ihi = i1 < i2 ? i2 : i1; const float wlo = i1 < i2 ? w1 : w2, whi = i1 < i2 ? w2 : w1;
            const int pi = ilo == 0 ? ihi - 1 : (ilo == 1 ? ihi + 1 : 5), bk = gi * 6 + pi;
            if (F.lane == 0) { const unsigned pos = __hip_atomic_fetch_add(cnt + bk * 64, 1u, RLX_AGENT);
                LIST[bk * 32768 + pos] = row; float2 ww; ww.x = wlo; ww.y = whi; *(float2*)(WL + ((size_t)bk * 32768 + pos) * 2) = ww; }
        }
    }
}
__device__ __forceinline__ void moe_table(const Ctx& F, const gu32* cnt) {
    int* tinfo = (int*)(F.lds + TINFO_OFF);
    __syncthreads();
    if (F.tid == 0) { int nt = 0;
        for (int b = 0; b < 24; ++b) { const int c = (int)__hip_atomic_load(cnt + b * 64, RLX_AGENT); const int tiles = (c + 255) >> 8;
            tinfo[256 + b] = nt * 256; tinfo[288 + b] = c; for (int i = 0; i < tiles; ++i) tinfo[1 + nt + i] = b; nt += tiles; }
        tinfo[0] = nt; }
    __syncthreads();
}
__device__ __forceinline__ void permute_phase(const Ctx& F, const bf16* XN2, const int* ROUTE, bf16* XN2S, int* TOKW) {
    const int* tinfo = (const int*)(F.lds + TINFO_OFF);
    for (int ch = F.gw; ch < T / 4; ch += F.NGW) {
        v4i r[4]; v4u a[4], bq[4];
#pragma unroll
        for (int i = 0; i < 4; ++i) { const int row = ch * 4 + i; r[i] = *(const v4i*)(ROUTE + (size_t)row * 4);
            a[i] = *(const v4u*)(XN2 + (size_t)row * DM + 8 * F.lane); bq[i] = *(const v4u*)(XN2 + (size_t)row * DM + 512 + 8 * F.lane); }
#pragma unroll
        for (int i = 0; i < 4; ++i) { const int row = ch * 4 + i, srow = tinfo[256 + r[i].x] + r[i].y;
            *(v4u*)(XN2S + (size_t)srow * DM + 8 * F.lane) = a[i]; *(v4u*)(XN2S + (size_t)srow * DM + 512 + 8 * F.lane) = bq[i];
            if (F.lane == 0) { v4i w; w.x = row; w.y = r[i].z; w.z = r[i].w; w.w = 0; *(v4i*)(TOKW + (size_t)srow * 4) = w; } }
    }
}

constexpr float W32C[16] = {1.f, 0.98078528040323043f, 0.92387953251128674f, 0.83146961230254524f, 0.70710678118654752f, 0.55557023301960218f, 0.38268343236508977f, 0.19509032201612825f,
                            0.f, -0.19509032201612825f, -0.38268343236508977f, -0.55557023301960218f, -0.70710678118654752f, -0.83146961230254524f, -0.92387953251128674f, -0.98078528040323043f};
constexpr float W32S[16] = {0.f, 0.19509032201612825f, 0.38268343236508977f, 0.55557023301960218f, 0.70710678118654752f, 0.83146961230254524f, 0.92387953251128674f, 0.98078528040323043f,
                            1.f, 0.98078528040323043f, 0.92387953251128674f, 0.83146961230254524f, 0.70710678118654752f, 0.55557023301960218f, 0.38268343236508977f, 0.19509032201612825f};
struct FftTw { const c32* T1; c32 tob; const c32* T2; };
template <int A> __device__ __forceinline__ c32 mul_to(c32 x, c32 tob) { const c32 y = cmul(x, tob); return cmk(y.x * W32C[A] + y.y * W32S[A], y.y * W32C[A] - y.x * W32S[A]); }
template <int A> __device__ __forceinline__ c32 mul_toc(c32 x, c32 tob) { const c32 y = cmulc(x, tob); return cmk(y.x * W32C[A] - y.y * W32S[A], y.y * W32C[A] + y.x * W32S[A]); }
#define TO_ALL(OP) OP(0) OP(1) OP(2) OP(3) OP(4) OP(5) OP(6) OP(7) OP(8) OP(9) OP(10) OP(11) OP(12) OP(13) OP(14) OP(15)
__device__ __forceinline__ void fft_twiddles(FftTw& W, int gt, c32* t1tab, c32* t2tab, int tid) {
    if (tid < 256) { float s, c; sincosf(-6.283185307179586f * (float)(((tid >> 4) * (tid & 15)) & 255) * (1.f / 256.f), &s, &c); t2tab[(tid >> 4) * 17 + (tid & 15)] = cmk(c, s); }
    for (int i = tid; i < 4096; i += NTHR) { const int p = i >> 8, t = i & 255; float s, c; sincosf(-6.283185307179586f * (float)((t * p) & 4095) * (1.f / 4096.f), &s, &c); t1tab[i] = cmk(c, s); }
    { float s, c; sincosf(-6.283185307179586f * (float)gt * (1.f / 8192.f), &s, &c); W.tob = cmk(c, s); }
    W.T1 = t1tab + gt; W.T2 = t2tab + (gt & 15) * 17;
    __syncthreads();
}
__device__ __forceinline__ void fft_forward_a(c32 (&v)[16], const FftTw& W, c32* ex, int gt) {
    __syncthreads();
    fft_fwd_a(v, W.T1, ex, gt);
    __syncthreads();
}
__device__ __forceinline__ void fft_forward_bc(c32 (&v)[16], const FftTw& W, c32* ex, int gt) {
    fft_fwd_b(v, W.T2, ex, ex, gt);
    __builtin_amdgcn_wave_barrier(); asm volatile("" ::: "memory");
    fft_fwd_c(v, ex, gt);
}
__device__ __forceinline__ void fft_forward(c32 (&v)[16], const FftTw& W, c32* ex, int gt) { fft_forward_a(v, W, ex, gt); fft_forward_bc(v, W, ex, gt); }
__device__ __forceinline__ void fft_inverse(c32 (&v)[16], const FftTw& W, c32* ex, int gt) {
    __builtin_amdgcn_wave_barrier(); asm volatile("" ::: "memory");
    fft_inv_a(v, ex, gt);
    __builtin_amdgcn_wave_barrier(); asm volatile("" ::: "memory");
    fft_inv_b(v, W.T2, ex, ex, gt);
    __syncthreads();
    fft_inv_c(v, W.T1, ex, gt);
}
__device__ __forceinline__ void filter_phase(const Ctx& F, const float* HT, const float* fbias, c32* KF) {
    const int g = __builtin_amdgcn_readfirstlane(F.tid >> 8), gt = F.tid & 255;
    c32* ex = (c32*)(F.lds + RING_OFF + g * 36864);
    float* rev = (float*)ex;
    float* red = (float*)(F.lds + RED_OFF);
    FftTw W; fft_twiddles(W, gt, (c32*)(F.lds + RING_OFF + 73728), (c32*)(F.lds + RING_OFF + 110592), F.tid);
    for (int d = F.vcu; d < DM; d += F.G) {
        int gtv = gt; asm volatile("" : "+v"(gtv));
        const float delta = fabsf(-120.39728043259361f + (float)d * ((40.546510810816436f + 120.39728043259361f) / 1023.f));
        const float* hfp = HT + (size_t)(g * 2048 + d) * 4096; const float* hbp = HT + (size_t)(g * 2048 + 1024 + d) * 4096;
        float hf[16], hb[16]; float sf = 0.f, sb = 0.f;
#pragma unroll
        for (int a = 0; a < 16; ++a) { const int t = 256 * a + gtv; const float dec = __expf(-((float)t * (1.f / 4095.f)) * delta); hf[a] = hfp[t] * dec; hb[a] = hbp[t] * dec; sf += fabsf(hf[a]); sb += fabsf(hb[a]); }
        sf = wave_sum(sf); sb = wave_sum(sb);
        __syncthreads();
        if (F.lane == 0) { red[F.wave * 2] = sf; red[F.wave * 2 + 1] = sb; }
        __syncthreads();
        sf = red[g * 8] + red[g * 8 + 2] + red[g * 8 + 4] + red[g * 8 + 6]; sb = red[g * 8 + 1] + red[g * 8 + 3] + red[g * 8 + 5] + red[g * 8 + 7];
        const float nf = 1.f / (sf + EPS) * (1.f / 8192.f), nb = 1.f / (sb + EPS) * (1.f / 8192.f);
#pragma unroll
        for (int a = 0; a < 16; ++a) rev[256 * a + gt] = hb[a] * nb;
        __syncthreads();
        c32 v[16];
#pragma unroll
        for (int a = 0; a < 16; ++a) { const int n = 256 * a + gt; hb[a] = n == 0 ? 0.f : rev[4096 - n]; hf[a] *= nf; v[a] = cmk(hf[a] + hb[a], 0.f); }
        fft_forward(v, W, ex, gt);
        c32* kf = KF + ((size_t)(d * 2 + g) * 2) * 4096; const float fb = fbias[g * 1024 + d] * (1.f / 4096.f);
#pragma unroll
        for (int i = 0; i < 16; ++i) kf[i * 256 + gtv] = cmk(v[i].x + fb, v[i].y);
#define OPX(A) v[A] = mul_to<A>(cmk(hf[A] - hb[A], 0.f), W.tob);
        TO_ALL(OPX)
#undef OPX
        fft_forward(v, W, ex, gt);
#pragma unroll
        for (int i = 0; i < 16; ++i) kf[4096 + i * 256 + gtv] = v[i];
    }
}
__device__ __forceinline__ void long_conv(c32 (&z)[16], const c32* kf, const FftTw& W, c32* ex, int gt) {
    typedef float f32x2v __attribute__((ext_vector_type(2))); typedef __attribute__((address_space(1))) const f32x2v gc32;
    c32 v[16], k[16]; int gk = gt; asm volatile("" : "+v"(gk));
#define OPX(A) v[A] = mul_to<A>(z[A], W.tob);
    TO_ALL(OPX)
#undef OPX
    fft_forward_a(v, W, ex, gt);
    asm volatile("" ::: "memory");
#pragma unroll
    for (int i = 0; i < 16; ++i) { const f32x2v t_ = ((gc32*)kf)[4096 + i * 256 + gk]; k[i] = cmk(t_.x, t_.y); }
    fft_forward_bc(v, W, ex, gt);
#pragma unroll
    for (int i = 0; i < 16; ++i) v[i] = cmul(v[i], k[i]);
    fft_inverse(v, W, ex, gt);
#define OPX(A) v[A] = mul_toc<A>(v[A], W.tob);
    TO_ALL(OPX)
#undef OPX
    fft_forward_a(z, W, ex, gt);
    asm volatile("" ::: "memory");
#pragma unroll
    for (int i = 0; i < 16; ++i) { const f32x2v t_ = ((gc32*)kf)[i * 256 + gk]; k[i] = cmk(t_.x, t_.y); }
    fft_forward_bc(z, W, ex, gt);
#pragma unroll
    for (int i = 0; i < 16; ++i) z[i] = cmul(z[i], k[i]);
    fft_inverse(z, W, ex, gt);
#pragma unroll
    for (int a = 0; a < 16; ++a) z[a] = cadd(z[a], v[a]);
}
struct RawSeq { v4u r[2][2]; };
__device__ __forceinline__ void raw_issue(RawSeq& q, const bf16* urow, int b0, int gt) {
    typedef __attribute__((address_space(1))) const v4u gv4u;
    asm volatile("" : "+v"(gt));
#pragma unroll
    for (int s_ = 0; s_ < 2; ++s_)
#pragma unroll
        for (int i = 0; i < 2; ++i) q.r[s_][i] = *(gv4u*)(urow + (size_t)(b0 + s_) * SEQ + (gt + 256 * i) * 8);
}
__device__ __forceinline__ void stage_conv3(c32 (&o)[16], const RawSeq& q, float w0, float w1, float w2, float cb, bf16* stg, int gt) {
    constexpr int SS = 4112;
    __syncthreads();
#pragma unroll
    for (int s_ = 0; s_ < 2; ++s_) {
#pragma unroll
        for (int i = 0; i < 2; ++i) *(v4u*)(stg + s_ * SS + 8 + (gt + 256 * i) * 8) = q.r[s_][i];
        if (gt == 0) { stg[s_ * SS + 7] = 0; stg[s_ * SS + 4104] = 0; } }
    __syncthreads();
#pragma unroll
    for (int a = 0; a < 16; ++a) { const int t = 256 * a + gt; float r[2];
#pragma unroll
        for (int s_ = 0; s_ < 2; ++s_) { const bf16* sp = stg + s_ * SS + 7 + t; r[s_] = w0 * bf2f(sp[0]) + w1 * bf2f(sp[1]) + w2 * bf2f(sp[2]) + cb; }
        o[a] = cmk(r[0], r[1]); if ((a & 3) == 3) __builtin_amdgcn_sched_barrier(0); }
}
__device__ __forceinline__ void conv_phase(const Ctx& F, const bf16* UT, const c32* KF, const float* convw, const float* convb, bf16* ZT) {
    const int g = __builtin_amdgcn_readfirstlane(F.tid >> 8), gt = F.tid & 255;
    c32* ex = (c32*)(F.lds + RING_OFF + g * 36864);
    bf16* stg = (bf16*)ex;
    FftTw W; fft_twiddles(W, gt, (c32*)(F.lds + RING_OFF + 73728), (c32*)(F.lds + RING_OFF + 110592), F.tid);
    RawSeq raw;
    if (F.vcu < DM) raw_issue(raw, UT + (size_t)(2048 + F.vcu) * T, (2 * g) * 2, gt);
    for (int d = F.vcu; d < DM; d += F.G) {
        const c32* kf0 = KF + ((size_t)(d * 2 + 0) * 2) * 4096; const c32* kf1 = KF + ((size_t)(d * 2 + 1) * 2) * 4096;
        for (int pp = 0; pp < 2; ++pp) { const int b0 = (2 * g + pp) * 2;
            int gtv = gt; asm volatile("" : "+v"(gtv));
            c32 z[16], gate[16];
            { const int c = 2048 + d; stage_conv3(z, raw, convw[c], convw[3072 + c], convw[6144 + c], convb[c], stg, gtv); }
            raw_issue(raw, UT + (size_t)d * T, b0, gtv);
            long_conv(z, kf0, W, ex, gtv);
            { const int c = d; stage_conv3(gate, raw, convw[c], convw[3072 + c], convw[6144 + c], convb[c], stg, gtv); }
            raw_issue(raw, UT + (size_t)(1024 + d) * T, b0, gtv);
#pragma unroll
            for (int a = 0; a < 16; ++a) z[a] = cmk(z[a].x * gate[a].x, z[a].y * gate[a].y);
            long_conv(z, kf1, W, ex, gtv);
            { const int c = 1024 + d; stage_conv3(gate, raw, convw[c], convw[3072 + c], convw[6144 + c], convb[c], stg, gtv); }
            { const int dn = pp == 0 ? d : d + F.G; if (dn < DM) raw_issue(raw, UT + (size_t)(2048 + dn) * T, pp == 0 ? b0 + 2 : (2 * g) * 2, gtv); }
            bf16* zr = ZT + (size_t)d * T + (size_t)b0 * SEQ;
#pragma unroll
            for (int a = 0; a < 16; ++a) { const int t = 256 * a + gtv; const unsigned pk = pk2(z[a].x * gate[a].x, z[a].y * gate[a].y); zr[t] = (bf16)(pk & 0xffffu); zr[SEQ + t] = (bf16)(pk >> 16); }
        }
    }
}
__device__ __forceinline__ void transpose_phase(const Ctx& F, const bf16* ZT, bf16* Z) {
    bf16* tile = (bf16*)(F.lds + RING_OFF + F.wave * 8704);
    const int l = F.lane;
    v4u x[8];
    if (F.gw < 16 * 512) { const int d0 = (F.gw & 15) * 64, t0 = (F.gw >> 4) * 64;
#pragma unroll
        for (int i = 0; i < 8; ++i) x[i] = *(const v4u*)(ZT + (size_t)(d0 + i * 8 + (l >> 3)) * T + t0 + (l & 7) * 8); }
    for (int it = F.gw; it < 16 * 512; it += F.NGW) { const int d0 = (it & 15) * 64, t0 = (it >> 4) * 64;
#pragma unroll
        for (int i = 0; i < 8; ++i) { const int dr = i * 8 + (l >> 3), c = l & 7;
            v2u* p = (v2u*)(tile + dr * 68 + c * 8); v2u a; a.x = x[i].x; a.y = x[i].y; p[0] = a; a.x = x[i].z; a.y = x[i].w; p[1] = a; }
        const int itn = it + F.NGW;
        if (itn < 16 * 512) { const int dn = (itn & 15) * 64, tn = (itn >> 4) * 64;
#pragma unroll
            for (int i = 0; i < 8; ++i) x[i] = *(const v4u*)(ZT + (size_t)(dn + i * 8 + (l >> 3)) * T + tn + (l & 7) * 8); }
        LDS_WAIT();
#pragma unroll
        for (int i = 0; i < 8; ++i) { const int tr = i * 8 + (l >> 3), c = l & 7; unsigned short e[8];
#pragma unroll
            for (int k = 0; k < 8; ++k) e[k] = tile[(c * 8 + k) * 68 + tr];
            v4u o; o.x = e[0] | ((unsigned)e[1] << 16); o.y = e[2] | ((unsigned)e[3] << 16); o.z = e[4] | ((unsigned)e[5] << 16); o.w = e[6] | ((unsigned)e[7] << 16);
            *(v4u*)(Z + (size_t)(t0 + tr) * DM + d0 + c * 8) = o; }
        LDS_WAIT();
    }
}

constexpr int NPH = 22;
constexpr int seam_id(int k) { return k == 0 ? 0 : k == 1 ? 1 : k == 2 ? 2 : k == 4 ? 3 : k == 6 ? 4 : k == 7 ? 5 : k == 8 ? 6 : k == 10 ? 7 : k == 11 ? 8 : k == 12 ? 9 : k == 14 ? 10 : k == 15 ? 11 : k == 16 ? 12 : k == 17 ? 13 : k == 18 ? 14 : k == 20 ? 15 : -100; }
#ifdef PROBE_SEAM
__device__ __forceinline__ unsigned long long probe_now() { unsigned long long t; asm volatile("s_memrealtime %0\n\ts_waitcnt lgkmcnt(0)" : "=s"(t) :: "memory"); return t; }
#define SEAMHOOK(id) do { if ((id) == PROBE_SEAM) { const unsigned long long t1_ = probe_now(); while (probe_now() < t1_ + (t1_ - tlast_)) __builtin_amdgcn_s_sleep(4); } \
                          if ((id) + 1 == PROBE_SEAM) tlast_ = probe_now(); } while (0)
#define SEAMBAR(k) do { xcd_barrier(bar); SEAMHOOK(seam_id(k)); } while (0)
#else
#define SEAMHOOK(id) do { } while (0)
#define SEAMBAR(k) xcd_barrier(bar)
#endif
#define MOE_PHASES(L) do { \
        const int mb = 8 + 10 * L; \
        if (IN(mb)) { PH_ARGS; const float* mod = WSP(float, WS_MOD) + (size_t)L * 8 * 6144; gu32* cnt = (gu32*)(ws + WS_CTL) + CW_CNT + L * 24 * 64; \
            route_phase(F, WSP(bf16, WS_XR), in[6] + L * 1024, mod + 4 * 1024, mod + 3 * 1024, in[31] + L * 4096, in[32] + L * 4, in[33] + L * 16384, in[34] + L * 16, WSP(bf16, WS_XN2), WSP(int, WS_LIST), WSP(float, WS_WL), cnt); \
            if (L == 0) { __syncthreads();        \
                pg8::Gemm gmh{WSP(bf16, WS_W4S), WSP(bf16, WS_HDNS), 4096, 4096, 256}; pg8::StaticOrder Sh; Sh.init(4096, 4096, F.G, (int)blockIdx.x); pg8::EpiF32 Eh{WSP(float, WS_HT), 4096}; \
                REP(11) pg8::gemm_phase<pg8::EpiF32, pg8::StaticOrder, true, true>(ring, gmh, Sh, Eh, F.tid); } } \
        if (IN(mb) && IN(mb + 2)) SEAMBAR(mb); \
        if (IN(mb + 2)) { PH_ARGS; gu32* cnt = (gu32*)(ws + WS_CTL) + CW_CNT + L * 24 * 64; moe_table(F, cnt); \
              \
            pg8::Gemm gm{WSP(bf16, WS_XN2), (const bf16*)(ws + WS_WGU + (size_t)L * 16 * 512 * 1024), MS_ROWS, 8192, 512}; pg8::MoeOrder S{tinfo, F.G, F.vcu, 0, WSP(int, WS_LIST)}; pg8::EpiSwiGLU E{WSP(bf16, WS_HACT), WSP(float, WS_WL), tinfo}; \
            REP(10) pg8::gemm_phase_gather<pg8::EpiSwiGLU, pg8::MoeOrder, true, true, 5>(ring, gm, S, E, F.tid); } SEAM(mb + 2); \
        if (IN(mb + 3)) { PH_ARGS; gu32* cnt = (gu32*)(ws + WS_CTL) + CW_CNT + L * 24 * 64; moe_table(F, cnt); const float* mod = WSP(float, WS_MOD) + (size_t)L * 8 * 6144; \
            pg8::Gemm gm{WSP(bf16, WS_HACT), WSP(bf16, WS_WDN) + (size_t)L * 24 * 1024 * 512, MS_ROWS, 24 * 1024, 512}; pg8::MoeOrder S{tinfo, F.G, F.vcu, 1, WSP(int, WS_LIST)}; if (L == 0) { pg8::EpiMoeOut<bf16> E{WSP(bf16, WS_XR), WSP(bf16, WS_XR), mod + 5 * 1024, WSP(int, WS_LIST), tinfo, (PG8_LAS float*)((PG8_LAS unsigned char*)lds + EPIX_OFF)}; pg8::gemm_phase<pg8::EpiMoeOut<bf16>, pg8::MoeOrder, true, true>(ring, gm, S, E, F.tid); } \
            else { pg8::EpiMoeOut<float> E{WSP(bf16, WS_XR), out, mod + 5 * 1024, WSP(int, WS_LIST), tinfo, (PG8_LAS float*)((PG8_LAS unsigned char*)lds + EPIX_OFF)}; pg8::gemm_phase<pg8::EpiMoeOut<float>, pg8::MoeOrder, true, true>(ring, gm, S, E, F.tid); } \
            if (L == 0) { __syncthreads(); REP(13) filter_phase(F, WSP(float, WS_HT), in[29], WSP(c32, WS_KF)); }       \
            } \
    } while (0)
struct Args { const float* in[38]; float* out; unsigned char* ws; int ph_lo, ph_hi; };
static_assert(sizeof(Args) == 38 * 8 + 8 + 8 + 8, "Args layout (read back through the kernarg segment pointer)");
__global__ void __launch_bounds__(NTHR, 2) fwd_kernel(Args args) {
    extern __shared__ __attribute__((aligned(16))) unsigned char lds[];
#define MK_CTX(F, tx) Ctx F; F.lds = lds; F.tid = (tx); F.lane = F.tid & 63; F.wave = __builtin_amdgcn_readfirstlane(F.tid >> 6); \
    F.G = gridDim.x; { const int bx = blockIdx.x; F.vcu = (F.G % 8 == 0) ? (bx % 8) * (F.G / 8) + bx / 8 : bx; } F.gw = F.vcu * NWAVES + F.wave; F.NGW = F.G * NWAVES
    for (int u = threadIdx.x; u < (LDS_BYTES - LDSCTL_OFF) / 4; u += NTHR) ((LAS unsigned*)((LAS unsigned char*)lds + LDSCTL_OFF))[u] = 0u;
    __syncthreads();
    const int wave_s_ = __builtin_amdgcn_readfirstlane(threadIdx.x >> 6);
    const int lo = args.ph_lo, hi = args.ph_hi;
    const bool use_bar = (hi - lo) > 1;
    XcdBarrier bar; bar.bar = (unsigned*)(args.ws + WS_CTL) + CW_BAR; bar.x = 0; bar.st = nullptr; bar.w0 = 0;
    if (use_bar) bar = xcd_barrier_post((unsigned*)(args.ws + WS_CTL) + CW_BAR, (volatile LAS unsigned*)((LAS unsigned char*)lds + MISC_OFF) + 8);
    bar.w0 = (wave_s_ == 0) ? 1 : 0;
#ifndef PHMASK
#define PHMASK 0xFFFFFFFFu
#endif
#define IN(k) (((PHMASK >> ((k) >= 18 ? (k) - 10 : (k))) & 1u) && lo <= (k) && (k) < hi)
#ifndef REPMASK
#define REPMASK 0u
#endif
#define NREP(k) (((REPMASK >> (k)) & 1u) ? 2 : 1)
#define REP(k) for (int rep_ = 0; rep_ < NREP(k); ++rep_)
#define SEAM(k) do { if (IN(k) && IN((k) + 1)) SEAMBAR(k); } while (0)
#define PH_STR2(x) #x
#define PH_STR(x) PH_STR2(x)
#define PH_ARGS int opq_ = 0; asm volatile("; PHMARK line " PH_STR(__LINE__) : "+s"(opq_)); const In in{opq_}; unsigned char* const ws = karg_ws(opq_); float* const out = karg_out(opq_); (void)in; (void)ws; (void)out; int tx_; asm volatile("v_mbcnt_lo_u32_b32 %0, -1, 0\n\tv_mbcnt_hi_u32_b32 %0, -1, %0" : "=v"(tx_)); tx_ += wave_s_ * 64; MK_CTX(F, tx_)
#define WSP(type, off) ((type*)(ws + (off)))
    PG8_LAS unsigned char* ring = (PG8_LAS unsigned char*)lds + RING_OFF;
    const PG8_LAS int* tinfo = (const PG8_LAS int*)((PG8_LAS unsigned char*)lds + TINFO_OFF);

#ifdef PROBE_SEAM
    unsigned long long tlast_ = probe_now();
#endif
    if (IN(0)) { PH_ARGS; REP(0) p0_prologue(F, in, ws); } SEAM(0);

            if (IN(1)) { PH_ARGS; const float* mod = WSP(float, WS_MOD); REP(1) norm_mod_phase<float, true>(F, in[0], in[5], mod + 1024, mod, WSP(bf16, WS_XN)); } SEAM(1);
            if (IN(2)) { PH_ARGS; pg8::Gemm gm{WSP(bf16, WS_XN), WSP(bf16, WS_WD), T, 512, 512};   pg8::StaticOrder S; S.init(T, 512, F.G, (int)blockIdx.x);
                pg8::EpiLat E{WSP(unsigned char, WS_CQN), WSP(bf16, WS_CKVN), WSP(unsigned char, WS_KPE), in[8], in[9], in[13], WSP(float, WS_ROPE), (PG8_LAS float*)((PG8_LAS unsigned char*)lds + EPIX_OFF)};
                REP(2) pg8::gemm_phase<pg8::EpiLat, pg8::StaticOrder, true, true, 5>(ring, gm, S, E, F.tid); }
            if (IN(2) && IN(4)) SEAMBAR(2);
            if (IN(4)) { REP(4) {
                { PH_ARGS; pg8::Gemm gm{WSP(bf16, WS_CQN), WSP(bf16, WS_WUQ), T, 1536, 128};   pg8::StaticOrder S; S.init(T, 1536, F.G, (int)blockIdx.x); pg8::EpiBf16R E{WSP(bf16, WS_QRAW), 1536, nullptr};
                  pg8::gemm_phase<pg8::EpiBf16R, pg8::StaticOrder, true, true, 4>(ring, gm, S, E, F.tid); }
                { PH_ARGS; pg8::Gemm gm{WSP(bf16, WS_CKVN), WSP(bf16, WS_WUKV), T, 1024, 128};   pg8::StaticOrder S; S.init(T, 1024, F.G, (int)blockIdx.x);
                  pg8::EpiK8 E{WSP(unsigned char, WS_K8), in[13], (PG8_LAS float*)((PG8_LAS unsigned char*)lds + EPIX_OFF)};
                  pg8::gemm_phase<pg8::EpiK8, pg8::StaticOrder, true, true>(ring, gm, S, E, F.tid); }
                { PH_ARGS; pg8::Gemm gm{WSP(bf16, WS_WUKV) + 1024 * 128, WSP(bf16, WS_CKVN), 1024, T, 128}; pg8::StaticOrder S; S.init(1024, T, F.G, (int)blockIdx.x);
                  pg8::EpiF8T E{WSP(unsigned char, WS_VT8), T};
                  pg8::gemm_phase<pg8::EpiF8T, pg8::StaticOrder, true, true>(ring, gm, S, E, F.tid); } }
            } if (IN(4) && IN(6)) SEAMBAR(4);
            if (IN(6)) { PH_ARGS;
                const float* qg = in[12]; const float* kg = in[13];
                float gqn = 0.f, gkn = 0.f, gqp = 0.f, gkp = 0.f;
                for (int i = 0; i < 128; ++i) { gqn = fmaxf(gqn, fabsf(qg[i])); gkn = fmaxf(gkn, fabsf(kg[i])); }
                for (int i = 128; i < 192; ++i) { gqp = fmaxf(gqp, fabsf(qg[i])); gkp = fmaxf(gkp, fabsf(kg[i])); }
                const float smaxC = (128.f * gqn * gkn + 64.f * gqp * gkp) * (0.072168783648703220f * 1.4426950408889634f);
                unsigned redo_mask = 0u;
                if (smaxC < 60.f) for (int rep_ = 0; rep_ < NREP(6); ++rep_) { int i = 0;
                    for (int u = F.vcu; u < 1024; u += F.G, ++i) { const int b = u >> 7, h = (u >> 4) & 7, qb = u & 15;
                        if (att::attn_unit<false>(b, h, qb * 256, WSP(bf16, WS_QRAW), WSP(unsigned char, WS_VT8), WSP(unsigned char, WS_K8), WSP(unsigned char, WS_KPE), WSP(bf16, WS_O), WSP(float, WS_ROPE), qg, smaxC, (char*)lds + RING_OFF, F.tid)) redo_mask |= 1u << (i & 31); } }
                else redo_mask = 0xffffffffu;
                redo_mask = (unsigned)__builtin_amdgcn_readfirstlane((int)redo_mask);
                if (redo_mask) { int i = 0;
                    for (int u = F.vcu; u < 1024; u += F.G, ++i) { const int b = u >> 7, h = (u >> 4) & 7, qb = u & 15;
                        if ((redo_mask >> (i & 31)) & 1u) (void)att::attn_unit<true>(b, h, qb * 256, WSP(bf16, WS_QRAW), WSP(unsigned char, WS_VT8), WSP(unsigned char, WS_K8), WSP(unsigned char, WS_KPE), WSP(bf16, WS_O), WSP(float, WS_ROPE), qg, smaxC, (char*)lds + RING_OFF, F.tid); } }
            } SEAM(6);
            if (IN(7)) { PH_ARGS; pg8::Gemm gm{WSP(bf16, WS_O), WSP(bf16, WS_WO), T, 1024, 512};   pg8::StaticOrder S; S.init(T, 1024, F.G, (int)blockIdx.x); pg8::EpiResGate<float, bf16> E{in[0], WSP(bf16, WS_XR), WSP(float, WS_MOD) + 2048, 1024};
                REP(7) pg8::gemm_phase<pg8::EpiResGate<float, bf16>, pg8::StaticOrder, true, true, 10>(ring, gm, S, E, F.tid); } SEAM(7);
    MOE_PHASES(0); SEAM(11);
            if (IN(12)) { PH_ARGS; const float* mod = WSP(float, WS_MOD) + 8 * 6144; REP(12) norm_mod_phase(F, WSP(bf16, WS_XR), in[5] + 1024, mod + 1024, mod, (bf16*)out); }
            if (IN(12) && IN(14)) SEAMBAR(12);
            if (IN(14)) { PH_ARGS; pg8::Gemm gm{WSP(bf16, WS_WIN), (const bf16*)out, 3072, T, 1024}; pg8::StaticOrder S; S.init(3072, T, F.G, (int)blockIdx.x); pg8::EpiBf16R E{WSP(bf16, WS_UT), T, in[16]};
                REP(14) pg8::gemm_phase<pg8::EpiBf16R, pg8::StaticOrder, true, true>(ring, gm, S, E, F.tid); } SEAM(14);
            if (IN(15)) { PH_ARGS; for (int rep = 0; rep < NREP(15); ++rep) conv_phase(F, WSP(bf16, WS_UT), WSP(c32, WS_KF), in[17], in[18], (bf16*)out); } SEAM(15);
            if (IN(16)) { PH_ARGS; REP(16) transpose_phase(F, (const bf16*)out, WSP(bf16, WS_Z)); } SEAM(16);
            if (IN(17)) { PH_ARGS; pg8::Gemm gm{WSP(bf16, WS_Z), WSP(bf16, WS_WOUT), T, 1024, 1024}; pg8::StaticOrder S; S.init(T, 1024, F.G, (int)blockIdx.x); pg8::EpiResGate<bf16, bf16> E{WSP(bf16, WS_XR), WSP(bf16, WS_XR), WSP(float, WS_MOD) + 8 * 6144 + 2048, 1024};
                pg8::gemm_phase<pg8::EpiResGate<bf16, bf16>, pg8::StaticOrder, true, true>(ring, gm, S, E, F.tid); } SEAM(17);
    MOE_PHASES(1);
#ifdef PROBE_SEAM
    SEAMHOOK(16);
#endif
#undef IN
#undef SEAM
}

#ifndef ONE_LAUNCH
#define ONE_LAUNCH 1
#endif
extern "C" void kernel_launch(void* const* d_in, const int* in_sizes, int n_in, void* d_out, int out_size, void* d_ws, size_t ws_size, hipStream_t stream) {
    static int grid = 0;
    if (grid == 0) {
        if (n_in != 38 || in_sizes[0] != T * DM || out_size != T * DM || ws_size < WS_END) { fprintf(stderr, "kernel_launch: shape mismatch n_in %d in0 %d out %d ws %zu\n", n_in, n_in > 0 ? in_sizes[0] : -1, out_size, ws_size); grid = -1; return; }
        int dev = 0, cus = 0, per_cu = 0;
        if (hipGetDevice(&dev) != hipSuccess || hipDeviceGetAttribute(&cus, hipDeviceAttributeMultiprocessorCount, dev) != hipSuccess) { grid = -1; return; }
        if (hipFuncSetAttribute((const void*)fwd_kernel, hipFuncAttributeMaxDynamicSharedMemorySize, LDS_BYTES) != hipSuccess) { fprintf(stderr, "kernel_launch: hipFuncSetAttribute failed\n"); grid = -1; return; }
        if (hipOccupancyMaxActiveBlocksPerMultiprocessor(&per_cu, (const void*)fwd_kernel, NTHR, LDS_BYTES) != hipSuccess || per_cu < 1) { fprintf(stderr, "kernel_launch: occupancy query says %d\n", per_cu); }
        (void)hipGetLastError();
        grid = cus;
    }
    if (grid < 0) return;
    if (hipMemsetAsync((char*)d_ws + WS_CTL, 0, CTL_ZERO_BYTES, stream) != hipSuccess) return;
    Args a{};
    for (int i = 0; i < 38; ++i) a.in[i] = (const float*)d_in[i];
    a.out = (float*)d_out; a.ws = (unsigned char*)d_ws;
#if ONE_LAUNCH
    a.ph_lo = 0; a.ph_hi = NPH;
    hipLaunchKernelGGL(fwd_kernel, dim3(grid), dim3(NTHR), LDS_BYTES, stream, a);
#else
    for (int p = 0; p < NPH; ++p) { a.ph_lo = p; a.ph_hi = p + 1; hipLaunchKernelGGL(fwd_kernel, dim3(grid), dim3(NTHR), LDS_BYTES, stream, a); }
#endif
    const hipError_t le = hipPeekAtLastError();
    if (le != hipSuccess) fprintf(stderr, "kernel_launch: launch failed: %s\n", hipGetErrorName(le));
}
```

```cpp
#include <hip/hip_runtime.h>
#include <cstdio>
#include <cstdint>
namespace pg8 {
#define PG8_LAS __attribute__((address_space(3)))
typedef unsigned short bf16_t;
typedef short bf16x8 __attribute__((ext_vector_type(8)));
typedef float f32x4 __attribute__((ext_vector_type(4)));
typedef unsigned u32x4 __attribute__((ext_vector_type(4)));
typedef int v4i_t __attribute__((ext_vector_type(4)));
typedef int v8i_t __attribute__((ext_vector_type(8)));
constexpr int BM = 256, BK = 64, HALF = 128, HTB = HALF * BK * 2  , STAGE_BYTES = 8 * HTB, NXCD = 8, WGM = 8;

__host__ __device__ __forceinline__ int lds_byte(int r, int c) { const int st = (r >> 4) * 2 + (c >> 5), rr = r & 15, cc = c & 31, ob = rr * 64 + cc * 2; return st * 1024 + (ob ^ (((ob >> 9) & 1) << 5)); }
__host__ __device__ __forceinline__ void stage_rc(int b, int& R, int& C) { const int st = b / 1024, sb = b % 1024, swz = sb ^ (((sb >> 9) & 1) << 5); R = (st >> 1) * 16 + swz / 64; C = (st & 1) * 32 + (swz % 64) / 2; }
__host__ __device__ __forceinline__ int perm32(int rho) { const int n = rho >> 4, i = rho & 15; return 8 * (i >> 2) + 4 * n + (i & 3); }

struct Unit { int pm, pn; };
struct Gemm { const bf16_t* A; const bf16_t* Bt; int M, N, K; };

struct StaticOrder {
    int nM, nN, nwg, G, c;
    __host__ __device__ void init(int M, int N, int G_, int c_) { nM = M / BM; nN = N / BM; nwg = nM * nN; G = G_; c = c_; }
    __host__ __device__ bool next(int i, Unit& u) const {
        const long L = (long)i * G + c; if (L >= nwg) return false;
        int wgid = (int)L; { const int q = nwg / NXCD, r = nwg % NXCD, xcd = wgid % NXCD, off = wgid / NXCD; wgid = (xcd < r ? xcd * (q + 1) : r * (q + 1) + (xcd - r) * q) + off; }
        const int nig = WGM * nN, gid = wgid / nig, fm = gid * WGM, gsz = (nM - fm) < WGM ? (nM - fm) : WGM;
        u.pm = fm + ((wgid % nig) % gsz); u.pn = (wgid % nig) / gsz; return true;
    }
    __device__ __forceinline__ void a_ready(const Unit&) const {}
    __device__ __forceinline__ void done(const Unit&) const {}
};

__device__ __forceinline__ unsigned cvt_pk_bf16(float lo, float hi) { unsigned r; asm volatile("v_cvt_pk_bf16_f32 %0, %1, %2" : "=v"(r) : "v"(lo), "v"(hi)); return r; }
typedef float f32x2 __attribute__((ext_vector_type(2)));
typedef unsigned u32x2 __attribute__((ext_vector_type(2)));
struct EpiF32 {
    static constexpr bool PERM = false, AFTER_DRAIN = false;
    float* C; int ldc;
    __device__ __forceinline__ void operator()(const f32x4 (&acc)[2][2][4][2], const Unit& u, int wr, int wc, int fr, int fq) const {
        const int row0 = u.pm * BM + wr * 64 + fr, col0 = u.pn * BM + wc * 32 + 4 * fq;
#pragma unroll
        for (int ai = 0; ai < 2; ++ai)
#pragma unroll
            for (int m = 0; m < 4; ++m) { float* rowp = C + (size_t)(row0 + ai * HALF + m * 16) * ldc + col0;
#pragma unroll
                for (int bj = 0; bj < 2; ++bj)
#pragma unroll
                    for (int n = 0; n < 2; ++n) *(f32x4*)(rowp + bj * HALF + n * 16) = acc[ai][bj][m][n]; }
    }
};
struct EpiBf16R {
    static constexpr bool PERM = true, AFTER_DRAIN = false;
    bf16_t* O; int ldc; const float* rowbias;
    __device__ __forceinline__ void operator()(const f32x4 (&acc)[2][2][4][2], const Unit& u, int wr, int wc, int fr, int fq) const {
        const int row0 = u.pm * BM + wr * 64 + fr, col0 = u.pn * BM + wc * 32 + 8 * fq;
#pragma unroll
        for (int ai = 0; ai < 2; ++ai)
#pragma unroll
            for (int m = 0; m < 4; ++m) { const int row = row0 + ai * HALF + m * 16; bf16_t* rowp = O + (size_t)row * ldc + col0; const float rb = rowbias ? rowbias[row] : 0.f;
#pragma unroll
                for (int bj = 0; bj < 2; ++bj) { const f32x4 v0 = acc[ai][bj][m][0] + rb, v1 = acc[ai][bj][m][1] + rb;
                    u32x4 w; w.x = cvt_pk_bf16(v0[0], v0[1]); w.y = cvt_pk_bf16(v0[2], v0[3]); w.z = cvt_pk_bf16(v1[0], v1[1]); w.w = cvt_pk_bf16(v1[2], v1[3]);
                    *(u32x4*)(rowp + bj * HALF) = w; } }
    }
};
__device__ __forceinline__ f32x4 ld4(const float* p) { return *(const f32x4*)p; }
__device__ __forceinline__ f32x4 ld4(const bf16_t* p) { const u32x2 w = *(const u32x2*)p; f32x4 r; r[0] = __uint_as_float(w.x << 16); r[1] = __uint_as_float(w.x & 0xffff0000u); r[2] = __uint_as_float(w.y << 16); r[3] = __uint_as_float(w.y & 0xffff0000u); return r; }
__device__ __forceinline__ void st4(float* p, f32x4 v) { *(f32x4*)p = v; }
__device__ __forceinline__ void st4(bf16_t* p, f32x4 v) { u32x2 w; w.x = cvt_pk_bf16(v[0], v[1]); w.y = cvt_pk_bf16(v[2], v[3]); *(u32x2*)p = w; }
__device__ __forceinline__ f32x4 ldraw(const float* p) { return *(const f32x4*)p; }
__device__ __forceinline__ u32x2 ldraw(const bf16_t* p) { return *(const u32x2*)p; }
__device__ __forceinline__ f32x4 cvraw(f32x4 v) { return v; }
__device__ __forceinline__ f32x4 cvraw(u32x2 w) { f32x4 r; r[0] = __uint_as_float(w.x << 16); r[1] = __uint_as_float(w.x & 0xffff0000u); r[2] = __uint_as_float(w.y << 16); r[3] = __uint_as_float(w.y & 0xffff0000u); return r; }
template <class TB, class TO> struct EpiResGate {
    static constexpr bool PERM = false, AFTER_DRAIN = false;
    const TB* base; TO* out; const float* gate; int ldc;
    __device__ __forceinline__ void operator()(const f32x4 (&acc)[2][2][4][2], const Unit& u, int wr, int wc, int fr, int fq) const {
        const int row0 = u.pm * BM + wr * 64 + fr, col0 = u.pn * BM + wc * 32 + 4 * fq;
        const float* gp = gate + (size_t)(u.pm >> 4) * 6144 + col0;
        f32x4 gv[2][2];
#pragma unroll
        for (int bj = 0; bj < 2; ++bj)
#pragma unroll
            for (int n = 0; n < 2; ++n) gv[bj][n] = *(const f32x4*)(gp + bj * HALF + n * 16);
        constexpr int GB = sizeof(TB) == 2 ? 8 : 4;
        typedef decltype(ldraw(base)) raw_t;
#pragma unroll
        for (int g0 = 0; g0 < 8; g0 += GB) {
            raw_t bs[GB][2][2];
#pragma unroll
            for (int g = 0; g < GB; ++g) { const unsigned off = (unsigned)((row0 + ((g0 + g) >> 2) * HALF + ((g0 + g) & 3) * 16) * ldc + col0);
#pragma unroll
                for (int bj = 0; bj < 2; ++bj)
#pragma unroll
                    for (int n = 0; n < 2; ++n) bs[g][bj][n] = ldraw(base + off + bj * HALF + n * 16); }
#pragma unroll
            for (int g = 0; g < GB; ++g) { const int ai = (g0 + g) >> 2, m = (g0 + g) & 3; const unsigned off = (unsigned)((row0 + ai * HALF + m * 16) * ldc + col0);
#pragma unroll
                for (int bj = 0; bj < 2; ++bj)
#pragma unroll
                    for (int n = 0; n < 2; ++n) st4(out + off + bj * HALF + n * 16, cvraw(bs[g][bj][n]) + gv[bj][n] * acc[ai][bj][m][n]); }
            asm volatile("" ::: "memory"); }
    }
};
struct EpiLat {
    static constexpr bool PERM = false, AFTER_DRAIN = false;
    unsigned char* CQN  ; bf16_t* CKVN; unsigned char* KPE  ; const float* qag; const float* kvag; const float* kng; const float* rope; PG8_LAS float* P;
    __device__ __forceinline__ void operator()(const f32x4 (&acc)[2][2][4][2], const Unit& u, int wr, int wc, int, int) const {
        int ln = (int)__builtin_amdgcn_mbcnt_hi(~0u, __builtin_amdgcn_mbcnt_lo(~0u, 0u)); asm volatile("" : "+v"(ln)); const int fr = ln & 15, fq = ln >> 4;
        const int row0 = u.pm * BM + wr * 64 + fr;
#pragma unroll
        for (int ai = 0; ai < 2; ++ai)
#pragma unroll
            for (int m = 0; m < 4; ++m) { float s0 = 0.f, s1 = 0.f;
#pragma unroll
                for (int n = 0; n < 2; ++n) { const f32x4 a = acc[ai][0][m][n], b = acc[ai][1][m][n];
                    s0 += (a[0] * a[0] + a[1] * a[1]) + (a[2] * a[2] + a[3] * a[3]); s1 += (b[0] * b[0] + b[1] * b[1]) + (b[2] * b[2] + b[3] * b[3]); }
                s0 += __shfl_xor(s0, 16); s0 += __shfl_xor(s0, 32); s1 += __shfl_xor(s1, 16); s1 += __shfl_xor(s1, 32);
                if (fq == 0) { const int rl = ai * HALF + wr * 64 + m * 16 + fr; P[rl * 8 + wc] = s0; P[rl * 8 + 4 + wc] = s1; } }
        asm volatile("s_waitcnt lgkmcnt(0)" ::: "memory"); __builtin_amdgcn_s_barrier(); asm volatile("" ::: "memory");
        const int cl = wc * 32 + 4 * fq;
        if (u.pn == 0) {
            f32x4 g[2][2];
#pragma unroll
            for (int bj = 0; bj < 2; ++bj)
#pragma unroll
                for (int n = 0; n < 2; ++n) g[bj][n] = *(const f32x4*)(qag + bj * HALF + cl + 16 * n);
#pragma unroll
            for (int ai = 0; ai < 2; ++ai)
#pragma unroll
                for (int m = 0; m < 4; ++m) { const int rl = ai * HALF + wr * 64 + m * 16 + fr; const f32x4 pa = *(const PG8_LAS f32x4*)(P + rl * 8), pb = *(const PG8_LAS f32x4*)(P + rl * 8 + 4);
                    const float r = __builtin_amdgcn_rsqf((((pa[0] + pa[1]) + (pa[2] + pa[3])) + ((pb[0] + pb[1]) + (pb[2] + pb[3]))) * (1.f / 256.f) + 1e-6f);
                    unsigned char* rowp = CQN + (size_t)(row0 + ai * HALF + m * 16) * 256 + cl;
#pragma unroll
                    for (int bj = 0; bj < 2; ++bj)
#pragma unroll
                        for (int n = 0; n < 2; ++n) { const f32x4 v = acc[ai][bj][m][n] * r * g[bj][n]; int p = 0; p = __builtin_amdgcn_cvt_pk_fp8_f32(v[0], v[1], p, false); p = __builtin_amdgcn_cvt_pk_fp8_f32(v[2], v[3], p, true); *(int*)(rowp + bj * HALF + 16 * n) = p; } }
        } else {
            f32x4 gk[2], gp[2]; const int e0 = 16 * (wc & 1) + 4 * fq;
#pragma unroll
            for (int n = 0; n < 2; ++n) { gk[n] = *(const f32x4*)(kvag + cl + 16 * n); gp[n] = *(const f32x4*)(kng + 128 + e0 + 32 * n); }
#pragma unroll
            for (int ai = 0; ai < 2; ++ai)
#pragma unroll
                for (int m = 0; m < 4; ++m) { const int rl = ai * HALF + wr * 64 + m * 16 + fr; const f32x4 pa = *(const PG8_LAS f32x4*)(P + rl * 8), pb = *(const PG8_LAS f32x4*)(P + rl * 8 + 4);
                    const float rkv = __builtin_amdgcn_rsqf(((pa[0] + pa[1]) + (pa[2] + pa[3])) * (1.f / 128.f) + 1e-6f), rpe = __builtin_amdgcn_rsqf((pb[0] + pb[1]) * (1.f / 64.f) + 1e-6f);
                    const size_t row = (size_t)(row0 + ai * HALF + m * 16);
#pragma unroll
                    for (int n = 0; n < 2; ++n) { const f32x4 v = acc[ai][0][m][n] * rkv * gk[n]; u32x2 w; w.x = cvt_pk_bf16(v[0], v[1]); w.y = cvt_pk_bf16(v[2], v[3]); *(u32x2*)(CKVN + row * 128 + cl + 16 * n) = w; }
                    if (wc < 2) { const f32x4 x1 = acc[ai][1][m][0] * rpe * gp[0], x2 = acc[ai][1][m][1] * rpe * gp[1];
                        const f32x4 c0 = *(const f32x4*)(rope + row * 64 + e0 * 2), c1 = *(const f32x4*)(rope + row * 64 + e0 * 2 + 4);
                        const float cs[4] = {c0[0], c0[2], c1[0], c1[2]}, sn[4] = {c0[1], c0[3], c1[1], c1[3]};
                        float o1[4], o2[4];
#pragma unroll
                        for (int j = 0; j < 4; ++j) { o1[j] = x1[j] * cs[j] - x2[j] * sn[j]; o2[j] = x1[j] * sn[j] + x2[j] * cs[j]; }
                        int w1 = 0, w2 = 0; w1 = __builtin_amdgcn_cvt_pk_fp8_f32(o1[0], o1[1], w1, false); w1 = __builtin_amdgcn_cvt_pk_fp8_f32(o1[2], o1[3], w1, true); w2 = __builtin_amdgcn_cvt_pk_fp8_f32(o2[0], o2[1], w2, false); w2 = __builtin_amdgcn_cvt_pk_fp8_f32(o2[2], o2[3], w2, true);
                        *(int*)(KPE + row * 64 + e0) = w1; *(int*)(KPE + row * 64 + 32 + e0) = w2; }
                    asm volatile("" ::: "memory"); }
        }
        asm volatile("s_waitcnt lgkmcnt(0)" ::: "memory"); __builtin_amdgcn_s_barrier(); asm volatile("" ::: "memory");
    }
};
struct EpiK8 {
    static constexpr bool PERM = true, AFTER_DRAIN = false;
    unsigned char* K8; const float* kng; PG8_LAS float* P;
    __device__ __forceinline__ void operator()(const f32x4 (&acc)[2][2][4][2], const Unit& u, int wr, int wc, int, int) const {
        int ln = (int)__builtin_amdgcn_mbcnt_hi(~0u, __builtin_amdgcn_mbcnt_lo(~0u, 0u)); asm volatile("" : "+v"(ln)); const int fr = ln & 15, fq = ln >> 4;
#pragma unroll
        for (int ai = 0; ai < 2; ++ai)
#pragma unroll
            for (int m = 0; m < 4; ++m) {
#pragma unroll
                for (int bj = 0; bj < 2; ++bj) { const f32x4 a = acc[ai][bj][m][0], b = acc[ai][bj][m][1];
                    float s = (a[0] * a[0] + a[1] * a[1]) + (a[2] * a[2] + a[3] * a[3]) + (b[0] * b[0] + b[1] * b[1]) + (b[2] * b[2] + b[3] * b[3]);
                    s += __shfl_xor(s, 16); s += __shfl_xor(s, 32);
                    if (fq == 0) P[(ai * HALF + wr * 64 + m * 16 + fr) * 8 + bj * 4 + wc] = s; } }
        asm volatile("s_waitcnt lgkmcnt(0)" ::: "memory"); __builtin_amdgcn_s_barrier(); asm volatile("" ::: "memory");
        const f32x4 g0 = *(const f32x4*)(kng + wc * 32 + 8 * fq), g1 = *(const f32x4*)(kng + wc * 32 + 8 * fq + 4);
        const int row0 = u.pm * BM + wr * 64 + fr;
#pragma unroll
        for (int ai = 0; ai < 2; ++ai)
#pragma unroll
            for (int m = 0; m < 4; ++m) { const int rl = ai * HALF + wr * 64 + m * 16 + fr;
#pragma unroll
                for (int bj = 0; bj < 2; ++bj) { const f32x4 p4 = *(const PG8_LAS f32x4*)(P + rl * 8 + bj * 4);
                    const float r = __builtin_amdgcn_rsqf(((p4[0] + p4[1]) + (p4[2] + p4[3])) * (1.f / 128.f) + 1e-6f);
                    const f32x4 v0 = acc[ai][bj][m][0] * r * g0, v1 = acc[ai][bj][m][1] * r * g1;
                    int w0 = 0, w1 = 0; w0 = __builtin_amdgcn_cvt_pk_fp8_f32(v0[0], v0[1], w0, false); w0 = __builtin_amdgcn_cvt_pk_fp8_f32(v0[2], v0[3], w0, true); w1 = __builtin_amdgcn_cvt_pk_fp8_f32(v1[0], v1[1], w1, false); w1 = __builtin_amdgcn_cvt_pk_fp8_f32(v1[2], v1[3], w1, true);
                    u32x2 w; w.x = (unsigned)w0; w.y = (unsigned)w1; *(u32x2*)(K8 + ((size_t)(row0 + ai * HALF + m * 16) * 8 + 2 * u.pn + bj) * 128 + wc * 32 + 8 * fq) = w; } }
        asm volatile("s_waitcnt lgkmcnt(0)" ::: "memory"); __builtin_amdgcn_s_barrier(); asm volatile("" ::: "memory");
    }
};
struct EpiF8T {
    static constexpr bool PERM = true, AFTER_DRAIN = false;
    unsigned char* O; int ldc;
    __device__ __forceinline__ void operator()(const f32x4 (&acc)[2][2][4][2], const Unit& u, int wr, int wc, int fr, int fq) const {
        const int row0 = u.pm * BM + wr * 64 + fr, col0 = u.pn * BM + wc * 32 + 8 * fq;
#pragma unroll
        for (int ai = 0; ai < 2; ++ai)
#pragma unroll
            for (int m = 0; m < 4; ++m) { unsigned char* rowp = O + (size_t)(row0 + ai * HALF + m * 16) * ldc + col0;
#pragma unroll
                for (int bj = 0; bj < 2; ++bj) { const f32x4 v0 = acc[ai][bj][m][0], v1 = acc[ai][bj][m][1];
                    int w0 = 0, w1 = 0; w0 = __builtin_amdgcn_cvt_pk_fp8_f32(v0[0], v0[1], w0, false); w0 = __builtin_amdgcn_cvt_pk_fp8_f32(v0[2], v0[3], w0, true); w1 = __builtin_amdgcn_cvt_pk_fp8_f32(v1[0], v1[1], w1, false); w1 = __builtin_amdgcn_cvt_pk_fp8_f32(v1[2], v1[3], w1, true);
                    u32x2 w; w.x = (unsigned)w0; w.y = (unsigned)w1; *(u32x2*)(rowp + bj * HALF) = w; } }
    }
};
__device__ __forceinline__ void pair_of(int pi, int& i, int& j) { i = pi < 3 ? 0 : (pi < 5 ? 1 : 2); j = pi < 3 ? pi + 1 : (pi < 5 ? pi - 1 : 3); }
struct MoeOrder {
    const PG8_LAS int* tinfo; int G, c, mode; const int* list;
    __device__ __forceinline__ int tok(const Unit& u, int r) const { const int bk = tinfo[1 + u.pm], pos = u.pm * BM - tinfo[256 + bk] + r; return list[bk * 32768 + (pos < tinfo[288 + bk] ? pos : 0)]; }
    __device__ __forceinline__ bool next(int i, Unit& u) const {
        const long L = (long)i * G + c; const int nt = tinfo[0]; if (L >= 4L * nt) return false;
        const int mt = (int)(L >> 2), q = (int)(L & 3), bk = tinfo[1 + mt];
        u.pm = mt;
        if (mode == 0) { int ii, jj; pair_of(bk % 6, ii, jj); const int e = (bk / 6) * 4 + ((q >> 1) ? jj : ii); u.pn = e * 2 + (q & 1); }
        else u.pn = bk * 4 + q;
        return true;
    }
    __device__ __forceinline__ void a_ready(const Unit&) const {}
    __device__ __forceinline__ void done(const Unit&) const {}
};
struct EpiSwiGLU {
    static constexpr bool PERM = true, AFTER_DRAIN = false;
    unsigned char* H; const float* wl; const PG8_LAS int* tinfo;
    __device__ __forceinline__ void operator()(const f32x4 (&acc)[2][2][4][2], const Unit& u, int wr, int wc, int, int) const {
        int ln = (int)__builtin_amdgcn_mbcnt_hi(~0u, __builtin_amdgcn_mbcnt_lo(~0u, 0u)); asm volatile("" : "+v"(ln)); const int fr = ln & 15, fq = ln >> 4;
        const int bk = tinfo[1 + u.pm]; int ii, jj; pair_of(bk % 6, ii, jj);
        const int e = u.pn >> 1, hh = u.pn & 1, slot = (e == (bk / 6) * 4 + jj) ? 1 : 0;
        const int row0 = u.pm * BM + wr * 64 + fr, col0 = slot * 256 + hh * 128 + wc * 32 + 8 * fq;
        float w8[8];
#pragma unroll
        for (int g = 0; g < 8; ++g) { const int pos = row0 + (g >> 2) * HALF + (g & 3) * 16 - tinfo[256 + bk]; w8[g] = pos < tinfo[288 + bk] ? 8.f * wl[((size_t)bk * 32768 + pos) * 2 + slot] : 0.f; }
#pragma unroll
        for (int ai = 0; ai < 2; ++ai)
#pragma unroll
            for (int m = 0; m < 4; ++m) { const int row = row0 + ai * HALF + m * 16; const float w = w8[ai * 4 + m];
                float a[8];
#pragma unroll
                for (int n = 0; n < 2; ++n)
#pragma unroll
                    for (int j = 0; j < 4; ++j) { const float g = acc[ai][0][m][n][j], up = acc[ai][1][m][n][j];
                        const float sg = g * __builtin_amdgcn_rcpf(1.0f + __builtin_amdgcn_exp2f(-1.4426950408889634f * g)); a[n * 4 + j] = sg * up * w; }
                int o0 = 0, o1 = 0; o0 = __builtin_amdgcn_cvt_pk_fp8_f32(a[0], a[1], o0, false); o0 = __builtin_amdgcn_cvt_pk_fp8_f32(a[2], a[3], o0, true);
                o1 = __builtin_amdgcn_cvt_pk_fp8_f32(a[4], a[5], o1, false); o1 = __builtin_amdgcn_cvt_pk_fp8_f32(a[6], a[7], o1, true);
                u32x2 o; o.x = (unsigned)o0; o.y = (unsigned)o1; *(u32x2*)(H + (size_t)row * 512 + col0) = o; }
    }
};
template <class TO> struct EpiMoeOut {
    static constexpr bool PERM = false, AFTER_DRAIN = false;
    const bf16_t* xr; TO* out; const float* gate; const int* list; const PG8_LAS int* tinfo; PG8_LAS float* gl;
    __device__ __forceinline__ void operator()(const f32x4 (&acc)[2][2][4][2], const Unit& u, int wr, int wc, int, int) const {
        int ln = (int)__builtin_amdgcn_mbcnt_hi(~0u, __builtin_amdgcn_mbcnt_lo(~0u, 0u)); asm volatile("" : "+v"(ln)); const int fr = ln & 15, fq = ln >> 4;
        const int bk = tinfo[1 + u.pm], r_beg = tinfo[256 + bk], r_end = r_beg + tinfo[288 + bk];
        const int row0 = u.pm * BM + wr * 64 + fr, colu = (u.pn & 3) * BM, cl = wc * 32 + 4 * fq;
        int tk[8];
#pragma unroll
        for (int g = 0; g < 8; ++g) { const int row = row0 + (g >> 2) * HALF + (g & 3) * 16; tk[g] = row < r_end ? list[bk * 32768 + row - r_beg] : -1; }
        { const int t = (wr * 4 + wc) * 64 + fq * 16 + fr; const f32x4 gs = *(const f32x4*)(gate + (size_t)(t >> 6) * 6144 + colu + (t & 63) * 4);
          *(PG8_LAS f32x4*)(gl + (t >> 6) * 256 + (t & 63) * 4) = gs; }
        asm volatile("s_waitcnt lgkmcnt(0)" ::: "memory"); __builtin_amdgcn_s_barrier();
#pragma unroll
        for (int g0 = 0; g0 < 8; g0 += 4) {
            u32x2 bs[4][2][2];
#pragma unroll
            for (int g = 0; g < 4; ++g) { const unsigned xo = (unsigned)((tk[g0 + g] < 0 ? 0 : tk[g0 + g]) * 1024 + colu + cl);
#pragma unroll
                for (int bj = 0; bj < 2; ++bj)
#pragma unroll
                    for (int n = 0; n < 2; ++n) bs[g][bj][n] = ldraw(xr + xo + bj * HALF + n * 16); }
#pragma unroll
            for (int g = 0; g < 4; ++g) { const int ai = (g0 + g) >> 2, m = (g0 + g) & 3, tkg = tk[g0 + g];
                if (tkg >= 0) { TO* op = out + (size_t)tkg * 1024 + colu + cl; const PG8_LAS float* gp = gl + (tkg >> 12) * 256 + cl;
#pragma unroll
                    for (int bj = 0; bj < 2; ++bj)
#pragma unroll
                        for (int n = 0; n < 2; ++n) { const f32x4 gv = *(const PG8_LAS f32x4*)(gp + bj * HALF + n * 16); st4(op + bj * HALF + n * 16, cvraw(bs[g][bj][n]) + gv * acc[ai][bj][m][n]); } } }
            asm volatile("" ::: "memory"); }
    }
};
template <class Epi, class Sched, bool ALIGN_EPI = false, bool SP2 = false, int F8 = -1>
__device__ __forceinline__ void gemm_phase(PG8_LAS unsigned char* lds, const Gemm g, const Sched& S, const Epi& E, const int tid_in) {
    int tid = tid_in; asm volatile("" : "+v"(tid));
    const int wid = __builtin_amdgcn_readfirstlane(tid >> 6), lane = tid & 63, wr = wid >> 2, wc = wid & 3, fr = lane & 15, fq = lane >> 4;
    int K = g.K; asm volatile("" : "+s"(K)); const int nt = K / BK;
    unsigned voffA[2], voffB[2];
#pragma unroll
    for (int i = 0; i < 2; ++i) { int R, C; stage_rc(tid * 16 + i * 8192, R, C); const int Rb = Epi::PERM ? ((R & ~31) + perm32(R & 31)) : R;
        voffA[i] = (unsigned)(R * K + C) * 2u; voffB[i] = (unsigned)(Rb * K + C) * 2u; }
    const size_t kstep = (size_t)(BK * 2);
    const size_t hstep = (size_t)HALF * K * 2;
    const size_t tstep = 2 * hstep;
    const unsigned ldsw = (unsigned)wid * 1024u;
    const int aoff = lds_byte(wr * 64 + fr, fq * 8), boff = lds_byte(wc * 32 + fr, fq * 8);
#define PG8_SA(b, h) (((b) * 2 + (h)) * HTB)
#define PG8_SB(b, h) ((4 + (b) * 2 + (h)) * HTB)
#define PG8_STAGE(bufoff, gbase, voff) do { _Pragma("unroll") for (int _i = 0; _i < 2; ++_i) { unsigned vo_ = (voff)[_i]; asm volatile("" : "+v"(vo_));   \
        __builtin_amdgcn_global_load_lds((const unsigned*)((const char*)(gbase) + vo_), (PG8_LAS unsigned*)(lds + (bufoff) + ldsw + _i * 8192), 16, 0, 0); } } while (0)
#define PG8_LDA(dst, b, h) do { _Pragma("unroll") for (int m = 0; m < 4; ++m) { const bf16x8 x0_ = *(const PG8_LAS bf16x8*)(lds + PG8_SA(b, h) + aoff + m * 2048), x1_ = *(const PG8_LAS bf16x8*)(lds + PG8_SA(b, h) + aoff + m * 2048 + 1024); \
        if constexpr (F8 >= 0) dst##8[m] = PG8_CAT(x0_, x1_); else { dst[m][0] = x0_; dst[m][1] = x1_; } } } while (0)
#define PG8_LDB(dst, b, h) do { _Pragma("unroll") for (int n = 0; n < 2; ++n) { const bf16x8 x0_ = *(const PG8_LAS bf16x8*)(lds + PG8_SB(b, h) + boff + n * 2048), x1_ = *(const PG8_LAS bf16x8*)(lds + PG8_SB(b, h) + boff + n * 2048 + 1024); \
        if constexpr (F8 >= 0) dst##8[n] = PG8_CAT(x0_, x1_); else { dst[n][0] = x0_; dst[n][1] = x1_; } } } while (0)
#define PG8_CAT(x0, x1) ({ const v4i_t lo_ = __builtin_bit_cast(v4i_t, x0), hi_ = __builtin_bit_cast(v4i_t, x1); (v8i_t){lo_[0], lo_[1], lo_[2], lo_[3], hi_[0], hi_[1], hi_[2], hi_[3]}; })
#define PG8_MMA(ai, bj, At, Bt) do { __builtin_amdgcn_s_setprio(1); _Pragma("unroll") for (int m = 0; m < 4; ++m) _Pragma("unroll") for (int n = 0; n < 2; ++n) { \
        if constexpr (F8 >= 0) acc[ai][bj][m][n] = __builtin_amdgcn_mfma_scale_f32_16x16x128_f8f6f4(Bt##8[n], At##8[m], acc[ai][bj][m][n], 0, 0, 0, 0x7f7f7f7f, 0, (127 - F8) * 0x01010101); \
        else { _Pragma("unroll") for (int k = 0; k < 2; ++k) acc[ai][bj][m][n] = __builtin_amdgcn_mfma_f32_16x16x32_bf16(Bt[n][k], At[m][k], acc[ai][bj][m][n], 0, 0, 0); } } \
        __builtin_amdgcn_s_setprio(0); } while (0)
#define PG8_WAIT_V(n) asm volatile("s_waitcnt vmcnt(" #n ")" ::: "memory")
#define PG8_WAIT_L(n) asm volatile("s_waitcnt lgkmcnt(" #n ")" ::: "memory")
#define PG8_BAR __builtin_amdgcn_s_barrier()
#define PG8_SCHED __builtin_amdgcn_sched_barrier(0)
    Unit cur, nxt; int ui = 0;
    if (!S.next(0, cur)) return;
    f32x4 acc[2][2][4][2];
#pragma unroll
    for (int a = 0; a < 2; ++a)
#pragma unroll
        for (int b = 0; b < 2; ++b)
#pragma unroll
            for (int m = 0; m < 4; ++m)
#pragma unroll
                for (int n = 0; n < 2; ++n) acc[a][b][m][n] = (f32x4){0.f, 0.f, 0.f, 0.f};
    bf16x8 At[4][2], B0[2][2], B1[2][2]; v8i_t At8[4], B08[2], B18[2];
    const char* cA = (const char*)g.A + (size_t)cur.pm * tstep; const char* cB = (const char*)g.Bt + (size_t)cur.pn * tstep;
    S.a_ready(cur);
    if constexpr (SP2) {
        PG8_STAGE(PG8_SB(0, 0), cB, voffB); PG8_STAGE(PG8_SB(0, 1), cB + hstep, voffB); PG8_STAGE(PG8_SA(0, 0), cA, voffA); PG8_STAGE(PG8_SA(0, 1), cA + hstep, voffA);
        if (wr == 1) PG8_BAR;
        PG8_WAIT_V(2); PG8_BAR;
        PG8_STAGE(PG8_SB(1, 0), cB + kstep, voffB); PG8_STAGE(PG8_SA(1, 0), cA + kstep, voffA); PG8_STAGE(PG8_SB(1, 1), cB + hstep + kstep, voffB);
        PG8_WAIT_V(6); PG8_BAR;
    } else {
        PG8_STAGE(PG8_SB(0, 0), cB, voffB); PG8_STAGE(PG8_SA(0, 0), cA, voffA); PG8_STAGE(PG8_SB(0, 1), cB + hstep, voffB); PG8_STAGE(PG8_SA(0, 1), cA + hstep, voffA);
        if (wr == 1) PG8_BAR;
        PG8_WAIT_V(4); PG8_BAR;
        PG8_STAGE(PG8_SB(1, 0), cB + kstep, voffB); PG8_STAGE(PG8_SA(1, 0), cA + kstep, voffA); PG8_STAGE(PG8_SB(1, 1), cB + hstep + kstep, voffB);
        PG8_WAIT_V(6); PG8_BAR;
    }
    for (;;) {
        const bool has_next = S.next(ui + 1, nxt);
        const char* nA = has_next ? (const char*)g.A + (size_t)nxt.pm * tstep : cA; const char* nB = has_next ? (const char*)g.Bt + (size_t)nxt.pn * tstep : cB;
        for (int t = 0; t < nt; t += 2) {
            const bool last = (t == nt - 2);
            const char* a1 = cA + (size_t)(t + 1) * kstep;
            const char* a2 = last ? nA : cA + (size_t)(t + 2) * kstep; const char* b2 = last ? nB : cB + (size_t)(t + 2) * kstep;
            const char* a3 = a2 + kstep; const char* b3 = b2 + kstep;
            if (last && has_next) S.a_ready(nxt);
            if constexpr (SP2) {
            PG8_LDB(B0, 0, 0); PG8_LDB(B1, 0, 1); PG8_SCHED; PG8_LDA(At, 0, 0); PG8_STAGE(PG8_SA(1, 1), a1 + hstep, voffA);
            PG8_WAIT_V(8); PG8_WAIT_L(0); PG8_BAR; PG8_MMA(0, 0, At, B0); PG8_MMA(0, 1, At, B1); PG8_BAR; PG8_SCHED;
            PG8_LDA(At, 0, 1); PG8_STAGE(PG8_SB(0, 0), b2, voffB); PG8_STAGE(PG8_SB(0, 1), b2 + hstep, voffB); PG8_STAGE(PG8_SA(0, 0), a2, voffA);
            PG8_WAIT_V(8); PG8_WAIT_L(0); PG8_BAR; PG8_MMA(1, 0, At, B0); PG8_MMA(1, 1, At, B1); PG8_BAR; PG8_SCHED;
            PG8_LDB(B0, 1, 0); PG8_LDB(B1, 1, 1); PG8_SCHED; PG8_LDA(At, 1, 0); PG8_STAGE(PG8_SA(0, 1), a2 + hstep, voffA);
            PG8_WAIT_V(8); PG8_WAIT_L(0); PG8_BAR; PG8_MMA(0, 0, At, B0); PG8_MMA(0, 1, At, B1); PG8_BAR; PG8_SCHED;
            PG8_LDA(At, 1, 1); PG8_STAGE(PG8_SB(1, 0), b3, voffB); PG8_STAGE(PG8_SB(1, 1), b3 + hstep, voffB); PG8_STAGE(PG8_SA(1, 0), a3, voffA);
            PG8_WAIT_V(8); PG8_WAIT_L(0); PG8_BAR; PG8_MMA(1, 0, At, B0); PG8_MMA(1, 1, At, B1); PG8_BAR; PG8_SCHED;
            } else {
            PG8_LDB(B0, 0, 0); PG8_SCHED; PG8_LDA(At, 0, 0); PG8_STAGE(PG8_SA(1, 1), a1 + hstep, voffA);
            PG8_WAIT_L(8); PG8_BAR; PG8_WAIT_L(0); PG8_MMA(0, 0, At, B0); PG8_BAR; PG8_SCHED;
            PG8_LDB(B1, 0, 1); PG8_STAGE(PG8_SB(0, 0), b2, voffB);
            PG8_BAR; PG8_WAIT_L(0); PG8_MMA(0, 1, At, B1); PG8_BAR;
            PG8_LDA(At, 0, 1); PG8_STAGE(PG8_SA(0, 0), a2, voffA);
            PG8_BAR; PG8_WAIT_L(0); PG8_MMA(1, 0, At, B0); PG8_BAR; PG8_SCHED;
            PG8_STAGE(PG8_SB(0, 1), b2 + hstep, voffB);
            PG8_WAIT_V(6); PG8_BAR; PG8_MMA(1, 1, At, B1); PG8_BAR;
            PG8_LDB(B0, 1, 0); PG8_SCHED; PG8_LDA(At, 1, 0); PG8_STAGE(PG8_SA(0, 1), a2 + hstep, voffA);
            PG8_WAIT_L(8); PG8_BAR; PG8_WAIT_L(0); PG8_MMA(0, 0, At, B0); PG8_BAR; PG8_SCHED;
            PG8_LDB(B1, 1, 1); PG8_STAGE(PG8_SB(1, 0), b3, voffB);
            PG8_BAR; PG8_WAIT_L(0); PG8_MMA(0, 1, At, B1); PG8_BAR;
            PG8_LDA(At, 1, 1); PG8_STAGE(PG8_SA(1, 0), a3, voffA);
            PG8_BAR; PG8_WAIT_L(0); PG8_MMA(1, 0, At, B0); PG8_BAR; PG8_SCHED;
            PG8_STAGE(PG8_SB(1, 1), b3 + hstep, voffB);
            PG8_WAIT_V(6); PG8_BAR; PG8_MMA(1, 1, At, B1); PG8_BAR;
            }
        }
        if constexpr (ALIGN_EPI) { if (wr == 0) PG8_BAR; }
        if constexpr (!Epi::AFTER_DRAIN) { E(acc, cur, wr, wc, fr, fq); S.done(cur); }
        if (!has_next) break;
#pragma unroll
        for (int a = 0; a < 2; ++a)
#pragma unroll
            for (int b = 0; b < 2; ++b)
#pragma unroll
                for (int m = 0; m < 4; ++m)
#pragma unroll
                    for (int n = 0; n < 2; ++n) acc[a][b][m][n] = (f32x4){0.f, 0.f, 0.f, 0.f};
        cur = nxt; cA = nA; cB = nB; ++ui;
        if constexpr (ALIGN_EPI) { if (wr == 1) PG8_BAR; }
    }
    PG8_WAIT_V(0);
    if constexpr (!ALIGN_EPI) { if (wr == 0) PG8_BAR; }
    PG8_BAR;
    if constexpr (Epi::AFTER_DRAIN) { E.fused(acc, cur, wr, wc, fr, fq, lds, wid, lane); S.done(cur); }
#undef PG8_SA
#undef PG8_SB
#undef PG8_STAGE
#undef PG8_LDA
#undef PG8_LDB
#undef PG8_MMA
#undef PG8_WAIT_V
#undef PG8_WAIT_L
#undef PG8_BAR
#undef PG8_SCHED
}
template <class Epi, class Sched, bool ALIGN_EPI = true, bool SP2 = true, int F8 = -1>
__device__ __forceinline__ void gemm_phase_gather(PG8_LAS unsigned char* lds, const Gemm g, const Sched& S, const Epi& E, const int tid_in) {
    int tid = tid_in; asm volatile("" : "+v"(tid));
    static_assert(SP2, "gather form: SP2 loop only");
    const int wid = __builtin_amdgcn_readfirstlane(tid >> 6), lane = tid & 63, wr = wid >> 2, wc = wid & 3, fr = lane & 15, fq = lane >> 4;
    int K = g.K; asm volatile("" : "+s"(K)); const int nt = K / BK;
    unsigned voffA[2], voffB[2];
#pragma unroll
    for (int i = 0; i < 2; ++i) { int R, C; stage_rc(tid * 16 + i * 8192, R, C); const int Rb = Epi::PERM ? ((R & ~31) + perm32(R & 31)) : R;
        voffA[i] = (unsigned)(R * K + C) * 2u; voffB[i] = (unsigned)(Rb * K + C) * 2u; }
    int gR, gC; stage_rc(tid * 16, gR, gC);
    unsigned vG[2][2], vN[2][2];
    const size_t kstep = (size_t)(BK * 2);
    const size_t hstep = (size_t)HALF * K * 2;
    const size_t tstep = 2 * hstep;
    const unsigned ldsw = (unsigned)wid * 1024u;
    const int aoff = lds_byte(wr * 64 + fr, fq * 8), boff = lds_byte(wc * 32 + fr, fq * 8);
#define PG8_SA(b, h) (((b) * 2 + (h)) * HTB)
#define PG8_SB(b, h) ((4 + (b) * 2 + (h)) * HTB)
#define PG8_STAGE(bufoff, gbase, voff) do { _Pragma("unroll") for (int _i = 0; _i < 2; ++_i) { unsigned vo_ = (voff)[_i]; asm volatile("" : "+v"(vo_));   \
        __builtin_amdgcn_global_load_lds((const unsigned*)((const char*)(gbase) + vo_), (PG8_LAS unsigned*)(lds + (bufoff) + ldsw + _i * 8192), 16, 0, 0); } } while (0)
#define PG8_LDA(dst, b, h) do { _Pragma("unroll") for (int m = 0; m < 4; ++m) { const bf16x8 x0_ = *(const PG8_LAS bf16x8*)(lds + PG8_SA(b, h) + aoff + m * 2048), x1_ = *(const PG8_LAS bf16x8*)(lds + PG8_SA(b, h) + aoff + m * 2048 + 1024); \
        if constexpr (F8 >= 0) dst##8[m] = PG8_CAT(x0_, x1_); else { dst[m][0] = x0_; dst[m][1] = x1_; } } } while (0)
#define PG8_LDB(dst, b, h) do { _Pragma("unroll") for (int n = 0; n < 2; ++n) { const bf16x8 x0_ = *(const PG8_LAS bf16x8*)(lds + PG8_SB(b, h) + boff + n * 2048), x1_ = *(const PG8_LAS bf16x8*)(lds + PG8_SB(b, h) + boff + n * 2048 + 1024); \
        if constexpr (F8 >= 0) dst##8[n] = PG8_CAT(x0_, x1_); else { dst[n][0] = x0_; dst[n][1] = x1_; } } } while (0)
#define PG8_CAT(x0, x1) ({ const v4i_t lo_ = __builtin_bit_cast(v4i_t, x0), hi_ = __builtin_bit_cast(v4i_t, x1); (v8i_t){lo_[0], lo_[1], lo_[2], lo_[3], hi_[0], hi_[1], hi_[2], hi_[3]}; })
#define PG8_MMA(ai, bj, At, Bt) do { __builtin_amdgcn_s_setprio(1); _Pragma("unroll") for (int m = 0; m < 4; ++m) _Pragma("unroll") for (int n = 0; n < 2; ++n) { \
        if constexpr (F8 >= 0) acc[ai][bj][m][n] = __builtin_amdgcn_mfma_scale_f32_16x16x128_f8f6f4(Bt##8[n], At##8[m], acc[ai][bj][m][n], 0, 0, 0, 0x7f7f7f7f, 0, (127 - F8) * 0x01010101); \
        else { _Pragma("unroll") for (int k = 0; k < 2; ++k) acc[ai][bj][m][n] = __builtin_amdgcn_mfma_f32_16x16x32_bf16(Bt[n][k], At[m][k], acc[ai][bj][m][n], 0, 0, 0); } } \
        __builtin_amdgcn_s_setprio(0); } while (0)
#define PG8_WAIT_V(n) asm volatile("s_waitcnt vmcnt(" #n ")" ::: "memory")
#define PG8_WAIT_L(n) asm volatile("s_waitcnt lgkmcnt(" #n ")" ::: "memory")
#define PG8_BAR __builtin_amdgcn_s_barrier()
#define PG8_SCHED __builtin_amdgcn_sched_barrier(0)
    Unit cur, nxt; int ui = 0;
    if (!S.next(0, cur)) return;
    f32x4 acc[2][2][4][2];
#pragma unroll
    for (int a = 0; a < 2; ++a)
#pragma unroll
        for (int b = 0; b < 2; ++b)
#pragma unroll
            for (int m = 0; m < 4; ++m)
#pragma unroll
                for (int n = 0; n < 2; ++n) acc[a][b][m][n] = (f32x4){0.f, 0.f, 0.f, 0.f};
    bf16x8 At[4][2], B0[2][2], B1[2][2]; v8i_t At8[4], B08[2], B18[2];
    const char* cA = (const char*)g.A; const char* cB = (const char*)g.Bt + (size_t)cur.pn * tstep;
    S.a_ready(cur);
#pragma unroll
    for (int h = 0; h < 2; ++h)
#pragma unroll
        for (int i = 0; i < 2; ++i) vG[h][i] = (unsigned)S.tok(cur, h * HALF + gR + 64 * i) * (unsigned)(K * 2) + (unsigned)(gC * 2);
    if constexpr (SP2) {
        PG8_STAGE(PG8_SB(0, 0), cB, voffB); PG8_STAGE(PG8_SB(0, 1), cB + hstep, voffB); PG8_STAGE(PG8_SA(0, 0), cA, vG[0]); PG8_STAGE(PG8_SA(0, 1), cA, vG[1]);
        if (wr == 1) PG8_BAR;
        PG8_WAIT_V(2); PG8_BAR;
        PG8_STAGE(PG8_SB(1, 0), cB + kstep, voffB); PG8_STAGE(PG8_SA(1, 0), cA + kstep, vG[0]); PG8_STAGE(PG8_SB(1, 1), cB + hstep + kstep, voffB);
        PG8_WAIT_V(6); PG8_BAR;
    } else {
        PG8_STAGE(PG8_SB(0, 0), cB, voffB); PG8_STAGE(PG8_SA(0, 0), cA, voffA); PG8_STAGE(PG8_SB(0, 1), cB + hstep, voffB); PG8_STAGE(PG8_SA(0, 1), cA + hstep, voffA);
        if (wr == 1) PG8_BAR;
        PG8_WAIT_V(4); PG8_BAR;
        PG8_STAGE(PG8_SB(1, 0), cB + kstep, voffB); PG8_STAGE(PG8_SA(1, 0), cA + kstep, voffA); PG8_STAGE(PG8_SB(1, 1), cB + hstep + kstep, voffB);
        PG8_WAIT_V(6); PG8_BAR;
    }
    for (;;) {
        const bool has_next = S.next(ui + 1, nxt);
        const char* nA = cA; const char* nB = has_next ? (const char*)g.Bt + (size_t)nxt.pn * tstep : cB;
        for (int t = 0; t < nt; t += 2) {
            const bool last = (t == nt - 2);
            const char* a1 = cA + (size_t)(t + 1) * kstep;
            const char* a2 = last ? nA : cA + (size_t)(t + 2) * kstep; const char* b2 = last ? nB : cB + (size_t)(t + 2) * kstep;
            const char* a3 = a2 + kstep; const char* b3 = b2 + kstep;
            if (last && has_next) { S.a_ready(nxt);
#pragma unroll
                for (int h = 0; h < 2; ++h)
#pragma unroll
                    for (int i = 0; i < 2; ++i) vN[h][i] = (unsigned)S.tok(nxt, h * HALF + gR + 64 * i) * (unsigned)(K * 2) + (unsigned)(gC * 2); }
            if constexpr (SP2) {
            PG8_LDB(B0, 0, 0); PG8_LDB(B1, 0, 1); PG8_SCHED; PG8_LDA(At, 0, 0); PG8_STAGE(PG8_SA(1, 1), a1, vG[1]);
            if (last && has_next) { vG[0][0] = vN[0][0]; vG[0][1] = vN[0][1]; vG[1][0] = vN[1][0]; vG[1][1] = vN[1][1]; }
            PG8_WAIT_V(8); PG8_WAIT_L(0); PG8_BAR; PG8_MMA(0, 0, At, B0); PG8_MMA(0, 1, At, B1); PG8_BAR; PG8_SCHED;
            PG8_LDA(At, 0, 1); PG8_STAGE(PG8_SB(0, 0), b2, voffB); PG8_STAGE(PG8_SB(0, 1), b2 + hstep, voffB); PG8_STAGE(PG8_SA(0, 0), a2, vG[0]);
            PG8_WAIT_V(8); PG8_WAIT_L(0); PG8_BAR; PG8_MMA(1, 0, At, B0); PG8_MMA(1, 1, At, B1); PG8_BAR; PG8_SCHED;
            PG8_LDB(B0, 1, 0); PG8_LDB(B1, 1, 1); PG8_SCHED; PG8_LDA(At, 1, 0); PG8_STAGE(PG8_SA(0, 1), a2, vG[1]);
            PG8_WAIT_V(8); PG8_WAIT_L(0); PG8_BAR; PG8_MMA(0, 0, At, B0); PG8_MMA(0, 1, At, B1); PG8_BAR; PG8_SCHED;
            PG8_LDA(At, 1, 1); PG8_STAGE(PG8_SB(1, 0), b3, voffB); PG8_STAGE(PG8_SB(1, 1), b3 + hstep, voffB); PG8_STAGE(PG8_SA(1, 0), a3, vG[0]);
            PG8_WAIT_V(8); PG8_WAIT_L(0); PG8_BAR; PG8_MMA(1, 0, At, B0); PG8_MMA(1, 1, At, B1); PG8_BAR; PG8_SCHED;
            } else {
            PG8_LDB(B0, 0, 0); PG8_SCHED; PG8_LDA(At, 0, 0); PG8_STAGE(PG8_SA(1, 1), a1 + hstep, voffA);
            PG8_WAIT_L(8); PG8_BAR; PG8_WAIT_L(0); PG8_MMA(0, 0, At, B0); PG8_BAR; PG8_SCHED;
            PG8_LDB(B1, 0, 1); PG8_STAGE(PG8_SB(0, 0), b2, voffB);
            PG8_BAR; PG8_WAIT_L(0); PG8_MMA(0, 1, At, B1); PG8_BAR;
            PG8_LDA(At, 0, 1); PG8_STAGE(PG8_SA(0, 0), a2, voffA);
            PG8_BAR; PG8_WAIT_L(0); PG8_MMA(1, 0, At, B0); PG8_BAR; PG8_SCHED;
            PG8_STAGE(PG8_SB(0, 1), b2 + hstep, voffB);
            PG8_WAIT_V(6); PG8_BAR; PG8_MMA(1, 1, At, B1); PG8_BAR;
            PG8_LDB(B0, 1, 0); PG8_SCHED; PG8_LDA(At, 1, 0); PG8_STAGE(PG8_SA(0, 1), a2 + hstep, voffA);
            PG8_WAIT_L(8); PG8_BAR; PG8_WAIT_L(0); PG8_MMA(0, 0, At, B0); PG8_BAR; PG8_SCHED;
            PG8_LDB(B1, 1, 1); PG8_STAGE(PG8_SB(1, 0), b3, voffB);
            PG8_BAR; PG8_WAIT_L(0); PG8_MMA(0, 1, At, B1); PG8_BAR;
            PG8_LDA(At, 1, 1); PG8_STAGE(PG8_SA(1, 0), a3, voffA);
            PG8_BAR; PG8_WAIT_L(0); PG8_MMA(1, 0, At, B0); PG8_BAR; PG8_SCHED;
            PG8_STAGE(PG8_SB(1, 1), b3 + hstep, voffB);
            PG8_WAIT_V(6); PG8_BAR; PG8_MMA(1, 1, At, B1); PG8_BAR;
            }
        }
        if constexpr (ALIGN_EPI) { if (wr == 0) PG8_BAR; }
        if constexpr (!Epi::AFTER_DRAIN) { E(acc, cur, wr, wc, fr, fq); S.done(cur); }
        if (!has_next) break;
#pragma unroll
        for (int a = 0; a < 2; ++a)
#pragma unroll
            for (int b = 0; b < 2; ++b)
#pragma unroll
                for (int m = 0; m < 4; ++m)
#pragma unroll
                    for (int n = 0; n < 2; ++n) acc[a][b][m][n] = (f32x4){0.f, 0.f, 0.f, 0.f};
        cur = nxt; cA = nA; cB = nB; ++ui;
        if constexpr (ALIGN_EPI) { if (wr == 1) PG8_BAR; }
    }
    PG8_WAIT_V(0);
    if constexpr (!ALIGN_EPI) { if (wr == 0) PG8_BAR; }
    PG8_BAR;
    if constexpr (Epi::AFTER_DRAIN) { E.fused(acc, cur, wr, wc, fr, fq, lds, wid, lane); S.done(cur); }
#undef PG8_SA
#undef PG8_SB
#undef PG8_STAGE
#undef PG8_LDA
#undef PG8_LDB
#undef PG8_MMA
#undef PG8_WAIT_V
#undef PG8_WAIT_L
#undef PG8_BAR
#undef PG8_SCHED
}
}
namespace att {
typedef unsigned short bf16;
using bf16x8 = __attribute__((ext_vector_type(8))) short;
using s16x4  = __attribute__((ext_vector_type(4))) short;
using f32x16 = __attribute__((ext_vector_type(16))) float;
using u32x4  = __attribute__((ext_vector_type(4))) unsigned;
using f32x4_t = __attribute__((ext_vector_type(4))) float;
constexpr int NW = 8, QBLK = 32, KVBLK = 64, SEQ = 4096;
constexpr int LDQ = 1536, LDKV = 2048, LDO = 1024;
constexpr int SHM_VT = 128 * 80, SHM_K8 = 64 * 208;
constexpr int OFF_V = 0, OFF_K8 = 3 * SHM_VT, OFF_WS = OFF_K8 + 2 * SHM_K8, LDS_BYTES = OFF_WS + NW * 64 * 4 + 64;
typedef int v8i32 __attribute__((ext_vector_type(8)));
typedef int v4i32 __attribute__((ext_vector_type(4)));
typedef int v2i32 __attribute__((ext_vector_type(2)));
constexpr int T_TOK = 8 * SEQ;
#define ASBAR() __builtin_amdgcn_sched_barrier(0)
__device__ __forceinline__ int crow(int r, int hi) { return (r & 3) + 8 * (r >> 2) + 4 * hi; }
__device__ __forceinline__ unsigned cvtpk(float lo, float hi) { unsigned r; asm volatile("v_cvt_pk_bf16_f32 %0, %1, %2" : "=v"(r) : "v"(lo), "v"(hi)); return r; }
__device__ __forceinline__ float bf2f(unsigned short b) { return __uint_as_float(((unsigned)b) << 16); }
template <bool SHIFT> __device__ __forceinline__ void smA(f32x16& p0, float negm) { for (int r = 0; r < 16; ++r) p0[r] = __builtin_amdgcn_exp2f(SHIFT ? p0[r] + negm : p0[r]); }
template <bool SHIFT> __device__ __forceinline__ void smB(f32x16& p0, f32x16& p1, float& l_reg, v8i32& p8, float negm) {
  for (int r = 0; r < 16; ++r) p1[r] = __builtin_amdgcn_exp2f(SHIFT ? p1[r] + negm : p1[r]);
  float ps = 0; for (int r = 0; r < 16; ++r) ps += p0[r]; for (int r = 0; r < 16; ++r) ps += p1[r];
  l_reg += ps;
#pragma unroll
  for (int w = 0; w < 4; ++w) { int a = 0, bq = 0;
    a = __builtin_amdgcn_cvt_pk_bf8_f32(p0[4 * w], p0[4 * w + 1], a, false); a = __builtin_amdgcn_cvt_pk_bf8_f32(p0[4 * w + 2], p0[4 * w + 3], a, true);
    bq = __builtin_amdgcn_cvt_pk_bf8_f32(p1[4 * w], p1[4 * w + 1], bq, false); bq = __builtin_amdgcn_cvt_pk_bf8_f32(p1[4 * w + 2], p1[4 * w + 3], bq, true);
    p8[w] = a; p8[4 + w] = bq; }
}
template <bool SHIFT> __device__ __forceinline__ void qkt(f32x16& p0, f32x16& p1, const char* K8, const v8i32* q8, float negm, int r32, int hi) {
  p0 = f32x16{}; p1 = f32x16{};
#define K8RD(m, half, part) (*reinterpret_cast<const v4i32*>(K8 + ((half) * 32 + r32) * 208 + (m) * 64 + hi * 32 + (part) * 16))
#define K8FR(m, half) ({ const v4i32 lo_ = K8RD(m, half, 0), hi_ = K8RD(m, half, 1); (v8i32){lo_[0], lo_[1], lo_[2], lo_[3], hi_[0], hi_[1], hi_[2], hi_[3]}; })
  v8i32 a0 = K8FR(0, 0), a1 = K8FR(0, 1), b0 = K8FR(1, 0), b1 = K8FR(1, 1);
  ASBAR();
  p0 = __builtin_amdgcn_mfma_scale_f32_32x32x64_f8f6f4(a0, q8[0], p0, 0, 0, 0, 0x7f7f7f7f, 0, 0x7f7f7f7f);
  p1 = __builtin_amdgcn_mfma_scale_f32_32x32x64_f8f6f4(a1, q8[0], p1, 0, 0, 0, 0x7f7f7f7f, 0, 0x7f7f7f7f);
  a0 = K8FR(2, 0); a1 = K8FR(2, 1);
  ASBAR();
  p0 = __builtin_amdgcn_mfma_scale_f32_32x32x64_f8f6f4(b0, q8[1], p0, 0, 0, 0, 0x7f7f7f7f, 0, 0x7f7f7f7f);
  p1 = __builtin_amdgcn_mfma_scale_f32_32x32x64_f8f6f4(b1, q8[1], p1, 0, 0, 0, 0x7f7f7f7f, 0, 0x7f7f7f7f);
  ASBAR();
  p0 = __builtin_amdgcn_mfma_scale_f32_32x32x64_f8f6f4(a0, q8[2], p0, 0, 0, 0, 0x7f7f7f7f, 0, 0x7f7f7f7f);
  p1 = __builtin_amdgcn_mfma_scale_f32_32x32x64_f8f6f4(a1, q8[2], p1, 0, 0, 0, 0x7f7f7f7f, 0, 0x7f7f7f7f);
  ASBAR();
#undef K8RD
#undef K8FR
}
__device__ __forceinline__ void pv_d0(f32x16* o, const char* VT, v8i32 p8, int r32, int hi) {
#define VTFR(d0) ({ const v4i32 lo_ = *reinterpret_cast<const v4i32*>(VT + ((d0) * 32 + r32) * 80 + hi * 32), hi_ = *reinterpret_cast<const v4i32*>(VT + ((d0) * 32 + r32) * 80 + hi * 32 + 16); (v8i32){lo_[0], lo_[1], lo_[2], lo_[3], hi_[0], hi_[1], hi_[2], hi_[3]}; })
#define PVMMA(d0, fr) o[d0] = __builtin_amdgcn_mfma_scale_f32_32x32x64_f8f6f4(p8, fr, o[d0], 1  , 0  , 0, 0x7f7f7f7f, 0, 0x7f7f7f7f)
  v8i32 fa = VTFR(0), fb = VTFR(1);
  ASBAR();
  PVMMA(0, fa); fa = VTFR(2); ASBAR();
  PVMMA(1, fb); fb = VTFR(3); ASBAR();
  PVMMA(2, fa); PVMMA(3, fb); ASBAR();
#undef VTFR
#undef PVMMA
}
template <bool SHIFT> __device__ __forceinline__ bool attn_unit(int b, int h, int s0, const bf16* Qraw, const unsigned char* __restrict__ VT8g, const unsigned char* __restrict__ K8g, const unsigned char* __restrict__ KP8g, bf16* __restrict__ O,
                                          const float* rope, const float* qg, float smaxC, char* lds, int tid) {
  asm volatile("" : "+v"(tid));
  const int wid = __builtin_amdgcn_readfirstlane(tid >> 6), lane = tid & 63, r32 = lane & 31, hi = lane >> 5;
  asm volatile("" : "+s"(qg));
  char* V_lds = lds + OFF_V; char* K8_lds = lds + OFF_K8;
  float* ws = (float*)(lds + OFF_WS) + wid * 64; float* li_l = ws;
  constexpr float C = 0.072168783648703220f * 1.4426950408889634f;
  v8i32 q8[3];
  {
    typedef __attribute__((address_space(1))) const bf16x8 gbf16x8; typedef __attribute__((address_space(1))) const f32x4_t gf32x4;
    const long trow = (long)b * SEQ + s0 + wid * QBLK + r32;
    unsigned qo = (unsigned)((trow * LDQ + h * 192) * 2); const unsigned ro = (unsigned)(trow * 256), go = (unsigned)(hi * 128);
#define Qn_(i) (*(gbf16x8*)((const char*)Qraw + qo + hi * 64 + (i) * 16))
#define Qr_(i) (*(gbf16x8*)((const char*)Qraw + qo + 256 + (i) * 16))
#define rp4_(i) (*(gf32x4*)((const char*)rope + ro + (i) * 16))
#define qgn_(i) (*(gf32x4*)((const char*)qg + go + (i) * 16))
#define qgr_(i) (*(gf32x4*)((const char*)qg + 512 + (i) * 16))
    float ssn = 0.f, ssp = 0.f;
#pragma unroll
    for (int c = 0; c < 8; ++c) { const bf16x8 a = Qn_((c >> 2) * 8 + (c & 3)), r = Qr_(c);
#pragma unroll
      for (int j = 0; j < 8; ++j) { const float f = bf2f((unsigned short)a[j]), g = bf2f((unsigned short)r[j]); ssn += f * f; ssp += g * g; } }
    ssn += __shfl_xor(ssn, 32);
    const float rn = rsqrtf(ssn * (1.f / 128.f) + 1e-6f) * C, rp = rsqrtf(ssp * (1.f / 64.f) + 1e-6f) * C;
    { float rn_ = rn, rp_ = rp; asm volatile("" : "+v"(qo), "+v"(rn_), "+v"(rp_) :: "memory"); }
#pragma unroll
    for (int m = 0; m < 2; ++m)
#pragma unroll
      for (int c = 0; c < 4; ++c) { const bf16x8 raw = Qn_(8 * m + c); const f32x4_t ga = qgn_(16 * m + 2 * c), gb = qgn_(16 * m + 2 * c + 1); float g[8];
#pragma unroll
        for (int j = 0; j < 8; ++j) g[j] = bf2f((unsigned short)raw[j]) * rn * (j < 4 ? ga[j & 3] : gb[j & 3]);
        int w0 = 0, w1 = 0; w0 = __builtin_amdgcn_cvt_pk_fp8_f32(g[0], g[1], w0, false); w0 = __builtin_amdgcn_cvt_pk_fp8_f32(g[2], g[3], w0, true);
        w1 = __builtin_amdgcn_cvt_pk_fp8_f32(g[4], g[5], w1, false); w1 = __builtin_amdgcn_cvt_pk_fp8_f32(g[6], g[7], w1, true);
        asm volatile("" : "+v"(w0), "+v"(w1) :: "memory");        q8[m][2 * c] = w0; q8[m][2 * c + 1] = w1; }
#pragma unroll
    for (int c = 0; c < 4; ++c) {
      const bf16x8 r1 = Qr_(c), r2 = Qr_(4 + c);
      const f32x4_t g1a = qgr_(2 * c), g1b = qgr_(2 * c + 1), g2a = qgr_(8 + 2 * c), g2b = qgr_(8 + 2 * c + 1); float ov[8];
#pragma unroll
      for (int j = 0; j < 8; ++j) { const f32x4_t cs4 = rp4_(4 * c + (j >> 1));
        const float cs = cs4[(j & 1) * 2], sn = cs4[(j & 1) * 2 + 1];
        const float x1 = bf2f((unsigned short)r1[j]) * rp * (j < 4 ? g1a[j & 3] : g1b[j & 3]), x2 = bf2f((unsigned short)r2[j]) * rp * (j < 4 ? g2a[j & 3] : g2b[j & 3]);
        ov[j] = hi == 0 ? (x1 * cs - x2 * sn) : (x1 * sn + x2 * cs); }
      int w0 = 0, w1 = 0; w0 = __builtin_amdgcn_cvt_pk_fp8_f32(ov[0], ov[1], w0, false); w0 = __builtin_amdgcn_cvt_pk_fp8_f32(ov[2], ov[3], w0, true);
      w1 = __builtin_amdgcn_cvt_pk_fp8_f32(ov[4], ov[5], w1, false); w1 = __builtin_amdgcn_cvt_pk_fp8_f32(ov[6], ov[7], w1, true);
      asm volatile("" : "+v"(w0), "+v"(w1) :: "memory"); q8[2][2 * c] = w0; q8[2][2 * c + 1] = w1; }
  #undef Qn_
#undef Qr_
#undef rp4_
#undef qgn_
#undef qgr_
  }
  const float negm = 15.0f - smaxC;
  float l_reg = 0.f; f32x16 o[4] = {};
  const char* Vg = (const char*)(VT8g + (size_t)h * 128 * T_TOK + (size_t)b * SEQ); const char* Kg = (const char*)(K8g + ((long)b * SEQ * 8 + h) * 128); const char* Pg = (const char*)(KP8g + (long)b * SEQ * 64);
  const int vc = tid >> 2, vq = tid & 3, vst = vc * 80 + 16 * (vq >> 1) + 8 * (vq & 1); const unsigned gvt = (unsigned)vc * (unsigned)T_TOK + 16u * (unsigned)vq;
  const int kr = tid >> 3, kc = tid & 7, kst = kr * 208 + kc * 16; const unsigned gk8 = (unsigned)(kr * 1024 + kc * 16);
  const int pr = (tid & 255) >> 2, pc = tid & 3, pst = pr * 208 + 128 + pc * 16; const unsigned gp8 = (unsigned)(pr * 64 + pc * 16);
  v4i32 s_v, s_k, s_p;
#define SLOAD(k0) do { s_v = *reinterpret_cast<const v4i32*>(Vg + (size_t)(k0) + gvt); \
    s_k = *reinterpret_cast<const v4i32*>(Kg + (size_t)(k0) * 1024 + gk8); if (tid < 256) s_p = *reinterpret_cast<const v4i32*>(Pg + (size_t)(k0) * 64 + gp8); } while (0)
#define SWRITE(kbuf, vbuf_) do { { v2i32 a_ = {s_v[0], s_v[2]}, b_ = {s_v[1], s_v[3]}; *(v2i32*)(V_lds + (vbuf_) * SHM_VT + vst) = a_; *(v2i32*)(V_lds + (vbuf_) * SHM_VT + vst + 32) = b_; } \
    *(v4i32*)(K8_lds + (kbuf) * SHM_K8 + kst) = s_k; if (tid < 256) *(v4i32*)(K8_lds + (kbuf) * SHM_K8 + pst) = s_p; } while (0)
  constexpr int NT = SEQ / KVBLK;
  v8i32 p8;
  SLOAD(0); SWRITE(0, 0); __syncthreads(); SLOAD(KVBLK);
  if (wid < 4) {
    for (int j = 0, kb = 0, vbuf = 0, vnx = 1; j < NT; ++j) {
      f32x16 p0, p1;
      qkt<SHIFT>(p0, p1, K8_lds + kb * SHM_K8, q8, negm, r32, hi);
      smA<SHIFT>(p0, negm); smB<SHIFT>(p0, p1, l_reg, p8, negm); ASBAR();
      pv_d0(o, V_lds + vbuf * SHM_VT, p8, r32, hi);
      if (j + 1 < NT) SWRITE(kb ^ 1, vnx);
      __syncthreads();
      if (j + 2 < NT) SLOAD((j + 2) * KVBLK);
      kb ^= 1; vbuf = vnx; vnx = vnx == 2 ? 0 : vnx + 1;
    }
  } else {
    int vprev = 0;
    __builtin_amdgcn_s_setprio(1);
    for (int j = 0, kb = 0, vbuf = 0, vnx = 1; j < NT; ++j) {
      f32x16 p0, p1;
      if (j > 0) pv_d0(o, V_lds + vprev * SHM_VT, p8, r32, hi);
      qkt<SHIFT>(p0, p1, K8_lds + kb * SHM_K8, q8, negm, r32, hi);
      smA<SHIFT>(p0, negm); smB<SHIFT>(p0, p1, l_reg, p8, negm); ASBAR();
      if (j + 1 < NT) SWRITE(kb ^ 1, vnx);
      __syncthreads();
      if (j + 2 < NT) SLOAD((j + 2) * KVBLK);
      kb ^= 1; vprev = vbuf; vbuf = vnx; vnx = vnx == 2 ? 0 : vnx + 1;
    }
    pv_d0(o, V_lds + vprev * SHM_VT, p8, r32, hi);
    __builtin_amdgcn_s_setprio(0);
  }
  int lane_e = lane; asm volatile("" : "+v"(lane_e));
  const int r32e = lane_e & 31, hie = lane_e >> 5;
  l_reg += __shfl_xor(l_reg, 32);
  int* satf = (int*)(lds + OFF_WS + NW * 64 * 4);
  if (!SHIFT) { const bool sat = __any(l_reg >= 57344.f); if (lane_e == 0) satf[wid] = sat ? 1 : 0; }
  if (hie == 0) li_l[r32e] = l_reg; asm volatile("s_waitcnt lgkmcnt(0)" ::: "memory");
  float rli[16];
#pragma unroll
  for (int r = 0; r < 16; ++r) rli[r] = __builtin_amdgcn_rcpf(li_l[crow(r, hie)]);
  char* Ow = (char*)O + ((long)b * SEQ + s0 + wid * QBLK) * LDO + h * 128;
#pragma unroll
  for (int r = 0; r < 16; ++r) { const unsigned ooff = (unsigned)(crow(r, hie) * LDO + r32e);
#pragma unroll
    for (int d0 = 0; d0 < 4; ++d0) { const int pk = __builtin_amdgcn_cvt_pk_fp8_f32(o[d0][r] * rli[r] * 32.f, 0.f, 0, false); *(unsigned char*)(Ow + ooff + d0 * 32) = (unsigned char)(pk & 0xff); } }
  __syncthreads();
  bool redo = false;
  if (!SHIFT) { redo = (satf[0] | satf[1] | satf[2] | satf[3] | satf[4] | satf[5] | satf[6] | satf[7]) != 0; __syncthreads(); }
  return redo;
#undef SLOAD
#undef SWRITE
}
}
#ifndef HD
#define HD __device__ __forceinline__
#endif
struct c32 { float x, y; };
HD c32 cmk(float x, float y) { c32 r; r.x = x; r.y = y; return r; }
HD c32 cadd(c32 a, c32 b) { return cmk(a.x + b.x, a.y + b.y); }
HD c32 csub(c32 a, c32 b) { return cmk(a.x - b.x, a.y - b.y); }
HD c32 cmul(c32 a, c32 b) { return cmk(a.x * b.x - a.y * b.y, a.x * b.y + a.y * b.x); }
HD c32 cmulc(c32 a, c32 b) { return cmk(a.x * b.x + a.y * b.y, a.y * b.x - a.x * b.y); }
constexpr int BR4(int i) { return ((i & 1) << 3) | ((i & 2) << 1) | ((i & 4) >> 1) | ((i & 8) >> 3); }
template <int SGN, int J> HD c32 tw16(c32 a) {
    if constexpr (J == 0) return a;
    else if constexpr (J == 4) return SGN < 0 ? cmk(a.y, -a.x) : cmk(-a.y, a.x);
    else {
        constexpr float CS[8] = {1.f, 0.92387953251128674f, 0.70710678118654752f, 0.38268343236508977f, 0.f, -0.38268343236508977f, -0.70710678118654752f, -0.92387953251128674f};
        constexpr float SN[8] = {0.f, 0.38268343236508977f, 0.70710678118654752f, 0.92387953251128674f, 1.f, 0.92387953251128674f, 0.70710678118654752f, 0.38268343236508977f};
        constexpr float c = CS[J], s = SN[J];
        if constexpr (SGN < 0) return cmk(a.x * c + a.y * s, a.y * c - a.x * s);
        else return cmk(a.x * c - a.y * s, a.y * c + a.x * s);
    }
}
#define FFT_BF(i, j, J) { const c32 u_ = v[i], w_ = v[j]; v[i] = cadd(u_, w_); v[j] = tw16<SGN, J>(csub(u_, w_)); }
template <int SGN> HD void dft16_dif(c32 (&v)[16]) {
    FFT_BF(0, 8, 0) FFT_BF(1, 9, 1) FFT_BF(2, 10, 2) FFT_BF(3, 11, 3) FFT_BF(4, 12, 4) FFT_BF(5, 13, 5) FFT_BF(6, 14, 6) FFT_BF(7, 15, 7)
    FFT_BF(0, 4, 0) FFT_BF(1, 5, 2) FFT_BF(2, 6, 4) FFT_BF(3, 7, 6) FFT_BF(8, 12, 0) FFT_BF(9, 13, 2) FFT_BF(10, 14, 4) FFT_BF(11, 15, 6)
    FFT_BF(0, 2, 0) FFT_BF(1, 3, 4) FFT_BF(4, 6, 0) FFT_BF(5, 7, 4) FFT_BF(8, 10, 0) FFT_BF(9, 11, 4) FFT_BF(12, 14, 0) FFT_BF(13, 15, 4)
    FFT_BF(0, 1, 0) FFT_BF(2, 3, 0) FFT_BF(4, 5, 0) FFT_BF(6, 7, 0) FFT_BF(8, 9, 0) FFT_BF(10, 11, 0) FFT_BF(12, 13, 0) FFT_BF(14, 15, 0)
}
#undef FFT_BF
#define FFT_BT(i, j, J) { const c32 u_ = v[i], w_ = tw16<SGN, J>(v[j]); v[i] = cadd(u_, w_); v[j] = csub(u_, w_); }
template <int SGN> HD void dft16_dit(c32 (&v)[16]) {
    FFT_BT(0, 1, 0) FFT_BT(2, 3, 0) FFT_BT(4, 5, 0) FFT_BT(6, 7, 0) FFT_BT(8, 9, 0) FFT_BT(10, 11, 0) FFT_BT(12, 13, 0) FFT_BT(14, 15, 0)
    FFT_BT(0, 2, 0) FFT_BT(1, 3, 4) FFT_BT(4, 6, 0) FFT_BT(5, 7, 4) FFT_BT(8, 10, 0) FFT_BT(9, 11, 4) FFT_BT(12, 14, 0) FFT_BT(13, 15, 4)
    FFT_BT(0, 4, 0) FFT_BT(1, 5, 2) FFT_BT(2, 6, 4) FFT_BT(3, 7, 6) FFT_BT(8, 12, 0) FFT_BT(9, 13, 2) FFT_BT(10, 14, 4) FFT_BT(11, 15, 6)
    FFT_BT(0, 8, 0) FFT_BT(1, 9, 1) FFT_BT(2, 10, 2) FFT_BT(3, 11, 3) FFT_BT(4, 12, 4) FFT_BT(5, 13, 5) FFT_BT(6, 14, 6) FFT_BT(7, 15, 7)
}
#undef FFT_BT
constexpr int FFT_PS = 272;
constexpr int FFT_EX_ELEMS = 16 * FFT_PS;
template <class EX> HD void fft_fwd_a(c32 (&v)[16], const c32* T1, EX ex, int tid) {
    dft16_dif<-1>(v);
#pragma unroll
    for (int p = 0; p < 16; ++p) { ex[p * FFT_PS + tid] = cmul(v[BR4(p)], T1[256 * p]); if ((p & 3) == 3) __builtin_amdgcn_sched_barrier(0); }
}
template <class EX> HD void fft_fwd_b(c32 (&v)[16], const c32* T2, EX exr, EX ex, int tid) {
    const int p2 = tid >> 4, c = tid & 15;
#pragma unroll
    for (int b = 0; b < 16; ++b) v[b] = exr[p2 * FFT_PS + 16 * b + c];
    dft16_dif<-1>(v);
#pragma unroll
    for (int q = 0; q < 16; ++q) ex[p2 * FFT_PS + q * 16 + ((c + q) & 15)] = cmul(v[BR4(q)], T2[q]);
}
template <class EX> HD void fft_fwd_c(c32 (&v)[16], EX ex, int tid) {
    const int p2 = tid >> 4, q = tid & 15;
#pragma unroll
    for (int c = 0; c < 16; ++c) v[c] = ex[p2 * FFT_PS + q * 16 + ((c + q) & 15)];
    dft16_dif<-1>(v);
}
template <class EX> HD void fft_inv_a(c32 (&v)[16], EX ex, int tid) {
    const int p = tid >> 4, q = tid & 15;
    dft16_dit<+1>(v);
#pragma unroll
    for (int c = 0; c < 16; ++c) ex[p * FFT_PS + q * 16 + ((c + q) & 15)] = v[c];
}
template <class EX> HD void fft_inv_b(c32 (&v)[16], const c32* T2, EX exr, EX ex, int tid) {
    const int p = tid >> 4, c = tid & 15;
#pragma unroll
    for (int q = 0; q < 16; ++q) v[BR4(q)] = cmulc(exr[p * FFT_PS + q * 16 + ((c + q) & 15)], T2[q]);
    dft16_dit<+1>(v);
#pragma unroll
    for (int b = 0; b < 16; ++b) ex[p * FFT_PS + 16 * b + c] = v[b];
}
template <class EX> HD void fft_inv_c(c32 (&v)[16], const c32* T1, EX ex, int tid) {
#pragma unroll
    for (int p = 0; p < 16; ++p) { v[BR4(p)] = cmulc(ex[p * FFT_PS + tid], T1[256 * p]); if ((p & 3) == 3) __builtin_amdgcn_sched_barrier(0); }
    dft16_dit<+1>(v);
}
constexpr int NWAVES = 8, NTHR = 512;
constexpr int BATCH = 8, SEQ = 4096, DM = 1024, T = BATCH * SEQ;
constexpr float EPS = 1e-6f;
constexpr size_t MiB = 1u << 20;
constexpr size_t WS_CTL = 0, CTL_ZERO_BYTES = 64 * 1024;
constexpr size_t WS_MOD = 1 * MiB;
constexpr size_t WS_HDNS = 1 * MiB + 512 * 1024;
constexpr size_t WS_W4S = 3 * MiB + 512 * 1024;
constexpr size_t WS_LIST = 101 * MiB;
constexpr size_t WS_WL = 396 * MiB;
constexpr size_t WS_WD = 8 * MiB;
constexpr size_t WS_WUQ = 9 * MiB;
constexpr size_t WS_WUKV = 10 * MiB;
constexpr size_t WS_WO = 11 * MiB;
constexpr size_t WS_WIN = 13 * MiB;
constexpr size_t WS_WOUT = 19 * MiB;
constexpr size_t WS_WGU = 21 * MiB;
constexpr size_t WS_WDN = 53 * MiB;
constexpr size_t R1 = 104 * MiB;
constexpr size_t R2 = 232 * MiB;
constexpr size_t R3 = 424 * MiB;
constexpr size_t WS_VT8 = R1, WS_XN2 = R1, WS_KF = R1;
constexpr size_t WS_XN = R2, WS_O = R2;
constexpr size_t WS_LAT = R2 + 64 * MiB;
constexpr size_t WS_HACT = R2 + 64 * MiB;
constexpr size_t WS_CQN = R2 + 128 * MiB;
constexpr size_t WS_CKVN = R2 + 144 * MiB;
constexpr size_t WS_KPE = R2 + 160 * MiB;
constexpr size_t WS_K8 = R2 + 64 * MiB;
constexpr size_t WS_ROPE = R2 + 164 * MiB;
constexpr size_t WS_QRAW = 408 * MiB;
constexpr size_t WS_XN2S = 424 * MiB;
constexpr size_t WS_XR = 424 * MiB;
constexpr size_t WS_HT = R2;
constexpr size_t WS_UT = R2;
constexpr size_t WS_Z = R2;
constexpr size_t WS_END = 512 * MiB;
constexpr int MS_ROWS = T + 24 * 256;
constexpr int CW_BAR = 4096;
constexpr int CW_CNT = 8192;
constexpr int RING_OFF = 0, RING_BYTES = 147456;
constexpr int LDSCTL_OFF = RING_BYTES;
constexpr int MISC_OFF = LDSCTL_OFF;
constexpr int TINFO_OFF = LDSCTL_OFF + 256;
constexpr int RED_OFF = LDSCTL_OFF + 256 + 1280;
constexpr int EPIX_OFF = LDSCTL_OFF + 2048;
constexpr int LDS_BYTES = 163840;
static_assert(RED_OFF + 256 <= LDS_BYTES, "LDS map");

#define GAS __attribute__((address_space(1)))
#define LAS __attribute__((address_space(3)))
typedef unsigned short bf16;
typedef unsigned v4u __attribute__((ext_vector_type(4)));
typedef unsigned v2u __attribute__((ext_vector_type(2)));
typedef int v4i __attribute__((ext_vector_type(4)));
typedef float f32x4 __attribute__((ext_vector_type(4)));
typedef GAS unsigned gu32;
#define RLX_AGENT __ATOMIC_RELAXED, __HIP_MEMORY_SCOPE_AGENT
#define LDS_WAIT() asm volatile("s_waitcnt lgkmcnt(0)" ::: "memory")
__device__ __forceinline__ unsigned pk2(float lo, float hi) { return pg8::cvt_pk_bf16(lo, hi); }
__device__ __forceinline__ float bf2f(unsigned short b) { return __uint_as_float(((unsigned)b) << 16); }
__device__ __forceinline__ float wave_sum(float v) {
#pragma unroll
    for (int o = 1; o < 64; o <<= 1) v += __shfl_xor(v, o);
    return v;
}

#define XB_TMO      128
#define XB_XCNT(j)  (256  + 64 * (j))
#define XB_XSUB(j)  (1280 + 64 * (j))
#define XB_XGEN(j)  (2304 + 64 * (j))
#define XB_TOP      3328
#define XB_TOPGEN   3392
#define XCD_BAR_WORDS 3456
#define XB_SPIN_CAP (1u << 18)

__device__ __forceinline__ unsigned xb_ld(unsigned* p)              { return __hip_atomic_load(p, __ATOMIC_RELAXED, __HIP_MEMORY_SCOPE_AGENT); }
__device__ __forceinline__ unsigned xb_add(unsigned* p, unsigned v) { return __hip_atomic_fetch_add(p, v, __ATOMIC_RELAXED, __HIP_MEMORY_SCOPE_AGENT); }
__device__ __forceinline__ unsigned xb_xcc_id() { return (unsigned)__builtin_amdgcn_s_getreg((3 << 11) | 20) & 0xFu; }
#define XB_SPIN(cond, bar) do { unsigned _sp = 0; while (cond) { __builtin_amdgcn_s_sleep(1); \
    if ((++_sp & 255u) == 0u) { if (xb_ld(&(bar)[XB_TMO])) break; if (_sp > XB_SPIN_CAP) { atomicAdd(&(bar)[XB_TMO], 1u); break; } } } } while (0)

struct XcdBarrier {
    unsigned* bar; unsigned x;
    volatile LAS unsigned* st;
    int w0;
};

__device__ __forceinline__ XcdBarrier xcd_barrier_post(unsigned* bar, volatile LAS unsigned* st) {
    XcdBarrier b; b.bar = bar; b.x = xb_xcc_id(); b.st = st; b.w0 = 0;
    if (threadIdx.x == 0) (void)xb_add(&bar[XB_XCNT(b.x)], 1u);
    return b;
}
__device__ __forceinline__ void xcd_barrier_complete(unsigned* bar, unsigned x, unsigned& nloc, unsigned& nx) {
    const unsigned G = gridDim.x * gridDim.y * gridDim.z;
    unsigned sum, cnt, mine, sp = 0u;
    for (;;) {
        sum = 0u; cnt = 0u; mine = 0u;
#pragma unroll
        for (unsigned j = 0; j < 16; ++j) { const unsigned c = xb_ld(&bar[XB_XCNT(j)]); sum += c; cnt += (c > 0u) ? 1u : 0u; mine = (j == x) ? c : mine; }
        if (sum == G) break;
        __builtin_amdgcn_s_sleep(1);
        if ((++sp & 255u) == 0u) { if (xb_ld(&bar[XB_TMO])) break; if (sp > XB_SPIN_CAP) { atomicAdd(&bar[XB_TMO], 1u); break; } }
    }
    nloc = mine > 0u ? mine : 1u; nx = cnt > 0u ? cnt : 1u;
}

__device__ __forceinline__ void xcd_barrier(const XcdBarrier& b) {
    asm volatile("s_waitcnt vmcnt(0)" ::: "memory");
    __syncthreads();
    if (b.w0 && __builtin_amdgcn_mbcnt_hi(~0u, __builtin_amdgcn_mbcnt_lo(~0u, 0u)) == 0u) {
        unsigned* bar = b.bar;
        __builtin_amdgcn_s_waitcnt(0);
        unsigned nloc = b.st[0], nx = b.st[1];
        if (nloc == 0u) { xcd_barrier_complete(bar, b.x, nloc, nx); b.st[0] = nloc; b.st[1] = nx; }
        const unsigned old = xb_add(&bar[XB_XSUB(b.x)], 1u);
        const unsigned gen = old / nloc;
        if (old + 1u == (gen + 1u) * nloc) {
            __builtin_amdgcn_fence(__ATOMIC_RELEASE, "agent");
            asm volatile("s_waitcnt vmcnt(0)" ::: "memory");
            const unsigned og = xb_add(&bar[XB_TOP], 1u);
            const unsigned tg = og / nx;
            if (og + 1u == (tg + 1u) * nx) xb_add(&bar[XB_TOPGEN], 1u);
            else XB_SPIN(xb_ld(&bar[XB_TOPGEN]) == tg, bar);
            __builtin_amdgcn_fence(__ATOMIC_ACQUIRE, "agent");
            xb_add(&bar[XB_XGEN(b.x)], 1u);
            asm volatile("s_waitcnt vmcnt(0)" ::: "memory");
        } else {
            XB_SPIN(xb_ld(&bar[XB_XGEN(b.x)]) == gen, bar);
            __builtin_amdgcn_fence(__ATOMIC_ACQUIRE, "agent");
            asm volatile("s_waitcnt vmcnt(0)" ::: "memory");
        }
    }
    __syncthreads();
}


struct Ctx { unsigned char* lds; int tid, lane, wave, vcu, G, gw, NGW; };

__device__ __forceinline__ void transpose_item(const float* W, int ldw, int k0, int n0, bf16* WT, int ldt, int drow0, int dcol0, float* scr, int lane, bool kpe_perm) {
    float tv[32];
#pragma unroll
    for (int i = 0; i < 32; ++i) { const int kk = 2 * i + (lane >> 5); tv[i] = W[(size_t)(k0 + kk) * ldw + n0 + (lane & 31)]; }
#pragma unroll
    for (int i = 0; i < 32; ++i) { const int kk = 2 * i + (lane >> 5); scr[kk * 33 + (lane & 31)] = tv[i]; }
    LDS_WAIT();
    const int c = lane & 7;
#pragma unroll
    for (int j = 0; j < 4; ++j) { const int n = (lane >> 3) + 8 * j; const float* s = scr + (8 * c) * 33 + n;
        v4u o; o.x = pk2(s[0 * 33], s[1 * 33]); o.y = pk2(s[2 * 33], s[3 * 33]); o.z = pk2(s[4 * 33], s[5 * 33]); o.w = pk2(s[6 * 33], s[7 * 33]);
        int dr = drow0 + n; if (kpe_perm && dr >= 384 && dr < 448) { const int e = dr - 384; dr = 384 + 32 * ((e >> 4) & 1) + 16 * (e >> 5) + (e & 15); }
        *(v4u*)(WT + (size_t)dr * ldt + dcol0 + k0 + 8 * c) = o; }
    LDS_WAIT();
}
__device__ __forceinline__ void transpose_item8(const float* W, int ldw, int k0, int n0, unsigned char* WT8, int ldt8, int drow0, int dcol0, float* scr, int lane, float scale, bool kpe_perm) {
    float tv[32];
#pragma unroll
    for (int i = 0; i < 32; ++i) { const int kk = 2 * i + (lane >> 5); tv[i] = W[(size_t)(k0 + kk) * ldw + n0 + (lane & 31)]; }
#pragma unroll
    for (int i = 0; i < 32; ++i) { const int kk = 2 * i + (lane >> 5); scr[kk * 33 + (lane & 31)] = tv[i]; }
    LDS_WAIT();
    const int n = lane >> 1, hf = lane & 1; const float* sp = scr + (32 * hf) * 33 + n;
    v4u o0, o1; unsigned w[8];
#pragma unroll
    for (int q = 0; q < 8; ++q) { int p = 0; p = __builtin_amdgcn_cvt_pk_fp8_f32(sp[(4 * q) * 33] * scale, sp[(4 * q + 1) * 33] * scale, p, false); p = __builtin_amdgcn_cvt_pk_fp8_f32(sp[(4 * q + 2) * 33] * scale, sp[(4 * q + 3) * 33] * scale, p, true); w[q] = (unsigned)p; }
    o0.x = w[0]; o0.y = w[1]; o0.z = w[2]; o0.w = w[3]; o1.x = w[4]; o1.y = w[5]; o1.z = w[6]; o1.w = w[7];
    int dr = drow0 + n; if (kpe_perm && dr >= 384 && dr < 448) { const int e = dr - 384; dr = 384 + 32 * ((e >> 4) & 1) + 16 * (e >> 5) + (e & 15); }
    unsigned char* d = WT8 + (size_t)dr * ldt8 + dcol0 + k0 + 32 * hf;
    *(v4u*)d = o0; *(v4u*)(d + 16) = o1;
    LDS_WAIT();
}
typedef __attribute__((address_space(4))) const char kchar;
struct In { int opq;
    __device__ __forceinline__ const float* operator[](int k) const { kchar* ka = (kchar*)__builtin_amdgcn_kernarg_segment_ptr(); return *(const float* const __attribute__((address_space(4)))*)(ka + 8 * k + opq); } };
__device__ __forceinline__ unsigned char* karg_ws(int opq) { kchar* ka = (kchar*)__builtin_amdgcn_kernarg_segment_ptr(); return *(unsigned char* const __attribute__((address_space(4)))*)(ka + 38 * 8 + 8 + opq); }
__device__ __forceinline__ float* karg_out(int opq) { kchar* ka = (kchar*)__builtin_amdgcn_kernarg_segment_ptr(); return *(float* const __attribute__((address_space(4)))*)(ka + 38 * 8 + opq); }

__device__ __forceinline__ void p0_prologue(const Ctx& F, const In& in, unsigned char* ws) {
    float* scr = (float*)(F.lds + RING_OFF + F.wave * 16384);
    bf16* Wd = (bf16*)(ws + WS_WD); bf16* Wuq = (bf16*)(ws + WS_WUQ); bf16* Wukv = (bf16*)(ws + WS_WUKV); bf16* Wo = (bf16*)(ws + WS_WO);
    bf16* Win = (bf16*)(ws + WS_WIN); bf16* Wout = (bf16*)(ws + WS_WOUT); bf16* Wgu = (bf16*)(ws + WS_WGU); bf16* Wdn = (bf16*)(ws + WS_WDN);
    constexpr int I_D = 16 * 14, I_UQ = 4 * 48, I_UKV = 2 * 64, I_O = 16 * 32, I_IN = 16 * 96, I_OUT = 16 * 32, I_GU = 2 * 16 * 2 * (16 * 8), I_DN = 2 * 24 * 2 * (4 * 32);
    constexpr int NITEMS = I_D + I_UQ + I_UKV + I_O + I_IN + I_OUT + I_GU + I_DN;
    for (int it = F.gw; it < NITEMS; it += F.NGW) {
        int r = it; const float* W; int ldw, k0, n0, ldt, drow0, dcol0 = 0; bf16* WT; float f8s = 0.f;
        if (r < I_D) { W = in[7]; ldw = 448; k0 = (r / 14) * 64; n0 = (r % 14) * 32; WT = Wd; ldt = 1024; drow0 = n0; f8s = 32.f; }
        else if ((r -= I_D) < I_UQ) { W = in[10]; ldw = 1536; k0 = (r / 48) * 64; n0 = (r % 48) * 32; WT = Wuq; ldt = 256; drow0 = n0; f8s = 16.f; }
        else if ((r -= I_UQ) < I_UKV) { W = in[11]; ldw = 2048; k0 = (r / 64) * 64; n0 = (r % 64) * 32; ldt = 128;
            WT = Wukv + ((n0 & 128) ? 1024 * 128 : 0); drow0 = (n0 >> 8) * 128 + (n0 & 127); }
        else if ((r -= I_UKV) < I_O) { W = in[14]; ldw = 1024; k0 = (r / 32) * 64; n0 = (r % 32) * 32; WT = Wo; ldt = 1024; drow0 = n0; f8s = 32.f; }
        else if ((r -= I_O) < I_IN) { W = in[15]; ldw = 3072; k0 = (r / 96) * 64; n0 = (r % 96) * 32; WT = Win; ldt = 1024; drow0 = n0; }
        else if ((r -= I_IN) < I_OUT) { W = in[30]; ldw = 1024; k0 = (r / 32) * 64; n0 = (r % 32) * 32; WT = Wout; ldt = 1024; drow0 = n0; }
        else if ((r -= I_OUT) < I_GU) {
            const int sub = r % 128, mat = r / 128, which = mat & 1, le = mat >> 1;
            W = (which ? in[36] : in[35]) + (size_t)le * 1024 * 256; ldw = 256; k0 = (sub / 8) * 64; n0 = (sub % 8) * 32;
            WT = (bf16*)((unsigned char*)Wgu + (size_t)le * 512 * 1024); ldt = 1024; drow0 = (n0 >> 7) * 256 + which * 128 + (n0 & 127); f8s = 32.f; }
        else { r -= I_GU;
            const int sub = r % 128, mat = r / 128, slot = mat & 1, lb = mat >> 1, layer = lb / 24, bk = lb % 24;
            int ii, jj; pg8::pair_of(bk % 6, ii, jj); const int e = (bk / 6) * 4 + (slot ? jj : ii);
            W = in[37] + (size_t)(layer * 16 + e) * 256 * 1024; ldw = 1024; k0 = (sub / 32) * 64; n0 = (sub % 32) * 32;
            WT = (bf16*)((unsigned char*)Wdn + (size_t)lb * 1024 * 512); ldt = 512; drow0 = n0; dcol0 = slot * 256; f8s = 32.f; }
        if (f8s != 0.f) transpose_item8(W, ldw, k0, n0, (unsigned char*)WT, ldt, drow0, dcol0, scr, F.lane, f8s, it < I_D);
        else transpose_item(W, ldw, k0, n0, WT, ldt, drow0, dcol0, scr, F.lane, it < I_D);
    }
    { const int gt = F.vcu * NTHR + F.tid, NGT = F.G * NTHR; const v4u z = {0u, 0u, 0u, 0u};
      for (int i = gt; i < 64 * 1024 / 16; i += NGT) *(v4u*)((unsigned char*)Wd + (size_t)448 * 1024 + (size_t)i * 16) = z;
    }
    { const int gt = F.vcu * NTHR + F.tid, NGT = F.G * NTHR; float* RT = (float*)(ws + WS_ROPE); const int* posi = (const int*)in[2];
      const float inv = __builtin_amdgcn_exp2f(-0.41524101186092029f * (float)(gt & 31));
      for (int i = gt; i < T * 32; i += NGT) { const int t = i >> 5;
        float sn, cs; sincosf((float)posi[t] * inv, &sn, &cs); *(v2u*)(RT + (size_t)i * 2) = (v2u){__float_as_uint(cs), __float_as_uint(sn)}; } }
    { const int gt = F.vcu * NTHR + F.tid, NGT = F.G * NTHR; bf16* W4S = (bf16*)(ws + WS_W4S); const float* w4 = in[28];
      for (int i = gt; i < 4096 * 8; i += NGT) { const int col = i & 4095, oct = i >> 12; float w[8];
#pragma unroll
        for (int q = 0; q < 8; ++q) w[q] = w4[(size_t)(8 * oct + q) * 4096 + col];
        unsigned hw[4], lw[4];
#pragma unroll
        for (int q = 0; q < 4; ++q) { const unsigned h2 = pk2(w[2 * q], w[2 * q + 1]); hw[q] = h2;
          lw[q] = pk2(w[2 * q] - __uint_as_float(h2 << 16), w[2 * q + 1] - __uint_as_float(h2 & 0xffff0000u)); }
        bf16* d = W4S + (size_t)col * 256 + 8 * oct; const v4u hv = {hw[0], hw[1], hw[2], hw[3]}, lv = {lw[0], lw[1], lw[2], lw[3]}, zv = {0u, 0u, 0u, 0u};
        *(v4u*)d = hv; *(v4u*)(d + 64) = hv; *(v4u*)(d + 128) = lv; *(v4u*)(d + 192) = zv; } }
    __syncthreads();
    { bf16* HDp = (bf16*)(ws + WS_HDNS); float* wl = (float*)(F.lds + RING_OFF); float* sv = wl + 161 * 64 + F.wave * 64;
      for (int i = F.tid; i < 161 * 64; i += NTHR) wl[i] = i < 33 * 64 ? in[19][i] : (i < 97 * 64 ? in[22][i - 33 * 64] : in[25][i - 97 * 64]);
      __syncthreads();
      const int j = F.lane; const float b1 = in[20][j], f1 = in[21][j], b2 = in[23][j], f2 = in[24][j], b3 = in[26][j], f3 = in[27][j];
      for (int t = F.gw; t < 4096; t += F.NGW) {
        float zf = 0.f;
        { const float w = 6.2831855f * (float)t * (1.f / 4096.f);
          if (j == 0) zf = (float)t / 4095.f;
          else if (j <= 16) { const float fr = 1e-4f + (float)(j - 1) * ((15.f - 1e-4f) / 15.f); zf = cosf(fr * w); }
          else if (j <= 32) { const float fr = 1e-4f + (float)(j - 17) * ((15.f - 1e-4f) / 15.f); zf = -sinf(fr * w); } }
        sv[j] = zf; LDS_WAIT();
        float a = b1;
#pragma unroll
        for (int k = 0; k < 33; ++k) a += sv[k] * wl[k * 64 + j];
        float h = sinf(f1 * a); LDS_WAIT(); sv[j] = h; LDS_WAIT();
        a = b2;
#pragma unroll 16
        for (int k = 0; k < 64; ++k) a += sv[k] * wl[(33 + k) * 64 + j];
        h = sinf(f2 * a); LDS_WAIT(); sv[j] = h; LDS_WAIT();
        a = b3;
#pragma unroll 16
        for (int k = 0; k < 64; ++k) a += sv[k] * wl[(97 + k) * 64 + j];
        h = sinf(f3 * a); LDS_WAIT();
        const unsigned hi = pk2(h, 0.f) & 0xffffu; const float lo = h - bf2f((unsigned short)hi); const unsigned lob = pk2(lo, 0.f) & 0xffffu;
        bf16* d = HDp + (size_t)t * 256 + j; d[0] = (bf16)hi; d[64] = (bf16)lob; d[128] = (bf16)hi; d[192] = 0;
      } }
    __syncthreads();
    { float* cact = (float*)(F.lds + RING_OFF); float* red = cact + 8 * 1024;
      float* MOD = (float*)(ws + WS_MOD);
      for (int i = F.tid; i < 8 * 1024; i += NTHR) { const float x = in[1][i]; cact[(i & 1023) * 8 + (i >> 10)] = x / (1.f + __expf(-x)); }
      __syncthreads();
      for (int it = F.vcu; it < 2 * 96; it += F.G) {
        const int layer = it / 96, cb = it - 96 * layer, r4 = F.lane >> 4, cq = F.lane & 15;
        const float* W = in[3] + (size_t)layer * 1024 * 6144 + cb * 64 + 4 * cq + (size_t)(F.wave * 128 + r4) * 6144;
        f32x4 acc[8];
#pragma unroll
        for (int b = 0; b < 8; ++b) acc[b] = (f32x4){0.f, 0.f, 0.f, 0.f};
#pragma unroll
        for (int hf = 0; hf < 2; ++hf) { f32x4 wv[16];
#pragma unroll
          for (int q = 0; q < 16; ++q) wv[q] = *(const f32x4*)(W + (size_t)(4 * (16 * hf + q)) * 6144);
#pragma unroll
          for (int q = 0; q < 16; ++q) { const int kk = 4 * (16 * hf + q) + r4; const float* cp = cact + (F.wave * 128 + kk) * 8; const f32x4 c0 = *(const f32x4*)cp, c1 = *(const f32x4*)(cp + 4);
#pragma unroll
            for (int b = 0; b < 8; ++b) acc[b] += (b < 4 ? c0[b & 3] : c1[b & 3]) * wv[q]; } }
#pragma unroll
        for (int b = 0; b < 8; ++b) *(f32x4*)(red + ((F.wave * 4 + r4) * 8 + b) * 64 + 4 * cq) = acc[b];
        __syncthreads();
        { const int b = F.tid >> 6, col = F.tid & 63; float s = in[4][layer * 6144 + cb * 64 + col];
#pragma unroll 8
          for (int p = 0; p < 32; ++p) s += red[(p * 8 + b) * 64 + col];
          MOD[((size_t)layer * 8 + b) * 6144 + cb * 64 + col] = s; }
        __syncthreads();
      } }
}

template <class TX> __device__ __forceinline__ f32x4 ldrow4(const TX* p);
template <> __device__ __forceinline__ f32x4 ldrow4<float>(const float* p) { return *(const __attribute__((address_space(1))) f32x4*)p; }
template <> __device__ __forceinline__ f32x4 ldrow4<bf16>(const bf16* p) { const v2u w = *(const __attribute__((address_space(1))) v2u*)p; f32x4 r; r[0] = __uint_as_float(w.x << 16); r[1] = __uint_as_float(w.x & 0xffff0000u); r[2] = __uint_as_float(w.y << 16); r[3] = __uint_as_float(w.y & 0xffff0000u); return r; }
template <class TX, bool OUT8 = false> __device__ __forceinline__ void norm_mod_phase(const Ctx& F, const TX* X, const float* g, const float* sc, const float* sh, bf16* OUT) {
    for (int ch = F.gw; ch < T / 16; ch += F.NGW) {
        const int r0 = ch * 16, b = r0 >> 12;
        f32x4 A[4], S[4];
#pragma unroll
        for (int j = 0; j < 4; ++j) { const int col = 4 * F.lane + 256 * j; const f32x4 gv = *(const f32x4*)(g + col), sv = *(const f32x4*)(sc + (size_t)b * 6144 + col); A[j] = gv * (1.f + sv); S[j] = *(const f32x4*)(sh + (size_t)b * 6144 + col); }
        const TX* xr = X + (size_t)r0 * DM + 4 * F.lane;
        f32x4 nx[4];
#pragma unroll
        for (int j = 0; j < 4; ++j) nx[j] = ldrow4<TX>(xr + 256 * j);
        for (int rr = 0; rr < 16; ++rr) {
            f32x4 v[4]; float ss = 0.f;
#pragma unroll
            for (int j = 0; j < 4; ++j) { v[j] = nx[j]; ss += (v[j].x * v[j].x + v[j].y * v[j].y) + (v[j].z * v[j].z + v[j].w * v[j].w); }
            if (rr < 15) {
#pragma unroll
                for (int j = 0; j < 4; ++j) nx[j] = ldrow4<TX>(xr + (size_t)(rr + 1) * DM + 256 * j); }
            const float rstd = rsqrtf(wave_sum(ss) * (1.f / DM) + EPS);
            if constexpr (OUT8) { unsigned char* orow = (unsigned char*)OUT + (size_t)(r0 + rr) * DM + 4 * F.lane;
#pragma unroll
                for (int j = 0; j < 4; ++j) { const f32x4 o = v[j] * rstd * A[j] + S[j]; int p = 0; p = __builtin_amdgcn_cvt_pk_fp8_f32(o.x, o.y, p, false); p = __builtin_amdgcn_cvt_pk_fp8_f32(o.z, o.w, p, true); *(int*)(orow + 256 * j) = p; } }
            else { bf16* orow = OUT + (size_t)(r0 + rr) * DM + 4 * F.lane;
#pragma unroll
                for (int j = 0; j < 4; ++j) { const f32x4 o = v[j] * rstd * A[j] + S[j]; v2u w; w.x = pk2(o.x, o.y); w.y = pk2(o.z, o.w); *(v2u*)(orow + 256 * j) = w; } } }
    }
}

__device__ __forceinline__ void lat_post_phase(const Ctx& F, const float* LAT, const float* qag, const float* kvag, const float* kng, const float* rope, bf16* CQN, bf16* CKVN, bf16* KPE) {
    const int l = F.lane;
    const f32x4 gq = *(const f32x4*)(qag + 4 * l);
    const f32x4 g2 = l < 32 ? *(const f32x4*)(kvag + 4 * l) : (l < 48 ? *(const f32x4*)(kng + 128 + 4 * (l - 32)) : (f32x4){0.f, 0.f, 0.f, 0.f});
    f32x4 na = *(const f32x4*)(LAT + (size_t)F.gw * 512 + 4 * l), nc = l < 48 ? *(const f32x4*)(LAT + (size_t)F.gw * 512 + 256 + 4 * l) : (f32x4){0.f, 0.f, 0.f, 0.f};
    for (int row = F.gw; row < T; row += F.NGW) {
        const f32x4 a = na, c = nc;
        if (row + F.NGW < T) { const float* nr = LAT + (size_t)(row + F.NGW) * 512; na = *(const f32x4*)(nr + 4 * l); if (l < 48) nc = *(const f32x4*)(nr + 256 + 4 * l); }
        const float sq = (a.x * a.x + a.y * a.y) + (a.z * a.z + a.w * a.w), sc = (c.x * c.x + c.y * c.y) + (c.z * c.z + c.w * c.w);
        const float s_q = wave_sum(sq), s_kv = wave_sum(l < 32 ? sc : 0.f), s_pe = wave_sum((l >= 32 && l < 48) ? sc : 0.f);
        const float rq = rsqrtf(s_q * (1.f / 256.f) + EPS), rkv = rsqrtf(s_kv * (1.f / 128.f) + EPS), rpe = rsqrtf(s_pe * (1.f / 64.f) + EPS);
        { const f32x4 o = a * rq * gq; v2u w; w.x = pk2(o.x, o.y); w.y = pk2(o.z, o.w); *(v2u*)(CQN + (size_t)row * 256 + 4 * l) = w; }
        if (l < 32) { const f32x4 o = c * rkv * g2; v2u w; w.x = pk2(o.x, o.y); w.y = pk2(o.z, o.w); *(v2u*)(CKVN + (size_t)row * 256 + 4 * l) = w; }
        else { v2u w; w.x = 0u; w.y = 0u; *(v2u*)(CKVN + (size_t)row * 256 + 128 + 4 * (l - 32)) = w; }
        const f32x4 n = c * rpe * g2;
        f32x4 other; other.x = __shfl_xor(n.x, 8); other.y = __shfl_xor(n.y, 8); other.z = __shfl_xor(n.z, 8); other.w = __shfl_xor(n.w, 8);
        if (l >= 32 && l < 48) { const bool first = l < 40; const int e0 = 4 * ((l - 32) & 7);
            float o[4];
#pragma unroll
            for (int i = 0; i < 4; ++i) { const int e = e0 + i; const float cs = rope[(size_t)row * 64 + e * 2], sn = rope[(size_t)row * 64 + e * 2 + 1];
                const float mine = n[i], oth = other[i]; o[i] = first ? (mine * cs - oth * sn) : (oth * sn + mine * cs); }
            v2u w; w.x = pk2(o[0], o[1]); w.y = pk2(o[2], o[3]); *(v2u*)(KPE + (size_t)row * 64 + 4 * (l - 32)) = w; }
    }
}

__device__ __forceinline__ void knorm_phase(const Ctx& F, bf16* KV, const float* kng) {
    const int l = F.lane, h = l >> 3, e0 = (l & 7) * 16;
    float g[16];
#pragma unroll
    for (int i = 0; i < 16; ++i) g[i] = kng[e0 + i];
    for (int row = F.gw; row < T; row += F.NGW) {
        bf16* p = KV + (size_t)row * 2048 + h * 256 + e0;
        const v4u r0 = *(const v4u*)p, r1 = *(const v4u*)(p + 8);
        float f[16]; const unsigned w[8] = {r0.x, r0.y, r0.z, r0.w, r1.x, r1.y, r1.z, r1.w};
        float ss = 0.f;
#pragma unroll
        for (int i = 0; i < 8; ++i) { f[2 * i] = __uint_as_float(w[i] << 16); f[2 * i + 1] = __uint_as_float(w[i] & 0xffff0000u); ss += f[2 * i] * f[2 * i] + f[2 * i + 1] * f[2 * i + 1]; }
        ss += __shfl_xor(ss, 1); ss += __shfl_xor(ss, 2); ss += __shfl_xor(ss, 4);
        const float r = rsqrtf(ss * (1.f / 128.f) + EPS);
        v4u o0, o1;
        o0.x = pk2(f[0] * r * g[0], f[1] * r * g[1]); o0.y = pk2(f[2] * r * g[2], f[3] * r * g[3]); o0.z = pk2(f[4] * r * g[4], f[5] * r * g[5]); o0.w = pk2(f[6] * r * g[6], f[7] * r * g[7]);
        o1.x = pk2(f[8] * r * g[8], f[9] * r * g[9]); o1.y = pk2(f[10] * r * g[10], f[11] * r * g[11]); o1.z = pk2(f[12] * r * g[12], f[13] * r * g[13]); o1.w = pk2(f[14] * r * g[14], f[15] * r * g[15]);
        *(v4u*)p = o0; *(v4u*)(p + 8) = o1;
    }
}

__device__ __forceinline__ void route_phase(const Ctx& F, const bf16* X, const float* g, const float* sc, const float* sh, const float* wg, const float* bg, const float* we, const float* be,
                                            bf16* XN2, int* LIST, float* WL, gu32* cnt) {
    float* W20 = (float*)(F.lds + RING_OFF);
    for (int i = F.tid; i < 20 * 1024; i += NTHR) { const int o = i >> 10, col = i & 1023; W20[i] = o < 4 ? wg[col * 4 + o] : we[col * 16 + (o - 4)]; }
    __syncthreads();
    float bgv[4];
#pragma unroll
    for (int i = 0; i < 4; ++i) bgv[i] = bg[i];
    for (int ch = F.gw; ch < T / 16; ch += F.NGW) {
        const int r0 = ch * 16, b = r0 >> 12;
        f32x4 A[4], S[4];
#pragma unroll
        for (int j = 0; j < 4; ++j) { const int col = 4 * F.lane + 256 * j; const f32x4 gv = *(const f32x4*)(g + col), sv = *(const f32x4*)(sc + (size_t)b * 6144 + col); A[j] = gv * (1.f + sv); S[j] = *(const f32x4*)(sh + (size_t)b * 6144 + col); }
        const bf16* xr = X + (size_t)r0 * DM + 4 * F.lane;
        f32x4 nx[4];
#pragma unroll
        for (int j = 0; j < 4; ++j) nx[j] = ldrow4<bf16>(xr + 256 * j);
        for (int rr = 0; rr < 16; ++rr) { const int row = r0 + rr;
            f32x4 v[4]; float ss = 0.f;
#pragma unroll
            for (int j = 0; j < 4; ++j) { v[j] = nx[j]; ss += (v[j].x * v[j].x + v[j].y * v[j].y) + (v[j].z * v[j].z + v[j].w * v[j].w); }
            if (rr < 15) {
#pragma unroll
                for (int j = 0; j < 4; ++j) nx[j] = ldrow4<bf16>(xr + (size_t)(rr + 1) * DM + 256 * j); }
            const float rstd = rsqrtf(wave_sum(ss) * (1.f / DM) + EPS);
            unsigned char* orow = (unsigned char*)XN2 + (size_t)row * DM + 4 * F.lane;
#pragma unroll
            for (int j = 0; j < 4; ++j) { v[j] = v[j] * rstd * A[j] + S[j]; int p = 0; p = __builtin_amdgcn_cvt_pk_fp8_f32(v[j].x, v[j].y, p, false); p = __builtin_amdgcn_cvt_pk_fp8_f32(v[j].z, v[j].w, p, true); *(int*)(orow + 256 * j) = p; }
            float gl[4];
#pragma unroll
            for (int o = 0; o < 4; ++o) { float a = 0.f;
#pragma unroll
                for (int j = 0; j < 4; ++j) { const f32x4 w = *(const f32x4*)(W20 + o * 1024 + 4 * F.lane + 256 * j); a += (v[j].x * w.x + v[j].y * w.y) + (v[j].z * w.z + v[j].w * w.w); }
                gl[o] = wave_sum(a) + bgv[o]; }
            int gi = 0; float gm = gl[0]; if (gl[1] > gm) { gm = gl[1]; gi = 1; } if (gl[2] > gm) { gm = gl[2]; gi = 2; } if (gl[3] > gm) { gm = gl[3]; gi = 3; }
            gi = __builtin_amdgcn_readfirstlane(gi);
            const float gw_ = 1.f / (__expf(gl[0] - gm) + __expf(gl[1] - gm) + __expf(gl[2] - gm) + __expf(gl[3] - gm));
            const float* We = W20 + (4 + 4 * gi) * 1024 + 4 * F.lane;
            float e[4];
#pragma unroll
            for (int k = 0; k < 4; ++k) { float a = 0.f;
#pragma unroll
                for (int j = 0; j < 4; ++j) { const f32x4 w = *(const f32x4*)(We + k * 1024 + 256 * j); a += (v[j].x * w.x + v[j].y * w.y) + (v[j].z * w.z + v[j].w * w.w); }
                e[k] = wave_sum(a) + be[4 * gi + k]; }
            int i1 = 0; float m1 = e[0];
#pragma unroll
            for (int k = 1; k < 4; ++k) if (e[k] > m1) { m1 = e[k]; i1 = k; }
            int i2 = -1; float m2 = -3.0e38f;
#pragma unroll
            for (int k = 0; k < 4; ++k) if (k != i1 && e[k] > m2) { m2 = e[k]; i2 = k; }
            const float t2 = __expf(m2 - m1), w1 = gw_ / (1.f + t2), w2 = gw_ * t2 / (1.f + t2);
            const int ilo = i1 < i2 ? i1 : i2, ihi = i1 < i2 ? i2 : i1; const float wlo = i1 < i2 ? w1 : w2, whi = i1 < i2 ? w2 : w1;
            const int pi = ilo == 0 ? ihi - 1 : (ilo == 1 ? ihi + 1 : 5), bk = gi * 6 + pi;
            if (F.lane == 0) { const unsigned pos = __hip_atomic_fetch_add(cnt + bk * 64, 1u, RLX_AGENT);
                LIST[bk * 32768 + pos] = row; float2 ww; ww.x = wlo; ww.y = whi; *(float2*)(WL + ((size_t)bk * 32768 + pos) * 2) = ww; }
        }
    }
}
__device__ __forceinline__ void moe_table(const Ctx& F, const gu32* cnt) {
    int* tinfo = (int*)(F.lds + TINFO_OFF);
    __syncthreads();
    if (F.tid == 0) { int nt = 0;
        for (int b = 0; b < 24; ++b) { const int c = (int)__hip_atomic_load(cnt + b * 64, RLX_AGENT); const int tiles = (c + 255) >> 8;
            tinfo[256 + b] = nt * 256; tinfo[288 + b] = c; for (int i = 0; i < tiles; ++i) tinfo[1 + nt + i] = b; nt += tiles; }
        tinfo[0] = nt; }
    __syncthreads();
}
__device__ __forceinline__ void permute_phase(const Ctx& F, const bf16* XN2, const int* ROUTE, bf16* XN2S, int* TOKW) {
    const int* tinfo = (const int*)(F.lds + TINFO_OFF);
    for (int ch = F.gw; ch < T / 4; ch += F.NGW) {
        v4i r[4]; v4u a[4], bq[4];
#pragma unroll
        for (int i = 0; i < 4; ++i) { const int row = ch * 4 + i; r[i] = *(const v4i*)(ROUTE + (size_t)row * 4);
            a[i] = *(const v4u*)(XN2 + (size_t)row * DM + 8 * F.lane); bq[i] = *(const v4u*)(XN2 + (size_t)row * DM + 512 + 8 * F.lane); }
#pragma unroll
        for (int i = 0; i < 4; ++i) { const int row = ch * 4 + i, srow = tinfo[256 + r[i].x] + r[i].y;
            *(v4u*)(XN2S + (size_t)srow * DM + 8 * F.lane) = a[i]; *(v4u*)(XN2S + (size_t)srow * DM + 512 + 8 * F.lane) = bq[i];
            if (F.lane == 0) { v4i w; w.x = row; w.y = r[i].z; w.z = r[i].w; w.w = 0; *(v4i*)(TOKW + (size_t)srow * 4) = w; } }
    }
}

constexpr float W32C[16] = {1.f, 0.98078528040323043f, 0.92387953251128674f, 0.83146961230254524f, 0.70710678118654752f, 0.55557023301960218f, 0.38268343236508977f, 0.19509032201612825f,
                            0.f, -0.19509032201612825f, -0.38268343236508977f, -0.55557023301960218f, -0.70710678118654752f, -0.83146961230254524f, -0.92387953251128674f, -0.98078528040323043f};
constexpr float W32S[16] = {0.f, 0.19509032201612825f, 0.38268343236508977f, 0.55557023301960218f, 0.70710678118654752f, 0.83146961230254524f, 0.92387953251128674f, 0.98078528040323043f,
                            1.f, 0.98078528040323043f, 0.92387953251128674f, 0.83146961230254524f, 0.70710678118654752f, 0.55557023301960218f, 0.38268343236508977f, 0.19509032201612825f};
struct FftTw { const c32* T1; c32 tob; const c32* T2; };
template <int A> __device__ __forceinline__ c32 mul_to(c32 x, c32 tob) { const c32 y = cmul(x, tob); return cmk(y.x * W32C[A] + y.y * W32S[A], y.y * W32C[A] - y.x * W32S[A]); }
template <int A> __device__ __forceinline__ c32 mul_toc(c32 x, c32 tob) { const c32 y = cmulc(x, tob); return cmk(y.x * W32C[A] - y.y * W32S[A], y.y * W32C[A] + y.x * W32S[A]); }
#define TO_ALL(OP) OP(0) OP(1) OP(2) OP(3) OP(4) OP(5) OP(6) OP(7) OP(8) OP(9) OP(10) OP(11) OP(12) OP(13) OP(14) OP(15)
__device__ __forceinline__ void fft_twiddles(FftTw& W, int gt, c32* t1tab, c32* t2tab, int tid) {
    if (tid < 256) { float s, c; sincosf(-6.283185307179586f * (float)(((tid >> 4) * (tid & 15)) & 255) * (1.f / 256.f), &s, &c); t2tab[(tid >> 4) * 17 + (tid & 15)] = cmk(c, s); }
    for (int i = tid; i < 4096; i += NTHR) { const int p = i >> 8, t = i & 255; float s, c; sincosf(-6.283185307179586f * (float)((t * p) & 4095) * (1.f / 4096.f), &s, &c); t1tab[i] = cmk(c, s); }
    { float s, c; sincosf(-6.283185307179586f * (float)gt * (1.f / 8192.f), &s, &c); W.tob = cmk(c, s); }
    W.T1 = t1tab + gt; W.T2 = t2tab + (gt & 15) * 17;
    __syncthreads();
}
__device__ __forceinline__ void fft_forward_a(c32 (&v)[16], const FftTw& W, c32* ex, int gt) {
    __syncthreads();
    fft_fwd_a(v, W.T1, ex, gt);
    __syncthreads();
}
__device__ __forceinline__ void fft_forward_bc(c32 (&v)[16], const FftTw& W, c32* ex, int gt) {
    fft_fwd_b(v, W.T2, ex, ex, gt);
    __builtin_amdgcn_wave_barrier(); asm volatile("" ::: "memory");
    fft_fwd_c(v, ex, gt);
}
__device__ __forceinline__ void fft_forward(c32 (&v)[16], const FftTw& W, c32* ex, int gt) { fft_forward_a(v, W, ex, gt); fft_forward_bc(v, W, ex, gt); }
__device__ __forceinline__ void fft_inverse(c32 (&v)[16], const FftTw& W, c32* ex, int gt) {
    __builtin_amdgcn_wave_barrier(); asm volatile("" ::: "memory");
    fft_inv_a(v, ex, gt);
    __builtin_amdgcn_wave_barrier(); asm volatile("" ::: "memory");
    fft_inv_b(v, W.T2, ex, ex, gt);
    __syncthreads();
    fft_inv_c(v, W.T1, ex, gt);
}
__device__ __forceinline__ void filter_phase(const Ctx& F, const float* HT, const float* fbias, c32* KF) {
    const int g = __builtin_amdgcn_readfirstlane(F.tid >> 8), gt = F.tid & 255;
    c32* ex = (c32*)(F.lds + RING_OFF + g * 36864);
    float* rev = (float*)ex;
    float* red = (float*)(F.lds + RED_OFF);
    FftTw W; fft_twiddles(W, gt, (c32*)(F.lds + RING_OFF + 73728), (c32*)(F.lds + RING_OFF + 110592), F.tid);
    for (int d = F.vcu; d < DM; d += F.G) {
        int gtv = gt; asm volatile("" : "+v"(gtv));
        const float delta = fabsf(-120.39728043259361f + (float)d * ((40.546510810816436f + 120.39728043259361f) / 1023.f));
        const float* hfp = HT + (size_t)(g * 2048 + d) * 4096; const float* hbp = HT + (size_t)(g * 2048 + 1024 + d) * 4096;
        float hf[16], hb[16]; float sf = 0.f, sb = 0.f;
#pragma unroll
        for (int a = 0; a < 16; ++a) { const int t = 256 * a + gtv; const float dec = __expf(-((float)t * (1.f / 4095.f)) * delta); hf[a] = hfp[t] * dec; hb[a] = hbp[t] * dec; sf += fabsf(hf[a]); sb += fabsf(hb[a]); }
        sf = wave_sum(sf); sb = wave_sum(sb);
        __syncthreads();
        if (F.lane == 0) { red[F.wave * 2] = sf; red[F.wave * 2 + 1] = sb; }
        __syncthreads();
        sf = red[g * 8] + red[g * 8 + 2] + red[g * 8 + 4] + red[g * 8 + 6]; sb = red[g * 8 + 1] + red[g * 8 + 3] + red[g * 8 + 5] + red[g * 8 + 7];
        const float nf = 1.f / (sf + EPS) * (1.f / 8192.f), nb = 1.f / (sb + EPS) * (1.f / 8192.f);
#pragma unroll
        for (int a = 0; a < 16; ++a) rev[256 * a + gt] = hb[a] * nb;
        __syncthreads();
        c32 v[16];
#pragma unroll
        for (int a = 0; a < 16; ++a) { const int n = 256 * a + gt; hb[a] = n == 0 ? 0.f : rev[4096 - n]; hf[a] *= nf; v[a] = cmk(hf[a] + hb[a], 0.f); }
        fft_forward(v, W, ex, gt);
        c32* kf = KF + ((size_t)(d * 2 + g) * 2) * 4096; const float fb = fbias[g * 1024 + d] * (1.f / 4096.f);
#pragma unroll
        for (int i = 0; i < 16; ++i) kf[i * 256 + gtv] = cmk(v[i].x + fb, v[i].y);
#define OPX(A) v[A] = mul_to<A>(cmk(hf[A] - hb[A], 0.f), W.tob);
        TO_ALL(OPX)
#undef OPX
        fft_forward(v, W, ex, gt);
#pragma unroll
        for (int i = 0; i < 16; ++i) kf[4096 + i * 256 + gtv] = v[i];
    }
}
__device__ __forceinline__ void long_conv(c32 (&z)[16], const c32* kf, const FftTw& W, c32* ex, int gt) {
    typedef float f32x2v __attribute__((ext_vector_type(2))); typedef __attribute__((address_space(1))) const f32x2v gc32;
    c32 v[16], k[16]; int gk = gt; asm volatile("" : "+v"(gk));
#define OPX(A) v[A] = mul_to<A>(z[A], W.tob);
    TO_ALL(OPX)
#undef OPX
    fft_forward_a(v, W, ex, gt);
    asm volatile("" ::: "memory");
#pragma unroll
    for (int i = 0; i < 16; ++i) { const f32x2v t_ = ((gc32*)kf)[4096 + i * 256 + gk]; k[i] = cmk(t_.x, t_.y); }
    fft_forward_bc(v, W, ex, gt);
#pragma unroll
    for (int i = 0; i < 16; ++i) v[i] = cmul(v[i], k[i]);
    fft_inverse(v, W, ex, gt);
#define OPX(A) v[A] = mul_toc<A>(v[A], W.tob);
    TO_ALL(OPX)
#undef OPX
    fft_forward_a(z, W, ex, gt);
    asm volatile("" ::: "memory");
#pragma unroll
    for (int i = 0; i < 16; ++i) { const f32x2v t_ = ((gc32*)kf)[i * 256 + gk]; k[i] = cmk(t_.x, t_.y); }
    fft_forward_bc(z, W, ex, gt);
#pragma unroll
    for (int i = 0; i < 16; ++i) z[i] = cmul(z[i], k[i]);
    fft_inverse(z, W, ex, gt);
#pragma unroll
    for (int a = 0; a < 16; ++a) z[a] = cadd(z[a], v[a]);
}
struct RawSeq { v4u r[2][2]; };
__device__ __forceinline__ void raw_issue(RawSeq& q, const bf16* urow, int b0, int gt) {
    typedef __attribute__((address_space(1))) const v4u gv4u;
    asm volatile("" : "+v"(gt));
#pragma unroll
    for (int s_ = 0; s_ < 2; ++s_)
#pragma unroll
        for (int i = 0; i < 2; ++i) q.r[s_][i] = *(gv4u*)(urow + (size_t)(b0 + s_) * SEQ + (gt + 256 * i) * 8);
}
__device__ __forceinline__ void stage_conv3(c32 (&o)[16], const RawSeq& q, float w0, float w1, float w2, float cb, bf16* stg, int gt) {
    constexpr int SS = 4112;
    __syncthreads();
#pragma unroll
    for (int s_ = 0; s_ < 2; ++s_) {
#pragma unroll
        for (int i = 0; i < 2; ++i) *(v4u*)(stg + s_ * SS + 8 + (gt + 256 * i) * 8) = q.r[s_][i];
        if (gt == 0) { stg[s_ * SS + 7] = 0; stg[s_ * SS + 4104] = 0; } }
    __syncthreads();
#pragma unroll
    for (int a = 0; a < 16; ++a) { const int t = 256 * a + gt; float r[2];
#pragma unroll
        for (int s_ = 0; s_ < 2; ++s_) { const bf16* sp = stg + s_ * SS + 7 + t; r[s_] = w0 * bf2f(sp[0]) + w1 * bf2f(sp[1]) + w2 * bf2f(sp[2]) + cb; }
        o[a] = cmk(r[0], r[1]); if ((a & 3) == 3) __builtin_amdgcn_sched_barrier(0); }
}
__device__ __forceinline__ void conv_phase(const Ctx& F, const bf16* UT, const c32* KF, const float* convw, const float* convb, bf16* ZT) {
    const int g = __builtin_amdgcn_readfirstlane(F.tid >> 8), gt = F.tid & 255;
    c32* ex = (c32*)(F.lds + RING_OFF + g * 36864);
    bf16* stg = (bf16*)ex;
    FftTw W; fft_twiddles(W, gt, (c32*)(F.lds + RING_OFF + 73728), (c32*)(F.lds + RING_OFF + 110592), F.tid);
    RawSeq raw;
    if (F.vcu < DM) raw_issue(raw, UT + (size_t)(2048 + F.vcu) * T, (2 * g) * 2, gt);
    for (int d = F.vcu; d < DM; d += F.G) {
        const c32* kf0 = KF + ((size_t)(d * 2 + 0) * 2) * 4096; const c32* kf1 = KF + ((size_t)(d * 2 + 1) * 2) * 4096;
        for (int pp = 0; pp < 2; ++pp) { const int b0 = (2 * g + pp) * 2;
            int gtv = gt; asm volatile("" : "+v"(gtv));
            c32 z[16], gate[16];
            { const int c = 2048 + d; stage_conv3(z, raw, convw[c], convw[3072 + c], convw[6144 + c], convb[c], stg, gtv); }
            raw_issue(raw, UT + (size_t)d * T, b0, gtv);
            long_conv(z, kf0, W, ex, gtv);
            { const int c = d; stage_conv3(gate, raw, convw[c], convw[3072 + c], convw[6144 + c], convb[c], stg, gtv); }
            raw_issue(raw, UT + (size_t)(1024 + d) * T, b0, gtv);
#pragma unroll
            for (int a = 0; a < 16; ++a) z[a] = cmk(z[a].x * gate[a].x, z[a].y * gate[a].y);
            long_conv(z, kf1, W, ex, gtv);
            { const int c = 1024 + d; stage_conv3(gate, raw, convw[c], convw[3072 + c], convw[6144 + c], convb[c], stg, gtv); }
            { const int dn = pp == 0 ? d : d + F.G; if (dn < DM) raw_issue(raw, UT + (size_t)(2048 + dn) * T, pp == 0 ? b0 + 2 : (2 * g) * 2, gtv); }
            bf16* zr = ZT + (size_t)d * T + (size_t)b0 * SEQ;
#pragma unroll
            for (int a = 0; a < 16; ++a) { const int t = 256 * a + gtv; const unsigned pk = pk2(z[a].x * gate[a].x, z[a].y * gate[a].y); zr[t] = (bf16)(pk & 0xffffu); zr[SEQ + t] = (bf16)(pk >> 16); }
        }
    }
}
__device__ __forceinline__ void transpose_phase(const Ctx& F, const bf16* ZT, bf16* Z) {
    bf16* tile = (bf16*)(F.lds + RING_OFF + F.wave * 8704);
    const int l = F.lane;
    v4u x[8];
    if (F.gw < 16 * 512) { const int d0 = (F.gw & 15) * 64, t0 = (F.gw >> 4) * 64;
#pragma unroll
        for (int i = 0; i < 8; ++i) x[i] = *(const v4u*)(ZT + (size_t)(d0 + i * 8 + (l >> 3)) * T + t0 + (l & 7) * 8); }
    for (int it = F.gw; it < 16 * 512; it += F.NGW) { const int d0 = (it & 15) * 64, t0 = (it >> 4) * 64;
#pragma unroll
        for (int i = 0; i < 8; ++i) { const int dr = i * 8 + (l >> 3), c = l & 7;
            v2u* p = (v2u*)(tile + dr * 68 + c * 8); v2u a; a.x = x[i].x; a.y = x[i].y; p[0] = a; a.x = x[i].z; a.y = x[i].w; p[1] = a; }
        const int itn = it + F.NGW;
        if (itn < 16 * 512) { const int dn = (itn & 15) * 64, tn = (itn >> 4) * 64;
#pragma unroll
            for (int i = 0; i < 8; ++i) x[i] = *(const v4u*)(ZT + (size_t)(dn + i * 8 + (l >> 3)) * T + tn + (l & 7) * 8); }
        LDS_WAIT();
#pragma unroll
        for (int i = 0; i < 8; ++i) { const int tr = i * 8 + (l >> 3), c = l & 7; unsigned short e[8];
#pragma unroll
            for (int k = 0; k < 8; ++k) e[k] = tile[(c * 8 + k) * 68 + tr];
            v4u o; o.x = e[0] | ((unsigned)e[1] << 16); o.y = e[2] | ((unsigned)e[3] << 16); o.z = e[4] | ((unsigned)e[5] << 16); o.w = e[6] | ((unsigned)e[7] << 16);
            *(v4u*)(Z + (size_t)(t0 + tr) * DM + d0 + c * 8) = o; }
        LDS_WAIT();
    }
}

constexpr int NPH = 22;
constexpr int seam_id(int k) { return k == 0 ? 0 : k == 1 ? 1 : k == 2 ? 2 : k == 4 ? 3 : k == 6 ? 4 : k == 7 ? 5 : k == 8 ? 6 : k == 10 ? 7 : k == 11 ? 8 : k == 12 ? 9 : k == 14 ? 10 : k == 15 ? 11 : k == 16 ? 12 : k == 17 ? 13 : k == 18 ? 14 : k == 20 ? 15 : -100; }
#ifdef PROBE_SEAM
__device__ __forceinline__ unsigned long long probe_now() { unsigned long long t; asm volatile("s_memrealtime %0\n\ts_waitcnt lgkmcnt(0)" : "=s"(t) :: "memory"); return t; }
#define SEAMHOOK(id) do { if ((id) == PROBE_SEAM) { const unsigned long long t1_ = probe_now(); while (probe_now() < t1_ + (t1_ - tlast_)) __builtin_amdgcn_s_sleep(4); } \
                          if ((id) + 1 == PROBE_SEAM) tlast_ = probe_now(); } while (0)
#define SEAMBAR(k) do { xcd_barrier(bar); SEAMHOOK(seam_id(k)); } while (0)
#else
#define SEAMHOOK(id) do { } while (0)
#define SEAMBAR(k) xcd_barrier(bar)
#endif
#define MOE_PHASES(L) do { \
        const int mb = 8 + 10 * L; \
        if (IN(mb)) { PH_ARGS; const float* mod = WSP(float, WS_MOD) + (size_t)L * 8 * 6144; gu32* cnt = (gu32*)(ws + WS_CTL) + CW_CNT + L * 24 * 64; \
            route_phase(F, WSP(bf16, WS_XR), in[6] + L * 1024, mod + 4 * 1024, mod + 3 * 1024, in[31] + L * 4096, in[32] + L * 4, in[33] + L * 16384, in[34] + L * 16, WSP(bf16, WS_XN2), WSP(int, WS_LIST), WSP(float, WS_WL), cnt); \
            if (L == 0) { __syncthreads();        \
                pg8::Gemm gmh{WSP(bf16, WS_W4S), WSP(bf16, WS_HDNS), 4096, 4096, 256}; pg8::StaticOrder Sh; Sh.init(4096, 4096, F.G, (int)blockIdx.x); pg8::EpiF32 Eh{WSP(float, WS_HT), 4096}; \
                REP(11) pg8::gemm_phase<pg8::EpiF32, pg8::StaticOrder, true, true>(ring, gmh, Sh, Eh, F.tid); } } \
        if (IN(mb) && IN(mb + 2)) SEAMBAR(mb); \
        if (IN(mb + 2)) { PH_ARGS; gu32* cnt = (gu32*)(ws + WS_CTL) + CW_CNT + L * 24 * 64; moe_table(F, cnt); \
              \
            pg8::Gemm gm{WSP(bf16, WS_XN2), (const bf16*)(ws + WS_WGU + (size_t)L * 16 * 512 * 1024), MS_ROWS, 8192, 512}; pg8::MoeOrder S{tinfo, F.G, F.vcu, 0, WSP(int, WS_LIST)}; pg8::EpiSwiGLU E{WSP(unsigned char, WS_HACT), WSP(float, WS_WL), tinfo}; \
            REP(10) pg8::gemm_phase_gather<pg8::EpiSwiGLU, pg8::MoeOrder, true, true, 5>(ring, gm, S, E, F.tid); } SEAM(mb + 2); \
        if (IN(mb + 3)) { PH_ARGS; gu32* cnt = (gu32*)(ws + WS_CTL) + CW_CNT + L * 24 * 64; moe_table(F, cnt); const float* mod = WSP(float, WS_MOD) + (size_t)L * 8 * 6144; \
            pg8::Gemm gm{WSP(bf16, WS_HACT), (const bf16*)(ws + WS_WDN + (size_t)L * 24 * 1024 * 512), MS_ROWS, 24 * 1024, 256};   pg8::MoeOrder S{tinfo, F.G, F.vcu, 1, WSP(int, WS_LIST)}; if (L == 0) { pg8::EpiMoeOut<bf16> E{WSP(bf16, WS_XR), WSP(bf16, WS_XR), mod + 5 * 1024, WSP(int, WS_LIST), tinfo, (PG8_LAS float*)((PG8_LAS unsigned char*)lds + EPIX_OFF)}; pg8::gemm_phase<pg8::EpiMoeOut<bf16>, pg8::MoeOrder, true, true, 8>(ring, gm, S, E, F.tid); } \
            else { pg8::EpiMoeOut<float> E{WSP(bf16, WS_XR), out, mod + 5 * 1024, WSP(int, WS_LIST), tinfo, (PG8_LAS float*)((PG8_LAS unsigned char*)lds + EPIX_OFF)}; pg8::gemm_phase<pg8::EpiMoeOut<float>, pg8::MoeOrder, true, true, 8>(ring, gm, S, E, F.tid); } \
            if (L == 0) { __syncthreads(); REP(13) filter_phase(F, WSP(float, WS_HT), in[29], WSP(c32, WS_KF)); }       \
            } \
    } while (0)
struct Args { const float* in[38]; float* out; unsigned char* ws; int ph_lo, ph_hi; };
static_assert(sizeof(Args) == 38 * 8 + 8 + 8 + 8, "Args layout (read back through the kernarg segment pointer)");
__global__ void __launch_bounds__(NTHR, 2) fwd_kernel(Args args) {
    extern __shared__ __attribute__((aligned(16))) unsigned char lds[];
#define MK_CTX(F, tx) Ctx F; F.lds = lds; F.tid = (tx); F.lane = F.tid & 63; F.wave = __builtin_amdgcn_readfirstlane(F.tid >> 6); \
    F.G = gridDim.x; { const int bx = blockIdx.x; F.vcu = (F.G % 8 == 0) ? (bx % 8) * (F.G / 8) + bx / 8 : bx; } F.gw = F.vcu * NWAVES + F.wave; F.NGW = F.G * NWAVES
    for (int u = threadIdx.x; u < (LDS_BYTES - LDSCTL_OFF) / 4; u += NTHR) ((LAS unsigned*)((LAS unsigned char*)lds + LDSCTL_OFF))[u] = 0u;
    __syncthreads();
    const int wave_s_ = __builtin_amdgcn_readfirstlane(threadIdx.x >> 6);
    const int lo = args.ph_lo, hi = args.ph_hi;
    const bool use_bar = (hi - lo) > 1;
    XcdBarrier bar; bar.bar = (unsigned*)(args.ws + WS_CTL) + CW_BAR; bar.x = 0; bar.st = nullptr; bar.w0 = 0;
    if (use_bar) bar = xcd_barrier_post((unsigned*)(args.ws + WS_CTL) + CW_BAR, (volatile LAS unsigned*)((LAS unsigned char*)lds + MISC_OFF) + 8);
    bar.w0 = (wave_s_ == 0) ? 1 : 0;
#ifndef PHMASK
#define PHMASK 0xFFFFFFFFu
#endif
#define IN(k) (((PHMASK >> ((k) >= 18 ? (k) - 10 : (k))) & 1u) && lo <= (k) && (k) < hi)
#ifndef REPMASK
#define REPMASK 0u
#endif
#define NREP(k) (((REPMASK >> (k)) & 1u) ? 2 : 1)
#define REP(k) for (int rep_ = 0; rep_ < NREP(k); ++rep_)
#define SEAM(k) do { if (IN(k) && IN((k) + 1)) SEAMBAR(k); } while (0)
#define PH_STR2(x) #x
#define PH_STR(x) PH_STR2(x)
#define PH_ARGS int opq_ = 0; asm volatile("; PHMARK line " PH_STR(__LINE__) : "+s"(opq_)); const In in{opq_}; unsigned char* const ws = karg_ws(opq_); float* const out = karg_out(opq_); (void)in; (void)ws; (void)out; int tx_; asm volatile("v_mbcnt_lo_u32_b32 %0, -1, 0\n\tv_mbcnt_hi_u32_b32 %0, -1, %0" : "=v"(tx_)); tx_ += wave_s_ * 64; MK_CTX(F, tx_)
#define WSP(type, off) ((type*)(ws + (off)))
    PG8_LAS unsigned char* ring = (PG8_LAS unsigned char*)lds + RING_OFF;
    const PG8_LAS int* tinfo = (const PG8_LAS int*)((PG8_LAS unsigned char*)lds + TINFO_OFF);

#ifdef PROBE_SEAM
    unsigned long long tlast_ = probe_now();
#endif
    if (IN(0)) { PH_ARGS; REP(0) p0_prologue(F, in, ws); } SEAM(0);

            if (IN(1)) { PH_ARGS; const float* mod = WSP(float, WS_MOD); REP(1) norm_mod_phase<float, true>(F, in[0], in[5], mod + 1024, mod, WSP(bf16, WS_XN)); } SEAM(1);
            if (IN(2)) { PH_ARGS; pg8::Gemm gm{WSP(bf16, WS_XN), WSP(bf16, WS_WD), T, 512, 512};   pg8::StaticOrder S; S.init(T, 512, F.G, (int)blockIdx.x);
                pg8::EpiLat E{WSP(unsigned char, WS_CQN), WSP(bf16, WS_CKVN), WSP(unsigned char, WS_KPE), in[8], in[9], in[13], WSP(float, WS_ROPE), (PG8_LAS float*)((PG8_LAS unsigned char*)lds + EPIX_OFF)};
                REP(2) pg8::gemm_phase<pg8::EpiLat, pg8::StaticOrder, true, true, 5>(ring, gm, S, E, F.tid); }
            if (IN(2) && IN(4)) SEAMBAR(2);
            if (IN(4)) { REP(4) {
                { PH_ARGS; pg8::Gemm gm{WSP(bf16, WS_CQN), WSP(bf16, WS_WUQ), T, 1536, 128};   pg8::StaticOrder S; S.init(T, 1536, F.G, (int)blockIdx.x); pg8::EpiBf16R E{WSP(bf16, WS_QRAW), 1536, nullptr};
                  pg8::gemm_phase<pg8::EpiBf16R, pg8::StaticOrder, true, true, 4>(ring, gm, S, E, F.tid); }
                { PH_ARGS; pg8::Gemm gm{WSP(bf16, WS_CKVN), WSP(bf16, WS_WUKV), T, 1024, 128};   pg8::StaticOrder S; S.init(T, 1024, F.G, (int)blockIdx.x);
                  pg8::EpiK8 E{WSP(unsigned char, WS_K8), in[13], (PG8_LAS float*)((PG8_LAS unsigned char*)lds + EPIX_OFF)};
                  pg8::gemm_phase<pg8::EpiK8, pg8::StaticOrder, true, true>(ring, gm, S, E, F.tid); }
                { PH_ARGS; pg8::Gemm gm{WSP(bf16, WS_WUKV) + 1024 * 128, WSP(bf16, WS_CKVN), 1024, T, 128}; pg8::StaticOrder S; S.init(1024, T, F.G, (int)blockIdx.x);
                  pg8::EpiF8T E{WSP(unsigned char, WS_VT8), T};
                  pg8::gemm_phase<pg8::EpiF8T, pg8::StaticOrder, true, true>(ring, gm, S, E, F.tid); } }
            } if (IN(4) && IN(6)) SEAMBAR(4);
            if (IN(6)) { PH_ARGS;
                const float* qg = in[12]; const float* kg = in[13];
                float gqn = 0.f, gkn = 0.f, gqp = 0.f, gkp = 0.f;
                for (int i = 0; i < 128; ++i) { gqn = fmaxf(gqn, fabsf(qg[i])); gkn = fmaxf(gkn, fabsf(kg[i])); }
                for (int i = 128; i < 192; ++i) { gqp = fmaxf(gqp, fabsf(qg[i])); gkp = fmaxf(gkp, fabsf(kg[i])); }
                const float smaxC = (128.f * gqn * gkn + 64.f * gqp * gkp) * (0.072168783648703220f * 1.4426950408889634f);
                unsigned redo_mask = 0u;
                if (smaxC < 60.f) for (int rep_ = 0; rep_ < NREP(6); ++rep_) { int i = 0;
                    for (int u = F.vcu; u < 1024; u += F.G, ++i) { const int b = u >> 7, h = (u >> 4) & 7, qb = u & 15;
                        if (att::attn_unit<false>(b, h, qb * 256, WSP(bf16, WS_QRAW), WSP(unsigned char, WS_VT8), WSP(unsigned char, WS_K8), WSP(unsigned char, WS_KPE), WSP(bf16, WS_O), WSP(float, WS_ROPE), qg, smaxC, (char*)lds + RING_OFF, F.tid)) redo_mask |= 1u << (i & 31); } }
                else redo_mask = 0xffffffffu;
                redo_mask = (unsigned)__builtin_amdgcn_readfirstlane((int)redo_mask);
                if (redo_mask) { int i = 0;
                    for (int u = F.vcu; u < 1024; u += F.G, ++i) { const int b = u >> 7, h = (u >> 4) & 7, qb = u & 15;
                        if ((redo_mask >> (i & 31)) & 1u) (void)att::attn_unit<true>(b, h, qb * 256, WSP(bf16, WS_QRAW), WSP(unsigned char, WS_VT8), WSP(unsigned char, WS_K8), WSP(unsigned char, WS_KPE), WSP(bf16, WS_O), WSP(float, WS_ROPE), qg, smaxC, (char*)lds + RING_OFF, F.tid); } }
            } SEAM(6);
            if (IN(7)) { PH_ARGS; pg8::Gemm gm{WSP(bf16, WS_O), WSP(bf16, WS_WO), T, 1024, 512};   pg8::StaticOrder S; S.init(T, 1024, F.G, (int)blockIdx.x); pg8::EpiResGate<float, bf16> E{in[0], WSP(bf16, WS_XR), WSP(float, WS_MOD) + 2048, 1024};
                REP(7) pg8::gemm_phase<pg8::EpiResGate<float, bf16>, pg8::StaticOrder, true, true, 10>(ring, gm, S, E, F.tid); } SEAM(7);
    MOE_PHASES(0); SEAM(11);
            if (IN(12)) { PH_ARGS; const float* mod = WSP(float, WS_MOD) + 8 * 6144; REP(12) norm_mod_phase(F, WSP(bf16, WS_XR), in[5] + 1024, mod + 1024, mod, (bf16*)out); }
            if (IN(12) && IN(14)) SEAMBAR(12);
            if (IN(14)) { PH_ARGS; pg8::Gemm gm{WSP(bf16, WS_WIN), (const bf16*)out, 3072, T, 1024}; pg8::StaticOrder S; S.init(3072, T, F.G, (int)blockIdx.x); pg8::EpiBf16R E{WSP(bf16, WS_UT), T, in[16]};
                REP(14) pg8::gemm_phase<pg8::EpiBf16R, pg8::StaticOrder, true, true>(ring, gm, S, E, F.tid); } SEAM(14);
            if (IN(15)) { PH_ARGS; for (int rep = 0; rep < NREP(15); ++rep) conv_phase(F, WSP(bf16, WS_UT), WSP(c32, WS_KF), in[17], in[18], (bf16*)out); } SEAM(15);
            if (IN(16)) { PH_ARGS; REP(16) transpose_phase(F, (const bf16*)out, WSP(bf16, WS_Z)); } SEAM(16);
            if (IN(17)) { PH_ARGS; pg8::Gemm gm{WSP(bf16, WS_Z), WSP(bf16, WS_WOUT), T, 1024, 1024}; pg8::StaticOrder S; S.init(T, 1024, F.G, (int)blockIdx.x); pg8::EpiResGate<bf16, bf16> E{WSP(bf16, WS_XR), WSP(bf16, WS_XR), WSP(float, WS_MOD) + 8 * 6144 + 2048, 1024};
                pg8::gemm_phase<pg8::EpiResGate<bf16, bf16>, pg8::StaticOrder, true, true>(ring, gm, S, E, F.tid); } SEAM(17);
    MOE_PHASES(1);
#ifdef PROBE_SEAM
    SEAMHOOK(16);
#endif
#undef IN
#undef SEAM
}

#ifndef ONE_LAUNCH
#define ONE_LAUNCH 1
#endif
extern "C" void kernel_launch(void* const* d_in, const int* in_sizes, int n_in, void* d_out, int out_size, void* d_ws, size_t ws_size, hipStream_t stream) {
    static int grid = 0;
    if (grid == 0) {
        if (n_in != 38 || in_sizes[0] != T * DM || out_size != T * DM || ws_size < WS_END) { fprintf(stderr, "kernel_launch: shape mismatch n_in %d in0 %d out %d ws %zu\n", n_in, n_in > 0 ? in_sizes[0] : -1, out_size, ws_size); grid = -1; return; }
        int dev = 0, cus = 0, per_cu = 0;
        if (hipGetDevice(&dev) != hipSuccess || hipDeviceGetAttribute(&cus, hipDeviceAttributeMultiprocessorCount, dev) != hipSuccess) { grid = -1; return; }
        if (hipFuncSetAttribute((const void*)fwd_kernel, hipFuncAttributeMaxDynamicSharedMemorySize, LDS_BYTES) != hipSuccess) { fprintf(stderr, "kernel_launch: hipFuncSetAttribute failed\n"); grid = -1; return; }
        if (hipOccupancyMaxActiveBlocksPerMultiprocessor(&per_cu, (const void*)fwd_kernel, NTHR, LDS_BYTES) != hipSuccess || per_cu < 1) { fprintf(stderr, "kernel_launch: occupancy query says %d\n", per_cu); }
        (void)hipGetLastError();
        grid = cus;
    }
    if (grid < 0) return;
    if (hipMemsetAsync((char*)d_ws + WS_CTL, 0, CTL_ZERO_BYTES, stream) != hipSuccess) return;
    Args a{};
    for (int i = 0; i < 38; ++i) a.in[i] = (const float*)d_in[i];
    a.out = (float*)d_out; a.ws = (unsigned char*)d_ws;
#if ONE_LAUNCH
    a.ph_lo = 0; a.ph_hi = NPH;
    hipLaunchKernelGGL(fwd_kernel, dim3(grid), dim3(NTHR), LDS_BYTES, stream, a);
#else
    for (int p = 0; p < NPH; ++p) { a.ph_lo = p; a.ph_hi = p + 1; hipLaunchKernelGGL(fwd_kernel, dim3(grid), dim3(NTHR), LDS_BYTES, stream, a); }
#endif
    const hipError_t le = hipPeekAtLastError();
    if (le != hipSuccess) fprintf(stderr, "kernel_launch: launch failed: %s\n", hipGetErrorName(le));
}
```

```cpp
#include <hip/hip_runtime.h>
#include <cstdio>
#include <cstdint>
namespace pg8 {
#define PG8_LAS __attribute__((address_space(3)))
typedef unsigned short bf16_t;
typedef short bf16x8 __attribute__((ext_vector_type(8)));
typedef float f32x4 __attribute__((ext_vector_type(4)));
typedef unsigned u32x4 __attribute__((ext_vector_type(4)));
typedef int v4i_t __attribute__((ext_vector_type(4)));
typedef int v8i_t __attribute__((ext_vector_type(8)));
constexpr int BM = 256, BK = 64, HALF = 128, HTB = HALF * BK * 2  , STAGE_BYTES = 8 * HTB, NXCD = 8, WGM = 8;

__host__ __device__ __forceinline__ int lds_byte(int r, int c) { const int st = (r >> 4) * 2 + (c >> 5), rr = r & 15, cc = c & 31, ob = rr * 64 + cc * 2; return st * 1024 + (ob ^ (((ob >> 9) & 1) << 5)); }
__host__ __device__ __forceinline__ void stage_rc(int b, int& R, int& C) { const int st = b / 1024, sb = b % 1024, swz = sb ^ (((sb >> 9) & 1) << 5); R = (st >> 1) * 16 + swz / 64; C = (st & 1) * 32 + (swz % 64) / 2; }
__host__ __device__ __forceinline__ int perm32(int rho) { const int n = rho >> 4, i = rho & 15; return 8 * (i >> 2) + 4 * n + (i & 3); }

struct Unit { int pm, pn; };
struct Gemm { const bf16_t* A; const bf16_t* Bt; int M, N, K; };

struct StaticOrder {
    int nM, nN, nwg, G, c;
    __host__ __device__ void init(int M, int N, int G_, int c_) { nM = M / BM; nN = N / BM; nwg = nM * nN; G = G_; c = c_; }
    __host__ __device__ bool next(int i, Unit& u) const {
        const long L = (long)i * G + c; if (L >= nwg) return false;
        int wgid = (int)L; { const int q = nwg / NXCD, r = nwg % NXCD, xcd = wgid % NXCD, off = wgid / NXCD; wgid = (xcd < r ? xcd * (q + 1) : r * (q + 1) + (xcd - r) * q) + off; }
        const int nig = WGM * nN, gid = wgid / nig, fm = gid * WGM, gsz = (nM - fm) < WGM ? (nM - fm) : WGM;
        u.pm = fm + ((wgid % nig) % gsz); u.pn = (wgid % nig) / gsz; return true;
    }
    __device__ __forceinline__ void a_ready(const Unit&) const {}
    __device__ __forceinline__ void done(const Unit&) const {}
};

__device__ __forceinline__ unsigned cvt_pk_bf16(float lo, float hi) { unsigned r; asm volatile("v_cvt_pk_bf16_f32 %0, %1, %2" : "=v"(r) : "v"(lo), "v"(hi)); return r; }
typedef float f32x2 __attribute__((ext_vector_type(2)));
typedef unsigned u32x2 __attribute__((ext_vector_type(2)));
struct EpiF32 {
    static constexpr bool PERM = false, AFTER_DRAIN = false;
    float* C; int ldc;
    __device__ __forceinline__ void operator()(const f32x4 (&acc)[2][2][4][2], const Unit& u, int wr, int wc, int fr, int fq) const {
        const int row0 = u.pm * BM + wr * 64 + fr, col0 = u.pn * BM + wc * 32 + 4 * fq;
#pragma unroll
        for (int ai = 0; ai < 2; ++ai)
#pragma unroll
            for (int m = 0; m < 4; ++m) { float* rowp = C + (size_t)(row0 + ai * HALF + m * 16) * ldc + col0;
#pragma unroll
                for (int bj = 0; bj < 2; ++bj)
#pragma unroll
                    for (int n = 0; n < 2; ++n) *(f32x4*)(rowp + bj * HALF + n * 16) = acc[ai][bj][m][n]; }
    }
};
struct EpiBf16R {
    static constexpr bool PERM = true, AFTER_DRAIN = false;
    bf16_t* O; int ldc; const float* rowbias;
    __device__ __forceinline__ void operator()(const f32x4 (&acc)[2][2][4][2], const Unit& u, int wr, int wc, int fr, int fq) const {
        const int row0 = u.pm * BM + wr * 64 + fr, col0 = u.pn * BM + wc * 32 + 8 * fq;
#pragma unroll
        for (int ai = 0; ai < 2; ++ai)
#pragma unroll
            for (int m = 0; m < 4; ++m) { const int row = row0 + ai * HALF + m * 16; bf16_t* rowp = O + (size_t)row * ldc + col0; const float rb = rowbias ? rowbias[row] : 0.f;
#pragma unroll
                for (int bj = 0; bj < 2; ++bj) { const f32x4 v0 = acc[ai][bj][m][0] + rb, v1 = acc[ai][bj][m][1] + rb;
                    u32x4 w; w.x = cvt_pk_bf16(v0[0], v0[1]); w.y = cvt_pk_bf16(v0[2], v0[3]); w.z = cvt_pk_bf16(v1[0], v1[1]); w.w = cvt_pk_bf16(v1[2], v1[3]);
                    *(u32x4*)(rowp + bj * HALF) = w; } }
    }
};
__device__ __forceinline__ f32x4 ld4(const float* p) { return *(const f32x4*)p; }
__device__ __forceinline__ f32x4 ld4(const bf16_t* p) { const u32x2 w = *(const u32x2*)p; f32x4 r; r[0] = __uint_as_float(w.x << 16); r[1] = __uint_as_float(w.x & 0xffff0000u); r[2] = __uint_as_float(w.y << 16); r[3] = __uint_as_float(w.y & 0xffff0000u); return r; }
__device__ __forceinline__ void st4(float* p, f32x4 v) { *(f32x4*)p = v; }
__device__ __forceinline__ void st4(bf16_t* p, f32x4 v) { u32x2 w; w.x = cvt_pk_bf16(v[0], v[1]); w.y = cvt_pk_bf16(v[2], v[3]); *(u32x2*)p = w; }
__device__ __forceinline__ f32x4 ldraw(const float* p) { return *(const f32x4*)p; }
__device__ __forceinline__ u32x2 ldraw(const bf16_t* p) { return *(const u32x2*)p; }
__device__ __forceinline__ f32x4 cvraw(f32x4 v) { return v; }
__device__ __forceinline__ f32x4 cvraw(u32x2 w) { f32x4 r; r[0] = __uint_as_float(w.x << 16); r[1] = __uint_as_float(w.x & 0xffff0000u); r[2] = __uint_as_float(w.y << 16); r[3] = __uint_as_float(w.y & 0xffff0000u); return r; }
template <class TB, class TO> struct EpiResGate {
    static constexpr bool PERM = false, AFTER_DRAIN = false;
    const TB* base; TO* out; const float* gate; int ldc;
    __device__ __forceinline__ void operator()(const f32x4 (&acc)[2][2][4][2], const Unit& u, int wr, int wc, int fr, int fq) const {
        const int row0 = u.pm * BM + wr * 64 + fr, col0 = u.pn * BM + wc * 32 + 4 * fq;
        const float* gp = gate + (size_t)(u.pm >> 4) * 6144 + col0;
        f32x4 gv[2][2];
#pragma unroll
        for (int bj = 0; bj < 2; ++bj)
#pragma unroll
            for (int n = 0; n < 2; ++n) gv[bj][n] = *(const f32x4*)(gp + bj * HALF + n * 16);
        constexpr int GB = sizeof(TB) == 2 ? 8 : 4;
        typedef decltype(ldraw(base)) raw_t;
#pragma unroll
        for (int g0 = 0; g0 < 8; g0 += GB) {
            raw_t bs[GB][2][2];
#pragma unroll
            for (int g = 0; g < GB; ++g) { const unsigned off = (unsigned)((row0 + ((g0 + g) >> 2) * HALF + ((g0 + g) & 3) * 16) * ldc + col0);
#pragma unroll
                for (int bj = 0; bj < 2; ++bj)
#pragma unroll
                    for (int n = 0; n < 2; ++n) bs[g][bj][n] = ldraw(base + off + bj * HALF + n * 16); }
#pragma unroll
            for (int g = 0; g < GB; ++g) { const int ai = (g0 + g) >> 2, m = (g0 + g) & 3; const unsigned off = (unsigned)((row0 + ai * HALF + m * 16) * ldc + col0);
#pragma unroll
                for (int bj = 0; bj < 2; ++bj)
#pragma unroll
                    for (int n = 0; n < 2; ++n) st4(out + off + bj * HALF + n * 16, cvraw(bs[g][bj][n]) + gv[bj][n] * acc[ai][bj][m][n]); }
            asm volatile("" ::: "memory"); }
    }
};
struct EpiLat {
    static constexpr bool PERM = false, AFTER_DRAIN = false;
    unsigned char* CQN  ; bf16_t* CKVN; unsigned char* KPE  ; const float* qag; const float* kvag; const float* kng; const float* rope; PG8_LAS float* P;
    __device__ __forceinline__ void operator()(const f32x4 (&acc)[2][2][4][2], const Unit& u, int wr, int wc, int, int) const {
        int ln = (int)__builtin_amdgcn_mbcnt_hi(~0u, __builtin_amdgcn_mbcnt_lo(~0u, 0u)); asm volatile("" : "+v"(ln)); const int fr = ln & 15, fq = ln >> 4;
        const int row0 = u.pm * BM + wr * 64 + fr;
#pragma unroll
        for (int ai = 0; ai < 2; ++ai)
#pragma unroll
            for (int m = 0; m < 4; ++m) { float s0 = 0.f, s1 = 0.f;
#pragma unroll
                for (int n = 0; n < 2; ++n) { const f32x4 a = acc[ai][0][m][n], b = acc[ai][1][m][n];
                    s0 += (a[0] * a[0] + a[1] * a[1]) + (a[2] * a[2] + a[3] * a[3]); s1 += (b[0] * b[0] + b[1] * b[1]) + (b[2] * b[2] + b[3] * b[3]); }
                s0 += __shfl_xor(s0, 16); s0 += __shfl_xor(s0, 32); s1 += __shfl_xor(s1, 16); s1 += __shfl_xor(s1, 32);
                if (fq == 0) { const int rl = ai * HALF + wr * 64 + m * 16 + fr; P[rl * 8 + wc] = s0; P[rl * 8 + 4 + wc] = s1; } }
        asm volatile("s_waitcnt lgkmcnt(0)" ::: "memory"); __builtin_amdgcn_s_barrier(); asm volatile("" ::: "memory");
        const int cl = wc * 32 + 4 * fq;
        if (u.pn == 0) {
            f32x4 g[2][2];
#pragma unroll
            for (int bj = 0; bj < 2; ++bj)
#pragma unroll
                for (int n = 0; n < 2; ++n) g[bj][n] = *(const f32x4*)(qag + bj * HALF + cl + 16 * n);
#pragma unroll
            for (int ai = 0; ai < 2; ++ai)
#pragma unroll
                for (int m = 0; m < 4; ++m) { const int rl = ai * HALF + wr * 64 + m * 16 + fr; const f32x4 pa = *(const PG8_LAS f32x4*)(P + rl * 8), pb = *(const PG8_LAS f32x4*)(P + rl * 8 + 4);
                    const float r = __builtin_amdgcn_rsqf((((pa[0] + pa[1]) + (pa[2] + pa[3])) + ((pb[0] + pb[1]) + (pb[2] + pb[3]))) * (1.f / 256.f) + 1e-6f);
                    unsigned char* rowp = CQN + (size_t)(row0 + ai * HALF + m * 16) * 256 + cl;
#pragma unroll
                    for (int bj = 0; bj < 2; ++bj)
#pragma unroll
                        for (int n = 0; n < 2; ++n) { const f32x4 v = acc[ai][bj][m][n] * r * g[bj][n]; int p = 0; p = __builtin_amdgcn_cvt_pk_fp8_f32(v[0], v[1], p, false); p = __builtin_amdgcn_cvt_pk_fp8_f32(v[2], v[3], p, true); *(int*)(rowp + bj * HALF + 16 * n) = p; } }
        } else {
            f32x4 gk[2], gp[2]; const int e0 = 16 * (wc & 1) + 4 * fq;
#pragma unroll
            for (int n = 0; n < 2; ++n) { gk[n] = *(const f32x4*)(kvag + cl + 16 * n); gp[n] = *(const f32x4*)(kng + 128 + e0 + 32 * n); }
#pragma unroll
            for (int ai = 0; ai < 2; ++ai)
#pragma unroll
                for (int m = 0; m < 4; ++m) { const int rl = ai * HALF + wr * 64 + m * 16 + fr; const f32x4 pa = *(const PG8_LAS f32x4*)(P + rl * 8), pb = *(const PG8_LAS f32x4*)(P + rl * 8 + 4);
                    const float rkv = __builtin_amdgcn_rsqf(((pa[0] + pa[1]) + (pa[2] + pa[3])) * (1.f / 128.f) + 1e-6f), rpe = __builtin_amdgcn_rsqf((pb[0] + pb[1]) * (1.f / 64.f) + 1e-6f);
                    const size_t row = (size_t)(row0 + ai * HALF + m * 16);
#pragma unroll
                    for (int n = 0; n < 2; ++n) { const f32x4 v = acc[ai][0][m][n] * rkv * gk[n]; u32x2 w; w.x = cvt_pk_bf16(v[0], v[1]); w.y = cvt_pk_bf16(v[2], v[3]); *(u32x2*)(CKVN + row * 128 + cl + 16 * n) = w; }
                    if (wc < 2) { const f32x4 x1 = acc[ai][1][m][0] * rpe * gp[0], x2 = acc[ai][1][m][1] * rpe * gp[1];
                        const f32x4 c0 = *(const f32x4*)(rope + row * 64 + e0 * 2), c1 = *(const f32x4*)(rope + row * 64 + e0 * 2 + 4);
                        const float cs[4] = {c0[0], c0[2], c1[0], c1[2]}, sn[4] = {c0[1], c0[3], c1[1], c1[3]};
                        float o1[4], o2[4];
#pragma unroll
                        for (int j = 0; j < 4; ++j) { o1[j] = x1[j] * cs[j] - x2[j] * sn[j]; o2[j] = x1[j] * sn[j] + x2[j] * cs[j]; }
                        int w1 = 0, w2 = 0; w1 = __builtin_amdgcn_cvt_pk_fp8_f32(o1[0], o1[1], w1, false); w1 = __builtin_amdgcn_cvt_pk_fp8_f32(o1[2], o1[3], w1, true); w2 = __builtin_amdgcn_cvt_pk_fp8_f32(o2[0], o2[1], w2, false); w2 = __builtin_amdgcn_cvt_pk_fp8_f32(o2[2], o2[3], w2, true);
                        *(int*)(KPE + row * 64 + e0) = w1; *(int*)(KPE + row * 64 + 32 + e0) = w2; }
                    asm volatile("" ::: "memory"); }
        }
        asm volatile("s_waitcnt lgkmcnt(0)" ::: "memory"); __builtin_amdgcn_s_barrier(); asm volatile("" ::: "memory");
    }
};
struct EpiK8 {
    static constexpr bool PERM = true, AFTER_DRAIN = false;
    unsigned char* K8; const float* kng; PG8_LAS float* P;
    __device__ __forceinline__ void operator()(const f32x4 (&acc)[2][2][4][2], const Unit& u, int wr, int wc, int, int) const {
        int ln = (int)__builtin_amdgcn_mbcnt_hi(~0u, __builtin_amdgcn_mbcnt_lo(~0u, 0u)); asm volatile("" : "+v"(ln)); const int fr = ln & 15, fq = ln >> 4;
#pragma unroll
        for (int ai = 0; ai < 2; ++ai)
#pragma unroll
            for (int m = 0; m < 4; ++m) {
#pragma unroll
                for (int bj = 0; bj < 2; ++bj) { const f32x4 a = acc[ai][bj][m][0], b = acc[ai][bj][m][1];
                    float s = (a[0] * a[0] + a[1] * a[1]) + (a[2] * a[2] + a[3] * a[3]) + (b[0] * b[0] + b[1] * b[1]) + (b[2] * b[2] + b[3] * b[3]);
                    s += __shfl_xor(s, 16); s += __shfl_xor(s, 32);
                    if (fq == 0) P[(ai * HALF + wr * 64 + m * 16 + fr) * 8 + bj * 4 + wc] = s; } }
        asm volatile("s_waitcnt lgkmcnt(0)" ::: "memory"); __builtin_amdgcn_s_barrier(); asm volatile("" ::: "memory");
        const f32x4 g0 = *(const f32x4*)(kng + wc * 32 + 8 * fq), g1 = *(const f32x4*)(kng + wc * 32 + 8 * fq + 4);
        const int row0 = u.pm * BM + wr * 64 + fr;
#pragma unroll
        for (int ai = 0; ai < 2; ++ai)
#pragma unroll
            for (int m = 0; m < 4; ++m) { const int rl = ai * HALF + wr * 64 + m * 16 + fr;
#pragma unroll
                for (int bj = 0; bj < 2; ++bj) { const f32x4 p4 = *(const PG8_LAS f32x4*)(P + rl * 8 + bj * 4);
                    const float r = __builtin_amdgcn_rsqf(((p4[0] + p4[1]) + (p4[2] + p4[3])) * (1.f / 128.f) + 1e-6f);
                    const f32x4 v0 = acc[ai][bj][m][0] * r * g0, v1 = acc[ai][bj][m][1] * r * g1;
                    int w0 = 0, w1 = 0; w0 = __builtin_amdgcn_cvt_pk_fp8_f32(v0[0], v0[1], w0, false); w0 = __builtin_amdgcn_cvt_pk_fp8_f32(v0[2], v0[3], w0, true); w1 = __builtin_amdgcn_cvt_pk_fp8_f32(v1[0], v1[1], w1, false); w1 = __builtin_amdgcn_cvt_pk_fp8_f32(v1[2], v1[3], w1, true);
                    u32x2 w; w.x = (unsigned)w0; w.y = (unsigned)w1; *(u32x2*)(K8 + ((size_t)(row0 + ai * HALF + m * 16) * 8 + 2 * u.pn + bj) * 128 + wc * 32 + 8 * fq) = w; } }
        asm volatile("s_waitcnt lgkmcnt(0)" ::: "memory"); __builtin_amdgcn_s_barrier(); asm volatile("" ::: "memory");
    }
};
struct EpiF8T {
    static constexpr bool PERM = true, AFTER_DRAIN = false;
    unsigned char* O; int ldc;
    __device__ __forceinline__ void operator()(const f32x4 (&acc)[2][2][4][2], const Unit& u, int wr, int wc, int fr, int fq) const {
        const int row0 = u.pm * BM + wr * 64 + fr, col0 = u.pn * BM + wc * 32 + 8 * fq;
#pragma unroll
        for (int ai = 0; ai < 2; ++ai)
#pragma unroll
            for (int m = 0; m < 4; ++m) { unsigned char* rowp = O + (size_t)(row0 + ai * HALF + m * 16) * ldc + col0;
#pragma unroll
                for (int bj = 0; bj < 2; ++bj) { const f32x4 v0 = acc[ai][bj][m][0], v1 = acc[ai][bj][m][1];
                    int w0 = 0, w1 = 0; w0 = __builtin_amdgcn_cvt_pk_fp8_f32(v0[0], v0[1], w0, false); w0 = __builtin_amdgcn_cvt_pk_fp8_f32(v0[2], v0[3], w0, true); w1 = __builtin_amdgcn_cvt_pk_fp8_f32(v1[0], v1[1], w1, false); w1 = __builtin_amdgcn_cvt_pk_fp8_f32(v1[2], v1[3], w1, true);
                    u32x2 w; w.x = (unsigned)w0; w.y = (unsigned)w1; *(u32x2*)(rowp + bj * HALF) = w; } }
    }
};
__device__ __forceinline__ void pair_of(int pi, int& i, int& j) { i = pi < 3 ? 0 : (pi < 5 ? 1 : 2); j = pi < 3 ? pi + 1 : (pi < 5 ? pi - 1 : 3); }
struct MoeOrder {
    const PG8_LAS int* tinfo; int G, c, mode; const int* list;
    __device__ __forceinline__ int tok(const Unit& u, int r) const { const int bk = tinfo[1 + u.pm], pos = u.pm * BM - tinfo[256 + bk] + r; return list[bk * 32768 + (pos < tinfo[288 + bk] ? pos : 0)]; }
    __device__ __forceinline__ bool next(int i, Unit& u) const {
        const long L = (long)i * G + c; const int nt = tinfo[0]; if (L >= 4L * nt) return false;
        const int mt = (int)(L >> 2), q = (int)(L & 3), bk = tinfo[1 + mt];
        u.pm = mt;
        if (mode == 0) { int ii, jj; pair_of(bk % 6, ii, jj); const int e = (bk / 6) * 4 + ((q >> 1) ? jj : ii); u.pn = e * 2 + (q & 1); }
        else u.pn = bk * 4 + q;
        return true;
    }
    __device__ __forceinline__ void a_ready(const Unit&) const {}
    __device__ __forceinline__ void done(const Unit&) const {}
};
struct EpiSwiGLU {
    static constexpr bool PERM = true, AFTER_DRAIN = false;
    unsigned char* H; const float* wl; const PG8_LAS int* tinfo;
    __device__ __forceinline__ void operator()(const f32x4 (&acc)[2][2][4][2], const Unit& u, int wr, int wc, int, int) const {
        int ln = (int)__builtin_amdgcn_mbcnt_hi(~0u, __builtin_amdgcn_mbcnt_lo(~0u, 0u)); asm volatile("" : "+v"(ln)); const int fr = ln & 15, fq = ln >> 4;
        const int bk = tinfo[1 + u.pm]; int ii, jj; pair_of(bk % 6, ii, jj);
        const int e = u.pn >> 1, hh = u.pn & 1, slot = (e == (bk / 6) * 4 + jj) ? 1 : 0;
        const int row0 = u.pm * BM + wr * 64 + fr, col0 = slot * 256 + hh * 128 + wc * 32 + 8 * fq;
        float w8[8];
#pragma unroll
        for (int g = 0; g < 8; ++g) { const int pos = row0 + (g >> 2) * HALF + (g & 3) * 16 - tinfo[256 + bk]; w8[g] = pos < tinfo[288 + bk] ? 8.f * wl[((size_t)bk * 32768 + pos) * 2 + slot] : 0.f; }
#pragma unroll
        for (int ai = 0; ai < 2; ++ai)
#pragma unroll
            for (int m = 0; m < 4; ++m) { const int row = row0 + ai * HALF + m * 16; const float w = w8[ai * 4 + m];
                float a[8];
#pragma unroll
                for (int n = 0; n < 2; ++n)
#pragma unroll
                    for (int j = 0; j < 4; ++j) { const float g = acc[ai][0][m][n][j], up = acc[ai][1][m][n][j];
                        const float sg = g * __builtin_amdgcn_rcpf(1.0f + __builtin_amdgcn_exp2f(-1.4426950408889634f * g)); a[n * 4 + j] = sg * up * w; }
                int o0 = 0, o1 = 0; o0 = __builtin_amdgcn_cvt_pk_fp8_f32(a[0], a[1], o0, false); o0 = __builtin_amdgcn_cvt_pk_fp8_f32(a[2], a[3], o0, true);
                o1 = __builtin_amdgcn_cvt_pk_fp8_f32(a[4], a[5], o1, false); o1 = __builtin_amdgcn_cvt_pk_fp8_f32(a[6], a[7], o1, true);
                u32x2 o; o.x = (unsigned)o0; o.y = (unsigned)o1; *(u32x2*)(H + (size_t)row * 512 + col0) = o; }
    }
};
template <class TO> struct EpiMoeOut {
    static constexpr bool PERM = false, AFTER_DRAIN = false;
    const bf16_t* xr; TO* out; const float* gate; const int* list; const PG8_LAS int* tinfo; PG8_LAS float* gl;
    __device__ __forceinline__ void operator()(const f32x4 (&acc)[2][2][4][2], const Unit& u, int wr, int wc, int, int) const {
        int ln = (int)__builtin_amdgcn_mbcnt_hi(~0u, __builtin_amdgcn_mbcnt_lo(~0u, 0u)); asm volatile("" : "+v"(ln)); const int fr = ln & 15, fq = ln >> 4;
        const int bk = tinfo[1 + u.pm], r_beg = tinfo[256 + bk], r_end = r_beg + tinfo[288 + bk];
        const int row0 = u.pm * BM + wr * 64 + fr, colu = (u.pn & 3) * BM, cl = wc * 32 + 4 * fq;
        int tk[8];
#pragma unroll
        for (int g = 0; g < 8; ++g) { const int row = row0 + (g >> 2) * HALF + (g & 3) * 16; tk[g] = row < r_end ? list[bk * 32768 + row - r_beg] : -1; }
        { const int t = (wr * 4 + wc) * 64 + fq * 16 + fr; const f32x4 gs = *(const f32x4*)(gate + (size_t)(t >> 6) * 6144 + colu + (t & 63) * 4);
          *(PG8_LAS f32x4*)(gl + (t >> 6) * 256 + (t & 63) * 4) = gs; }
        asm volatile("s_waitcnt lgkmcnt(0)" ::: "memory"); __builtin_amdgcn_s_barrier();
#pragma unroll
        for (int g0 = 0; g0 < 8; g0 += 4) {
            u32x2 bs[4][2][2];
#pragma unroll
            for (int g = 0; g < 4; ++g) { const unsigned xo = (unsigned)((tk[g0 + g] < 0 ? 0 : tk[g0 + g]) * 1024 + colu + cl);
#pragma unroll
                for (int bj = 0; bj < 2; ++bj)
#pragma unroll
                    for (int n = 0; n < 2; ++n) bs[g][bj][n] = ldraw(xr + xo + bj * HALF + n * 16); }
#pragma unroll
            for (int g = 0; g < 4; ++g) { const int ai = (g0 + g) >> 2, m = (g0 + g) & 3, tkg = tk[g0 + g];
                if (tkg >= 0) { TO* op = out + (size_t)tkg * 1024 + colu + cl; const PG8_LAS float* gp = gl + (tkg >> 12) * 256 + cl;
#pragma unroll
                    for (int bj = 0; bj < 2; ++bj)
#pragma unroll
                        for (int n = 0; n < 2; ++n) { const f32x4 gv = *(const PG8_LAS f32x4*)(gp + bj * HALF + n * 16); st4(op + bj * HALF + n * 16, cvraw(bs[g][bj][n]) + gv * acc[ai][bj][m][n]); } } }
            asm volatile("" ::: "memory"); }
    }
};
template <class Epi, class Sched, bool ALIGN_EPI = false, bool SP2 = false, int F8 = -1>
__device__ __forceinline__ void gemm_phase(PG8_LAS unsigned char* lds, const Gemm g, const Sched& S, const Epi& E, const int tid_in) {
    int tid = tid_in; asm volatile("" : "+v"(tid));
    const int wid = __builtin_amdgcn_readfirstlane(tid >> 6), lane = tid & 63, wr = wid >> 2, wc = wid & 3, fr = lane & 15, fq = lane >> 4;
    int K = g.K; asm volatile("" : "+s"(K)); const int nt = K / BK;
    unsigned voffA[2], voffB[2];
#pragma unroll
    for (int i = 0; i < 2; ++i) { int R, C; stage_rc(tid * 16 + i * 8192, R, C); const int Rb = Epi::PERM ? ((R & ~31) + perm32(R & 31)) : R;
        voffA[i] = (unsigned)(R * K + C) * 2u; voffB[i] = (unsigned)(Rb * K + C) * 2u; }
    const size_t kstep = (size_t)(BK * 2);
    const size_t hstep = (size_t)HALF * K * 2;
    const size_t tstep = 2 * hstep;
    const unsigned ldsw = (unsigned)wid * 1024u;
    const int aoff = lds_byte(wr * 64 + fr, fq * 8), boff = lds_byte(wc * 32 + fr, fq * 8);
#define PG8_SA(b, h) (((b) * 2 + (h)) * HTB)
#define PG8_SB(b, h) ((4 + (b) * 2 + (h)) * HTB)
#define PG8_STAGE(bufoff, gbase, voff) do { _Pragma("unroll") for (int _i = 0; _i < 2; ++_i) { unsigned vo_ = (voff)[_i]; asm volatile("" : "+v"(vo_));   \
        __builtin_amdgcn_global_load_lds((const unsigned*)((const char*)(gbase) + vo_), (PG8_LAS unsigned*)(lds + (bufoff) + ldsw + _i * 8192), 16, 0, 0); } } while (0)
#define PG8_LDA(dst, b, h) do { _Pragma("unroll") for (int m = 0; m < 4; ++m) { const bf16x8 x0_ = *(const PG8_LAS bf16x8*)(lds + PG8_SA(b, h) + aoff + m * 2048), x1_ = *(const PG8_LAS bf16x8*)(lds + PG8_SA(b, h) + aoff + m * 2048 + 1024); \
        if constexpr (F8 >= 0) dst##8[m] = PG8_CAT(x0_, x1_); else { dst[m][0] = x0_; dst[m][1] = x1_; } } } while (0)
#define PG8_LDB(dst, b, h) do { _Pragma("unroll") for (int n = 0; n < 2; ++n) { const bf16x8 x0_ = *(const PG8_LAS bf16x8*)(lds + PG8_SB(b, h) + boff + n * 2048), x1_ = *(const PG8_LAS bf16x8*)(lds + PG8_SB(b, h) + boff + n * 2048 + 1024); \
        if constexpr (F8 >= 0) dst##8[n] = PG8_CAT(x0_, x1_); else { dst[n][0] = x0_; dst[n][1] = x1_; } } } while (0)
#define PG8_CAT(x0, x1) ({ const v4i_t lo_ = __builtin_bit_cast(v4i_t, x0), hi_ = __builtin_bit_cast(v4i_t, x1); (v8i_t){lo_[0], lo_[1], lo_[2], lo_[3], hi_[0], hi_[1], hi_[2], hi_[3]}; })
#define PG8_MMA(ai, bj, At, Bt) do { __builtin_amdgcn_s_setprio(1); _Pragma("unroll") for (int m = 0; m < 4; ++m) _Pragma("unroll") for (int n = 0; n < 2; ++n) { \
        if constexpr (F8 >= 0) acc[ai][bj][m][n] = __builtin_amdgcn_mfma_scale_f32_16x16x128_f8f6f4(Bt##8[n], At##8[m], acc[ai][bj][m][n], 0, 0, 0, 0x7f7f7f7f, 0, (127 - F8) * 0x01010101); \
        else { _Pragma("unroll") for (int k = 0; k < 2; ++k) acc[ai][bj][m][n] = __builtin_amdgcn_mfma_f32_16x16x32_bf16(Bt[n][k], At[m][k], acc[ai][bj][m][n], 0, 0, 0); } } \
        __builtin_amdgcn_s_setprio(0); } while (0)
#define PG8_WAIT_V(n) asm volatile("s_waitcnt vmcnt(" #n ")" ::: "memory")
#define PG8_WAIT_L(n) asm volatile("s_waitcnt lgkmcnt(" #n ")" ::: "memory")
#define PG8_BAR __builtin_amdgcn_s_barrier()
#define PG8_SCHED __builtin_amdgcn_sched_barrier(0)
    Unit cur, nxt; int ui = 0;
    if (!S.next(0, cur)) return;
    f32x4 acc[2][2][4][2];
#pragma unroll
    for (int a = 0; a < 2; ++a)
#pragma unroll
        for (int b = 0; b < 2; ++b)
#pragma unroll
            for (int m = 0; m < 4; ++m)
#pragma unroll
                for (int n = 0; n < 2; ++n) acc[a][b][m][n] = (f32x4){0.f, 0.f, 0.f, 0.f};
    bf16x8 At[4][2], B0[2][2], B1[2][2]; v8i_t At8[4], B08[2], B18[2];
    const char* cA = (const char*)g.A + (size_t)cur.pm * tstep; const char* cB = (const char*)g.Bt + (size_t)cur.pn * tstep;
    S.a_ready(cur);
    if constexpr (SP2) {
        PG8_STAGE(PG8_SB(0, 0), cB, voffB); PG8_STAGE(PG8_SB(0, 1), cB + hstep, voffB); PG8_STAGE(PG8_SA(0, 0), cA, voffA); PG8_STAGE(PG8_SA(0, 1), cA + hstep, voffA);
        if (wr == 1) PG8_BAR;
        PG8_WAIT_V(2); PG8_BAR;
        PG8_STAGE(PG8_SB(1, 0), cB + kstep, voffB); PG8_STAGE(PG8_SA(1, 0), cA + kstep, voffA); PG8_STAGE(PG8_SB(1, 1), cB + hstep + kstep, voffB);
        PG8_WAIT_V(6); PG8_BAR;
    } else {
        PG8_STAGE(PG8_SB(0, 0), cB, voffB); PG8_STAGE(PG8_SA(0, 0), cA, voffA); PG8_STAGE(PG8_SB(0, 1), cB + hstep, voffB); PG8_STAGE(PG8_SA(0, 1), cA + hstep, voffA);
        if (wr == 1) PG8_BAR;
        PG8_WAIT_V(4); PG8_BAR;
        PG8_STAGE(PG8_SB(1, 0), cB + kstep, voffB); PG8_STAGE(PG8_SA(1, 0), cA + kstep, voffA); PG8_STAGE(PG8_SB(1, 1), cB + hstep + kstep, voffB);
        PG8_WAIT_V(6); PG8_BAR;
    }
    for (;;) {
        const bool has_next = S.next(ui + 1, nxt);
        const char* nA = has_next ? (const char*)g.A + (size_t)nxt.pm * tstep : cA; const char* nB = has_next ? (const char*)g.Bt + (size_t)nxt.pn * tstep : cB;
        for (int t = 0; t < nt; t += 2) {
            const bool last = (t == nt - 2);
            const char* a1 = cA + (size_t)(t + 1) * kstep;
            const char* a2 = last ? nA : cA + (size_t)(t + 2) * kstep; const char* b2 = last ? nB : cB + (size_t)(t + 2) * kstep;
            const char* a3 = a2 + kstep; const char* b3 = b2 + kstep;
            if (last && has_next) S.a_ready(nxt);
            if constexpr (SP2) {
            PG8_LDB(B0, 0, 0); PG8_LDB(B1, 0, 1); PG8_SCHED; PG8_LDA(At, 0, 0); PG8_STAGE(PG8_SA(1, 1), a1 + hstep, voffA);
            PG8_WAIT_V(8); PG8_WAIT_L(0); PG8_BAR; PG8_MMA(0, 0, At, B0); PG8_MMA(0, 1, At, B1); PG8_BAR; PG8_SCHED;
            PG8_LDA(At, 0, 1); PG8_STAGE(PG8_SB(0, 0), b2, voffB); PG8_STAGE(PG8_SB(0, 1), b2 + hstep, voffB); PG8_STAGE(PG8_SA(0, 0), a2, voffA);
            PG8_WAIT_V(8); PG8_WAIT_L(0); PG8_BAR; PG8_MMA(1, 0, At, B0); PG8_MMA(1, 1, At, B1); PG8_BAR; PG8_SCHED;
            PG8_LDB(B0, 1, 0); PG8_LDB(B1, 1, 1); PG8_SCHED; PG8_LDA(At, 1, 0); PG8_STAGE(PG8_SA(0, 1), a2 + hstep, voffA);
            PG8_WAIT_V(8); PG8_WAIT_L(0); PG8_BAR; PG8_MMA(0, 0, At, B0); PG8_MMA(0, 1, At, B1); PG8_BAR; PG8_SCHED;
            PG8_LDA(At, 1, 1); PG8_STAGE(PG8_SB(1, 0), b3, voffB); PG8_STAGE(PG8_SB(1, 1), b3 + hstep, voffB); PG8_STAGE(PG8_SA(1, 0), a3, voffA);
            PG8_WAIT_V(8); PG8_WAIT_L(0); PG8_BAR; PG8_MMA(1, 0, At, B0); PG8_MMA(1, 1, At, B1); PG8_BAR; PG8_SCHED;
            } else {
            PG8_LDB(B0, 0, 0); PG8_SCHED; PG8_LDA(At, 0, 0); PG8_STAGE(PG8_SA(1, 1), a1 + hstep, voffA);
            PG8_WAIT_L(8); PG8_BAR; PG8_WAIT_L(0); PG8_MMA(0, 0, At, B0); PG8_BAR; PG8_SCHED;
            PG8_LDB(B1, 0, 1); PG8_STAGE(PG8_SB(0, 0), b2, voffB);
            PG8_BAR; PG8_WAIT_L(0); PG8_MMA(0, 1, At, B1); PG8_BAR;
            PG8_LDA(At, 0, 1); PG8_STAGE(PG8_SA(0, 0), a2, voffA);
            PG8_BAR; PG8_WAIT_L(0); PG8_MMA(1, 0, At, B0); PG8_BAR; PG8_SCHED;
            PG8_STAGE(PG8_SB(0, 1), b2 + hstep, voffB);
            PG8_WAIT_V(6); PG8_BAR; PG8_MMA(1, 1, At, B1); PG8_BAR;
            PG8_LDB(B0, 1, 0); PG8_SCHED; PG8_LDA(At, 1, 0); PG8_STAGE(PG8_SA(0, 1), a2 + hstep, voffA);
            PG8_WAIT_L(8); PG8_BAR; PG8_WAIT_L(0); PG8_MMA(0, 0, At, B0); PG8_BAR; PG8_SCHED;
            PG8_LDB(B1, 1, 1); PG8_STAGE(PG8_SB(1, 0), b3, voffB);
            PG8_BAR; PG8_WAIT_L(0); PG8_MMA(0, 1, At, B1); PG8_BAR;
            PG8_LDA(At, 1, 1); PG8_STAGE(PG8_SA(1, 0), a3, voffA);
            PG8_BAR; PG8_WAIT_L(0); PG8_MMA(1, 0, At, B0); PG8_BAR; PG8_SCHED;
            PG8_STAGE(PG8_SB(1, 1), b3 + hstep, voffB);
            PG8_WAIT_V(6); PG8_BAR; PG8_MMA(1, 1, At, B1); PG8_BAR;
            }
        }
        if constexpr (ALIGN_EPI) { if (wr == 0) PG8_BAR; }
        if constexpr (!Epi::AFTER_DRAIN) { E(acc, cur, wr, wc, fr, fq); S.done(cur); }
        if (!has_next) break;
#pragma unroll
        for (int a = 0; a < 2; ++a)
#pragma unroll
            for (int b = 0; b < 2; ++b)
#pragma unroll
                for (int m = 0; m < 4; ++m)
#pragma unroll
                    for (int n = 0; n < 2; ++n) acc[a][b][m][n] = (f32x4){0.f, 0.f, 0.f, 0.f};
        cur = nxt; cA = nA; cB = nB; ++ui;
        if constexpr (ALIGN_EPI) { if (wr == 1) PG8_BAR; }
    }
    PG8_WAIT_V(0);
    if constexpr (!ALIGN_EPI) { if (wr == 0) PG8_BAR; }
    PG8_BAR;
    if constexpr (Epi::AFTER_DRAIN) { E.fused(acc, cur, wr, wc, fr, fq, lds, wid, lane); S.done(cur); }
#undef PG8_SA
#undef PG8_SB
#undef PG8_STAGE
#undef PG8_LDA
#undef PG8_LDB
#undef PG8_MMA
#undef PG8_WAIT_V
#undef PG8_WAIT_L
#undef PG8_BAR
#undef PG8_SCHED
}
template <class Epi, class Sched, bool ALIGN_EPI = true, bool SP2 = true, int F8 = -1>
__device__ __forceinline__ void gemm_phase_gather(PG8_LAS unsigned char* lds, const Gemm g, const Sched& S, const Epi& E, const int tid_in) {
    int tid = tid_in; asm volatile("" : "+v"(tid));
    static_assert(SP2, "gather form: SP2 loop only");
    const int wid = __builtin_amdgcn_readfirstlane(tid >> 6), lane = tid & 63, wr = wid >> 2, wc = wid & 3, fr = lane & 15, fq = lane >> 4;
    int K = g.K; asm volatile("" : "+s"(K)); const int nt = K / BK;
    unsigned voffA[2], voffB[2];
#pragma unroll
    for (int i = 0; i < 2; ++i) { int R, C; stage_rc(tid * 16 + i * 8192, R, C); const int Rb = Epi::PERM ? ((R & ~31) + perm32(R & 31)) : R;
        voffA[i] = (unsigned)(R * K + C) * 2u; voffB[i] = (unsigned)(Rb * K + C) * 2u; }
    int gR, gC; stage_rc(tid * 16, gR, gC);
    unsigned vG[2][2], vN[2][2];
    const size_t kstep = (size_t)(BK * 2);
    const size_t hstep = (size_t)HALF * K * 2;
    const size_t tstep = 2 * hstep;
    const unsigned ldsw = (unsigned)wid * 1024u;
    const int aoff = lds_byte(wr * 64 + fr, fq * 8), boff = lds_byte(wc * 32 + fr, fq * 8);
#define PG8_SA(b, h) (((b) * 2 + (h)) * HTB)
#define PG8_SB(b, h) ((4 + (b) * 2 + (h)) * HTB)
#define PG8_STAGE(bufoff, gbase, voff) do { _Pragma("unroll") for (int _i = 0; _i < 2; ++_i) { unsigned vo_ = (voff)[_i]; asm volatile("" : "+v"(vo_));   \
        __builtin_amdgcn_global_load_lds((const unsigned*)((const char*)(gbase) + vo_), (PG8_LAS unsigned*)(lds + (bufoff) + ldsw + _i * 8192), 16, 0, 0); } } while (0)
#define PG8_LDA(dst, b, h) do { _Pragma("unroll") for (int m = 0; m < 4; ++m) { const bf16x8 x0_ = *(const PG8_LAS bf16x8*)(lds + PG8_SA(b, h) + aoff + m * 2048), x1_ = *(const PG8_LAS bf16x8*)(lds + PG8_SA(b, h) + aoff + m * 2048 + 1024); \
        if constexpr (F8 >= 0) dst##8[m] = PG8_CAT(x0_, x1_); else { dst[m][0] = x0_; dst[m][1] = x1_; } } } while (0)
#define PG8_LDB(dst, b, h) do { _Pragma("unroll") for (int n = 0; n < 2; ++n) { const bf16x8 x0_ = *(const PG8_LAS bf16x8*)(lds + PG8_SB(b, h) + boff + n * 2048), x1_ = *(const PG8_LAS bf16x8*)(lds + PG8_SB(b, h) + boff + n * 2048 + 1024); \
        if constexpr (F8 >= 0) dst##8[n] = PG8_CAT(x0_, x1_); else { dst[n][0] = x0_; dst[n][1] = x1_; } } } while (0)
#define PG8_CAT(x0, x1) ({ const v4i_t lo_ = __builtin_bit_cast(v4i_t, x0), hi_ = __builtin_bit_cast(v4i_t, x1); (v8i_t){lo_[0], lo_[1], lo_[2], lo_[3], hi_[0], hi_[1], hi_[2], hi_[3]}; })
#define PG8_MMA(ai, bj, At, Bt) do { __builtin_amdgcn_s_setprio(1); _Pragma("unroll") for (int m = 0; m < 4; ++m) _Pragma("unroll") for (int n = 0; n < 2; ++n) { \
        if constexpr (F8 >= 0) acc[ai][bj][m][n] = __builtin_amdgcn_mfma_scale_f32_16x16x128_f8f6f4(Bt##8[n], At##8[m], acc[ai][bj][m][n], 0, 0, 0, 0x7f7f7f7f, 0, (127 - F8) * 0x01010101); \
        else { _Pragma("unroll") for (int k = 0; k < 2; ++k) acc[ai][bj][m][n] = __builtin_amdgcn_mfma_f32_16x16x32_bf16(Bt[n][k], At[m][k], acc[ai][bj][m][n], 0, 0, 0); } } \
        __builtin_amdgcn_s_setprio(0); } while (0)
#define PG8_WAIT_V(n) asm volatile("s_waitcnt vmcnt(" #n ")" ::: "memory")
#define PG8_WAIT_L(n) asm volatile("s_waitcnt lgkmcnt(" #n ")" ::: "memory")
#define PG8_BAR __builtin_amdgcn_s_barrier()
#define PG8_SCHED __builtin_amdgcn_sched_barrier(0)
    Unit cur, nxt; int ui = 0;
    if (!S.next(0, cur)) return;
    f32x4 acc[2][2][4][2];
#pragma unroll
    for (int a = 0; a < 2; ++a)
#pragma unroll
        for (int b = 0; b < 2; ++b)
#pragma unroll
            for (int m = 0; m < 4; ++m)
#pragma unroll
                for (int n = 0; n < 2; ++n) acc[a][b][m][n] = (f32x4){0.f, 0.f, 0.f, 0.f};
    bf16x8 At[4][2], B0[2][2], B1[2][2]; v8i_t At8[4], B08[2], B18[2];
    const char* cA = (const char*)g.A; const char* cB = (const char*)g.Bt + (size_t)cur.pn * tstep;
    S.a_ready(cur);
#pragma unroll
    for (int h = 0; h < 2; ++h)
#pragma unroll
        for (int i = 0; i < 2; ++i) vG[h][i] = (unsigned)S.tok(cur, h * HALF + gR + 64 * i) * (unsigned)(K * 2) + (unsigned)(gC * 2);
    if constexpr (SP2) {
        PG8_STAGE(PG8_SB(0, 0), cB, voffB); PG8_STAGE(PG8_SB(0, 1), cB + hstep, voffB); PG8_STAGE(PG8_SA(0, 0), cA, vG[0]); PG8_STAGE(PG8_SA(0, 1), cA, vG[1]);
        if (wr == 1) PG8_BAR;
        PG8_WAIT_V(2); PG8_BAR;
        PG8_STAGE(PG8_SB(1, 0), cB + kstep, voffB); PG8_STAGE(PG8_SA(1, 0), cA + kstep, vG[0]); PG8_STAGE(PG8_SB(1, 1), cB + hstep + kstep, voffB);
        PG8_WAIT_V(6); PG8_BAR;
    } else {
        PG8_STAGE(PG8_SB(0, 0), cB, voffB); PG8_STAGE(PG8_SA(0, 0), cA, voffA); PG8_STAGE(PG8_SB(0, 1), cB + hstep, voffB); PG8_STAGE(PG8_SA(0, 1), cA + hstep, voffA);
        if (wr == 1) PG8_BAR;
        PG8_WAIT_V(4); PG8_BAR;
        PG8_STAGE(PG8_SB(1, 0), cB + kstep, voffB); PG8_STAGE(PG8_SA(1, 0), cA + kstep, voffA); PG8_STAGE(PG8_SB(1, 1), cB + hstep + kstep, voffB);
        PG8_WAIT_V(6); PG8_BAR;
    }
    for (;;) {
        const bool has_next = S.next(ui + 1, nxt);
        const char* nA = cA; const char* nB = has_next ? (const char*)g.Bt + (size_t)nxt.pn * tstep : cB;
        for (int t = 0; t < nt; t += 2) {
            const bool last = (t == nt - 2);
            const char* a1 = cA + (size_t)(t + 1) * kstep;
            const char* a2 = last ? nA : cA + (size_t)(t + 2) * kstep; const char* b2 = last ? nB : cB + (size_t)(t + 2) * kstep;
            const char* a3 = a2 + kstep; const char* b3 = b2 + kstep;
            if (last && has_next) { S.a_ready(nxt);
#pragma unroll
                for (int h = 0; h < 2; ++h)
#pragma unroll
                    for (int i = 0; i < 2; ++i) vN[h][i] = (unsigned)S.tok(nxt, h * HALF + gR + 64 * i) * (unsigned)(K * 2) + (unsigned)(gC * 2); }
            if constexpr (SP2) {
            PG8_LDB(B0, 0, 0); PG8_LDB(B1, 0, 1); PG8_SCHED; PG8_LDA(At, 0, 0); PG8_STAGE(PG8_SA(1, 1), a1, vG[1]);
            if (last && has_next) { vG[0][0] = vN[0][0]; vG[0][1] = vN[0][1]; vG[1][0] = vN[1][0]; vG[1][1] = vN[1][1]; }
            PG8_WAIT_V(8); PG8_WAIT_L(0); PG8_BAR; PG8_MMA(0, 0, At, B0); PG8_MMA(0, 1, At, B1); PG8_BAR; PG8_SCHED;
            PG8_LDA(At, 0, 1); PG8_STAGE(PG8_SB(0, 0), b2, voffB); PG8_STAGE(PG8_SB(0, 1), b2 + hstep, voffB); PG8_STAGE(PG8_SA(0, 0), a2, vG[0]);
            PG8_WAIT_V(8); PG8_WAIT_L(0); PG8_BAR; PG8_MMA(1, 0, At, B0); PG8_MMA(1, 1, At, B1); PG8_BAR; PG8_SCHED;
            PG8_LDB(B0, 1, 0); PG8_LDB(B1, 1, 1); PG8_SCHED; PG8_LDA(At, 1, 0); PG8_STAGE(PG8_SA(0, 1), a2, vG[1]);
            PG8_WAIT_V(8); PG8_WAIT_L(0); PG8_BAR; PG8_MMA(0, 0, At, B0); PG8_MMA(0, 1, At, B1); PG8_BAR; PG8_SCHED;
            PG8_LDA(At, 1, 1); PG8_STAGE(PG8_SB(1, 0), b3, voffB); PG8_STAGE(PG8_SB(1, 1), b3 + hstep, voffB); PG8_STAGE(PG8_SA(1, 0), a3, vG[0]);
            PG8_WAIT_V(8); PG8_WAIT_L(0); PG8_BAR; PG8_MMA(1, 0, At, B0); PG8_MMA(1, 1, At, B1); PG8_BAR; PG8_SCHED;
            } else {
            PG8_LDB(B0, 0, 0); PG8_SCHED; PG8_LDA(At, 0, 0); PG8_STAGE(PG8_SA(1, 1), a1 + hstep, voffA);
            PG8_WAIT_L(8); PG8_BAR; PG8_WAIT_L(0); PG8_MMA(0, 0, At, B0); PG8_BAR; PG8_SCHED;
            PG8_LDB(B1, 0, 1); PG8_STAGE(PG8_SB(0, 0), b2, voffB);
            PG8_BAR; PG8_WAIT_L(0); PG8_MMA(0, 1, At, B1); PG8_BAR;
            PG8_LDA(At, 0, 1); PG8_STAGE(PG8_SA(0, 0), a2, voffA);
            PG8_BAR; PG8_WAIT_L(0); PG8_MMA(1, 0, At, B0); PG8_BAR; PG8_SCHED;
            PG8_STAGE(PG8_SB(0, 1), b2 + hstep, voffB);
            PG8_WAIT_V(6); PG8_BAR; PG8_MMA(1, 1, At, B1); PG8_BAR;
            PG8_LDB(B0, 1, 0); PG8_SCHED; PG8_LDA(At, 1, 0); PG8_STAGE(PG8_SA(0, 1), a2 + hstep, voffA);
            PG8_WAIT_L(8); PG8_BAR; PG8_WAIT_L(0); PG8_MMA(0, 0, At, B0); PG8_BAR; PG8_SCHED;
            PG8_LDB(B1, 1, 1); PG8_STAGE(PG8_SB(1, 0), b3, voffB);
            PG8_BAR; PG8_WAIT_L(0); PG8_MMA(0, 1, At, B1); PG8_BAR;
            PG8_LDA(At, 1, 1); PG8_STAGE(PG8_SA(1, 0), a3, voffA);
            PG8_BAR; PG8_WAIT_L(0); PG8_MMA(1, 0, At, B0); PG8_BAR; PG8_SCHED;
            PG8_STAGE(PG8_SB(1, 1), b3 + hstep, voffB);
            PG8_WAIT_V(6); PG8_BAR; PG8_MMA(1, 1, At, B1); PG8_BAR;
            }
        }
        if constexpr (ALIGN_EPI) { if (wr == 0) PG8_BAR; }
        if constexpr (!Epi::AFTER_DRAIN) { E(acc, cur, wr, wc, fr, fq); S.done(cur); }
        if (!has_next) break;
#pragma unroll
        for (int a = 0; a < 2; ++a)
#pragma unroll
            for (int b = 0; b < 2; ++b)
#pragma unroll
                for (int m = 0; m < 4; ++m)
#pragma unroll
                    for (int n = 0; n < 2; ++n) acc[a][b][m][n] = (f32x4){0.f, 0.f, 0.f, 0.f};
        cur = nxt; cA = nA; cB = nB; ++ui;
        if constexpr (ALIGN_EPI) { if (wr == 1) PG8_BAR; }
    }
    PG8_WAIT_V(0);
    if constexpr (!ALIGN_EPI) { if (wr == 0) PG8_BAR; }
    PG8_BAR;
    if constexpr (Epi::AFTER_DRAIN) { E.fused(acc, cur, wr, wc, fr, fq, lds, wid, lane); S.done(cur); }
#undef PG8_SA
#undef PG8_SB
#undef PG8_STAGE
#undef PG8_LDA
#undef PG8_LDB
#undef PG8_MMA
#undef PG8_WAIT_V
#undef PG8_WAIT_L
#undef PG8_BAR
#undef PG8_SCHED
}
}
namespace att {
typedef unsigned short bf16;
using bf16x8 = __attribute__((ext_vector_type(8))) short;
using s16x4  = __attribute__((ext_vector_type(4))) short;
using f32x16 = __attribute__((ext_vector_type(16))) float;
using u32x4  = __attribute__((ext_vector_type(4))) unsigned;
using f32x4_t = __attribute__((ext_vector_type(4))) float;
constexpr int NW = 8, QBLK = 32, KVBLK = 64, SEQ = 4096;
constexpr int LDQ = 1536, LDKV = 2048, LDO = 1024;
constexpr int SHM_VT = 128 * 80, SHM_K8 = 64 * 208;
constexpr int OFF_V = 0, OFF_K8 = 3 * SHM_VT, OFF_WS = OFF_K8 + 2 * SHM_K8, LDS_BYTES = OFF_WS + NW * 64 * 4 + 64;
typedef int v8i32 __attribute__((ext_vector_type(8)));
typedef int v4i32 __attribute__((ext_vector_type(4)));
typedef int v2i32 __attribute__((ext_vector_type(2)));
constexpr int T_TOK = 8 * SEQ;
#define ASBAR() __builtin_amdgcn_sched_barrier(0)
__device__ __forceinline__ int crow(int r, int hi) { return (r & 3) + 8 * (r >> 2) + 4 * hi; }
__device__ __forceinline__ unsigned cvtpk(float lo, float hi) { unsigned r; asm volatile("v_cvt_pk_bf16_f32 %0, %1, %2" : "=v"(r) : "v"(lo), "v"(hi)); return r; }
__device__ __forceinline__ float bf2f(unsigned short b) { return __uint_as_float(((unsigned)b) << 16); }
template <bool SHIFT> __device__ __forceinline__ void smA(f32x16& p0, float negm) { for (int r = 0; r < 16; ++r) p0[r] = __builtin_amdgcn_exp2f(SHIFT ? p0[r] + negm : p0[r]); }
template <bool SHIFT> __device__ __forceinline__ void smB(f32x16& p0, f32x16& p1, float& l_reg, v8i32& p8, float negm) {
  for (int r = 0; r < 16; ++r) p1[r] = __builtin_amdgcn_exp2f(SHIFT ? p1[r] + negm : p1[r]);
  float ps = 0; for (int r = 0; r < 16; ++r) ps += p0[r]; for (int r = 0; r < 16; ++r) ps += p1[r];
  l_reg += ps;
#pragma unroll
  for (int w = 0; w < 4; ++w) { int a = 0, bq = 0;
    a = __builtin_amdgcn_cvt_pk_bf8_f32(p0[4 * w], p0[4 * w + 1], a, false); a = __builtin_amdgcn_cvt_pk_bf8_f32(p0[4 * w + 2], p0[4 * w + 3], a, true);
    bq = __builtin_amdgcn_cvt_pk_bf8_f32(p1[4 * w], p1[4 * w + 1], bq, false); bq = __builtin_amdgcn_cvt_pk_bf8_f32(p1[4 * w + 2], p1[4 * w + 3], bq, true);
    p8[w] = a; p8[4 + w] = bq; }
}
template <bool SHIFT> __device__ __forceinline__ void qkt(f32x16& p0, f32x16& p1, const char* K8, const v8i32* q8, float negm, int r32, int hi) {
  p0 = f32x16{}; p1 = f32x16{};
#define K8RD(m, half, part) (*reinterpret_cast<const v4i32*>(K8 + ((half) * 32 + r32) * 208 + (m) * 64 + hi * 32 + (part) * 16))
#define K8FR(m, half) ({ const v4i32 lo_ = K8RD(m, half, 0), hi_ = K8RD(m, half, 1); (v8i32){lo_[0], lo_[1], lo_[2], lo_[3], hi_[0], hi_[1], hi_[2], hi_[3]}; })
  v8i32 a0 = K8FR(0, 0), a1 = K8FR(0, 1), b0 = K8FR(1, 0), b1 = K8FR(1, 1);
  ASBAR();
  p0 = __builtin_amdgcn_mfma_scale_f32_32x32x64_f8f6f4(a0, q8[0], p0, 0, 0, 0, 0x7f7f7f7f, 0, 0x7f7f7f7f);
  p1 = __builtin_amdgcn_mfma_scale_f32_32x32x64_f8f6f4(a1, q8[0], p1, 0, 0, 0, 0x7f7f7f7f, 0, 0x7f7f7f7f);
  a0 = K8FR(2, 0); a1 = K8FR(2, 1);
  ASBAR();
  p0 = __builtin_amdgcn_mfma_scale_f32_32x32x64_f8f6f4(b0, q8[1], p0, 0, 0, 0, 0x7f7f7f7f, 0, 0x7f7f7f7f);
  p1 = __builtin_amdgcn_mfma_scale_f32_32x32x64_f8f6f4(b1, q8[1], p1, 0, 0, 0, 0x7f7f7f7f, 0, 0x7f7f7f7f);
  ASBAR();
  p0 = __builtin_amdgcn_mfma_scale_f32_32x32x64_f8f6f4(a0, q8[2], p0, 0, 0, 0, 0x7f7f7f7f, 0, 0x7f7f7f7f);
  p1 = __builtin_amdgcn_mfma_scale_f32_32x32x64_f8f6f4(a1, q8[2], p1, 0, 0, 0, 0x7f7f7f7f, 0, 0x7f7f7f7f);
  ASBAR();
#undef K8RD
#undef K8FR
}
__device__ __forceinline__ void pv_d0(f32x16* o, const char* VT, v8i32 p8, int r32, int hi) {
#define VTFR(d0) ({ const v4i32 lo_ = *reinterpret_cast<const v4i32*>(VT + ((d0) * 32 + r32) * 80 + hi * 32), hi_ = *reinterpret_cast<const v4i32*>(VT + ((d0) * 32 + r32) * 80 + hi * 32 + 16); (v8i32){lo_[0], lo_[1], lo_[2], lo_[3], hi_[0], hi_[1], hi_[2], hi_[3]}; })
#define PVMMA(d0, fr) o[d0] = __builtin_amdgcn_mfma_scale_f32_32x32x64_f8f6f4(p8, fr, o[d0], 1  , 0  , 0, 0x7f7f7f7f, 0, 0x7f7f7f7f)
  v8i32 fa = VTFR(0), fb = VTFR(1);
  ASBAR();
  PVMMA(0, fa); fa = VTFR(2); ASBAR();
  PVMMA(1, fb); fb = VTFR(3); ASBAR();
  PVMMA(2, fa); PVMMA(3, fb); ASBAR();
#undef VTFR
#undef PVMMA
}
template <bool SHIFT> __device__ __forceinline__ bool attn_unit(int b, int h, int s0, const bf16* Qraw, const unsigned char* __restrict__ VT8g, const unsigned char* __restrict__ K8g, const unsigned char* __restrict__ KP8g, bf16* __restrict__ O,
                                          const float* rope, const float* qg, float smaxC, char* lds, int tid) {
  asm volatile("" : "+v"(tid));
  const int wid = __builtin_amdgcn_readfirstlane(tid >> 6), lane = tid & 63, r32 = lane & 31, hi = lane >> 5;
  asm volatile("" : "+s"(qg));
  char* V_lds = lds + OFF_V; char* K8_lds = lds + OFF_K8;
  float* ws = (float*)(lds + OFF_WS) + wid * 64; float* li_l = ws;
  constexpr float C = 0.072168783648703220f * 1.4426950408889634f;
  v8i32 q8[3];
  {
    typedef __attribute__((address_space(1))) const bf16x8 gbf16x8; typedef __attribute__((address_space(1))) const f32x4_t gf32x4;
    const long trow = (long)b * SEQ + s0 + wid * QBLK + r32;
    unsigned qo = (unsigned)((trow * LDQ + h * 192) * 2); const unsigned ro = (unsigned)(trow * 256), go = (unsigned)(hi * 128);
#define Qn_(i) (*(gbf16x8*)((const char*)Qraw + qo + hi * 64 + (i) * 16))
#define Qr_(i) (*(gbf16x8*)((const char*)Qraw + qo + 256 + (i) * 16))
#define rp4_(i) (*(gf32x4*)((const char*)rope + ro + (i) * 16))
#define qgn_(i) (*(gf32x4*)((const char*)qg + go + (i) * 16))
#define qgr_(i) (*(gf32x4*)((const char*)qg + 512 + (i) * 16))
    float ssn = 0.f, ssp = 0.f;
#pragma unroll
    for (int c = 0; c < 8; ++c) { const bf16x8 a = Qn_((c >> 2) * 8 + (c & 3)), r = Qr_(c);
#pragma unroll
      for (int j = 0; j < 8; ++j) { const float f = bf2f((unsigned short)a[j]), g = bf2f((unsigned short)r[j]); ssn += f * f; ssp += g * g; } }
    ssn += __shfl_xor(ssn, 32);
    const float rn = rsqrtf(ssn * (1.f / 128.f) + 1e-6f) * C, rp = rsqrtf(ssp * (1.f / 64.f) + 1e-6f) * C;
    { float rn_ = rn, rp_ = rp; asm volatile("" : "+v"(qo), "+v"(rn_), "+v"(rp_) :: "memory"); }
#pragma unroll
    for (int m = 0; m < 2; ++m)
#pragma unroll
      for (int c = 0; c < 4; ++c) { const bf16x8 raw = Qn_(8 * m + c); const f32x4_t ga = qgn_(16 * m + 2 * c), gb = qgn_(16 * m + 2 * c + 1); float g[8];
#pragma unroll
        for (int j = 0; j < 8; ++j) g[j] = bf2f((unsigned short)raw[j]) * rn * (j < 4 ? ga[j & 3] : gb[j & 3]);
        int w0 = 0, w1 = 0; w0 = __builtin_amdgcn_cvt_pk_fp8_f32(g[0], g[1], w0, false); w0 = __builtin_amdgcn_cvt_pk_fp8_f32(g[2], g[3], w0, true);
        w1 = __builtin_amdgcn_cvt_pk_fp8_f32(g[4], g[5], w1, false); w1 = __builtin_amdgcn_cvt_pk_fp8_f32(g[6], g[7], w1, true);
        asm volatile("" : "+v"(w0), "+v"(w1) :: "memory");        q8[m][2 * c] = w0; q8[m][2 * c + 1] = w1; }
#pragma unroll
    for (int c = 0; c < 4; ++c) {
      const bf16x8 r1 = Qr_(c), r2 = Qr_(4 + c);
      const f32x4_t g1a = qgr_(2 * c), g1b = qgr_(2 * c + 1), g2a = qgr_(8 + 2 * c), g2b = qgr_(8 + 2 * c + 1); float ov[8];
#pragma unroll
      for (int j = 0; j < 8; ++j) { const f32x4_t cs4 = rp4_(4 * c + (j >> 1));
        const float cs = cs4[(j & 1) * 2], sn = cs4[(j & 1) * 2 + 1];
        const float x1 = bf2f((unsigned short)r1[j]) * rp * (j < 4 ? g1a[j & 3] : g1b[j & 3]), x2 = bf2f((unsigned short)r2[j]) * rp * (j < 4 ? g2a[j & 3] : g2b[j & 3]);
        ov[j] = hi == 0 ? (x1 * cs - x2 * sn) : (x1 * sn + x2 * cs); }
      int w0 = 0, w1 = 0; w0 = __builtin_amdgcn_cvt_pk_fp8_f32(ov[0], ov[1], w0, false); w0 = __builtin_amdgcn_cvt_pk_fp8_f32(ov[2], ov[3], w0, true);
      w1 = __builtin_amdgcn_cvt_pk_fp8_f32(ov[4], ov[5], w1, false); w1 = __builtin_amdgcn_cvt_pk_fp8_f32(ov[6], ov[7], w1, true);
      asm volatile("" : "+v"(w0), "+v"(w1) :: "memory"); q8[2][2 * c] = w0; q8[2][2 * c + 1] = w1; }
  #undef Qn_
#undef Qr_
#undef rp4_
#undef qgn_
#undef qgr_
  }
  const float negm = 15.0f - smaxC;
  float l_reg = 0.f; f32x16 o[4] = {};
  const char* Vg = (const char*)(VT8g + (size_t)h * 128 * T_TOK + (size_t)b * SEQ); const char* Kg = (const char*)(K8g + ((long)b * SEQ * 8 + h) * 128); const char* Pg = (const char*)(KP8g + (long)b * SEQ * 64);
  const int vc = tid >> 2, vq = tid & 3, vst = vc * 80 + 16 * (vq >> 1) + 8 * (vq & 1); const unsigned gvt = (unsigned)vc * (unsigned)T_TOK + 16u * (unsigned)vq;
  const int kr = tid >> 3, kc = tid & 7, kst = kr * 208 + kc * 16; const unsigned gk8 = (unsigned)(kr * 1024 + kc * 16);
  const int pr = (tid & 255) >> 2, pc = tid & 3, pst = pr * 208 + 128 + pc * 16; const unsigned gp8 = (unsigned)(pr * 64 + pc * 16);
  v4i32 s_v, s_k, s_p;
#define SLOAD(k0) do { s_v = *reinterpret_cast<const v4i32*>(Vg + (size_t)(k0) + gvt); \
    s_k = *reinterpret_cast<const v4i32*>(Kg + (size_t)(k0) * 1024 + gk8); if (tid < 256) s_p = *reinterpret_cast<const v4i32*>(Pg + (size_t)(k0) * 64 + gp8); } while (0)
#define SWRITE(kbuf, vbuf_) do { { v2i32 a_ = {s_v[0], s_v[2]}, b_ = {s_v[1], s_v[3]}; *(v2i32*)(V_lds + (vbuf_) * SHM_VT + vst) = a_; *(v2i32*)(V_lds + (vbuf_) * SHM_VT + vst + 32) = b_; } \
    *(v4i32*)(K8_lds + (kbuf) * SHM_K8 + kst) = s_k; if (tid < 256) *(v4i32*)(K8_lds + (kbuf) * SHM_K8 + pst) = s_p; } while (0)
  constexpr int NT = SEQ / KVBLK;
  v8i32 p8;
  SLOAD(0); SWRITE(0, 0); __syncthreads(); SLOAD(KVBLK);
  if (wid < 4) {
    for (int j = 0, kb = 0, vbuf = 0, vnx = 1; j < NT; ++j) {
      f32x16 p0, p1;
      qkt<SHIFT>(p0, p1, K8_lds + kb * SHM_K8, q8, negm, r32, hi);
      smA<SHIFT>(p0, negm); smB<SHIFT>(p0, p1, l_reg, p8, negm); ASBAR();
      pv_d0(o, V_lds + vbuf * SHM_VT, p8, r32, hi);
      if (j + 1 < NT) SWRITE(kb ^ 1, vnx);
      __syncthreads();
      if (j + 2 < NT) SLOAD((j + 2) * KVBLK);
      kb ^= 1; vbuf = vnx; vnx = vnx == 2 ? 0 : vnx + 1;
    }
  } else {
    int vprev = 0;
    __builtin_amdgcn_s_setprio(1);
    for (int j = 0, kb = 0, vbuf = 0, vnx = 1; j < NT; ++j) {
      f32x16 p0, p1;
      if (j > 0) pv_d0(o, V_lds + vprev * SHM_VT, p8, r32, hi);
      qkt<SHIFT>(p0, p1, K8_lds + kb * SHM_K8, q8, negm, r32, hi);
      smA<SHIFT>(p0, negm); smB<SHIFT>(p0, p1, l_reg, p8, negm); ASBAR();
      if (j + 1 < NT) SWRITE(kb ^ 1, vnx);
      __syncthreads();
      if (j + 2 < NT) SLOAD((j + 2) * KVBLK);
      kb ^= 1; vprev = vbuf; vbuf = vnx; vnx = vnx == 2 ? 0 : vnx + 1;
    }
    pv_d0(o, V_lds + vprev * SHM_VT, p8, r32, hi);
    __builtin_amdgcn_s_setprio(0);
  }
  int lane_e = lane; asm volatile("" : "+v"(lane_e));
  const int r32e = lane_e & 31, hie = lane_e >> 5;
  l_reg += __shfl_xor(l_reg, 32);
  int* satf = (int*)(lds + OFF_WS + NW * 64 * 4);
  if (!SHIFT) { const bool sat = __any(l_reg >= 57344.f); if (lane_e == 0) satf[wid] = sat ? 1 : 0; }
  if (hie == 0) li_l[r32e] = l_reg; asm volatile("s_waitcnt lgkmcnt(0)" ::: "memory");
  float rli[16];
#pragma unroll
  for (int r = 0; r < 16; ++r) rli[r] = __builtin_amdgcn_rcpf(li_l[crow(r, hie)]);
  char* Ow = (char*)O + ((long)b * SEQ + s0 + wid * QBLK) * LDO + h * 128;
#pragma unroll
  for (int r = 0; r < 16; ++r) { const unsigned ooff = (unsigned)(crow(r, hie) * LDO + r32e);
#pragma unroll
    for (int d0 = 0; d0 < 4; ++d0) { const int pk = __builtin_amdgcn_cvt_pk_fp8_f32(o[d0][r] * rli[r] * 32.f, 0.f, 0, false); *(unsigned char*)(Ow + ooff + d0 * 32) = (unsigned char)(pk & 0xff); } }
  __syncthreads();
  bool redo = false;
  if (!SHIFT) { redo = (satf[0] | satf[1] | satf[2] | satf[3] | satf[4] | satf[5] | satf[6] | satf[7]) != 0; __syncthreads(); }
  return redo;
#undef SLOAD
#undef SWRITE
}
}
#ifndef HD
#define HD __device__ __forceinline__
#endif
struct c32 { float x, y; };
HD c32 cmk(float x, float y) { c32 r; r.x = x; r.y = y; return r; }
HD c32 cadd(c32 a, c32 b) { return cmk(a.x + b.x, a.y + b.y); }
HD c32 csub(c32 a, c32 b) { return cmk(a.x - b.x, a.y - b.y); }
HD c32 cmul(c32 a, c32 b) { return cmk(a.x * b.x - a.y * b.y, a.x * b.y + a.y * b.x); }
HD c32 cmulc(c32 a, c32 b) { return cmk(a.x * b.x + a.y * b.y, a.y * b.x - a.x * b.y); }
constexpr int BR4(int i) { return ((i & 1) << 3) | ((i & 2) << 1) | ((i & 4) >> 1) | ((i & 8) >> 3); }
template <int SGN, int J> HD c32 tw16(c32 a) {
    if constexpr (J == 0) return a;
    else if constexpr (J == 4) return SGN < 0 ? cmk(a.y, -a.x) : cmk(-a.y, a.x);
    else {
        constexpr float CS[8] = {1.f, 0.92387953251128674f, 0.70710678118654752f, 0.38268343236508977f, 0.f, -0.38268343236508977f, -0.70710678118654752f, -0.92387953251128674f};
        constexpr float SN[8] = {0.f, 0.38268343236508977f, 0.70710678118654752f, 0.92387953251128674f, 1.f, 0.92387953251128674f, 0.70710678118654752f, 0.38268343236508977f};
        constexpr float c = CS[J], s = SN[J];
        if constexpr (SGN < 0) return cmk(a.x * c + a.y * s, a.y * c - a.x * s);
        else return cmk(a.x * c - a.y * s, a.y * c + a.x * s);
    }
}
#define FFT_BF(i, j, J) { const c32 u_ = v[i], w_ = v[j]; v[i] = cadd(u_, w_); v[j] = tw16<SGN, J>(csub(u_, w_)); }
template <int SGN> HD void dft16_dif(c32 (&v)[16]) {
    FFT_BF(0, 8, 0) FFT_BF(1, 9, 1) FFT_BF(2, 10, 2) FFT_BF(3, 11, 3) FFT_BF(4, 12, 4) FFT_BF(5, 13, 5) FFT_BF(6, 14, 6) FFT_BF(7, 15, 7)
    FFT_BF(0, 4, 0) FFT_BF(1, 5, 2) FFT_BF(2, 6, 4) FFT_BF(3, 7, 6) FFT_BF(8, 12, 0) FFT_BF(9, 13, 2) FFT_BF(10, 14, 4) FFT_BF(11, 15, 6)
    FFT_BF(0, 2, 0) FFT_BF(1, 3, 4) FFT_BF(4, 6, 0) FFT_BF(5, 7, 4) FFT_BF(8, 10, 0) FFT_BF(9, 11, 4) FFT_BF(12, 14, 0) FFT_BF(13, 15, 4)
    FFT_BF(0, 1, 0) FFT_BF(2, 3, 0) FFT_BF(4, 5, 0) FFT_BF(6, 7, 0) FFT_BF(8, 9, 0) FFT_BF(10, 11, 0) FFT_BF(12, 13, 0) FFT_BF(14, 15, 0)
}
#undef FFT_BF
#define FFT_BT(i, j, J) { const c32 u_ = v[i], w_ = tw16<SGN, J>(v[j]); v[i] = cadd(u_, w_); v[j] = csub(u_, w_); }
template <int SGN> HD void dft16_dit(c32 (&v)[16]) {
    FFT_BT(0, 1, 0) FFT_BT(2, 3, 0) FFT_BT(4, 5, 0) FFT_BT(6, 7, 0) FFT_BT(8, 9, 0) FFT_BT(10, 11, 0) FFT_BT(12, 13, 0) FFT_BT(14, 15, 0)
    FFT_BT(0, 2, 0) FFT_BT(1, 3, 4) FFT_BT(4, 6, 0) FFT_BT(5, 7, 4) FFT_BT(8, 10, 0) FFT_BT(9, 11, 4) FFT_BT(12, 14, 0) FFT_BT(13, 15, 4)
    FFT_BT(0, 4, 0) FFT_BT(1, 5, 2) FFT_BT(2, 6, 4) FFT_BT(3, 7, 6) FFT_BT(8, 12, 0) FFT_BT(9, 13, 2) FFT_BT(10, 14, 4) FFT_BT(11, 15, 6)
    FFT_BT(0, 8, 0) FFT_BT(1, 9, 1) FFT_BT(2, 10, 2) FFT_BT(3, 11, 3) FFT_BT(4, 12, 4) FFT_BT(5, 13, 5) FFT_BT(6, 14, 6) FFT_BT(7, 15, 7)
}
#undef FFT_BT
constexpr int FFT_PS = 272;
constexpr int FFT_EX_ELEMS = 16 * FFT_PS;
template <class EX> HD void fft_fwd_a(c32 (&v)[16], const c32* T1, EX ex, int tid) {
    dft16_dif<-1>(v);
#pragma unroll
    for (int p = 0; p < 16; ++p) { ex[p * FFT_PS + tid] = cmul(v[BR4(p)], T1[256 * p]); if ((p & 3) == 3) __builtin_amdgcn_sched_barrier(0); }
}
template <class EX> HD void fft_fwd_b(c32 (&v)[16], const c32* T2, EX exr, EX ex, int tid) {
    const int p2 = tid >> 4, c = tid & 15;
#pragma unroll
    for (int b = 0; b < 16; ++b) v[b] = exr[p2 * FFT_PS + 16 * b + c];
    dft16_dif<-1>(v);
#pragma unroll
    for (int q = 0; q < 16; ++q) ex[p2 * FFT_PS + q * 16 + ((c + q) & 15)] = cmul(v[BR4(q)], T2[q]);
}
template <class EX> HD void fft_fwd_c(c32 (&v)[16], EX ex, int tid) {
    const int p2 = tid >> 4, q = tid & 15;
#pragma unroll
    for (int c = 0; c < 16; ++c) v[c] = ex[p2 * FFT_PS + q * 16 + ((c + q) & 15)];
    dft16_dif<-1>(v);
}
template <class EX> HD void fft_inv_a(c32 (&v)[16], EX ex, int tid) {
    const int p = tid >> 4, q = tid & 15;
    dft16_dit<+1>(v);
#pragma unroll
    for (int c = 0; c < 16; ++c) ex[p * FFT_PS + q * 16 + ((c + q) & 15)] = v[c];
}
template <class EX> HD void fft_inv_b(c32 (&v)[16], const c32* T2, EX exr, EX ex, int tid) {
    const int p = tid >> 4, c = tid & 15;
#pragma unroll
    for (int q = 0; q < 16; ++q) v[BR4(q)] = cmulc(exr[p * FFT_PS + q * 16 + ((c + q) & 15)], T2[q]);
    dft16_dit<+1>(v);
#pragma unroll
    for (int b = 0; b < 16; ++b) ex[p * FFT_PS + 16 * b + c] = v[b];
}
template <class EX> HD void fft_inv_c(c32 (&v)[16], const c32* T1, EX ex, int tid) {
#pragma unroll
    for (int p = 0; p < 16; ++p) { v[BR4(p)] = cmulc(ex[p * FFT_PS + tid], T1[256 * p]); if ((p & 3) == 3) __builtin_amdgcn_sched_barrier(0); }
    dft16_dit<+1>(v);
}
constexpr int NWAVES = 8, NTHR = 512;
constexpr int BATCH = 8, SEQ = 4096, DM = 1024, T = BATCH * SEQ;
constexpr float EPS = 1e-6f;
constexpr size_t MiB = 1u << 20;
constexpr size_t WS_CTL = 0, CTL_ZERO_BYTES = 64 * 1024;
constexpr size_t WS_MOD = 1 * MiB;
constexpr size_t WS_HDNS = 1 * MiB + 512 * 1024;
constexpr size_t WS_W4S = 3 * MiB + 512 * 1024;
constexpr size_t WS_LIST = 101 * MiB;
constexpr size_t WS_WL = 396 * MiB;
constexpr size_t WS_WD = 8 * MiB;
constexpr size_t WS_WUQ = 9 * MiB;
constexpr size_t WS_WUKV = 10 * MiB;
constexpr size_t WS_WO = 11 * MiB;
constexpr size_t WS_WIN = 13 * MiB;
constexpr size_t WS_WOUT = 19 * MiB;
constexpr size_t WS_WGU = 21 * MiB;
constexpr size_t WS_WDN = 53 * MiB;
constexpr size_t R1 = 104 * MiB;
constexpr size_t R2 = 232 * MiB;
constexpr size_t R3 = 424 * MiB;
constexpr size_t WS_VT8 = R1, WS_XN2 = R1, WS_KF = R1;
constexpr size_t WS_XN = R2, WS_O = R2;
constexpr size_t WS_LAT = R2 + 64 * MiB;
constexpr size_t WS_HACT = R2 + 64 * MiB;
constexpr size_t WS_CQN = R2 + 128 * MiB;
constexpr size_t WS_CKVN = R2 + 144 * MiB;
constexpr size_t WS_KPE = R2 + 160 * MiB;
constexpr size_t WS_K8 = R2 + 64 * MiB;
constexpr size_t WS_ROPE = R2 + 164 * MiB;
constexpr size_t WS_QRAW = 408 * MiB;
constexpr size_t WS_XN2S = 424 * MiB;
constexpr size_t WS_XR = 424 * MiB;
constexpr size_t WS_HT = R2;
constexpr size_t WS_UT = R2;
constexpr size_t WS_Z = R2;
constexpr size_t WS_END = 512 * MiB;
constexpr int MS_ROWS = T + 24 * 256;
constexpr int CW_BAR = 4096;
constexpr int CW_CNT = 8192;
constexpr int RING_OFF = 0, RING_BYTES = 147456;
constexpr int LDSCTL_OFF = RING_BYTES;
constexpr int MISC_OFF = LDSCTL_OFF;
constexpr int TINFO_OFF = LDSCTL_OFF + 256;
constexpr int RED_OFF = LDSCTL_OFF + 256 + 1280;
constexpr int EPIX_OFF = LDSCTL_OFF + 2048;
constexpr int LDS_BYTES = 163840;
static_assert(RED_OFF + 256 <= LDS_BYTES, "LDS map");

#define GAS __attribute__((address_space(1)))
#define LAS __attribute__((address_space(3)))
typedef unsigned short bf16;
typedef unsigned v4u __attribute__((ext_vector_type(4)));
typedef unsigned v2u __attribute__((ext_vector_type(2)));
typedef int v4i __attribute__((ext_vector_type(4)));
typedef float f32x4 __attribute__((ext_vector_type(4)));
typedef GAS unsigned gu32;
#define RLX_AGENT __ATOMIC_RELAXED, __HIP_MEMORY_SCOPE_AGENT
#define LDS_WAIT() asm volatile("s_waitcnt lgkmcnt(0)" ::: "memory")
__device__ __forceinline__ unsigned pk2(float lo, float hi) { return pg8::cvt_pk_bf16(lo, hi); }
__device__ __forceinline__ float bf2f(unsigned short b) { return __uint_as_float(((unsigned)b) << 16); }
__device__ __forceinline__ float wave_sum(float v) {
#pragma unroll
    for (int o = 1; o < 64; o <<= 1) v += __shfl_xor(v, o);
    return v;
}

#define XB_TMO      128
#define XB_XCNT(j)  (256  + 64 * (j))
#define XB_XSUB(j)  (1280 + 64 * (j))
#define XB_XGEN(j)  (2304 + 64 * (j))
#define XB_TOP      3328
#define XB_TOPGEN   3392
#define XCD_BAR_WORDS 3456
#define XB_SPIN_CAP (1u << 18)

__device__ __forceinline__ unsigned xb_ld(unsigned* p)              { return __hip_atomic_load(p, __ATOMIC_RELAXED, __HIP_MEMORY_SCOPE_AGENT); }
__device__ __forceinline__ unsigned xb_add(unsigned* p, unsigned v) { return __hip_atomic_fetch_add(p, v, __ATOMIC_RELAXED, __HIP_MEMORY_SCOPE_AGENT); }
__device__ __forceinline__ unsigned xb_xcc_id() { return (unsigned)__builtin_amdgcn_s_getreg((3 << 11) | 20) & 0xFu; }
#define XB_SPIN(cond, bar) do { unsigned _sp = 0; while (cond) { __builtin_amdgcn_s_sleep(1); \
    if ((++_sp & 255u) == 0u) { if (xb_ld(&(bar)[XB_TMO])) break; if (_sp > XB_SPIN_CAP) { atomicAdd(&(bar)[XB_TMO], 1u); break; } } } } while (0)

struct XcdBarrier {
    unsigned* bar; unsigned x;
    volatile LAS unsigned* st;
    int w0;
};

__device__ __forceinline__ XcdBarrier xcd_barrier_post(unsigned* bar, volatile LAS unsigned* st) {
    XcdBarrier b; b.bar = bar; b.x = xb_xcc_id(); b.st = st; b.w0 = 0;
    if (threadIdx.x == 0) (void)xb_add(&bar[XB_XCNT(b.x)], 1u);
    return b;
}
__device__ __forceinline__ void xcd_barrier_complete(unsigned* bar, unsigned x, unsigned& nloc, unsigned& nx) {
    const unsigned G = gridDim.x * gridDim.y * gridDim.z;
    unsigned sum, cnt, mine, sp = 0u;
    for (;;) {
        sum = 0u; cnt = 0u; mine = 0u;
#pragma unroll
        for (unsigned j = 0; j < 16; ++j) { const unsigned c = xb_ld(&bar[XB_XCNT(j)]); sum += c; cnt += (c > 0u) ? 1u : 0u; mine = (j == x) ? c : mine; }
        if (sum == G) break;
        __builtin_amdgcn_s_sleep(1);
        if ((++sp & 255u) == 0u) { if (xb_ld(&bar[XB_TMO])) break; if (sp > XB_SPIN_CAP) { atomicAdd(&bar[XB_TMO], 1u); break; } }
    }
    nloc = mine > 0u ? mine : 1u; nx = cnt > 0u ? cnt : 1u;
}

__device__ __forceinline__ void xcd_barrier(const XcdBarrier& b) {
    asm volatile("s_waitcnt vmcnt(0)" ::: "memory");
    __syncthreads();
    if (b.w0 && __builtin_amdgcn_mbcnt_hi(~0u, __builtin_amdgcn_mbcnt_lo(~0u, 0u)) == 0u) {
        unsigned* bar = b.bar;
        __builtin_amdgcn_s_waitcnt(0);
        unsigned nloc = b.st[0], nx = b.st[1];
        if (nloc == 0u) { xcd_barrier_complete(bar, b.x, nloc, nx); b.st[0] = nloc; b.st[1] = nx; }
        const unsigned old = xb_add(&bar[XB_XSUB(b.x)], 1u);
        const unsigned gen = old / nloc;
        if (old + 1u == (gen + 1u) * nloc) {
            __builtin_amdgcn_fence(__ATOMIC_RELEASE, "agent");
            asm volatile("s_waitcnt vmcnt(0)" ::: "memory");
            const unsigned og = xb_add(&bar[XB_TOP], 1u);
            const unsigned tg = og / nx;
            if (og + 1u == (tg + 1u) * nx) xb_add(&bar[XB_TOPGEN], 1u);
            else XB_SPIN(xb_ld(&bar[XB_TOPGEN]) == tg, bar);
            __builtin_amdgcn_fence(__ATOMIC_ACQUIRE, "agent");
            xb_add(&bar[XB_XGEN(b.x)], 1u);
            asm volatile("s_waitcnt vmcnt(0)" ::: "memory");
        } else {
            XB_SPIN(xb_ld(&bar[XB_XGEN(b.x)]) == gen, bar);
            __builtin_amdgcn_fence(__ATOMIC_ACQUIRE, "agent");
            asm volatile("s_waitcnt vmcnt(0)" ::: "memory");
        }
    }
    __syncthreads();
}


struct Ctx { unsigned char* lds; int tid, lane, wave, vcu, G, gw, NGW; };

__device__ __forceinline__ void transpose_item(const float* W, int ldw, int k0, int n0, bf16* WT, int ldt, int drow0, int dcol0, float* scr, int lane, bool kpe_perm) {
    float tv[32];
#pragma unroll
    for (int i = 0; i < 32; ++i) { const int kk = 2 * i + (lane >> 5); tv[i] = W[(size_t)(k0 + kk) * ldw + n0 + (lane & 31)]; }
#pragma unroll
    for (int i = 0; i < 32; ++i) { const int kk = 2 * i + (lane >> 5); scr[kk * 33 + (lane & 31)] = tv[i]; }
    LDS_WAIT();
    const int c = lane & 7;
#pragma unroll
    for (int j = 0; j < 4; ++j) { const int n = (lane >> 3) + 8 * j; const float* s = scr + (8 * c) * 33 + n;
        v4u o; o.x = pk2(s[0 * 33], s[1 * 33]); o.y = pk2(s[2 * 33], s[3 * 33]); o.z = pk2(s[4 * 33], s[5 * 33]); o.w = pk2(s[6 * 33], s[7 * 33]);
        int dr = drow0 + n; if (kpe_perm && dr >= 384 && dr < 448) { const int e = dr - 384; dr = 384 + 32 * ((e >> 4) & 1) + 16 * (e >> 5) + (e & 15); }
        *(v4u*)(WT + (size_t)dr * ldt + dcol0 + k0 + 8 * c) = o; }
    LDS_WAIT();
}
__device__ __forceinline__ void transpose_item8(const float* W, int ldw, int k0, int n0, unsigned char* WT8, int ldt8, int drow0, int dcol0, float* scr, int lane, float scale, bool kpe_perm) {
    float tv[32];
#pragma unroll
    for (int i = 0; i < 32; ++i) { const int kk = 2 * i + (lane >> 5); tv[i] = W[(size_t)(k0 + kk) * ldw + n0 + (lane & 31)]; }
#pragma unroll
    for (int i = 0; i < 32; ++i) { const int kk = 2 * i + (lane >> 5); scr[kk * 33 + (lane & 31)] = tv[i]; }
    LDS_WAIT();
    const int n = lane >> 1, hf = lane & 1; const float* sp = scr + (32 * hf) * 33 + n;
    v4u o0, o1; unsigned w[8];
#pragma unroll
    for (int q = 0; q < 8; ++q) { int p = 0; p = __builtin_amdgcn_cvt_pk_fp8_f32(sp[(4 * q) * 33] * scale, sp[(4 * q + 1) * 33] * scale, p, false); p = __builtin_amdgcn_cvt_pk_fp8_f32(sp[(4 * q + 2) * 33] * scale, sp[(4 * q + 3) * 33] * scale, p, true); w[q] = (unsigned)p; }
    o0.x = w[0]; o0.y = w[1]; o0.z = w[2]; o0.w = w[3]; o1.x = w[4]; o1.y = w[5]; o1.z = w[6]; o1.w = w[7];
    int dr = drow0 + n; if (kpe_perm && dr >= 384 && dr < 448) { const int e = dr - 384; dr = 384 + 32 * ((e >> 4) & 1) + 16 * (e >> 5) + (e & 15); }
    unsigned char* d = WT8 + (size_t)dr * ldt8 + dcol0 + k0 + 32 * hf;
    *(v4u*)d = o0; *(v4u*)(d + 16) = o1;
    LDS_WAIT();
}
typedef __attribute__((address_space(4))) const char kchar;
struct In { int opq;
    __device__ __forceinline__ const float* operator[](int k) const { kchar* ka = (kchar*)__builtin_amdgcn_kernarg_segment_ptr(); return *(const float* const __attribute__((address_space(4)))*)(ka + 8 * k + opq); } };
__device__ __forceinline__ unsigned char* karg_ws(int opq) { kchar* ka = (kchar*)__builtin_amdgcn_kernarg_segment_ptr(); return *(unsigned char* const __attribute__((address_space(4)))*)(ka + 38 * 8 + 8 + opq); }
__device__ __forceinline__ float* karg_out(int opq) { kchar* ka = (kchar*)__builtin_amdgcn_kernarg_segment_ptr(); return *(float* const __attribute__((address_space(4)))*)(ka + 38 * 8 + opq); }

__device__ __forceinline__ void p0_prologue(const Ctx& F, const In& in, unsigned char* ws) {
    float* scr = (float*)(F.lds + RING_OFF + F.wave * 16384);
    bf16* Wd = (bf16*)(ws + WS_WD); bf16* Wuq = (bf16*)(ws + WS_WUQ); bf16* Wukv = (bf16*)(ws + WS_WUKV); bf16* Wo = (bf16*)(ws + WS_WO);
    bf16* Win = (bf16*)(ws + WS_WIN); bf16* Wout = (bf16*)(ws + WS_WOUT); bf16* Wgu = (bf16*)(ws + WS_WGU); bf16* Wdn = (bf16*)(ws + WS_WDN);
    constexpr int I_D = 16 * 14, I_UQ = 4 * 48, I_UKV = 2 * 64, I_O = 16 * 32, I_IN = 16 * 96, I_OUT = 16 * 32, I_GU = 2 * 16 * 2 * (16 * 8), I_DN = 2 * 24 * 2 * (4 * 32);
    constexpr int NITEMS = I_D + I_UQ + I_UKV + I_O + I_IN + I_OUT + I_GU + I_DN;
    for (int it = F.gw; it < NITEMS; it += F.NGW) {
        int r = it; const float* W; int ldw, k0, n0, ldt, drow0, dcol0 = 0; bf16* WT; float f8s = 0.f;
        if (r < I_D) { W = in[7]; ldw = 448; k0 = (r / 14) * 64; n0 = (r % 14) * 32; WT = Wd; ldt = 1024; drow0 = n0; f8s = 32.f; }
        else if ((r -= I_D) < I_UQ) { W = in[10]; ldw = 1536; k0 = (r / 48) * 64; n0 = (r % 48) * 32; WT = Wuq; ldt = 256; drow0 = n0; f8s = 16.f; }
        else if ((r -= I_UQ) < I_UKV) { W = in[11]; ldw = 2048; k0 = (r / 64) * 64; n0 = (r % 64) * 32; ldt = 128;
            WT = Wukv + ((n0 & 128) ? 1024 * 128 : 0); drow0 = (n0 >> 8) * 128 + (n0 & 127); }
        else if ((r -= I_UKV) < I_O) { W = in[14]; ldw = 1024; k0 = (r / 32) * 64; n0 = (r % 32) * 32; WT = Wo; ldt = 1024; drow0 = n0; f8s = 32.f; }
        else if ((r -= I_O) < I_IN) { W = in[15]; ldw = 3072; k0 = (r / 96) * 64; n0 = (r % 96) * 32; WT = Win; ldt = 1024; drow0 = n0; }
        else if ((r -= I_IN) < I_OUT) { W = in[30]; ldw = 1024; k0 = (r / 32) * 64; n0 = (r % 32) * 32; WT = Wout; ldt = 1024; drow0 = n0; }
        else if ((r -= I_OUT) < I_GU) {
            const int sub = r % 128, mat = r / 128, which = mat & 1, le = mat >> 1;
            W = (which ? in[36] : in[35]) + (size_t)le * 1024 * 256; ldw = 256; k0 = (sub / 8) * 64; n0 = (sub % 8) * 32;
            WT = (bf16*)((unsigned char*)Wgu + (size_t)le * 512 * 1024); ldt = 1024; drow0 = (n0 >> 7) * 256 + which * 128 + (n0 & 127); f8s = 32.f; }
        else { r -= I_GU;
            const int sub = r % 128, mat = r / 128, slot = mat & 1, lb = mat >> 1, layer = lb / 24, bk = lb % 24;
            int ii, jj; pg8::pair_of(bk % 6, ii, jj); const int e = (bk / 6) * 4 + (slot ? jj : ii);
            W = in[37] + (size_t)(layer * 16 + e) * 256 * 1024; ldw = 1024; k0 = (sub / 32) * 64; n0 = (sub % 32) * 32;
            WT = (bf16*)((unsigned char*)Wdn + (size_t)lb * 1024 * 512); ldt = 512; drow0 = n0; dcol0 = slot * 256; f8s = 32.f; }
        if (f8s != 0.f) transpose_item8(W, ldw, k0, n0, (unsigned char*)WT, ldt, drow0, dcol0, scr, F.lane, f8s, it < I_D);
        else transpose_item(W, ldw, k0, n0, WT, ldt, drow0, dcol0, scr, F.lane, it < I_D);
    }
    { const int gt = F.vcu * NTHR + F.tid, NGT = F.G * NTHR; const v4u z = {0u, 0u, 0u, 0u};
      for (int i = gt; i < 64 * 1024 / 16; i += NGT) *(v4u*)((unsigned char*)Wd + (size_t)448 * 1024 + (size_t)i * 16) = z;
    }
    { const int gt = F.vcu * NTHR + F.tid, NGT = F.G * NTHR; float* RT = (float*)(ws + WS_ROPE); const int* posi = (const int*)in[2];
      const float inv = __builtin_amdgcn_exp2f(-0.41524101186092029f * (float)(gt & 31));
      for (int i = gt; i < T * 32; i += NGT) { const int t = i >> 5;
        float sn, cs; sincosf((float)posi[t] * inv, &sn, &cs); *(v2u*)(RT + (size_t)i * 2) = (v2u){__float_as_uint(cs), __float_as_uint(sn)}; } }
    { const int gt = F.vcu * NTHR + F.tid, NGT = F.G * NTHR; bf16* W4S = (bf16*)(ws + WS_W4S); const float* w4 = in[28];
      for (int i = gt; i < 4096 * 8; i += NGT) { const int col = i & 4095, oct = i >> 12; float w[8];
#pragma unroll
        for (int q = 0; q < 8; ++q) w[q] = w4[(size_t)(8 * oct + q) * 4096 + col];
        unsigned hw[4], lw[4];
#pragma unroll
        for (int q = 0; q < 4; ++q) { const unsigned h2 = pk2(w[2 * q], w[2 * q + 1]); hw[q] = h2;
          lw[q] = pk2(w[2 * q] - __uint_as_float(h2 << 16), w[2 * q + 1] - __uint_as_float(h2 & 0xffff0000u)); }
        bf16* d = W4S + (size_t)col * 256 + 8 * oct; const v4u hv = {hw[0], hw[1], hw[2], hw[3]}, lv = {lw[0], lw[1], lw[2], lw[3]}, zv = {0u, 0u, 0u, 0u};
        *(v4u*)d = hv; *(v4u*)(d + 64) = hv; *(v4u*)(d + 128) = lv; *(v4u*)(d + 192) = zv; } }
    __syncthreads();
    { bf16* HDp = (bf16*)(ws + WS_HDNS); float* wl = (float*)(F.lds + RING_OFF); float* sv = wl + 161 * 64 + F.wave * 64;
      for (int i = F.tid; i < 161 * 64; i += NTHR) wl[i] = i < 33 * 64 ? in[19][i] : (i < 97 * 64 ? in[22][i - 33 * 64] : in[25][i - 97 * 64]);
      __syncthreads();
      const int j = F.lane; const float b1 = in[20][j], f1 = in[21][j], b2 = in[23][j], f2 = in[24][j], b3 = in[26][j], f3 = in[27][j];
      for (int t = F.gw; t < 4096; t += F.NGW) {
        float zf = 0.f;
        { const float w = 6.2831855f * (float)t * (1.f / 4096.f);
          if (j == 0) zf = (float)t / 4095.f;
          else if (j <= 16) { const float fr = 1e-4f + (float)(j - 1) * ((15.f - 1e-4f) / 15.f); zf = cosf(fr * w); }
          else if (j <= 32) { const float fr = 1e-4f + (float)(j - 17) * ((15.f - 1e-4f) / 15.f); zf = -sinf(fr * w); } }
        sv[j] = zf; LDS_WAIT();
        float a = b1;
#pragma unroll
        for (int k = 0; k < 33; ++k) a += sv[k] * wl[k * 64 + j];
        float h = sinf(f1 * a); LDS_WAIT(); sv[j] = h; LDS_WAIT();
        a = b2;
#pragma unroll 16
        for (int k = 0; k < 64; ++k) a += sv[k] * wl[(33 + k) * 64 + j];
        h = sinf(f2 * a); LDS_WAIT(); sv[j] = h; LDS_WAIT();
        a = b3;
#pragma unroll 16
        for (int k = 0; k < 64; ++k) a += sv[k] * wl[(97 + k) * 64 + j];
        h = sinf(f3 * a); LDS_WAIT();
        const unsigned hi = pk2(h, 0.f) & 0xffffu; const float lo = h - bf2f((unsigned short)hi); const unsigned lob = pk2(lo, 0.f) & 0xffffu;
        bf16* d = HDp + (size_t)t * 256 + j; d[0] = (bf16)hi; d[64] = (bf16)lob; d[128] = (bf16)hi; d[192] = 0;
      } }
    __syncthreads();
    { float* cact = (float*)(F.lds + RING_OFF); float* red = cact + 8 * 1024;
      float* MOD = (float*)(ws + WS_MOD);
      for (int i = F.tid; i < 8 * 1024; i += NTHR) { const float x = in[1][i]; cact[(i & 1023) * 8 + (i >> 10)] = x / (1.f + __expf(-x)); }
      __syncthreads();
      for (int it = F.vcu; it < 2 * 96; it += F.G) {
        const int layer = it / 96, cb = it - 96 * layer, r4 = F.lane >> 4, cq = F.lane & 15;
        const float* W = in[3] + (size_t)layer * 1024 * 6144 + cb * 64 + 4 * cq + (size_t)(F.wave * 128 + r4) * 6144;
        f32x4 acc[8];
#pragma unroll
        for (int b = 0; b < 8; ++b) acc[b] = (f32x4){0.f, 0.f, 0.f, 0.f};
#pragma unroll
        for (int hf = 0; hf < 2; ++hf) { f32x4 wv[16];
#pragma unroll
          for (int q = 0; q < 16; ++q) wv[q] = *(const f32x4*)(W + (size_t)(4 * (16 * hf + q)) * 6144);
#pragma unroll
          for (int q = 0; q < 16; ++q) { const int kk = 4 * (16 * hf + q) + r4; const float* cp = cact + (F.wave * 128 + kk) * 8; const f32x4 c0 = *(const f32x4*)cp, c1 = *(const f32x4*)(cp + 4);
#pragma unroll
            for (int b = 0; b < 8; ++b) acc[b] += (b < 4 ? c0[b & 3] : c1[b & 3]) * wv[q]; } }
#pragma unroll
        for (int b = 0; b < 8; ++b) *(f32x4*)(red + ((F.wave * 4 + r4) * 8 + b) * 64 + 4 * cq) = acc[b];
        __syncthreads();
        { const int b = F.tid >> 6, col = F.tid & 63; float s = in[4][layer * 6144 + cb * 64 + col];
#pragma unroll 8
          for (int p = 0; p < 32; ++p) s += red[(p * 8 + b) * 64 + col];
          MOD[((size_t)layer * 8 + b) * 6144 + cb * 64 + col] = s; }
        __syncthreads();
      } }
}

template <class TX> __device__ __forceinline__ f32x4 ldrow4(const TX* p);
template <> __device__ __forceinline__ f32x4 ldrow4<float>(const float* p) { return *(const __attribute__((address_space(1))) f32x4*)p; }
template <> __device__ __forceinline__ f32x4 ldrow4<bf16>(const bf16* p) { const v2u w = *(const __attribute__((address_space(1))) v2u*)p; f32x4 r; r[0] = __uint_as_float(w.x << 16); r[1] = __uint_as_float(w.x & 0xffff0000u); r[2] = __uint_as_float(w.y << 16); r[3] = __uint_as_float(w.y & 0xffff0000u); return r; }
template <class TX, bool OUT8 = false> __device__ __forceinline__ void norm_mod_phase(const Ctx& F, const TX* X, const float* g, const float* sc, const float* sh, bf16* OUT) {
    for (int ch = F.gw; ch < T / 16; ch += F.NGW) {
        const int r0 = ch * 16, b = r0 >> 12;
        f32x4 A[4], S[4];
#pragma unroll
        for (int j = 0; j < 4; ++j) { const int col = 4 * F.lane + 256 * j; const f32x4 gv = *(const f32x4*)(g + col), sv = *(const f32x4*)(sc + (size_t)b * 6144 + col); A[j] = gv * (1.f + sv); S[j] = *(const f32x4*)(sh + (size_t)b * 6144 + col); }
        const TX* xr = X + (size_t)r0 * DM + 4 * F.lane;
        f32x4 nx[4];
#pragma unroll
        for (int j = 0; j < 4; ++j) nx[j] = ldrow4<TX>(xr + 256 * j);
        for (int rr = 0; rr < 16; ++rr) {
            f32x4 v[4]; float ss = 0.f;
#pragma unroll
            for (int j = 0; j < 4; ++j) { v[j] = nx[j]; ss += (v[j].x * v[j].x + v[j].y * v[j].y) + (v[j].z * v[j].z + v[j].w * v[j].w); }
            if (rr < 15) {
#pragma unroll
                for (int j = 0; j < 4; ++j) nx[j] = ldrow4<TX>(xr + (size_t)(rr + 1) * DM + 256 * j); }
            const float rstd = rsqrtf(wave_sum(ss) * (1.f / DM) + EPS);
            if constexpr (OUT8) { unsigned char* orow = (unsigned char*)OUT + (size_t)(r0 + rr) * DM + 4 * F.lane;
#pragma unroll
                for (int j = 0; j < 4; ++j) { const f32x4 o = v[j] * rstd * A[j] + S[j]; int p = 0; p = __builtin_amdgcn_cvt_pk_fp8_f32(o.x, o.y, p, false); p = __builtin_amdgcn_cvt_pk_fp8_f32(o.z, o.w, p, true); *(int*)(orow + 256 * j) = p; } }
            else { bf16* orow = OUT + (size_t)(r0 + rr) * DM + 4 * F.lane;
#pragma unroll
                for (int j = 0; j < 4; ++j) { const f32x4 o = v[j] * rstd * A[j] + S[j]; v2u w; w.x = pk2(o.x, o.y); w.y = pk2(o.z, o.w); *(v2u*)(orow + 256 * j) = w; } } }
    }
}

__device__ __forceinline__ void lat_post_phase(const Ctx& F, const float* LAT, const float* qag, const float* kvag, const float* kng, const float* rope, bf16* CQN, bf16* CKVN, bf16* KPE) {
    const int l = F.lane;
    const f32x4 gq = *(const f32x4*)(qag + 4 * l);
    const f32x4 g2 = l < 32 ? *(const f32x4*)(kvag + 4 * l) : (l < 48 ? *(const f32x4*)(kng + 128 + 4 * (l - 32)) : (f32x4){0.f, 0.f, 0.f, 0.f});
    f32x4 na = *(const f32x4*)(LAT + (size_t)F.gw * 512 + 4 * l), nc = l < 48 ? *(const f32x4*)(LAT + (size_t)F.gw * 512 + 256 + 4 * l) : (f32x4){0.f, 0.f, 0.f, 0.f};
    for (int row = F.gw; row < T; row += F.NGW) {
        const f32x4 a = na, c = nc;
        if (row + F.NGW < T) { const float* nr = LAT + (size_t)(row + F.NGW) * 512; na = *(const f32x4*)(nr + 4 * l); if (l < 48) nc = *(const f32x4*)(nr + 256 + 4 * l); }
        const float sq = (a.x * a.x + a.y * a.y) + (a.z * a.z + a.w * a.w), sc = (c.x * c.x + c.y * c.y) + (c.z * c.z + c.w * c.w);
        const float s_q = wave_sum(sq), s_kv = wave_sum(l < 32 ? sc : 0.f), s_pe = wave_sum((l >= 32 && l < 48) ? sc : 0.f);
        const float rq = rsqrtf(s_q * (1.f / 256.f) + EPS), rkv = rsqrtf(s_kv * (1.f / 128.f) + EPS), rpe = rsqrtf(s_pe * (1.f / 64.f) + EPS);
        { const f32x4 o = a * rq * gq; v2u w; w.x = pk2(o.x, o.y); w.y = pk2(o.z, o.w); *(v2u*)(CQN + (size_t)row * 256 + 4 * l) = w; }
        if (l < 32) { const f32x4 o = c * rkv * g2; v2u w; w.x = pk2(o.x, o.y); w.y = pk2(o.z, o.w); *(v2u*)(CKVN + (size_t)row * 256 + 4 * l) = w; }
        else { v2u w; w.x = 0u; w.y = 0u; *(v2u*)(CKVN + (size_t)row * 256 + 128 + 4 * (l - 32)) = w; }
        const f32x4 n = c * rpe * g2;
        f32x4 other; other.x = __shfl_xor(n.x, 8); other.y = __shfl_xor(n.y, 8); other.z = __shfl_xor(n.z, 8); other.w = __shfl_xor(n.w, 8);
        if (l >= 32 && l < 48) { const bool first = l < 40; const int e0 = 4 * ((l - 32) & 7);
            float o[4];
#pragma unroll
            for (int i = 0; i < 4; ++i) { const int e = e0 + i; const float cs = rope[(size_t)row * 64 + e * 2], sn = rope[(size_t)row * 64 + e * 2 + 1];
                const float mine = n[i], oth = other[i]; o[i] = first ? (mine * cs - oth * sn) : (oth * sn + mine * cs); }
            v2u w; w.x = pk2(o[0], o[1]); w.y = pk2(o[2], o[3]); *(v2u*)(KPE + (size_t)row * 64 + 4 * (l - 32)) = w; }
    }
}

__device__ __forceinline__ void knorm_phase(const Ctx& F, bf16* KV, const float* kng) {
    const int l = F.lane, h = l >> 3, e0 = (l & 7) * 16;
    float g[16];
#pragma unroll
    for (int i = 0; i < 16; ++i) g[i] = kng[e0 + i];
    for (int row = F.gw; row < T; row += F.NGW) {
        bf16* p = KV + (size_t)row * 2048 + h * 256 + e0;
        const v4u r0 = *(const v4u*)p, r1 = *(const v4u*)(p + 8);
        float f[16]; const unsigned w[8] = {r0.x, r0.y, r0.z, r0.w, r1.x, r1.y, r1.z, r1.w};
        float ss = 0.f;
#pragma unroll
        for (int i = 0; i < 8; ++i) { f[2 * i] = __uint_as_float(w[i] << 16); f[2 * i + 1] = __uint_as_float(w[i] & 0xffff0000u); ss += f[2 * i] * f[2 * i] + f[2 * i + 1] * f[2 * i + 1]; }
        ss += __shfl_xor(ss, 1); ss += __shfl_xor(ss, 2); ss += __shfl_xor(ss, 4);
        const float r = rsqrtf(ss * (1.f / 128.f) + EPS);
        v4u o0, o1;
        o0.x = pk2(f[0] * r * g[0], f[1] * r * g[1]); o0.y = pk2(f[2] * r * g[2], f[3] * r * g[3]); o0.z = pk2(f[4] * r * g[4], f[5] * r * g[5]); o0.w = pk2(f[6] * r * g[6], f[7] * r * g[7]);
        o1.x = pk2(f[8] * r * g[8], f[9] * r * g[9]); o1.y = pk2(f[10] * r * g[10], f[11] * r * g[11]); o1.z = pk2(f[12] * r * g[12], f[13] * r * g[13]); o1.w = pk2(f[14] * r * g[14], f[15] * r * g[15]);
        *(v4u*)p = o0; *(v4u*)(p + 8) = o1;
    }
}

__device__ __forceinline__ void route_phase(const Ctx& F, const bf16* X, const float* g, const float* sc, const float* sh, const float* wg, const float* bg, const float* we, const float* be,
                                            bf16* XN2, int* LIST, float* WL, gu32* cnt) {
    float* W20 = (float*)(F.lds + RING_OFF); constexpr int W20P = 1028;
    unsigned* lcnt = (unsigned*)(F.lds + RED_OFF); unsigned* gbase = lcnt + 32;
    if (F.tid < 24) lcnt[F.tid] = 0u;
    for (int i = F.tid; i < 4 * 1024; i += NTHR) W20[(i & 3) * W20P + (i >> 2)] = wg[i];
    for (int i = F.tid; i < 16 * 1024; i += NTHR) W20[(4 + (i & 15)) * W20P + (i >> 4)] = we[i];
    __syncthreads();
    float bgv[4];
#pragma unroll
    for (int i = 0; i < 4; ++i) bgv[i] = bg[i];
    for (int ch0 = 0; ch0 < T / 16; ch0 += F.NGW) {
        const int ch = ch0 + F.gw; const bool act = ch < T / 16; const int r0 = (act ? ch : 0) * 16, b = r0 >> 12;
        f32x4 A[4], S[4];
#pragma unroll
        for (int j = 0; j < 4; ++j) { const int col = 4 * F.lane + 256 * j; const f32x4 gv = *(const f32x4*)(g + col), sv = *(const f32x4*)(sc + (size_t)b * 6144 + col); A[j] = gv * (1.f + sv); S[j] = *(const f32x4*)(sh + (size_t)b * 6144 + col); }
        const bf16* xr = X + (size_t)r0 * DM + 4 * F.lane;
        f32x4 nx[4];
#pragma unroll
        for (int j = 0; j < 4; ++j) nx[j] = ldrow4<bf16>(xr + 256 * j);
        int my_bk = 0; float my_wlo = 0.f, my_whi = 0.f;
        for (int rr = 0; rr < 16; ++rr) { const int row = r0 + rr;
            f32x4 v[4]; float ss = 0.f;
#pragma unroll
            for (int j = 0; j < 4; ++j) { v[j] = nx[j]; ss += (v[j].x * v[j].x + v[j].y * v[j].y) + (v[j].z * v[j].z + v[j].w * v[j].w); }
            if (rr < 15) {
#pragma unroll
                for (int j = 0; j < 4; ++j) nx[j] = ldrow4<bf16>(xr + (size_t)(rr + 1) * DM + 256 * j); }
            const float rstd = rsqrtf(wave_sum(ss) * (1.f / DM) + EPS);
            unsigned char* orow = (unsigned char*)XN2 + (size_t)row * DM + 4 * F.lane;
#pragma unroll
            for (int j = 0; j < 4; ++j) { v[j] = v[j] * rstd * A[j] + S[j]; int p = 0; p = __builtin_amdgcn_cvt_pk_fp8_f32(v[j].x, v[j].y, p, false); p = __builtin_amdgcn_cvt_pk_fp8_f32(v[j].z, v[j].w, p, true); *(int*)(orow + 256 * j) = p; }
            float gl[4];
#pragma unroll
            for (int o = 0; o < 4; ++o) { float a = 0.f;
#pragma unroll
                for (int j = 0; j < 4; ++j) { const f32x4 w = *(const f32x4*)(W20 + o * W20P + 4 * F.lane + 256 * j); a += (v[j].x * w.x + v[j].y * w.y) + (v[j].z * w.z + v[j].w * w.w); }
                gl[o] = wave_sum(a) + bgv[o]; }
            int gi = 0; float gm = gl[0]; if (gl[1] > gm) { gm = gl[1]; gi = 1; } if (gl[2] > gm) { gm = gl[2]; gi = 2; } if (gl[3] > gm) { gm = gl[3]; gi = 3; }
            gi = __builtin_amdgcn_readfirstlane(gi);
            const float gw_ = 1.f / (__expf(gl[0] - gm) + __expf(gl[1] - gm) + __expf(gl[2] - gm) + __expf(gl[3] - gm));
            const float* We = W20 + (4 + 4 * gi) * W20P + 4 * F.lane;
            float e[4];
#pragma unroll
            for (int k = 0; k < 4; ++k) { float a = 0.f;
#pragma unroll
                for (int j = 0; j < 4; ++j) { const f32x4 w = *(const f32x4*)(We + k * W20P + 256 * j); a += (v[j].x * w.x + v[j].y * w.y) + (v[j].z * w.z + v[j].w * w.w); }
                e[k] = wave_sum(a) + be[4 * gi + k]; }
            int i1 = 0; float m1 = e[0];
#pragma unroll
            for (int k = 1; k < 4; ++k) if (e[k] > m1) { m1 = e[k]; i1 = k; }
            int i2 = -1; float m2 = -3.0e38f;
#pragma unroll
            for (int k = 0; k < 4; ++k) if (k != i1 && e[k] > m2) { m2 = e[k]; i2 = k; }
            const float t2 = __expf(m2 - m1), w1 = gw_ / (1.f + t2), w2 = gw_ * t2 / (1.f + t2);
            const int ilo = i1 < i2 ? i1 : i2, ihi = i1 < i2 ? i2 : i1; const float wlo = i1 < i2 ? w1 : w2, whi = i1 < i2 ? w2 : w1;
            const int pi = ilo == 0 ? ihi - 1 : (ilo == 1 ? ihi + 1 : 5), bk = gi * 6 + pi;
            if (F.lane == rr) { my_bk = bk; my_wlo = wlo; my_whi = whi; }
        }
        unsigned rank = 0u; if (F.lane < 16 && act) rank = __hip_atomic_fetch_add(lcnt + my_bk, 1u, __ATOMIC_RELAXED, __HIP_MEMORY_SCOPE_WORKGROUP);
        __syncthreads();
        if (F.tid < 24) { const unsigned n = lcnt[F.tid]; gbase[F.tid] = n ? __hip_atomic_fetch_add(cnt + F.tid * 64, n, RLX_AGENT) : 0u; }
        __syncthreads();
        if (F.lane < 16 && act) { const unsigned pos = gbase[my_bk] + rank;
            LIST[my_bk * 32768 + pos] = r0 + F.lane; float2 ww; ww.x = my_wlo; ww.y = my_whi; *(float2*)(WL + ((size_t)my_bk * 32768 + pos) * 2) = ww; }
        __syncthreads();
        if (F.tid < 24) lcnt[F.tid] = 0u;
        __syncthreads();
    }
}
__device__ __forceinline__ void moe_table(const Ctx& F, const gu32* cnt) {
    int* tinfo = (int*)(F.lds + TINFO_OFF);
    __syncthreads();
    if (F.tid == 0) { int nt = 0;
        for (int b = 0; b < 24; ++b) { const int c = (int)__hip_atomic_load(cnt + b * 64, RLX_AGENT); const int tiles = (c + 255) >> 8;
            tinfo[256 + b] = nt * 256; tinfo[288 + b] = c; for (int i = 0; i < tiles; ++i) tinfo[1 + nt + i] = b; nt += tiles; }
        tinfo[0] = nt; }
    __syncthreads();
}
__device__ __forceinline__ void permute_phase(const Ctx& F, const bf16* XN2, const int* ROUTE, bf16* XN2S, int* TOKW) {
    const int* tinfo = (const int*)(F.lds + TINFO_OFF);
    for (int ch = F.gw; ch < T / 4; ch += F.NGW) {
        v4i r[4]; v4u a[4], bq[4];
#pragma unroll
        for (int i = 0; i < 4; ++i) { const int row = ch * 4 + i; r[i] = *(const v4i*)(ROUTE + (size_t)row * 4);
            a[i] = *(const v4u*)(XN2 + (size_t)row * DM + 8 * F.lane); bq[i] = *(const v4u*)(XN2 + (size_t)row * DM + 512 + 8 * F.lane); }
#pragma unroll
        for (int i = 0; i < 4; ++i) { const int row = ch * 4 + i, srow = tinfo[256 + r[i].x] + r[i].y;
            *(v4u*)(XN2S + (size_t)srow * DM + 8 * F.lane) = a[i]; *(v4u*)(XN2S + (size_t)srow * DM + 512 + 8 * F.lane) = bq[i];
            if (F.lane == 0) { v4i w; w.x = row; w.y = r[i].z; w.z = r[i].w; w.w = 0; *(v4i*)(TOKW + (size_t)srow * 4) = w; } }
    }
}

constexpr float W32C[16] = {1.f, 0.98078528040323043f, 0.92387953251128674f, 0.83146961230254524f, 0.70710678118654752f, 0.55557023301960218f, 0.38268343236508977f, 0.19509032201612825f,
                            0.f, -0.19509032201612825f, -0.38268343236508977f, -0.55557023301960218f, -0.70710678118654752f, -0.83146961230254524f, -0.92387953251128674f, -0.98078528040323043f};
constexpr float W32S[16] = {0.f, 0.19509032201612825f, 0.38268343236508977f, 0.55557023301960218f, 0.70710678118654752f, 0.83146961230254524f, 0.92387953251128674f, 0.98078528040323043f,
                            1.f, 0.98078528040323043f, 0.92387953251128674f, 0.83146961230254524f, 0.70710678118654752f, 0.55557023301960218f, 0.38268343236508977f, 0.19509032201612825f};
struct FftTw { const c32* T1; c32 tob; const c32* T2; };
template <int A> __device__ __forceinline__ c32 mul_to(c32 x, c32 tob) { const c32 y = cmul(x, tob); return cmk(y.x * W32C[A] + y.y * W32S[A], y.y * W32C[A] - y.x * W32S[A]); }
template <int A> __device__ __forceinline__ c32 mul_toc(c32 x, c32 tob) { const c32 y = cmulc(x, tob); return cmk(y.x * W32C[A] - y.y * W32S[A], y.y * W32C[A] + y.x * W32S[A]); }
#define TO_ALL(OP) OP(0) OP(1) OP(2) OP(3) OP(4) OP(5) OP(6) OP(7) OP(8) OP(9) OP(10) OP(11) OP(12) OP(13) OP(14) OP(15)
__device__ __forceinline__ void fft_twiddles(FftTw& W, int gt, c32* t1tab, c32* t2tab, int tid) {
    if (tid < 256) { float s, c; sincosf(-6.283185307179586f * (float)(((tid >> 4) * (tid & 15)) & 255) * (1.f / 256.f), &s, &c); t2tab[(tid >> 4) * 17 + (tid & 15)] = cmk(c, s); }
    for (int i = tid; i < 4096; i += NTHR) { const int p = i >> 8, t = i & 255; float s, c; sincosf(-6.283185307179586f * (float)((t * p) & 4095) * (1.f / 4096.f), &s, &c); t1tab[i] = cmk(c, s); }
    { float s, c; sincosf(-6.283185307179586f * (float)gt * (1.f / 8192.f), &s, &c); W.tob = cmk(c, s); }
    W.T1 = t1tab + gt; W.T2 = t2tab + (gt & 15) * 17;
    __syncthreads();
}
__device__ __forceinline__ void fft_forward_a(c32 (&v)[16], const FftTw& W, c32* ex, int gt) {
    __syncthreads();
    fft_fwd_a(v, W.T1, ex, gt);
    __syncthreads();
}
__device__ __forceinline__ void fft_forward_bc(c32 (&v)[16], const FftTw& W, c32* ex, int gt) {
    fft_fwd_b(v, W.T2, ex, ex, gt);
    __builtin_amdgcn_wave_barrier(); asm volatile("" ::: "memory");
    fft_fwd_c(v, ex, gt);
}
__device__ __forceinline__ void fft_forward(c32 (&v)[16], const FftTw& W, c32* ex, int gt) { fft_forward_a(v, W, ex, gt); fft_forward_bc(v, W, ex, gt); }
__device__ __forceinline__ void fft_inverse(c32 (&v)[16], const FftTw& W, c32* ex, int gt) {
    __builtin_amdgcn_wave_barrier(); asm volatile("" ::: "memory");
    fft_inv_a(v, ex, gt);
    __builtin_amdgcn_wave_barrier(); asm volatile("" ::: "memory");
    fft_inv_b(v, W.T2, ex, ex, gt);
    __syncthreads();
    fft_inv_c(v, W.T1, ex, gt);
}
__device__ __forceinline__ void filter_phase(const Ctx& F, const float* HT, const float* fbias, c32* KF) {
    const int g = __builtin_amdgcn_readfirstlane(F.tid >> 8), gt = F.tid & 255;
    c32* ex = (c32*)(F.lds + RING_OFF + g * 36864);
    float* rev = (float*)ex;
    float* red = (float*)(F.lds + RED_OFF);
    FftTw W; fft_twiddles(W, gt, (c32*)(F.lds + RING_OFF + 73728), (c32*)(F.lds + RING_OFF + 110592), F.tid);
    for (int d = F.vcu; d < DM; d += F.G) {
        int gtv = gt; asm volatile("" : "+v"(gtv));
        const float delta = fabsf(-120.39728043259361f + (float)d * ((40.546510810816436f + 120.39728043259361f) / 1023.f));
        const float* hfp = HT + (size_t)(g * 2048 + d) * 4096; const float* hbp = HT + (size_t)(g * 2048 + 1024 + d) * 4096;
        float hf[16], hb[16]; float sf = 0.f, sb = 0.f;
#pragma unroll
        for (int a = 0; a < 16; ++a) { const int t = 256 * a + gtv; const float dec = __expf(-((float)t * (1.f / 4095.f)) * delta); hf[a] = hfp[t] * dec; hb[a] = hbp[t] * dec; sf += fabsf(hf[a]); sb += fabsf(hb[a]); }
        sf = wave_sum(sf); sb = wave_sum(sb);
        __syncthreads();
        if (F.lane == 0) { red[F.wave * 2] = sf; red[F.wave * 2 + 1] = sb; }
        __syncthreads();
        sf = red[g * 8] + red[g * 8 + 2] + red[g * 8 + 4] + red[g * 8 + 6]; sb = red[g * 8 + 1] + red[g * 8 + 3] + red[g * 8 + 5] + red[g * 8 + 7];
        const float nf = 1.f / (sf + EPS) * (1.f / 8192.f), nb = 1.f / (sb + EPS) * (1.f / 8192.f);
#pragma unroll
        for (int a = 0; a < 16; ++a) rev[256 * a + gt] = hb[a] * nb;
        __syncthreads();
        c32 v[16];
#pragma unroll
        for (int a = 0; a < 16; ++a) { const int n = 256 * a + gt; hb[a] = n == 0 ? 0.f : rev[4096 - n]; hf[a] *= nf; v[a] = cmk(hf[a] + hb[a], 0.f); }
        fft_forward(v, W, ex, gt);
        c32* kf = KF + ((size_t)(d * 2 + g) * 2) * 4096; const float fb = fbias[g * 1024 + d] * (1.f / 4096.f);
#pragma unroll
        for (int i = 0; i < 16; ++i) kf[i * 256 + gtv] = cmk(v[i].x + fb, v[i].y);
#define OPX(A) v[A] = mul_to<A>(cmk(hf[A] - hb[A], 0.f), W.tob);
        TO_ALL(OPX)
#undef OPX
        fft_forward(v, W, ex, gt);
#pragma unroll
        for (int i = 0; i < 16; ++i) kf[4096 + i * 256 + gtv] = v[i];
    }
}
__device__ __forceinline__ void long_conv(c32 (&z)[16], const c32* kf, const FftTw& W, c32* ex, int gt) {
    typedef float f32x2v __attribute__((ext_vector_type(2))); typedef __attribute__((address_space(1))) const f32x2v gc32;
    c32 v[16], k[16]; int gk = gt; asm volatile("" : "+v"(gk));
#define OPX(A) v[A] = mul_to<A>(z[A], W.tob);
    TO_ALL(OPX)
#undef OPX
    fft_forward_a(v, W, ex, gt);
    asm volatile("" ::: "memory");
#pragma unroll
    for (int i = 0; i < 16; ++i) { const f32x2v t_ = ((gc32*)kf)[4096 + i * 256 + gk]; k[i] = cmk(t_.x, t_.y); }
    fft_forward_bc(v, W, ex, gt);
#pragma unroll
    for (int i = 0; i < 16; ++i) v[i] = cmul(v[i], k[i]);
    fft_inverse(v, W, ex, gt);
#define OPX(A) v[A] = mul_toc<A>(v[A], W.tob);
    TO_ALL(OPX)
#undef OPX
    fft_forward_a(z, W, ex, gt);
    asm volatile("" ::: "memory");
#pragma unroll
    for (int i = 0; i < 16; ++i) { const f32x2v t_ = ((gc32*)kf)[i * 256 + gk]; k[i] = cmk(t_.x, t_.y); }
    fft_forward_bc(z, W, ex, gt);
#pragma unroll
    for (int i = 0; i < 16; ++i) z[i] = cmul(z[i], k[i]);
    fft_inverse(z, W, ex, gt);
#pragma unroll
    for (int a = 0; a < 16; ++a) z[a] = cadd(z[a], v[a]);
}
struct RawSeq { v4u r[2][2]; };
__device__ __forceinline__ void raw_issue(RawSeq& q, const bf16* urow, int b0, int gt) {
    typedef __attribute__((address_space(1))) const v4u gv4u;
    asm volatile("" : "+v"(gt));
#pragma unroll
    for (int s_ = 0; s_ < 2; ++s_)
#pragma unroll
        for (int i = 0; i < 2; ++i) q.r[s_][i] = *(gv4u*)(urow + (size_t)(b0 + s_) * SEQ + (gt + 256 * i) * 8);
}
__device__ __forceinline__ void stage_conv3(c32 (&o)[16], const RawSeq& q, float w0, float w1, float w2, float cb, bf16* stg, int gt) {
    constexpr int SS = 4112;
    __syncthreads();
#pragma unroll
    for (int s_ = 0; s_ < 2; ++s_) {
#pragma unroll
        for (int i = 0; i < 2; ++i) *(v4u*)(stg + s_ * SS + 8 + (gt + 256 * i) * 8) = q.r[s_][i];
        if (gt == 0) { stg[s_ * SS + 7] = 0; stg[s_ * SS + 4104] = 0; } }
    __syncthreads();
#pragma unroll
    for (int a = 0; a < 16; ++a) { const int t = 256 * a + gt; float r[2];
#pragma unroll
        for (int s_ = 0; s_ < 2; ++s_) { const bf16* sp = stg + s_ * SS + 7 + t; r[s_] = w0 * bf2f(sp[0]) + w1 * bf2f(sp[1]) + w2 * bf2f(sp[2]) + cb; }
        o[a] = cmk(r[0], r[1]); if ((a & 3) == 3) __builtin_amdgcn_sched_barrier(0); }
}
__device__ __forceinline__ void conv_phase(const Ctx& F, const bf16* UT, const c32* KF, const float* convw, const float* convb, bf16* ZT) {
    const int g = __builtin_amdgcn_readfirstlane(F.tid >> 8), gt = F.tid & 255;
    c32* ex = (c32*)(F.lds + RING_OFF + g * 36864);
    bf16* stg = (bf16*)ex;
    FftTw W; fft_twiddles(W, gt, (c32*)(F.lds + RING_OFF + 73728), (c32*)(F.lds + RING_OFF + 110592), F.tid);
    RawSeq raw;
    if (F.vcu < DM) raw_issue(raw, UT + (size_t)(2048 + F.vcu) * T, (2 * g) * 2, gt);
    for (int d = F.vcu; d < DM; d += F.G) {
        const c32* kf0 = KF + ((size_t)(d * 2 + 0) * 2) * 4096; const c32* kf1 = KF + ((size_t)(d * 2 + 1) * 2) * 4096;
        for (int pp = 0; pp < 2; ++pp) { const int b0 = (2 * g + pp) * 2;
            int gtv = gt; asm volatile("" : "+v"(gtv));
            c32 z[16], gate[16];
            { const int c = 2048 + d; stage_conv3(z, raw, convw[c], convw[3072 + c], convw[6144 + c], convb[c], stg, gtv); }
            raw_issue(raw, UT + (size_t)d * T, b0, gtv);
            long_conv(z, kf0, W, ex, gtv);
            { const int c = d; stage_conv3(gate, raw, convw[c], convw[3072 + c], convw[6144 + c], convb[c], stg, gtv); }
            raw_issue(raw, UT + (size_t)(1024 + d) * T, b0, gtv);
#pragma unroll
            for (int a = 0; a < 16; ++a) z[a] = cmk(z[a].x * gate[a].x, z[a].y * gate[a].y);
            long_conv(z, kf1, W, ex, gtv);
            { const int c = 1024 + d; stage_conv3(gate, raw, convw[c], convw[3072 + c], convw[6144 + c], convb[c], stg, gtv); }
            { const int dn = pp == 0 ? d : d + F.G; if (dn < DM) raw_issue(raw, UT + (size_t)(2048 + dn) * T, pp == 0 ? b0 + 2 : (2 * g) * 2, gtv); }
            bf16* zr = ZT + (size_t)d * T + (size_t)b0 * SEQ;
#pragma unroll
            for (int a = 0; a < 16; ++a) { const int t = 256 * a + gtv; const unsigned pk = pk2(z[a].x * gate[a].x, z[a].y * gate[a].y); zr[t] = (bf16)(pk & 0xffffu); zr[SEQ + t] = (bf16)(pk >> 16); }
        }
    }
}
__device__ __forceinline__ void transpose_phase(const Ctx& F, const bf16* ZT, bf16* Z) {
    bf16* tile = (bf16*)(F.lds + RING_OFF + F.wave * 8704);
    const int l = F.lane;
    v4u x[8];
    if (F.gw < 16 * 512) { const int d0 = (F.gw & 15) * 64, t0 = (F.gw >> 4) * 64;
#pragma unroll
        for (int i = 0; i < 8; ++i) x[i] = *(const v4u*)(ZT + (size_t)(d0 + i * 8 + (l >> 3)) * T + t0 + (l & 7) * 8); }
    for (int it = F.gw; it < 16 * 512; it += F.NGW) { const int d0 = (it & 15) * 64, t0 = (it >> 4) * 64;
#pragma unroll
        for (int i = 0; i < 8; ++i) { const int dr = i * 8 + (l >> 3), c = l & 7;
            v2u* p = (v2u*)(tile + dr * 68 + c * 8); v2u a; a.x = x[i].x; a.y = x[i].y; p[0] = a; a.x = x[i].z; a.y = x[i].w; p[1] = a; }
        const int itn = it + F.NGW;
        if (itn < 16 * 512) { const int dn = (itn & 15) * 64, tn = (itn >> 4) * 64;
#pragma unroll
            for (int i = 0; i < 8; ++i) x[i] = *(const v4u*)(ZT + (size_t)(dn + i * 8 + (l >> 3)) * T + tn + (l & 7) * 8); }
        LDS_WAIT();
#pragma unroll
        for (int i = 0; i < 8; ++i) { const int tr = i * 8 + (l >> 3), c = l & 7; unsigned short e[8];
#pragma unroll
            for (int k = 0; k < 8; ++k) e[k] = tile[(c * 8 + k) * 68 + tr];
            v4u o; o.x = e[0] | ((unsigned)e[1] << 16); o.y = e[2] | ((unsigned)e[3] << 16); o.z = e[4] | ((unsigned)e[5] << 16); o.w = e[6] | ((unsigned)e[7] << 16);
            *(v4u*)(Z + (size_t)(t0 + tr) * DM + d0 + c * 8) = o; }
        LDS_WAIT();
    }
}

constexpr int NPH = 22;
constexpr int seam_id(int k) { return k == 0 ? 0 : k == 1 ? 1 : k == 2 ? 2 : k == 4 ? 3 : k == 6 ? 4 : k == 7 ? 5 : k == 8 ? 6 : k == 10 ? 7 : k == 11 ? 8 : k == 12 ? 9 : k == 14 ? 10 : k == 15 ? 11 : k == 16 ? 12 : k == 17 ? 13 : k == 18 ? 14 : k == 20 ? 15 : -100; }
#ifdef PROBE_SEAM
__device__ __forceinline__ unsigned long long probe_now() { unsigned long long t; asm volatile("s_memrealtime %0\n\ts_waitcnt lgkmcnt(0)" : "=s"(t) :: "memory"); return t; }
#define SEAMHOOK(id) do { if ((id) == PROBE_SEAM) { const unsigned long long t1_ = probe_now(); while (probe_now() < t1_ + (t1_ - tlast_)) __builtin_amdgcn_s_sleep(4); } \
                          if ((id) + 1 == PROBE_SEAM) tlast_ = probe_now(); } while (0)
#define SEAMBAR(k) do { xcd_barrier(bar); SEAMHOOK(seam_id(k)); } while (0)
#else
#define SEAMHOOK(id) do { } while (0)
#define SEAMBAR(k) xcd_barrier(bar)
#endif
#define MOE_PHASES(L) do { \
        const int mb = 8 + 10 * L; \
        if (IN(mb)) { PH_ARGS; const float* mod = WSP(float, WS_MOD) + (size_t)L * 8 * 6144; gu32* cnt = (gu32*)(ws + WS_CTL) + CW_CNT + L * 24 * 64; \
            route_phase(F, WSP(bf16, WS_XR), in[6] + L * 1024, mod + 4 * 1024, mod + 3 * 1024, in[31] + L * 4096, in[32] + L * 4, in[33] + L * 16384, in[34] + L * 16, WSP(bf16, WS_XN2), WSP(int, WS_LIST), WSP(float, WS_WL), cnt); \
            if (L == 0) { __syncthreads();        \
                pg8::Gemm gmh{WSP(bf16, WS_W4S), WSP(bf16, WS_HDNS), 4096, 4096, 256}; pg8::StaticOrder Sh; Sh.init(4096, 4096, F.G, (int)blockIdx.x); pg8::EpiF32 Eh{WSP(float, WS_HT), 4096}; \
                REP(11) pg8::gemm_phase<pg8::EpiF32, pg8::StaticOrder, true, true>(ring, gmh, Sh, Eh, F.tid); } } \
        if (IN(mb) && IN(mb + 2)) SEAMBAR(mb); \
        if (IN(mb + 2)) { PH_ARGS; gu32* cnt = (gu32*)(ws + WS_CTL) + CW_CNT + L * 24 * 64; moe_table(F, cnt); \
              \
            pg8::Gemm gm{WSP(bf16, WS_XN2), (const bf16*)(ws + WS_WGU + (size_t)L * 16 * 512 * 1024), MS_ROWS, 8192, 512}; pg8::MoeOrder S{tinfo, F.G, F.vcu, 0, WSP(int, WS_LIST)}; pg8::EpiSwiGLU E{WSP(unsigned char, WS_HACT), WSP(float, WS_WL), tinfo}; \
            REP(10) pg8::gemm_phase_gather<pg8::EpiSwiGLU, pg8::MoeOrder, true, true, 5>(ring, gm, S, E, F.tid); } SEAM(mb + 2); \
        if (IN(mb + 3)) { PH_ARGS; gu32* cnt = (gu32*)(ws + WS_CTL) + CW_CNT + L * 24 * 64; moe_table(F, cnt); const float* mod = WSP(float, WS_MOD) + (size_t)L * 8 * 6144; \
            pg8::Gemm gm{WSP(bf16, WS_HACT), (const bf16*)(ws + WS_WDN + (size_t)L * 24 * 1024 * 512), MS_ROWS, 24 * 1024, 256};   pg8::MoeOrder S{tinfo, F.G, F.vcu, 1, WSP(int, WS_LIST)}; if (L == 0) { pg8::EpiMoeOut<bf16> E{WSP(bf16, WS_XR), WSP(bf16, WS_XR), mod + 5 * 1024, WSP(int, WS_LIST), tinfo, (PG8_LAS float*)((PG8_LAS unsigned char*)lds + EPIX_OFF)}; pg8::gemm_phase<pg8::EpiMoeOut<bf16>, pg8::MoeOrder, true, true, 8>(ring, gm, S, E, F.tid); } \
            else { pg8::EpiMoeOut<float> E{WSP(bf16, WS_XR), out, mod + 5 * 1024, WSP(int, WS_LIST), tinfo, (PG8_LAS float*)((PG8_LAS unsigned char*)lds + EPIX_OFF)}; pg8::gemm_phase<pg8::EpiMoeOut<float>, pg8::MoeOrder, true, true, 8>(ring, gm, S, E, F.tid); } \
            if (L == 0) { __syncthreads(); REP(13) filter_phase(F, WSP(float, WS_HT), in[29], WSP(c32, WS_KF)); }       \
            } \
    } while (0)
struct Args { const float* in[38]; float* out; unsigned char* ws; int ph_lo, ph_hi; };
static_assert(sizeof(Args) == 38 * 8 + 8 + 8 + 8, "Args layout (read back through the kernarg segment pointer)");
__global__ void __launch_bounds__(NTHR, 2) fwd_kernel(Args args) {
    extern __shared__ __attribute__((aligned(16))) unsigned char lds[];
#define MK_CTX(F, tx) Ctx F; F.lds = lds; F.tid = (tx); F.lane = F.tid & 63; F.wave = __builtin_amdgcn_readfirstlane(F.tid >> 6); \
    F.G = gridDim.x; { const int bx = blockIdx.x; F.vcu = (F.G % 8 == 0) ? (bx % 8) * (F.G / 8) + bx / 8 : bx; } F.gw = F.vcu * NWAVES + F.wave; F.NGW = F.G * NWAVES
    for (int u = threadIdx.x; u < (LDS_BYTES - LDSCTL_OFF) / 4; u += NTHR) ((LAS unsigned*)((LAS unsigned char*)lds + LDSCTL_OFF))[u] = 0u;
    __syncthreads();
    const int wave_s_ = __builtin_amdgcn_readfirstlane(threadIdx.x >> 6);
    const int lo = args.ph_lo, hi = args.ph_hi;
    const bool use_bar = (hi - lo) > 1;
    XcdBarrier bar; bar.bar = (unsigned*)(args.ws + WS_CTL) + CW_BAR; bar.x = 0; bar.st = nullptr; bar.w0 = 0;
    if (use_bar) bar = xcd_barrier_post((unsigned*)(args.ws + WS_CTL) + CW_BAR, (volatile LAS unsigned*)((LAS unsigned char*)lds + MISC_OFF) + 8);
    bar.w0 = (wave_s_ == 0) ? 1 : 0;
#ifndef PHMASK
#define PHMASK 0xFFFFFFFFu
#endif
#define IN(k) (((PHMASK >> ((k) >= 18 ? (k) - 10 : (k))) & 1u) && lo <= (k) && (k) < hi)
#ifndef REPMASK
#define REPMASK 0u
#endif
#define NREP(k) (((REPMASK >> (k)) & 1u) ? 2 : 1)
#define REP(k) for (int rep_ = 0; rep_ < NREP(k); ++rep_)
#define SEAM(k) do { if (IN(k) && IN((k) + 1)) SEAMBAR(k); } while (0)
#define PH_STR2(x) #x
#define PH_STR(x) PH_STR2(x)
#define PH_ARGS int opq_ = 0; asm volatile("; PHMARK line " PH_STR(__LINE__) : "+s"(opq_)); const In in{opq_}; unsigned char* const ws = karg_ws(opq_); float* const out = karg_out(opq_); (void)in; (void)ws; (void)out; int tx_; asm volatile("v_mbcnt_lo_u32_b32 %0, -1, 0\n\tv_mbcnt_hi_u32_b32 %0, -1, %0" : "=v"(tx_)); tx_ += wave_s_ * 64; MK_CTX(F, tx_)
#define WSP(type, off) ((type*)(ws + (off)))
    PG8_LAS unsigned char* ring = (PG8_LAS unsigned char*)lds + RING_OFF;
    const PG8_LAS int* tinfo = (const PG8_LAS int*)((PG8_LAS unsigned char*)lds + TINFO_OFF);

#ifdef PROBE_SEAM
    unsigned long long tlast_ = probe_now();
#endif
    if (IN(0)) { PH_ARGS; REP(0) p0_prologue(F, in, ws); } SEAM(0);

            if (IN(1)) { PH_ARGS; const float* mod = WSP(float, WS_MOD); REP(1) norm_mod_phase<float, true>(F, in[0], in[5], mod + 1024, mod, WSP(bf16, WS_XN)); } SEAM(1);
            if (IN(2)) { PH_ARGS; pg8::Gemm gm{WSP(bf16, WS_XN), WSP(bf16, WS_WD), T, 512, 512};   pg8::StaticOrder S; S.init(T, 512, F.G, (int)blockIdx.x);
                pg8::EpiLat E{WSP(unsigned char, WS_CQN), WSP(bf16, WS_CKVN), WSP(unsigned char, WS_KPE), in[8], in[9], in[13], WSP(float, WS_ROPE), (PG8_LAS float*)((PG8_LAS unsigned char*)lds + EPIX_OFF)};
                REP(2) pg8::gemm_phase<pg8::EpiLat, pg8::StaticOrder, true, true, 5>(ring, gm, S, E, F.tid); }
            if (IN(2) && IN(4)) SEAMBAR(2);
            if (IN(4)) { REP(4) {
                { PH_ARGS; pg8::Gemm gm{WSP(bf16, WS_CQN), WSP(bf16, WS_WUQ), T, 1536, 128};   pg8::StaticOrder S; S.init(T, 1536, F.G, (int)blockIdx.x); pg8::EpiBf16R E{WSP(bf16, WS_QRAW), 1536, nullptr};
                  pg8::gemm_phase<pg8::EpiBf16R, pg8::StaticOrder, true, true, 4>(ring, gm, S, E, F.tid); }
                { PH_ARGS; pg8::Gemm gm{WSP(bf16, WS_CKVN), WSP(bf16, WS_WUKV), T, 1024, 128};   pg8::StaticOrder S; S.init(T, 1024, F.G, (int)blockIdx.x);
                  pg8::EpiK8 E{WSP(unsigned char, WS_K8), in[13], (PG8_LAS float*)((PG8_LAS unsigned char*)lds + EPIX_OFF)};
                  pg8::gemm_phase<pg8::EpiK8, pg8::StaticOrder, true, true>(ring, gm, S, E, F.tid); }
                { PH_ARGS; pg8::Gemm gm{WSP(bf16, WS_WUKV) + 1024 * 128, WSP(bf16, WS_CKVN), 1024, T, 128}; pg8::StaticOrder S; S.init(1024, T, F.G, (int)blockIdx.x);
                  pg8::EpiF8T E{WSP(unsigned char, WS_VT8), T};
                  pg8::gemm_phase<pg8::EpiF8T, pg8::StaticOrder, true, true>(ring, gm, S, E, F.tid); } }
            } if (IN(4) && IN(6)) SEAMBAR(4);
            if (IN(6)) { PH_ARGS;
                const float* qg = in[12]; const float* kg = in[13];
                float gqn = 0.f, gkn = 0.f, gqp = 0.f, gkp = 0.f;
                for (int i = 0; i < 128; ++i) { gqn = fmaxf(gqn, fabsf(qg[i])); gkn = fmaxf(gkn, fabsf(kg[i])); }
                for (int i = 128; i < 192; ++i) { gqp = fmaxf(gqp, fabsf(qg[i])); gkp = fmaxf(gkp, fabsf(kg[i])); }
                const float smaxC = (128.f * gqn * gkn + 64.f * gqp * gkp) * (0.072168783648703220f * 1.4426950408889634f);
                unsigned redo_mask = 0u;
                if (smaxC < 60.f) for (int rep_ = 0; rep_ < NREP(6); ++rep_) { int i = 0;
                    for (int u = F.vcu; u < 1024; u += F.G, ++i) { const int b = u >> 7, h = (u >> 4) & 7, qb = u & 15;
                        if (att::attn_unit<false>(b, h, qb * 256, WSP(bf16, WS_QRAW), WSP(unsigned char, WS_VT8), WSP(unsigned char, WS_K8), WSP(unsigned char, WS_KPE), WSP(bf16, WS_O), WSP(float, WS_ROPE), qg, smaxC, (char*)lds + RING_OFF, F.tid)) redo_mask |= 1u << (i & 31); } }
                else redo_mask = 0xffffffffu;
                redo_mask = (unsigned)__builtin_amdgcn_readfirstlane((int)redo_mask);
                if (redo_mask) { int i = 0;
                    for (int u = F.vcu; u < 1024; u += F.G, ++i) { const int b = u >> 7, h = (u >> 4) & 7, qb = u & 15;
                        if ((redo_mask >> (i & 31)) & 1u) (void)att::attn_unit<true>(b, h, qb * 256, WSP(bf16, WS_QRAW), WSP(unsigned char, WS_VT8), WSP(unsigned char, WS_K8), WSP(unsigned char, WS_KPE), WSP(bf16, WS_O), WSP(float, WS_ROPE), qg, smaxC, (char*)lds + RING_OFF, F.tid); } }
            } SEAM(6);
            if (IN(7)) { PH_ARGS; pg8::Gemm gm{WSP(bf16, WS_O), WSP(bf16, WS_WO), T, 1024, 512};   pg8::StaticOrder S; S.init(T, 1024, F.G, (int)blockIdx.x); pg8::EpiResGate<float, bf16> E{in[0], WSP(bf16, WS_XR), WSP(float, WS_MOD) + 2048, 1024};
                REP(7) pg8::gemm_phase<pg8::EpiResGate<float, bf16>, pg8::StaticOrder, true, true, 10>(ring, gm, S, E, F.tid); } SEAM(7);
    MOE_PHASES(0); SEAM(11);
            if (IN(12)) { PH_ARGS; const float* mod = WSP(float, WS_MOD) + 8 * 6144; REP(12) norm_mod_phase(F, WSP(bf16, WS_XR), in[5] + 1024, mod + 1024, mod, (bf16*)out); }
            if (IN(12) && IN(14)) SEAMBAR(12);
            if (IN(14)) { PH_ARGS; pg8::Gemm gm{WSP(bf16, WS_WIN), (const bf16*)out, 3072, T, 1024}; pg8::StaticOrder S; S.init(3072, T, F.G, (int)blockIdx.x); pg8::EpiBf16R E{WSP(bf16, WS_UT), T, in[16]};
                REP(14) pg8::gemm_phase<pg8::EpiBf16R, pg8::StaticOrder, true, true>(ring, gm, S, E, F.tid); } SEAM(14);
            if (IN(15)) { PH_ARGS; for (int rep = 0; rep < NREP(15); ++rep) conv_phase(F, WSP(bf16, WS_UT), WSP(c32, WS_KF), in[17], in[18], (bf16*)out); } SEAM(15);
            if (IN(16)) { PH_ARGS; REP(16) transpose_phase(F, (const bf16*)out, WSP(bf16, WS_Z)); } SEAM(16);
            if (IN(17)) { PH_ARGS; pg8::Gemm gm{WSP(bf16, WS_Z), WSP(bf16, WS_WOUT), T, 1024, 1024}; pg8::StaticOrder S; S.init(T, 1024, F.G, (int)blockIdx.x); pg8::EpiResGate<bf16, bf16> E{WSP(bf16, WS_XR), WSP(bf16, WS_XR), WSP(float, WS_MOD) + 8 * 6144 + 2048, 1024};
                pg8::gemm_phase<pg8::EpiResGate<bf16, bf16>, pg8::StaticOrder, true, true>(ring, gm, S, E, F.tid); } SEAM(17);
    MOE_PHASES(1);
#ifdef PROBE_SEAM
    SEAMHOOK(16);
#endif
#undef IN
#undef SEAM
}

#ifndef ONE_LAUNCH
#define ONE_LAUNCH 1
#endif
extern "C" void kernel_launch(void* const* d_in, const int* in_sizes, int n_in, void* d_out, int out_size, void* d_ws, size_t ws_size, hipStream_t stream) {
    static int grid = 0;
    if (grid == 0) {
        if (n_in != 38 || in_sizes[0] != T * DM || out_size != T * DM || ws_size < WS_END) { fprintf(stderr, "kernel_launch: shape mismatch n_in %d in0 %d out %d ws %zu\n", n_in, n_in > 0 ? in_sizes[0] : -1, out_size, ws_size); grid = -1; return; }
        int dev = 0, cus = 0, per_cu = 0;
        if (hipGetDevice(&dev) != hipSuccess || hipDeviceGetAttribute(&cus, hipDeviceAttributeMultiprocessorCount, dev) != hipSuccess) { grid = -1; return; }
        if (hipFuncSetAttribute((const void*)fwd_kernel, hipFuncAttributeMaxDynamicSharedMemorySize, LDS_BYTES) != hipSuccess) { fprintf(stderr, "kernel_launch: hipFuncSetAttribute failed\n"); grid = -1; return; }
        if (hipOccupancyMaxActiveBlocksPerMultiprocessor(&per_cu, (const void*)fwd_kernel, NTHR, LDS_BYTES) != hipSuccess || per_cu < 1) { fprintf(stderr, "kernel_launch: occupancy query says %d\n", per_cu); }
        (void)hipGetLastError();
        grid = cus;
    }
    if (grid < 0) return;
    if (hipMemsetAsync((char*)d_ws + WS_CTL, 0, CTL_ZERO_BYTES, stream) != hipSuccess) return;
    Args a{};
    for (int i = 0; i < 38; ++i) a.in[i] = (const float*)d_in[i];
    a.out = (float*)d_out; a.ws = (unsigned char*)d_ws;
#if ONE_LAUNCH
    a.ph_lo = 0; a.ph_hi = NPH;
    hipLaunchKernelGGL(fwd_kernel, dim3(grid), dim3(NTHR), LDS_BYTES, stream, a);
#else
    for (int p = 0; p < NPH; ++p) { a.ph_lo = p; a.ph_hi = p + 1; hipLaunchKernelGGL(fwd_kernel, dim3(grid), dim3(NTHR), LDS_BYTES, stream, a); }
#endif
    const hipError_t le = hipPeekAtLastError();
    if (le != hipSuccess) fprintf(stderr, "kernel_launch: launch failed: %s\n", hipGetErrorName(le));
}
```

```cpp
#include <hip/hip_runtime.h>
#include <cstdio>
#include <cstdint>
namespace pg8 {
#define PG8_LAS __attribute__((address_space(3)))
typedef unsigned short bf16_t;
typedef short bf16x8 __attribute__((ext_vector_type(8)));
typedef float f32x4 __attribute__((ext_vector_type(4)));
typedef unsigned u32x4 __attribute__((ext_vector_type(4)));
typedef int v4i_t __attribute__((ext_vector_type(4)));
typedef int v8i_t __attribute__((ext_vector_type(8)));
constexpr int BM = 256, BK = 64, HALF = 128, HTB = HALF * BK * 2  , STAGE_BYTES = 8 * HTB, NXCD = 8, WGM = 8;

__host__ __device__ __forceinline__ int lds_byte(int r, int c) { const int st = (r >> 4) * 2 + (c >> 5), rr = r & 15, cc = c & 31, ob = rr * 64 + cc * 2; return st * 1024 + (ob ^ (((ob >> 9) & 1) << 5)); }
__host__ __device__ __forceinline__ void stage_rc(int b, int& R, int& C) { const int st = b / 1024, sb = b % 1024, swz = sb ^ (((sb >> 9) & 1) << 5); R = (st >> 1) * 16 + swz / 64; C = (st & 1) * 32 + (swz % 64) / 2; }
__host__ __device__ __forceinline__ int perm32(int rho) { const int n = rho >> 4, i = rho & 15; return 8 * (i >> 2) + 4 * n + (i & 3); }

struct Unit { int pm, pn; };
struct Gemm { const bf16_t* A; const bf16_t* Bt; int M, N, K; };

struct StaticOrder {
    int nM, nN, nwg, G, c;
    __host__ __device__ void init(int M, int N, int G_, int c_) { nM = M / BM; nN = N / BM; nwg = nM * nN; G = G_; c = c_; }
    __host__ __device__ bool next(int i, Unit& u) const {
        const long L = (long)i * G + c; if (L >= nwg) return false;
        int wgid = (int)L; { const int q = nwg / NXCD, r = nwg % NXCD, xcd = wgid % NXCD, off = wgid / NXCD; wgid = (xcd < r ? xcd * (q + 1) : r * (q + 1) + (xcd - r) * q) + off; }
        const int nig = WGM * nN, gid = wgid / nig, fm = gid * WGM, gsz = (nM - fm) < WGM ? (nM - fm) : WGM;
        u.pm = fm + ((wgid % nig) % gsz); u.pn = (wgid % nig) / gsz; return true;
    }
    __device__ __forceinline__ void a_ready(const Unit&) const {}
    __device__ __forceinline__ void done(const Unit&) const {}
};

__device__ __forceinline__ unsigned cvt_pk_bf16(float lo, float hi) { unsigned r; asm volatile("v_cvt_pk_bf16_f32 %0, %1, %2" : "=v"(r) : "v"(lo), "v"(hi)); return r; }
typedef float f32x2 __attribute__((ext_vector_type(2)));
typedef unsigned u32x2 __attribute__((ext_vector_type(2)));
struct EpiF32 {
    static constexpr bool PERM = false, AFTER_DRAIN = false;
    float* C; int ldc;
    __device__ __forceinline__ void operator()(const f32x4 (&acc)[2][2][4][2], const Unit& u, int wr, int wc, int fr, int fq) const {
        const int row0 = u.pm * BM + wr * 64 + fr, col0 = u.pn * BM + wc * 32 + 4 * fq;
#pragma unroll
        for (int ai = 0; ai < 2; ++ai)
#pragma unroll
            for (int m = 0; m < 4; ++m) { float* rowp = C + (size_t)(row0 + ai * HALF + m * 16) * ldc + col0;
#pragma unroll
                for (int bj = 0; bj < 2; ++bj)
#pragma unroll
                    for (int n = 0; n < 2; ++n) *(f32x4*)(rowp + bj * HALF + n * 16) = acc[ai][bj][m][n]; }
    }
};
struct EpiBf16R {
    static constexpr bool PERM = true, AFTER_DRAIN = false;
    bf16_t* O; int ldc; const float* rowbias;
    __device__ __forceinline__ void operator()(const f32x4 (&acc)[2][2][4][2], const Unit& u, int wr, int wc, int fr, int fq) const {
        const int row0 = u.pm * BM + wr * 64 + fr, col0 = u.pn * BM + wc * 32 + 8 * fq;
#pragma unroll
        for (int ai = 0; ai < 2; ++ai)
#pragma unroll
            for (int m = 0; m < 4; ++m) { const int row = row0 + ai * HALF + m * 16; bf16_t* rowp = O + (size_t)row * ldc + col0; const float rb = rowbias ? rowbias[row] : 0.f;
#pragma unroll
                for (int bj = 0; bj < 2; ++bj) { const f32x4 v0 = acc[ai][bj][m][0] + rb, v1 = acc[ai][bj][m][1] + rb;
                    u32x4 w; w.x = cvt_pk_bf16(v0[0], v0[1]); w.y = cvt_pk_bf16(v0[2], v0[3]); w.z = cvt_pk_bf16(v1[0], v1[1]); w.w = cvt_pk_bf16(v1[2], v1[3]);
                    *(u32x4*)(rowp + bj * HALF) = w; } }
    }
};
__device__ __forceinline__ f32x4 ld4(const float* p) { return *(const f32x4*)p; }
__device__ __forceinline__ f32x4 ld4(const bf16_t* p) { const u32x2 w = *(const u32x2*)p; f32x4 r; r[0] = __uint_as_float(w.x << 16); r[1] = __uint_as_float(w.x & 0xffff0000u); r[2] = __uint_as_float(w.y << 16); r[3] = __uint_as_float(w.y & 0xffff0000u); return r; }
__device__ __forceinline__ void st4(float* p, f32x4 v) { *(f32x4*)p = v; }
__device__ __forceinline__ void st4(bf16_t* p, f32x4 v) { u32x2 w; w.x = cvt_pk_bf16(v[0], v[1]); w.y = cvt_pk_bf16(v[2], v[3]); *(u32x2*)p = w; }
__device__ __forceinline__ f32x4 ldraw(const float* p) { return *(const f32x4*)p; }
__device__ __forceinline__ u32x2 ldraw(const bf16_t* p) { return *(const u32x2*)p; }
__device__ __forceinline__ f32x4 cvraw(f32x4 v) { return v; }
__device__ __forceinline__ f32x4 cvraw(u32x2 w) { f32x4 r; r[0] = __uint_as_float(w.x << 16); r[1] = __uint_as_float(w.x & 0xffff0000u); r[2] = __uint_as_float(w.y << 16); r[3] = __uint_as_float(w.y & 0xffff0000u); return r; }
template <class TB, class TO> struct EpiResGate {
    static constexpr bool PERM = false, AFTER_DRAIN = false;
    const TB* base; TO* out; const float* gate; int ldc;
    __device__ __forceinline__ void operator()(const f32x4 (&acc)[2][2][4][2], const Unit& u, int wr, int wc, int fr, int fq) const {
        const int row0 = u.pm * BM + wr * 64 + fr, col0 = u.pn * BM + wc * 32 + 4 * fq;
        const float* gp = gate + (size_t)(u.pm >> 4) * 6144 + col0;
        f32x4 gv[2][2];
#pragma unroll
        for (int bj = 0; bj < 2; ++bj)
#pragma unroll
            for (int n = 0; n < 2; ++n) gv[bj][n] = *(const f32x4*)(gp + bj * HALF + n * 16);
        constexpr int GB = sizeof(TB) == 2 ? 8 : 4;
        typedef decltype(ldraw(base)) raw_t;
#pragma unroll
        for (int g0 = 0; g0 < 8; g0 += GB) {
            raw_t bs[GB][2][2];
#pragma unroll
            for (int g = 0; g < GB; ++g) { const unsigned off = (unsigned)((row0 + ((g0 + g) >> 2) * HALF + ((g0 + g) & 3) * 16) * ldc + col0);
#pragma unroll
                for (int bj = 0; bj < 2; ++bj)
#pragma unroll
                    for (int n = 0; n < 2; ++n) bs[g][bj][n] = ldraw(base + off + bj * HALF + n * 16); }
#pragma unroll
            for (int g = 0; g < GB; ++g) { const int ai = (g0 + g) >> 2, m = (g0 + g) & 3; const unsigned off = (unsigned)((row0 + ai * HALF + m * 16) * ldc + col0);
#pragma unroll
                for (int bj = 0; bj < 2; ++bj)
#pragma unroll
                    for (int n = 0; n < 2; ++n) st4(out + off + bj * HALF + n * 16, cvraw(bs[g][bj][n]) + gv[bj][n] * acc[ai][bj][m][n]); }
            asm volatile("" ::: "memory"); }
    }
};
struct EpiLat {
    static constexpr bool PERM = false, AFTER_DRAIN = false;
    unsigned char* CQN  ; bf16_t* CKVN; unsigned char* KPE  ; const float* qag; const float* kvag; const float* kng; const float* rope; PG8_LAS float* P;
    __device__ __forceinline__ void operator()(const f32x4 (&acc)[2][2][4][2], const Unit& u, int wr, int wc, int, int) const {
        int ln = (int)__builtin_amdgcn_mbcnt_hi(~0u, __builtin_amdgcn_mbcnt_lo(~0u, 0u)); asm volatile("" : "+v"(ln)); const int fr = ln & 15, fq = ln >> 4;
        const int row0 = u.pm * BM + wr * 64 + fr;
#pragma unroll
        for (int ai = 0; ai < 2; ++ai)
#pragma unroll
            for (int m = 0; m < 4; ++m) { float s0 = 0.f, s1 = 0.f;
#pragma unroll
                for (int n = 0; n < 2; ++n) { const f32x4 a = acc[ai][0][m][n], b = acc[ai][1][m][n];
                    s0 += (a[0] * a[0] + a[1] * a[1]) + (a[2] * a[2] + a[3] * a[3]); s1 += (b[0] * b[0] + b[1] * b[1]) + (b[2] * b[2] + b[3] * b[3]); }
                s0 += __shfl_xor(s0, 16); s0 += __shfl_xor(s0, 32); s1 += __shfl_xor(s1, 16); s1 += __shfl_xor(s1, 32);
                if (fq == 0) { const int rl = ai * HALF + wr * 64 + m * 16 + fr; P[rl * 8 + wc] = s0; P[rl * 8 + 4 + wc] = s1; } }
        asm volatile("s_waitcnt lgkmcnt(0)" ::: "memory"); __builtin_amdgcn_s_barrier(); asm volatile("" ::: "memory");
        const int cl = wc * 32 + 4 * fq;
        if (u.pn == 0) {
            f32x4 g[2][2];
#pragma unroll
            for (int bj = 0; bj < 2; ++bj)
#pragma unroll
                for (int n = 0; n < 2; ++n) g[bj][n] = *(const f32x4*)(qag + bj * HALF + cl + 16 * n);
#pragma unroll
            for (int ai = 0; ai < 2; ++ai)
#pragma unroll
                for (int m = 0; m < 4; ++m) { const int rl = ai * HALF + wr * 64 + m * 16 + fr; const f32x4 pa = *(const PG8_LAS f32x4*)(P + rl * 8), pb = *(const PG8_LAS f32x4*)(P + rl * 8 + 4);
                    const float r = __builtin_amdgcn_rsqf((((pa[0] + pa[1]) + (pa[2] + pa[3])) + ((pb[0] + pb[1]) + (pb[2] + pb[3]))) * (1.f / 256.f) + 1e-6f);
                    unsigned char* rowp = CQN + (size_t)(row0 + ai * HALF + m * 16) * 256 + cl;
#pragma unroll
                    for (int bj = 0; bj < 2; ++bj)
#pragma unroll
                        for (int n = 0; n < 2; ++n) { const f32x4 v = acc[ai][bj][m][n] * r * g[bj][n]; int p = 0; p = __builtin_amdgcn_cvt_pk_fp8_f32(v[0], v[1], p, false); p = __builtin_amdgcn_cvt_pk_fp8_f32(v[2], v[3], p, true); *(int*)(rowp + bj * HALF + 16 * n) = p; } }
        } else {
            f32x4 gk[2], gp[2]; const int e0 = 16 * (wc & 1) + 4 * fq;
#pragma unroll
            for (int n = 0; n < 2; ++n) { gk[n] = *(const f32x4*)(kvag + cl + 16 * n); gp[n] = *(const f32x4*)(kng + 128 + e0 + 32 * n); }
#pragma unroll
            for (int ai = 0; ai < 2; ++ai)
#pragma unroll
                for (int m = 0; m < 4; ++m) { const int rl = ai * HALF + wr * 64 + m * 16 + fr; const f32x4 pa = *(const PG8_LAS f32x4*)(P + rl * 8), pb = *(const PG8_LAS f32x4*)(P + rl * 8 + 4);
                    const float rkv = __builtin_amdgcn_rsqf(((pa[0] + pa[1]) + (pa[2] + pa[3])) * (1.f / 128.f) + 1e-6f), rpe = __builtin_amdgcn_rsqf((pb[0] + pb[1]) * (1.f / 64.f) + 1e-6f);
                    const size_t row = (size_t)(row0 + ai * HALF + m * 16);
#pragma unroll
                    for (int n = 0; n < 2; ++n) { const f32x4 v = acc[ai][0][m][n] * rkv * gk[n]; u32x2 w; w.x = cvt_pk_bf16(v[0], v[1]); w.y = cvt_pk_bf16(v[2], v[3]); *(u32x2*)(CKVN + row * 128 + cl + 16 * n) = w; }
                    if (wc < 2) { const f32x4 x1 = acc[ai][1][m][0] * rpe * gp[0], x2 = acc[ai][1][m][1] * rpe * gp[1];
                        const f32x4 c0 = *(const f32x4*)(rope + row * 64 + e0 * 2), c1 = *(const f32x4*)(rope + row * 64 + e0 * 2 + 4);
                        const float cs[4] = {c0[0], c0[2], c1[0], c1[2]}, sn[4] = {c0[1], c0[3], c1[1], c1[3]};
                        float o1[4], o2[4];
#pragma unroll
                        for (int j = 0; j < 4; ++j) { o1[j] = x1[j] * cs[j] - x2[j] * sn[j]; o2[j] = x1[j] * sn[j] + x2[j] * cs[j]; }
                        int w1 = 0, w2 = 0; w1 = __builtin_amdgcn_cvt_pk_fp8_f32(o1[0], o1[1], w1, false); w1 = __builtin_amdgcn_cvt_pk_fp8_f32(o1[2], o1[3], w1, true); w2 = __builtin_amdgcn_cvt_pk_fp8_f32(o2[0], o2[1], w2, false); w2 = __builtin_amdgcn_cvt_pk_fp8_f32(o2[2], o2[3], w2, true);
                        *(int*)(KPE + row * 64 + e0) = w1; *(int*)(KPE + row * 64 + 32 + e0) = w2; }
                    asm volatile("" ::: "memory"); }
        }
        asm volatile("s_waitcnt lgkmcnt(0)" ::: "memory"); __builtin_amdgcn_s_barrier(); asm volatile("" ::: "memory");
    }
};
struct EpiK8 {
    static constexpr bool PERM = true, AFTER_DRAIN = false;
    unsigned char* K8; const float* kng; PG8_LAS float* P;
    __device__ __forceinline__ void operator()(const f32x4 (&acc)[2][2][4][2], const Unit& u, int wr, int wc, int, int) const {
        int ln = (int)__builtin_amdgcn_mbcnt_hi(~0u, __builtin_amdgcn_mbcnt_lo(~0u, 0u)); asm volatile("" : "+v"(ln)); const int fr = ln & 15, fq = ln >> 4;
#pragma unroll
        for (int ai = 0; ai < 2; ++ai)
#pragma unroll
            for (int m = 0; m < 4; ++m) {
#pragma unroll
                for (int bj = 0; bj < 2; ++bj) { const f32x4 a = acc[ai][bj][m][0], b = acc[ai][bj][m][1];
                    float s = (a[0] * a[0] + a[1] * a[1]) + (a[2] * a[2] + a[3] * a[3]) + (b[0] * b[0] + b[1] * b[1]) + (b[2] * b[2] + b[3] * b[3]);
                    s += __shfl_xor(s, 16); s += __shfl_xor(s, 32);
                    if (fq == 0) P[(ai * HALF + wr * 64 + m * 16 + fr) * 8 + bj * 4 + wc] = s; } }
        asm volatile("s_waitcnt lgkmcnt(0)" ::: "memory"); __builtin_amdgcn_s_barrier(); asm volatile("" ::: "memory");
        const f32x4 g0 = *(const f32x4*)(kng + wc * 32 + 8 * fq), g1 = *(const f32x4*)(kng + wc * 32 + 8 * fq + 4);
        const int row0 = u.pm * BM + wr * 64 + fr;
#pragma unroll
        for (int ai = 0; ai < 2; ++ai)
#pragma unroll
            for (int m = 0; m < 4; ++m) { const int rl = ai * HALF + wr * 64 + m * 16 + fr;
#pragma unroll
                for (int bj = 0; bj < 2; ++bj) { const f32x4 p4 = *(const PG8_LAS f32x4*)(P + rl * 8 + bj * 4);
                    const float r = __builtin_amdgcn_rsqf(((p4[0] + p4[1]) + (p4[2] + p4[3])) * (1.f / 128.f) + 1e-6f);
                    const f32x4 v0 = acc[ai][bj][m][0] * r * g0, v1 = acc[ai][bj][m][1] * r * g1;
                    int w0 = 0, w1 = 0; w0 = __builtin_amdgcn_cvt_pk_fp8_f32(v0[0], v0[1], w0, false); w0 = __builtin_amdgcn_cvt_pk_fp8_f32(v0[2], v0[3], w0, true); w1 = __builtin_amdgcn_cvt_pk_fp8_f32(v1[0], v1[1], w1, false); w1 = __builtin_amdgcn_cvt_pk_fp8_f32(v1[2], v1[3], w1, true);
                    u32x2 w; w.x = (unsigned)w0; w.y = (unsigned)w1; *(u32x2*)(K8 + ((size_t)(row0 + ai * HALF + m * 16) * 8 + 2 * u.pn + bj) * 128 + wc * 32 + 8 * fq) = w; } }
        asm volatile("s_waitcnt lgkmcnt(0)" ::: "memory"); __builtin_amdgcn_s_barrier(); asm volatile("" ::: "memory");
    }
};
struct EpiF8T {
    static constexpr bool PERM = true, AFTER_DRAIN = false;
    unsigned char* O; int ldc;
    __device__ __forceinline__ void operator()(const f32x4 (&acc)[2][2][4][2], const Unit& u, int wr, int wc, int fr, int fq) const {
        const int row0 = u.pm * BM + wr * 64 + fr, col0 = u.pn * BM + wc * 32 + 8 * fq;
#pragma unroll
        for (int ai = 0; ai < 2; ++ai)
#pragma unroll
            for (int m = 0; m < 4; ++m) { unsigned char* rowp = O + (size_t)(row0 + ai * HALF + m * 16) * ldc + col0;
#pragma unroll
                for (int bj = 0; bj < 2; ++bj) { const f32x4 v0 = acc[ai][bj][m][0], v1 = acc[ai][bj][m][1];
                    int w0 = 0, w1 = 0; w0 = __builtin_amdgcn_cvt_pk_fp8_f32(v0[0], v0[1], w0, false); w0 = __builtin_amdgcn_cvt_pk_fp8_f32(v0[2], v0[3], w0, true); w1 = __builtin_amdgcn_cvt_pk_fp8_f32(v1[0], v1[1], w1, false); w1 = __builtin_amdgcn_cvt_pk_fp8_f32(v1[2], v1[3], w1, true);
                    u32x2 w; w.x = (unsigned)w0; w.y = (unsigned)w1; *(u32x2*)(rowp + bj * HALF) = w; } }
    }
};
__device__ __forceinline__ void pair_of(int pi, int& i, int& j) { i = pi < 3 ? 0 : (pi < 5 ? 1 : 2); j = pi < 3 ? pi + 1 : (pi < 5 ? pi - 1 : 3); }
struct MoeOrder {
    const PG8_LAS int* tinfo; int G, c, mode; const int* list;
    __device__ __forceinline__ int tok(const Unit& u, int r) const { const int bk = tinfo[1 + u.pm], pos = u.pm * BM - tinfo[256 + bk] + r; return list[bk * 32768 + (pos < tinfo[288 + bk] ? pos : 0)]; }
    __device__ __forceinline__ bool next(int i, Unit& u) const {
        const long L = (long)i * G + c; const int nt = tinfo[0]; if (L >= 4L * nt) return false;
        const int mt = (int)(L >> 2), q = (int)(L & 3), bk = tinfo[1 + mt];
        u.pm = mt;
        if (mode == 0) { int ii, jj; pair_of(bk % 6, ii, jj); const int e = (bk / 6) * 4 + ((q >> 1) ? jj : ii); u.pn = e * 2 + (q & 1); }
        else u.pn = bk * 4 + q;
        return true;
    }
    __device__ __forceinline__ void a_ready(const Unit&) const {}
    __device__ __forceinline__ void done(const Unit&) const {}
};
struct EpiSwiGLU {
    static constexpr bool PERM = true, AFTER_DRAIN = false;
    unsigned char* H; const float* wl; const PG8_LAS int* tinfo;
    __device__ __forceinline__ void operator()(const f32x4 (&acc)[2][2][4][2], const Unit& u, int wr, int wc, int, int) const {
        int ln = (int)__builtin_amdgcn_mbcnt_hi(~0u, __builtin_amdgcn_mbcnt_lo(~0u, 0u)); asm volatile("" : "+v"(ln)); const int fr = ln & 15, fq = ln >> 4;
        const int bk = tinfo[1 + u.pm]; int ii, jj; pair_of(bk % 6, ii, jj);
        const int e = u.pn >> 1, hh = u.pn & 1, slot = (e == (bk / 6) * 4 + jj) ? 1 : 0;
        const int row0 = u.pm * BM + wr * 64 + fr, col0 = slot * 256 + hh * 128 + wc * 32 + 8 * fq;
        float w8[8];
#pragma unroll
        for (int g = 0; g < 8; ++g) { const int pos = row0 + (g >> 2) * HALF + (g & 3) * 16 - tinfo[256 + bk]; w8[g] = pos < tinfo[288 + bk] ? 8.f * wl[((size_t)bk * 32768 + pos) * 2 + slot] : 0.f; }
#pragma unroll
        for (int ai = 0; ai < 2; ++ai)
#pragma unroll
            for (int m = 0; m < 4; ++m) { const int row = row0 + ai * HALF + m * 16; const float w = w8[ai * 4 + m];
                float a[8];
#pragma unroll
                for (int n = 0; n < 2; ++n)
#pragma unroll
                    for (int j = 0; j < 4; ++j) { const float g = acc[ai][0][m][n][j], up = acc[ai][1][m][n][j];
                        const float sg = g * __builtin_amdgcn_rcpf(1.0f + __builtin_amdgcn_exp2f(-1.4426950408889634f * g)); a[n * 4 + j] = sg * up * w; }
                int o0 = 0, o1 = 0; o0 = __builtin_amdgcn_cvt_pk_fp8_f32(a[0], a[1], o0, false); o0 = __builtin_amdgcn_cvt_pk_fp8_f32(a[2], a[3], o0, true);
                o1 = __builtin_amdgcn_cvt_pk_fp8_f32(a[4], a[5], o1, false); o1 = __builtin_amdgcn_cvt_pk_fp8_f32(a[6], a[7], o1, true);
                u32x2 o; o.x = (unsigned)o0; o.y = (unsigned)o1; *(u32x2*)(H + (size_t)row * 512 + col0) = o; }
    }
};
template <class TO> struct EpiMoeOut {
    static constexpr bool PERM = false, AFTER_DRAIN = false;
    const bf16_t* xr; TO* out; const float* gate; const int* list; const PG8_LAS int* tinfo; PG8_LAS float* gl;
    __device__ __forceinline__ void operator()(const f32x4 (&acc)[2][2][4][2], const Unit& u, int wr, int wc, int, int) const {
        int ln = (int)__builtin_amdgcn_mbcnt_hi(~0u, __builtin_amdgcn_mbcnt_lo(~0u, 0u)); asm volatile("" : "+v"(ln)); const int fr = ln & 15, fq = ln >> 4;
        const int bk = tinfo[1 + u.pm], r_beg = tinfo[256 + bk], r_end = r_beg + tinfo[288 + bk];
        const int row0 = u.pm * BM + wr * 64 + fr, colu = (u.pn & 3) * BM, cl = wc * 32 + 4 * fq;
        int tk[8];
#pragma unroll
        for (int g = 0; g < 8; ++g) { const int row = row0 + (g >> 2) * HALF + (g & 3) * 16; tk[g] = row < r_end ? list[bk * 32768 + row - r_beg] : -1; }
        { const int t = (wr * 4 + wc) * 64 + fq * 16 + fr; const f32x4 gs = *(const f32x4*)(gate + (size_t)(t >> 6) * 6144 + colu + (t & 63) * 4);
          *(PG8_LAS f32x4*)(gl + (t >> 6) * 256 + (t & 63) * 4) = gs; }
        asm volatile("s_waitcnt lgkmcnt(0)" ::: "memory"); __builtin_amdgcn_s_barrier();
#pragma unroll
        for (int g0 = 0; g0 < 8; g0 += 4) {
            u32x2 bs[4][2][2];
#pragma unroll
            for (int g = 0; g < 4; ++g) { const unsigned xo = (unsigned)((tk[g0 + g] < 0 ? 0 : tk[g0 + g]) * 1024 + colu + cl);
#pragma unroll
                for (int bj = 0; bj < 2; ++bj)
#pragma unroll
                    for (int n = 0; n < 2; ++n) bs[g][bj][n] = ldraw(xr + xo + bj * HALF + n * 16); }
#pragma unroll
            for (int g = 0; g < 4; ++g) { const int ai = (g0 + g) >> 2, m = (g0 + g) & 3, tkg = tk[g0 + g];
                if (tkg >= 0) { TO* op = out + (size_t)tkg * 1024 + colu + cl; const PG8_LAS float* gp = gl + (tkg >> 12) * 256 + cl;
#pragma unroll
                    for (int bj = 0; bj < 2; ++bj)
#pragma unroll
                        for (int n = 0; n < 2; ++n) { const f32x4 gv = *(const PG8_LAS f32x4*)(gp + bj * HALF + n * 16); st4(op + bj * HALF + n * 16, cvraw(bs[g][bj][n]) + gv * acc[ai][bj][m][n]); } } }
            asm volatile("" ::: "memory"); }
    }
};
template <class Epi, class Sched, bool ALIGN_EPI = false, bool SP2 = false, int F8 = -1>
__device__ __forceinline__ void gemm_phase(PG8_LAS unsigned char* lds, const Gemm g, const Sched& S, const Epi& E, const int tid_in) {
    int tid = tid_in; asm volatile("" : "+v"(tid));
    const int wid = __builtin_amdgcn_readfirstlane(tid >> 6), lane = tid & 63, wr = wid >> 2, wc = wid & 3, fr = lane & 15, fq = lane >> 4;
    int K = g.K; asm volatile("" : "+s"(K)); const int nt = K / BK;
    unsigned voffA[2], voffB[2];
#pragma unroll
    for (int i = 0; i < 2; ++i) { int R, C; stage_rc(tid * 16 + i * 8192, R, C); const int Rb = Epi::PERM ? ((R & ~31) + perm32(R & 31)) : R;
        voffA[i] = (unsigned)(R * K + C) * 2u; voffB[i] = (unsigned)(Rb * K + C) * 2u; }
    const size_t kstep = (size_t)(BK * 2);
    const size_t hstep = (size_t)HALF * K * 2;
    const size_t tstep = 2 * hstep;
    const unsigned ldsw = (unsigned)wid * 1024u;
    const int aoff = lds_byte(wr * 64 + fr, fq * 8), boff = lds_byte(wc * 32 + fr, fq * 8);
#define PG8_SA(b, h) (((b) * 2 + (h)) * HTB)
#define PG8_SB(b, h) ((4 + (b) * 2 + (h)) * HTB)
#define PG8_STAGE(bufoff, gbase, voff) do { _Pragma("unroll") for (int _i = 0; _i < 2; ++_i) { unsigned vo_ = (voff)[_i]; asm volatile("" : "+v"(vo_));   \
        __builtin_amdgcn_global_load_lds((const unsigned*)((const char*)(gbase) + vo_), (PG8_LAS unsigned*)(lds + (bufoff) + ldsw + _i * 8192), 16, 0, 0); } } while (0)
#define PG8_LDA(dst, b, h) do { _Pragma("unroll") for (int m = 0; m < 4; ++m) { const bf16x8 x0_ = *(const PG8_LAS bf16x8*)(lds + PG8_SA(b, h) + aoff + m * 2048), x1_ = *(const PG8_LAS bf16x8*)(lds + PG8_SA(b, h) + aoff + m * 2048 + 1024); \
        if constexpr (F8 >= 0) dst##8[m] = PG8_CAT(x0_, x1_); else { dst[m][0] = x0_; dst[m][1] = x1_; } } } while (0)
#define PG8_LDB(dst, b, h) do { _Pragma("unroll") for (int n = 0; n < 2; ++n) { const bf16x8 x0_ = *(const PG8_LAS bf16x8*)(lds + PG8_SB(b, h) + boff + n * 2048), x1_ = *(const PG8_LAS bf16x8*)(lds + PG8_SB(b, h) + boff + n * 2048 + 1024); \
        if constexpr (F8 >= 0) dst##8[n] = PG8_CAT(x0_, x1_); else { dst[n][0] = x0_; dst[n][1] = x1_; } } } while (0)
#define PG8_CAT(x0, x1) ({ const v4i_t lo_ = __builtin_bit_cast(v4i_t, x0), hi_ = __builtin_bit_cast(v4i_t, x1); (v8i_t){lo_[0], lo_[1], lo_[2], lo_[3], hi_[0], hi_[1], hi_[2], hi_[3]}; })
#define PG8_MMA(ai, bj, At, Bt) do { __builtin_amdgcn_s_setprio(1); _Pragma("unroll") for (int m = 0; m < 4; ++m) _Pragma("unroll") for (int n = 0; n < 2; ++n) { \
        if constexpr (F8 >= 0) acc[ai][bj][m][n] = __builtin_amdgcn_mfma_scale_f32_16x16x128_f8f6f4(Bt##8[n], At##8[m], acc[ai][bj][m][n], 0, 0, 0, 0x7f7f7f7f, 0, (127 - F8) * 0x01010101); \
        else { _Pragma("unroll") for (int k = 0; k < 2; ++k) acc[ai][bj][m][n] = __builtin_amdgcn_mfma_f32_16x16x32_bf16(Bt[n][k], At[m][k], acc[ai][bj][m][n], 0, 0, 0); } } \
        __builtin_amdgcn_s_setprio(0); } while (0)
#define PG8_WAIT_V(n) asm volatile("s_waitcnt vmcnt(" #n ")" ::: "memory")
#define PG8_WAIT_L(n) asm volatile("s_waitcnt lgkmcnt(" #n ")" ::: "memory")
#define PG8_BAR __builtin_amdgcn_s_barrier()
#define PG8_SCHED __builtin_amdgcn_sched_barrier(0)
    Unit cur, nxt; int ui = 0;
    if (!S.next(0, cur)) return;
    f32x4 acc[2][2][4][2];
#pragma unroll
    for (int a = 0; a < 2; ++a)
#pragma unroll
        for (int b = 0; b < 2; ++b)
#pragma unroll
            for (int m = 0; m < 4; ++m)
#pragma unroll
                for (int n = 0; n < 2; ++n) acc[a][b][m][n] = (f32x4){0.f, 0.f, 0.f, 0.f};
    bf16x8 At[4][2], B0[2][2], B1[2][2]; v8i_t At8[4], B08[2], B18[2];
    const char* cA = (const char*)g.A + (size_t)cur.pm * tstep; const char* cB = (const char*)g.Bt + (size_t)cur.pn * tstep;
    S.a_ready(cur);
    if constexpr (SP2) {
        PG8_STAGE(PG8_SB(0, 0), cB, voffB); PG8_STAGE(PG8_SB(0, 1), cB + hstep, voffB); PG8_STAGE(PG8_SA(0, 0), cA, voffA); PG8_STAGE(PG8_SA(0, 1), cA + hstep, voffA);
        if (wr == 1) PG8_BAR;
        PG8_WAIT_V(2); PG8_BAR;
        PG8_STAGE(PG8_SB(1, 0), cB + kstep, voffB); PG8_STAGE(PG8_SA(1, 0), cA + kstep, voffA); PG8_STAGE(PG8_SB(1, 1), cB + hstep + kstep, voffB);
        PG8_WAIT_V(6); PG8_BAR;
    } else {
        PG8_STAGE(PG8_SB(0, 0), cB, voffB); PG8_STAGE(PG8_SA(0, 0), cA, voffA); PG8_STAGE(PG8_SB(0, 1), cB + hstep, voffB); PG8_STAGE(PG8_SA(0, 1), cA + hstep, voffA);
        if (wr == 1) PG8_BAR;
        PG8_WAIT_V(4); PG8_BAR;
        PG8_STAGE(PG8_SB(1, 0), cB + kstep, voffB); PG8_STAGE(PG8_SA(1, 0), cA + kstep, voffA); PG8_STAGE(PG8_SB(1, 1), cB + hstep + kstep, voffB);
        PG8_WAIT_V(6); PG8_BAR;
    }
    for (;;) {
        const bool has_next = S.next(ui + 1, nxt);
        const char* nA = has_next ? (const char*)g.A + (size_t)nxt.pm * tstep : cA; const char* nB = has_next ? (const char*)g.Bt + (size_t)nxt.pn * tstep : cB;
        for (int t = 0; t < nt; t += 2) {
            const bool last = (t == nt - 2);
            const char* a1 = cA + (size_t)(t + 1) * kstep;
            const char* a2 = last ? nA : cA + (size_t)(t + 2) * kstep; const char* b2 = last ? nB : cB + (size_t)(t + 2) * kstep;
            const char* a3 = a2 + kstep; const char* b3 = b2 + kstep;
            if (last && has_next) S.a_ready(nxt);
            if constexpr (SP2) {
            PG8_LDB(B0, 0, 0); PG8_LDB(B1, 0, 1); PG8_SCHED; PG8_LDA(At, 0, 0); PG8_STAGE(PG8_SA(1, 1), a1 + hstep, voffA);
            PG8_WAIT_V(8); PG8_WAIT_L(0); PG8_BAR; PG8_MMA(0, 0, At, B0); PG8_MMA(0, 1, At, B1); PG8_BAR; PG8_SCHED;
            PG8_LDA(At, 0, 1); PG8_STAGE(PG8_SB(0, 0), b2, voffB); PG8_STAGE(PG8_SB(0, 1), b2 + hstep, voffB); PG8_STAGE(PG8_SA(0, 0), a2, voffA);
            PG8_WAIT_V(8); PG8_WAIT_L(0); PG8_BAR; PG8_MMA(1, 0, At, B0); PG8_MMA(1, 1, At, B1); PG8_BAR; PG8_SCHED;
            PG8_LDB(B0, 1, 0); PG8_LDB(B1, 1, 1); PG8_SCHED; PG8_LDA(At, 1, 0); PG8_STAGE(PG8_SA(0, 1), a2 + hstep, voffA);
            PG8_WAIT_V(8); PG8_WAIT_L(0); PG8_BAR; PG8_MMA(0, 0, At, B0); PG8_MMA(0, 1, At, B1); PG8_BAR; PG8_SCHED;
            PG8_LDA(At, 1, 1); PG8_STAGE(PG8_SB(1, 0), b3, voffB); PG8_STAGE(PG8_SB(1, 1), b3 + hstep, voffB); PG8_STAGE(PG8_SA(1, 0), a3, voffA);
            PG8_WAIT_V(8); PG8_WAIT_L(0); PG8_BAR; PG8_MMA(1, 0, At, B0); PG8_MMA(1, 1, At, B1); PG8_BAR; PG8_SCHED;
            } else {
            PG8_LDB(B0, 0, 0); PG8_SCHED; PG8_LDA(At, 0, 0); PG8_STAGE(PG8_SA(1, 1), a1 + hstep, voffA);
            PG8_WAIT_L(8); PG8_BAR; PG8_WAIT_L(0); PG8_MMA(0, 0, At, B0); PG8_BAR; PG8_SCHED;
            PG8_LDB(B1, 0, 1); PG8_STAGE(PG8_SB(0, 0), b2, voffB);
            PG8_BAR; PG8_WAIT_L(0); PG8_MMA(0, 1, At, B1); PG8_BAR;
            PG8_LDA(At, 0, 1); PG8_STAGE(PG8_SA(0, 0), a2, voffA);
            PG8_BAR; PG8_WAIT_L(0); PG8_MMA(1, 0, At, B0); PG8_BAR; PG8_SCHED;
            PG8_STAGE(PG8_SB(0, 1), b2 + hstep, voffB);
            PG8_WAIT_V(6); PG8_BAR; PG8_MMA(1, 1, At, B1); PG8_BAR;
            PG8_LDB(B0, 1, 0); PG8_SCHED; PG8_LDA(At, 1, 0); PG8_STAGE(PG8_SA(0, 1), a2 + hstep, voffA);
            PG8_WAIT_L(8); PG8_BAR; PG8_WAIT_L(0); PG8_MMA(0, 0, At, B0); PG8_BAR; PG8_SCHED;
            PG8_LDB(B1, 1, 1); PG8_STAGE(PG8_SB(1, 0), b3, voffB);
            PG8_BAR; PG8_WAIT_L(0); PG8_MMA(0, 1, At, B1); PG8_BAR;
            PG8_LDA(At, 1, 1); PG8_STAGE(PG8_SA(1, 0), a3, voffA);
            PG8_BAR; PG8_WAIT_L(0); PG8_MMA(1, 0, At, B0); PG8_BAR; PG8_SCHED;
            PG8_STAGE(PG8_SB(1, 1), b3 + hstep, voffB);
            PG8_WAIT_V(6); PG8_BAR; PG8_MMA(1, 1, At, B1); PG8_BAR;
            }
        }
        if constexpr (ALIGN_EPI) { if (wr == 0) PG8_BAR; }
        if constexpr (!Epi::AFTER_DRAIN) { E(acc, cur, wr, wc, fr, fq); S.done(cur); }
        if (!has_next) break;
#pragma unroll
        for (int a = 0; a < 2; ++a)
#pragma unroll
            for (int b = 0; b < 2; ++b)
#pragma unroll
                for (int m = 0; m < 4; ++m)
#pragma unroll
                    for (int n = 0; n < 2; ++n) acc[a][b][m][n] = (f32x4){0.f, 0.f, 0.f, 0.f};
        cur = nxt; cA = nA; cB = nB; ++ui;
        if constexpr (ALIGN_EPI) { if (wr == 1) PG8_BAR; }
    }
    PG8_WAIT_V(0);
    if constexpr (!ALIGN_EPI) { if (wr == 0) PG8_BAR; }
    PG8_BAR;
    if constexpr (Epi::AFTER_DRAIN) { E.fused(acc, cur, wr, wc, fr, fq, lds, wid, lane); S.done(cur); }
#undef PG8_SA
#undef PG8_SB
#undef PG8_STAGE
#undef PG8_LDA
#undef PG8_LDB
#undef PG8_MMA
#undef PG8_WAIT_V
#undef PG8_WAIT_L
#undef PG8_BAR
#undef PG8_SCHED
}
template <class Epi, class Sched, bool ALIGN_EPI = true, bool SP2 = true, int F8 = -1>
__device__ __forceinline__ void gemm_phase_gather(PG8_LAS unsigned char* lds, const Gemm g, const Sched& S, const Epi& E, const int tid_in) {
    int tid = tid_in; asm volatile("" : "+v"(tid));
    static_assert(SP2, "gather form: SP2 loop only");
    const int wid = __builtin_amdgcn_readfirstlane(tid >> 6), lane = tid & 63, wr = wid >> 2, wc = wid & 3, fr = lane & 15, fq = lane >> 4;
    int K = g.K; asm volatile("" : "+s"(K)); const int nt = K / BK;
    unsigned voffA[2], voffB[2];
#pragma unroll
    for (int i = 0; i < 2; ++i) { int R, C; stage_rc(tid * 16 + i * 8192, R, C); const int Rb = Epi::PERM ? ((R & ~31) + perm32(R & 31)) : R;
        voffA[i] = (unsigned)(R * K + C) * 2u; voffB[i] = (unsigned)(Rb * K + C) * 2u; }
    int gR, gC; stage_rc(tid * 16, gR, gC);
    unsigned vG[2][2], vN[2][2];
    const size_t kstep = (size_t)(BK * 2);
    const size_t hstep = (size_t)HALF * K * 2;
    const size_t tstep = 2 * hstep;
    const unsigned ldsw = (unsigned)wid * 1024u;
    const int aoff = lds_byte(wr * 64 + fr, fq * 8), boff = lds_byte(wc * 32 + fr, fq * 8);
#define PG8_SA(b, h) (((b) * 2 + (h)) * HTB)
#define PG8_SB(b, h) ((4 + (b) * 2 + (h)) * HTB)
#define PG8_STAGE(bufoff, gbase, voff) do { _Pragma("unroll") for (int _i = 0; _i < 2; ++_i) { unsigned vo_ = (voff)[_i]; asm volatile("" : "+v"(vo_));   \
        __builtin_amdgcn_global_load_lds((const unsigned*)((const char*)(gbase) + vo_), (PG8_LAS unsigned*)(lds + (bufoff) + ldsw + _i * 8192), 16, 0, 0); } } while (0)
#define PG8_LDA(dst, b, h) do { _Pragma("unroll") for (int m = 0; m < 4; ++m) { const bf16x8 x0_ = *(const PG8_LAS bf16x8*)(lds + PG8_SA(b, h) + aoff + m * 2048), x1_ = *(const PG8_LAS bf16x8*)(lds + PG8_SA(b, h) + aoff + m * 2048 + 1024); \
        if constexpr (F8 >= 0) dst##8[m] = PG8_CAT(x0_, x1_); else { dst[m][0] = x0_; dst[m][1] = x1_; } } } while (0)
#define PG8_LDB(dst, b, h) do { _Pragma("unroll") for (int n = 0; n < 2; ++n) { const bf16x8 x0_ = *(const PG8_LAS bf16x8*)(lds + PG8_SB(b, h) + boff + n * 2048), x1_ = *(const PG8_LAS bf16x8*)(lds + PG8_SB(b, h) + boff + n * 2048 + 1024); \
        if constexpr (F8 >= 0) dst##8[n] = PG8_CAT(x0_, x1_); else { dst[n][0] = x0_; dst[n][1] = x1_; } } } while (0)
#define PG8_CAT(x0, x1) ({ const v4i_t lo_ = __builtin_bit_cast(v4i_t, x0), hi_ = __builtin_bit_cast(v4i_t, x1); (v8i_t){lo_[0], lo_[1], lo_[2], lo_[3], hi_[0], hi_[1], hi_[2], hi_[3]}; })
#define PG8_MMA(ai, bj, At, Bt) do { __builtin_amdgcn_s_setprio(1); _Pragma("unroll") for (int m = 0; m < 4; ++m) _Pragma("unroll") for (int n = 0; n < 2; ++n) { \
        if constexpr (F8 >= 0) acc[ai][bj][m][n] = __builtin_amdgcn_mfma_scale_f32_16x16x128_f8f6f4(Bt##8[n], At##8[m], acc[ai][bj][m][n], 0, 0, 0, 0x7f7f7f7f, 0, (127 - F8) * 0x01010101); \
        else { _Pragma("unroll") for (int k = 0; k < 2; ++k) acc[ai][bj][m][n] = __builtin_amdgcn_mfma_f32_16x16x32_bf16(Bt[n][k], At[m][k], acc[ai][bj][m][n], 0, 0, 0); } } \
        __builtin_amdgcn_s_setprio(0); } while (0)
#define PG8_WAIT_V(n) asm volatile("s_waitcnt vmcnt(" #n ")" ::: "memory")
#define PG8_WAIT_L(n) asm volatile("s_waitcnt lgkmcnt(" #n ")" ::: "memory")
#define PG8_BAR __builtin_amdgcn_s_barrier()
#define PG8_SCHED __builtin_amdgcn_sched_barrier(0)
    Unit cur, nxt; int ui = 0;
    if (!S.next(0, cur)) return;
    f32x4 acc[2][2][4][2];
#pragma unroll
    for (int a = 0; a < 2; ++a)
#pragma unroll
        for (int b = 0; b < 2; ++b)
#pragma unroll
            for (int m = 0; m < 4; ++m)
#pragma unroll
                for (int n = 0; n < 2; ++n) acc[a][b][m][n] = (f32x4){0.f, 0.f, 0.f, 0.f};
    bf16x8 At[4][2], B0[2][2], B1[2][2]; v8i_t At8[4], B08[2], B18[2];
    const char* cA = (const char*)g.A; const char* cB = (const char*)g.Bt + (size_t)cur.pn * tstep;
    S.a_ready(cur);
#pragma unroll
    for (int h = 0; h < 2; ++h)
#pragma unroll
        for (int i = 0; i < 2; ++i) vG[h][i] = (unsigned)S.tok(cur, h * HALF + gR + 64 * i) * (unsigned)(K * 2) + (unsigned)(gC * 2);
    if constexpr (SP2) {
        PG8_STAGE(PG8_SB(0, 0), cB, voffB); PG8_STAGE(PG8_SB(0, 1), cB + hstep, voffB); PG8_STAGE(PG8_SA(0, 0), cA, vG[0]); PG8_STAGE(PG8_SA(0, 1), cA, vG[1]);
        if (wr == 1) PG8_BAR;
        PG8_WAIT_V(2); PG8_BAR;
        PG8_STAGE(PG8_SB(1, 0), cB + kstep, voffB); PG8_STAGE(PG8_SA(1, 0), cA + kstep, vG[0]); PG8_STAGE(PG8_SB(1, 1), cB + hstep + kstep, voffB);
        PG8_WAIT_V(6); PG8_BAR;
    } else {
        PG8_STAGE(PG8_SB(0, 0), cB, voffB); PG8_STAGE(PG8_SA(0, 0), cA, voffA); PG8_STAGE(PG8_SB(0, 1), cB + hstep, voffB); PG8_STAGE(PG8_SA(0, 1), cA + hstep, voffA);
        if (wr == 1) PG8_BAR;
        PG8_WAIT_V(4); PG8_BAR;
        PG8_STAGE(PG8_SB(1, 0), cB + kstep, voffB); PG8_STAGE(PG8_SA(1, 0), cA + kstep, voffA); PG8_STAGE(PG8_SB(1, 1), cB + hstep + kstep, voffB);
        PG8_WAIT_V(6); PG8_BAR;
    }
    for (;;) {
        const bool has_next = S.next(ui + 1, nxt);
        const char* nA = cA; const char* nB = has_next ? (const char*)g.Bt + (size_t)nxt.pn * tstep : cB;
        for (int t = 0; t < nt; t += 2) {
            const bool last = (t == nt - 2);
            const char* a1 = cA + (size_t)(t + 1) * kstep;
            const char* a2 = last ? nA : cA + (size_t)(t + 2) * kstep; const char* b2 = last ? nB : cB + (size_t)(t + 2) * kstep;
            const char* a3 = a2 + kstep; const char* b3 = b2 + kstep;
            if (last && has_next) { S.a_ready(nxt);
#pragma unroll
                for (int h = 0; h < 2; ++h)
#pragma unroll
                    for (int i = 0; i < 2; ++i) vN[h][i] = (unsigned)S.tok(nxt, h * HALF + gR + 64 * i) * (unsigned)(K * 2) + (unsigned)(gC * 2); }
            if constexpr (SP2) {
            PG8_LDB(B0, 0, 0); PG8_LDB(B1, 0, 1); PG8_SCHED; PG8_LDA(At, 0, 0); PG8_STAGE(PG8_SA(1, 1), a1, vG[1]);
            if (last && has_next) { vG[0][0] = vN[0][0]; vG[0][1] = vN[0][1]; vG[1][0] = vN[1][0]; vG[1][1] = vN[1][1]; }
            PG8_WAIT_V(8); PG8_WAIT_L(0); PG8_BAR; PG8_MMA(0, 0, At, B0); PG8_MMA(0, 1, At, B1); PG8_BAR; PG8_SCHED;
            PG8_LDA(At, 0, 1); PG8_STAGE(PG8_SB(0, 0), b2, voffB); PG8_STAGE(PG8_SB(0, 1), b2 + hstep, voffB); PG8_STAGE(PG8_SA(0, 0), a2, vG[0]);
            PG8_WAIT_V(8); PG8_WAIT_L(0); PG8_BAR; PG8_MMA(1, 0, At, B0); PG8_MMA(1, 1, At, B1); PG8_BAR; PG8_SCHED;
            PG8_LDB(B0, 1, 0); PG8_LDB(B1, 1, 1); PG8_SCHED; PG8_LDA(At, 1, 0); PG8_STAGE(PG8_SA(0, 1), a2, vG[1]);
            PG8_WAIT_V(8); PG8_WAIT_L(0); PG8_BAR; PG8_MMA(0, 0, At, B0); PG8_MMA(0, 1, At, B1); PG8_BAR; PG8_SCHED;
            PG8_LDA(At, 1, 1); PG8_STAGE(PG8_SB(1, 0), b3, voffB); PG8_STAGE(PG8_SB(1, 1), b3 + hstep, voffB); PG8_STAGE(PG8_SA(1, 0), a3, vG[0]);
            PG8_WAIT_V(8); PG8_WAIT_L(0); PG8_BAR; PG8_MMA(1, 0, At, B0); PG8_MMA(1, 1, At, B1); PG8_BAR; PG8_SCHED;
            } else {
            PG8_LDB(B0, 0, 0); PG8_SCHED; PG8_LDA(At, 0, 0); PG8_STAGE(PG8_SA(1, 1), a1 + hstep, voffA);
            PG8_WAIT_L(8); PG8_BAR; PG8_WAIT_L(0); PG8_MMA(0, 0, At, B0); PG8_BAR; PG8_SCHED;
            PG8_LDB(B1, 0, 1); PG8_STAGE(PG8_SB(0, 0), b2, voffB);
            PG8_BAR; PG8_WAIT_L(0); PG8_MMA(0, 1, At, B1); PG8_BAR;
            PG8_LDA(At, 0, 1); PG8_STAGE(PG8_SA(0, 0), a2, voffA);
            PG8_BAR; PG8_WAIT_L(0); PG8_MMA(1, 0, At, B0); PG8_BAR; PG8_SCHED;
            PG8_STAGE(PG8_SB(0, 1), b2 + hstep, voffB);
            PG8_WAIT_V(6); PG8_BAR; PG8_MMA(1, 1, At, B1); PG8_BAR;
            PG8_LDB(B0, 1, 0); PG8_SCHED; PG8_LDA(At, 1, 0); PG8_STAGE(PG8_SA(0, 1), a2 + hstep, voffA);
            PG8_WAIT_L(8); PG8_BAR; PG8_WAIT_L(0); PG8_MMA(0, 0, At, B0); PG8_BAR; PG8_SCHED;
            PG8_LDB(B1, 1, 1); PG8_STAGE(PG8_SB(1, 0), b3, voffB);
            PG8_BAR; PG8_WAIT_L(0); PG8_MMA(0, 1, At, B1); PG8_BAR;
            PG8_LDA(At, 1, 1); PG8_STAGE(PG8_SA(1, 0), a3, voffA);
            PG8_BAR; PG8_WAIT_L(0); PG8_MMA(1, 0, At, B0); PG8_BAR; PG8_SCHED;
            PG8_STAGE(PG8_SB(1, 1), b3 + hstep, voffB);
            PG8_WAIT_V(6); PG8_BAR; PG8_MMA(1, 1, At, B1); PG8_BAR;
            }
        }
        if constexpr (ALIGN_EPI) { if (wr == 0) PG8_BAR; }
        if constexpr (!Epi::AFTER_DRAIN) { E(acc, cur, wr, wc, fr, fq); S.done(cur); }
        if (!has_next) break;
#pragma unroll
        for (int a = 0; a < 2; ++a)
#pragma unroll
            for (int b = 0; b < 2; ++b)
#pragma unroll
                for (int m = 0; m < 4; ++m)
#pragma unroll
                    for (int n = 0; n < 2; ++n) acc[a][b][m][n] = (f32x4){0.f, 0.f, 0.f, 0.f};
        cur = nxt; cA = nA; cB = nB; ++ui;
        if constexpr (ALIGN_EPI) { if (wr == 1) PG8_BAR; }
    }
    PG8_WAIT_V(0);
    if constexpr (!ALIGN_EPI) { if (wr == 0) PG8_BAR; }
    PG8_BAR;
    if constexpr (Epi::AFTER_DRAIN) { E.fused(acc, cur, wr, wc, fr, fq, lds, wid, lane); S.done(cur); }
#undef PG8_SA
#undef PG8_SB
#undef PG8_STAGE
#undef PG8_LDA
#undef PG8_LDB
#undef PG8_MMA
#undef PG8_WAIT_V
#undef PG8_WAIT_L
#undef PG8_BAR
#undef PG8_SCHED
}
}
namespace att {
typedef unsigned short bf16;
using bf16x8 = __attribute__((ext_vector_type(8))) short;
using s16x4  = __attribute__((ext_vector_type(4))) short;
using f32x16 = __attribute__((ext_vector_type(16))) float;
using u32x4  = __attribute__((ext_vector_type(4))) unsigned;
using f32x4_t = __attribute__((ext_vector_type(4))) float;
constexpr int NW = 8, QBLK = 32, KVBLK = 64, SEQ = 4096;
constexpr int LDQ = 1536, LDKV = 2048, LDO = 1024;
constexpr int SHM_VT = 128 * 80, SHM_K8 = 64 * 208;
constexpr int OFF_V = 0, OFF_K8 = 3 * SHM_VT, OFF_WS = OFF_K8 + 2 * SHM_K8, LDS_BYTES = OFF_WS + NW * 64 * 4 + 64;
typedef int v8i32 __attribute__((ext_vector_type(8)));
typedef int v4i32 __attribute__((ext_vector_type(4)));
typedef int v2i32 __attribute__((ext_vector_type(2)));
constexpr int T_TOK = 8 * SEQ;
#define ASBAR() __builtin_amdgcn_sched_barrier(0)
__device__ __forceinline__ int crow(int r, int hi) { return (r & 3) + 8 * (r >> 2) + 4 * hi; }
__device__ __forceinline__ unsigned cvtpk(float lo, float hi) { unsigned r; asm volatile("v_cvt_pk_bf16_f32 %0, %1, %2" : "=v"(r) : "v"(lo), "v"(hi)); return r; }
__device__ __forceinline__ float bf2f(unsigned short b) { return __uint_as_float(((unsigned)b) << 16); }
template <bool SHIFT> __device__ __forceinline__ void smA(f32x16& p0, float negm) { for (int r = 0; r < 16; ++r) p0[r] = __builtin_amdgcn_exp2f(SHIFT ? p0[r] + negm : p0[r]); }
template <bool SHIFT> __device__ __forceinline__ void smB(f32x16& p0, f32x16& p1, float& l_reg, v8i32& p8, float negm) {
  for (int r = 0; r < 16; ++r) p1[r] = __builtin_amdgcn_exp2f(SHIFT ? p1[r] + negm : p1[r]);
  float ps = 0; for (int r = 0; r < 16; ++r) ps += p0[r]; for (int r = 0; r < 16; ++r) ps += p1[r];
  l_reg += ps;
#pragma unroll
  for (int w = 0; w < 4; ++w) { int a = 0, bq = 0;
    a = __builtin_amdgcn_cvt_pk_bf8_f32(p0[4 * w], p0[4 * w + 1], a, false); a = __builtin_amdgcn_cvt_pk_bf8_f32(p0[4 * w + 2], p0[4 * w + 3], a, true);
    bq = __builtin_amdgcn_cvt_pk_bf8_f32(p1[4 * w], p1[4 * w + 1], bq, false); bq = __builtin_amdgcn_cvt_pk_bf8_f32(p1[4 * w + 2], p1[4 * w + 3], bq, true);
    p8[w] = a; p8[4 + w] = bq; }
}
template <bool SHIFT> __device__ __forceinline__ void qkt(f32x16& p0, f32x16& p1, const char* K8, const v8i32* q8, float negm, int r32, int hi) {
  p0 = f32x16{}; p1 = f32x16{};
#define K8RD(m, half, part) (*reinterpret_cast<const v4i32*>(K8 + ((half) * 32 + r32) * 208 + (m) * 64 + hi * 32 + (part) * 16))
#define K8FR(m, half) ({ const v4i32 lo_ = K8RD(m, half, 0), hi_ = K8RD(m, half, 1); (v8i32){lo_[0], lo_[1], lo_[2], lo_[3], hi_[0], hi_[1], hi_[2], hi_[3]}; })
  v8i32 a0 = K8FR(0, 0), a1 = K8FR(0, 1), b0 = K8FR(1, 0), b1 = K8FR(1, 1);
  ASBAR();
  p0 = __builtin_amdgcn_mfma_scale_f32_32x32x64_f8f6f4(a0, q8[0], p0, 0, 0, 0, 0x7f7f7f7f, 0, 0x7f7f7f7f);
  p1 = __builtin_amdgcn_mfma_scale_f32_32x32x64_f8f6f4(a1, q8[0], p1, 0, 0, 0, 0x7f7f7f7f, 0, 0x7f7f7f7f);
  a0 = K8FR(2, 0); a1 = K8FR(2, 1);
  ASBAR();
  p0 = __builtin_amdgcn_mfma_scale_f32_32x32x64_f8f6f4(b0, q8[1], p0, 0, 0, 0, 0x7f7f7f7f, 0, 0x7f7f7f7f);
  p1 = __builtin_amdgcn_mfma_scale_f32_32x32x64_f8f6f4(b1, q8[1], p1, 0, 0, 0, 0x7f7f7f7f, 0, 0x7f7f7f7f);
  ASBAR();
  p0 = __builtin_amdgcn_mfma_scale_f32_32x32x64_f8f6f4(a0, q8[2], p0, 0, 0, 0, 0x7f7f7f7f, 0, 0x7f7f7f7f);
  p1 = __builtin_amdgcn_mfma_scale_f32_32x32x64_f8f6f4(a1, q8[2], p1, 0, 0, 0, 0x7f7f7f7f, 0, 0x7f7f7f7f);
  ASBAR();
#undef K8RD
#undef K8FR
}
__device__ __forceinline__ void pv_d0(f32x16* o, const char* VT, v8i32 p8, int r32, int hi) {
#define VTFR(d0) ({ const v4i32 lo_ = *reinterpret_cast<const v4i32*>(VT + ((d0) * 32 + r32) * 80 + hi * 32), hi_ = *reinterpret_cast<const v4i32*>(VT + ((d0) * 32 + r32) * 80 + hi * 32 + 16); (v8i32){lo_[0], lo_[1], lo_[2], lo_[3], hi_[0], hi_[1], hi_[2], hi_[3]}; })
#define PVMMA(d0, fr) o[d0] = __builtin_amdgcn_mfma_scale_f32_32x32x64_f8f6f4(p8, fr, o[d0], 1  , 0  , 0, 0x7f7f7f7f, 0, 0x7f7f7f7f)
  v8i32 fa = VTFR(0), fb = VTFR(1);
  ASBAR();
  PVMMA(0, fa); fa = VTFR(2); ASBAR();
  PVMMA(1, fb); fb = VTFR(3); ASBAR();
  PVMMA(2, fa); PVMMA(3, fb); ASBAR();
#undef VTFR
#undef PVMMA
}
template <bool SHIFT> __device__ __forceinline__ bool attn_unit(int b, int h, int s0, const bf16* Qraw, const unsigned char* __restrict__ VT8g, const unsigned char* __restrict__ K8g, const unsigned char* __restrict__ KP8g, bf16* __restrict__ O,
                                          const float* rope, const float* qg, float smaxC, char* lds, int tid) {
  asm volatile("" : "+v"(tid));
  const int wid = __builtin_amdgcn_readfirstlane(tid >> 6), lane = tid & 63, r32 = lane & 31, hi = lane >> 5;
  asm volatile("" : "+s"(qg));
  char* V_lds = lds + OFF_V; char* K8_lds = lds + OFF_K8;
  float* ws = (float*)(lds + OFF_WS) + wid * 64; float* li_l = ws;
  constexpr float C = 0.072168783648703220f * 1.4426950408889634f;
  v8i32 q8[3];
  {
    typedef __attribute__((address_space(1))) const bf16x8 gbf16x8; typedef __attribute__((address_space(1))) const f32x4_t gf32x4;
    const long trow = (long)b * SEQ + s0 + wid * QBLK + r32;
    unsigned qo = (unsigned)((trow * LDQ + h * 192) * 2); const unsigned ro = (unsigned)(trow * 256), go = (unsigned)(hi * 128);
#define Qn_(i) (*(gbf16x8*)((const char*)Qraw + qo + hi * 64 + (i) * 16))
#define Qr_(i) (*(gbf16x8*)((const char*)Qraw + qo + 256 + (i) * 16))
#define rp4_(i) (*(gf32x4*)((const char*)rope + ro + (i) * 16))
#define qgn_(i) (*(gf32x4*)((const char*)qg + go + (i) * 16))
#define qgr_(i) (*(gf32x4*)((const char*)qg + 512 + (i) * 16))
    float ssn = 0.f, ssp = 0.f;
#pragma unroll
    for (int c = 0; c < 8; ++c) { const bf16x8 a = Qn_((c >> 2) * 8 + (c & 3)), r = Qr_(c);
#pragma unroll
      for (int j = 0; j < 8; ++j) { const float f = bf2f((unsigned short)a[j]), g = bf2f((unsigned short)r[j]); ssn += f * f; ssp += g * g; } }
    ssn += __shfl_xor(ssn, 32);
    const float rn = rsqrtf(ssn * (1.f / 128.f) + 1e-6f) * C, rp = rsqrtf(ssp * (1.f / 64.f) + 1e-6f) * C;
    { float rn_ = rn, rp_ = rp; asm volatile("" : "+v"(qo), "+v"(rn_), "+v"(rp_) :: "memory"); }
#pragma unroll
    for (int m = 0; m < 2; ++m)
#pragma unroll
      for (int c = 0; c < 4; ++c) { const bf16x8 raw = Qn_(8 * m + c); const f32x4_t ga = qgn_(16 * m + 2 * c), gb = qgn_(16 * m + 2 * c + 1); float g[8];
#pragma unroll
        for (int j = 0; j < 8; ++j) g[j] = bf2f((unsigned short)raw[j]) * rn * (j < 4 ? ga[j & 3] : gb[j & 3]);
        int w0 = 0, w1 = 0; w0 = __builtin_amdgcn_cvt_pk_fp8_f32(g[0], g[1], w0, false); w0 = __builtin_amdgcn_cvt_pk_fp8_f32(g[2], g[3], w0, true);
        w1 = __builtin_amdgcn_cvt_pk_fp8_f32(g[4], g[5], w1, false); w1 = __builtin_amdgcn_cvt_pk_fp8_f32(g[6], g[7], w1, true);
        asm volatile("" : "+v"(w0), "+v"(w1) :: "memory");        q8[m][2 * c] = w0; q8[m][2 * c + 1] = w1; }
#pragma unroll
    for (int c = 0; c < 4; ++c) {
      const bf16x8 r1 = Qr_(c), r2 = Qr_(4 + c);
      const f32x4_t g1a = qgr_(2 * c), g1b = qgr_(2 * c + 1), g2a = qgr_(8 + 2 * c), g2b = qgr_(8 + 2 * c + 1); float ov[8];
#pragma unroll
      for (int j = 0; j < 8; ++j) { const f32x4_t cs4 = rp4_(4 * c + (j >> 1));
        const float cs = cs4[(j & 1) * 2], sn = cs4[(j & 1) * 2 + 1];
        const float x1 = bf2f((unsigned short)r1[j]) * rp * (j < 4 ? g1a[j & 3] : g1b[j & 3]), x2 = bf2f((unsigned short)r2[j]) * rp * (j < 4 ? g2a[j & 3] : g2b[j & 3]);
        ov[j] = hi == 0 ? (x1 * cs - x2 * sn) : (x1 * sn + x2 * cs); }
      int w0 = 0, w1 = 0; w0 = __builtin_amdgcn_cvt_pk_fp8_f32(ov[0], ov[1], w0, false); w0 = __builtin_amdgcn_cvt_pk_fp8_f32(ov[2], ov[3], w0, true);
      w1 = __builtin_amdgcn_cvt_pk_fp8_f32(ov[4], ov[5], w1, false); w1 = __builtin_amdgcn_cvt_pk_fp8_f32(ov[6], ov[7], w1, true);
      asm volatile("" : "+v"(w0), "+v"(w1) :: "memory"); q8[2][2 * c] = w0; q8[2][2 * c + 1] = w1; }
  #undef Qn_
#undef Qr_
#undef rp4_
#undef qgn_
#undef qgr_
  }
  const float negm = 15.0f - smaxC;
  float l_reg = 0.f; f32x16 o[4] = {};
  const char* Vg = (const char*)(VT8g + (size_t)h * 128 * T_TOK + (size_t)b * SEQ); const char* Kg = (const char*)(K8g + ((long)b * SEQ * 8 + h) * 128); const char* Pg = (const char*)(KP8g + (long)b * SEQ * 64);
  const int vc = tid >> 2, vq = tid & 3, vst = vc * 80 + 16 * (vq >> 1) + 8 * (vq & 1); const unsigned gvt = (unsigned)vc * (unsigned)T_TOK + 16u * (unsigned)vq;
  const int kr = tid >> 3, kc = tid & 7, kst = kr * 208 + kc * 16; const unsigned gk8 = (unsigned)(kr * 1024 + kc * 16);
  const int pr = (tid & 255) >> 2, pc = tid & 3, pst = pr * 208 + 128 + pc * 16; const unsigned gp8 = (unsigned)(pr * 64 + pc * 16);
  v4i32 s_v, s_k, s_p;
#define SLOAD(k0) do { s_v = *reinterpret_cast<const v4i32*>(Vg + (size_t)(k0) + gvt); \
    s_k = *reinterpret_cast<const v4i32*>(Kg + (size_t)(k0) * 1024 + gk8); if (tid < 256) s_p = *reinterpret_cast<const v4i32*>(Pg + (size_t)(k0) * 64 + gp8); } while (0)
#define SWRITE(kbuf, vbuf_) do { { v2i32 a_ = {s_v[0], s_v[2]}, b_ = {s_v[1], s_v[3]}; *(v2i32*)(V_lds + (vbuf_) * SHM_VT + vst) = a_; *(v2i32*)(V_lds + (vbuf_) * SHM_VT + vst + 32) = b_; } \
    *(v4i32*)(K8_lds + (kbuf) * SHM_K8 + kst) = s_k; if (tid < 256) *(v4i32*)(K8_lds + (kbuf) * SHM_K8 + pst) = s_p; } while (0)
  constexpr int NT = SEQ / KVBLK;
  v8i32 p8;
  SLOAD(0); SWRITE(0, 0); __syncthreads(); SLOAD(KVBLK);
  if (wid < 4) {
    for (int j = 0, kb = 0, vbuf = 0, vnx = 1; j < NT; ++j) {
      f32x16 p0, p1;
      qkt<SHIFT>(p0, p1, K8_lds + kb * SHM_K8, q8, negm, r32, hi);
      smA<SHIFT>(p0, negm); smB<SHIFT>(p0, p1, l_reg, p8, negm); ASBAR();
      pv_d0(o, V_lds + vbuf * SHM_VT, p8, r32, hi);
      if (j + 1 < NT) SWRITE(kb ^ 1, vnx);
      __syncthreads();
      if (j + 2 < NT) SLOAD((j + 2) * KVBLK);
      kb ^= 1; vbuf = vnx; vnx = vnx == 2 ? 0 : vnx + 1;
    }
  } else {
    int vprev = 0;
    __builtin_amdgcn_s_setprio(1);
    for (int j = 0, kb = 0, vbuf = 0, vnx = 1; j < NT; ++j) {
      f32x16 p0, p1;
      if (j > 0) pv_d0(o, V_lds + vprev * SHM_VT, p8, r32, hi);
      qkt<SHIFT>(p0, p1, K8_lds + kb * SHM_K8, q8, negm, r32, hi);
      smA<SHIFT>(p0, negm); smB<SHIFT>(p0, p1, l_reg, p8, negm); ASBAR();
      if (j + 1 < NT) SWRITE(kb ^ 1, vnx);
      __syncthreads();
      if (j + 2 < NT) SLOAD((j + 2) * KVBLK);
      kb ^= 1; vprev = vbuf; vbuf = vnx; vnx = vnx == 2 ? 0 : vnx + 1;
    }
    pv_d0(o, V_lds + vprev * SHM_VT, p8, r32, hi);
    __builtin_amdgcn_s_setprio(0);
  }
  int lane_e = lane; asm volatile("" : "+v"(lane_e));
  const int r32e = lane_e & 31, hie = lane_e >> 5;
  l_reg += __shfl_xor(l_reg, 32);
  int* satf = (int*)(lds + OFF_WS + NW * 64 * 4);
  if (!SHIFT) { const bool sat = __any(l_reg >= 57344.f); if (lane_e == 0) satf[wid] = sat ? 1 : 0; }
  if (hie == 0) li_l[r32e] = l_reg; asm volatile("s_waitcnt lgkmcnt(0)" ::: "memory");
  float rli[16];
#pragma unroll
  for (int r = 0; r < 16; ++r) rli[r] = __builtin_amdgcn_rcpf(li_l[crow(r, hie)]);
  char* Ow = (char*)O + ((long)b * SEQ + s0 + wid * QBLK) * LDO + h * 128;
#pragma unroll
  for (int r = 0; r < 16; ++r) { const unsigned ooff = (unsigned)(crow(r, hie) * LDO + r32e);
#pragma unroll
    for (int d0 = 0; d0 < 4; ++d0) { const int pk = __builtin_amdgcn_cvt_pk_fp8_f32(o[d0][r] * rli[r] * 32.f, 0.f, 0, false); *(unsigned char*)(Ow + ooff + d0 * 32) = (unsigned char)(pk & 0xff); } }
  __syncthreads();
  bool redo = false;
  if (!SHIFT) { redo = (satf[0] | satf[1] | satf[2] | satf[3] | satf[4] | satf[5] | satf[6] | satf[7]) != 0; __syncthreads(); }
  return redo;
#undef SLOAD
#undef SWRITE
}
}
#ifndef HD
#define HD __device__ __forceinline__
#endif
struct c32 { float x, y; };
HD c32 cmk(float x, float y) { c32 r; r.x = x; r.y = y; return r; }
HD c32 cadd(c32 a, c32 b) { return cmk(a.x + b.x, a.y + b.y); }
HD c32 csub(c32 a, c32 b) { return cmk(a.x - b.x, a.y - b.y); }
HD c32 cmul(c32 a, c32 b) { return cmk(a.x * b.x - a.y * b.y, a.x * b.y + a.y * b.x); }
HD c32 cmulc(c32 a, c32 b) { return cmk(a.x * b.x + a.y * b.y, a.y * b.x - a.x * b.y); }
constexpr int BR4(int i) { return ((i & 1) << 3) | ((i & 2) << 1) | ((i & 4) >> 1) | ((i & 8) >> 3); }
template <int SGN, int J> HD c32 tw16(c32 a) {
    if constexpr (J == 0) return a;
    else if constexpr (J == 4) return SGN < 0 ? cmk(a.y, -a.x) : cmk(-a.y, a.x);
    else {
        constexpr float CS[8] = {1.f, 0.92387953251128674f, 0.70710678118654752f, 0.38268343236508977f, 0.f, -0.38268343236508977f, -0.70710678118654752f, -0.92387953251128674f};
        constexpr float SN[8] = {0.f, 0.38268343236508977f, 0.70710678118654752f, 0.92387953251128674f, 1.f, 0.92387953251128674f, 0.70710678118654752f, 0.38268343236508977f};
        constexpr float c = CS[J], s = SN[J];
        if constexpr (SGN < 0) return cmk(a.x * c + a.y * s, a.y * c - a.x * s);
        else return cmk(a.x * c - a.y * s, a.y * c + a.x * s);
    }
}
#define FFT_BF(i, j, J) { const c32 u_ = v[i], w_ = v[j]; v[i] = cadd(u_, w_); v[j] = tw16<SGN, J>(csub(u_, w_)); }
template <int SGN> HD void dft16_dif(c32 (&v)[16]) {
    FFT_BF(0, 8, 0) FFT_BF(1, 9, 1) FFT_BF(2, 10, 2) FFT_BF(3, 11, 3) FFT_BF(4, 12, 4) FFT_BF(5, 13, 5) FFT_BF(6, 14, 6) FFT_BF(7, 15, 7)
    FFT_BF(0, 4, 0) FFT_BF(1, 5, 2) FFT_BF(2, 6, 4) FFT_BF(3, 7, 6) FFT_BF(8, 12, 0) FFT_BF(9, 13, 2) FFT_BF(10, 14, 4) FFT_BF(11, 15, 6)
    FFT_BF(0, 2, 0) FFT_BF(1, 3, 4) FFT_BF(4, 6, 0) FFT_BF(5, 7, 4) FFT_BF(8, 10, 0) FFT_BF(9, 11, 4) FFT_BF(12, 14, 0) FFT_BF(13, 15, 4)
    FFT_BF(0, 1, 0) FFT_BF(2, 3, 0) FFT_BF(4, 5, 0) FFT_BF(6, 7, 0) FFT_BF(8, 9, 0) FFT_BF(10, 11, 0) FFT_BF(12, 13, 0) FFT_BF(14, 15, 0)
}
#undef FFT_BF
#define FFT_BT(i, j, J) { const c32 u_ = v[i], w_ = tw16<SGN, J>(v[j]); v[i] = cadd(u_, w_); v[j] = csub(u_, w_); }
template <int SGN> HD void dft16_dit(c32 (&v)[16]) {
    FFT_BT(0, 1, 0) FFT_BT(2, 3, 0) FFT_BT(4, 5, 0) FFT_BT(6, 7, 0) FFT_BT(8, 9, 0) FFT_BT(10, 11, 0) FFT_BT(12, 13, 0) FFT_BT(14, 15, 0)
    FFT_BT(0, 2, 0) FFT_BT(1, 3, 4) FFT_BT(4, 6, 0) FFT_BT(5, 7, 4) FFT_BT(8, 10, 0) FFT_BT(9, 11, 4) FFT_BT(12, 14, 0) FFT_BT(13, 15, 4)
    FFT_BT(0, 4, 0) FFT_BT(1, 5, 2) FFT_BT(2, 6, 4) FFT_BT(3, 7, 6) FFT_BT(8, 12, 0) FFT_BT(9, 13, 2) FFT_BT(10, 14, 4) FFT_BT(11, 15, 6)
    FFT_BT(0, 8, 0) FFT_BT(1, 9, 1) FFT_BT(2, 10, 2) FFT_BT(3, 11, 3) FFT_BT(4, 12, 4) FFT_BT(5, 13, 5) FFT_BT(6, 14, 6) FFT_BT(7, 15, 7)
}
#undef FFT_BT
constexpr int FFT_PS = 272;
constexpr int FFT_EX_ELEMS = 16 * FFT_PS;
template <class EX> HD void fft_fwd_a(c32 (&v)[16], const c32* T1, EX ex, int tid) {
    dft16_dif<-1>(v);
#pragma unroll
    for (int p = 0; p < 16; ++p) { ex[p * FFT_PS + tid] = cmul(v[BR4(p)], T1[256 * p]); if ((p & 3) == 3) __builtin_amdgcn_sched_barrier(0); }
}
template <class EX> HD void fft_fwd_b(c32 (&v)[16], const c32* T2, EX exr, EX ex, int tid) {
    const int p2 = tid >> 4, c = tid & 15;
#pragma unroll
    for (int b = 0; b < 16; ++b) v[b] = exr[p2 * FFT_PS + 16 * b + c];
    dft16_dif<-1>(v);
#pragma unroll
    for (int q = 0; q < 16; ++q) ex[p2 * FFT_PS + q * 16 + ((c + q) & 15)] = cmul(v[BR4(q)], T2[q]);
}
template <class EX> HD void fft_fwd_c(c32 (&v)[16], EX ex, int tid) {
    const int p2 = tid >> 4, q = tid & 15;
#pragma unroll
    for (int c = 0; c < 16; ++c) v[c] = ex[p2 * FFT_PS + q * 16 + ((c + q) & 15)];
    dft16_dif<-1>(v);
}
template <class EX> HD void fft_inv_a(c32 (&v)[16], EX ex, int tid) {
    const int p = tid >> 4, q = tid & 15;
    dft16_dit<+1>(v);
#pragma unroll
    for (int c = 0; c < 16; ++c) ex[p * FFT_PS + q * 16 + ((c + q) & 15)] = v[c];
}
template <class EX> HD void fft_inv_b(c32 (&v)[16], const c32* T2, EX exr, EX ex, int tid) {
    const int p = tid >> 4, c = tid & 15;
#pragma unroll
    for (int q = 0; q < 16; ++q) v[BR4(q)] = cmulc(exr[p * FFT_PS + q * 16 + ((c + q) & 15)], T2[q]);
    dft16_dit<+1>(v);
#pragma unroll
    for (int b = 0; b < 16; ++b) ex[p * FFT_PS + 16 * b + c] = v[b];
}
template <class EX> HD void fft_inv_c(c32 (&v)[16], const c32* T1, EX ex, int tid) {
#pragma unroll
    for (int p = 0; p < 16; ++p) { v[BR4(p)] = cmulc(ex[p * FFT_PS + tid], T1[256 * p]); if ((p & 3) == 3) __builtin_amdgcn_sched_barrier(0); }
    dft16_dit<+1>(v);
}
constexpr int NWAVES = 8, NTHR = 512;
constexpr int BATCH = 8, SEQ = 4096, DM = 1024, T = BATCH * SEQ;
constexpr float EPS = 1e-6f;
constexpr size_t MiB = 1u << 20;
constexpr size_t WS_CTL = 0, CTL_ZERO_BYTES = 64 * 1024;
constexpr size_t WS_MOD = 1 * MiB;
constexpr size_t WS_HDNS = 1 * MiB + 512 * 1024;
constexpr size_t WS_W4S = 3 * MiB + 512 * 1024;
constexpr size_t WS_LIST = 101 * MiB;
constexpr size_t WS_WL = 396 * MiB;
constexpr size_t WS_WD = 8 * MiB;
constexpr size_t WS_WUQ = 9 * MiB;
constexpr size_t WS_WUKV = 10 * MiB;
constexpr size_t WS_WO = 11 * MiB;
constexpr size_t WS_WIN = 13 * MiB;
constexpr size_t WS_WOUT = 19 * MiB;
constexpr size_t WS_WGU = 21 * MiB;
constexpr size_t WS_WDN = 53 * MiB;
constexpr size_t R1 = 104 * MiB;
constexpr size_t R2 = 232 * MiB;
constexpr size_t R3 = 424 * MiB;
constexpr size_t WS_VT8 = R1, WS_XN2 = R1, WS_KF = R1;
constexpr size_t WS_XN = R2, WS_O = R2;
constexpr size_t WS_LAT = R2 + 64 * MiB;
constexpr size_t WS_HACT = R2 + 64 * MiB;
constexpr size_t WS_CQN = R2 + 128 * MiB;
constexpr size_t WS_CKVN = R2 + 144 * MiB;
constexpr size_t WS_KPE = R2 + 160 * MiB;
constexpr size_t WS_K8 = R2 + 64 * MiB;
constexpr size_t WS_ROPE = R2 + 164 * MiB;
constexpr size_t WS_QRAW = 408 * MiB;
constexpr size_t WS_XN2S = 424 * MiB;
constexpr size_t WS_XR = 424 * MiB;
constexpr size_t WS_HT = R2;
constexpr size_t WS_UT = R2;
constexpr size_t WS_Z = R2;
constexpr size_t WS_END = 512 * MiB;
constexpr int MS_ROWS = T + 24 * 256;
constexpr int CW_BAR = 4096;
constexpr int CW_CNT = 8192;
constexpr int RING_OFF = 0, RING_BYTES = 147456;
constexpr int LDSCTL_OFF = RING_BYTES;
constexpr int MISC_OFF = LDSCTL_OFF;
constexpr int TINFO_OFF = LDSCTL_OFF + 256;
constexpr int RED_OFF = LDSCTL_OFF + 256 + 1280;
constexpr int EPIX_OFF = LDSCTL_OFF + 2048;
constexpr int LDS_BYTES = 163840;
static_assert(RED_OFF + 256 <= LDS_BYTES, "LDS map");

#define GAS __attribute__((address_space(1)))
#define LAS __attribute__((address_space(3)))
typedef unsigned short bf16;
typedef unsigned v4u __attribute__((ext_vector_type(4)));
typedef unsigned v2u __attribute__((ext_vector_type(2)));
typedef int v4i __attribute__((ext_vector_type(4)));
typedef float f32x4 __attribute__((ext_vector_type(4)));
typedef GAS unsigned gu32;
#define RLX_AGENT __ATOMIC_RELAXED, __HIP_MEMORY_SCOPE_AGENT
#define LDS_WAIT() asm volatile("s_waitcnt lgkmcnt(0)" ::: "memory")
__device__ __forceinline__ unsigned pk2(float lo, float hi) { return pg8::cvt_pk_bf16(lo, hi); }
__device__ __forceinline__ float bf2f(unsigned short b) { return __uint_as_float(((unsigned)b) << 16); }
__device__ __forceinline__ float wave_sum(float v) {
#define WS_DPP(x, ctrl, rmask) __int_as_float(__builtin_amdgcn_update_dpp(0, __float_as_int(x), ctrl, rmask, 0xf, false))
    v += WS_DPP(v, 0xB1, 0xf); v += WS_DPP(v, 0x4E, 0xf); v += WS_DPP(v, 0x141, 0xf); v += WS_DPP(v, 0x140, 0xf);
    v += WS_DPP(v, 0x142, 0xa); v += WS_DPP(v, 0x143, 0xc);
#undef WS_DPP
    return __int_as_float(__builtin_amdgcn_readlane(__float_as_int(v), 63));
}

#define XB_TMO      128
#define XB_XCNT(j)  (256  + 64 * (j))
#define XB_XSUB(j)  (1280 + 64 * (j))
#define XB_XGEN(j)  (2304 + 64 * (j))
#define XB_TOP      3328
#define XB_TOPGEN   3392
#define XCD_BAR_WORDS 3456
#define XB_SPIN_CAP (1u << 18)

__device__ __forceinline__ unsigned xb_ld(unsigned* p)              { return __hip_atomic_load(p, __ATOMIC_RELAXED, __HIP_MEMORY_SCOPE_AGENT); }
__device__ __forceinline__ unsigned xb_add(unsigned* p, unsigned v) { return __hip_atomic_fetch_add(p, v, __ATOMIC_RELAXED, __HIP_MEMORY_SCOPE_AGENT); }
__device__ __forceinline__ unsigned xb_xcc_id() { return (unsigned)__builtin_amdgcn_s_getreg((3 << 11) | 20) & 0xFu; }
#define XB_SPIN(cond, bar) do { unsigned _sp = 0; while (cond) { __builtin_amdgcn_s_sleep(1); \
    if ((++_sp & 255u) == 0u) { if (xb_ld(&(bar)[XB_TMO])) break; if (_sp > XB_SPIN_CAP) { atomicAdd(&(bar)[XB_TMO], 1u); break; } } } } while (0)

struct XcdBarrier {
    unsigned* bar; unsigned x;
    volatile LAS unsigned* st;
    int w0;
};

__device__ __forceinline__ XcdBarrier xcd_barrier_post(unsigned* bar, volatile LAS unsigned* st) {
    XcdBarrier b; b.bar = bar; b.x = xb_xcc_id(); b.st = st; b.w0 = 0;
    if (threadIdx.x == 0) (void)xb_add(&bar[XB_XCNT(b.x)], 1u);
    return b;
}
__device__ __forceinline__ void xcd_barrier_complete(unsigned* bar, unsigned x, unsigned& nloc, unsigned& nx) {
    const unsigned G = gridDim.x * gridDim.y * gridDim.z;
    unsigned sum, cnt, mine, sp = 0u;
    for (;;) {
        sum = 0u; cnt = 0u; mine = 0u;
#pragma unroll
        for (unsigned j = 0; j < 16; ++j) { const unsigned c = xb_ld(&bar[XB_XCNT(j)]); sum += c; cnt += (c > 0u) ? 1u : 0u; mine = (j == x) ? c : mine; }
        if (sum == G) break;
        __builtin_amdgcn_s_sleep(1);
        if ((++sp & 255u) == 0u) { if (xb_ld(&bar[XB_TMO])) break; if (sp > XB_SPIN_CAP) { atomicAdd(&bar[XB_TMO], 1u); break; } }
    }
    nloc = mine > 0u ? mine : 1u; nx = cnt > 0u ? cnt : 1u;
}

__device__ __forceinline__ void xcd_barrier(const XcdBarrier& b) {
    asm volatile("s_waitcnt vmcnt(0)" ::: "memory");
    __syncthreads();
    if (b.w0 && __builtin_amdgcn_mbcnt_hi(~0u, __builtin_amdgcn_mbcnt_lo(~0u, 0u)) == 0u) {
        unsigned* bar = b.bar;
        __builtin_amdgcn_s_waitcnt(0);
        unsigned nloc = b.st[0], nx = b.st[1];
        if (nloc == 0u) { xcd_barrier_complete(bar, b.x, nloc, nx); b.st[0] = nloc; b.st[1] = nx; }
        const unsigned old = xb_add(&bar[XB_XSUB(b.x)], 1u);
        const unsigned gen = old / nloc;
        if (old + 1u == (gen + 1u) * nloc) {
            __builtin_amdgcn_fence(__ATOMIC_RELEASE, "agent");
            asm volatile("s_waitcnt vmcnt(0)" ::: "memory");
            const unsigned og = xb_add(&bar[XB_TOP], 1u);
            const unsigned tg = og / nx;
            if (og + 1u == (tg + 1u) * nx) xb_add(&bar[XB_TOPGEN], 1u);
            else XB_SPIN(xb_ld(&bar[XB_TOPGEN]) == tg, bar);
            __builtin_amdgcn_fence(__ATOMIC_ACQUIRE, "agent");
            xb_add(&bar[XB_XGEN(b.x)], 1u);
            asm volatile("s_waitcnt vmcnt(0)" ::: "memory");
        } else {
            XB_SPIN(xb_ld(&bar[XB_XGEN(b.x)]) == gen, bar);
            __builtin_amdgcn_fence(__ATOMIC_ACQUIRE, "agent");
            asm volatile("s_waitcnt vmcnt(0)" ::: "memory");
        }
    }
    __syncthreads();
}


struct Ctx { unsigned char* lds; int tid, lane, wave, vcu, G, gw, NGW; };

__device__ __forceinline__ void transpose_item(const float* W, int ldw, int k0, int n0, bf16* WT, int ldt, int drow0, int dcol0, float* scr, int lane, bool kpe_perm) {
    float tv[32];
#pragma unroll
    for (int i = 0; i < 32; ++i) { const int kk = 2 * i + (lane >> 5); tv[i] = W[(size_t)(k0 + kk) * ldw + n0 + (lane & 31)]; }
#pragma unroll
    for (int i = 0; i < 32; ++i) { const int kk = 2 * i + (lane >> 5); scr[kk * 33 + (lane & 31)] = tv[i]; }
    LDS_WAIT();
    const int c = lane & 7;
#pragma unroll
    for (int j = 0; j < 4; ++j) { const int n = (lane >> 3) + 8 * j; const float* s = scr + (8 * c) * 33 + n;
        v4u o; o.x = pk2(s[0 * 33], s[1 * 33]); o.y = pk2(s[2 * 33], s[3 * 33]); o.z = pk2(s[4 * 33], s[5 * 33]); o.w = pk2(s[6 * 33], s[7 * 33]);
        int dr = drow0 + n; if (kpe_perm && dr >= 384 && dr < 448) { const int e = dr - 384; dr = 384 + 32 * ((e >> 4) & 1) + 16 * (e >> 5) + (e & 15); }
        *(v4u*)(WT + (size_t)dr * ldt + dcol0 + k0 + 8 * c) = o; }
    LDS_WAIT();
}
__device__ __forceinline__ void transpose_item8(const float* W, int ldw, int k0, int n0, unsigned char* WT8, int ldt8, int drow0, int dcol0, float* scr, int lane, float scale, bool kpe_perm) {
    float tv[32];
#pragma unroll
    for (int i = 0; i < 32; ++i) { const int kk = 2 * i + (lane >> 5); tv[i] = W[(size_t)(k0 + kk) * ldw + n0 + (lane & 31)]; }
#pragma unroll
    for (int i = 0; i < 32; ++i) { const int kk = 2 * i + (lane >> 5); scr[kk * 33 + (lane & 31)] = tv[i]; }
    LDS_WAIT();
    const int n = lane >> 1, hf = lane & 1; const float* sp = scr + (32 * hf) * 33 + n;
    v4u o0, o1; unsigned w[8];
#pragma unroll
    for (int q = 0; q < 8; ++q) { int p = 0; p = __builtin_amdgcn_cvt_pk_fp8_f32(sp[(4 * q) * 33] * scale, sp[(4 * q + 1) * 33] * scale, p, false); p = __builtin_amdgcn_cvt_pk_fp8_f32(sp[(4 * q + 2) * 33] * scale, sp[(4 * q + 3) * 33] * scale, p, true); w[q] = (unsigned)p; }
    o0.x = w[0]; o0.y = w[1]; o0.z = w[2]; o0.w = w[3]; o1.x = w[4]; o1.y = w[5]; o1.z = w[6]; o1.w = w[7];
    int dr = drow0 + n; if (kpe_perm && dr >= 384 && dr < 448) { const int e = dr - 384; dr = 384 + 32 * ((e >> 4) & 1) + 16 * (e >> 5) + (e & 15); }
    unsigned char* d = WT8 + (size_t)dr * ldt8 + dcol0 + k0 + 32 * hf;
    *(v4u*)d = o0; *(v4u*)(d + 16) = o1;
    LDS_WAIT();
}
typedef __attribute__((address_space(4))) const char kchar;
struct In { int opq;
    __device__ __forceinline__ const float* operator[](int k) const { kchar* ka = (kchar*)__builtin_amdgcn_kernarg_segment_ptr(); return *(const float* const __attribute__((address_space(4)))*)(ka + 8 * k + opq); } };
__device__ __forceinline__ unsigned char* karg_ws(int opq) { kchar* ka = (kchar*)__builtin_amdgcn_kernarg_segment_ptr(); return *(unsigned char* const __attribute__((address_space(4)))*)(ka + 38 * 8 + 8 + opq); }
__device__ __forceinline__ float* karg_out(int opq) { kchar* ka = (kchar*)__builtin_amdgcn_kernarg_segment_ptr(); return *(float* const __attribute__((address_space(4)))*)(ka + 38 * 8 + opq); }

__device__ __forceinline__ void p0_prologue(const Ctx& F, const In& in, unsigned char* ws) {
    float* scr = (float*)(F.lds + RING_OFF + F.wave * 16384);
    bf16* Wd = (bf16*)(ws + WS_WD); bf16* Wuq = (bf16*)(ws + WS_WUQ); bf16* Wukv = (bf16*)(ws + WS_WUKV); bf16* Wo = (bf16*)(ws + WS_WO);
    bf16* Win = (bf16*)(ws + WS_WIN); bf16* Wout = (bf16*)(ws + WS_WOUT); bf16* Wgu = (bf16*)(ws + WS_WGU); bf16* Wdn = (bf16*)(ws + WS_WDN);
    constexpr int I_D = 16 * 14, I_UQ = 4 * 48, I_UKV = 2 * 64, I_O = 16 * 32, I_IN = 16 * 96, I_OUT = 16 * 32, I_GU = 2 * 16 * 2 * (16 * 8), I_DN = 2 * 24 * 2 * (4 * 32);
    constexpr int NITEMS = I_D + I_UQ + I_UKV + I_O + I_IN + I_OUT + I_GU + I_DN;
    for (int it = F.gw; it < NITEMS; it += F.NGW) {
        int r = it; const float* W; int ldw, k0, n0, ldt, drow0, dcol0 = 0; bf16* WT; float f8s = 0.f;
        if (r < I_D) { W = in[7]; ldw = 448; k0 = (r / 14) * 64; n0 = (r % 14) * 32; WT = Wd; ldt = 1024; drow0 = n0; f8s = 32.f; }
        else if ((r -= I_D) < I_UQ) { W = in[10]; ldw = 1536; k0 = (r / 48) * 64; n0 = (r % 48) * 32; WT = Wuq; ldt = 256; drow0 = n0; f8s = 16.f; }
        else if ((r -= I_UQ) < I_UKV) { W = in[11]; ldw = 2048; k0 = (r / 64) * 64; n0 = (r % 64) * 32; ldt = 128;
            WT = Wukv + ((n0 & 128) ? 1024 * 128 : 0); drow0 = (n0 >> 8) * 128 + (n0 & 127); }
        else if ((r -= I_UKV) < I_O) { W = in[14]; ldw = 1024; k0 = (r / 32) * 64; n0 = (r % 32) * 32; WT = Wo; ldt = 1024; drow0 = n0; f8s = 32.f; }
        else if ((r -= I_O) < I_IN) { W = in[15]; ldw = 3072; k0 = (r / 96) * 64; n0 = (r % 96) * 32; WT = Win; ldt = 1024; drow0 = n0; }
        else if ((r -= I_IN) < I_OUT) { W = in[30]; ldw = 1024; k0 = (r / 32) * 64; n0 = (r % 32) * 32; WT = Wout; ldt = 1024; drow0 = n0; }
        else if ((r -= I_OUT) < I_GU) {
            const int sub = r % 128, mat = r / 128, which = mat & 1, le = mat >> 1;
            W = (which ? in[36] : in[35]) + (size_t)le * 1024 * 256; ldw = 256; k0 = (sub / 8) * 64; n0 = (sub % 8) * 32;
            WT = (bf16*)((unsigned char*)Wgu + (size_t)le * 512 * 1024); ldt = 1024; drow0 = (n0 >> 7) * 256 + which * 128 + (n0 & 127); f8s = 32.f; }
        else { r -= I_GU;
            const int sub = r % 128, mat = r / 128, slot = mat & 1, lb = mat >> 1, layer = lb / 24, bk = lb % 24;
            int ii, jj; pg8::pair_of(bk % 6, ii, jj); const int e = (bk / 6) * 4 + (slot ? jj : ii);
            W = in[37] + (size_t)(layer * 16 + e) * 256 * 1024; ldw = 1024; k0 = (sub / 32) * 64; n0 = (sub % 32) * 32;
            WT = (bf16*)((unsigned char*)Wdn + (size_t)lb * 1024 * 512); ldt = 512; drow0 = n0; dcol0 = slot * 256; f8s = 32.f; }
        if (f8s != 0.f) transpose_item8(W, ldw, k0, n0, (unsigned char*)WT, ldt, drow0, dcol0, scr, F.lane, f8s, it < I_D);
        else transpose_item(W, ldw, k0, n0, WT, ldt, drow0, dcol0, scr, F.lane, it < I_D);
    }
    { const int gt = F.vcu * NTHR + F.tid, NGT = F.G * NTHR; const v4u z = {0u, 0u, 0u, 0u};
      for (int i = gt; i < 64 * 1024 / 16; i += NGT) *(v4u*)((unsigned char*)Wd + (size_t)448 * 1024 + (size_t)i * 16) = z;
    }
    { const int gt = F.vcu * NTHR + F.tid, NGT = F.G * NTHR; float* RT = (float*)(ws + WS_ROPE); const int* posi = (const int*)in[2];
      const float inv = __builtin_amdgcn_exp2f(-0.41524101186092029f * (float)(gt & 31));
      for (int i = gt; i < T * 32; i += NGT) { const int t = i >> 5;
        float sn, cs; sincosf((float)posi[t] * inv, &sn, &cs); *(v2u*)(RT + (size_t)i * 2) = (v2u){__float_as_uint(cs), __float_as_uint(sn)}; } }
    { const int gt = F.vcu * NTHR + F.tid, NGT = F.G * NTHR; bf16* W4S = (bf16*)(ws + WS_W4S); const float* w4 = in[28];
      for (int i = gt; i < 4096 * 8; i += NGT) { const int col = i & 4095, oct = i >> 12; float w[8];
#pragma unroll
        for (int q = 0; q < 8; ++q) w[q] = w4[(size_t)(8 * oct + q) * 4096 + col];
        unsigned hw[4], lw[4];
#pragma unroll
        for (int q = 0; q < 4; ++q) { const unsigned h2 = pk2(w[2 * q], w[2 * q + 1]); hw[q] = h2;
          lw[q] = pk2(w[2 * q] - __uint_as_float(h2 << 16), w[2 * q + 1] - __uint_as_float(h2 & 0xffff0000u)); }
        bf16* d = W4S + (size_t)col * 256 + 8 * oct; const v4u hv = {hw[0], hw[1], hw[2], hw[3]}, lv = {lw[0], lw[1], lw[2], lw[3]}, zv = {0u, 0u, 0u, 0u};
        *(v4u*)d = hv; *(v4u*)(d + 64) = hv; *(v4u*)(d + 128) = lv; *(v4u*)(d + 192) = zv; } }
    __syncthreads();
    { bf16* HDp = (bf16*)(ws + WS_HDNS); float* wl = (float*)(F.lds + RING_OFF); float* sv = wl + 161 * 64 + F.wave * 64;
      for (int i = F.tid; i < 161 * 64; i += NTHR) wl[i] = i < 33 * 64 ? in[19][i] : (i < 97 * 64 ? in[22][i - 33 * 64] : in[25][i - 97 * 64]);
      __syncthreads();
      const int j = F.lane; const float b1 = in[20][j], f1 = in[21][j], b2 = in[23][j], f2 = in[24][j], b3 = in[26][j], f3 = in[27][j];
      for (int t = F.gw; t < 4096; t += F.NGW) {
        float zf = 0.f;
        { const float w = 6.2831855f * (float)t * (1.f / 4096.f);
          if (j == 0) zf = (float)t / 4095.f;
          else if (j <= 16) { const float fr = 1e-4f + (float)(j - 1) * ((15.f - 1e-4f) / 15.f); zf = cosf(fr * w); }
          else if (j <= 32) { const float fr = 1e-4f + (float)(j - 17) * ((15.f - 1e-4f) / 15.f); zf = -sinf(fr * w); } }
        sv[j] = zf; LDS_WAIT();
        float a = b1;
#pragma unroll
        for (int k = 0; k < 33; ++k) a += sv[k] * wl[k * 64 + j];
        float h = sinf(f1 * a); LDS_WAIT(); sv[j] = h; LDS_WAIT();
        a = b2;
#pragma unroll 16
        for (int k = 0; k < 64; ++k) a += sv[k] * wl[(33 + k) * 64 + j];
        h = sinf(f2 * a); LDS_WAIT(); sv[j] = h; LDS_WAIT();
        a = b3;
#pragma unroll 16
        for (int k = 0; k < 64; ++k) a += sv[k] * wl[(97 + k) * 64 + j];
        h = sinf(f3 * a); LDS_WAIT();
        const unsigned hi = pk2(h, 0.f) & 0xffffu; const float lo = h - bf2f((unsigned short)hi); const unsigned lob = pk2(lo, 0.f) & 0xffffu;
        bf16* d = HDp + (size_t)t * 256 + j; d[0] = (bf16)hi; d[64] = (bf16)lob; d[128] = (bf16)hi; d[192] = 0;
      } }
    __syncthreads();
    { float* cact = (float*)(F.lds + RING_OFF); float* red = cact + 8 * 1024;
      float* MOD = (float*)(ws + WS_MOD);
      for (int i = F.tid; i < 8 * 1024; i += NTHR) { const float x = in[1][i]; cact[(i & 1023) * 8 + (i >> 10)] = x / (1.f + __expf(-x)); }
      __syncthreads();
      for (int it = F.vcu; it < 2 * 96; it += F.G) {
        const int layer = it / 96, cb = it - 96 * layer, r4 = F.lane >> 4, cq = F.lane & 15;
        const float* W = in[3] + (size_t)layer * 1024 * 6144 + cb * 64 + 4 * cq + (size_t)(F.wave * 128 + r4) * 6144;
        f32x4 acc[8];
#pragma unroll
        for (int b = 0; b < 8; ++b) acc[b] = (f32x4){0.f, 0.f, 0.f, 0.f};
#pragma unroll
        for (int hf = 0; hf < 2; ++hf) { f32x4 wv[16];
#pragma unroll
          for (int q = 0; q < 16; ++q) wv[q] = *(const f32x4*)(W + (size_t)(4 * (16 * hf + q)) * 6144);
#pragma unroll
          for (int q = 0; q < 16; ++q) { const int kk = 4 * (16 * hf + q) + r4; const float* cp = cact + (F.wave * 128 + kk) * 8; const f32x4 c0 = *(const f32x4*)cp, c1 = *(const f32x4*)(cp + 4);
#pragma unroll
            for (int b = 0; b < 8; ++b) acc[b] += (b < 4 ? c0[b & 3] : c1[b & 3]) * wv[q]; } }
#pragma unroll
        for (int b = 0; b < 8; ++b) *(f32x4*)(red + ((F.wave * 4 + r4) * 8 + b) * 64 + 4 * cq) = acc[b];
        __syncthreads();
        { const int b = F.tid >> 6, col = F.tid & 63; float s = in[4][layer * 6144 + cb * 64 + col];
#pragma unroll 8
          for (int p = 0; p < 32; ++p) s += red[(p * 8 + b) * 64 + col];
          MOD[((size_t)layer * 8 + b) * 6144 + cb * 64 + col] = s; }
        __syncthreads();
      } }
}

template <class TX> __device__ __forceinline__ f32x4 ldrow4(const TX* p);
template <> __device__ __forceinline__ f32x4 ldrow4<float>(const float* p) { return *(const __attribute__((address_space(1))) f32x4*)p; }
template <> __device__ __forceinline__ f32x4 ldrow4<bf16>(const bf16* p) { const v2u w = *(const __attribute__((address_space(1))) v2u*)p; f32x4 r; r[0] = __uint_as_float(w.x << 16); r[1] = __uint_as_float(w.x & 0xffff0000u); r[2] = __uint_as_float(w.y << 16); r[3] = __uint_as_float(w.y & 0xffff0000u); return r; }
template <class TX, bool OUT8 = false> __device__ __forceinline__ void norm_mod_phase(const Ctx& F, const TX* X, const float* g, const float* sc, const float* sh, bf16* OUT) {
    for (int ch = F.gw; ch < T / 16; ch += F.NGW) {
        const int r0 = ch * 16, b = r0 >> 12;
        f32x4 A[4], S[4];
#pragma unroll
        for (int j = 0; j < 4; ++j) { const int col = 4 * F.lane + 256 * j; const f32x4 gv = *(const f32x4*)(g + col), sv = *(const f32x4*)(sc + (size_t)b * 6144 + col); A[j] = gv * (1.f + sv); S[j] = *(const f32x4*)(sh + (size_t)b * 6144 + col); }
        const TX* xr = X + (size_t)r0 * DM + 4 * F.lane;
        f32x4 nx[4];
#pragma unroll
        for (int j = 0; j < 4; ++j) nx[j] = ldrow4<TX>(xr + 256 * j);
        for (int rr = 0; rr < 16; ++rr) {
            f32x4 v[4]; float ss = 0.f;
#pragma unroll
            for (int j = 0; j < 4; ++j) { v[j] = nx[j]; ss += (v[j].x * v[j].x + v[j].y * v[j].y) + (v[j].z * v[j].z + v[j].w * v[j].w); }
            if (rr < 15) {
#pragma unroll
                for (int j = 0; j < 4; ++j) nx[j] = ldrow4<TX>(xr + (size_t)(rr + 1) * DM + 256 * j); }
            const float rstd = rsqrtf(wave_sum(ss) * (1.f / DM) + EPS);
            if constexpr (OUT8) { unsigned char* orow = (unsigned char*)OUT + (size_t)(r0 + rr) * DM + 4 * F.lane;
#pragma unroll
                for (int j = 0; j < 4; ++j) { const f32x4 o = v[j] * rstd * A[j] + S[j]; int p = 0; p = __builtin_amdgcn_cvt_pk_fp8_f32(o.x, o.y, p, false); p = __builtin_amdgcn_cvt_pk_fp8_f32(o.z, o.w, p, true); *(int*)(orow + 256 * j) = p; } }
            else { bf16* orow = OUT + (size_t)(r0 + rr) * DM + 4 * F.lane;
#pragma unroll
                for (int j = 0; j < 4; ++j) { const f32x4 o = v[j] * rstd * A[j] + S[j]; v2u w; w.x = pk2(o.x, o.y); w.y = pk2(o.z, o.w); *(v2u*)(orow + 256 * j) = w; } } }
    }
}

__device__ __forceinline__ void lat_post_phase(const Ctx& F, const float* LAT, const float* qag, const float* kvag, const float* kng, const float* rope, bf16* CQN, bf16* CKVN, bf16* KPE) {
    const int l = F.lane;
    const f32x4 gq = *(const f32x4*)(qag + 4 * l);
    const f32x4 g2 = l < 32 ? *(const f32x4*)(kvag + 4 * l) : (l < 48 ? *(const f32x4*)(kng + 128 + 4 * (l - 32)) : (f32x4){0.f, 0.f, 0.f, 0.f});
    f32x4 na = *(const f32x4*)(LAT + (size_t)F.gw * 512 + 4 * l), nc = l < 48 ? *(const f32x4*)(LAT + (size_t)F.gw * 512 + 256 + 4 * l) : (f32x4){0.f, 0.f, 0.f, 0.f};
    for (int row = F.gw; row < T; row += F.NGW) {
        const f32x4 a = na, c = nc;
        if (row + F.NGW < T) { const float* nr = LAT + (size_t)(row + F.NGW) * 512; na = *(const f32x4*)(nr + 4 * l); if (l < 48) nc = *(const f32x4*)(nr + 256 + 4 * l); }
        const float sq = (a.x * a.x + a.y * a.y) + (a.z * a.z + a.w * a.w), sc = (c.x * c.x + c.y * c.y) + (c.z * c.z + c.w * c.w);
        const float s_q = wave_sum(sq), s_kv = wave_sum(l < 32 ? sc : 0.f), s_pe = wave_sum((l >= 32 && l < 48) ? sc : 0.f);
        const float rq = rsqrtf(s_q * (1.f / 256.f) + EPS), rkv = rsqrtf(s_kv * (1.f / 128.f) + EPS), rpe = rsqrtf(s_pe * (1.f / 64.f) + EPS);
        { const f32x4 o = a * rq * gq; v2u w; w.x = pk2(o.x, o.y); w.y = pk2(o.z, o.w); *(v2u*)(CQN + (size_t)row * 256 + 4 * l) = w; }
        if (l < 32) { const f32x4 o = c * rkv * g2; v2u w; w.x = pk2(o.x, o.y); w.y = pk2(o.z, o.w); *(v2u*)(CKVN + (size_t)row * 256 + 4 * l) = w; }
        else { v2u w; w.x = 0u; w.y = 0u; *(v2u*)(CKVN + (size_t)row * 256 + 128 + 4 * (l - 32)) = w; }
        const f32x4 n = c * rpe * g2;
        f32x4 other; other.x = __shfl_xor(n.x, 8); other.y = __shfl_xor(n.y, 8); other.z = __shfl_xor(n.z, 8); other.w = __shfl_xor(n.w, 8);
        if (l >= 32 && l < 48) { const bool first = l < 40; const int e0 = 4 * ((l - 32) & 7);
            float o[4];
#pragma unroll
            for (int i = 0; i < 4; ++i) { const int e = e0 + i; const float cs = rope[(size_t)row * 64 + e * 2], sn = rope[(size_t)row * 64 + e * 2 + 1];
                const float mine = n[i], oth = other[i]; o[i] = first ? (mine * cs - oth * sn) : (oth * sn + mine * cs); }
            v2u w; w.x = pk2(o[0], o[1]); w.y = pk2(o[2], o[3]); *(v2u*)(KPE + (size_t)row * 64 + 4 * (l - 32)) = w; }
    }
}

__device__ __forceinline__ void knorm_phase(const Ctx& F, bf16* KV, const float* kng) {
    const int l = F.lane, h = l >> 3, e0 = (l & 7) * 16;
    float g[16];
#pragma unroll
    for (int i = 0; i < 16; ++i) g[i] = kng[e0 + i];
    for (int row = F.gw; row < T; row += F.NGW) {
        bf16* p = KV + (size_t)row * 2048 + h * 256 + e0;
        const v4u r0 = *(const v4u*)p, r1 = *(const v4u*)(p + 8);
        float f[16]; const unsigned w[8] = {r0.x, r0.y, r0.z, r0.w, r1.x, r1.y, r1.z, r1.w};
        float ss = 0.f;
#pragma unroll
        for (int i = 0; i < 8; ++i) { f[2 * i] = __uint_as_float(w[i] << 16); f[2 * i + 1] = __uint_as_float(w[i] & 0xffff0000u); ss += f[2 * i] * f[2 * i] + f[2 * i + 1] * f[2 * i + 1]; }
        ss += __shfl_xor(ss, 1); ss += __shfl_xor(ss, 2); ss += __shfl_xor(ss, 4);
        const float r = rsqrtf(ss * (1.f / 128.f) + EPS);
        v4u o0, o1;
        o0.x = pk2(f[0] * r * g[0], f[1] * r * g[1]); o0.y = pk2(f[2] * r * g[2], f[3] * r * g[3]); o0.z = pk2(f[4] * r * g[4], f[5] * r * g[5]); o0.w = pk2(f[6] * r * g[6], f[7] * r * g[7]);
        o1.x = pk2(f[8] * r * g[8], f[9] * r * g[9]); o1.y = pk2(f[10] * r * g[10], f[11] * r * g[11]); o1.z = pk2(f[12] * r * g[12], f[13] * r * g[13]); o1.w = pk2(f[14] * r * g[14], f[15] * r * g[15]);
        *(v4u*)p = o0; *(v4u*)(p + 8) = o1;
    }
}

__device__ __forceinline__ void route_phase(const Ctx& F, const bf16* X, const float* g, const float* sc, const float* sh, const float* wg, const float* bg, const float* we, const float* be,
                                            bf16* XN2, int* LIST, float* WL, gu32* cnt) {
    float* W20 = (float*)(F.lds + RING_OFF); constexpr int W20P = 1028;
    unsigned* lcnt = (unsigned*)(F.lds + RED_OFF); unsigned* gbase = lcnt + 32;
    if (F.tid < 24) lcnt[F.tid] = 0u;
    for (int i = F.tid; i < 4 * 1024; i += NTHR) W20[(i & 3) * W20P + (i >> 2)] = wg[i];
    for (int i = F.tid; i < 16 * 1024; i += NTHR) W20[(4 + (i & 15)) * W20P + (i >> 4)] = we[i];
    __syncthreads();
    float bgv[4];
#pragma unroll
    for (int i = 0; i < 4; ++i) bgv[i] = bg[i];
    for (int ch0 = 0; ch0 < T / 16; ch0 += F.NGW) {
        const int ch = ch0 + F.gw; const bool act = ch < T / 16; const int r0 = (act ? ch : 0) * 16, b = r0 >> 12;
        f32x4 A[4], S[4];
#pragma unroll
        for (int j = 0; j < 4; ++j) { const int col = 4 * F.lane + 256 * j; const f32x4 gv = *(const f32x4*)(g + col), sv = *(const f32x4*)(sc + (size_t)b * 6144 + col); A[j] = gv * (1.f + sv); S[j] = *(const f32x4*)(sh + (size_t)b * 6144 + col); }
        const bf16* xr = X + (size_t)r0 * DM + 4 * F.lane;
        f32x4 nx[2][4];
#pragma unroll
        for (int u = 0; u < 2; ++u)
#pragma unroll
            for (int j = 0; j < 4; ++j) nx[u][j] = ldrow4<bf16>(xr + (size_t)u * DM + 256 * j);
        int my_bk = 0; float my_wlo = 0.f, my_whi = 0.f;
        for (int rr = 0; rr < 16; rr += 2) {
            f32x4 v[2][4]; float ss[2];
#pragma unroll
            for (int u = 0; u < 2; ++u) { ss[u] = 0.f;
#pragma unroll
                for (int j = 0; j < 4; ++j) { v[u][j] = nx[u][j]; ss[u] += (v[u][j].x * v[u][j].x + v[u][j].y * v[u][j].y) + (v[u][j].z * v[u][j].z + v[u][j].w * v[u][j].w); } }
            if (rr < 14) {
#pragma unroll
                for (int u = 0; u < 2; ++u)
#pragma unroll
                    for (int j = 0; j < 4; ++j) nx[u][j] = ldrow4<bf16>(xr + (size_t)(rr + 2 + u) * DM + 256 * j); }
            float gl[2][4]; int gi[2]; float gm[2];
#pragma unroll
            for (int u = 0; u < 2; ++u) { const int row = r0 + rr + u;
                const float rstd = rsqrtf(wave_sum(ss[u]) * (1.f / DM) + EPS);
                unsigned char* orow = (unsigned char*)XN2 + (size_t)row * DM + 4 * F.lane;
#pragma unroll
                for (int j = 0; j < 4; ++j) { v[u][j] = v[u][j] * rstd * A[j] + S[j]; int p = 0; p = __builtin_amdgcn_cvt_pk_fp8_f32(v[u][j].x, v[u][j].y, p, false); p = __builtin_amdgcn_cvt_pk_fp8_f32(v[u][j].z, v[u][j].w, p, true); *(int*)(orow + 256 * j) = p; }
#pragma unroll
                for (int o = 0; o < 4; ++o) { float a = 0.f;
#pragma unroll
                    for (int j = 0; j < 4; ++j) { const f32x4 w = *(const f32x4*)(W20 + o * W20P + 4 * F.lane + 256 * j); a += (v[u][j].x * w.x + v[u][j].y * w.y) + (v[u][j].z * w.z + v[u][j].w * w.w); }
                    gl[u][o] = wave_sum(a) + bgv[o]; }
                int g_ = 0; float m_ = gl[u][0]; if (gl[u][1] > m_) { m_ = gl[u][1]; g_ = 1; } if (gl[u][2] > m_) { m_ = gl[u][2]; g_ = 2; } if (gl[u][3] > m_) { m_ = gl[u][3]; g_ = 3; }
                gi[u] = __builtin_amdgcn_readfirstlane(g_); gm[u] = m_; }
#pragma unroll
            for (int u = 0; u < 2; ++u) {
                const float gw_ = __builtin_amdgcn_rcpf(__expf(gl[u][0] - gm[u]) + __expf(gl[u][1] - gm[u]) + __expf(gl[u][2] - gm[u]) + __expf(gl[u][3] - gm[u]));
                const float* We = W20 + (4 + 4 * gi[u]) * W20P + 4 * F.lane;
                float e[4];
#pragma unroll
                for (int k = 0; k < 4; ++k) { float a = 0.f;
#pragma unroll
                    for (int j = 0; j < 4; ++j) { const f32x4 w = *(const f32x4*)(We + k * W20P + 256 * j); a += (v[u][j].x * w.x + v[u][j].y * w.y) + (v[u][j].z * w.z + v[u][j].w * w.w); }
                    e[k] = wave_sum(a) + be[4 * gi[u] + k]; }
                int i1 = 0; float m1 = e[0];
#pragma unroll
                for (int k = 1; k < 4; ++k) if (e[k] > m1) { m1 = e[k]; i1 = k; }
                int i2 = -1; float m2 = -3.0e38f;
#pragma unroll
                for (int k = 0; k < 4; ++k) if (k != i1 && e[k] > m2) { m2 = e[k]; i2 = k; }
                const float t2 = __expf(m2 - m1), w1 = gw_ * __builtin_amdgcn_rcpf(1.f + t2), w2 = w1 * t2;
                const int ilo = i1 < i2 ? i1 : i2, ihi = i1 < i2 ? i2 : i1; const float wlo = i1 < i2 ? w1 : w2, whi = i1 < i2 ? w2 : w1;
                const int pi = ilo == 0 ? ihi - 1 : (ilo == 1 ? ihi + 1 : 5), bk = gi[u] * 6 + pi;
                if (F.lane == rr + u) { my_bk = bk; my_wlo = wlo; my_whi = whi; }
            }
        }
        unsigned rank = 0u; if (F.lane < 16 && act) rank = __hip_atomic_fetch_add(lcnt + my_bk, 1u, __ATOMIC_RELAXED, __HIP_MEMORY_SCOPE_WORKGROUP);
        __syncthreads();
        if (F.tid < 24) { const unsigned n = lcnt[F.tid]; gbase[F.tid] = n ? __hip_atomic_fetch_add(cnt + F.tid * 64, n, RLX_AGENT) : 0u; }
        __syncthreads();
        if (F.lane < 16 && act) { const unsigned pos = gbase[my_bk] + rank;
            LIST[my_bk * 32768 + pos] = r0 + F.lane; float2 ww; ww.x = my_wlo; ww.y = my_whi; *(float2*)(WL + ((size_t)my_bk * 32768 + pos) * 2) = ww; }
        __syncthreads();
        if (F.tid < 24) lcnt[F.tid] = 0u;
        __syncthreads();
    }
}
__device__ __forceinline__ void moe_table(const Ctx& F, const gu32* cnt) {
    int* tinfo = (int*)(F.lds + TINFO_OFF);
    __syncthreads();
    if (F.tid == 0) { int nt = 0;
        for (int b = 0; b < 24; ++b) { const int c = (int)__hip_atomic_load(cnt + b * 64, RLX_AGENT); const int tiles = (c + 255) >> 8;
            tinfo[256 + b] = nt * 256; tinfo[288 + b] = c; for (int i = 0; i < tiles; ++i) tinfo[1 + nt + i] = b; nt += tiles; }
        tinfo[0] = nt; }
    __syncthreads();
}
__device__ __forceinline__ void permute_phase(const Ctx& F, const bf16* XN2, const int* ROUTE, bf16* XN2S, int* TOKW) {
    const int* tinfo = (const int*)(F.lds + TINFO_OFF);
    for (int ch = F.gw; ch < T / 4; ch += F.NGW) {
        v4i r[4]; v4u a[4], bq[4];
#pragma unroll
        for (int i = 0; i < 4; ++i) { const int row = ch * 4 + i; r[i] = *(const v4i*)(ROUTE + (size_t)row * 4);
            a[i] = *(const v4u*)(XN2 + (size_t)row * DM + 8 * F.lane); bq[i] = *(const v4u*)(XN2 + (size_t)row * DM + 512 + 8 * F.lane); }
#pragma unroll
        for (int i = 0; i < 4; ++i) { const int row = ch * 4 + i, srow = tinfo[256 + r[i].x] + r[i].y;
            *(v4u*)(XN2S + (size_t)srow * DM + 8 * F.lane) = a[i]; *(v4u*)(XN2S + (size_t)srow * DM + 512 + 8 * F.lane) = bq[i];
            if (F.lane == 0) { v4i w; w.x = row; w.y = r[i].z; w.z = r[i].w; w.w = 0; *(v4i*)(TOKW + (size_t)srow * 4) = w; } }
    }
}

constexpr float W32C[16] = {1.f, 0.98078528040323043f, 0.92387953251128674f, 0.83146961230254524f, 0.70710678118654752f, 0.55557023301960218f, 0.38268343236508977f, 0.19509032201612825f,
                            0.f, -0.19509032201612825f, -0.38268343236508977f, -0.55557023301960218f, -0.70710678118654752f, -0.83146961230254524f, -0.92387953251128674f, -0.98078528040323043f};
constexpr float W32S[16] = {0.f, 0.19509032201612825f, 0.38268343236508977f, 0.55557023301960218f, 0.70710678118654752f, 0.83146961230254524f, 0.92387953251128674f, 0.98078528040323043f,
                            1.f, 0.98078528040323043f, 0.92387953251128674f, 0.83146961230254524f, 0.70710678118654752f, 0.55557023301960218f, 0.38268343236508977f, 0.19509032201612825f};
struct FftTw { const c32* T1; c32 tob; const c32* T2; };
template <int A> __device__ __forceinline__ c32 mul_to(c32 x, c32 tob) { const c32 y = cmul(x, tob); return cmk(y.x * W32C[A] + y.y * W32S[A], y.y * W32C[A] - y.x * W32S[A]); }
template <int A> __device__ __forceinline__ c32 mul_toc(c32 x, c32 tob) { const c32 y = cmulc(x, tob); return cmk(y.x * W32C[A] - y.y * W32S[A], y.y * W32C[A] + y.x * W32S[A]); }
#define TO_ALL(OP) OP(0) OP(1) OP(2) OP(3) OP(4) OP(5) OP(6) OP(7) OP(8) OP(9) OP(10) OP(11) OP(12) OP(13) OP(14) OP(15)
__device__ __forceinline__ void fft_twiddles(FftTw& W, int gt, c32* t1tab, c32* t2tab, int tid) {
    if (tid < 256) { float s, c; sincosf(-6.283185307179586f * (float)(((tid >> 4) * (tid & 15)) & 255) * (1.f / 256.f), &s, &c); t2tab[(tid >> 4) * 17 + (tid & 15)] = cmk(c, s); }
    for (int i = tid; i < 4096; i += NTHR) { const int p = i >> 8, t = i & 255; float s, c; sincosf(-6.283185307179586f * (float)((t * p) & 4095) * (1.f / 4096.f), &s, &c); t1tab[i] = cmk(c, s); }
    { float s, c; sincosf(-6.283185307179586f * (float)gt * (1.f / 8192.f), &s, &c); W.tob = cmk(c, s); }
    W.T1 = t1tab + gt; W.T2 = t2tab + (gt & 15) * 17;
    __syncthreads();
}
__device__ __forceinline__ void fft_forward_a(c32 (&v)[16], const FftTw& W, c32* ex, int gt) {
    __syncthreads();
    fft_fwd_a(v, W.T1, ex, gt);
    __syncthreads();
}
__device__ __forceinline__ void fft_forward_bc(c32 (&v)[16], const FftTw& W, c32* ex, int gt) {
    fft_fwd_b(v, W.T2, ex, ex, gt);
    __builtin_amdgcn_wave_barrier(); asm volatile("" ::: "memory");
    fft_fwd_c(v, ex, gt);
}
__device__ __forceinline__ void fft_forward(c32 (&v)[16], const FftTw& W, c32* ex, int gt) { fft_forward_a(v, W, ex, gt); fft_forward_bc(v, W, ex, gt); }
__device__ __forceinline__ void fft_inverse(c32 (&v)[16], const FftTw& W, c32* ex, int gt) {
    __builtin_amdgcn_wave_barrier(); asm volatile("" ::: "memory");
    fft_inv_a(v, ex, gt);
    __builtin_amdgcn_wave_barrier(); asm volatile("" ::: "memory");
    fft_inv_b(v, W.T2, ex, ex, gt);
    __syncthreads();
    fft_inv_c(v, W.T1, ex, gt);
}
__device__ __forceinline__ void filter_phase(const Ctx& F, const float* HT, const float* fbias, c32* KF) {
    const int g = __builtin_amdgcn_readfirstlane(F.tid >> 8), gt = F.tid & 255;
    c32* ex = (c32*)(F.lds + RING_OFF + g * 36864);
    float* rev = (float*)ex;
    float* red = (float*)(F.lds + RED_OFF);
    FftTw W; fft_twiddles(W, gt, (c32*)(F.lds + RING_OFF + 73728), (c32*)(F.lds + RING_OFF + 110592), F.tid);
    for (int d = F.vcu; d < DM; d += F.G) {
        int gtv = gt; asm volatile("" : "+v"(gtv));
        const float delta = fabsf(-120.39728043259361f + (float)d * ((40.546510810816436f + 120.39728043259361f) / 1023.f));
        const float* hfp = HT + (size_t)(g * 2048 + d) * 4096; const float* hbp = HT + (size_t)(g * 2048 + 1024 + d) * 4096;
        float hf[16], hb[16]; float sf = 0.f, sb = 0.f;
#pragma unroll
        for (int a = 0; a < 16; ++a) { const int t = 256 * a + gtv; const float dec = __expf(-((float)t * (1.f / 4095.f)) * delta); hf[a] = hfp[t] * dec; hb[a] = hbp[t] * dec; sf += fabsf(hf[a]); sb += fabsf(hb[a]); }
        sf = wave_sum(sf); sb = wave_sum(sb);
        __syncthreads();
        if (F.lane == 0) { red[F.wave * 2] = sf; red[F.wave * 2 + 1] = sb; }
        __syncthreads();
        sf = red[g * 8] + red[g * 8 + 2] + red[g * 8 + 4] + red[g * 8 + 6]; sb = red[g * 8 + 1] + red[g * 8 + 3] + red[g * 8 + 5] + red[g * 8 + 7];
        const float nf = 1.f / (sf + EPS) * (1.f / 8192.f), nb = 1.f / (sb + EPS) * (1.f / 8192.f);
#pragma unroll
        for (int a = 0; a < 16; ++a) rev[256 * a + gt] = hb[a] * nb;
        __syncthreads();
        c32 v[16];
#pragma unroll
        for (int a = 0; a < 16; ++a) { const int n = 256 * a + gt; hb[a] = n == 0 ? 0.f : rev[4096 - n]; hf[a] *= nf; v[a] = cmk(hf[a] + hb[a], 0.f); }
        fft_forward(v, W, ex, gt);
        c32* kf = KF + ((size_t)(d * 2 + g) * 2) * 4096; const float fb = fbias[g * 1024 + d] * (1.f / 4096.f);
#pragma unroll
        for (int i = 0; i < 16; ++i) kf[i * 256 + gtv] = cmk(v[i].x + fb, v[i].y);
#define OPX(A) v[A] = mul_to<A>(cmk(hf[A] - hb[A], 0.f), W.tob);
        TO_ALL(OPX)
#undef OPX
        fft_forward(v, W, ex, gt);
#pragma unroll
        for (int i = 0; i < 16; ++i) kf[4096 + i * 256 + gtv] = v[i];
    }
}
__device__ __forceinline__ void long_conv(c32 (&z)[16], const c32* kf, const FftTw& W, c32* ex, int gt) {
    typedef float f32x2v __attribute__((ext_vector_type(2))); typedef __attribute__((address_space(1))) const f32x2v gc32;
    c32 v[16], k[16]; int gk = gt; asm volatile("" : "+v"(gk));
#define OPX(A) v[A] = mul_to<A>(z[A], W.tob);
    TO_ALL(OPX)
#undef OPX
    fft_forward_a(v, W, ex, gt);
    asm volatile("" ::: "memory");
#pragma unroll
    for (int i = 0; i < 16; ++i) { const f32x2v t_ = ((gc32*)kf)[4096 + i * 256 + gk]; k[i] = cmk(t_.x, t_.y); }
    fft_forward_bc(v, W, ex, gt);
#pragma unroll
    for (int i = 0; i < 16; ++i) v[i] = cmul(v[i], k[i]);
    fft_inverse(v, W, ex, gt);
#define OPX(A) v[A] = mul_toc<A>(v[A], W.tob);
    TO_ALL(OPX)
#undef OPX
    fft_forward_a(z, W, ex, gt);
    asm volatile("" ::: "memory");
#pragma unroll
    for (int i = 0; i < 16; ++i) { const f32x2v t_ = ((gc32*)kf)[i * 256 + gk]; k[i] = cmk(t_.x, t_.y); }
    fft_forward_bc(z, W, ex, gt);
#pragma unroll
    for (int i = 0; i < 16; ++i) z[i] = cmul(z[i], k[i]);
    fft_inverse(z, W, ex, gt);
#pragma unroll
    for (int a = 0; a < 16; ++a) z[a] = cadd(z[a], v[a]);
}
struct RawSeq { v4u r[2][2]; };
__device__ __forceinline__ void raw_issue(RawSeq& q, const bf16* urow, int b0, int gt) {
    typedef __attribute__((address_space(1))) const v4u gv4u;
    asm volatile("" : "+v"(gt));
#pragma unroll
    for (int s_ = 0; s_ < 2; ++s_)
#pragma unroll
        for (int i = 0; i < 2; ++i) q.r[s_][i] = *(gv4u*)(urow + (size_t)(b0 + s_) * SEQ + (gt + 256 * i) * 8);
}
__device__ __forceinline__ void stage_conv3(c32 (&o)[16], const RawSeq& q, float w0, float w1, float w2, float cb, bf16* stg, int gt) {
    constexpr int SS = 4112;
    __syncthreads();
#pragma unroll
    for (int s_ = 0; s_ < 2; ++s_) {
#pragma unroll
        for (int i = 0; i < 2; ++i) *(v4u*)(stg + s_ * SS + 8 + (gt + 256 * i) * 8) = q.r[s_][i];
        if (gt == 0) { stg[s_ * SS + 7] = 0; stg[s_ * SS + 4104] = 0; } }
    __syncthreads();
#pragma unroll
    for (int a = 0; a < 16; ++a) { const int t = 256 * a + gt; float r[2];
#pragma unroll
        for (int s_ = 0; s_ < 2; ++s_) { const bf16* sp = stg + s_ * SS + 7 + t; r[s_] = w0 * bf2f(sp[0]) + w1 * bf2f(sp[1]) + w2 * bf2f(sp[2]) + cb; }
        o[a] = cmk(r[0], r[1]); if ((a & 3) == 3) __builtin_amdgcn_sched_barrier(0); }
}
__device__ __forceinline__ void conv_phase(const Ctx& F, const bf16* UT, const c32* KF, const float* convw, const float* convb, bf16* ZT) {
    const int g = __builtin_amdgcn_readfirstlane(F.tid >> 8), gt = F.tid & 255;
    c32* ex = (c32*)(F.lds + RING_OFF + g * 36864);
    bf16* stg = (bf16*)ex;
    FftTw W; fft_twiddles(W, gt, (c32*)(F.lds + RING_OFF + 73728), (c32*)(F.lds + RING_OFF + 110592), F.tid);
    RawSeq raw;
    if (F.vcu < DM) raw_issue(raw, UT + (size_t)(2048 + F.vcu) * T, (2 * g) * 2, gt);
    for (int d = F.vcu; d < DM; d += F.G) {
        const c32* kf0 = KF + ((size_t)(d * 2 + 0) * 2) * 4096; const c32* kf1 = KF + ((size_t)(d * 2 + 1) * 2) * 4096;
        for (int pp = 0; pp < 2; ++pp) { const int b0 = (2 * g + pp) * 2;
            int gtv = gt; asm volatile("" : "+v"(gtv));
            c32 z[16], gate[16];
            { const int c = 2048 + d; stage_conv3(z, raw, convw[c], convw[3072 + c], convw[6144 + c], convb[c], stg, gtv); }
            raw_issue(raw, UT + (size_t)d * T, b0, gtv);
            long_conv(z, kf0, W, ex, gtv);
            { const int c = d; stage_conv3(gate, raw, convw[c], convw[3072 + c], convw[6144 + c], convb[c], stg, gtv); }
            raw_issue(raw, UT + (size_t)(1024 + d) * T, b0, gtv);
#pragma unroll
            for (int a = 0; a < 16; ++a) z[a] = cmk(z[a].x * gate[a].x, z[a].y * gate[a].y);
            long_conv(z, kf1, W, ex, gtv);
            { const int c = 1024 + d; stage_conv3(gate, raw, convw[c], convw[3072 + c], convw[6144 + c], convb[c], stg, gtv); }
            { const int dn = pp == 0 ? d : d + F.G; if (dn < DM) raw_issue(raw, UT + (size_t)(2048 + dn) * T, pp == 0 ? b0 + 2 : (2 * g) * 2, gtv); }
            bf16* zr = ZT + (size_t)d * T + (size_t)b0 * SEQ;
#pragma unroll
            for (int a = 0; a < 16; ++a) { const int t = 256 * a + gtv; const unsigned pk = pk2(z[a].x * gate[a].x, z[a].y * gate[a].y); zr[t] = (bf16)(pk & 0xffffu); zr[SEQ + t] = (bf16)(pk >> 16); }
        }
    }
}
__device__ __forceinline__ void transpose_phase(const Ctx& F, const bf16* ZT, bf16* Z) {
    bf16* tile = (bf16*)(F.lds + RING_OFF + F.wave * 8704);
    const int l = F.lane;
    v4u x[8];
    if (F.gw < 16 * 512) { const int d0 = (F.gw & 15) * 64, t0 = (F.gw >> 4) * 64;
#pragma unroll
        for (int i = 0; i < 8; ++i) x[i] = *(const v4u*)(ZT + (size_t)(d0 + i * 8 + (l >> 3)) * T + t0 + (l & 7) * 8); }
    for (int it = F.gw; it < 16 * 512; it += F.NGW) { const int d0 = (it & 15) * 64, t0 = (it >> 4) * 64;
#pragma unroll
        for (int i = 0; i < 8; ++i) { const int dr = i * 8 + (l >> 3), c = l & 7;
            v2u* p = (v2u*)(tile + dr * 68 + c * 8); v2u a; a.x = x[i].x; a.y = x[i].y; p[0] = a; a.x = x[i].z; a.y = x[i].w; p[1] = a; }
        const int itn = it + F.NGW;
        if (itn < 16 * 512) { const int dn = (itn & 15) * 64, tn = (itn >> 4) * 64;
#pragma unroll
            for (int i = 0; i < 8; ++i) x[i] = *(const v4u*)(ZT + (size_t)(dn + i * 8 + (l >> 3)) * T + tn + (l & 7) * 8); }
        LDS_WAIT();
#pragma unroll
        for (int i = 0; i < 8; ++i) { const int tr = i * 8 + (l >> 3), c = l & 7; unsigned short e[8];
#pragma unroll
            for (int k = 0; k < 8; ++k) e[k] = tile[(c * 8 + k) * 68 + tr];
            v4u o; o.x = e[0] | ((unsigned)e[1] << 16); o.y = e[2] | ((unsigned)e[3] << 16); o.z = e[4] | ((unsigned)e[5] << 16); o.w = e[6] | ((unsigned)e[7] << 16);
            *(v4u*)(Z + (size_t)(t0 + tr) * DM + d0 + c * 8) = o; }
        LDS_WAIT();
    }
}

constexpr int NPH = 22;
constexpr int seam_id(int k) { return k == 0 ? 0 : k == 1 ? 1 : k == 2 ? 2 : k == 4 ? 3 : k == 6 ? 4 : k == 7 ? 5 : k == 8 ? 6 : k == 10 ? 7 : k == 11 ? 8 : k == 12 ? 9 : k == 14 ? 10 : k == 15 ? 11 : k == 16 ? 12 : k == 17 ? 13 : k == 18 ? 14 : k == 20 ? 15 : -100; }
#ifdef PROBE_SEAM
__device__ __forceinline__ unsigned long long probe_now() { unsigned long long t; asm volatile("s_memrealtime %0\n\ts_waitcnt lgkmcnt(0)" : "=s"(t) :: "memory"); return t; }
#define SEAMHOOK(id) do { if ((id) == PROBE_SEAM) { const unsigned long long t1_ = probe_now(); while (probe_now() < t1_ + (t1_ - tlast_)) __builtin_amdgcn_s_sleep(4); } \
                          if ((id) + 1 == PROBE_SEAM) tlast_ = probe_now(); } while (0)
#define SEAMBAR(k) do { xcd_barrier(bar); SEAMHOOK(seam_id(k)); } while (0)
#else
#define SEAMHOOK(id) do { } while (0)
#define SEAMBAR(k) xcd_barrier(bar)
#endif
#define MOE_PHASES(L) do { \
        const int mb = 8 + 10 * L; \
        if (IN(mb)) { PH_ARGS; const float* mod = WSP(float, WS_MOD) + (size_t)L * 8 * 6144; gu32* cnt = (gu32*)(ws + WS_CTL) + CW_CNT + L * 24 * 64; \
            route_phase(F, WSP(bf16, WS_XR), in[6] + L * 1024, mod + 4 * 1024, mod + 3 * 1024, in[31] + L * 4096, in[32] + L * 4, in[33] + L * 16384, in[34] + L * 16, WSP(bf16, WS_XN2), WSP(int, WS_LIST), WSP(float, WS_WL), cnt); \
            if (L == 0) { __syncthreads();        \
                pg8::Gemm gmh{WSP(bf16, WS_W4S), WSP(bf16, WS_HDNS), 4096, 4096, 256}; pg8::StaticOrder Sh; Sh.init(4096, 4096, F.G, (int)blockIdx.x); pg8::EpiF32 Eh{WSP(float, WS_HT), 4096}; \
                REP(11) pg8::gemm_phase<pg8::EpiF32, pg8::StaticOrder, true, true>(ring, gmh, Sh, Eh, F.tid); } } \
        if (IN(mb) && IN(mb + 2)) SEAMBAR(mb); \
        if (IN(mb + 2)) { PH_ARGS; gu32* cnt = (gu32*)(ws + WS_CTL) + CW_CNT + L * 24 * 64; moe_table(F, cnt); \
              \
            pg8::Gemm gm{WSP(bf16, WS_XN2), (const bf16*)(ws + WS_WGU + (size_t)L * 16 * 512 * 1024), MS_ROWS, 8192, 512}; pg8::MoeOrder S{tinfo, F.G, F.vcu, 0, WSP(int, WS_LIST)}; pg8::EpiSwiGLU E{WSP(unsigned char, WS_HACT), WSP(float, WS_WL), tinfo}; \
            REP(10) pg8::gemm_phase_gather<pg8::EpiSwiGLU, pg8::MoeOrder, true, true, 5>(ring, gm, S, E, F.tid); } SEAM(mb + 2); \
        if (IN(mb + 3)) { PH_ARGS; gu32* cnt = (gu32*)(ws + WS_CTL) + CW_CNT + L * 24 * 64; moe_table(F, cnt); const float* mod = WSP(float, WS_MOD) + (size_t)L * 8 * 6144; \
            pg8::Gemm gm{WSP(bf16, WS_HACT), (const bf16*)(ws + WS_WDN + (size_t)L * 24 * 1024 * 512), MS_ROWS, 24 * 1024, 256};   pg8::MoeOrder S{tinfo, F.G, F.vcu, 1, WSP(int, WS_LIST)}; if (L == 0) { pg8::EpiMoeOut<bf16> E{WSP(bf16, WS_XR), WSP(bf16, WS_XR), mod + 5 * 1024, WSP(int, WS_LIST), tinfo, (PG8_LAS float*)((PG8_LAS unsigned char*)lds + EPIX_OFF)}; pg8::gemm_phase<pg8::EpiMoeOut<bf16>, pg8::MoeOrder, true, true, 8>(ring, gm, S, E, F.tid); } \
            else { pg8::EpiMoeOut<float> E{WSP(bf16, WS_XR), out, mod + 5 * 1024, WSP(int, WS_LIST), tinfo, (PG8_LAS float*)((PG8_LAS unsigned char*)lds + EPIX_OFF)}; pg8::gemm_phase<pg8::EpiMoeOut<float>, pg8::MoeOrder, true, true, 8>(ring, gm, S, E, F.tid); } \
            if (L == 0) { __syncthreads(); REP(13) filter_phase(F, WSP(float, WS_HT), in[29], WSP(c32, WS_KF)); }       \
            } \
    } while (0)
struct Args { const float* in[38]; float* out; unsigned char* ws; int ph_lo, ph_hi; };
static_assert(sizeof(Args) == 38 * 8 + 8 + 8 + 8, "Args layout (read back through the kernarg segment pointer)");
__global__ void __launch_bounds__(NTHR, 2) fwd_kernel(Args args) {
    extern __shared__ __attribute__((aligned(16))) unsigned char lds[];
#define MK_CTX(F, tx) Ctx F; F.lds = lds; F.tid = (tx); F.lane = F.tid & 63; F.wave = __builtin_amdgcn_readfirstlane(F.tid >> 6); \
    F.G = gridDim.x; { const int bx = blockIdx.x; F.vcu = (F.G % 8 == 0) ? (bx % 8) * (F.G / 8) + bx / 8 : bx; } F.gw = F.vcu * NWAVES + F.wave; F.NGW = F.G * NWAVES
    for (int u = threadIdx.x; u < (LDS_BYTES - LDSCTL_OFF) / 4; u += NTHR) ((LAS unsigned*)((LAS unsigned char*)lds + LDSCTL_OFF))[u] = 0u;
    __syncthreads();
    const int wave_s_ = __builtin_amdgcn_readfirstlane(threadIdx.x >> 6);
    const int lo = args.ph_lo, hi = args.ph_hi;
    const bool use_bar = (hi - lo) > 1;
    XcdBarrier bar; bar.bar = (unsigned*)(args.ws + WS_CTL) + CW_BAR; bar.x = 0; bar.st = nullptr; bar.w0 = 0;
    if (use_bar) bar = xcd_barrier_post((unsigned*)(args.ws + WS_CTL) + CW_BAR, (volatile LAS unsigned*)((LAS unsigned char*)lds + MISC_OFF) + 8);
    bar.w0 = (wave_s_ == 0) ? 1 : 0;
#ifndef PHMASK
#define PHMASK 0xFFFFFFFFu
#endif
#define IN(k) (((PHMASK >> ((k) >= 18 ? (k) - 10 : (k))) & 1u) && lo <= (k) && (k) < hi)
#ifndef REPMASK
#define REPMASK 0u
#endif
#define NREP(k) (((REPMASK >> (k)) & 1u) ? 2 : 1)
#define REP(k) for (int rep_ = 0; rep_ < NREP(k); ++rep_)
#define SEAM(k) do { if (IN(k) && IN((k) + 1)) SEAMBAR(k); } while (0)
#define PH_STR2(x) #x
#define PH_STR(x) PH_STR2(x)
#define PH_ARGS int opq_ = 0; asm volatile("; PHMARK line " PH_STR(__LINE__) : "+s"(opq_)); const In in{opq_}; unsigned char* const ws = karg_ws(opq_); float* const out = karg_out(opq_); (void)in; (void)ws; (void)out; int tx_; asm volatile("v_mbcnt_lo_u32_b32 %0, -1, 0\n\tv_mbcnt_hi_u32_b32 %0, -1, %0" : "=v"(tx_)); tx_ += wave_s_ * 64; MK_CTX(F, tx_)
#define WSP(type, off) ((type*)(ws + (off)))
    PG8_LAS unsigned char* ring = (PG8_LAS unsigned char*)lds + RING_OFF;
    const PG8_LAS int* tinfo = (const PG8_LAS int*)((PG8_LAS unsigned char*)lds + TINFO_OFF);

#ifdef PROBE_SEAM
    unsigned long long tlast_ = probe_now();
#endif
    if (IN(0)) { PH_ARGS; REP(0) p0_prologue(F, in, ws); } SEAM(0);

            if (IN(1)) { PH_ARGS; const float* mod = WSP(float, WS_MOD); REP(1) norm_mod_phase<float, true>(F, in[0], in[5], mod + 1024, mod, WSP(bf16, WS_XN)); } SEAM(1);
            if (IN(2)) { PH_ARGS; pg8::Gemm gm{WSP(bf16, WS_XN), WSP(bf16, WS_WD), T, 512, 512};   pg8::StaticOrder S; S.init(T, 512, F.G, (int)blockIdx.x);
                pg8::EpiLat E{WSP(unsigned char, WS_CQN), WSP(bf16, WS_CKVN), WSP(unsigned char, WS_KPE), in[8], in[9], in[13], WSP(float, WS_ROPE), (PG8_LAS float*)((PG8_LAS unsigned char*)lds + EPIX_OFF)};
                REP(2) pg8::gemm_phase<pg8::EpiLat, pg8::StaticOrder, true, true, 5>(ring, gm, S, E, F.tid); }
            if (IN(2) && IN(4)) SEAMBAR(2);
            if (IN(4)) { REP(4) {
                { PH_ARGS; pg8::Gemm gm{WSP(bf16, WS_CQN), WSP(bf16, WS_WUQ), T, 1536, 128};   pg8::StaticOrder S; S.init(T, 1536, F.G, (int)blockIdx.x); pg8::EpiBf16R E{WSP(bf16, WS_QRAW), 1536, nullptr};
                  pg8::gemm_phase<pg8::EpiBf16R, pg8::StaticOrder, true, true, 4>(ring, gm, S, E, F.tid); }
                { PH_ARGS; pg8::Gemm gm{WSP(bf16, WS_CKVN), WSP(bf16, WS_WUKV), T, 1024, 128};   pg8::StaticOrder S; S.init(T, 1024, F.G, (int)blockIdx.x);
                  pg8::EpiK8 E{WSP(unsigned char, WS_K8), in[13], (PG8_LAS float*)((PG8_LAS unsigned char*)lds + EPIX_OFF)};
                  pg8::gemm_phase<pg8::EpiK8, pg8::StaticOrder, true, true>(ring, gm, S, E, F.tid); }
                { PH_ARGS; pg8::Gemm gm{WSP(bf16, WS_WUKV) + 1024 * 128, WSP(bf16, WS_CKVN), 1024, T, 128}; pg8::StaticOrder S; S.init(1024, T, F.G, (int)blockIdx.x);
                  pg8::EpiF8T E{WSP(unsigned char, WS_VT8), T};
                  pg8::gemm_phase<pg8::EpiF8T, pg8::StaticOrder, true, true>(ring, gm, S, E, F.tid); } }
            } if (IN(4) && IN(6)) SEAMBAR(4);
            if (IN(6)) { PH_ARGS;
                const float* qg = in[12]; const float* kg = in[13];
                float gqn = 0.f, gkn = 0.f, gqp = 0.f, gkp = 0.f;
                for (int i = 0; i < 128; ++i) { gqn = fmaxf(gqn, fabsf(qg[i])); gkn = fmaxf(gkn, fabsf(kg[i])); }
                for (int i = 128; i < 192; ++i) { gqp = fmaxf(gqp, fabsf(qg[i])); gkp = fmaxf(gkp, fabsf(kg[i])); }
                const float smaxC = (128.f * gqn * gkn + 64.f * gqp * gkp) * (0.072168783648703220f * 1.4426950408889634f);
                unsigned redo_mask = 0u;
                if (smaxC < 60.f) for (int rep_ = 0; rep_ < NREP(6); ++rep_) { int i = 0;
                    for (int u = F.vcu; u < 1024; u += F.G, ++i) { const int b = u >> 7, h = (u >> 4) & 7, qb = u & 15;
                        if (att::attn_unit<false>(b, h, qb * 256, WSP(bf16, WS_QRAW), WSP(unsigned char, WS_VT8), WSP(unsigned char, WS_K8), WSP(unsigned char, WS_KPE), WSP(bf16, WS_O), WSP(float, WS_ROPE), qg, smaxC, (char*)lds + RING_OFF, F.tid)) redo_mask |= 1u << (i & 31); } }
                else redo_mask = 0xffffffffu;
                redo_mask = (unsigned)__builtin_amdgcn_readfirstlane((int)redo_mask);
                if (redo_mask) { int i = 0;
                    for (int u = F.vcu; u < 1024; u += F.G, ++i) { const int b = u >> 7, h = (u >> 4) & 7, qb = u & 15;
                        if ((redo_mask >> (i & 31)) & 1u) (void)att::attn_unit<true>(b, h, qb * 256, WSP(bf16, WS_QRAW), WSP(unsigned char, WS_VT8), WSP(unsigned char, WS_K8), WSP(unsigned char, WS_KPE), WSP(bf16, WS_O), WSP(float, WS_ROPE), qg, smaxC, (char*)lds + RING_OFF, F.tid); } }
            } SEAM(6);
            if (IN(7)) { PH_ARGS; pg8::Gemm gm{WSP(bf16, WS_O), WSP(bf16, WS_WO), T, 1024, 512};   pg8::StaticOrder S; S.init(T, 1024, F.G, (int)blockIdx.x); pg8::EpiResGate<float, bf16> E{in[0], WSP(bf16, WS_XR), WSP(float, WS_MOD) + 2048, 1024};
                REP(7) pg8::gemm_phase<pg8::EpiResGate<float, bf16>, pg8::StaticOrder, true, true, 10>(ring, gm, S, E, F.tid); } SEAM(7);
    MOE_PHASES(0); SEAM(11);
            if (IN(12)) { PH_ARGS; const float* mod = WSP(float, WS_MOD) + 8 * 6144; REP(12) norm_mod_phase(F, WSP(bf16, WS_XR), in[5] + 1024, mod + 1024, mod, (bf16*)out); }
            if (IN(12) && IN(14)) SEAMBAR(12);
            if (IN(14)) { PH_ARGS; pg8::Gemm gm{WSP(bf16, WS_WIN), (const bf16*)out, 3072, T, 1024}; pg8::StaticOrder S; S.init(3072, T, F.G, (int)blockIdx.x); pg8::EpiBf16R E{WSP(bf16, WS_UT), T, in[16]};
                REP(14) pg8::gemm_phase<pg8::EpiBf16R, pg8::StaticOrder, true, true>(ring, gm, S, E, F.tid); } SEAM(14);
            if (IN(15)) { PH_ARGS; for (int rep = 0; rep < NREP(15); ++rep) conv_phase(F, WSP(bf16, WS_UT), WSP(c32, WS_KF), in[17], in[18], (bf16*)out); } SEAM(15);
            if (IN(16)) { PH_ARGS; REP(16) transpose_phase(F, (const bf16*)out, WSP(bf16, WS_Z)); } SEAM(16);
            if (IN(17)) { PH_ARGS; pg8::Gemm gm{WSP(bf16, WS_Z), WSP(bf16, WS_WOUT), T, 1024, 1024}; pg8::StaticOrder S; S.init(T, 1024, F.G, (int)blockIdx.x); pg8::EpiResGate<bf16, bf16> E{WSP(bf16, WS_XR), WSP(bf16, WS_XR), WSP(float, WS_MOD) + 8 * 6144 + 2048, 1024};
                pg8::gemm_phase<pg8::EpiResGate<bf16, bf16>, pg8::StaticOrder, true, true>(ring, gm, S, E, F.tid); } SEAM(17);
    MOE_PHASES(1);
#ifdef PROBE_SEAM
    SEAMHOOK(16);
#endif
#undef IN
#undef SEAM
}

#ifndef ONE_LAUNCH
#define ONE_LAUNCH 1
#endif
extern "C" void kernel_launch(void* const* d_in, const int* in_sizes, int n_in, void* d_out, int out_size, void* d_ws, size_t ws_size, hipStream_t stream) {
    static int grid = 0;
    if (grid == 0) {
        if (n_in != 38 || in_sizes[0] != T * DM || out_size != T * DM || ws_size < WS_END) { fprintf(stderr, "kernel_launch: shape mismatch n_in %d in0 %d out %d ws %zu\n", n_in, n_in > 0 ? in_sizes[0] : -1, out_size, ws_size); grid = -1; return; }
        int dev = 0, cus = 0, per_cu = 0;
        if (hipGetDevice(&dev) != hipSuccess || hipDeviceGetAttribute(&cus, hipDeviceAttributeMultiprocessorCount, dev) != hipSuccess) { grid = -1; return; }
        if (hipFuncSetAttribute((const void*)fwd_kernel, hipFuncAttributeMaxDynamicSharedMemorySize, LDS_BYTES) != hipSuccess) { fprintf(stderr, "kernel_launch: hipFuncSetAttribute failed\n"); grid = -1; return; }
        if (hipOccupancyMaxActiveBlocksPerMultiprocessor(&per_cu, (const void*)fwd_kernel, NTHR, LDS_BYTES) != hipSuccess || per_cu < 1) { fprintf(stderr, "kernel_launch: occupancy query says %d\n", per_cu); }
        (void)hipGetLastError();
        grid = cus;
    }
    if (grid < 0) return;
    if (hipMemsetAsync((char*)d_ws + WS_CTL, 0, CTL_ZERO_BYTES, stream) != hipSuccess) return;
    Args a{};
    for (int i = 0; i < 38; ++i) a.in[i] = (const float*)d_in[i];
    a.out = (float*)d_out; a.ws = (unsigned char*)d_ws;
#if ONE_LAUNCH
    a.ph_lo = 0; a.ph_hi = NPH;
    hipLaunchKernelGGL(fwd_kernel, dim3(grid), dim3(NTHR), LDS_BYTES, stream, a);
#else
    for (int p = 0; p < NPH; ++p) { a.ph_lo = p; a.ph_hi = p + 1; hipLaunchKernelGGL(fwd_kernel, dim3(grid), dim3(NTHR), LDS_BYTES, stream, a); }
#endif
    const hipError_t le = hipPeekAtLastError();
    if (le != hipSuccess) fprintf(stderr, "kernel_launch: launch failed: %s\n", hipGetErrorName(le));
}
```

```cpp
#include <hip/hip_runtime.h>
#include <cstdio>
#include <cstdint>
namespace pg8 {
#define PG8_LAS __attribute__((address_space(3)))
typedef unsigned short bf16_t;
typedef short bf16x8 __attribute__((ext_vector_type(8)));
typedef float f32x4 __attribute__((ext_vector_type(4)));
typedef unsigned u32x4 __attribute__((ext_vector_type(4)));
typedef int v4i_t __attribute__((ext_vector_type(4)));
typedef int v8i_t __attribute__((ext_vector_type(8)));
constexpr int BM = 256, BK = 64, HALF = 128, HTB = HALF * BK * 2  , STAGE_BYTES = 8 * HTB, NXCD = 8, WGM = 8;

__host__ __device__ __forceinline__ int lds_byte(int r, int c) { const int st = (r >> 4) * 2 + (c >> 5), rr = r & 15, cc = c & 31, ob = rr * 64 + cc * 2; return st * 1024 + (ob ^ (((ob >> 9) & 1) << 5)); }
__host__ __device__ __forceinline__ void stage_rc(int b, int& R, int& C) { const int st = b / 1024, sb = b % 1024, swz = sb ^ (((sb >> 9) & 1) << 5); R = (st >> 1) * 16 + swz / 64; C = (st & 1) * 32 + (swz % 64) / 2; }
__host__ __device__ __forceinline__ int perm32(int rho) { const int n = rho >> 4, i = rho & 15; return 8 * (i >> 2) + 4 * n + (i & 3); }

struct Unit { int pm, pn; };
struct Gemm { const bf16_t* A; const bf16_t* Bt; int M, N, K; };

struct StaticOrder {
    int nM, nN, nwg, G, c;
    __host__ __device__ void init(int M, int N, int G_, int c_) { nM = M / BM; nN = N / BM; nwg = nM * nN; G = G_; c = c_; }
    __host__ __device__ bool next(int i, Unit& u) const {
        const long L = (long)i * G + c; if (L >= nwg) return false;
        int wgid = (int)L; { const int q = nwg / NXCD, r = nwg % NXCD, xcd = wgid % NXCD, off = wgid / NXCD; wgid = (xcd < r ? xcd * (q + 1) : r * (q + 1) + (xcd - r) * q) + off; }
        const int nig = WGM * nN, gid = wgid / nig, fm = gid * WGM, gsz = (nM - fm) < WGM ? (nM - fm) : WGM;
        u.pm = fm + ((wgid % nig) % gsz); u.pn = (wgid % nig) / gsz; return true;
    }
    __device__ __forceinline__ void a_ready(const Unit&) const {}
    __device__ __forceinline__ void done(const Unit&) const {}
};

__device__ __forceinline__ unsigned cvt_pk_bf16(float lo, float hi) { unsigned r; asm volatile("v_cvt_pk_bf16_f32 %0, %1, %2" : "=v"(r) : "v"(lo), "v"(hi)); return r; }
typedef float f32x2 __attribute__((ext_vector_type(2)));
typedef unsigned u32x2 __attribute__((ext_vector_type(2)));
struct EpiF32 {
    static constexpr bool PERM = false, AFTER_DRAIN = false;
    float* C; int ldc;
    __device__ __forceinline__ void operator()(const f32x4 (&acc)[2][2][4][2], const Unit& u, int wr, int wc, int fr, int fq) const {
        const int row0 = u.pm * BM + wr * 64 + fr, col0 = u.pn * BM + wc * 32 + 4 * fq;
#pragma unroll
        for (int ai = 0; ai < 2; ++ai)
#pragma unroll
            for (int m = 0; m < 4; ++m) { float* rowp = C + (size_t)(row0 + ai * HALF + m * 16) * ldc + col0;
#pragma unroll
                for (int bj = 0; bj < 2; ++bj)
#pragma unroll
                    for (int n = 0; n < 2; ++n) *(f32x4*)(rowp + bj * HALF + n * 16) = acc[ai][bj][m][n]; }
    }
};
struct EpiBf16R {
    static constexpr bool PERM = true, AFTER_DRAIN = false;
    bf16_t* O; int ldc; const float* rowbias;
    __device__ __forceinline__ void operator()(const f32x4 (&acc)[2][2][4][2], const Unit& u, int wr, int wc, int fr, int fq) const {
        const int row0 = u.pm * BM + wr * 64 + fr, col0 = u.pn * BM + wc * 32 + 8 * fq;
#pragma unroll
        for (int ai = 0; ai < 2; ++ai)
#pragma unroll
            for (int m = 0; m < 4; ++m) { const int row = row0 + ai * HALF + m * 16; bf16_t* rowp = O + (size_t)row * ldc + col0; const float rb = rowbias ? rowbias[row] : 0.f;
#pragma unroll
                for (int bj = 0; bj < 2; ++bj) { const f32x4 v0 = acc[ai][bj][m][0] + rb, v1 = acc[ai][bj][m][1] + rb;
                    u32x4 w; w.x = cvt_pk_bf16(v0[0], v0[1]); w.y = cvt_pk_bf16(v0[2], v0[3]); w.z = cvt_pk_bf16(v1[0], v1[1]); w.w = cvt_pk_bf16(v1[2], v1[3]);
                    *(u32x4*)(rowp + bj * HALF) = w; } }
    }
};
__device__ __forceinline__ f32x4 ld4(const float* p) { return *(const f32x4*)p; }
__device__ __forceinline__ f32x4 ld4(const bf16_t* p) { const u32x2 w = *(const u32x2*)p; f32x4 r; r[0] = __uint_as_float(w.x << 16); r[1] = __uint_as_float(w.x & 0xffff0000u); r[2] = __uint_as_float(w.y << 16); r[3] = __uint_as_float(w.y & 0xffff0000u); return r; }
__device__ __forceinline__ void st4(float* p, f32x4 v) { *(f32x4*)p = v; }
__device__ __forceinline__ void st4(bf16_t* p, f32x4 v) { u32x2 w; w.x = cvt_pk_bf16(v[0], v[1]); w.y = cvt_pk_bf16(v[2], v[3]); *(u32x2*)p = w; }
__device__ __forceinline__ f32x4 ldraw(const float* p) { return *(const f32x4*)p; }
__device__ __forceinline__ u32x2 ldraw(const bf16_t* p) { return *(const u32x2*)p; }
__device__ __forceinline__ f32x4 cvraw(f32x4 v) { return v; }
__device__ __forceinline__ f32x4 cvraw(u32x2 w) { f32x4 r; r[0] = __uint_as_float(w.x << 16); r[1] = __uint_as_float(w.x & 0xffff0000u); r[2] = __uint_as_float(w.y << 16); r[3] = __uint_as_float(w.y & 0xffff0000u); return r; }
template <class TB, class TO> struct EpiResGate {
    static constexpr bool PERM = false, AFTER_DRAIN = false;
    const TB* base; TO* out; const float* gate; int ldc;
    __device__ __forceinline__ void operator()(const f32x4 (&acc)[2][2][4][2], const Unit& u, int wr, int wc, int fr, int fq) const {
        const int row0 = u.pm * BM + wr * 64 + fr, col0 = u.pn * BM + wc * 32 + 4 * fq;
        const float* gp = gate + (size_t)(u.pm >> 4) * 6144 + col0;
        f32x4 gv[2][2];
#pragma unroll
        for (int bj = 0; bj < 2; ++bj)
#pragma unroll
            for (int n = 0; n < 2; ++n) gv[bj][n] = *(const f32x4*)(gp + bj * HALF + n * 16);
        constexpr int GB = sizeof(TB) == 2 ? 8 : 4;
        typedef decltype(ldraw(base)) raw_t;
#pragma unroll
        for (int g0 = 0; g0 < 8; g0 += GB) {
            raw_t bs[GB][2][2];
#pragma unroll
            for (int g = 0; g < GB; ++g) { const unsigned off = (unsigned)((row0 + ((g0 + g) >> 2) * HALF + ((g0 + g) & 3) * 16) * ldc + col0);
#pragma unroll
                for (int bj = 0; bj < 2; ++bj)
#pragma unroll
                    for (int n = 0; n < 2; ++n) bs[g][bj][n] = ldraw(base + off + bj * HALF + n * 16); }
#pragma unroll
            for (int g = 0; g < GB; ++g) { const int ai = (g0 + g) >> 2, m = (g0 + g) & 3; const unsigned off = (unsigned)((row0 + ai * HALF + m * 16) * ldc + col0);
#pragma unroll
                for (int bj = 0; bj < 2; ++bj)
#pragma unroll
                    for (int n = 0; n < 2; ++n) st4(out + off + bj * HALF + n * 16, cvraw(bs[g][bj][n]) + gv[bj][n] * acc[ai][bj][m][n]); }
            asm volatile("" ::: "memory"); }
    }
};
struct EpiLat {
    static constexpr bool PERM = false, AFTER_DRAIN = false;
    unsigned char* CQN  ; bf16_t* CKVN; unsigned char* KPE  ; const float* qag; const float* kvag; const float* kng; const float* rope; PG8_LAS float* P;
    __device__ __forceinline__ void operator()(const f32x4 (&acc)[2][2][4][2], const Unit& u, int wr, int wc, int, int) const {
        int ln = (int)__builtin_amdgcn_mbcnt_hi(~0u, __builtin_amdgcn_mbcnt_lo(~0u, 0u)); asm volatile("" : "+v"(ln)); const int fr = ln & 15, fq = ln >> 4;
        const int row0 = u.pm * BM + wr * 64 + fr;
#pragma unroll
        for (int ai = 0; ai < 2; ++ai)
#pragma unroll
            for (int m = 0; m < 4; ++m) { float s0 = 0.f, s1 = 0.f;
#pragma unroll
                for (int n = 0; n < 2; ++n) { const f32x4 a = acc[ai][0][m][n], b = acc[ai][1][m][n];
                    s0 += (a[0] * a[0] + a[1] * a[1]) + (a[2] * a[2] + a[3] * a[3]); s1 += (b[0] * b[0] + b[1] * b[1]) + (b[2] * b[2] + b[3] * b[3]); }
                s0 += __shfl_xor(s0, 16); s0 += __shfl_xor(s0, 32); s1 += __shfl_xor(s1, 16); s1 += __shfl_xor(s1, 32);
                if (fq == 0) { const int rl = ai * HALF + wr * 64 + m * 16 + fr; P[rl * 8 + wc] = s0; P[rl * 8 + 4 + wc] = s1; } }
        asm volatile("s_waitcnt lgkmcnt(0)" ::: "memory"); __builtin_amdgcn_s_barrier(); asm volatile("" ::: "memory");
        const int cl = wc * 32 + 4 * fq;
        if (u.pn == 0) {
            f32x4 g[2][2];
#pragma unroll
            for (int bj = 0; bj < 2; ++bj)
#pragma unroll
                for (int n = 0; n < 2; ++n) g[bj][n] = *(const f32x4*)(qag + bj * HALF + cl + 16 * n);
#pragma unroll
            for (int ai = 0; ai < 2; ++ai)
#pragma unroll
                for (int m = 0; m < 4; ++m) { const int rl = ai * HALF + wr * 64 + m * 16 + fr; const f32x4 pa = *(const PG8_LAS f32x4*)(P + rl * 8), pb = *(const PG8_LAS f32x4*)(P + rl * 8 + 4);
                    const float r = __builtin_amdgcn_rsqf((((pa[0] + pa[1]) + (pa[2] + pa[3])) + ((pb[0] + pb[1]) + (pb[2] + pb[3]))) * (1.f / 256.f) + 1e-6f);
                    unsigned char* rowp = CQN + (size_t)(row0 + ai * HALF + m * 16) * 256 + cl;
#pragma unroll
                    for (int bj = 0; bj < 2; ++bj)
#pragma unroll
                        for (int n = 0; n < 2; ++n) { const f32x4 v = acc[ai][bj][m][n] * r * g[bj][n]; int p = 0; p = __builtin_amdgcn_cvt_pk_fp8_f32(v[0], v[1], p, false); p = __builtin_amdgcn_cvt_pk_fp8_f32(v[2], v[3], p, true); *(int*)(rowp + bj * HALF + 16 * n) = p; } }
        } else {
            f32x4 gk[2], gp[2]; const int e0 = 16 * (wc & 1) + 4 * fq;
#pragma unroll
            for (int n = 0; n < 2; ++n) { gk[n] = *(const f32x4*)(kvag + cl + 16 * n); gp[n] = *(const f32x4*)(kng + 128 + e0 + 32 * n); }
#pragma unroll
            for (int ai = 0; ai < 2; ++ai)
#pragma unroll
                for (int m = 0; m < 4; ++m) { const int rl = ai * HALF + wr * 64 + m * 16 + fr; const f32x4 pa = *(const PG8_LAS f32x4*)(P + rl * 8), pb = *(const PG8_LAS f32x4*)(P + rl * 8 + 4);
                    const float rkv = __builtin_amdgcn_rsqf(((pa[0] + pa[1]) + (pa[2] + pa[3])) * (1.f / 128.f) + 1e-6f), rpe = __builtin_amdgcn_rsqf((pb[0] + pb[1]) * (1.f / 64.f) + 1e-6f);
                    const size_t row = (size_t)(row0 + ai * HALF + m * 16);
#pragma unroll
                    for (int n = 0; n < 2; ++n) { const f32x4 v = acc[ai][0][m][n] * rkv * gk[n]; u32x2 w; w.x = cvt_pk_bf16(v[0], v[1]); w.y = cvt_pk_bf16(v[2], v[3]); *(u32x2*)(CKVN + row * 128 + cl + 16 * n) = w; }
                    if (wc < 2) { const f32x4 x1 = acc[ai][1][m][0] * rpe * gp[0], x2 = acc[ai][1][m][1] * rpe * gp[1];
                        const f32x4 c0 = *(const f32x4*)(rope + row * 64 + e0 * 2), c1 = *(const f32x4*)(rope + row * 64 + e0 * 2 + 4);
                        const float cs[4] = {c0[0], c0[2], c1[0], c1[2]}, sn[4] = {c0[1], c0[3], c1[1], c1[3]};
                        float o1[4], o2[4];
#pragma unroll
                        for (int j = 0; j < 4; ++j) { o1[j] = x1[j] * cs[j] - x2[j] * sn[j]; o2[j] = x1[j] * sn[j] + x2[j] * cs[j]; }
                        int w1 = 0, w2 = 0; w1 = __builtin_amdgcn_cvt_pk_fp8_f32(o1[0], o1[1], w1, false); w1 = __builtin_amdgcn_cvt_pk_fp8_f32(o1[2], o1[3], w1, true); w2 = __builtin_amdgcn_cvt_pk_fp8_f32(o2[0], o2[1], w2, false); w2 = __builtin_amdgcn_cvt_pk_fp8_f32(o2[2], o2[3], w2, true);
                        *(int*)(KPE + row * 64 + e0) = w1; *(int*)(KPE + row * 64 + 32 + e0) = w2; }
                    asm volatile("" ::: "memory"); }
        }
        asm volatile("s_waitcnt lgkmcnt(0)" ::: "memory"); __builtin_amdgcn_s_barrier(); asm volatile("" ::: "memory");
    }
};
struct EpiK8 {
    static constexpr bool PERM = true, AFTER_DRAIN = false;
    unsigned char* K8; const float* kng; PG8_LAS float* P;
    __device__ __forceinline__ void operator()(const f32x4 (&acc)[2][2][4][2], const Unit& u, int wr, int wc, int, int) const {
        int ln = (int)__builtin_amdgcn_mbcnt_hi(~0u, __builtin_amdgcn_mbcnt_lo(~0u, 0u)); asm volatile("" : "+v"(ln)); const int fr = ln & 15, fq = ln >> 4;
#pragma unroll
        for (int ai = 0; ai < 2; ++ai)
#pragma unroll
            for (int m = 0; m < 4; ++m) {
#pragma unroll
                for (int bj = 0; bj < 2; ++bj) { const f32x4 a = acc[ai][bj][m][0], b = acc[ai][bj][m][1];
                    float s = (a[0] * a[0] + a[1] * a[1]) + (a[2] * a[2] + a[3] * a[3]) + (b[0] * b[0] + b[1] * b[1]) + (b[2] * b[2] + b[3] * b[3]);
                    s += __shfl_xor(s, 16); s += __shfl_xor(s, 32);
                    if (fq == 0) P[(ai * HALF + wr * 64 + m * 16 + fr) * 8 + bj * 4 + wc] = s; } }
        asm volatile("s_waitcnt lgkmcnt(0)" ::: "memory"); __builtin_amdgcn_s_barrier(); asm volatile("" ::: "memory");
        const f32x4 g0 = *(const f32x4*)(kng + wc * 32 + 8 * fq), g1 = *(const f32x4*)(kng + wc * 32 + 8 * fq + 4);
        const int row0 = u.pm * BM + wr * 64 + fr;
#pragma unroll
        for (int ai = 0; ai < 2; ++ai)
#pragma unroll
            for (int m = 0; m < 4; ++m) { const int rl = ai * HALF + wr * 64 + m * 16 + fr;
#pragma unroll
                for (int bj = 0; bj < 2; ++bj) { const f32x4 p4 = *(const PG8_LAS f32x4*)(P + rl * 8 + bj * 4);
                    const float r = __builtin_amdgcn_rsqf(((p4[0] + p4[1]) + (p4[2] + p4[3])) * (1.f / 128.f) + 1e-6f);
                    const f32x4 v0 = acc[ai][bj][m][0] * r * g0, v1 = acc[ai][bj][m][1] * r * g1;
                    int w0 = 0, w1 = 0; w0 = __builtin_amdgcn_cvt_pk_fp8_f32(v0[0], v0[1], w0, false); w0 = __builtin_amdgcn_cvt_pk_fp8_f32(v0[2], v0[3], w0, true); w1 = __builtin_amdgcn_cvt_pk_fp8_f32(v1[0], v1[1], w1, false); w1 = __builtin_amdgcn_cvt_pk_fp8_f32(v1[2], v1[3], w1, true);
                    u32x2 w; w.x = (unsigned)w0; w.y = (unsigned)w1; *(u32x2*)(K8 + ((size_t)(row0 + ai * HALF + m * 16) * 8 + 2 * u.pn + bj) * 128 + wc * 32 + 8 * fq) = w; } }
        asm volatile("s_waitcnt lgkmcnt(0)" ::: "memory"); __builtin_amdgcn_s_barrier(); asm volatile("" ::: "memory");
    }
};
struct EpiF8T {
    static constexpr bool PERM = true, AFTER_DRAIN = false;
    unsigned char* O; int ldc;
    __device__ __forceinline__ void operator()(const f32x4 (&acc)[2][2][4][2], const Unit& u, int wr, int wc, int fr, int fq) const {
        const int row0 = u.pm * BM + wr * 64 + fr, col0 = u.pn * BM + wc * 32 + 8 * fq;
#pragma unroll
        for (int ai = 0; ai < 2; ++ai)
#pragma unroll
            for (int m = 0; m < 4; ++m) { unsigned char* rowp = O + (size_t)(row0 + ai * HALF + m * 16) * ldc + col0;
#pragma unroll
                for (int bj = 0; bj < 2; ++bj) { const f32x4 v0 = acc[ai][bj][m][0], v1 = acc[ai][bj][m][1];
                    int w0 = 0, w1 = 0; w0 = __builtin_amdgcn_cvt_pk_fp8_f32(v0[0], v0[1], w0, false); w0 = __builtin_amdgcn_cvt_pk_fp8_f32(v0[2], v0[3], w0, true); w1 = __builtin_amdgcn_cvt_pk_fp8_f32(v1[0], v1[1], w1, false); w1 = __builtin_amdgcn_cvt_pk_fp8_f32(v1[2], v1[3], w1, true);
                    u32x2 w; w.x = (unsigned)w0; w.y = (unsigned)w1; *(u32x2*)(rowp + bj * HALF) = w; } }
    }
};
__device__ __forceinline__ void pair_of(int pi, int& i, int& j) { i = pi < 3 ? 0 : (pi < 5 ? 1 : 2); j = pi < 3 ? pi + 1 : (pi < 5 ? pi - 1 : 3); }
struct MoeOrder {
    const PG8_LAS int* tinfo; int G, c, mode; const int* list;
    __device__ __forceinline__ int tok(const Unit& u, int r) const { const int bk = tinfo[1 + u.pm], pos = u.pm * BM - tinfo[256 + bk] + r; return list[bk * 32768 + (pos < tinfo[288 + bk] ? pos : 0)]; }
    __device__ __forceinline__ bool next(int i, Unit& u) const {
        const long L = (long)i * G + c; const int nt = tinfo[0]; if (L >= 4L * nt) return false;
        const int mt = (int)(L >> 2), q = (int)(L & 3), bk = tinfo[1 + mt];
        u.pm = mt;
        if (mode == 0) { int ii, jj; pair_of(bk % 6, ii, jj); const int e = (bk / 6) * 4 + ((q >> 1) ? jj : ii); u.pn = e * 2 + (q & 1); }
        else u.pn = bk * 4 + q;
        return true;
    }
    __device__ __forceinline__ void a_ready(const Unit&) const {}
    __device__ __forceinline__ void done(const Unit&) const {}
};
struct EpiSwiGLU {
    static constexpr bool PERM = true, AFTER_DRAIN = false;
    unsigned char* H; const float* wl; const PG8_LAS int* tinfo;
    __device__ __forceinline__ void operator()(const f32x4 (&acc)[2][2][4][2], const Unit& u, int wr, int wc, int, int) const {
        int ln = (int)__builtin_amdgcn_mbcnt_hi(~0u, __builtin_amdgcn_mbcnt_lo(~0u, 0u)); asm volatile("" : "+v"(ln)); const int fr = ln & 15, fq = ln >> 4;
        const int bk = tinfo[1 + u.pm]; int ii, jj; pair_of(bk % 6, ii, jj);
        const int e = u.pn >> 1, hh = u.pn & 1, slot = (e == (bk / 6) * 4 + jj) ? 1 : 0;
        const int row0 = u.pm * BM + wr * 64 + fr, col0 = slot * 256 + hh * 128 + wc * 32 + 8 * fq;
        float w8[8];
#pragma unroll
        for (int g = 0; g < 8; ++g) { const int pos = row0 + (g >> 2) * HALF + (g & 3) * 16 - tinfo[256 + bk]; w8[g] = pos < tinfo[288 + bk] ? 8.f * wl[((size_t)bk * 32768 + pos) * 2 + slot] : 0.f; }
#pragma unroll
        for (int ai = 0; ai < 2; ++ai)
#pragma unroll
            for (int m = 0; m < 4; ++m) { const int row = row0 + ai * HALF + m * 16; const float w = w8[ai * 4 + m];
                float a[8];
#pragma unroll
                for (int n = 0; n < 2; ++n)
#pragma unroll
                    for (int j = 0; j < 4; ++j) { const float g = acc[ai][0][m][n][j], up = acc[ai][1][m][n][j];
                        const float sg = g * __builtin_amdgcn_rcpf(1.0f + __builtin_amdgcn_exp2f(-1.4426950408889634f * g)); a[n * 4 + j] = sg * up * w; }
                int o0 = 0, o1 = 0; o0 = __builtin_amdgcn_cvt_pk_fp8_f32(a[0], a[1], o0, false); o0 = __builtin_amdgcn_cvt_pk_fp8_f32(a[2], a[3], o0, true);
                o1 = __builtin_amdgcn_cvt_pk_fp8_f32(a[4], a[5], o1, false); o1 = __builtin_amdgcn_cvt_pk_fp8_f32(a[6], a[7], o1, true);
                u32x2 o; o.x = (unsigned)o0; o.y = (unsigned)o1; *(u32x2*)(H + (size_t)row * 512 + col0) = o; }
    }
};
template <class TO> struct EpiMoeOut {
    static constexpr bool PERM = false, AFTER_DRAIN = false;
    const bf16_t* xr; TO* out; const float* gate; const int* list; const PG8_LAS int* tinfo; PG8_LAS float* gl;
    __device__ __forceinline__ void operator()(const f32x4 (&acc)[2][2][4][2], const Unit& u, int wr, int wc, int, int) const {
        int ln = (int)__builtin_amdgcn_mbcnt_hi(~0u, __builtin_amdgcn_mbcnt_lo(~0u, 0u)); asm volatile("" : "+v"(ln)); const int fr = ln & 15, fq = ln >> 4;
        const int bk = tinfo[1 + u.pm], r_beg = tinfo[256 + bk], r_end = r_beg + tinfo[288 + bk];
        const int row0 = u.pm * BM + wr * 64 + fr, colu = (u.pn & 3) * BM, cl = wc * 32 + 4 * fq;
        int tk[8];
#pragma unroll
        for (int g = 0; g < 8; ++g) { const int row = row0 + (g >> 2) * HALF + (g & 3) * 16; tk[g] = row < r_end ? list[bk * 32768 + row - r_beg] : -1; }
        { const int t = (wr * 4 + wc) * 64 + fq * 16 + fr; const f32x4 gs = *(const f32x4*)(gate + (size_t)(t >> 6) * 6144 + colu + (t & 63) * 4);
          *(PG8_LAS f32x4*)(gl + (t >> 6) * 256 + (t & 63) * 4) = gs; }
        asm volatile("s_waitcnt lgkmcnt(0)" ::: "memory"); __builtin_amdgcn_s_barrier();
#pragma unroll
        for (int g0 = 0; g0 < 8; g0 += 4) {
            u32x2 bs[4][2][2];
#pragma unroll
            for (int g = 0; g < 4; ++g) { const unsigned xo = (unsigned)((tk[g0 + g] < 0 ? 0 : tk[g0 + g]) * 1024 + colu + cl);
#pragma unroll
                for (int bj = 0; bj < 2; ++bj)
#pragma unroll
                    for (int n = 0; n < 2; ++n) bs[g][bj][n] = ldraw(xr + xo + bj * HALF + n * 16); }
#pragma unroll
            for (int g = 0; g < 4; ++g) { const int ai = (g0 + g) >> 2, m = (g0 + g) & 3, tkg = tk[g0 + g];
                if (tkg >= 0) { TO* op = out + (size_t)tkg * 1024 + colu + cl; const PG8_LAS float* gp = gl + (tkg >> 12) * 256 + cl;
#pragma unroll
                    for (int bj = 0; bj < 2; ++bj)
#pragma unroll
                        for (int n = 0; n < 2; ++n) { const f32x4 gv = *(const PG8_LAS f32x4*)(gp + bj * HALF + n * 16); st4(op + bj * HALF + n * 16, cvraw(bs[g][bj][n]) + gv * acc[ai][bj][m][n]); } } }
            asm volatile("" ::: "memory"); }
    }
};
template <class Epi, class Sched, bool ALIGN_EPI = false, bool SP2 = false, int F8 = -1>
__device__ __forceinline__ void gemm_phase(PG8_LAS unsigned char* lds, const Gemm g, const Sched& S, const Epi& E, const int tid_in) {
    int tid = tid_in; asm volatile("" : "+v"(tid));
    const int wid = __builtin_amdgcn_readfirstlane(tid >> 6), lane = tid & 63, wr = wid >> 2, wc = wid & 3, fr = lane & 15, fq = lane >> 4;
    int K = g.K; asm volatile("" : "+s"(K)); const int nt = K / BK;
    unsigned voffA[2], voffB[2];
#pragma unroll
    for (int i = 0; i < 2; ++i) { int R, C; stage_rc(tid * 16 + i * 8192, R, C); const int Rb = Epi::PERM ? ((R & ~31) + perm32(R & 31)) : R;
        voffA[i] = (unsigned)(R * K + C) * 2u; voffB[i] = (unsigned)(Rb * K + C) * 2u; }
    const size_t kstep = (size_t)(BK * 2);
    const size_t hstep = (size_t)HALF * K * 2;
    const size_t tstep = 2 * hstep;
    const unsigned ldsw = (unsigned)wid * 1024u;
    const int aoff = lds_byte(wr * 64 + fr, fq * 8), boff = lds_byte(wc * 32 + fr, fq * 8);
#define PG8_SA(b, h) (((b) * 2 + (h)) * HTB)
#define PG8_SB(b, h) ((4 + (b) * 2 + (h)) * HTB)
#define PG8_STAGE(bufoff, gbase, voff) do { _Pragma("unroll") for (int _i = 0; _i < 2; ++_i) { unsigned vo_ = (voff)[_i]; asm volatile("" : "+v"(vo_));   \
        __builtin_amdgcn_global_load_lds((const unsigned*)((const char*)(gbase) + vo_), (PG8_LAS unsigned*)(lds + (bufoff) + ldsw + _i * 8192), 16, 0, 0); } } while (0)
#define PG8_LDA(dst, b, h) do { _Pragma("unroll") for (int m = 0; m < 4; ++m) { const bf16x8 x0_ = *(const PG8_LAS bf16x8*)(lds + PG8_SA(b, h) + aoff + m * 2048), x1_ = *(const PG8_LAS bf16x8*)(lds + PG8_SA(b, h) + aoff + m * 2048 + 1024); \
        if constexpr (F8 >= 0) dst##8[m] = PG8_CAT(x0_, x1_); else { dst[m][0] = x0_; dst[m][1] = x1_; } } } while (0)
#define PG8_LDB(dst, b, h) do { _Pragma("unroll") for (int n = 0; n < 2; ++n) { const bf16x8 x0_ = *(const PG8_LAS bf16x8*)(lds + PG8_SB(b, h) + boff + n * 2048), x1_ = *(const PG8_LAS bf16x8*)(lds + PG8_SB(b, h) + boff + n * 2048 + 1024); \
        if constexpr (F8 >= 0) dst##8[n] = PG8_CAT(x0_, x1_); else { dst[n][0] = x0_; dst[n][1] = x1_; } } } while (0)
#define PG8_CAT(x0, x1) ({ const v4i_t lo_ = __builtin_bit_cast(v4i_t, x0), hi_ = __builtin_bit_cast(v4i_t, x1); (v8i_t){lo_[0], lo_[1], lo_[2], lo_[3], hi_[0], hi_[1], hi_[2], hi_[3]}; })
#define PG8_MMA(ai, bj, At, Bt) do { __builtin_amdgcn_s_setprio(1); _Pragma("unroll") for (int m = 0; m < 4; ++m) _Pragma("unroll") for (int n = 0; n < 2; ++n) { \
        if constexpr (F8 >= 0) acc[ai][bj][m][n] = __builtin_amdgcn_mfma_scale_f32_16x16x128_f8f6f4(Bt##8[n], At##8[m], acc[ai][bj][m][n], 0, 0, 0, 0x7f7f7f7f, 0, (127 - F8) * 0x01010101); \
        else { _Pragma("unroll") for (int k = 0; k < 2; ++k) acc[ai][bj][m][n] = __builtin_amdgcn_mfma_f32_16x16x32_bf16(Bt[n][k], At[m][k], acc[ai][bj][m][n], 0, 0, 0); } } \
        __builtin_amdgcn_s_setprio(0); } while (0)
#define PG8_WAIT_V(n) asm volatile("s_waitcnt vmcnt(" #n ")" ::: "memory")
#define PG8_WAIT_L(n) asm volatile("s_waitcnt lgkmcnt(" #n ")" ::: "memory")
#define PG8_BAR __builtin_amdgcn_s_barrier()
#define PG8_SCHED __builtin_amdgcn_sched_barrier(0)
    Unit cur, nxt; int ui = 0;
    if (!S.next(0, cur)) return;
    f32x4 acc[2][2][4][2];
#pragma unroll
    for (int a = 0; a < 2; ++a)
#pragma unroll
        for (int b = 0; b < 2; ++b)
#pragma unroll
            for (int m = 0; m < 4; ++m)
#pragma unroll
                for (int n = 0; n < 2; ++n) acc[a][b][m][n] = (f32x4){0.f, 0.f, 0.f, 0.f};
    bf16x8 At[4][2], B0[2][2], B1[2][2]; v8i_t At8[4], B08[2], B18[2];
    const char* cA = (const char*)g.A + (size_t)cur.pm * tstep; const char* cB = (const char*)g.Bt + (size_t)cur.pn * tstep;
    S.a_ready(cur);
    if constexpr (SP2) {
        PG8_STAGE(PG8_SB(0, 0), cB, voffB); PG8_STAGE(PG8_SB(0, 1), cB + hstep, voffB); PG8_STAGE(PG8_SA(0, 0), cA, voffA); PG8_STAGE(PG8_SA(0, 1), cA + hstep, voffA);
        if (wr == 1) PG8_BAR;
        PG8_WAIT_V(2); PG8_BAR;
        PG8_STAGE(PG8_SB(1, 0), cB + kstep, voffB); PG8_STAGE(PG8_SA(1, 0), cA + kstep, voffA); PG8_STAGE(PG8_SB(1, 1), cB + hstep + kstep, voffB);
        PG8_WAIT_V(6); PG8_BAR;
    } else {
        PG8_STAGE(PG8_SB(0, 0), cB, voffB); PG8_STAGE(PG8_SA(0, 0), cA, voffA); PG8_STAGE(PG8_SB(0, 1), cB + hstep, voffB); PG8_STAGE(PG8_SA(0, 1), cA + hstep, voffA);
        if (wr == 1) PG8_BAR;
        PG8_WAIT_V(4); PG8_BAR;
        PG8_STAGE(PG8_SB(1, 0), cB + kstep, voffB); PG8_STAGE(PG8_SA(1, 0), cA + kstep, voffA); PG8_STAGE(PG8_SB(1, 1), cB + hstep + kstep, voffB);
        PG8_WAIT_V(6); PG8_BAR;
    }
    for (;;) {
        const bool has_next = S.next(ui + 1, nxt);
        const char* nA = has_next ? (const char*)g.A + (size_t)nxt.pm * tstep : cA; const char* nB = has_next ? (const char*)g.Bt + (size_t)nxt.pn * tstep : cB;
        for (int t = 0; t < nt; t += 2) {
            const bool last = (t == nt - 2);
            const char* a1 = cA + (size_t)(t + 1) * kstep;
            const char* a2 = last ? nA : cA + (size_t)(t + 2) * kstep; const char* b2 = last ? nB : cB + (size_t)(t + 2) * kstep;
            const char* a3 = a2 + kstep; const char* b3 = b2 + kstep;
            if (last && has_next) S.a_ready(nxt);
            if constexpr (SP2) {
            PG8_LDB(B0, 0, 0); PG8_LDB(B1, 0, 1); PG8_SCHED; PG8_LDA(At, 0, 0); PG8_STAGE(PG8_SA(1, 1), a1 + hstep, voffA);
            PG8_WAIT_V(8); PG8_WAIT_L(0); PG8_BAR; PG8_MMA(0, 0, At, B0); PG8_MMA(0, 1, At, B1); PG8_BAR; PG8_SCHED;
            PG8_LDA(At, 0, 1); PG8_STAGE(PG8_SB(0, 0), b2, voffB); PG8_STAGE(PG8_SB(0, 1), b2 + hstep, voffB); PG8_STAGE(PG8_SA(0, 0), a2, voffA);
            PG8_WAIT_V(8); PG8_WAIT_L(0); PG8_BAR; PG8_MMA(1, 0, At, B0); PG8_MMA(1, 1, At, B1); PG8_BAR; PG8_SCHED;
            PG8_LDB(B0, 1, 0); PG8_LDB(B1, 1, 1); PG8_SCHED; PG8_LDA(At, 1, 0); PG8_STAGE(PG8_SA(0, 1), a2 + hstep, voffA);
            PG8_WAIT_V(8); PG8_WAIT_L(0); PG8_BAR; PG8_MMA(0, 0, At, B0); PG8_MMA(0, 1, At, B1); PG8_BAR; PG8_SCHED;
            PG8_LDA(At, 1, 1); PG8_STAGE(PG8_SB(1, 0), b3, voffB); PG8_STAGE(PG8_SB(1, 1), b3 + hstep, voffB); PG8_STAGE(PG8_SA(1, 0), a3, voffA);
            PG8_WAIT_V(8); PG8_WAIT_L(0); PG8_BAR; PG8_MMA(1, 0, At, B0); PG8_MMA(1, 1, At, B1); PG8_BAR; PG8_SCHED;
            } else {
            PG8_LDB(B0, 0, 0); PG8_SCHED; PG8_LDA(At, 0, 0); PG8_STAGE(PG8_SA(1, 1), a1 + hstep, voffA);
            PG8_WAIT_L(8); PG8_BAR; PG8_WAIT_L(0); PG8_MMA(0, 0, At, B0); PG8_BAR; PG8_SCHED;
            PG8_LDB(B1, 0, 1); PG8_STAGE(PG8_SB(0, 0), b2, voffB);
            PG8_BAR; PG8_WAIT_L(0); PG8_MMA(0, 1, At, B1); PG8_BAR;
            PG8_LDA(At, 0, 1); PG8_STAGE(PG8_SA(0, 0), a2, voffA);
            PG8_BAR; PG8_WAIT_L(0); PG8_MMA(1, 0, At, B0); PG8_BAR; PG8_SCHED;
            PG8_STAGE(PG8_SB(0, 1), b2 + hstep, voffB);
            PG8_WAIT_V(6); PG8_BAR; PG8_MMA(1, 1, At, B1); PG8_BAR;
            PG8_LDB(B0, 1, 0); PG8_SCHED; PG8_LDA(At, 1, 0); PG8_STAGE(PG8_SA(0, 1), a2 + hstep, voffA);
            PG8_WAIT_L(8); PG8_BAR; PG8_WAIT_L(0); PG8_MMA(0, 0, At, B0); PG8_BAR; PG8_SCHED;
            PG8_LDB(B1, 1, 1); PG8_STAGE(PG8_SB(1, 0), b3, voffB);
            PG8_BAR; PG8_WAIT_L(0); PG8_MMA(0, 1, At, B1); PG8_BAR;
            PG8_LDA(At, 1, 1); PG8_STAGE(PG8_SA(1, 0), a3, voffA);
            PG8_BAR; PG8_WAIT_L(0); PG8_MMA(1, 0, At, B0); PG8_BAR; PG8_SCHED;
            PG8_STAGE(PG8_SB(1, 1), b3 + hstep, voffB);
            PG8_WAIT_V(6); PG8_BAR; PG8_MMA(1, 1, At, B1); PG8_BAR;
            }
        }
        if constexpr (ALIGN_EPI) { if (wr == 0) PG8_BAR; }
        if constexpr (!Epi::AFTER_DRAIN) { E(acc, cur, wr, wc, fr, fq); S.done(cur); }
        if (!has_next) break;
#pragma unroll
        for (int a = 0; a < 2; ++a)
#pragma unroll
            for (int b = 0; b < 2; ++b)
#pragma unroll
                for (int m = 0; m < 4; ++m)
#pragma unroll
                    for (int n = 0; n < 2; ++n) acc[a][b][m][n] = (f32x4){0.f, 0.f, 0.f, 0.f};
        cur = nxt; cA = nA; cB = nB; ++ui;
        if constexpr (ALIGN_EPI) { if (wr == 1) PG8_BAR; }
    }
    PG8_WAIT_V(0);
    if constexpr (!ALIGN_EPI) { if (wr == 0) PG8_BAR; }
    PG8_BAR;
    if constexpr (Epi::AFTER_DRAIN) { E.fused(acc, cur, wr, wc, fr, fq, lds, wid, lane); S.done(cur); }
#undef PG8_SA
#undef PG8_SB
#undef PG8_STAGE
#undef PG8_LDA
#undef PG8_LDB
#undef PG8_MMA
#undef PG8_WAIT_V
#undef PG8_WAIT_L
#undef PG8_BAR
#undef PG8_SCHED
}
template <class Epi, class Sched, bool ALIGN_EPI = true, bool SP2 = true, int F8 = -1>
__device__ __forceinline__ void gemm_phase_gather(PG8_LAS unsigned char* lds, const Gemm g, const Sched& S, const Epi& E, const int tid_in) {
    int tid = tid_in; asm volatile("" : "+v"(tid));
    static_assert(SP2, "gather form: SP2 loop only");
    const int wid = __builtin_amdgcn_readfirstlane(tid >> 6), lane = tid & 63, wr = wid >> 2, wc = wid & 3, fr = lane & 15, fq = lane >> 4;
    int K = g.K; asm volatile("" : "+s"(K)); const int nt = K / BK;
    unsigned voffA[2], voffB[2];
#pragma unroll
    for (int i = 0; i < 2; ++i) { int R, C; stage_rc(tid * 16 + i * 8192, R, C); const int Rb = Epi::PERM ? ((R & ~31) + perm32(R & 31)) : R;
        voffA[i] = (unsigned)(R * K + C) * 2u; voffB[i] = (unsigned)(Rb * K + C) * 2u; }
    int gR, gC; stage_rc(tid * 16, gR, gC);
    unsigned vG[2][2], vN[2][2];
    const size_t kstep = (size_t)(BK * 2);
    const size_t hstep = (size_t)HALF * K * 2;
    const size_t tstep = 2 * hstep;
    const unsigned ldsw = (unsigned)wid * 1024u;
    const int aoff = lds_byte(wr * 64 + fr, fq * 8), boff = lds_byte(wc * 32 + fr, fq * 8);
#define PG8_SA(b, h) (((b) * 2 + (h)) * HTB)
#define PG8_SB(b, h) ((4 + (b) * 2 + (h)) * HTB)
#define PG8_STAGE(bufoff, gbase, voff) do { _Pragma("unroll") for (int _i = 0; _i < 2; ++_i) { unsigned vo_ = (voff)[_i]; asm volatile("" : "+v"(vo_));   \
        __builtin_amdgcn_global_load_lds((const unsigned*)((const char*)(gbase) + vo_), (PG8_LAS unsigned*)(lds + (bufoff) + ldsw + _i * 8192), 16, 0, 0); } } while (0)
#define PG8_LDA(dst, b, h) do { _Pragma("unroll") for (int m = 0; m < 4; ++m) { const bf16x8 x0_ = *(const PG8_LAS bf16x8*)(lds + PG8_SA(b, h) + aoff + m * 2048), x1_ = *(const PG8_LAS bf16x8*)(lds + PG8_SA(b, h) + aoff + m * 2048 + 1024); \
        if constexpr (F8 >= 0) dst##8[m] = PG8_CAT(x0_, x1_); else { dst[m][0] = x0_; dst[m][1] = x1_; } } } while (0)
#define PG8_LDB(dst, b, h) do { _Pragma("unroll") for (int n = 0; n < 2; ++n) { const bf16x8 x0_ = *(const PG8_LAS bf16x8*)(lds + PG8_SB(b, h) + boff + n * 2048), x1_ = *(const PG8_LAS bf16x8*)(lds + PG8_SB(b, h) + boff + n * 2048 + 1024); \
        if constexpr (F8 >= 0) dst##8[n] = PG8_CAT(x0_, x1_); else { dst[n][0] = x0_; dst[n][1] = x1_; } } } while (0)
#define PG8_CAT(x0, x1) ({ const v4i_t lo_ = __builtin_bit_cast(v4i_t, x0), hi_ = __builtin_bit_cast(v4i_t, x1); (v8i_t){lo_[0], lo_[1], lo_[2], lo_[3], hi_[0], hi_[1], hi_[2], hi_[3]}; })
#define PG8_MMA(ai, bj, At, Bt) do { __builtin_amdgcn_s_setprio(1); _Pragma("unroll") for (int m = 0; m < 4; ++m) _Pragma("unroll") for (int n = 0; n < 2; ++n) { \
        if constexpr (F8 >= 0) acc[ai][bj][m][n] = __builtin_amdgcn_mfma_scale_f32_16x16x128_f8f6f4(Bt##8[n], At##8[m], acc[ai][bj][m][n], 0, 0, 0, 0x7f7f7f7f, 0, (127 - F8) * 0x01010101); \
        else { _Pragma("unroll") for (int k = 0; k < 2; ++k) acc[ai][bj][m][n] = __builtin_amdgcn_mfma_f32_16x16x32_bf16(Bt[n][k], At[m][k], acc[ai][bj][m][n], 0, 0, 0); } } \
        __builtin_amdgcn_s_setprio(0); } while (0)
#define PG8_WAIT_V(n) asm volatile("s_waitcnt vmcnt(" #n ")" ::: "memory")
#define PG8_WAIT_L(n) asm volatile("s_waitcnt lgkmcnt(" #n ")" ::: "memory")
#define PG8_BAR __builtin_amdgcn_s_barrier()
#define PG8_SCHED __builtin_amdgcn_sched_barrier(0)
    Unit cur, nxt; int ui = 0;
    if (!S.next(0, cur)) return;
    f32x4 acc[2][2][4][2];
#pragma unroll
    for (int a = 0; a < 2; ++a)
#pragma unroll
        for (int b = 0; b < 2; ++b)
#pragma unroll
            for (int m = 0; m < 4; ++m)
#pragma unroll
                for (int n = 0; n < 2; ++n) acc[a][b][m][n] = (f32x4){0.f, 0.f, 0.f, 0.f};
    bf16x8 At[4][2], B0[2][2], B1[2][2]; v8i_t At8[4], B08[2], B18[2];
    const char* cA = (const char*)g.A; const char* cB = (const char*)g.Bt + (size_t)cur.pn * tstep;
    S.a_ready(cur);
#pragma unroll
    for (int h = 0; h < 2; ++h)
#pragma unroll
        for (int i = 0; i < 2; ++i) vG[h][i] = (unsigned)S.tok(cur, h * HALF + gR + 64 * i) * (unsigned)(K * 2) + (unsigned)(gC * 2);
    if constexpr (SP2) {
        PG8_STAGE(PG8_SB(0, 0), cB, voffB); PG8_STAGE(PG8_SB(0, 1), cB + hstep, voffB); PG8_STAGE(PG8_SA(0, 0), cA, vG[0]); PG8_STAGE(PG8_SA(0, 1), cA, vG[1]);
        if (wr == 1) PG8_BAR;
        PG8_WAIT_V(2); PG8_BAR;
        PG8_STAGE(PG8_SB(1, 0), cB + kstep, voffB); PG8_STAGE(PG8_SA(1, 0), cA + kstep, vG[0]); PG8_STAGE(PG8_SB(1, 1), cB + hstep + kstep, voffB);
        PG8_WAIT_V(6); PG8_BAR;
    } else {
        PG8_STAGE(PG8_SB(0, 0), cB, voffB); PG8_STAGE(PG8_SA(0, 0), cA, voffA); PG8_STAGE(PG8_SB(0, 1), cB + hstep, voffB); PG8_STAGE(PG8_SA(0, 1), cA + hstep, voffA);
        if (wr == 1) PG8_BAR;
        PG8_WAIT_V(4); PG8_BAR;
        PG8_STAGE(PG8_SB(1, 0), cB + kstep, voffB); PG8_STAGE(PG8_SA(1, 0), cA + kstep, voffA); PG8_STAGE(PG8_SB(1, 1), cB + hstep + kstep, voffB);
        PG8_WAIT_V(6); PG8_BAR;
    }
    for (;;) {
        const bool has_next = S.next(ui + 1, nxt);
        const char* nA = cA; const char* nB = has_next ? (const char*)g.Bt + (size_t)nxt.pn * tstep : cB;
        for (int t = 0; t < nt; t += 2) {
            const bool last = (t == nt - 2);
            const char* a1 = cA + (size_t)(t + 1) * kstep;
            const char* a2 = last ? nA : cA + (size_t)(t + 2) * kstep; const char* b2 = last ? nB : cB + (size_t)(t + 2) * kstep;
            const char* a3 = a2 + kstep; const char* b3 = b2 + kstep;
            if (last && has_next) { S.a_ready(nxt);
#pragma unroll
                for (int h = 0; h < 2; ++h)
#pragma unroll
                    for (int i = 0; i < 2; ++i) vN[h][i] = (unsigned)S.tok(nxt, h * HALF + gR + 64 * i) * (unsigned)(K * 2) + (unsigned)(gC * 2); }
            if constexpr (SP2) {
            PG8_LDB(B0, 0, 0); PG8_LDB(B1, 0, 1); PG8_SCHED; PG8_LDA(At, 0, 0); PG8_STAGE(PG8_SA(1, 1), a1, vG[1]);
            if (last && has_next) { vG[0][0] = vN[0][0]; vG[0][1] = vN[0][1]; vG[1][0] = vN[1][0]; vG[1][1] = vN[1][1]; }
            PG8_WAIT_V(8); PG8_WAIT_L(0); PG8_BAR; PG8_MMA(0, 0, At, B0); PG8_MMA(0, 1, At, B1); PG8_BAR; PG8_SCHED;
            PG8_LDA(At, 0, 1); PG8_STAGE(PG8_SB(0, 0), b2, voffB); PG8_STAGE(PG8_SB(0, 1), b2 + hstep, voffB); PG8_STAGE(PG8_SA(0, 0), a2, vG[0]);
            PG8_WAIT_V(8); PG8_WAIT_L(0); PG8_BAR; PG8_MMA(1, 0, At, B0); PG8_MMA(1, 1, At, B1); PG8_BAR; PG8_SCHED;
            PG8_LDB(B0, 1, 0); PG8_LDB(B1, 1, 1); PG8_SCHED; PG8_LDA(At, 1, 0); PG8_STAGE(PG8_SA(0, 1), a2, vG[1]);
            PG8_WAIT_V(8); PG8_WAIT_L(0); PG8_BAR; PG8_MMA(0, 0, At, B0); PG8_MMA(0, 1, At, B1); PG8_BAR; PG8_SCHED;
            PG8_LDA(At, 1, 1); PG8_STAGE(PG8_SB(1, 0), b3, voffB); PG8_STAGE(PG8_SB(1, 1), b3 + hstep, voffB); PG8_STAGE(PG8_SA(1, 0), a3, vG[0]);
            PG8_WAIT_V(8); PG8_WAIT_L(0); PG8_BAR; PG8_MMA(1, 0, At, B0); PG8_MMA(1, 1, At, B1); PG8_BAR; PG8_SCHED;
            } else {
            PG8_LDB(B0, 0, 0); PG8_SCHED; PG8_LDA(At, 0, 0); PG8_STAGE(PG8_SA(1, 1), a1 + hstep, voffA);
            PG8_WAIT_L(8); PG8_BAR; PG8_WAIT_L(0); PG8_MMA(0, 0, At, B0); PG8_BAR; PG8_SCHED;
            PG8_LDB(B1, 0, 1); PG8_STAGE(PG8_SB(0, 0), b2, voffB);
            PG8_BAR; PG8_WAIT_L(0); PG8_MMA(0, 1, At, B1); PG8_BAR;
            PG8_LDA(At, 0, 1); PG8_STAGE(PG8_SA(0, 0), a2, voffA);
            PG8_BAR; PG8_WAIT_L(0); PG8_MMA(1, 0, At, B0); PG8_BAR; PG8_SCHED;
            PG8_STAGE(PG8_SB(0, 1), b2 + hstep, voffB);
            PG8_WAIT_V(6); PG8_BAR; PG8_MMA(1, 1, At, B1); PG8_BAR;
            PG8_LDB(B0, 1, 0); PG8_SCHED; PG8_LDA(At, 1, 0); PG8_STAGE(PG8_SA(0, 1), a2 + hstep, voffA);
            PG8_WAIT_L(8); PG8_BAR; PG8_WAIT_L(0); PG8_MMA(0, 0, At, B0); PG8_BAR; PG8_SCHED;
            PG8_LDB(B1, 1, 1); PG8_STAGE(PG8_SB(1, 0), b3, voffB);
            PG8_BAR; PG8_WAIT_L(0); PG8_MMA(0, 1, At, B1); PG8_BAR;
            PG8_LDA(At, 1, 1); PG8_STAGE(PG8_SA(1, 0), a3, voffA);
            PG8_BAR; PG8_WAIT_L(0); PG8_MMA(1, 0, At, B0); PG8_BAR; PG8_SCHED;
            PG8_STAGE(PG8_SB(1, 1), b3 + hstep, voffB);
            PG8_WAIT_V(6); PG8_BAR; PG8_MMA(1, 1, At, B1); PG8_BAR;
            }
        }
        if constexpr (ALIGN_EPI) { if (wr == 0) PG8_BAR; }
        if constexpr (!Epi::AFTER_DRAIN) { E(acc, cur, wr, wc, fr, fq); S.done(cur); }
        if (!has_next) break;
#pragma unroll
        for (int a = 0; a < 2; ++a)
#pragma unroll
            for (int b = 0; b < 2; ++b)
#pragma unroll
                for (int m = 0; m < 4; ++m)
#pragma unroll
                    for (int n = 0; n < 2; ++n) acc[a][b][m][n] = (f32x4){0.f, 0.f, 0.f, 0.f};
        cur = nxt; cA = nA; cB = nB; ++ui;
        if constexpr (ALIGN_EPI) { if (wr == 1) PG8_BAR; }
    }
    PG8_WAIT_V(0);
    if constexpr (!ALIGN_EPI) { if (wr == 0) PG8_BAR; }
    PG8_BAR;
    if constexpr (Epi::AFTER_DRAIN) { E.fused(acc, cur, wr, wc, fr, fq, lds, wid, lane); S.done(cur); }
#undef PG8_SA
#undef PG8_SB
#undef PG8_STAGE
#undef PG8_LDA
#undef PG8_LDB
#undef PG8_MMA
#undef PG8_WAIT_V
#undef PG8_WAIT_L
#undef PG8_BAR
#undef PG8_SCHED
}
}
namespace att {
typedef unsigned short bf16;
using bf16x8 = __attribute__((ext_vector_type(8))) short;
using s16x4  = __attribute__((ext_vector_type(4))) short;
using f32x16 = __attribute__((ext_vector_type(16))) float;
using u32x4  = __attribute__((ext_vector_type(4))) unsigned;
using f32x4_t = __attribute__((ext_vector_type(4))) float;
constexpr int NW = 8, QBLK = 32, KVBLK = 64, SEQ = 4096;
constexpr int LDQ = 1536, LDKV = 2048, LDO = 1024;
constexpr int SHM_VT = 128 * 80, SHM_K8 = 64 * 208;
constexpr int OFF_V = 0, OFF_K8 = 3 * SHM_VT, OFF_WS = OFF_K8 + 2 * SHM_K8, LDS_BYTES = OFF_WS + NW * 64 * 4 + 64;
typedef int v8i32 __attribute__((ext_vector_type(8)));
typedef int v4i32 __attribute__((ext_vector_type(4)));
typedef int v2i32 __attribute__((ext_vector_type(2)));
constexpr int T_TOK = 8 * SEQ;
#define ASBAR() __builtin_amdgcn_sched_barrier(0)
__device__ __forceinline__ int crow(int r, int hi) { return (r & 3) + 8 * (r >> 2) + 4 * hi; }
__device__ __forceinline__ unsigned cvtpk(float lo, float hi) { unsigned r; asm volatile("v_cvt_pk_bf16_f32 %0, %1, %2" : "=v"(r) : "v"(lo), "v"(hi)); return r; }
__device__ __forceinline__ float bf2f(unsigned short b) { return __uint_as_float(((unsigned)b) << 16); }
template <bool SHIFT> __device__ __forceinline__ void smA(f32x16& p0, float negm) { for (int r = 0; r < 16; ++r) p0[r] = __builtin_amdgcn_exp2f(SHIFT ? p0[r] + negm : p0[r]); }
template <bool SHIFT> __device__ __forceinline__ void smB(f32x16& p0, f32x16& p1, float& l_reg, v8i32& p8, float negm) {
  for (int r = 0; r < 16; ++r) p1[r] = __builtin_amdgcn_exp2f(SHIFT ? p1[r] + negm : p1[r]);
  float ps = 0; for (int r = 0; r < 16; ++r) ps += p0[r]; for (int r = 0; r < 16; ++r) ps += p1[r];
  l_reg += ps;
#pragma unroll
  for (int w = 0; w < 4; ++w) { int a = 0, bq = 0;
    a = __builtin_amdgcn_cvt_pk_bf8_f32(p0[4 * w], p0[4 * w + 1], a, false); a = __builtin_amdgcn_cvt_pk_bf8_f32(p0[4 * w + 2], p0[4 * w + 3], a, true);
    bq = __builtin_amdgcn_cvt_pk_bf8_f32(p1[4 * w], p1[4 * w + 1], bq, false); bq = __builtin_amdgcn_cvt_pk_bf8_f32(p1[4 * w + 2], p1[4 * w + 3], bq, true);
    p8[w] = a; p8[4 + w] = bq; }
}
template <bool SHIFT> __device__ __forceinline__ void qkt(f32x16& p0, f32x16& p1, const char* K8, const v8i32* q8, float negm, int r32, int hi) {
  p0 = f32x16{}; p1 = f32x16{};
#define K8RD(m, half, part) (*reinterpret_cast<const v4i32*>(K8 + ((half) * 32 + r32) * 208 + (m) * 64 + hi * 32 + (part) * 16))
#define K8FR(m, half) ({ const v4i32 lo_ = K8RD(m, half, 0), hi_ = K8RD(m, half, 1); (v8i32){lo_[0], lo_[1], lo_[2], lo_[3], hi_[0], hi_[1], hi_[2], hi_[3]}; })
  v8i32 a0 = K8FR(0, 0), a1 = K8FR(0, 1), b0 = K8FR(1, 0), b1 = K8FR(1, 1);
  ASBAR();
  p0 = __builtin_amdgcn_mfma_scale_f32_32x32x64_f8f6f4(a0, q8[0], p0, 0, 0, 0, 0x7f7f7f7f, 0, 0x7f7f7f7f);
  p1 = __builtin_amdgcn_mfma_scale_f32_32x32x64_f8f6f4(a1, q8[0], p1, 0, 0, 0, 0x7f7f7f7f, 0, 0x7f7f7f7f);
  a0 = K8FR(2, 0); a1 = K8FR(2, 1);
  ASBAR();
  p0 = __builtin_amdgcn_mfma_scale_f32_32x32x64_f8f6f4(b0, q8[1], p0, 0, 0, 0, 0x7f7f7f7f, 0, 0x7f7f7f7f);
  p1 = __builtin_amdgcn_mfma_scale_f32_32x32x64_f8f6f4(b1, q8[1], p1, 0, 0, 0, 0x7f7f7f7f, 0, 0x7f7f7f7f);
  ASBAR();
  p0 = __builtin_amdgcn_mfma_scale_f32_32x32x64_f8f6f4(a0, q8[2], p0, 0, 0, 0, 0x7f7f7f7f, 0, 0x7f7f7f7f);
  p1 = __builtin_amdgcn_mfma_scale_f32_32x32x64_f8f6f4(a1, q8[2], p1, 0, 0, 0, 0x7f7f7f7f, 0, 0x7f7f7f7f);
  ASBAR();
#undef K8RD
#undef K8FR
}
__device__ __forceinline__ void pv_d0(f32x16* o, const char* VT, v8i32 p8, int r32, int hi) {
#define VTFR(d0) ({ const v4i32 lo_ = *reinterpret_cast<const v4i32*>(VT + ((d0) * 32 + r32) * 80 + hi * 32), hi_ = *reinterpret_cast<const v4i32*>(VT + ((d0) * 32 + r32) * 80 + hi * 32 + 16); (v8i32){lo_[0], lo_[1], lo_[2], lo_[3], hi_[0], hi_[1], hi_[2], hi_[3]}; })
#define PVMMA(d0, fr) o[d0] = __builtin_amdgcn_mfma_scale_f32_32x32x64_f8f6f4(p8, fr, o[d0], 1  , 0  , 0, 0x7f7f7f7f, 0, 0x7f7f7f7f)
  v8i32 fa = VTFR(0), fb = VTFR(1);
  ASBAR();
  PVMMA(0, fa); fa = VTFR(2); ASBAR();
  PVMMA(1, fb); fb = VTFR(3); ASBAR();
  PVMMA(2, fa); PVMMA(3, fb); ASBAR();
#undef VTFR
#undef PVMMA
}
template <bool SHIFT> __device__ __forceinline__ bool attn_unit(int b, int h, int s0, const bf16* Qraw, const unsigned char* __restrict__ VT8g, const unsigned char* __restrict__ K8g, const unsigned char* __restrict__ KP8g, bf16* __restrict__ O,
                                          const float* rope, const float* qg, float smaxC, char* lds, int tid) {
  asm volatile("" : "+v"(tid));
  const int wid = __builtin_amdgcn_readfirstlane(tid >> 6), lane = tid & 63, r32 = lane & 31, hi = lane >> 5;
  asm volatile("" : "+s"(qg));
  char* V_lds = lds + OFF_V; char* K8_lds = lds + OFF_K8;
  float* ws = (float*)(lds + OFF_WS) + wid * 64; float* li_l = ws;
  constexpr float C = 0.072168783648703220f * 1.4426950408889634f;
  v8i32 q8[3];
  {
    typedef __attribute__((address_space(1))) const bf16x8 gbf16x8; typedef __attribute__((address_space(1))) const f32x4_t gf32x4;
    const long trow = (long)b * SEQ + s0 + wid * QBLK + r32;
    unsigned qo = (unsigned)((trow * LDQ + h * 192) * 2); const unsigned ro = (unsigned)(trow * 256), go = (unsigned)(hi * 128);
#define Qn_(i) (*(gbf16x8*)((const char*)Qraw + qo + hi * 64 + (i) * 16))
#define Qr_(i) (*(gbf16x8*)((const char*)Qraw + qo + 256 + (i) * 16))
#define rp4_(i) (*(gf32x4*)((const char*)rope + ro + (i) * 16))
#define qgn_(i) (*(gf32x4*)((const char*)qg + go + (i) * 16))
#define qgr_(i) (*(gf32x4*)((const char*)qg + 512 + (i) * 16))
    float ssn = 0.f, ssp = 0.f;
#pragma unroll
    for (int c = 0; c < 8; ++c) { const bf16x8 a = Qn_((c >> 2) * 8 + (c & 3)), r = Qr_(c);
#pragma unroll
      for (int j = 0; j < 8; ++j) { const float f = bf2f((unsigned short)a[j]), g = bf2f((unsigned short)r[j]); ssn += f * f; ssp += g * g; } }
    ssn += __shfl_xor(ssn, 32);
    const float rn = rsqrtf(ssn * (1.f / 128.f) + 1e-6f) * C, rp = rsqrtf(ssp * (1.f / 64.f) + 1e-6f) * C;
    { float rn_ = rn, rp_ = rp; asm volatile("" : "+v"(qo), "+v"(rn_), "+v"(rp_) :: "memory"); }
#pragma unroll
    for (int m = 0; m < 2; ++m)
#pragma unroll
      for (int c = 0; c < 4; ++c) { const bf16x8 raw = Qn_(8 * m + c); const f32x4_t ga = qgn_(16 * m + 2 * c), gb = qgn_(16 * m + 2 * c + 1); float g[8];
#pragma unroll
        for (int j = 0; j < 8; ++j) g[j] = bf2f((unsigned short)raw[j]) * rn * (j < 4 ? ga[j & 3] : gb[j & 3]);
        int w0 = 0, w1 = 0; w0 = __builtin_amdgcn_cvt_pk_fp8_f32(g[0], g[1], w0, false); w0 = __builtin_amdgcn_cvt_pk_fp8_f32(g[2], g[3], w0, true);
        w1 = __builtin_amdgcn_cvt_pk_fp8_f32(g[4], g[5], w1, false); w1 = __builtin_amdgcn_cvt_pk_fp8_f32(g[6], g[7], w1, true);
        asm volatile("" : "+v"(w0), "+v"(w1) :: "memory");        q8[m][2 * c] = w0; q8[m][2 * c + 1] = w1; }
#pragma unroll
    for (int c = 0; c < 4; ++c) {
      const bf16x8 r1 = Qr_(c), r2 = Qr_(4 + c);
      const f32x4_t g1a = qgr_(2 * c), g1b = qgr_(2 * c + 1), g2a = qgr_(8 + 2 * c), g2b = qgr_(8 + 2 * c + 1); float ov[8];
#pragma unroll
      for (int j = 0; j < 8; ++j) { const f32x4_t cs4 = rp4_(4 * c + (j >> 1));
        const float cs = cs4[(j & 1) * 2], sn = cs4[(j & 1) * 2 + 1];
        const float x1 = bf2f((unsigned short)r1[j]) * rp * (j < 4 ? g1a[j & 3] : g1b[j & 3]), x2 = bf2f((unsigned short)r2[j]) * rp * (j < 4 ? g2a[j & 3] : g2b[j & 3]);
        ov[j] = hi == 0 ? (x1 * cs - x2 * sn) : (x1 * sn + x2 * cs); }
      int w0 = 0, w1 = 0; w0 = __builtin_amdgcn_cvt_pk_fp8_f32(ov[0], ov[1], w0, false); w0 = __builtin_amdgcn_cvt_pk_fp8_f32(ov[2], ov[3], w0, true);
      w1 = __builtin_amdgcn_cvt_pk_fp8_f32(ov[4], ov[5], w1, false); w1 = __builtin_amdgcn_cvt_pk_fp8_f32(ov[6], ov[7], w1, true);
      asm volatile("" : "+v"(w0), "+v"(w1) :: "memory"); q8[2][2 * c] = w0; q8[2][2 * c + 1] = w1; }
  #undef Qn_
#undef Qr_
#undef rp4_
#undef qgn_
#undef qgr_
  }
  const float negm = 15.0f - smaxC;
  float l_reg = 0.f; f32x16 o[4] = {};
  const char* Vg = (const char*)(VT8g + (size_t)h * 128 * T_TOK + (size_t)b * SEQ); const char* Kg = (const char*)(K8g + ((long)b * SEQ * 8 + h) * 128); const char* Pg = (const char*)(KP8g + (long)b * SEQ * 64);
  const int vc = tid >> 2, vq = tid & 3, vst = vc * 80 + 16 * (vq >> 1) + 8 * (vq & 1); const unsigned gvt = (unsigned)vc * (unsigned)T_TOK + 16u * (unsigned)vq;
  const int kr = tid >> 3, kc = tid & 7, kst = kr * 208 + kc * 16; const unsigned gk8 = (unsigned)(kr * 1024 + kc * 16);
  const int pr = (tid & 255) >> 2, pc = tid & 3, pst = pr * 208 + 128 + pc * 16; const unsigned gp8 = (unsigned)(pr * 64 + pc * 16);
  v4i32 s_v, s_k, s_p;
#define SLOAD(k0) do { s_v = *reinterpret_cast<const v4i32*>(Vg + (size_t)(k0) + gvt); \
    s_k = *reinterpret_cast<const v4i32*>(Kg + (size_t)(k0) * 1024 + gk8); if (tid < 256) s_p = *reinterpret_cast<const v4i32*>(Pg + (size_t)(k0) * 64 + gp8); } while (0)
#define SWRITE(kbuf, vbuf_) do { { v2i32 a_ = {s_v[0], s_v[2]}, b_ = {s_v[1], s_v[3]}; *(v2i32*)(V_lds + (vbuf_) * SHM_VT + vst) = a_; *(v2i32*)(V_lds + (vbuf_) * SHM_VT + vst + 32) = b_; } \
    *(v4i32*)(K8_lds + (kbuf) * SHM_K8 + kst) = s_k; if (tid < 256) *(v4i32*)(K8_lds + (kbuf) * SHM_K8 + pst) = s_p; } while (0)
  constexpr int NT = SEQ / KVBLK;
  v8i32 p8;
  SLOAD(0); SWRITE(0, 0); __syncthreads(); SLOAD(KVBLK);
  if (wid < 4) {
    for (int j = 0, kb = 0, vbuf = 0, vnx = 1; j < NT; ++j) {
      f32x16 p0, p1;
      qkt<SHIFT>(p0, p1, K8_lds + kb * SHM_K8, q8, negm, r32, hi);
      smA<SHIFT>(p0, negm); smB<SHIFT>(p0, p1, l_reg, p8, negm); ASBAR();
      pv_d0(o, V_lds + vbuf * SHM_VT, p8, r32, hi);
      if (j + 1 < NT) SWRITE(kb ^ 1, vnx);
      __syncthreads();
      if (j + 2 < NT) SLOAD((j + 2) * KVBLK);
      kb ^= 1; vbuf = vnx; vnx = vnx == 2 ? 0 : vnx + 1;
    }
  } else {
    int vprev = 0;
    __builtin_amdgcn_s_setprio(1);
    for (int j = 0, kb = 0, vbuf = 0, vnx = 1; j < NT; ++j) {
      f32x16 p0, p1;
      if (j > 0) pv_d0(o, V_lds + vprev * SHM_VT, p8, r32, hi);
      qkt<SHIFT>(p0, p1, K8_lds + kb * SHM_K8, q8, negm, r32, hi);
      smA<SHIFT>(p0, negm); smB<SHIFT>(p0, p1, l_reg, p8, negm); ASBAR();
      if (j + 1 < NT) SWRITE(kb ^ 1, vnx);
      __syncthreads();
      if (j + 2 < NT) SLOAD((j + 2) * KVBLK);
      kb ^= 1; vprev = vbuf; vbuf = vnx; vnx = vnx == 2 ? 0 : vnx + 1;
    }
    pv_d0(o, V_lds + vprev * SHM_VT, p8, r32, hi);
    __builtin_amdgcn_s_setprio(0);
  }
  int lane_e = lane; asm volatile("" : "+v"(lane_e));
  const int r32e = lane_e & 31, hie = lane_e >> 5;
  l_reg += __shfl_xor(l_reg, 32);
  int* satf = (int*)(lds + OFF_WS + NW * 64 * 4);
  if (!SHIFT) { const bool sat = __any(l_reg >= 57344.f); if (lane_e == 0) satf[wid] = sat ? 1 : 0; }
  if (hie == 0) li_l[r32e] = l_reg; asm volatile("s_waitcnt lgkmcnt(0)" ::: "memory");
  float rli[16];
#pragma unroll
  for (int r = 0; r < 16; ++r) rli[r] = __builtin_amdgcn_rcpf(li_l[crow(r, hie)]);
  char* Ow = (char*)O + ((long)b * SEQ + s0 + wid * QBLK) * LDO + h * 128;
#pragma unroll
  for (int r = 0; r < 16; ++r) { const unsigned ooff = (unsigned)(crow(r, hie) * LDO + r32e);
#pragma unroll
    for (int d0 = 0; d0 < 4; ++d0) { const int pk = __builtin_amdgcn_cvt_pk_fp8_f32(o[d0][r] * rli[r] * 32.f, 0.f, 0, false); *(unsigned char*)(Ow + ooff + d0 * 32) = (unsigned char)(pk & 0xff); } }
  __syncthreads();
  bool redo = false;
  if (!SHIFT) { redo = (satf[0] | satf[1] | satf[2] | satf[3] | satf[4] | satf[5] | satf[6] | satf[7]) != 0; __syncthreads(); }
  return redo;
#undef SLOAD
#undef SWRITE
}
}
#ifndef HD
#define HD __device__ __forceinline__
#endif
struct c32 { float x, y; };
HD c32 cmk(float x, float y) { c32 r; r.x = x; r.y = y; return r; }
HD c32 cadd(c32 a, c32 b) { return cmk(a.x + b.x, a.y + b.y); }
HD c32 csub(c32 a, c32 b) { return cmk(a.x - b.x, a.y - b.y); }
HD c32 cmul(c32 a, c32 b) { return cmk(a.x * b.x - a.y * b.y, a.x * b.y + a.y * b.x); }
HD c32 cmulc(c32 a, c32 b) { return cmk(a.x * b.x + a.y * b.y, a.y * b.x - a.x * b.y); }
constexpr int BR4(int i) { return ((i & 1) << 3) | ((i & 2) << 1) | ((i & 4) >> 1) | ((i & 8) >> 3); }
template <int SGN, int J> HD c32 tw16(c32 a) {
    if constexpr (J == 0) return a;
    else if constexpr (J == 4) return SGN < 0 ? cmk(a.y, -a.x) : cmk(-a.y, a.x);
    else {
        constexpr float CS[8] = {1.f, 0.92387953251128674f, 0.70710678118654752f, 0.38268343236508977f, 0.f, -0.38268343236508977f, -0.70710678118654752f, -0.92387953251128674f};
        constexpr float SN[8] = {0.f, 0.38268343236508977f, 0.70710678118654752f, 0.92387953251128674f, 1.f, 0.92387953251128674f, 0.70710678118654752f, 0.38268343236508977f};
        constexpr float c = CS[J], s = SN[J];
        if constexpr (SGN < 0) return cmk(a.x * c + a.y * s, a.y * c - a.x * s);
        else return cmk(a.x * c - a.y * s, a.y * c + a.x * s);
    }
}
#define FFT_BF(i, j, J) { const c32 u_ = v[i], w_ = v[j]; v[i] = cadd(u_, w_); v[j] = tw16<SGN, J>(csub(u_, w_)); }
template <int SGN> HD void dft16_dif(c32 (&v)[16]) {
    FFT_BF(0, 8, 0) FFT_BF(1, 9, 1) FFT_BF(2, 10, 2) FFT_BF(3, 11, 3) FFT_BF(4, 12, 4) FFT_BF(5, 13, 5) FFT_BF(6, 14, 6) FFT_BF(7, 15, 7)
    FFT_BF(0, 4, 0) FFT_BF(1, 5, 2) FFT_BF(2, 6, 4) FFT_BF(3, 7, 6) FFT_BF(8, 12, 0) FFT_BF(9, 13, 2) FFT_BF(10, 14, 4) FFT_BF(11, 15, 6)
    FFT_BF(0, 2, 0) FFT_BF(1, 3, 4) FFT_BF(4, 6, 0) FFT_BF(5, 7, 4) FFT_BF(8, 10, 0) FFT_BF(9, 11, 4) FFT_BF(12, 14, 0) FFT_BF(13, 15, 4)
    FFT_BF(0, 1, 0) FFT_BF(2, 3, 0) FFT_BF(4, 5, 0) FFT_BF(6, 7, 0) FFT_BF(8, 9, 0) FFT_BF(10, 11, 0) FFT_BF(12, 13, 0) FFT_BF(14, 15, 0)
}
#undef FFT_BF
#define FFT_BT(i, j, J) { const c32 u_ = v[i], w_ = tw16<SGN, J>(v[j]); v[i] = cadd(u_, w_); v[j] = csub(u_, w_); }
template <int SGN> HD void dft16_dit(c32 (&v)[16]) {
    FFT_BT(0, 1, 0) FFT_BT(2, 3, 0) FFT_BT(4, 5, 0) FFT_BT(6, 7, 0) FFT_BT(8, 9, 0) FFT_BT(10, 11, 0) FFT_BT(12, 13, 0) FFT_BT(14, 15, 0)
    FFT_BT(0, 2, 0) FFT_BT(1, 3, 4) FFT_BT(4, 6, 0) FFT_BT(5, 7, 4) FFT_BT(8, 10, 0) FFT_BT(9, 11, 4) FFT_BT(12, 14, 0) FFT_BT(13, 15, 4)
    FFT_BT(0, 4, 0) FFT_BT(1, 5, 2) FFT_BT(2, 6, 4) FFT_BT(3, 7, 6) FFT_BT(8, 12, 0) FFT_BT(9, 13, 2) FFT_BT(10, 14, 4) FFT_BT(11, 15, 6)
    FFT_BT(0, 8, 0) FFT_BT(1, 9, 1) FFT_BT(2, 10, 2) FFT_BT(3, 11, 3) FFT_BT(4, 12, 4) FFT_BT(5, 13, 5) FFT_BT(6, 14, 6) FFT_BT(7, 15, 7)
}
#undef FFT_BT
constexpr int FFT_PS = 272;
constexpr int FFT_EX_ELEMS = 16 * FFT_PS;
template <class EX> HD void fft_fwd_a(c32 (&v)[16], const c32* T1, EX ex, int tid) {
    dft16_dif<-1>(v);
#pragma unroll
    for (int p = 0; p < 16; ++p) { ex[p * FFT_PS + tid] = cmul(v[BR4(p)], T1[256 * p]); if ((p & 3) == 3) __builtin_amdgcn_sched_barrier(0); }
}
template <class EX> HD void fft_fwd_b(c32 (&v)[16], const c32* T2, EX exr, EX ex, int tid) {
    const int p2 = tid >> 4, c = tid & 15;
#pragma unroll
    for (int b = 0; b < 16; ++b) v[b] = exr[p2 * FFT_PS + 16 * b + c];
    dft16_dif<-1>(v);
#pragma unroll
    for (int q = 0; q < 16; ++q) ex[p2 * FFT_PS + q * 16 + ((c + q) & 15)] = cmul(v[BR4(q)], T2[q]);
}
template <class EX> HD void fft_fwd_c(c32 (&v)[16], EX ex, int tid) {
    const int p2 = tid >> 4, q = tid & 15;
#pragma unroll
    for (int c = 0; c < 16; ++c) v[c] = ex[p2 * FFT_PS + q * 16 + ((c + q) & 15)];
    dft16_dif<-1>(v);
}
template <class EX> HD void fft_inv_a(c32 (&v)[16], EX ex, int tid) {
    const int p = tid >> 4, q = tid & 15;
    dft16_dit<+1>(v);
#pragma unroll
    for (int c = 0; c < 16; ++c) ex[p * FFT_PS + q * 16 + ((c + q) & 15)] = v[c];
}
template <class EX> HD void fft_inv_b(c32 (&v)[16], const c32* T2, EX exr, EX ex, int tid) {
    const int p = tid >> 4, c = tid & 15;
#pragma unroll
    for (int q = 0; q < 16; ++q) v[BR4(q)] = cmulc(exr[p * FFT_PS + q * 16 + ((c + q) & 15)], T2[q]);
    dft16_dit<+1>(v);
#pragma unroll
    for (int b = 0; b < 16; ++b) ex[p * FFT_PS + 16 * b + c] = v[b];
}
template <class EX> HD void fft_inv_c(c32 (&v)[16], const c32* T1, EX ex, int tid) {
#pragma unroll
    for (int p = 0; p < 16; ++p) { v[BR4(p)] = cmulc(ex[p * FFT_PS + tid], T1[256 * p]); if ((p & 3) == 3) __builtin_amdgcn_sched_barrier(0); }
    dft16_dit<+1>(v);
}
constexpr int NWAVES = 8, NTHR = 512;
constexpr int BATCH = 8, SEQ = 4096, DM = 1024, T = BATCH * SEQ;
constexpr float EPS = 1e-6f;
constexpr size_t MiB = 1u << 20;
constexpr size_t WS_CTL = 0, CTL_ZERO_BYTES = 64 * 1024;
constexpr size_t WS_MOD = 1 * MiB;
constexpr size_t WS_HDNS = 1 * MiB + 512 * 1024;
constexpr size_t WS_W4S = 3 * MiB + 512 * 1024;
constexpr size_t WS_LIST = 101 * MiB;
constexpr size_t WS_WL = 396 * MiB;
constexpr size_t WS_WD = 8 * MiB;
constexpr size_t WS_WUQ = 9 * MiB;
constexpr size_t WS_WUKV = 10 * MiB;
constexpr size_t WS_WO = 11 * MiB;
constexpr size_t WS_WIN = 13 * MiB;
constexpr size_t WS_WOUT = 19 * MiB;
constexpr size_t WS_WGU = 21 * MiB;
constexpr size_t WS_WDN = 53 * MiB;
constexpr size_t R1 = 104 * MiB;
constexpr size_t R2 = 232 * MiB;
constexpr size_t R3 = 424 * MiB;
constexpr size_t WS_VT8 = R1, WS_XN2 = R1, WS_KF = R1;
constexpr size_t WS_XN = R2, WS_O = R2;
constexpr size_t WS_LAT = R2 + 64 * MiB;
constexpr size_t WS_HACT = R2 + 64 * MiB;
constexpr size_t WS_CQN = R2 + 128 * MiB;
constexpr size_t WS_CKVN = R2 + 144 * MiB;
constexpr size_t WS_KPE = R2 + 160 * MiB;
constexpr size_t WS_K8 = R2 + 64 * MiB;
constexpr size_t WS_ROPE = R2 + 164 * MiB;
constexpr size_t WS_QRAW = 408 * MiB;
constexpr size_t WS_XN2S = 424 * MiB;
constexpr size_t WS_XR = 424 * MiB;
constexpr size_t WS_HT = R2;
constexpr size_t WS_UT = R2;
constexpr size_t WS_Z = R2;
constexpr size_t WS_END = 512 * MiB;
constexpr int MS_ROWS = T + 24 * 256;
constexpr int CW_BAR = 4096;
constexpr int CW_FILT = 12352;
constexpr int CW_CNT = 8192;
constexpr int RING_OFF = 0, RING_BYTES = 147456;
constexpr int LDSCTL_OFF = RING_BYTES;
constexpr int MISC_OFF = LDSCTL_OFF;
constexpr int TINFO_OFF = LDSCTL_OFF + 256;
constexpr int RED_OFF = LDSCTL_OFF + 256 + 1280;
constexpr int EPIX_OFF = LDSCTL_OFF + 2048;
constexpr int LDS_BYTES = 163840;
static_assert(RED_OFF + 256 <= LDS_BYTES, "LDS map");

#define GAS __attribute__((address_space(1)))
#define LAS __attribute__((address_space(3)))
typedef unsigned short bf16;
typedef unsigned v4u __attribute__((ext_vector_type(4)));
typedef unsigned v2u __attribute__((ext_vector_type(2)));
typedef int v4i __attribute__((ext_vector_type(4)));
typedef float f32x4 __attribute__((ext_vector_type(4)));
typedef GAS unsigned gu32;
#define RLX_AGENT __ATOMIC_RELAXED, __HIP_MEMORY_SCOPE_AGENT
#define LDS_WAIT() asm volatile("s_waitcnt lgkmcnt(0)" ::: "memory")
__device__ __forceinline__ unsigned pk2(float lo, float hi) { return pg8::cvt_pk_bf16(lo, hi); }
__device__ __forceinline__ float bf2f(unsigned short b) { return __uint_as_float(((unsigned)b) << 16); }
__device__ __forceinline__ float wave_sum(float v) {
#define WS_DPP(x, ctrl, rmask) __int_as_float(__builtin_amdgcn_update_dpp(0, __float_as_int(x), ctrl, rmask, 0xf, false))
    v += WS_DPP(v, 0xB1, 0xf); v += WS_DPP(v, 0x4E, 0xf); v += WS_DPP(v, 0x141, 0xf); v += WS_DPP(v, 0x140, 0xf);
    v += WS_DPP(v, 0x142, 0xa); v += WS_DPP(v, 0x143, 0xc);
#undef WS_DPP
    return __int_as_float(__builtin_amdgcn_readlane(__float_as_int(v), 63));
}

#define XB_TMO      128
#define XB_XCNT(j)  (256  + 64 * (j))
#define XB_XSUB(j)  (1280 + 64 * (j))
#define XB_XGEN(j)  (2304 + 64 * (j))
#define XB_TOP      3328
#define XB_TOPGEN   3392
#define XCD_BAR_WORDS 3456
#define XB_SPIN_CAP (1u << 18)

__device__ __forceinline__ unsigned xb_ld(unsigned* p)              { return __hip_atomic_load(p, __ATOMIC_RELAXED, __HIP_MEMORY_SCOPE_AGENT); }
__device__ __forceinline__ unsigned xb_add(unsigned* p, unsigned v) { return __hip_atomic_fetch_add(p, v, __ATOMIC_RELAXED, __HIP_MEMORY_SCOPE_AGENT); }
__device__ __forceinline__ unsigned xb_xcc_id() { return (unsigned)__builtin_amdgcn_s_getreg((3 << 11) | 20) & 0xFu; }
#define XB_SPIN(cond, bar) do { unsigned _sp = 0; while (cond) { __builtin_amdgcn_s_sleep(1); \
    if ((++_sp & 255u) == 0u) { if (xb_ld(&(bar)[XB_TMO])) break; if (_sp > XB_SPIN_CAP) { atomicAdd(&(bar)[XB_TMO], 1u); break; } } } } while (0)

struct XcdBarrier {
    unsigned* bar; unsigned x;
    volatile LAS unsigned* st;
    int w0;
};

__device__ __forceinline__ XcdBarrier xcd_barrier_post(unsigned* bar, volatile LAS unsigned* st) {
    XcdBarrier b; b.bar = bar; b.x = xb_xcc_id(); b.st = st; b.w0 = 0;
    if (threadIdx.x == 0) (void)xb_add(&bar[XB_XCNT(b.x)], 1u);
    return b;
}
__device__ __forceinline__ void xcd_barrier_complete(unsigned* bar, unsigned x, unsigned& nloc, unsigned& nx) {
    const unsigned G = gridDim.x * gridDim.y * gridDim.z;
    unsigned sum, cnt, mine, sp = 0u;
    for (;;) {
        sum = 0u; cnt = 0u; mine = 0u;
#pragma unroll
        for (unsigned j = 0; j < 16; ++j) { const unsigned c = xb_ld(&bar[XB_XCNT(j)]); sum += c; cnt += (c > 0u) ? 1u : 0u; mine = (j == x) ? c : mine; }
        if (sum == G) break;
        __builtin_amdgcn_s_sleep(1);
        if ((++sp & 255u) == 0u) { if (xb_ld(&bar[XB_TMO])) break; if (sp > XB_SPIN_CAP) { atomicAdd(&bar[XB_TMO], 1u); break; } }
    }
    nloc = mine > 0u ? mine : 1u; nx = cnt > 0u ? cnt : 1u;
}

__device__ __forceinline__ void xcd_barrier(const XcdBarrier& b) {
    asm volatile("s_waitcnt vmcnt(0)" ::: "memory");
    __syncthreads();
    if (b.w0 && __builtin_amdgcn_mbcnt_hi(~0u, __builtin_amdgcn_mbcnt_lo(~0u, 0u)) == 0u) {
        unsigned* bar = b.bar;
        __builtin_amdgcn_s_waitcnt(0);
        unsigned nloc = b.st[0], nx = b.st[1];
        if (nloc == 0u) { xcd_barrier_complete(bar, b.x, nloc, nx); b.st[0] = nloc; b.st[1] = nx; }
        const unsigned old = xb_add(&bar[XB_XSUB(b.x)], 1u);
        const unsigned gen = old / nloc;
        if (old + 1u == (gen + 1u) * nloc) {
            __builtin_amdgcn_fence(__ATOMIC_RELEASE, "agent");
            asm volatile("s_waitcnt vmcnt(0)" ::: "memory");
            const unsigned og = xb_add(&bar[XB_TOP], 1u);
            const unsigned tg = og / nx;
            if (og + 1u == (tg + 1u) * nx) xb_add(&bar[XB_TOPGEN], 1u);
            else XB_SPIN(xb_ld(&bar[XB_TOPGEN]) == tg, bar);
            __builtin_amdgcn_fence(__ATOMIC_ACQUIRE, "agent");
            xb_add(&bar[XB_XGEN(b.x)], 1u);
            asm volatile("s_waitcnt vmcnt(0)" ::: "memory");
        } else {
            XB_SPIN(xb_ld(&bar[XB_XGEN(b.x)]) == gen, bar);
            __builtin_amdgcn_fence(__ATOMIC_ACQUIRE, "agent");
            asm volatile("s_waitcnt vmcnt(0)" ::: "memory");
        }
    }
    __syncthreads();
}


struct Ctx { unsigned char* lds; int tid, lane, wave, vcu, G, gw, NGW; };

__device__ __forceinline__ void transpose_item(const float* W, int ldw, int k0, int n0, bf16* WT, int ldt, int drow0, int dcol0, float* scr, int lane, bool kpe_perm) {
    float tv[32];
#pragma unroll
    for (int i = 0; i < 32; ++i) { const int kk = 2 * i + (lane >> 5); tv[i] = W[(size_t)(k0 + kk) * ldw + n0 + (lane & 31)]; }
#pragma unroll
    for (int i = 0; i < 32; ++i) { const int kk = 2 * i + (lane >> 5); scr[kk * 33 + (lane & 31)] = tv[i]; }
    LDS_WAIT();
    const int c = lane & 7;
#pragma unroll
    for (int j = 0; j < 4; ++j) { const int n = (lane >> 3) + 8 * j; const float* s = scr + (8 * c) * 33 + n;
        v4u o; o.x = pk2(s[0 * 33], s[1 * 33]); o.y = pk2(s[2 * 33], s[3 * 33]); o.z = pk2(s[4 * 33], s[5 * 33]); o.w = pk2(s[6 * 33], s[7 * 33]);
        int dr = drow0 + n; if (kpe_perm && dr >= 384 && dr < 448) { const int e = dr - 384; dr = 384 + 32 * ((e >> 4) & 1) + 16 * (e >> 5) + (e & 15); }
        *(v4u*)(WT + (size_t)dr * ldt + dcol0 + k0 + 8 * c) = o; }
    LDS_WAIT();
}
__device__ __forceinline__ void transpose_item8(const float* W, int ldw, int k0, int n0, unsigned char* WT8, int ldt8, int drow0, int dcol0, float* scr, int lane, float scale, bool kpe_perm) {
    float tv[32];
#pragma unroll
    for (int i = 0; i < 32; ++i) { const int kk = 2 * i + (lane >> 5); tv[i] = W[(size_t)(k0 + kk) * ldw + n0 + (lane & 31)]; }
#pragma unroll
    for (int i = 0; i < 32; ++i) { const int kk = 2 * i + (lane >> 5); scr[kk * 33 + (lane & 31)] = tv[i]; }
    LDS_WAIT();
    const int n = lane >> 1, hf = lane & 1; const float* sp = scr + (32 * hf) * 33 + n;
    v4u o0, o1; unsigned w[8];
#pragma unroll
    for (int q = 0; q < 8; ++q) { int p = 0; p = __builtin_amdgcn_cvt_pk_fp8_f32(sp[(4 * q) * 33] * scale, sp[(4 * q + 1) * 33] * scale, p, false); p = __builtin_amdgcn_cvt_pk_fp8_f32(sp[(4 * q + 2) * 33] * scale, sp[(4 * q + 3) * 33] * scale, p, true); w[q] = (unsigned)p; }
    o0.x = w[0]; o0.y = w[1]; o0.z = w[2]; o0.w = w[3]; o1.x = w[4]; o1.y = w[5]; o1.z = w[6]; o1.w = w[7];
    int dr = drow0 + n; if (kpe_perm && dr >= 384 && dr < 448) { const int e = dr - 384; dr = 384 + 32 * ((e >> 4) & 1) + 16 * (e >> 5) + (e & 15); }
    unsigned char* d = WT8 + (size_t)dr * ldt8 + dcol0 + k0 + 32 * hf;
    *(v4u*)d = o0; *(v4u*)(d + 16) = o1;
    LDS_WAIT();
}
typedef __attribute__((address_space(4))) const char kchar;
struct In { int opq;
    __device__ __forceinline__ const float* operator[](int k) const { kchar* ka = (kchar*)__builtin_amdgcn_kernarg_segment_ptr(); return *(const float* const __attribute__((address_space(4)))*)(ka + 8 * k + opq); } };
__device__ __forceinline__ unsigned char* karg_ws(int opq) { kchar* ka = (kchar*)__builtin_amdgcn_kernarg_segment_ptr(); return *(unsigned char* const __attribute__((address_space(4)))*)(ka + 38 * 8 + 8 + opq); }
__device__ __forceinline__ float* karg_out(int opq) { kchar* ka = (kchar*)__builtin_amdgcn_kernarg_segment_ptr(); return *(float* const __attribute__((address_space(4)))*)(ka + 38 * 8 + opq); }

__device__ __forceinline__ void p0_prologue(const Ctx& F, const In& in, unsigned char* ws) {
    float* scr = (float*)(F.lds + RING_OFF + F.wave * 16384);
    bf16* Wd = (bf16*)(ws + WS_WD); bf16* Wuq = (bf16*)(ws + WS_WUQ); bf16* Wukv = (bf16*)(ws + WS_WUKV); bf16* Wo = (bf16*)(ws + WS_WO);
    bf16* Win = (bf16*)(ws + WS_WIN); bf16* Wout = (bf16*)(ws + WS_WOUT); bf16* Wgu = (bf16*)(ws + WS_WGU); bf16* Wdn = (bf16*)(ws + WS_WDN);
    constexpr int I_D = 16 * 14, I_UQ = 4 * 48, I_UKV = 2 * 64, I_O = 16 * 32, I_IN = 16 * 96, I_OUT = 16 * 32, I_GU = 2 * 16 * 2 * (16 * 8), I_DN = 2 * 24 * 2 * (4 * 32);
    constexpr int NITEMS = I_D + I_UQ + I_UKV + I_O + I_IN + I_OUT + I_GU + I_DN;
    for (int it = F.gw; it < NITEMS; it += F.NGW) {
        int r = it; const float* W; int ldw, k0, n0, ldt, drow0, dcol0 = 0; bf16* WT; float f8s = 0.f;
        if (r < I_D) { W = in[7]; ldw = 448; k0 = (r / 14) * 64; n0 = (r % 14) * 32; WT = Wd; ldt = 1024; drow0 = n0; f8s = 32.f; }
        else if ((r -= I_D) < I_UQ) { W = in[10]; ldw = 1536; k0 = (r / 48) * 64; n0 = (r % 48) * 32; WT = Wuq; ldt = 256; drow0 = n0; f8s = 16.f; }
        else if ((r -= I_UQ) < I_UKV) { W = in[11]; ldw = 2048; k0 = (r / 64) * 64; n0 = (r % 64) * 32; ldt = 128;
            WT = Wukv + ((n0 & 128) ? 1024 * 128 : 0); drow0 = (n0 >> 8) * 128 + (n0 & 127); }
        else if ((r -= I_UKV) < I_O) { W = in[14]; ldw = 1024; k0 = (r / 32) * 64; n0 = (r % 32) * 32; WT = Wo; ldt = 1024; drow0 = n0; f8s = 32.f; }
        else if ((r -= I_O) < I_IN) { W = in[15]; ldw = 3072; k0 = (r / 96) * 64; n0 = (r % 96) * 32; WT = Win; ldt = 1024; drow0 = n0; }
        else if ((r -= I_IN) < I_OUT) { W = in[30]; ldw = 1024; k0 = (r / 32) * 64; n0 = (r % 32) * 32; WT = Wout; ldt = 1024; drow0 = n0; }
        else if ((r -= I_OUT) < I_GU) {
            const int sub = r % 128, mat = r / 128, which = mat & 1, le = mat >> 1;
            W = (which ? in[36] : in[35]) + (size_t)le * 1024 * 256; ldw = 256; k0 = (sub / 8) * 64; n0 = (sub % 8) * 32;
            WT = (bf16*)((unsigned char*)Wgu + (size_t)le * 512 * 1024); ldt = 1024; drow0 = (n0 >> 7) * 256 + which * 128 + (n0 & 127); f8s = 32.f; }
        else { r -= I_GU;
            const int sub = r % 128, mat = r / 128, slot = mat & 1, lb = mat >> 1, layer = lb / 24, bk = lb % 24;
            int ii, jj; pg8::pair_of(bk % 6, ii, jj); const int e = (bk / 6) * 4 + (slot ? jj : ii);
            W = in[37] + (size_t)(layer * 16 + e) * 256 * 1024; ldw = 1024; k0 = (sub / 32) * 64; n0 = (sub % 32) * 32;
            WT = (bf16*)((unsigned char*)Wdn + (size_t)lb * 1024 * 512); ldt = 512; drow0 = n0; dcol0 = slot * 256; f8s = 32.f; }
        if (f8s != 0.f) transpose_item8(W, ldw, k0, n0, (unsigned char*)WT, ldt, drow0, dcol0, scr, F.lane, f8s, it < I_D);
        else transpose_item(W, ldw, k0, n0, WT, ldt, drow0, dcol0, scr, F.lane, it < I_D);
    }
    { const int gt = F.vcu * NTHR + F.tid, NGT = F.G * NTHR; const v4u z = {0u, 0u, 0u, 0u};
      for (int i = gt; i < 64 * 1024 / 16; i += NGT) *(v4u*)((unsigned char*)Wd + (size_t)448 * 1024 + (size_t)i * 16) = z;
    }
    { const int gt = F.vcu * NTHR + F.tid, NGT = F.G * NTHR; float* RT = (float*)(ws + WS_ROPE); const int* posi = (const int*)in[2];
      const float inv = __builtin_amdgcn_exp2f(-0.41524101186092029f * (float)(gt & 31));
      for (int i = gt; i < T * 32; i += NGT) { const int t = i >> 5;
        float sn, cs; sincosf((float)posi[t] * inv, &sn, &cs); *(v2u*)(RT + (size_t)i * 2) = (v2u){__float_as_uint(cs), __float_as_uint(sn)}; } }
    { const int gt = F.vcu * NTHR + F.tid, NGT = F.G * NTHR; bf16* W4S = (bf16*)(ws + WS_W4S); const float* w4 = in[28];
      for (int i = gt; i < 4096 * 8; i += NGT) { const int col = i & 4095, oct = i >> 12; float w[8];
#pragma unroll
        for (int q = 0; q < 8; ++q) w[q] = w4[(size_t)(8 * oct + q) * 4096 + col];
        unsigned hw[4], lw[4];
#pragma unroll
        for (int q = 0; q < 4; ++q) { const unsigned h2 = pk2(w[2 * q], w[2 * q + 1]); hw[q] = h2;
          lw[q] = pk2(w[2 * q] - __uint_as_float(h2 << 16), w[2 * q + 1] - __uint_as_float(h2 & 0xffff0000u)); }
        bf16* d = W4S + (size_t)col * 256 + 8 * oct; const v4u hv = {hw[0], hw[1], hw[2], hw[3]}, lv = {lw[0], lw[1], lw[2], lw[3]}, zv = {0u, 0u, 0u, 0u};
        *(v4u*)d = hv; *(v4u*)(d + 64) = hv; *(v4u*)(d + 128) = lv; *(v4u*)(d + 192) = zv; } }
    __syncthreads();
    { bf16* HDp = (bf16*)(ws + WS_HDNS); float* wl = (float*)(F.lds + RING_OFF); float* sv = wl + 161 * 64 + F.wave * 64;
      for (int i = F.tid; i < 161 * 64; i += NTHR) wl[i] = i < 33 * 64 ? in[19][i] : (i < 97 * 64 ? in[22][i - 33 * 64] : in[25][i - 97 * 64]);
      __syncthreads();
      const int j = F.lane; const float b1 = in[20][j], f1 = in[21][j], b2 = in[23][j], f2 = in[24][j], b3 = in[26][j], f3 = in[27][j];
      for (int t = F.gw; t < 4096; t += F.NGW) {
        float zf = 0.f;
        { const float w = 6.2831855f * (float)t * (1.f / 4096.f);
          if (j == 0) zf = (float)t / 4095.f;
          else if (j <= 16) { const float fr = 1e-4f + (float)(j - 1) * ((15.f - 1e-4f) / 15.f); zf = cosf(fr * w); }
          else if (j <= 32) { const float fr = 1e-4f + (float)(j - 17) * ((15.f - 1e-4f) / 15.f); zf = -sinf(fr * w); } }
        sv[j] = zf; LDS_WAIT();
        float a = b1;
#pragma unroll
        for (int k = 0; k < 33; ++k) a += sv[k] * wl[k * 64 + j];
        float h = sinf(f1 * a); LDS_WAIT(); sv[j] = h; LDS_WAIT();
        a = b2;
#pragma unroll 16
        for (int k = 0; k < 64; ++k) a += sv[k] * wl[(33 + k) * 64 + j];
        h = sinf(f2 * a); LDS_WAIT(); sv[j] = h; LDS_WAIT();
        a = b3;
#pragma unroll 16
        for (int k = 0; k < 64; ++k) a += sv[k] * wl[(97 + k) * 64 + j];
        h = sinf(f3 * a); LDS_WAIT();
        const unsigned hi = pk2(h, 0.f) & 0xffffu; const float lo = h - bf2f((unsigned short)hi); const unsigned lob = pk2(lo, 0.f) & 0xffffu;
        bf16* d = HDp + (size_t)t * 256 + j; d[0] = (bf16)hi; d[64] = (bf16)lob; d[128] = (bf16)hi; d[192] = 0;
      } }
    __syncthreads();
    { float* cact = (float*)(F.lds + RING_OFF); float* red = cact + 8 * 1024;
      float* MOD = (float*)(ws + WS_MOD);
      for (int i = F.tid; i < 8 * 1024; i += NTHR) { const float x = in[1][i]; cact[(i & 1023) * 8 + (i >> 10)] = x / (1.f + __expf(-x)); }
      __syncthreads();
      for (int it = F.vcu; it < 2 * 96; it += F.G) {
        const int layer = it / 96, cb = it - 96 * layer, r4 = F.lane >> 4, cq = F.lane & 15;
        const float* W = in[3] + (size_t)layer * 1024 * 6144 + cb * 64 + 4 * cq + (size_t)(F.wave * 128 + r4) * 6144;
        f32x4 acc[8];
#pragma unroll
        for (int b = 0; b < 8; ++b) acc[b] = (f32x4){0.f, 0.f, 0.f, 0.f};
#pragma unroll
        for (int hf = 0; hf < 2; ++hf) { f32x4 wv[16];
#pragma unroll
          for (int q = 0; q < 16; ++q) wv[q] = *(const f32x4*)(W + (size_t)(4 * (16 * hf + q)) * 6144);
#pragma unroll
          for (int q = 0; q < 16; ++q) { const int kk = 4 * (16 * hf + q) + r4; const float* cp = cact + (F.wave * 128 + kk) * 8; const f32x4 c0 = *(const f32x4*)cp, c1 = *(const f32x4*)(cp + 4);
#pragma unroll
            for (int b = 0; b < 8; ++b) acc[b] += (b < 4 ? c0[b & 3] : c1[b & 3]) * wv[q]; } }
#pragma unroll
        for (int b = 0; b < 8; ++b) *(f32x4*)(red + ((F.wave * 4 + r4) * 8 + b) * 64 + 4 * cq) = acc[b];
        __syncthreads();
        { const int b = F.tid >> 6, col = F.tid & 63; float s = in[4][layer * 6144 + cb * 64 + col];
#pragma unroll 8
          for (int p = 0; p < 32; ++p) s += red[(p * 8 + b) * 64 + col];
          MOD[((size_t)layer * 8 + b) * 6144 + cb * 64 + col] = s; }
        __syncthreads();
      } }
}

template <class TX> __device__ __forceinline__ f32x4 ldrow4(const TX* p);
template <> __device__ __forceinline__ f32x4 ldrow4<float>(const float* p) { return *(const __attribute__((address_space(1))) f32x4*)p; }
template <> __device__ __forceinline__ f32x4 ldrow4<bf16>(const bf16* p) { const v2u w = *(const __attribute__((address_space(1))) v2u*)p; f32x4 r; r[0] = __uint_as_float(w.x << 16); r[1] = __uint_as_float(w.x & 0xffff0000u); r[2] = __uint_as_float(w.y << 16); r[3] = __uint_as_float(w.y & 0xffff0000u); return r; }
template <class TX, bool OUT8 = false> __device__ __forceinline__ void norm_mod_phase(const Ctx& F, const TX* X, const float* g, const float* sc, const float* sh, bf16* OUT) {
    for (int ch = F.gw; ch < T / 16; ch += F.NGW) {
        const int r0 = ch * 16, b = r0 >> 12;
        f32x4 A[4], S[4];
#pragma unroll
        for (int j = 0; j < 4; ++j) { const int col = 4 * F.lane + 256 * j; const f32x4 gv = *(const f32x4*)(g + col), sv = *(const f32x4*)(sc + (size_t)b * 6144 + col); A[j] = gv * (1.f + sv); S[j] = *(const f32x4*)(sh + (size_t)b * 6144 + col); }
        const TX* xr = X + (size_t)r0 * DM + 4 * F.lane;
        f32x4 nx[4];
#pragma unroll
        for (int j = 0; j < 4; ++j) nx[j] = ldrow4<TX>(xr + 256 * j);
        for (int rr = 0; rr < 16; ++rr) {
            f32x4 v[4]; float ss = 0.f;
#pragma unroll
            for (int j = 0; j < 4; ++j) { v[j] = nx[j]; ss += (v[j].x * v[j].x + v[j].y * v[j].y) + (v[j].z * v[j].z + v[j].w * v[j].w); }
            if (rr < 15) {
#pragma unroll
                for (int j = 0; j < 4; ++j) nx[j] = ldrow4<TX>(xr + (size_t)(rr + 1) * DM + 256 * j); }
            const float rstd = rsqrtf(wave_sum(ss) * (1.f / DM) + EPS);
            if constexpr (OUT8) { unsigned char* orow = (unsigned char*)OUT + (size_t)(r0 + rr) * DM + 4 * F.lane;
#pragma unroll
                for (int j = 0; j < 4; ++j) { const f32x4 o = v[j] * rstd * A[j] + S[j]; int p = 0; p = __builtin_amdgcn_cvt_pk_fp8_f32(o.x, o.y, p, false); p = __builtin_amdgcn_cvt_pk_fp8_f32(o.z, o.w, p, true); *(int*)(orow + 256 * j) = p; } }
            else { bf16* orow = OUT + (size_t)(r0 + rr) * DM + 4 * F.lane;
#pragma unroll
                for (int j = 0; j < 4; ++j) { const f32x4 o = v[j] * rstd * A[j] + S[j]; v2u w; w.x = pk2(o.x, o.y); w.y = pk2(o.z, o.w); *(v2u*)(orow + 256 * j) = w; } } }
    }
}

__device__ __forceinline__ void lat_post_phase(const Ctx& F, const float* LAT, const float* qag, const float* kvag, const float* kng, const float* rope, bf16* CQN, bf16* CKVN, bf16* KPE) {
    const int l = F.lane;
    const f32x4 gq = *(const f32x4*)(qag + 4 * l);
    const f32x4 g2 = l < 32 ? *(const f32x4*)(kvag + 4 * l) : (l < 48 ? *(const f32x4*)(kng + 128 + 4 * (l - 32)) : (f32x4){0.f, 0.f, 0.f, 0.f});
    f32x4 na = *(const f32x4*)(LAT + (size_t)F.gw * 512 + 4 * l), nc = l < 48 ? *(const f32x4*)(LAT + (size_t)F.gw * 512 + 256 + 4 * l) : (f32x4){0.f, 0.f, 0.f, 0.f};
    for (int row = F.gw; row < T; row += F.NGW) {
        const f32x4 a = na, c = nc;
        if (row + F.NGW < T) { const float* nr = LAT + (size_t)(row + F.NGW) * 512; na = *(const f32x4*)(nr + 4 * l); if (l < 48) nc = *(const f32x4*)(nr + 256 + 4 * l); }
        const float sq = (a.x * a.x + a.y * a.y) + (a.z * a.z + a.w * a.w), sc = (c.x * c.x + c.y * c.y) + (c.z * c.z + c.w * c.w);
        const float s_q = wave_sum(sq), s_kv = wave_sum(l < 32 ? sc : 0.f), s_pe = wave_sum((l >= 32 && l < 48) ? sc : 0.f);
        const float rq = rsqrtf(s_q * (1.f / 256.f) + EPS), rkv = rsqrtf(s_kv * (1.f / 128.f) + EPS), rpe = rsqrtf(s_pe * (1.f / 64.f) + EPS);
        { const f32x4 o = a * rq * gq; v2u w; w.x = pk2(o.x, o.y); w.y = pk2(o.z, o.w); *(v2u*)(CQN + (size_t)row * 256 + 4 * l) = w; }
        if (l < 32) { const f32x4 o = c * rkv * g2; v2u w; w.x = pk2(o.x, o.y); w.y = pk2(o.z, o.w); *(v2u*)(CKVN + (size_t)row * 256 + 4 * l) = w; }
        else { v2u w; w.x = 0u; w.y = 0u; *(v2u*)(CKVN + (size_t)row * 256 + 128 + 4 * (l - 32)) = w; }
        const f32x4 n = c * rpe * g2;
        f32x4 other; other.x = __shfl_xor(n.x, 8); other.y = __shfl_xor(n.y, 8); other.z = __shfl_xor(n.z, 8); other.w = __shfl_xor(n.w, 8);
        if (l >= 32 && l < 48) { const bool first = l < 40; const int e0 = 4 * ((l - 32) & 7);
            float o[4];
#pragma unroll
            for (int i = 0; i < 4; ++i) { const int e = e0 + i; const float cs = rope[(size_t)row * 64 + e * 2], sn = rope[(size_t)row * 64 + e * 2 + 1];
                const float mine = n[i], oth = other[i]; o[i] = first ? (mine * cs - oth * sn) : (oth * sn + mine * cs); }
            v2u w; w.x = pk2(o[0], o[1]); w.y = pk2(o[2], o[3]); *(v2u*)(KPE + (size_t)row * 64 + 4 * (l - 32)) = w; }
    }
}

__device__ __forceinline__ void knorm_phase(const Ctx& F, bf16* KV, const float* kng) {
    const int l = F.lane, h = l >> 3, e0 = (l & 7) * 16;
    float g[16];
#pragma unroll
    for (int i = 0; i < 16; ++i) g[i] = kng[e0 + i];
    for (int row = F.gw; row < T; row += F.NGW) {
        bf16* p = KV + (size_t)row * 2048 + h * 256 + e0;
        const v4u r0 = *(const v4u*)p, r1 = *(const v4u*)(p + 8);
        float f[16]; const unsigned w[8] = {r0.x, r0.y, r0.z, r0.w, r1.x, r1.y, r1.z, r1.w};
        float ss = 0.f;
#pragma unroll
        for (int i = 0; i < 8; ++i) { f[2 * i] = __uint_as_float(w[i] << 16); f[2 * i + 1] = __uint_as_float(w[i] & 0xffff0000u); ss += f[2 * i] * f[2 * i] + f[2 * i + 1] * f[2 * i + 1]; }
        ss += __shfl_xor(ss, 1); ss += __shfl_xor(ss, 2); ss += __shfl_xor(ss, 4);
        const float r = rsqrtf(ss * (1.f / 128.f) + EPS);
        v4u o0, o1;
        o0.x = pk2(f[0] * r * g[0], f[1] * r * g[1]); o0.y = pk2(f[2] * r * g[2], f[3] * r * g[3]); o0.z = pk2(f[4] * r * g[4], f[5] * r * g[5]); o0.w = pk2(f[6] * r * g[6], f[7] * r * g[7]);
        o1.x = pk2(f[8] * r * g[8], f[9] * r * g[9]); o1.y = pk2(f[10] * r * g[10], f[11] * r * g[11]); o1.z = pk2(f[12] * r * g[12], f[13] * r * g[13]); o1.w = pk2(f[14] * r * g[14], f[15] * r * g[15]);
        *(v4u*)p = o0; *(v4u*)(p + 8) = o1;
    }
}

__device__ __forceinline__ void route_phase(const Ctx& F, const bf16* X, const float* g, const float* sc, const float* sh, const float* wg, const float* bg, const float* we, const float* be,
                                            bf16* XN2, int* LIST, float* WL, gu32* cnt) {
    float* W20 = (float*)(F.lds + RING_OFF); constexpr int W20P = 1028;
    unsigned* lcnt = (unsigned*)(F.lds + RED_OFF); unsigned* gbase = lcnt + 32;
    if (F.tid < 24) lcnt[F.tid] = 0u;
    for (int i = F.tid; i < 4 * 1024; i += NTHR) W20[(i & 3) * W20P + (i >> 2)] = wg[i];
    for (int i = F.tid; i < 16 * 1024; i += NTHR) W20[(4 + (i & 15)) * W20P + (i >> 4)] = we[i];
    __syncthreads();
    float bgv[4];
#pragma unroll
    for (int i = 0; i < 4; ++i) bgv[i] = bg[i];
    for (int ch0 = 0; ch0 < T / 16; ch0 += F.NGW) {
        const int ch = ch0 + F.gw; const bool act = ch < T / 16; const int r0 = (act ? ch : 0) * 16, b = r0 >> 12;
        f32x4 A[4], S[4];
#pragma unroll
        for (int j = 0; j < 4; ++j) { const int col = 4 * F.lane + 256 * j; const f32x4 gv = *(const f32x4*)(g + col), sv = *(const f32x4*)(sc + (size_t)b * 6144 + col); A[j] = gv * (1.f + sv); S[j] = *(const f32x4*)(sh + (size_t)b * 6144 + col); }
        const bf16* xr = X + (size_t)r0 * DM + 4 * F.lane;
        f32x4 nx[2][4];
#pragma unroll
        for (int u = 0; u < 2; ++u)
#pragma unroll
            for (int j = 0; j < 4; ++j) nx[u][j] = ldrow4<bf16>(xr + (size_t)u * DM + 256 * j);
        int my_bk = 0; float my_wlo = 0.f, my_whi = 0.f;
        for (int rr = 0; rr < 16; rr += 2) {
            f32x4 v[2][4]; float ss[2];
#pragma unroll
            for (int u = 0; u < 2; ++u) { ss[u] = 0.f;
#pragma unroll
                for (int j = 0; j < 4; ++j) { v[u][j] = nx[u][j]; ss[u] += (v[u][j].x * v[u][j].x + v[u][j].y * v[u][j].y) + (v[u][j].z * v[u][j].z + v[u][j].w * v[u][j].w); } }
            if (rr < 14) {
#pragma unroll
                for (int u = 0; u < 2; ++u)
#pragma unroll
                    for (int j = 0; j < 4; ++j) nx[u][j] = ldrow4<bf16>(xr + (size_t)(rr + 2 + u) * DM + 256 * j); }
            float gl[2][4]; int gi[2]; float gm[2];
#pragma unroll
            for (int u = 0; u < 2; ++u) { const int row = r0 + rr + u;
                const float rstd = rsqrtf(wave_sum(ss[u]) * (1.f / DM) + EPS);
                unsigned char* orow = (unsigned char*)XN2 + (size_t)row * DM + 4 * F.lane;
#pragma unroll
                for (int j = 0; j < 4; ++j) { v[u][j] = v[u][j] * rstd * A[j] + S[j]; int p = 0; p = __builtin_amdgcn_cvt_pk_fp8_f32(v[u][j].x, v[u][j].y, p, false); p = __builtin_amdgcn_cvt_pk_fp8_f32(v[u][j].z, v[u][j].w, p, true); *(int*)(orow + 256 * j) = p; }
#pragma unroll
                for (int o = 0; o < 4; ++o) { float a = 0.f;
#pragma unroll
                    for (int j = 0; j < 4; ++j) { const f32x4 w = *(const f32x4*)(W20 + o * W20P + 4 * F.lane + 256 * j); a += (v[u][j].x * w.x + v[u][j].y * w.y) + (v[u][j].z * w.z + v[u][j].w * w.w); }
                    gl[u][o] = wave_sum(a) + bgv[o]; }
                int g_ = 0; float m_ = gl[u][0]; if (gl[u][1] > m_) { m_ = gl[u][1]; g_ = 1; } if (gl[u][2] > m_) { m_ = gl[u][2]; g_ = 2; } if (gl[u][3] > m_) { m_ = gl[u][3]; g_ = 3; }
                gi[u] = __builtin_amdgcn_readfirstlane(g_); gm[u] = m_; }
#pragma unroll
            for (int u = 0; u < 2; ++u) {
                const float gw_ = __builtin_amdgcn_rcpf(__expf(gl[u][0] - gm[u]) + __expf(gl[u][1] - gm[u]) + __expf(gl[u][2] - gm[u]) + __expf(gl[u][3] - gm[u]));
                const float* We = W20 + (4 + 4 * gi[u]) * W20P + 4 * F.lane;
                float e[4];
#pragma unroll
                for (int k = 0; k < 4; ++k) { float a = 0.f;
#pragma unroll
                    for (int j = 0; j < 4; ++j) { const f32x4 w = *(const f32x4*)(We + k * W20P + 256 * j); a += (v[u][j].x * w.x + v[u][j].y * w.y) + (v[u][j].z * w.z + v[u][j].w * w.w); }
                    e[k] = wave_sum(a) + be[4 * gi[u] + k]; }
                int i1 = 0; float m1 = e[0];
#pragma unroll
                for (int k = 1; k < 4; ++k) if (e[k] > m1) { m1 = e[k]; i1 = k; }
                int i2 = -1; float m2 = -3.0e38f;
#pragma unroll
                for (int k = 0; k < 4; ++k) if (k != i1 && e[k] > m2) { m2 = e[k]; i2 = k; }
                const float t2 = __expf(m2 - m1), w1 = gw_ * __builtin_amdgcn_rcpf(1.f + t2), w2 = w1 * t2;
                const int ilo = i1 < i2 ? i1 : i2, ihi = i1 < i2 ? i2 : i1; const float wlo = i1 < i2 ? w1 : w2, whi = i1 < i2 ? w2 : w1;
                const int pi = ilo == 0 ? ihi - 1 : (ilo == 1 ? ihi + 1 : 5), bk = gi[u] * 6 + pi;
                if (F.lane == rr + u) { my_bk = bk; my_wlo = wlo; my_whi = whi; }
            }
        }
        unsigned rank = 0u; if (F.lane < 16 && act) rank = __hip_atomic_fetch_add(lcnt + my_bk, 1u, __ATOMIC_RELAXED, __HIP_MEMORY_SCOPE_WORKGROUP);
        __syncthreads();
        if (F.tid < 24) { const unsigned n = lcnt[F.tid]; gbase[F.tid] = n ? __hip_atomic_fetch_add(cnt + F.tid * 64, n, RLX_AGENT) : 0u; }
        __syncthreads();
        if (F.lane < 16 && act) { const unsigned pos = gbase[my_bk] + rank;
            LIST[my_bk * 32768 + pos] = r0 + F.lane; float2 ww; ww.x = my_wlo; ww.y = my_whi; *(float2*)(WL + ((size_t)my_bk * 32768 + pos) * 2) = ww; }
        __syncthreads();
        if (F.tid < 24) lcnt[F.tid] = 0u;
        __syncthreads();
    }
}
__device__ __forceinline__ void moe_table(const Ctx& F, const gu32* cnt) {
    int* tinfo = (int*)(F.lds + TINFO_OFF);
    __syncthreads();
    if (F.tid == 0) { int nt = 0;
        for (int b = 0; b < 24; ++b) { const int c = (int)__hip_atomic_load(cnt + b * 64, RLX_AGENT); const int tiles = (c + 255) >> 8;
            tinfo[256 + b] = nt * 256; tinfo[288 + b] = c; for (int i = 0; i < tiles; ++i) tinfo[1 + nt + i] = b; nt += tiles; }
        tinfo[0] = nt; }
    __syncthreads();
}
__device__ __forceinline__ void permute_phase(const Ctx& F, const bf16* XN2, const int* ROUTE, bf16* XN2S, int* TOKW) {
    const int* tinfo = (const int*)(F.lds + TINFO_OFF);
    for (int ch = F.gw; ch < T / 4; ch += F.NGW) {
        v4i r[4]; v4u a[4], bq[4];
#pragma unroll
        for (int i = 0; i < 4; ++i) { const int row = ch * 4 + i; r[i] = *(const v4i*)(ROUTE + (size_t)row * 4);
            a[i] = *(const v4u*)(XN2 + (size_t)row * DM + 8 * F.lane); bq[i] = *(const v4u*)(XN2 + (size_t)row * DM + 512 + 8 * F.lane); }
#pragma unroll
        for (int i = 0; i < 4; ++i) { const int row = ch * 4 + i, srow = tinfo[256 + r[i].x] + r[i].y;
            *(v4u*)(XN2S + (size_t)srow * DM + 8 * F.lane) = a[i]; *(v4u*)(XN2S + (size_t)srow * DM + 512 + 8 * F.lane) = bq[i];
            if (F.lane == 0) { v4i w; w.x = row; w.y = r[i].z; w.z = r[i].w; w.w = 0; *(v4i*)(TOKW + (size_t)srow * 4) = w; } }
    }
}

constexpr float W32C[16] = {1.f, 0.98078528040323043f, 0.92387953251128674f, 0.83146961230254524f, 0.70710678118654752f, 0.55557023301960218f, 0.38268343236508977f, 0.19509032201612825f,
                            0.f, -0.19509032201612825f, -0.38268343236508977f, -0.55557023301960218f, -0.70710678118654752f, -0.83146961230254524f, -0.92387953251128674f, -0.98078528040323043f};
constexpr float W32S[16] = {0.f, 0.19509032201612825f, 0.38268343236508977f, 0.55557023301960218f, 0.70710678118654752f, 0.83146961230254524f, 0.92387953251128674f, 0.98078528040323043f,
                            1.f, 0.98078528040323043f, 0.92387953251128674f, 0.83146961230254524f, 0.70710678118654752f, 0.55557023301960218f, 0.38268343236508977f, 0.19509032201612825f};
struct FftTw { const c32* T1; c32 tob; const c32* T2; };
template <int A> __device__ __forceinline__ c32 mul_to(c32 x, c32 tob) { const c32 y = cmul(x, tob); return cmk(y.x * W32C[A] + y.y * W32S[A], y.y * W32C[A] - y.x * W32S[A]); }
template <int A> __device__ __forceinline__ c32 mul_toc(c32 x, c32 tob) { const c32 y = cmulc(x, tob); return cmk(y.x * W32C[A] - y.y * W32S[A], y.y * W32C[A] + y.x * W32S[A]); }
#define TO_ALL(OP) OP(0) OP(1) OP(2) OP(3) OP(4) OP(5) OP(6) OP(7) OP(8) OP(9) OP(10) OP(11) OP(12) OP(13) OP(14) OP(15)
__device__ __forceinline__ void fft_twiddles(FftTw& W, int gt, c32* t1tab, c32* t2tab, int tid) {
    if (tid < 256) { float s, c; sincosf(-6.283185307179586f * (float)(((tid >> 4) * (tid & 15)) & 255) * (1.f / 256.f), &s, &c); t2tab[(tid >> 4) * 17 + (tid & 15)] = cmk(c, s); }
    for (int i = tid; i < 4096; i += NTHR) { const int p = i >> 8, t = i & 255; float s, c; sincosf(-6.283185307179586f * (float)((t * p) & 4095) * (1.f / 4096.f), &s, &c); t1tab[i] = cmk(c, s); }
    { float s, c; sincosf(-6.283185307179586f * (float)gt * (1.f / 8192.f), &s, &c); W.tob = cmk(c, s); }
    W.T1 = t1tab + gt; W.T2 = t2tab + (gt & 15) * 17;
    __syncthreads();
}
__device__ __forceinline__ void fft_forward_a(c32 (&v)[16], const FftTw& W, c32* ex, int gt) {
    __syncthreads();
    fft_fwd_a(v, W.T1, ex, gt);
    __syncthreads();
}
__device__ __forceinline__ void fft_forward_bc(c32 (&v)[16], const FftTw& W, c32* ex, int gt) {
    fft_fwd_b(v, W.T2, ex, ex, gt);
    __builtin_amdgcn_wave_barrier(); asm volatile("" ::: "memory");
    fft_fwd_c(v, ex, gt);
}
__device__ __forceinline__ void fft_forward(c32 (&v)[16], const FftTw& W, c32* ex, int gt) { fft_forward_a(v, W, ex, gt); fft_forward_bc(v, W, ex, gt); }
__device__ __forceinline__ void fft_inverse(c32 (&v)[16], const FftTw& W, c32* ex, int gt) {
    __builtin_amdgcn_wave_barrier(); asm volatile("" ::: "memory");
    fft_inv_a(v, ex, gt);
    __builtin_amdgcn_wave_barrier(); asm volatile("" ::: "memory");
    fft_inv_b(v, W.T2, ex, ex, gt);
    __syncthreads();
    fft_inv_c(v, W.T1, ex, gt);
}
__device__ __forceinline__ void filter_phase(const Ctx& F, const float* HT, const float* fbias, c32* KF, gu32* claim, int max_items) {
    const int g = __builtin_amdgcn_readfirstlane(F.tid >> 8), gt = F.tid & 255;
    c32* ex = (c32*)(F.lds + RING_OFF + g * 36864);
    float* rev = (float*)ex;
    float* red = (float*)(F.lds + RED_OFF);
    FftTw W; fft_twiddles(W, gt, (c32*)(F.lds + RING_OFF + 73728), (c32*)(F.lds + RING_OFF + 110592), F.tid);
    int* dsl = (int*)(F.lds + RED_OFF) + 60;
    for (int n = 0; n < max_items; ++n) {
        __syncthreads();
        if (F.tid == 0) *dsl = (int)__hip_atomic_fetch_add(claim, 1u, RLX_AGENT);
        __syncthreads();
        const int d = *dsl; if (d >= DM) break;
        int gtv = gt; asm volatile("" : "+v"(gtv));
        const float delta = fabsf(-120.39728043259361f + (float)d * ((40.546510810816436f + 120.39728043259361f) / 1023.f));
        const float* hfp = HT + (size_t)(g * 2048 + d) * 4096; const float* hbp = HT + (size_t)(g * 2048 + 1024 + d) * 4096;
        float hf[16], hb[16]; float sf = 0.f, sb = 0.f;
#pragma unroll
        for (int a = 0; a < 16; ++a) { const int t = 256 * a + gtv; const float dec = __expf(-((float)t * (1.f / 4095.f)) * delta); hf[a] = hfp[t] * dec; hb[a] = hbp[t] * dec; sf += fabsf(hf[a]); sb += fabsf(hb[a]); }
        sf = wave_sum(sf); sb = wave_sum(sb);
        __syncthreads();
        if (F.lane == 0) { red[F.wave * 2] = sf; red[F.wave * 2 + 1] = sb; }
        __syncthreads();
        sf = red[g * 8] + red[g * 8 + 2] + red[g * 8 + 4] + red[g * 8 + 6]; sb = red[g * 8 + 1] + red[g * 8 + 3] + red[g * 8 + 5] + red[g * 8 + 7];
        const float nf = 1.f / (sf + EPS) * (1.f / 8192.f), nb = 1.f / (sb + EPS) * (1.f / 8192.f);
#pragma unroll
        for (int a = 0; a < 16; ++a) rev[256 * a + gt] = hb[a] * nb;
        __syncthreads();
        c32 v[16];
#pragma unroll
        for (int a = 0; a < 16; ++a) { const int n = 256 * a + gt; hb[a] = n == 0 ? 0.f : rev[4096 - n]; hf[a] *= nf; v[a] = cmk(hf[a] + hb[a], 0.f); }
        fft_forward(v, W, ex, gt);
        c32* kf = KF + ((size_t)(d * 2 + g) * 2) * 4096; const float fb = fbias[g * 1024 + d] * (1.f / 4096.f);
#pragma unroll
        for (int i = 0; i < 16; ++i) kf[i * 256 + gtv] = cmk(v[i].x + fb, v[i].y);
#define OPX(A) v[A] = mul_to<A>(cmk(hf[A] - hb[A], 0.f), W.tob);
        TO_ALL(OPX)
#undef OPX
        fft_forward(v, W, ex, gt);
#pragma unroll
        for (int i = 0; i < 16; ++i) kf[4096 + i * 256 + gtv] = v[i];
    }
}
__device__ __forceinline__ void long_conv(c32 (&z)[16], const c32* kf, const FftTw& W, c32* ex, int gt) {
    typedef float f32x2v __attribute__((ext_vector_type(2))); typedef __attribute__((address_space(1))) const f32x2v gc32;
    c32 v[16], k[16]; int gk = gt; asm volatile("" : "+v"(gk));
#define OPX(A) v[A] = mul_to<A>(z[A], W.tob);
    TO_ALL(OPX)
#undef OPX
    fft_forward_a(v, W, ex, gt);
    asm volatile("" ::: "memory");
#pragma unroll
    for (int i = 0; i < 16; ++i) { const f32x2v t_ = ((gc32*)kf)[4096 + i * 256 + gk]; k[i] = cmk(t_.x, t_.y); }
    fft_forward_bc(v, W, ex, gt);
#pragma unroll
    for (int i = 0; i < 16; ++i) v[i] = cmul(v[i], k[i]);
    fft_inverse(v, W, ex, gt);
#define OPX(A) v[A] = mul_toc<A>(v[A], W.tob);
    TO_ALL(OPX)
#undef OPX
    fft_forward_a(z, W, ex, gt);
    asm volatile("" ::: "memory");
#pragma unroll
    for (int i = 0; i < 16; ++i) { const f32x2v t_ = ((gc32*)kf)[i * 256 + gk]; k[i] = cmk(t_.x, t_.y); }
    fft_forward_bc(z, W, ex, gt);
#pragma unroll
    for (int i = 0; i < 16; ++i) z[i] = cmul(z[i], k[i]);
    fft_inverse(z, W, ex, gt);
#pragma unroll
    for (int a = 0; a < 16; ++a) z[a] = cadd(z[a], v[a]);
}
struct RawSeq { v4u r[2][2]; };
__device__ __forceinline__ void raw_issue(RawSeq& q, const bf16* urow, int b0, int gt) {
    typedef __attribute__((address_space(1))) const v4u gv4u;
    asm volatile("" : "+v"(gt));
#pragma unroll
    for (int s_ = 0; s_ < 2; ++s_)
#pragma unroll
        for (int i = 0; i < 2; ++i) q.r[s_][i] = *(gv4u*)(urow + (size_t)(b0 + s_) * SEQ + (gt + 256 * i) * 8);
}
__device__ __forceinline__ void stage_conv3(c32 (&o)[16], const RawSeq& q, float w0, float w1, float w2, float cb, bf16* stg, int gt) {
    constexpr int SS = 4112;
    __syncthreads();
#pragma unroll
    for (int s_ = 0; s_ < 2; ++s_) {
#pragma unroll
        for (int i = 0; i < 2; ++i) *(v4u*)(stg + s_ * SS + 8 + (gt + 256 * i) * 8) = q.r[s_][i];
        if (gt == 0) { stg[s_ * SS + 7] = 0; stg[s_ * SS + 4104] = 0; } }
    __syncthreads();
#pragma unroll
    for (int a = 0; a < 16; ++a) { const int t = 256 * a + gt; float r[2];
#pragma unroll
        for (int s_ = 0; s_ < 2; ++s_) { const bf16* sp = stg + s_ * SS + 7 + t; r[s_] = w0 * bf2f(sp[0]) + w1 * bf2f(sp[1]) + w2 * bf2f(sp[2]) + cb; }
        o[a] = cmk(r[0], r[1]); if ((a & 3) == 3) __builtin_amdgcn_sched_barrier(0); }
}
__device__ __forceinline__ void conv_phase(const Ctx& F, const bf16* UT, const c32* KF, const float* convw, const float* convb, bf16* ZT) {
    const int g = __builtin_amdgcn_readfirstlane(F.tid >> 8), gt = F.tid & 255;
    c32* ex = (c32*)(F.lds + RING_OFF + g * 36864);
    bf16* stg = (bf16*)ex;
    FftTw W; fft_twiddles(W, gt, (c32*)(F.lds + RING_OFF + 73728), (c32*)(F.lds + RING_OFF + 110592), F.tid);
    RawSeq raw;
    if (F.vcu < DM) raw_issue(raw, UT + (size_t)(2048 + F.vcu) * T, (2 * g) * 2, gt);
    for (int d = F.vcu; d < DM; d += F.G) {
        const c32* kf0 = KF + ((size_t)(d * 2 + 0) * 2) * 4096; const c32* kf1 = KF + ((size_t)(d * 2 + 1) * 2) * 4096;
        for (int pp = 0; pp < 2; ++pp) { const int b0 = (2 * g + pp) * 2;
            int gtv = gt; asm volatile("" : "+v"(gtv));
            c32 z[16], gate[16];
            { const int c = 2048 + d; stage_conv3(z, raw, convw[c], convw[3072 + c], convw[6144 + c], convb[c], stg, gtv); }
            raw_issue(raw, UT + (size_t)d * T, b0, gtv);
            long_conv(z, kf0, W, ex, gtv);
            { const int c = d; stage_conv3(gate, raw, convw[c], convw[3072 + c], convw[6144 + c], convb[c], stg, gtv); }
            raw_issue(raw, UT + (size_t)(1024 + d) * T, b0, gtv);
#pragma unroll
            for (int a = 0; a < 16; ++a) z[a] = cmk(z[a].x * gate[a].x, z[a].y * gate[a].y);
            long_conv(z, kf1, W, ex, gtv);
            { const int c = 1024 + d; stage_conv3(gate, raw, convw[c], convw[3072 + c], convw[6144 + c], convb[c], stg, gtv); }
            { const int dn = pp == 0 ? d : d + F.G; if (dn < DM) raw_issue(raw, UT + (size_t)(2048 + dn) * T, pp == 0 ? b0 + 2 : (2 * g) * 2, gtv); }
            bf16* zr = ZT + (size_t)d * T + (size_t)b0 * SEQ;
#pragma unroll
            for (int a = 0; a < 16; ++a) { const int t = 256 * a + gtv; const unsigned pk = pk2(z[a].x * gate[a].x, z[a].y * gate[a].y); zr[t] = (bf16)(pk & 0xffffu); zr[SEQ + t] = (bf16)(pk >> 16); }
        }
    }
}
__device__ __forceinline__ void transpose_phase(const Ctx& F, const bf16* ZT, bf16* Z) {
    bf16* tile = (bf16*)(F.lds + RING_OFF + F.wave * 8704);
    const int l = F.lane;
    v4u x[8];
    if (F.gw < 16 * 512) { const int d0 = (F.gw & 15) * 64, t0 = (F.gw >> 4) * 64;
#pragma unroll
        for (int i = 0; i < 8; ++i) x[i] = *(const v4u*)(ZT + (size_t)(d0 + i * 8 + (l >> 3)) * T + t0 + (l & 7) * 8); }
    for (int it = F.gw; it < 16 * 512; it += F.NGW) { const int d0 = (it & 15) * 64, t0 = (it >> 4) * 64;
#pragma unroll
        for (int i = 0; i < 8; ++i) { const int dr = i * 8 + (l >> 3), c = l & 7;
            v2u* p = (v2u*)(tile + dr * 68 + c * 8); v2u a; a.x = x[i].x; a.y = x[i].y; p[0] = a; a.x = x[i].z; a.y = x[i].w; p[1] = a; }
        const int itn = it + F.NGW;
        if (itn < 16 * 512) { const int dn = (itn & 15) * 64, tn = (itn >> 4) * 64;
#pragma unroll
            for (int i = 0; i < 8; ++i) x[i] = *(const v4u*)(ZT + (size_t)(dn + i * 8 + (l >> 3)) * T + tn + (l & 7) * 8); }
        LDS_WAIT();
#pragma unroll
        for (int i = 0; i < 8; ++i) { const int tr = i * 8 + (l >> 3), c = l & 7; unsigned short e[8];
#pragma unroll
            for (int k = 0; k < 8; ++k) e[k] = tile[(c * 8 + k) * 68 + tr];
            v4u o; o.x = e[0] | ((unsigned)e[1] << 16); o.y = e[2] | ((unsigned)e[3] << 16); o.z = e[4] | ((unsigned)e[5] << 16); o.w = e[6] | ((unsigned)e[7] << 16);
            *(v4u*)(Z + (size_t)(t0 + tr) * DM + d0 + c * 8) = o; }
        LDS_WAIT();
    }
}

constexpr int NPH = 22;
constexpr int seam_id(int k) { return k == 0 ? 0 : k == 1 ? 1 : k == 2 ? 2 : k == 4 ? 3 : k == 6 ? 4 : k == 7 ? 5 : k == 8 ? 6 : k == 10 ? 7 : k == 11 ? 8 : k == 12 ? 9 : k == 14 ? 10 : k == 15 ? 11 : k == 16 ? 12 : k == 17 ? 13 : k == 18 ? 14 : k == 20 ? 15 : -100; }
#ifdef PROBE_SEAM
__device__ __forceinline__ unsigned long long probe_now() { unsigned long long t; asm volatile("s_memrealtime %0\n\ts_waitcnt lgkmcnt(0)" : "=s"(t) :: "memory"); return t; }
#define SEAMHOOK(id) do { if ((id) == PROBE_SEAM) { const unsigned long long t1_ = probe_now(); while (probe_now() < t1_ + (t1_ - tlast_)) __builtin_amdgcn_s_sleep(4); } \
                          if ((id) + 1 == PROBE_SEAM) tlast_ = probe_now(); } while (0)
#define SEAMBAR(k) do { xcd_barrier(bar); SEAMHOOK(seam_id(k)); } while (0)
#else
#define SEAMHOOK(id) do { } while (0)
#define SEAMBAR(k) xcd_barrier(bar)
#endif
#define XN2P(L) ((L) == 0 ? (bf16*)out : WSP(bf16, WS_XN2))
#define MOE_PHASES(L) do { \
        const int mb = 8 + 10 * L; \
        if (IN(mb)) { PH_ARGS; const float* mod = WSP(float, WS_MOD) + (size_t)L * 8 * 6144; gu32* cnt = (gu32*)(ws + WS_CTL) + CW_CNT + L * 24 * 64; \
            route_phase(F, WSP(bf16, WS_XR), in[6] + L * 1024, mod + 4 * 1024, mod + 3 * 1024, in[31] + L * 4096, in[32] + L * 4, in[33] + L * 16384, in[34] + L * 16, XN2P(L), WSP(int, WS_LIST), WSP(float, WS_WL), cnt); \
            if (L == 0) { __syncthreads();        \
                pg8::Gemm gmh{WSP(bf16, WS_W4S), WSP(bf16, WS_HDNS), 4096, 4096, 256}; pg8::StaticOrder Sh; Sh.init(4096, 4096, F.G, (int)blockIdx.x); pg8::EpiF32 Eh{WSP(float, WS_HT), 4096}; \
                REP(11) pg8::gemm_phase<pg8::EpiF32, pg8::StaticOrder, true, true>(ring, gmh, Sh, Eh, F.tid); } } \
        if (IN(mb) && IN(mb + 2)) SEAMBAR(mb); \
        if (IN(mb + 2)) { PH_ARGS; gu32* cnt = (gu32*)(ws + WS_CTL) + CW_CNT + L * 24 * 64; moe_table(F, cnt); \
              \
            pg8::Gemm gm{XN2P(L), (const bf16*)(ws + WS_WGU + (size_t)L * 16 * 512 * 1024), MS_ROWS, 8192, 512}; pg8::MoeOrder S{tinfo, F.G, F.vcu, 0, WSP(int, WS_LIST)}; pg8::EpiSwiGLU E{WSP(unsigned char, WS_HACT), WSP(float, WS_WL), tinfo}; \
            REP(10) pg8::gemm_phase_gather<pg8::EpiSwiGLU, pg8::MoeOrder, true, true, 5>(ring, gm, S, E, F.tid); \
            if (L == 0) { const int nu = 4 * tinfo[0], mine = (nu - F.vcu + F.G - 1) / F.G, most = (nu + F.G - 1) / F.G;        \
                if (mine < most) { __syncthreads(); filter_phase(F, WSP(float, WS_HT), in[29], WSP(c32, WS_KF), (gu32*)(ws + WS_CTL) + CW_FILT, most - mine); } } } SEAM(mb + 2); \
        if (IN(mb + 3)) { PH_ARGS; gu32* cnt = (gu32*)(ws + WS_CTL) + CW_CNT + L * 24 * 64; moe_table(F, cnt); const float* mod = WSP(float, WS_MOD) + (size_t)L * 8 * 6144; \
            pg8::Gemm gm{WSP(bf16, WS_HACT), (const bf16*)(ws + WS_WDN + (size_t)L * 24 * 1024 * 512), MS_ROWS, 24 * 1024, 256};   pg8::MoeOrder S{tinfo, F.G, F.vcu, 1, WSP(int, WS_LIST)}; if (L == 0) { pg8::EpiMoeOut<bf16> E{WSP(bf16, WS_XR), WSP(bf16, WS_XR), mod + 5 * 1024, WSP(int, WS_LIST), tinfo, (PG8_LAS float*)((PG8_LAS unsigned char*)lds + EPIX_OFF)}; pg8::gemm_phase<pg8::EpiMoeOut<bf16>, pg8::MoeOrder, true, true, 8>(ring, gm, S, E, F.tid); } \
            else { pg8::EpiMoeOut<float> E{WSP(bf16, WS_XR), out, mod + 5 * 1024, WSP(int, WS_LIST), tinfo, (PG8_LAS float*)((PG8_LAS unsigned char*)lds + EPIX_OFF)}; pg8::gemm_phase<pg8::EpiMoeOut<float>, pg8::MoeOrder, true, true, 8>(ring, gm, S, E, F.tid); } \
            if (L == 0) { __syncthreads(); filter_phase(F, WSP(float, WS_HT), in[29], WSP(c32, WS_KF), (gu32*)(ws + WS_CTL) + CW_FILT, DM); }       \
            } \
    } while (0)
struct Args { const float* in[38]; float* out; unsigned char* ws; int ph_lo, ph_hi; };
static_assert(sizeof(Args) == 38 * 8 + 8 + 8 + 8, "Args layout (read back through the kernarg segment pointer)");
__global__ void __launch_bounds__(NTHR, 2) fwd_kernel(Args args) {
    extern __shared__ __attribute__((aligned(16))) unsigned char lds[];
#define MK_CTX(F, tx) Ctx F; F.lds = lds; F.tid = (tx); F.lane = F.tid & 63; F.wave = __builtin_amdgcn_readfirstlane(F.tid >> 6); \
    F.G = gridDim.x; { const int bx = blockIdx.x; F.vcu = (F.G % 8 == 0) ? (bx % 8) * (F.G / 8) + bx / 8 : bx; } F.gw = F.vcu * NWAVES + F.wave; F.NGW = F.G * NWAVES
    for (int u = threadIdx.x; u < (LDS_BYTES - LDSCTL_OFF) / 4; u += NTHR) ((LAS unsigned*)((LAS unsigned char*)lds + LDSCTL_OFF))[u] = 0u;
    __syncthreads();
    const int wave_s_ = __builtin_amdgcn_readfirstlane(threadIdx.x >> 6);
    const int lo = args.ph_lo, hi = args.ph_hi;
    const bool use_bar = (hi - lo) > 1;
    XcdBarrier bar; bar.bar = (unsigned*)(args.ws + WS_CTL) + CW_BAR; bar.x = 0; bar.st = nullptr; bar.w0 = 0;
    if (use_bar) bar = xcd_barrier_post((unsigned*)(args.ws + WS_CTL) + CW_BAR, (volatile LAS unsigned*)((LAS unsigned char*)lds + MISC_OFF) + 8);
    bar.w0 = (wave_s_ == 0) ? 1 : 0;
#ifndef PHMASK
#define PHMASK 0xFFFFFFFFu
#endif
#define IN(k) (((PHMASK >> ((k) >= 18 ? (k) - 10 : (k))) & 1u) && lo <= (k) && (k) < hi)
#ifndef REPMASK
#define REPMASK 0u
#endif
#define NREP(k) (((REPMASK >> (k)) & 1u) ? 2 : 1)
#define REP(k) for (int rep_ = 0; rep_ < NREP(k); ++rep_)
#define SEAM(k) do { if (IN(k) && IN((k) + 1)) SEAMBAR(k); } while (0)
#define PH_STR2(x) #x
#define PH_STR(x) PH_STR2(x)
#define PH_ARGS int opq_ = 0; asm volatile("; PHMARK line " PH_STR(__LINE__) : "+s"(opq_)); const In in{opq_}; unsigned char* const ws = karg_ws(opq_); float* const out = karg_out(opq_); (void)in; (void)ws; (void)out; int tx_; asm volatile("v_mbcnt_lo_u32_b32 %0, -1, 0\n\tv_mbcnt_hi_u32_b32 %0, -1, %0" : "=v"(tx_)); tx_ += wave_s_ * 64; MK_CTX(F, tx_)
#define WSP(type, off) ((type*)(ws + (off)))
    PG8_LAS unsigned char* ring = (PG8_LAS unsigned char*)lds + RING_OFF;
    const PG8_LAS int* tinfo = (const PG8_LAS int*)((PG8_LAS unsigned char*)lds + TINFO_OFF);

#ifdef PROBE_SEAM
    unsigned long long tlast_ = probe_now();
#endif
    if (IN(0)) { PH_ARGS; REP(0) p0_prologue(F, in, ws); } SEAM(0);

            if (IN(1)) { PH_ARGS; const float* mod = WSP(float, WS_MOD); REP(1) norm_mod_phase<float, true>(F, in[0], in[5], mod + 1024, mod, WSP(bf16, WS_XN)); } SEAM(1);
            if (IN(2)) { PH_ARGS; pg8::Gemm gm{WSP(bf16, WS_XN), WSP(bf16, WS_WD), T, 512, 512};   pg8::StaticOrder S; S.init(T, 512, F.G, (int)blockIdx.x);
                pg8::EpiLat E{WSP(unsigned char, WS_CQN), WSP(bf16, WS_CKVN), WSP(unsigned char, WS_KPE), in[8], in[9], in[13], WSP(float, WS_ROPE), (PG8_LAS float*)((PG8_LAS unsigned char*)lds + EPIX_OFF)};
                REP(2) pg8::gemm_phase<pg8::EpiLat, pg8::StaticOrder, true, true, 5>(ring, gm, S, E, F.tid); }
            if (IN(2) && IN(4)) SEAMBAR(2);
            if (IN(4)) { REP(4) {
                { PH_ARGS; pg8::Gemm gm{WSP(bf16, WS_CQN), WSP(bf16, WS_WUQ), T, 1536, 128};   pg8::StaticOrder S; S.init(T, 1536, F.G, (int)blockIdx.x); pg8::EpiBf16R E{WSP(bf16, WS_QRAW), 1536, nullptr};
                  pg8::gemm_phase<pg8::EpiBf16R, pg8::StaticOrder, true, true, 4>(ring, gm, S, E, F.tid); }
                { PH_ARGS; pg8::Gemm gm{WSP(bf16, WS_CKVN), WSP(bf16, WS_WUKV), T, 1024, 128};   pg8::StaticOrder S; S.init(T, 1024, F.G, (int)blockIdx.x);
                  pg8::EpiK8 E{WSP(unsigned char, WS_K8), in[13], (PG8_LAS float*)((PG8_LAS unsigned char*)lds + EPIX_OFF)};
                  pg8::gemm_phase<pg8::EpiK8, pg8::StaticOrder, true, true>(ring, gm, S, E, F.tid); }
                { PH_ARGS; pg8::Gemm gm{WSP(bf16, WS_WUKV) + 1024 * 128, WSP(bf16, WS_CKVN), 1024, T, 128}; pg8::StaticOrder S; S.init(1024, T, F.G, (int)blockIdx.x);
                  pg8::EpiF8T E{WSP(unsigned char, WS_VT8), T};
                  pg8::gemm_phase<pg8::EpiF8T, pg8::StaticOrder, true, true>(ring, gm, S, E, F.tid); } }
            } if (IN(4) && IN(6)) SEAMBAR(4);
            if (IN(6)) { PH_ARGS;
                const float* qg = in[12]; const float* kg = in[13];
                float gqn = 0.f, gkn = 0.f, gqp = 0.f, gkp = 0.f;
                for (int i = 0; i < 128; ++i) { gqn = fmaxf(gqn, fabsf(qg[i])); gkn = fmaxf(gkn, fabsf(kg[i])); }
                for (int i = 128; i < 192; ++i) { gqp = fmaxf(gqp, fabsf(qg[i])); gkp = fmaxf(gkp, fabsf(kg[i])); }
                const float smaxC = (128.f * gqn * gkn + 64.f * gqp * gkp) * (0.072168783648703220f * 1.4426950408889634f);
                unsigned redo_mask = 0u;
                if (smaxC < 60.f) for (int rep_ = 0; rep_ < NREP(6); ++rep_) { int i = 0;
                    for (int u = F.vcu; u < 1024; u += F.G, ++i) { const int b = u >> 7, h = (u >> 4) & 7, qb = u & 15;
                        if (att::attn_unit<false>(b, h, qb * 256, WSP(bf16, WS_QRAW), WSP(unsigned char, WS_VT8), WSP(unsigned char, WS_K8), WSP(unsigned char, WS_KPE), WSP(bf16, WS_O), WSP(float, WS_ROPE), qg, smaxC, (char*)lds + RING_OFF, F.tid)) redo_mask |= 1u << (i & 31); } }
                else redo_mask = 0xffffffffu;
                redo_mask = (unsigned)__builtin_amdgcn_readfirstlane((int)redo_mask);
                if (redo_mask) { int i = 0;
                    for (int u = F.vcu; u < 1024; u += F.G, ++i) { const int b = u >> 7, h = (u >> 4) & 7, qb = u & 15;
                        if ((redo_mask >> (i & 31)) & 1u) (void)att::attn_unit<true>(b, h, qb * 256, WSP(bf16, WS_QRAW), WSP(unsigned char, WS_VT8), WSP(unsigned char, WS_K8), WSP(unsigned char, WS_KPE), WSP(bf16, WS_O), WSP(float, WS_ROPE), qg, smaxC, (char*)lds + RING_OFF, F.tid); } }
            } SEAM(6);
            if (IN(7)) { PH_ARGS; pg8::Gemm gm{WSP(bf16, WS_O), WSP(bf16, WS_WO), T, 1024, 512};   pg8::StaticOrder S; S.init(T, 1024, F.G, (int)blockIdx.x); pg8::EpiResGate<float, bf16> E{in[0], WSP(bf16, WS_XR), WSP(float, WS_MOD) + 2048, 1024};
                REP(7) pg8::gemm_phase<pg8::EpiResGate<float, bf16>, pg8::StaticOrder, true, true, 10>(ring, gm, S, E, F.tid); } SEAM(7);
    MOE_PHASES(0); SEAM(11);
            if (IN(12)) { PH_ARGS; const float* mod = WSP(float, WS_MOD) + 8 * 6144; REP(12) norm_mod_phase(F, WSP(bf16, WS_XR), in[5] + 1024, mod + 1024, mod, (bf16*)out); }
            if (IN(12) && IN(14)) SEAMBAR(12);
            if (IN(14)) { PH_ARGS; pg8::Gemm gm{WSP(bf16, WS_WIN), (const bf16*)out, 3072, T, 1024}; pg8::StaticOrder S; S.init(3072, T, F.G, (int)blockIdx.x); pg8::EpiBf16R E{WSP(bf16, WS_UT), T, in[16]};
                REP(14) pg8::gemm_phase<pg8::EpiBf16R, pg8::StaticOrder, true, true>(ring, gm, S, E, F.tid); } SEAM(14);
            if (IN(15)) { PH_ARGS; for (int rep = 0; rep < NREP(15); ++rep) conv_phase(F, WSP(bf16, WS_UT), WSP(c32, WS_KF), in[17], in[18], (bf16*)out); } SEAM(15);
            if (IN(16)) { PH_ARGS; REP(16) transpose_phase(F, (const bf16*)out, WSP(bf16, WS_Z)); } SEAM(16);
            if (IN(17)) { PH_ARGS; pg8::Gemm gm{WSP(bf16, WS_Z), WSP(bf16, WS_WOUT), T, 1024, 1024}; pg8::StaticOrder S; S.init(T, 1024, F.G, (int)blockIdx.x); pg8::EpiResGate<bf16, bf16> E{WSP(bf16, WS_XR), WSP(bf16, WS_XR), WSP(float, WS_MOD) + 8 * 6144 + 2048, 1024};
                pg8::gemm_phase<pg8::EpiResGate<bf16, bf16>, pg8::StaticOrder, true, true>(ring, gm, S, E, F.tid); } SEAM(17);
    MOE_PHASES(1);
#ifdef PROBE_SEAM
    SEAMHOOK(16);
#endif
#undef IN
#undef SEAM
}

#ifndef ONE_LAUNCH
#define ONE_LAUNCH 1
#endif
extern "C" void kernel_launch(void* const* d_in, const int* in_sizes, int n_in, void* d_out, int out_size, void* d_ws, size_t ws_size, hipStream_t stream) {
    static int grid = 0;
    if (grid == 0) {
        if (n_in != 38 || in_sizes[0] != T * DM || out_size != T * DM || ws_size < WS_END) { fprintf(stderr, "kernel_launch: shape mismatch n_in %d in0 %d out %d ws %zu\n", n_in, n_in > 0 ? in_sizes[0] : -1, out_size, ws_size); grid = -1; return; }
        int dev = 0, cus = 0, per_cu = 0;
        if (hipGetDevice(&dev) != hipSuccess || hipDeviceGetAttribute(&cus, hipDeviceAttributeMultiprocessorCount, dev) != hipSuccess) { grid = -1; return; }
        if (hipFuncSetAttribute((const void*)fwd_kernel, hipFuncAttributeMaxDynamicSharedMemorySize, LDS_BYTES) != hipSuccess) { fprintf(stderr, "kernel_launch: hipFuncSetAttribute failed\n"); grid = -1; return; }
        if (hipOccupancyMaxActiveBlocksPerMultiprocessor(&per_cu, (const void*)fwd_kernel, NTHR, LDS_BYTES) != hipSuccess || per_cu < 1) { fprintf(stderr, "kernel_launch: occupancy query says %d\n", per_cu); }
        (void)hipGetLastError();
        grid = cus;
    }
    if (grid < 0) return;
    if (hipMemsetAsync((char*)d_ws + WS_CTL, 0, CTL_ZERO_BYTES, stream) != hipSuccess) return;
    Args a{};
    for (int i = 0; i < 38; ++i) a.in[i] = (const float*)d_in[i];
    a.out = (float*)d_out; a.ws = (unsigned char*)d_ws;
#if ONE_LAUNCH
    a.ph_lo = 0; a.ph_hi = NPH;
    hipLaunchKernelGGL(fwd_kernel, dim3(grid), dim3(NTHR), LDS_BYTES, stream, a);
#else
    for (int p = 0; p < NPH; ++p) { a.ph_lo = p; a.ph_hi = p + 1; hipLaunchKernelGGL(fwd_kernel, dim3(grid), dim3(NTHR), LDS_BYTES, stream, a); }
#endif
    const hipError_t le = hipPeekAtLastError();
    if (le != hipSuccess) fprintf(stderr, "kernel_launch: launch failed: %s\n", hipGetErrorName(le));
}
```

```cpp
#include <hip/hip_runtime.h>
#include <cstdio>
#include <cstdint>
namespace pg8 {
#define PG8_LAS __attribute__((address_space(3)))
typedef unsigned short bf16_t;
typedef short bf16x8 __attribute__((ext_vector_type(8)));
typedef float f32x4 __attribute__((ext_vector_type(4)));
typedef unsigned u32x4 __attribute__((ext_vector_type(4)));
typedef int v4i_t __attribute__((ext_vector_type(4)));
typedef int v8i_t __attribute__((ext_vector_type(8)));
constexpr int BM = 256, BK = 64, HALF = 128, HTB = HALF * BK * 2  , STAGE_BYTES = 8 * HTB, NXCD = 8, WGM = 8;

__host__ __device__ __forceinline__ int lds_byte(int r, int c) { const int st = (r >> 4) * 2 + (c >> 5), rr = r & 15, cc = c & 31, ob = rr * 64 + cc * 2; return st * 1024 + (ob ^ (((ob >> 9) & 1) << 5)); }
__host__ __device__ __forceinline__ void stage_rc(int b, int& R, int& C) { const int st = b / 1024, sb = b % 1024, swz = sb ^ (((sb >> 9) & 1) << 5); R = (st >> 1) * 16 + swz / 64; C = (st & 1) * 32 + (swz % 64) / 2; }
__host__ __device__ __forceinline__ int perm32(int rho) { const int n = rho >> 4, i = rho & 15; return 8 * (i >> 2) + 4 * n + (i & 3); }

struct Unit { int pm, pn; };
struct Gemm { const bf16_t* A; const bf16_t* Bt; int M, N, K; };

struct StaticOrder {
    int nM, nN, nwg, G, c;
    __host__ __device__ void init(int M, int N, int G_, int c_) { nM = M / BM; nN = N / BM; nwg = nM * nN; G = G_; c = c_; }
    __host__ __device__ bool next(int i, Unit& u) const {
        const long L = (long)i * G + c; if (L >= nwg) return false;
        int wgid = (int)L; { const int q = nwg / NXCD, r = nwg % NXCD, xcd = wgid % NXCD, off = wgid / NXCD; wgid = (xcd < r ? xcd * (q + 1) : r * (q + 1) + (xcd - r) * q) + off; }
        const int nig = WGM * nN, gid = wgid / nig, fm = gid * WGM, gsz = (nM - fm) < WGM ? (nM - fm) : WGM;
        u.pm = fm + ((wgid % nig) % gsz); u.pn = (wgid % nig) / gsz; return true;
    }
    __device__ __forceinline__ void a_ready(const Unit&) const {}
    __device__ __forceinline__ void done(const Unit&) const {}
};

__device__ __forceinline__ unsigned cvt_pk_bf16(float lo, float hi) { unsigned r; asm volatile("v_cvt_pk_bf16_f32 %0, %1, %2" : "=v"(r) : "v"(lo), "v"(hi)); return r; }
typedef float f32x2 __attribute__((ext_vector_type(2)));
typedef unsigned u32x2 __attribute__((ext_vector_type(2)));
struct EpiF32 {
    static constexpr bool PERM = false, AFTER_DRAIN = false;
    float* C; int ldc;
    __device__ __forceinline__ void operator()(const f32x4 (&acc)[2][2][4][2], const Unit& u, int wr, int wc, int fr, int fq) const {
        const int row0 = u.pm * BM + wr * 64 + fr, col0 = u.pn * BM + wc * 32 + 4 * fq;
#pragma unroll
        for (int ai = 0; ai < 2; ++ai)
#pragma unroll
            for (int m = 0; m < 4; ++m) { float* rowp = C + (size_t)(row0 + ai * HALF + m * 16) * ldc + col0;
#pragma unroll
                for (int bj = 0; bj < 2; ++bj)
#pragma unroll
                    for (int n = 0; n < 2; ++n) *(f32x4*)(rowp + bj * HALF + n * 16) = acc[ai][bj][m][n]; }
    }
};
struct EpiBf16R {
    static constexpr bool PERM = true, AFTER_DRAIN = false;
    bf16_t* O; int ldc; const float* rowbias;
    __device__ __forceinline__ void operator()(const f32x4 (&acc)[2][2][4][2], const Unit& u, int wr, int wc, int fr, int fq) const {
        const int row0 = u.pm * BM + wr * 64 + fr, col0 = u.pn * BM + wc * 32 + 8 * fq;
#pragma unroll
        for (int ai = 0; ai < 2; ++ai)
#pragma unroll
            for (int m = 0; m < 4; ++m) { const int row = row0 + ai * HALF + m * 16; bf16_t* rowp = O + (size_t)row * ldc + col0; const float rb = rowbias ? rowbias[row] : 0.f;
#pragma unroll
                for (int bj = 0; bj < 2; ++bj) { const f32x4 v0 = acc[ai][bj][m][0] + rb, v1 = acc[ai][bj][m][1] + rb;
                    u32x4 w; w.x = cvt_pk_bf16(v0[0], v0[1]); w.y = cvt_pk_bf16(v0[2], v0[3]); w.z = cvt_pk_bf16(v1[0], v1[1]); w.w = cvt_pk_bf16(v1[2], v1[3]);
                    *(u32x4*)(rowp + bj * HALF) = w; } }
    }
};
__device__ __forceinline__ f32x4 ld4(const float* p) { return *(const f32x4*)p; }
__device__ __forceinline__ f32x4 ld4(const bf16_t* p) { const u32x2 w = *(const u32x2*)p; f32x4 r; r[0] = __uint_as_float(w.x << 16); r[1] = __uint_as_float(w.x & 0xffff0000u); r[2] = __uint_as_float(w.y << 16); r[3] = __uint_as_float(w.y & 0xffff0000u); return r; }
__device__ __forceinline__ void st4(float* p, f32x4 v) { *(f32x4*)p = v; }
__device__ __forceinline__ void st4(bf16_t* p, f32x4 v) { u32x2 w; w.x = cvt_pk_bf16(v[0], v[1]); w.y = cvt_pk_bf16(v[2], v[3]); *(u32x2*)p = w; }
__device__ __forceinline__ f32x4 ldraw(const float* p) { return *(const f32x4*)p; }
__device__ __forceinline__ u32x2 ldraw(const bf16_t* p) { return *(const u32x2*)p; }
__device__ __forceinline__ f32x4 cvraw(f32x4 v) { return v; }
__device__ __forceinline__ f32x4 cvraw(u32x2 w) { f32x4 r; r[0] = __uint_as_float(w.x << 16); r[1] = __uint_as_float(w.x & 0xffff0000u); r[2] = __uint_as_float(w.y << 16); r[3] = __uint_as_float(w.y & 0xffff0000u); return r; }
template <class TB, class TO> struct EpiResGate {
    static constexpr bool PERM = false, AFTER_DRAIN = false;
    const TB* base; TO* out; const float* gate; int ldc;
    __device__ __forceinline__ void operator()(const f32x4 (&acc)[2][2][4][2], const Unit& u, int wr, int wc, int fr, int fq) const {
        const int row0 = u.pm * BM + wr * 64 + fr, col0 = u.pn * BM + wc * 32 + 4 * fq;
        const float* gp = gate + (size_t)(u.pm >> 4) * 6144 + col0;
        f32x4 gv[2][2];
#pragma unroll
        for (int bj = 0; bj < 2; ++bj)
#pragma unroll
            for (int n = 0; n < 2; ++n) gv[bj][n] = *(const f32x4*)(gp + bj * HALF + n * 16);
        constexpr int GB = sizeof(TB) == 2 ? 8 : 4;
        typedef decltype(ldraw(base)) raw_t;
#pragma unroll
        for (int g0 = 0; g0 < 8; g0 += GB) {
            raw_t bs[GB][2][2];
#pragma unroll
            for (int g = 0; g < GB; ++g) { const unsigned off = (unsigned)((row0 + ((g0 + g) >> 2) * HALF + ((g0 + g) & 3) * 16) * ldc + col0);
#pragma unroll
                for (int bj = 0; bj < 2; ++bj)
#pragma unroll
                    for (int n = 0; n < 2; ++n) bs[g][bj][n] = ldraw(base + off + bj * HALF + n * 16); }
#pragma unroll
            for (int g = 0; g < GB; ++g) { const int ai = (g0 + g) >> 2, m = (g0 + g) & 3; const unsigned off = (unsigned)((row0 + ai * HALF + m * 16) * ldc + col0);
#pragma unroll
                for (int bj = 0; bj < 2; ++bj)
#pragma unroll
                    for (int n = 0; n < 2; ++n) st4(out + off + bj * HALF + n * 16, cvraw(bs[g][bj][n]) + gv[bj][n] * acc[ai][bj][m][n]); }
            asm volatile("" ::: "memory"); }
    }
};
struct EpiLat {
    static constexpr bool PERM = false, AFTER_DRAIN = false;
    unsigned char* CQN  ; bf16_t* CKVN; unsigned char* KPE  ; const float* qag; const float* kvag; const float* kng; const float* rope; PG8_LAS float* P;
    __device__ __forceinline__ void operator()(const f32x4 (&acc)[2][2][4][2], const Unit& u, int wr, int wc, int, int) const {
        int ln = (int)__builtin_amdgcn_mbcnt_hi(~0u, __builtin_amdgcn_mbcnt_lo(~0u, 0u)); asm volatile("" : "+v"(ln)); const int fr = ln & 15, fq = ln >> 4;
        const int row0 = u.pm * BM + wr * 64 + fr;
#pragma unroll
        for (int ai = 0; ai < 2; ++ai)
#pragma unroll
            for (int m = 0; m < 4; ++m) { float s0 = 0.f, s1 = 0.f;
#pragma unroll
                for (int n = 0; n < 2; ++n) { const f32x4 a = acc[ai][0][m][n], b = acc[ai][1][m][n];
                    s0 += (a[0] * a[0] + a[1] * a[1]) + (a[2] * a[2] + a[3] * a[3]); s1 += (b[0] * b[0] + b[1] * b[1]) + (b[2] * b[2] + b[3] * b[3]); }
                s0 += __shfl_xor(s0, 16); s0 += __shfl_xor(s0, 32); s1 += __shfl_xor(s1, 16); s1 += __shfl_xor(s1, 32);
                if (fq == 0) { const int rl = ai * HALF + wr * 64 + m * 16 + fr; P[rl * 8 + wc] = s0; P[rl * 8 + 4 + wc] = s1; } }
        asm volatile("s_waitcnt lgkmcnt(0)" ::: "memory"); __builtin_amdgcn_s_barrier(); asm volatile("" ::: "memory");
        const int cl = wc * 32 + 4 * fq;
        if (u.pn == 0) {
            f32x4 g[2][2];
#pragma unroll
            for (int bj = 0; bj < 2; ++bj)
#pragma unroll
                for (int n = 0; n < 2; ++n) g[bj][n] = *(const f32x4*)(qag + bj * HALF + cl + 16 * n);
#pragma unroll
            for (int ai = 0; ai < 2; ++ai)
#pragma unroll
                for (int m = 0; m < 4; ++m) { const int rl = ai * HALF + wr * 64 + m * 16 + fr; const f32x4 pa = *(const PG8_LAS f32x4*)(P + rl * 8), pb = *(const PG8_LAS f32x4*)(P + rl * 8 + 4);
                    const float r = __builtin_amdgcn_rsqf((((pa[0] + pa[1]) + (pa[2] + pa[3])) + ((pb[0] + pb[1]) + (pb[2] + pb[3]))) * (1.f / 256.f) + 1e-6f);
                    unsigned char* rowp = CQN + (size_t)(row0 + ai * HALF + m * 16) * 256 + cl;
#pragma unroll
                    for (int bj = 0; bj < 2; ++bj)
#pragma unroll
                        for (int n = 0; n < 2; ++n) { const f32x4 v = acc[ai][bj][m][n] * r * g[bj][n]; int p = 0; p = __builtin_amdgcn_cvt_pk_fp8_f32(v[0], v[1], p, false); p = __builtin_amdgcn_cvt_pk_fp8_f32(v[2], v[3], p, true); *(int*)(rowp + bj * HALF + 16 * n) = p; } }
        } else {
            f32x4 gk[2], gp[2]; const int e0 = 16 * (wc & 1) + 4 * fq;
#pragma unroll
            for (int n = 0; n < 2; ++n) { gk[n] = *(const f32x4*)(kvag + cl + 16 * n); gp[n] = *(const f32x4*)(kng + 128 + e0 + 32 * n); }
#pragma unroll
            for (int ai = 0; ai < 2; ++ai)
#pragma unroll
                for (int m = 0; m < 4; ++m) { const int rl = ai * HALF + wr * 64 + m * 16 + fr; const f32x4 pa = *(const PG8_LAS f32x4*)(P + rl * 8), pb = *(const PG8_LAS f32x4*)(P + rl * 8 + 4);
                    const float rkv = __builtin_amdgcn_rsqf(((pa[0] + pa[1]) + (pa[2] + pa[3])) * (1.f / 128.f) + 1e-6f), rpe = __builtin_amdgcn_rsqf((pb[0] + pb[1]) * (1.f / 64.f) + 1e-6f);
                    const size_t row = (size_t)(row0 + ai * HALF + m * 16);
#pragma unroll
                    for (int n = 0; n < 2; ++n) { const f32x4 v = acc[ai][0][m][n] * rkv * gk[n]; u32x2 w; w.x = cvt_pk_bf16(v[0], v[1]); w.y = cvt_pk_bf16(v[2], v[3]); *(u32x2*)(CKVN + row * 128 + cl + 16 * n) = w; }
                    if (wc < 2) { const f32x4 x1 = acc[ai][1][m][0] * rpe * gp[0], x2 = acc[ai][1][m][1] * rpe * gp[1];
                        const f32x4 c0 = *(const f32x4*)(rope + row * 64 + e0 * 2), c1 = *(const f32x4*)(rope + row * 64 + e0 * 2 + 4);
                        const float cs[4] = {c0[0], c0[2], c1[0], c1[2]}, sn[4] = {c0[1], c0[3], c1[1], c1[3]};
                        float o1[4], o2[4];
#pragma unroll
                        for (int j = 0; j < 4; ++j) { o1[j] = x1[j] * cs[j] - x2[j] * sn[j]; o2[j] = x1[j] * sn[j] + x2[j] * cs[j]; }
                        int w1 = 0, w2 = 0; w1 = __builtin_amdgcn_cvt_pk_fp8_f32(o1[0], o1[1], w1, false); w1 = __builtin_amdgcn_cvt_pk_fp8_f32(o1[2], o1[3], w1, true); w2 = __builtin_amdgcn_cvt_pk_fp8_f32(o2[0], o2[1], w2, false); w2 = __builtin_amdgcn_cvt_pk_fp8_f32(o2[2], o2[3], w2, true);
                        *(int*)(KPE + row * 64 + e0) = w1; *(int*)(KPE + row * 64 + 32 + e0) = w2; }
                    asm volatile("" ::: "memory"); }
        }
        asm volatile("s_waitcnt lgkmcnt(0)" ::: "memory"); __builtin_amdgcn_s_barrier(); asm volatile("" ::: "memory");
    }
};
struct EpiK8 {
    static constexpr bool PERM = true, AFTER_DRAIN = false;
    unsigned char* K8; const float* kng; PG8_LAS float* P;
    __device__ __forceinline__ void operator()(const f32x4 (&acc)[2][2][4][2], const Unit& u, int wr, int wc, int, int) const {
        int ln = (int)__builtin_amdgcn_mbcnt_hi(~0u, __builtin_amdgcn_mbcnt_lo(~0u, 0u)); asm volatile("" : "+v"(ln)); const int fr = ln & 15, fq = ln >> 4;
#pragma unroll
        for (int ai = 0; ai < 2; ++ai)
#pragma unroll
            for (int m = 0; m < 4; ++m) {
#pragma unroll
                for (int bj = 0; bj < 2; ++bj) { const f32x4 a = acc[ai][bj][m][0], b = acc[ai][bj][m][1];
                    float s = (a[0] * a[0] + a[1] * a[1]) + (a[2] * a[2] + a[3] * a[3]) + (b[0] * b[0] + b[1] * b[1]) + (b[2] * b[2] + b[3] * b[3]);
                    s += __shfl_xor(s, 16); s += __shfl_xor(s, 32);
                    if (fq == 0) P[(ai * HALF + wr * 64 + m * 16 + fr) * 8 + bj * 4 + wc] = s; } }
        asm volatile("s_waitcnt lgkmcnt(0)" ::: "memory"); __builtin_amdgcn_s_barrier(); asm volatile("" ::: "memory");
        const f32x4 g0 = *(const f32x4*)(kng + wc * 32 + 8 * fq), g1 = *(const f32x4*)(kng + wc * 32 + 8 * fq + 4);
        const int row0 = u.pm * BM + wr * 64 + fr;
#pragma unroll
        for (int ai = 0; ai < 2; ++ai)
#pragma unroll
            for (int m = 0; m < 4; ++m) { const int rl = ai * HALF + wr * 64 + m * 16 + fr;
#pragma unroll
                for (int bj = 0; bj < 2; ++bj) { const f32x4 p4 = *(const PG8_LAS f32x4*)(P + rl * 8 + bj * 4);
                    const float r = __builtin_amdgcn_rsqf(((p4[0] + p4[1]) + (p4[2] + p4[3])) * (1.f / 128.f) + 1e-6f);
                    const f32x4 v0 = acc[ai][bj][m][0] * r * g0, v1 = acc[ai][bj][m][1] * r * g1;
                    int w0 = 0, w1 = 0; w0 = __builtin_amdgcn_cvt_pk_fp8_f32(v0[0], v0[1], w0, false); w0 = __builtin_amdgcn_cvt_pk_fp8_f32(v0[2], v0[3], w0, true); w1 = __builtin_amdgcn_cvt_pk_fp8_f32(v1[0], v1[1], w1, false); w1 = __builtin_amdgcn_cvt_pk_fp8_f32(v1[2], v1[3], w1, true);
                    u32x2 w; w.x = (unsigned)w0; w.y = (unsigned)w1; *(u32x2*)(K8 + ((size_t)(row0 + ai * HALF + m * 16) * 8 + 2 * u.pn + bj) * 128 + wc * 32 + 8 * fq) = w; } }
        asm volatile("s_waitcnt lgkmcnt(0)" ::: "memory"); __builtin_amdgcn_s_barrier(); asm volatile("" ::: "memory");
    }
};
struct EpiF8T {
    static constexpr bool PERM = true, AFTER_DRAIN = false;
    unsigned char* O; int ldc;
    __device__ __forceinline__ void operator()(const f32x4 (&acc)[2][2][4][2], const Unit& u, int wr, int wc, int fr, int fq) const {
        const int row0 = u.pm * BM + wr * 64 + fr, col0 = u.pn * BM + wc * 32 + 8 * fq;
#pragma unroll
        for (int ai = 0; ai < 2; ++ai)
#pragma unroll
            for (int m = 0; m < 4; ++m) { unsigned char* rowp = O + (size_t)(row0 + ai * HALF + m * 16) * ldc + col0;
#pragma unroll
                for (int bj = 0; bj < 2; ++bj) { const f32x4 v0 = acc[ai][bj][m][0], v1 = acc[ai][bj][m][1];
                    int w0 = 0, w1 = 0; w0 = __builtin_amdgcn_cvt_pk_fp8_f32(v0[0], v0[1], w0, false); w0 = __builtin_amdgcn_cvt_pk_fp8_f32(v0[2], v0[3], w0, true); w1 = __builtin_amdgcn_cvt_pk_fp8_f32(v1[0], v1[1], w1, false); w1 = __builtin_amdgcn_cvt_pk_fp8_f32(v1[2], v1[3], w1, true);
                    u32x2 w; w.x = (unsigned)w0; w.y = (unsigned)w1; *(u32x2*)(rowp + bj * HALF) = w; } }
    }
};
__device__ __forceinline__ void pair_of(int pi, int& i, int& j) { i = pi < 3 ? 0 : (pi < 5 ? 1 : 2); j = pi < 3 ? pi + 1 : (pi < 5 ? pi - 1 : 3); }
struct MoeOrder {
    const PG8_LAS int* tinfo; int G, c, mode; const int* list;
    __device__ __forceinline__ int tok(const Unit& u, int r) const { const int bk = tinfo[1 + u.pm], pos = u.pm * BM - tinfo[256 + bk] + r; return list[bk * 32768 + (pos < tinfo[288 + bk] ? pos : 0)]; }
    __device__ __forceinline__ bool next(int i, Unit& u) const {
        const long L = (long)i * G + c; const int nt = tinfo[0]; if (L >= 4L * nt) return false;
        const int mt = (int)(L >> 2), q = (int)(L & 3), bk = tinfo[1 + mt];
        u.pm = mt;
        if (mode == 0) { int ii, jj; pair_of(bk % 6, ii, jj); const int e = (bk / 6) * 4 + ((q >> 1) ? jj : ii); u.pn = e * 2 + (q & 1); }
        else u.pn = bk * 4 + q;
        return true;
    }
    __device__ __forceinline__ void a_ready(const Unit&) const {}
    __device__ __forceinline__ void done(const Unit&) const {}
};
struct EpiSwiGLU {
    static constexpr bool PERM = true, AFTER_DRAIN = false;
    unsigned char* H; const float* wl; const PG8_LAS int* tinfo;
    __device__ __forceinline__ void operator()(const f32x4 (&acc)[2][2][4][2], const Unit& u, int wr, int wc, int, int) const {
        int ln = (int)__builtin_amdgcn_mbcnt_hi(~0u, __builtin_amdgcn_mbcnt_lo(~0u, 0u)); asm volatile("" : "+v"(ln)); const int fr = ln & 15, fq = ln >> 4;
        const int bk = tinfo[1 + u.pm]; int ii, jj; pair_of(bk % 6, ii, jj);
        const int e = u.pn >> 1, hh = u.pn & 1, slot = (e == (bk / 6) * 4 + jj) ? 1 : 0;
        const int row0 = u.pm * BM + wr * 64 + fr, col0 = slot * 256 + hh * 128 + wc * 32 + 8 * fq;
        float w8[8];
#pragma unroll
        for (int g = 0; g < 8; ++g) { const int pos = row0 + (g >> 2) * HALF + (g & 3) * 16 - tinfo[256 + bk]; w8[g] = pos < tinfo[288 + bk] ? 8.f * wl[((size_t)bk * 32768 + pos) * 2 + slot] : 0.f; }
#pragma unroll
        for (int ai = 0; ai < 2; ++ai)
#pragma unroll
            for (int m = 0; m < 4; ++m) { const int row = row0 + ai * HALF + m * 16; const float w = w8[ai * 4 + m];
                float a[8];
#pragma unroll
                for (int n = 0; n < 2; ++n)
#pragma unroll
                    for (int j = 0; j < 4; ++j) { const float g = acc[ai][0][m][n][j], up = acc[ai][1][m][n][j];
                        const float sg = g * __builtin_amdgcn_rcpf(1.0f + __builtin_amdgcn_exp2f(-1.4426950408889634f * g)); a[n * 4 + j] = sg * up * w; }
                int o0 = 0, o1 = 0; o0 = __builtin_amdgcn_cvt_pk_fp8_f32(a[0], a[1], o0, false); o0 = __builtin_amdgcn_cvt_pk_fp8_f32(a[2], a[3], o0, true);
                o1 = __builtin_amdgcn_cvt_pk_fp8_f32(a[4], a[5], o1, false); o1 = __builtin_amdgcn_cvt_pk_fp8_f32(a[6], a[7], o1, true);
                u32x2 o; o.x = (unsigned)o0; o.y = (unsigned)o1; *(u32x2*)(H + (size_t)row * 512 + col0) = o; }
    }
};
template <class TO> struct EpiMoeOut {
    static constexpr bool PERM = false, AFTER_DRAIN = false;
    const bf16_t* xr; TO* out; const float* gate; const int* list; const PG8_LAS int* tinfo; PG8_LAS float* gl;
    __device__ __forceinline__ void operator()(const f32x4 (&acc)[2][2][4][2], const Unit& u, int wr, int wc, int, int) const {
        int ln = (int)__builtin_amdgcn_mbcnt_hi(~0u, __builtin_amdgcn_mbcnt_lo(~0u, 0u)); asm volatile("" : "+v"(ln)); const int fr = ln & 15, fq = ln >> 4;
        const int bk = tinfo[1 + u.pm], r_beg = tinfo[256 + bk], r_end = r_beg + tinfo[288 + bk];
        const int row0 = u.pm * BM + wr * 64 + fr, colu = (u.pn & 3) * BM, cl = wc * 32 + 4 * fq;
        int tk[8];
#pragma unroll
        for (int g = 0; g < 8; ++g) { const int row = row0 + (g >> 2) * HALF + (g & 3) * 16; tk[g] = row < r_end ? list[bk * 32768 + row - r_beg] : -1; }
        { const int t = (wr * 4 + wc) * 64 + fq * 16 + fr; const f32x4 gs = *(const f32x4*)(gate + (size_t)(t >> 6) * 6144 + colu + (t & 63) * 4);
          *(PG8_LAS f32x4*)(gl + (t >> 6) * 256 + (t & 63) * 4) = gs; }
        asm volatile("s_waitcnt lgkmcnt(0)" ::: "memory"); __builtin_amdgcn_s_barrier();
#pragma unroll
        for (int g0 = 0; g0 < 8; g0 += 4) {
            u32x2 bs[4][2][2];
#pragma unroll
            for (int g = 0; g < 4; ++g) { const unsigned xo = (unsigned)((tk[g0 + g] < 0 ? 0 : tk[g0 + g]) * 1024 + colu + cl);
#pragma unroll
                for (int bj = 0; bj < 2; ++bj)
#pragma unroll
                    for (int n = 0; n < 2; ++n) bs[g][bj][n] = ldraw(xr + xo + bj * HALF + n * 16); }
#pragma unroll
            for (int g = 0; g < 4; ++g) { const int ai = (g0 + g) >> 2, m = (g0 + g) & 3, tkg = tk[g0 + g];
                if (tkg >= 0) { TO* op = out + (size_t)tkg * 1024 + colu + cl; const PG8_LAS float* gp = gl + (tkg >> 12) * 256 + cl;
#pragma unroll
                    for (int bj = 0; bj < 2; ++bj)
#pragma unroll
                        for (int n = 0; n < 2; ++n) { const f32x4 gv = *(const PG8_LAS f32x4*)(gp + bj * HALF + n * 16); st4(op + bj * HALF + n * 16, cvraw(bs[g][bj][n]) + gv * acc[ai][bj][m][n]); } } }
            asm volatile("" ::: "memory"); }
    }
};
template <class Epi, class Sched, bool ALIGN_EPI = false, bool SP2 = false, int F8 = -1>
__device__ __forceinline__ void gemm_phase(PG8_LAS unsigned char* lds, const Gemm g, const Sched& S, const Epi& E, const int tid_in) {
    int tid = tid_in; asm volatile("" : "+v"(tid));
    const int wid = __builtin_amdgcn_readfirstlane(tid >> 6), lane = tid & 63, wr = wid >> 2, wc = wid & 3, fr = lane & 15, fq = lane >> 4;
    int K = g.K; asm volatile("" : "+s"(K)); const int nt = K / BK;
    unsigned voffA[2], voffB[2];
#pragma unroll
    for (int i = 0; i < 2; ++i) { int R, C; stage_rc(tid * 16 + i * 8192, R, C); const int Rb = Epi::PERM ? ((R & ~31) + perm32(R & 31)) : R;
        voffA[i] = (unsigned)(R * K + C) * 2u; voffB[i] = (unsigned)(Rb * K + C) * 2u; }
    const size_t kstep = (size_t)(BK * 2);
    const size_t hstep = (size_t)HALF * K * 2;
    const size_t tstep = 2 * hstep;
    const unsigned ldsw = (unsigned)wid * 1024u;
    const int aoff = lds_byte(wr * 64 + fr, fq * 8), boff = lds_byte(wc * 32 + fr, fq * 8);
#define PG8_SA(b, h) (((b) * 2 + (h)) * HTB)
#define PG8_SB(b, h) ((4 + (b) * 2 + (h)) * HTB)
#define PG8_STAGE(bufoff, gbase, voff) do { _Pragma("unroll") for (int _i = 0; _i < 2; ++_i) { unsigned vo_ = (voff)[_i]; asm volatile("" : "+v"(vo_));   \
        __builtin_amdgcn_global_load_lds((const unsigned*)((const char*)(gbase) + vo_), (PG8_LAS unsigned*)(lds + (bufoff) + ldsw + _i * 8192), 16, 0, 0); } } while (0)
#define PG8_LDA(dst, b, h) do { _Pragma("unroll") for (int m = 0; m < 4; ++m) { const bf16x8 x0_ = *(const PG8_LAS bf16x8*)(lds + PG8_SA(b, h) + aoff + m * 2048), x1_ = *(const PG8_LAS bf16x8*)(lds + PG8_SA(b, h) + aoff + m * 2048 + 1024); \
        if constexpr (F8 >= 0) dst##8[m] = PG8_CAT(x0_, x1_); else { dst[m][0] = x0_; dst[m][1] = x1_; } } } while (0)
#define PG8_LDB(dst, b, h) do { _Pragma("unroll") for (int n = 0; n < 2; ++n) { const bf16x8 x0_ = *(const PG8_LAS bf16x8*)(lds + PG8_SB(b, h) + boff + n * 2048), x1_ = *(const PG8_LAS bf16x8*)(lds + PG8_SB(b, h) + boff + n * 2048 + 1024); \
        if constexpr (F8 >= 0) dst##8[n] = PG8_CAT(x0_, x1_); else { dst[n][0] = x0_; dst[n][1] = x1_; } } } while (0)
#define PG8_CAT(x0, x1) ({ const v4i_t lo_ = __builtin_bit_cast(v4i_t, x0), hi_ = __builtin_bit_cast(v4i_t, x1); (v8i_t){lo_[0], lo_[1], lo_[2], lo_[3], hi_[0], hi_[1], hi_[2], hi_[3]}; })
#define PG8_MMA(ai, bj, At, Bt) do { __builtin_amdgcn_s_setprio(1); _Pragma("unroll") for (int m = 0; m < 4; ++m) _Pragma("unroll") for (int n = 0; n < 2; ++n) { \
        if constexpr (F8 >= 0) acc[ai][bj][m][n] = __builtin_amdgcn_mfma_scale_f32_16x16x128_f8f6f4(Bt##8[n], At##8[m], acc[ai][bj][m][n], 0, 0, 0, 0x7f7f7f7f, 0, (127 - F8) * 0x01010101); \
        else { _Pragma("unroll") for (int k = 0; k < 2; ++k) acc[ai][bj][m][n] = __builtin_amdgcn_mfma_f32_16x16x32_bf16(Bt[n][k], At[m][k], acc[ai][bj][m][n], 0, 0, 0); } } \
        __builtin_amdgcn_s_setprio(0); } while (0)
#define PG8_WAIT_V(n) asm volatile("s_waitcnt vmcnt(" #n ")" ::: "memory")
#define PG8_WAIT_L(n) asm volatile("s_waitcnt lgkmcnt(" #n ")" ::: "memory")
#define PG8_BAR __builtin_amdgcn_s_barrier()
#define PG8_SCHED __builtin_amdgcn_sched_barrier(0)
    Unit cur, nxt; int ui = 0;
    if (!S.next(0, cur)) return;
    f32x4 acc[2][2][4][2];
#pragma unroll
    for (int a = 0; a < 2; ++a)
#pragma unroll
        for (int b = 0; b < 2; ++b)
#pragma unroll
            for (int m = 0; m < 4; ++m)
#pragma unroll
                for (int n = 0; n < 2; ++n) acc[a][b][m][n] = (f32x4){0.f, 0.f, 0.f, 0.f};
    bf16x8 At[4][2], B0[2][2], B1[2][2]; v8i_t At8[4], B08[2], B18[2];
    const char* cA = (const char*)g.A + (size_t)cur.pm * tstep; const char* cB = (const char*)g.Bt + (size_t)cur.pn * tstep;
    S.a_ready(cur);
    if constexpr (SP2) {
        PG8_STAGE(PG8_SB(0, 0), cB, voffB); PG8_STAGE(PG8_SB(0, 1), cB + hstep, voffB); PG8_STAGE(PG8_SA(0, 0), cA, voffA); PG8_STAGE(PG8_SA(0, 1), cA + hstep, voffA);
        if (wr == 1) PG8_BAR;
        PG8_WAIT_V(2); PG8_BAR;
        PG8_STAGE(PG8_SB(1, 0), cB + kstep, voffB); PG8_STAGE(PG8_SA(1, 0), cA + kstep, voffA); PG8_STAGE(PG8_SB(1, 1), cB + hstep + kstep, voffB);
        PG8_WAIT_V(6); PG8_BAR;
    } else {
        PG8_STAGE(PG8_SB(0, 0), cB, voffB); PG8_STAGE(PG8_SA(0, 0), cA, voffA); PG8_STAGE(PG8_SB(0, 1), cB + hstep, voffB); PG8_STAGE(PG8_SA(0, 1), cA + hstep, voffA);
        if (wr == 1) PG8_BAR;
        PG8_WAIT_V(4); PG8_BAR;
        PG8_STAGE(PG8_SB(1, 0), cB + kstep, voffB); PG8_STAGE(PG8_SA(1, 0), cA + kstep, voffA); PG8_STAGE(PG8_SB(1, 1), cB + hstep + kstep, voffB);
        PG8_WAIT_V(6); PG8_BAR;
    }
    for (;;) {
        const bool has_next = S.next(ui + 1, nxt);
        const char* nA = has_next ? (const char*)g.A + (size_t)nxt.pm * tstep : cA; const char* nB = has_next ? (const char*)g.Bt + (size_t)nxt.pn * tstep : cB;
        for (int t = 0; t < nt; t += 2) {
            const bool last = (t == nt - 2);
            const char* a1 = cA + (size_t)(t + 1) * kstep;
            const char* a2 = last ? nA : cA + (size_t)(t + 2) * kstep; const char* b2 = last ? nB : cB + (size_t)(t + 2) * kstep;
            const char* a3 = a2 + kstep; const char* b3 = b2 + kstep;
            if (last && has_next) S.a_ready(nxt);
            if constexpr (SP2) {
            PG8_LDB(B0, 0, 0); PG8_LDB(B1, 0, 1); PG8_SCHED; PG8_LDA(At, 0, 0); PG8_STAGE(PG8_SA(1, 1), a1 + hstep, voffA);
            PG8_WAIT_V(8); PG8_WAIT_L(0); PG8_BAR; PG8_MMA(0, 0, At, B0); PG8_MMA(0, 1, At, B1); PG8_BAR; PG8_SCHED;
            PG8_LDA(At, 0, 1); PG8_STAGE(PG8_SB(0, 0), b2, voffB); PG8_STAGE(PG8_SB(0, 1), b2 + hstep, voffB); PG8_STAGE(PG8_SA(0, 0), a2, voffA);
            PG8_WAIT_V(8); PG8_WAIT_L(0); PG8_BAR; PG8_MMA(1, 0, At, B0); PG8_MMA(1, 1, At, B1); PG8_BAR; PG8_SCHED;
            PG8_LDB(B0, 1, 0); PG8_LDB(B1, 1, 1); PG8_SCHED; PG8_LDA(At, 1, 0); PG8_STAGE(PG8_SA(0, 1), a2 + hstep, voffA);
            PG8_WAIT_V(8); PG8_WAIT_L(0); PG8_BAR; PG8_MMA(0, 0, At, B0); PG8_MMA(0, 1, At, B1); PG8_BAR; PG8_SCHED;
            PG8_LDA(At, 1, 1); PG8_STAGE(PG8_SB(1, 0), b3, voffB); PG8_STAGE(PG8_SB(1, 1), b3 + hstep, voffB); PG8_STAGE(PG8_SA(1, 0), a3, voffA);
            PG8_WAIT_V(8); PG8_WAIT_L(0); PG8_BAR; PG8_MMA(1, 0, At, B0); PG8_MMA(1, 1, At, B1); PG8_BAR; PG8_SCHED;
            } else {
            PG8_LDB(B0, 0, 0); PG8_SCHED; PG8_LDA(At, 0, 0); PG8_STAGE(PG8_SA(1, 1), a1 + hstep, voffA);
            PG8_WAIT_L(8); PG8_BAR; PG8_WAIT_L(0); PG8_MMA(0, 0, At, B0); PG8_BAR; PG8_SCHED;
            PG8_LDB(B1, 0, 1); PG8_STAGE(PG8_SB(0, 0), b2, voffB);
            PG8_BAR; PG8_WAIT_L(0); PG8_MMA(0, 1, At, B1); PG8_BAR;
            PG8_LDA(At, 0, 1); PG8_STAGE(PG8_SA(0, 0), a2, voffA);
            PG8_BAR; PG8_WAIT_L(0); PG8_MMA(1, 0, At, B0); PG8_BAR; PG8_SCHED;
            PG8_STAGE(PG8_SB(0, 1), b2 + hstep, voffB);
            PG8_WAIT_V(6); PG8_BAR; PG8_MMA(1, 1, At, B1); PG8_BAR;
            PG8_LDB(B0, 1, 0); PG8_SCHED; PG8_LDA(At, 1, 0); PG8_STAGE(PG8_SA(0, 1), a2 + hstep, voffA);
            PG8_WAIT_L(8); PG8_BAR; PG8_WAIT_L(0); PG8_MMA(0, 0, At, B0); PG8_BAR; PG8_SCHED;
            PG8_LDB(B1, 1, 1); PG8_STAGE(PG8_SB(1, 0), b3, voffB);
            PG8_BAR; PG8_WAIT_L(0); PG8_MMA(0, 1, At, B1); PG8_BAR;
            PG8_LDA(At, 1, 1); PG8_STAGE(PG8_SA(1, 0), a3, voffA);
            PG8_BAR; PG8_WAIT_L(0); PG8_MMA(1, 0, At, B0); PG8_BAR; PG8_SCHED;
            PG8_STAGE(PG8_SB(1, 1), b3 + hstep, voffB);
            PG8_WAIT_V(6); PG8_BAR; PG8_MMA(1, 1, At, B1); PG8_BAR;
            }
        }
        if constexpr (ALIGN_EPI) { if (wr == 0) PG8_BAR; }
        if constexpr (!Epi::AFTER_DRAIN) { E(acc, cur, wr, wc, fr, fq); S.done(cur); }
        if (!has_next) break;
#pragma unroll
        for (int a = 0; a < 2; ++a)
#pragma unroll
            for (int b = 0; b < 2; ++b)
#pragma unroll
                for (int m = 0; m < 4; ++m)
#pragma unroll
                    for (int n = 0; n < 2; ++n) acc[a][b][m][n] = (f32x4){0.f, 0.f, 0.f, 0.f};
        cur = nxt; cA = nA; cB = nB; ++ui;
        if constexpr (ALIGN_EPI) { if (wr == 1) PG8_BAR; }
    }
    PG8_WAIT_V(0);
    if constexpr (!ALIGN_EPI) { if (wr == 0) PG8_BAR; }
    PG8_BAR;
    if constexpr (Epi::AFTER_DRAIN) { E.fused(acc, cur, wr, wc, fr, fq, lds, wid, lane); S.done(cur); }
#undef PG8_SA
#undef PG8_SB
#undef PG8_STAGE
#undef PG8_LDA
#undef PG8_LDB
#undef PG8_MMA
#undef PG8_WAIT_V
#undef PG8_WAIT_L
#undef PG8_BAR
#undef PG8_SCHED
}
template <class Epi, class Sched, bool ALIGN_EPI = true, bool SP2 = true, int F8 = -1>
__device__ __forceinline__ void gemm_phase_gather(PG8_LAS unsigned char* lds, const Gemm g, const Sched& S, const Epi& E, const int tid_in) {
    int tid = tid_in; asm volatile("" : "+v"(tid));
    static_assert(SP2, "gather form: SP2 loop only");
    const int wid = __builtin_amdgcn_readfirstlane(tid >> 6), lane = tid & 63, wr = wid >> 2, wc = wid & 3, fr = lane & 15, fq = lane >> 4;
    int K = g.K; asm volatile("" : "+s"(K)); const int nt = K / BK;
    unsigned voffA[2], voffB[2];
#pragma unroll
    for (int i = 0; i < 2; ++i) { int R, C; stage_rc(tid * 16 + i * 8192, R, C); const int Rb = Epi::PERM ? ((R & ~31) + perm32(R & 31)) : R;
        voffA[i] = (unsigned)(R * K + C) * 2u; voffB[i] = (unsigned)(Rb * K + C) * 2u; }
    int gR, gC; stage_rc(tid * 16, gR, gC);
    unsigned vG[2][2], vN[2][2];
    const size_t kstep = (size_t)(BK * 2);
    const size_t hstep = (size_t)HALF * K * 2;
    const size_t tstep = 2 * hstep;
    const unsigned ldsw = (unsigned)wid * 1024u;
    const int aoff = lds_byte(wr * 64 + fr, fq * 8), boff = lds_byte(wc * 32 + fr, fq * 8);
#define PG8_SA(b, h) (((b) * 2 + (h)) * HTB)
#define PG8_SB(b, h) ((4 + (b) * 2 + (h)) * HTB)
#define PG8_STAGE(bufoff, gbase, voff) do { _Pragma("unroll") for (int _i = 0; _i < 2; ++_i) { unsigned vo_ = (voff)[_i]; asm volatile("" : "+v"(vo_));   \
        __builtin_amdgcn_global_load_lds((const unsigned*)((const char*)(gbase) + vo_), (PG8_LAS unsigned*)(lds + (bufoff) + ldsw + _i * 8192), 16, 0, 0); } } while (0)
#define PG8_LDA(dst, b, h) do { _Pragma("unroll") for (int m = 0; m < 4; ++m) { const bf16x8 x0_ = *(const PG8_LAS bf16x8*)(lds + PG8_SA(b, h) + aoff + m * 2048), x1_ = *(const PG8_LAS bf16x8*)(lds + PG8_SA(b, h) + aoff + m * 2048 + 1024); \
        if constexpr (F8 >= 0) dst##8[m] = PG8_CAT(x0_, x1_); else { dst[m][0] = x0_; dst[m][1] = x1_; } } } while (0)
#define PG8_LDB(dst, b, h) do { _Pragma("unroll") for (int n = 0; n < 2; ++n) { const bf16x8 x0_ = *(const PG8_LAS bf16x8*)(lds + PG8_SB(b, h) + boff + n * 2048), x1_ = *(const PG8_LAS bf16x8*)(lds + PG8_SB(b, h) + boff + n * 2048 + 1024); \
        if constexpr (F8 >= 0) dst##8[n] = PG8_CAT(x0_, x1_); else { dst[n][0] = x0_; dst[n][1] = x1_; } } } while (0)
#define PG8_CAT(x0, x1) ({ const v4i_t lo_ = __builtin_bit_cast(v4i_t, x0), hi_ = __builtin_bit_cast(v4i_t, x1); (v8i_t){lo_[0], lo_[1], lo_[2], lo_[3], hi_[0], hi_[1], hi_[2], hi_[3]}; })
#define PG8_MMA(ai, bj, At, Bt) do { __builtin_amdgcn_s_setprio(1); _Pragma("unroll") for (int m = 0; m < 4; ++m) _Pragma("unroll") for (int n = 0; n < 2; ++n) { \
        if constexpr (F8 >= 0) acc[ai][bj][m][n] = __builtin_amdgcn_mfma_scale_f32_16x16x128_f8f6f4(Bt##8[n], At##8[m], acc[ai][bj][m][n], 0, 0, 0, 0x7f7f7f7f, 0, (127 - F8) * 0x01010101); \
        else { _Pragma("unroll") for (int k = 0; k < 2; ++k) acc[ai][bj][m][n] = __builtin_amdgcn_mfma_f32_16x16x32_bf16(Bt[n][k], At[m][k], acc[ai][bj][m][n], 0, 0, 0); } } \
        __builtin_amdgcn_s_setprio(0); } while (0)
#define PG8_WAIT_V(n) asm volatile("s_waitcnt vmcnt(" #n ")" ::: "memory")
#define PG8_WAIT_L(n) asm volatile("s_waitcnt lgkmcnt(" #n ")" ::: "memory")
#define PG8_BAR __builtin_amdgcn_s_barrier()
#define PG8_SCHED __builtin_amdgcn_sched_barrier(0)
    Unit cur, nxt; int ui = 0;
    if (!S.next(0, cur)) return;
    f32x4 acc[2][2][4][2];
#pragma unroll
    for (int a = 0; a < 2; ++a)
#pragma unroll
        for (int b = 0; b < 2; ++b)
#pragma unroll
            for (int m = 0; m < 4; ++m)
#pragma unroll
                for (int n = 0; n < 2; ++n) acc[a][b][m][n] = (f32x4){0.f, 0.f, 0.f, 0.f};
    bf16x8 At[4][2], B0[2][2], B1[2][2]; v8i_t At8[4], B08[2], B18[2];
    const char* cA = (const char*)g.A; const char* cB = (const char*)g.Bt + (size_t)cur.pn * tstep;
    S.a_ready(cur);
#pragma unroll
    for (int h = 0; h < 2; ++h)
#pragma unroll
        for (int i = 0; i < 2; ++i) vG[h][i] = (unsigned)S.tok(cur, h * HALF + gR + 64 * i) * (unsigned)(K * 2) + (unsigned)(gC * 2);
    if constexpr (SP2) {
        PG8_STAGE(PG8_SB(0, 0), cB, voffB); PG8_STAGE(PG8_SB(0, 1), cB + hstep, voffB); PG8_STAGE(PG8_SA(0, 0), cA, vG[0]); PG8_STAGE(PG8_SA(0, 1), cA, vG[1]);
        if (wr == 1) PG8_BAR;
        PG8_WAIT_V(2); PG8_BAR;
        PG8_STAGE(PG8_SB(1, 0), cB + kstep, voffB); PG8_STAGE(PG8_SA(1, 0), cA + kstep, vG[0]); PG8_STAGE(PG8_SB(1, 1), cB + hstep + kstep, voffB);
        PG8_WAIT_V(6); PG8_BAR;
    } else {
        PG8_STAGE(PG8_SB(0, 0), cB, voffB); PG8_STAGE(PG8_SA(0, 0), cA, voffA); PG8_STAGE(PG8_SB(0, 1), cB + hstep, voffB); PG8_STAGE(PG8_SA(0, 1), cA + hstep, voffA);
        if (wr == 1) PG8_BAR;
        PG8_WAIT_V(4); PG8_BAR;
        PG8_STAGE(PG8_SB(1, 0), cB + kstep, voffB); PG8_STAGE(PG8_SA(1, 0), cA + kstep, voffA); PG8_STAGE(PG8_SB(1, 1), cB + hstep + kstep, voffB);
        PG8_WAIT_V(6); PG8_BAR;
    }
    for (;;) {
        const bool has_next = S.next(ui + 1, nxt);
        const char* nA = cA; const char* nB = has_next ? (const char*)g.Bt + (size_t)nxt.pn * tstep : cB;
        for (int t = 0; t < nt; t += 2) {
            const bool last = (t == nt - 2);
            const char* a1 = cA + (size_t)(t + 1) * kstep;
            const char* a2 = last ? nA : cA + (size_t)(t + 2) * kstep; const char* b2 = last ? nB : cB + (size_t)(t + 2) * kstep;
            const char* a3 = a2 + kstep; const char* b3 = b2 + kstep;
            if (last && has_next) { S.a_ready(nxt);
#pragma unroll
                for (int h = 0; h < 2; ++h)
#pragma unroll
                    for (int i = 0; i < 2; ++i) vN[h][i] = (unsigned)S.tok(nxt, h * HALF + gR + 64 * i) * (unsigned)(K * 2) + (unsigned)(gC * 2); }
            if constexpr (SP2) {
            PG8_LDB(B0, 0, 0); PG8_LDB(B1, 0, 1); PG8_SCHED; PG8_LDA(At, 0, 0); PG8_STAGE(PG8_SA(1, 1), a1, vG[1]);
            if (last && has_next) { vG[0][0] = vN[0][0]; vG[0][1] = vN[0][1]; vG[1][0] = vN[1][0]; vG[1][1] = vN[1][1]; }
            PG8_WAIT_V(8); PG8_WAIT_L(0); PG8_BAR; PG8_MMA(0, 0, At, B0); PG8_MMA(0, 1, At, B1); PG8_BAR; PG8_SCHED;
            PG8_LDA(At, 0, 1); PG8_STAGE(PG8_SB(0, 0), b2, voffB); PG8_STAGE(PG8_SB(0, 1), b2 + hstep, voffB); PG8_STAGE(PG8_SA(0, 0), a2, vG[0]);
            PG8_WAIT_V(8); PG8_WAIT_L(0); PG8_BAR; PG8_MMA(1, 0, At, B0); PG8_MMA(1, 1, At, B1); PG8_BAR; PG8_SCHED;
            PG8_LDB(B0, 1, 0); PG8_LDB(B1, 1, 1); PG8_SCHED; PG8_LDA(At, 1, 0); PG8_STAGE(PG8_SA(0, 1), a2, vG[1]);
            PG8_WAIT_V(8); PG8_WAIT_L(0); PG8_BAR; PG8_MMA(0, 0, At, B0); PG8_MMA(0, 1, At, B1); PG8_BAR; PG8_SCHED;
            PG8_LDA(At, 1, 1); PG8_STAGE(PG8_SB(1, 0), b3, voffB); PG8_STAGE(PG8_SB(1, 1), b3 + hstep, voffB); PG8_STAGE(PG8_SA(1, 0), a3, vG[0]);
            PG8_WAIT_V(8); PG8_WAIT_L(0); PG8_BAR; PG8_MMA(1, 0, At, B0); PG8_MMA(1, 1, At, B1); PG8_BAR; PG8_SCHED;
            } else {
            PG8_LDB(B0, 0, 0); PG8_SCHED; PG8_LDA(At, 0, 0); PG8_STAGE(PG8_SA(1, 1), a1 + hstep, voffA);
            PG8_WAIT_L(8); PG8_BAR; PG8_WAIT_L(0); PG8_MMA(0, 0, At, B0); PG8_BAR; PG8_SCHED;
            PG8_LDB(B1, 0, 1); PG8_STAGE(PG8_SB(0, 0), b2, voffB);
            PG8_BAR; PG8_WAIT_L(0); PG8_MMA(0, 1, At, B1); PG8_BAR;
            PG8_LDA(At, 0, 1); PG8_STAGE(PG8_SA(0, 0), a2, voffA);
            PG8_BAR; PG8_WAIT_L(0); PG8_MMA(1, 0, At, B0); PG8_BAR; PG8_SCHED;
            PG8_STAGE(PG8_SB(0, 1), b2 + hstep, voffB);
            PG8_WAIT_V(6); PG8_BAR; PG8_MMA(1, 1, At, B1); PG8_BAR;
            PG8_LDB(B0, 1, 0); PG8_SCHED; PG8_LDA(At, 1, 0); PG8_STAGE(PG8_SA(0, 1), a2 + hstep, voffA);
            PG8_WAIT_L(8); PG8_BAR; PG8_WAIT_L(0); PG8_MMA(0, 0, At, B0); PG8_BAR; PG8_SCHED;
            PG8_LDB(B1, 1, 1); PG8_STAGE(PG8_SB(1, 0), b3, voffB);
            PG8_BAR; PG8_WAIT_L(0); PG8_MMA(0, 1, At, B1); PG8_BAR;
            PG8_LDA(At, 1, 1); PG8_STAGE(PG8_SA(1, 0), a3, voffA);
            PG8_BAR; PG8_WAIT_L(0); PG8_MMA(1, 0, At, B0); PG8_BAR; PG8_SCHED;
            PG8_STAGE(PG8_SB(1, 1), b3 + hstep, voffB);
            PG8_WAIT_V(6); PG8_BAR; PG8_MMA(1, 1, At, B1); PG8_BAR;
            }
        }
        if constexpr (ALIGN_EPI) { if (wr == 0) PG8_BAR; }
        if constexpr (!Epi::AFTER_DRAIN) { E(acc, cur, wr, wc, fr, fq); S.done(cur); }
        if (!has_next) break;
#pragma unroll
        for (int a = 0; a < 2; ++a)
#pragma unroll
            for (int b = 0; b < 2; ++b)
#pragma unroll
                for (int m = 0; m < 4; ++m)
#pragma unroll
                    for (int n = 0; n < 2; ++n) acc[a][b][m][n] = (f32x4){0.f, 0.f, 0.f, 0.f};
        cur = nxt; cA = nA; cB = nB; ++ui;
        if constexpr (ALIGN_EPI) { if (wr == 1) PG8_BAR; }
    }
    PG8_WAIT_V(0);
    if constexpr (!ALIGN_EPI) { if (wr == 0) PG8_BAR; }
    PG8_BAR;
    if constexpr (Epi::AFTER_DRAIN) { E.fused(acc, cur, wr, wc, fr, fq, lds, wid, lane); S.done(cur); }
#undef PG8_SA
#undef PG8_SB
#undef PG8_STAGE
#undef PG8_LDA
#undef PG8_LDB
#undef PG8_MMA
#undef PG8_WAIT_V
#undef PG8_WAIT_L
#undef PG8_BAR
#undef PG8_SCHED
}
}
namespace att {
typedef unsigned short bf16;
using bf16x8 = __attribute__((ext_vector_type(8))) short;
using s16x4  = __attribute__((ext_vector_type(4))) short;
using f32x16 = __attribute__((ext_vector_type(16))) float;
using u32x4  = __attribute__((ext_vector_type(4))) unsigned;
using f32x4_t = __attribute__((ext_vector_type(4))) float;
constexpr int NW = 8, QBLK = 32, KVBLK = 64, SEQ = 4096;
constexpr int LDQ = 1536, LDKV = 2048, LDO = 1024;
constexpr int SHM_VT = 128 * 80, SHM_K8 = 64 * 208;
constexpr int OFF_V = 0, OFF_K8 = 3 * SHM_VT, OFF_WS = OFF_K8 + 2 * SHM_K8, LDS_BYTES = OFF_WS + NW * 64 * 4 + 64;
typedef int v8i32 __attribute__((ext_vector_type(8)));
typedef int v4i32 __attribute__((ext_vector_type(4)));
typedef int v2i32 __attribute__((ext_vector_type(2)));
constexpr int T_TOK = 8 * SEQ;
#define ASBAR() __builtin_amdgcn_sched_barrier(0)
__device__ __forceinline__ int crow(int r, int hi) { return (r & 3) + 8 * (r >> 2) + 4 * hi; }
__device__ __forceinline__ unsigned cvtpk(float lo, float hi) { unsigned r; asm volatile("v_cvt_pk_bf16_f32 %0, %1, %2" : "=v"(r) : "v"(lo), "v"(hi)); return r; }
__device__ __forceinline__ float bf2f(unsigned short b) { return __uint_as_float(((unsigned)b) << 16); }
template <bool SHIFT> __device__ __forceinline__ void smA(f32x16& p0, float negm) { for (int r = 0; r < 16; ++r) p0[r] = __builtin_amdgcn_exp2f(SHIFT ? p0[r] + negm : p0[r]); }
template <bool SHIFT> __device__ __forceinline__ void smB(f32x16& p0, f32x16& p1, float& l_reg, v8i32& p8, float negm) {
  for (int r = 0; r < 16; ++r) p1[r] = __builtin_amdgcn_exp2f(SHIFT ? p1[r] + negm : p1[r]);
  float ps = 0; for (int r = 0; r < 16; ++r) ps += p0[r]; for (int r = 0; r < 16; ++r) ps += p1[r];
  l_reg += ps;
#pragma unroll
  for (int w = 0; w < 4; ++w) { int a = 0, bq = 0;
    a = __builtin_amdgcn_cvt_pk_bf8_f32(p0[4 * w], p0[4 * w + 1], a, false); a = __builtin_amdgcn_cvt_pk_bf8_f32(p0[4 * w + 2], p0[4 * w + 3], a, true);
    bq = __builtin_amdgcn_cvt_pk_bf8_f32(p1[4 * w], p1[4 * w + 1], bq, false); bq = __builtin_amdgcn_cvt_pk_bf8_f32(p1[4 * w + 2], p1[4 * w + 3], bq, true);
    p8[w] = a; p8[4 + w] = bq; }
}
template <bool SHIFT> __device__ __forceinline__ void qkt(f32x16& p0, f32x16& p1, const char* K8, const v8i32* q8, float negm, int r32, int hi) {
  p0 = f32x16{}; p1 = f32x16{};
#define K8RD(m, half, part) (*reinterpret_cast<const v4i32*>(K8 + ((half) * 32 + r32) * 208 + (m) * 64 + hi * 32 + (part) * 16))
#define K8FR(m, half) ({ const v4i32 lo_ = K8RD(m, half, 0), hi_ = K8RD(m, half, 1); (v8i32){lo_[0], lo_[1], lo_[2], lo_[3], hi_[0], hi_[1], hi_[2], hi_[3]}; })
  v8i32 a0 = K8FR(0, 0), a1 = K8FR(0, 1), b0 = K8FR(1, 0), b1 = K8FR(1, 1);
  ASBAR();
  p0 = __builtin_amdgcn_mfma_scale_f32_32x32x64_f8f6f4(a0, q8[0], p0, 0, 0, 0, 0x7f7f7f7f, 0, 0x7f7f7f7f);
  p1 = __builtin_amdgcn_mfma_scale_f32_32x32x64_f8f6f4(a1, q8[0], p1, 0, 0, 0, 0x7f7f7f7f, 0, 0x7f7f7f7f);
  a0 = K8FR(2, 0); a1 = K8FR(2, 1);
  ASBAR();
  p0 = __builtin_amdgcn_mfma_scale_f32_32x32x64_f8f6f4(b0, q8[1], p0, 0, 0, 0, 0x7f7f7f7f, 0, 0x7f7f7f7f);
  p1 = __builtin_amdgcn_mfma_scale_f32_32x32x64_f8f6f4(b1, q8[1], p1, 0, 0, 0, 0x7f7f7f7f, 0, 0x7f7f7f7f);
  ASBAR();
  p0 = __builtin_amdgcn_mfma_scale_f32_32x32x64_f8f6f4(a0, q8[2], p0, 0, 0, 0, 0x7f7f7f7f, 0, 0x7f7f7f7f);
  p1 = __builtin_amdgcn_mfma_scale_f32_32x32x64_f8f6f4(a1, q8[2], p1, 0, 0, 0, 0x7f7f7f7f, 0, 0x7f7f7f7f);
  ASBAR();
#undef K8RD
#undef K8FR
}
__device__ __forceinline__ void pv_d0(f32x16* o, const char* VT, v8i32 p8, int r32, int hi) {
#define VTFR(d0) ({ const v4i32 lo_ = *reinterpret_cast<const v4i32*>(VT + ((d0) * 32 + r32) * 80 + hi * 32), hi_ = *reinterpret_cast<const v4i32*>(VT + ((d0) * 32 + r32) * 80 + hi * 32 + 16); (v8i32){lo_[0], lo_[1], lo_[2], lo_[3], hi_[0], hi_[1], hi_[2], hi_[3]}; })
#define PVMMA(d0, fr) o[d0] = __builtin_amdgcn_mfma_scale_f32_32x32x64_f8f6f4(p8, fr, o[d0], 1  , 0  , 0, 0x7f7f7f7f, 0, 0x7f7f7f7f)
  v8i32 fa = VTFR(0), fb = VTFR(1);
  ASBAR();
  PVMMA(0, fa); fa = VTFR(2); ASBAR();
  PVMMA(1, fb); fb = VTFR(3); ASBAR();
  PVMMA(2, fa); PVMMA(3, fb); ASBAR();
#undef VTFR
#undef PVMMA
}
template <bool SHIFT> __device__ __forceinline__ bool attn_unit(int b, int h, int s0, const bf16* Qraw, const unsigned char* __restrict__ VT8g, const unsigned char* __restrict__ K8g, const unsigned char* __restrict__ KP8g, bf16* __restrict__ O,
                                          const float* rope, const float* qg, float smaxC, char* lds, int tid) {
  asm volatile("" : "+v"(tid));
  const int wid = __builtin_amdgcn_readfirstlane(tid >> 6), lane = tid & 63, r32 = lane & 31, hi = lane >> 5;
  asm volatile("" : "+s"(qg));
  char* V_lds = lds + OFF_V; char* K8_lds = lds + OFF_K8;
  float* ws = (float*)(lds + OFF_WS) + wid * 64; float* li_l = ws;
  constexpr float C = 0.072168783648703220f * 1.4426950408889634f;
  v8i32 q8[3];
  {
    typedef __attribute__((address_space(1))) const bf16x8 gbf16x8; typedef __attribute__((address_space(1))) const f32x4_t gf32x4;
    const long trow = (long)b * SEQ + s0 + wid * QBLK + r32;
    unsigned qo = (unsigned)((trow * LDQ + h * 192) * 2); const unsigned ro = (unsigned)(trow * 256), go = (unsigned)(hi * 128);
#define Qn_(i) (*(gbf16x8*)((const char*)Qraw + qo + hi * 64 + (i) * 16))
#define Qr_(i) (*(gbf16x8*)((const char*)Qraw + qo + 256 + (i) * 16))
#define rp4_(i) (*(gf32x4*)((const char*)rope + ro + (i) * 16))
#define qgn_(i) (*(gf32x4*)((const char*)qg + go + (i) * 16))
#define qgr_(i) (*(gf32x4*)((const char*)qg + 512 + (i) * 16))
    float ssn = 0.f, ssp = 0.f;
#pragma unroll
    for (int c = 0; c < 8; ++c) { const bf16x8 a = Qn_((c >> 2) * 8 + (c & 3)), r = Qr_(c);
#pragma unroll
      for (int j = 0; j < 8; ++j) { const float f = bf2f((unsigned short)a[j]), g = bf2f((unsigned short)r[j]); ssn += f * f; ssp += g * g; } }
    ssn += __shfl_xor(ssn, 32);
    const float rn = rsqrtf(ssn * (1.f / 128.f) + 1e-6f) * C, rp = rsqrtf(ssp * (1.f / 64.f) + 1e-6f) * C;
    { float rn_ = rn, rp_ = rp; asm volatile("" : "+v"(qo), "+v"(rn_), "+v"(rp_) :: "memory"); }
#pragma unroll
    for (int m = 0; m < 2; ++m)
#pragma unroll
      for (int c = 0; c < 4; ++c) { const bf16x8 raw = Qn_(8 * m + c); const f32x4_t ga = qgn_(16 * m + 2 * c), gb = qgn_(16 * m + 2 * c + 1); float g[8];
#pragma unroll
        for (int j = 0; j < 8; ++j) g[j] = bf2f((unsigned short)raw[j]) * rn * (j < 4 ? ga[j & 3] : gb[j & 3]);
        int w0 = 0, w1 = 0; w0 = __builtin_amdgcn_cvt_pk_fp8_f32(g[0], g[1], w0, false); w0 = __builtin_amdgcn_cvt_pk_fp8_f32(g[2], g[3], w0, true);
        w1 = __builtin_amdgcn_cvt_pk_fp8_f32(g[4], g[5], w1, false); w1 = __builtin_amdgcn_cvt_pk_fp8_f32(g[6], g[7], w1, true);
        asm volatile("" : "+v"(w0), "+v"(w1) :: "memory");        q8[m][2 * c] = w0; q8[m][2 * c + 1] = w1; }
#pragma unroll
    for (int c = 0; c < 4; ++c) {
      const bf16x8 r1 = Qr_(c), r2 = Qr_(4 + c);
      const f32x4_t g1a = qgr_(2 * c), g1b = qgr_(2 * c + 1), g2a = qgr_(8 + 2 * c), g2b = qgr_(8 + 2 * c + 1); float ov[8];
#pragma unroll
      for (int j = 0; j < 8; ++j) { const f32x4_t cs4 = rp4_(4 * c + (j >> 1));
        const float cs = cs4[(j & 1) * 2], sn = cs4[(j & 1) * 2 + 1];
        const float x1 = bf2f((unsigned short)r1[j]) * rp * (j < 4 ? g1a[j & 3] : g1b[j & 3]), x2 = bf2f((unsigned short)r2[j]) * rp * (j < 4 ? g2a[j & 3] : g2b[j & 3]);
        ov[j] = hi == 0 ? (x1 * cs - x2 * sn) : (x1 * sn + x2 * cs); }
      int w0 = 0, w1 = 0; w0 = __builtin_amdgcn_cvt_pk_fp8_f32(ov[0], ov[1], w0, false); w0 = __builtin_amdgcn_cvt_pk_fp8_f32(ov[2], ov[3], w0, true);
      w1 = __builtin_amdgcn_cvt_pk_fp8_f32(ov[4], ov[5], w1, false); w1 = __builtin_amdgcn_cvt_pk_fp8_f32(ov[6], ov[7], w1, true);
      asm volatile("" : "+v"(w0), "+v"(w1) :: "memory"); q8[2][2 * c] = w0; q8[2][2 * c + 1] = w1; }
  #undef Qn_
#undef Qr_
#undef rp4_
#undef qgn_
#undef qgr_
  }
  const float negm = 15.0f - smaxC;
  float l_reg = 0.f; f32x16 o[4] = {};
  const char* Vg = (const char*)(VT8g + (size_t)h * 128 * T_TOK + (size_t)b * SEQ); const char* Kg = (const char*)(K8g + ((long)b * SEQ * 8 + h) * 128); const char* Pg = (const char*)(KP8g + (long)b * SEQ * 64);
  const int vc = tid >> 2, vq = tid & 3, vst = vc * 80 + 16 * (vq >> 1) + 8 * (vq & 1); const unsigned gvt = (unsigned)vc * (unsigned)T_TOK + 16u * (unsigned)vq;
  const int kr = tid >> 3, kc = tid & 7, kst = kr * 208 + kc * 16; const unsigned gk8 = (unsigned)(kr * 1024 + kc * 16);
  const int pr = (tid & 255) >> 2, pc = tid & 3, pst = pr * 208 + 128 + pc * 16; const unsigned gp8 = (unsigned)(pr * 64 + pc * 16);
  v4i32 s_v, s_k, s_p;
#define SLOAD(k0) do { s_v = *reinterpret_cast<const v4i32*>(Vg + (size_t)(k0) + gvt); \
    s_k = *reinterpret_cast<const v4i32*>(Kg + (size_t)(k0) * 1024 + gk8); if (tid < 256) s_p = *reinterpret_cast<const v4i32*>(Pg + (size_t)(k0) * 64 + gp8); } while (0)
#define SWRITE(kbuf, vbuf_) do { { v2i32 a_ = {s_v[0], s_v[2]}, b_ = {s_v[1], s_v[3]}; *(v2i32*)(V_lds + (vbuf_) * SHM_VT + vst) = a_; *(v2i32*)(V_lds + (vbuf_) * SHM_VT + vst + 32) = b_; } \
    *(v4i32*)(K8_lds + (kbuf) * SHM_K8 + kst) = s_k; if (tid < 256) *(v4i32*)(K8_lds + (kbuf) * SHM_K8 + pst) = s_p; } while (0)
  constexpr int NT = SEQ / KVBLK;
  v8i32 p8;
  SLOAD(0); SWRITE(0, 0); __syncthreads(); SLOAD(KVBLK);
  if (wid < 4) {
    for (int j = 0, kb = 0, vbuf = 0, vnx = 1; j < NT; ++j) {
      f32x16 p0, p1;
      qkt<SHIFT>(p0, p1, K8_lds + kb * SHM_K8, q8, negm, r32, hi);
      smA<SHIFT>(p0, negm); smB<SHIFT>(p0, p1, l_reg, p8, negm); ASBAR();
      pv_d0(o, V_lds + vbuf * SHM_VT, p8, r32, hi);
      if (j + 1 < NT) SWRITE(kb ^ 1, vnx);
      __syncthreads();
      if (j + 2 < NT) SLOAD((j + 2) * KVBLK);
      kb ^= 1; vbuf = vnx; vnx = vnx == 2 ? 0 : vnx + 1;
    }
  } else {
    int vprev = 0;
    __builtin_amdgcn_s_setprio(1);
    for (int j = 0, kb = 0, vbuf = 0, vnx = 1; j < NT; ++j) {
      f32x16 p0, p1;
      if (j > 0) pv_d0(o, V_lds + vprev * SHM_VT, p8, r32, hi);
      qkt<SHIFT>(p0, p1, K8_lds + kb * SHM_K8, q8, negm, r32, hi);
      smA<SHIFT>(p0, negm); smB<SHIFT>(p0, p1, l_reg, p8, negm); ASBAR();
      if (j + 1 < NT) SWRITE(kb ^ 1, vnx);
      __syncthreads();
      if (j + 2 < NT) SLOAD((j + 2) * KVBLK);
      kb ^= 1; vprev = vbuf; vbuf = vnx; vnx = vnx == 2 ? 0 : vnx + 1;
    }
    pv_d0(o, V_lds + vprev * SHM_VT, p8, r32, hi);
    __builtin_amdgcn_s_setprio(0);
  }
  int lane_e = lane; asm volatile("" : "+v"(lane_e));
  const int r32e = lane_e & 31, hie = lane_e >> 5;
  l_reg += __shfl_xor(l_reg, 32);
  int* satf = (int*)(lds + OFF_WS + NW * 64 * 4);
  if (!SHIFT) { const bool sat = __any(l_reg >= 57344.f); if (lane_e == 0) satf[wid] = sat ? 1 : 0; }
  if (hie == 0) li_l[r32e] = l_reg; asm volatile("s_waitcnt lgkmcnt(0)" ::: "memory");
  float rli[16];
#pragma unroll
  for (int r = 0; r < 16; ++r) rli[r] = __builtin_amdgcn_rcpf(li_l[crow(r, hie)]);
  char* Ow = (char*)O + ((long)b * SEQ + s0 + wid * QBLK) * LDO + h * 128;
#pragma unroll
  for (int r = 0; r < 16; ++r) { const unsigned ooff = (unsigned)(crow(r, hie) * LDO + r32e);
#pragma unroll
    for (int d0 = 0; d0 < 4; ++d0) { const int pk = __builtin_amdgcn_cvt_pk_fp8_f32(o[d0][r] * rli[r] * 32.f, 0.f, 0, false); *(unsigned char*)(Ow + ooff + d0 * 32) = (unsigned char)(pk & 0xff); } }
  __syncthreads();
  bool redo = false;
  if (!SHIFT) { redo = (satf[0] | satf[1] | satf[2] | satf[3] | satf[4] | satf[5] | satf[6] | satf[7]) != 0; __syncthreads(); }
  return redo;
#undef SLOAD
#undef SWRITE
}
}
#ifndef HD
#define HD __device__ __forceinline__
#endif
struct c32 { float x, y; };
HD c32 cmk(float x, float y) { c32 r; r.x = x; r.y = y; return r; }
HD c32 cadd(c32 a, c32 b) { return cmk(a.x + b.x, a.y + b.y); }
HD c32 csub(c32 a, c32 b) { return cmk(a.x - b.x, a.y - b.y); }
HD c32 cmul(c32 a, c32 b) { return cmk(a.x * b.x - a.y * b.y, a.x * b.y + a.y * b.x); }
HD c32 cmulc(c32 a, c32 b) { return cmk(a.x * b.x + a.y * b.y, a.y * b.x - a.x * b.y); }
constexpr int BR4(int i) { return ((i & 1) << 3) | ((i & 2) << 1) | ((i & 4) >> 1) | ((i & 8) >> 3); }
template <int SGN, int J> HD c32 tw16(c32 a) {
    if constexpr (J == 0) return a;
    else if constexpr (J == 4) return SGN < 0 ? cmk(a.y, -a.x) : cmk(-a.y, a.x);
    else {
        constexpr float CS[8] = {1.f, 0.92387953251128674f, 0.70710678118654752f, 0.38268343236508977f, 0.f, -0.38268343236508977f, -0.70710678118654752f, -0.92387953251128674f};
        constexpr float SN[8] = {0.f, 0.38268343236508977f, 0.70710678118654752f, 0.92387953251128674f, 1.f, 0.92387953251128674f, 0.70710678118654752f, 0.38268343236508977f};
        constexpr float c = CS[J], s = SN[J];
        if constexpr (SGN < 0) return cmk(a.x * c + a.y * s, a.y * c - a.x * s);
        else return cmk(a.x * c - a.y * s, a.y * c + a.x * s);
    }
}
#define FFT_BF(i, j, J) { const c32 u_ = v[i], w_ = v[j]; v[i] = cadd(u_, w_); v[j] = tw16<SGN, J>(csub(u_, w_)); }
template <int SGN> HD void dft16_dif(c32 (&v)[16]) {
    FFT_BF(0, 8, 0) FFT_BF(1, 9, 1) FFT_BF(2, 10, 2) FFT_BF(3, 11, 3) FFT_BF(4, 12, 4) FFT_BF(5, 13, 5) FFT_BF(6, 14, 6) FFT_BF(7, 15, 7)
    FFT_BF(0, 4, 0) FFT_BF(1, 5, 2) FFT_BF(2, 6, 4) FFT_BF(3, 7, 6) FFT_BF(8, 12, 0) FFT_BF(9, 13, 2) FFT_BF(10, 14, 4) FFT_BF(11, 15, 6)
    FFT_BF(0, 2, 0) FFT_BF(1, 3, 4) FFT_BF(4, 6, 0) FFT_BF(5, 7, 4) FFT_BF(8, 10, 0) FFT_BF(9, 11, 4) FFT_BF(12, 14, 0) FFT_BF(13, 15, 4)
    FFT_BF(0, 1, 0) FFT_BF(2, 3, 0) FFT_BF(4, 5, 0) FFT_BF(6, 7, 0) FFT_BF(8, 9, 0) FFT_BF(10, 11, 0) FFT_BF(12, 13, 0) FFT_BF(14, 15, 0)
}
#undef FFT_BF
#define FFT_BT(i, j, J) { const c32 u_ = v[i], w_ = tw16<SGN, J>(v[j]); v[i] = cadd(u_, w_); v[j] = csub(u_, w_); }
template <int SGN> HD void dft16_dit(c32 (&v)[16]) {
    FFT_BT(0, 1, 0) FFT_BT(2, 3, 0) FFT_BT(4, 5, 0) FFT_BT(6, 7, 0) FFT_BT(8, 9, 0) FFT_BT(10, 11, 0) FFT_BT(12, 13, 0) FFT_BT(14, 15, 0)
    FFT_BT(0, 2, 0) FFT_BT(1, 3, 4) FFT_BT(4, 6, 0) FFT_BT(5, 7, 4) FFT_BT(8, 10, 0) FFT_BT(9, 11, 4) FFT_BT(12, 14, 0) FFT_BT(13, 15, 4)
    FFT_BT(0, 4, 0) FFT_BT(1, 5, 2) FFT_BT(2, 6, 4) FFT_BT(3, 7, 6) FFT_BT(8, 12, 0) FFT_BT(9, 13, 2) FFT_BT(10, 14, 4) FFT_BT(11, 15, 6)
    FFT_BT(0, 8, 0) FFT_BT(1, 9, 1) FFT_BT(2, 10, 2) FFT_BT(3, 11, 3) FFT_BT(4, 12, 4) FFT_BT(5, 13, 5) FFT_BT(6, 14, 6) FFT_BT(7, 15, 7)
}
#undef FFT_BT
constexpr int FFT_PS = 272;
constexpr int FFT_EX_ELEMS = 16 * FFT_PS;
template <class EX> HD void fft_fwd_a(c32 (&v)[16], const c32* T1, EX ex, int tid) {
    dft16_dif<-1>(v);
#pragma unroll
    for (int p = 0; p < 16; ++p) { ex[p * FFT_PS + tid] = cmul(v[BR4(p)], T1[256 * p]); if ((p & 3) == 3) __builtin_amdgcn_sched_barrier(0); }
}
template <class EX> HD void fft_fwd_b(c32 (&v)[16], const c32* T2, EX exr, EX ex, int tid) {
    const int p2 = tid >> 4, c = tid & 15;
#pragma unroll
    for (int b = 0; b < 16; ++b) v[b] = exr[p2 * FFT_PS + 16 * b + c];
    dft16_dif<-1>(v);
#pragma unroll
    for (int q = 0; q < 16; ++q) ex[p2 * FFT_PS + q * 16 + ((c + q) & 15)] = cmul(v[BR4(q)], T2[q]);
}
template <class EX> HD void fft_fwd_c(c32 (&v)[16], EX ex, int tid) {
    const int p2 = tid >> 4, q = tid & 15;
#pragma unroll
    for (int c = 0; c < 16; ++c) v[c] = ex[p2 * FFT_PS + q * 16 + ((c + q) & 15)];
    dft16_dif<-1>(v);
}
template <class EX> HD void fft_inv_a(c32 (&v)[16], EX ex, int tid) {
    const int p = tid >> 4, q = tid & 15;
    dft16_dit<+1>(v);
#pragma unroll
    for (int c = 0; c < 16; ++c) ex[p * FFT_PS + q * 16 + ((c + q) & 15)] = v[c];
}
template <class EX> HD void fft_inv_b(c32 (&v)[16], const c32* T2, EX exr, EX ex, int tid) {
    const int p = tid >> 4, c = tid & 15;
#pragma unroll
    for (int q = 0; q < 16; ++q) v[BR4(q)] = cmulc(exr[p * FFT_PS + q * 16 + ((c + q) & 15)], T2[q]);
    dft16_dit<+1>(v);
#pragma unroll
    for (int b = 0; b < 16; ++b) ex[p * FFT_PS + 16 * b + c] = v[b];
}
template <class EX> HD void fft_inv_c(c32 (&v)[16], const c32* T1, EX ex, int tid) {
#pragma unroll
    for (int p = 0; p < 16; ++p) { v[BR4(p)] = cmulc(ex[p * FFT_PS + tid], T1[256 * p]); if ((p & 3) == 3) __builtin_amdgcn_sched_barrier(0); }
    dft16_dit<+1>(v);
}
constexpr int NWAVES = 8, NTHR = 512;
constexpr int BATCH = 8, SEQ = 4096, DM = 1024, T = BATCH * SEQ;
constexpr float EPS = 1e-6f;
constexpr size_t MiB = 1u << 20;
constexpr size_t WS_CTL = 0, CTL_ZERO_BYTES = 64 * 1024;
constexpr size_t WS_MOD = 1 * MiB;
constexpr size_t WS_HDNS = 1 * MiB + 512 * 1024;
constexpr size_t WS_W4S = 3 * MiB + 512 * 1024;
constexpr size_t WS_LIST = 101 * MiB;
constexpr size_t WS_WL = 396 * MiB;
constexpr size_t WS_WD = 8 * MiB;
constexpr size_t WS_WUQ = 9 * MiB;
constexpr size_t WS_WUKV = 10 * MiB;
constexpr size_t WS_WO = 11 * MiB;
constexpr size_t WS_WIN = 13 * MiB;
constexpr size_t WS_WOUT = 19 * MiB;
constexpr size_t WS_WGU = 21 * MiB;
constexpr size_t WS_WDN = 53 * MiB;
constexpr size_t R1 = 104 * MiB;
constexpr size_t R2 = 232 * MiB;
constexpr size_t R3 = 424 * MiB;
constexpr size_t WS_VT8 = R1, WS_XN2 = R1, WS_KF = R1;
constexpr size_t WS_XN = R2, WS_O = R2;
constexpr size_t WS_LAT = R2 + 64 * MiB;
constexpr size_t WS_HACT = R2 + 64 * MiB;
constexpr size_t WS_CQN = R2 + 128 * MiB;
constexpr size_t WS_CKVN = R2 + 144 * MiB;
constexpr size_t WS_KPE = R2 + 160 * MiB;
constexpr size_t WS_K8 = R2 + 64 * MiB;
constexpr size_t WS_ROPE = R2 + 164 * MiB;
constexpr size_t WS_QRAW = 408 * MiB;
constexpr size_t WS_XN2S = 424 * MiB;
constexpr size_t WS_XR = 424 * MiB;
constexpr size_t WS_HT = R2;
constexpr size_t WS_UT = R2;
constexpr size_t WS_Z = R2;
constexpr size_t WS_END = 512 * MiB;
constexpr int MS_ROWS = T + 24 * 256;
constexpr int CW_BAR = 4096;
constexpr int CW_FILT = 12352;
constexpr int CW_CNT = 8192;
constexpr int RING_OFF = 0, RING_BYTES = 147456;
constexpr int LDSCTL_OFF = RING_BYTES;
constexpr int MISC_OFF = LDSCTL_OFF;
constexpr int TINFO_OFF = LDSCTL_OFF + 256;
constexpr int RED_OFF = LDSCTL_OFF + 256 + 1280;
constexpr int EPIX_OFF = LDSCTL_OFF + 2048;
constexpr int LDS_BYTES = 163840;
static_assert(RED_OFF + 256 <= LDS_BYTES, "LDS map");

#define GAS __attribute__((address_space(1)))
#define LAS __attribute__((address_space(3)))
typedef unsigned short bf16;
typedef unsigned v4u __attribute__((ext_vector_type(4)));
typedef unsigned v2u __attribute__((ext_vector_type(2)));
typedef int v4i __attribute__((ext_vector_type(4)));
typedef float f32x4 __attribute__((ext_vector_type(4)));
typedef GAS unsigned gu32;
#define RLX_AGENT __ATOMIC_RELAXED, __HIP_MEMORY_SCOPE_AGENT
#define LDS_WAIT() asm volatile("s_waitcnt lgkmcnt(0)" ::: "memory")
__device__ __forceinline__ unsigned pk2(float lo, float hi) { return pg8::cvt_pk_bf16(lo, hi); }
__device__ __forceinline__ float bf2f(unsigned short b) { return __uint_as_float(((unsigned)b) << 16); }
__device__ __forceinline__ float wave_sum(float v) {
#define WS_DPP(x, ctrl, rmask) __int_as_float(__builtin_amdgcn_update_dpp(0, __float_as_int(x), ctrl, rmask, 0xf, false))
    v += WS_DPP(v, 0xB1, 0xf); v += WS_DPP(v, 0x4E, 0xf); v += WS_DPP(v, 0x141, 0xf); v += WS_DPP(v, 0x140, 0xf);
    v += WS_DPP(v, 0x142, 0xa); v += WS_DPP(v, 0x143, 0xc);
#undef WS_DPP
    return __int_as_float(__builtin_amdgcn_readlane(__float_as_int(v), 63));
}

#define XB_TMO      128
#define XB_XCNT(j)  (256  + 64 * (j))
#define XB_XSUB(j)  (1280 + 64 * (j))
#define XB_XGEN(j)  (2304 + 64 * (j))
#define XB_TOP      3328
#define XB_TOPGEN   3392
#define XCD_BAR_WORDS 3456
#define XB_SPIN_CAP (1u << 18)

__device__ __forceinline__ unsigned xb_ld(unsigned* p)              { return __hip_atomic_load(p, __ATOMIC_RELAXED, __HIP_MEMORY_SCOPE_AGENT); }
__device__ __forceinline__ unsigned xb_add(unsigned* p, unsigned v) { return __hip_atomic_fetch_add(p, v, __ATOMIC_RELAXED, __HIP_MEMORY_SCOPE_AGENT); }
__device__ __forceinline__ unsigned xb_xcc_id() { return (unsigned)__builtin_amdgcn_s_getreg((3 << 11) | 20) & 0xFu; }
#define XB_SPIN(cond, bar) do { unsigned _sp = 0; while (cond) { __builtin_amdgcn_s_sleep(1); \
    if ((++_sp & 255u) == 0u) { if (xb_ld(&(bar)[XB_TMO])) break; if (_sp > XB_SPIN_CAP) { atomicAdd(&(bar)[XB_TMO], 1u); break; } } } } while (0)

struct XcdBarrier {
    unsigned* bar; unsigned x;
    volatile LAS unsigned* st;
    int w0;
};

__device__ __forceinline__ XcdBarrier xcd_barrier_post(unsigned* bar, volatile LAS unsigned* st) {
    XcdBarrier b; b.bar = bar; b.x = xb_xcc_id(); b.st = st; b.w0 = 0;
    if (threadIdx.x == 0) (void)xb_add(&bar[XB_XCNT(b.x)], 1u);
    return b;
}
__device__ __forceinline__ void xcd_barrier_complete(unsigned* bar, unsigned x, unsigned& nloc, unsigned& nx) {
    const unsigned G = gridDim.x * gridDim.y * gridDim.z;
    unsigned sum, cnt, mine, sp = 0u;
    for (;;) {
        sum = 0u; cnt = 0u; mine = 0u;
#pragma unroll
        for (unsigned j = 0; j < 16; ++j) { const unsigned c = xb_ld(&bar[XB_XCNT(j)]); sum += c; cnt += (c > 0u) ? 1u : 0u; mine = (j == x) ? c : mine; }
        if (sum == G) break;
        __builtin_amdgcn_s_sleep(1);
        if ((++sp & 255u) == 0u) { if (xb_ld(&bar[XB_TMO])) break; if (sp > XB_SPIN_CAP) { atomicAdd(&bar[XB_TMO], 1u); break; } }
    }
    nloc = mine > 0u ? mine : 1u; nx = cnt > 0u ? cnt : 1u;
}

__device__ __forceinline__ void xcd_barrier(const XcdBarrier& b) {
    asm volatile("s_waitcnt vmcnt(0)" ::: "memory");
    __syncthreads();
    if (b.w0 && __builtin_amdgcn_mbcnt_hi(~0u, __builtin_amdgcn_mbcnt_lo(~0u, 0u)) == 0u) {
        unsigned* bar = b.bar;
        __builtin_amdgcn_s_waitcnt(0);
        unsigned nloc = b.st[0], nx = b.st[1];
        if (nloc == 0u) { xcd_barrier_complete(bar, b.x, nloc, nx); b.st[0] = nloc; b.st[1] = nx; }
        const unsigned old = xb_add(&bar[XB_XSUB(b.x)], 1u);
        const unsigned gen = old / nloc;
        if (old + 1u == (gen + 1u) * nloc) {
            __builtin_amdgcn_fence(__ATOMIC_RELEASE, "agent");
            asm volatile("s_waitcnt vmcnt(0)" ::: "memory");
            const unsigned og = xb_add(&bar[XB_TOP], 1u);
            const unsigned tg = og / nx;
            if (og + 1u == (tg + 1u) * nx) xb_add(&bar[XB_TOPGEN], 1u);
            else XB_SPIN(xb_ld(&bar[XB_TOPGEN]) == tg, bar);
            __builtin_amdgcn_fence(__ATOMIC_ACQUIRE, "agent");
            xb_add(&bar[XB_XGEN(b.x)], 1u);
            asm volatile("s_waitcnt vmcnt(0)" ::: "memory");
        } else {
            XB_SPIN(xb_ld(&bar[XB_XGEN(b.x)]) == gen, bar);
            __builtin_amdgcn_fence(__ATOMIC_ACQUIRE, "agent");
            asm volatile("s_waitcnt vmcnt(0)" ::: "memory");
        }
    }
    __syncthreads();
}


struct Ctx { unsigned char* lds; int tid, lane, wave, vcu, G, gw, NGW; };

__device__ __forceinline__ void transpose_item(const float* W, int ldw, int k0, int n0, bf16* WT, int ldt, int drow0, int dcol0, float* scr, int lane, bool kpe_perm) {
    float tv[32];
#pragma unroll
    for (int i = 0; i < 32; ++i) { const int kk = 2 * i + (lane >> 5); tv[i] = W[(size_t)(k0 + kk) * ldw + n0 + (lane & 31)]; }
#pragma unroll
    for (int i = 0; i < 32; ++i) { const int kk = 2 * i + (lane >> 5); scr[kk * 33 + (lane & 31)] = tv[i]; }
    LDS_WAIT();
    const int c = lane & 7;
#pragma unroll
    for (int j = 0; j < 4; ++j) { const int n = (lane >> 3) + 8 * j; const float* s = scr + (8 * c) * 33 + n;
        v4u o; o.x = pk2(s[0 * 33], s[1 * 33]); o.y = pk2(s[2 * 33], s[3 * 33]); o.z = pk2(s[4 * 33], s[5 * 33]); o.w = pk2(s[6 * 33], s[7 * 33]);
        int dr = drow0 + n; if (kpe_perm && dr >= 384 && dr < 448) { const int e = dr - 384; dr = 384 + 32 * ((e >> 4) & 1) + 16 * (e >> 5) + (e & 15); }
        *(v4u*)(WT + (size_t)dr * ldt + dcol0 + k0 + 8 * c) = o; }
    LDS_WAIT();
}
__device__ __forceinline__ void transpose_item8(const float* W, int ldw, int k0, int n0, unsigned char* WT8, int ldt8, int drow0, int dcol0, float* scr, int lane, float scale, bool kpe_perm) {
    float tv[32];
#pragma unroll
    for (int i = 0; i < 32; ++i) { const int kk = 2 * i + (lane >> 5); tv[i] = W[(size_t)(k0 + kk) * ldw + n0 + (lane & 31)]; }
#pragma unroll
    for (int i = 0; i < 32; ++i) { const int kk = 2 * i + (lane >> 5); scr[kk * 33 + (lane & 31)] = tv[i]; }
    LDS_WAIT();
    const int n = lane >> 1, hf = lane & 1; const float* sp = scr + (32 * hf) * 33 + n;
    v4u o0, o1; unsigned w[8];
#pragma unroll
    for (int q = 0; q < 8; ++q) { int p = 0; p = __builtin_amdgcn_cvt_pk_fp8_f32(sp[(4 * q) * 33] * scale, sp[(4 * q + 1) * 33] * scale, p, false); p = __builtin_amdgcn_cvt_pk_fp8_f32(sp[(4 * q + 2) * 33] * scale, sp[(4 * q + 3) * 33] * scale, p, true); w[q] = (unsigned)p; }
    o0.x = w[0]; o0.y = w[1]; o0.z = w[2]; o0.w = w[3]; o1.x = w[4]; o1.y = w[5]; o1.z = w[6]; o1.w = w[7];
    int dr = drow0 + n; if (kpe_perm && dr >= 384 && dr < 448) { const int e = dr - 384; dr = 384 + 32 * ((e >> 4) & 1) + 16 * (e >> 5) + (e & 15); }
    unsigned char* d = WT8 + (size_t)dr * ldt8 + dcol0 + k0 + 32 * hf;
    *(v4u*)d = o0; *(v4u*)(d + 16) = o1;
    LDS_WAIT();
}
typedef __attribute__((address_space(4))) const char kchar;
struct In { int opq;
    __device__ __forceinline__ const float* operator[](int k) const { kchar* ka = (kchar*)__builtin_amdgcn_kernarg_segment_ptr(); return *(const float* const __attribute__((address_space(4)))*)(ka + 8 * k + opq); } };
__device__ __forceinline__ unsigned char* karg_ws(int opq) { kchar* ka = (kchar*)__builtin_amdgcn_kernarg_segment_ptr(); return *(unsigned char* const __attribute__((address_space(4)))*)(ka + 38 * 8 + 8 + opq); }
__device__ __forceinline__ float* karg_out(int opq) { kchar* ka = (kchar*)__builtin_amdgcn_kernarg_segment_ptr(); return *(float* const __attribute__((address_space(4)))*)(ka + 38 * 8 + opq); }

__device__ __forceinline__ void p0_prologue(const Ctx& F, const In& in, unsigned char* ws) {
    float* scr = (float*)(F.lds + RING_OFF + F.wave * 8448);
    float* cact = (float*)(F.lds + RING_OFF + 67584); float* red = (float*)(F.lds + RING_OFF + 100352);
    bf16* Wd = (bf16*)(ws + WS_WD); bf16* Wuq = (bf16*)(ws + WS_WUQ); bf16* Wukv = (bf16*)(ws + WS_WUKV); bf16* Wo = (bf16*)(ws + WS_WO);
    bf16* Win = (bf16*)(ws + WS_WIN); bf16* Wout = (bf16*)(ws + WS_WOUT); bf16* Wgu = (bf16*)(ws + WS_WGU); bf16* Wdn = (bf16*)(ws + WS_WDN);
    constexpr int I_D = 16 * 14, I_UQ = 4 * 48, I_UKV = 2 * 64, I_O = 16 * 32, I_IN = 16 * 96, I_OUT = 16 * 32, I_GU = 2 * 16 * 2 * (16 * 8), I_DN = 2 * 24 * 2 * (4 * 32);
    constexpr int NITEMS = I_D + I_UQ + I_UKV + I_O + I_IN + I_OUT + I_GU + I_DN;
    for (int i = F.tid; i < 8 * 1024; i += NTHR) { const float x = in[1][i]; cact[(i & 1023) * 8 + (i >> 10)] = x / (1.f + __expf(-x)); }
    __syncthreads();
    const bool ada_on = F.vcu < 2 * 96; const int ada_layer = F.vcu / 96, ada_cb = F.vcu - 96 * ada_layer, ada_r4 = F.lane >> 4, ada_cq = F.lane & 15;
    const float* adaW = in[3] + (size_t)ada_layer * 1024 * 6144 + ada_cb * 64 + 4 * ada_cq + (size_t)(F.wave * 128 + ada_r4) * 6144;
    f32x4 ada_acc[8], ada_wv[16];
#pragma unroll
    for (int b = 0; b < 8; ++b) ada_acc[b] = (f32x4){0.f, 0.f, 0.f, 0.f};
#define ADA_ISSUE(hf) do { if (ada_on) { _Pragma("unroll") for (int q = 0; q < 16; ++q) ada_wv[q] = *(const f32x4*)(adaW + (size_t)(4 * (16 * (hf) + q)) * 6144); } asm volatile("" ::: "memory"); } while (0)
#define ADA_EAT(hf) do { if (ada_on) { _Pragma("unroll") for (int q = 0; q < 16; ++q) { const int kk = 4 * (16 * (hf) + q) + ada_r4; const float* cp = cact + (F.wave * 128 + kk) * 8; const f32x4 c0 = *(const f32x4*)cp, c1 = *(const f32x4*)(cp + 4); \
        _Pragma("unroll") for (int b = 0; b < 8; ++b) ada_acc[b] += (b < 4 ? c0[b & 3] : c1[b & 3]) * ada_wv[q]; } } } while (0)
    ADA_ISSUE(0);
    const int it_mid = F.gw + 6 * F.NGW;
    for (int part = 0; part < 2; ++part) {
    if (part == 1) { ADA_EAT(0); ADA_ISSUE(1); }
    for (int it = part ? it_mid : F.gw; it < (part ? NITEMS : (it_mid < NITEMS ? it_mid : NITEMS)); it += F.NGW) {
        int r = it; const float* W; int ldw, k0, n0, ldt, drow0, dcol0 = 0; bf16* WT; float f8s = 0.f;
        if (r < I_D) { W = in[7]; ldw = 448; k0 = (r / 14) * 64; n0 = (r % 14) * 32; WT = Wd; ldt = 1024; drow0 = n0; f8s = 32.f; }
        else if ((r -= I_D) < I_UQ) { W = in[10]; ldw = 1536; k0 = (r / 48) * 64; n0 = (r % 48) * 32; WT = Wuq; ldt = 256; drow0 = n0; f8s = 16.f; }
        else if ((r -= I_UQ) < I_UKV) { W = in[11]; ldw = 2048; k0 = (r / 64) * 64; n0 = (r % 64) * 32; ldt = 128;
            WT = Wukv + ((n0 & 128) ? 1024 * 128 : 0); drow0 = (n0 >> 8) * 128 + (n0 & 127); }
        else if ((r -= I_UKV) < I_O) { W = in[14]; ldw = 1024; k0 = (r / 32) * 64; n0 = (r % 32) * 32; WT = Wo; ldt = 1024; drow0 = n0; f8s = 32.f; }
        else if ((r -= I_O) < I_IN) { W = in[15]; ldw = 3072; k0 = (r / 96) * 64; n0 = (r % 96) * 32; WT = Win; ldt = 1024; drow0 = n0; }
        else if ((r -= I_IN) < I_OUT) { W = in[30]; ldw = 1024; k0 = (r / 32) * 64; n0 = (r % 32) * 32; WT = Wout; ldt = 1024; drow0 = n0; }
        else if ((r -= I_OUT) < I_GU) {
            const int sub = r % 128, mat = r / 128, which = mat & 1, le = mat >> 1;
            W = (which ? in[36] : in[35]) + (size_t)le * 1024 * 256; ldw = 256; k0 = (sub / 8) * 64; n0 = (sub % 8) * 32;
            WT = (bf16*)((unsigned char*)Wgu + (size_t)le * 512 * 1024); ldt = 1024; drow0 = (n0 >> 7) * 256 + which * 128 + (n0 & 127); f8s = 32.f; }
        else { r -= I_GU;
            const int sub = r % 128, mat = r / 128, slot = mat & 1, lb = mat >> 1, layer = lb / 24, bk = lb % 24;
            int ii, jj; pg8::pair_of(bk % 6, ii, jj); const int e = (bk / 6) * 4 + (slot ? jj : ii);
            W = in[37] + (size_t)(layer * 16 + e) * 256 * 1024; ldw = 1024; k0 = (sub / 32) * 64; n0 = (sub % 32) * 32;
            WT = (bf16*)((unsigned char*)Wdn + (size_t)lb * 1024 * 512); ldt = 512; drow0 = n0; dcol0 = slot * 256; f8s = 32.f; }
        if (f8s != 0.f) transpose_item8(W, ldw, k0, n0, (unsigned char*)WT, ldt, drow0, dcol0, scr, F.lane, f8s, it < I_D);
        else transpose_item(W, ldw, k0, n0, WT, ldt, drow0, dcol0, scr, F.lane, it < I_D);
    } }
    ADA_EAT(1);
#undef ADA_ISSUE
#undef ADA_EAT
    if (ada_on) {
#pragma unroll
        for (int b = 0; b < 8; ++b)
#pragma unroll
            for (int j = 0; j < 4; ++j) { float v = ada_acc[b][j]; v += __shfl_xor(v, 16); v += __shfl_xor(v, 32); ada_acc[b][j] = v; }
        if (F.lane < 16) {
#pragma unroll
            for (int b = 0; b < 8; ++b) *(f32x4*)(red + (F.wave * 8 + b) * 64 + 4 * ada_cq) = ada_acc[b]; } }
    { const int gt = F.vcu * NTHR + F.tid, NGT = F.G * NTHR; const v4u z = {0u, 0u, 0u, 0u};
      for (int i = gt; i < 64 * 1024 / 16; i += NGT) *(v4u*)((unsigned char*)Wd + (size_t)448 * 1024 + (size_t)i * 16) = z;
    }
    { const int gt = F.vcu * NTHR + F.tid, NGT = F.G * NTHR; float* RT = (float*)(ws + WS_ROPE); const int* posi = (const int*)in[2];
      const float inv = __builtin_amdgcn_exp2f(-0.41524101186092029f * (float)(gt & 31));
      for (int i = gt; i < T * 32; i += NGT) { const int t = i >> 5;
        float sn, cs; sincosf((float)posi[t] * inv, &sn, &cs); *(v2u*)(RT + (size_t)i * 2) = (v2u){__float_as_uint(cs), __float_as_uint(sn)}; } }
    { const int gt = F.vcu * NTHR + F.tid, NGT = F.G * NTHR; bf16* W4S = (bf16*)(ws + WS_W4S); const float* w4 = in[28];
      for (int i = gt; i < 4096 * 8; i += NGT) { const int col = i & 4095, oct = i >> 12; float w[8];
#pragma unroll
        for (int q = 0; q < 8; ++q) w[q] = w4[(size_t)(8 * oct + q) * 4096 + col];
        unsigned hw[4], lw[4];
#pragma unroll
        for (int q = 0; q < 4; ++q) { const unsigned h2 = pk2(w[2 * q], w[2 * q + 1]); hw[q] = h2;
          lw[q] = pk2(w[2 * q] - __uint_as_float(h2 << 16), w[2 * q + 1] - __uint_as_float(h2 & 0xffff0000u)); }
        bf16* d = W4S + (size_t)col * 256 + 8 * oct; const v4u hv = {hw[0], hw[1], hw[2], hw[3]}, lv = {lw[0], lw[1], lw[2], lw[3]}, zv = {0u, 0u, 0u, 0u};
        *(v4u*)d = hv; *(v4u*)(d + 64) = hv; *(v4u*)(d + 128) = lv; *(v4u*)(d + 192) = zv; } }
    __syncthreads();
    { bf16* HDp = (bf16*)(ws + WS_HDNS); float* wl = (float*)(F.lds + RING_OFF); float* sv = wl + 161 * 64 + F.wave * 64;
      for (int i = F.tid; i < 161 * 64; i += NTHR) wl[i] = i < 33 * 64 ? in[19][i] : (i < 97 * 64 ? in[22][i - 33 * 64] : in[25][i - 97 * 64]);
      __syncthreads();
      const int j = F.lane; const float b1 = in[20][j], f1 = in[21][j], b2 = in[23][j], f2 = in[24][j], b3 = in[26][j], f3 = in[27][j];
      for (int t = F.gw; t < 4096; t += F.NGW) {
        float zf = 0.f;
        { const float w = 6.2831855f * (float)t * (1.f / 4096.f);
          if (j == 0) zf = (float)t / 4095.f;
          else if (j <= 16) { const float fr = 1e-4f + (float)(j - 1) * ((15.f - 1e-4f) / 15.f); zf = cosf(fr * w); }
          else if (j <= 32) { const float fr = 1e-4f + (float)(j - 17) * ((15.f - 1e-4f) / 15.f); zf = -sinf(fr * w); } }
        sv[j] = zf; LDS_WAIT();
        float a = b1;
#pragma unroll
        for (int k = 0; k < 33; ++k) a += sv[k] * wl[k * 64 + j];
        float h = sinf(f1 * a); LDS_WAIT(); sv[j] = h; LDS_WAIT();
        a = b2;
#pragma unroll 16
        for (int k = 0; k < 64; ++k) a += sv[k] * wl[(33 + k) * 64 + j];
        h = sinf(f2 * a); LDS_WAIT(); sv[j] = h; LDS_WAIT();
        a = b3;
#pragma unroll 16
        for (int k = 0; k < 64; ++k) a += sv[k] * wl[(97 + k) * 64 + j];
        h = sinf(f3 * a); LDS_WAIT();
        const unsigned hi = pk2(h, 0.f) & 0xffffu; const float lo = h - bf2f((unsigned short)hi); const unsigned lob = pk2(lo, 0.f) & 0xffffu;
        bf16* d = HDp + (size_t)t * 256 + j; d[0] = (bf16)hi; d[64] = (bf16)lob; d[128] = (bf16)hi; d[192] = 0;
      } }
    __syncthreads();
    if (ada_on) { const int b = F.tid >> 6, col = F.tid & 63; float s_ = in[4][ada_layer * 6144 + ada_cb * 64 + col];
#pragma unroll
        for (int w = 0; w < 8; ++w) s_ += red[(w * 8 + b) * 64 + col];
        ((float*)(ws + WS_MOD))[((size_t)ada_layer * 8 + b) * 6144 + ada_cb * 64 + col] = s_; }
}

template <class TX> __device__ __forceinline__ f32x4 ldrow4(const TX* p);
template <> __device__ __forceinline__ f32x4 ldrow4<float>(const float* p) { return *(const __attribute__((address_space(1))) f32x4*)p; }
template <> __device__ __forceinline__ f32x4 ldrow4<bf16>(const bf16* p) { const v2u w = *(const __attribute__((address_space(1))) v2u*)p; f32x4 r; r[0] = __uint_as_float(w.x << 16); r[1] = __uint_as_float(w.x & 0xffff0000u); r[2] = __uint_as_float(w.y << 16); r[3] = __uint_as_float(w.y & 0xffff0000u); return r; }
template <class TX, bool OUT8 = false> __device__ __forceinline__ void norm_mod_phase(const Ctx& F, const TX* X, const float* g, const float* sc, const float* sh, bf16* OUT) {
    for (int ch = F.gw; ch < T / 16; ch += F.NGW) {
        const int r0 = ch * 16, b = r0 >> 12;
        f32x4 A[4], S[4];
#pragma unroll
        for (int j = 0; j < 4; ++j) { const int col = 4 * F.lane + 256 * j; const f32x4 gv = *(const f32x4*)(g + col), sv = *(const f32x4*)(sc + (size_t)b * 6144 + col); A[j] = gv * (1.f + sv); S[j] = *(const f32x4*)(sh + (size_t)b * 6144 + col); }
        const TX* xr = X + (size_t)r0 * DM + 4 * F.lane;
        f32x4 nx[4];
#pragma unroll
        for (int j = 0; j < 4; ++j) nx[j] = ldrow4<TX>(xr + 256 * j);
        for (int rr = 0; rr < 16; ++rr) {
            f32x4 v[4]; float ss = 0.f;
#pragma unroll
            for (int j = 0; j < 4; ++j) { v[j] = nx[j]; ss += (v[j].x * v[j].x + v[j].y * v[j].y) + (v[j].z * v[j].z + v[j].w * v[j].w); }
            if (rr < 15) {
#pragma unroll
                for (int j = 0; j < 4; ++j) nx[j] = ldrow4<TX>(xr + (size_t)(rr + 1) * DM + 256 * j); }
            const float rstd = rsqrtf(wave_sum(ss) * (1.f / DM) + EPS);
            if constexpr (OUT8) { unsigned char* orow = (unsigned char*)OUT + (size_t)(r0 + rr) * DM + 4 * F.lane;
#pragma unroll
                for (int j = 0; j < 4; ++j) { const f32x4 o = v[j] * rstd * A[j] + S[j]; int p = 0; p = __builtin_amdgcn_cvt_pk_fp8_f32(o.x, o.y, p, false); p = __builtin_amdgcn_cvt_pk_fp8_f32(o.z, o.w, p, true); *(int*)(orow + 256 * j) = p; } }
            else { bf16* orow = OUT + (size_t)(r0 + rr) * DM + 4 * F.lane;
#pragma unroll
                for (int j = 0; j < 4; ++j) { const f32x4 o = v[j] * rstd * A[j] + S[j]; v2u w; w.x = pk2(o.x, o.y); w.y = pk2(o.z, o.w); *(v2u*)(orow + 256 * j) = w; } } }
    }
}

__device__ __forceinline__ void lat_post_phase(const Ctx& F, const float* LAT, const float* qag, const float* kvag, const float* kng, const float* rope, bf16* CQN, bf16* CKVN, bf16* KPE) {
    const int l = F.lane;
    const f32x4 gq = *(const f32x4*)(qag + 4 * l);
    const f32x4 g2 = l < 32 ? *(const f32x4*)(kvag + 4 * l) : (l < 48 ? *(const f32x4*)(kng + 128 + 4 * (l - 32)) : (f32x4){0.f, 0.f, 0.f, 0.f});
    f32x4 na = *(const f32x4*)(LAT + (size_t)F.gw * 512 + 4 * l), nc = l < 48 ? *(const f32x4*)(LAT + (size_t)F.gw * 512 + 256 + 4 * l) : (f32x4){0.f, 0.f, 0.f, 0.f};
    for (int row = F.gw; row < T; row += F.NGW) {
        const f32x4 a = na, c = nc;
        if (row + F.NGW < T) { const float* nr = LAT + (size_t)(row + F.NGW) * 512; na = *(const f32x4*)(nr + 4 * l); if (l < 48) nc = *(const f32x4*)(nr + 256 + 4 * l); }
        const float sq = (a.x * a.x + a.y * a.y) + (a.z * a.z + a.w * a.w), sc = (c.x * c.x + c.y * c.y) + (c.z * c.z + c.w * c.w);
        const float s_q = wave_sum(sq), s_kv = wave_sum(l < 32 ? sc : 0.f), s_pe = wave_sum((l >= 32 && l < 48) ? sc : 0.f);
        const float rq = rsqrtf(s_q * (1.f / 256.f) + EPS), rkv = rsqrtf(s_kv * (1.f / 128.f) + EPS), rpe = rsqrtf(s_pe * (1.f / 64.f) + EPS);
        { const f32x4 o = a * rq * gq; v2u w; w.x = pk2(o.x, o.y); w.y = pk2(o.z, o.w); *(v2u*)(CQN + (size_t)row * 256 + 4 * l) = w; }
        if (l < 32) { const f32x4 o = c * rkv * g2; v2u w; w.x = pk2(o.x, o.y); w.y = pk2(o.z, o.w); *(v2u*)(CKVN + (size_t)row * 256 + 4 * l) = w; }
        else { v2u w; w.x = 0u; w.y = 0u; *(v2u*)(CKVN + (size_t)row * 256 + 128 + 4 * (l - 32)) = w; }
        const f32x4 n = c * rpe * g2;
        f32x4 other; other.x = __shfl_xor(n.x, 8); other.y = __shfl_xor(n.y, 8); other.z = __shfl_xor(n.z, 8); other.w = __shfl_xor(n.w, 8);
        if (l >= 32 && l < 48) { const bool first = l < 40; const int e0 = 4 * ((l - 32) & 7);
            float o[4];
#pragma unroll
            for (int i = 0; i < 4; ++i) { const int e = e0 + i; const float cs = rope[(size_t)row * 64 + e * 2], sn = rope[(size_t)row * 64 + e * 2 + 1];
                const float mine = n[i], oth = other[i]; o[i] = first ? (mine * cs - oth * sn) : (oth * sn + mine * cs); }
            v2u w; w.x = pk2(o[0], o[1]); w.y = pk2(o[2], o[3]); *(v2u*)(KPE + (size_t)row * 64 + 4 * (l - 32)) = w; }
    }
}

__device__ __forceinline__ void knorm_phase(const Ctx& F, bf16* KV, const float* kng) {
    const int l = F.lane, h = l >> 3, e0 = (l & 7) * 16;
    float g[16];
#pragma unroll
    for (int i = 0; i < 16; ++i) g[i] = kng[e0 + i];
    for (int row = F.gw; row < T; row += F.NGW) {
        bf16* p = KV + (size_t)row * 2048 + h * 256 + e0;
        const v4u r0 = *(const v4u*)p, r1 = *(const v4u*)(p + 8);
        float f[16]; const unsigned w[8] = {r0.x, r0.y, r0.z, r0.w, r1.x, r1.y, r1.z, r1.w};
        float ss = 0.f;
#pragma unroll
        for (int i = 0; i < 8; ++i) { f[2 * i] = __uint_as_float(w[i] << 16); f[2 * i + 1] = __uint_as_float(w[i] & 0xffff0000u); ss += f[2 * i] * f[2 * i] + f[2 * i + 1] * f[2 * i + 1]; }
        ss += __shfl_xor(ss, 1); ss += __shfl_xor(ss, 2); ss += __shfl_xor(ss, 4);
        const float r = rsqrtf(ss * (1.f / 128.f) + EPS);
        v4u o0, o1;
        o0.x = pk2(f[0] * r * g[0], f[1] * r * g[1]); o0.y = pk2(f[2] * r * g[2], f[3] * r * g[3]); o0.z = pk2(f[4] * r * g[4], f[5] * r * g[5]); o0.w = pk2(f[6] * r * g[6], f[7] * r * g[7]);
        o1.x = pk2(f[8] * r * g[8], f[9] * r * g[9]); o1.y = pk2(f[10] * r * g[10], f[11] * r * g[11]); o1.z = pk2(f[12] * r * g[12], f[13] * r * g[13]); o1.w = pk2(f[14] * r * g[14], f[15] * r * g[15]);
        *(v4u*)p = o0; *(v4u*)(p + 8) = o1;
    }
}

__device__ __forceinline__ void route_phase(const Ctx& F, const bf16* X, const float* g, const float* sc, const float* sh, const float* wg, const float* bg, const float* we, const float* be,
                                            bf16* XN2, int* LIST, float* WL, gu32* cnt) {
    float* W20 = (float*)(F.lds + RING_OFF); constexpr int W20P = 1028;
    unsigned* lcnt = (unsigned*)(F.lds + RED_OFF); unsigned* gbase = lcnt + 32;
    if (F.tid < 24) lcnt[F.tid] = 0u;
    for (int i = F.tid; i < 4 * 1024; i += NTHR) W20[(i & 3) * W20P + (i >> 2)] = wg[i];
    for (int i = F.tid; i < 16 * 1024; i += NTHR) W20[(4 + (i & 15)) * W20P + (i >> 4)] = we[i];
    __syncthreads();
    float bgv[4];
#pragma unroll
    for (int i = 0; i < 4; ++i) bgv[i] = bg[i];
    for (int ch0 = 0; ch0 < T / 16; ch0 += F.NGW) {
        const int ch = ch0 + F.gw; const bool act = ch < T / 16; const int r0 = (act ? ch : 0) * 16, b = r0 >> 12;
        f32x4 A[4], S[4];
#pragma unroll
        for (int j = 0; j < 4; ++j) { const int col = 4 * F.lane + 256 * j; const f32x4 gv = *(const f32x4*)(g + col), sv = *(const f32x4*)(sc + (size_t)b * 6144 + col); A[j] = gv * (1.f + sv); S[j] = *(const f32x4*)(sh + (size_t)b * 6144 + col); }
        const bf16* xr = X + (size_t)r0 * DM + 4 * F.lane;
        f32x4 nx[2][4];
#pragma unroll
        for (int u = 0; u < 2; ++u)
#pragma unroll
            for (int j = 0; j < 4; ++j) nx[u][j] = ldrow4<bf16>(xr + (size_t)u * DM + 256 * j);
        int my_bk = 0; float my_wlo = 0.f, my_whi = 0.f;
        for (int rr = 0; rr < 16; rr += 2) {
            f32x4 v[2][4]; float ss[2];
#pragma unroll
            for (int u = 0; u < 2; ++u) { ss[u] = 0.f;
#pragma unroll
                for (int j = 0; j < 4; ++j) { v[u][j] = nx[u][j]; ss[u] += (v[u][j].x * v[u][j].x + v[u][j].y * v[u][j].y) + (v[u][j].z * v[u][j].z + v[u][j].w * v[u][j].w); } }
            if (rr < 14) {
#pragma unroll
                for (int u = 0; u < 2; ++u)
#pragma unroll
                    for (int j = 0; j < 4; ++j) nx[u][j] = ldrow4<bf16>(xr + (size_t)(rr + 2 + u) * DM + 256 * j); }
            float gl[2][4]; int gi[2]; float gm[2];
#pragma unroll
            for (int u = 0; u < 2; ++u) { const int row = r0 + rr + u;
                const float rstd = rsqrtf(wave_sum(ss[u]) * (1.f / DM) + EPS);
                unsigned char* orow = (unsigned char*)XN2 + (size_t)row * DM + 4 * F.lane;
#pragma unroll
                for (int j = 0; j < 4; ++j) { v[u][j] = v[u][j] * rstd * A[j] + S[j]; int p = 0; p = __builtin_amdgcn_cvt_pk_fp8_f32(v[u][j].x, v[u][j].y, p, false); p = __builtin_amdgcn_cvt_pk_fp8_f32(v[u][j].z, v[u][j].w, p, true); *(int*)(orow + 256 * j) = p; }
#pragma unroll
                for (int o = 0; o < 4; ++o) { float a = 0.f;
#pragma unroll
                    for (int j = 0; j < 4; ++j) { const f32x4 w = *(const f32x4*)(W20 + o * W20P + 4 * F.lane + 256 * j); a += (v[u][j].x * w.x + v[u][j].y * w.y) + (v[u][j].z * w.z + v[u][j].w * w.w); }
                    gl[u][o] = wave_sum(a) + bgv[o]; }
                int g_ = 0; float m_ = gl[u][0]; if (gl[u][1] > m_) { m_ = gl[u][1]; g_ = 1; } if (gl[u][2] > m_) { m_ = gl[u][2]; g_ = 2; } if (gl[u][3] > m_) { m_ = gl[u][3]; g_ = 3; }
                gi[u] = __builtin_amdgcn_readfirstlane(g_); gm[u] = m_; }
#pragma unroll
            for (int u = 0; u < 2; ++u) {
                const float gw_ = __builtin_amdgcn_rcpf(__expf(gl[u][0] - gm[u]) + __expf(gl[u][1] - gm[u]) + __expf(gl[u][2] - gm[u]) + __expf(gl[u][3] - gm[u]));
                const float* We = W20 + (4 + 4 * gi[u]) * W20P + 4 * F.lane;
                float e[4];
#pragma unroll
                for (int k = 0; k < 4; ++k) { float a = 0.f;
#pragma unroll
                    for (int j = 0; j < 4; ++j) { const f32x4 w = *(const f32x4*)(We + k * W20P + 256 * j); a += (v[u][j].x * w.x + v[u][j].y * w.y) + (v[u][j].z * w.z + v[u][j].w * w.w); }
                    e[k] = wave_sum(a) + be[4 * gi[u] + k]; }
                int i1 = 0; float m1 = e[0];
#pragma unroll
                for (int k = 1; k < 4; ++k) if (e[k] > m1) { m1 = e[k]; i1 = k; }
                int i2 = -1; float m2 = -3.0e38f;
#pragma unroll
                for (int k = 0; k < 4; ++k) if (k != i1 && e[k] > m2) { m2 = e[k]; i2 = k; }
                const float t2 = __expf(m2 - m1), w1 = gw_ * __builtin_amdgcn_rcpf(1.f + t2), w2 = w1 * t2;
                const int ilo = i1 < i2 ? i1 : i2, ihi = i1 < i2 ? i2 : i1; const float wlo = i1 < i2 ? w1 : w2, whi = i1 < i2 ? w2 : w1;
                const int pi = ilo == 0 ? ihi - 1 : (ilo == 1 ? ihi + 1 : 5), bk = gi[u] * 6 + pi;
                if (F.lane == rr + u) { my_bk = bk; my_wlo = wlo; my_whi = whi; }
            }
        }
        unsigned rank = 0u; if (F.lane < 16 && act) rank = __hip_atomic_fetch_add(lcnt + my_bk, 1u, __ATOMIC_RELAXED, __HIP_MEMORY_SCOPE_WORKGROUP);
        __syncthreads();
        if (F.tid < 24) { const unsigned n = lcnt[F.tid]; gbase[F.tid] = n ? __hip_atomic_fetch_add(cnt + F.tid * 64, n, RLX_AGENT) : 0u; }
        __syncthreads();
        if (F.lane < 16 && act) { const unsigned pos = gbase[my_bk] + rank;
            LIST[my_bk * 32768 + pos] = r0 + F.lane; float2 ww; ww.x = my_wlo; ww.y = my_whi; *(float2*)(WL + ((size_t)my_bk * 32768 + pos) * 2) = ww; }
        __syncthreads();
        if (F.tid < 24) lcnt[F.tid] = 0u;
        __syncthreads();
    }
}
__device__ __forceinline__ void moe_table(const Ctx& F, const gu32* cnt) {
    int* tinfo = (int*)(F.lds + TINFO_OFF);
    __syncthreads();
    if (F.tid == 0) { int nt = 0;
        for (int b = 0; b < 24; ++b) { const int c = (int)__hip_atomic_load(cnt + b * 64, RLX_AGENT); const int tiles = (c + 255) >> 8;
            tinfo[256 + b] = nt * 256; tinfo[288 + b] = c; for (int i = 0; i < tiles; ++i) tinfo[1 + nt + i] = b; nt += tiles; }
        tinfo[0] = nt; }
    __syncthreads();
}
__device__ __forceinline__ void permute_phase(const Ctx& F, const bf16* XN2, const int* ROUTE, bf16* XN2S, int* TOKW) {
    const int* tinfo = (const int*)(F.lds + TINFO_OFF);
    for (int ch = F.gw; ch < T / 4; ch += F.NGW) {
        v4i r[4]; v4u a[4], bq[4];
#pragma unroll
        for (int i = 0; i < 4; ++i) { const int row = ch * 4 + i; r[i] = *(const v4i*)(ROUTE + (size_t)row * 4);
            a[i] = *(const v4u*)(XN2 + (size_t)row * DM + 8 * F.lane); bq[i] = *(const v4u*)(XN2 + (size_t)row * DM + 512 + 8 * F.lane); }
#pragma unroll
        for (int i = 0; i < 4; ++i) { const int row = ch * 4 + i, srow = tinfo[256 + r[i].x] + r[i].y;
            *(v4u*)(XN2S + (size_t)srow * DM + 8 * F.lane) = a[i]; *(v4u*)(XN2S + (size_t)srow * DM + 512 + 8 * F.lane) = bq[i];
            if (F.lane == 0) { v4i w; w.x = row; w.y = r[i].z; w.z = r[i].w; w.w = 0; *(v4i*)(TOKW + (size_t)srow * 4) = w; } }
    }
}

constexpr float W32C[16] = {1.f, 0.98078528040323043f, 0.92387953251128674f, 0.83146961230254524f, 0.70710678118654752f, 0.55557023301960218f, 0.38268343236508977f, 0.19509032201612825f,
                            0.f, -0.19509032201612825f, -0.38268343236508977f, -0.55557023301960218f, -0.70710678118654752f, -0.83146961230254524f, -0.92387953251128674f, -0.98078528040323043f};
constexpr float W32S[16] = {0.f, 0.19509032201612825f, 0.38268343236508977f, 0.55557023301960218f, 0.70710678118654752f, 0.83146961230254524f, 0.92387953251128674f, 0.98078528040323043f,
                            1.f, 0.98078528040323043f, 0.92387953251128674f, 0.83146961230254524f, 0.70710678118654752f, 0.55557023301960218f, 0.38268343236508977f, 0.19509032201612825f};
struct FftTw { const c32* T1; c32 tob; const c32* T2; };
template <int A> __device__ __forceinline__ c32 mul_to(c32 x, c32 tob) { const c32 y = cmul(x, tob); return cmk(y.x * W32C[A] + y.y * W32S[A], y.y * W32C[A] - y.x * W32S[A]); }
template <int A> __device__ __forceinline__ c32 mul_toc(c32 x, c32 tob) { const c32 y = cmulc(x, tob); return cmk(y.x * W32C[A] - y.y * W32S[A], y.y * W32C[A] + y.x * W32S[A]); }
#define TO_ALL(OP) OP(0) OP(1) OP(2) OP(3) OP(4) OP(5) OP(6) OP(7) OP(8) OP(9) OP(10) OP(11) OP(12) OP(13) OP(14) OP(15)
__device__ __forceinline__ void fft_twiddles(FftTw& W, int gt, c32* t1tab, c32* t2tab, int tid) {
    if (tid < 256) { float s, c; sincosf(-6.283185307179586f * (float)(((tid >> 4) * (tid & 15)) & 255) * (1.f / 256.f), &s, &c); t2tab[(tid >> 4) * 17 + (tid & 15)] = cmk(c, s); }
    for (int i = tid; i < 4096; i += NTHR) { const int p = i >> 8, t = i & 255; float s, c; sincosf(-6.283185307179586f * (float)((t * p) & 4095) * (1.f / 4096.f), &s, &c); t1tab[i] = cmk(c, s); }
    { float s, c; sincosf(-6.283185307179586f * (float)gt * (1.f / 8192.f), &s, &c); W.tob = cmk(c, s); }
    W.T1 = t1tab + gt; W.T2 = t2tab + (gt & 15) * 17;
    __syncthreads();
}
__device__ __forceinline__ void fft_forward_a(c32 (&v)[16], const FftTw& W, c32* ex, int gt) {
    __syncthreads();
    fft_fwd_a(v, W.T1, ex, gt);
    __syncthreads();
}
__device__ __forceinline__ void fft_forward_bc(c32 (&v)[16], const FftTw& W, c32* ex, int gt) {
    fft_fwd_b(v, W.T2, ex, ex, gt);
    __builtin_amdgcn_wave_barrier(); asm volatile("" ::: "memory");
    fft_fwd_c(v, ex, gt);
}
__device__ __forceinline__ void fft_forward(c32 (&v)[16], const FftTw& W, c32* ex, int gt) { fft_forward_a(v, W, ex, gt); fft_forward_bc(v, W, ex, gt); }
__device__ __forceinline__ void fft_inverse(c32 (&v)[16], const FftTw& W, c32* ex, int gt) {
    __builtin_amdgcn_wave_barrier(); asm volatile("" ::: "memory");
    fft_inv_a(v, ex, gt);
    __builtin_amdgcn_wave_barrier(); asm volatile("" ::: "memory");
    fft_inv_b(v, W.T2, ex, ex, gt);
    __syncthreads();
    fft_inv_c(v, W.T1, ex, gt);
}
__device__ __forceinline__ void filter_phase(const Ctx& F, const float* HT, const float* fbias, c32* KF, gu32* claim, int max_items) {
    const int g = __builtin_amdgcn_readfirstlane(F.tid >> 8), gt = F.tid & 255;
    c32* ex = (c32*)(F.lds + RING_OFF + g * 36864);
    float* rev = (float*)ex;
    float* red = (float*)(F.lds + RED_OFF);
    FftTw W; fft_twiddles(W, gt, (c32*)(F.lds + RING_OFF + 73728), (c32*)(F.lds + RING_OFF + 110592), F.tid);
    int* dsl = (int*)(F.lds + RED_OFF) + 60;
    for (int n = 0; n < max_items; ++n) {
        __syncthreads();
        if (F.tid == 0) *dsl = (int)__hip_atomic_fetch_add(claim, 1u, RLX_AGENT);
        __syncthreads();
        const int d = *dsl; if (d >= DM) break;
        int gtv = gt; asm volatile("" : "+v"(gtv));
        const float delta = fabsf(-120.39728043259361f + (float)d * ((40.546510810816436f + 120.39728043259361f) / 1023.f));
        const float* hfp = HT + (size_t)(g * 2048 + d) * 4096; const float* hbp = HT + (size_t)(g * 2048 + 1024 + d) * 4096;
        float hf[16], hb[16]; float sf = 0.f, sb = 0.f;
#pragma unroll
        for (int a = 0; a < 16; ++a) { const int t = 256 * a + gtv; const float dec = __expf(-((float)t * (1.f / 4095.f)) * delta); hf[a] = hfp[t] * dec; hb[a] = hbp[t] * dec; sf += fabsf(hf[a]); sb += fabsf(hb[a]); }
        sf = wave_sum(sf); sb = wave_sum(sb);
        __syncthreads();
        if (F.lane == 0) { red[F.wave * 2] = sf; red[F.wave * 2 + 1] = sb; }
        __syncthreads();
        sf = red[g * 8] + red[g * 8 + 2] + red[g * 8 + 4] + red[g * 8 + 6]; sb = red[g * 8 + 1] + red[g * 8 + 3] + red[g * 8 + 5] + red[g * 8 + 7];
        const float nf = 1.f / (sf + EPS) * (1.f / 8192.f), nb = 1.f / (sb + EPS) * (1.f / 8192.f);
#pragma unroll
        for (int a = 0; a < 16; ++a) rev[256 * a + gt] = hb[a] * nb;
        __syncthreads();
        c32 v[16];
#pragma unroll
        for (int a = 0; a < 16; ++a) { const int n = 256 * a + gt; hb[a] = n == 0 ? 0.f : rev[4096 - n]; hf[a] *= nf; v[a] = cmk(hf[a] + hb[a], 0.f); }
        fft_forward(v, W, ex, gt);
        c32* kf = KF + ((size_t)(d * 2 + g) * 2) * 4096; const float fb = fbias[g * 1024 + d] * (1.f / 4096.f);
#pragma unroll
        for (int i = 0; i < 16; ++i) kf[i * 256 + gtv] = cmk(v[i].x + fb, v[i].y);
#define OPX(A) v[A] = mul_to<A>(cmk(hf[A] - hb[A], 0.f), W.tob);
        TO_ALL(OPX)
#undef OPX
        fft_forward(v, W, ex, gt);
#pragma unroll
        for (int i = 0; i < 16; ++i) kf[4096 + i * 256 + gtv] = v[i];
    }
}
__device__ __forceinline__ void long_conv(c32 (&z)[16], const c32* kf, const FftTw& W, c32* ex, int gt) {
    typedef float f32x2v __attribute__((ext_vector_type(2))); typedef __attribute__((address_space(1))) const f32x2v gc32;
    c32 v[16], k[16]; int gk = gt; asm volatile("" : "+v"(gk));
#define OPX(A) v[A] = mul_to<A>(z[A], W.tob);
    TO_ALL(OPX)
#undef OPX
    fft_forward_a(v, W, ex, gt);
    asm volatile("" ::: "memory");
#pragma unroll
    for (int i = 0; i < 16; ++i) { const f32x2v t_ = ((gc32*)kf)[4096 + i * 256 + gk]; k[i] = cmk(t_.x, t_.y); }
    fft_forward_bc(v, W, ex, gt);
#pragma unroll
    for (int i = 0; i < 16; ++i) v[i] = cmul(v[i], k[i]);
    fft_inverse(v, W, ex, gt);
#define OPX(A) v[A] = mul_toc<A>(v[A], W.tob);
    TO_ALL(OPX)
#undef OPX
    fft_forward_a(z, W, ex, gt);
    asm volatile("" ::: "memory");
#pragma unroll
    for (int i = 0; i < 16; ++i) { const f32x2v t_ = ((gc32*)kf)[i * 256 + gk]; k[i] = cmk(t_.x, t_.y); }
    fft_forward_bc(z, W, ex, gt);
#pragma unroll
    for (int i = 0; i < 16; ++i) z[i] = cmul(z[i], k[i]);
    fft_inverse(z, W, ex, gt);
#pragma unroll
    for (int a = 0; a < 16; ++a) z[a] = cadd(z[a], v[a]);
}
struct RawSeq { v4u r[2][2]; };
__device__ __forceinline__ void raw_issue(RawSeq& q, const bf16* urow, int b0, int gt) {
    typedef __attribute__((address_space(1))) const v4u gv4u;
    asm volatile("" : "+v"(gt));
#pragma unroll
    for (int s_ = 0; s_ < 2; ++s_)
#pragma unroll
        for (int i = 0; i < 2; ++i) q.r[s_][i] = *(gv4u*)(urow + (size_t)(b0 + s_) * SEQ + (gt + 256 * i) * 8);
}
__device__ __forceinline__ void stage_conv3(c32 (&o)[16], const RawSeq& q, float w0, float w1, float w2, float cb, bf16* stg, int gt) {
    constexpr int SS = 4112;
    __syncthreads();
#pragma unroll
    for (int s_ = 0; s_ < 2; ++s_) {
#pragma unroll
        for (int i = 0; i < 2; ++i) *(v4u*)(stg + s_ * SS + 8 + (gt + 256 * i) * 8) = q.r[s_][i];
        if (gt == 0) { stg[s_ * SS + 7] = 0; stg[s_ * SS + 4104] = 0; } }
    __syncthreads();
#pragma unroll
    for (int a = 0; a < 16; ++a) { const int t = 256 * a + gt; float r[2];
#pragma unroll
        for (int s_ = 0; s_ < 2; ++s_) { const bf16* sp = stg + s_ * SS + 7 + t; r[s_] = w0 * bf2f(sp[0]) + w1 * bf2f(sp[1]) + w2 * bf2f(sp[2]) + cb; }
        o[a] = cmk(r[0], r[1]); if ((a & 3) == 3) __builtin_amdgcn_sched_barrier(0); }
}
__device__ __forceinline__ void conv_phase(const Ctx& F, const bf16* UT, const c32* KF, const float* convw, const float* convb, bf16* ZT) {
    const int g = __builtin_amdgcn_readfirstlane(F.tid >> 8), gt = F.tid & 255;
    c32* ex = (c32*)(F.lds + RING_OFF + g * 36864);
    bf16* stg = (bf16*)ex;
    FftTw W; fft_twiddles(W, gt, (c32*)(F.lds + RING_OFF + 73728), (c32*)(F.lds + RING_OFF + 110592), F.tid);
    RawSeq raw;
    if (F.vcu < DM) raw_issue(raw, UT + (size_t)(2048 + F.vcu) * T, (2 * g) * 2, gt);
    for (int d = F.vcu; d < DM; d += F.G) {
        const c32* kf0 = KF + ((size_t)(d * 2 + 0) * 2) * 4096; const c32* kf1 = KF + ((size_t)(d * 2 + 1) * 2) * 4096;
        for (int pp = 0; pp < 2; ++pp) { const int b0 = (2 * g + pp) * 2;
            int gtv = gt; asm volatile("" : "+v"(gtv));
            c32 z[16], gate[16];
            { const int c = 2048 + d; stage_conv3(z, raw, convw[c], convw[3072 + c], convw[6144 + c], convb[c], stg, gtv); }
            raw_issue(raw, UT + (size_t)d * T, b0, gtv);
            long_conv(z, kf0, W, ex, gtv);
            { const int c = d; stage_conv3(gate, raw, convw[c], convw[3072 + c], convw[6144 + c], convb[c], stg, gtv); }
            raw_issue(raw, UT + (size_t)(1024 + d) * T, b0, gtv);
#pragma unroll
            for (int a = 0; a < 16; ++a) z[a] = cmk(z[a].x * gate[a].x, z[a].y * gate[a].y);
            long_conv(z, kf1, W, ex, gtv);
            { const int c = 1024 + d; stage_conv3(gate, raw, convw[c], convw[3072 + c], convw[6144 + c], convb[c], stg, gtv); }
            { const int dn = pp == 0 ? d : d + F.G; if (dn < DM) raw_issue(raw, UT + (size_t)(2048 + dn) * T, pp == 0 ? b0 + 2 : (2 * g) * 2, gtv); }
            bf16* zr = ZT + (size_t)d * T + (size_t)b0 * SEQ;
#pragma unroll
            for (int a = 0; a < 16; ++a) { const int t = 256 * a + gtv; const unsigned pk = pk2(z[a].x * gate[a].x, z[a].y * gate[a].y); zr[t] = (bf16)(pk & 0xffffu); zr[SEQ + t] = (bf16)(pk >> 16); }
        }
    }
}
__device__ __forceinline__ void transpose_phase(const Ctx& F, const bf16* ZT, bf16* Z) {
    bf16* tile = (bf16*)(F.lds + RING_OFF + F.wave * 8704);
    const int l = F.lane;
    v4u x[8];
    if (F.gw < 16 * 512) { const int d0 = (F.gw & 15) * 64, t0 = (F.gw >> 4) * 64;
#pragma unroll
        for (int i = 0; i < 8; ++i) x[i] = *(const v4u*)(ZT + (size_t)(d0 + i * 8 + (l >> 3)) * T + t0 + (l & 7) * 8); }
    for (int it = F.gw; it < 16 * 512; it += F.NGW) { const int d0 = (it & 15) * 64, t0 = (it >> 4) * 64;
#pragma unroll
        for (int i = 0; i < 8; ++i) { const int dr = i * 8 + (l >> 3), c = l & 7;
            v2u* p = (v2u*)(tile + dr * 68 + c * 8); v2u a; a.x = x[i].x; a.y = x[i].y; p[0] = a; a.x = x[i].z; a.y = x[i].w; p[1] = a; }
        const int itn = it + F.NGW;
        if (itn < 16 * 512) { const int dn = (itn & 15) * 64, tn = (itn >> 4) * 64;
#pragma unroll
            for (int i = 0; i < 8; ++i) x[i] = *(const v4u*)(ZT + (size_t)(dn + i * 8 + (l >> 3)) * T + tn + (l & 7) * 8); }
        LDS_WAIT();
#pragma unroll
        for (int i = 0; i < 8; ++i) { const int tr = i * 8 + (l >> 3), c = l & 7; unsigned short e[8];
#pragma unroll
            for (int k = 0; k < 8; ++k) e[k] = tile[(c * 8 + k) * 68 + tr];
            v4u o; o.x = e[0] | ((unsigned)e[1] << 16); o.y = e[2] | ((unsigned)e[3] << 16); o.z = e[4] | ((unsigned)e[5] << 16); o.w = e[6] | ((unsigned)e[7] << 16);
            *(v4u*)(Z + (size_t)(t0 + tr) * DM + d0 + c * 8) = o; }
        LDS_WAIT();
    }
}

constexpr int NPH = 22;
constexpr int seam_id(int k) { return k == 0 ? 0 : k == 1 ? 1 : k == 2 ? 2 : k == 4 ? 3 : k == 6 ? 4 : k == 7 ? 5 : k == 8 ? 6 : k == 10 ? 7 : k == 11 ? 8 : k == 12 ? 9 : k == 14 ? 10 : k == 15 ? 11 : k == 16 ? 12 : k == 17 ? 13 : k == 18 ? 14 : k == 20 ? 15 : -100; }
#ifdef PROBE_SEAM
__device__ __forceinline__ unsigned long long probe_now() { unsigned long long t; asm volatile("s_memrealtime %0\n\ts_waitcnt lgkmcnt(0)" : "=s"(t) :: "memory"); return t; }
#define SEAMHOOK(id) do { if ((id) == PROBE_SEAM) { const unsigned long long t1_ = probe_now(); while (probe_now() < t1_ + (t1_ - tlast_)) __builtin_amdgcn_s_sleep(4); } \
                          if ((id) + 1 == PROBE_SEAM) tlast_ = probe_now(); } while (0)
#define SEAMBAR(k) do { xcd_barrier(bar); SEAMHOOK(seam_id(k)); } while (0)
#else
#define SEAMHOOK(id) do { } while (0)
#define SEAMBAR(k) xcd_barrier(bar)
#endif
#define XN2P(L) ((L) == 0 ? (bf16*)out : WSP(bf16, WS_XN2))
#define MOE_PHASES(L) do { \
        const int mb = 8 + 10 * L; \
        if (IN(mb)) { PH_ARGS; const float* mod = WSP(float, WS_MOD) + (size_t)L * 8 * 6144; gu32* cnt = (gu32*)(ws + WS_CTL) + CW_CNT + L * 24 * 64; \
            route_phase(F, WSP(bf16, WS_XR), in[6] + L * 1024, mod + 4 * 1024, mod + 3 * 1024, in[31] + L * 4096, in[32] + L * 4, in[33] + L * 16384, in[34] + L * 16, XN2P(L), WSP(int, WS_LIST), WSP(float, WS_WL), cnt); \
            if (L == 0) { __syncthreads();        \
                pg8::Gemm gmh{WSP(bf16, WS_W4S), WSP(bf16, WS_HDNS), 4096, 4096, 256}; pg8::StaticOrder Sh; Sh.init(4096, 4096, F.G, (int)blockIdx.x); pg8::EpiF32 Eh{WSP(float, WS_HT), 4096}; \
                REP(11) pg8::gemm_phase<pg8::EpiF32, pg8::StaticOrder, true, true>(ring, gmh, Sh, Eh, F.tid); } } \
        if (IN(mb) && IN(mb + 2)) SEAMBAR(mb); \
        if (IN(mb + 2)) { PH_ARGS; gu32* cnt = (gu32*)(ws + WS_CTL) + CW_CNT + L * 24 * 64; moe_table(F, cnt); \
              \
            pg8::Gemm gm{XN2P(L), (const bf16*)(ws + WS_WGU + (size_t)L * 16 * 512 * 1024), MS_ROWS, 8192, 512}; pg8::MoeOrder S{tinfo, F.G, F.vcu, 0, WSP(int, WS_LIST)}; pg8::EpiSwiGLU E{WSP(unsigned char, WS_HACT), WSP(float, WS_WL), tinfo}; \
            REP(10) pg8::gemm_phase_gather<pg8::EpiSwiGLU, pg8::MoeOrder, true, true, 5>(ring, gm, S, E, F.tid); \
            if (L == 0) { const int nu = 4 * tinfo[0], mine = (nu - F.vcu + F.G - 1) / F.G, most = (nu + F.G - 1) / F.G;        \
                if (mine < most) { __syncthreads(); filter_phase(F, WSP(float, WS_HT), in[29], WSP(c32, WS_KF), (gu32*)(ws + WS_CTL) + CW_FILT, most - mine); } } } SEAM(mb + 2); \
        if (IN(mb + 3)) { PH_ARGS; gu32* cnt = (gu32*)(ws + WS_CTL) + CW_CNT + L * 24 * 64; moe_table(F, cnt); const float* mod = WSP(float, WS_MOD) + (size_t)L * 8 * 6144; \
            pg8::Gemm gm{WSP(bf16, WS_HACT), (const bf16*)(ws + WS_WDN + (size_t)L * 24 * 1024 * 512), MS_ROWS, 24 * 1024, 256};   pg8::MoeOrder S{tinfo, F.G, F.vcu, 1, WSP(int, WS_LIST)}; if (L == 0) { pg8::EpiMoeOut<bf16> E{WSP(bf16, WS_XR), WSP(bf16, WS_XR), mod + 5 * 1024, WSP(int, WS_LIST), tinfo, (PG8_LAS float*)((PG8_LAS unsigned char*)lds + EPIX_OFF)}; pg8::gemm_phase<pg8::EpiMoeOut<bf16>, pg8::MoeOrder, true, true, 8>(ring, gm, S, E, F.tid); } \
            else { pg8::EpiMoeOut<float> E{WSP(bf16, WS_XR), out, mod + 5 * 1024, WSP(int, WS_LIST), tinfo, (PG8_LAS float*)((PG8_LAS unsigned char*)lds + EPIX_OFF)}; pg8::gemm_phase<pg8::EpiMoeOut<float>, pg8::MoeOrder, true, true, 8>(ring, gm, S, E, F.tid); } \
            if (L == 0) { __syncthreads(); filter_phase(F, WSP(float, WS_HT), in[29], WSP(c32, WS_KF), (gu32*)(ws + WS_CTL) + CW_FILT, DM); }       \
            } \
    } while (0)
struct Args { const float* in[38]; float* out; unsigned char* ws; int ph_lo, ph_hi; };
static_assert(sizeof(Args) == 38 * 8 + 8 + 8 + 8, "Args layout (read back through the kernarg segment pointer)");
__global__ void __launch_bounds__(NTHR, 2) fwd_kernel(Args args) {
    extern __shared__ __attribute__((aligned(16))) unsigned char lds[];
#define MK_CTX(F, tx) Ctx F; F.lds = lds; F.tid = (tx); F.lane = F.tid & 63; F.wave = __builtin_amdgcn_readfirstlane(F.tid >> 6); \
    F.G = gridDim.x; { const int bx = blockIdx.x; F.vcu = (F.G % 8 == 0) ? (bx % 8) * (F.G / 8) + bx / 8 : bx; } F.gw = F.vcu * NWAVES + F.wave; F.NGW = F.G * NWAVES
    for (int u = threadIdx.x; u < (LDS_BYTES - LDSCTL_OFF) / 4; u += NTHR) ((LAS unsigned*)((LAS unsigned char*)lds + LDSCTL_OFF))[u] = 0u;
    __syncthreads();
    const int wave_s_ = __builtin_amdgcn_readfirstlane(threadIdx.x >> 6);
    const int lo = args.ph_lo, hi = args.ph_hi;
    const bool use_bar = (hi - lo) > 1;
    XcdBarrier bar; bar.bar = (unsigned*)(args.ws + WS_CTL) + CW_BAR; bar.x = 0; bar.st = nullptr; bar.w0 = 0;
    if (use_bar) bar = xcd_barrier_post((unsigned*)(args.ws + WS_CTL) + CW_BAR, (volatile LAS unsigned*)((LAS unsigned char*)lds + MISC_OFF) + 8);
    bar.w0 = (wave_s_ == 0) ? 1 : 0;
#ifndef PHMASK
#define PHMASK 0xFFFFFFFFu
#endif
#define IN(k) (((PHMASK >> ((k) >= 18 ? (k) - 10 : (k))) & 1u) && lo <= (k) && (k) < hi)
#ifndef REPMASK
#define REPMASK 0u
#endif
#define NREP(k) (((REPMASK >> (k)) & 1u) ? 2 : 1)
#define REP(k) for (int rep_ = 0; rep_ < NREP(k); ++rep_)
#define SEAM(k) do { if (IN(k) && IN((k) + 1)) SEAMBAR(k); } while (0)
#define PH_STR2(x) #x
#define PH_STR(x) PH_STR2(x)
#define PH_ARGS int opq_ = 0; asm volatile("; PHMARK line " PH_STR(__LINE__) : "+s"(opq_)); const In in{opq_}; unsigned char* const ws = karg_ws(opq_); float* const out = karg_out(opq_); (void)in; (void)ws; (void)out; int tx_; asm volatile("v_mbcnt_lo_u32_b32 %0, -1, 0\n\tv_mbcnt_hi_u32_b32 %0, -1, %0" : "=v"(tx_)); tx_ += wave_s_ * 64; MK_CTX(F, tx_)
#define WSP(type, off) ((type*)(ws + (off)))
    PG8_LAS unsigned char* ring = (PG8_LAS unsigned char*)lds + RING_OFF;
    const PG8_LAS int* tinfo = (const PG8_LAS int*)((PG8_LAS unsigned char*)lds + TINFO_OFF);

#ifdef PROBE_SEAM
    unsigned long long tlast_ = probe_now();
#endif
    if (IN(0)) { PH_ARGS; REP(0) p0_prologue(F, in, ws); } SEAM(0);

            if (IN(1)) { PH_ARGS; const float* mod = WSP(float, WS_MOD); REP(1) norm_mod_phase<float, true>(F, in[0], in[5], mod + 1024, mod, WSP(bf16, WS_XN)); } SEAM(1);
            if (IN(2)) { PH_ARGS; pg8::Gemm gm{WSP(bf16, WS_XN), WSP(bf16, WS_WD), T, 512, 512};   pg8::StaticOrder S; S.init(T, 512, F.G, (int)blockIdx.x);
                pg8::EpiLat E{WSP(unsigned char, WS_CQN), WSP(bf16, WS_CKVN), WSP(unsigned char, WS_KPE), in[8], in[9], in[13], WSP(float, WS_ROPE), (PG8_LAS float*)((PG8_LAS unsigned char*)lds + EPIX_OFF)};
                REP(2) pg8::gemm_phase<pg8::EpiLat, pg8::StaticOrder, true, true, 5>(ring, gm, S, E, F.tid); }
            if (IN(2) && IN(4)) SEAMBAR(2);
            if (IN(4)) { REP(4) {
                { PH_ARGS; pg8::Gemm gm{WSP(bf16, WS_CQN), WSP(bf16, WS_WUQ), T, 1536, 128};   pg8::StaticOrder S; S.init(T, 1536, F.G, (int)blockIdx.x); pg8::EpiBf16R E{WSP(bf16, WS_QRAW), 1536, nullptr};
                  pg8::gemm_phase<pg8::EpiBf16R, pg8::StaticOrder, true, true, 4>(ring, gm, S, E, F.tid); }
                { PH_ARGS; pg8::Gemm gm{WSP(bf16, WS_CKVN), WSP(bf16, WS_WUKV), T, 1024, 128};   pg8::StaticOrder S; S.init(T, 1024, F.G, (int)blockIdx.x);
                  pg8::EpiK8 E{WSP(unsigned char, WS_K8), in[13], (PG8_LAS float*)((PG8_LAS unsigned char*)lds + EPIX_OFF)};
                  pg8::gemm_phase<pg8::EpiK8, pg8::StaticOrder, true, true>(ring, gm, S, E, F.tid); }
                { PH_ARGS; pg8::Gemm gm{WSP(bf16, WS_WUKV) + 1024 * 128, WSP(bf16, WS_CKVN), 1024, T, 128}; pg8::StaticOrder S; S.init(1024, T, F.G, (int)blockIdx.x);
                  pg8::EpiF8T E{WSP(unsigned char, WS_VT8), T};
                  pg8::gemm_phase<pg8::EpiF8T, pg8::StaticOrder, true, true>(ring, gm, S, E, F.tid); } }
            } if (IN(4) && IN(6)) SEAMBAR(4);
            if (IN(6)) { PH_ARGS;
                const float* qg = in[12]; const float* kg = in[13];
                float gqn = 0.f, gkn = 0.f, gqp = 0.f, gkp = 0.f;
                for (int i = 0; i < 128; ++i) { gqn = fmaxf(gqn, fabsf(qg[i])); gkn = fmaxf(gkn, fabsf(kg[i])); }
                for (int i = 128; i < 192; ++i) { gqp = fmaxf(gqp, fabsf(qg[i])); gkp = fmaxf(gkp, fabsf(kg[i])); }
                const float smaxC = (128.f * gqn * gkn + 64.f * gqp * gkp) * (0.072168783648703220f * 1.4426950408889634f);
                unsigned redo_mask = 0u;
                if (smaxC < 60.f) for (int rep_ = 0; rep_ < NREP(6); ++rep_) { int i = 0;
                    for (int u = F.vcu; u < 1024; u += F.G, ++i) { const int b = u >> 7, h = (u >> 4) & 7, qb = u & 15;
                        if (att::attn_unit<false>(b, h, qb * 256, WSP(bf16, WS_QRAW), WSP(unsigned char, WS_VT8), WSP(unsigned char, WS_K8), WSP(unsigned char, WS_KPE), WSP(bf16, WS_O), WSP(float, WS_ROPE), qg, smaxC, (char*)lds + RING_OFF, F.tid)) redo_mask |= 1u << (i & 31); } }
                else redo_mask = 0xffffffffu;
                redo_mask = (unsigned)__builtin_amdgcn_readfirstlane((int)redo_mask);
                if (redo_mask) { int i = 0;
                    for (int u = F.vcu; u < 1024; u += F.G, ++i) { const int b = u >> 7, h = (u >> 4) & 7, qb = u & 15;
                        if ((redo_mask >> (i & 31)) & 1u) (void)att::attn_unit<true>(b, h, qb * 256, WSP(bf16, WS_QRAW), WSP(unsigned char, WS_VT8), WSP(unsigned char, WS_K8), WSP(unsigned char, WS_KPE), WSP(bf16, WS_O), WSP(float, WS_ROPE), qg, smaxC, (char*)lds + RING_OFF, F.tid); } }
            } SEAM(6);
            if (IN(7)) { PH_ARGS; pg8::Gemm gm{WSP(bf16, WS_O), WSP(bf16, WS_WO), T, 1024, 512};   pg8::StaticOrder S; S.init(T, 1024, F.G, (int)blockIdx.x); pg8::EpiResGate<float, bf16> E{in[0], WSP(bf16, WS_XR), WSP(float, WS_MOD) + 2048, 1024};
                REP(7) pg8::gemm_phase<pg8::EpiResGate<float, bf16>, pg8::StaticOrder, true, true, 10>(ring, gm, S, E, F.tid); } SEAM(7);
    MOE_PHASES(0); SEAM(11);
            if (IN(12)) { PH_ARGS; const float* mod = WSP(float, WS_MOD) + 8 * 6144; REP(12) norm_mod_phase(F, WSP(bf16, WS_XR), in[5] + 1024, mod + 1024, mod, (bf16*)out); }
            if (IN(12) && IN(14)) SEAMBAR(12);
            if (IN(14)) { PH_ARGS; pg8::Gemm gm{WSP(bf16, WS_WIN), (const bf16*)out, 3072, T, 1024}; pg8::StaticOrder S; S.init(3072, T, F.G, (int)blockIdx.x); pg8::EpiBf16R E{WSP(bf16, WS_UT), T, in[16]};
                REP(14) pg8::gemm_phase<pg8::EpiBf16R, pg8::StaticOrder, true, true>(ring, gm, S, E, F.tid); } SEAM(14);
            if (IN(15)) { PH_ARGS; for (int rep = 0; rep < NREP(15); ++rep) conv_phase(F, WSP(bf16, WS_UT), WSP(c32, WS_KF), in[17], in[18], (bf16*)out); } SEAM(15);
            if (IN(16)) { PH_ARGS; REP(16) transpose_phase(F, (const bf16*)out, WSP(bf16, WS_Z)); } SEAM(16);
            if (IN(17)) { PH_ARGS; pg8::Gemm gm{WSP(bf16, WS_Z), WSP(bf16, WS_WOUT), T, 1024, 1024}; pg8::StaticOrder S; S.init(T, 1024, F.G, (int)blockIdx.x); pg8::EpiResGate<bf16, bf16> E{WSP(bf16, WS_XR), WSP(bf16, WS_XR), WSP(float, WS_MOD) + 8 * 6144 + 2048, 1024};
                pg8::gemm_phase<pg8::EpiResGate<bf16, bf16>, pg8::StaticOrder, true, true>(ring, gm, S, E, F.tid); } SEAM(17);
    MOE_PHASES(1);
#ifdef PROBE_SEAM
    SEAMHOOK(16);
#endif
#undef IN
#undef SEAM
}

#ifndef ONE_LAUNCH
#define ONE_LAUNCH 1
#endif
extern "C" void kernel_launch(void* const* d_in, const int* in_sizes, int n_in, void* d_out, int out_size, void* d_ws, size_t ws_size, hipStream_t stream) {
    static int grid = 0;
    if (grid == 0) {
        if (n_in != 38 || in_sizes[0] != T * DM || out_size != T * DM || ws_size < WS_END) { fprintf(stderr, "kernel_launch: shape mismatch n_in %d in0 %d out %d ws %zu\n", n_in, n_in > 0 ? in_sizes[0] : -1, out_size, ws_size); grid = -1; return; }
        int dev = 0, cus = 0, per_cu = 0;
        if (hipGetDevice(&dev) != hipSuccess || hipDeviceGetAttribute(&cus, hipDeviceAttributeMultiprocessorCount, dev) != hipSuccess) { grid = -1; return; }
        if (hipFuncSetAttribute((const void*)fwd_kernel, hipFuncAttributeMaxDynamicSharedMemorySize, LDS_BYTES) != hipSuccess) { fprintf(stderr, "kernel_launch: hipFuncSetAttribute failed\n"); grid = -1; return; }
        if (hipOccupancyMaxActiveBlocksPerMultiprocessor(&per_cu, (const void*)fwd_kernel, NTHR, LDS_BYTES) != hipSuccess || per_cu < 1) { fprintf(stderr, "kernel_launch: occupancy query says %d\n", per_cu); }
        (void)hipGetLastError();
        grid = cus;
    }
    if (grid < 0) return;
    if (hipMemsetAsync((char*)d_ws + WS_CTL, 0, CTL_ZERO_BYTES, stream) != hipSuccess) return;
    Args a{};
    for (int i = 0; i < 38; ++i) a.in[i] = (const float*)d_in[i];
    a.out = (float*)d_out; a.ws = (unsigned char*)d_ws;
#if ONE_LAUNCH
    a.ph_lo = 0; a.ph_hi = NPH;
    hipLaunchKernelGGL(fwd_kernel, dim3(grid), dim3(NTHR), LDS_BYTES, stream, a);
#else
    for (int p = 0; p < NPH; ++p) { a.ph_lo = p; a.ph_hi = p + 1; hipLaunchKernelGGL(fwd_kernel, dim3(grid), dim3(NTHR), LDS_BYTES, stream, a); }
#endif
    const hipError_t le = hipPeekAtLastError();
    if (le != hipSuccess) fprintf(stderr, "kernel_launch: launch failed: %s\n", hipGetErrorName(le));
}
```

```cpp
#include <hip/hip_runtime.h>
#include <cstdio>
#include <cstdint>
namespace pg8 {
#define PG8_LAS __attribute__((address_space(3)))
typedef unsigned short bf16_t;
typedef short bf16x8 __attribute__((ext_vector_type(8)));
typedef float f32x4 __attribute__((ext_vector_type(4)));
typedef unsigned u32x4 __attribute__((ext_vector_type(4)));
typedef int v4i_t __attribute__((ext_vector_type(4)));
typedef int v8i_t __attribute__((ext_vector_type(8)));
constexpr int BM = 256, BK = 64, HALF = 128, HTB = HALF * BK * 2  , STAGE_BYTES = 8 * HTB, NXCD = 8, WGM = 8;

__host__ __device__ __forceinline__ int lds_byte(int r, int c) { const int st = (r >> 4) * 2 + (c >> 5), rr = r & 15, cc = c & 31, ob = rr * 64 + cc * 2; return st * 1024 + (ob ^ (((ob >> 9) & 1) << 5)); }
__host__ __device__ __forceinline__ void stage_rc(int b, int& R, int& C) { const int st = b / 1024, sb = b % 1024, swz = sb ^ (((sb >> 9) & 1) << 5); R = (st >> 1) * 16 + swz / 64; C = (st & 1) * 32 + (swz % 64) / 2; }
__host__ __device__ __forceinline__ int perm32(int rho) { const int n = rho >> 4, i = rho & 15; return 8 * (i >> 2) + 4 * n + (i & 3); }

struct Unit { int pm, pn; };
struct Gemm { const bf16_t* A; const bf16_t* Bt; int M, N, K; };

struct StaticOrder {
    int nM, nN, nwg, G, c;
    __host__ __device__ void init(int M, int N, int G_, int c_) { nM = M / BM; nN = N / BM; nwg = nM * nN; G = G_; c = c_; }
    __host__ __device__ bool next(int i, Unit& u) const {
        const long L = (long)i * G + c; if (L >= nwg) return false;
        int wgid = (int)L; { const int q = nwg / NXCD, r = nwg % NXCD, xcd = wgid % NXCD, off = wgid / NXCD; wgid = (xcd < r ? xcd * (q + 1) : r * (q + 1) + (xcd - r) * q) + off; }
        const int nig = WGM * nN, gid = wgid / nig, fm = gid * WGM, gsz = (nM - fm) < WGM ? (nM - fm) : WGM;
        u.pm = fm + ((wgid % nig) % gsz); u.pn = (wgid % nig) / gsz; return true;
    }
    __device__ __forceinline__ void a_ready(const Unit&) const {}
    __device__ __forceinline__ void done(const Unit&) const {}
};

__device__ __forceinline__ unsigned cvt_pk_bf16(float lo, float hi) { unsigned r; asm volatile("v_cvt_pk_bf16_f32 %0, %1, %2" : "=v"(r) : "v"(lo), "v"(hi)); return r; }
typedef float f32x2 __attribute__((ext_vector_type(2)));
typedef unsigned u32x2 __attribute__((ext_vector_type(2)));
struct EpiF32 {
    static constexpr bool PERM = false, AFTER_DRAIN = false;
    float* C; int ldc;
    __device__ __forceinline__ void operator()(const f32x4 (&acc)[2][2][4][2], const Unit& u, int wr, int wc, int fr, int fq) const {
        const int row0 = u.pm * BM + wr * 64 + fr, col0 = u.pn * BM + wc * 32 + 4 * fq;
#pragma unroll
        for (int ai = 0; ai < 2; ++ai)
#pragma unroll
            for (int m = 0; m < 4; ++m) { float* rowp = C + (size_t)(row0 + ai * HALF + m * 16) * ldc + col0;
#pragma unroll
                for (int bj = 0; bj < 2; ++bj)
#pragma unroll
                    for (int n = 0; n < 2; ++n) *(f32x4*)(rowp + bj * HALF + n * 16) = acc[ai][bj][m][n]; }
    }
};
struct EpiBf16R {
    static constexpr bool PERM = true, AFTER_DRAIN = false;
    bf16_t* O; int ldc; const float* rowbias;
    __device__ __forceinline__ void operator()(const f32x4 (&acc)[2][2][4][2], const Unit& u, int wr, int wc, int fr, int fq) const {
        const int row0 = u.pm * BM + wr * 64 + fr, col0 = u.pn * BM + wc * 32 + 8 * fq;
#pragma unroll
        for (int ai = 0; ai < 2; ++ai)
#pragma unroll
            for (int m = 0; m < 4; ++m) { const int row = row0 + ai * HALF + m * 16; bf16_t* rowp = O + (size_t)row * ldc + col0; const float rb = rowbias ? rowbias[row] : 0.f;
#pragma unroll
                for (int bj = 0; bj < 2; ++bj) { const f32x4 v0 = acc[ai][bj][m][0] + rb, v1 = acc[ai][bj][m][1] + rb;
                    u32x4 w; w.x = cvt_pk_bf16(v0[0], v0[1]); w.y = cvt_pk_bf16(v0[2], v0[3]); w.z = cvt_pk_bf16(v1[0], v1[1]); w.w = cvt_pk_bf16(v1[2], v1[3]);
                    *(u32x4*)(rowp + bj * HALF) = w; } }
    }
};
struct EpiF8R {
    static constexpr bool PERM = true, AFTER_DRAIN = false;
    unsigned char* O; int ldc; float scale;
    __device__ __forceinline__ void operator()(const f32x4 (&acc)[2][2][4][2], const Unit& u, int wr, int wc, int fr, int fq) const {
        const int row0 = u.pm * BM + wr * 64 + fr, col0 = u.pn * BM + wc * 32 + 8 * fq;
#pragma unroll
        for (int ai = 0; ai < 2; ++ai)
#pragma unroll
            for (int m = 0; m < 4; ++m) { unsigned char* rowp = O + (size_t)(row0 + ai * HALF + m * 16) * ldc + col0;
#pragma unroll
                for (int bj = 0; bj < 2; ++bj) { const f32x4 v0 = acc[ai][bj][m][0] * scale, v1 = acc[ai][bj][m][1] * scale;
                    int o0 = 0, o1 = 0; o0 = __builtin_amdgcn_cvt_pk_fp8_f32(v0[0], v0[1], o0, false); o0 = __builtin_amdgcn_cvt_pk_fp8_f32(v0[2], v0[3], o0, true);
                    o1 = __builtin_amdgcn_cvt_pk_fp8_f32(v1[0], v1[1], o1, false); o1 = __builtin_amdgcn_cvt_pk_fp8_f32(v1[2], v1[3], o1, true);
                    u32x2 w; w.x = (unsigned)o0; w.y = (unsigned)o1; *(u32x2*)(rowp + bj * HALF) = w; } }
    }
};
__device__ __forceinline__ f32x4 ld4(const float* p) { return *(const f32x4*)p; }
__device__ __forceinline__ f32x4 ld4(const bf16_t* p) { const u32x2 w = *(const u32x2*)p; f32x4 r; r[0] = __uint_as_float(w.x << 16); r[1] = __uint_as_float(w.x & 0xffff0000u); r[2] = __uint_as_float(w.y << 16); r[3] = __uint_as_float(w.y & 0xffff0000u); return r; }
__device__ __forceinline__ void st4(float* p, f32x4 v) { *(f32x4*)p = v; }
__device__ __forceinline__ void st4(bf16_t* p, f32x4 v) { u32x2 w; w.x = cvt_pk_bf16(v[0], v[1]); w.y = cvt_pk_bf16(v[2], v[3]); *(u32x2*)p = w; }
__device__ __forceinline__ f32x4 ldraw(const float* p) { return *(const f32x4*)p; }
__device__ __forceinline__ u32x2 ldraw(const bf16_t* p) { return *(const u32x2*)p; }
__device__ __forceinline__ f32x4 cvraw(f32x4 v) { return v; }
__device__ __forceinline__ f32x4 cvraw(u32x2 w) { f32x4 r; r[0] = __uint_as_float(w.x << 16); r[1] = __uint_as_float(w.x & 0xffff0000u); r[2] = __uint_as_float(w.y << 16); r[3] = __uint_as_float(w.y & 0xffff0000u); return r; }
template <class TB, class TO> struct EpiResGate {
    static constexpr bool PERM = false, AFTER_DRAIN = false;
    const TB* base; TO* out; const float* gate; int ldc;
    __device__ __forceinline__ void operator()(const f32x4 (&acc)[2][2][4][2], const Unit& u, int wr, int wc, int fr, int fq) const {
        const int row0 = u.pm * BM + wr * 64 + fr, col0 = u.pn * BM + wc * 32 + 4 * fq;
        const float* gp = gate + (size_t)(u.pm >> 4) * 6144 + col0;
        f32x4 gv[2][2];
#pragma unroll
        for (int bj = 0; bj < 2; ++bj)
#pragma unroll
            for (int n = 0; n < 2; ++n) gv[bj][n] = *(const f32x4*)(gp + bj * HALF + n * 16);
        constexpr int GB = sizeof(TB) == 2 ? 8 : 4;
        typedef decltype(ldraw(base)) raw_t;
#pragma unroll
        for (int g0 = 0; g0 < 8; g0 += GB) {
            raw_t bs[GB][2][2];
#pragma unroll
            for (int g = 0; g < GB; ++g) { const unsigned off = (unsigned)((row0 + ((g0 + g) >> 2) * HALF + ((g0 + g) & 3) * 16) * ldc + col0);
#pragma unroll
                for (int bj = 0; bj < 2; ++bj)
#pragma unroll
                    for (int n = 0; n < 2; ++n) bs[g][bj][n] = ldraw(base + off + bj * HALF + n * 16); }
#pragma unroll
            for (int g = 0; g < GB; ++g) { const int ai = (g0 + g) >> 2, m = (g0 + g) & 3; const unsigned off = (unsigned)((row0 + ai * HALF + m * 16) * ldc + col0);
#pragma unroll
                for (int bj = 0; bj < 2; ++bj)
#pragma unroll
                    for (int n = 0; n < 2; ++n) st4(out + off + bj * HALF + n * 16, cvraw(bs[g][bj][n]) + gv[bj][n] * acc[ai][bj][m][n]); }
            asm volatile("" ::: "memory"); }
    }
};
struct EpiLat {
    static constexpr bool PERM = false, AFTER_DRAIN = false;
    unsigned char* CQN  ; bf16_t* CKVN; unsigned char* KPE  ; const float* qag; const float* kvag; const float* kng; const float* rope; PG8_LAS float* P;
    __device__ __forceinline__ void operator()(const f32x4 (&acc)[2][2][4][2], const Unit& u, int wr, int wc, int, int) const {
        int ln = (int)__builtin_amdgcn_mbcnt_hi(~0u, __builtin_amdgcn_mbcnt_lo(~0u, 0u)); asm volatile("" : "+v"(ln)); const int fr = ln & 15, fq = ln >> 4;
        const int row0 = u.pm * BM + wr * 64 + fr;
#pragma unroll
        for (int ai = 0; ai < 2; ++ai)
#pragma unroll
            for (int m = 0; m < 4; ++m) { float s0 = 0.f, s1 = 0.f;
#pragma unroll
                for (int n = 0; n < 2; ++n) { const f32x4 a = acc[ai][0][m][n], b = acc[ai][1][m][n];
                    s0 += (a[0] * a[0] + a[1] * a[1]) + (a[2] * a[2] + a[3] * a[3]); s1 += (b[0] * b[0] + b[1] * b[1]) + (b[2] * b[2] + b[3] * b[3]); }
                s0 += __shfl_xor(s0, 16); s0 += __shfl_xor(s0, 32); s1 += __shfl_xor(s1, 16); s1 += __shfl_xor(s1, 32);
                if (fq == 0) { const int rl = ai * HALF + wr * 64 + m * 16 + fr; P[rl * 8 + wc] = s0; P[rl * 8 + 4 + wc] = s1; } }
        asm volatile("s_waitcnt lgkmcnt(0)" ::: "memory"); __builtin_amdgcn_s_barrier(); asm volatile("" ::: "memory");
        const int cl = wc * 32 + 4 * fq;
        if (u.pn == 0) {
            f32x4 g[2][2];
#pragma unroll
            for (int bj = 0; bj < 2; ++bj)
#pragma unroll
                for (int n = 0; n < 2; ++n) g[bj][n] = *(const f32x4*)(qag + bj * HALF + cl + 16 * n);
#pragma unroll
            for (int ai = 0; ai < 2; ++ai)
#pragma unroll
                for (int m = 0; m < 4; ++m) { const int rl = ai * HALF + wr * 64 + m * 16 + fr; const f32x4 pa = *(const PG8_LAS f32x4*)(P + rl * 8), pb = *(const PG8_LAS f32x4*)(P + rl * 8 + 4);
                    const float r = __builtin_amdgcn_rsqf((((pa[0] + pa[1]) + (pa[2] + pa[3])) + ((pb[0] + pb[1]) + (pb[2] + pb[3]))) * (1.f / 256.f) + 1e-6f);
                    unsigned char* rowp = CQN + (size_t)(row0 + ai * HALF + m * 16) * 256 + cl;
#pragma unroll
                    for (int bj = 0; bj < 2; ++bj)
#pragma unroll
                        for (int n = 0; n < 2; ++n) { const f32x4 v = acc[ai][bj][m][n] * r * g[bj][n]; int p = 0; p = __builtin_amdgcn_cvt_pk_fp8_f32(v[0], v[1], p, false); p = __builtin_amdgcn_cvt_pk_fp8_f32(v[2], v[3], p, true); *(int*)(rowp + bj * HALF + 16 * n) = p; } }
        } else {
            f32x4 gk[2], gp[2]; const int e0 = 16 * (wc & 1) + 4 * fq;
#pragma unroll
            for (int n = 0; n < 2; ++n) { gk[n] = *(const f32x4*)(kvag + cl + 16 * n); gp[n] = *(const f32x4*)(kng + 128 + e0 + 32 * n); }
#pragma unroll
            for (int ai = 0; ai < 2; ++ai)
#pragma unroll
                for (int m = 0; m < 4; ++m) { const int rl = ai * HALF + wr * 64 + m * 16 + fr; const f32x4 pa = *(const PG8_LAS f32x4*)(P + rl * 8), pb = *(const PG8_LAS f32x4*)(P + rl * 8 + 4);
                    const float rkv = __builtin_amdgcn_rsqf(((pa[0] + pa[1]) + (pa[2] + pa[3])) * (1.f / 128.f) + 1e-6f), rpe = __builtin_amdgcn_rsqf((pb[0] + pb[1]) * (1.f / 64.f) + 1e-6f);
                    const size_t row = (size_t)(row0 + ai * HALF + m * 16);
#pragma unroll
                    for (int n = 0; n < 2; ++n) { const f32x4 v = acc[ai][0][m][n] * rkv * gk[n]; u32x2 w; w.x = cvt_pk_bf16(v[0], v[1]); w.y = cvt_pk_bf16(v[2], v[3]); *(u32x2*)(CKVN + row * 128 + cl + 16 * n) = w; }
                    if (wc < 2) { const f32x4 x1 = acc[ai][1][m][0] * rpe * gp[0], x2 = acc[ai][1][m][1] * rpe * gp[1];
                        const f32x4 c0 = *(const f32x4*)(rope + row * 64 + e0 * 2), c1 = *(const f32x4*)(rope + row * 64 + e0 * 2 + 4);
                        const float cs[4] = {c0[0], c0[2], c1[0], c1[2]}, sn[4] = {c0[1], c0[3], c1[1], c1[3]};
                        float o1[4], o2[4];
#pragma unroll
                        for (int j = 0; j < 4; ++j) { o1[j] = x1[j] * cs[j] - x2[j] * sn[j]; o2[j] = x1[j] * sn[j] + x2[j] * cs[j]; }
                        int w1 = 0, w2 = 0; w1 = __builtin_amdgcn_cvt_pk_fp8_f32(o1[0], o1[1], w1, false); w1 = __builtin_amdgcn_cvt_pk_fp8_f32(o1[2], o1[3], w1, true); w2 = __builtin_amdgcn_cvt_pk_fp8_f32(o2[0], o2[1], w2, false); w2 = __builtin_amdgcn_cvt_pk_fp8_f32(o2[2], o2[3], w2, true);
                        *(int*)(KPE + row * 64 + e0) = w1; *(int*)(KPE + row * 64 + 32 + e0) = w2; }
                    asm volatile("" ::: "memory"); }
        }
        asm volatile("s_waitcnt lgkmcnt(0)" ::: "memory"); __builtin_amdgcn_s_barrier(); asm volatile("" ::: "memory");
    }
};
struct EpiK8 {
    static constexpr bool PERM = true, AFTER_DRAIN = false;
    unsigned char* K8; const float* kng; PG8_LAS float* P;
    __device__ __forceinline__ void operator()(const f32x4 (&acc)[2][2][4][2], const Unit& u, int wr, int wc, int, int) const {
        int ln = (int)__builtin_amdgcn_mbcnt_hi(~0u, __builtin_amdgcn_mbcnt_lo(~0u, 0u)); asm volatile("" : "+v"(ln)); const int fr = ln & 15, fq = ln >> 4;
#pragma unroll
        for (int ai = 0; ai < 2; ++ai)
#pragma unroll
            for (int m = 0; m < 4; ++m) {
#pragma unroll
                for (int bj = 0; bj < 2; ++bj) { const f32x4 a = acc[ai][bj][m][0], b = acc[ai][bj][m][1];
                    float s = (a[0] * a[0] + a[1] * a[1]) + (a[2] * a[2] + a[3] * a[3]) + (b[0] * b[0] + b[1] * b[1]) + (b[2] * b[2] + b[3] * b[3]);
                    s += __shfl_xor(s, 16); s += __shfl_xor(s, 32);
                    if (fq == 0) P[(ai * HALF + wr * 64 + m * 16 + fr) * 8 + bj * 4 + wc] = s; } }
        asm volatile("s_waitcnt lgkmcnt(0)" ::: "memory"); __builtin_amdgcn_s_barrier(); asm volatile("" ::: "memory");
        const f32x4 g0 = *(const f32x4*)(kng + wc * 32 + 8 * fq), g1 = *(const f32x4*)(kng + wc * 32 + 8 * fq + 4);
        const int row0 = u.pm * BM + wr * 64 + fr;
#pragma unroll
        for (int ai = 0; ai < 2; ++ai)
#pragma unroll
            for (int m = 0; m < 4; ++m) { const int rl = ai * HALF + wr * 64 + m * 16 + fr;
#pragma unroll
                for (int bj = 0; bj < 2; ++bj) { const f32x4 p4 = *(const PG8_LAS f32x4*)(P + rl * 8 + bj * 4);
                    const float r = __builtin_amdgcn_rsqf(((p4[0] + p4[1]) + (p4[2] + p4[3])) * (1.f / 128.f) + 1e-6f);
                    const f32x4 v0 = acc[ai][bj][m][0] * r * g0, v1 = acc[ai][bj][m][1] * r * g1;
                    int w0 = 0, w1 = 0; w0 = __builtin_amdgcn_cvt_pk_fp8_f32(v0[0], v0[1], w0, false); w0 = __builtin_amdgcn_cvt_pk_fp8_f32(v0[2], v0[3], w0, true); w1 = __builtin_amdgcn_cvt_pk_fp8_f32(v1[0], v1[1], w1, false); w1 = __builtin_amdgcn_cvt_pk_fp8_f32(v1[2], v1[3], w1, true);
                    u32x2 w; w.x = (unsigned)w0; w.y = (unsigned)w1; *(u32x2*)(K8 + ((size_t)(row0 + ai * HALF + m * 16) * 8 + 2 * u.pn + bj) * 128 + wc * 32 + 8 * fq) = w; } }
        asm volatile("s_waitcnt lgkmcnt(0)" ::: "memory"); __builtin_amdgcn_s_barrier(); asm volatile("" ::: "memory");
    }
};
struct EpiF8T {
    static constexpr bool PERM = true, AFTER_DRAIN = false;
    unsigned char* O; int ldc;
    __device__ __forceinline__ void operator()(const f32x4 (&acc)[2][2][4][2], const Unit& u, int wr, int wc, int fr, int fq) const {
        const int row0 = u.pm * BM + wr * 64 + fr, col0 = u.pn * BM + wc * 32 + 8 * fq;
#pragma unroll
        for (int ai = 0; ai < 2; ++ai)
#pragma unroll
            for (int m = 0; m < 4; ++m) { unsigned char* rowp = O + (size_t)(row0 + ai * HALF + m * 16) * ldc + col0;
#pragma unroll
                for (int bj = 0; bj < 2; ++bj) { const f32x4 v0 = acc[ai][bj][m][0], v1 = acc[ai][bj][m][1];
                    int w0 = 0, w1 = 0; w0 = __builtin_amdgcn_cvt_pk_fp8_f32(v0[0], v0[1], w0, false); w0 = __builtin_amdgcn_cvt_pk_fp8_f32(v0[2], v0[3], w0, true); w1 = __builtin_amdgcn_cvt_pk_fp8_f32(v1[0], v1[1], w1, false); w1 = __builtin_amdgcn_cvt_pk_fp8_f32(v1[2], v1[3], w1, true);
                    u32x2 w; w.x = (unsigned)w0; w.y = (unsigned)w1; *(u32x2*)(rowp + bj * HALF) = w; } }
    }
};
__device__ __forceinline__ void pair_of(int pi, int& i, int& j) { i = pi < 3 ? 0 : (pi < 5 ? 1 : 2); j = pi < 3 ? pi + 1 : (pi < 5 ? pi - 1 : 3); }
struct MoeOrder {
    const PG8_LAS int* tinfo; int G, c, mode; const int* list;
    __device__ __forceinline__ int tok(const Unit& u, int r) const { const int bk = tinfo[1 + u.pm], pos = u.pm * BM - tinfo[256 + bk] + r; return list[bk * 32768 + (pos < tinfo[288 + bk] ? pos : 0)]; }
    __device__ __forceinline__ bool next(int i, Unit& u) const {
        const long L = (long)i * G + c; const int nt = tinfo[0]; if (L >= 4L * nt) return false;
        const int mt = (int)(L >> 2), q = (int)(L & 3), bk = tinfo[1 + mt];
        u.pm = mt;
        if (mode == 0) { int ii, jj; pair_of(bk % 6, ii, jj); const int e = (bk / 6) * 4 + ((q >> 1) ? jj : ii); u.pn = e * 2 + (q & 1); }
        else u.pn = bk * 4 + q;
        return true;
    }
    __device__ __forceinline__ void a_ready(const Unit&) const {}
    __device__ __forceinline__ void done(const Unit&) const {}
};
struct EpiSwiGLU {
    static constexpr bool PERM = true, AFTER_DRAIN = false;
    unsigned char* H; const float* wl; const PG8_LAS int* tinfo;
    __device__ __forceinline__ void operator()(const f32x4 (&acc)[2][2][4][2], const Unit& u, int wr, int wc, int, int) const {
        int ln = (int)__builtin_amdgcn_mbcnt_hi(~0u, __builtin_amdgcn_mbcnt_lo(~0u, 0u)); asm volatile("" : "+v"(ln)); const int fr = ln & 15, fq = ln >> 4;
        const int bk = tinfo[1 + u.pm]; int ii, jj; pair_of(bk % 6, ii, jj);
        const int e = u.pn >> 1, hh = u.pn & 1, slot = (e == (bk / 6) * 4 + jj) ? 1 : 0;
        const int row0 = u.pm * BM + wr * 64 + fr, col0 = slot * 256 + hh * 128 + wc * 32 + 8 * fq;
        float w8[8];
#pragma unroll
        for (int g = 0; g < 8; ++g) { const int pos = row0 + (g >> 2) * HALF + (g & 3) * 16 - tinfo[256 + bk]; w8[g] = pos < tinfo[288 + bk] ? 8.f * wl[((size_t)bk * 32768 + pos) * 2 + slot] : 0.f; }
#pragma unroll
        for (int ai = 0; ai < 2; ++ai)
#pragma unroll
            for (int m = 0; m < 4; ++m) { const int row = row0 + ai * HALF + m * 16; const float w = w8[ai * 4 + m];
                float a[8];
#pragma unroll
                for (int n = 0; n < 2; ++n)
#pragma unroll
                    for (int j = 0; j < 4; ++j) { const float g = acc[ai][0][m][n][j], up = acc[ai][1][m][n][j];
                        const float sg = g * __builtin_amdgcn_rcpf(1.0f + __builtin_amdgcn_exp2f(-1.4426950408889634f * g)); a[n * 4 + j] = sg * up * w; }
                int o0 = 0, o1 = 0; o0 = __builtin_amdgcn_cvt_pk_fp8_f32(a[0], a[1], o0, false); o0 = __builtin_amdgcn_cvt_pk_fp8_f32(a[2], a[3], o0, true);
                o1 = __builtin_amdgcn_cvt_pk_fp8_f32(a[4], a[5], o1, false); o1 = __builtin_amdgcn_cvt_pk_fp8_f32(a[6], a[7], o1, true);
                u32x2 o; o.x = (unsigned)o0; o.y = (unsigned)o1; *(u32x2*)(H + (size_t)row * 512 + col0) = o; }
    }
};
template <class TO> struct EpiMoeOut {
    static constexpr bool PERM = false, AFTER_DRAIN = false;
    const bf16_t* xr; TO* out; const float* gate; const int* list; const PG8_LAS int* tinfo; PG8_LAS float* gl;
    __device__ __forceinline__ void operator()(const f32x4 (&acc)[2][2][4][2], const Unit& u, int wr, int wc, int, int) const {
        int ln = (int)__builtin_amdgcn_mbcnt_hi(~0u, __builtin_amdgcn_mbcnt_lo(~0u, 0u)); asm volatile("" : "+v"(ln)); const int fr = ln & 15, fq = ln >> 4;
        const int bk = tinfo[1 + u.pm], r_beg = tinfo[256 + bk], r_end = r_beg + tinfo[288 + bk];
        const int row0 = u.pm * BM + wr * 64 + fr, colu = (u.pn & 3) * BM, cl = wc * 32 + 4 * fq;
        int tk[8];
#pragma unroll
        for (int g = 0; g < 8; ++g) { const int row = row0 + (g >> 2) * HALF + (g & 3) * 16; tk[g] = row < r_end ? list[bk * 32768 + row - r_beg] : -1; }
        { const int t = (wr * 4 + wc) * 64 + fq * 16 + fr; const f32x4 gs = *(const f32x4*)(gate + (size_t)(t >> 6) * 6144 + colu + (t & 63) * 4);
          *(PG8_LAS f32x4*)(gl + (t >> 6) * 256 + (t & 63) * 4) = gs; }
        asm volatile("s_waitcnt lgkmcnt(0)" ::: "memory"); __builtin_amdgcn_s_barrier();
#pragma unroll
        for (int g0 = 0; g0 < 8; g0 += 4) {
            u32x2 bs[4][2][2];
#pragma unroll
            for (int g = 0; g < 4; ++g) { const unsigned xo = (unsigned)((tk[g0 + g] < 0 ? 0 : tk[g0 + g]) * 1024 + colu + cl);
#pragma unroll
                for (int bj = 0; bj < 2; ++bj)
#pragma unroll
                    for (int n = 0; n < 2; ++n) bs[g][bj][n] = ldraw(xr + xo + bj * HALF + n * 16); }
#pragma unroll
            for (int g = 0; g < 4; ++g) { const int ai = (g0 + g) >> 2, m = (g0 + g) & 3, tkg = tk[g0 + g];
                if (tkg >= 0) { TO* op = out + (size_t)tkg * 1024 + colu + cl; const PG8_LAS float* gp = gl + (tkg >> 12) * 256 + cl;
#pragma unroll
                    for (int bj = 0; bj < 2; ++bj)
#pragma unroll
                        for (int n = 0; n < 2; ++n) { const f32x4 gv = *(const PG8_LAS f32x4*)(gp + bj * HALF + n * 16); st4(op + bj * HALF + n * 16, cvraw(bs[g][bj][n]) + gv * acc[ai][bj][m][n]); } } }
            asm volatile("" ::: "memory"); }
    }
};
template <class Epi, class Sched, bool ALIGN_EPI = false, bool SP2 = false, int F8 = -1>
__device__ __forceinline__ void gemm_phase(PG8_LAS unsigned char* lds, const Gemm g, const Sched& S, const Epi& E, const int tid_in) {
    int tid = tid_in; asm volatile("" : "+v"(tid));
    const int wid = __builtin_amdgcn_readfirstlane(tid >> 6), lane = tid & 63, wr = wid >> 2, wc = wid & 3, fr = lane & 15, fq = lane >> 4;
    int K = g.K; asm volatile("" : "+s"(K)); const int nt = K / BK;
    unsigned voffA[2], voffB[2];
#pragma unroll
    for (int i = 0; i < 2; ++i) { int R, C; stage_rc(tid * 16 + i * 8192, R, C); const int Rb = Epi::PERM ? ((R & ~31) + perm32(R & 31)) : R;
        voffA[i] = (unsigned)(R * K + C) * 2u; voffB[i] = (unsigned)(Rb * K + C) * 2u; }
    const size_t kstep = (size_t)(BK * 2);
    const size_t hstep = (size_t)HALF * K * 2;
    const size_t tstep = 2 * hstep;
    const unsigned ldsw = (unsigned)wid * 1024u;
    const int aoff = lds_byte(wr * 64 + fr, fq * 8), boff = lds_byte(wc * 32 + fr, fq * 8);
#define PG8_SA(b, h) (((b) * 2 + (h)) * HTB)
#define PG8_SB(b, h) ((4 + (b) * 2 + (h)) * HTB)
#define PG8_STAGE(bufoff, gbase, voff) do { _Pragma("unroll") for (int _i = 0; _i < 2; ++_i) { unsigned vo_ = (voff)[_i]; asm volatile("" : "+v"(vo_));   \
        __builtin_amdgcn_global_load_lds((const unsigned*)((const char*)(gbase) + vo_), (PG8_LAS unsigned*)(lds + (bufoff) + ldsw + _i * 8192), 16, 0, 0); } } while (0)
#define PG8_LDA(dst, b, h) do { _Pragma("unroll") for (int m = 0; m < 4; ++m) { const bf16x8 x0_ = *(const PG8_LAS bf16x8*)(lds + PG8_SA(b, h) + aoff + m * 2048), x1_ = *(const PG8_LAS bf16x8*)(lds + PG8_SA(b, h) + aoff + m * 2048 + 1024); \
        if constexpr (F8 >= 0) dst##8[m] = PG8_CAT(x0_, x1_); else { dst[m][0] = x0_; dst[m][1] = x1_; } } } while (0)
#define PG8_LDB(dst, b, h) do { _Pragma("unroll") for (int n = 0; n < 2; ++n) { const bf16x8 x0_ = *(const PG8_LAS bf16x8*)(lds + PG8_SB(b, h) + boff + n * 2048), x1_ = *(const PG8_LAS bf16x8*)(lds + PG8_SB(b, h) + boff + n * 2048 + 1024); \
        if constexpr (F8 >= 0) dst##8[n] = PG8_CAT(x0_, x1_); else { dst[n][0] = x0_; dst[n][1] = x1_; } } } while (0)
#define PG8_CAT(x0, x1) ({ const v4i_t lo_ = __builtin_bit_cast(v4i_t, x0), hi_ = __builtin_bit_cast(v4i_t, x1); (v8i_t){lo_[0], lo_[1], lo_[2], lo_[3], hi_[0], hi_[1], hi_[2], hi_[3]}; })
#define PG8_MMA(ai, bj, At, Bt) do { __builtin_amdgcn_s_setprio(1); _Pragma("unroll") for (int m = 0; m < 4; ++m) _Pragma("unroll") for (int n = 0; n < 2; ++n) { \
        if constexpr (F8 >= 0) acc[ai][bj][m][n] = __builtin_amdgcn_mfma_scale_f32_16x16x128_f8f6f4(Bt##8[n], At##8[m], acc[ai][bj][m][n], 0, 0, 0, 0x7f7f7f7f, 0, (127 - F8) * 0x01010101); \
        else { _Pragma("unroll") for (int k = 0; k < 2; ++k) acc[ai][bj][m][n] = __builtin_amdgcn_mfma_f32_16x16x32_bf16(Bt[n][k], At[m][k], acc[ai][bj][m][n], 0, 0, 0); } } \
        __builtin_amdgcn_s_setprio(0); } while (0)
#define PG8_WAIT_V(n) asm volatile("s_waitcnt vmcnt(" #n ")" ::: "memory")
#define PG8_WAIT_L(n) asm volatile("s_waitcnt lgkmcnt(" #n ")" ::: "memory")
#define PG8_BAR __builtin_amdgcn_s_barrier()
#define PG8_SCHED __builtin_amdgcn_sched_barrier(0)
    Unit cur, nxt; int ui = 0;
    if (!S.next(0, cur)) return;
    f32x4 acc[2][2][4][2];
#pragma unroll
    for (int a = 0; a < 2; ++a)
#pragma unroll
        for (int b = 0; b < 2; ++b)
#pragma unroll
            for (int m = 0; m < 4; ++m)
#pragma unroll
                for (int n = 0; n < 2; ++n) acc[a][b][m][n] = (f32x4){0.f, 0.f, 0.f, 0.f};
    bf16x8 At[4][2], B0[2][2], B1[2][2]; v8i_t At8[4], B08[2], B18[2];
    const char* cA = (const char*)g.A + (size_t)cur.pm * tstep; const char* cB = (const char*)g.Bt + (size_t)cur.pn * tstep;
    S.a_ready(cur);
    if constexpr (SP2) {
        PG8_STAGE(PG8_SB(0, 0), cB, voffB); PG8_STAGE(PG8_SB(0, 1), cB + hstep, voffB); PG8_STAGE(PG8_SA(0, 0), cA, voffA); PG8_STAGE(PG8_SA(0, 1), cA + hstep, voffA);
        if (wr == 1) PG8_BAR;
        PG8_WAIT_V(2); PG8_BAR;
        PG8_STAGE(PG8_SB(1, 0), cB + kstep, voffB); PG8_STAGE(PG8_SA(1, 0), cA + kstep, voffA); PG8_STAGE(PG8_SB(1, 1), cB + hstep + kstep, voffB);
        PG8_WAIT_V(6); PG8_BAR;
    } else {
        PG8_STAGE(PG8_SB(0, 0), cB, voffB); PG8_STAGE(PG8_SA(0, 0), cA, voffA); PG8_STAGE(PG8_SB(0, 1), cB + hstep, voffB); PG8_STAGE(PG8_SA(0, 1), cA + hstep, voffA);
        if (wr == 1) PG8_BAR;
        PG8_WAIT_V(4); PG8_BAR;
        PG8_STAGE(PG8_SB(1, 0), cB + kstep, voffB); PG8_STAGE(PG8_SA(1, 0), cA + kstep, voffA); PG8_STAGE(PG8_SB(1, 1), cB + hstep + kstep, voffB);
        PG8_WAIT_V(6); PG8_BAR;
    }
    for (;;) {
        const bool has_next = S.next(ui + 1, nxt);
        const char* nA = has_next ? (const char*)g.A + (size_t)nxt.pm * tstep : cA; const char* nB = has_next ? (const char*)g.Bt + (size_t)nxt.pn * tstep : cB;
        for (int t = 0; t < nt; t += 2) {
            const bool last = (t == nt - 2);
            const char* a1 = cA + (size_t)(t + 1) * kstep;
            const char* a2 = last ? nA : cA + (size_t)(t + 2) * kstep; const char* b2 = last ? nB : cB + (size_t)(t + 2) * kstep;
            const char* a3 = a2 + kstep; const char* b3 = b2 + kstep;
            if (last && has_next) S.a_ready(nxt);
            if constexpr (SP2) {
            PG8_LDB(B0, 0, 0); PG8_LDB(B1, 0, 1); PG8_SCHED; PG8_LDA(At, 0, 0); PG8_STAGE(PG8_SA(1, 1), a1 + hstep, voffA);
            PG8_WAIT_V(8); PG8_WAIT_L(0); PG8_BAR; PG8_MMA(0, 0, At, B0); PG8_MMA(0, 1, At, B1); PG8_BAR; PG8_SCHED;
            PG8_LDA(At, 0, 1); PG8_STAGE(PG8_SB(0, 0), b2, voffB); PG8_STAGE(PG8_SB(0, 1), b2 + hstep, voffB); PG8_STAGE(PG8_SA(0, 0), a2, voffA);
            PG8_WAIT_V(8); PG8_WAIT_L(0); PG8_BAR; PG8_MMA(1, 0, At, B0); PG8_MMA(1, 1, At, B1); PG8_BAR; PG8_SCHED;
            PG8_LDB(B0, 1, 0); PG8_LDB(B1, 1, 1); PG8_SCHED; PG8_LDA(At, 1, 0); PG8_STAGE(PG8_SA(0, 1), a2 + hstep, voffA);
            PG8_WAIT_V(8); PG8_WAIT_L(0); PG8_BAR; PG8_MMA(0, 0, At, B0); PG8_MMA(0, 1, At, B1); PG8_BAR; PG8_SCHED;
            PG8_LDA(At, 1, 1); PG8_STAGE(PG8_SB(1, 0), b3, voffB); PG8_STAGE(PG8_SB(1, 1), b3 + hstep, voffB); PG8_STAGE(PG8_SA(1, 0), a3, voffA);
            PG8_WAIT_V(8); PG8_WAIT_L(0); PG8_BAR; PG8_MMA(1, 0, At, B0); PG8_MMA(1, 1, At, B1); PG8_BAR; PG8_SCHED;
            } else {
            PG8_LDB(B0, 0, 0); PG8_SCHED; PG8_LDA(At, 0, 0); PG8_STAGE(PG8_SA(1, 1), a1 + hstep, voffA);
            PG8_WAIT_L(8); PG8_BAR; PG8_WAIT_L(0); PG8_MMA(0, 0, At, B0); PG8_BAR; PG8_SCHED;
            PG8_LDB(B1, 0, 1); PG8_STAGE(PG8_SB(0, 0), b2, voffB);
            PG8_BAR; PG8_WAIT_L(0); PG8_MMA(0, 1, At, B1); PG8_BAR;
            PG8_LDA(At, 0, 1); PG8_STAGE(PG8_SA(0, 0), a2, voffA);
            PG8_BAR; PG8_WAIT_L(0); PG8_MMA(1, 0, At, B0); PG8_BAR; PG8_SCHED;
            PG8_STAGE(PG8_SB(0, 1), b2 + hstep, voffB);
            PG8_WAIT_V(6); PG8_BAR; PG8_MMA(1, 1, At, B1); PG8_BAR;
            PG8_LDB(B0, 1, 0); PG8_SCHED; PG8_LDA(At, 1, 0); PG8_STAGE(PG8_SA(0, 1), a2 + hstep, voffA);
            PG8_WAIT_L(8); PG8_BAR; PG8_WAIT_L(0); PG8_MMA(0, 0, At, B0); PG8_BAR; PG8_SCHED;
            PG8_LDB(B1, 1, 1); PG8_STAGE(PG8_SB(1, 0), b3, voffB);
            PG8_BAR; PG8_WAIT_L(0); PG8_MMA(0, 1, At, B1); PG8_BAR;
            PG8_LDA(At, 1, 1); PG8_STAGE(PG8_SA(1, 0), a3, voffA);
            PG8_BAR; PG8_WAIT_L(0); PG8_MMA(1, 0, At, B0); PG8_BAR; PG8_SCHED;
            PG8_STAGE(PG8_SB(1, 1), b3 + hstep, voffB);
            PG8_WAIT_V(6); PG8_BAR; PG8_MMA(1, 1, At, B1); PG8_BAR;
            }
        }
        if constexpr (ALIGN_EPI) { if (wr == 0) PG8_BAR; }
        if constexpr (!Epi::AFTER_DRAIN) { E(acc, cur, wr, wc, fr, fq); S.done(cur); }
        if (!has_next) break;
#pragma unroll
        for (int a = 0; a < 2; ++a)
#pragma unroll
            for (int b = 0; b < 2; ++b)
#pragma unroll
                for (int m = 0; m < 4; ++m)
#pragma unroll
                    for (int n = 0; n < 2; ++n) acc[a][b][m][n] = (f32x4){0.f, 0.f, 0.f, 0.f};
        cur = nxt; cA = nA; cB = nB; ++ui;
        if constexpr (ALIGN_EPI) { if (wr == 1) PG8_BAR; }
    }
    PG8_WAIT_V(0);
    if constexpr (!ALIGN_EPI) { if (wr == 0) PG8_BAR; }
    PG8_BAR;
    if constexpr (Epi::AFTER_DRAIN) { E.fused(acc, cur, wr, wc, fr, fq, lds, wid, lane); S.done(cur); }
#undef PG8_SA
#undef PG8_SB
#undef PG8_STAGE
#undef PG8_LDA
#undef PG8_LDB
#undef PG8_MMA
#undef PG8_WAIT_V
#undef PG8_WAIT_L
#undef PG8_BAR
#undef PG8_SCHED
}
template <class Epi, class Sched, bool ALIGN_EPI = true, bool SP2 = true, int F8 = -1>
__device__ __forceinline__ void gemm_phase_gather(PG8_LAS unsigned char* lds, const Gemm g, const Sched& S, const Epi& E, const int tid_in) {
    int tid = tid_in; asm volatile("" : "+v"(tid));
    static_assert(SP2, "gather form: SP2 loop only");
    const int wid = __builtin_amdgcn_readfirstlane(tid >> 6), lane = tid & 63, wr = wid >> 2, wc = wid & 3, fr = lane & 15, fq = lane >> 4;
    int K = g.K; asm volatile("" : "+s"(K)); const int nt = K / BK;
    unsigned voffA[2], voffB[2];
#pragma unroll
    for (int i = 0; i < 2; ++i) { int R, C; stage_rc(tid * 16 + i * 8192, R, C); const int Rb = Epi::PERM ? ((R & ~31) + perm32(R & 31)) : R;
        voffA[i] = (unsigned)(R * K + C) * 2u; voffB[i] = (unsigned)(Rb * K + C) * 2u; }
    int gR, gC; stage_rc(tid * 16, gR, gC);
    unsigned vG[2][2], vN[2][2];
    const size_t kstep = (size_t)(BK * 2);
    const size_t hstep = (size_t)HALF * K * 2;
    const size_t tstep = 2 * hstep;
    const unsigned ldsw = (unsigned)wid * 1024u;
    const int aoff = lds_byte(wr * 64 + fr, fq * 8), boff = lds_byte(wc * 32 + fr, fq * 8);
#define PG8_SA(b, h) (((b) * 2 + (h)) * HTB)
#define PG8_SB(b, h) ((4 + (b) * 2 + (h)) * HTB)
#define PG8_STAGE(bufoff, gbase, voff) do { _Pragma("unroll") for (int _i = 0; _i < 2; ++_i) { unsigned vo_ = (voff)[_i]; asm volatile("" : "+v"(vo_));   \
        __builtin_amdgcn_global_load_lds((const unsigned*)((const char*)(gbase) + vo_), (PG8_LAS unsigned*)(lds + (bufoff) + ldsw + _i * 8192), 16, 0, 0); } } while (0)
#define PG8_LDA(dst, b, h) do { _Pragma("unroll") for (int m = 0; m < 4; ++m) { const bf16x8 x0_ = *(const PG8_LAS bf16x8*)(lds + PG8_SA(b, h) + aoff + m * 2048), x1_ = *(const PG8_LAS bf16x8*)(lds + PG8_SA(b, h) + aoff + m * 2048 + 1024); \
        if constexpr (F8 >= 0) dst##8[m] = PG8_CAT(x0_, x1_); else { dst[m][0] = x0_; dst[m][1] = x1_; } } } while (0)
#define PG8_LDB(dst, b, h) do { _Pragma("unroll") for (int n = 0; n < 2; ++n) { const bf16x8 x0_ = *(const PG8_LAS bf16x8*)(lds + PG8_SB(b, h) + boff + n * 2048), x1_ = *(const PG8_LAS bf16x8*)(lds + PG8_SB(b, h) + boff + n * 2048 + 1024); \
        if constexpr (F8 >= 0) dst##8[n] = PG8_CAT(x0_, x1_); else { dst[n][0] = x0_; dst[n][1] = x1_; } } } while (0)
#define PG8_CAT(x0, x1) ({ const v4i_t lo_ = __builtin_bit_cast(v4i_t, x0), hi_ = __builtin_bit_cast(v4i_t, x1); (v8i_t){lo_[0], lo_[1], lo_[2], lo_[3], hi_[0], hi_[1], hi_[2], hi_[3]}; })
#define PG8_MMA(ai, bj, At, Bt) do { __builtin_amdgcn_s_setprio(1); _Pragma("unroll") for (int m = 0; m < 4; ++m) _Pragma("unroll") for (int n = 0; n < 2; ++n) { \
        if constexpr (F8 >= 0) acc[ai][bj][m][n] = __builtin_amdgcn_mfma_scale_f32_16x16x128_f8f6f4(Bt##8[n], At##8[m], acc[ai][bj][m][n], 0, 0, 0, 0x7f7f7f7f, 0, (127 - F8) * 0x01010101); \
        else { _Pragma("unroll") for (int k = 0; k < 2; ++k) acc[ai][bj][m][n] = __builtin_amdgcn_mfma_f32_16x16x32_bf16(Bt[n][k], At[m][k], acc[ai][bj][m][n], 0, 0, 0); } } \
        __builtin_amdgcn_s_setprio(0); } while (0)
#define PG8_WAIT_V(n) asm volatile("s_waitcnt vmcnt(" #n ")" ::: "memory")
#define PG8_WAIT_L(n) asm volatile("s_waitcnt lgkmcnt(" #n ")" ::: "memory")
#define PG8_BAR __builtin_amdgcn_s_barrier()
#define PG8_SCHED __builtin_amdgcn_sched_barrier(0)
    Unit cur, nxt; int ui = 0;
    if (!S.next(0, cur)) return;
    f32x4 acc[2][2][4][2];
#pragma unroll
    for (int a = 0; a < 2; ++a)
#pragma unroll
        for (int b = 0; b < 2; ++b)
#pragma unroll
            for (int m = 0; m < 4; ++m)
#pragma unroll
                for (int n = 0; n < 2; ++n) acc[a][b][m][n] = (f32x4){0.f, 0.f, 0.f, 0.f};
    bf16x8 At[4][2], B0[2][2], B1[2][2]; v8i_t At8[4], B08[2], B18[2];
    const char* cA = (const char*)g.A; const char* cB = (const char*)g.Bt + (size_t)cur.pn * tstep;
    S.a_ready(cur);
#pragma unroll
    for (int h = 0; h < 2; ++h)
#pragma unroll
        for (int i = 0; i < 2; ++i) vG[h][i] = (unsigned)S.tok(cur, h * HALF + gR + 64 * i) * (unsigned)(K * 2) + (unsigned)(gC * 2);
    if constexpr (SP2) {
        PG8_STAGE(PG8_SB(0, 0), cB, voffB); PG8_STAGE(PG8_SB(0, 1), cB + hstep, voffB); PG8_STAGE(PG8_SA(0, 0), cA, vG[0]); PG8_STAGE(PG8_SA(0, 1), cA, vG[1]);
        if (wr == 1) PG8_BAR;
        PG8_WAIT_V(2); PG8_BAR;
        PG8_STAGE(PG8_SB(1, 0), cB + kstep, voffB); PG8_STAGE(PG8_SA(1, 0), cA + kstep, vG[0]); PG8_STAGE(PG8_SB(1, 1), cB + hstep + kstep, voffB);
        PG8_WAIT_V(6); PG8_BAR;
    } else {
        PG8_STAGE(PG8_SB(0, 0), cB, voffB); PG8_STAGE(PG8_SA(0, 0), cA, voffA); PG8_STAGE(PG8_SB(0, 1), cB + hstep, voffB); PG8_STAGE(PG8_SA(0, 1), cA + hstep, voffA);
        if (wr == 1) PG8_BAR;
        PG8_WAIT_V(4); PG8_BAR;
        PG8_STAGE(PG8_SB(1, 0), cB + kstep, voffB); PG8_STAGE(PG8_SA(1, 0), cA + kstep, voffA); PG8_STAGE(PG8_SB(1, 1), cB + hstep + kstep, voffB);
        PG8_WAIT_V(6); PG8_BAR;
    }
    for (;;) {
        const bool has_next = S.next(ui + 1, nxt);
        const char* nA = cA; const char* nB = has_next ? (const char*)g.Bt + (size_t)nxt.pn * tstep : cB;
        for (int t = 0; t < nt; t += 2) {
            const bool last = (t == nt - 2);
            const char* a1 = cA + (size_t)(t + 1) * kstep;
            const char* a2 = last ? nA : cA + (size_t)(t + 2) * kstep; const char* b2 = last ? nB : cB + (size_t)(t + 2) * kstep;
            const char* a3 = a2 + kstep; const char* b3 = b2 + kstep;
            if (last && has_next) { S.a_ready(nxt);
#pragma unroll
                for (int h = 0; h < 2; ++h)
#pragma unroll
                    for (int i = 0; i < 2; ++i) vN[h][i] = (unsigned)S.tok(nxt, h * HALF + gR + 64 * i) * (unsigned)(K * 2) + (unsigned)(gC * 2); }
            if constexpr (SP2) {
            PG8_LDB(B0, 0, 0); PG8_LDB(B1, 0, 1); PG8_SCHED; PG8_LDA(At, 0, 0); PG8_STAGE(PG8_SA(1, 1), a1, vG[1]);
            if (last && has_next) { vG[0][0] = vN[0][0]; vG[0][1] = vN[0][1]; vG[1][0] = vN[1][0]; vG[1][1] = vN[1][1]; }
            PG8_WAIT_V(8); PG8_WAIT_L(0); PG8_BAR; PG8_MMA(0, 0, At, B0); PG8_MMA(0, 1, At, B1); PG8_BAR; PG8_SCHED;
            PG8_LDA(At, 0, 1); PG8_STAGE(PG8_SB(0, 0), b2, voffB); PG8_STAGE(PG8_SB(0, 1), b2 + hstep, voffB); PG8_STAGE(PG8_SA(0, 0), a2, vG[0]);
            PG8_WAIT_V(8); PG8_WAIT_L(0); PG8_BAR; PG8_MMA(1, 0, At, B0); PG8_MMA(1, 1, At, B1); PG8_BAR; PG8_SCHED;
            PG8_LDB(B0, 1, 0); PG8_LDB(B1, 1, 1); PG8_SCHED; PG8_LDA(At, 1, 0); PG8_STAGE(PG8_SA(0, 1), a2, vG[1]);
            PG8_WAIT_V(8); PG8_WAIT_L(0); PG8_BAR; PG8_MMA(0, 0, At, B0); PG8_MMA(0, 1, At, B1); PG8_BAR; PG8_SCHED;
            PG8_LDA(At, 1, 1); PG8_STAGE(PG8_SB(1, 0), b3, voffB); PG8_STAGE(PG8_SB(1, 1), b3 + hstep, voffB); PG8_STAGE(PG8_SA(1, 0), a3, vG[0]);
            PG8_WAIT_V(8); PG8_WAIT_L(0); PG8_BAR; PG8_MMA(1, 0, At, B0); PG8_MMA(1, 1, At, B1); PG8_BAR; PG8_SCHED;
            } else {
            PG8_LDB(B0, 0, 0); PG8_SCHED; PG8_LDA(At, 0, 0); PG8_STAGE(PG8_SA(1, 1), a1 + hstep, voffA);
            PG8_WAIT_L(8); PG8_BAR; PG8_WAIT_L(0); PG8_MMA(0, 0, At, B0); PG8_BAR; PG8_SCHED;
            PG8_LDB(B1, 0, 1); PG8_STAGE(PG8_SB(0, 0), b2, voffB);
            PG8_BAR; PG8_WAIT_L(0); PG8_MMA(0, 1, At, B1); PG8_BAR;
            PG8_LDA(At, 0, 1); PG8_STAGE(PG8_SA(0, 0), a2, voffA);
            PG8_BAR; PG8_WAIT_L(0); PG8_MMA(1, 0, At, B0); PG8_BAR; PG8_SCHED;
            PG8_STAGE(PG8_SB(0, 1), b2 + hstep, voffB);
            PG8_WAIT_V(6); PG8_BAR; PG8_MMA(1, 1, At, B1); PG8_BAR;
            PG8_LDB(B0, 1, 0); PG8_SCHED; PG8_LDA(At, 1, 0); PG8_STAGE(PG8_SA(0, 1), a2 + hstep, voffA);
            PG8_WAIT_L(8); PG8_BAR; PG8_WAIT_L(0); PG8_MMA(0, 0, At, B0); PG8_BAR; PG8_SCHED;
            PG8_LDB(B1, 1, 1); PG8_STAGE(PG8_SB(1, 0), b3, voffB);
            PG8_BAR; PG8_WAIT_L(0); PG8_MMA(0, 1, At, B1); PG8_BAR;
            PG8_LDA(At, 1, 1); PG8_STAGE(PG8_SA(1, 0), a3, voffA);
            PG8_BAR; PG8_WAIT_L(0); PG8_MMA(1, 0, At, B0); PG8_BAR; PG8_SCHED;
            PG8_STAGE(PG8_SB(1, 1), b3 + hstep, voffB);
            PG8_WAIT_V(6); PG8_BAR; PG8_MMA(1, 1, At, B1); PG8_BAR;
            }
        }
        if constexpr (ALIGN_EPI) { if (wr == 0) PG8_BAR; }
        if constexpr (!Epi::AFTER_DRAIN) { E(acc, cur, wr, wc, fr, fq); S.done(cur); }
        if (!has_next) break;
#pragma unroll
        for (int a = 0; a < 2; ++a)
#pragma unroll
            for (int b = 0; b < 2; ++b)
#pragma unroll
                for (int m = 0; m < 4; ++m)
#pragma unroll
                    for (int n = 0; n < 2; ++n) acc[a][b][m][n] = (f32x4){0.f, 0.f, 0.f, 0.f};
        cur = nxt; cA = nA; cB = nB; ++ui;
        if constexpr (ALIGN_EPI) { if (wr == 1) PG8_BAR; }
    }
    PG8_WAIT_V(0);
    if constexpr (!ALIGN_EPI) { if (wr == 0) PG8_BAR; }
    PG8_BAR;
    if constexpr (Epi::AFTER_DRAIN) { E.fused(acc, cur, wr, wc, fr, fq, lds, wid, lane); S.done(cur); }
#undef PG8_SA
#undef PG8_SB
#undef PG8_STAGE
#undef PG8_LDA
#undef PG8_LDB
#undef PG8_MMA
#undef PG8_WAIT_V
#undef PG8_WAIT_L
#undef PG8_BAR
#undef PG8_SCHED
}
}
namespace att {
typedef unsigned short bf16;
using bf16x8 = __attribute__((ext_vector_type(8))) short;
using s16x4  = __attribute__((ext_vector_type(4))) short;
using f32x16 = __attribute__((ext_vector_type(16))) float;
using u32x4  = __attribute__((ext_vector_type(4))) unsigned;
using f32x4_t = __attribute__((ext_vector_type(4))) float;
constexpr int NW = 8, QBLK = 32, KVBLK = 64, SEQ = 4096;
constexpr int LDQ = 1536, LDKV = 2048, LDO = 1024;
constexpr int SHM_VT = 128 * 80, SHM_K8 = 64 * 208;
constexpr int OFF_V = 0, OFF_K8 = 3 * SHM_VT, OFF_WS = OFF_K8 + 2 * SHM_K8, LDS_BYTES = OFF_WS + NW * 64 * 4 + 64;
typedef int v8i32 __attribute__((ext_vector_type(8)));
typedef int v4i32 __attribute__((ext_vector_type(4)));
typedef int v2i32 __attribute__((ext_vector_type(2)));
constexpr int T_TOK = 8 * SEQ;
#define ASBAR() __builtin_amdgcn_sched_barrier(0)
__device__ __forceinline__ int crow(int r, int hi) { return (r & 3) + 8 * (r >> 2) + 4 * hi; }
__device__ __forceinline__ unsigned cvtpk(float lo, float hi) { unsigned r; asm volatile("v_cvt_pk_bf16_f32 %0, %1, %2" : "=v"(r) : "v"(lo), "v"(hi)); return r; }
__device__ __forceinline__ float bf2f(unsigned short b) { return __uint_as_float(((unsigned)b) << 16); }
template <bool SHIFT> __device__ __forceinline__ void smA(f32x16& p0, float negm) { for (int r = 0; r < 16; ++r) p0[r] = __builtin_amdgcn_exp2f(SHIFT ? p0[r] + negm : p0[r]); }
template <bool SHIFT> __device__ __forceinline__ void smB(f32x16& p0, f32x16& p1, float& l_reg, v8i32& p8, float negm) {
  for (int r = 0; r < 16; ++r) p1[r] = __builtin_amdgcn_exp2f(SHIFT ? p1[r] + negm : p1[r]);
  float ps = 0; for (int r = 0; r < 16; ++r) ps += p0[r]; for (int r = 0; r < 16; ++r) ps += p1[r];
  l_reg += ps;
#pragma unroll
  for (int w = 0; w < 4; ++w) { int a = 0, bq = 0;
    a = __builtin_amdgcn_cvt_pk_bf8_f32(p0[4 * w], p0[4 * w + 1], a, false); a = __builtin_amdgcn_cvt_pk_bf8_f32(p0[4 * w + 2], p0[4 * w + 3], a, true);
    bq = __builtin_amdgcn_cvt_pk_bf8_f32(p1[4 * w], p1[4 * w + 1], bq, false); bq = __builtin_amdgcn_cvt_pk_bf8_f32(p1[4 * w + 2], p1[4 * w + 3], bq, true);
    p8[w] = a; p8[4 + w] = bq; }
}
template <bool SHIFT> __device__ __forceinline__ void qkt(f32x16& p0, f32x16& p1, const char* K8, const v8i32* q8, float negm, int r32, int hi) {
  p0 = f32x16{}; p1 = f32x16{};
#define K8RD(m, half, part) (*reinterpret_cast<const v4i32*>(K8 + ((half) * 32 + r32) * 208 + (m) * 64 + hi * 32 + (part) * 16))
#define K8FR(m, half) ({ const v4i32 lo_ = K8RD(m, half, 0), hi_ = K8RD(m, half, 1); (v8i32){lo_[0], lo_[1], lo_[2], lo_[3], hi_[0], hi_[1], hi_[2], hi_[3]}; })
  v8i32 a0 = K8FR(0, 0), a1 = K8FR(0, 1), b0 = K8FR(1, 0), b1 = K8FR(1, 1);
  ASBAR();
  p0 = __builtin_amdgcn_mfma_scale_f32_32x32x64_f8f6f4(a0, q8[0], p0, 0, 0, 0, 0x7f7f7f7f, 0, 0x7f7f7f7f);
  p1 = __builtin_amdgcn_mfma_scale_f32_32x32x64_f8f6f4(a1, q8[0], p1, 0, 0, 0, 0x7f7f7f7f, 0, 0x7f7f7f7f);
  a0 = K8FR(2, 0); a1 = K8FR(2, 1);
  ASBAR();
  p0 = __builtin_amdgcn_mfma_scale_f32_32x32x64_f8f6f4(b0, q8[1], p0, 0, 0, 0, 0x7f7f7f7f, 0, 0x7f7f7f7f);
  p1 = __builtin_amdgcn_mfma_scale_f32_32x32x64_f8f6f4(b1, q8[1], p1, 0, 0, 0, 0x7f7f7f7f, 0, 0x7f7f7f7f);
  ASBAR();
  p0 = __builtin_amdgcn_mfma_scale_f32_32x32x64_f8f6f4(a0, q8[2], p0, 0, 0, 0, 0x7f7f7f7f, 0, 0x7f7f7f7f);
  p1 = __builtin_amdgcn_mfma_scale_f32_32x32x64_f8f6f4(a1, q8[2], p1, 0, 0, 0, 0x7f7f7f7f, 0, 0x7f7f7f7f);
  ASBAR();
#undef K8RD
#undef K8FR
}
__device__ __forceinline__ void pv_d0(f32x16* o, const char* VT, v8i32 p8, int r32, int hi) {
#define VTFR(d0) ({ const v4i32 lo_ = *reinterpret_cast<const v4i32*>(VT + ((d0) * 32 + r32) * 80 + hi * 32), hi_ = *reinterpret_cast<const v4i32*>(VT + ((d0) * 32 + r32) * 80 + hi * 32 + 16); (v8i32){lo_[0], lo_[1], lo_[2], lo_[3], hi_[0], hi_[1], hi_[2], hi_[3]}; })
#define PVMMA(d0, fr) o[d0] = __builtin_amdgcn_mfma_scale_f32_32x32x64_f8f6f4(p8, fr, o[d0], 1  , 0  , 0, 0x7f7f7f7f, 0, 0x7f7f7f7f)
  v8i32 fa = VTFR(0), fb = VTFR(1);
  ASBAR();
  PVMMA(0, fa); fa = VTFR(2); ASBAR();
  PVMMA(1, fb); fb = VTFR(3); ASBAR();
  PVMMA(2, fa); PVMMA(3, fb); ASBAR();
#undef VTFR
#undef PVMMA
}
template <bool SHIFT> __device__ __forceinline__ bool attn_unit(int b, int h, int s0, const bf16* Qraw, const unsigned char* __restrict__ VT8g, const unsigned char* __restrict__ K8g, const unsigned char* __restrict__ KP8g, bf16* __restrict__ O,
                                          const float* rope, const float* qg, float smaxC, char* lds, int tid) {
  asm volatile("" : "+v"(tid));
  const int wid = __builtin_amdgcn_readfirstlane(tid >> 6), lane = tid & 63, r32 = lane & 31, hi = lane >> 5;
  asm volatile("" : "+s"(qg));
  char* V_lds = lds + OFF_V; char* K8_lds = lds + OFF_K8;
  float* ws = (float*)(lds + OFF_WS) + wid * 64; float* li_l = ws;
  constexpr float C = 0.072168783648703220f * 1.4426950408889634f;
  v8i32 q8[3];
  {
    typedef __attribute__((address_space(1))) const v4i32 gv4i; typedef __attribute__((address_space(1))) const f32x4_t gf32x4; typedef float f32x2_t __attribute__((ext_vector_type(2)));
    const long trow = (long)b * SEQ + s0 + wid * QBLK + r32;
    const unsigned qo = (unsigned)(trow * LDQ + h * 192), ro = (unsigned)(trow * 256), go = (unsigned)(hi * 128);
#define rp4_(i) (*(gf32x4*)((const char*)rope + ro + (i) * 16))
#define qgn_(i) (*(gf32x4*)((const char*)qg + go + (i) * 16))
#define qgr_(i) (*(gf32x4*)((const char*)qg + 512 + (i) * 16))
#define F8LO(w) __builtin_amdgcn_cvt_pk_f32_fp8((w), false)
#define F8HI(w) __builtin_amdgcn_cvt_pk_f32_fp8((w), true)
    v4i32 rn_[2][2], rr_[4];
#pragma unroll
    for (int m = 0; m < 2; ++m)
#pragma unroll
      for (int part = 0; part < 2; ++part) rn_[m][part] = *(gv4i*)((const char*)Qraw + qo + 64 * m + 32 * hi + 16 * part);
#pragma unroll
    for (int c = 0; c < 4; ++c) rr_[c] = *(gv4i*)((const char*)Qraw + qo + 128 + 16 * c);
    float ssn = 0.f, ssp = 0.f;
#pragma unroll
    for (int m = 0; m < 2; ++m)
#pragma unroll
      for (int part = 0; part < 2; ++part)
#pragma unroll
        for (int wi = 0; wi < 4; ++wi) { const f32x2_t a = F8LO(rn_[m][part][wi]), c2 = F8HI(rn_[m][part][wi]); ssn += (a.x * a.x + a.y * a.y) + (c2.x * c2.x + c2.y * c2.y); }
#pragma unroll
    for (int c = 0; c < 4; ++c)
#pragma unroll
      for (int wi = 0; wi < 4; ++wi) { const f32x2_t a = F8LO(rr_[c][wi]), c2 = F8HI(rr_[c][wi]); ssp += (a.x * a.x + a.y * a.y) + (c2.x * c2.x + c2.y * c2.y); }
    ssn += __shfl_xor(ssn, 32);
    const float rn = rsqrtf(ssn * (1.f / 128.f) + 64e-6f) * C, rp = rsqrtf(ssp * (1.f / 64.f) + 64e-6f) * C;
#pragma unroll
    for (int m = 0; m < 2; ++m)
#pragma unroll
      for (int part = 0; part < 2; ++part)
#pragma unroll
        for (int wi = 0; wi < 4; ++wi) { const f32x4_t g = qgn_(16 * m + 4 * part + wi); const f32x2_t a = F8LO(rn_[m][part][wi]), c2 = F8HI(rn_[m][part][wi]);
          int w0 = 0; w0 = __builtin_amdgcn_cvt_pk_fp8_f32(a.x * rn * g[0], a.y * rn * g[1], w0, false); w0 = __builtin_amdgcn_cvt_pk_fp8_f32(c2.x * rn * g[2], c2.y * rn * g[3], w0, true);
          q8[m][4 * part + wi] = w0; }
#pragma unroll
    for (int wi = 0; wi < 8; ++wi) {
      const int w1r = rr_[wi >> 2][wi & 3], w2r = rr_[2 + (wi >> 2)][wi & 3];
      const f32x4_t g1 = qgr_(wi), g2 = qgr_(8 + wi), csA = rp4_(2 * wi), csB = rp4_(2 * wi + 1);
      const f32x2_t x1a = F8LO(w1r), x1b = F8HI(w1r), x2a = F8LO(w2r), x2b = F8HI(w2r);
      const float x1[4] = {x1a.x * rp * g1[0], x1a.y * rp * g1[1], x1b.x * rp * g1[2], x1b.y * rp * g1[3]}, x2[4] = {x2a.x * rp * g2[0], x2a.y * rp * g2[1], x2b.x * rp * g2[2], x2b.y * rp * g2[3]};
      const float cs[4] = {csA[0], csA[2], csB[0], csB[2]}, sn[4] = {csA[1], csA[3], csB[1], csB[3]}; float ov[4];
#pragma unroll
      for (int j = 0; j < 4; ++j) ov[j] = hi == 0 ? (x1[j] * cs[j] - x2[j] * sn[j]) : (x1[j] * sn[j] + x2[j] * cs[j]);
      int w0 = 0; w0 = __builtin_amdgcn_cvt_pk_fp8_f32(ov[0], ov[1], w0, false); w0 = __builtin_amdgcn_cvt_pk_fp8_f32(ov[2], ov[3], w0, true);
      asm volatile("" : "+v"(w0) :: "memory"); q8[2][wi] = w0; }
#undef rp4_
#undef qgn_
#undef qgr_
#undef F8LO
#undef F8HI
  }
  const float negm = 15.0f - smaxC;
  float l_reg = 0.f; f32x16 o[4] = {};
  const char* Vg = (const char*)(VT8g + (size_t)h * 128 * T_TOK + (size_t)b * SEQ); const char* Kg = (const char*)(K8g + ((long)b * SEQ * 8 + h) * 128); const char* Pg = (const char*)(KP8g + (long)b * SEQ * 64);
  const int vc = tid >> 2, vq = tid & 3, vst = vc * 80 + 16 * (vq >> 1) + 8 * (vq & 1); const unsigned gvt = (unsigned)vc * (unsigned)T_TOK + 16u * (unsigned)vq;
  const int kr = tid >> 3, kc = tid & 7, kst = kr * 208 + kc * 16; const unsigned gk8 = (unsigned)(kr * 1024 + kc * 16);
  const int pr = (tid & 255) >> 2, pc = tid & 3, pst = pr * 208 + 128 + pc * 16; const unsigned gp8 = (unsigned)(pr * 64 + pc * 16);
  v4i32 s_v, s_k, s_p;
#define SLOAD(k0) do { s_v = *reinterpret_cast<const v4i32*>(Vg + (size_t)(k0) + gvt); \
    s_k = *reinterpret_cast<const v4i32*>(Kg + (size_t)(k0) * 1024 + gk8); if (tid < 256) s_p = *reinterpret_cast<const v4i32*>(Pg + (size_t)(k0) * 64 + gp8); } while (0)
#define SWRITE(kbuf, vbuf_) do { { v2i32 a_ = {s_v[0], s_v[2]}, b_ = {s_v[1], s_v[3]}; *(v2i32*)(V_lds + (vbuf_) * SHM_VT + vst) = a_; *(v2i32*)(V_lds + (vbuf_) * SHM_VT + vst + 32) = b_; } \
    *(v4i32*)(K8_lds + (kbuf) * SHM_K8 + kst) = s_k; if (tid < 256) *(v4i32*)(K8_lds + (kbuf) * SHM_K8 + pst) = s_p; } while (0)
  constexpr int NT = SEQ / KVBLK;
  v8i32 p8;
  SLOAD(0); SWRITE(0, 0); __syncthreads(); SLOAD(KVBLK);
  if (wid < 4) {
    for (int j = 0, kb = 0, vbuf = 0, vnx = 1; j < NT; ++j) {
      f32x16 p0, p1;
      qkt<SHIFT>(p0, p1, K8_lds + kb * SHM_K8, q8, negm, r32, hi);
      smA<SHIFT>(p0, negm); smB<SHIFT>(p0, p1, l_reg, p8, negm); ASBAR();
      pv_d0(o, V_lds + vbuf * SHM_VT, p8, r32, hi);
      if (j + 1 < NT) SWRITE(kb ^ 1, vnx);
      __syncthreads();
      if (j + 2 < NT) SLOAD((j + 2) * KVBLK);
      kb ^= 1; vbuf = vnx; vnx = vnx == 2 ? 0 : vnx + 1;
    }
  } else {
    int vprev = 0;
    __builtin_amdgcn_s_setprio(1);
    for (int j = 0, kb = 0, vbuf = 0, vnx = 1; j < NT; ++j) {
      f32x16 p0, p1;
      if (j > 0) pv_d0(o, V_lds + vprev * SHM_VT, p8, r32, hi);
      qkt<SHIFT>(p0, p1, K8_lds + kb * SHM_K8, q8, negm, r32, hi);
      smA<SHIFT>(p0, negm); smB<SHIFT>(p0, p1, l_reg, p8, negm); ASBAR();
      if (j + 1 < NT) SWRITE(kb ^ 1, vnx);
      __syncthreads();
      if (j + 2 < NT) SLOAD((j + 2) * KVBLK);
      kb ^= 1; vprev = vbuf; vbuf = vnx; vnx = vnx == 2 ? 0 : vnx + 1;
    }
    pv_d0(o, V_lds + vprev * SHM_VT, p8, r32, hi);
    __builtin_amdgcn_s_setprio(0);
  }
  int lane_e = lane; asm volatile("" : "+v"(lane_e));
  const int r32e = lane_e & 31, hie = lane_e >> 5;
  l_reg += __shfl_xor(l_reg, 32);
  int* satf = (int*)(lds + OFF_WS + NW * 64 * 4);
  if (!SHIFT) { const bool sat = __any(l_reg >= 57344.f); if (lane_e == 0) satf[wid] = sat ? 1 : 0; }
  if (hie == 0) li_l[r32e] = l_reg; asm volatile("s_waitcnt lgkmcnt(0)" ::: "memory");
  float rli[16];
#pragma unroll
  for (int r = 0; r < 16; ++r) rli[r] = __builtin_amdgcn_rcpf(li_l[crow(r, hie)]);
  char* Ow = (char*)O + ((long)b * SEQ + s0 + wid * QBLK) * LDO + h * 128;
#pragma unroll
  for (int r = 0; r < 16; ++r) { const unsigned ooff = (unsigned)(crow(r, hie) * LDO + r32e);
#pragma unroll
    for (int d0 = 0; d0 < 4; ++d0) { const int pk = __builtin_amdgcn_cvt_pk_fp8_f32(o[d0][r] * rli[r] * 32.f, 0.f, 0, false); *(unsigned char*)(Ow + ooff + d0 * 32) = (unsigned char)(pk & 0xff); } }
  __syncthreads();
  bool redo = false;
  if (!SHIFT) { redo = (satf[0] | satf[1] | satf[2] | satf[3] | satf[4] | satf[5] | satf[6] | satf[7]) != 0; __syncthreads(); }
  return redo;
#undef SLOAD
#undef SWRITE
}
}
#ifndef HD
#define HD __device__ __forceinline__
#endif
struct c32 { float x, y; };
HD c32 cmk(float x, float y) { c32 r; r.x = x; r.y = y; return r; }
HD c32 cadd(c32 a, c32 b) { return cmk(a.x + b.x, a.y + b.y); }
HD c32 csub(c32 a, c32 b) { return cmk(a.x - b.x, a.y - b.y); }
HD c32 cmul(c32 a, c32 b) { return cmk(a.x * b.x - a.y * b.y, a.x * b.y + a.y * b.x); }
HD c32 cmulc(c32 a, c32 b) { return cmk(a.x * b.x + a.y * b.y, a.y * b.x - a.x * b.y); }
constexpr int BR4(int i) { return ((i & 1) << 3) | ((i & 2) << 1) | ((i & 4) >> 1) | ((i & 8) >> 3); }
template <int SGN, int J> HD c32 tw16(c32 a) {
    if constexpr (J == 0) return a;
    else if constexpr (J == 4) return SGN < 0 ? cmk(a.y, -a.x) : cmk(-a.y, a.x);
    else {
        constexpr float CS[8] = {1.f, 0.92387953251128674f, 0.70710678118654752f, 0.38268343236508977f, 0.f, -0.38268343236508977f, -0.70710678118654752f, -0.92387953251128674f};
        constexpr float SN[8] = {0.f, 0.38268343236508977f, 0.70710678118654752f, 0.92387953251128674f, 1.f, 0.92387953251128674f, 0.70710678118654752f, 0.38268343236508977f};
        constexpr float c = CS[J], s = SN[J];
        if constexpr (SGN < 0) return cmk(a.x * c + a.y * s, a.y * c - a.x * s);
        else return cmk(a.x * c - a.y * s, a.y * c + a.x * s);
    }
}
#define FFT_BF(i, j, J) { const c32 u_ = v[i], w_ = v[j]; v[i] = cadd(u_, w_); v[j] = tw16<SGN, J>(csub(u_, w_)); }
template <int SGN> HD void dft16_dif(c32 (&v)[16]) {
    FFT_BF(0, 8, 0) FFT_BF(1, 9, 1) FFT_BF(2, 10, 2) FFT_BF(3, 11, 3) FFT_BF(4, 12, 4) FFT_BF(5, 13, 5) FFT_BF(6, 14, 6) FFT_BF(7, 15, 7)
    FFT_BF(0, 4, 0) FFT_BF(1, 5, 2) FFT_BF(2, 6, 4) FFT_BF(3, 7, 6) FFT_BF(8, 12, 0) FFT_BF(9, 13, 2) FFT_BF(10, 14, 4) FFT_BF(11, 15, 6)
    FFT_BF(0, 2, 0) FFT_BF(1, 3, 4) FFT_BF(4, 6, 0) FFT_BF(5, 7, 4) FFT_BF(8, 10, 0) FFT_BF(9, 11, 4) FFT_BF(12, 14, 0) FFT_BF(13, 15, 4)
    FFT_BF(0, 1, 0) FFT_BF(2, 3, 0) FFT_BF(4, 5, 0) FFT_BF(6, 7, 0) FFT_BF(8, 9, 0) FFT_BF(10, 11, 0) FFT_BF(12, 13, 0) FFT_BF(14, 15, 0)
}
#undef FFT_BF
#define FFT_BT(i, j, J) { const c32 u_ = v[i], w_ = tw16<SGN, J>(v[j]); v[i] = cadd(u_, w_); v[j] = csub(u_, w_); }
template <int SGN> HD void dft16_dit(c32 (&v)[16]) {
    FFT_BT(0, 1, 0) FFT_BT(2, 3, 0) FFT_BT(4, 5, 0) FFT_BT(6, 7, 0) FFT_BT(8, 9, 0) FFT_BT(10, 11, 0) FFT_BT(12, 13, 0) FFT_BT(14, 15, 0)
    FFT_BT(0, 2, 0) FFT_BT(1, 3, 4) FFT_BT(4, 6, 0) FFT_BT(5, 7, 4) FFT_BT(8, 10, 0) FFT_BT(9, 11, 4) FFT_BT(12, 14, 0) FFT_BT(13, 15, 4)
    FFT_BT(0, 4, 0) FFT_BT(1, 5, 2) FFT_BT(2, 6, 4) FFT_BT(3, 7, 6) FFT_BT(8, 12, 0) FFT_BT(9, 13, 2) FFT_BT(10, 14, 4) FFT_BT(11, 15, 6)
    FFT_BT(0, 8, 0) FFT_BT(1, 9, 1) FFT_BT(2, 10, 2) FFT_BT(3, 11, 3) FFT_BT(4, 12, 4) FFT_BT(5, 13, 5) FFT_BT(6, 14, 6) FFT_BT(7, 15, 7)
}
#undef FFT_BT
constexpr int FFT_PS = 272;
constexpr int FFT_EX_ELEMS = 16 * FFT_PS;
template <class EX> HD void fft_fwd_a(c32 (&v)[16], const c32* T1, EX ex, int tid) {
    dft16_dif<-1>(v);
#pragma unroll
    for (int p = 0; p < 16; ++p) { ex[p * FFT_PS + tid] = cmul(v[BR4(p)], T1[256 * p]); if ((p & 3) == 3) __builtin_amdgcn_sched_barrier(0); }
}
template <class EX> HD void fft_fwd_b(c32 (&v)[16], const c32* T2, EX exr, EX ex, int tid) {
    const int p2 = tid >> 4, c = tid & 15;
#pragma unroll
    for (int b = 0; b < 16; ++b) v[b] = exr[p2 * FFT_PS + 16 * b + c];
    dft16_dif<-1>(v);
#pragma unroll
    for (int q = 0; q < 16; ++q) ex[p2 * FFT_PS + q * 16 + ((c + q) & 15)] = cmul(v[BR4(q)], T2[q]);
}
template <class EX> HD void fft_fwd_c(c32 (&v)[16], EX ex, int tid) {
    const int p2 = tid >> 4, q = tid & 15;
#pragma unroll
    for (int c = 0; c < 16; ++c) v[c] = ex[p2 * FFT_PS + q * 16 + ((c + q) & 15)];
    dft16_dif<-1>(v);
}
template <class EX> HD void fft_inv_a(c32 (&v)[16], EX ex, int tid) {
    const int p = tid >> 4, q = tid & 15;
    dft16_dit<+1>(v);
#pragma unroll
    for (int c = 0; c < 16; ++c) ex[p * FFT_PS + q * 16 + ((c + q) & 15)] = v[c];
}
template <class EX> HD void fft_inv_b(c32 (&v)[16], const c32* T2, EX exr, EX ex, int tid) {
    const int p = tid >> 4, c = tid & 15;
#pragma unroll
    for (int q = 0; q < 16; ++q) v[BR4(q)] = cmulc(exr[p * FFT_PS + q * 16 + ((c + q) & 15)], T2[q]);
    dft16_dit<+1>(v);
#pragma unroll
    for (int b = 0; b < 16; ++b) ex[p * FFT_PS + 16 * b + c] = v[b];
}
template <class EX> HD void fft_inv_c(c32 (&v)[16], const c32* T1, EX ex, int tid) {
#pragma unroll
    for (int p = 0; p < 16; ++p) { v[BR4(p)] = cmulc(ex[p * FFT_PS + tid], T1[256 * p]); if ((p & 3) == 3) __builtin_amdgcn_sched_barrier(0); }
    dft16_dit<+1>(v);
}
constexpr int NWAVES = 8, NTHR = 512;
constexpr int BATCH = 8, SEQ = 4096, DM = 1024, T = BATCH * SEQ;
constexpr float EPS = 1e-6f;
constexpr size_t MiB = 1u << 20;
constexpr size_t WS_CTL = 0, CTL_ZERO_BYTES = 64 * 1024;
constexpr size_t WS_MOD = 1 * MiB;
constexpr size_t WS_HDNS = 1 * MiB + 512 * 1024;
constexpr size_t WS_W4S = 3 * MiB + 512 * 1024;
constexpr size_t WS_LIST = 101 * MiB;
constexpr size_t WS_WL = 396 * MiB;
constexpr size_t WS_WD = 8 * MiB;
constexpr size_t WS_WUQ = 9 * MiB;
constexpr size_t WS_WUKV = 10 * MiB;
constexpr size_t WS_WO = 11 * MiB;
constexpr size_t WS_WIN = 13 * MiB;
constexpr size_t WS_WOUT = 19 * MiB;
constexpr size_t WS_WGU = 21 * MiB;
constexpr size_t WS_WDN = 53 * MiB;
constexpr size_t R1 = 104 * MiB;
constexpr size_t R2 = 232 * MiB;
constexpr size_t R3 = 424 * MiB;
constexpr size_t WS_VT8 = R1, WS_XN2 = R1, WS_KF = R1;
constexpr size_t WS_XN = R2, WS_O = R2;
constexpr size_t WS_LAT = R2 + 64 * MiB;
constexpr size_t WS_HACT = R2 + 64 * MiB;
constexpr size_t WS_CQN = R2 + 128 * MiB;
constexpr size_t WS_CKVN = R2 + 144 * MiB;
constexpr size_t WS_KPE = R2 + 160 * MiB;
constexpr size_t WS_K8 = R2 + 64 * MiB;
constexpr size_t WS_ROPE = R2 + 164 * MiB;
constexpr size_t WS_QRAW = 408 * MiB;
constexpr size_t WS_XN2S = 424 * MiB;
constexpr size_t WS_XR = 424 * MiB;
constexpr size_t WS_HT = R2;
constexpr size_t WS_UT = R2;
constexpr size_t WS_Z = R2;
constexpr size_t WS_END = 512 * MiB;
constexpr int MS_ROWS = T + 24 * 256;
constexpr int CW_BAR = 4096;
constexpr int CW_FILT = 12352;
constexpr int CW_CNT = 8192;
constexpr int RING_OFF = 0, RING_BYTES = 147456;
constexpr int LDSCTL_OFF = RING_BYTES;
constexpr int MISC_OFF = LDSCTL_OFF;
constexpr int TINFO_OFF = LDSCTL_OFF + 256;
constexpr int RED_OFF = LDSCTL_OFF + 256 + 1280;
constexpr int EPIX_OFF = LDSCTL_OFF + 2048;
constexpr int LDS_BYTES = 163840;
static_assert(RED_OFF + 256 <= LDS_BYTES, "LDS map");

#define GAS __attribute__((address_space(1)))
#define LAS __attribute__((address_space(3)))
typedef unsigned short bf16;
typedef unsigned v4u __attribute__((ext_vector_type(4)));
typedef unsigned v2u __attribute__((ext_vector_type(2)));
typedef int v4i __attribute__((ext_vector_type(4)));
typedef float f32x4 __attribute__((ext_vector_type(4)));
typedef GAS unsigned gu32;
#define RLX_AGENT __ATOMIC_RELAXED, __HIP_MEMORY_SCOPE_AGENT
#define LDS_WAIT() asm volatile("s_waitcnt lgkmcnt(0)" ::: "memory")
__device__ __forceinline__ unsigned pk2(float lo, float hi) { return pg8::cvt_pk_bf16(lo, hi); }
__device__ __forceinline__ float bf2f(unsigned short b) { return __uint_as_float(((unsigned)b) << 16); }
__device__ __forceinline__ float wave_sum(float v) {
#define WS_DPP(x, ctrl, rmask) __int_as_float(__builtin_amdgcn_update_dpp(0, __float_as_int(x), ctrl, rmask, 0xf, false))
    v += WS_DPP(v, 0xB1, 0xf); v += WS_DPP(v, 0x4E, 0xf); v += WS_DPP(v, 0x141, 0xf); v += WS_DPP(v, 0x140, 0xf);
    v += WS_DPP(v, 0x142, 0xa); v += WS_DPP(v, 0x143, 0xc);
#undef WS_DPP
    return __int_as_float(__builtin_amdgcn_readlane(__float_as_int(v), 63));
}

#define XB_TMO      128
#define XB_XCNT(j)  (256  + 64 * (j))
#define XB_XSUB(j)  (1280 + 64 * (j))
#define XB_XGEN(j)  (2304 + 64 * (j))
#define XB_TOP      3328
#define XB_TOPGEN   3392
#define XCD_BAR_WORDS 3456
#define XB_SPIN_CAP (1u << 18)

__device__ __forceinline__ unsigned xb_ld(unsigned* p)              { return __hip_atomic_load(p, __ATOMIC_RELAXED, __HIP_MEMORY_SCOPE_AGENT); }
__device__ __forceinline__ unsigned xb_add(unsigned* p, unsigned v) { return __hip_atomic_fetch_add(p, v, __ATOMIC_RELAXED, __HIP_MEMORY_SCOPE_AGENT); }
__device__ __forceinline__ unsigned xb_xcc_id() { return (unsigned)__builtin_amdgcn_s_getreg((3 << 11) | 20) & 0xFu; }
#define XB_SPIN(cond, bar) do { unsigned _sp = 0; while (cond) { __builtin_amdgcn_s_sleep(1); \
    if ((++_sp & 255u) == 0u) { if (xb_ld(&(bar)[XB_TMO])) break; if (_sp > XB_SPIN_CAP) { atomicAdd(&(bar)[XB_TMO], 1u); break; } } } } while (0)

struct XcdBarrier {
    unsigned* bar; unsigned x;
    volatile LAS unsigned* st;
    int w0;
};

__device__ __forceinline__ XcdBarrier xcd_barrier_post(unsigned* bar, volatile LAS unsigned* st) {
    XcdBarrier b; b.bar = bar; b.x = xb_xcc_id(); b.st = st; b.w0 = 0;
    if (threadIdx.x == 0) (void)xb_add(&bar[XB_XCNT(b.x)], 1u);
    return b;
}
__device__ __forceinline__ void xcd_barrier_complete(unsigned* bar, unsigned x, unsigned& nloc, unsigned& nx) {
    const unsigned G = gridDim.x * gridDim.y * gridDim.z;
    unsigned sum, cnt, mine, sp = 0u;
    for (;;) {
        sum = 0u; cnt = 0u; mine = 0u;
#pragma unroll
        for (unsigned j = 0; j < 16; ++j) { const unsigned c = xb_ld(&bar[XB_XCNT(j)]); sum += c; cnt += (c > 0u) ? 1u : 0u; mine = (j == x) ? c : mine; }
        if (sum == G) break;
        __builtin_amdgcn_s_sleep(1);
        if ((++sp & 255u) == 0u) { if (xb_ld(&bar[XB_TMO])) break; if (sp > XB_SPIN_CAP) { atomicAdd(&bar[XB_TMO], 1u); break; } }
    }
    nloc = mine > 0u ? mine : 1u; nx = cnt > 0u ? cnt : 1u;
}

__device__ __forceinline__ void xcd_barrier(const XcdBarrier& b) {
    asm volatile("s_waitcnt vmcnt(0)" ::: "memory");
    __syncthreads();
    if (b.w0 && __builtin_amdgcn_mbcnt_hi(~0u, __builtin_amdgcn_mbcnt_lo(~0u, 0u)) == 0u) {
        unsigned* bar = b.bar;
        __builtin_amdgcn_s_waitcnt(0);
        unsigned nloc = b.st[0], nx = b.st[1];
        if (nloc == 0u) { xcd_barrier_complete(bar, b.x, nloc, nx); b.st[0] = nloc; b.st[1] = nx; }
        const unsigned old = xb_add(&bar[XB_XSUB(b.x)], 1u);
        const unsigned gen = old / nloc;
        if (old + 1u == (gen + 1u) * nloc) {
            __builtin_amdgcn_fence(__ATOMIC_RELEASE, "agent");
            asm volatile("s_waitcnt vmcnt(0)" ::: "memory");
            const unsigned og = xb_add(&bar[XB_TOP], 1u);
            const unsigned tg = og / nx;
            if (og + 1u == (tg + 1u) * nx) xb_add(&bar[XB_TOPGEN], 1u);
            else XB_SPIN(xb_ld(&bar[XB_TOPGEN]) == tg, bar);
            __builtin_amdgcn_fence(__ATOMIC_ACQUIRE, "agent");
            xb_add(&bar[XB_XGEN(b.x)], 1u);
            asm volatile("s_waitcnt vmcnt(0)" ::: "memory");
        } else {
            XB_SPIN(xb_ld(&bar[XB_XGEN(b.x)]) == gen, bar);
            __builtin_amdgcn_fence(__ATOMIC_ACQUIRE, "agent");
            asm volatile("s_waitcnt vmcnt(0)" ::: "memory");
        }
    }
    __syncthreads();
}


struct Ctx { unsigned char* lds; int tid, lane, wave, vcu, G, gw, NGW; };

__device__ __forceinline__ void transpose_item(const float* W, int ldw, int k0, int n0, bf16* WT, int ldt, int drow0, int dcol0, float* scr, int lane, bool kpe_perm) {
    float tv[32];
#pragma unroll
    for (int i = 0; i < 32; ++i) { const int kk = 2 * i + (lane >> 5); tv[i] = W[(size_t)(k0 + kk) * ldw + n0 + (lane & 31)]; }
#pragma unroll
    for (int i = 0; i < 32; ++i) { const int kk = 2 * i + (lane >> 5); scr[kk * 33 + (lane & 31)] = tv[i]; }
    LDS_WAIT();
    const int c = lane & 7;
#pragma unroll
    for (int j = 0; j < 4; ++j) { const int n = (lane >> 3) + 8 * j; const float* s = scr + (8 * c) * 33 + n;
        v4u o; o.x = pk2(s[0 * 33], s[1 * 33]); o.y = pk2(s[2 * 33], s[3 * 33]); o.z = pk2(s[4 * 33], s[5 * 33]); o.w = pk2(s[6 * 33], s[7 * 33]);
        int dr = drow0 + n; if (kpe_perm && dr >= 384 && dr < 448) { const int e = dr - 384; dr = 384 + 32 * ((e >> 4) & 1) + 16 * (e >> 5) + (e & 15); }
        *(v4u*)(WT + (size_t)dr * ldt + dcol0 + k0 + 8 * c) = o; }
    LDS_WAIT();
}
__device__ __forceinline__ void transpose_item8(const float* W, int ldw, int k0, int n0, unsigned char* WT8, int ldt8, int drow0, int dcol0, float* scr, int lane, float scale, bool kpe_perm) {
    float tv[32];
#pragma unroll
    for (int i = 0; i < 32; ++i) { const int kk = 2 * i + (lane >> 5); tv[i] = W[(size_t)(k0 + kk) * ldw + n0 + (lane & 31)]; }
#pragma unroll
    for (int i = 0; i < 32; ++i) { const int kk = 2 * i + (lane >> 5); scr[kk * 33 + (lane & 31)] = tv[i]; }
    LDS_WAIT();
    const int n = lane >> 1, hf = lane & 1; const float* sp = scr + (32 * hf) * 33 + n;
    v4u o0, o1; unsigned w[8];
#pragma unroll
    for (int q = 0; q < 8; ++q) { int p = 0; p = __builtin_amdgcn_cvt_pk_fp8_f32(sp[(4 * q) * 33] * scale, sp[(4 * q + 1) * 33] * scale, p, false); p = __builtin_amdgcn_cvt_pk_fp8_f32(sp[(4 * q + 2) * 33] * scale, sp[(4 * q + 3) * 33] * scale, p, true); w[q] = (unsigned)p; }
    o0.x = w[0]; o0.y = w[1]; o0.z = w[2]; o0.w = w[3]; o1.x = w[4]; o1.y = w[5]; o1.z = w[6]; o1.w = w[7];
    int dr = drow0 + n; if (kpe_perm && dr >= 384 && dr < 448) { const int e = dr - 384; dr = 384 + 32 * ((e >> 4) & 1) + 16 * (e >> 5) + (e & 15); }
    unsigned char* d = WT8 + (size_t)dr * ldt8 + dcol0 + k0 + 32 * hf;
    *(v4u*)d = o0; *(v4u*)(d + 16) = o1;
    LDS_WAIT();
}
typedef __attribute__((address_space(4))) const char kchar;
struct In { int opq;
    __device__ __forceinline__ const float* operator[](int k) const { kchar* ka = (kchar*)__builtin_amdgcn_kernarg_segment_ptr(); return *(const float* const __attribute__((address_space(4)))*)(ka + 8 * k + opq); } };
__device__ __forceinline__ unsigned char* karg_ws(int opq) { kchar* ka = (kchar*)__builtin_amdgcn_kernarg_segment_ptr(); return *(unsigned char* const __attribute__((address_space(4)))*)(ka + 38 * 8 + 8 + opq); }
__device__ __forceinline__ float* karg_out(int opq) { kchar* ka = (kchar*)__builtin_amdgcn_kernarg_segment_ptr(); return *(float* const __attribute__((address_space(4)))*)(ka + 38 * 8 + opq); }

__device__ __forceinline__ void p0_prologue(const Ctx& F, const In& in, unsigned char* ws) {
    float* scr = (float*)(F.lds + RING_OFF + F.wave * 8448);
    float* cact = (float*)(F.lds + RING_OFF + 67584); float* red = (float*)(F.lds + RING_OFF + 100352);
    bf16* Wd = (bf16*)(ws + WS_WD); bf16* Wuq = (bf16*)(ws + WS_WUQ); bf16* Wukv = (bf16*)(ws + WS_WUKV); bf16* Wo = (bf16*)(ws + WS_WO);
    bf16* Win = (bf16*)(ws + WS_WIN); bf16* Wout = (bf16*)(ws + WS_WOUT); bf16* Wgu = (bf16*)(ws + WS_WGU); bf16* Wdn = (bf16*)(ws + WS_WDN);
    constexpr int I_D = 16 * 14, I_UQ = 4 * 48, I_UKV = 2 * 64, I_O = 16 * 32, I_IN = 16 * 96, I_OUT = 16 * 32, I_GU = 2 * 16 * 2 * (16 * 8), I_DN = 2 * 24 * 2 * (4 * 32);
    constexpr int NITEMS = I_D + I_UQ + I_UKV + I_O + I_IN + I_OUT + I_GU + I_DN;
    for (int i = F.tid; i < 8 * 1024; i += NTHR) { const float x = in[1][i]; cact[(i & 1023) * 8 + (i >> 10)] = x / (1.f + __expf(-x)); }
    __syncthreads();
    const bool ada_on = F.vcu < 2 * 96; const int ada_layer = F.vcu / 96, ada_cb = F.vcu - 96 * ada_layer, ada_r4 = F.lane >> 4, ada_cq = F.lane & 15;
    const float* adaW = in[3] + (size_t)ada_layer * 1024 * 6144 + ada_cb * 64 + 4 * ada_cq + (size_t)(F.wave * 128 + ada_r4) * 6144;
    f32x4 ada_acc[8], ada_wv[16];
#pragma unroll
    for (int b = 0; b < 8; ++b) ada_acc[b] = (f32x4){0.f, 0.f, 0.f, 0.f};
#define ADA_ISSUE(hf) do { if (ada_on) { _Pragma("unroll") for (int q = 0; q < 16; ++q) ada_wv[q] = *(const f32x4*)(adaW + (size_t)(4 * (16 * (hf) + q)) * 6144); } asm volatile("" ::: "memory"); } while (0)
#define ADA_EAT(hf) do { if (ada_on) { _Pragma("unroll") for (int q = 0; q < 16; ++q) { const int kk = 4 * (16 * (hf) + q) + ada_r4; const float* cp = cact + (F.wave * 128 + kk) * 8; const f32x4 c0 = *(const f32x4*)cp, c1 = *(const f32x4*)(cp + 4); \
        _Pragma("unroll") for (int b = 0; b < 8; ++b) ada_acc[b] += (b < 4 ? c0[b & 3] : c1[b & 3]) * ada_wv[q]; } } } while (0)
    ADA_ISSUE(0);
    const int it_mid = F.gw + 6 * F.NGW;
    for (int part = 0; part < 2; ++part) {
    if (part == 1) { ADA_EAT(0); ADA_ISSUE(1); }
    for (int it = part ? it_mid : F.gw; it < (part ? NITEMS : (it_mid < NITEMS ? it_mid : NITEMS)); it += F.NGW) {
        int r = it; const float* W; int ldw, k0, n0, ldt, drow0, dcol0 = 0; bf16* WT; float f8s = 0.f;
        if (r < I_D) { W = in[7]; ldw = 448; k0 = (r / 14) * 64; n0 = (r % 14) * 32; WT = Wd; ldt = 1024; drow0 = n0; f8s = 32.f; }
        else if ((r -= I_D) < I_UQ) { W = in[10]; ldw = 1536; k0 = (r / 48) * 64; n0 = (r % 48) * 32; WT = Wuq; ldt = 256; drow0 = n0; f8s = 16.f; }
        else if ((r -= I_UQ) < I_UKV) { W = in[11]; ldw = 2048; k0 = (r / 64) * 64; n0 = (r % 64) * 32; ldt = 128;
            WT = Wukv + ((n0 & 128) ? 1024 * 128 : 0); drow0 = (n0 >> 8) * 128 + (n0 & 127); }
        else if ((r -= I_UKV) < I_O) { W = in[14]; ldw = 1024; k0 = (r / 32) * 64; n0 = (r % 32) * 32; WT = Wo; ldt = 1024; drow0 = n0; f8s = 32.f; }
        else if ((r -= I_O) < I_IN) { W = in[15]; ldw = 3072; k0 = (r / 96) * 64; n0 = (r % 96) * 32; WT = Win; ldt = 1024; drow0 = n0; }
        else if ((r -= I_IN) < I_OUT) { W = in[30]; ldw = 1024; k0 = (r / 32) * 64; n0 = (r % 32) * 32; WT = Wout; ldt = 1024; drow0 = n0; }
        else if ((r -= I_OUT) < I_GU) {
            const int sub = r % 128, mat = r / 128, which = mat & 1, le = mat >> 1;
            W = (which ? in[36] : in[35]) + (size_t)le * 1024 * 256; ldw = 256; k0 = (sub / 8) * 64; n0 = (sub % 8) * 32;
            WT = (bf16*)((unsigned char*)Wgu + (size_t)le * 512 * 1024); ldt = 1024; drow0 = (n0 >> 7) * 256 + which * 128 + (n0 & 127); f8s = 32.f; }
        else { r -= I_GU;
            const int sub = r % 128, mat = r / 128, slot = mat & 1, lb = mat >> 1, layer = lb / 24, bk = lb % 24;
            int ii, jj; pg8::pair_of(bk % 6, ii, jj); const int e = (bk / 6) * 4 + (slot ? jj : ii);
            W = in[37] + (size_t)(layer * 16 + e) * 256 * 1024; ldw = 1024; k0 = (sub / 32) * 64; n0 = (sub % 32) * 32;
            WT = (bf16*)((unsigned char*)Wdn + (size_t)lb * 1024 * 512); ldt = 512; drow0 = n0; dcol0 = slot * 256; f8s = 32.f; }
        if (f8s != 0.f) transpose_item8(W, ldw, k0, n0, (unsigned char*)WT, ldt, drow0, dcol0, scr, F.lane, f8s, it < I_D);
        else transpose_item(W, ldw, k0, n0, WT, ldt, drow0, dcol0, scr, F.lane, it < I_D);
    } }
    ADA_EAT(1);
#undef ADA_ISSUE
#undef ADA_EAT
    if (ada_on) {
#pragma unroll
        for (int b = 0; b < 8; ++b)
#pragma unroll
            for (int j = 0; j < 4; ++j) { float v = ada_acc[b][j]; v += __shfl_xor(v, 16); v += __shfl_xor(v, 32); ada_acc[b][j] = v; }
        if (F.lane < 16) {
#pragma unroll
            for (int b = 0; b < 8; ++b) *(f32x4*)(red + (F.wave * 8 + b) * 64 + 4 * ada_cq) = ada_acc[b]; } }
    { const int gt = F.vcu * NTHR + F.tid, NGT = F.G * NTHR; const v4u z = {0u, 0u, 0u, 0u};
      for (int i = gt; i < 64 * 1024 / 16; i += NGT) *(v4u*)((unsigned char*)Wd + (size_t)448 * 1024 + (size_t)i * 16) = z;
    }
    { const int gt = F.vcu * NTHR + F.tid, NGT = F.G * NTHR; float* RT = (float*)(ws + WS_ROPE); const int* posi = (const int*)in[2];
      const float inv = __builtin_amdgcn_exp2f(-0.41524101186092029f * (float)(gt & 31));
      for (int i = gt; i < T * 32; i += NGT) { const int t = i >> 5;
        float sn, cs; sincosf((float)posi[t] * inv, &sn, &cs); *(v2u*)(RT + (size_t)i * 2) = (v2u){__float_as_uint(cs), __float_as_uint(sn)}; } }
    { const int gt = F.vcu * NTHR + F.tid, NGT = F.G * NTHR; bf16* W4S = (bf16*)(ws + WS_W4S); const float* w4 = in[28];
      for (int i = gt; i < 4096 * 8; i += NGT) { const int col = i & 4095, oct = i >> 12; float w[8];
#pragma unroll
        for (int q = 0; q < 8; ++q) w[q] = w4[(size_t)(8 * oct + q) * 4096 + col];
        unsigned hw[4], lw[4];
#pragma unroll
        for (int q = 0; q < 4; ++q) { const unsigned h2 = pk2(w[2 * q], w[2 * q + 1]); hw[q] = h2;
          lw[q] = pk2(w[2 * q] - __uint_as_float(h2 << 16), w[2 * q + 1] - __uint_as_float(h2 & 0xffff0000u)); }
        bf16* d = W4S + (size_t)col * 256 + 8 * oct; const v4u hv = {hw[0], hw[1], hw[2], hw[3]}, lv = {lw[0], lw[1], lw[2], lw[3]}, zv = {0u, 0u, 0u, 0u};
        *(v4u*)d = hv; *(v4u*)(d + 64) = hv; *(v4u*)(d + 128) = lv; *(v4u*)(d + 192) = zv; } }
    __syncthreads();
    { bf16* HDp = (bf16*)(ws + WS_HDNS); float* wl = (float*)(F.lds + RING_OFF); float* sv = wl + 161 * 64 + F.wave * 64;
      for (int i = F.tid; i < 161 * 64; i += NTHR) wl[i] = i < 33 * 64 ? in[19][i] : (i < 97 * 64 ? in[22][i - 33 * 64] : in[25][i - 97 * 64]);
      __syncthreads();
      const int j = F.lane; const float b1 = in[20][j], f1 = in[21][j], b2 = in[23][j], f2 = in[24][j], b3 = in[26][j], f3 = in[27][j];
      for (int t = F.gw; t < 4096; t += F.NGW) {
        float zf = 0.f;
        { const float w = 6.2831855f * (float)t * (1.f / 4096.f);
          if (j == 0) zf = (float)t / 4095.f;
          else if (j <= 16) { const float fr = 1e-4f + (float)(j - 1) * ((15.f - 1e-4f) / 15.f); zf = cosf(fr * w); }
          else if (j <= 32) { const float fr = 1e-4f + (float)(j - 17) * ((15.f - 1e-4f) / 15.f); zf = -sinf(fr * w); } }
        sv[j] = zf; LDS_WAIT();
        float a = b1;
#pragma unroll
        for (int k = 0; k < 33; ++k) a += sv[k] * wl[k * 64 + j];
        float h = sinf(f1 * a); LDS_WAIT(); sv[j] = h; LDS_WAIT();
        a = b2;
#pragma unroll 16
        for (int k = 0; k < 64; ++k) a += sv[k] * wl[(33 + k) * 64 + j];
        h = sinf(f2 * a); LDS_WAIT(); sv[j] = h; LDS_WAIT();
        a = b3;
#pragma unroll 16
        for (int k = 0; k < 64; ++k) a += sv[k] * wl[(97 + k) * 64 + j];
        h = sinf(f3 * a); LDS_WAIT();
        const unsigned hi = pk2(h, 0.f) & 0xffffu; const float lo = h - bf2f((unsigned short)hi); const unsigned lob = pk2(lo, 0.f) & 0xffffu;
        bf16* d = HDp + (size_t)t * 256 + j; d[0] = (bf16)hi; d[64] = (bf16)lob; d[128] = (bf16)hi; d[192] = 0;
      } }
    __syncthreads();
    if (ada_on) { const int b = F.tid >> 6, col = F.tid & 63; float s_ = in[4][ada_layer * 6144 + ada_cb * 64 + col];
#pragma unroll
        for (int w = 0; w < 8; ++w) s_ += red[(w * 8 + b) * 64 + col];
        ((float*)(ws + WS_MOD))[((size_t)ada_layer * 8 + b) * 6144 + ada_cb * 64 + col] = s_; }
}

template <class TX> __device__ __forceinline__ f32x4 ldrow4(const TX* p);
template <> __device__ __forceinline__ f32x4 ldrow4<float>(const float* p) { return *(const __attribute__((address_space(1))) f32x4*)p; }
template <> __device__ __forceinline__ f32x4 ldrow4<bf16>(const bf16* p) { const v2u w = *(const __attribute__((address_space(1))) v2u*)p; f32x4 r; r[0] = __uint_as_float(w.x << 16); r[1] = __uint_as_float(w.x & 0xffff0000u); r[2] = __uint_as_float(w.y << 16); r[3] = __uint_as_float(w.y & 0xffff0000u); return r; }
template <class TX, bool OUT8 = false> __device__ __forceinline__ void norm_mod_phase(const Ctx& F, const TX* X, const float* g, const float* sc, const float* sh, bf16* OUT) {
    for (int ch = F.gw; ch < T / 16; ch += F.NGW) {
        const int r0 = ch * 16, b = r0 >> 12;
        f32x4 A[4], S[4];
#pragma unroll
        for (int j = 0; j < 4; ++j) { const int col = 4 * F.lane + 256 * j; const f32x4 gv = *(const f32x4*)(g + col), sv = *(const f32x4*)(sc + (size_t)b * 6144 + col); A[j] = gv * (1.f + sv); S[j] = *(const f32x4*)(sh + (size_t)b * 6144 + col); }
        const TX* xr = X + (size_t)r0 * DM + 4 * F.lane;
        f32x4 nx[4];
#pragma unroll
        for (int j = 0; j < 4; ++j) nx[j] = ldrow4<TX>(xr + 256 * j);
        for (int rr = 0; rr < 16; ++rr) {
            f32x4 v[4]; float ss = 0.f;
#pragma unroll
            for (int j = 0; j < 4; ++j) { v[j] = nx[j]; ss += (v[j].x * v[j].x + v[j].y * v[j].y) + (v[j].z * v[j].z + v[j].w * v[j].w); }
            if (rr < 15) {
#pragma unroll
                for (int j = 0; j < 4; ++j) nx[j] = ldrow4<TX>(xr + (size_t)(rr + 1) * DM + 256 * j); }
            const float rstd = rsqrtf(wave_sum(ss) * (1.f / DM) + EPS);
            if constexpr (OUT8) { unsigned char* orow = (unsigned char*)OUT + (size_t)(r0 + rr) * DM + 4 * F.lane;
#pragma unroll
                for (int j = 0; j < 4; ++j) { const f32x4 o = v[j] * rstd * A[j] + S[j]; int p = 0; p = __builtin_amdgcn_cvt_pk_fp8_f32(o.x, o.y, p, false); p = __builtin_amdgcn_cvt_pk_fp8_f32(o.z, o.w, p, true); *(int*)(orow + 256 * j) = p; } }
            else { bf16* orow = OUT + (size_t)(r0 + rr) * DM + 4 * F.lane;
#pragma unroll
                for (int j = 0; j < 4; ++j) { const f32x4 o = v[j] * rstd * A[j] + S[j]; v2u w; w.x = pk2(o.x, o.y); w.y = pk2(o.z, o.w); *(v2u*)(orow + 256 * j) = w; } } }
    }
}

__device__ __forceinline__ void lat_post_phase(const Ctx& F, const float* LAT, const float* qag, const float* kvag, const float* kng, const float* rope, bf16* CQN, bf16* CKVN, bf16* KPE) {
    const int l = F.lane;
    const f32x4 gq = *(const f32x4*)(qag + 4 * l);
    const f32x4 g2 = l < 32 ? *(const f32x4*)(kvag + 4 * l) : (l < 48 ? *(const f32x4*)(kng + 128 + 4 * (l - 32)) : (f32x4){0.f, 0.f, 0.f, 0.f});
    f32x4 na = *(const f32x4*)(LAT + (size_t)F.gw * 512 + 4 * l), nc = l < 48 ? *(const f32x4*)(LAT + (size_t)F.gw * 512 + 256 + 4 * l) : (f32x4){0.f, 0.f, 0.f, 0.f};
    for (int row = F.gw; row < T; row += F.NGW) {
        const f32x4 a = na, c = nc;
        if (row + F.NGW < T) { const float* nr = LAT + (size_t)(row + F.NGW) * 512; na = *(const f32x4*)(nr + 4 * l); if (l < 48) nc = *(const f32x4*)(nr + 256 + 4 * l); }
        const float sq = (a.x * a.x + a.y * a.y) + (a.z * a.z + a.w * a.w), sc = (c.x * c.x + c.y * c.y) + (c.z * c.z + c.w * c.w);
        const float s_q = wave_sum(sq), s_kv = wave_sum(l < 32 ? sc : 0.f), s_pe = wave_sum((l >= 32 && l < 48) ? sc : 0.f);
        const float rq = rsqrtf(s_q * (1.f / 256.f) + EPS), rkv = rsqrtf(s_kv * (1.f / 128.f) + EPS), rpe = rsqrtf(s_pe * (1.f / 64.f) + EPS);
        { const f32x4 o = a * rq * gq; v2u w; w.x = pk2(o.x, o.y); w.y = pk2(o.z, o.w); *(v2u*)(CQN + (size_t)row * 256 + 4 * l) = w; }
        if (l < 32) { const f32x4 o = c * rkv * g2; v2u w; w.x = pk2(o.x, o.y); w.y = pk2(o.z, o.w); *(v2u*)(CKVN + (size_t)row * 256 + 4 * l) = w; }
        else { v2u w; w.x = 0u; w.y = 0u; *(v2u*)(CKVN + (size_t)row * 256 + 128 + 4 * (l - 32)) = w; }
        const f32x4 n = c * rpe * g2;
        f32x4 other; other.x = __shfl_xor(n.x, 8); other.y = __shfl_xor(n.y, 8); other.z = __shfl_xor(n.z, 8); other.w = __shfl_xor(n.w, 8);
        if (l >= 32 && l < 48) { const bool first = l < 40; const int e0 = 4 * ((l - 32) & 7);
            float o[4];
#pragma unroll
            for (int i = 0; i < 4; ++i) { const int e = e0 + i; const float cs = rope[(size_t)row * 64 + e * 2], sn = rope[(size_t)row * 64 + e * 2 + 1];
                const float mine = n[i], oth = other[i]; o[i] = first ? (mine * cs - oth * sn) : (oth * sn + mine * cs); }
            v2u w; w.x = pk2(o[0], o[1]); w.y = pk2(o[2], o[3]); *(v2u*)(KPE + (size_t)row * 64 + 4 * (l - 32)) = w; }
    }
}

__device__ __forceinline__ void knorm_phase(const Ctx& F, bf16* KV, const float* kng) {
    const int l = F.lane, h = l >> 3, e0 = (l & 7) * 16;
    float g[16];
#pragma unroll
    for (int i = 0; i < 16; ++i) g[i] = kng[e0 + i];
    for (int row = F.gw; row < T; row += F.NGW) {
        bf16* p = KV + (size_t)row * 2048 + h * 256 + e0;
        const v4u r0 = *(const v4u*)p, r1 = *(const v4u*)(p + 8);
        float f[16]; const unsigned w[8] = {r0.x, r0.y, r0.z, r0.w, r1.x, r1.y, r1.z, r1.w};
        float ss = 0.f;
#pragma unroll
        for (int i = 0; i < 8; ++i) { f[2 * i] = __uint_as_float(w[i] << 16); f[2 * i + 1] = __uint_as_float(w[i] & 0xffff0000u); ss += f[2 * i] * f[2 * i] + f[2 * i + 1] * f[2 * i + 1]; }
        ss += __shfl_xor(ss, 1); ss += __shfl_xor(ss, 2); ss += __shfl_xor(ss, 4);
        const float r = rsqrtf(ss * (1.f / 128.f) + EPS);
        v4u o0, o1;
        o0.x = pk2(f[0] * r * g[0], f[1] * r * g[1]); o0.y = pk2(f[2] * r * g[2], f[3] * r * g[3]); o0.z = pk2(f[4] * r * g[4], f[5] * r * g[5]); o0.w = pk2(f[6] * r * g[6], f[7] * r * g[7]);
        o1.x = pk2(f[8] * r * g[8], f[9] * r * g[9]); o1.y = pk2(f[10] * r * g[10], f[11] * r * g[11]); o1.z = pk2(f[12] * r * g[12], f[13] * r * g[13]); o1.w = pk2(f[14] * r * g[14], f[15] * r * g[15]);
        *(v4u*)p = o0; *(v4u*)(p + 8) = o1;
    }
}

__device__ __forceinline__ void route_phase(const Ctx& F, const bf16* X, const float* g, const float* sc, const float* sh, const float* wg, const float* bg, const float* we, const float* be,
                                            bf16* XN2, int* LIST, float* WL, gu32* cnt) {
    float* W20 = (float*)(F.lds + RING_OFF); constexpr int W20P = 1028;
    unsigned* lcnt = (unsigned*)(F.lds + RED_OFF); unsigned* gbase = lcnt + 32;
    if (F.tid < 24) lcnt[F.tid] = 0u;
    for (int i = F.tid; i < 4 * 1024; i += NTHR) W20[(i & 3) * W20P + (i >> 2)] = wg[i];
    for (int i = F.tid; i < 16 * 1024; i += NTHR) W20[(4 + (i & 15)) * W20P + (i >> 4)] = we[i];
    __syncthreads();
    float bgv[4];
#pragma unroll
    for (int i = 0; i < 4; ++i) bgv[i] = bg[i];
    for (int ch0 = 0; ch0 < T / 16; ch0 += F.NGW) {
        const int ch = ch0 + F.gw; const bool act = ch < T / 16; const int r0 = (act ? ch : 0) * 16, b = r0 >> 12;
        f32x4 A[4], S[4];
#pragma unroll
        for (int j = 0; j < 4; ++j) { const int col = 4 * F.lane + 256 * j; const f32x4 gv = *(const f32x4*)(g + col), sv = *(const f32x4*)(sc + (size_t)b * 6144 + col); A[j] = gv * (1.f + sv); S[j] = *(const f32x4*)(sh + (size_t)b * 6144 + col); }
        const bf16* xr = X + (size_t)r0 * DM + 4 * F.lane;
        f32x4 nx[2][4];
#pragma unroll
        for (int u = 0; u < 2; ++u)
#pragma unroll
            for (int j = 0; j < 4; ++j) nx[u][j] = ldrow4<bf16>(xr + (size_t)u * DM + 256 * j);
        int my_bk = 0; float my_wlo = 0.f, my_whi = 0.f;
        for (int rr = 0; rr < 16; rr += 2) {
            f32x4 v[2][4]; float ss[2];
#pragma unroll
            for (int u = 0; u < 2; ++u) { ss[u] = 0.f;
#pragma unroll
                for (int j = 0; j < 4; ++j) { v[u][j] = nx[u][j]; ss[u] += (v[u][j].x * v[u][j].x + v[u][j].y * v[u][j].y) + (v[u][j].z * v[u][j].z + v[u][j].w * v[u][j].w); } }
            if (rr < 14) {
#pragma unroll
                for (int u = 0; u < 2; ++u)
#pragma unroll
                    for (int j = 0; j < 4; ++j) nx[u][j] = ldrow4<bf16>(xr + (size_t)(rr + 2 + u) * DM + 256 * j); }
            float gl[2][4]; int gi[2]; float gm[2];
#pragma unroll
            for (int u = 0; u < 2; ++u) { const int row = r0 + rr + u;
                const float rstd = rsqrtf(wave_sum(ss[u]) * (1.f / DM) + EPS);
                unsigned char* orow = (unsigned char*)XN2 + (size_t)row * DM + 4 * F.lane;
#pragma unroll
                for (int j = 0; j < 4; ++j) { v[u][j] = v[u][j] * rstd * A[j] + S[j]; int p = 0; p = __builtin_amdgcn_cvt_pk_fp8_f32(v[u][j].x, v[u][j].y, p, false); p = __builtin_amdgcn_cvt_pk_fp8_f32(v[u][j].z, v[u][j].w, p, true); *(int*)(orow + 256 * j) = p; }
#pragma unroll
                for (int o = 0; o < 4; ++o) { float a = 0.f;
#pragma unroll
                    for (int j = 0; j < 4; ++j) { const f32x4 w = *(const f32x4*)(W20 + o * W20P + 4 * F.lane + 256 * j); a += (v[u][j].x * w.x + v[u][j].y * w.y) + (v[u][j].z * w.z + v[u][j].w * w.w); }
                    gl[u][o] = wave_sum(a) + bgv[o]; }
                int g_ = 0; float m_ = gl[u][0]; if (gl[u][1] > m_) { m_ = gl[u][1]; g_ = 1; } if (gl[u][2] > m_) { m_ = gl[u][2]; g_ = 2; } if (gl[u][3] > m_) { m_ = gl[u][3]; g_ = 3; }
                gi[u] = __builtin_amdgcn_readfirstlane(g_); gm[u] = m_; }
#pragma unroll
            for (int u = 0; u < 2; ++u) {
                const float gw_ = __builtin_amdgcn_rcpf(__expf(gl[u][0] - gm[u]) + __expf(gl[u][1] - gm[u]) + __expf(gl[u][2] - gm[u]) + __expf(gl[u][3] - gm[u]));
                const float* We = W20 + (4 + 4 * gi[u]) * W20P + 4 * F.lane;
                float e[4];
#pragma unroll
                for (int k = 0; k < 4; ++k) { float a = 0.f;
#pragma unroll
                    for (int j = 0; j < 4; ++j) { const f32x4 w = *(const f32x4*)(We + k * W20P + 256 * j); a += (v[u][j].x * w.x + v[u][j].y * w.y) + (v[u][j].z * w.z + v[u][j].w * w.w); }
                    e[k] = wave_sum(a) + be[4 * gi[u] + k]; }
                int i1 = 0; float m1 = e[0];
#pragma unroll
                for (int k = 1; k < 4; ++k) if (e[k] > m1) { m1 = e[k]; i1 = k; }
                int i2 = -1; float m2 = -3.0e38f;
#pragma unroll
                for (int k = 0; k < 4; ++k) if (k != i1 && e[k] > m2) { m2 = e[k]; i2 = k; }
                const float t2 = __expf(m2 - m1), w1 = gw_ * __builtin_amdgcn_rcpf(1.f + t2), w2 = w1 * t2;
                const int ilo = i1 < i2 ? i1 : i2, ihi = i1 < i2 ? i2 : i1; const float wlo = i1 < i2 ? w1 : w2, whi = i1 < i2 ? w2 : w1;
                const int pi = ilo == 0 ? ihi - 1 : (ilo == 1 ? ihi + 1 : 5), bk = gi[u] * 6 + pi;
                if (F.lane == rr + u) { my_bk = bk; my_wlo = wlo; my_whi = whi; }
            }
        }
        unsigned rank = 0u; if (F.lane < 16 && act) rank = __hip_atomic_fetch_add(lcnt + my_bk, 1u, __ATOMIC_RELAXED, __HIP_MEMORY_SCOPE_WORKGROUP);
        __syncthreads();
        if (F.tid < 24) { const unsigned n = lcnt[F.tid]; gbase[F.tid] = n ? __hip_atomic_fetch_add(cnt + F.tid * 64, n, RLX_AGENT) : 0u; }
        __syncthreads();
        if (F.lane < 16 && act) { const unsigned pos = gbase[my_bk] + rank;
            LIST[my_bk * 32768 + pos] = r0 + F.lane; float2 ww; ww.x = my_wlo; ww.y = my_whi; *(float2*)(WL + ((size_t)my_bk * 32768 + pos) * 2) = ww; }
        __syncthreads();
        if (F.tid < 24) lcnt[F.tid] = 0u;
        __syncthreads();
    }
}
__device__ __forceinline__ void moe_table(const Ctx& F, const gu32* cnt) {
    int* tinfo = (int*)(F.lds + TINFO_OFF);
    __syncthreads();
    if (F.tid == 0) { int nt = 0;
        for (int b = 0; b < 24; ++b) { const int c = (int)__hip_atomic_load(cnt + b * 64, RLX_AGENT); const int tiles = (c + 255) >> 8;
            tinfo[256 + b] = nt * 256; tinfo[288 + b] = c; for (int i = 0; i < tiles; ++i) tinfo[1 + nt + i] = b; nt += tiles; }
        tinfo[0] = nt; }
    __syncthreads();
}
__device__ __forceinline__ void permute_phase(const Ctx& F, const bf16* XN2, const int* ROUTE, bf16* XN2S, int* TOKW) {
    const int* tinfo = (const int*)(F.lds + TINFO_OFF);
    for (int ch = F.gw; ch < T / 4; ch += F.NGW) {
        v4i r[4]; v4u a[4], bq[4];
#pragma unroll
        for (int i = 0; i < 4; ++i) { const int row = ch * 4 + i; r[i] = *(const v4i*)(ROUTE + (size_t)row * 4);
            a[i] = *(const v4u*)(XN2 + (size_t)row * DM + 8 * F.lane); bq[i] = *(const v4u*)(XN2 + (size_t)row * DM + 512 + 8 * F.lane); }
#pragma unroll
        for (int i = 0; i < 4; ++i) { const int row = ch * 4 + i, srow = tinfo[256 + r[i].x] + r[i].y;
            *(v4u*)(XN2S + (size_t)srow * DM + 8 * F.lane) = a[i]; *(v4u*)(XN2S + (size_t)srow * DM + 512 + 8 * F.lane) = bq[i];
            if (F.lane == 0) { v4i w; w.x = row; w.y = r[i].z; w.z = r[i].w; w.w = 0; *(v4i*)(TOKW + (size_t)srow * 4) = w; } }
    }
}

constexpr float W32C[16] = {1.f, 0.98078528040323043f, 0.92387953251128674f, 0.83146961230254524f, 0.70710678118654752f, 0.55557023301960218f, 0.38268343236508977f, 0.19509032201612825f,
                            0.f, -0.19509032201612825f, -0.38268343236508977f, -0.55557023301960218f, -0.70710678118654752f, -0.83146961230254524f, -0.92387953251128674f, -0.98078528040323043f};
constexpr float W32S[16] = {0.f, 0.19509032201612825f, 0.38268343236508977f, 0.55557023301960218f, 0.70710678118654752f, 0.83146961230254524f, 0.92387953251128674f, 0.98078528040323043f,
                            1.f, 0.98078528040323043f, 0.92387953251128674f, 0.83146961230254524f, 0.70710678118654752f, 0.55557023301960218f, 0.38268343236508977f, 0.19509032201612825f};
struct FftTw { const c32* T1; c32 tob; const c32* T2; };
template <int A> __device__ __forceinline__ c32 mul_to(c32 x, c32 tob) { const c32 y = cmul(x, tob); return cmk(y.x * W32C[A] + y.y * W32S[A], y.y * W32C[A] - y.x * W32S[A]); }
template <int A> __device__ __forceinline__ c32 mul_toc(c32 x, c32 tob) { const c32 y = cmulc(x, tob); return cmk(y.x * W32C[A] - y.y * W32S[A], y.y * W32C[A] + y.x * W32S[A]); }
#define TO_ALL(OP) OP(0) OP(1) OP(2) OP(3) OP(4) OP(5) OP(6) OP(7) OP(8) OP(9) OP(10) OP(11) OP(12) OP(13) OP(14) OP(15)
__device__ __forceinline__ void fft_twiddles(FftTw& W, int gt, c32* t1tab, c32* t2tab, int tid) {
    if (tid < 256) { float s, c; sincosf(-6.283185307179586f * (float)(((tid >> 4) * (tid & 15)) & 255) * (1.f / 256.f), &s, &c); t2tab[(tid >> 4) * 17 + (tid & 15)] = cmk(c, s); }
    for (int i = tid; i < 4096; i += NTHR) { const int p = i >> 8, t = i & 255; float s, c; sincosf(-6.283185307179586f * (float)((t * p) & 4095) * (1.f / 4096.f), &s, &c); t1tab[i] = cmk(c, s); }
    { float s, c; sincosf(-6.283185307179586f * (float)gt * (1.f / 8192.f), &s, &c); W.tob = cmk(c, s); }
    W.T1 = t1tab + gt; W.T2 = t2tab + (gt & 15) * 17;
    __syncthreads();
}
__device__ __forceinline__ void fft_forward_a(c32 (&v)[16], const FftTw& W, c32* ex, int gt) {
    __syncthreads();
    fft_fwd_a(v, W.T1, ex, gt);
    __syncthreads();
}
__device__ __forceinline__ void fft_forward_bc(c32 (&v)[16], const FftTw& W, c32* ex, int gt) {
    fft_fwd_b(v, W.T2, ex, ex, gt);
    __builtin_amdgcn_wave_barrier(); asm volatile("" ::: "memory");
    fft_fwd_c(v, ex, gt);
}
__device__ __forceinline__ void fft_forward(c32 (&v)[16], const FftTw& W, c32* ex, int gt) { fft_forward_a(v, W, ex, gt); fft_forward_bc(v, W, ex, gt); }
__device__ __forceinline__ void fft_inverse(c32 (&v)[16], const FftTw& W, c32* ex, int gt) {
    __builtin_amdgcn_wave_barrier(); asm volatile("" ::: "memory");
    fft_inv_a(v, ex, gt);
    __builtin_amdgcn_wave_barrier(); asm volatile("" ::: "memory");
    fft_inv_b(v, W.T2, ex, ex, gt);
    __syncthreads();
    fft_inv_c(v, W.T1, ex, gt);
}
__device__ __forceinline__ void filter_phase(const Ctx& F, const float* HT, const float* fbias, c32* KF, gu32* claim, int max_items) {
    const int g = __builtin_amdgcn_readfirstlane(F.tid >> 8), gt = F.tid & 255;
    c32* ex = (c32*)(F.lds + RING_OFF + g * 36864);
    float* rev = (float*)ex;
    float* red = (float*)(F.lds + RED_OFF);
    FftTw W; fft_twiddles(W, gt, (c32*)(F.lds + RING_OFF + 73728), (c32*)(F.lds + RING_OFF + 110592), F.tid);
    int* dsl = (int*)(F.lds + RED_OFF) + 60;
    for (int n = 0; n < max_items; ++n) {
        __syncthreads();
        if (F.tid == 0) *dsl = (int)__hip_atomic_fetch_add(claim, 1u, RLX_AGENT);
        __syncthreads();
        const int d = *dsl; if (d >= DM) break;
        int gtv = gt; asm volatile("" : "+v"(gtv));
        const float delta = fabsf(-120.39728043259361f + (float)d * ((40.546510810816436f + 120.39728043259361f) / 1023.f));
        const float* hfp = HT + (size_t)(g * 2048 + d) * 4096; const float* hbp = HT + (size_t)(g * 2048 + 1024 + d) * 4096;
        float hf[16], hb[16]; float sf = 0.f, sb = 0.f;
#pragma unroll
        for (int a = 0; a < 16; ++a) { const int t = 256 * a + gtv; const float dec = __expf(-((float)t * (1.f / 4095.f)) * delta); hf[a] = hfp[t] * dec; hb[a] = hbp[t] * dec; sf += fabsf(hf[a]); sb += fabsf(hb[a]); }
        sf = wave_sum(sf); sb = wave_sum(sb);
        __syncthreads();
        if (F.lane == 0) { red[F.wave * 2] = sf; red[F.wave * 2 + 1] = sb; }
        __syncthreads();
        sf = red[g * 8] + red[g * 8 + 2] + red[g * 8 + 4] + red[g * 8 + 6]; sb = red[g * 8 + 1] + red[g * 8 + 3] + red[g * 8 + 5] + red[g * 8 + 7];
        const float nf = 1.f / (sf + EPS) * (1.f / 8192.f), nb = 1.f / (sb + EPS) * (1.f / 8192.f);
#pragma unroll
        for (int a = 0; a < 16; ++a) rev[256 * a + gt] = hb[a] * nb;
        __syncthreads();
        c32 v[16];
#pragma unroll
        for (int a = 0; a < 16; ++a) { const int n = 256 * a + gt; hb[a] = n == 0 ? 0.f : rev[4096 - n]; hf[a] *= nf; v[a] = cmk(hf[a] + hb[a], 0.f); }
        fft_forward(v, W, ex, gt);
        c32* kf = KF + ((size_t)(d * 2 + g) * 2) * 4096; const float fb = fbias[g * 1024 + d] * (1.f / 4096.f);
#pragma unroll
        for (int i = 0; i < 16; ++i) kf[i * 256 + gtv] = cmk(v[i].x + fb, v[i].y);
#define OPX(A) v[A] = mul_to<A>(cmk(hf[A] - hb[A], 0.f), W.tob);
        TO_ALL(OPX)
#undef OPX
        fft_forward(v, W, ex, gt);
#pragma unroll
        for (int i = 0; i < 16; ++i) kf[4096 + i * 256 + gtv] = v[i];
    }
}
__device__ __forceinline__ void long_conv(c32 (&z)[16], const c32* kf, const FftTw& W, c32* ex, int gt) {
    typedef float f32x2v __attribute__((ext_vector_type(2))); typedef __attribute__((address_space(1))) const f32x2v gc32;
    c32 v[16], k[16]; int gk = gt; asm volatile("" : "+v"(gk));
#define OPX(A) v[A] = mul_to<A>(z[A], W.tob);
    TO_ALL(OPX)
#undef OPX
    fft_forward_a(v, W, ex, gt);
    asm volatile("" ::: "memory");
#pragma unroll
    for (int i = 0; i < 16; ++i) { const f32x2v t_ = ((gc32*)kf)[4096 + i * 256 + gk]; k[i] = cmk(t_.x, t_.y); }
    fft_forward_bc(v, W, ex, gt);
#pragma unroll
    for (int i = 0; i < 16; ++i) v[i] = cmul(v[i], k[i]);
    fft_inverse(v, W, ex, gt);
#define OPX(A) v[A] = mul_toc<A>(v[A], W.tob);
    TO_ALL(OPX)
#undef OPX
    fft_forward_a(z, W, ex, gt);
    asm volatile("" ::: "memory");
#pragma unroll
    for (int i = 0; i < 16; ++i) { const f32x2v t_ = ((gc32*)kf)[i * 256 + gk]; k[i] = cmk(t_.x, t_.y); }
    fft_forward_bc(z, W, ex, gt);
#pragma unroll
    for (int i = 0; i < 16; ++i) z[i] = cmul(z[i], k[i]);
    fft_inverse(z, W, ex, gt);
#pragma unroll
    for (int a = 0; a < 16; ++a) z[a] = cadd(z[a], v[a]);
}
struct RawSeq { v4u r[2][2]; };
__device__ __forceinline__ void raw_issue(RawSeq& q, const bf16* urow, int b0, int gt) {
    typedef __attribute__((address_space(1))) const v4u gv4u;
    asm volatile("" : "+v"(gt));
#pragma unroll
    for (int s_ = 0; s_ < 2; ++s_)
#pragma unroll
        for (int i = 0; i < 2; ++i) q.r[s_][i] = *(gv4u*)(urow + (size_t)(b0 + s_) * SEQ + (gt + 256 * i) * 8);
}
__device__ __forceinline__ void stage_conv3(c32 (&o)[16], const RawSeq& q, float w0, float w1, float w2, float cb, bf16* stg, int gt) {
    constexpr int SS = 4112;
    __syncthreads();
#pragma unroll
    for (int s_ = 0; s_ < 2; ++s_) {
#pragma unroll
        for (int i = 0; i < 2; ++i) *(v4u*)(stg + s_ * SS + 8 + (gt + 256 * i) * 8) = q.r[s_][i];
        if (gt == 0) { stg[s_ * SS + 7] = 0; stg[s_ * SS + 4104] = 0; } }
    __syncthreads();
#pragma unroll
    for (int a = 0; a < 16; ++a) { const int t = 256 * a + gt; float r[2];
#pragma unroll
        for (int s_ = 0; s_ < 2; ++s_) { const bf16* sp = stg + s_ * SS + 7 + t; r[s_] = w0 * bf2f(sp[0]) + w1 * bf2f(sp[1]) + w2 * bf2f(sp[2]) + cb; }
        o[a] = cmk(r[0], r[1]); if ((a & 3) == 3) __builtin_amdgcn_sched_barrier(0); }
}
__device__ __forceinline__ void conv_phase(const Ctx& F, const bf16* UT, const c32* KF, const float* convw, const float* convb, bf16* ZT) {
    const int g = __builtin_amdgcn_readfirstlane(F.tid >> 8), gt = F.tid & 255;
    c32* ex = (c32*)(F.lds + RING_OFF + g * 36864);
    bf16* stg = (bf16*)ex;
    FftTw W; fft_twiddles(W, gt, (c32*)(F.lds + RING_OFF + 73728), (c32*)(F.lds + RING_OFF + 110592), F.tid);
    RawSeq raw;
    if (F.vcu < DM) raw_issue(raw, UT + (size_t)(2048 + F.vcu) * T, (2 * g) * 2, gt);
    for (int d = F.vcu; d < DM; d += F.G) {
        const c32* kf0 = KF + ((size_t)(d * 2 + 0) * 2) * 4096; const c32* kf1 = KF + ((size_t)(d * 2 + 1) * 2) * 4096;
        for (int pp = 0; pp < 2; ++pp) { const int b0 = (2 * g + pp) * 2;
            int gtv = gt; asm volatile("" : "+v"(gtv));
            c32 z[16], gate[16];
            { const int c = 2048 + d; stage_conv3(z, raw, convw[c], convw[3072 + c], convw[6144 + c], convb[c], stg, gtv); }
            raw_issue(raw, UT + (size_t)d * T, b0, gtv);
            long_conv(z, kf0, W, ex, gtv);
            { const int c = d; stage_conv3(gate, raw, convw[c], convw[3072 + c], convw[6144 + c], convb[c], stg, gtv); }
            raw_issue(raw, UT + (size_t)(1024 + d) * T, b0, gtv);
#pragma unroll
            for (int a = 0; a < 16; ++a) z[a] = cmk(z[a].x * gate[a].x, z[a].y * gate[a].y);
            long_conv(z, kf1, W, ex, gtv);
            { const int c = 1024 + d; stage_conv3(gate, raw, convw[c], convw[3072 + c], convw[6144 + c], convb[c], stg, gtv); }
            { const int dn = pp == 0 ? d : d + F.G; if (dn < DM) raw_issue(raw, UT + (size_t)(2048 + dn) * T, pp == 0 ? b0 + 2 : (2 * g) * 2, gtv); }
            bf16* zr = ZT + (size_t)d * T + (size_t)b0 * SEQ;
#pragma unroll
            for (int a = 0; a < 16; ++a) { const int t = 256 * a + gtv; const unsigned pk = pk2(z[a].x * gate[a].x, z[a].y * gate[a].y); zr[t] = (bf16)(pk & 0xffffu); zr[SEQ + t] = (bf16)(pk >> 16); }
        }
    }
}
__device__ __forceinline__ void transpose_phase(const Ctx& F, const bf16* ZT, bf16* Z) {
    bf16* tile = (bf16*)(F.lds + RING_OFF + F.wave * 8704);
    const int l = F.lane;
    v4u x[8];
    if (F.gw < 16 * 512) { const int d0 = (F.gw & 15) * 64, t0 = (F.gw >> 4) * 64;
#pragma unroll
        for (int i = 0; i < 8; ++i) x[i] = *(const v4u*)(ZT + (size_t)(d0 + i * 8 + (l >> 3)) * T + t0 + (l & 7) * 8); }
    for (int it = F.gw; it < 16 * 512; it += F.NGW) { const int d0 = (it & 15) * 64, t0 = (it >> 4) * 64;
#pragma unroll
        for (int i = 0; i < 8; ++i) { const int dr = i * 8 + (l >> 3), c = l & 7;
            v2u* p = (v2u*)(tile + dr * 68 + c * 8); v2u a; a.x = x[i].x; a.y = x[i].y; p[0] = a; a.x = x[i].z; a.y = x[i].w; p[1] = a; }
        const int itn = it + F.NGW;
        if (itn < 16 * 512) { const int dn = (itn & 15) * 64, tn = (itn >> 4) * 64;
#pragma unroll
            for (int i = 0; i < 8; ++i) x[i] = *(const v4u*)(ZT + (size_t)(dn + i * 8 + (l >> 3)) * T + tn + (l & 7) * 8); }
        LDS_WAIT();
#pragma unroll
        for (int i = 0; i < 8; ++i) { const int tr = i * 8 + (l >> 3), c = l & 7; unsigned short e[8];
#pragma unroll
            for (int k = 0; k < 8; ++k) e[k] = tile[(c * 8 + k) * 68 + tr];
            v4u o; o.x = e[0] | ((unsigned)e[1] << 16); o.y = e[2] | ((unsigned)e[3] << 16); o.z = e[4] | ((unsigned)e[5] << 16); o.w = e[6] | ((unsigned)e[7] << 16);
            *(v4u*)(Z + (size_t)(t0 + tr) * DM + d0 + c * 8) = o; }
        LDS_WAIT();
    }
}

constexpr int NPH = 22;
constexpr int seam_id(int k) { return k == 0 ? 0 : k == 1 ? 1 : k == 2 ? 2 : k == 4 ? 3 : k == 6 ? 4 : k == 7 ? 5 : k == 8 ? 6 : k == 10 ? 7 : k == 11 ? 8 : k == 12 ? 9 : k == 14 ? 10 : k == 15 ? 11 : k == 16 ? 12 : k == 17 ? 13 : k == 18 ? 14 : k == 20 ? 15 : -100; }
#ifdef PROBE_SEAM
__device__ __forceinline__ unsigned long long probe_now() { unsigned long long t; asm volatile("s_memrealtime %0\n\ts_waitcnt lgkmcnt(0)" : "=s"(t) :: "memory"); return t; }
#define SEAMHOOK(id) do { if ((id) == PROBE_SEAM) { const unsigned long long t1_ = probe_now(); while (probe_now() < t1_ + (t1_ - tlast_)) __builtin_amdgcn_s_sleep(4); } \
                          if ((id) + 1 == PROBE_SEAM) tlast_ = probe_now(); } while (0)
#define SEAMBAR(k) do { xcd_barrier(bar); SEAMHOOK(seam_id(k)); } while (0)
#else
#define SEAMHOOK(id) do { } while (0)
#define SEAMBAR(k) xcd_barrier(bar)
#endif
#define XN2P(L) ((L) == 0 ? (bf16*)out : WSP(bf16, WS_XN2))
#define MOE_PHASES(L) do { \
        const int mb = 8 + 10 * L; \
        if (IN(mb)) { PH_ARGS; const float* mod = WSP(float, WS_MOD) + (size_t)L * 8 * 6144; gu32* cnt = (gu32*)(ws + WS_CTL) + CW_CNT + L * 24 * 64; \
            route_phase(F, WSP(bf16, WS_XR), in[6] + L * 1024, mod + 4 * 1024, mod + 3 * 1024, in[31] + L * 4096, in[32] + L * 4, in[33] + L * 16384, in[34] + L * 16, XN2P(L), WSP(int, WS_LIST), WSP(float, WS_WL), cnt); \
            if (L == 0) { __syncthreads();        \
                pg8::Gemm gmh{WSP(bf16, WS_W4S), WSP(bf16, WS_HDNS), 4096, 4096, 256}; pg8::StaticOrder Sh; Sh.init(4096, 4096, F.G, (int)blockIdx.x); pg8::EpiF32 Eh{WSP(float, WS_HT), 4096}; \
                REP(11) pg8::gemm_phase<pg8::EpiF32, pg8::StaticOrder, true, true>(ring, gmh, Sh, Eh, F.tid); } } \
        if (IN(mb) && IN(mb + 2)) SEAMBAR(mb); \
        if (IN(mb + 2)) { PH_ARGS; gu32* cnt = (gu32*)(ws + WS_CTL) + CW_CNT + L * 24 * 64; moe_table(F, cnt); \
              \
            pg8::Gemm gm{XN2P(L), (const bf16*)(ws + WS_WGU + (size_t)L * 16 * 512 * 1024), MS_ROWS, 8192, 512}; pg8::MoeOrder S{tinfo, F.G, F.vcu, 0, WSP(int, WS_LIST)}; pg8::EpiSwiGLU E{WSP(unsigned char, WS_HACT), WSP(float, WS_WL), tinfo}; \
            REP(10) pg8::gemm_phase_gather<pg8::EpiSwiGLU, pg8::MoeOrder, true, true, 5>(ring, gm, S, E, F.tid); \
            if (L == 0) { const int nu = 4 * tinfo[0], mine = (nu - F.vcu + F.G - 1) / F.G, most = (nu + F.G - 1) / F.G;        \
                if (mine < most) { __syncthreads(); filter_phase(F, WSP(float, WS_HT), in[29], WSP(c32, WS_KF), (gu32*)(ws + WS_CTL) + CW_FILT, most - mine); } } } SEAM(mb + 2); \
        if (IN(mb + 3)) { PH_ARGS; gu32* cnt = (gu32*)(ws + WS_CTL) + CW_CNT + L * 24 * 64; moe_table(F, cnt); const float* mod = WSP(float, WS_MOD) + (size_t)L * 8 * 6144; \
            pg8::Gemm gm{WSP(bf16, WS_HACT), (const bf16*)(ws + WS_WDN + (size_t)L * 24 * 1024 * 512), MS_ROWS, 24 * 1024, 256};   pg8::MoeOrder S{tinfo, F.G, F.vcu, 1, WSP(int, WS_LIST)}; if (L == 0) { pg8::EpiMoeOut<bf16> E{WSP(bf16, WS_XR), WSP(bf16, WS_XR), mod + 5 * 1024, WSP(int, WS_LIST), tinfo, (PG8_LAS float*)((PG8_LAS unsigned char*)lds + EPIX_OFF)}; pg8::gemm_phase<pg8::EpiMoeOut<bf16>, pg8::MoeOrder, true, true, 8>(ring, gm, S, E, F.tid); } \
            else { pg8::EpiMoeOut<float> E{WSP(bf16, WS_XR), out, mod + 5 * 1024, WSP(int, WS_LIST), tinfo, (PG8_LAS float*)((PG8_LAS unsigned char*)lds + EPIX_OFF)}; pg8::gemm_phase<pg8::EpiMoeOut<float>, pg8::MoeOrder, true, true, 8>(ring, gm, S, E, F.tid); } \
            if (L == 0) { __syncthreads(); filter_phase(F, WSP(float, WS_HT), in[29], WSP(c32, WS_KF), (gu32*)(ws + WS_CTL) + CW_FILT, DM); }       \
            } \
    } while (0)
struct Args { const float* in[38]; float* out; unsigned char* ws; int ph_lo, ph_hi; };
static_assert(sizeof(Args) == 38 * 8 + 8 + 8 + 8, "Args layout (read back through the kernarg segment pointer)");
__global__ void __launch_bounds__(NTHR, 2) fwd_kernel(Args args) {
    extern __shared__ __attribute__((aligned(16))) unsigned char lds[];
#define MK_CTX(F, tx) Ctx F; F.lds = lds; F.tid = (tx); F.lane = F.tid & 63; F.wave = __builtin_amdgcn_readfirstlane(F.tid >> 6); \
    F.G = gridDim.x; { const int bx = blockIdx.x; F.vcu = (F.G % 8 == 0) ? (bx % 8) * (F.G / 8) + bx / 8 : bx; } F.gw = F.vcu * NWAVES + F.wave; F.NGW = F.G * NWAVES
    for (int u = threadIdx.x; u < (LDS_BYTES - LDSCTL_OFF) / 4; u += NTHR) ((LAS unsigned*)((LAS unsigned char*)lds + LDSCTL_OFF))[u] = 0u;
    __syncthreads();
    const int wave_s_ = __builtin_amdgcn_readfirstlane(threadIdx.x >> 6);
    const int lo = args.ph_lo, hi = args.ph_hi;
    const bool use_bar = (hi - lo) > 1;
    XcdBarrier bar; bar.bar = (unsigned*)(args.ws + WS_CTL) + CW_BAR; bar.x = 0; bar.st = nullptr; bar.w0 = 0;
    if (use_bar) bar = xcd_barrier_post((unsigned*)(args.ws + WS_CTL) + CW_BAR, (volatile LAS unsigned*)((LAS unsigned char*)lds + MISC_OFF) + 8);
    bar.w0 = (wave_s_ == 0) ? 1 : 0;
#ifndef PHMASK
#define PHMASK 0xFFFFFFFFu
#endif
#define IN(k) (((PHMASK >> ((k) >= 18 ? (k) - 10 : (k))) & 1u) && lo <= (k) && (k) < hi)
#ifndef REPMASK
#define REPMASK 0u
#endif
#define NREP(k) (((REPMASK >> (k)) & 1u) ? 2 : 1)
#define REP(k) for (int rep_ = 0; rep_ < NREP(k); ++rep_)
#define SEAM(k) do { if (IN(k) && IN((k) + 1)) SEAMBAR(k); } while (0)
#define PH_STR2(x) #x
#define PH_STR(x) PH_STR2(x)
#define PH_ARGS int opq_ = 0; asm volatile("; PHMARK line " PH_STR(__LINE__) : "+s"(opq_)); const In in{opq_}; unsigned char* const ws = karg_ws(opq_); float* const out = karg_out(opq_); (void)in; (void)ws; (void)out; int tx_; asm volatile("v_mbcnt_lo_u32_b32 %0, -1, 0\n\tv_mbcnt_hi_u32_b32 %0, -1, %0" : "=v"(tx_)); tx_ += wave_s_ * 64; MK_CTX(F, tx_)
#define WSP(type, off) ((type*)(ws + (off)))
    PG8_LAS unsigned char* ring = (PG8_LAS unsigned char*)lds + RING_OFF;
    const PG8_LAS int* tinfo = (const PG8_LAS int*)((PG8_LAS unsigned char*)lds + TINFO_OFF);

#ifdef PROBE_SEAM
    unsigned long long tlast_ = probe_now();
#endif
    if (IN(0)) { PH_ARGS; REP(0) p0_prologue(F, in, ws); } SEAM(0);

            if (IN(1)) { PH_ARGS; const float* mod = WSP(float, WS_MOD); REP(1) norm_mod_phase<float, true>(F, in[0], in[5], mod + 1024, mod, WSP(bf16, WS_XN)); } SEAM(1);
            if (IN(2)) { PH_ARGS; pg8::Gemm gm{WSP(bf16, WS_XN), WSP(bf16, WS_WD), T, 512, 512};   pg8::StaticOrder S; S.init(T, 512, F.G, (int)blockIdx.x);
                pg8::EpiLat E{WSP(unsigned char, WS_CQN), WSP(bf16, WS_CKVN), WSP(unsigned char, WS_KPE), in[8], in[9], in[13], WSP(float, WS_ROPE), (PG8_LAS float*)((PG8_LAS unsigned char*)lds + EPIX_OFF)};
                REP(2) pg8::gemm_phase<pg8::EpiLat, pg8::StaticOrder, true, true, 5>(ring, gm, S, E, F.tid); }
            if (IN(2) && IN(4)) SEAMBAR(2);
            if (IN(4)) { REP(4) {
                { PH_ARGS; pg8::Gemm gm{WSP(bf16, WS_CQN), WSP(bf16, WS_WUQ), T, 1536, 128};   pg8::StaticOrder S; S.init(T, 1536, F.G, (int)blockIdx.x); pg8::EpiF8R E{WSP(unsigned char, WS_QRAW), 1536, 8.f};
                  pg8::gemm_phase<pg8::EpiF8R, pg8::StaticOrder, true, true, 4>(ring, gm, S, E, F.tid); }
                { PH_ARGS; pg8::Gemm gm{WSP(bf16, WS_CKVN), WSP(bf16, WS_WUKV), T, 1024, 128};   pg8::StaticOrder S; S.init(T, 1024, F.G, (int)blockIdx.x);
                  pg8::EpiK8 E{WSP(unsigned char, WS_K8), in[13], (PG8_LAS float*)((PG8_LAS unsigned char*)lds + EPIX_OFF)};
                  pg8::gemm_phase<pg8::EpiK8, pg8::StaticOrder, true, true>(ring, gm, S, E, F.tid); }
                { PH_ARGS; pg8::Gemm gm{WSP(bf16, WS_WUKV) + 1024 * 128, WSP(bf16, WS_CKVN), 1024, T, 128}; pg8::StaticOrder S; S.init(1024, T, F.G, (int)blockIdx.x);
                  pg8::EpiF8T E{WSP(unsigned char, WS_VT8), T};
                  pg8::gemm_phase<pg8::EpiF8T, pg8::StaticOrder, true, true>(ring, gm, S, E, F.tid); } }
            } if (IN(4) && IN(6)) SEAMBAR(4);
            if (IN(6)) { PH_ARGS;
                const float* qg = in[12]; const float* kg = in[13];
                float gqn = 0.f, gkn = 0.f, gqp = 0.f, gkp = 0.f;
                for (int i = 0; i < 128; ++i) { gqn = fmaxf(gqn, fabsf(qg[i])); gkn = fmaxf(gkn, fabsf(kg[i])); }
                for (int i = 128; i < 192; ++i) { gqp = fmaxf(gqp, fabsf(qg[i])); gkp = fmaxf(gkp, fabsf(kg[i])); }
                const float smaxC = (128.f * gqn * gkn + 64.f * gqp * gkp) * (0.072168783648703220f * 1.4426950408889634f);
                unsigned redo_mask = 0u;
                if (smaxC < 60.f) for (int rep_ = 0; rep_ < NREP(6); ++rep_) { int i = 0;
                    for (int u = F.vcu; u < 1024; u += F.G, ++i) { const int b = u >> 7, h = (u >> 4) & 7, qb = u & 15;
                        if (att::attn_unit<false>(b, h, qb * 256, WSP(bf16, WS_QRAW), WSP(unsigned char, WS_VT8), WSP(unsigned char, WS_K8), WSP(unsigned char, WS_KPE), WSP(bf16, WS_O), WSP(float, WS_ROPE), qg, smaxC, (char*)lds + RING_OFF, F.tid)) redo_mask |= 1u << (i & 31); } }
                else redo_mask = 0xffffffffu;
                redo_mask = (unsigned)__builtin_amdgcn_readfirstlane((int)redo_mask);
                if (redo_mask) { int i = 0;
                    for (int u = F.vcu; u < 1024; u += F.G, ++i) { const int b = u >> 7, h = (u >> 4) & 7, qb = u & 15;
                        if ((redo_mask >> (i & 31)) & 1u) (void)att::attn_unit<true>(b, h, qb * 256, WSP(bf16, WS_QRAW), WSP(unsigned char, WS_VT8), WSP(unsigned char, WS_K8), WSP(unsigned char, WS_KPE), WSP(bf16, WS_O), WSP(float, WS_ROPE), qg, smaxC, (char*)lds + RING_OFF, F.tid); } }
            } SEAM(6);
            if (IN(7)) { PH_ARGS; pg8::Gemm gm{WSP(bf16, WS_O), WSP(bf16, WS_WO), T, 1024, 512};   pg8::StaticOrder S; S.init(T, 1024, F.G, (int)blockIdx.x); pg8::EpiResGate<float, bf16> E{in[0], WSP(bf16, WS_XR), WSP(float, WS_MOD) + 2048, 1024};
                REP(7) pg8::gemm_phase<pg8::EpiResGate<float, bf16>, pg8::StaticOrder, true, true, 10>(ring, gm, S, E, F.tid); } SEAM(7);
    MOE_PHASES(0); SEAM(11);
            if (IN(12)) { PH_ARGS; const float* mod = WSP(float, WS_MOD) + 8 * 6144; REP(12) norm_mod_phase(F, WSP(bf16, WS_XR), in[5] + 1024, mod + 1024, mod, (bf16*)out); }
            if (IN(12) && IN(14)) SEAMBAR(12);
            if (IN(14)) { PH_ARGS; pg8::Gemm gm{WSP(bf16, WS_WIN), (const bf16*)out, 3072, T, 1024}; pg8::StaticOrder S; S.init(3072, T, F.G, (int)blockIdx.x); pg8::EpiBf16R E{WSP(bf16, WS_UT), T, in[16]};
                REP(14) pg8::gemm_phase<pg8::EpiBf16R, pg8::StaticOrder, true, true>(ring, gm, S, E, F.tid); } SEAM(14);
            if (IN(15)) { PH_ARGS; for (int rep = 0; rep < NREP(15); ++rep) conv_phase(F, WSP(bf16, WS_UT), WSP(c32, WS_KF), in[17], in[18], (bf16*)out); } SEAM(15);
            if (IN(16)) { PH_ARGS; REP(16) transpose_phase(F, (const bf16*)out, WSP(bf16, WS_Z)); } SEAM(16);
            if (IN(17)) { PH_ARGS; pg8::Gemm gm{WSP(bf16, WS_Z), WSP(bf16, WS_WOUT), T, 1024, 1024}; pg8::StaticOrder S; S.init(T, 1024, F.G, (int)blockIdx.x); pg8::EpiResGate<bf16, bf16> E{WSP(bf16, WS_XR), WSP(bf16, WS_XR), WSP(float, WS_MOD) + 8 * 6144 + 2048, 1024};
                pg8::gemm_phase<pg8::EpiResGate<bf16, bf16>, pg8::StaticOrder, true, true>(ring, gm, S, E, F.tid); } SEAM(17);
    MOE_PHASES(1);
#ifdef PROBE_SEAM
    SEAMHOOK(16);
#endif
#undef IN
#undef SEAM
}

#ifndef ONE_LAUNCH
#define ONE_LAUNCH 1
#endif
extern "C" void kernel_launch(void* const* d_in, const int* in_sizes, int n_in, void* d_out, int out_size, void* d_ws, size_t ws_size, hipStream_t stream) {
    static int grid = 0;
    if (grid == 0) {
        if (n_in != 38 || in_sizes[0] != T * DM || out_size != T * DM || ws_size < WS_END) { fprintf(stderr, "kernel_launch: shape mismatch n_in %d in0 %d out %d ws %zu\n", n_in, n_in > 0 ? in_sizes[0] : -1, out_size, ws_size); grid = -1; return; }
        int dev = 0, cus = 0, per_cu = 0;
        if (hipGetDevice(&dev) != hipSuccess || hipDeviceGetAttribute(&cus, hipDeviceAttributeMultiprocessorCount, dev) != hipSuccess) { grid = -1; return; }
        if (hipFuncSetAttribute((const void*)fwd_kernel, hipFuncAttributeMaxDynamicSharedMemorySize, LDS_BYTES) != hipSuccess) { fprintf(stderr, "kernel_launch: hipFuncSetAttribute failed\n"); grid = -1; return; }
        if (hipOccupancyMaxActiveBlocksPerMultiprocessor(&per_cu, (const void*)fwd_kernel, NTHR, LDS_BYTES) != hipSuccess || per_cu < 1) { fprintf(stderr, "kernel_launch: occupancy query says %d\n", per_cu); }
        (void)hipGetLastError();
        grid = cus;
    }
    if (grid < 0) return;
    if (hipMemsetAsync((char*)d_ws + WS_CTL, 0, CTL_ZERO_BYTES, stream) != hipSuccess) return;
    Args a{};
    for (int i = 0; i < 38; ++i) a.in[i] = (const float*)d_in[i];
    a.out = (float*)d_out; a.ws = (unsigned char*)d_ws;
#if ONE_LAUNCH
    a.ph_lo = 0; a.ph_hi = NPH;
    hipLaunchKernelGGL(fwd_kernel, dim3(grid), dim3(NTHR), LDS_BYTES, stream, a);
#else
    for (int p = 0; p < NPH; ++p) { a.ph_lo = p; a.ph_hi = p + 1; hipLaunchKernelGGL(fwd_kernel, dim3(grid), dim3(NTHR), LDS_BYTES, stream, a); }
#endif
    const hipError_t le = hipPeekAtLastError();
    if (le != hipSuccess) fprintf(stderr, "kernel_launch: launch failed: %s\n", hipGetErrorName(le));
}
```

```cpp
#include <hip/hip_runtime.h>
#include <cstdio>
#include <cstdint>
namespace pg8 {
#define PG8_LAS __attribute__((address_space(3)))
typedef unsigned short bf16_t;
typedef short bf16x8 __attribute__((ext_vector_type(8)));
typedef float f32x4 __attribute__((ext_vector_type(4)));
typedef unsigned u32x4 __attribute__((ext_vector_type(4)));
typedef int v4i_t __attribute__((ext_vector_type(4)));
typedef int v8i_t __attribute__((ext_vector_type(8)));
constexpr int BM = 256, BK = 64, HALF = 128, HTB = HALF * BK * 2  , STAGE_BYTES = 8 * HTB, NXCD = 8, WGM = 8;

__host__ __device__ __forceinline__ int lds_byte(int r, int c) { const int st = (r >> 4) * 2 + (c >> 5), rr = r & 15, cc = c & 31, ob = rr * 64 + cc * 2; return st * 1024 + (ob ^ (((ob >> 9) & 1) << 5)); }
__host__ __device__ __forceinline__ void stage_rc(int b, int& R, int& C) { const int st = b / 1024, sb = b % 1024, swz = sb ^ (((sb >> 9) & 1) << 5); R = (st >> 1) * 16 + swz / 64; C = (st & 1) * 32 + (swz % 64) / 2; }
__host__ __device__ __forceinline__ int perm32(int rho) { const int n = rho >> 4, i = rho & 15; return 8 * (i >> 2) + 4 * n + (i & 3); }

struct Unit { int pm, pn; };
struct Gemm { const bf16_t* A; const bf16_t* Bt; int M, N, K; };

struct StaticOrder {
    int nM, nN, nwg, G, c;
    __host__ __device__ void init(int M, int N, int G_, int c_) { nM = M / BM; nN = N / BM; nwg = nM * nN; G = G_; c = c_; }
    __host__ __device__ bool next(int i, Unit& u) const {
        const long L = (long)i * G + c; if (L >= nwg) return false;
        int wgid = (int)L; { const int q = nwg / NXCD, r = nwg % NXCD, xcd = wgid % NXCD, off = wgid / NXCD; wgid = (xcd < r ? xcd * (q + 1) : r * (q + 1) + (xcd - r) * q) + off; }
        const int nig = WGM * nN, gid = wgid / nig, fm = gid * WGM, gsz = (nM - fm) < WGM ? (nM - fm) : WGM;
        u.pm = fm + ((wgid % nig) % gsz); u.pn = (wgid % nig) / gsz; return true;
    }
    __device__ __forceinline__ void a_ready(const Unit&) const {}
    __device__ __forceinline__ void done(const Unit&) const {}
    __device__ __forceinline__ const char* bpair(const Gemm& g, const Unit&, int) const { return (const char*)g.Bt; }
};

__device__ __forceinline__ unsigned cvt_pk_bf16(float lo, float hi) { unsigned r; asm volatile("v_cvt_pk_bf16_f32 %0, %1, %2" : "=v"(r) : "v"(lo), "v"(hi)); return r; }
typedef float f32x2 __attribute__((ext_vector_type(2)));
typedef unsigned u32x2 __attribute__((ext_vector_type(2)));
struct EpiF32 {
    static constexpr bool PERM = false, AFTER_DRAIN = false;
    float* C; int ldc;
    __device__ __forceinline__ void operator()(const f32x4 (&acc)[2][2][4][2], const Unit& u, int wr, int wc, int fr, int fq) const {
        const int row0 = u.pm * BM + wr * 64 + fr, col0 = u.pn * BM + wc * 32 + 4 * fq;
#pragma unroll
        for (int ai = 0; ai < 2; ++ai)
#pragma unroll
            for (int m = 0; m < 4; ++m) { float* rowp = C + (size_t)(row0 + ai * HALF + m * 16) * ldc + col0;
#pragma unroll
                for (int bj = 0; bj < 2; ++bj)
#pragma unroll
                    for (int n = 0; n < 2; ++n) *(f32x4*)(rowp + bj * HALF + n * 16) = acc[ai][bj][m][n]; }
    }
};
struct EpiBf16R {
    static constexpr bool PERM = true, AFTER_DRAIN = false;
    bf16_t* O; int ldc; const float* rowbias;
    __device__ __forceinline__ void operator()(const f32x4 (&acc)[2][2][4][2], const Unit& u, int wr, int wc, int fr, int fq) const {
        const int row0 = u.pm * BM + wr * 64 + fr, col0 = u.pn * BM + wc * 32 + 8 * fq;
        float rb8[8];
#pragma unroll
        for (int g = 0; g < 8; ++g) rb8[g] = rowbias ? rowbias[row0 + (g >> 2) * HALF + (g & 3) * 16] : 0.f;
#pragma unroll
        for (int ai = 0; ai < 2; ++ai)
#pragma unroll
            for (int m = 0; m < 4; ++m) { const int row = row0 + ai * HALF + m * 16; bf16_t* rowp = O + (size_t)row * ldc + col0; const float rb = rb8[ai * 4 + m];
#pragma unroll
                for (int bj = 0; bj < 2; ++bj) { const f32x4 v0 = acc[ai][bj][m][0] + rb, v1 = acc[ai][bj][m][1] + rb;
                    u32x4 w; w.x = cvt_pk_bf16(v0[0], v0[1]); w.y = cvt_pk_bf16(v0[2], v0[3]); w.z = cvt_pk_bf16(v1[0], v1[1]); w.w = cvt_pk_bf16(v1[2], v1[3]);
                    *(u32x4*)(rowp + bj * HALF) = w; } }
    }
};
__device__ __forceinline__ float xsum16_32(float v) {
    const auto a = __builtin_amdgcn_permlane16_swap(__float_as_uint(v), __float_as_uint(v), false, false); v = __uint_as_float(a[0]) + __uint_as_float(a[1]);
    const auto b = __builtin_amdgcn_permlane32_swap(__float_as_uint(v), __float_as_uint(v), false, false); return __uint_as_float(b[0]) + __uint_as_float(b[1]);
}
struct EpiF8R {
    static constexpr bool PERM = true, AFTER_DRAIN = false;
    unsigned char* O; int ldc; float scale;
    __device__ __forceinline__ void operator()(const f32x4 (&acc)[2][2][4][2], const Unit& u, int wr, int wc, int, int) const {
        int ln = (int)__builtin_amdgcn_mbcnt_hi(~0u, __builtin_amdgcn_mbcnt_lo(~0u, 0u)); asm volatile("" : "+v"(ln)); const int fr = ln & 15, fq = ln >> 4;
        const int odd = fq & 1; unsigned char* base = O + (size_t)(u.pm * BM + wr * 64 + fr + odd * 16) * ldc + u.pn * BM + wc * 32 + 8 * (fq - odd);
#pragma unroll
        for (int ai = 0; ai < 2; ++ai)
#pragma unroll
            for (int mp = 0; mp < 4; mp += 2) { unsigned char* rowp = base + (size_t)(ai * HALF + mp * 16) * ldc;
#pragma unroll
                for (int bj = 0; bj < 2; ++bj) { unsigned w[2][2];
#pragma unroll
                    for (int q = 0; q < 2; ++q) { const f32x4 v0 = acc[ai][bj][mp + q][0] * scale, v1 = acc[ai][bj][mp + q][1] * scale; int o0 = 0, o1 = 0;
                        o0 = __builtin_amdgcn_cvt_pk_fp8_f32(v0[0], v0[1], o0, false); o0 = __builtin_amdgcn_cvt_pk_fp8_f32(v0[2], v0[3], o0, true);
                        o1 = __builtin_amdgcn_cvt_pk_fp8_f32(v1[0], v1[1], o1, false); o1 = __builtin_amdgcn_cvt_pk_fp8_f32(v1[2], v1[3], o1, true); w[q][0] = (unsigned)o0; w[q][1] = (unsigned)o1; }
                    const auto s0_ = __builtin_amdgcn_permlane16_swap(w[0][0], w[1][0], false, false), s1_ = __builtin_amdgcn_permlane16_swap(w[0][1], w[1][1], false, false);
                    u32x4 o; o.x = s0_[0]; o.y = s1_[0]; o.z = s0_[1]; o.w = s1_[1]; *(u32x4*)(rowp + bj * HALF) = o; } }
    }
};
__device__ __forceinline__ f32x4 ld4(const float* p) { return *(const f32x4*)p; }
__device__ __forceinline__ f32x4 ld4(const bf16_t* p) { const u32x2 w = *(const u32x2*)p; f32x4 r; r[0] = __uint_as_float(w.x << 16); r[1] = __uint_as_float(w.x & 0xffff0000u); r[2] = __uint_as_float(w.y << 16); r[3] = __uint_as_float(w.y & 0xffff0000u); return r; }
__device__ __forceinline__ void st4(float* p, f32x4 v) { *(f32x4*)p = v; }
__device__ __forceinline__ void st4(bf16_t* p, f32x4 v) { u32x2 w; w.x = cvt_pk_bf16(v[0], v[1]); w.y = cvt_pk_bf16(v[2], v[3]); *(u32x2*)p = w; }
__device__ __forceinline__ f32x4 ldraw(const float* p) { return *(const f32x4*)p; }
__device__ __forceinline__ u32x2 ldraw(const bf16_t* p) { return *(const u32x2*)p; }
__device__ __forceinline__ f32x4 cvraw(f32x4 v) { return v; }
__device__ __forceinline__ f32x4 cvraw(u32x2 w) { f32x4 r; r[0] = __uint_as_float(w.x << 16); r[1] = __uint_as_float(w.x & 0xffff0000u); r[2] = __uint_as_float(w.y << 16); r[3] = __uint_as_float(w.y & 0xffff0000u); return r; }
template <class TB, class TO> struct EpiResGate {
    static constexpr bool PERM = true, AFTER_DRAIN = false;
    const TB* base; TO* out; const float* gate; int ldc;
    __device__ __forceinline__ void operator()(const f32x4 (&acc)[2][2][4][2], const Unit& u, int wr, int wc, int fr, int fq) const {
        const int row0 = u.pm * BM + wr * 64 + fr, col0 = u.pn * BM + wc * 32 + 8 * fq;
        const float* gp = gate + (size_t)(u.pm >> 4) * 6144 + col0;
        f32x4 gv[2][2];
#pragma unroll
        for (int bj = 0; bj < 2; ++bj)
#pragma unroll
            for (int n = 0; n < 2; ++n) gv[bj][n] = *(const f32x4*)(gp + bj * HALF + n * 4);
        constexpr int GB = sizeof(TB) == 2 ? 8 : 4;
        typedef decltype(ldraw(base)) raw_t;
#pragma unroll
        for (int g0 = 0; g0 < 8; g0 += GB) {
            raw_t bs[GB][2][2];
#pragma unroll
            for (int g = 0; g < GB; ++g) { const unsigned off = (unsigned)((row0 + ((g0 + g) >> 2) * HALF + ((g0 + g) & 3) * 16) * ldc + col0);
#pragma unroll
                for (int bj = 0; bj < 2; ++bj)
#pragma unroll
                    for (int n = 0; n < 2; ++n) bs[g][bj][n] = ldraw(base + off + bj * HALF + n * 4); }
#pragma unroll
            for (int g = 0; g < GB; ++g) { const int ai = (g0 + g) >> 2, m = (g0 + g) & 3; const unsigned off = (unsigned)((row0 + ai * HALF + m * 16) * ldc + col0);
#pragma unroll
                for (int bj = 0; bj < 2; ++bj)
                    { const f32x4 r0 = cvraw(bs[g][bj][0]) + gv[bj][0] * acc[ai][bj][m][0], r1 = cvraw(bs[g][bj][1]) + gv[bj][1] * acc[ai][bj][m][1];
                      if constexpr (sizeof(TO) == 2) { u32x4 w; w.x = cvt_pk_bf16(r0[0], r0[1]); w.y = cvt_pk_bf16(r0[2], r0[3]); w.z = cvt_pk_bf16(r1[0], r1[1]); w.w = cvt_pk_bf16(r1[2], r1[3]); *(u32x4*)(out + off + bj * HALF) = w; }
                      else { st4(out + off + bj * HALF, r0); st4(out + off + bj * HALF + 4, r1); } } }
            asm volatile("" ::: "memory"); }
    }
};
struct EpiLat {
    static constexpr bool PERM = false, AFTER_DRAIN = false;
    unsigned char* CQN  ; bf16_t* CKVN; unsigned char* KPE  ; const float* qag; const float* kvag; const float* kng; const float* rope; PG8_LAS float* P;
    __device__ __forceinline__ void operator()(const f32x4 (&acc)[2][2][4][2], const Unit& u, int wr, int wc, int, int) const {
        int ln = (int)__builtin_amdgcn_mbcnt_hi(~0u, __builtin_amdgcn_mbcnt_lo(~0u, 0u)); asm volatile("" : "+v"(ln)); const int fr = ln & 15, fq = ln >> 4;
        const int row0 = u.pm * BM + wr * 64 + fr;
#pragma unroll
        for (int ai = 0; ai < 2; ++ai)
#pragma unroll
            for (int m = 0; m < 4; ++m) { float s0 = 0.f, s1 = 0.f;
#pragma unroll
                for (int n = 0; n < 2; ++n) { const f32x4 a = acc[ai][0][m][n], b = acc[ai][1][m][n];
                    s0 += (a[0] * a[0] + a[1] * a[1]) + (a[2] * a[2] + a[3] * a[3]); s1 += (b[0] * b[0] + b[1] * b[1]) + (b[2] * b[2] + b[3] * b[3]); }
                s0 = xsum16_32(s0); s1 = xsum16_32(s1);
                if (fq == 0) { const int rl = ai * HALF + wr * 64 + m * 16 + fr; P[rl * 8 + wc] = s0; P[rl * 8 + 4 + wc] = s1; } }
        asm volatile("s_waitcnt lgkmcnt(0)" ::: "memory"); __builtin_amdgcn_s_barrier(); asm volatile("" ::: "memory");
        const int cl = wc * 32 + 4 * fq;
        if (u.pn == 0) {
            f32x4 g[2][2];
#pragma unroll
            for (int bj = 0; bj < 2; ++bj)
#pragma unroll
                for (int n = 0; n < 2; ++n) g[bj][n] = *(const f32x4*)(qag + bj * HALF + cl + 16 * n);
#pragma unroll
            for (int ai = 0; ai < 2; ++ai)
#pragma unroll
                for (int m = 0; m < 4; ++m) { const int rl = ai * HALF + wr * 64 + m * 16 + fr; const f32x4 pa = *(const PG8_LAS f32x4*)(P + rl * 8), pb = *(const PG8_LAS f32x4*)(P + rl * 8 + 4);
                    const float r = __builtin_amdgcn_rsqf((((pa[0] + pa[1]) + (pa[2] + pa[3])) + ((pb[0] + pb[1]) + (pb[2] + pb[3]))) * (1.f / 256.f) + 1e-6f);
                    unsigned char* rowp = CQN + (size_t)(row0 + ai * HALF + m * 16) * 256 + cl;
#pragma unroll
                    for (int bj = 0; bj < 2; ++bj)
#pragma unroll
                        for (int n = 0; n < 2; ++n) { const f32x4 v = acc[ai][bj][m][n] * r * g[bj][n]; int p = 0; p = __builtin_amdgcn_cvt_pk_fp8_f32(v[0], v[1], p, false); p = __builtin_amdgcn_cvt_pk_fp8_f32(v[2], v[3], p, true); *(int*)(rowp + bj * HALF + 16 * n) = p; } }
        } else {
            f32x4 gk[2], gp[2]; const int e0 = 16 * (wc & 1) + 4 * fq;
#pragma unroll
            for (int n = 0; n < 2; ++n) { gk[n] = *(const f32x4*)(kvag + cl + 16 * n); gp[n] = *(const f32x4*)(kng + 128 + e0 + 32 * n); }
            f32x4 rc0[8], rc1[8];
            if (wc < 2) {
#pragma unroll
                for (int gq = 0; gq < 8; ++gq) { const size_t row = (size_t)(row0 + (gq >> 2) * HALF + (gq & 3) * 16); rc0[gq] = *(const f32x4*)(rope + row * 64 + e0 * 2); rc1[gq] = *(const f32x4*)(rope + row * 64 + e0 * 2 + 4); } }
#pragma unroll
            for (int ai = 0; ai < 2; ++ai)
#pragma unroll
                for (int m = 0; m < 4; ++m) { const int rl = ai * HALF + wr * 64 + m * 16 + fr; const f32x4 pa = *(const PG8_LAS f32x4*)(P + rl * 8), pb = *(const PG8_LAS f32x4*)(P + rl * 8 + 4);
                    const float rkv = __builtin_amdgcn_rsqf(((pa[0] + pa[1]) + (pa[2] + pa[3])) * (1.f / 128.f) + 1e-6f), rpe = __builtin_amdgcn_rsqf((pb[0] + pb[1]) * (1.f / 64.f) + 1e-6f);
                    const size_t row = (size_t)(row0 + ai * HALF + m * 16);
#pragma unroll
                    for (int n = 0; n < 2; ++n) { const f32x4 v = acc[ai][0][m][n] * rkv * gk[n]; u32x2 w; w.x = cvt_pk_bf16(v[0], v[1]); w.y = cvt_pk_bf16(v[2], v[3]); *(u32x2*)(CKVN + row * 128 + cl + 16 * n) = w; }
                    if (wc < 2) { const f32x4 x1 = acc[ai][1][m][0] * rpe * gp[0], x2 = acc[ai][1][m][1] * rpe * gp[1];
                        const f32x4 c0 = rc0[ai * 4 + m], c1 = rc1[ai * 4 + m];
                        const float cs[4] = {c0[0], c0[2], c1[0], c1[2]}, sn[4] = {c0[1], c0[3], c1[1], c1[3]};
                        float o1[4], o2[4];
#pragma unroll
                        for (int j = 0; j < 4; ++j) { o1[j] = x1[j] * cs[j] - x2[j] * sn[j]; o2[j] = x1[j] * sn[j] + x2[j] * cs[j]; }
                        int w1 = 0, w2 = 0; w1 = __builtin_amdgcn_cvt_pk_fp8_f32(o1[0], o1[1], w1, false); w1 = __builtin_amdgcn_cvt_pk_fp8_f32(o1[2], o1[3], w1, true); w2 = __builtin_amdgcn_cvt_pk_fp8_f32(o2[0], o2[1], w2, false); w2 = __builtin_amdgcn_cvt_pk_fp8_f32(o2[2], o2[3], w2, true);
                        *(int*)(KPE + row * 64 + e0) = w1; *(int*)(KPE + row * 64 + 32 + e0) = w2; }
                    asm volatile("" ::: "memory"); }
        }
        asm volatile("s_waitcnt lgkmcnt(0)" ::: "memory"); __builtin_amdgcn_s_barrier(); asm volatile("" ::: "memory");
    }
};
struct EpiK8 {
    static constexpr bool PERM = true, AFTER_DRAIN = false;
    unsigned char* K8; const float* kng; PG8_LAS float* P;
    __device__ __forceinline__ void operator()(const f32x4 (&acc)[2][2][4][2], const Unit& u, int wr, int wc, int, int) const {
        int ln = (int)__builtin_amdgcn_mbcnt_hi(~0u, __builtin_amdgcn_mbcnt_lo(~0u, 0u)); asm volatile("" : "+v"(ln)); const int fr = ln & 15, fq = ln >> 4;
#pragma unroll
        for (int ai = 0; ai < 2; ++ai)
#pragma unroll
            for (int m = 0; m < 4; ++m) {
#pragma unroll
                for (int bj = 0; bj < 2; ++bj) { const f32x4 a = acc[ai][bj][m][0], b = acc[ai][bj][m][1];
                    float s = (a[0] * a[0] + a[1] * a[1]) + (a[2] * a[2] + a[3] * a[3]) + (b[0] * b[0] + b[1] * b[1]) + (b[2] * b[2] + b[3] * b[3]);
                    s = xsum16_32(s);
                    if (fq == 0) P[(ai * HALF + wr * 64 + m * 16 + fr) * 8 + bj * 4 + wc] = s; } }
        asm volatile("s_waitcnt lgkmcnt(0)" ::: "memory"); __builtin_amdgcn_s_barrier(); asm volatile("" ::: "memory");
        const f32x4 g0 = *(const f32x4*)(kng + wc * 32 + 8 * fq), g1 = *(const f32x4*)(kng + wc * 32 + 8 * fq + 4);
        const int row0 = u.pm * BM + wr * 64 + fr;
#pragma unroll
        for (int ai = 0; ai < 2; ++ai)
#pragma unroll
            for (int m = 0; m < 4; ++m) { const int rl = ai * HALF + wr * 64 + m * 16 + fr;
#pragma unroll
                for (int bj = 0; bj < 2; ++bj) { const f32x4 p4 = *(const PG8_LAS f32x4*)(P + rl * 8 + bj * 4);
                    const float r = __builtin_amdgcn_rsqf(((p4[0] + p4[1]) + (p4[2] + p4[3])) * (1.f / 128.f) + 1e-6f);
                    const f32x4 v0 = acc[ai][bj][m][0] * r * g0, v1 = acc[ai][bj][m][1] * r * g1;
                    int w0 = 0, w1 = 0; w0 = __builtin_amdgcn_cvt_pk_fp8_f32(v0[0], v0[1], w0, false); w0 = __builtin_amdgcn_cvt_pk_fp8_f32(v0[2], v0[3], w0, true); w1 = __builtin_amdgcn_cvt_pk_fp8_f32(v1[0], v1[1], w1, false); w1 = __builtin_amdgcn_cvt_pk_fp8_f32(v1[2], v1[3], w1, true);
                    u32x2 w; w.x = (unsigned)w0; w.y = (unsigned)w1; *(u32x2*)(K8 + ((size_t)(row0 + ai * HALF + m * 16) * 8 + 2 * u.pn + bj) * 128 + wc * 32 + 8 * fq) = w; } }
        asm volatile("s_waitcnt lgkmcnt(0)" ::: "memory"); __builtin_amdgcn_s_barrier(); asm volatile("" ::: "memory");
    }
};
struct EpiF8T {
    static constexpr bool PERM = true, AFTER_DRAIN = false;
    unsigned char* O; int ldc;
    __device__ __forceinline__ void operator()(const f32x4 (&acc)[2][2][4][2], const Unit& u, int wr, int wc, int fr, int fq) const {
        const int row0 = u.pm * BM + wr * 64 + fr, col0 = u.pn * BM + wc * 32 + 8 * fq;
#pragma unroll
        for (int ai = 0; ai < 2; ++ai)
#pragma unroll
            for (int m = 0; m < 4; ++m) { unsigned char* rowp = O + (size_t)(row0 + ai * HALF + m * 16) * ldc + col0;
#pragma unroll
                for (int bj = 0; bj < 2; ++bj) { const f32x4 v0 = acc[ai][bj][m][0], v1 = acc[ai][bj][m][1];
                    int w0 = 0, w1 = 0; w0 = __builtin_amdgcn_cvt_pk_fp8_f32(v0[0], v0[1], w0, false); w0 = __builtin_amdgcn_cvt_pk_fp8_f32(v0[2], v0[3], w0, true); w1 = __builtin_amdgcn_cvt_pk_fp8_f32(v1[0], v1[1], w1, false); w1 = __builtin_amdgcn_cvt_pk_fp8_f32(v1[2], v1[3], w1, true);
                    u32x2 w; w.x = (unsigned)w0; w.y = (unsigned)w1; *(u32x2*)(rowp + bj * HALF) = w; } }
    }
};
__device__ __forceinline__ void pair_of(int pi, int& i, int& j) { i = pi < 3 ? 0 : (pi < 5 ? 1 : 2); j = pi < 3 ? pi + 1 : (pi < 5 ? pi - 1 : 3); }
struct MoeOrder {
    const PG8_LAS int* tinfo; int G, c, mode; const int* list;
    __device__ __forceinline__ int tok(const Unit& u, int r) const { const int bk = tinfo[1 + u.pm], pos = u.pm * BM - tinfo[256 + bk] + r; return list[bk * 32768 + (pos < tinfo[288 + bk] ? pos : 0)]; }
    __device__ __forceinline__ bool next(int i, Unit& u) const {
        const long L = (long)i * G + c; const int nt = tinfo[0]; if (L >= 4L * nt) return false;
        const int mt = (int)(L >> 2), q = (int)(L & 3), bk = tinfo[1 + mt];
        u.pm = mt;
        if (mode == 0) { int ii, jj; pair_of(bk % 6, ii, jj); const int e = (bk / 6) * 4 + ((q >> 1) ? jj : ii); u.pn = e * 2 + (q & 1); }
        else u.pn = bk * 4 + q;
        return true;
    }
    __device__ __forceinline__ void a_ready(const Unit&) const {}
    __device__ __forceinline__ void done(const Unit&) const {}
    __device__ __forceinline__ const char* bpair(const Gemm& g, const Unit& u, int which) const { const int bk = tinfo[1 + u.pm]; int ii, jj; pair_of(bk % 6, ii, jj); const int e = (bk / 6) * 4 + (which ? jj : ii);
        return (const char*)g.Bt + ((size_t)e * 1024 + (size_t)(u.pn & 3) * BM) * (size_t)g.K; }
};
struct EpiSwiGLU {
    static constexpr bool PERM = true, AFTER_DRAIN = false;
    unsigned char* H; const float* wl; const PG8_LAS int* tinfo;
    __device__ __forceinline__ void operator()(const f32x4 (&acc)[2][2][4][2], const Unit& u, int wr, int wc, int, int) const {
        int ln = (int)__builtin_amdgcn_mbcnt_hi(~0u, __builtin_amdgcn_mbcnt_lo(~0u, 0u)); asm volatile("" : "+v"(ln)); const int fr = ln & 15, fq = ln >> 4;
        const int bk = tinfo[1 + u.pm]; int ii, jj; pair_of(bk % 6, ii, jj);
        const int e = u.pn >> 1, hh = u.pn & 1, slot = (e == (bk / 6) * 4 + jj) ? 1 : 0;
        const int row0 = u.pm * BM + wr * 64 + fr, col0 = slot * 256 + hh * 128 + wc * 32 + 8 * fq;
        float w8[8];
        { const int cntb = tinfo[288 + bk]; float wraw[8];
#pragma unroll
          for (int g = 0; g < 8; ++g) { const int pos = row0 + (g >> 2) * HALF + (g & 3) * 16 - tinfo[256 + bk]; wraw[g] = wl[((size_t)bk * 32768 + (pos < cntb ? pos : cntb - 1)) * 2 + slot]; }
#pragma unroll
          for (int g = 0; g < 8; ++g) { const int pos = row0 + (g >> 2) * HALF + (g & 3) * 16 - tinfo[256 + bk]; w8[g] = pos < cntb ? 8.f * wraw[g] : 0.f; } }
#pragma unroll
        for (int ai = 0; ai < 2; ++ai)
#pragma unroll
            for (int m = 0; m < 4; ++m) { const int row = row0 + ai * HALF + m * 16; const float w = w8[ai * 4 + m];
                float a[8];
#pragma unroll
                for (int n = 0; n < 2; ++n)
#pragma unroll
                    for (int j = 0; j < 4; ++j) { const float g = acc[ai][0][m][n][j], up = acc[ai][1][m][n][j];
                        const float sg = g * __builtin_amdgcn_rcpf(1.0f + __builtin_amdgcn_exp2f(-1.4426950408889634f * g)); a[n * 4 + j] = sg * up * w; }
                int o0 = 0, o1 = 0; o0 = __builtin_amdgcn_cvt_pk_fp8_f32(a[0], a[1], o0, false); o0 = __builtin_amdgcn_cvt_pk_fp8_f32(a[2], a[3], o0, true);
                o1 = __builtin_amdgcn_cvt_pk_fp8_f32(a[4], a[5], o1, false); o1 = __builtin_amdgcn_cvt_pk_fp8_f32(a[6], a[7], o1, true);
                u32x2 o; o.x = (unsigned)o0; o.y = (unsigned)o1; *(u32x2*)(H + (size_t)row * 512 + col0) = o; }
    }
};
template <class TO> struct EpiMoeOut {
    static constexpr bool PERM = true, AFTER_DRAIN = false;
    const bf16_t* xr; TO* out; const float* gate; const int* list; const PG8_LAS int* tinfo; PG8_LAS float* gl;
    __device__ __forceinline__ void operator()(const f32x4 (&acc)[2][2][4][2], const Unit& u, int wr, int wc, int, int) const {
        int ln = (int)__builtin_amdgcn_mbcnt_hi(~0u, __builtin_amdgcn_mbcnt_lo(~0u, 0u)); asm volatile("" : "+v"(ln)); const int fr = ln & 15, fq = ln >> 4;
        const int bk = tinfo[1 + u.pm], r_beg = tinfo[256 + bk], r_end = r_beg + tinfo[288 + bk];
        const int row0 = u.pm * BM + wr * 64 + fr, colu = (u.pn & 3) * BM, cl = wc * 32 + 8 * fq;
        int tk[8];
#pragma unroll
        for (int g = 0; g < 8; ++g) { const int row = row0 + (g >> 2) * HALF + (g & 3) * 16; tk[g] = list[bk * 32768 + (row < r_end ? row - r_beg : 0)]; }
#pragma unroll
        for (int g = 0; g < 8; ++g) { const int row = row0 + (g >> 2) * HALF + (g & 3) * 16; tk[g] = row < r_end ? tk[g] : -1; }
        { const int t = (wr * 4 + wc) * 64 + fq * 16 + fr; const f32x4 gs = *(const f32x4*)(gate + (size_t)(t >> 6) * 6144 + colu + (t & 63) * 4);
          *(PG8_LAS f32x4*)(gl + (t >> 6) * 256 + (t & 63) * 4) = gs; }
        asm volatile("s_waitcnt lgkmcnt(0)" ::: "memory"); __builtin_amdgcn_s_barrier();
#pragma unroll
        for (int g0 = 0; g0 < 8; g0 += 4) {
            u32x2 bs[4][2][2];
#pragma unroll
            for (int g = 0; g < 4; ++g) { const unsigned xo = (unsigned)((tk[g0 + g] < 0 ? 0 : tk[g0 + g]) * 1024 + colu + cl);
#pragma unroll
                for (int bj = 0; bj < 2; ++bj)
#pragma unroll
                    for (int n = 0; n < 2; ++n) bs[g][bj][n] = ldraw(xr + xo + bj * HALF + n * 4); }
#pragma unroll
            for (int g = 0; g < 4; ++g) { const int ai = (g0 + g) >> 2, m = (g0 + g) & 3, tkg = tk[g0 + g];
                if (tkg >= 0) { TO* op = out + (size_t)tkg * 1024 + colu + cl; const PG8_LAS float* gp = gl + (tkg >> 12) * 256 + cl;
#pragma unroll
                    for (int bj = 0; bj < 2; ++bj)
                        { const f32x4 gv0 = *(const PG8_LAS f32x4*)(gp + bj * HALF), gv1 = *(const PG8_LAS f32x4*)(gp + bj * HALF + 4);
                          const f32x4 r0 = cvraw(bs[g][bj][0]) + gv0 * acc[ai][bj][m][0], r1 = cvraw(bs[g][bj][1]) + gv1 * acc[ai][bj][m][1];
                          if constexpr (sizeof(TO) == 2) { u32x4 w; w.x = cvt_pk_bf16(r0[0], r0[1]); w.y = cvt_pk_bf16(r0[2], r0[3]); w.z = cvt_pk_bf16(r1[0], r1[1]); w.w = cvt_pk_bf16(r1[2], r1[3]); *(u32x4*)(op + bj * HALF) = w; }
                          else { st4(op + bj * HALF, r0); st4(op + bj * HALF + 4, r1); } } } }
            asm volatile("" ::: "memory"); }
    }
};
template <class Epi, class Sched, bool ALIGN_EPI = false, bool SP2 = false, int F8 = -1, bool PAIRB = false>
__device__ __forceinline__ void gemm_phase(PG8_LAS unsigned char* lds, const Gemm g, const Sched& S, const Epi& E, const int tid_in) {
    int tid = tid_in; asm volatile("" : "+v"(tid));
    const int wid = __builtin_amdgcn_readfirstlane(tid >> 6), lane = tid & 63, wr = wid >> 2, wc = wid & 3, fr = lane & 15, fq = lane >> 4;
    int K = g.K; asm volatile("" : "+s"(K)); const int nt = K / BK;
    unsigned voffA[2], voffB[2];
#pragma unroll
    for (int i = 0; i < 2; ++i) { int R, C; stage_rc(tid * 16 + i * 8192, R, C); const int Rb = Epi::PERM ? ((R & ~31) + perm32(R & 31)) : R;
        voffA[i] = (unsigned)(R * K + C) * 2u; voffB[i] = (unsigned)(Rb * (PAIRB ? K / 2 : K) + C) * 2u; }
    const size_t kstep = (size_t)(BK * 2);
    const size_t hstep = (size_t)HALF * K * 2;
    const size_t tstep = 2 * hstep;
    const size_t hstepB = PAIRB ? hstep / 2 : hstep;
    const size_t bsplit = (size_t)(nt / 2) * kstep;
    const unsigned ldsw = (unsigned)wid * 1024u;
    const int aoff = lds_byte(wr * 64 + fr, fq * 8), boff = lds_byte(wc * 32 + fr, fq * 8);
#define PG8_SA(b, h) (((b) * 2 + (h)) * HTB)
#define PG8_SB(b, h) ((4 + (b) * 2 + (h)) * HTB)
#define PG8_STAGE(bufoff, gbase, voff) do { _Pragma("unroll") for (int _i = 0; _i < 2; ++_i) { unsigned vo_ = (voff)[_i]; asm volatile("" : "+v"(vo_));   \
        __builtin_amdgcn_global_load_lds((const unsigned*)((const char*)(gbase) + vo_), (PG8_LAS unsigned*)(lds + (bufoff) + ldsw + _i * 8192), 16, 0, 0); } } while (0)
#define PG8_LDA(dst, b, h) do { _Pragma("unroll") for (int m = 0; m < 4; ++m) { const bf16x8 x0_ = *(const PG8_LAS bf16x8*)(lds + PG8_SA(b, h) + aoff + m * 2048), x1_ = *(const PG8_LAS bf16x8*)(lds + PG8_SA(b, h) + aoff + m * 2048 + 1024); \
        if constexpr (F8 >= 0) dst##8[m] = PG8_CAT(x0_, x1_); else { dst[m][0] = x0_; dst[m][1] = x1_; } } } while (0)
#define PG8_LDB(dst, b, h) do { _Pragma("unroll") for (int n = 0; n < 2; ++n) { const bf16x8 x0_ = *(const PG8_LAS bf16x8*)(lds + PG8_SB(b, h) + boff + n * 2048), x1_ = *(const PG8_LAS bf16x8*)(lds + PG8_SB(b, h) + boff + n * 2048 + 1024); \
        if constexpr (F8 >= 0) dst##8[n] = PG8_CAT(x0_, x1_); else { dst[n][0] = x0_; dst[n][1] = x1_; } } } while (0)
#define PG8_CAT(x0, x1) ({ const v4i_t lo_ = __builtin_bit_cast(v4i_t, x0), hi_ = __builtin_bit_cast(v4i_t, x1); (v8i_t){lo_[0], lo_[1], lo_[2], lo_[3], hi_[0], hi_[1], hi_[2], hi_[3]}; })
#define PG8_MMA(ai, bj, At, Bt) do { __builtin_amdgcn_s_setprio(1); _Pragma("unroll") for (int m = 0; m < 4; ++m) _Pragma("unroll") for (int n = 0; n < 2; ++n) { \
        if constexpr (F8 >= 0) acc[ai][bj][m][n] = __builtin_amdgcn_mfma_scale_f32_16x16x128_f8f6f4(Bt##8[n], At##8[m], acc[ai][bj][m][n], 0, 0, 0, 0x7f7f7f7f, 0, (127 - F8) * 0x01010101); \
        else { _Pragma("unroll") for (int k = 0; k < 2; ++k) acc[ai][bj][m][n] = __builtin_amdgcn_mfma_f32_16x16x32_bf16(Bt[n][k], At[m][k], acc[ai][bj][m][n], 0, 0, 0); } } \
        __builtin_amdgcn_s_setprio(0); } while (0)
#define PG8_WAIT_V(n) asm volatile("s_waitcnt vmcnt(" #n ")" ::: "memory")
#define PG8_WAIT_L(n) asm volatile("s_waitcnt lgkmcnt(" #n ")" ::: "memory")
#define PG8_BAR __builtin_amdgcn_s_barrier()
#define PG8_SCHED __builtin_amdgcn_sched_barrier(0)
    Unit cur, nxt; int ui = 0;
    if (!S.next(0, cur)) return;
    f32x4 acc[2][2][4][2];
#pragma unroll
    for (int a = 0; a < 2; ++a)
#pragma unroll
        for (int b = 0; b < 2; ++b)
#pragma unroll
            for (int m = 0; m < 4; ++m)
#pragma unroll
                for (int n = 0; n < 2; ++n) acc[a][b][m][n] = (f32x4){0.f, 0.f, 0.f, 0.f};
    bf16x8 At[4][2], B0[2][2], B1[2][2]; v8i_t At8[4], B08[2], B18[2];
    const char* cA = (const char*)g.A + (size_t)cur.pm * tstep; const char* cB = PAIRB ? S.bpair(g, cur, 0) : (const char*)g.Bt + (size_t)cur.pn * tstep;
    const char* cB2 = PAIRB ? S.bpair(g, cur, 1) - bsplit : (const char*)g.Bt;
    S.a_ready(cur);
    if constexpr (SP2) {
        PG8_STAGE(PG8_SB(0, 0), cB, voffB); PG8_STAGE(PG8_SB(0, 1), cB + hstepB, voffB); PG8_STAGE(PG8_SA(0, 0), cA, voffA); PG8_STAGE(PG8_SA(0, 1), cA + hstep, voffA);
        if (wr == 1) PG8_BAR;
        PG8_WAIT_V(2); PG8_BAR;
        PG8_STAGE(PG8_SB(1, 0), cB + kstep, voffB); PG8_STAGE(PG8_SA(1, 0), cA + kstep, voffA); PG8_STAGE(PG8_SB(1, 1), cB + hstepB + kstep, voffB);
        PG8_WAIT_V(6); PG8_BAR;
    } else {
        PG8_STAGE(PG8_SB(0, 0), cB, voffB); PG8_STAGE(PG8_SA(0, 0), cA, voffA); PG8_STAGE(PG8_SB(0, 1), cB + hstepB, voffB); PG8_STAGE(PG8_SA(0, 1), cA + hstep, voffA);
        if (wr == 1) PG8_BAR;
        PG8_WAIT_V(4); PG8_BAR;
        PG8_STAGE(PG8_SB(1, 0), cB + kstep, voffB); PG8_STAGE(PG8_SA(1, 0), cA + kstep, voffA); PG8_STAGE(PG8_SB(1, 1), cB + hstepB + kstep, voffB);
        PG8_WAIT_V(6); PG8_BAR;
    }
    for (;;) {
        const bool has_next = S.next(ui + 1, nxt);
        const char* nA = has_next ? (const char*)g.A + (size_t)nxt.pm * tstep : cA; const char* nB = has_next ? (PAIRB ? S.bpair(g, nxt, 0) : (const char*)g.Bt + (size_t)nxt.pn * tstep) : cB;
        const char* nB2 = PAIRB ? (has_next ? S.bpair(g, nxt, 1) - bsplit : cB2) : nB;
        for (int t = 0; t < nt; t += 2) {
            const bool last = (t == nt - 2);
            const char* a1 = cA + (size_t)(t + 1) * kstep;
            const char* a2 = last ? nA : cA + (size_t)(t + 2) * kstep; const char* b2 = last ? nB : (PAIRB && t + 2 >= nt / 2 ? cB2 : cB) + (size_t)(t + 2) * kstep;
            const char* a3 = a2 + kstep; const char* b3 = b2 + kstep;
            if (last && has_next) S.a_ready(nxt);
            if constexpr (SP2) {
            PG8_LDB(B0, 0, 0); PG8_LDB(B1, 0, 1); PG8_SCHED; PG8_LDA(At, 0, 0); PG8_STAGE(PG8_SA(1, 1), a1 + hstep, voffA);
            PG8_WAIT_V(8); PG8_WAIT_L(0); PG8_BAR; PG8_MMA(0, 0, At, B0); PG8_MMA(0, 1, At, B1); PG8_BAR; PG8_SCHED;
            PG8_LDA(At, 0, 1); PG8_STAGE(PG8_SB(0, 0), b2, voffB); PG8_STAGE(PG8_SB(0, 1), b2 + hstepB, voffB); PG8_STAGE(PG8_SA(0, 0), a2, voffA);
            PG8_WAIT_V(8); PG8_WAIT_L(0); PG8_BAR; PG8_MMA(1, 0, At, B0); PG8_MMA(1, 1, At, B1); PG8_BAR; PG8_SCHED;
            PG8_LDB(B0, 1, 0); PG8_LDB(B1, 1, 1); PG8_SCHED; PG8_LDA(At, 1, 0); PG8_STAGE(PG8_SA(0, 1), a2 + hstep, voffA);
            PG8_WAIT_V(8); PG8_WAIT_L(0); PG8_BAR; PG8_MMA(0, 0, At, B0); PG8_MMA(0, 1, At, B1); PG8_BAR; PG8_SCHED;
            PG8_LDA(At, 1, 1); PG8_STAGE(PG8_SB(1, 0), b3, voffB); PG8_STAGE(PG8_SB(1, 1), b3 + hstepB, voffB); PG8_STAGE(PG8_SA(1, 0), a3, voffA);
            PG8_WAIT_V(8); PG8_WAIT_L(0); PG8_BAR; PG8_MMA(1, 0, At, B0); PG8_MMA(1, 1, At, B1); PG8_BAR; PG8_SCHED;
            } else {
            PG8_LDB(B0, 0, 0); PG8_SCHED; PG8_LDA(At, 0, 0); PG8_STAGE(PG8_SA(1, 1), a1 + hstep, voffA);
            PG8_WAIT_L(8); PG8_BAR; PG8_WAIT_L(0); PG8_MMA(0, 0, At, B0); PG8_BAR; PG8_SCHED;
            PG8_LDB(B1, 0, 1); PG8_STAGE(PG8_SB(0, 0), b2, voffB);
            PG8_BAR; PG8_WAIT_L(0); PG8_MMA(0, 1, At, B1); PG8_BAR;
            PG8_LDA(At, 0, 1); PG8_STAGE(PG8_SA(0, 0), a2, voffA);
            PG8_BAR; PG8_WAIT_L(0); PG8_MMA(1, 0, At, B0); PG8_BAR; PG8_SCHED;
            PG8_STAGE(PG8_SB(0, 1), b2 + hstepB, voffB);
            PG8_WAIT_V(6); PG8_BAR; PG8_MMA(1, 1, At, B1); PG8_BAR;
            PG8_LDB(B0, 1, 0); PG8_SCHED; PG8_LDA(At, 1, 0); PG8_STAGE(PG8_SA(0, 1), a2 + hstep, voffA);
            PG8_WAIT_L(8); PG8_BAR; PG8_WAIT_L(0); PG8_MMA(0, 0, At, B0); PG8_BAR; PG8_SCHED;
            PG8_LDB(B1, 1, 1); PG8_STAGE(PG8_SB(1, 0), b3, voffB);
            PG8_BAR; PG8_WAIT_L(0); PG8_MMA(0, 1, At, B1); PG8_BAR;
            PG8_LDA(At, 1, 1); PG8_STAGE(PG8_SA(1, 0), a3, voffA);
            PG8_BAR; PG8_WAIT_L(0); PG8_MMA(1, 0, At, B0); PG8_BAR; PG8_SCHED;
            PG8_STAGE(PG8_SB(1, 1), b3 + hstepB, voffB);
            PG8_WAIT_V(6); PG8_BAR; PG8_MMA(1, 1, At, B1); PG8_BAR;
            }
        }
        if constexpr (ALIGN_EPI) { if (wr == 0) PG8_BAR; }
        if constexpr (!Epi::AFTER_DRAIN) { E(acc, cur, wr, wc, fr, fq); S.done(cur); }
        if (!has_next) break;
#pragma unroll
        for (int a = 0; a < 2; ++a)
#pragma unroll
            for (int b = 0; b < 2; ++b)
#pragma unroll
                for (int m = 0; m < 4; ++m)
#pragma unroll
                    for (int n = 0; n < 2; ++n) acc[a][b][m][n] = (f32x4){0.f, 0.f, 0.f, 0.f};
        cur = nxt; cA = nA; cB = nB; cB2 = nB2; ++ui;
        if constexpr (ALIGN_EPI) { if (wr == 1) PG8_BAR; }
    }
    PG8_WAIT_V(0);
    if constexpr (!ALIGN_EPI) { if (wr == 0) PG8_BAR; }
    PG8_BAR;
    if constexpr (Epi::AFTER_DRAIN) { E.fused(acc, cur, wr, wc, fr, fq, lds, wid, lane); S.done(cur); }
#undef PG8_SA
#undef PG8_SB
#undef PG8_STAGE
#undef PG8_LDA
#undef PG8_LDB
#undef PG8_MMA
#undef PG8_WAIT_V
#undef PG8_WAIT_L
#undef PG8_BAR
#undef PG8_SCHED
}
template <class Epi, class Sched, bool ALIGN_EPI = true, bool SP2 = true, int F8 = -1>
__device__ __forceinline__ void gemm_phase_gather(PG8_LAS unsigned char* lds, const Gemm g, const Sched& S, const Epi& E, const int tid_in) {
    int tid = tid_in; asm volatile("" : "+v"(tid));
    static_assert(SP2, "gather form: SP2 loop only");
    const int wid = __builtin_amdgcn_readfirstlane(tid >> 6), lane = tid & 63, wr = wid >> 2, wc = wid & 3, fr = lane & 15, fq = lane >> 4;
    int K = g.K; asm volatile("" : "+s"(K)); const int nt = K / BK;
    unsigned voffA[2], voffB[2];
#pragma unroll
    for (int i = 0; i < 2; ++i) { int R, C; stage_rc(tid * 16 + i * 8192, R, C); const int Rb = Epi::PERM ? ((R & ~31) + perm32(R & 31)) : R;
        voffA[i] = (unsigned)(R * K + C) * 2u; voffB[i] = (unsigned)(Rb * K + C) * 2u; }
    int gR, gC; stage_rc(tid * 16, gR, gC);
    unsigned vG[2][2], vN[2][2];
    const size_t kstep = (size_t)(BK * 2);
    const size_t hstep = (size_t)HALF * K * 2;
    const size_t tstep = 2 * hstep;
    const unsigned ldsw = (unsigned)wid * 1024u;
    const int aoff = lds_byte(wr * 64 + fr, fq * 8), boff = lds_byte(wc * 32 + fr, fq * 8);
#define PG8_SA(b, h) (((b) * 2 + (h)) * HTB)
#define PG8_SB(b, h) ((4 + (b) * 2 + (h)) * HTB)
#define PG8_STAGE(bufoff, gbase, voff) do { _Pragma("unroll") for (int _i = 0; _i < 2; ++_i) { unsigned vo_ = (voff)[_i]; asm volatile("" : "+v"(vo_));   \
        __builtin_amdgcn_global_load_lds((const unsigned*)((const char*)(gbase) + vo_), (PG8_LAS unsigned*)(lds + (bufoff) + ldsw + _i * 8192), 16, 0, 0); } } while (0)
#define PG8_LDA(dst, b, h) do { _Pragma("unroll") for (int m = 0; m < 4; ++m) { const bf16x8 x0_ = *(const PG8_LAS bf16x8*)(lds + PG8_SA(b, h) + aoff + m * 2048), x1_ = *(const PG8_LAS bf16x8*)(lds + PG8_SA(b, h) + aoff + m * 2048 + 1024); \
        if constexpr (F8 >= 0) dst##8[m] = PG8_CAT(x0_, x1_); else { dst[m][0] = x0_; dst[m][1] = x1_; } } } while (0)
#define PG8_LDB(dst, b, h) do { _Pragma("unroll") for (int n = 0; n < 2; ++n) { const bf16x8 x0_ = *(const PG8_LAS bf16x8*)(lds + PG8_SB(b, h) + boff + n * 2048), x1_ = *(const PG8_LAS bf16x8*)(lds + PG8_SB(b, h) + boff + n * 2048 + 1024); \
        if constexpr (F8 >= 0) dst##8[n] = PG8_CAT(x0_, x1_); else { dst[n][0] = x0_; dst[n][1] = x1_; } } } while (0)
#define PG8_CAT(x0, x1) ({ const v4i_t lo_ = __builtin_bit_cast(v4i_t, x0), hi_ = __builtin_bit_cast(v4i_t, x1); (v8i_t){lo_[0], lo_[1], lo_[2], lo_[3], hi_[0], hi_[1], hi_[2], hi_[3]}; })
#define PG8_MMA(ai, bj, At, Bt) do { __builtin_amdgcn_s_setprio(1); _Pragma("unroll") for (int m = 0; m < 4; ++m) _Pragma("unroll") for (int n = 0; n < 2; ++n) { \
        if constexpr (F8 >= 0) acc[ai][bj][m][n] = __builtin_amdgcn_mfma_scale_f32_16x16x128_f8f6f4(Bt##8[n], At##8[m], acc[ai][bj][m][n], 0, 0, 0, 0x7f7f7f7f, 0, (127 - F8) * 0x01010101); \
        else { _Pragma("unroll") for (int k = 0; k < 2; ++k) acc[ai][bj][m][n] = __builtin_amdgcn_mfma_f32_16x16x32_bf16(Bt[n][k], At[m][k], acc[ai][bj][m][n], 0, 0, 0); } } \
        __builtin_amdgcn_s_setprio(0); } while (0)
#define PG8_WAIT_V(n) asm volatile("s_waitcnt vmcnt(" #n ")" ::: "memory")
#define PG8_WAIT_L(n) asm volatile("s_waitcnt lgkmcnt(" #n ")" ::: "memory")
#define PG8_BAR __builtin_amdgcn_s_barrier()
#define PG8_SCHED __builtin_amdgcn_sched_barrier(0)
    Unit cur, nxt; int ui = 0;
    if (!S.next(0, cur)) return;
    f32x4 acc[2][2][4][2];
#pragma unroll
    for (int a = 0; a < 2; ++a)
#pragma unroll
        for (int b = 0; b < 2; ++b)
#pragma unroll
            for (int m = 0; m < 4; ++m)
#pragma unroll
                for (int n = 0; n < 2; ++n) acc[a][b][m][n] = (f32x4){0.f, 0.f, 0.f, 0.f};
    bf16x8 At[4][2], B0[2][2], B1[2][2]; v8i_t At8[4], B08[2], B18[2];
    const char* cA = (const char*)g.A; const char* cB = (const char*)g.Bt + (size_t)cur.pn * tstep;
    S.a_ready(cur);
#pragma unroll
    for (int h = 0; h < 2; ++h)
#pragma unroll
        for (int i = 0; i < 2; ++i) vG[h][i] = (unsigned)S.tok(cur, h * HALF + gR + 64 * i) * (unsigned)(K * 2) + (unsigned)(gC * 2);
    if constexpr (SP2) {
        PG8_STAGE(PG8_SB(0, 0), cB, voffB); PG8_STAGE(PG8_SB(0, 1), cB + hstep, voffB); PG8_STAGE(PG8_SA(0, 0), cA, vG[0]); PG8_STAGE(PG8_SA(0, 1), cA, vG[1]);
        if (wr == 1) PG8_BAR;
        PG8_WAIT_V(2); PG8_BAR;
        PG8_STAGE(PG8_SB(1, 0), cB + kstep, voffB); PG8_STAGE(PG8_SA(1, 0), cA + kstep, vG[0]); PG8_STAGE(PG8_SB(1, 1), cB + hstep + kstep, voffB);
        PG8_WAIT_V(6); PG8_BAR;
    } else {
        PG8_STAGE(PG8_SB(0, 0), cB, voffB); PG8_STAGE(PG8_SA(0, 0), cA, voffA); PG8_STAGE(PG8_SB(0, 1), cB + hstep, voffB); PG8_STAGE(PG8_SA(0, 1), cA + hstep, voffA);
        if (wr == 1) PG8_BAR;
        PG8_WAIT_V(4); PG8_BAR;
        PG8_STAGE(PG8_SB(1, 0), cB + kstep, voffB); PG8_STAGE(PG8_SA(1, 0), cA + kstep, voffA); PG8_STAGE(PG8_SB(1, 1), cB + hstep + kstep, voffB);
        PG8_WAIT_V(6); PG8_BAR;
    }
    for (;;) {
        const bool has_next = S.next(ui + 1, nxt);
        const char* nA = cA; const char* nB = has_next ? (const char*)g.Bt + (size_t)nxt.pn * tstep : cB;
        int tokN[2][2] = {{0, 0}, {0, 0}};
        if (has_next) {
#pragma unroll
            for (int h = 0; h < 2; ++h)
#pragma unroll
                for (int i = 0; i < 2; ++i) tokN[h][i] = S.tok(nxt, h * HALF + gR + 64 * i); }
        for (int t = 0; t < nt; t += 2) {
            const bool last = (t == nt - 2);
            const char* a1 = cA + (size_t)(t + 1) * kstep;
            const char* a2 = last ? nA : cA + (size_t)(t + 2) * kstep; const char* b2 = last ? nB : cB + (size_t)(t + 2) * kstep;
            const char* a3 = a2 + kstep; const char* b3 = b2 + kstep;
            if (last && has_next) { S.a_ready(nxt);
#pragma unroll
                for (int h = 0; h < 2; ++h)
#pragma unroll
                    for (int i = 0; i < 2; ++i) vN[h][i] = (unsigned)tokN[h][i] * (unsigned)(K * 2) + (unsigned)(gC * 2); }
            if constexpr (SP2) {
            PG8_LDB(B0, 0, 0); PG8_LDB(B1, 0, 1); PG8_SCHED; PG8_LDA(At, 0, 0); PG8_STAGE(PG8_SA(1, 1), a1, vG[1]);
            if (last && has_next) { vG[0][0] = vN[0][0]; vG[0][1] = vN[0][1]; vG[1][0] = vN[1][0]; vG[1][1] = vN[1][1]; }
            PG8_WAIT_V(8); PG8_WAIT_L(0); PG8_BAR; PG8_MMA(0, 0, At, B0); PG8_MMA(0, 1, At, B1); PG8_BAR; PG8_SCHED;
            PG8_LDA(At, 0, 1); PG8_STAGE(PG8_SB(0, 0), b2, voffB); PG8_STAGE(PG8_SB(0, 1), b2 + hstep, voffB); PG8_STAGE(PG8_SA(0, 0), a2, vG[0]);
            PG8_WAIT_V(8); PG8_WAIT_L(0); PG8_BAR; PG8_MMA(1, 0, At, B0); PG8_MMA(1, 1, At, B1); PG8_BAR; PG8_SCHED;
            PG8_LDB(B0, 1, 0); PG8_LDB(B1, 1, 1); PG8_SCHED; PG8_LDA(At, 1, 0); PG8_STAGE(PG8_SA(0, 1), a2, vG[1]);
            PG8_WAIT_V(8); PG8_WAIT_L(0); PG8_BAR; PG8_MMA(0, 0, At, B0); PG8_MMA(0, 1, At, B1); PG8_BAR; PG8_SCHED;
            PG8_LDA(At, 1, 1); PG8_STAGE(PG8_SB(1, 0), b3, voffB); PG8_STAGE(PG8_SB(1, 1), b3 + hstep, voffB); PG8_STAGE(PG8_SA(1, 0), a3, vG[0]);
            PG8_WAIT_V(8); PG8_WAIT_L(0); PG8_BAR; PG8_MMA(1, 0, At, B0); PG8_MMA(1, 1, At, B1); PG8_BAR; PG8_SCHED;
            } else {
            PG8_LDB(B0, 0, 0); PG8_SCHED; PG8_LDA(At, 0, 0); PG8_STAGE(PG8_SA(1, 1), a1 + hstep, voffA);
            PG8_WAIT_L(8); PG8_BAR; PG8_WAIT_L(0); PG8_MMA(0, 0, At, B0); PG8_BAR; PG8_SCHED;
            PG8_LDB(B1, 0, 1); PG8_STAGE(PG8_SB(0, 0), b2, voffB);
            PG8_BAR; PG8_WAIT_L(0); PG8_MMA(0, 1, At, B1); PG8_BAR;
            PG8_LDA(At, 0, 1); PG8_STAGE(PG8_SA(0, 0), a2, voffA);
            PG8_BAR; PG8_WAIT_L(0); PG8_MMA(1, 0, At, B0); PG8_BAR; PG8_SCHED;
            PG8_STAGE(PG8_SB(0, 1), b2 + hstep, voffB);
            PG8_WAIT_V(6); PG8_BAR; PG8_MMA(1, 1, At, B1); PG8_BAR;
            PG8_LDB(B0, 1, 0); PG8_SCHED; PG8_LDA(At, 1, 0); PG8_STAGE(PG8_SA(0, 1), a2 + hstep, voffA);
            PG8_WAIT_L(8); PG8_BAR; PG8_WAIT_L(0); PG8_MMA(0, 0, At, B0); PG8_BAR; PG8_SCHED;
            PG8_LDB(B1, 1, 1); PG8_STAGE(PG8_SB(1, 0), b3, voffB);
            PG8_BAR; PG8_WAIT_L(0); PG8_MMA(0, 1, At, B1); PG8_BAR;
            PG8_LDA(At, 1, 1); PG8_STAGE(PG8_SA(1, 0), a3, voffA);
            PG8_BAR; PG8_WAIT_L(0); PG8_MMA(1, 0, At, B0); PG8_BAR; PG8_SCHED;
            PG8_STAGE(PG8_SB(1, 1), b3 + hstep, voffB);
            PG8_WAIT_V(6); PG8_BAR; PG8_MMA(1, 1, At, B1); PG8_BAR;
            }
        }
        if constexpr (ALIGN_EPI) { if (wr == 0) PG8_BAR; }
        if constexpr (!Epi::AFTER_DRAIN) { E(acc, cur, wr, wc, fr, fq); S.done(cur); }
        if (!has_next) break;
#pragma unroll
        for (int a = 0; a < 2; ++a)
#pragma unroll
            for (int b = 0; b < 2; ++b)
#pragma unroll
                for (int m = 0; m < 4; ++m)
#pragma unroll
                    for (int n = 0; n < 2; ++n) acc[a][b][m][n] = (f32x4){0.f, 0.f, 0.f, 0.f};
        cur = nxt; cA = nA; cB = nB; ++ui;
        if constexpr (ALIGN_EPI) { if (wr == 1) PG8_BAR; }
    }
    PG8_WAIT_V(0);
    if constexpr (!ALIGN_EPI) { if (wr == 0) PG8_BAR; }
    PG8_BAR;
    if constexpr (Epi::AFTER_DRAIN) { E.fused(acc, cur, wr, wc, fr, fq, lds, wid, lane); S.done(cur); }
#undef PG8_SA
#undef PG8_SB
#undef PG8_STAGE
#undef PG8_LDA
#undef PG8_LDB
#undef PG8_MMA
#undef PG8_WAIT_V
#undef PG8_WAIT_L
#undef PG8_BAR
#undef PG8_SCHED
}
}
namespace att {
typedef unsigned short bf16;
using bf16x8 = __attribute__((ext_vector_type(8))) short;
using s16x4  = __attribute__((ext_vector_type(4))) short;
using f32x16 = __attribute__((ext_vector_type(16))) float;
using u32x4  = __attribute__((ext_vector_type(4))) unsigned;
using f32x4_t = __attribute__((ext_vector_type(4))) float;
constexpr int NW = 8, QBLK = 32, KVBLK = 64, SEQ = 4096;
constexpr int LDQ = 1536, LDKV = 2048, LDO = 1024;
constexpr int SHM_VT = 128 * 80, SHM_K8 = 64 * 208;
constexpr int OFF_V = 0, OFF_K8 = 3 * SHM_VT, OFF_WS = OFF_K8 + 2 * SHM_K8, OFF_QG = 60416, LDS_BYTES = OFF_QG + 768;
typedef int v8i32 __attribute__((ext_vector_type(8)));
typedef int v4i32 __attribute__((ext_vector_type(4)));
typedef int v2i32 __attribute__((ext_vector_type(2)));
constexpr int T_TOK = 8 * SEQ;
#define ASBAR() __builtin_amdgcn_sched_barrier(0)
__device__ __forceinline__ int crow(int r, int hi) { return (r & 3) + 8 * (r >> 2) + 4 * hi; }
__device__ __forceinline__ unsigned cvtpk(float lo, float hi) { unsigned r; asm volatile("v_cvt_pk_bf16_f32 %0, %1, %2" : "=v"(r) : "v"(lo), "v"(hi)); return r; }
__device__ __forceinline__ float bf2f(unsigned short b) { return __uint_as_float(((unsigned)b) << 16); }
template <bool SHIFT> __device__ __forceinline__ void smA(f32x16& p0, float negm) { for (int r = 0; r < 16; ++r) p0[r] = __builtin_amdgcn_exp2f(SHIFT ? p0[r] + negm : p0[r]); }
template <bool SHIFT> __device__ __forceinline__ void smB(f32x16& p0, f32x16& p1, float& l_reg, v8i32& p8, float negm) {
  for (int r = 0; r < 16; ++r) p1[r] = __builtin_amdgcn_exp2f(SHIFT ? p1[r] + negm : p1[r]);
  float ps = 0; for (int r = 0; r < 16; ++r) ps += p0[r]; for (int r = 0; r < 16; ++r) ps += p1[r];
  l_reg += ps;
#pragma unroll
  for (int w = 0; w < 4; ++w) { int a = 0, bq = 0;
    a = __builtin_amdgcn_cvt_pk_bf8_f32(p0[4 * w], p0[4 * w + 1], a, false); a = __builtin_amdgcn_cvt_pk_bf8_f32(p0[4 * w + 2], p0[4 * w + 3], a, true);
    bq = __builtin_amdgcn_cvt_pk_bf8_f32(p1[4 * w], p1[4 * w + 1], bq, false); bq = __builtin_amdgcn_cvt_pk_bf8_f32(p1[4 * w + 2], p1[4 * w + 3], bq, true);
    p8[w] = a; p8[4 + w] = bq; }
}
template <bool SHIFT> __device__ __forceinline__ void qkt(f32x16& p0, f32x16& p1, const char* K8, const v8i32* q8, float negm, int r32, int hi) {
  p0 = f32x16{}; p1 = f32x16{};
#define K8RD(m, half, part) (*reinterpret_cast<const v4i32*>(K8 + ((half) * 32 + r32) * 208 + (m) * 64 + hi * 32 + (part) * 16))
#define K8FR(m, half) ({ const v4i32 lo_ = K8RD(m, half, 0), hi_ = K8RD(m, half, 1); (v8i32){lo_[0], lo_[1], lo_[2], lo_[3], hi_[0], hi_[1], hi_[2], hi_[3]}; })
  v8i32 a0 = K8FR(0, 0), a1 = K8FR(0, 1), b0 = K8FR(1, 0), b1 = K8FR(1, 1);
  ASBAR();
  p0 = __builtin_amdgcn_mfma_scale_f32_32x32x64_f8f6f4(a0, q8[0], p0, 0, 0, 0, 0x7f7f7f7f, 0, 0x7f7f7f7f);
  p1 = __builtin_amdgcn_mfma_scale_f32_32x32x64_f8f6f4(a1, q8[0], p1, 0, 0, 0, 0x7f7f7f7f, 0, 0x7f7f7f7f);
  a0 = K8FR(2, 0); a1 = K8FR(2, 1);
  ASBAR();
  p0 = __builtin_amdgcn_mfma_scale_f32_32x32x64_f8f6f4(b0, q8[1], p0, 0, 0, 0, 0x7f7f7f7f, 0, 0x7f7f7f7f);
  p1 = __builtin_amdgcn_mfma_scale_f32_32x32x64_f8f6f4(b1, q8[1], p1, 0, 0, 0, 0x7f7f7f7f, 0, 0x7f7f7f7f);
  ASBAR();
  p0 = __builtin_amdgcn_mfma_scale_f32_32x32x64_f8f6f4(a0, q8[2], p0, 0, 0, 0, 0x7f7f7f7f, 0, 0x7f7f7f7f);
  p1 = __builtin_amdgcn_mfma_scale_f32_32x32x64_f8f6f4(a1, q8[2], p1, 0, 0, 0, 0x7f7f7f7f, 0, 0x7f7f7f7f);
  ASBAR();
#undef K8RD
#undef K8FR
}
__device__ __forceinline__ void pv_d0(f32x16* o, const char* VT, v8i32 p8, int r32, int hi) {
#define VTFR(d0) ({ const v4i32 lo_ = *reinterpret_cast<const v4i32*>(VT + ((d0) * 32 + r32) * 80 + hi * 32), hi_ = *reinterpret_cast<const v4i32*>(VT + ((d0) * 32 + r32) * 80 + hi * 32 + 16); (v8i32){lo_[0], lo_[1], lo_[2], lo_[3], hi_[0], hi_[1], hi_[2], hi_[3]}; })
#define PVMMA(d0, fr) o[d0] = __builtin_amdgcn_mfma_scale_f32_32x32x64_f8f6f4(fr, p8, o[d0], 0  , 1  , 0, 0x7f7f7f7f, 0, 0x7f7f7f7f)
  v8i32 fa = VTFR(0), fb = VTFR(1);
  ASBAR();
  PVMMA(0, fa); fa = VTFR(2); ASBAR();
  PVMMA(1, fb); fb = VTFR(3); ASBAR();
  PVMMA(2, fa); PVMMA(3, fb); ASBAR();
#undef VTFR
#undef PVMMA
}
template <bool SHIFT> __device__ __forceinline__ bool attn_unit(int b, int h, int s0, const bf16* Qraw, const unsigned char* __restrict__ VT8g, const unsigned char* __restrict__ K8g, const unsigned char* __restrict__ KP8g, bf16* __restrict__ O,
                                          const float* rope, const float* qg, float smaxC, char* lds, int tid) {
  asm volatile("" : "+v"(tid));
  const int wid = __builtin_amdgcn_readfirstlane(tid >> 6), lane = tid & 63, r32 = lane & 31, hi = lane >> 5;
  asm volatile("" : "+s"(qg));
  char* V_lds = lds + OFF_V; char* K8_lds = lds + OFF_K8;
  float* ws = (float*)(lds + OFF_WS) + wid * 64; float* li_l = ws;
  constexpr float C = 0.072168783648703220f * 1.4426950408889634f;
  const char* Vg = (const char*)(VT8g + (size_t)h * 128 * T_TOK + (size_t)b * SEQ); const char* Kg = (const char*)(K8g + ((long)b * SEQ * 8 + h) * 128); const char* Pg = (const char*)(KP8g + (long)b * SEQ * 64);
  const int vc = tid >> 2, vq = tid & 3, vst = vc * 80 + 16 * (vq >> 1) + 8 * (vq & 1); const unsigned gvt = (unsigned)vc * (unsigned)T_TOK + 16u * (unsigned)vq;
  const int kr = tid >> 3, kc = tid & 7, kst = kr * 208 + kc * 16; const unsigned gk8 = (unsigned)(kr * 1024 + kc * 16);
  const int pr = (tid & 255) >> 2, pc = tid & 3, pst = pr * 208 + 128 + pc * 16; const unsigned gp8 = (unsigned)(pr * 64 + pc * 16);
  v4i32 s_v, s_k, s_p;
#define SLOAD(k0) do { s_v = *reinterpret_cast<const v4i32*>(Vg + (size_t)(k0) + gvt); \
    s_k = *reinterpret_cast<const v4i32*>(Kg + (size_t)(k0) * 1024 + gk8); if (tid < 256) s_p = *reinterpret_cast<const v4i32*>(Pg + (size_t)(k0) * 64 + gp8); } while (0)
#define SWRITE(kbuf, vbuf_) do { { v2i32 a_ = {s_v[0], s_v[2]}, b_ = {s_v[1], s_v[3]}; *(v2i32*)(V_lds + (vbuf_) * SHM_VT + vst) = a_; *(v2i32*)(V_lds + (vbuf_) * SHM_VT + vst + 32) = b_; } \
    *(v4i32*)(K8_lds + (kbuf) * SHM_K8 + kst) = s_k; if (tid < 256) *(v4i32*)(K8_lds + (kbuf) * SHM_K8 + pst) = s_p; } while (0)
  SLOAD(0);
  v8i32 q8[3];
  {
    typedef __attribute__((address_space(1))) const v4i32 gv4i; typedef __attribute__((address_space(1))) const f32x4_t gf32x4; typedef float f32x2_t __attribute__((ext_vector_type(2)));
    const long trow = (long)b * SEQ + s0 + wid * QBLK + r32;
    const unsigned qo = (unsigned)(trow * LDQ + h * 192), ro = (unsigned)(trow * 256), go = (unsigned)(hi * 128);
#define rp4_(i) (*(gf32x4*)((const char*)rope + ro + (i) * 16))
    typedef __attribute__((address_space(3))) const f32x4_t lf32x4; const __attribute__((address_space(3))) char* qgl = (const __attribute__((address_space(3))) char*)(lds + OFF_QG);
#define qgn_(i) (*(lf32x4*)(qgl + go + (i) * 16))
#define qgr_(i) (*(lf32x4*)(qgl + 512 + (i) * 16))
#define F8LO(w) __builtin_amdgcn_cvt_pk_f32_fp8((w), false)
#define F8HI(w) __builtin_amdgcn_cvt_pk_f32_fp8((w), true)
    v4i32 rn_[2][2], rr_[4];
#pragma unroll
    for (int m = 0; m < 2; ++m)
#pragma unroll
      for (int part = 0; part < 2; ++part) rn_[m][part] = *(gv4i*)((const char*)Qraw + qo + 64 * m + 32 * hi + 16 * part);
#pragma unroll
    for (int c = 0; c < 4; ++c) rr_[c] = *(gv4i*)((const char*)Qraw + qo + 128 + 16 * c);
    float ssn = 0.f, ssp = 0.f;
#pragma unroll
    for (int m = 0; m < 2; ++m)
#pragma unroll
      for (int part = 0; part < 2; ++part)
#pragma unroll
        for (int wi = 0; wi < 4; ++wi) { const f32x2_t a = F8LO(rn_[m][part][wi]), c2 = F8HI(rn_[m][part][wi]); ssn += (a.x * a.x + a.y * a.y) + (c2.x * c2.x + c2.y * c2.y); }
#pragma unroll
    for (int c = 0; c < 4; ++c)
#pragma unroll
      for (int wi = 0; wi < 4; ++wi) { const f32x2_t a = F8LO(rr_[c][wi]), c2 = F8HI(rr_[c][wi]); ssp += (a.x * a.x + a.y * a.y) + (c2.x * c2.x + c2.y * c2.y); }
    ssn += __shfl_xor(ssn, 32);
    const float rn = rsqrtf(ssn * (1.f / 128.f) + 64e-6f) * C, rp = rsqrtf(ssp * (1.f / 64.f) + 64e-6f) * C;
#pragma unroll
    for (int m = 0; m < 2; ++m)
#pragma unroll
      for (int part = 0; part < 2; ++part)
#pragma unroll
        for (int wi = 0; wi < 4; ++wi) { const f32x4_t g = qgn_(16 * m + 4 * part + wi); const f32x2_t a = F8LO(rn_[m][part][wi]), c2 = F8HI(rn_[m][part][wi]);
          int w0 = 0; w0 = __builtin_amdgcn_cvt_pk_fp8_f32(a.x * rn * g[0], a.y * rn * g[1], w0, false); w0 = __builtin_amdgcn_cvt_pk_fp8_f32(c2.x * rn * g[2], c2.y * rn * g[3], w0, true);
          q8[m][4 * part + wi] = w0; }
#pragma unroll
    for (int wh = 0; wh < 4; ++wh) { f32x4_t cs4[4];
#pragma unroll
    for (int i = 0; i < 4; ++i) cs4[i] = rp4_(4 * wh + i);
#pragma unroll
    for (int wi = 2 * wh; wi < 2 * wh + 2; ++wi) {
      const int w1r = rr_[wi >> 2][wi & 3], w2r = rr_[2 + (wi >> 2)][wi & 3];
      const f32x4_t g1 = qgr_(wi), g2 = qgr_(8 + wi), csA = cs4[2 * (wi - 2 * wh)], csB = cs4[2 * (wi - 2 * wh) + 1];
      const f32x2_t x1a = F8LO(w1r), x1b = F8HI(w1r), x2a = F8LO(w2r), x2b = F8HI(w2r);
      const float x1[4] = {x1a.x * rp * g1[0], x1a.y * rp * g1[1], x1b.x * rp * g1[2], x1b.y * rp * g1[3]}, x2[4] = {x2a.x * rp * g2[0], x2a.y * rp * g2[1], x2b.x * rp * g2[2], x2b.y * rp * g2[3]};
      const float cs[4] = {csA[0], csA[2], csB[0], csB[2]}, sn[4] = {csA[1], csA[3], csB[1], csB[3]}; float ov[4];
#pragma unroll
      for (int j = 0; j < 4; ++j) ov[j] = hi == 0 ? (x1[j] * cs[j] - x2[j] * sn[j]) : (x1[j] * sn[j] + x2[j] * cs[j]);
      int w0 = 0; w0 = __builtin_amdgcn_cvt_pk_fp8_f32(ov[0], ov[1], w0, false); w0 = __builtin_amdgcn_cvt_pk_fp8_f32(ov[2], ov[3], w0, true);
      asm volatile("" : "+v"(w0) :: "memory"); q8[2][wi] = w0; } }
#undef rp4_
#undef qgn_
#undef qgr_
#undef F8LO
#undef F8HI
  }
  const float negm = 15.0f - smaxC;
  float l_reg = 0.f; f32x16 o[4] = {};
  constexpr int NT = SEQ / KVBLK;
  v8i32 p8;
  SWRITE(0, 0); __syncthreads(); SLOAD(KVBLK);
  if (wid < 4) {
    for (int j = 0, kb = 0, vbuf = 0, vnx = 1; j < NT; ++j) {
      f32x16 p0, p1;
      qkt<SHIFT>(p0, p1, K8_lds + kb * SHM_K8, q8, negm, r32, hi);
      smA<SHIFT>(p0, negm); smB<SHIFT>(p0, p1, l_reg, p8, negm); ASBAR();
      pv_d0(o, V_lds + vbuf * SHM_VT, p8, r32, hi);
      if (j + 1 < NT) SWRITE(kb ^ 1, vnx);
      __syncthreads();
      if (j + 2 < NT) SLOAD((j + 2) * KVBLK);
      kb ^= 1; vbuf = vnx; vnx = vnx == 2 ? 0 : vnx + 1;
    }
  } else {
    int vprev = 0;
    for (int j = 0, kb = 0, vbuf = 0, vnx = 1; j < NT; ++j) {
      f32x16 p0, p1;
      if (j > 0) pv_d0(o, V_lds + vprev * SHM_VT, p8, r32, hi);
      qkt<SHIFT>(p0, p1, K8_lds + kb * SHM_K8, q8, negm, r32, hi);
      smA<SHIFT>(p0, negm); smB<SHIFT>(p0, p1, l_reg, p8, negm); ASBAR();
      if (j + 1 < NT) SWRITE(kb ^ 1, vnx);
      __syncthreads();
      if (j + 2 < NT) SLOAD((j + 2) * KVBLK);
      kb ^= 1; vprev = vbuf; vbuf = vnx; vnx = vnx == 2 ? 0 : vnx + 1;
    }
    pv_d0(o, V_lds + vprev * SHM_VT, p8, r32, hi);
    __builtin_amdgcn_s_setprio(0);
  }
  int lane_e = lane; asm volatile("" : "+v"(lane_e));
  const int r32e = lane_e & 31, hie = lane_e >> 5;
  l_reg += __shfl_xor(l_reg, 32);
  int* satf = (int*)(lds + OFF_WS + NW * 64 * 4);
  if (!SHIFT) { const bool sat = __any(l_reg >= 57344.f); if (lane_e == 0) satf[wid] = sat ? 1 : 0; }
  const float inv = 32.f * __builtin_amdgcn_rcpf(l_reg);
  char* Ow = (char*)O + ((long)b * SEQ + s0 + wid * QBLK + r32e) * LDO + h * 128 + hie * 16;
#pragma unroll
  for (int d0 = 0; d0 < 4; ++d0) { unsigned w[2][2];
#pragma unroll
    for (int gp = 0; gp < 2; ++gp) { int wa = 0, wb = 0;
      wa = __builtin_amdgcn_cvt_pk_fp8_f32(o[d0][8 * gp + 0] * inv, o[d0][8 * gp + 1] * inv, wa, false); wa = __builtin_amdgcn_cvt_pk_fp8_f32(o[d0][8 * gp + 2] * inv, o[d0][8 * gp + 3] * inv, wa, true);
      wb = __builtin_amdgcn_cvt_pk_fp8_f32(o[d0][8 * gp + 4] * inv, o[d0][8 * gp + 5] * inv, wb, false); wb = __builtin_amdgcn_cvt_pk_fp8_f32(o[d0][8 * gp + 6] * inv, o[d0][8 * gp + 7] * inv, wb, true);
      const auto sw = __builtin_amdgcn_permlane32_swap((unsigned)wa, (unsigned)wb, false, false);
      w[gp][0] = sw[0]; w[gp][1] = sw[1]; }
    const auto s0_ = __builtin_amdgcn_permlane32_swap(w[0][0], w[1][0], false, false), s1_ = __builtin_amdgcn_permlane32_swap(w[0][1], w[1][1], false, false);
    v4i32 w4; w4[0] = (int)s0_[0]; w4[1] = (int)s1_[0]; w4[2] = (int)s0_[1]; w4[3] = (int)s1_[1]; *(v4i32*)(Ow + 32 * d0) = w4; }
  __syncthreads();
  bool redo = false;
  if (!SHIFT) redo = (satf[0] | satf[1] | satf[2] | satf[3] | satf[4] | satf[5] | satf[6] | satf[7]) != 0;
  return redo;
#undef SLOAD
#undef SWRITE
}
}
#ifndef HD
#define HD __device__ __forceinline__
#endif
struct c32 { float x, y; };
HD c32 cmk(float x, float y) { c32 r; r.x = x; r.y = y; return r; }
HD c32 cadd(c32 a, c32 b) { return cmk(a.x + b.x, a.y + b.y); }
HD c32 csub(c32 a, c32 b) { return cmk(a.x - b.x, a.y - b.y); }
HD c32 cmul(c32 a, c32 b) { return cmk(a.x * b.x - a.y * b.y, a.x * b.y + a.y * b.x); }
HD c32 cmulc(c32 a, c32 b) { return cmk(a.x * b.x + a.y * b.y, a.y * b.x - a.x * b.y); }
constexpr int BR4(int i) { return ((i & 1) << 3) | ((i & 2) << 1) | ((i & 4) >> 1) | ((i & 8) >> 3); }
template <int SGN, int J> HD c32 tw16(c32 a) {
    if constexpr (J == 0) return a;
    else if constexpr (J == 4) return SGN < 0 ? cmk(a.y, -a.x) : cmk(-a.y, a.x);
    else {
        constexpr float CS[8] = {1.f, 0.92387953251128674f, 0.70710678118654752f, 0.38268343236508977f, 0.f, -0.38268343236508977f, -0.70710678118654752f, -0.92387953251128674f};
        constexpr float SN[8] = {0.f, 0.38268343236508977f, 0.70710678118654752f, 0.92387953251128674f, 1.f, 0.92387953251128674f, 0.70710678118654752f, 0.38268343236508977f};
        constexpr float c = CS[J], s = SN[J];
        if constexpr (SGN < 0) return cmk(a.x * c + a.y * s, a.y * c - a.x * s);
        else return cmk(a.x * c - a.y * s, a.y * c + a.x * s);
    }
}
#define FFT_BF(i, j, J) { const c32 u_ = v[i], w_ = v[j]; v[i] = cadd(u_, w_); v[j] = tw16<SGN, J>(csub(u_, w_)); }
template <int SGN> HD void dft16_dif(c32 (&v)[16]) {
    FFT_BF(0, 8, 0) FFT_BF(1, 9, 1) FFT_BF(2, 10, 2) FFT_BF(3, 11, 3) FFT_BF(4, 12, 4) FFT_BF(5, 13, 5) FFT_BF(6, 14, 6) FFT_BF(7, 15, 7)
    FFT_BF(0, 4, 0) FFT_BF(1, 5, 2) FFT_BF(2, 6, 4) FFT_BF(3, 7, 6) FFT_BF(8, 12, 0) FFT_BF(9, 13, 2) FFT_BF(10, 14, 4) FFT_BF(11, 15, 6)
    FFT_BF(0, 2, 0) FFT_BF(1, 3, 4) FFT_BF(4, 6, 0) FFT_BF(5, 7, 4) FFT_BF(8, 10, 0) FFT_BF(9, 11, 4) FFT_BF(12, 14, 0) FFT_BF(13, 15, 4)
    FFT_BF(0, 1, 0) FFT_BF(2, 3, 0) FFT_BF(4, 5, 0) FFT_BF(6, 7, 0) FFT_BF(8, 9, 0) FFT_BF(10, 11, 0) FFT_BF(12, 13, 0) FFT_BF(14, 15, 0)
}
#undef FFT_BF
#define FFT_BT(i, j, J) { const c32 u_ = v[i], w_ = tw16<SGN, J>(v[j]); v[i] = cadd(u_, w_); v[j] = csub(u_, w_); }
template <int SGN> HD void dft16_dit(c32 (&v)[16]) {
    FFT_BT(0, 1, 0) FFT_BT(2, 3, 0) FFT_BT(4, 5, 0) FFT_BT(6, 7, 0) FFT_BT(8, 9, 0) FFT_BT(10, 11, 0) FFT_BT(12, 13, 0) FFT_BT(14, 15, 0)
    FFT_BT(0, 2, 0) FFT_BT(1, 3, 4) FFT_BT(4, 6, 0) FFT_BT(5, 7, 4) FFT_BT(8, 10, 0) FFT_BT(9, 11, 4) FFT_BT(12, 14, 0) FFT_BT(13, 15, 4)
    FFT_BT(0, 4, 0) FFT_BT(1, 5, 2) FFT_BT(2, 6, 4) FFT_BT(3, 7, 6) FFT_BT(8, 12, 0) FFT_BT(9, 13, 2) FFT_BT(10, 14, 4) FFT_BT(11, 15, 6)
    FFT_BT(0, 8, 0) FFT_BT(1, 9, 1) FFT_BT(2, 10, 2) FFT_BT(3, 11, 3) FFT_BT(4, 12, 4) FFT_BT(5, 13, 5) FFT_BT(6, 14, 6) FFT_BT(7, 15, 7)
}
#undef FFT_BT
constexpr int FFT_PS = 272;
constexpr int FFT_EX_ELEMS = 16 * FFT_PS;
template <class EX> HD void fft_fwd_a(c32 (&v)[16], const c32* T1, EX ex, int tid) {
    dft16_dif<-1>(v);
#pragma unroll
    for (int p = 0; p < 16; ++p) { ex[p * FFT_PS + tid] = cmul(v[BR4(p)], T1[256 * p]); if ((p & 3) == 3) __builtin_amdgcn_sched_barrier(0); }
}
template <class EX> HD void fft_fwd_b(c32 (&v)[16], const c32* T2, EX exr, EX ex, int tid) {
    const int p2 = tid >> 4, c = tid & 15;
#pragma unroll
    for (int b = 0; b < 16; ++b) v[b] = exr[p2 * FFT_PS + 16 * b + c];
    dft16_dif<-1>(v);
#pragma unroll
    for (int q = 0; q < 16; ++q) ex[p2 * FFT_PS + q * 16 + ((c + q) & 15)] = cmul(v[BR4(q)], T2[q]);
}
template <class EX> HD void fft_fwd_c(c32 (&v)[16], EX ex, int tid) {
    const int p2 = tid >> 4, q = tid & 15;
#pragma unroll
    for (int c = 0; c < 16; ++c) v[c] = ex[p2 * FFT_PS + q * 16 + ((c + q) & 15)];
    dft16_dif<-1>(v);
}
template <class EX> HD void fft_inv_a(c32 (&v)[16], EX ex, int tid) {
    const int p = tid >> 4, q = tid & 15;
    dft16_dit<+1>(v);
#pragma unroll
    for (int c = 0; c < 16; ++c) ex[p * FFT_PS + q * 16 + ((c + q) & 15)] = v[c];
}
template <class EX> HD void fft_inv_b(c32 (&v)[16], const c32* T2, EX exr, EX ex, int tid) {
    const int p = tid >> 4, c = tid & 15;
#pragma unroll
    for (int q = 0; q < 16; ++q) v[BR4(q)] = cmulc(exr[p * FFT_PS + q * 16 + ((c + q) & 15)], T2[q]);
    dft16_dit<+1>(v);
#pragma unroll
    for (int b = 0; b < 16; ++b) ex[p * FFT_PS + 16 * b + c] = v[b];
}
template <class EX> HD void fft_inv_c(c32 (&v)[16], const c32* T1, EX ex, int tid) {
#pragma unroll
    for (int p = 0; p < 16; ++p) { v[BR4(p)] = cmulc(ex[p * FFT_PS + tid], T1[256 * p]); if ((p & 3) == 3) __builtin_amdgcn_sched_barrier(0); }
    dft16_dit<+1>(v);
}
constexpr int NWAVES = 8, NTHR = 512;
constexpr int BATCH = 8, SEQ = 4096, DM = 1024, T = BATCH * SEQ;
constexpr float EPS = 1e-6f;
constexpr size_t MiB = 1u << 20;
constexpr size_t WS_CTL = 0, CTL_ZERO_BYTES = 64 * 1024;
constexpr size_t WS_MOD = 1 * MiB;
constexpr size_t WS_HDNS = 1 * MiB + 512 * 1024;
constexpr size_t WS_W4S = 3 * MiB + 512 * 1024;
constexpr size_t WS_LIST = 101 * MiB;
constexpr size_t WS_WL = 396 * MiB;
constexpr size_t WS_WD = 8 * MiB;
constexpr size_t WS_WUQ = 9 * MiB;
constexpr size_t WS_WUKV = 10 * MiB;
constexpr size_t WS_WO = 11 * MiB;
constexpr size_t WS_WIN = 13 * MiB;
constexpr size_t WS_WOUT = 19 * MiB;
constexpr size_t WS_WGU = 21 * MiB;
constexpr size_t WS_WDN = 53 * MiB;
constexpr size_t R1 = 104 * MiB;
constexpr size_t R2 = 232 * MiB;
constexpr size_t R3 = 424 * MiB;
constexpr size_t WS_VT8 = R1, WS_XN2 = R1, WS_KF = R1;
constexpr size_t WS_XN = R2, WS_O = R2;
constexpr size_t WS_LAT = R2 + 64 * MiB;
constexpr size_t WS_HACT = R2 + 64 * MiB;
constexpr size_t WS_CQN = R2 + 128 * MiB;
constexpr size_t WS_CKVN = R2 + 144 * MiB;
constexpr size_t WS_KPE = R2 + 160 * MiB;
constexpr size_t WS_K8 = R2 + 64 * MiB;
constexpr size_t WS_ROPE = R2 + 164 * MiB;
constexpr size_t WS_QRAW = 408 * MiB;
constexpr size_t WS_XN2S = 424 * MiB;
constexpr size_t WS_XR = 424 * MiB;
constexpr size_t WS_HT = R2;
constexpr size_t WS_UT = R2;
constexpr size_t WS_Z = R2;
constexpr size_t WS_END = 512 * MiB;
constexpr int MS_ROWS = T + 24 * 256;
constexpr int CW_BAR = 4096;
constexpr int CW_ADA = 12416;
constexpr int CW_FILT = 12352;
constexpr int CW_CNT = 8192;
constexpr int RING_OFF = 0, RING_BYTES = 147456;
constexpr int LDSCTL_OFF = RING_BYTES;
constexpr int MISC_OFF = LDSCTL_OFF;
constexpr int TINFO_OFF = LDSCTL_OFF + 256;
constexpr int RED_OFF = LDSCTL_OFF + 256 + 1280;
constexpr int EPIX_OFF = LDSCTL_OFF + 2048;
constexpr int LDS_BYTES = 163840;
static_assert(RED_OFF + 256 <= LDS_BYTES, "LDS map");

#define GAS __attribute__((address_space(1)))
#define LAS __attribute__((address_space(3)))
typedef unsigned short bf16;
typedef unsigned v4u __attribute__((ext_vector_type(4)));
typedef unsigned v2u __attribute__((ext_vector_type(2)));
typedef int v4i __attribute__((ext_vector_type(4)));
typedef float f32x4 __attribute__((ext_vector_type(4)));
typedef GAS unsigned gu32;
#define RLX_AGENT __ATOMIC_RELAXED, __HIP_MEMORY_SCOPE_AGENT
#define LDS_WAIT() asm volatile("s_waitcnt lgkmcnt(0)" ::: "memory")
__device__ __forceinline__ unsigned pk2(float lo, float hi) { return pg8::cvt_pk_bf16(lo, hi); }
__device__ __forceinline__ float bf2f(unsigned short b) { return __uint_as_float(((unsigned)b) << 16); }
__device__ __forceinline__ float wave_max_nn(float v) {
#define WM_DPP(x, ctrl, rmask) __int_as_float(__builtin_amdgcn_update_dpp(0, __float_as_int(x), ctrl, rmask, 0xf, false))
    v = fmaxf(v, WM_DPP(v, 0xB1, 0xf)); v = fmaxf(v, WM_DPP(v, 0x4E, 0xf)); v = fmaxf(v, WM_DPP(v, 0x141, 0xf)); v = fmaxf(v, WM_DPP(v, 0x140, 0xf));
    v = fmaxf(v, WM_DPP(v, 0x142, 0xa)); v = fmaxf(v, WM_DPP(v, 0x143, 0xc));
#undef WM_DPP
    return __int_as_float(__builtin_amdgcn_readlane(__float_as_int(v), 63));
}
__device__ __forceinline__ float wave_sum(float v) {
#define WS_DPP(x, ctrl, rmask) __int_as_float(__builtin_amdgcn_update_dpp(0, __float_as_int(x), ctrl, rmask, 0xf, false))
    v += WS_DPP(v, 0xB1, 0xf); v += WS_DPP(v, 0x4E, 0xf); v += WS_DPP(v, 0x141, 0xf); v += WS_DPP(v, 0x140, 0xf);
    v += WS_DPP(v, 0x142, 0xa); v += WS_DPP(v, 0x143, 0xc);
#undef WS_DPP
    return __int_as_float(__builtin_amdgcn_readlane(__float_as_int(v), 63));
}

#define XB_TMO      128
#define XB_XCNT(j)  (256  + 64 * (j))
#define XB_XSUB(j)  (1280 + 64 * (j))
#define XB_XGEN(j)  (2304 + 64 * (j))
#define XB_TOP      3328
#define XB_TOPGEN   3392
#define XCD_BAR_WORDS 3456
#define XB_SPIN_CAP (1u << 18)

__device__ __forceinline__ unsigned xb_ld(unsigned* p)              { return __hip_atomic_load(p, __ATOMIC_RELAXED, __HIP_MEMORY_SCOPE_AGENT); }
__device__ __forceinline__ unsigned xb_add(unsigned* p, unsigned v) { return __hip_atomic_fetch_add(p, v, __ATOMIC_RELAXED, __HIP_MEMORY_SCOPE_AGENT); }
__device__ __forceinline__ unsigned xb_xcc_id() { return (unsigned)__builtin_amdgcn_s_getreg((3 << 11) | 20) & 0xFu; }
#define XB_SPIN(cond, bar) do { unsigned _sp = 0; while (cond) { __builtin_amdgcn_s_sleep(1); \
    if ((++_sp & 255u) == 0u) { if (xb_ld(&(bar)[XB_TMO])) break; if (_sp > XB_SPIN_CAP) { atomicAdd(&(bar)[XB_TMO], 1u); break; } } } } while (0)

struct XcdBarrier {
    unsigned* bar; unsigned x;
    volatile LAS unsigned* st;
    int w0;
};

__device__ __forceinline__ XcdBarrier xcd_barrier_post(unsigned* bar, volatile LAS unsigned* st) {
    XcdBarrier b; b.bar = bar; b.x = xb_xcc_id(); b.st = st; b.w0 = 0;
    if (threadIdx.x == 0) (void)xb_add(&bar[XB_XCNT(b.x)], 1u);
    return b;
}
__device__ __forceinline__ void xcd_barrier_complete(unsigned* bar, unsigned x, unsigned& nloc, unsigned& nx) {
    const unsigned G = gridDim.x * gridDim.y * gridDim.z;
    unsigned sum, cnt, mine, sp = 0u;
    for (;;) {
        sum = 0u; cnt = 0u; mine = 0u;
#pragma unroll
        for (unsigned j = 0; j < 16; ++j) { const unsigned c = xb_ld(&bar[XB_XCNT(j)]); sum += c; cnt += (c > 0u) ? 1u : 0u; mine = (j == x) ? c : mine; }
        if (sum == G) break;
        __builtin_amdgcn_s_sleep(1);
        if ((++sp & 255u) == 0u) { if (xb_ld(&bar[XB_TMO])) break; if (sp > XB_SPIN_CAP) { atomicAdd(&bar[XB_TMO], 1u); break; } }
    }
    nloc = mine > 0u ? mine : 1u; nx = cnt > 0u ? cnt : 1u;
}

__device__ __forceinline__ void xcd_barrier(const XcdBarrier& b) {
    asm volatile("s_waitcnt vmcnt(0)" ::: "memory");
    __syncthreads();
    if (b.w0 && __builtin_amdgcn_mbcnt_hi(~0u, __builtin_amdgcn_mbcnt_lo(~0u, 0u)) == 0u) {
        unsigned* bar = b.bar;
        __builtin_amdgcn_s_waitcnt(0);
        unsigned nloc = b.st[0], nx = b.st[1];
        if (nloc == 0u) { xcd_barrier_complete(bar, b.x, nloc, nx); b.st[0] = nloc; b.st[1] = nx; }
        const unsigned old = xb_add(&bar[XB_XSUB(b.x)], 1u);
        const unsigned gen = old / nloc;
        if (old + 1u == (gen + 1u) * nloc) {
            __builtin_amdgcn_fence(__ATOMIC_RELEASE, "agent");
            asm volatile("s_waitcnt vmcnt(0)" ::: "memory");
            const unsigned og = xb_add(&bar[XB_TOP], 1u);
            const unsigned tg = og / nx;
            if (og + 1u == (tg + 1u) * nx) xb_add(&bar[XB_TOPGEN], 1u);
            else XB_SPIN(xb_ld(&bar[XB_TOPGEN]) == tg, bar);
            __builtin_amdgcn_fence(__ATOMIC_ACQUIRE, "agent");
            xb_add(&bar[XB_XGEN(b.x)], 1u);
            asm volatile("s_waitcnt vmcnt(0)" ::: "memory");
        } else {
            XB_SPIN(xb_ld(&bar[XB_XGEN(b.x)]) == gen, bar);
            __builtin_amdgcn_fence(__ATOMIC_ACQUIRE, "agent");
            asm volatile("s_waitcnt vmcnt(0)" ::: "memory");
        }
    }
    __syncthreads();
}


struct Ctx { unsigned char* lds; int tid, lane, wave, vcu, G, gw, NGW; };

__device__ __forceinline__ void transpose_item(const float* W, int ldw, int k0, int n0, bf16* WT, int ldt, int drow0, int dcol0, float* scr, int lane, bool kpe_perm) {
    float tv[32];
#pragma unroll
    for (int i = 0; i < 32; ++i) { const int kk = 2 * i + (lane >> 5); tv[i] = W[(size_t)(k0 + kk) * ldw + n0 + (lane & 31)]; }
#pragma unroll
    for (int i = 0; i < 32; ++i) { const int kk = 2 * i + (lane >> 5); scr[kk * 33 + (lane & 31)] = tv[i]; }
    LDS_WAIT();
    const int c = lane & 7;
#pragma unroll
    for (int j = 0; j < 4; ++j) { const int n = (lane >> 3) + 8 * j; const float* s = scr + (8 * c) * 33 + n;
        v4u o; o.x = pk2(s[0 * 33], s[1 * 33]); o.y = pk2(s[2 * 33], s[3 * 33]); o.z = pk2(s[4 * 33], s[5 * 33]); o.w = pk2(s[6 * 33], s[7 * 33]);
        int dr = drow0 + n; if (kpe_perm && dr >= 384 && dr < 448) { const int e = dr - 384; dr = 384 + 32 * ((e >> 4) & 1) + 16 * (e >> 5) + (e & 15); }
        *(v4u*)(WT + (size_t)dr * ldt + dcol0 + k0 + 8 * c) = o; }
    LDS_WAIT();
}
__device__ __forceinline__ void transpose_item8(const float* W, int ldw, int k0, int n0, unsigned char* WT8, int ldt8, int drow0, int dcol0, float* scr, int lane, float scale, bool kpe_perm) {
    float tv[32];
#pragma unroll
    for (int i = 0; i < 32; ++i) { const int kk = 2 * i + (lane >> 5); tv[i] = W[(size_t)(k0 + kk) * ldw + n0 + (lane & 31)]; }
#pragma unroll
    for (int i = 0; i < 32; ++i) { const int kk = 2 * i + (lane >> 5); scr[kk * 33 + (lane & 31)] = tv[i]; }
    LDS_WAIT();
    const int n = lane >> 1, hf = lane & 1; const float* sp = scr + (32 * hf) * 33 + n;
    v4u o0, o1; unsigned w[8];
#pragma unroll
    for (int q = 0; q < 8; ++q) { int p = 0; p = __builtin_amdgcn_cvt_pk_fp8_f32(sp[(4 * q) * 33] * scale, sp[(4 * q + 1) * 33] * scale, p, false); p = __builtin_amdgcn_cvt_pk_fp8_f32(sp[(4 * q + 2) * 33] * scale, sp[(4 * q + 3) * 33] * scale, p, true); w[q] = (unsigned)p; }
    o0.x = w[0]; o0.y = w[1]; o0.z = w[2]; o0.w = w[3]; o1.x = w[4]; o1.y = w[5]; o1.z = w[6]; o1.w = w[7];
    int dr = drow0 + n; if (kpe_perm && dr >= 384 && dr < 448) { const int e = dr - 384; dr = 384 + 32 * ((e >> 4) & 1) + 16 * (e >> 5) + (e & 15); }
    unsigned char* d = WT8 + (size_t)dr * ldt8 + dcol0 + k0 + 32 * hf;
    *(v4u*)d = o0; *(v4u*)(d + 16) = o1;
    LDS_WAIT();
}
typedef __attribute__((address_space(4))) const char kchar;
struct In { int opq;
    __device__ __forceinline__ const float* operator[](int k) const { kchar* ka = (kchar*)__builtin_amdgcn_kernarg_segment_ptr(); return *(const float* const __attribute__((address_space(4)))*)(ka + 8 * k + opq); } };
__device__ __forceinline__ unsigned char* karg_ws(int opq) { kchar* ka = (kchar*)__builtin_amdgcn_kernarg_segment_ptr(); return *(unsigned char* const __attribute__((address_space(4)))*)(ka + 38 * 8 + 8 + opq); }
__device__ __forceinline__ float* karg_out(int opq) { kchar* ka = (kchar*)__builtin_amdgcn_kernarg_segment_ptr(); return *(float* const __attribute__((address_space(4)))*)(ka + 38 * 8 + opq); }

__device__ __forceinline__ int adaln_claim(const Ctx& F, const In& in, unsigned char* ws, int layer, gu32* claim, int max_items) {
    float* cact = (float*)(F.lds + RING_OFF); float* red = cact + 8 * 1024; int* dsl = (int*)(F.lds + RED_OFF) + 61;
    float* MOD = (float*)(ws + WS_MOD); int done = 0;
    for (int n = 0; n < max_items; ++n) {
        __syncthreads();
        if (F.tid == 0) *dsl = (int)__hip_atomic_fetch_add(claim, 1u, RLX_AGENT);
        __syncthreads();
        const int cb = *dsl; if (cb >= 96) break;
        if (done == 0) { { float xc_[16];
#pragma unroll
      for (int q = 0; q < 16; ++q) xc_[q] = in[1][F.tid + q * NTHR];
#pragma unroll
      for (int q = 0; q < 16; ++q) { const int i = F.tid + q * NTHR; const float x = xc_[q]; cact[(i & 1023) * 8 + (i >> 10)] = x / (1.f + __expf(-x)); } } __syncthreads(); }
        const int r4 = F.lane >> 4, cq = F.lane & 15;
        const float* W = in[3] + (size_t)layer * 1024 * 6144 + cb * 64 + 4 * cq + (size_t)(F.wave * 128 + r4) * 6144;
        f32x4 acc[8];
#pragma unroll
        for (int b = 0; b < 8; ++b) acc[b] = (f32x4){0.f, 0.f, 0.f, 0.f};
#pragma unroll
        for (int hf = 0; hf < 2; ++hf) { f32x4 wv[16];
#pragma unroll
          for (int q = 0; q < 16; ++q) wv[q] = *(const f32x4*)(W + (size_t)(4 * (16 * hf + q)) * 6144);
          asm volatile("" ::: "memory");
#pragma unroll
          for (int q = 0; q < 16; ++q) { const int kk = 4 * (16 * hf + q) + r4; const float* cp = cact + (F.wave * 128 + kk) * 8; const f32x4 c0 = *(const f32x4*)cp, c1 = *(const f32x4*)(cp + 4);
#pragma unroll
            for (int b = 0; b < 8; ++b) acc[b] += (b < 4 ? c0[b & 3] : c1[b & 3]) * wv[q]; } }
#pragma unroll
        for (int b = 0; b < 8; ++b) *(f32x4*)(red + ((F.wave * 4 + r4) * 8 + b) * 64 + 4 * cq) = acc[b];
        __syncthreads();
        { const int b = F.tid >> 6, col = F.tid & 63; float s_ = in[4][layer * 6144 + cb * 64 + col];
#pragma unroll 8
          for (int p = 0; p < 32; ++p) s_ += red[(p * 8 + b) * 64 + col];
          MOD[((size_t)layer * 8 + b) * 6144 + cb * 64 + col] = s_; }
        ++done;
    }
    __syncthreads();
    return done;
}
__device__ __forceinline__ void p0_prologue(const Ctx& F, const In& in, unsigned char* ws) {
    float* scr = (float*)(F.lds + RING_OFF + F.wave * 8448);
    float* cact = (float*)(F.lds + RING_OFF + 67584); float* red = (float*)(F.lds + RING_OFF + 100352);
    bf16* Wd = (bf16*)(ws + WS_WD); bf16* Wuq = (bf16*)(ws + WS_WUQ); bf16* Wukv = (bf16*)(ws + WS_WUKV); bf16* Wo = (bf16*)(ws + WS_WO);
    bf16* Win = (bf16*)(ws + WS_WIN); bf16* Wout = (bf16*)(ws + WS_WOUT); bf16* Wgu = (bf16*)(ws + WS_WGU); bf16* Wdn = (bf16*)(ws + WS_WDN);
    constexpr int I_D = 16 * 14, I_UQ = 4 * 48, I_UKV = 2 * 64, I_O = 16 * 32, I_IN = 16 * 96, I_OUT = 16 * 32, I_GU = 2 * 16 * 2 * (16 * 8), I_DN = 2 * 16 * (4 * 32);
    constexpr int NITEMS = I_D + I_UQ + I_UKV + I_O + I_IN + I_OUT + I_GU + I_DN;
    { float xc_[16];
#pragma unroll
      for (int q = 0; q < 16; ++q) xc_[q] = in[1][F.tid + q * NTHR];
#pragma unroll
      for (int q = 0; q < 16; ++q) { const int i = F.tid + q * NTHR; const float x = xc_[q]; cact[(i & 1023) * 8 + (i >> 10)] = x / (1.f + __expf(-x)); } }
    __syncthreads();
    const bool ada_on = F.vcu < 96; const int ada_layer = 0, ada_cb = F.vcu, ada_r4 = F.lane >> 4, ada_cq = F.lane & 15;
    const float* adaW = in[3] + (size_t)ada_layer * 1024 * 6144 + ada_cb * 64 + 4 * ada_cq + (size_t)(F.wave * 128 + ada_r4) * 6144;
    f32x4 ada_acc[8], ada_wv[16];
#pragma unroll
    for (int b = 0; b < 8; ++b) ada_acc[b] = (f32x4){0.f, 0.f, 0.f, 0.f};
#define ADA_ISSUE(hf) do { if (ada_on) { _Pragma("unroll") for (int q = 0; q < 16; ++q) ada_wv[q] = *(const f32x4*)(adaW + (size_t)(4 * (16 * (hf) + q)) * 6144); } asm volatile("" ::: "memory"); } while (0)
#define ADA_EAT(hf) do { if (ada_on) { _Pragma("unroll") for (int q = 0; q < 16; ++q) { const int kk = 4 * (16 * (hf) + q) + ada_r4; const float* cp = cact + (F.wave * 128 + kk) * 8; const f32x4 c0 = *(const f32x4*)cp, c1 = *(const f32x4*)(cp + 4); \
        _Pragma("unroll") for (int b = 0; b < 8; ++b) ada_acc[b] += (b < 4 ? c0[b & 3] : c1[b & 3]) * ada_wv[q]; } } } while (0)
    ADA_ISSUE(0);
    const int it_mid = F.gw + 6 * F.NGW;
    for (int part = 0; part < 2; ++part) {
    if (part == 1) { ADA_EAT(0); ADA_ISSUE(1); }
    for (int it = part ? it_mid : F.gw; it < (part ? NITEMS : (it_mid < NITEMS ? it_mid : NITEMS)); it += F.NGW) {
        int r = it; const float* W; int ldw, k0, n0, ldt, drow0, dcol0 = 0; bf16* WT; float f8s = 0.f;
        if (r < I_D) { W = in[7]; ldw = 448; k0 = (r / 14) * 64; n0 = (r % 14) * 32; WT = Wd; ldt = 1024; drow0 = n0; f8s = 32.f; }
        else if ((r -= I_D) < I_UQ) { W = in[10]; ldw = 1536; k0 = (r / 48) * 64; n0 = (r % 48) * 32; WT = Wuq; ldt = 256; drow0 = n0; f8s = 16.f; }
        else if ((r -= I_UQ) < I_UKV) { W = in[11]; ldw = 2048; k0 = (r / 64) * 64; n0 = (r % 64) * 32; ldt = 128;
            WT = Wukv + ((n0 & 128) ? 1024 * 128 : 0); drow0 = (n0 >> 8) * 128 + (n0 & 127); }
        else if ((r -= I_UKV) < I_O) { W = in[14]; ldw = 1024; k0 = (r / 32) * 64; n0 = (r % 32) * 32; WT = Wo; ldt = 1024; drow0 = n0; f8s = 32.f; }
        else if ((r -= I_O) < I_IN) { W = in[15]; ldw = 3072; k0 = (r / 96) * 64; n0 = (r % 96) * 32; WT = Win; ldt = 1024; drow0 = n0; }
        else if ((r -= I_IN) < I_OUT) { W = in[30]; ldw = 1024; k0 = (r / 32) * 64; n0 = (r % 32) * 32; WT = Wout; ldt = 1024; drow0 = n0; }
        else if ((r -= I_OUT) < I_GU) {
            const int sub = r % 128, mat = r / 128, which = mat & 1, le = mat >> 1;
            W = (which ? in[36] : in[35]) + (size_t)le * 1024 * 256; ldw = 256; k0 = (sub / 8) * 64; n0 = (sub % 8) * 32;
            WT = (bf16*)((unsigned char*)Wgu + (size_t)le * 512 * 1024); ldt = 1024; drow0 = (n0 >> 7) * 256 + which * 128 + (n0 & 127); f8s = 32.f; }
        else { r -= I_GU;
            const int sub = r % 128, le = r / 128;
            W = in[37] + (size_t)le * 256 * 1024; ldw = 1024; k0 = (sub / 32) * 64; n0 = (sub % 32) * 32;
            WT = (bf16*)((unsigned char*)Wdn + (size_t)le * 1024 * 256); ldt = 256; drow0 = n0; f8s = 32.f; }
        if (f8s != 0.f) transpose_item8(W, ldw, k0, n0, (unsigned char*)WT, ldt, drow0, dcol0, scr, F.lane, f8s, it < I_D);
        else transpose_item(W, ldw, k0, n0, WT, ldt, drow0, dcol0, scr, F.lane, it < I_D);
    } }
    ADA_EAT(1);
#undef ADA_ISSUE
#undef ADA_EAT
    if (ada_on) {
#pragma unroll
        for (int b = 0; b < 8; ++b)
#pragma unroll
            for (int j = 0; j < 4; ++j) ada_acc[b][j] = pg8::xsum16_32(ada_acc[b][j]);
        if (F.lane < 16) {
#pragma unroll
            for (int b = 0; b < 8; ++b) *(f32x4*)(red + (F.wave * 8 + b) * 64 + 4 * ada_cq) = ada_acc[b]; } }
    { const int gt = F.vcu * NTHR + F.tid, NGT = F.G * NTHR; const v4u z = {0u, 0u, 0u, 0u};
      for (int i = gt; i < 64 * 1024 / 16; i += NGT) *(v4u*)((unsigned char*)Wd + (size_t)448 * 1024 + (size_t)i * 16) = z;
    }
    { const int gt = F.vcu * NTHR + F.tid, NGT = F.G * NTHR; float* RT = (float*)(ws + WS_ROPE); const int* posi = (const int*)in[2];
      const float inv = __builtin_amdgcn_exp2f(-0.41524101186092029f * (float)(gt & 31));
      if (NGT * 8 == T * 32) {
        int pos8[8];
#pragma unroll
        for (int q = 0; q < 8; ++q) pos8[q] = posi[(gt + q * NGT) >> 5];
#pragma unroll
        for (int q = 0; q < 8; ++q) { const int i = gt + q * NGT; float sn, cs; sincosf((float)pos8[q] * inv, &sn, &cs); *(v2u*)(RT + (size_t)i * 2) = (v2u){__float_as_uint(cs), __float_as_uint(sn)}; }
      } else
      for (int i = gt; i < T * 32; i += NGT) { const int t = i >> 5;
        float sn, cs; sincosf((float)posi[t] * inv, &sn, &cs); *(v2u*)(RT + (size_t)i * 2) = (v2u){__float_as_uint(cs), __float_as_uint(sn)}; } }
    { const int gt = F.vcu * NTHR + F.tid, NGT = F.G * NTHR; bf16* W4S = (bf16*)(ws + WS_W4S); const float* w4 = in[28];
      for (int i = gt; i < 4096 * 8; i += NGT) { const int col = i & 4095, oct = i >> 12; float w[8];
#pragma unroll
        for (int q = 0; q < 8; ++q) w[q] = w4[(size_t)(8 * oct + q) * 4096 + col];
        unsigned hw[4], lw[4];
#pragma unroll
        for (int q = 0; q < 4; ++q) { const unsigned h2 = pk2(w[2 * q], w[2 * q + 1]); hw[q] = h2;
          lw[q] = pk2(w[2 * q] - __uint_as_float(h2 << 16), w[2 * q + 1] - __uint_as_float(h2 & 0xffff0000u)); }
        bf16* d = W4S + (size_t)col * 256 + 8 * oct; const v4u hv = {hw[0], hw[1], hw[2], hw[3]}, lv = {lw[0], lw[1], lw[2], lw[3]}, zv = {0u, 0u, 0u, 0u};
        *(v4u*)d = hv; *(v4u*)(d + 64) = hv; *(v4u*)(d + 128) = lv; *(v4u*)(d + 192) = zv; } }
    __syncthreads();
    { bf16* HDp = (bf16*)(ws + WS_HDNS); float* wl = (float*)(F.lds + RING_OFF); float* sv = wl + 161 * 64 + F.wave * 64;
      { float wt_[21];
#pragma unroll
        for (int q = 0; q < 21; ++q) { const int i = F.tid + q * NTHR; wt_[q] = i < 33 * 64 ? in[19][i] : (i < 97 * 64 ? in[22][i - 33 * 64] : (i < 161 * 64 ? in[25][i - 97 * 64] : 0.f)); }
#pragma unroll
        for (int q = 0; q < 21; ++q) { const int i = F.tid + q * NTHR; if (i < 161 * 64) wl[i] = wt_[q]; } }
      __syncthreads();
      const int j = F.lane; const float b1 = in[20][j], f1 = in[21][j], b2 = in[23][j], f2 = in[24][j], b3 = in[26][j], f3 = in[27][j];
      for (int t = F.gw; t < 4096; t += F.NGW) {
        float zf = 0.f;
        { const float w = 6.2831855f * (float)t * (1.f / 4096.f);
          if (j == 0) zf = (float)t / 4095.f;
          else if (j <= 16) { const float fr = 1e-4f + (float)(j - 1) * ((15.f - 1e-4f) / 15.f); zf = cosf(fr * w); }
          else if (j <= 32) { const float fr = 1e-4f + (float)(j - 17) * ((15.f - 1e-4f) / 15.f); zf = -sinf(fr * w); } }
        sv[j] = zf; LDS_WAIT();
        float a = b1;
#pragma unroll
        for (int k = 0; k < 33; ++k) a += sv[k] * wl[k * 64 + j];
        float h = sinf(f1 * a); LDS_WAIT(); sv[j] = h; LDS_WAIT();
        a = b2;
#pragma unroll 16
        for (int k = 0; k < 64; ++k) a += sv[k] * wl[(33 + k) * 64 + j];
        h = sinf(f2 * a); LDS_WAIT(); sv[j] = h; LDS_WAIT();
        a = b3;
#pragma unroll 16
        for (int k = 0; k < 64; ++k) a += sv[k] * wl[(97 + k) * 64 + j];
        h = sinf(f3 * a); LDS_WAIT();
        const unsigned hi = pk2(h, 0.f) & 0xffffu; const float lo = h - bf2f((unsigned short)hi); const unsigned lob = pk2(lo, 0.f) & 0xffffu;
        bf16* d = HDp + (size_t)t * 256 + j; d[0] = (bf16)hi; d[64] = (bf16)lob; d[128] = (bf16)hi; d[192] = 0;
      } }
    __syncthreads();
    if (ada_on) { const int b = F.tid >> 6, col = F.tid & 63; float s_ = in[4][ada_layer * 6144 + ada_cb * 64 + col];
#pragma unroll
        for (int w = 0; w < 8; ++w) s_ += red[(w * 8 + b) * 64 + col];
        ((float*)(ws + WS_MOD))[((size_t)ada_layer * 8 + b) * 6144 + ada_cb * 64 + col] = s_; }
}

template <class TX> __device__ __forceinline__ f32x4 ldrow4(const TX* p);
template <> __device__ __forceinline__ f32x4 ldrow4<float>(const float* p) { return *(const __attribute__((address_space(1))) f32x4*)p; }
template <> __device__ __forceinline__ f32x4 ldrow4<bf16>(const bf16* p) { const v2u w = *(const __attribute__((address_space(1))) v2u*)p; f32x4 r; r[0] = __uint_as_float(w.x << 16); r[1] = __uint_as_float(w.x & 0xffff0000u); r[2] = __uint_as_float(w.y << 16); r[3] = __uint_as_float(w.y & 0xffff0000u); return r; }
template <class TX, bool OUT8 = false> __device__ __forceinline__ void norm_mod_phase(const Ctx& F, const TX* X, const float* g, const float* sc, const float* sh, bf16* OUT) {
    for (int ch = F.gw; ch < T / 16; ch += F.NGW) {
        const int r0 = ch * 16, b = r0 >> 12;
        f32x4 A[4], S[4];
#pragma unroll
        for (int j = 0; j < 4; ++j) { const int col = 4 * F.lane + 256 * j; const f32x4 gv = *(const f32x4*)(g + col), sv = *(const f32x4*)(sc + (size_t)b * 6144 + col); A[j] = gv * (1.f + sv); S[j] = *(const f32x4*)(sh + (size_t)b * 6144 + col); }
        const TX* xr = X + (size_t)r0 * DM + 4 * F.lane;
        f32x4 nx[4];
#pragma unroll
        for (int j = 0; j < 4; ++j) nx[j] = ldrow4<TX>(xr + 256 * j);
        for (int rr = 0; rr < 16; ++rr) {
            f32x4 v[4]; float ss = 0.f;
#pragma unroll
            for (int j = 0; j < 4; ++j) { v[j] = nx[j]; ss += (v[j].x * v[j].x + v[j].y * v[j].y) + (v[j].z * v[j].z + v[j].w * v[j].w); }
            if (rr < 15) {
#pragma unroll
                for (int j = 0; j < 4; ++j) nx[j] = ldrow4<TX>(xr + (size_t)(rr + 1) * DM + 256 * j); }
            const float rstd = rsqrtf(wave_sum(ss) * (1.f / DM) + EPS);
            if constexpr (OUT8) { unsigned char* orow = (unsigned char*)OUT + (size_t)(r0 + rr) * DM + 4 * F.lane;
#pragma unroll
                for (int j = 0; j < 4; ++j) { const f32x4 o = v[j] * rstd * A[j] + S[j]; int p = 0; p = __builtin_amdgcn_cvt_pk_fp8_f32(o.x, o.y, p, false); p = __builtin_amdgcn_cvt_pk_fp8_f32(o.z, o.w, p, true); *(int*)(orow + 256 * j) = p; } }
            else { bf16* orow = OUT + (size_t)(r0 + rr) * DM + 4 * F.lane;
#pragma unroll
                for (int j = 0; j < 4; ++j) { const f32x4 o = v[j] * rstd * A[j] + S[j]; v2u w; w.x = pk2(o.x, o.y); w.y = pk2(o.z, o.w); *(v2u*)(orow + 256 * j) = w; } } }
    }
}

__device__ __forceinline__ void lat_post_phase(const Ctx& F, const float* LAT, const float* qag, const float* kvag, const float* kng, const float* rope, bf16* CQN, bf16* CKVN, bf16* KPE) {
    const int l = F.lane;
    const f32x4 gq = *(const f32x4*)(qag + 4 * l);
    const f32x4 g2 = l < 32 ? *(const f32x4*)(kvag + 4 * l) : (l < 48 ? *(const f32x4*)(kng + 128 + 4 * (l - 32)) : (f32x4){0.f, 0.f, 0.f, 0.f});
    f32x4 na = *(const f32x4*)(LAT + (size_t)F.gw * 512 + 4 * l), nc = l < 48 ? *(const f32x4*)(LAT + (size_t)F.gw * 512 + 256 + 4 * l) : (f32x4){0.f, 0.f, 0.f, 0.f};
    for (int row = F.gw; row < T; row += F.NGW) {
        const f32x4 a = na, c = nc;
        if (row + F.NGW < T) { const float* nr = LAT + (size_t)(row + F.NGW) * 512; na = *(const f32x4*)(nr + 4 * l); if (l < 48) nc = *(const f32x4*)(nr + 256 + 4 * l); }
        const float sq = (a.x * a.x + a.y * a.y) + (a.z * a.z + a.w * a.w), sc = (c.x * c.x + c.y * c.y) + (c.z * c.z + c.w * c.w);
        const float s_q = wave_sum(sq), s_kv = wave_sum(l < 32 ? sc : 0.f), s_pe = wave_sum((l >= 32 && l < 48) ? sc : 0.f);
        const float rq = rsqrtf(s_q * (1.f / 256.f) + EPS), rkv = rsqrtf(s_kv * (1.f / 128.f) + EPS), rpe = rsqrtf(s_pe * (1.f / 64.f) + EPS);
        { const f32x4 o = a * rq * gq; v2u w; w.x = pk2(o.x, o.y); w.y = pk2(o.z, o.w); *(v2u*)(CQN + (size_t)row * 256 + 4 * l) = w; }
        if (l < 32) { const f32x4 o = c * rkv * g2; v2u w; w.x = pk2(o.x, o.y); w.y = pk2(o.z, o.w); *(v2u*)(CKVN + (size_t)row * 256 + 4 * l) = w; }
        else { v2u w; w.x = 0u; w.y = 0u; *(v2u*)(CKVN + (size_t)row * 256 + 128 + 4 * (l - 32)) = w; }
        const f32x4 n = c * rpe * g2;
        f32x4 other; other.x = __shfl_xor(n.x, 8); other.y = __shfl_xor(n.y, 8); other.z = __shfl_xor(n.z, 8); other.w = __shfl_xor(n.w, 8);
        if (l >= 32 && l < 48) { const bool first = l < 40; const int e0 = 4 * ((l - 32) & 7);
            float o[4];
#pragma unroll
            for (int i = 0; i < 4; ++i) { const int e = e0 + i; const float cs = rope[(size_t)row * 64 + e * 2], sn = rope[(size_t)row * 64 + e * 2 + 1];
                const float mine = n[i], oth = other[i]; o[i] = first ? (mine * cs - oth * sn) : (oth * sn + mine * cs); }
            v2u w; w.x = pk2(o[0], o[1]); w.y = pk2(o[2], o[3]); *(v2u*)(KPE + (size_t)row * 64 + 4 * (l - 32)) = w; }
    }
}

__device__ __forceinline__ void knorm_phase(const Ctx& F, bf16* KV, const float* kng) {
    const int l = F.lane, h = l >> 3, e0 = (l & 7) * 16;
    float g[16];
#pragma unroll
    for (int i = 0; i < 16; ++i) g[i] = kng[e0 + i];
    for (int row = F.gw; row < T; row += F.NGW) {
        bf16* p = KV + (size_t)row * 2048 + h * 256 + e0;
        const v4u r0 = *(const v4u*)p, r1 = *(const v4u*)(p + 8);
        float f[16]; const unsigned w[8] = {r0.x, r0.y, r0.z, r0.w, r1.x, r1.y, r1.z, r1.w};
        float ss = 0.f;
#pragma unroll
        for (int i = 0; i < 8; ++i) { f[2 * i] = __uint_as_float(w[i] << 16); f[2 * i + 1] = __uint_as_float(w[i] & 0xffff0000u); ss += f[2 * i] * f[2 * i] + f[2 * i + 1] * f[2 * i + 1]; }
        ss += __shfl_xor(ss, 1); ss += __shfl_xor(ss, 2); ss += __shfl_xor(ss, 4);
        const float r = rsqrtf(ss * (1.f / 128.f) + EPS);
        v4u o0, o1;
        o0.x = pk2(f[0] * r * g[0], f[1] * r * g[1]); o0.y = pk2(f[2] * r * g[2], f[3] * r * g[3]); o0.z = pk2(f[4] * r * g[4], f[5] * r * g[5]); o0.w = pk2(f[6] * r * g[6], f[7] * r * g[7]);
        o1.x = pk2(f[8] * r * g[8], f[9] * r * g[9]); o1.y = pk2(f[10] * r * g[10], f[11] * r * g[11]); o1.z = pk2(f[12] * r * g[12], f[13] * r * g[13]); o1.w = pk2(f[14] * r * g[14], f[15] * r * g[15]);
        *(v4u*)p = o0; *(v4u*)(p + 8) = o1;
    }
}

__device__ __forceinline__ void route_phase(const Ctx& F, const bf16* X, const float* g, const float* sc, const float* sh, const float* wg, const float* bg, const float* we, const float* be,
                                            bf16* XN2, int* LIST, float* WL, gu32* cnt) {
    float* W20 = (float*)(F.lds + RING_OFF); constexpr int W20P = 1028;
    unsigned* lcnt = (unsigned*)(F.lds + RED_OFF); unsigned* gbase = lcnt + 32;
    if (F.tid < 24) lcnt[F.tid] = 0u;
    { float t_[8];
#pragma unroll
      for (int q = 0; q < 8; ++q) t_[q] = wg[F.tid + q * NTHR];
#pragma unroll
      for (int q = 0; q < 8; ++q) { const int i = F.tid + q * NTHR; W20[(i & 3) * W20P + (i >> 2)] = t_[q]; }
      for (int b0 = 0; b0 < 16 * 1024; b0 += 8 * NTHR) {
#pragma unroll
        for (int q = 0; q < 8; ++q) t_[q] = we[b0 + F.tid + q * NTHR];
#pragma unroll
        for (int q = 0; q < 8; ++q) { const int i = b0 + F.tid + q * NTHR; W20[(4 + (i & 15)) * W20P + (i >> 4)] = t_[q]; } } }
    float* beL = W20 + 20 * W20P; if (F.tid < 16) beL[F.tid] = be[F.tid];
    __syncthreads();
    float bgv[4];
#pragma unroll
    for (int i = 0; i < 4; ++i) bgv[i] = bg[i];
    for (int ch0 = 0; ch0 < T / 16; ch0 += F.NGW) {
        const int ch = ch0 + F.gw; const bool act = ch < T / 16; const int r0 = (act ? ch : 0) * 16, b = r0 >> 12;
        f32x4 A[4], S[4];
#pragma unroll
        for (int j = 0; j < 4; ++j) { const int col = 4 * F.lane + 256 * j; const f32x4 gv = *(const f32x4*)(g + col), sv = *(const f32x4*)(sc + (size_t)b * 6144 + col); A[j] = gv * (1.f + sv); S[j] = *(const f32x4*)(sh + (size_t)b * 6144 + col); }
        const bf16* xr = X + (size_t)r0 * DM + 4 * F.lane;
        f32x4 nx[2][4];
#pragma unroll
        for (int u = 0; u < 2; ++u)
#pragma unroll
            for (int j = 0; j < 4; ++j) nx[u][j] = ldrow4<bf16>(xr + (size_t)u * DM + 256 * j);
        int my_bk = 0; float my_wlo = 0.f, my_whi = 0.f;
        for (int rr = 0; rr < 16; rr += 2) {
            f32x4 v[2][4]; float ss[2];
#pragma unroll
            for (int u = 0; u < 2; ++u) { ss[u] = 0.f;
#pragma unroll
                for (int j = 0; j < 4; ++j) { v[u][j] = nx[u][j]; ss[u] += (v[u][j].x * v[u][j].x + v[u][j].y * v[u][j].y) + (v[u][j].z * v[u][j].z + v[u][j].w * v[u][j].w); } }
            if (rr < 14) {
#pragma unroll
                for (int u = 0; u < 2; ++u)
#pragma unroll
                    for (int j = 0; j < 4; ++j) nx[u][j] = ldrow4<bf16>(xr + (size_t)(rr + 2 + u) * DM + 256 * j); }
            float gl[2][4]; int gi[2]; float gm[2];
#pragma unroll
            for (int u = 0; u < 2; ++u) { const int row = r0 + rr + u;
                const float rstd = rsqrtf(wave_sum(ss[u]) * (1.f / DM) + EPS);
                unsigned char* orow = (unsigned char*)XN2 + (size_t)row * DM + 4 * F.lane;
#pragma unroll
                for (int j = 0; j < 4; ++j) { v[u][j] = v[u][j] * rstd * A[j] + S[j]; int p = 0; p = __builtin_amdgcn_cvt_pk_fp8_f32(v[u][j].x, v[u][j].y, p, false); p = __builtin_amdgcn_cvt_pk_fp8_f32(v[u][j].z, v[u][j].w, p, true); *(int*)(orow + 256 * j) = p; }
#pragma unroll
                for (int o = 0; o < 4; ++o) { float a = 0.f;
#pragma unroll
                    for (int j = 0; j < 4; ++j) { const f32x4 w = *(const f32x4*)(W20 + o * W20P + 4 * F.lane + 256 * j); a += (v[u][j].x * w.x + v[u][j].y * w.y) + (v[u][j].z * w.z + v[u][j].w * w.w); }
                    gl[u][o] = wave_sum(a) + bgv[o]; }
                int g_ = 0; float m_ = gl[u][0]; if (gl[u][1] > m_) { m_ = gl[u][1]; g_ = 1; } if (gl[u][2] > m_) { m_ = gl[u][2]; g_ = 2; } if (gl[u][3] > m_) { m_ = gl[u][3]; g_ = 3; }
                gi[u] = __builtin_amdgcn_readfirstlane(g_); gm[u] = m_; }
#pragma unroll
            for (int u = 0; u < 2; ++u) {
                const float gw_ = __builtin_amdgcn_rcpf(__expf(gl[u][0] - gm[u]) + __expf(gl[u][1] - gm[u]) + __expf(gl[u][2] - gm[u]) + __expf(gl[u][3] - gm[u]));
                const float* We = W20 + (4 + 4 * gi[u]) * W20P + 4 * F.lane;
                float e[4];
#pragma unroll
                for (int k = 0; k < 4; ++k) { float a = 0.f;
#pragma unroll
                    for (int j = 0; j < 4; ++j) { const f32x4 w = *(const f32x4*)(We + k * W20P + 256 * j); a += (v[u][j].x * w.x + v[u][j].y * w.y) + (v[u][j].z * w.z + v[u][j].w * w.w); }
                    e[k] = wave_sum(a) + beL[4 * gi[u] + k]; }
                int i1 = 0; float m1 = e[0];
#pragma unroll
                for (int k = 1; k < 4; ++k) if (e[k] > m1) { m1 = e[k]; i1 = k; }
                int i2 = -1; float m2 = -3.0e38f;
#pragma unroll
                for (int k = 0; k < 4; ++k) if (k != i1 && e[k] > m2) { m2 = e[k]; i2 = k; }
                const float t2 = __expf(m2 - m1), w1 = gw_ * __builtin_amdgcn_rcpf(1.f + t2), w2 = w1 * t2;
                const int ilo = i1 < i2 ? i1 : i2, ihi = i1 < i2 ? i2 : i1; const float wlo = i1 < i2 ? w1 : w2, whi = i1 < i2 ? w2 : w1;
                const int pi = ilo == 0 ? ihi - 1 : (ilo == 1 ? ihi + 1 : 5), bk = gi[u] * 6 + pi;
                if (F.lane == rr + u) { my_bk = bk; my_wlo = wlo; my_whi = whi; }
            }
        }
        unsigned rank = 0u; if (F.lane < 16 && act) rank = __hip_atomic_fetch_add(lcnt + my_bk, 1u, __ATOMIC_RELAXED, __HIP_MEMORY_SCOPE_WORKGROUP);
        __syncthreads();
        if (F.tid < 24) { const unsigned n = lcnt[F.tid]; gbase[F.tid] = n ? __hip_atomic_fetch_add(cnt + F.tid * 64, n, RLX_AGENT) : 0u; }
        __syncthreads();
        if (F.lane < 16 && act) { const unsigned pos = gbase[my_bk] + rank;
            LIST[my_bk * 32768 + pos] = r0 + F.lane; float2 ww; ww.x = my_wlo; ww.y = my_whi; *(float2*)(WL + ((size_t)my_bk * 32768 + pos) * 2) = ww; }
        __syncthreads();
        if (F.tid < 24) lcnt[F.tid] = 0u;
        __syncthreads();
    }
}
__device__ __forceinline__ void moe_table(const Ctx& F, const gu32* cnt) {
    int* tinfo = (int*)(F.lds + TINFO_OFF);
    __syncthreads();
    if (F.tid < 24) tinfo[288 + F.tid] = (int)__hip_atomic_load(cnt + F.tid * 64, RLX_AGENT);
    __syncthreads();
    if (F.tid == 0) { int nt = 0;
        for (int b = 0; b < 24; ++b) { const int c = tinfo[288 + b]; const int tiles = (c + 255) >> 8;
            tinfo[256 + b] = nt * 256; for (int i = 0; i < tiles; ++i) tinfo[1 + nt + i] = b; nt += tiles; }
        tinfo[0] = nt; }
    __syncthreads();
}
__device__ __forceinline__ void permute_phase(const Ctx& F, const bf16* XN2, const int* ROUTE, bf16* XN2S, int* TOKW) {
    const int* tinfo = (const int*)(F.lds + TINFO_OFF);
    for (int ch = F.gw; ch < T / 4; ch += F.NGW) {
        v4i r[4]; v4u a[4], bq[4];
#pragma unroll
        for (int i = 0; i < 4; ++i) { const int row = ch * 4 + i; r[i] = *(const v4i*)(ROUTE + (size_t)row * 4);
            a[i] = *(const v4u*)(XN2 + (size_t)row * DM + 8 * F.lane); bq[i] = *(const v4u*)(XN2 + (size_t)row * DM + 512 + 8 * F.lane); }
#pragma unroll
        for (int i = 0; i < 4; ++i) { const int row = ch * 4 + i, srow = tinfo[256 + r[i].x] + r[i].y;
            *(v4u*)(XN2S + (size_t)srow * DM + 8 * F.lane) = a[i]; *(v4u*)(XN2S + (size_t)srow * DM + 512 + 8 * F.lane) = bq[i];
            if (F.lane == 0) { v4i w; w.x = row; w.y = r[i].z; w.z = r[i].w; w.w = 0; *(v4i*)(TOKW + (size_t)srow * 4) = w; } }
    }
}

constexpr float W32C[16] = {1.f, 0.98078528040323043f, 0.92387953251128674f, 0.83146961230254524f, 0.70710678118654752f, 0.55557023301960218f, 0.38268343236508977f, 0.19509032201612825f,
                            0.f, -0.19509032201612825f, -0.38268343236508977f, -0.55557023301960218f, -0.70710678118654752f, -0.83146961230254524f, -0.92387953251128674f, -0.98078528040323043f};
constexpr float W32S[16] = {0.f, 0.19509032201612825f, 0.38268343236508977f, 0.55557023301960218f, 0.70710678118654752f, 0.83146961230254524f, 0.92387953251128674f, 0.98078528040323043f,
                            1.f, 0.98078528040323043f, 0.92387953251128674f, 0.83146961230254524f, 0.70710678118654752f, 0.55557023301960218f, 0.38268343236508977f, 0.19509032201612825f};
struct FftTw { const c32* T1; c32 tob; const c32* T2; };
template <int A> __device__ __forceinline__ c32 mul_to(c32 x, c32 tob) { const c32 y = cmul(x, tob); return cmk(y.x * W32C[A] + y.y * W32S[A], y.y * W32C[A] - y.x * W32S[A]); }
template <int A> __device__ __forceinline__ c32 mul_toc(c32 x, c32 tob) { const c32 y = cmulc(x, tob); return cmk(y.x * W32C[A] - y.y * W32S[A], y.y * W32C[A] + y.x * W32S[A]); }
#define TO_ALL(OP) OP(0) OP(1) OP(2) OP(3) OP(4) OP(5) OP(6) OP(7) OP(8) OP(9) OP(10) OP(11) OP(12) OP(13) OP(14) OP(15)
__device__ __forceinline__ void fft_twiddles(FftTw& W, int gt, c32* t1tab, c32* t2tab, int tid) {
    if (tid < 256) { float s, c; sincosf(-6.283185307179586f * (float)(((tid >> 4) * (tid & 15)) & 255) * (1.f / 256.f), &s, &c); t2tab[(tid >> 4) * 17 + (tid & 15)] = cmk(c, s); }
    for (int i = tid; i < 4096; i += NTHR) { const int p = i >> 8, t = i & 255; float s, c; sincosf(-6.283185307179586f * (float)((t * p) & 4095) * (1.f / 4096.f), &s, &c); t1tab[i] = cmk(c, s); }
    { float s, c; sincosf(-6.283185307179586f * (float)gt * (1.f / 8192.f), &s, &c); W.tob = cmk(c, s); }
    W.T1 = t1tab + gt; W.T2 = t2tab + (gt & 15) * 17;
    __syncthreads();
}
__device__ __forceinline__ void fft_forward_a(c32 (&v)[16], const FftTw& W, c32* ex, int gt) {
    __syncthreads();
    fft_fwd_a(v, W.T1, ex, gt);
    __syncthreads();
}
__device__ __forceinline__ void fft_forward_bc(c32 (&v)[16], const FftTw& W, c32* ex, int gt) {
    fft_fwd_b(v, W.T2, ex, ex, gt);
    __builtin_amdgcn_wave_barrier(); asm volatile("" ::: "memory");
    fft_fwd_c(v, ex, gt);
}
__device__ __forceinline__ void fft_forward(c32 (&v)[16], const FftTw& W, c32* ex, int gt) { fft_forward_a(v, W, ex, gt); fft_forward_bc(v, W, ex, gt); }
__device__ __forceinline__ void fft_inverse(c32 (&v)[16], const FftTw& W, c32* ex, int gt) {
    __builtin_amdgcn_wave_barrier(); asm volatile("" ::: "memory");
    fft_inv_a(v, ex, gt);
    __builtin_amdgcn_wave_barrier(); asm volatile("" ::: "memory");
    fft_inv_b(v, W.T2, ex, ex, gt);
    __syncthreads();
    fft_inv_c(v, W.T1, ex, gt);
}
__device__ __forceinline__ void filter_phase(const Ctx& F, const float* HT, const float* fbias, c32* KF, gu32* claim, int max_items) {
    const int g = __builtin_amdgcn_readfirstlane(F.tid >> 8), gt = F.tid & 255;
    c32* ex = (c32*)(F.lds + RING_OFF + g * 36864);
    float* rev = (float*)ex;
    float* red = (float*)(F.lds + RED_OFF);
    FftTw W; fft_twiddles(W, gt, (c32*)(F.lds + RING_OFF + 73728), (c32*)(F.lds + RING_OFF + 110592), F.tid);
    int* dsl = (int*)(F.lds + RED_OFF) + 60;
    for (int n = 0; n < max_items; ++n) {
        __syncthreads();
        if (F.tid == 0) *dsl = (int)__hip_atomic_fetch_add(claim, 1u, RLX_AGENT);
        __syncthreads();
        const int d = *dsl; if (d >= DM) break;
        int gtv = gt; asm volatile("" : "+v"(gtv));
        const float delta = fabsf(-120.39728043259361f + (float)d * ((40.546510810816436f + 120.39728043259361f) / 1023.f));
        const float* hfp = HT + (size_t)(g * 2048 + d) * 4096; const float* hbp = HT + (size_t)(g * 2048 + 1024 + d) * 4096;
        float hf[16], hb[16]; float sf = 0.f, sb = 0.f;
#pragma unroll
        for (int a = 0; a < 16; ++a) { const int t = 256 * a + gtv; const float dec = __expf(-((float)t * (1.f / 4095.f)) * delta); hf[a] = hfp[t] * dec; hb[a] = hbp[t] * dec; sf += fabsf(hf[a]); sb += fabsf(hb[a]); }
        sf = wave_sum(sf); sb = wave_sum(sb);
        __syncthreads();
        if (F.lane == 0) { red[F.wave * 2] = sf; red[F.wave * 2 + 1] = sb; }
        __syncthreads();
        sf = red[g * 8] + red[g * 8 + 2] + red[g * 8 + 4] + red[g * 8 + 6]; sb = red[g * 8 + 1] + red[g * 8 + 3] + red[g * 8 + 5] + red[g * 8 + 7];
        const float nf = 1.f / (sf + EPS) * (1.f / 8192.f), nb = 1.f / (sb + EPS) * (1.f / 8192.f);
#pragma unroll
        for (int a = 0; a < 16; ++a) rev[256 * a + gt] = hb[a] * nb;
        __syncthreads();
        c32 v[16];
#pragma unroll
        for (int a = 0; a < 16; ++a) { const int n = 256 * a + gt; hb[a] = n == 0 ? 0.f : rev[4096 - n]; hf[a] *= nf; v[a] = cmk(hf[a] + hb[a], 0.f); }
        fft_forward(v, W, ex, gt);
        c32* kf = KF + ((size_t)(d * 2 + g) * 2) * 4096; const float fb = fbias[g * 1024 + d] * (1.f / 4096.f);
#pragma unroll
        for (int i = 0; i < 16; ++i) kf[i * 256 + gtv] = cmk(v[i].x + fb, v[i].y);
#define OPX(A) v[A] = mul_to<A>(cmk(hf[A] - hb[A], 0.f), W.tob);
        TO_ALL(OPX)
#undef OPX
        fft_forward(v, W, ex, gt);
#pragma unroll
        for (int i = 0; i < 16; ++i) kf[4096 + i * 256 + gtv] = v[i];
    }
}
__device__ __forceinline__ void long_conv(c32 (&z)[16], const c32* kf, const FftTw& W, c32* ex, int gt) {
    typedef float f32x2v __attribute__((ext_vector_type(2))); typedef __attribute__((address_space(1))) const f32x2v gc32;
    c32 v[16], k[16]; int gk = gt; asm volatile("" : "+v"(gk));
#define OPX(A) v[A] = mul_to<A>(z[A], W.tob);
    TO_ALL(OPX)
#undef OPX
    fft_forward_a(v, W, ex, gt);
    asm volatile("" ::: "memory");
#pragma unroll
    for (int i = 0; i < 16; ++i) { const f32x2v t_ = ((gc32*)kf)[4096 + i * 256 + gk]; k[i] = cmk(t_.x, t_.y); }
    fft_forward_bc(v, W, ex, gt);
#pragma unroll
    for (int i = 0; i < 16; ++i) v[i] = cmul(v[i], k[i]);
    fft_inverse(v, W, ex, gt);
#define OPX(A) v[A] = mul_toc<A>(v[A], W.tob);
    TO_ALL(OPX)
#undef OPX
    fft_forward_a(z, W, ex, gt);
    asm volatile("" ::: "memory");
#pragma unroll
    for (int i = 0; i < 16; ++i) { const f32x2v t_ = ((gc32*)kf)[i * 256 + gk]; k[i] = cmk(t_.x, t_.y); }
    fft_forward_bc(z, W, ex, gt);
#pragma unroll
    for (int i = 0; i < 16; ++i) z[i] = cmul(z[i], k[i]);
    fft_inverse(z, W, ex, gt);
#pragma unroll
    for (int a = 0; a < 16; ++a) z[a] = cadd(z[a], v[a]);
}
struct RawSeq { v4u r[2][2]; };
__device__ __forceinline__ void raw_issue(RawSeq& q, const bf16* urow, int b0, int gt) {
    typedef __attribute__((address_space(1))) const v4u gv4u;
    asm volatile("" : "+v"(gt));
#pragma unroll
    for (int s_ = 0; s_ < 2; ++s_)
#pragma unroll
        for (int i = 0; i < 2; ++i) q.r[s_][i] = *(gv4u*)(urow + (size_t)(b0 + s_) * SEQ + (gt + 256 * i) * 8);
}
__device__ __forceinline__ void stage_conv3(c32 (&o)[16], const RawSeq& q, float w0, float w1, float w2, float cb, bf16* stg, int gt) {
    constexpr int SS = 4112;
    __syncthreads();
#pragma unroll
    for (int s_ = 0; s_ < 2; ++s_) {
#pragma unroll
        for (int i = 0; i < 2; ++i) *(v4u*)(stg + s_ * SS + 8 + (gt + 256 * i) * 8) = q.r[s_][i];
        if (gt == 0) { stg[s_ * SS + 7] = 0; stg[s_ * SS + 4104] = 0; } }
    __syncthreads();
#pragma unroll
    for (int a = 0; a < 16; ++a) { const int t = 256 * a + gt; float r[2];
#pragma unroll
        for (int s_ = 0; s_ < 2; ++s_) { const bf16* sp = stg + s_ * SS + 7 + t; r[s_] = w0 * bf2f(sp[0]) + w1 * bf2f(sp[1]) + w2 * bf2f(sp[2]) + cb; }
        o[a] = cmk(r[0], r[1]); if ((a & 3) == 3) __builtin_amdgcn_sched_barrier(0); }
}
__device__ __forceinline__ void conv_phase(const Ctx& F, const bf16* UT, const c32* KF, const float* convw, const float* convb, bf16* ZT) {
    const int g = __builtin_amdgcn_readfirstlane(F.tid >> 8), gt = F.tid & 255;
    c32* ex = (c32*)(F.lds + RING_OFF + g * 36864);
    bf16* stg = (bf16*)ex;
    float* cwl = (float*)(F.lds + RING_OFF + 112768);
    if (F.tid < 64) { const int k = F.tid >> 4, q = (F.tid >> 2) & 3, j = F.tid & 3, d = F.vcu + k * F.G, c = 1024 * q + d; if (q < 3 && d < DM) cwl[F.tid] = j < 3 ? convw[3072 * j + c] : convb[c]; }
    FftTw W; fft_twiddles(W, gt, (c32*)(F.lds + RING_OFF + 73728), (c32*)(F.lds + RING_OFF + 110592), F.tid);
    RawSeq raw;
    if (F.vcu < DM) raw_issue(raw, UT + (size_t)(2048 + F.vcu) * T, (2 * g) * 2, gt);
    int kitem = 0;
    for (int d = F.vcu; d < DM; d += F.G, ++kitem) {
        const c32* kf0 = KF + ((size_t)(d * 2 + 0) * 2) * 4096; const c32* kf1 = KF + ((size_t)(d * 2 + 1) * 2) * 4096;
        const float* cw = cwl + 16 * (kitem & 3);
        for (int pp = 0; pp < 2; ++pp) { const int b0 = (2 * g + pp) * 2;
            int gtv = gt; asm volatile("" : "+v"(gtv));
            c32 z[16], gate[16];
            stage_conv3(z, raw, cw[8], cw[9], cw[10], cw[11], stg, gtv);
            raw_issue(raw, UT + (size_t)d * T, b0, gtv);
            long_conv(z, kf0, W, ex, gtv);
            stage_conv3(gate, raw, cw[0], cw[1], cw[2], cw[3], stg, gtv);
            raw_issue(raw, UT + (size_t)(1024 + d) * T, b0, gtv);
#pragma unroll
            for (int a = 0; a < 16; ++a) z[a] = cmk(z[a].x * gate[a].x, z[a].y * gate[a].y);
            long_conv(z, kf1, W, ex, gtv);
            stage_conv3(gate, raw, cw[4], cw[5], cw[6], cw[7], stg, gtv);
            { const int dn = pp == 0 ? d : d + F.G; if (dn < DM) raw_issue(raw, UT + (size_t)(2048 + dn) * T, pp == 0 ? b0 + 2 : (2 * g) * 2, gtv); }
            bf16* zr = ZT + (size_t)d * T + (size_t)b0 * SEQ;
#pragma unroll
            for (int a = 0; a < 16; ++a) { const int t = 256 * a + gtv; const unsigned pk = pk2(z[a].x * gate[a].x, z[a].y * gate[a].y); zr[t] = (bf16)(pk & 0xffffu); zr[SEQ + t] = (bf16)(pk >> 16); }
        }
    }
}
__device__ __forceinline__ void transpose_phase(const Ctx& F, const bf16* ZT, bf16* Z) {
    bf16* tile = (bf16*)(F.lds + RING_OFF + F.wave * 8704);
    const int l = F.lane;
    v4u x[8];
    if (F.gw < 16 * 512) { const int d0 = (F.gw & 15) * 64, t0 = (F.gw >> 4) * 64;
#pragma unroll
        for (int i = 0; i < 8; ++i) x[i] = *(const v4u*)(ZT + (size_t)(d0 + i * 8 + (l >> 3)) * T + t0 + (l & 7) * 8); }
    for (int it = F.gw; it < 16 * 512; it += F.NGW) { const int d0 = (it & 15) * 64, t0 = (it >> 4) * 64;
#pragma unroll
        for (int i = 0; i < 8; ++i) { const int dr = i * 8 + (l >> 3), c = l & 7;
            v2u* p = (v2u*)(tile + dr * 68 + c * 8); v2u a; a.x = x[i].x; a.y = x[i].y; p[0] = a; a.x = x[i].z; a.y = x[i].w; p[1] = a; }
        const int itn = it + F.NGW;
        if (itn < 16 * 512) { const int dn = (itn & 15) * 64, tn = (itn >> 4) * 64;
#pragma unroll
            for (int i = 0; i < 8; ++i) x[i] = *(const v4u*)(ZT + (size_t)(dn + i * 8 + (l >> 3)) * T + tn + (l & 7) * 8); }
        LDS_WAIT();
#pragma unroll
        for (int i = 0; i < 8; ++i) { const int tr = i * 8 + (l >> 3), c = l & 7; unsigned short e[8];
#pragma unroll
            for (int k = 0; k < 8; ++k) e[k] = tile[(c * 8 + k) * 68 + tr];
            v4u o; o.x = e[0] | ((unsigned)e[1] << 16); o.y = e[2] | ((unsigned)e[3] << 16); o.z = e[4] | ((unsigned)e[5] << 16); o.w = e[6] | ((unsigned)e[7] << 16);
            *(v4u*)(Z + (size_t)(t0 + tr) * DM + d0 + c * 8) = o; }
        LDS_WAIT();
    }
}

constexpr int NPH = 22;
constexpr int seam_id(int k) { return k == 0 ? 0 : k == 1 ? 1 : k == 2 ? 2 : k == 4 ? 3 : k == 6 ? 4 : k == 7 ? 5 : k == 8 ? 6 : k == 10 ? 7 : k == 11 ? 8 : k == 12 ? 9 : k == 14 ? 10 : k == 15 ? 11 : k == 16 ? 12 : k == 17 ? 13 : k == 18 ? 14 : k == 20 ? 15 : -100; }
#ifdef PROBE_SEAM
__device__ __forceinline__ unsigned long long probe_now() { unsigned long long t; asm volatile("s_memrealtime %0\n\ts_waitcnt lgkmcnt(0)" : "=s"(t) :: "memory"); return t; }
#define SEAMHOOK(id) do { if ((id) == PROBE_SEAM) { const unsigned long long t1_ = probe_now(); while (probe_now() < t1_ + (t1_ - tlast_)) __builtin_amdgcn_s_sleep(4); } \
                          if ((id) + 1 == PROBE_SEAM) tlast_ = probe_now(); } while (0)
#define SEAMBAR(k) do { xcd_barrier(bar); SEAMHOOK(seam_id(k)); } while (0)
#else
#define SEAMHOOK(id) do { } while (0)
#define SEAMBAR(k) xcd_barrier(bar)
#endif
#define XN2P(L) ((L) == 0 ? (bf16*)out : WSP(bf16, WS_XN2))
#define MOE_PHASES(L) do { \
        const int mb = 8 + 10 * L; \
        if (IN(mb)) { PH_ARGS; const float* mod = WSP(float, WS_MOD) + (size_t)L * 8 * 6144; gu32* cnt = (gu32*)(ws + WS_CTL) + CW_CNT + L * 24 * 64; \
            route_phase(F, WSP(bf16, WS_XR), in[6] + L * 1024, mod + 4 * 1024, mod + 3 * 1024, in[31] + L * 4096, in[32] + L * 4, in[33] + L * 16384, in[34] + L * 16, XN2P(L), WSP(int, WS_LIST), WSP(float, WS_WL), cnt); \
            if (L == 0) { __syncthreads();        \
                pg8::Gemm gmh{WSP(bf16, WS_W4S), WSP(bf16, WS_HDNS), 4096, 4096, 256}; pg8::StaticOrder Sh; Sh.init(4096, 4096, F.G, (int)blockIdx.x); pg8::EpiF32 Eh{WSP(float, WS_HT), 4096}; \
                REP(11) pg8::gemm_phase<pg8::EpiF32, pg8::StaticOrder, true, true>(ring, gmh, Sh, Eh, F.tid); } } \
        if (IN(mb) && IN(mb + 2)) SEAMBAR(mb); \
        if (IN(mb + 2)) { PH_ARGS; gu32* cnt = (gu32*)(ws + WS_CTL) + CW_CNT + L * 24 * 64; moe_table(F, cnt); \
              \
            pg8::Gemm gm{XN2P(L), (const bf16*)(ws + WS_WGU + (size_t)L * 16 * 512 * 1024), MS_ROWS, 8192, 512}; pg8::MoeOrder S{tinfo, F.G, F.vcu, 0, WSP(int, WS_LIST)}; pg8::EpiSwiGLU E{WSP(unsigned char, WS_HACT), WSP(float, WS_WL), tinfo}; \
            REP(10) pg8::gemm_phase_gather<pg8::EpiSwiGLU, pg8::MoeOrder, true, true, 5>(ring, gm, S, E, F.tid); \
            if (L == 0) { const int nu = 4 * tinfo[0], mine = (nu - F.vcu + F.G - 1) / F.G, most = (nu + F.G - 1) / F.G;        \
                if (mine < most) { __syncthreads(); if (adaln_claim(F, in, ws, 1, (gu32*)(ws + WS_CTL) + CW_ADA, 1) == 0) filter_phase(F, WSP(float, WS_HT), in[29], WSP(c32, WS_KF), (gu32*)(ws + WS_CTL) + CW_FILT, most - mine); } } } SEAM(mb + 2); \
        if (IN(mb + 3)) { PH_ARGS; gu32* cnt = (gu32*)(ws + WS_CTL) + CW_CNT + L * 24 * 64; moe_table(F, cnt); const float* mod = WSP(float, WS_MOD) + (size_t)L * 8 * 6144; \
            pg8::Gemm gm{WSP(bf16, WS_HACT), (const bf16*)(ws + WS_WDN + (size_t)L * 16 * 1024 * 256), MS_ROWS, 16 * 1024, 256};   pg8::MoeOrder S{tinfo, F.G, F.vcu, 1, WSP(int, WS_LIST)}; if (L == 0) { pg8::EpiMoeOut<bf16> E{WSP(bf16, WS_XR), WSP(bf16, WS_XR), mod + 5 * 1024, WSP(int, WS_LIST), tinfo, (PG8_LAS float*)((PG8_LAS unsigned char*)lds + EPIX_OFF)}; pg8::gemm_phase<pg8::EpiMoeOut<bf16>, pg8::MoeOrder, true, true, 8, true>(ring, gm, S, E, F.tid); } \
            else { pg8::EpiMoeOut<float> E{WSP(bf16, WS_XR), out, mod + 5 * 1024, WSP(int, WS_LIST), tinfo, (PG8_LAS float*)((PG8_LAS unsigned char*)lds + EPIX_OFF)}; pg8::gemm_phase<pg8::EpiMoeOut<float>, pg8::MoeOrder, true, true, 8, true>(ring, gm, S, E, F.tid); } \
            if (L == 0) { __syncthreads(); { PH_ARGS; (void)adaln_claim(F, in, ws, 1, (gu32*)(ws + WS_CTL) + CW_ADA, 96); filter_phase(F, WSP(float, WS_HT), in[29], WSP(c32, WS_KF), (gu32*)(ws + WS_CTL) + CW_FILT, DM); } }       \
            } \
    } while (0)
struct Args { const float* in[38]; float* out; unsigned char* ws; int ph_lo, ph_hi; };
static_assert(sizeof(Args) == 38 * 8 + 8 + 8 + 8, "Args layout (read back through the kernarg segment pointer)");
__global__ void __launch_bounds__(NTHR, 2) fwd_kernel(Args args) {
    extern __shared__ __attribute__((aligned(16))) unsigned char lds[];
#define MK_CTX(F, tx) Ctx F; F.lds = lds; F.tid = (tx); F.lane = F.tid & 63; F.wave = __builtin_amdgcn_readfirstlane(F.tid >> 6); \
    F.G = gridDim.x; { const int bx = blockIdx.x; F.vcu = (F.G % 8 == 0) ? (bx % 8) * (F.G / 8) + bx / 8 : bx; } F.gw = F.vcu * NWAVES + F.wave; F.NGW = F.G * NWAVES
    for (int u = threadIdx.x; u < (LDS_BYTES - LDSCTL_OFF) / 4; u += NTHR) ((LAS unsigned*)((LAS unsigned char*)lds + LDSCTL_OFF))[u] = 0u;
    __syncthreads();
    const int wave_s_ = __builtin_amdgcn_readfirstlane(threadIdx.x >> 6);
    const int lo = args.ph_lo, hi = args.ph_hi;
    const bool use_bar = (hi - lo) > 1;
    XcdBarrier bar; bar.bar = (unsigned*)(args.ws + WS_CTL) + CW_BAR; bar.x = 0; bar.st = nullptr; bar.w0 = 0;
    if (use_bar) bar = xcd_barrier_post((unsigned*)(args.ws + WS_CTL) + CW_BAR, (volatile LAS unsigned*)((LAS unsigned char*)lds + MISC_OFF) + 8);
    bar.w0 = (wave_s_ == 0) ? 1 : 0;
#ifndef PHMASK
#define PHMASK 0xFFFFFFFFu
#endif
#define IN(k) (((PHMASK >> ((k) >= 18 ? (k) - 10 : (k))) & 1u) && lo <= (k) && (k) < hi)
#ifndef REPMASK
#define REPMASK 0u
#endif
#define NREP(k) (((REPMASK >> (k)) & 1u) ? 2 : 1)
#define REP(k) for (int rep_ = 0; rep_ < NREP(k); ++rep_)
#define SEAM(k) do { if (IN(k) && IN((k) + 1)) SEAMBAR(k); } while (0)
#define PH_STR2(x) #x
#define PH_STR(x) PH_STR2(x)
#define PH_ARGS int opq_ = 0; asm volatile("; PHMARK line " PH_STR(__LINE__) : "+s"(opq_)); const In in{opq_}; unsigned char* const ws = karg_ws(opq_); float* const out = karg_out(opq_); (void)in; (void)ws; (void)out; int tx_; asm volatile("v_mbcnt_lo_u32_b32 %0, -1, 0\n\tv_mbcnt_hi_u32_b32 %0, -1, %0" : "=v"(tx_)); tx_ += wave_s_ * 64; MK_CTX(F, tx_)
#define WSP(type, off) ((type*)(ws + (off)))
    PG8_LAS unsigned char* ring = (PG8_LAS unsigned char*)lds + RING_OFF;
    const PG8_LAS int* tinfo = (const PG8_LAS int*)((PG8_LAS unsigned char*)lds + TINFO_OFF);

#ifdef PROBE_SEAM
    unsigned long long tlast_ = probe_now();
#endif
    if (IN(0)) { PH_ARGS; REP(0) p0_prologue(F, in, ws); } SEAM(0);

            if (IN(1)) { PH_ARGS; const float* mod = WSP(float, WS_MOD); REP(1) norm_mod_phase<float, true>(F, in[0], in[5], mod + 1024, mod, WSP(bf16, WS_XN)); } SEAM(1);
            if (IN(2)) { PH_ARGS; pg8::Gemm gm{WSP(bf16, WS_XN), WSP(bf16, WS_WD), T, 512, 512};   pg8::StaticOrder S; S.init(T, 512, F.G, (int)blockIdx.x);
                pg8::EpiLat E{WSP(unsigned char, WS_CQN), WSP(bf16, WS_CKVN), WSP(unsigned char, WS_KPE), in[8], in[9], in[13], WSP(float, WS_ROPE), (PG8_LAS float*)((PG8_LAS unsigned char*)lds + EPIX_OFF)};
                REP(2) pg8::gemm_phase<pg8::EpiLat, pg8::StaticOrder, true, true, 5>(ring, gm, S, E, F.tid); }
            if (IN(2) && IN(4)) SEAMBAR(2);
            if (IN(4)) { REP(4) {
                { PH_ARGS; pg8::Gemm gm{WSP(bf16, WS_CQN), WSP(bf16, WS_WUQ), T, 1536, 128};   pg8::StaticOrder S; S.init(T, 1536, F.G, (int)blockIdx.x); pg8::EpiF8R E{WSP(unsigned char, WS_QRAW), 1536, 8.f};
                  pg8::gemm_phase<pg8::EpiF8R, pg8::StaticOrder, true, true, 4>(ring, gm, S, E, F.tid); }
                { PH_ARGS; pg8::Gemm gm{WSP(bf16, WS_CKVN), WSP(bf16, WS_WUKV), T, 1024, 128};   pg8::StaticOrder S; S.init(T, 1024, F.G, (int)blockIdx.x);
                  pg8::EpiK8 E{WSP(unsigned char, WS_K8), in[13], (PG8_LAS float*)((PG8_LAS unsigned char*)lds + EPIX_OFF)};
                  pg8::gemm_phase<pg8::EpiK8, pg8::StaticOrder, true, true>(ring, gm, S, E, F.tid); }
                { PH_ARGS; pg8::Gemm gm{WSP(bf16, WS_WUKV) + 1024 * 128, WSP(bf16, WS_CKVN), 1024, T, 128}; pg8::StaticOrder S; S.init(1024, T, F.G, (int)blockIdx.x);
                  pg8::EpiF8T E{WSP(unsigned char, WS_VT8), T};
                  pg8::gemm_phase<pg8::EpiF8T, pg8::StaticOrder, true, true>(ring, gm, S, E, F.tid); } }
            } if (IN(4) && IN(6)) SEAMBAR(4);
            if (IN(6)) { PH_ARGS;
                const float* qg = in[12]; const float* kg = in[13];
                const float q0_ = fabsf(qg[F.lane]), q1_ = fabsf(qg[64 + F.lane]), q2_ = fabsf(qg[128 + F.lane]), k0_ = fabsf(kg[F.lane]), k1_ = fabsf(kg[64 + F.lane]), k2_ = fabsf(kg[128 + F.lane]);
                const float gqn = wave_max_nn(fmaxf(q0_, q1_)), gkn = wave_max_nn(fmaxf(k0_, k1_)), gqp = wave_max_nn(q2_), gkp = wave_max_nn(k2_);
                const float smaxC = (128.f * gqn * gkn + 64.f * gqp * gkp) * (0.072168783648703220f * 1.4426950408889634f);
                { float* qgL = (float*)((char*)lds + RING_OFF + att::OFF_QG); if (F.tid < 192) qgL[F.tid] = qg[F.tid]; __syncthreads(); }
                unsigned redo_mask = 0u;
                if (smaxC < 60.f) for (int rep_ = 0; rep_ < NREP(6); ++rep_) { int i = 0;
                    for (int u = F.vcu; u < 1024; u += F.G, ++i) { const int b = u >> 7, h = (u >> 4) & 7, qb = u & 15;
                        if (att::attn_unit<false>(b, h, qb * 256, WSP(bf16, WS_QRAW), WSP(unsigned char, WS_VT8), WSP(unsigned char, WS_K8), WSP(unsigned char, WS_KPE), WSP(bf16, WS_O), WSP(float, WS_ROPE), qg, smaxC, (char*)lds + RING_OFF, F.tid)) redo_mask |= 1u << (i & 31); } }
                else redo_mask = 0xffffffffu;
                redo_mask = (unsigned)__builtin_amdgcn_readfirstlane((int)redo_mask);
                if (redo_mask) { int i = 0;
                    for (int u = F.vcu; u < 1024; u += F.G, ++i) { const int b = u >> 7, h = (u >> 4) & 7, qb = u & 15;
                        if ((redo_mask >> (i & 31)) & 1u) (void)att::attn_unit<true>(b, h, qb * 256, WSP(bf16, WS_QRAW), WSP(unsigned char, WS_VT8), WSP(unsigned char, WS_K8), WSP(unsigned char, WS_KPE), WSP(bf16, WS_O), WSP(float, WS_ROPE), qg, smaxC, (char*)lds + RING_OFF, F.tid); } }
            } SEAM(6);
            if (IN(7)) { PH_ARGS; pg8::Gemm gm{WSP(bf16, WS_O), WSP(bf16, WS_WO), T, 1024, 512};   pg8::StaticOrder S; S.init(T, 1024, F.G, (int)blockIdx.x); pg8::EpiResGate<float, bf16> E{in[0], WSP(bf16, WS_XR), WSP(float, WS_MOD) + 2048, 1024};
                REP(7) pg8::gemm_phase<pg8::EpiResGate<float, bf16>, pg8::StaticOrder, true, true, 10>(ring, gm, S, E, F.tid); } SEAM(7);
    MOE_PHASES(0); SEAM(11);
            if (IN(12)) { PH_ARGS; const float* mod = WSP(float, WS_MOD) + 8 * 6144; REP(12) norm_mod_phase(F, WSP(bf16, WS_XR), in[5] + 1024, mod + 1024, mod, (bf16*)out); }
            if (IN(12) && IN(14)) SEAMBAR(12);
            if (IN(14)) { PH_ARGS; pg8::Gemm gm{WSP(bf16, WS_WIN), (const bf16*)out, 3072, T, 1024}; pg8::StaticOrder S; S.init(3072, T, F.G, (int)blockIdx.x); pg8::EpiBf16R E{WSP(bf16, WS_UT), T, in[16]};
                REP(14) pg8::gemm_phase<pg8::EpiBf16R, pg8::StaticOrder, true, true>(ring, gm, S, E, F.tid); } SEAM(14);
            if (IN(15)) { PH_ARGS; for (int rep = 0; rep < NREP(15); ++rep) conv_phase(F, WSP(bf16, WS_UT), WSP(c32, WS_KF), in[17], in[18], (bf16*)out); } SEAM(15);
            if (IN(16)) { PH_ARGS; REP(16) transpose_phase(F, (const bf16*)out, WSP(bf16, WS_Z)); } SEAM(16);
            if (IN(17)) { PH_ARGS; pg8::Gemm gm{WSP(bf16, WS_Z), WSP(bf16, WS_WOUT), T, 1024, 1024}; pg8::StaticOrder S; S.init(T, 1024, F.G, (int)blockIdx.x); pg8::EpiResGate<bf16, bf16> E{WSP(bf16, WS_XR), WSP(bf16, WS_XR), WSP(float, WS_MOD) + 8 * 6144 + 2048, 1024};
                pg8::gemm_phase<pg8::EpiResGate<bf16, bf16>, pg8::StaticOrder, true, true>(ring, gm, S, E, F.tid); } SEAM(17);
    MOE_PHASES(1);
#ifdef PROBE_SEAM
    SEAMHOOK(16);
#endif
#undef IN
#undef SEAM
}

#ifndef ONE_LAUNCH
#define ONE_LAUNCH 1
#endif
extern "C" void kernel_launch(void* const* d_in, const int* in_sizes, int n_in, void* d_out, int out_size, void* d_ws, size_t ws_size, hipStream_t stream) {
    static int grid = 0;
    if (grid == 0) {
        if (n_in != 38 || in_sizes[0] != T * DM || out_size != T * DM || ws_size < WS_END) { fprintf(stderr, "kernel_launch: shape mismatch n_in %d in0 %d out %d ws %zu\n", n_in, n_in > 0 ? in_sizes[0] : -1, out_size, ws_size); grid = -1; return; }
        int dev = 0, cus = 0, per_cu = 0;
        if (hipGetDevice(&dev) != hipSuccess || hipDeviceGetAttribute(&cus, hipDeviceAttributeMultiprocessorCount, dev) != hipSuccess) { grid = -1; return; }
        if (hipFuncSetAttribute((const void*)fwd_kernel, hipFuncAttributeMaxDynamicSharedMemorySize, LDS_BYTES) != hipSuccess) { fprintf(stderr, "kernel_launch: hipFuncSetAttribute failed\n"); grid = -1; return; }
        if (hipOccupancyMaxActiveBlocksPerMultiprocessor(&per_cu, (const void*)fwd_kernel, NTHR, LDS_BYTES) != hipSuccess || per_cu < 1) { fprintf(stderr, "kernel_launch: occupancy query says %d\n", per_cu); }
        (void)hipGetLastError();
        grid = cus;
    }
    if (grid < 0) return;
    if (hipMemsetAsync((char*)d_ws + WS_CTL, 0, CTL_ZERO_BYTES, stream) != hipSuccess) return;
    Args a{};
    for (int i = 0; i < 38; ++i) a.in[i] = (const float*)d_in[i];
    a.out = (float*)d_out; a.ws = (unsigned char*)d_ws;
#if ONE_LAUNCH
    a.ph_lo = 0; a.ph_hi = NPH;
    hipLaunchKernelGGL(fwd_kernel, dim3(grid), dim3(NTHR), LDS_BYTES, stream, a);
#else
    for (int p = 0; p < NPH; ++p) { a.ph_lo = p; a.ph_hi = p + 1; hipLaunchKernelGGL(fwd_kernel, dim3(grid), dim3(NTHR), LDS_BYTES, stream, a); }
#endif
    const hipError_t le = hipPeekAtLastError();
    if (le != hipSuccess) fprintf(stderr, "kernel_launch: launch failed: %s\n", hipGetErrorName(le));
}
```
